# Optimizing an MI355X kernel written in HIP

```python
import math
import jax, jax.numpy as jnp
from jax import lax
import numpy as np

D_MODEL = 1024
BATCH = 16
SEQ = 4096
DEPTH = 2
DEC_BATCH = 1
DEC_SEQ = 16384
PAST_LEN = 128

HEAD_DIM = 64
H_NA = 4
H_DIL = 6
H_GDN = 6
W_NA = H_NA * HEAD_DIM
W_DIL = H_DIL * HEAD_DIM
W_GDN = H_GDN * HEAD_DIM
GRID_W = 64
NA_KH = 8
NA_KW = 16
NA_QB = 16
NA_BAND = 32
DIL_PATTERN = ((128, 1), (512, 4), (2048, 16))
DIL_HPG = H_DIL // len(DIL_PATTERN)
BAND_Q = 64
ROPE_THETA = 10000.0
GDN_CHUNK = 64
CONV_K = 5
N_EXPERTS = 16
D_EXPERT = 2048
EC_FACTOR = 2
N_BRANCH = 3
D_IN = 3 * W_NA + 3 * W_DIL + 4 * W_GDN + 4 * H_GDN + N_BRANCH * D_MODEL
DN_ALPHA = (2 * DEPTH) ** 0.25
DN_BETA = (8 * DEPTH) ** -0.25
LN_EPS = 1e-5
NORM_EPS = 1e-6

kernel_name = 'hybrid_natten_longnet_gdn_ec_encoder'


def layer_norm(x, g, b):
    xf = x.astype(jnp.float32)
    mu = jnp.mean(xf, axis=-1, keepdims=True)
    var = jnp.mean(jnp.square(xf - mu), axis=-1, keepdims=True)
    return ((xf - mu) * lax.rsqrt(var + LN_EPS) * g + b).astype(x.dtype)


def rope(x, pos):
    half = x.shape[-1] // 2
    inv = ROPE_THETA ** (-jnp.arange(half, dtype=jnp.float32) / half)
    ang = pos.astype(jnp.float32)[:, None] * inv[None, :]
    cos, sin = jnp.cos(ang)[:, None, :], jnp.sin(ang)[:, None, :]
    x1, x2 = x[..., :half], x[..., half:]
    return jnp.concatenate([x1 * cos - x2 * sin, x1 * sin + x2 * cos], axis=-1)


def neighbourhood_attention(q, k, v, rpb):
    b, s, h, dh = q.shape
    rows = s // GRID_W
    kh = min(NA_KH, rows)
    n_cb = GRID_W // NA_QB
    r = jnp.arange(rows)
    row_idx = jnp.clip(r - kh // 2, 0, rows - kh)[:, None] + jnp.arange(kh)[None, :]
    band_start = jnp.clip(jnp.arange(n_cb) * NA_QB - (NA_BAND - NA_QB) // 2, 0, GRID_W - NA_BAND)
    col_idx = band_start[:, None] + jnp.arange(NA_BAND)[None, :]
    qc = jnp.arange(n_cb)[:, None] * NA_QB + jnp.arange(NA_QB)[None, :]
    win_start = jnp.clip(qc - NA_KW // 2, 0, GRID_W - NA_KW)
    kcol = col_idx[:, None, :]
    col_ok = (kcol >= win_start[:, :, None]) & (kcol < win_start[:, :, None] + NA_KW)
    dr = row_idx - r[:, None] + (NA_KH - 1)
    dc = jnp.clip(kcol - qc[:, :, None], -(NA_KW - 1), NA_KW - 1) + (NA_KW - 1)
    bias = rpb[:, dr[:, None, None, :, None], dc[None, :, :, None, :]]
    qg = q.astype(jnp.float32).reshape(b, rows, n_cb, NA_QB, h, dh) * dh ** -0.5
    kg = k.astype(jnp.float32).reshape(b, rows, GRID_W, h, dh)
    vg = v.astype(jnp.float32).reshape(b, rows, GRID_W, h, dh)
    gi_r, gi_c = row_idx[:, None, :, None], col_idx[None, :, None, :]
    kn = kg[:, gi_r, gi_c]
    vn = vg[:, gi_r, gi_c]
    sc = jnp.einsum('brjqhd,brjiwhd->bhrjqiw', qg, kn) + bias
    sc = jnp.where(col_ok[:, :, None, :], sc, -jnp.inf)
    p = jax.nn.softmax(sc, axis=(-2, -1))
    o = jnp.einsum('bhrjqiw,brjiwhd->brjqhd', p, vn)
    return o.reshape(b, s, h * dh)


def banded_attention(q, k, v, half):
    n, L, h, dh = q.shape
    qb = min(BAND_Q, L)
    nb = -(-L // qb)
    Lp = nb * qb
    width = qb + 2 * half
    qp = jnp.pad(q.astype(jnp.float32), ((0, 0), (0, Lp - L), (0, 0), (0, 0))).reshape(n, nb, qb, h, dh)
    pad_kv = ((0, 0), (half, Lp - L + half), (0, 0), (0, 0))
    kp = jnp.pad(k.astype(jnp.float32), pad_kv)
    vp = jnp.pad(v.astype(jnp.float32), pad_kv)
    starts = jnp.arange(nb) * qb
    kidx = starts[:, None] + jnp.arange(width)[None, :]
    kb = kp[:, kidx]
    vb = vp[:, kidx]
    qpos = starts[:, None] + jnp.arange(qb)[None, :]
    kpos = (kidx - half)[:, None, :]
    valid = (jnp.abs(qpos[:, :, None] - kpos) <= half) & (kpos >= 0) & (kpos < L)
    sc = jnp.einsum('nbqhd,nbkhd->nhbqk', qp, kb) * dh ** -0.5
    sc = jnp.where(valid, sc, -jnp.inf)
    m = jnp.max(sc, axis=-1, keepdims=True)
    p = jnp.exp(sc - m)
    den = jnp.sum(p, axis=-1)
    den_t = jnp.moveaxis(den, 1, -1)
    o = jnp.einsum('nhbqk,nbkhd->nbqhd', p, vb) / den_t[..., None]
    o = o.reshape(n, Lp, h, dh)[:, :L]
    m_t = jnp.moveaxis(m[..., 0], 1, -1).reshape(n, Lp, h)[:, :L]
    return o, m_t, den_t.reshape(n, Lp, h)[:, :L]


def dilated_attention(q, k, v):
    b, s, h, dh = q.shape
    outs, maxes, dens = [], [], []
    for g, (win, dil) in enumerate(DIL_PATTERN):
        lo, hi = g * DIL_HPG, (g + 1) * DIL_HPG
        half = win // (2 * dil)
        L = s // dil

        def to_classes(t):
            t = t[:, :, lo:hi].reshape(b, L, dil, DIL_HPG, dh)
            return jnp.swapaxes(t, 1, 2).reshape(b * dil, L, DIL_HPG, dh)

        def from_classes(t):
            rest = t.shape[2:]
            return jnp.swapaxes(t.reshape(b, dil, L, *rest), 1, 2).reshape(b, s, *rest)

        o, m, den = banded_attention(to_classes(q), to_classes(k), to_classes(v), half)
        outs.append(from_classes(o))
        maxes.append(from_classes(m))
        dens.append(from_classes(den))
    o = jnp.stack(outs)
    m = jnp.stack(maxes)
    den = jnp.stack(dens)
    wgt = den * jnp.exp(m - jnp.max(m, axis=0))
    o = jnp.sum(wgt[..., None] * o, axis=0) / jnp.sum(wgt, axis=0)[..., None]
    return o.reshape(b, s, DIL_HPG * dh)


def centred_depthwise_conv(x, w):
    c = x.shape[-1]
    return lax.conv_general_dilated(x, w[:, None, :].astype(x.dtype), window_strides=(1,),
                                    padding=[(CONV_K // 2, CONV_K // 2)],
                                    dimension_numbers=('NWC', 'WIO', 'NWC'), feature_group_count=c)


def l2_normalize(x):
    return x * lax.rsqrt(jnp.sum(jnp.square(x), axis=-1, keepdims=True) + NORM_EPS)


def gated_delta_chunked(q, k, v, beta, g):
    b, s, h, dk = q.shape
    c = GDN_CHUNK
    n = s // c

    def chunks(t):
        return jnp.moveaxis(t.reshape(b, n, c, h, -1), 3, 1)

    q = chunks(q) * dk ** -0.5
    k = chunks(k)
    v = chunks(v)
    beta = jnp.moveaxis(beta.reshape(b, n, c, h), 3, 1)
    gc = jnp.cumsum(jnp.moveaxis(g.reshape(b, n, c, h), 3, 1), axis=-1)
    incl = jnp.tril(jnp.ones((c, c), bool))
    strict = jnp.tril(jnp.ones((c, c), bool), -1)
    diff = gc[..., :, None] - gc[..., None, :]
    decay = jnp.where(incl, jnp.exp(jnp.where(incl, diff, 0.0)), 0.0)
    kb = k * beta[..., None]
    a_mat = jnp.where(strict, jnp.einsum('bhnid,bhnjd->bhnij', kb, k) * decay, 0.0)
    eye = jnp.eye(c, dtype=a_mat.dtype)
    t_mat = lax.linalg.triangular_solve(a_mat + eye, jnp.broadcast_to(eye, a_mat.shape),
                                        left_side=True, lower=True, unit_diagonal=True)
    w = jnp.einsum('bhnij,bhnjd->bhnid', t_mat, kb * jnp.exp(gc)[..., None])
    u = jnp.einsum('bhnij,bhnjd->bhnid', t_mat, v * beta[..., None])
    intra = jnp.where(incl, jnp.einsum('bhnid,bhnjd->bhnij', q, k) * decay, 0.0)
    q_dec = q * jnp.exp(gc)[..., None]
    k_dec = k * jnp.exp(gc[..., -1:] - gc)[..., None]
    g_last = jnp.exp(gc[..., -1])

    def step(state, inp):
        q_i, k_i, u_i, w_i, intra_i, gl_i = inp
        v_new = u_i - jnp.einsum('bhcd,bhde->bhce', w_i, state)
        o_i = jnp.einsum('bhcd,bhde->bhce', q_i, state) + jnp.einsum('bhij,bhje->bhie', intra_i, v_new)
        state = state * gl_i[..., None, None] + jnp.einsum('bhcd,bhce->bhde', k_i, v_new)
        return state, o_i

    xs = tuple(jnp.moveaxis(t, 2, 0) for t in (q_dec, k_dec, u, w, intra, g_last))
    state0 = jnp.zeros((b, h, dk, v.shape[-1]), q.dtype)
    _, o = lax.scan(step, state0, xs)
    o = jnp.moveaxis(jnp.moveaxis(o, 0, 2), 1, 3)
    return o.reshape(b, s, h, -1)


def gdn_branch(q, k, v, z, b_logit, a_logit, conv_w, a_log, dt_bias, norm_w):
    b, s, _ = q.shape
    qkv = jax.nn.silu(centred_depthwise_conv(jnp.concatenate([q, k, v], axis=-1), conv_w)).astype(jnp.float32)
    q, k, v = jnp.split(qkv, 3, axis=-1)
    q = l2_normalize(q.reshape(b, s, H_GDN, HEAD_DIM))
    k = l2_normalize(k.reshape(b, s, H_GDN, HEAD_DIM))
    v = v.reshape(b, s, H_GDN, HEAD_DIM)
    beta = jax.nn.sigmoid(b_logit.astype(jnp.float32)).reshape(b, s, 2, H_GDN)
    g = -jnp.exp(a_log) * jax.nn.softplus(a_logit.astype(jnp.float32).reshape(b, s, 2, H_GDN) + dt_bias)
    o_fwd = gated_delta_chunked(q, k, v, beta[:, :, 0], g[:, :, 0])
    rev = lambda t: jnp.flip(t, axis=1)
    o_bwd = rev(gated_delta_chunked(rev(q), rev(k), rev(v), rev(beta[:, :, 1]), rev(g[:, :, 1])))
    o = o_fwd + o_bwd
    o = o * lax.rsqrt(jnp.mean(jnp.square(o), axis=-1, keepdims=True) + NORM_EPS) * norm_w
    return o.reshape(b, s, W_GDN) * jax.nn.silu(z.astype(jnp.float32))


def token_mixer(x, w_in, na_rpb, conv_w, a_log, dt_bias, gdn_norm_w, w_br_na, w_br_dil, w_br_gdn, w_out):
    b, s, _ = x.shape
    proj = jnp.einsum('bsd,de->bse', x, w_in)
    sizes = (W_NA,) * 3 + (W_DIL,) * 3 + (W_GDN,) * 4 + (2 * H_GDN, 2 * H_GDN, N_BRANCH * D_MODEL)
    offsets = [int(o) for o in np.cumsum(sizes)[:-1]]
    qa, ka, va, qd, kd, vd, qc, kc, vc, zc, bc, ac, gates = jnp.split(proj, offsets, axis=-1)
    heads = lambda t, h: t.reshape(b, s, h, HEAD_DIM)
    o_na = neighbourhood_attention(heads(qa, H_NA), heads(ka, H_NA), heads(va, H_NA), na_rpb)
    pos = jnp.arange(s)
    o_dil = dilated_attention(rope(heads(qd, H_DIL).astype(jnp.float32), pos),
                              rope(heads(kd, H_DIL).astype(jnp.float32), pos), heads(vd, H_DIL))
    o_gdn = gdn_branch(qc, kc, vc, zc, bc, ac, conv_w, a_log, dt_bias, gdn_norm_w)
    gate = jax.nn.sigmoid(gates.astype(jnp.float32)).reshape(b, s, N_BRANCH, D_MODEL)
    br_na = jnp.einsum('bsw,wd->bsd', o_na.astype(x.dtype), w_br_na)
    br_dil = jnp.einsum('bsw,wd->bsd', o_dil.astype(x.dtype), w_br_dil)
    br_gdn = jnp.einsum('bsw,wd->bsd', o_gdn.astype(x.dtype), w_br_gdn)
    merged = gate[:, :, 0] * br_na + gate[:, :, 1] * br_dil + gate[:, :, 2] * br_gdn
    return jnp.einsum('bsd,de->bse', merged.astype(x.dtype), w_out)


def expert_choice_ffn(x, w_router, w_up, w_gate, w_down):
    b, s, d = x.shape
    n = b * s
    t = x.reshape(n, d)
    aff = jax.nn.softmax(jnp.einsum('nd,de->ne', t, w_router).astype(jnp.float32), axis=-1)
    cap = EC_FACTOR * n // N_EXPERTS
    gate, idx = lax.top_k(aff.T, cap)
    xe = t[idx]
    hid = jax.nn.silu(jnp.einsum('ecd,edf->ecf', xe, w_gate)) * jnp.einsum('ecd,edf->ecf', xe, w_up)
    ye = jnp.einsum('ecf,efd->ecd', hid, w_down) * gate[..., None].astype(x.dtype)
    y = jnp.zeros_like(t).at[idx.reshape(-1)].add(ye.reshape(-1, d))
    return y.reshape(b, s, d)


def trunk(x, w_in, na_rpb, conv_w, a_log, dt_bias, gdn_norm_w, w_br_na, w_br_dil, w_br_gdn, w_out,
          ln1_g, ln1_b, w_router, w_up, w_gate, w_down, ln2_g, ln2_b):
    for l in range(DEPTH):
        mix = token_mixer(x, w_in[l], na_rpb[l], conv_w[l], a_log[l], dt_bias[l], gdn_norm_w[l],
                          w_br_na[l], w_br_dil[l], w_br_gdn[l], w_out[l])
        x = layer_norm(DN_ALPHA * x + mix, ln1_g[l], ln1_b[l])
        ffn = expert_choice_ffn(x, w_router[l], w_up[l], w_gate[l], w_down[l])
        x = layer_norm(DN_ALPHA * x + ffn, ln2_g[l], ln2_b[l])
    return x


def setup_inputs(seed: int = 0) -> dict:
    key = jax.random.key(seed)
    ks = jax.random.split(key, 20)
    f32 = jnp.float32
    nrm = lambda k, shape, scale: jax.random.normal(k, shape, f32) * scale
    w_dil_out = DIL_HPG * HEAD_DIM
    dt = jnp.exp(jax.random.uniform(ks[6], (DEPTH, 2, H_GDN), f32, math.log(1e-3), math.log(1e-1)))
    return {
        'x_prompt': nrm(ks[0], (BATCH, SEQ, D_MODEL), 1.0),
        'x_sample': nrm(ks[1], (DEC_BATCH, DEC_SEQ, D_MODEL), 1.0),
        'w_in': nrm(ks[2], (DEPTH, D_MODEL, D_IN), D_MODEL ** -0.5),
        'na_rpb': nrm(ks[3], (DEPTH, H_NA, 2 * NA_KH - 1, 2 * NA_KW - 1), 0.1),
        'conv_w': nrm(ks[4], (DEPTH, CONV_K, 3 * W_GDN), CONV_K ** -0.5),
        'a_log': jnp.log(jax.random.uniform(ks[5], (DEPTH, 2, H_GDN), f32, 1.0, 16.0)),
        'dt_bias': dt + jnp.log(-jnp.expm1(-dt)),
        'gdn_norm_w': 1.0 + nrm(ks[7], (DEPTH, HEAD_DIM), 0.01),
        'w_br_na': nrm(ks[8], (DEPTH, W_NA, D_MODEL), W_NA ** -0.5 * DN_BETA),
        'w_br_dil': nrm(ks[9], (DEPTH, w_dil_out, D_MODEL), w_dil_out ** -0.5 * DN_BETA),
        'w_br_gdn': nrm(ks[10], (DEPTH, W_GDN, D_MODEL), W_GDN ** -0.5 * DN_BETA),
        'w_out': nrm(ks[11], (DEPTH, D_MODEL, D_MODEL), D_MODEL ** -0.5 * DN_BETA),
        'ln1_g': 1.0 + nrm(ks[12], (DEPTH, D_MODEL), 0.01),
        'ln1_b': nrm(ks[13], (DEPTH, D_MODEL), 0.01),
        'w_router': nrm(ks[14], (DEPTH, D_MODEL, N_EXPERTS), D_MODEL ** -0.5),
        'w_up': nrm(ks[15], (DEPTH, N_EXPERTS, D_MODEL, D_EXPERT), D_MODEL ** -0.5),
        'w_gate': nrm(ks[16], (DEPTH, N_EXPERTS, D_MODEL, D_EXPERT), D_MODEL ** -0.5),
        'w_down': nrm(ks[17], (DEPTH, N_EXPERTS, D_EXPERT, D_MODEL), D_EXPERT ** -0.5 * DN_BETA),
        'ln2_g': 1.0 + nrm(ks[18], (DEPTH, D_MODEL), 0.01),
        'ln2_b': nrm(ks[19], (DEPTH, D_MODEL), 0.01),
    }


def reference(x_prompt, x_sample, w_in, na_rpb, conv_w, a_log, dt_bias, gdn_norm_w, w_br_na, w_br_dil,
              w_br_gdn, w_out, ln1_g, ln1_b, w_router, w_up, w_gate, w_down, ln2_g, ln2_b):
    y_prompt = trunk(x_prompt, w_in, na_rpb, conv_w, a_log, dt_bias, gdn_norm_w, w_br_na, w_br_dil, w_br_gdn,
                     w_out, ln1_g, ln1_b, w_router, w_up, w_gate, w_down, ln2_g, ln2_b)
    y_sample = trunk(x_sample, w_in, na_rpb, conv_w, a_log, dt_bias, gdn_norm_w, w_br_na, w_br_dil, w_br_gdn,
                     w_out, ln1_g, ln1_b, w_router, w_up, w_gate, w_down, ln2_g, ln2_b)
    return (y_prompt, y_sample)
```

```cpp
#include <hip/hip_runtime.h>
#include <stdint.h>
#include <stdio.h>

#define LAS __attribute__((address_space(3)))
#define DI __device__ __forceinline__
typedef unsigned short bf16_t;
typedef short bf16x8 __attribute__((ext_vector_type(8)));
typedef float f32x4 __attribute__((ext_vector_type(4)));
typedef float f32x2 __attribute__((ext_vector_type(2)));
typedef float f32x16 __attribute__((ext_vector_type(16)));
typedef unsigned u32x4 __attribute__((ext_vector_type(4)));
typedef unsigned u32x2 __attribute__((ext_vector_type(2)));
typedef __bf16 bf16x2v __attribute__((ext_vector_type(2)));

#ifndef MK_N_LAUNCHES
#define MK_N_LAUNCHES 1
#endif

constexpr int D = 1024, T_ALL = 81920, T_P = 65536, T_S = 16384, SLABMAX = 32768, NSLAB = 3;
constexpr int DIN = 6552, NPROJ = 6656;
constexpr int C_GATE = 0, C_QA = 3072, C_KA = 3328, C_VA = 3584, C_QD = 3840, C_KD = 4224, C_VD = 4608, C_QC = 4992, C_KC = 5376, C_VC = 5760, C_ZC = 6144;
constexpr int NE = 16, DE = 2048, CAP_P = 8192, CAP_S = 2048, CAP = CAP_P + CAP_S;
constexpr float ALPHA = 1.41421356237f, LN_EPS = 1e-5f, NORM_EPS = 1e-6f;
constexpr size_t MiB = 1u << 20;
constexpr size_t WS_CTL = 0, WS_WIN = 1 * MiB, WS_WBR = 14 * MiB, WS_WOUT = 16 * MiB, WS_WGU = 18 * MiB, WS_WD = 146 * MiB, WS_XB = 210 * MiB;
constexpr size_t WS_AFF = 370 * MiB, WS_SLOT = 375 * MiB, WS_IDX = 380 * MiB, WS_GATEV = 381 * MiB, WS_CS = 382 * MiB, WS_BIG = 386 * MiB, WS_END = 1130 * MiB;
constexpr size_t B_PROJ = 0, B_BA = 416 * MiB, B_ONA = 420 * MiB, B_ODIL = 436 * MiB, B_OGDN = 452 * MiB, B_DILP = 476 * MiB, B_DILM = 500 * MiB, B_GSCR = 502 * MiB, B_MERGEF = 502 * MiB, B_MERGED = 630 * MiB;
constexpr size_t B_XY0 = 0, B_XY1 = 160 * MiB, B_HID = 320 * MiB;
constexpr int GSTRIDE = 41216;
constexpr int LDS_BYTES = 147456;
constexpr int LDS_MISC = 145408;

DI unsigned pk2(float lo, float hi) { f32x2 v = {lo, hi}; bf16x2v b = __builtin_convertvector(v, bf16x2v); return __builtin_bit_cast(unsigned, b); }
DI float bflo(unsigned u) { return __uint_as_float(u << 16); }
DI float bfhi(unsigned u) { return __uint_as_float(u & 0xffff0000u); }
DI float frcp(float x) { return __builtin_amdgcn_rcpf(x); }
DI float frsq(float x) { return __builtin_amdgcn_rsqf(x); }
DI float sigmoidf_(float x) { return frcp(1.0f + __expf(-x)); }
DI float siluf_(float x) { return x * frcp(1.0f + __expf(-x)); }
DI float wave_sum(float v) {
#pragma unroll
    for (int o = 1; o < 64; o <<= 1) v += __shfl_xor(v, o);
    return v;
}
#define MFMA32(a, b, c) __builtin_amdgcn_mfma_f32_32x32x16_bf16((a), (b), (c), 0, 0, 0)
DI int crow(int reg, int h) { return (reg & 3) + 8 * (reg >> 2) + 4 * h; }
DI f32x16 zero16() { f32x16 z; for (int i = 0; i < 16; ++i) z[i] = 0.f; return z; }
template <int S> DI bf16x8 pack8(const f32x16& x) {
    u32x4 p; p[0] = pk2(x[8 * S], x[8 * S + 1]); p[1] = pk2(x[8 * S + 2], x[8 * S + 3]); p[2] = pk2(x[8 * S + 4], x[8 * S + 5]); p[3] = pk2(x[8 * S + 6], x[8 * S + 7]);
    return __builtin_bit_cast(bf16x8, p);
}

namespace pg8 {
constexpr int BM = 256, BK = 64, HALF = 128, HTB = HALF * BK * 2, STAGE_BYTES = 8 * HTB, NXCD = 8, WGM = 8;
__host__ __device__ __forceinline__ int lds_byte(int r, int c) { const int st = (r >> 4) * 2 + (c >> 5), rr = r & 15, cc = c & 31, ob = rr * 64 + cc * 2; return st * 1024 + (ob ^ (((ob >> 9) & 1) << 5)); }
__host__ __device__ __forceinline__ void stage_rc(int b, int& R, int& C) { const int st = b / 1024, sb = b % 1024, swz = sb ^ (((sb >> 9) & 1) << 5); R = (st >> 1) * 16 + swz / 64; C = (st & 1) * 32 + (swz % 64) / 2; }
__host__ __device__ __forceinline__ int perm32(int rho) { const int n = rho >> 4, i = rho & 15; return 8 * (i >> 2) + 4 * n + (i & 3); }
struct Unit { int pm, pn; };
struct Gemm { const bf16_t* A; const bf16_t* Bt; int M, N, K; };
struct StaticOrder {
    int nM, nN, nwg, G, c;
    __device__ void init(int M, int N, int G_, int c_) { nM = M / BM; nN = N / BM; nwg = nM * nN; G = G_; c = c_; }
    __device__ bool next(int i, Unit& u) const {
        const long L = (long)i * G + c; if (L >= nwg) return false;
        int wgid = (int)L; { const int q = nwg / NXCD, r = nwg % NXCD, xcd = wgid % NXCD, off = wgid / NXCD; wgid = (xcd < r ? xcd * (q + 1) : r * (q + 1) + (xcd - r) * q) + off; }
        const int nig = WGM * nN, gid = wgid / nig, fm = gid * WGM, gsz = (nM - fm) < WGM ? (nM - fm) : WGM;
        u.pm = fm + ((wgid % nig) % gsz); u.pn = (wgid % nig) / gsz; return true;
    }
    __device__ __forceinline__ void a_ready(const Unit&) const {}
    __device__ __forceinline__ void done(const Unit&) const {}
};
struct MoeOrder {
    int nMe, nNe, per, total, G, c;
    __device__ void init(int nE, int nMe_, int nNe_, int G_, int c_) { nMe = nMe_; nNe = nNe_; per = nMe * nNe; total = nE * per; G = G_; c = c_; }
    __device__ bool next(int i, Unit& u) const {
        const long L = (long)i * G + c; if (L >= total) return false;
        const int e = (int)(L / per), r = (int)(L % per);
        const int nig = WGM * nNe, gid = r / nig, fm = gid * WGM, gsz = (nMe - fm) < WGM ? (nMe - fm) : WGM;
        u.pm = e * nMe + fm + ((r % nig) % gsz); u.pn = e * nNe + (r % nig) / gsz; return true;
    }
    __device__ __forceinline__ void a_ready(const Unit&) const {}
    __device__ __forceinline__ void done(const Unit&) const {}
};

template <class Epi, class Sched>
__device__ __forceinline__ void gemm_phase(LAS unsigned char* lds, const Gemm g, const Sched& S, const Epi& E) {
    int tid = threadIdx.x; asm volatile("" : "+v"(tid));
    const int wid = __builtin_amdgcn_readfirstlane(tid >> 6), lane = tid & 63, wr = wid >> 2, wc = wid & 3, fr = lane & 15, fq = lane >> 4;
    int Kv = g.K; asm volatile("" : "+s"(Kv));
    const int K = Kv, nt = K / BK;
    unsigned voffA[2], voffB[2];
#pragma unroll
    for (int i = 0; i < 2; ++i) { int R, C; stage_rc(tid * 16 + i * 8192, R, C); const int Rb = Epi::PERM ? ((R & ~31) + perm32(R & 31)) : R;
        voffA[i] = (unsigned)(R * K + C) * 2u; voffB[i] = (unsigned)(Rb * K + C) * 2u; }
    const size_t kstep = (size_t)(BK * 2);
    const size_t hstep = (size_t)HALF * K * 2;
    const size_t tstep = 2 * hstep;
    const unsigned ldsw = (unsigned)wid * 1024u;
    const int aoff = lds_byte(wr * 64 + fr, fq * 8), boff = lds_byte(wc * 32 + fr, fq * 8);
#define PG8_SA(b, h) (((b) * 2 + (h)) * HTB)
#define PG8_SB(b, h) ((4 + (b) * 2 + (h)) * HTB)
#define PG8_STAGE(bufoff, gbase, voff) do { _Pragma("unroll") for (int _i = 0; _i < 2; ++_i) \
        __builtin_amdgcn_global_load_lds((const unsigned*)((const char*)(gbase) + (voff)[_i]), (LAS unsigned*)(lds + (bufoff) + ldsw + _i * 8192), 16, 0, 0); } while (0)
#define PG8_LDA(dst, b, h) do { _Pragma("unroll") for (int m = 0; m < 4; ++m) _Pragma("unroll") for (int k = 0; k < 2; ++k) dst[m][k] = *(const LAS bf16x8*)(lds + PG8_SA(b, h) + aoff + m * 2048 + k * 1024); } while (0)
#define PG8_LDB(dst, b, h) do { _Pragma("unroll") for (int n = 0; n < 2; ++n) _Pragma("unroll") for (int k = 0; k < 2; ++k) dst[n][k] = *(const LAS bf16x8*)(lds + PG8_SB(b, h) + boff + n * 2048 + k * 1024); } while (0)
#define PG8_MMA(ai, bj, At, Bt) do { __builtin_amdgcn_s_setprio(1); _Pragma("unroll") for (int m = 0; m < 4; ++m) _Pragma("unroll") for (int n = 0; n < 2; ++n) _Pragma("unroll") for (int k = 0; k < 2; ++k) \
        acc[ai][bj][m][n] = __builtin_amdgcn_mfma_f32_16x16x32_bf16(Bt[n][k], At[m][k], acc[ai][bj][m][n], 0, 0, 0); __builtin_amdgcn_s_setprio(0); } while (0)
#define PG8_WAIT_V(n) asm volatile("s_waitcnt vmcnt(" #n ")" ::: "memory")
#define PG8_WAIT_L(n) asm volatile("s_waitcnt lgkmcnt(" #n ")" ::: "memory")
#define PG8_BAR __builtin_amdgcn_s_barrier()
#define PG8_SCHED __builtin_amdgcn_sched_barrier(0)
    Unit cur, nxt; int ui = 0;
    if (!S.next(0, cur)) return;
    f32x4 acc[2][2][4][2];
#pragma unroll
    for (int a = 0; a < 2; ++a)
#pragma unroll
        for (int b = 0; b < 2; ++b)
#pragma unroll
            for (int m = 0; m < 4; ++m)
#pragma unroll
                for (int n = 0; n < 2; ++n) acc[a][b][m][n] = (f32x4){0.f, 0.f, 0.f, 0.f};
    bf16x8 At[4][2], B0[2][2], B1[2][2];
    const char* cA = (const char*)g.A + (size_t)cur.pm * tstep; const char* cB = (const char*)g.Bt + (size_t)cur.pn * tstep;
    S.a_ready(cur);
    PG8_STAGE(PG8_SB(0, 0), cB, voffB); PG8_STAGE(PG8_SA(0, 0), cA, voffA); PG8_STAGE(PG8_SB(0, 1), cB + hstep, voffB); PG8_STAGE(PG8_SA(0, 1), cA + hstep, voffA);
    if (wr == 1) PG8_BAR;
    PG8_WAIT_V(4); PG8_BAR;
    PG8_STAGE(PG8_SB(1, 0), cB + kstep, voffB); PG8_STAGE(PG8_SA(1, 0), cA + kstep, voffA); PG8_STAGE(PG8_SB(1, 1), cB + hstep + kstep, voffB);
    PG8_WAIT_V(6); PG8_BAR;
    for (;;) {
        const bool has_next = S.next(ui + 1, nxt);
        const char* nA = has_next ? (const char*)g.A + (size_t)nxt.pm * tstep : cA; const char* nB = has_next ? (const char*)g.Bt + (size_t)nxt.pn * tstep : cB;
        for (int t = 0; t < nt; t += 2) {
            const bool last = (t == nt - 2);
            const char* a1 = cA + (size_t)(t + 1) * kstep;
            const char* a2 = last ? nA : cA + (size_t)(t + 2) * kstep; const char* b2 = last ? nB : cB + (size_t)(t + 2) * kstep;
            const char* a3 = a2 + kstep; const char* b3 = b2 + kstep;
            if (last && has_next) S.a_ready(nxt);
            if constexpr (Epi::SEG) { if (t == 4 || t == 8) { int tz = tid; asm volatile("" : "+v"(tz)); const int wz = __builtin_amdgcn_readfirstlane(tz >> 6), lz = tz & 63; E.mid(acc, cur, t == 4 ? 0 : 1, wz >> 2, wz & 3, lz & 15, lz >> 4); } }
            PG8_LDB(B0, 0, 0); PG8_SCHED; PG8_LDA(At, 0, 0); PG8_STAGE(PG8_SA(1, 1), a1 + hstep, voffA);
            PG8_WAIT_L(8); PG8_BAR; PG8_WAIT_L(0); PG8_MMA(0, 0, At, B0); PG8_BAR; PG8_SCHED;
            PG8_LDB(B1, 0, 1); PG8_STAGE(PG8_SB(0, 0), b2, voffB);
            PG8_BAR; PG8_WAIT_L(0); PG8_MMA(0, 1, At, B1); PG8_BAR;
            PG8_LDA(At, 0, 1); PG8_STAGE(PG8_SA(0, 0), a2, voffA);
            PG8_BAR; PG8_WAIT_L(0); PG8_MMA(1, 0, At, B0); PG8_BAR; PG8_SCHED;
            PG8_STAGE(PG8_SB(0, 1), b2 + hstep, voffB);
            PG8_WAIT_V(6); PG8_BAR; PG8_MMA(1, 1, At, B1); PG8_BAR;
            PG8_LDB(B0, 1, 0); PG8_SCHED; PG8_LDA(At, 1, 0); PG8_STAGE(PG8_SA(0, 1), a2 + hstep, voffA);
            PG8_WAIT_L(8); PG8_BAR; PG8_WAIT_L(0); PG8_MMA(0, 0, At, B0); PG8_BAR; PG8_SCHED;
            PG8_LDB(B1, 1, 1); PG8_STAGE(PG8_SB(1, 0), b3, voffB);
            PG8_BAR; PG8_WAIT_L(0); PG8_MMA(0, 1, At, B1); PG8_BAR;
            PG8_LDA(At, 1, 1); PG8_STAGE(PG8_SA(1, 0), a3, voffA);
            PG8_BAR; PG8_WAIT_L(0); PG8_MMA(1, 0, At, B0); PG8_BAR; PG8_SCHED;
            PG8_STAGE(PG8_SB(1, 1), b3 + hstep, voffB);
            PG8_WAIT_V(6); PG8_BAR; PG8_MMA(1, 1, At, B1); PG8_BAR;
        }
        { int tz = tid; asm volatile("" : "+v"(tz)); const int wz = __builtin_amdgcn_readfirstlane(tz >> 6), lz = tz & 63;
          E(acc, cur, wz >> 2, wz & 3, lz & 15, lz >> 4); } S.done(cur);
        if (!has_next) break;
#pragma unroll
        for (int a = 0; a < 2; ++a)
#pragma unroll
            for (int b = 0; b < 2; ++b)
#pragma unroll
                for (int m = 0; m < 4; ++m)
#pragma unroll
                    for (int n = 0; n < 2; ++n) acc[a][b][m][n] = (f32x4){0.f, 0.f, 0.f, 0.f};
        cur = nxt; cA = nA; cB = nB; ++ui;
    }
    PG8_WAIT_V(0);
    if (wr == 0) PG8_BAR;
    PG8_BAR;
#undef PG8_SA
#undef PG8_SB
#undef PG8_STAGE
#undef PG8_LDA
#undef PG8_LDB
#undef PG8_MMA
#undef PG8_WAIT_V
#undef PG8_WAIT_L
#undef PG8_BAR
#undef PG8_SCHED
}

struct EpiInProj {
    static constexpr bool PERM = true, SEG = false;
    bf16_t* O; float* BA;
    __device__ __forceinline__ void operator()(const f32x4 (&acc)[2][2][4][2], const Unit& u, int wr, int wc, int fr, int fq) const {
        const int row0 = u.pm * BM + wr * 64 + fr, col0 = u.pn * BM + wc * 32 + 8 * fq;
        const bool sig = u.pn < 12, ba = (u.pn == 25) && (wc == 0) && (fq < 3);
#pragma unroll
        for (int ai = 0; ai < 2; ++ai)
#pragma unroll
            for (int m = 0; m < 4; ++m) { const int row = row0 + ai * HALF + m * 16; bf16_t* rowp = O + (size_t)row * NPROJ + col0;
#pragma unroll
                for (int bj = 0; bj < 2; ++bj) { f32x4 v0 = acc[ai][bj][m][0], v1 = acc[ai][bj][m][1];
                    if (sig) {
#pragma unroll
                        for (int j = 0; j < 4; ++j) { v0[j] = sigmoidf_(v0[j]); v1[j] = sigmoidf_(v1[j]); } }
                    u32x4 w; w.x = pk2(v0[0], v0[1]); w.y = pk2(v0[2], v0[3]); w.z = pk2(v1[0], v1[1]); w.w = pk2(v1[2], v1[3]);
                    *(u32x4*)(rowp + bj * HALF) = w;
                    if (bj == 1 && ba) { float* bp = BA + (size_t)row * 32 + 8 * fq; *(f32x4*)bp = v0; *(f32x4*)(bp + 4) = v1; } } }
    }
};
struct EpiGateCat {
    static constexpr bool PERM = false, SEG = true;
    const bf16_t* PROJ; bf16_t* MB;
    __device__ __forceinline__ void mid(f32x4 (&acc)[2][2][4][2], const Unit& u, int seg, int wr, int wc, int fr, int fq) const {
        const int row0 = u.pm * BM + wr * 64 + fr, col0 = u.pn * BM + wc * 32 + 4 * fq;
#pragma unroll
        for (int ai = 0; ai < 2; ++ai)
#pragma unroll
            for (int m = 0; m < 4; ++m) { int rowi = row0 + ai * HALF + m * 16; asm volatile("" : "+v"(rowi)); const bf16_t* gp = PROJ + (size_t)rowi * NPROJ + C_GATE + seg * 1024 + col0;
#pragma unroll
                for (int bj = 0; bj < 2; ++bj)
#pragma unroll
                    for (int n = 0; n < 2; ++n) { const u32x2 ga = *(const u32x2*)(gp + bj * HALF + n * 16), gb = *(const u32x2*)(gp + 1024 + bj * HALF + n * 16);
                        f32x4& v = acc[ai][bj][m][n]; v[0] *= bflo(ga.x) * frcp(bflo(gb.x)); v[1] *= bfhi(ga.x) * frcp(bfhi(gb.x)); v[2] *= bflo(ga.y) * frcp(bflo(gb.y)); v[3] *= bfhi(ga.y) * frcp(bfhi(gb.y)); }
                asm volatile("" ::: "memory"); }
    }
    __device__ __forceinline__ void operator()(const f32x4 (&acc)[2][2][4][2], const Unit& u, int wr, int wc, int fr, int fq) const {
        const int row0 = u.pm * BM + wr * 64 + fr, col0 = u.pn * BM + wc * 32 + 4 * fq;
#pragma unroll
        for (int ai = 0; ai < 2; ++ai)
#pragma unroll
            for (int m = 0; m < 4; ++m) { int rowi = row0 + ai * HALF + m * 16; asm volatile("" : "+v"(rowi)); const size_t row = (size_t)rowi;
#pragma unroll
                for (int bj = 0; bj < 2; ++bj)
#pragma unroll
                    for (int n = 0; n < 2; ++n) { const int col = col0 + bj * HALF + n * 16;
                        const u32x2 gw = *(const u32x2*)(PROJ + row * NPROJ + C_GATE + 2 * 1024 + col);
                        const f32x4 v = acc[ai][bj][m][n];
                        u32x2 w; w.x = pk2(v[0] * bflo(gw.x), v[1] * bfhi(gw.x)); w.y = pk2(v[2] * bflo(gw.y), v[3] * bfhi(gw.y)); *(u32x2*)(MB + row * D + col) = w; }
                asm volatile("" ::: "memory"); }
    }
};
struct EpiRes {
    static constexpr bool PERM = false, SEG = false;
    const float* XR; float* H;
    __device__ __forceinline__ void operator()(const f32x4 (&acc)[2][2][4][2], const Unit& u, int wr, int wc, int fr, int fq) const {
        const int row0 = u.pm * BM + wr * 64 + fr, col0 = u.pn * BM + wc * 32 + 4 * fq;
#pragma unroll
        for (int ai = 0; ai < 2; ++ai)
#pragma unroll
            for (int m = 0; m < 4; ++m) { int rowi = row0 + ai * HALF + m * 16; asm volatile("" : "+v"(rowi)); const size_t off = (size_t)rowi * D + col0;
#pragma unroll
                for (int bj = 0; bj < 2; ++bj)
#pragma unroll
                    for (int n = 0; n < 2; ++n) { const f32x4 xr = *(const f32x4*)(XR + off + bj * HALF + n * 16);
                        *(f32x4*)(H + off + bj * HALF + n * 16) = xr * ALPHA + acc[ai][bj][m][n]; }
                asm volatile("" ::: "memory"); }
    }
};
struct EpiSwiglu {
    static constexpr bool PERM = true, SEG = false;
    bf16_t* HID;
    __device__ __forceinline__ void operator()(const f32x4 (&acc)[2][2][4][2], const Unit& u, int wr, int wc, int fr, int fq) const {
        const int row0 = u.pm * BM + wr * 64 + fr, col0 = (u.pn & 15) * 128 + wc * 32 + 8 * fq;
#pragma unroll
        for (int ai = 0; ai < 2; ++ai)
#pragma unroll
            for (int m = 0; m < 4; ++m) { const f32x4 g0 = acc[ai][0][m][0], g1 = acc[ai][0][m][1], u0 = acc[ai][1][m][0], u1 = acc[ai][1][m][1];
                f32x4 h0, h1;
#pragma unroll
                for (int j = 0; j < 4; ++j) { h0[j] = siluf_(g0[j]) * u0[j]; h1[j] = siluf_(g1[j]) * u1[j]; }
                u32x4 w; w.x = pk2(h0[0], h0[1]); w.y = pk2(h0[2], h0[3]); w.z = pk2(h1[0], h1[1]); w.w = pk2(h1[2], h1[3]);
                *(u32x4*)(HID + (size_t)(row0 + ai * HALF + m * 16) * DE + col0) = w; }
    }
};
struct EpiDown {
    static constexpr bool PERM = true, SEG = false;
    bf16_t* Y; const float* GV;
    __device__ __forceinline__ void operator()(const f32x4 (&acc)[2][2][4][2], const Unit& u, int wr, int wc, int fr, int fq) const {
        const int row0 = u.pm * BM + wr * 64 + fr, col0 = (u.pn & 3) * BM + wc * 32 + 8 * fq;
#pragma unroll
        for (int ai = 0; ai < 2; ++ai)
#pragma unroll
            for (int m = 0; m < 4; ++m) { const int row = row0 + ai * HALF + m * 16; const float gv = GV[row];
#pragma unroll
                for (int bj = 0; bj < 2; ++bj) { const f32x4 v0 = acc[ai][bj][m][0] * gv, v1 = acc[ai][bj][m][1] * gv;
                    u32x4 w; w.x = pk2(v0[0], v0[1]); w.y = pk2(v0[2], v0[3]); w.z = pk2(v1[0], v1[1]); w.w = pk2(v1[2], v1[3]);
                    *(u32x4*)(Y + (size_t)row * D + col0 + bj * HALF) = w; } }
    }
};
}

#define XB_TMO      128
#define XB_XCNT(j)  (256  + 64 * (j))
#define XB_XSUB(j)  (1280 + 64 * (j))
#define XB_XGEN(j)  (2304 + 64 * (j))
#define XB_TOP      3328
#define XB_TOPGEN   3392
#define XCD_BAR_WORDS 3456
#define XB_SPIN_CAP (1u << 22)
__device__ __forceinline__ unsigned xb_ld(unsigned* p)              { return __hip_atomic_load(p, __ATOMIC_RELAXED, __HIP_MEMORY_SCOPE_AGENT); }
__device__ __forceinline__ unsigned xb_add(unsigned* p, unsigned v) { return __hip_atomic_fetch_add(p, v, __ATOMIC_RELAXED, __HIP_MEMORY_SCOPE_AGENT); }
__device__ __forceinline__ unsigned xb_xcc_id() { return (unsigned)__builtin_amdgcn_s_getreg((3 << 11) | 20) & 0xFu; }
#define XB_SPIN(cond, bar) do { unsigned _sp = 0; while (cond) { __builtin_amdgcn_s_sleep(1); \
    if ((++_sp & 255u) == 0u) { if (xb_ld(&(bar)[XB_TMO])) break; if (_sp > XB_SPIN_CAP) { atomicAdd(&(bar)[XB_TMO], 1u); break; } } } } while (0)
struct XcdBarrier { unsigned* bar; unsigned x; volatile LAS unsigned* st; };
__device__ __forceinline__ XcdBarrier xcd_barrier_post(unsigned* bar, volatile LAS unsigned* st) {
    XcdBarrier b; b.bar = bar; b.x = xb_xcc_id(); b.st = st;
    if (threadIdx.x == 0) (void)xb_add(&bar[XB_XCNT(b.x)], 1u);
    return b;
}
__device__ __forceinline__ void xcd_barrier_complete(unsigned* bar, unsigned x, unsigned& nloc, unsigned& nx) {
    const unsigned G = gridDim.x * gridDim.y * gridDim.z;
    unsigned sum, cnt, mine, sp = 0u;
    for (;;) {
        sum = 0u; cnt = 0u; mine = 0u;
#pragma unroll
        for (unsigned j = 0; j < 16; ++j) { const unsigned c = xb_ld(&bar[XB_XCNT(j)]); sum += c; cnt += (c > 0u) ? 1u : 0u; }
        mine = xb_ld(&bar[XB_XCNT(x)]);
        if (sum == G) break;
        __builtin_amdgcn_s_sleep(1);
        if ((++sp & 255u) == 0u) { if (xb_ld(&bar[XB_TMO])) break; if (sp > XB_SPIN_CAP) { atomicAdd(&bar[XB_TMO], 1u); break; } }
    }
    nloc = mine > 0u ? mine : 1u; nx = cnt > 0u ? cnt : 1u;
}
__device__ __forceinline__ void xcd_barrier(const XcdBarrier& b) {
    asm volatile("s_waitcnt vmcnt(0)" ::: "memory");
    __syncthreads();
    if (threadIdx.x == 0) {
        unsigned* bar = b.bar; asm volatile("" : "+s"(bar));
        __builtin_amdgcn_s_waitcnt(0);
        unsigned nloc = b.st[0], nx = b.st[1];
        if (nloc == 0u) { xcd_barrier_complete(bar, b.x, nloc, nx); b.st[0] = nloc; b.st[1] = nx; }
        const unsigned old = xb_add(&bar[XB_XSUB(b.x)], 1u);
        const unsigned gen = old / nloc;
        if (old + 1u == (gen + 1u) * nloc) {
            __builtin_amdgcn_fence(__ATOMIC_RELEASE, "agent");
            asm volatile("s_waitcnt vmcnt(0)" ::: "memory");
            const unsigned og = xb_add(&bar[XB_TOP], 1u);
            const unsigned tg = og / nx;
            if (og + 1u == (tg + 1u) * nx) xb_add(&bar[XB_TOPGEN], 1u);
            else XB_SPIN(xb_ld(&bar[XB_TOPGEN]) == tg, bar);
            __builtin_amdgcn_fence(__ATOMIC_ACQUIRE, "agent");
            xb_add(&bar[XB_XGEN(b.x)], 1u);
            asm volatile("s_waitcnt vmcnt(0)" ::: "memory");
        } else {
            XB_SPIN(xb_ld(&bar[XB_XGEN(b.x)]) == gen, bar);
            __builtin_amdgcn_fence(__ATOMIC_ACQUIRE, "agent");
            asm volatile("s_waitcnt vmcnt(0)" ::: "memory");
        }
    }
    __syncthreads();
}

struct Args { const float* in[20]; float* out; unsigned char* ws; int ph_lo, ph_hi; };
typedef const __attribute__((address_space(4))) Args* KArgs;
DI KArgs kargs() { KArgs p = (KArgs)__builtin_amdgcn_kernarg_segment_ptr(); asm volatile("" : "+s"(p)); return p; }
struct Ctx {
    float* out; unsigned char* ws;
    int tid, lane, wave, G, bid;
    int layer, slab;
    int nseq, seqlen;
    int stok, sbase;
    int dry;
};
#define WSP(T, off) ((T*)(c.ws + (off)))
#define BIGP(T, off) ((T*)(c.ws + WS_BIG + (off)))

__device__ const float INV_FREQ[32] = {1.000000000e+00f, 7.498942018e-01f, 5.623413324e-01f, 4.216965139e-01f, 3.162277639e-01f, 2.371373773e-01f, 1.778279394e-01f, 1.333521456e-01f, 1.000000015e-01f, 7.498942316e-02f, 5.623413250e-02f, 4.216964915e-02f, 3.162277490e-02f, 2.371373773e-02f, 1.778279431e-02f, 1.333521400e-02f, 9.999999776e-03f, 7.498942316e-03f, 5.623413250e-03f, 4.216964822e-03f, 3.162277630e-03f, 2.371373819e-03f, 1.778279431e-03f, 1.333521446e-03f, 1.000000047e-03f, 7.498941850e-04f, 5.623413017e-04f, 4.216965172e-04f, 3.162277571e-04f, 2.371373703e-04f, 1.778279402e-04f, 1.333521504e-04f};
DI void tr_item(const float* src, long src_ld, int src_col0, int nvalid, int kvalid, bf16_t* dst, long dst_ld, int dst_row0, int k0, LAS float* scr, int lane) {
    float tv[32];
#pragma unroll
    for (int i = 0; i < 32; ++i) { const int kk = 2 * i + (lane >> 5), cc = lane & 31;
        tv[i] = 0.f; if ((k0 + kk) < kvalid && cc < nvalid) tv[i] = src[(size_t)(k0 + kk) * src_ld + src_col0 + cc]; }
#pragma unroll
    for (int i = 0; i < 32; ++i) { const int kk = 2 * i + (lane >> 5), cc = lane & 31; scr[kk * 33 + cc] = tv[i]; }
    asm volatile("s_waitcnt lgkmcnt(0)" ::: "memory");
    const int c8 = lane & 7;
#pragma unroll
    for (int j = 0; j < 4; ++j) { const int n = (lane >> 3) + 8 * j; const LAS float* s = scr + (8 * c8) * 33 + n;
        u32x4 o; o.x = pk2(s[0 * 33], s[1 * 33]); o.y = pk2(s[2 * 33], s[3 * 33]); o.z = pk2(s[4 * 33], s[5 * 33]); o.w = pk2(s[6 * 33], s[7 * 33]);
        *(u32x4*)(dst + (size_t)(dst_row0 + n) * dst_ld + k0 + 8 * c8) = o; }
    asm volatile("s_waitcnt lgkmcnt(0)" ::: "memory");
}
DI void phase_weights(KArgs args, LAS unsigned char* lds, const Ctx& c) {
    const int l = c.layer, lane = c.lane;
    LAS float* scr = (LAS float*)(lds + c.wave * 8448);
    const int gw = c.bid * 8 + c.wave, NGW = c.G * 8;
    constexpr int I_IN = 16 * 208, I_NA = 4 * 32, I_DIL = 4 * 32, I_GDN = 6 * 32, I_OUT = 16 * 32, I_GU1 = 16 * 128, I_D1 = 32 * 32;
    constexpr int NITEMS = I_IN + I_NA + I_DIL + I_GDN + I_OUT + 16 * I_GU1 + 16 * I_D1;
    for (int it = gw; it < NITEMS; it += NGW) {
        int r = it;
        const float* src; long sld; int sc0, nv = 32, kv; bf16_t* dst; long dld; int dr0, k0;
        if (r < I_IN) { const int kb = r / 208, nb = r % 208, n0 = 32 * nb; src = args->in[2] + (size_t)l * D * DIN; sld = DIN; kv = D;
            if (n0 < 3072) { sc0 = 3480 + n0; } else { sc0 = n0 - 3072; nv = DIN - n0; if (nv < 0) { nv = 0; sc0 = 0; } }
            dst = WSP(bf16_t, WS_WIN); dld = D; dr0 = n0; k0 = 64 * kb; }
        else if ((r -= I_IN) < I_NA) { const int kb = r / 32, nb = r % 32; src = args->in[8] + (size_t)l * 256 * D; sld = D; sc0 = 32 * nb; kv = 256; dst = WSP(bf16_t, WS_WBR); dld = 896; dr0 = 32 * nb; k0 = 64 * kb; }
        else if ((r -= I_NA) < I_DIL) { const int kb = r / 32, nb = r % 32; src = args->in[9] + (size_t)l * 128 * D; sld = D; sc0 = 32 * nb; kv = 128; dst = WSP(bf16_t, WS_WBR) + 256; dld = 896; dr0 = 32 * nb; k0 = 64 * kb; }
        else if ((r -= I_DIL) < I_GDN) { const int kb = r / 32, nb = r % 32; src = args->in[10] + (size_t)l * 384 * D; sld = D; sc0 = 32 * nb; kv = 384; dst = WSP(bf16_t, WS_WBR) + 512; dld = 896; dr0 = 32 * nb; k0 = 64 * kb; }
        else if ((r -= I_GDN) < I_OUT) { const int kb = r / 32, nb = r % 32; src = args->in[11] + (size_t)l * D * D; sld = D; sc0 = 32 * nb; kv = D; dst = WSP(bf16_t, WS_WOUT); dld = D; dr0 = 32 * nb; k0 = 64 * kb; }
        else if ((r -= I_OUT) < 16 * I_GU1) { const int e = r / I_GU1, q = r % I_GU1, kb = q / 128, nb = q % 128, n0 = 32 * nb, j = n0 >> 8, rr = n0 & 255;
            src = (rr < 128 ? args->in[16] : args->in[15]) + ((size_t)l * NE + e) * D * DE; sld = DE; sc0 = 128 * j + (rr & 127); kv = D;
            dst = WSP(bf16_t, WS_WGU) + (size_t)e * 4096 * D; dld = D; dr0 = n0; k0 = 64 * kb; }
        else { r -= 16 * I_GU1; const int e = r / I_D1, q = r % I_D1, kb = q / 32, nb = q % 32;
            src = args->in[17] + ((size_t)l * NE + e) * DE * D; sld = D; sc0 = 32 * nb; kv = DE; dst = WSP(bf16_t, WS_WD) + (size_t)e * D * DE; dld = DE; dr0 = 32 * nb; k0 = 64 * kb; }
        tr_item(src, sld, sc0, nv, kv, dst, dld, dr0, k0, scr, lane);
    }
    if (l == 0) {
        for (int t = gw; t < T_ALL; t += NGW) {
            const float* xr = (t < T_P) ? args->in[0] + (size_t)t * D : args->in[1] + (size_t)(t - T_P) * D;
            bf16_t* o = WSP(bf16_t, WS_XB) + (size_t)t * D;
#pragma unroll
            for (int j = 0; j < 4; ++j) { const f32x4 v = *(const f32x4*)(xr + 4 * lane + 256 * j); u32x2 w; w.x = pk2(v[0], v[1]); w.y = pk2(v[2], v[3]); *(u32x2*)(o + 4 * lane + 256 * j) = w; }
        }
        float* cs = WSP(float, WS_CS);
        for (int i = c.bid * 512 + c.tid; i < 16384 * 32; i += c.G * 512) { const int pos = i >> 5, k = i & 31;
            const float inv = INV_FREQ[k];
            const float ang = (float)pos * inv;
            cs[pos * 64 + k] = cosf(ang); cs[pos * 64 + 32 + k] = sinf(ang); }
    }
}

constexpr int TLD = 72, TILEB = 64 * TLD * 2;
DI int tsw(int row) { return ((row >> 4) & 3) << 3; }
template <bool SA = false, bool SB = false> DI f32x16 mm_tile(const LAS bf16_t* A, const LAS bf16_t* Bt, int m0, int n0, int lane) {
    f32x16 acc = zero16(); const int r = lane & 31, hh = lane >> 5; const int sa = SA ? tsw(m0 + r) : 0, sb = SB ? tsw(n0 + r) : 0;
#pragma unroll
    for (int ks = 0; ks < 4; ++ks) { const bf16x8 a = *(const LAS bf16x8*)(A + (m0 + r) * TLD + ((16 * ks + 8 * hh) ^ sa)); const bf16x8 b = *(const LAS bf16x8*)(Bt + (n0 + r) * TLD + ((16 * ks + 8 * hh) ^ sb)); acc = MFMA32(a, b, acc); }
    return acc;
}

constexpr int PI_P0 = 0, PI_P1 = 9216, PI_INTRA = 18432, PI_AM = 27648, PI_TT = 45056, PI_TD0 = 54272, PI_TD1 = 60416, PI_PM = 65024, PI_VEC = 71168, PI_BYTES = 72704;
constexpr int PI_WT = PI_AM, PI_UT = PI_TD0;
DI void gdn_prep_pair(KArgs args, LAS unsigned char* L0, const Ctx& c, int pu) {
    int tid = c.tid; asm volatile("" : "+v"(tid)); const int lane = tid & 63, wave = __builtin_amdgcn_readfirstlane(tid >> 6), l = c.layer;
    const int dir = wave >> 2, wg = wave & 3, tg = tid & 255, head = pu % 6, gch = pu / 6, inst = (gch * 6 + head) * 2 + dir;
    const int cps = c.seqlen >> 6, seq = gch / cps, n = gch % cps;
    const bf16_t* PROJ = BIGP(bf16_t, B_PROJ); const float* BA = BIGP(float, B_BA);
    unsigned char* G = BIGP(unsigned char, B_GSCR) + (size_t)inst * GSTRIDE;
    LAS unsigned char* L = L0 + dir * PI_BYTES;
    LAS bf16_t* P0 = (LAS bf16_t*)(L + PI_P0); LAS bf16_t* P1 = (LAS bf16_t*)(L + PI_P1); LAS bf16_t* INTRA = (LAS bf16_t*)(L + PI_INTRA);
    LAS float* AM = (LAS float*)(L + PI_AM); LAS bf16_t* TT = (LAS bf16_t*)(L + PI_TT);
    LAS float* TD0 = (LAS float*)(L + PI_TD0); LAS float* TD1 = (LAS float*)(L + PI_TD1); LAS float* PM = (LAS float*)(L + PI_PM);
    LAS float* GV = (LAS float*)(L + PI_VEC); LAS float* BV = GV + 64; LAS float* GC = GV + 128;
    LAS bf16_t* WT = (LAS bf16_t*)(L + PI_WT); LAS bf16_t* UT = (LAS bf16_t*)(L + PI_UT);
    const int ia = tg >> 3, p = tg & 7;
    float q[2][8], k[2][8], v[2][8];
#pragma unroll
    for (int h2 = 0; h2 < 2; ++h2)
#pragma unroll
        for (int j = 0; j < 8; ++j) { q[h2][j] = 0.f; k[h2][j] = 0.f; v[h2][j] = 0.f; }
    const float* cw = args->in[4] + (size_t)l * 5 * 1152 + 64 * head + 8 * p;
#pragma unroll
    for (int tp = 0; tp < 5; ++tp) { const float* w = cw + tp * 1152;
        const f32x4 wq0 = *(const f32x4*)w, wq1 = *(const f32x4*)(w + 4), wk0 = *(const f32x4*)(w + 384), wk1 = *(const f32x4*)(w + 388), wv0 = *(const f32x4*)(w + 768), wv1 = *(const f32x4*)(w + 772);
#pragma unroll
        for (int h2 = 0; h2 < 2; ++h2) { const int i = ia + 32 * h2, tokl = dir ? 63 - i : i, pp = n * 64 + tokl + tp - 2;
            if (pp >= 0 && pp < c.seqlen) { const bf16_t* rp = PROJ + (size_t)(seq * c.seqlen + pp) * NPROJ + 64 * head + 8 * p;
                const u32x4 rq = *(const u32x4*)(rp + C_QC), rk = *(const u32x4*)(rp + C_KC), rv = *(const u32x4*)(rp + C_VC);
#pragma unroll
                for (int j = 0; j < 4; ++j) { const float a0 = (j < 2) ? wq0[2 * j] : wq1[2 * j - 4], a1 = (j < 2) ? wq0[2 * j + 1] : wq1[2 * j - 3];
                    const float b0 = (j < 2) ? wk0[2 * j] : wk1[2 * j - 4], b1 = (j < 2) ? wk0[2 * j + 1] : wk1[2 * j - 3];
                    const float c0 = (j < 2) ? wv0[2 * j] : wv1[2 * j - 4], c1 = (j < 2) ? wv0[2 * j + 1] : wv1[2 * j - 3];
                    q[h2][2 * j] += a0 * bflo(rq[j]); q[h2][2 * j + 1] += a1 * bfhi(rq[j]);
                    k[h2][2 * j] += b0 * bflo(rk[j]); k[h2][2 * j + 1] += b1 * bfhi(rk[j]);
                    v[h2][2 * j] += c0 * bflo(rv[j]); v[h2][2 * j + 1] += c1 * bfhi(rv[j]); } } } }
#pragma unroll
    for (int h2 = 0; h2 < 2; ++h2) { float sq = 0.f, sk = 0.f;
#pragma unroll
        for (int j = 0; j < 8; ++j) { q[h2][j] = siluf_(q[h2][j]); k[h2][j] = siluf_(k[h2][j]); v[h2][j] = siluf_(v[h2][j]); sq += q[h2][j] * q[h2][j]; sk += k[h2][j] * k[h2][j]; }
        sq += __shfl_xor(sq, 1); sq += __shfl_xor(sq, 2); sq += __shfl_xor(sq, 4);
        sk += __shfl_xor(sk, 1); sk += __shfl_xor(sk, 2); sk += __shfl_xor(sk, 4);
        const float rq_ = 0.125f * frsq(sq + NORM_EPS), rk_ = frsq(sk + NORM_EPS);
#pragma unroll
        for (int j = 0; j < 8; ++j) { q[h2][j] *= rq_; k[h2][j] *= rk_; }
        if (p == 0) { const int i = ia + 32 * h2, tokl = dir ? 63 - i : i; const float* bar = BA + (size_t)(seq * c.seqlen + n * 64 + tokl) * 32;
            const float bl = bar[dir * 6 + head], al = bar[12 + dir * 6 + head];
            const float xx = al + args->in[6][l * 12 + dir * 6 + head];
            const float sp = xx > 20.f ? xx : log1pf(expf(xx));
            GV[i] = -expf(args->in[5][l * 12 + dir * 6 + head]) * sp; BV[i] = sigmoidf_(bl); } }
    __syncthreads();
    float gcl_;
    { float x = GV[lane];
#pragma unroll
        for (int o = 1; o < 64; o <<= 1) { const float y = __shfl_up(x, o); if (lane >= o) x += y; }
        if (wg == 0) GC[lane] = x;
        gcl_ = x; }
    const float gc0 = __shfl(gcl_, ia), gc1 = __shfl(gcl_, ia + 32), gcl = __shfl(gcl_, 63);
#pragma unroll
    for (int h2 = 0; h2 < 2; ++h2) { const int i = ia + 32 * h2; u32x4 wq, wk;
#pragma unroll
        for (int j = 0; j < 4; ++j) { wq[j] = pk2(q[h2][2 * j], q[h2][2 * j + 1]); wk[j] = pk2(k[h2][2 * j], k[h2][2 * j + 1]); }
        *(LAS u32x4*)(P0 + i * TLD + 8 * p) = wq; *(LAS u32x4*)(P1 + i * TLD + 8 * p) = wk; }
    __syncthreads();
    { const int mat = wg >> 1, mt = wg & 1, hh = lane >> 5;
#pragma unroll
        for (int nt = 0; nt < 2; ++nt) { const int jc = 32 * nt + (lane & 31);
            const f32x16 a = mm_tile(mat ? P0 : P1, P1, 32 * mt, 32 * nt, lane);
            const float gj = GC[jc];
#pragma unroll
            for (int r = 0; r < 16; ++r) { const int ii = 32 * mt + crow(r, hh); const float gi = GC[ii];
                if (mat == 0) AM[ii * 68 + jc] = (jc < ii) ? BV[ii] * a[r] * __expf(gi - gj) : 0.f;
                else INTRA[ii * TLD + jc] = (bf16_t)(pk2((jc <= ii) ? a[r] * __expf(gi - gj) : 0.f, 0.f) & 0xffffu); } } }
    __syncthreads();
    if (wg == 0) {
        const int b = lane >> 5, cidx = lane & 31; float t[32];
#pragma unroll
        for (int ii = 0; ii < 32; ++ii) t[ii] = (ii == cidx) ? 1.f : 0.f;
        const LAS float* Ab = AM + (32 * b) * 68 + 32 * b;
#pragma unroll
        for (int ii = 1; ii < 32; ++ii) { float acc = 0.f;
#pragma unroll
            for (int j4 = 0; j4 < ii; j4 += 4) { const f32x4 a4 = *(const LAS f32x4*)(Ab + ii * 68 + j4);
                acc += a4[0] * t[j4]; acc += a4[1] * t[j4 + 1]; acc += a4[2] * t[j4 + 2]; acc += a4[3] * t[j4 + 3]; }
            t[ii] -= acc; }
        LAS float* td = b ? TD1 : TD0; const int tds = b ? 36 : 48;
#pragma unroll
        for (int ii = 0; ii < 32; ++ii) { td[ii * tds + cidx] = t[ii]; TT[(32 * b + ii) * TLD + 32 * b + cidx] = (bf16_t)(pk2(t[ii], 0.f) & 0xffffu); }
    }
#pragma unroll
    for (int h2 = 0; h2 < 2; ++h2) { const int i = ia + 32 * h2; const float be = BV[i], eg = __expf(h2 ? gc1 : gc0);
#pragma unroll
        for (int j = 0; j < 8; ++j) { const int d = 8 * p + j, o_ = d * TLD + (i ^ tsw(d)); P0[o_] = (bf16_t)(pk2(k[h2][j] * be * eg, 0.f) & 0xffffu); P1[o_] = (bf16_t)(pk2(v[h2][j] * be, 0.f) & 0xffffu); } }
    { unsigned zz; asm volatile("v_mov_b32 %0, 0" : "=v"(zz)); u32x2 z; z.x = zz; z.y = zz; *(LAS u32x2*)(TT + (tg >> 3) * TLD + 32 + 4 * (tg & 7)) = z; }
    __syncthreads();
    { const int qi = wg >> 1, qj = wg & 1, r16 = lane & 15, g4 = lane >> 4; f32x4 pc = {0.f, 0.f, 0.f, 0.f};
#pragma unroll
        for (int kk = 0; kk < 8; ++kk) pc = __builtin_amdgcn_mfma_f32_16x16x4f32(AM[(32 + 16 * qi + r16) * 68 + 4 * kk + g4], TD0[(4 * kk + g4) * 48 + 16 * qj + r16], pc, 0, 0, 0);
#pragma unroll
        for (int r = 0; r < 4; ++r) PM[(16 * qi + 4 * g4 + r) * 48 + 16 * qj + r16] = pc[r]; }
    __syncthreads();
    { const int qi = wg >> 1, qj = wg & 1, r16 = lane & 15, g4 = lane >> 4; f32x4 pc = {0.f, 0.f, 0.f, 0.f};
#pragma unroll
        for (int kk = 0; kk < 8; ++kk) pc = __builtin_amdgcn_mfma_f32_16x16x4f32(TD1[(16 * qi + r16) * 36 + 4 * kk + g4], PM[(4 * kk + g4) * 48 + 16 * qj + r16], pc, 0, 0, 0);
#pragma unroll
        for (int r = 0; r < 4; ++r) TT[(32 + 16 * qi + 4 * g4 + r) * TLD + 16 * qj + r16] = (bf16_t)(pk2(-pc[r], 0.f) & 0xffffu); }
    __syncthreads();
    { const int which = wg >> 1, mt = wg & 1, hh = lane >> 5;
#pragma unroll
        for (int nt = 0; nt < 2; ++nt) { const int dc = 32 * nt + (lane & 31);
            const f32x16 a = mm_tile<false, true>(TT, which ? P1 : P0, 32 * mt, 32 * nt, lane);
            LAS bf16_t* dst = (which ? UT : WT) + dc * TLD; const int sw = tsw(dc);
#pragma unroll
            for (int g = 0; g < 4; ++g) { u32x2 w; w.x = pk2(a[4 * g], a[4 * g + 1]); w.y = pk2(a[4 * g + 2], a[4 * g + 3]); *(LAS u32x2*)(dst + ((32 * mt + 8 * g + 4 * hh) ^ sw)) = w; } } }
    __syncthreads();
#pragma unroll
    for (int h2 = 0; h2 < 2; ++h2) { const int i = ia + 32 * h2; const float gci = h2 ? gc1 : gc0, eg = __expf(gci), ekd = __expf(gcl - gci); u32x4 wqd;
#pragma unroll
        for (int j = 0; j < 4; ++j) wqd[j] = pk2(q[h2][2 * j] * eg, q[h2][2 * j + 1] * eg);
        *(LAS u32x4*)(P1 + i * TLD + 8 * p) = wqd;
#pragma unroll
        for (int j = 0; j < 8; ++j) { const int d = 8 * p + j; P0[d * TLD + (i ^ tsw(d))] = (bf16_t)(pk2(k[h2][j] * ekd, 0.f) & 0xffffu); } }
    __syncthreads();
    { const int hh = lane >> 5, rr = lane & 31;
        if (wg == 0) {
#pragma unroll
            for (int t4 = 0; t4 < 4; ++t4) { const int mtb = t4 >> 1, nta = t4 & 1; const f32x16 a = mm_tile<true, true>(WT, P0, 32 * mtb, 32 * nta, lane);
                f32x16 na; for (int r = 0; r < 16; ++r) na[r] = -a[r];
                *(bf16x8*)(G + (size_t)((nta * 4 + 2 * mtb) * 64 + lane) * 16) = pack8<0>(na); *(bf16x8*)(G + (size_t)((nta * 4 + 2 * mtb + 1) * 64 + lane) * 16) = pack8<1>(na); }
        } else if (wg == 1) {
#pragma unroll
            for (int t4 = 0; t4 < 4; ++t4) { const int mta = t4 >> 1, nte = t4 & 1; const f32x16 a = mm_tile<true, true>(P0, UT, 32 * mta, 32 * nte, lane);
                bf16x8* dp = (bf16x8*)(G + 8192 + (size_t)((nte * 2 + mta) * 64 + lane) * 32); dp[0] = pack8<0>(a); dp[1] = pack8<1>(a); }
        } else if (wg == 2) {
#pragma unroll
            for (int t4 = 0; t4 < 4; ++t4) { const int mtb = t4 >> 1, nti = t4 & 1; const f32x16 a = mm_tile<true, false>(WT, INTRA, 32 * mtb, 32 * nti, lane);
                f32x16 qe; const LAS bf16_t* qd = P1 + (32 * nti + rr) * TLD + 32 * mtb + 4 * hh;
#pragma unroll
                for (int g = 0; g < 4; ++g) { const u32x2 w = *(const LAS u32x2*)(qd + 8 * g); qe[4 * g] = bflo(w.x) - a[4 * g]; qe[4 * g + 1] = bfhi(w.x) - a[4 * g + 1]; qe[4 * g + 2] = bflo(w.y) - a[4 * g + 2]; qe[4 * g + 3] = bfhi(w.y) - a[4 * g + 3]; }
                *(bf16x8*)(G + 16384 + (size_t)((nti * 4 + 2 * mtb) * 64 + lane) * 16) = pack8<0>(qe); *(bf16x8*)(G + 16384 + (size_t)((nti * 4 + 2 * mtb + 1) * 64 + lane) * 16) = pack8<1>(qe); }
        } else {
#pragma unroll
            for (int t4 = 0; t4 < 4; ++t4) { const int mti = t4 >> 1, nte = t4 & 1; const f32x16 a = mm_tile<false, true>(INTRA, UT, 32 * mti, 32 * nte, lane);
                bf16_t* dst = (bf16_t*)(G + 24576) + (size_t)(32 * nte + rr) * 64 + 32 * mti + 4 * hh;
#pragma unroll
                for (int g = 0; g < 4; ++g) { u32x2 w; w.x = pk2(a[4 * g], a[4 * g + 1]); w.y = pk2(a[4 * g + 2], a[4 * g + 3]); *(u32x2*)(dst + 8 * g) = w; } }
            if (lane == 0) *(float*)(G + 40960) = __expf(gcl);
        } }
    __syncthreads();
}

DI void pv_accum(const f32x16 (&acc)[2][2], f32x16 (&o)[2][2], const LAS bf16_t* Vt, int lane) {
    const int r = lane & 31, hh = lane >> 5;
#pragma unroll
    for (int mt = 0; mt < 2; ++mt) {
        {   const bf16x8 p0 = pack8<0>(acc[mt][0]), p1 = pack8<0>(acc[mt][1]);
#pragma unroll
            for (int mo = 0; mo < 2; ++mo) { const LAS bf16_t* s = Vt + (32 * mo + r) * TLD; const int c0 = (32 * mt + 4 * hh) ^ tsw(32 * mo + r);
                const u32x2 lo = *(const LAS u32x2*)(s + c0), hi = *(const LAS u32x2*)(s + (c0 ^ 8)); u32x4 w; w.x = lo.x; w.y = lo.y; w.z = hi.x; w.w = hi.y; const bf16x8 vf = __builtin_bit_cast(bf16x8, w);
                o[mo][0] = MFMA32(vf, p0, o[mo][0]); o[mo][1] = MFMA32(vf, p1, o[mo][1]); } }
        {   const bf16x8 p0 = pack8<1>(acc[mt][0]), p1 = pack8<1>(acc[mt][1]);
#pragma unroll
            for (int mo = 0; mo < 2; ++mo) { const LAS bf16_t* s = Vt + (32 * mo + r) * TLD; const int c0 = (32 * mt + 16 + 4 * hh) ^ tsw(32 * mo + r);
                const u32x2 lo = *(const LAS u32x2*)(s + c0), hi = *(const LAS u32x2*)(s + (c0 ^ 8)); u32x4 w; w.x = lo.x; w.y = lo.y; w.z = hi.x; w.w = hi.y; const bf16x8 vf = __builtin_bit_cast(bf16x8, w);
                o[mo][0] = MFMA32(vf, p0, o[mo][0]); o[mo][1] = MFMA32(vf, p1, o[mo][1]); } }
    }
}
template <class F> DI void stage_vt(LAS bf16_t* Vt, int lane, F vrow) {
#pragma unroll
    for (int it = 0; it < 8; ++it) { const int id = it * 64 + lane, key = id >> 3, part = id & 7;
        const u32x4 w = *(const u32x4*)(vrow(key) + 8 * part);
#pragma unroll
        for (int j = 0; j < 4; ++j) { const int d0 = 8 * part + 2 * j, ks_ = key ^ tsw(d0); Vt[d0 * TLD + ks_] = (bf16_t)(w[j] & 0xffffu); Vt[(d0 + 1) * TLD + ks_] = (bf16_t)(w[j] >> 16); } }
}
DI void write_o_slot(LAS float* SL, const f32x16 (&o)[2][2], int lane) {
    const int r = lane & 31, hh = lane >> 5;
#pragma unroll
    for (int mo = 0; mo < 2; ++mo)
#pragma unroll
        for (int nt = 0; nt < 2; ++nt)
#pragma unroll
            for (int g = 0; g < 4; ++g) { f32x4 v; v[0] = o[mo][nt][4 * g]; v[1] = o[mo][nt][4 * g + 1]; v[2] = o[mo][nt][4 * g + 2]; v[3] = o[mo][nt][4 * g + 3];
                *(LAS f32x4*)(SL + (32 * nt + r) * 68 + 32 * mo + 8 * g + 4 * hh) = v; }
}
DI void add_o_slot(const LAS float* SL, f32x16 (&o)[2][2], int lane) {
    const int r = lane & 31, hh = lane >> 5;
#pragma unroll
    for (int mo = 0; mo < 2; ++mo)
#pragma unroll
        for (int nt = 0; nt < 2; ++nt)
#pragma unroll
            for (int g = 0; g < 4; ++g) { const f32x4 v = *(const LAS f32x4*)(SL + (32 * nt + r) * 68 + 32 * mo + 8 * g + 4 * hh);
                o[mo][nt][4 * g] += v[0]; o[mo][nt][4 * g + 1] += v[1]; o[mo][nt][4 * g + 2] += v[2]; o[mo][nt][4 * g + 3] += v[3]; }
}

constexpr int WAREA = 10240;
DI void osm_update(f32x16 (&acc)[2][2], f32x16 (&o)[2][2], float (&m)[2], float (&l)[2]) {
#pragma unroll
    for (int nt = 0; nt < 2; ++nt) { float mx = -1e30f;
#pragma unroll
        for (int mt = 0; mt < 2; ++mt)
#pragma unroll
            for (int g = 0; g < 16; ++g) mx = fmaxf(mx, acc[mt][nt][g]);
        mx = fmaxf(mx, __shfl_xor(mx, 32));
        const float mn = fmaxf(m[nt], mx), sc = __expf(m[nt] - mn); float sm = 0.f;
#pragma unroll
        for (int mt = 0; mt < 2; ++mt)
#pragma unroll
            for (int g = 0; g < 16; ++g) { const float pz = __expf(acc[mt][nt][g] - mn); acc[mt][nt][g] = pz; sm += pz; }
        sm += __shfl_xor(sm, 32);
        l[nt] = l[nt] * sc + sm; m[nt] = mn;
#pragma unroll
        for (int g = 0; g < 16; ++g) { o[0][nt][g] *= sc; o[1][nt][g] *= sc; } }
}
template <class F> DI void store_o_rows(LAS bf16_t* T, const f32x16 (&o)[2][2], const float (&scale)[2], int lane, F rowp) {
    const int r = lane & 31, hh = lane >> 5;
#pragma unroll
    for (int mo = 0; mo < 2; ++mo)
#pragma unroll
        for (int nt = 0; nt < 2; ++nt)
#pragma unroll
            for (int g = 0; g < 4; ++g) { u32x2 w; w.x = pk2(o[mo][nt][4 * g] * scale[nt], o[mo][nt][4 * g + 1] * scale[nt]); w.y = pk2(o[mo][nt][4 * g + 2] * scale[nt], o[mo][nt][4 * g + 3] * scale[nt]);
                *(LAS u32x2*)(T + (32 * nt + r) * TLD + 32 * mo + 8 * g + 4 * hh) = w; }
    asm volatile("s_waitcnt lgkmcnt(0)" ::: "memory");
#pragma unroll
    for (int it = 0; it < 8; ++it) { const int id = it * 64 + lane, q = id >> 3, part = id & 7; *(u32x4*)(rowp(q) + 8 * part) = *(const LAS u32x4*)(T + q * TLD + 8 * part); }
    asm volatile("s_waitcnt lgkmcnt(0)" ::: "memory");
}
DI void na_wave_unit(KArgs args, LAS unsigned char* L, const Ctx& c, int u, int lane, int wave) {
    const int l = c.layer, head = u & 3, gr = u >> 2, rows = c.seqlen >> 6, seq = gr / rows, r = gr % rows;
    int rs = r - 4; rs = rs < 0 ? 0 : (rs > rows - 8 ? rows - 8 : rs);
    const bf16_t* PROJ = BIGP(bf16_t, B_PROJ);
    const size_t tq0 = (size_t)seq * c.seqlen + (size_t)r * 64;
    LAS bf16_t* Vt = (LAS bf16_t*)(L + wave * WAREA);
    LAS float* BIAS = (LAS float*)(L + wave * WAREA + 9216);
    const int rr = lane & 31, hh = lane >> 5;
#pragma unroll
    for (int w = 0; w < 4; ++w) { const int idx = w * 64 + lane, kw = idx >> 5, dc = idx & 31;
        if (dc < 31) BIAS[idx] = args->in[3][(((size_t)l * 4 + head) * 15 + (rs + kw - r + 7)) * 31 + dc]; }
    bf16x8 qf[2][4];
#pragma unroll
    for (int nt = 0; nt < 2; ++nt)
#pragma unroll
        for (int ks = 0; ks < 4; ++ks) qf[nt][ks] = *(const bf16x8*)(PROJ + (tq0 + 32 * nt + rr) * NPROJ + C_QA + 64 * head + 16 * ks + 8 * hh);
    f32x16 o[2][2]; o[0][0] = zero16(); o[0][1] = zero16(); o[1][0] = zero16(); o[1][1] = zero16();
    float m[2] = {-1e30f, -1e30f}, ls[2] = {0.f, 0.f};
    for (int w = 0; w < 8; ++w) {
        const size_t tk0 = (size_t)seq * c.seqlen + (size_t)(rs + w) * 64;
        asm volatile("s_waitcnt lgkmcnt(0)" ::: "memory");
        stage_vt(Vt, lane, [&](int key) { return PROJ + (tk0 + key) * NPROJ + C_VA + 64 * head; });
        f32x16 acc[2][2]; acc[0][0] = zero16(); acc[0][1] = zero16(); acc[1][0] = zero16(); acc[1][1] = zero16();
#pragma unroll
        for (int mt = 0; mt < 2; ++mt)
#pragma unroll
            for (int ks = 0; ks < 4; ++ks) { const bf16x8 kf = *(const bf16x8*)(PROJ + (tk0 + 32 * mt + rr) * NPROJ + C_KA + 64 * head + 16 * ks + 8 * hh);
                acc[mt][0] = MFMA32(kf, qf[0][ks], acc[mt][0]); acc[mt][1] = MFMA32(kf, qf[1][ks], acc[mt][1]); }
        asm volatile("s_waitcnt lgkmcnt(0)" ::: "memory");
        const LAS float* brow = BIAS + w * 32;
#pragma unroll
        for (int nt = 0; nt < 2; ++nt) { const int qc = 32 * nt + rr; int ws = qc - 8; ws = ws < 0 ? 0 : (ws > 48 ? 48 : ws);
#pragma unroll
            for (int mt = 0; mt < 2; ++mt)
#pragma unroll
                for (int g = 0; g < 16; ++g) { const int kc = 32 * mt + crow(g, hh); const bool ok = (kc >= ws) && (kc < ws + 16);
                    acc[mt][nt][g] = ok ? acc[mt][nt][g] * 0.125f + brow[ok ? (kc - qc + 15) : 0] : -1e30f; } }
        osm_update(acc, o, m, ls);
        pv_accum(acc, o, Vt, lane);
    }
    asm volatile("s_waitcnt lgkmcnt(0)" ::: "memory");
    const float sc[2] = {frcp(ls[0]), frcp(ls[1])};
    store_o_rows(Vt, o, sc, lane, [&](int q) { return BIGP(bf16_t, B_ONA) + (tq0 + q) * 896 + 64 * head; });
}
DI void rope_frag4(bf16x8 (&f)[4], const float* cs, int hh) {
#pragma unroll
    for (int ks = 0; ks < 2; ++ks) { const float* cp = cs + 16 * ks + 8 * hh;
        const f32x4 c0 = *(const f32x4*)cp, c1 = *(const f32x4*)(cp + 4), s0 = *(const f32x4*)(cp + 32), s1 = *(const f32x4*)(cp + 36);
        const u32x4 a = __builtin_bit_cast(u32x4, f[ks]), b = __builtin_bit_cast(u32x4, f[ks + 2]); u32x4 ra, rb;
#pragma unroll
        for (int j = 0; j < 4; ++j) { const float cl = (j < 2) ? c0[2 * j] : c1[2 * j - 4], ch = (j < 2) ? c0[2 * j + 1] : c1[2 * j - 3];
            const float sl = (j < 2) ? s0[2 * j] : s1[2 * j - 4], sh = (j < 2) ? s0[2 * j + 1] : s1[2 * j - 3];
            const float x1l = bflo(a[j]), x1h = bfhi(a[j]), x2l = bflo(b[j]), x2h = bfhi(b[j]);
            ra[j] = pk2(x1l * cl - x2l * sl, x1h * ch - x2h * sh); rb[j] = pk2(x1l * sl + x2l * cl, x1h * sh + x2h * ch); }
        f[ks] = __builtin_bit_cast(bf16x8, ra); f[ks + 2] = __builtin_bit_cast(bf16x8, rb); }
}
DI void dil_wave_unit(KArgs args, LAS unsigned char* L, const Ctx& c, int u, int lane, int wave) {
    const int hd = u & 1, uu = u >> 1, upg = c.stok >> 6, g = uu / upg, v = uu % upg, ups = c.seqlen >> 6, seq = v / ups, wq = v % ups;
    const int dsh = 2 * g, dd = 1 << dsh, nb = ups >> dsh, cls = wq / nb, jb = wq % nb, head = 2 * g + hd;
    const bf16_t* PROJ = BIGP(bf16_t, B_PROJ); const float* CS = WSP(float, WS_CS);
    const size_t sb = (size_t)seq * c.seqlen;
    const int rr = lane & 31, hh = lane >> 5;
    LAS bf16_t* Vt = (LAS bf16_t*)(L + wave * WAREA);
    bf16x8 qf[2][4];
#pragma unroll
    for (int nt = 0; nt < 2; ++nt) { const int pos = cls + dd * (64 * jb + 32 * nt + rr);
#pragma unroll
        for (int ks = 0; ks < 4; ++ks) qf[nt][ks] = *(const bf16x8*)(PROJ + (sb + pos) * NPROJ + C_QD + 64 * head + 16 * ks + 8 * hh);
        rope_frag4(qf[nt], CS + (size_t)pos * 64, hh); }
    f32x16 o[2][2]; o[0][0] = zero16(); o[0][1] = zero16(); o[1][0] = zero16(); o[1][1] = zero16();
    float m[2] = {-1e30f, -1e30f}, ls[2] = {0.f, 0.f};
    for (int kt = 0; kt < 3; ++kt) { const int kj = jb - 1 + kt;
        if (kj < 0 || kj >= nb) continue;
        asm volatile("s_waitcnt lgkmcnt(0)" ::: "memory");
        stage_vt(Vt, lane, [&](int key) { return PROJ + (sb + cls + (size_t)dd * (64 * kj + key)) * NPROJ + C_VD + 64 * head; });
        f32x16 acc[2][2]; acc[0][0] = zero16(); acc[0][1] = zero16(); acc[1][0] = zero16(); acc[1][1] = zero16();
#pragma unroll
        for (int mt = 0; mt < 2; ++mt) { const int pos = cls + dd * (64 * kj + 32 * mt + rr); bf16x8 kf[4];
#pragma unroll
            for (int ks = 0; ks < 4; ++ks) kf[ks] = *(const bf16x8*)(PROJ + (sb + pos) * NPROJ + C_KD + 64 * head + 16 * ks + 8 * hh);
            rope_frag4(kf, CS + (size_t)pos * 64, hh);
#pragma unroll
            for (int ks = 0; ks < 4; ++ks) { acc[mt][0] = MFMA32(kf[ks], qf[0][ks], acc[mt][0]); acc[mt][1] = MFMA32(kf[ks], qf[1][ks], acc[mt][1]); } }
#pragma unroll
        for (int nt = 0; nt < 2; ++nt) { const int qc = 32 * nt + rr;
#pragma unroll
            for (int mt = 0; mt < 2; ++mt)
#pragma unroll
                for (int gg = 0; gg < 16; ++gg) { const int kc = 32 * mt + crow(gg, hh); const bool ok = (kt == 1) || (kt == 0 ? (kc >= qc) : (kc <= qc));
                    acc[mt][nt][gg] = ok ? acc[mt][nt][gg] * 0.125f : -1e30f; } }
        osm_update(acc, o, m, ls);
        pv_accum(acc, o, Vt, lane);
    }
    asm volatile("s_waitcnt lgkmcnt(0)" ::: "memory");
    bf16_t* DP = BIGP(bf16_t, B_DILP); float* DM = BIGP(float, B_DILM);
    const float one[2] = {1.f, 1.f};
    store_o_rows(Vt, o, one, lane, [&](int q) { return DP + ((((size_t)g * SLABMAX + sb + cls + (size_t)dd * (64 * jb + q)) * 2 + hd)) * 64; });
    if (hh == 0) {
#pragma unroll
        for (int nt = 0; nt < 2; ++nt) { const size_t base = (((size_t)g * SLABMAX + sb + cls + (size_t)dd * (64 * jb + 32 * nt + rr)) * 2 + hd); DM[base * 2] = m[nt]; DM[base * 2 + 1] = ls[nt]; } }
}

DI void phase_mix_a(KArgs args, LAS unsigned char* L, const Ctx& c) {
    const int N_PREP = (c.stok >> 6) * 6;
    for (int u = c.bid; u < N_PREP; u += c.G) gdn_prep_pair(args, L, c, u);
}
DI void attn_wave_units(KArgs args, LAS unsigned char* L, const Ctx& c) {
    int tid = c.tid; asm volatile("" : "+v"(tid)); const int lane = tid & 63, wave = __builtin_amdgcn_readfirstlane(tid >> 6);
    const int nch_ = c.stok >> 6, N_NA = nch_ * 4, N_DIL = nch_ * 6;
    unsigned* q = (unsigned*)(c.ws + WS_CTL) + 32768 + 128 * (c.layer * 4 + c.slab);
    for (;;) { unsigned u = 0; if (lane == 0) u = __hip_atomic_fetch_add(q, 1u, __ATOMIC_RELAXED, __HIP_MEMORY_SCOPE_AGENT);
        u = (unsigned)__builtin_amdgcn_readfirstlane((int)u); if (u >= (unsigned)N_NA) break; na_wave_unit(args, L, c, (int)u, lane, wave); }
    int tid2 = c.tid; asm volatile("" : "+v"(tid2)); const int lane2 = tid2 & 63, wave2 = __builtin_amdgcn_readfirstlane(tid2 >> 6);
    for (;;) { unsigned u = 0; if (lane2 == 0) u = __hip_atomic_fetch_add(q + 64, 1u, __ATOMIC_RELAXED, __HIP_MEMORY_SCOPE_AGENT);
        u = (unsigned)__builtin_amdgcn_readfirstlane((int)u); if (u >= (unsigned)N_DIL) break; dil_wave_unit(args, L, c, (int)u, lane2, wave2); }
}

DI void phase_scan(KArgs args, LAS unsigned char* L, const Ctx& c) {
    const int nwu = c.nseq * 24, wu = c.bid;
    if (wu < nwu && c.wave == 0) {
        const int lane = c.lane, rr = lane & 31, hh = lane >> 5;
        const int chain = wu >> 1, nt = wu & 1, seq = chain / 12, rem = chain % 12, head = rem >> 1, dir = rem & 1;
        const int nch = c.seqlen >> 6, gch0 = seq * nch;
        unsigned char* GS = BIGP(unsigned char, B_GSCR);
        f32x16 S[2]; S[0] = zero16(); S[1] = zero16();
        bf16x8 A[2][2][4]; u32x4 cm[2][2][2]; float gl[2];
        const long gstep = (long)(dir ? -1 : 1) * 12 * GSTRIDE;
        const unsigned char* Gp = GS + (size_t)(((gch0 + (dir ? nch - 1 : 0)) * 6 + head) * 2 + dir) * GSTRIDE;
        unsigned char* Gs = (unsigned char*)Gp;
#define SCAN_LOAD(B) do { _Pragma("unroll") for (int mt = 0; mt < 2; ++mt) { _Pragma("unroll") for (int ks = 0; ks < 4; ++ks) A[B][mt][ks] = *(const bf16x8*)(Gp + (size_t)((mt * 4 + ks) * 64 + lane) * 16); \
            const u32x4* cp = (const u32x4*)(Gp + 8192 + (size_t)((nt * 2 + mt) * 64 + lane) * 32); cm[B][mt][0] = cp[0]; cm[B][mt][1] = cp[1]; } gl[B] = *(const float*)(Gp + 40960); } while (0)
#define SCAN_STEP(B) do { { bf16_t* St = (bf16_t*)(Gs + 32768) + (size_t)(32 * nt + rr) * 64 + 4 * hh; \
            _Pragma("unroll") for (int mt = 0; mt < 2; ++mt) _Pragma("unroll") for (int g = 0; g < 4; ++g) { u32x2 w; w.x = pk2(S[mt][4 * g], S[mt][4 * g + 1]); w.y = pk2(S[mt][4 * g + 2], S[mt][4 * g + 3]); *(u32x2*)(St + 32 * mt + 8 * g) = w; } } \
            const bf16x8 b0 = pack8<0>(S[0]), b1 = pack8<1>(S[0]), b2 = pack8<0>(S[1]), b3 = pack8<1>(S[1]); f32x16 nw[2]; \
            _Pragma("unroll") for (int mt = 0; mt < 2; ++mt) { \
                _Pragma("unroll") for (int g = 0; g < 8; ++g) { const unsigned wv = (g < 4) ? cm[B][mt][0][g] : cm[B][mt][1][g - 4]; nw[mt][2 * g] = gl[B] * S[mt][2 * g] + bflo(wv); nw[mt][2 * g + 1] = gl[B] * S[mt][2 * g + 1] + bfhi(wv); } \
                nw[mt] = MFMA32(A[B][mt][0], b0, nw[mt]); nw[mt] = MFMA32(A[B][mt][1], b1, nw[mt]); nw[mt] = MFMA32(A[B][mt][2], b2, nw[mt]); nw[mt] = MFMA32(A[B][mt][3], b3, nw[mt]); } \
            S[0] = nw[0]; S[1] = nw[1]; Gs += gstep; } while (0)
        SCAN_LOAD(0); Gp += gstep; SCAN_LOAD(1); Gp += gstep;
        for (int step = 0; step < nch; step += 2) {
            const bool more = step + 2 < nch;
            if (!more) Gp -= 2 * gstep;
            SCAN_STEP(0); SCAN_LOAD(0); Gp += gstep;
            SCAN_STEP(1); SCAN_LOAD(1); Gp += gstep;
        }
#undef SCAN_LOAD
#undef SCAN_STEP
    }
    attn_wave_units(args, L, c);
}

DI void dil_merge(const Ctx& c) {
    { const bf16_t* DP = BIGP(bf16_t, B_DILP); const float* DM = BIGP(float, B_DILM); bf16_t* OD = BIGP(bf16_t, B_ONA) + 256;
        for (int it = c.bid * 512 + c.tid; it < c.stok * 32; it += c.G * 512) { const int tok = it >> 5, part = it & 31;
            u32x4 w = {0u, 0u, 0u, 0u};
            if (part < 16) { const int hd = part >> 3, p = part & 7; float m[3], dn[3];
#pragma unroll
                for (int g = 0; g < 3; ++g) { const size_t b = (((size_t)g * SLABMAX + tok) * 2 + hd); m[g] = DM[b * 2]; dn[g] = DM[b * 2 + 1]; }
                const float M = fmaxf(m[0], fmaxf(m[1], m[2])); float num[8], den = 0.f;
#pragma unroll
                for (int j = 0; j < 8; ++j) num[j] = 0.f;
#pragma unroll
                for (int g = 0; g < 3; ++g) { const float f = __expf(m[g] - M); den += f * dn[g]; const u32x4 a = *(const u32x4*)(DP + (((size_t)g * SLABMAX + tok) * 2 + hd) * 64 + 8 * p);
                    num[0] += f * bflo(a[0]); num[1] += f * bfhi(a[0]); num[2] += f * bflo(a[1]); num[3] += f * bfhi(a[1]); num[4] += f * bflo(a[2]); num[5] += f * bfhi(a[2]); num[6] += f * bflo(a[3]); num[7] += f * bfhi(a[3]); }
                const float inv = frcp(den);
                w.x = pk2(num[0] * inv, num[1] * inv); w.y = pk2(num[2] * inv, num[3] * inv); w.z = pk2(num[4] * inv, num[5] * inv); w.w = pk2(num[6] * inv, num[7] * inv); }
            *(u32x4*)(OD + (size_t)tok * 896 + 8 * part) = w; } }
}

DI void phase_gdn_out(KArgs args, LAS unsigned char* L, const Ctx& c) {
    dil_merge(c);
    const int lane = c.lane, wave = c.wave, tid = c.tid, l = c.layer;
    const bf16_t* PROJ = BIGP(bf16_t, B_PROJ); unsigned char* GS = BIGP(unsigned char, B_GSCR); bf16_t* OG = BIGP(bf16_t, B_ONA) + 512;
    LAS float* OF = (LAS float*)L;
    for (int u = c.bid; u < (c.stok >> 6) * 6; u += c.G) { const int gch = u / 6, head = u % 6;
        { const int dir = wave >> 2, mt = (wave >> 1) & 1, nt = wave & 1, rr = lane & 31, hh = lane >> 5;
            const unsigned char* G = GS + (size_t)((gch * 6 + head) * 2 + dir) * GSTRIDE;
            const bf16_t* Qe = (const bf16_t*)(G + 16384); const bf16_t* Oct = (const bf16_t*)(G + 24576); const bf16_t* St = (const bf16_t*)(G + 32768);
            f32x16 acc = zero16();
#pragma unroll
            for (int ks = 0; ks < 4; ++ks) { const bf16x8 a = *(const bf16x8*)(Qe + (size_t)((mt * 4 + ks) * 64 + lane) * 8);
                const bf16_t* sp = St + (32 * nt + rr) * 64 + 32 * (ks >> 1) + 16 * (ks & 1) + 4 * hh; const u32x2 lo = *(const u32x2*)sp, hi = *(const u32x2*)(sp + 8);
                u32x4 bw; bw.x = lo.x; bw.y = lo.y; bw.z = hi.x; bw.w = hi.y; acc = MFMA32(a, __builtin_bit_cast(bf16x8, bw), acc); }
            const int e = 32 * nt + rr;
#pragma unroll
            for (int g = 0; g < 4; ++g) { const u32x2 w = *(const u32x2*)(Oct + e * 64 + 32 * mt + 8 * g + 4 * hh);
                const float v0 = acc[4 * g] + bflo(w.x), v1 = acc[4 * g + 1] + bfhi(w.x), v2 = acc[4 * g + 2] + bflo(w.y), v3 = acc[4 * g + 3] + bfhi(w.y);
                const int i0 = 32 * mt + 8 * g + 4 * hh;
#pragma unroll
                for (int j = 0; j < 4; ++j) { const int ii = i0 + j, tl = dir ? 63 - ii : ii; OF[(dir * 64 + tl) * 68 + e] = (j == 0) ? v0 : (j == 1) ? v1 : (j == 2) ? v2 : v3; } } }
        __syncthreads();
        { const int i = tid >> 3, p = tid & 7; const size_t tok = (size_t)gch * 64 + i;
            const LAS float* a = OF + i * 68 + 8 * p; const LAS float* b = OF + (64 + i) * 68 + 8 * p;
            float ov[8]; float ss = 0.f;
#pragma unroll
            for (int j = 0; j < 8; ++j) { ov[j] = a[j] + b[j]; ss += ov[j] * ov[j]; }
            ss += __shfl_xor(ss, 1); ss += __shfl_xor(ss, 2); ss += __shfl_xor(ss, 4);
            const float rs = frsq(ss * (1.0f / 64.0f) + NORM_EPS);
            const u32x4 zw = *(const u32x4*)(PROJ + tok * NPROJ + C_ZC + 64 * head + 8 * p);
            const float* nw = args->in[7] + l * 64 + 8 * p;
            float r[8];
#pragma unroll
            for (int j = 0; j < 4; ++j) { r[2 * j] = ov[2 * j] * rs * nw[2 * j] * siluf_(bflo(zw[j])); r[2 * j + 1] = ov[2 * j + 1] * rs * nw[2 * j + 1] * siluf_(bfhi(zw[j])); }
            u32x4 w; w.x = pk2(r[0], r[1]); w.y = pk2(r[2], r[3]); w.z = pk2(r[4], r[5]); w.w = pk2(r[6], r[7]);
            *(u32x4*)(OG + tok * 896 + 64 * head + 8 * p) = w; }
        __syncthreads();
    }
}

DI void phase_ln1(KArgs args, LAS unsigned char* L, const Ctx& c) {
    const int lane = c.lane, l = c.layer;
    LAS float* WR = (LAS float*)L;
    { const float* wr = args->in[14] + (size_t)l * D * 16;
        for (int i = c.tid; i < D * 16; i += 512) { const int col = i >> 4, e = i & 15, j = col >> 8, ln = (col >> 2) & 63, q = col & 3; WR[((j * 4 + q) * 64 + ln) * 20 + e] = wr[i]; } }
    __syncthreads();
    const float* g1 = args->in[12] + l * D; const float* b1 = args->in[13] + l * D;
    f32x4 gv[4], bv[4];
#pragma unroll
    for (int j = 0; j < 4; ++j) { gv[j] = *(const f32x4*)(g1 + 4 * lane + 256 * j); bv[j] = *(const f32x4*)(b1 + 4 * lane + 256 * j); }
    float* AFF = WSP(float, WS_AFF); int* SLOT = WSP(int, WS_SLOT); bf16_t* XB = WSP(bf16_t, WS_XB);
    f32x4 nv[4];
    { const int rl0 = c.bid * 8 + c.wave; if (rl0 < c.stok) { const float* hp = c.out + ((size_t)c.sbase + rl0) * D;
#pragma unroll
        for (int j = 0; j < 4; ++j) nv[j] = *(const f32x4*)(hp + 4 * lane + 256 * j); } }
    for (int rl = c.bid * 8 + c.wave; rl < c.stok; rl += c.G * 8) { const size_t tok = (size_t)c.sbase + rl;
        float* hr = c.out + tok * D; f32x4 v[4]; float s = 0.f;
#pragma unroll
        for (int j = 0; j < 4; ++j) { v[j] = nv[j]; s += (v[j][0] + v[j][1]) + (v[j][2] + v[j][3]); }
        if (rl + c.G * 8 < c.stok) { const float* hp = hr + (size_t)c.G * 8 * D;
#pragma unroll
            for (int j = 0; j < 4; ++j) nv[j] = *(const f32x4*)(hp + 4 * lane + 256 * j); }
        const float mean = wave_sum(s) * (1.0f / D); float s2 = 0.f;
#pragma unroll
        for (int j = 0; j < 4; ++j) { v[j] = v[j] - mean; s2 += (v[j][0] * v[j][0] + v[j][1] * v[j][1]) + (v[j][2] * v[j][2] + v[j][3] * v[j][3]); }
        const float rstd = frsq(wave_sum(s2) * (1.0f / D) + LN_EPS);
        float lg[16];
#pragma unroll
        for (int e = 0; e < 16; ++e) lg[e] = 0.f;
#pragma unroll
        for (int j = 0; j < 4; ++j) { v[j] = v[j] * rstd * gv[j] + bv[j];
            if (!c.dry) { *(f32x4*)(hr + 4 * lane + 256 * j) = v[j];
            u32x2 w; w.x = pk2(v[j][0], v[j][1]); w.y = pk2(v[j][2], v[j][3]); *(u32x2*)(XB + tok * D + 4 * lane + 256 * j) = w; }
#pragma unroll
            for (int q = 0; q < 4; ++q) { const LAS float* wp = WR + ((j * 4 + q) * 64 + lane) * 20; const float xv = v[j][q];
#pragma unroll
                for (int e4 = 0; e4 < 4; ++e4) { const f32x4 w4 = *(const LAS f32x4*)(wp + 4 * e4); lg[4 * e4] += xv * w4[0]; lg[4 * e4 + 1] += xv * w4[1]; lg[4 * e4 + 2] += xv * w4[2]; lg[4 * e4 + 3] += xv * w4[3]; } }
            asm volatile("" ::: "memory"); }
        float mx = -1e30f;
#pragma unroll
        for (int e = 0; e < 16; ++e) { lg[e] = wave_sum(lg[e]); mx = fmaxf(mx, lg[e]); }
        float den = 0.f;
#pragma unroll
        for (int e = 0; e < 16; ++e) { lg[e] = expf(lg[e] - mx); den += lg[e]; }
        float mine = 0.f;
#pragma unroll
        for (int e = 0; e < 16; ++e) mine = (lane == e) ? lg[e] : mine;
        if (lane < 16 && !c.dry) { AFF[(size_t)lane * T_ALL + tok] = mine / den; SLOT[tok * 16 + lane] = -1; }
    }
}
DI void phase_ln2(KArgs args, LAS unsigned char* L, const Ctx& c) {
    const int lane = c.lane, l = c.layer;
    const float* g2 = args->in[18] + l * D; const float* b2 = args->in[19] + l * D;
    f32x4 gv[4], bv[4];
#pragma unroll
    for (int j = 0; j < 4; ++j) { gv[j] = *(const f32x4*)(g2 + 4 * lane + 256 * j); bv[j] = *(const f32x4*)(b2 + 4 * lane + 256 * j); }
    const int* SLOT = WSP(int, WS_SLOT); bf16_t* XB = WSP(bf16_t, WS_XB);
    f32x4 nv[4]; int nsv = -1;
    { const int t0 = c.bid * 8 + c.wave; if (t0 < T_ALL) { const float* xp = c.out + (size_t)t0 * D; nsv = SLOT[(size_t)t0 * 16 + (lane & 15)];
#pragma unroll
        for (int j = 0; j < 4; ++j) nv[j] = *(const f32x4*)(xp + 4 * lane + 256 * j); } }
    for (int t = c.bid * 8 + c.wave; t < T_ALL; t += c.G * 8) { const size_t tok = (size_t)t;
        float* xr = c.out + tok * D; f32x4 v[4];
#pragma unroll
        for (int j = 0; j < 4; ++j) v[j] = nv[j] * ALPHA;
        const int sv = nsv;
        if (t + c.G * 8 < T_ALL) { const float* xp = xr + (size_t)c.G * 8 * D; nsv = SLOT[(tok + c.G * 8) * 16 + (lane & 15)];
#pragma unroll
            for (int j = 0; j < 4; ++j) nv[j] = *(const f32x4*)(xp + 4 * lane + 256 * j); }
#pragma unroll
        for (int e = 0; e < 16; ++e) { const int s = __builtin_amdgcn_readlane(sv, e);
            if (s >= 0) { const bf16_t* yr = BIGP(bf16_t, (e < 8 ? B_XY0 : B_XY1)) + ((size_t)(e & 7) * CAP + s) * D;
#pragma unroll
                for (int j = 0; j < 4; ++j) { const u32x2 w = *(const u32x2*)(yr + 4 * lane + 256 * j); v[j][0] += bflo(w.x); v[j][1] += bfhi(w.x); v[j][2] += bflo(w.y); v[j][3] += bfhi(w.y); } } }
        float s = 0.f;
#pragma unroll
        for (int j = 0; j < 4; ++j) s += (v[j][0] + v[j][1]) + (v[j][2] + v[j][3]);
        const float mean = wave_sum(s) * (1.0f / D); float s2 = 0.f;
#pragma unroll
        for (int j = 0; j < 4; ++j) { v[j] = v[j] - mean; s2 += (v[j][0] * v[j][0] + v[j][1] * v[j][1]) + (v[j][2] * v[j][2] + v[j][3] * v[j][3]); }
        const float rstd = frsq(wave_sum(s2) * (1.0f / D) + LN_EPS);
#pragma unroll
        for (int j = 0; j < 4; ++j) { v[j] = v[j] * rstd * gv[j] + bv[j];
            if (!c.dry) { *(f32x4*)(xr + 4 * lane + 256 * j) = v[j];
            u32x2 w; w.x = pk2(v[j][0], v[j][1]); w.y = pk2(v[j][2], v[j][3]); *(u32x2*)(XB + tok * D + 4 * lane + 256 * j) = w; } }
    }
}

DI int block_excl_scan(int v, LAS int* tmp, int tid, int& total) {
    const int lane = tid & 63, wave = tid >> 6; int x = v;
#pragma unroll
    for (int o = 1; o < 64; o <<= 1) { const int y = __shfl_up(x, o); if (lane >= o) x += y; }
    __syncthreads();
    if (lane == 63) tmp[wave] = x;
    __syncthreads();
    int base = 0, tot = 0;
#pragma unroll
    for (int w = 0; w < 8; ++w) { const int tw = tmp[w]; if (w < wave) base += tw; tot += tw; }
    total = tot;
    return base + x - v;
}
DI void phase_select(KArgs args, LAS unsigned char* L, const Ctx& c) {
    if (c.bid >= 32) return;
    const int tid = c.tid, grp = c.bid >> 4, e = c.bid & 15;
    const int n = grp ? T_S : T_P, t0 = grp ? T_P : 0, C = n >> 3, slot0 = grp ? CAP_P : 0;
    const unsigned* v = (const unsigned*)(WSP(float, WS_AFF) + (size_t)e * T_ALL + t0);
    LAS unsigned* hist = (LAS unsigned*)L; LAS int* sh = (LAS int*)(L + 1024); LAS int* tmp = (LAS int*)(L + 1024 + 64);
    unsigned prefix = 0u; int kk = C;
    for (int pass = 0; pass < 4; ++pass) { const int shift = 24 - 8 * pass; const unsigned mhi = pass == 0 ? 0u : (0xFFFFFFFFu << (shift + 8));
        if (tid < 256) hist[tid] = 0u;
        __syncthreads();
        for (int i = tid * 4; i < n; i += 512 * 16) {
            u32x4 x4[4];
#pragma unroll
            for (int k = 0; k < 4; ++k) x4[k] = *(const u32x4*)(v + i + k * 2048);
#pragma unroll
            for (int k = 0; k < 4; ++k)
#pragma unroll
                for (int j = 0; j < 4; ++j) { const unsigned x = x4[k][j]; if ((x & mhi) == prefix) __hip_atomic_fetch_add(&hist[(x >> shift) & 255u], 1u, __ATOMIC_RELAXED, __HIP_MEMORY_SCOPE_WORKGROUP); } }
        __syncthreads();
        if (tid == 0) { int cum = 0, sel = 0; for (int b = 255; b >= 0; --b) { const int h = (int)hist[b]; if (cum + h >= kk) { sel = b; break; } cum += h; } sh[0] = sel; sh[1] = kk - cum; }
        __syncthreads();
        prefix |= ((unsigned)sh[0]) << shift; kk = sh[1];
        __syncthreads();
    }
    const unsigned thr = prefix;
    const int per = n >> 9, i0 = tid * per;
    int ngt = 0, ntie = 0;
    for (int i = 0; i < per; i += 4) { const u32x4 x = *(const u32x4*)(v + i0 + i);
#pragma unroll
        for (int j = 0; j < 4; ++j) { ngt += (x[j] > thr); ntie += (x[j] == thr); } }
    int tot;
    const int tie_base = block_excl_scan(ntie, tmp, tid, tot);
    int take = kk - tie_base; take = take < 0 ? 0 : (take > ntie ? ntie : take);
    int pos = block_excl_scan(ngt + take, tmp, tid, tot);
    int* IDX = WSP(int, WS_IDX) + e * CAP + slot0;
    int tr = 0;
    for (int i = 0; i < per; i += 4) { const u32x4 x = *(const u32x4*)(v + i0 + i);
#pragma unroll
        for (int j = 0; j < 4; ++j) { bool s = x[j] > thr; if (x[j] == thr) { s = tr < take; ++tr; } if (s) { IDX[pos] = t0 + i0 + i + j; ++pos; } } }
}
DI void phase_gather(KArgs args, LAS unsigned char* L, const Ctx& c) {
    const int lane = c.lane; const int* IDX = WSP(int, WS_IDX); const bf16_t* XB = WSP(bf16_t, WS_XB);
    float* GATEV = WSP(float, WS_GATEV); int* SLOT = WSP(int, WS_SLOT); const float* AFF = WSP(float, WS_AFF);
    for (int row0 = (c.bid * 8 + c.wave) * 4; row0 < NE * CAP; row0 += c.G * 8 * 4) {
        const int e = row0 / CAP, s0 = row0 % CAP; int t[4]; u32x4 a[4], b[4];
#pragma unroll
        for (int k = 0; k < 4; ++k) t[k] = IDX[row0 + k];
#pragma unroll
        for (int k = 0; k < 4; ++k) { const u32x4* src = (const u32x4*)(XB + (size_t)t[k] * D); a[k] = src[lane]; b[k] = src[64 + lane]; }
        u32x4* dst = (u32x4*)(BIGP(bf16_t, (e < 8 ? B_XY0 : B_XY1)) + ((size_t)(e & 7) * CAP + s0) * D);
#pragma unroll
        for (int k = 0; k < 4; ++k) { dst[k * 128 + lane] = a[k]; dst[k * 128 + 64 + lane] = b[k]; }
        if (lane < 4) { const int tt = (lane == 0) ? t[0] : (lane == 1) ? t[1] : (lane == 2) ? t[2] : t[3]; SLOT[(size_t)tt * 16 + e] = s0 + lane; GATEV[row0 + lane] = AFF[(size_t)e * T_ALL + tt]; } }
}

__global__ void __launch_bounds__(512, 2) fwd_kernel(Args args) {
    extern __shared__ __attribute__((aligned(16))) unsigned char lds_raw[];
    LAS unsigned char* L = (LAS unsigned char*)lds_raw;
    Ctx c;
    c.out = args.out; c.ws = args.ws;
    c.tid = threadIdx.x; c.lane = c.tid & 63; c.wave = __builtin_amdgcn_readfirstlane(c.tid >> 6); c.G = gridDim.x; c.bid = blockIdx.x;
    c.layer = 0; c.slab = 0; c.nseq = 8; c.seqlen = 4096; c.stok = 32768; c.sbase = 0; c.dry = 0;
    const int lo = args.ph_lo, hi = args.ph_hi;
    volatile LAS unsigned* MISC = (volatile LAS unsigned*)(L + LDS_MISC);
    if (c.tid < 4) MISC[c.tid] = 0u;
    __syncthreads();
    XcdBarrier bar; bar.bar = (unsigned*)(c.ws + WS_CTL) + 1024; bar.x = 0; bar.st = MISC;
    if (hi - lo > 1) bar = xcd_barrier_post((unsigned*)(c.ws + WS_CTL) + 1024, MISC);
    int pc = 0;
#ifndef PHMASK
#define PHMASK 0xFFFF
#endif
#define PHON(k) (((PHMASK) >> (k)) & 1)
#ifndef REPMASK
#define REPMASK 0x0
#endif
#define PH_BEGIN(k) if (PHON(k) && pc >= lo && pc < hi) { { int tz = threadIdx.x; asm volatile("" : "+v"(tz)); c.tid = tz; c.lane = tz & 63; c.wave = __builtin_amdgcn_readfirstlane(tz >> 6); } KArgs ka = kargs(); c.ws = ka->ws; c.out = ka->out; { int b_ = blockIdx.x, g_ = gridDim.x; asm volatile("" : "+s"(b_), "+s"(g_)); c.bid = b_; c.G = g_; } for (int rep_ = 0; rep_ < (((REPMASK) >> (k)) & 1) + 1; ++rep_) { if (rep_) __syncthreads(); c.dry = (rep_ + 1 < (((REPMASK) >> (k)) & 1) + 1);
#ifndef BARREP
#define BARREP 0
#endif
#define PH_END   } if (pc + 1 < hi) { xcd_barrier(bar); if (BARREP) { xcd_barrier(bar); xcd_barrier(bar); } } else { asm volatile("s_waitcnt vmcnt(0)" ::: "memory"); __syncthreads(); } } ++pc;

    for (int layer = 0; layer < 2; ++layer) {
        c.layer = layer;
        PH_BEGIN(0) phase_weights(ka, L, c); PH_END
        for (int slab = 0; slab < NSLAB; ++slab) {
            c.slab = slab; c.nseq = slab < 2 ? 8 : 1; c.seqlen = slab < 2 ? 4096 : 16384; c.stok = slab < 2 ? 32768 : 16384; c.sbase = slab * 32768; const int stok = c.stok; const size_t sbase = (size_t)c.sbase;
            PH_BEGIN(1) {
                pg8::Gemm g{WSP(bf16_t, WS_XB) + sbase * D, WSP(bf16_t, WS_WIN), stok, NPROJ, D}; pg8::StaticOrder S; S.init(stok, NPROJ, c.G, c.bid);
                pg8::EpiInProj E{BIGP(bf16_t, B_PROJ), BIGP(float, B_BA)};
                pg8::gemm_phase<pg8::EpiInProj, pg8::StaticOrder>(L, g, S, E); } PH_END
            PH_BEGIN(2) phase_mix_a(ka, L, c); PH_END
            PH_BEGIN(3) phase_scan(ka, L, c); PH_END
            PH_BEGIN(4) phase_gdn_out(ka, L, c); PH_END
            PH_BEGIN(5) {
                pg8::StaticOrder S; S.init(stok, D, c.G, c.bid);
                pg8::Gemm g{BIGP(bf16_t, B_ONA), WSP(bf16_t, WS_WBR), stok, D, 896}; pg8::EpiGateCat E{BIGP(bf16_t, B_PROJ), BIGP(bf16_t, B_MERGED)};
                pg8::gemm_phase<pg8::EpiGateCat, pg8::StaticOrder>(L, g, S, E); } PH_END
            PH_BEGIN(6) {
                const float* xr = layer == 0 ? (slab < 2 ? ka->in[0] + sbase * D : ka->in[1]) : c.out + sbase * D;
                pg8::Gemm g{BIGP(bf16_t, B_MERGED), WSP(bf16_t, WS_WOUT), stok, D, D}; pg8::StaticOrder S; S.init(stok, D, c.G, c.bid);
                pg8::EpiRes E{xr, c.out + sbase * D};
                pg8::gemm_phase<pg8::EpiRes, pg8::StaticOrder>(L, g, S, E); } PH_END
#ifndef LN1PROBE
#define LN1PROBE 0
#endif
            PH_BEGIN(7) if (LN1PROBE) { c.dry = 1; phase_ln1(ka, L, c); __syncthreads(); c.dry = 0; } phase_ln1(ka, L, c); PH_END
        }
        PH_BEGIN(8) phase_select(ka, L, c); PH_END
        PH_BEGIN(9) phase_gather(ka, L, c); PH_END
        for (int half = 0; half < 2; ++half) {
            PH_BEGIN(10) {
                pg8::Gemm g{BIGP(bf16_t, half ? B_XY1 : B_XY0), WSP(bf16_t, WS_WGU) + (size_t)half * 8 * 4096 * D, 8 * CAP, 8 * 4096, D}; pg8::MoeOrder S; S.init(8, CAP / 256, 16, c.G, c.bid);
                pg8::EpiSwiglu E{BIGP(bf16_t, B_HID)};
                pg8::gemm_phase<pg8::EpiSwiglu, pg8::MoeOrder>(L, g, S, E); } PH_END
            PH_BEGIN(11) {
                pg8::Gemm g{BIGP(bf16_t, B_HID), WSP(bf16_t, WS_WD) + (size_t)half * 8 * D * DE, 8 * CAP, 8 * D, DE}; pg8::MoeOrder S; S.init(8, CAP / 256, 4, c.G, c.bid);
                pg8::EpiDown E{BIGP(bf16_t, half ? B_XY1 : B_XY0), WSP(float, WS_GATEV) + (size_t)half * 8 * CAP};
                pg8::gemm_phase<pg8::EpiDown, pg8::MoeOrder>(L, g, S, E); } PH_END
        }
        PH_BEGIN(12) phase_ln2(ka, L, c); PH_END
    }
#undef PH_BEGIN
#undef PH_END
}

constexpr int N_PHASES = 2 * (1 + NSLAB * 7 + 2 + 4 + 1);

extern "C" void kernel_launch(void* const* d_in, const int* in_sizes, int n_in, void* d_out, int out_size, void* d_ws, size_t ws_size, hipStream_t stream) {
    static int grid = 0;
    if (grid == 0) {
        if (n_in != 20 || ws_size < WS_END) { fprintf(stderr, "kernel_launch: unexpected n_in %d or ws_size %zu (< %zu)\n", n_in, ws_size, (size_t)WS_END); grid = -1; return; }
        int dev = 0, cus = 0, per_cu = 0;
        if (hipGetDevice(&dev) != hipSuccess || hipDeviceGetAttribute(&cus, hipDeviceAttributeMultiprocessorCount, dev) != hipSuccess) { grid = -1; return; }
        if (hipFuncSetAttribute((const void*)fwd_kernel, hipFuncAttributeMaxDynamicSharedMemorySize, LDS_BYTES) != hipSuccess) { fprintf(stderr, "kernel_launch: hipFuncSetAttribute failed\n"); grid = -1; return; }
        if (hipOccupancyMaxActiveBlocksPerMultiprocessor(&per_cu, (const void*)fwd_kernel, 512, LDS_BYTES) != hipSuccess || per_cu < 1) fprintf(stderr, "kernel_launch: occupancy query says %d\n", per_cu);
        (void)hipGetLastError();
        grid = cus;
    }
    if (grid < 0) return;
    (void)hipMemsetAsync((char*)d_ws + WS_CTL, 0, 1 * MiB, stream);
    Args a{};
    for (int i = 0; i < 20; ++i) a.in[i] = (const float*)d_in[i];
    a.out = (float*)d_out; a.ws = (unsigned char*)d_ws;
#if MK_N_LAUNCHES == 1
    a.ph_lo = 0; a.ph_hi = N_PHASES;
    hipLaunchKernelGGL(fwd_kernel, dim3(grid), dim3(512), LDS_BYTES, stream, a);
#else
    for (int p = 0; p < N_PHASES; ++p) { a.ph_lo = p; a.ph_hi = p + 1; hipLaunchKernelGGL(fwd_kernel, dim3(grid), dim3(512), LDS_BYTES, stream, a); }
#endif
}
```

```cpp
#include <hip/hip_runtime.h>
#include <stdint.h>
#include <stdio.h>

#define LAS __attribute__((address_space(3)))
#define DI __device__ __forceinline__
typedef unsigned short bf16_t;
typedef short bf16x8 __attribute__((ext_vector_type(8)));
typedef float f32x4 __attribute__((ext_vector_type(4)));
typedef float f32x2 __attribute__((ext_vector_type(2)));
typedef float f32x16 __attribute__((ext_vector_type(16)));
typedef unsigned u32x4 __attribute__((ext_vector_type(4)));
typedef unsigned u32x2 __attribute__((ext_vector_type(2)));
typedef __bf16 bf16x2v __attribute__((ext_vector_type(2)));

#ifndef MK_N_LAUNCHES
#define MK_N_LAUNCHES 1
#endif

constexpr int D = 1024, T_ALL = 81920, T_P = 65536, T_S = 16384, SLABMAX = 32768, NSLAB = 3;
constexpr int DIN = 6552, NPROJ = 6656;
constexpr int C_GATE = 0, C_QA = 3072, C_KA = 3328, C_VA = 3584, C_QD = 3840, C_KD = 4224, C_VD = 4608, C_QC = 4992, C_KC = 5376, C_VC = 5760, C_ZC = 6144;
constexpr int NE = 16, DE = 2048, CAP_P = 8192, CAP_S = 2048, CAP = CAP_P + CAP_S;
constexpr float ALPHA = 1.41421356237f, LN_EPS = 1e-5f, NORM_EPS = 1e-6f;
constexpr size_t MiB = 1u << 20;
constexpr size_t WS_CTL = 0, WS_WIN = 1 * MiB, WS_WBR = 14 * MiB, WS_WOUT = 16 * MiB, WS_WGU = 18 * MiB, WS_WD = 146 * MiB, WS_XB = 210 * MiB;
constexpr size_t WS_AFF = 370 * MiB, WS_SLOT = 375 * MiB, WS_IDX = 380 * MiB, WS_GATEV = 381 * MiB, WS_CS = 382 * MiB, WS_BIG = 386 * MiB, WS_END = 1130 * MiB;
constexpr size_t B_PROJ = 0, B_BA = 416 * MiB, B_ONA = 420 * MiB, B_ODIL = 436 * MiB, B_OGDN = 452 * MiB, B_DILP = 476 * MiB, B_DILM = 500 * MiB, B_GSCR = 502 * MiB, B_MERGEF = 502 * MiB, B_MERGED = 630 * MiB;
constexpr size_t B_XY0 = 0, B_XY1 = 160 * MiB, B_HID = 320 * MiB;
constexpr int GSTRIDE = 41216;
constexpr int LDS_BYTES = 147456;
constexpr int LDS_MISC = 145408;

DI unsigned pk2(float lo, float hi) { f32x2 v = {lo, hi}; bf16x2v b = __builtin_convertvector(v, bf16x2v); return __builtin_bit_cast(unsigned, b); }
DI float bflo(unsigned u) { return __uint_as_float(u << 16); }
DI float bfhi(unsigned u) { return __uint_as_float(u & 0xffff0000u); }
DI float frcp(float x) { return __builtin_amdgcn_rcpf(x); }
DI float frsq(float x) { return __builtin_amdgcn_rsqf(x); }
DI float sigmoidf_(float x) { return frcp(1.0f + __expf(-x)); }
DI float siluf_(float x) { return x * frcp(1.0f + __expf(-x)); }
DI float wave_sum(float v) {
#pragma unroll
    for (int o = 1; o < 64; o <<= 1) v += __shfl_xor(v, o);
    return v;
}
#define MFMA32(a, b, c) __builtin_amdgcn_mfma_f32_32x32x16_bf16((a), (b), (c), 0, 0, 0)
DI int crow(int reg, int h) { return (reg & 3) + 8 * (reg >> 2) + 4 * h; }
DI f32x16 zero16() { f32x16 z; for (int i = 0; i < 16; ++i) z[i] = 0.f; return z; }
template <int S> DI bf16x8 pack8(const f32x16& x) {
    u32x4 p; p[0] = pk2(x[8 * S], x[8 * S + 1]); p[1] = pk2(x[8 * S + 2], x[8 * S + 3]); p[2] = pk2(x[8 * S + 4], x[8 * S + 5]); p[3] = pk2(x[8 * S + 6], x[8 * S + 7]);
    return __builtin_bit_cast(bf16x8, p);
}

namespace pg8 {
constexpr int BM = 256, BK = 64, HALF = 128, HTB = HALF * BK * 2, STAGE_BYTES = 8 * HTB, NXCD = 8, WGM = 8;
__host__ __device__ __forceinline__ int lds_byte(int r, int c) { const int st = (r >> 4) * 2 + (c >> 5), rr = r & 15, cc = c & 31, ob = rr * 64 + cc * 2; return st * 1024 + (ob ^ (((ob >> 9) & 1) << 5)); }
__host__ __device__ __forceinline__ void stage_rc(int b, int& R, int& C) { const int st = b / 1024, sb = b % 1024, swz = sb ^ (((sb >> 9) & 1) << 5); R = (st >> 1) * 16 + swz / 64; C = (st & 1) * 32 + (swz % 64) / 2; }
__host__ __device__ __forceinline__ int perm32(int rho) { const int n = rho >> 4, i = rho & 15; return 8 * (i >> 2) + 4 * n + (i & 3); }
struct Unit { int pm, pn; };
struct Gemm { const bf16_t* A; const bf16_t* Bt; int M, N, K; };
struct StaticOrder {
    int nM, nN, nwg, G, c;
    __device__ void init(int M, int N, int G_, int c_) { nM = M / BM; nN = N / BM; nwg = nM * nN; G = G_; c = c_; }
    __device__ bool next(int i, Unit& u) const {
        const long L = (long)i * G + c; if (L >= nwg) return false;
        int wgid = (int)L; { const int q = nwg / NXCD, r = nwg % NXCD, xcd = wgid % NXCD, off = wgid / NXCD; wgid = (xcd < r ? xcd * (q + 1) : r * (q + 1) + (xcd - r) * q) + off; }
        const int nig = WGM * nN, gid = wgid / nig, fm = gid * WGM, gsz = (nM - fm) < WGM ? (nM - fm) : WGM;
        u.pm = fm + ((wgid % nig) % gsz); u.pn = (wgid % nig) / gsz; return true;
    }
    __device__ __forceinline__ void a_ready(const Unit&) const {}
    __device__ __forceinline__ void done(const Unit&) const {}
};
struct MoeOrder {
    int nMe, nNe, per, total, G, c, xr, xc, rpx, cpx, share;
    __device__ void init(int nE, int nMe_, int nNe_, int G_, int c_) { nMe = nMe_; nNe = nNe_; per = nMe * nNe; total = nE * per; G = G_; c = c_;
        xc = (nNe % 2 == 0 && nNe >= 8) ? 2 : 1; xr = 8 / xc; rpx = nMe / xr; cpx = nNe / xc; share = rpx * cpx; }
    __device__ bool next(int i, Unit& u) const {
        if ((G & 7) == 0 && nMe % xr == 0) {
            const int x = c & 7, q = c >> 3, nq = G >> 3; const long j = (long)i * nq + q; if (j >= (long)(total / 8)) return false;
            const int e = (int)(j / share), r = (int)(j % share); const int pm = (x / xc) * rpx + r % rpx, pn = (x % xc) * cpx + r / rpx;
            u.pm = e * nMe + pm; u.pn = e * nNe + pn; return true;
        }
        const long L = (long)i * G + c; if (L >= total) return false;
        const int e = (int)(L / per), r = (int)(L % per);
        u.pm = e * nMe + r % nMe; u.pn = e * nNe + r / nMe; return true;
    }
    __device__ __forceinline__ void a_ready(const Unit&) const {}
    __device__ __forceinline__ void done(const Unit&) const {}
};

template <class Epi, class Sched>
__device__ __forceinline__ void gemm_phase(LAS unsigned char* lds, const Gemm g, const Sched& S, const Epi& E) {
    int tid = threadIdx.x; asm volatile("" : "+v"(tid));
    const int wid = __builtin_amdgcn_readfirstlane(tid >> 6), lane = tid & 63, wr = wid >> 2, wc = wid & 3, fr = lane & 15, fq = lane >> 4;
    int Kv = g.K; asm volatile("" : "+s"(Kv));
    const int K = Kv, nt = K / BK;
    unsigned voffA[2], voffB[2];
#pragma unroll
    for (int i = 0; i < 2; ++i) { int R, C; stage_rc(tid * 16 + i * 8192, R, C); const int Rb = Epi::PERM ? ((R & ~31) + perm32(R & 31)) : R;
        voffA[i] = (unsigned)(R * K + C) * 2u; voffB[i] = (unsigned)(Rb * K + C) * 2u; }
    const size_t kstep = (size_t)(BK * 2);
    const size_t hstep = (size_t)HALF * K * 2;
    const size_t tstep = 2 * hstep;
    const unsigned ldsw = (unsigned)wid * 1024u;
    const int aoff = lds_byte(wr * 64 + fr, fq * 8), boff = lds_byte(wc * 32 + fr, fq * 8);
#define PG8_SA(b, h) (((b) * 2 + (h)) * HTB)
#define PG8_SB(b, h) ((4 + (b) * 2 + (h)) * HTB)
#define PG8_STAGE(bufoff, gbase, voff) do { _Pragma("unroll") for (int _i = 0; _i < 2; ++_i) \
        __builtin_amdgcn_global_load_lds((const unsigned*)((const char*)(gbase) + (voff)[_i]), (LAS unsigned*)(lds + (bufoff) + ldsw + _i * 8192), 16, 0, 0); } while (0)
#define PG8_LDA(dst, b, h) do { _Pragma("unroll") for (int m = 0; m < 4; ++m) _Pragma("unroll") for (int k = 0; k < 2; ++k) dst[m][k] = *(const LAS bf16x8*)(lds + PG8_SA(b, h) + aoff + m * 2048 + k * 1024); } while (0)
#define PG8_LDB(dst, b, h) do { _Pragma("unroll") for (int n = 0; n < 2; ++n) _Pragma("unroll") for (int k = 0; k < 2; ++k) dst[n][k] = *(const LAS bf16x8*)(lds + PG8_SB(b, h) + boff + n * 2048 + k * 1024); } while (0)
#define PG8_MMA(ai, bj, At, Bt) do { __builtin_amdgcn_s_setprio(1); _Pragma("unroll") for (int m = 0; m < 4; ++m) _Pragma("unroll") for (int n = 0; n < 2; ++n) _Pragma("unroll") for (int k = 0; k < 2; ++k) \
        acc[ai][bj][m][n] = __builtin_amdgcn_mfma_f32_16x16x32_bf16(Bt[n][k], At[m][k], acc[ai][bj][m][n], 0, 0, 0); __builtin_amdgcn_s_setprio(0); } while (0)
#define PG8_WAIT_V(n) asm volatile("s_waitcnt vmcnt(" #n ")" ::: "memory")
#define PG8_WAIT_L(n) asm volatile("s_waitcnt lgkmcnt(" #n ")" ::: "memory")
#define PG8_BAR __builtin_amdgcn_s_barrier()
#define PG8_SCHED __builtin_amdgcn_sched_barrier(0)
    Unit cur, nxt; int ui = 0;
    if (!S.next(0, cur)) return;
    f32x4 acc[2][2][4][2];
#pragma unroll
    for (int a = 0; a < 2; ++a)
#pragma unroll
        for (int b = 0; b < 2; ++b)
#pragma unroll
            for (int m = 0; m < 4; ++m)
#pragma unroll
                for (int n = 0; n < 2; ++n) acc[a][b][m][n] = (f32x4){0.f, 0.f, 0.f, 0.f};
    bf16x8 At[4][2], B0[2][2], B1[2][2];
    const char* cA = (const char*)g.A + (size_t)cur.pm * tstep; const char* cB = (const char*)g.Bt + (size_t)cur.pn * tstep;
    S.a_ready(cur);
    PG8_STAGE(PG8_SB(0, 0), cB, voffB); PG8_STAGE(PG8_SA(0, 0), cA, voffA); PG8_STAGE(PG8_SB(0, 1), cB + hstep, voffB); PG8_STAGE(PG8_SA(0, 1), cA + hstep, voffA);
    if (wr == 1) PG8_BAR;
    PG8_WAIT_V(4); PG8_BAR;
    PG8_STAGE(PG8_SB(1, 0), cB + kstep, voffB); PG8_STAGE(PG8_SA(1, 0), cA + kstep, voffA); PG8_STAGE(PG8_SB(1, 1), cB + hstep + kstep, voffB);
    PG8_WAIT_V(6); PG8_BAR;
    for (;;) {
        const bool has_next = S.next(ui + 1, nxt);
        const char* nA = has_next ? (const char*)g.A + (size_t)nxt.pm * tstep : cA; const char* nB = has_next ? (const char*)g.Bt + (size_t)nxt.pn * tstep : cB;
        for (int t = 0; t < nt; t += 2) {
            const bool last = (t == nt - 2);
            const char* a1 = cA + (size_t)(t + 1) * kstep;
            const char* a2 = last ? nA : cA + (size_t)(t + 2) * kstep; const char* b2 = last ? nB : cB + (size_t)(t + 2) * kstep;
            const char* a3 = a2 + kstep; const char* b3 = b2 + kstep;
            if (last && has_next) S.a_ready(nxt);
            if constexpr (Epi::SEG) { if (t == 4 || t == 6) { int tz = tid; asm volatile("" : "+v"(tz)); const int wz = __builtin_amdgcn_readfirstlane(tz >> 6), lz = tz & 63; E.mid(acc, cur, t == 4 ? 0 : 1, wz >> 2, wz & 3, lz & 15, lz >> 4); } }
            PG8_LDB(B0, 0, 0); PG8_SCHED; PG8_LDA(At, 0, 0); PG8_STAGE(PG8_SA(1, 1), a1 + hstep, voffA);
            PG8_WAIT_L(8); PG8_BAR; PG8_WAIT_L(0); PG8_MMA(0, 0, At, B0); PG8_BAR; PG8_SCHED;
            PG8_LDB(B1, 0, 1); PG8_STAGE(PG8_SB(0, 0), b2, voffB);
            PG8_BAR; PG8_WAIT_L(0); PG8_MMA(0, 1, At, B1); PG8_BAR;
            PG8_LDA(At, 0, 1); PG8_STAGE(PG8_SA(0, 0), a2, voffA);
            PG8_BAR; PG8_WAIT_L(0); PG8_MMA(1, 0, At, B0); PG8_BAR; PG8_SCHED;
            PG8_STAGE(PG8_SB(0, 1), b2 + hstep, voffB);
            PG8_WAIT_V(6); PG8_BAR; PG8_MMA(1, 1, At, B1); PG8_BAR;
            PG8_LDB(B0, 1, 0); PG8_SCHED; PG8_LDA(At, 1, 0); PG8_STAGE(PG8_SA(0, 1), a2 + hstep, voffA);
            PG8_WAIT_L(8); PG8_BAR; PG8_WAIT_L(0); PG8_MMA(0, 0, At, B0); PG8_BAR; PG8_SCHED;
            PG8_LDB(B1, 1, 1); PG8_STAGE(PG8_SB(1, 0), b3, voffB);
            PG8_BAR; PG8_WAIT_L(0); PG8_MMA(0, 1, At, B1); PG8_BAR;
            PG8_LDA(At, 1, 1); PG8_STAGE(PG8_SA(1, 0), a3, voffA);
            PG8_BAR; PG8_WAIT_L(0); PG8_MMA(1, 0, At, B0); PG8_BAR; PG8_SCHED;
            PG8_STAGE(PG8_SB(1, 1), b3 + hstep, voffB);
            PG8_WAIT_V(6); PG8_BAR; PG8_MMA(1, 1, At, B1); PG8_BAR;
        }
        { int tz = tid; asm volatile("" : "+v"(tz)); const int wz = __builtin_amdgcn_readfirstlane(tz >> 6), lz = tz & 63;
          E(acc, cur, wz >> 2, wz & 3, lz & 15, lz >> 4); } S.done(cur);
        if (!has_next) break;
#pragma unroll
        for (int a = 0; a < 2; ++a)
#pragma unroll
            for (int b = 0; b < 2; ++b)
#pragma unroll
                for (int m = 0; m < 4; ++m)
#pragma unroll
                    for (int n = 0; n < 2; ++n) acc[a][b][m][n] = (f32x4){0.f, 0.f, 0.f, 0.f};
        cur = nxt; cA = nA; cB = nB; ++ui;
    }
    PG8_WAIT_V(0);
    if (wr == 0) PG8_BAR;
    PG8_BAR;
#undef PG8_SA
#undef PG8_SB
#undef PG8_STAGE
#undef PG8_LDA
#undef PG8_LDB
#undef PG8_MMA
#undef PG8_WAIT_V
#undef PG8_WAIT_L
#undef PG8_BAR
#undef PG8_SCHED
}

struct EpiInProj {
    static constexpr bool PERM = true, SEG = false;
    bf16_t* O; float* BA;
    __device__ __forceinline__ void operator()(const f32x4 (&acc)[2][2][4][2], const Unit& u, int wr, int wc, int fr, int fq) const {
        const int row0 = u.pm * BM + wr * 64 + fr, col0 = u.pn * BM + wc * 32 + 8 * fq;
        const bool sig = u.pn < 12, ba = (u.pn == 25) && (wc == 0) && (fq < 3);
#pragma unroll
        for (int ai = 0; ai < 2; ++ai)
#pragma unroll
            for (int m = 0; m < 4; ++m) { const int row = row0 + ai * HALF + m * 16; bf16_t* rowp = O + (size_t)row * NPROJ + col0;
#pragma unroll
                for (int bj = 0; bj < 2; ++bj) { f32x4 v0 = acc[ai][bj][m][0], v1 = acc[ai][bj][m][1];
                    if (sig) {
#pragma unroll
                        for (int j = 0; j < 4; ++j) { v0[j] = sigmoidf_(v0[j]); v1[j] = sigmoidf_(v1[j]); } }
                    u32x4 w; w.x = pk2(v0[0], v0[1]); w.y = pk2(v0[2], v0[3]); w.z = pk2(v1[0], v1[1]); w.w = pk2(v1[2], v1[3]);
                    *(u32x4*)(rowp + bj * HALF) = w;
                    if (bj == 1 && ba) { float* bp = BA + (size_t)row * 32 + 8 * fq; *(f32x4*)bp = v0; *(f32x4*)(bp + 4) = v1; } } }
    }
};
struct EpiGateCat {
    static constexpr bool PERM = false, SEG = true;
    const bf16_t* PROJ; bf16_t* MB;
    __device__ __forceinline__ void mid(f32x4 (&acc)[2][2][4][2], const Unit& u, int seg, int wr, int wc, int fr, int fq) const {
        const int row0 = u.pm * BM + wr * 64 + fr, col0 = u.pn * BM + wc * 32 + 4 * fq;
#pragma unroll
        for (int ai = 0; ai < 2; ++ai)
#pragma unroll
            for (int m = 0; m < 4; ++m) { int rowi = row0 + ai * HALF + m * 16; asm volatile("" : "+v"(rowi)); const bf16_t* gp = PROJ + (size_t)rowi * NPROJ + C_GATE + seg * 1024 + col0;
#pragma unroll
                for (int bj = 0; bj < 2; ++bj)
#pragma unroll
                    for (int n = 0; n < 2; ++n) { const u32x2 ga = *(const u32x2*)(gp + bj * HALF + n * 16), gb = *(const u32x2*)(gp + 1024 + bj * HALF + n * 16);
                        f32x4& v = acc[ai][bj][m][n]; v[0] *= bflo(ga.x) * frcp(bflo(gb.x)); v[1] *= bfhi(ga.x) * frcp(bfhi(gb.x)); v[2] *= bflo(ga.y) * frcp(bflo(gb.y)); v[3] *= bfhi(ga.y) * frcp(bfhi(gb.y)); }
                asm volatile("" ::: "memory"); }
    }
    __device__ __forceinline__ void operator()(const f32x4 (&acc)[2][2][4][2], const Unit& u, int wr, int wc, int fr, int fq) const {
        const int row0 = u.pm * BM + wr * 64 + fr, col0 = u.pn * BM + wc * 32 + 4 * fq;
#pragma unroll
        for (int ai = 0; ai < 2; ++ai)
#pragma unroll
            for (int m = 0; m < 4; ++m) { int rowi = row0 + ai * HALF + m * 16; asm volatile("" : "+v"(rowi)); const size_t row = (size_t)rowi;
#pragma unroll
                for (int bj = 0; bj < 2; ++bj)
#pragma unroll
                    for (int n = 0; n < 2; ++n) { const int col = col0 + bj * HALF + n * 16;
                        const u32x2 gw = *(const u32x2*)(PROJ + row * NPROJ + C_GATE + 2 * 1024 + col);
                        const f32x4 v = acc[ai][bj][m][n];
                        u32x2 w; w.x = pk2(v[0] * bflo(gw.x), v[1] * bfhi(gw.x)); w.y = pk2(v[2] * bflo(gw.y), v[3] * bfhi(gw.y)); *(u32x2*)(MB + row * D + col) = w; }
                asm volatile("" ::: "memory"); }
    }
};
struct EpiRes {
    static constexpr bool PERM = false, SEG = false;
    const float* XR; float* H;
    __device__ __forceinline__ void operator()(const f32x4 (&acc)[2][2][4][2], const Unit& u, int wr, int wc, int fr, int fq) const {
        const int row0 = u.pm * BM + wr * 64 + fr, col0 = u.pn * BM + wc * 32 + 4 * fq;
#pragma unroll
        for (int ai = 0; ai < 2; ++ai)
#pragma unroll
            for (int m = 0; m < 4; ++m) { int rowi = row0 + ai * HALF + m * 16; asm volatile("" : "+v"(rowi)); const size_t off = (size_t)rowi * D + col0;
#pragma unroll
                for (int bj = 0; bj < 2; ++bj)
#pragma unroll
                    for (int n = 0; n < 2; ++n) { const f32x4 xr = *(const f32x4*)(XR + off + bj * HALF + n * 16);
                        *(f32x4*)(H + off + bj * HALF + n * 16) = xr * ALPHA + acc[ai][bj][m][n]; }
                asm volatile("" ::: "memory"); }
    }
};
struct EpiSwiglu {
    static constexpr bool PERM = true, SEG = false;
    bf16_t* HID;
    __device__ __forceinline__ void operator()(const f32x4 (&acc)[2][2][4][2], const Unit& u, int wr, int wc, int fr, int fq) const {
        const int row0 = u.pm * BM + wr * 64 + fr, col0 = (u.pn & 15) * 128 + wc * 32 + 8 * fq;
#pragma unroll
        for (int ai = 0; ai < 2; ++ai)
#pragma unroll
            for (int m = 0; m < 4; ++m) { const f32x4 g0 = acc[ai][0][m][0], g1 = acc[ai][0][m][1], u0 = acc[ai][1][m][0], u1 = acc[ai][1][m][1];
                f32x4 h0, h1;
#pragma unroll
                for (int j = 0; j < 4; ++j) { h0[j] = siluf_(g0[j]) * u0[j]; h1[j] = siluf_(g1[j]) * u1[j]; }
                u32x4 w; w.x = pk2(h0[0], h0[1]); w.y = pk2(h0[2], h0[3]); w.z = pk2(h1[0], h1[1]); w.w = pk2(h1[2], h1[3]);
                *(u32x4*)(HID + (size_t)(row0 + ai * HALF + m * 16) * DE + col0) = w; }
    }
};
struct EpiDown {
    static constexpr bool PERM = true, SEG = false;
    bf16_t* Y; const float* GV;
    __device__ __forceinline__ void operator()(const f32x4 (&acc)[2][2][4][2], const Unit& u, int wr, int wc, int fr, int fq) const {
        const int row0 = u.pm * BM + wr * 64 + fr, col0 = (u.pn & 3) * BM + wc * 32 + 8 * fq;
#pragma unroll
        for (int ai = 0; ai < 2; ++ai)
#pragma unroll
            for (int m = 0; m < 4; ++m) { const int row = row0 + ai * HALF + m * 16; const float gv = GV[row];
#pragma unroll
                for (int bj = 0; bj < 2; ++bj) { const f32x4 v0 = acc[ai][bj][m][0] * gv, v1 = acc[ai][bj][m][1] * gv;
                    u32x4 w; w.x = pk2(v0[0], v0[1]); w.y = pk2(v0[2], v0[3]); w.z = pk2(v1[0], v1[1]); w.w = pk2(v1[2], v1[3]);
                    *(u32x4*)(Y + (size_t)row * D + col0 + bj * HALF) = w; } }
    }
};
}

#define XB_TMO      128
#define XB_XCNT(j)  (256  + 64 * (j))
#define XB_XSUB(j)  (1280 + 64 * (j))
#define XB_XGEN(j)  (2304 + 64 * (j))
#define XB_TOP      3328
#define XB_TOPGEN   3392
#define XCD_BAR_WORDS 3456
#define XB_SPIN_CAP (1u << 22)
__device__ __forceinline__ unsigned xb_ld(unsigned* p)              { return __hip_atomic_load(p, __ATOMIC_RELAXED, __HIP_MEMORY_SCOPE_AGENT); }
__device__ __forceinline__ unsigned xb_add(unsigned* p, unsigned v) { return __hip_atomic_fetch_add(p, v, __ATOMIC_RELAXED, __HIP_MEMORY_SCOPE_AGENT); }
__device__ __forceinline__ unsigned xb_xcc_id() { return (unsigned)__builtin_amdgcn_s_getreg((3 << 11) | 20) & 0xFu; }
#define XB_SPIN(cond, bar) do { unsigned _sp = 0; while (cond) { __builtin_amdgcn_s_sleep(1); \
    if ((++_sp & 255u) == 0u) { if (xb_ld(&(bar)[XB_TMO])) break; if (_sp > XB_SPIN_CAP) { atomicAdd(&(bar)[XB_TMO], 1u); break; } } } } while (0)
struct XcdBarrier { unsigned* bar; unsigned x; volatile LAS unsigned* st; };
__device__ __forceinline__ XcdBarrier xcd_barrier_post(unsigned* bar, volatile LAS unsigned* st) {
    XcdBarrier b; b.bar = bar; b.x = xb_xcc_id(); b.st = st;
    if (threadIdx.x == 0) (void)xb_add(&bar[XB_XCNT(b.x)], 1u);
    return b;
}
__device__ __forceinline__ void xcd_barrier_complete(unsigned* bar, unsigned x, unsigned& nloc, unsigned& nx) {
    const unsigned G = gridDim.x * gridDim.y * gridDim.z;
    unsigned sum, cnt, mine, sp = 0u;
    for (;;) {
        sum = 0u; cnt = 0u; mine = 0u;
#pragma unroll
        for (unsigned j = 0; j < 16; ++j) { const unsigned c = xb_ld(&bar[XB_XCNT(j)]); sum += c; cnt += (c > 0u) ? 1u : 0u; }
        mine = xb_ld(&bar[XB_XCNT(x)]);
        if (sum == G) break;
        __builtin_amdgcn_s_sleep(1);
        if ((++sp & 255u) == 0u) { if (xb_ld(&bar[XB_TMO])) break; if (sp > XB_SPIN_CAP) { atomicAdd(&bar[XB_TMO], 1u); break; } }
    }
    nloc = mine > 0u ? mine : 1u; nx = cnt > 0u ? cnt : 1u;
}
__device__ __forceinline__ void xcd_barrier(const XcdBarrier& b) {
    asm volatile("s_waitcnt vmcnt(0)" ::: "memory");
    __syncthreads();
    if (threadIdx.x == 0) {
        unsigned* bar = b.bar; asm volatile("" : "+s"(bar));
        __builtin_amdgcn_s_waitcnt(0);
        unsigned nloc = b.st[0], nx = b.st[1];
        if (nloc == 0u) { xcd_barrier_complete(bar, b.x, nloc, nx); b.st[0] = nloc; b.st[1] = nx; }
        const unsigned old = xb_add(&bar[XB_XSUB(b.x)], 1u);
        const unsigned gen = old / nloc;
        if (old + 1u == (gen + 1u) * nloc) {
            __builtin_amdgcn_fence(__ATOMIC_RELEASE, "agent");
            asm volatile("s_waitcnt vmcnt(0)" ::: "memory");
            const unsigned og = xb_add(&bar[XB_TOP], 1u);
            const unsigned tg = og / nx;
            if (og + 1u == (tg + 1u) * nx) xb_add(&bar[XB_TOPGEN], 1u);
            else XB_SPIN(xb_ld(&bar[XB_TOPGEN]) == tg, bar);
            __builtin_amdgcn_fence(__ATOMIC_ACQUIRE, "agent");
            xb_add(&bar[XB_XGEN(b.x)], 1u);
            asm volatile("s_waitcnt vmcnt(0)" ::: "memory");
        } else {
            XB_SPIN(xb_ld(&bar[XB_XGEN(b.x)]) == gen, bar);
            __builtin_amdgcn_fence(__ATOMIC_ACQUIRE, "agent");
            asm volatile("s_waitcnt vmcnt(0)" ::: "memory");
        }
    }
    __syncthreads();
}

struct Args { const float* in[20]; float* out; unsigned char* ws; int ph_lo, ph_hi; };
typedef const __attribute__((address_space(4))) Args* KArgs;
DI KArgs kargs() { KArgs p = (KArgs)__builtin_amdgcn_kernarg_segment_ptr(); asm volatile("" : "+s"(p)); return p; }
struct Ctx {
    float* out; unsigned char* ws;
    int tid, lane, wave, G, bid;
    int layer, slab;
    int nseq, seqlen;
    int stok, sbase;
    int dry;
};
#define WSP(T, off) ((T*)(c.ws + (off)))
#define BIGP(T, off) ((T*)(c.ws + WS_BIG + (off)))

__device__ const float INV_FREQ[32] = {1.000000000e+00f, 7.498942018e-01f, 5.623413324e-01f, 4.216965139e-01f, 3.162277639e-01f, 2.371373773e-01f, 1.778279394e-01f, 1.333521456e-01f, 1.000000015e-01f, 7.498942316e-02f, 5.623413250e-02f, 4.216964915e-02f, 3.162277490e-02f, 2.371373773e-02f, 1.778279431e-02f, 1.333521400e-02f, 9.999999776e-03f, 7.498942316e-03f, 5.623413250e-03f, 4.216964822e-03f, 3.162277630e-03f, 2.371373819e-03f, 1.778279431e-03f, 1.333521446e-03f, 1.000000047e-03f, 7.498941850e-04f, 5.623413017e-04f, 4.216965172e-04f, 3.162277571e-04f, 2.371373703e-04f, 1.778279402e-04f, 1.333521504e-04f};
DI void tr_item(const float* src, long src_ld, int src_col0, int nvalid, int kvalid, bf16_t* dst, long dst_ld, int dst_row0, int k0, LAS float* scr, int lane) {
    float tv[32];
#pragma unroll
    for (int i = 0; i < 32; ++i) { const int kk = 2 * i + (lane >> 5), cc = lane & 31;
        tv[i] = 0.f; if ((k0 + kk) < kvalid && cc < nvalid) tv[i] = src[(size_t)(k0 + kk) * src_ld + src_col0 + cc]; }
#pragma unroll
    for (int i = 0; i < 32; ++i) { const int kk = 2 * i + (lane >> 5), cc = lane & 31; scr[kk * 33 + cc] = tv[i]; }
    asm volatile("s_waitcnt lgkmcnt(0)" ::: "memory");
    const int c8 = lane & 7;
#pragma unroll
    for (int j = 0; j < 4; ++j) { const int n = (lane >> 3) + 8 * j; const LAS float* s = scr + (8 * c8) * 33 + n;
        u32x4 o; o.x = pk2(s[0 * 33], s[1 * 33]); o.y = pk2(s[2 * 33], s[3 * 33]); o.z = pk2(s[4 * 33], s[5 * 33]); o.w = pk2(s[6 * 33], s[7 * 33]);
        *(u32x4*)(dst + (size_t)(dst_row0 + n) * dst_ld + k0 + 8 * c8) = o; }
    asm volatile("s_waitcnt lgkmcnt(0)" ::: "memory");
}
DI void phase_weights(KArgs args, LAS unsigned char* lds, const Ctx& c) {
    const int l = c.layer, lane = c.lane;
    LAS float* scr = (LAS float*)(lds + c.wave * 8448);
    const int gw = c.bid * 8 + c.wave, NGW = c.G * 8;
    constexpr int I_IN = 16 * 208, I_NA = 4 * 32, I_DIL = 2 * 32, I_GDN = 6 * 32, I_OUT = 16 * 32, I_GU1 = 16 * 128, I_D1 = 32 * 32;
    constexpr int NITEMS = I_IN + I_NA + I_DIL + I_GDN + I_OUT + 16 * I_GU1 + 16 * I_D1;
    for (int it = gw; it < NITEMS; it += NGW) {
        int r = it;
        const float* src; long sld; int sc0, nv = 32, kv; bf16_t* dst; long dld; int dr0, k0;
        if (r < I_IN) { const int kb = r / 208, nb = r % 208, n0 = 32 * nb; src = args->in[2] + (size_t)l * D * DIN; sld = DIN; kv = D;
            if (n0 < 3072) { sc0 = 3480 + n0; } else { sc0 = n0 - 3072; nv = DIN - n0; if (nv < 0) { nv = 0; sc0 = 0; } }
            dst = WSP(bf16_t, WS_WIN); dld = D; dr0 = n0; k0 = 64 * kb; }
        else if ((r -= I_IN) < I_NA) { const int kb = r / 32, nb = r % 32; src = args->in[8] + (size_t)l * 256 * D; sld = D; sc0 = 32 * nb; kv = 256; dst = WSP(bf16_t, WS_WBR); dld = 768; dr0 = 32 * nb; k0 = 64 * kb; }
        else if ((r -= I_NA) < I_DIL) { const int kb = r / 32, nb = r % 32; src = args->in[9] + (size_t)l * 128 * D; sld = D; sc0 = 32 * nb; kv = 128; dst = WSP(bf16_t, WS_WBR) + 256; dld = 768; dr0 = 32 * nb; k0 = 64 * kb; }
        else if ((r -= I_DIL) < I_GDN) { const int kb = r / 32, nb = r % 32; src = args->in[10] + (size_t)l * 384 * D; sld = D; sc0 = 32 * nb; kv = 384; dst = WSP(bf16_t, WS_WBR) + 384; dld = 768; dr0 = 32 * nb; k0 = 64 * kb; }
        else if ((r -= I_GDN) < I_OUT) { const int kb = r / 32, nb = r % 32; src = args->in[11] + (size_t)l * D * D; sld = D; sc0 = 32 * nb; kv = D; dst = WSP(bf16_t, WS_WOUT); dld = D; dr0 = 32 * nb; k0 = 64 * kb; }
        else if ((r -= I_OUT) < 16 * I_GU1) { const int e = r / I_GU1, q = r % I_GU1, kb = q / 128, nb = q % 128, n0 = 32 * nb, j = n0 >> 8, rr = n0 & 255;
            src = (rr < 128 ? args->in[16] : args->in[15]) + ((size_t)l * NE + e) * D * DE; sld = DE; sc0 = 128 * j + (rr & 127); kv = D;
            dst = WSP(bf16_t, WS_WGU) + (size_t)e * 4096 * D; dld = D; dr0 = n0; k0 = 64 * kb; }
        else { r -= 16 * I_GU1; const int e = r / I_D1, q = r % I_D1, kb = q / 32, nb = q % 32;
            src = args->in[17] + ((size_t)l * NE + e) * DE * D; sld = D; sc0 = 32 * nb; kv = DE; dst = WSP(bf16_t, WS_WD) + (size_t)e * D * DE; dld = DE; dr0 = 32 * nb; k0 = 64 * kb; }
        tr_item(src, sld, sc0, nv, kv, dst, dld, dr0, k0, scr, lane);
    }
    if (l == 0) {
        for (int t = gw; t < T_ALL; t += NGW) {
            const float* xr = (t < T_P) ? args->in[0] + (size_t)t * D : args->in[1] + (size_t)(t - T_P) * D;
            bf16_t* o = WSP(bf16_t, WS_XB) + (size_t)t * D;
#pragma unroll
            for (int j = 0; j < 4; ++j) { const f32x4 v = *(const f32x4*)(xr + 4 * lane + 256 * j); u32x2 w; w.x = pk2(v[0], v[1]); w.y = pk2(v[2], v[3]); *(u32x2*)(o + 4 * lane + 256 * j) = w; }
        }
        float* cs = WSP(float, WS_CS);
        for (int i = c.bid * 512 + c.tid; i < 16384 * 32; i += c.G * 512) { const int pos = i >> 5, k = i & 31;
            const float inv = INV_FREQ[k];
            const float ang = (float)pos * inv;
            cs[pos * 64 + k] = cosf(ang); cs[pos * 64 + 32 + k] = sinf(ang); }
    }
}

constexpr int TLD = 72, TILEB = 64 * TLD * 2;
DI int tsw(int row) { return ((row >> 4) & 3) << 3; }
template <bool SA = false, bool SB = false> DI f32x16 mm_tile(const LAS bf16_t* A, const LAS bf16_t* Bt, int m0, int n0, int lane) {
    f32x16 acc = zero16(); const int r = lane & 31, hh = lane >> 5; const int sa = SA ? tsw(m0 + r) : 0, sb = SB ? tsw(n0 + r) : 0;
#pragma unroll
    for (int ks = 0; ks < 4; ++ks) { const bf16x8 a = *(const LAS bf16x8*)(A + (m0 + r) * TLD + ((16 * ks + 8 * hh) ^ sa)); const bf16x8 b = *(const LAS bf16x8*)(Bt + (n0 + r) * TLD + ((16 * ks + 8 * hh) ^ sb)); acc = MFMA32(a, b, acc); }
    return acc;
}

constexpr int PI_P0 = 0, PI_P1 = 9216, PI_INTRA = 18432, PI_AM = 27648, PI_TT = 45056, PI_TD0 = 54272, PI_TD1 = 60416, PI_PM = 65024, PI_VEC = 71168, PI_BYTES = 72704;
constexpr int PI_WT = PI_AM, PI_UT = PI_TD0;
DI void gdn_prep_pair(KArgs args, LAS unsigned char* L0, const Ctx& c, int pu) {
    int tid = c.tid; asm volatile("" : "+v"(tid)); const int lane = tid & 63, wave = __builtin_amdgcn_readfirstlane(tid >> 6), l = c.layer;
    const int dir = wave >> 2, wg = wave & 3, tg = tid & 255, head = pu % 6, gch = pu / 6, inst = (gch * 6 + head) * 2 + dir;
    const int cps = c.seqlen >> 6, seq = gch / cps, n = gch % cps;
    const bf16_t* PROJ = BIGP(bf16_t, B_PROJ); const float* BA = BIGP(float, B_BA);
    unsigned char* G = BIGP(unsigned char, B_GSCR) + (size_t)inst * GSTRIDE;
    LAS unsigned char* L = L0 + dir * PI_BYTES;
    LAS bf16_t* P0 = (LAS bf16_t*)(L + PI_P0); LAS bf16_t* P1 = (LAS bf16_t*)(L + PI_P1); LAS bf16_t* INTRA = (LAS bf16_t*)(L + PI_INTRA);
    LAS float* AM = (LAS float*)(L + PI_AM); LAS bf16_t* TT = (LAS bf16_t*)(L + PI_TT);
    LAS float* TD0 = (LAS float*)(L + PI_TD0); LAS float* TD1 = (LAS float*)(L + PI_TD1); LAS float* PM = (LAS float*)(L + PI_PM);
    LAS float* GV = (LAS float*)(L + PI_VEC); LAS float* BV = GV + 64; LAS float* GC = GV + 128;
    LAS bf16_t* WT = (LAS bf16_t*)(L + PI_WT); LAS bf16_t* UT = (LAS bf16_t*)(L + PI_UT);
    const int ia = tg >> 3, p = tg & 7;
    float q[2][8], k[2][8], v[2][8];
#pragma unroll
    for (int h2 = 0; h2 < 2; ++h2)
#pragma unroll
        for (int j = 0; j < 8; ++j) { q[h2][j] = 0.f; k[h2][j] = 0.f; v[h2][j] = 0.f; }
    const float* cw = args->in[4] + (size_t)l * 5 * 1152 + 64 * head + 8 * p;
#pragma unroll
    for (int tp = 0; tp < 5; ++tp) { const float* w = cw + tp * 1152;
        const f32x4 wq0 = *(const f32x4*)w, wq1 = *(const f32x4*)(w + 4), wk0 = *(const f32x4*)(w + 384), wk1 = *(const f32x4*)(w + 388), wv0 = *(const f32x4*)(w + 768), wv1 = *(const f32x4*)(w + 772);
#pragma unroll
        for (int h2 = 0; h2 < 2; ++h2) { const int i = ia + 32 * h2, tokl = dir ? 63 - i : i, pp = n * 64 + tokl + tp - 2;
            if (pp >= 0 && pp < c.seqlen) { const bf16_t* rp = PROJ + (size_t)(seq * c.seqlen + pp) * NPROJ + 64 * head + 8 * p;
                const u32x4 rq = *(const u32x4*)(rp + C_QC), rk = *(const u32x4*)(rp + C_KC), rv = *(const u32x4*)(rp + C_VC);
#pragma unroll
                for (int j = 0; j < 4; ++j) { const float a0 = (j < 2) ? wq0[2 * j] : wq1[2 * j - 4], a1 = (j < 2) ? wq0[2 * j + 1] : wq1[2 * j - 3];
                    const float b0 = (j < 2) ? wk0[2 * j] : wk1[2 * j - 4], b1 = (j < 2) ? wk0[2 * j + 1] : wk1[2 * j - 3];
                    const float c0 = (j < 2) ? wv0[2 * j] : wv1[2 * j - 4], c1 = (j < 2) ? wv0[2 * j + 1] : wv1[2 * j - 3];
                    q[h2][2 * j] += a0 * bflo(rq[j]); q[h2][2 * j + 1] += a1 * bfhi(rq[j]);
                    k[h2][2 * j] += b0 * bflo(rk[j]); k[h2][2 * j + 1] += b1 * bfhi(rk[j]);
                    v[h2][2 * j] += c0 * bflo(rv[j]); v[h2][2 * j + 1] += c1 * bfhi(rv[j]); } } } }
#pragma unroll
    for (int h2 = 0; h2 < 2; ++h2) { float sq = 0.f, sk = 0.f;
#pragma unroll
        for (int j = 0; j < 8; ++j) { q[h2][j] = siluf_(q[h2][j]); k[h2][j] = siluf_(k[h2][j]); v[h2][j] = siluf_(v[h2][j]); sq += q[h2][j] * q[h2][j]; sk += k[h2][j] * k[h2][j]; }
        sq += __shfl_xor(sq, 1); sq += __shfl_xor(sq, 2); sq += __shfl_xor(sq, 4);
        sk += __shfl_xor(sk, 1); sk += __shfl_xor(sk, 2); sk += __shfl_xor(sk, 4);
        const float rq_ = 0.125f * frsq(sq + NORM_EPS), rk_ = frsq(sk + NORM_EPS);
#pragma unroll
        for (int j = 0; j < 8; ++j) { q[h2][j] *= rq_; k[h2][j] *= rk_; }
        if (p == 0) { const int i = ia + 32 * h2, tokl = dir ? 63 - i : i; const float* bar = BA + (size_t)(seq * c.seqlen + n * 64 + tokl) * 32;
            const float bl = bar[dir * 6 + head], al = bar[12 + dir * 6 + head];
            const float xx = al + args->in[6][l * 12 + dir * 6 + head];
            const float sp = xx > 20.f ? xx : log1pf(expf(xx));
            GV[i] = -expf(args->in[5][l * 12 + dir * 6 + head]) * sp; BV[i] = sigmoidf_(bl); } }
    __syncthreads();
    float gcl_;
    { float x = GV[lane];
#pragma unroll
        for (int o = 1; o < 64; o <<= 1) { const float y = __shfl_up(x, o); if (lane >= o) x += y; }
        if (wg == 0) GC[lane] = x;
        gcl_ = x; }
    const float gc0 = __shfl(gcl_, ia), gc1 = __shfl(gcl_, ia + 32), gcl = __shfl(gcl_, 63);
#pragma unroll
    for (int h2 = 0; h2 < 2; ++h2) { const int i = ia + 32 * h2; u32x4 wq, wk;
#pragma unroll
        for (int j = 0; j < 4; ++j) { wq[j] = pk2(q[h2][2 * j], q[h2][2 * j + 1]); wk[j] = pk2(k[h2][2 * j], k[h2][2 * j + 1]); }
        *(LAS u32x4*)(P0 + i * TLD + 8 * p) = wq; *(LAS u32x4*)(P1 + i * TLD + 8 * p) = wk; }
    __syncthreads();
    { const int mat = wg >> 1, mt = wg & 1, hh = lane >> 5;
#pragma unroll
        for (int nt = 0; nt < 2; ++nt) { const int jc = 32 * nt + (lane & 31);
            const f32x16 a = mm_tile(mat ? P0 : P1, P1, 32 * mt, 32 * nt, lane);
            const float gj = GC[jc];
#pragma unroll
            for (int r = 0; r < 16; ++r) { const int ii = 32 * mt + crow(r, hh); const float gi = GC[ii];
                if (mat == 0) AM[ii * 68 + jc] = (jc < ii) ? BV[ii] * a[r] * __expf(gi - gj) : 0.f;
                else INTRA[ii * TLD + jc] = (bf16_t)(pk2((jc <= ii) ? a[r] * __expf(gi - gj) : 0.f, 0.f) & 0xffffu); } } }
    __syncthreads();
    if (wg == 0) {
        const int b = lane >> 5, cidx = lane & 31; float t[32];
#pragma unroll
        for (int ii = 0; ii < 32; ++ii) t[ii] = (ii == cidx) ? 1.f : 0.f;
        const LAS float* Ab = AM + (32 * b) * 68 + 32 * b;
#pragma unroll
        for (int ii = 1; ii < 32; ++ii) { float acc = 0.f;
#pragma unroll
            for (int j4 = 0; j4 < ii; j4 += 4) { const f32x4 a4 = *(const LAS f32x4*)(Ab + ii * 68 + j4);
                acc += a4[0] * t[j4]; acc += a4[1] * t[j4 + 1]; acc += a4[2] * t[j4 + 2]; acc += a4[3] * t[j4 + 3]; }
            t[ii] -= acc; }
        LAS float* td = b ? TD1 : TD0; const int tds = b ? 36 : 48;
#pragma unroll
        for (int ii = 0; ii < 32; ++ii) { td[ii * tds + cidx] = t[ii]; TT[(32 * b + ii) * TLD + 32 * b + cidx] = (bf16_t)(pk2(t[ii], 0.f) & 0xffffu); }
    }
#pragma unroll
    for (int h2 = 0; h2 < 2; ++h2) { const int i = ia + 32 * h2; const float be = BV[i], eg = __expf(h2 ? gc1 : gc0);
#pragma unroll
        for (int j = 0; j < 8; ++j) { const int d = 8 * p + j, o_ = d * TLD + (i ^ tsw(d)); P0[o_] = (bf16_t)(pk2(k[h2][j] * be * eg, 0.f) & 0xffffu); P1[o_] = (bf16_t)(pk2(v[h2][j] * be, 0.f) & 0xffffu); } }
    { unsigned zz; asm volatile("v_mov_b32 %0, 0" : "=v"(zz)); u32x2 z; z.x = zz; z.y = zz; *(LAS u32x2*)(TT + (tg >> 3) * TLD + 32 + 4 * (tg & 7)) = z; }
    __syncthreads();
    { const int qi = wg >> 1, qj = wg & 1, r16 = lane & 15, g4 = lane >> 4; f32x4 pc = {0.f, 0.f, 0.f, 0.f};
#pragma unroll
        for (int kk = 0; kk < 8; ++kk) pc = __builtin_amdgcn_mfma_f32_16x16x4f32(AM[(32 + 16 * qi + r16) * 68 + 4 * kk + g4], TD0[(4 * kk + g4) * 48 + 16 * qj + r16], pc, 0, 0, 0);
#pragma unroll
        for (int r = 0; r < 4; ++r) PM[(16 * qi + 4 * g4 + r) * 48 + 16 * qj + r16] = pc[r]; }
    __syncthreads();
    { const int qi = wg >> 1, qj = wg & 1, r16 = lane & 15, g4 = lane >> 4; f32x4 pc = {0.f, 0.f, 0.f, 0.f};
#pragma unroll
        for (int kk = 0; kk < 8; ++kk) pc = __builtin_amdgcn_mfma_f32_16x16x4f32(TD1[(16 * qi + r16) * 36 + 4 * kk + g4], PM[(4 * kk + g4) * 48 + 16 * qj + r16], pc, 0, 0, 0);
#pragma unroll
        for (int r = 0; r < 4; ++r) TT[(32 + 16 * qi + 4 * g4 + r) * TLD + 16 * qj + r16] = (bf16_t)(pk2(-pc[r], 0.f) & 0xffffu); }
    __syncthreads();
    { const int which = wg >> 1, mt = wg & 1, hh = lane >> 5;
#pragma unroll
        for (int nt = 0; nt < 2; ++nt) { const int dc = 32 * nt + (lane & 31);
            const f32x16 a = mm_tile<false, true>(TT, which ? P1 : P0, 32 * mt, 32 * nt, lane);
            LAS bf16_t* dst = (which ? UT : WT) + dc * TLD; const int sw = tsw(dc);
#pragma unroll
            for (int g = 0; g < 4; ++g) { u32x2 w; w.x = pk2(a[4 * g], a[4 * g + 1]); w.y = pk2(a[4 * g + 2], a[4 * g + 3]); *(LAS u32x2*)(dst + ((32 * mt + 8 * g + 4 * hh) ^ sw)) = w; } } }
    __syncthreads();
#pragma unroll
    for (int h2 = 0; h2 < 2; ++h2) { const int i = ia + 32 * h2; const float gci = h2 ? gc1 : gc0, eg = __expf(gci), ekd = __expf(gcl - gci); u32x4 wqd;
#pragma unroll
        for (int j = 0; j < 4; ++j) wqd[j] = pk2(q[h2][2 * j] * eg, q[h2][2 * j + 1] * eg);
        *(LAS u32x4*)(P1 + i * TLD + 8 * p) = wqd;
#pragma unroll
        for (int j = 0; j < 8; ++j) { const int d = 8 * p + j; P0[d * TLD + (i ^ tsw(d))] = (bf16_t)(pk2(k[h2][j] * ekd, 0.f) & 0xffffu); } }
    __syncthreads();
    { const int hh = lane >> 5, rr = lane & 31;
        if (wg == 0) {
#pragma unroll
            for (int t4 = 0; t4 < 4; ++t4) { const int mtb = t4 >> 1, nta = t4 & 1; const f32x16 a = mm_tile<true, true>(WT, P0, 32 * mtb, 32 * nta, lane);
                f32x16 na; for (int r = 0; r < 16; ++r) na[r] = -a[r];
                *(bf16x8*)(G + (size_t)((nta * 4 + 2 * mtb) * 64 + lane) * 16) = pack8<0>(na); *(bf16x8*)(G + (size_t)((nta * 4 + 2 * mtb + 1) * 64 + lane) * 16) = pack8<1>(na); }
        } else if (wg == 1) {
#pragma unroll
            for (int t4 = 0; t4 < 4; ++t4) { const int mta = t4 >> 1, nte = t4 & 1; const f32x16 a = mm_tile<true, true>(P0, UT, 32 * mta, 32 * nte, lane);
                bf16x8* dp = (bf16x8*)(G + 8192 + (size_t)((nte * 2 + mta) * 64 + lane) * 32); dp[0] = pack8<0>(a); dp[1] = pack8<1>(a); }
        } else if (wg == 2) {
#pragma unroll
            for (int t4 = 0; t4 < 4; ++t4) { const int mtb = t4 >> 1, nti = t4 & 1; const f32x16 a = mm_tile<true, false>(WT, INTRA, 32 * mtb, 32 * nti, lane);
                f32x16 qe; const LAS bf16_t* qd = P1 + (32 * nti + rr) * TLD + 32 * mtb + 4 * hh;
#pragma unroll
                for (int g = 0; g < 4; ++g) { const u32x2 w = *(const LAS u32x2*)(qd + 8 * g); qe[4 * g] = bflo(w.x) - a[4 * g]; qe[4 * g + 1] = bfhi(w.x) - a[4 * g + 1]; qe[4 * g + 2] = bflo(w.y) - a[4 * g + 2]; qe[4 * g + 3] = bfhi(w.y) - a[4 * g + 3]; }
                *(bf16x8*)(G + 16384 + (size_t)((nti * 4 + 2 * mtb) * 64 + lane) * 16) = pack8<0>(qe); *(bf16x8*)(G + 16384 + (size_t)((nti * 4 + 2 * mtb + 1) * 64 + lane) * 16) = pack8<1>(qe); }
        } else {
#pragma unroll
            for (int t4 = 0; t4 < 4; ++t4) { const int mti = t4 >> 1, nte = t4 & 1; const f32x16 a = mm_tile<false, true>(INTRA, UT, 32 * mti, 32 * nte, lane);
                bf16_t* dst = (bf16_t*)(G + 24576) + (size_t)(32 * nte + rr) * 64 + 32 * mti + 4 * hh;
#pragma unroll
                for (int g = 0; g < 4; ++g) { u32x2 w; w.x = pk2(a[4 * g], a[4 * g + 1]); w.y = pk2(a[4 * g + 2], a[4 * g + 3]); *(u32x2*)(dst + 8 * g) = w; } }
            if (lane == 0) *(float*)(G + 40960) = __expf(gcl);
        } }
    __syncthreads();
}

DI void pv_accum(const f32x16 (&acc)[2][2], f32x16 (&o)[2][2], const LAS bf16_t* Vt, int lane) {
    const int r = lane & 31, hh = lane >> 5;
#pragma unroll
    for (int mt = 0; mt < 2; ++mt) {
        {   const bf16x8 p0 = pack8<0>(acc[mt][0]), p1 = pack8<0>(acc[mt][1]);
#pragma unroll
            for (int mo = 0; mo < 2; ++mo) { const LAS bf16_t* s = Vt + (32 * mo + r) * TLD; const int c0 = (32 * mt + 4 * hh) ^ tsw(32 * mo + r);
                const u32x2 lo = *(const LAS u32x2*)(s + c0), hi = *(const LAS u32x2*)(s + (c0 ^ 8)); u32x4 w; w.x = lo.x; w.y = lo.y; w.z = hi.x; w.w = hi.y; const bf16x8 vf = __builtin_bit_cast(bf16x8, w);
                o[mo][0] = MFMA32(vf, p0, o[mo][0]); o[mo][1] = MFMA32(vf, p1, o[mo][1]); } }
        {   const bf16x8 p0 = pack8<1>(acc[mt][0]), p1 = pack8<1>(acc[mt][1]);
#pragma unroll
            for (int mo = 0; mo < 2; ++mo) { const LAS bf16_t* s = Vt + (32 * mo + r) * TLD; const int c0 = (32 * mt + 16 + 4 * hh) ^ tsw(32 * mo + r);
                const u32x2 lo = *(const LAS u32x2*)(s + c0), hi = *(const LAS u32x2*)(s + (c0 ^ 8)); u32x4 w; w.x = lo.x; w.y = lo.y; w.z = hi.x; w.w = hi.y; const bf16x8 vf = __builtin_bit_cast(bf16x8, w);
                o[mo][0] = MFMA32(vf, p0, o[mo][0]); o[mo][1] = MFMA32(vf, p1, o[mo][1]); } }
    }
}
template <class F> DI void stage_vt(LAS bf16_t* Vt, int lane, F vrow) {
#pragma unroll
    for (int it = 0; it < 8; ++it) { const int id = it * 64 + lane, key = id >> 3, part = id & 7;
        const u32x4 w = *(const u32x4*)(vrow(key) + 8 * part);
#pragma unroll
        for (int j = 0; j < 4; ++j) { const int d0 = 8 * part + 2 * j, ks_ = key ^ tsw(d0); Vt[d0 * TLD + ks_] = (bf16_t)(w[j] & 0xffffu); Vt[(d0 + 1) * TLD + ks_] = (bf16_t)(w[j] >> 16); } }
}
DI void write_o_slot(LAS float* SL, const f32x16 (&o)[2][2], int lane) {
    const int r = lane & 31, hh = lane >> 5;
#pragma unroll
    for (int mo = 0; mo < 2; ++mo)
#pragma unroll
        for (int nt = 0; nt < 2; ++nt)
#pragma unroll
            for (int g = 0; g < 4; ++g) { f32x4 v; v[0] = o[mo][nt][4 * g]; v[1] = o[mo][nt][4 * g + 1]; v[2] = o[mo][nt][4 * g + 2]; v[3] = o[mo][nt][4 * g + 3];
                *(LAS f32x4*)(SL + (32 * nt + r) * 68 + 32 * mo + 8 * g + 4 * hh) = v; }
}
DI void add_o_slot(const LAS float* SL, f32x16 (&o)[2][2], int lane) {
    const int r = lane & 31, hh = lane >> 5;
#pragma unroll
    for (int mo = 0; mo < 2; ++mo)
#pragma unroll
        for (int nt = 0; nt < 2; ++nt)
#pragma unroll
            for (int g = 0; g < 4; ++g) { const f32x4 v = *(const LAS f32x4*)(SL + (32 * nt + r) * 68 + 32 * mo + 8 * g + 4 * hh);
                o[mo][nt][4 * g] += v[0]; o[mo][nt][4 * g + 1] += v[1]; o[mo][nt][4 * g + 2] += v[2]; o[mo][nt][4 * g + 3] += v[3]; }
}

constexpr int WAREA = 10240;
DI void osm_update(f32x16 (&acc)[2][2], f32x16 (&o)[2][2], float (&m)[2], float (&l)[2]) {
#pragma unroll
    for (int nt = 0; nt < 2; ++nt) { float mx = -1e30f;
#pragma unroll
        for (int mt = 0; mt < 2; ++mt)
#pragma unroll
            for (int g = 0; g < 16; ++g) mx = fmaxf(mx, acc[mt][nt][g]);
        mx = fmaxf(mx, __shfl_xor(mx, 32));
        const float mn = fmaxf(m[nt], mx), sc = __expf(m[nt] - mn); float sm = 0.f;
#pragma unroll
        for (int mt = 0; mt < 2; ++mt)
#pragma unroll
            for (int g = 0; g < 16; ++g) { const float pz = __expf(acc[mt][nt][g] - mn); acc[mt][nt][g] = pz; sm += pz; }
        sm += __shfl_xor(sm, 32);
        l[nt] = l[nt] * sc + sm; m[nt] = mn;
#pragma unroll
        for (int g = 0; g < 16; ++g) { o[0][nt][g] *= sc; o[1][nt][g] *= sc; } }
}
template <class F> DI void store_o_rows(LAS bf16_t* T, const f32x16 (&o)[2][2], const float (&scale)[2], int lane, F rowp) {
    const int r = lane & 31, hh = lane >> 5;
#pragma unroll
    for (int mo = 0; mo < 2; ++mo)
#pragma unroll
        for (int nt = 0; nt < 2; ++nt)
#pragma unroll
            for (int g = 0; g < 4; ++g) { u32x2 w; w.x = pk2(o[mo][nt][4 * g] * scale[nt], o[mo][nt][4 * g + 1] * scale[nt]); w.y = pk2(o[mo][nt][4 * g + 2] * scale[nt], o[mo][nt][4 * g + 3] * scale[nt]);
                *(LAS u32x2*)(T + (32 * nt + r) * TLD + 32 * mo + 8 * g + 4 * hh) = w; }
    asm volatile("s_waitcnt lgkmcnt(0)" ::: "memory");
#pragma unroll
    for (int it = 0; it < 8; ++it) { const int id = it * 64 + lane, q = id >> 3, part = id & 7; *(u32x4*)(rowp(q) + 8 * part) = *(const LAS u32x4*)(T + q * TLD + 8 * part); }
    asm volatile("s_waitcnt lgkmcnt(0)" ::: "memory");
}
DI void na_wave_unit(KArgs args, LAS unsigned char* L, const Ctx& c, int u, int lane, int wave) {
    const int l = c.layer, head = u & 3, gr = u >> 2, rows = c.seqlen >> 6, seq = gr / rows, r = gr % rows;
    int rs = r - 4; rs = rs < 0 ? 0 : (rs > rows - 8 ? rows - 8 : rs);
    const bf16_t* PROJ = BIGP(bf16_t, B_PROJ);
    const size_t tq0 = (size_t)seq * c.seqlen + (size_t)r * 64;
    LAS bf16_t* Vt = (LAS bf16_t*)(L + wave * WAREA);
    LAS float* BIAS = (LAS float*)(L + wave * WAREA + 9216);
    const int rr = lane & 31, hh = lane >> 5;
#pragma unroll
    for (int w = 0; w < 4; ++w) { const int idx = w * 64 + lane, kw = idx >> 5, dc = idx & 31;
        if (dc < 31) BIAS[idx] = args->in[3][(((size_t)l * 4 + head) * 15 + (rs + kw - r + 7)) * 31 + dc]; }
    bf16x8 qf[2][4];
#pragma unroll
    for (int nt = 0; nt < 2; ++nt)
#pragma unroll
        for (int ks = 0; ks < 4; ++ks) qf[nt][ks] = *(const bf16x8*)(PROJ + (tq0 + 32 * nt + rr) * NPROJ + C_QA + 64 * head + 16 * ks + 8 * hh);
    f32x16 o[2][2]; o[0][0] = zero16(); o[0][1] = zero16(); o[1][0] = zero16(); o[1][1] = zero16();
    float m[2] = {-1e30f, -1e30f}, ls[2] = {0.f, 0.f};
    for (int w = 0; w < 8; ++w) {
        const size_t tk0 = (size_t)seq * c.seqlen + (size_t)(rs + w) * 64;
        asm volatile("s_waitcnt lgkmcnt(0)" ::: "memory");
        stage_vt(Vt, lane, [&](int key) { return PROJ + (tk0 + key) * NPROJ + C_VA + 64 * head; });
        f32x16 acc[2][2]; acc[0][0] = zero16(); acc[0][1] = zero16(); acc[1][0] = zero16(); acc[1][1] = zero16();
#pragma unroll
        for (int mt = 0; mt < 2; ++mt)
#pragma unroll
            for (int ks = 0; ks < 4; ++ks) { const bf16x8 kf = *(const bf16x8*)(PROJ + (tk0 + 32 * mt + rr) * NPROJ + C_KA + 64 * head + 16 * ks + 8 * hh);
                acc[mt][0] = MFMA32(kf, qf[0][ks], acc[mt][0]); acc[mt][1] = MFMA32(kf, qf[1][ks], acc[mt][1]); }
        asm volatile("s_waitcnt lgkmcnt(0)" ::: "memory");
        const LAS float* brow = BIAS + w * 32;
#pragma unroll
        for (int nt = 0; nt < 2; ++nt) { const int qc = 32 * nt + rr; int ws = qc - 8; ws = ws < 0 ? 0 : (ws > 48 ? 48 : ws);
#pragma unroll
            for (int mt = 0; mt < 2; ++mt)
#pragma unroll
                for (int g = 0; g < 16; ++g) { const int kc = 32 * mt + crow(g, hh); const bool ok = (kc >= ws) && (kc < ws + 16);
                    acc[mt][nt][g] = ok ? acc[mt][nt][g] * 0.125f + brow[ok ? (kc - qc + 15) : 0] : -1e30f; } }
        osm_update(acc, o, m, ls);
        pv_accum(acc, o, Vt, lane);
    }
    asm volatile("s_waitcnt lgkmcnt(0)" ::: "memory");
    const float sc[2] = {frcp(ls[0]), frcp(ls[1])};
    store_o_rows(Vt, o, sc, lane, [&](int q) { return BIGP(bf16_t, B_ONA) + (tq0 + q) * 768 + 64 * head; });
}
DI void rope_frag4(bf16x8 (&f)[4], const float* cs, int hh) {
#pragma unroll
    for (int ks = 0; ks < 2; ++ks) { const float* cp = cs + 16 * ks + 8 * hh;
        const f32x4 c0 = *(const f32x4*)cp, c1 = *(const f32x4*)(cp + 4), s0 = *(const f32x4*)(cp + 32), s1 = *(const f32x4*)(cp + 36);
        const u32x4 a = __builtin_bit_cast(u32x4, f[ks]), b = __builtin_bit_cast(u32x4, f[ks + 2]); u32x4 ra, rb;
#pragma unroll
        for (int j = 0; j < 4; ++j) { const float cl = (j < 2) ? c0[2 * j] : c1[2 * j - 4], ch = (j < 2) ? c0[2 * j + 1] : c1[2 * j - 3];
            const float sl = (j < 2) ? s0[2 * j] : s1[2 * j - 4], sh = (j < 2) ? s0[2 * j + 1] : s1[2 * j - 3];
            const float x1l = bflo(a[j]), x1h = bfhi(a[j]), x2l = bflo(b[j]), x2h = bfhi(b[j]);
            ra[j] = pk2(x1l * cl - x2l * sl, x1h * ch - x2h * sh); rb[j] = pk2(x1l * sl + x2l * cl, x1h * sh + x2h * ch); }
        f[ks] = __builtin_bit_cast(bf16x8, ra); f[ks + 2] = __builtin_bit_cast(bf16x8, rb); }
}
DI void dil_wave_unit(KArgs args, LAS unsigned char* L, const Ctx& c, int u, int lane, int wave) {
    const int hd = u & 1, uu = u >> 1, upg = c.stok >> 6, g = uu / upg, v = uu % upg, ups = c.seqlen >> 6, seq = v / ups, wq = v % ups;
    const int dsh = 2 * g, dd = 1 << dsh, nb = ups >> dsh, cls = wq / nb, jb = wq % nb, head = 2 * g + hd;
    const bf16_t* PROJ = BIGP(bf16_t, B_PROJ); const float* CS = WSP(float, WS_CS);
    const size_t sb = (size_t)seq * c.seqlen;
    const int rr = lane & 31, hh = lane >> 5;
    LAS bf16_t* Vt = (LAS bf16_t*)(L + wave * WAREA);
    bf16x8 qf[2][4];
#pragma unroll
    for (int nt = 0; nt < 2; ++nt) { const int pos = cls + dd * (64 * jb + 32 * nt + rr);
#pragma unroll
        for (int ks = 0; ks < 4; ++ks) qf[nt][ks] = *(const bf16x8*)(PROJ + (sb + pos) * NPROJ + C_QD + 64 * head + 16 * ks + 8 * hh);
        rope_frag4(qf[nt], CS + (size_t)pos * 64, hh); }
    f32x16 o[2][2]; o[0][0] = zero16(); o[0][1] = zero16(); o[1][0] = zero16(); o[1][1] = zero16();
    float m[2] = {-1e30f, -1e30f}, ls[2] = {0.f, 0.f};
    for (int kt = 0; kt < 3; ++kt) { const int kj = jb - 1 + kt;
        if (kj < 0 || kj >= nb) continue;
        asm volatile("s_waitcnt lgkmcnt(0)" ::: "memory");
        stage_vt(Vt, lane, [&](int key) { return PROJ + (sb + cls + (size_t)dd * (64 * kj + key)) * NPROJ + C_VD + 64 * head; });
        f32x16 acc[2][2]; acc[0][0] = zero16(); acc[0][1] = zero16(); acc[1][0] = zero16(); acc[1][1] = zero16();
#pragma unroll
        for (int mt = 0; mt < 2; ++mt) { const int pos = cls + dd * (64 * kj + 32 * mt + rr); bf16x8 kf[4];
#pragma unroll
            for (int ks = 0; ks < 4; ++ks) kf[ks] = *(const bf16x8*)(PROJ + (sb + pos) * NPROJ + C_KD + 64 * head + 16 * ks + 8 * hh);
            rope_frag4(kf, CS + (size_t)pos * 64, hh);
#pragma unroll
            for (int ks = 0; ks < 4; ++ks) { acc[mt][0] = MFMA32(kf[ks], qf[0][ks], acc[mt][0]); acc[mt][1] = MFMA32(kf[ks], qf[1][ks], acc[mt][1]); } }
#pragma unroll
        for (int nt = 0; nt < 2; ++nt) { const int qc = 32 * nt + rr;
#pragma unroll
            for (int mt = 0; mt < 2; ++mt)
#pragma unroll
                for (int gg = 0; gg < 16; ++gg) { const int kc = 32 * mt + crow(gg, hh); const bool ok = (kt == 1) || (kt == 0 ? (kc >= qc) : (kc <= qc));
                    acc[mt][nt][gg] = ok ? acc[mt][nt][gg] * 0.125f : -1e30f; } }
        osm_update(acc, o, m, ls);
        pv_accum(acc, o, Vt, lane);
    }
    asm volatile("s_waitcnt lgkmcnt(0)" ::: "memory");
    bf16_t* DP = BIGP(bf16_t, B_DILP); float* DM = BIGP(float, B_DILM);
    const float one[2] = {1.f, 1.f};
    store_o_rows(Vt, o, one, lane, [&](int q) { return DP + ((((size_t)g * SLABMAX + sb + cls + (size_t)dd * (64 * jb + q)) * 2 + hd)) * 64; });
    if (hh == 0) {
#pragma unroll
        for (int nt = 0; nt < 2; ++nt) { const size_t base = (((size_t)g * SLABMAX + sb + cls + (size_t)dd * (64 * jb + 32 * nt + rr)) * 2 + hd); DM[base * 2] = m[nt]; DM[base * 2 + 1] = ls[nt]; } }
}

DI void phase_mix_a(KArgs args, LAS unsigned char* L, const Ctx& c) {
    const int N_PREP = (c.stok >> 6) * 6;
    for (int u = c.bid; u < N_PREP; u += c.G) gdn_prep_pair(args, L, c, u);
}
DI void attn_wave_units(KArgs args, LAS unsigned char* L, const Ctx& c) {
    int tid = c.tid; asm volatile("" : "+v"(tid)); const int lane = tid & 63, wave = __builtin_amdgcn_readfirstlane(tid >> 6);
    const int nch_ = c.stok >> 6, N_NA = nch_ * 4, N_DIL = nch_ * 6;
    unsigned* q = (unsigned*)(c.ws + WS_CTL) + 32768 + 128 * (c.layer * 4 + c.slab);
    for (;;) { unsigned u = 0; if (lane == 0) u = __hip_atomic_fetch_add(q, 1u, __ATOMIC_RELAXED, __HIP_MEMORY_SCOPE_AGENT);
        u = (unsigned)__builtin_amdgcn_readfirstlane((int)u); if (u >= (unsigned)N_NA) break; na_wave_unit(args, L, c, (int)u, lane, wave); }
    int tid2 = c.tid; asm volatile("" : "+v"(tid2)); const int lane2 = tid2 & 63, wave2 = __builtin_amdgcn_readfirstlane(tid2 >> 6);
    for (;;) { unsigned u = 0; if (lane2 == 0) u = __hip_atomic_fetch_add(q + 64, 1u, __ATOMIC_RELAXED, __HIP_MEMORY_SCOPE_AGENT);
        u = (unsigned)__builtin_amdgcn_readfirstlane((int)u); if (u >= (unsigned)N_DIL) break; dil_wave_unit(args, L, c, (int)u, lane2, wave2); }
}

DI void phase_scan(KArgs args, LAS unsigned char* L, const Ctx& c) {
    const int nwu = c.nseq * 24, wu = c.bid;
    if (wu < nwu && c.wave == 0) {
        const int lane = c.lane, rr = lane & 31, hh = lane >> 5;
        const int chain = wu >> 1, nt = wu & 1, seq = chain / 12, rem = chain % 12, head = rem >> 1, dir = rem & 1;
        const int nch = c.seqlen >> 6, gch0 = seq * nch;
        unsigned char* GS = BIGP(unsigned char, B_GSCR);
        f32x16 S[2]; S[0] = zero16(); S[1] = zero16();
        bf16x8 A[2][2][4]; u32x4 cm[2][2][2]; float gl[2];
        const long gstep = (long)(dir ? -1 : 1) * 12 * GSTRIDE;
        const unsigned char* Gp = GS + (size_t)(((gch0 + (dir ? nch - 1 : 0)) * 6 + head) * 2 + dir) * GSTRIDE;
        unsigned char* Gs = (unsigned char*)Gp;
#define SCAN_LOAD(B) do { _Pragma("unroll") for (int mt = 0; mt < 2; ++mt) { _Pragma("unroll") for (int ks = 0; ks < 4; ++ks) A[B][mt][ks] = *(const bf16x8*)(Gp + (size_t)((mt * 4 + ks) * 64 + lane) * 16); \
            const u32x4* cp = (const u32x4*)(Gp + 8192 + (size_t)((nt * 2 + mt) * 64 + lane) * 32); cm[B][mt][0] = cp[0]; cm[B][mt][1] = cp[1]; } gl[B] = *(const float*)(Gp + 40960); } while (0)
#define SCAN_STEP(B) do { { bf16_t* St = (bf16_t*)(Gs + 32768) + (size_t)(32 * nt + rr) * 64 + 4 * hh; \
            _Pragma("unroll") for (int mt = 0; mt < 2; ++mt) _Pragma("unroll") for (int g = 0; g < 4; ++g) { u32x2 w; w.x = pk2(S[mt][4 * g], S[mt][4 * g + 1]); w.y = pk2(S[mt][4 * g + 2], S[mt][4 * g + 3]); *(u32x2*)(St + 32 * mt + 8 * g) = w; } } \
            const bf16x8 b0 = pack8<0>(S[0]), b1 = pack8<1>(S[0]), b2 = pack8<0>(S[1]), b3 = pack8<1>(S[1]); f32x16 nw[2]; \
            _Pragma("unroll") for (int mt = 0; mt < 2; ++mt) { \
                _Pragma("unroll") for (int g = 0; g < 8; ++g) { const unsigned wv = (g < 4) ? cm[B][mt][0][g] : cm[B][mt][1][g - 4]; nw[mt][2 * g] = gl[B] * S[mt][2 * g] + bflo(wv); nw[mt][2 * g + 1] = gl[B] * S[mt][2 * g + 1] + bfhi(wv); } \
                nw[mt] = MFMA32(A[B][mt][0], b0, nw[mt]); nw[mt] = MFMA32(A[B][mt][1], b1, nw[mt]); nw[mt] = MFMA32(A[B][mt][2], b2, nw[mt]); nw[mt] = MFMA32(A[B][mt][3], b3, nw[mt]); } \
            S[0] = nw[0]; S[1] = nw[1]; Gs += gstep; } while (0)
        SCAN_LOAD(0); Gp += gstep; SCAN_LOAD(1); Gp += gstep;
        for (int step = 0; step < nch; step += 2) {
            const bool more = step + 2 < nch;
            if (!more) Gp -= 2 * gstep;
            SCAN_STEP(0); SCAN_LOAD(0); Gp += gstep;
            SCAN_STEP(1); SCAN_LOAD(1); Gp += gstep;
        }
#undef SCAN_LOAD
#undef SCAN_STEP
    }
    attn_wave_units(args, L, c);
}

DI void dil_merge(const Ctx& c) {
    { const bf16_t* DP = BIGP(bf16_t, B_DILP); const float* DM = BIGP(float, B_DILM); bf16_t* OD = BIGP(bf16_t, B_ONA) + 256;
        for (int it = c.bid * 512 + c.tid; it < c.stok * 32; it += c.G * 512) { const int tok = it >> 5, part = it & 31;
            u32x4 w = {0u, 0u, 0u, 0u};
            if (part < 16) { const int hd = part >> 3, p = part & 7; float m[3], dn[3];
#pragma unroll
                for (int g = 0; g < 3; ++g) { const size_t b = (((size_t)g * SLABMAX + tok) * 2 + hd); m[g] = DM[b * 2]; dn[g] = DM[b * 2 + 1]; }
                const float M = fmaxf(m[0], fmaxf(m[1], m[2])); float num[8], den = 0.f;
#pragma unroll
                for (int j = 0; j < 8; ++j) num[j] = 0.f;
#pragma unroll
                for (int g = 0; g < 3; ++g) { const float f = __expf(m[g] - M); den += f * dn[g]; const u32x4 a = *(const u32x4*)(DP + (((size_t)g * SLABMAX + tok) * 2 + hd) * 64 + 8 * p);
                    num[0] += f * bflo(a[0]); num[1] += f * bfhi(a[0]); num[2] += f * bflo(a[1]); num[3] += f * bfhi(a[1]); num[4] += f * bflo(a[2]); num[5] += f * bfhi(a[2]); num[6] += f * bflo(a[3]); num[7] += f * bfhi(a[3]); }
                const float inv = frcp(den);
                w.x = pk2(num[0] * inv, num[1] * inv); w.y = pk2(num[2] * inv, num[3] * inv); w.z = pk2(num[4] * inv, num[5] * inv); w.w = pk2(num[6] * inv, num[7] * inv); }
            if (part < 16) *(u32x4*)(OD + (size_t)tok * 768 + 8 * part) = w; } }
}

DI void phase_gdn_out(KArgs args, LAS unsigned char* L, const Ctx& c) {
    dil_merge(c);
    const int lane = c.lane, wave = c.wave, tid = c.tid, l = c.layer;
    const bf16_t* PROJ = BIGP(bf16_t, B_PROJ); unsigned char* GS = BIGP(unsigned char, B_GSCR); bf16_t* OG = BIGP(bf16_t, B_ONA) + 384;
    LAS float* OF = (LAS float*)L;
    for (int u = c.bid; u < (c.stok >> 6) * 6; u += c.G) { const int gch = u / 6, head = u % 6;
        { const int dir = wave >> 2, mt = (wave >> 1) & 1, nt = wave & 1, rr = lane & 31, hh = lane >> 5;
            const unsigned char* G = GS + (size_t)((gch * 6 + head) * 2 + dir) * GSTRIDE;
            const bf16_t* Qe = (const bf16_t*)(G + 16384); const bf16_t* Oct = (const bf16_t*)(G + 24576); const bf16_t* St = (const bf16_t*)(G + 32768);
            f32x16 acc = zero16();
#pragma unroll
            for (int ks = 0; ks < 4; ++ks) { const bf16x8 a = *(const bf16x8*)(Qe + (size_t)((mt * 4 + ks) * 64 + lane) * 8);
                const bf16_t* sp = St + (32 * nt + rr) * 64 + 32 * (ks >> 1) + 16 * (ks & 1) + 4 * hh; const u32x2 lo = *(const u32x2*)sp, hi = *(const u32x2*)(sp + 8);
                u32x4 bw; bw.x = lo.x; bw.y = lo.y; bw.z = hi.x; bw.w = hi.y; acc = MFMA32(a, __builtin_bit_cast(bf16x8, bw), acc); }
            const int e = 32 * nt + rr;
#pragma unroll
            for (int g = 0; g < 4; ++g) { const u32x2 w = *(const u32x2*)(Oct + e * 64 + 32 * mt + 8 * g + 4 * hh);
                const float v0 = acc[4 * g] + bflo(w.x), v1 = acc[4 * g + 1] + bfhi(w.x), v2 = acc[4 * g + 2] + bflo(w.y), v3 = acc[4 * g + 3] + bfhi(w.y);
                const int i0 = 32 * mt + 8 * g + 4 * hh;
#pragma unroll
                for (int j = 0; j < 4; ++j) { const int ii = i0 + j, tl = dir ? 63 - ii : ii; OF[(dir * 64 + tl) * 68 + e] = (j == 0) ? v0 : (j == 1) ? v1 : (j == 2) ? v2 : v3; } } }
        __syncthreads();
        { const int i = tid >> 3, p = tid & 7; const size_t tok = (size_t)gch * 64 + i;
            const LAS float* a = OF + i * 68 + 8 * p; const LAS float* b = OF + (64 + i) * 68 + 8 * p;
            float ov[8]; float ss = 0.f;
#pragma unroll
            for (int j = 0; j < 8; ++j) { ov[j] = a[j] + b[j]; ss += ov[j] * ov[j]; }
            ss += __shfl_xor(ss, 1); ss += __shfl_xor(ss, 2); ss += __shfl_xor(ss, 4);
            const float rs = frsq(ss * (1.0f / 64.0f) + NORM_EPS);
            const u32x4 zw = *(const u32x4*)(PROJ + tok * NPROJ + C_ZC + 64 * head + 8 * p);
            const float* nw = args->in[7] + l * 64 + 8 * p;
            float r[8];
#pragma unroll
            for (int j = 0; j < 4; ++j) { r[2 * j] = ov[2 * j] * rs * nw[2 * j] * siluf_(bflo(zw[j])); r[2 * j + 1] = ov[2 * j + 1] * rs * nw[2 * j + 1] * siluf_(bfhi(zw[j])); }
            u32x4 w; w.x = pk2(r[0], r[1]); w.y = pk2(r[2], r[3]); w.z = pk2(r[4], r[5]); w.w = pk2(r[6], r[7]);
            *(u32x4*)(OG + tok * 768 + 64 * head + 8 * p) = w; }
        __syncthreads();
    }
}

DI void phase_ln1(KArgs args, LAS unsigned char* L, const Ctx& c) {
    const int lane = c.lane, l = c.layer;
    LAS float* WR = (LAS float*)L;
    { const float* wr = args->in[14] + (size_t)l * D * 16;
        for (int i = c.tid; i < D * 16; i += 512) { const int col = i >> 4, e = i & 15, j = col >> 8, ln = (col >> 2) & 63, q = col & 3; WR[((j * 4 + q) * 64 + ln) * 20 + e] = wr[i]; } }
    __syncthreads();
    const float* g1 = args->in[12] + l * D; const float* b1 = args->in[13] + l * D;
    f32x4 gv[4], bv[4];
#pragma unroll
    for (int j = 0; j < 4; ++j) { gv[j] = *(const f32x4*)(g1 + 4 * lane + 256 * j); bv[j] = *(const f32x4*)(b1 + 4 * lane + 256 * j); }
    float* AFF = WSP(float, WS_AFF); int* SLOT = WSP(int, WS_SLOT); bf16_t* XB = WSP(bf16_t, WS_XB);
    f32x4 nv[4];
    { const int rl0 = c.bid * 8 + c.wave; if (rl0 < c.stok) { const float* hp = c.out + ((size_t)c.sbase + rl0) * D;
#pragma unroll
        for (int j = 0; j < 4; ++j) nv[j] = *(const f32x4*)(hp + 4 * lane + 256 * j); } }
    for (int rl = c.bid * 8 + c.wave; rl < c.stok; rl += c.G * 8) { const size_t tok = (size_t)c.sbase + rl;
        float* hr = c.out + tok * D; f32x4 v[4]; float s = 0.f;
#pragma unroll
        for (int j = 0; j < 4; ++j) { v[j] = nv[j]; s += (v[j][0] + v[j][1]) + (v[j][2] + v[j][3]); }
        if (rl + c.G * 8 < c.stok) { const float* hp = hr + (size_t)c.G * 8 * D;
#pragma unroll
            for (int j = 0; j < 4; ++j) nv[j] = *(const f32x4*)(hp + 4 * lane + 256 * j); }
        const float mean = wave_sum(s) * (1.0f / D); float s2 = 0.f;
#pragma unroll
        for (int j = 0; j < 4; ++j) { v[j] = v[j] - mean; s2 += (v[j][0] * v[j][0] + v[j][1] * v[j][1]) + (v[j][2] * v[j][2] + v[j][3] * v[j][3]); }
        const float rstd = frsq(wave_sum(s2) * (1.0f / D) + LN_EPS);
        float lg[16];
#pragma unroll
        for (int e = 0; e < 16; ++e) lg[e] = 0.f;
#pragma unroll
        for (int j = 0; j < 4; ++j) { v[j] = v[j] * rstd * gv[j] + bv[j];
            if (!c.dry) { *(f32x4*)(hr + 4 * lane + 256 * j) = v[j];
            u32x2 w; w.x = pk2(v[j][0], v[j][1]); w.y = pk2(v[j][2], v[j][3]); *(u32x2*)(XB + tok * D + 4 * lane + 256 * j) = w; }
#pragma unroll
            for (int q = 0; q < 4; ++q) { const LAS float* wp = WR + ((j * 4 + q) * 64 + lane) * 20; const float xv = v[j][q];
#pragma unroll
                for (int e4 = 0; e4 < 4; ++e4) { const f32x4 w4 = *(const LAS f32x4*)(wp + 4 * e4); lg[4 * e4] += xv * w4[0]; lg[4 * e4 + 1] += xv * w4[1]; lg[4 * e4 + 2] += xv * w4[2]; lg[4 * e4 + 3] += xv * w4[3]; } }
            asm volatile("" ::: "memory"); }
        float mx = -1e30f;
#pragma unroll
        for (int e = 0; e < 16; ++e) { lg[e] = wave_sum(lg[e]); mx = fmaxf(mx, lg[e]); }
        float den = 0.f;
#pragma unroll
        for (int e = 0; e < 16; ++e) { lg[e] = expf(lg[e] - mx); den += lg[e]; }
        float mine = 0.f;
#pragma unroll
        for (int e = 0; e < 16; ++e) mine = (lane == e) ? lg[e] : mine;
        if (lane < 16 && !c.dry) { AFF[(size_t)lane * T_ALL + tok] = mine / den; SLOT[tok * 16 + lane] = -1; }
    }
}
DI void phase_ln2(KArgs args, LAS unsigned char* L, const Ctx& c) {
    const int lane = c.lane, l = c.layer;
    const float* g2 = args->in[18] + l * D; const float* b2 = args->in[19] + l * D;
    f32x4 gv[4], bv[4];
#pragma unroll
    for (int j = 0; j < 4; ++j) { gv[j] = *(const f32x4*)(g2 + 4 * lane + 256 * j); bv[j] = *(const f32x4*)(b2 + 4 * lane + 256 * j); }
    const int* SLOT = WSP(int, WS_SLOT); bf16_t* XB = WSP(bf16_t, WS_XB);
    f32x4 nv[4]; int nsv = -1;
    { const int t0 = c.bid * 8 + c.wave; if (t0 < T_ALL) { const float* xp = c.out + (size_t)t0 * D; nsv = SLOT[(size_t)t0 * 16 + (lane & 15)];
#pragma unroll
        for (int j = 0; j < 4; ++j) nv[j] = *(const f32x4*)(xp + 4 * lane + 256 * j); } }
    for (int t = c.bid * 8 + c.wave; t < T_ALL; t += c.G * 8) { const size_t tok = (size_t)t;
        float* xr = c.out + tok * D; f32x4 v[4];
#pragma unroll
        for (int j = 0; j < 4; ++j) v[j] = nv[j] * ALPHA;
        const int sv = nsv;
        if (t + c.G * 8 < T_ALL) { const float* xp = xr + (size_t)c.G * 8 * D; nsv = SLOT[(tok + c.G * 8) * 16 + (lane & 15)];
#pragma unroll
            for (int j = 0; j < 4; ++j) nv[j] = *(const f32x4*)(xp + 4 * lane + 256 * j); }
#pragma unroll
        for (int e = 0; e < 16; ++e) { const int s = __builtin_amdgcn_readlane(sv, e);
            if (s >= 0) { const bf16_t* yr = BIGP(bf16_t, (e < 8 ? B_XY0 : B_XY1)) + ((size_t)(e & 7) * CAP + s) * D;
#pragma unroll
                for (int j = 0; j < 4; ++j) { const u32x2 w = *(const u32x2*)(yr + 4 * lane + 256 * j); v[j][0] += bflo(w.x); v[j][1] += bfhi(w.x); v[j][2] += bflo(w.y); v[j][3] += bfhi(w.y); } } }
        float s = 0.f;
#pragma unroll
        for (int j = 0; j < 4; ++j) s += (v[j][0] + v[j][1]) + (v[j][2] + v[j][3]);
        const float mean = wave_sum(s) * (1.0f / D); float s2 = 0.f;
#pragma unroll
        for (int j = 0; j < 4; ++j) { v[j] = v[j] - mean; s2 += (v[j][0] * v[j][0] + v[j][1] * v[j][1]) + (v[j][2] * v[j][2] + v[j][3] * v[j][3]); }
        const float rstd = frsq(wave_sum(s2) * (1.0f / D) + LN_EPS);
#pragma unroll
        for (int j = 0; j < 4; ++j) { v[j] = v[j] * rstd * gv[j] + bv[j];
            if (!c.dry) { *(f32x4*)(xr + 4 * lane + 256 * j) = v[j];
            u32x2 w; w.x = pk2(v[j][0], v[j][1]); w.y = pk2(v[j][2], v[j][3]); *(u32x2*)(XB + tok * D + 4 * lane + 256 * j) = w; } }
    }
}

DI int block_excl_scan(int v, LAS int* tmp, int tid, int& total) {
    const int lane = tid & 63, wave = tid >> 6; int x = v;
#pragma unroll
    for (int o = 1; o < 64; o <<= 1) { const int y = __shfl_up(x, o); if (lane >= o) x += y; }
    __syncthreads();
    if (lane == 63) tmp[wave] = x;
    __syncthreads();
    int base = 0, tot = 0;
#pragma unroll
    for (int w = 0; w < 8; ++w) { const int tw = tmp[w]; if (w < wave) base += tw; tot += tw; }
    total = tot;
    return base + x - v;
}
DI void phase_select(KArgs args, LAS unsigned char* L, const Ctx& c) {
    if (c.bid >= 32) return;
    const int tid = c.tid, grp = c.bid >> 4, e = c.bid & 15;
    const int n = grp ? T_S : T_P, t0 = grp ? T_P : 0, C = n >> 3, slot0 = grp ? CAP_P : 0;
    const unsigned* v = (const unsigned*)(WSP(float, WS_AFF) + (size_t)e * T_ALL + t0);
    LAS unsigned* hist = (LAS unsigned*)L; LAS int* sh = (LAS int*)(L + 1024); LAS int* tmp = (LAS int*)(L + 1024 + 64);
    unsigned prefix = 0u; int kk = C;
    for (int pass = 0; pass < 4; ++pass) { const int shift = 24 - 8 * pass; const unsigned mhi = pass == 0 ? 0u : (0xFFFFFFFFu << (shift + 8));
        if (tid < 256) hist[tid] = 0u;
        __syncthreads();
        for (int i = tid * 4; i < n; i += 512 * 16) {
            u32x4 x4[4];
#pragma unroll
            for (int k = 0; k < 4; ++k) x4[k] = *(const u32x4*)(v + i + k * 2048);
#pragma unroll
            for (int k = 0; k < 4; ++k)
#pragma unroll
                for (int j = 0; j < 4; ++j) { const unsigned x = x4[k][j]; if ((x & mhi) == prefix) __hip_atomic_fetch_add(&hist[(x >> shift) & 255u], 1u, __ATOMIC_RELAXED, __HIP_MEMORY_SCOPE_WORKGROUP); } }
        __syncthreads();
        if (tid == 0) { int cum = 0, sel = 0; for (int b = 255; b >= 0; --b) { const int h = (int)hist[b]; if (cum + h >= kk) { sel = b; break; } cum += h; } sh[0] = sel; sh[1] = kk - cum; }
        __syncthreads();
        prefix |= ((unsigned)sh[0]) << shift; kk = sh[1];
        __syncthreads();
    }
    const unsigned thr = prefix;
    const int per = n >> 9, i0 = tid * per;
    int ngt = 0, ntie = 0;
    for (int i = 0; i < per; i += 4) { const u32x4 x = *(const u32x4*)(v + i0 + i);
#pragma unroll
        for (int j = 0; j < 4; ++j) { ngt += (x[j] > thr); ntie += (x[j] == thr); } }
    int tot;
    const int tie_base = block_excl_scan(ntie, tmp, tid, tot);
    int take = kk - tie_base; take = take < 0 ? 0 : (take > ntie ? ntie : take);
    int pos = block_excl_scan(ngt + take, tmp, tid, tot);
    int* IDX = WSP(int, WS_IDX) + e * CAP + slot0;
    int tr = 0;
    for (int i = 0; i < per; i += 4) { const u32x4 x = *(const u32x4*)(v + i0 + i);
#pragma unroll
        for (int j = 0; j < 4; ++j) { bool s = x[j] > thr; if (x[j] == thr) { s = tr < take; ++tr; } if (s) { IDX[pos] = t0 + i0 + i + j; ++pos; } } }
}
DI void phase_gather(KArgs args, LAS unsigned char* L, const Ctx& c) {
    const int lane = c.lane; const int* IDX = WSP(int, WS_IDX); const bf16_t* XB = WSP(bf16_t, WS_XB);
    float* GATEV = WSP(float, WS_GATEV); int* SLOT = WSP(int, WS_SLOT); const float* AFF = WSP(float, WS_AFF);
    for (int row0 = (c.bid * 8 + c.wave) * 4; row0 < NE * CAP; row0 += c.G * 8 * 4) {
        const int e = row0 / CAP, s0 = row0 % CAP; int t[4]; u32x4 a[4], b[4];
#pragma unroll
        for (int k = 0; k < 4; ++k) t[k] = IDX[row0 + k];
#pragma unroll
        for (int k = 0; k < 4; ++k) { const u32x4* src = (const u32x4*)(XB + (size_t)t[k] * D); a[k] = src[lane]; b[k] = src[64 + lane]; }
        u32x4* dst = (u32x4*)(BIGP(bf16_t, (e < 8 ? B_XY0 : B_XY1)) + ((size_t)(e & 7) * CAP + s0) * D);
#pragma unroll
        for (int k = 0; k < 4; ++k) { dst[k * 128 + lane] = a[k]; dst[k * 128 + 64 + lane] = b[k]; }
        if (lane < 4) { const int tt = (lane == 0) ? t[0] : (lane == 1) ? t[1] : (lane == 2) ? t[2] : t[3]; SLOT[(size_t)tt * 16 + e] = s0 + lane; GATEV[row0 + lane] = AFF[(size_t)e * T_ALL + tt]; } }
}

__global__ void __launch_bounds__(512, 2) fwd_kernel(Args args) {
    extern __shared__ __attribute__((aligned(16))) unsigned char lds_raw[];
    LAS unsigned char* L = (LAS unsigned char*)lds_raw;
    Ctx c;
    c.out = args.out; c.ws = args.ws;
    c.tid = threadIdx.x; c.lane = c.tid & 63; c.wave = __builtin_amdgcn_readfirstlane(c.tid >> 6); c.G = gridDim.x; c.bid = blockIdx.x;
    c.layer = 0; c.slab = 0; c.nseq = 8; c.seqlen = 4096; c.stok = 32768; c.sbase = 0; c.dry = 0;
    const int lo = args.ph_lo, hi = args.ph_hi;
    volatile LAS unsigned* MISC = (volatile LAS unsigned*)(L + LDS_MISC);
    if (c.tid < 4) MISC[c.tid] = 0u;
    __syncthreads();
    XcdBarrier bar; bar.bar = (unsigned*)(c.ws + WS_CTL) + 1024; bar.x = 0; bar.st = MISC;
    if (hi - lo > 1) bar = xcd_barrier_post((unsigned*)(c.ws + WS_CTL) + 1024, MISC);
    int pc = 0;
#ifndef PHMASK
#define PHMASK 0xFFFF
#endif
#define PHON(k) (((PHMASK) >> (k)) & 1)
#ifndef REPMASK
#define REPMASK 0x0
#endif
#define PH_BEGIN(k) if (PHON(k) && pc >= lo && pc < hi) { { int tz = threadIdx.x; asm volatile("" : "+v"(tz)); c.tid = tz; c.lane = tz & 63; c.wave = __builtin_amdgcn_readfirstlane(tz >> 6); } KArgs ka = kargs(); c.ws = ka->ws; c.out = ka->out; { int b_ = blockIdx.x, g_ = gridDim.x; asm volatile("" : "+s"(b_), "+s"(g_)); c.bid = b_; c.G = g_; } for (int rep_ = 0; rep_ < (((REPMASK) >> (k)) & 1) + 1; ++rep_) { if (rep_) __syncthreads(); c.dry = (rep_ + 1 < (((REPMASK) >> (k)) & 1) + 1);
#ifndef BARREP
#define BARREP 0
#endif
#define PH_END   } if (pc + 1 < hi) { xcd_barrier(bar); if (BARREP) { xcd_barrier(bar); xcd_barrier(bar); } } else { asm volatile("s_waitcnt vmcnt(0)" ::: "memory"); __syncthreads(); } } ++pc;

    for (int layer = 0; layer < 2; ++layer) {
        c.layer = layer;
        PH_BEGIN(0) phase_weights(ka, L, c); PH_END
        for (int slab = 0; slab < NSLAB; ++slab) {
            c.slab = slab; c.nseq = slab < 2 ? 8 : 1; c.seqlen = slab < 2 ? 4096 : 16384; c.stok = slab < 2 ? 32768 : 16384; c.sbase = slab * 32768; const int stok = c.stok; const size_t sbase = (size_t)c.sbase;
            PH_BEGIN(1) {
                pg8::Gemm g{WSP(bf16_t, WS_XB) + sbase * D, WSP(bf16_t, WS_WIN), stok, NPROJ, D}; pg8::StaticOrder S; S.init(stok, NPROJ, c.G, c.bid);
                pg8::EpiInProj E{BIGP(bf16_t, B_PROJ), BIGP(float, B_BA)};
                pg8::gemm_phase<pg8::EpiInProj, pg8::StaticOrder>(L, g, S, E); } PH_END
            PH_BEGIN(2) phase_mix_a(ka, L, c); PH_END
            PH_BEGIN(3) phase_scan(ka, L, c); PH_END
            PH_BEGIN(4) phase_gdn_out(ka, L, c); PH_END
            PH_BEGIN(5) {
                pg8::StaticOrder S; S.init(stok, D, c.G, c.bid);
                pg8::Gemm g{BIGP(bf16_t, B_ONA), WSP(bf16_t, WS_WBR), stok, D, 768}; pg8::EpiGateCat E{BIGP(bf16_t, B_PROJ), BIGP(bf16_t, B_MERGED)};
                pg8::gemm_phase<pg8::EpiGateCat, pg8::StaticOrder>(L, g, S, E); } PH_END
            PH_BEGIN(6) {
                const float* xr = layer == 0 ? (slab < 2 ? ka->in[0] + sbase * D : ka->in[1]) : c.out + sbase * D;
                pg8::Gemm g{BIGP(bf16_t, B_MERGED), WSP(bf16_t, WS_WOUT), stok, D, D}; pg8::StaticOrder S; S.init(stok, D, c.G, c.bid);
                pg8::EpiRes E{xr, c.out + sbase * D};
                pg8::gemm_phase<pg8::EpiRes, pg8::StaticOrder>(L, g, S, E); } PH_END
#ifndef LN1PROBE
#define LN1PROBE 0
#endif
            PH_BEGIN(7) if (LN1PROBE) { c.dry = 1; phase_ln1(ka, L, c); __syncthreads(); c.dry = 0; } phase_ln1(ka, L, c); PH_END
        }
        PH_BEGIN(8) phase_select(ka, L, c); PH_END
        PH_BEGIN(9) phase_gather(ka, L, c); PH_END
        for (int half = 0; half < 2; ++half) {
            PH_BEGIN(10) {
                pg8::Gemm g{BIGP(bf16_t, half ? B_XY1 : B_XY0), WSP(bf16_t, WS_WGU) + (size_t)half * 8 * 4096 * D, 8 * CAP, 8 * 4096, D}; pg8::MoeOrder S; S.init(8, CAP / 256, 16, c.G, c.bid);
                pg8::EpiSwiglu E{BIGP(bf16_t, B_HID)};
                pg8::gemm_phase<pg8::EpiSwiglu, pg8::MoeOrder>(L, g, S, E); } PH_END
            PH_BEGIN(11) {
                pg8::Gemm g{BIGP(bf16_t, B_HID), WSP(bf16_t, WS_WD) + (size_t)half * 8 * D * DE, 8 * CAP, 8 * D, DE}; pg8::MoeOrder S; S.init(8, CAP / 256, 4, c.G, c.bid);
                pg8::EpiDown E{BIGP(bf16_t, half ? B_XY1 : B_XY0), WSP(float, WS_GATEV) + (size_t)half * 8 * CAP};
                pg8::gemm_phase<pg8::EpiDown, pg8::MoeOrder>(L, g, S, E); } PH_END
        }
        PH_BEGIN(12) phase_ln2(ka, L, c); PH_END
    }
#undef PH_BEGIN
#undef PH_END
}

constexpr int N_PHASES = 2 * (1 + NSLAB * 7 + 2 + 4 + 1);

extern "C" void kernel_launch(void* const* d_in, const int* in_sizes, int n_in, void* d_out, int out_size, void* d_ws, size_t ws_size, hipStream_t stream) {
    static int grid = 0;
    if (grid == 0) {
        if (n_in != 20 || ws_size < WS_END) { fprintf(stderr, "kernel_launch: unexpected n_in %d or ws_size %zu (< %zu)\n", n_in, ws_size, (size_t)WS_END); grid = -1; return; }
        int dev = 0, cus = 0, per_cu = 0;
        if (hipGetDevice(&dev) != hipSuccess || hipDeviceGetAttribute(&cus, hipDeviceAttributeMultiprocessorCount, dev) != hipSuccess) { grid = -1; return; }
        if (hipFuncSetAttribute((const void*)fwd_kernel, hipFuncAttributeMaxDynamicSharedMemorySize, LDS_BYTES) != hipSuccess) { fprintf(stderr, "kernel_launch: hipFuncSetAttribute failed\n"); grid = -1; return; }
        if (hipOccupancyMaxActiveBlocksPerMultiprocessor(&per_cu, (const void*)fwd_kernel, 512, LDS_BYTES) != hipSuccess || per_cu < 1) fprintf(stderr, "kernel_launch: occupancy query says %d\n", per_cu);
        (void)hipGetLastError();
        grid = cus;
    }
    if (grid < 0) return;
    (void)hipMemsetAsync((char*)d_ws + WS_CTL, 0, 1 * MiB, stream);
    Args a{};
    for (int i = 0; i < 20; ++i) a.in[i] = (const float*)d_in[i];
    a.out = (float*)d_out; a.ws = (unsigned char*)d_ws;
#if MK_N_LAUNCHES == 1
    a.ph_lo = 0; a.ph_hi = N_PHASES;
    hipLaunchKernelGGL(fwd_kernel, dim3(grid), dim3(512), LDS_BYTES, stream, a);
#else
    for (int p = 0; p < N_PHASES; ++p) { a.ph_lo = p; a.ph_hi = p + 1; hipLaunchKernelGGL(fwd_kernel, dim3(grid), dim3(512), LDS_BYTES, stream, a); }
#endif
}
```

```cpp
#include <hip/hip_runtime.h>
#include <stdint.h>
#include <stdio.h>

#define LAS __attribute__((address_space(3)))
#define DI __device__ __forceinline__
typedef unsigned short bf16_t;
typedef short bf16x8 __attribute__((ext_vector_type(8)));
typedef float f32x4 __attribute__((ext_vector_type(4)));
typedef float f32x2 __attribute__((ext_vector_type(2)));
typedef float f32x16 __attribute__((ext_vector_type(16)));
typedef unsigned u32x4 __attribute__((ext_vector_type(4)));
typedef unsigned u32x2 __attribute__((ext_vector_type(2)));
typedef __bf16 bf16x2v __attribute__((ext_vector_type(2)));

#ifndef MK_N_LAUNCHES
#define MK_N_LAUNCHES 1
#endif

constexpr int D = 1024, T_ALL = 81920, T_P = 65536, T_S = 16384, SLABMAX = 32768, NSLAB = 3;
constexpr int DIN = 6552, NPROJ = 6656;
constexpr int C_GATE = 0, C_QA = 3072, C_KA = 3328, C_VA = 3584, C_QD = 3840, C_KD = 4224, C_VD = 4608, C_QC = 4992, C_KC = 5376, C_VC = 5760, C_ZC = 6144;
constexpr int NE = 16, DE = 2048, CAP_P = 8192, CAP_S = 2048, CAP = CAP_P + CAP_S;
constexpr float ALPHA = 1.41421356237f, LN_EPS = 1e-5f, NORM_EPS = 1e-6f;
constexpr size_t MiB = 1u << 20;
constexpr size_t WS_CTL = 0, WS_WIN = 1 * MiB, WS_WBR = 14 * MiB, WS_WOUT = 16 * MiB, WS_WGU = 18 * MiB, WS_WD = 146 * MiB, WS_XB = 210 * MiB;
constexpr size_t WS_AFF = 370 * MiB, WS_SLOT = 375 * MiB, WS_IDX = 380 * MiB, WS_GATEV = 381 * MiB, WS_CS = 382 * MiB, WS_BIG = 386 * MiB, WS_END = 1130 * MiB;
constexpr size_t B_PROJ = 0, B_BA = 416 * MiB, B_ONA = 420 * MiB, B_ODIL = 436 * MiB, B_OGDN = 452 * MiB, B_DILP = 476 * MiB, B_DILM = 500 * MiB, B_GSCR = 502 * MiB, B_MERGEF = 502 * MiB, B_MERGED = 630 * MiB;
constexpr size_t B_XY0 = 0, B_XY1 = 160 * MiB, B_HID = 320 * MiB;
constexpr int GSTRIDE = 41216;
constexpr int LDS_BYTES = 147456;
constexpr int LDS_MISC = 145408;

DI unsigned pk2(float lo, float hi) { f32x2 v = {lo, hi}; bf16x2v b = __builtin_convertvector(v, bf16x2v); return __builtin_bit_cast(unsigned, b); }
DI float bflo(unsigned u) { return __uint_as_float(u << 16); }
DI float bfhi(unsigned u) { return __uint_as_float(u & 0xffff0000u); }
DI float frcp(float x) { return __builtin_amdgcn_rcpf(x); }
DI float frsq(float x) { return __builtin_amdgcn_rsqf(x); }
DI float sigmoidf_(float x) { return frcp(1.0f + __expf(-x)); }
DI float siluf_(float x) { return x * frcp(1.0f + __expf(-x)); }
DI float wave_sum(float v) {
#pragma unroll
    for (int o = 1; o < 64; o <<= 1) v += __shfl_xor(v, o);
    return v;
}
#define MFMA32(a, b, c) __builtin_amdgcn_mfma_f32_32x32x16_bf16((a), (b), (c), 0, 0, 0)
DI int crow(int reg, int h) { return (reg & 3) + 8 * (reg >> 2) + 4 * h; }
DI f32x16 zero16() { f32x16 z; for (int i = 0; i < 16; ++i) z[i] = 0.f; return z; }
template <int S> DI bf16x8 pack8(const f32x16& x) {
    u32x4 p; p[0] = pk2(x[8 * S], x[8 * S + 1]); p[1] = pk2(x[8 * S + 2], x[8 * S + 3]); p[2] = pk2(x[8 * S + 4], x[8 * S + 5]); p[3] = pk2(x[8 * S + 6], x[8 * S + 7]);
    return __builtin_bit_cast(bf16x8, p);
}

namespace pg8 {
constexpr int BM = 256, BK = 64, HALF = 128, HTB = HALF * BK * 2, STAGE_BYTES = 8 * HTB, NXCD = 8, WGM = 8;
__host__ __device__ __forceinline__ int lds_byte(int r, int c) { const int st = (r >> 4) * 2 + (c >> 5), rr = r & 15, cc = c & 31, ob = rr * 64 + cc * 2; return st * 1024 + (ob ^ (((ob >> 9) & 1) << 5)); }
__host__ __device__ __forceinline__ void stage_rc(int b, int& R, int& C) { const int st = b / 1024, sb = b % 1024, swz = sb ^ (((sb >> 9) & 1) << 5); R = (st >> 1) * 16 + swz / 64; C = (st & 1) * 32 + (swz % 64) / 2; }
__host__ __device__ __forceinline__ int perm32(int rho) { const int n = rho >> 4, i = rho & 15; return 8 * (i >> 2) + 4 * n + (i & 3); }
struct Unit { int pm, pn; };
struct Gemm { const bf16_t* A; const bf16_t* Bt; int M, N, K; };
struct StaticOrder {
    int nM, nN, nwg, G, c;
    __device__ void init(int M, int N, int G_, int c_) { nM = M / BM; nN = N / BM; nwg = nM * nN; G = G_; c = c_; }
    __device__ bool next(int i, Unit& u) const {
        const long L = (long)i * G + c; if (L >= nwg) return false;
        int wgid = (int)L; { const int q = nwg / NXCD, r = nwg % NXCD, xcd = wgid % NXCD, off = wgid / NXCD; wgid = (xcd < r ? xcd * (q + 1) : r * (q + 1) + (xcd - r) * q) + off; }
        const int nig = WGM * nN, gid = wgid / nig, fm = gid * WGM, gsz = (nM - fm) < WGM ? (nM - fm) : WGM;
        u.pm = fm + ((wgid % nig) % gsz); u.pn = (wgid % nig) / gsz; return true;
    }
    __device__ __forceinline__ void a_ready(const Unit&) const {}
    __device__ __forceinline__ void done(const Unit&) const {}
};
struct MoeOrder {
    int nMe, nNe, per, total, G, c, xr, xc, rpx, cpx, share;
    __device__ void init(int nE, int nMe_, int nNe_, int G_, int c_) { nMe = nMe_; nNe = nNe_; per = nMe * nNe; total = nE * per; G = G_; c = c_;
        xc = (nNe % 2 == 0 && nNe >= 8) ? 2 : 1; xr = 8 / xc; rpx = nMe / xr; cpx = nNe / xc; share = rpx * cpx; }
    __device__ bool next(int i, Unit& u) const {
        if ((G & 7) == 0 && nMe % xr == 0) {
            const int x = c & 7, q = c >> 3, nq = G >> 3; const long j = (long)i * nq + q; if (j >= (long)(total / 8)) return false;
            const int e = (int)(j / share), r = (int)(j % share); const int pm = (x / xc) * rpx + r % rpx, pn = (x % xc) * cpx + r / rpx;
            u.pm = e * nMe + pm; u.pn = e * nNe + pn; return true;
        }
        const long L = (long)i * G + c; if (L >= total) return false;
        const int e = (int)(L / per), r = (int)(L % per);
        u.pm = e * nMe + r % nMe; u.pn = e * nNe + r / nMe; return true;
    }
    __device__ __forceinline__ void a_ready(const Unit&) const {}
    __device__ __forceinline__ void done(const Unit&) const {}
};

template <class Epi, class Sched>
__device__ __forceinline__ void gemm_phase(LAS unsigned char* lds, const Gemm g, const Sched& S, const Epi& E) {
    int tid = threadIdx.x; asm volatile("" : "+v"(tid));
    const int wid = __builtin_amdgcn_readfirstlane(tid >> 6), lane = tid & 63, wr = wid >> 2, wc = wid & 3, fr = lane & 15, fq = lane >> 4;
    int Kv = g.K; asm volatile("" : "+s"(Kv));
    const int K = Kv, nt = K / BK;
    unsigned voffA[2], voffB[2];
#pragma unroll
    for (int i = 0; i < 2; ++i) { int R, C; stage_rc(tid * 16 + i * 8192, R, C); const int Rb = Epi::PERM ? ((R & ~31) + perm32(R & 31)) : R;
        voffA[i] = (unsigned)(R * K + C) * 2u; voffB[i] = (unsigned)(Rb * K + C) * 2u; }
    const size_t kstep = (size_t)(BK * 2);
    const size_t hstep = (size_t)HALF * K * 2;
    const size_t tstep = 2 * hstep;
    const unsigned ldsw = (unsigned)wid * 1024u;
    const int aoff = lds_byte(wr * 64 + fr, fq * 8), boff = lds_byte(wc * 32 + fr, fq * 8);
#define PG8_SA(b, h) (((b) * 2 + (h)) * HTB)
#define PG8_SB(b, h) ((4 + (b) * 2 + (h)) * HTB)
#define PG8_STAGE(bufoff, gbase, voff) do { _Pragma("unroll") for (int _i = 0; _i < 2; ++_i) \
        __builtin_amdgcn_global_load_lds((const unsigned*)((const char*)(gbase) + (voff)[_i]), (LAS unsigned*)(lds + (bufoff) + ldsw + _i * 8192), 16, 0, 0); } while (0)
#define PG8_LDA(dst, b, h) do { _Pragma("unroll") for (int m = 0; m < 4; ++m) _Pragma("unroll") for (int k = 0; k < 2; ++k) dst[m][k] = *(const LAS bf16x8*)(lds + PG8_SA(b, h) + aoff + m * 2048 + k * 1024); } while (0)
#define PG8_LDB(dst, b, h) do { _Pragma("unroll") for (int n = 0; n < 2; ++n) _Pragma("unroll") for (int k = 0; k < 2; ++k) dst[n][k] = *(const LAS bf16x8*)(lds + PG8_SB(b, h) + boff + n * 2048 + k * 1024); } while (0)
#define PG8_MMA(ai, bj, At, Bt) do { __builtin_amdgcn_s_setprio(1); _Pragma("unroll") for (int m = 0; m < 4; ++m) _Pragma("unroll") for (int n = 0; n < 2; ++n) _Pragma("unroll") for (int k = 0; k < 2; ++k) \
        acc[ai][bj][m][n] = __builtin_amdgcn_mfma_f32_16x16x32_bf16(Bt[n][k], At[m][k], acc[ai][bj][m][n], 0, 0, 0); __builtin_amdgcn_s_setprio(0); } while (0)
#define PG8_WAIT_V(n) asm volatile("s_waitcnt vmcnt(" #n ")" ::: "memory")
#define PG8_WAIT_L(n) asm volatile("s_waitcnt lgkmcnt(" #n ")" ::: "memory")
#define PG8_BAR __builtin_amdgcn_s_barrier()
#define PG8_SCHED __builtin_amdgcn_sched_barrier(0)
    Unit cur, nxt; int ui = 0;
    if (!S.next(0, cur)) return;
    f32x4 acc[2][2][4][2];
#pragma unroll
    for (int a = 0; a < 2; ++a)
#pragma unroll
        for (int b = 0; b < 2; ++b)
#pragma unroll
            for (int m = 0; m < 4; ++m)
#pragma unroll
                for (int n = 0; n < 2; ++n) acc[a][b][m][n] = (f32x4){0.f, 0.f, 0.f, 0.f};
    bf16x8 At[4][2], B0[2][2], B1[2][2];
    const char* cA = (const char*)g.A + (size_t)cur.pm * tstep; const char* cB = (const char*)g.Bt + (size_t)cur.pn * tstep;
    S.a_ready(cur);
    PG8_STAGE(PG8_SB(0, 0), cB, voffB); PG8_STAGE(PG8_SA(0, 0), cA, voffA); PG8_STAGE(PG8_SB(0, 1), cB + hstep, voffB); PG8_STAGE(PG8_SA(0, 1), cA + hstep, voffA);
    if (wr == 1) PG8_BAR;
    PG8_WAIT_V(4); PG8_BAR;
    PG8_STAGE(PG8_SB(1, 0), cB + kstep, voffB); PG8_STAGE(PG8_SA(1, 0), cA + kstep, voffA); PG8_STAGE(PG8_SB(1, 1), cB + hstep + kstep, voffB);
    PG8_WAIT_V(6); PG8_BAR;
    for (;;) {
        const bool has_next = S.next(ui + 1, nxt);
        const char* nA = has_next ? (const char*)g.A + (size_t)nxt.pm * tstep : cA; const char* nB = has_next ? (const char*)g.Bt + (size_t)nxt.pn * tstep : cB;
        for (int t = 0; t < nt; t += 2) {
            const bool last = (t == nt - 2);
            const char* a1 = cA + (size_t)(t + 1) * kstep;
            const char* a2 = last ? nA : cA + (size_t)(t + 2) * kstep; const char* b2 = last ? nB : cB + (size_t)(t + 2) * kstep;
            const char* a3 = a2 + kstep; const char* b3 = b2 + kstep;
            if (last && has_next) S.a_ready(nxt);
            if constexpr (Epi::SEG) { if (t == 4 || t == 6) { int tz = tid; asm volatile("" : "+v"(tz)); const int wz = __builtin_amdgcn_readfirstlane(tz >> 6), lz = tz & 63; E.mid(acc, cur, t == 4 ? 0 : 1, wz >> 2, wz & 3, lz & 15, lz >> 4); } }
            PG8_LDB(B0, 0, 0); PG8_SCHED; PG8_LDA(At, 0, 0); PG8_STAGE(PG8_SA(1, 1), a1 + hstep, voffA);
            PG8_WAIT_L(8); PG8_BAR; PG8_WAIT_L(0); PG8_MMA(0, 0, At, B0); PG8_BAR; PG8_SCHED;
            PG8_LDB(B1, 0, 1); PG8_STAGE(PG8_SB(0, 0), b2, voffB);
            PG8_BAR; PG8_WAIT_L(0); PG8_MMA(0, 1, At, B1); PG8_BAR;
            PG8_LDA(At, 0, 1); PG8_STAGE(PG8_SA(0, 0), a2, voffA);
            PG8_BAR; PG8_WAIT_L(0); PG8_MMA(1, 0, At, B0); PG8_BAR; PG8_SCHED;
            PG8_STAGE(PG8_SB(0, 1), b2 + hstep, voffB);
            PG8_WAIT_V(6); PG8_BAR; PG8_MMA(1, 1, At, B1); PG8_BAR;
            PG8_LDB(B0, 1, 0); PG8_SCHED; PG8_LDA(At, 1, 0); PG8_STAGE(PG8_SA(0, 1), a2 + hstep, voffA);
            PG8_WAIT_L(8); PG8_BAR; PG8_WAIT_L(0); PG8_MMA(0, 0, At, B0); PG8_BAR; PG8_SCHED;
            PG8_LDB(B1, 1, 1); PG8_STAGE(PG8_SB(1, 0), b3, voffB);
            PG8_BAR; PG8_WAIT_L(0); PG8_MMA(0, 1, At, B1); PG8_BAR;
            PG8_LDA(At, 1, 1); PG8_STAGE(PG8_SA(1, 0), a3, voffA);
            PG8_BAR; PG8_WAIT_L(0); PG8_MMA(1, 0, At, B0); PG8_BAR; PG8_SCHED;
            PG8_STAGE(PG8_SB(1, 1), b3 + hstep, voffB);
            PG8_WAIT_V(6); PG8_BAR; PG8_MMA(1, 1, At, B1); PG8_BAR;
        }
        { int tz = tid; asm volatile("" : "+v"(tz)); const int wz = __builtin_amdgcn_readfirstlane(tz >> 6), lz = tz & 63;
          E(acc, cur, wz >> 2, wz & 3, lz & 15, lz >> 4); } S.done(cur);
        if (!has_next) break;
#pragma unroll
        for (int a = 0; a < 2; ++a)
#pragma unroll
            for (int b = 0; b < 2; ++b)
#pragma unroll
                for (int m = 0; m < 4; ++m)
#pragma unroll
                    for (int n = 0; n < 2; ++n) acc[a][b][m][n] = (f32x4){0.f, 0.f, 0.f, 0.f};
        cur = nxt; cA = nA; cB = nB; ++ui;
    }
    PG8_WAIT_V(0);
    if (wr == 0) PG8_BAR;
    PG8_BAR;
#undef PG8_SA
#undef PG8_SB
#undef PG8_STAGE
#undef PG8_LDA
#undef PG8_LDB
#undef PG8_MMA
#undef PG8_WAIT_V
#undef PG8_WAIT_L
#undef PG8_BAR
#undef PG8_SCHED
}

struct EpiInProj {
    static constexpr bool PERM = true, SEG = false;
    bf16_t* O; float* BA;
    __device__ __forceinline__ void operator()(const f32x4 (&acc)[2][2][4][2], const Unit& u, int wr, int wc, int fr, int fq) const {
        const int row0 = u.pm * BM + wr * 64 + fr, col0 = u.pn * BM + wc * 32 + 8 * fq;
        const bool sig = u.pn < 12, ba = (u.pn == 25) && (wc == 0) && (fq < 3);
#pragma unroll
        for (int ai = 0; ai < 2; ++ai)
#pragma unroll
            for (int m = 0; m < 4; ++m) { const int row = row0 + ai * HALF + m * 16; bf16_t* rowp = O + (size_t)row * NPROJ + col0;
#pragma unroll
                for (int bj = 0; bj < 2; ++bj) { f32x4 v0 = acc[ai][bj][m][0], v1 = acc[ai][bj][m][1];
                    if (sig) {
#pragma unroll
                        for (int j = 0; j < 4; ++j) { v0[j] = sigmoidf_(v0[j]); v1[j] = sigmoidf_(v1[j]); } }
                    u32x4 w; w.x = pk2(v0[0], v0[1]); w.y = pk2(v0[2], v0[3]); w.z = pk2(v1[0], v1[1]); w.w = pk2(v1[2], v1[3]);
                    *(u32x4*)(rowp + bj * HALF) = w;
                    if (bj == 1 && ba) { float* bp = BA + (size_t)row * 32 + 8 * fq; *(f32x4*)bp = v0; *(f32x4*)(bp + 4) = v1; } } }
    }
};
struct EpiGateCat {
    static constexpr bool PERM = false, SEG = true;
    const bf16_t* PROJ; bf16_t* MB;
    __device__ __forceinline__ void mid(f32x4 (&acc)[2][2][4][2], const Unit& u, int seg, int wr, int wc, int fr, int fq) const {
        const int row0 = u.pm * BM + wr * 64 + fr, col0 = u.pn * BM + wc * 32 + 4 * fq;
#pragma unroll
        for (int ai = 0; ai < 2; ++ai)
#pragma unroll
            for (int m = 0; m < 4; ++m) { int rowi = row0 + ai * HALF + m * 16; asm volatile("" : "+v"(rowi)); const bf16_t* gp = PROJ + (size_t)rowi * NPROJ + C_GATE + seg * 1024 + col0;
#pragma unroll
                for (int bj = 0; bj < 2; ++bj)
#pragma unroll
                    for (int n = 0; n < 2; ++n) { const u32x2 ga = *(const u32x2*)(gp + bj * HALF + n * 16), gb = *(const u32x2*)(gp + 1024 + bj * HALF + n * 16);
                        f32x4& v = acc[ai][bj][m][n]; v[0] *= bflo(ga.x) * frcp(bflo(gb.x)); v[1] *= bfhi(ga.x) * frcp(bfhi(gb.x)); v[2] *= bflo(ga.y) * frcp(bflo(gb.y)); v[3] *= bfhi(ga.y) * frcp(bfhi(gb.y)); }
                asm volatile("" ::: "memory"); }
    }
    __device__ __forceinline__ void operator()(const f32x4 (&acc)[2][2][4][2], const Unit& u, int wr, int wc, int fr, int fq) const {
        const int row0 = u.pm * BM + wr * 64 + fr, col0 = u.pn * BM + wc * 32 + 4 * fq;
#pragma unroll
        for (int ai = 0; ai < 2; ++ai)
#pragma unroll
            for (int m = 0; m < 4; ++m) { int rowi = row0 + ai * HALF + m * 16; asm volatile("" : "+v"(rowi)); const size_t row = (size_t)rowi;
#pragma unroll
                for (int bj = 0; bj < 2; ++bj)
#pragma unroll
                    for (int n = 0; n < 2; ++n) { const int col = col0 + bj * HALF + n * 16;
                        const u32x2 gw = *(const u32x2*)(PROJ + row * NPROJ + C_GATE + 2 * 1024 + col);
                        const f32x4 v = acc[ai][bj][m][n];
                        u32x2 w; w.x = pk2(v[0] * bflo(gw.x), v[1] * bfhi(gw.x)); w.y = pk2(v[2] * bflo(gw.y), v[3] * bfhi(gw.y)); *(u32x2*)(MB + row * D + col) = w; }
                asm volatile("" ::: "memory"); }
    }
};
struct EpiRes {
    static constexpr bool PERM = false, SEG = false;
    const float* XR; float* H;
    __device__ __forceinline__ void operator()(const f32x4 (&acc)[2][2][4][2], const Unit& u, int wr, int wc, int fr, int fq) const {
        const int row0 = u.pm * BM + wr * 64 + fr, col0 = u.pn * BM + wc * 32 + 4 * fq;
#pragma unroll
        for (int ai = 0; ai < 2; ++ai)
#pragma unroll
            for (int m = 0; m < 4; ++m) { int rowi = row0 + ai * HALF + m * 16; asm volatile("" : "+v"(rowi)); const size_t off = (size_t)rowi * D + col0;
#pragma unroll
                for (int bj = 0; bj < 2; ++bj)
#pragma unroll
                    for (int n = 0; n < 2; ++n) { const f32x4 xr = *(const f32x4*)(XR + off + bj * HALF + n * 16);
                        *(f32x4*)(H + off + bj * HALF + n * 16) = xr * ALPHA + acc[ai][bj][m][n]; }
                asm volatile("" ::: "memory"); }
    }
};
struct EpiSwiglu {
    static constexpr bool PERM = true, SEG = false;
    bf16_t* HID;
    __device__ __forceinline__ void operator()(const f32x4 (&acc)[2][2][4][2], const Unit& u, int wr, int wc, int fr, int fq) const {
        const int row0 = u.pm * BM + wr * 64 + fr, col0 = (u.pn & 15) * 128 + wc * 32 + 8 * fq;
#pragma unroll
        for (int ai = 0; ai < 2; ++ai)
#pragma unroll
            for (int m = 0; m < 4; ++m) { const f32x4 g0 = acc[ai][0][m][0], g1 = acc[ai][0][m][1], u0 = acc[ai][1][m][0], u1 = acc[ai][1][m][1];
                f32x4 h0, h1;
#pragma unroll
                for (int j = 0; j < 4; ++j) { h0[j] = siluf_(g0[j]) * u0[j]; h1[j] = siluf_(g1[j]) * u1[j]; }
                u32x4 w; w.x = pk2(h0[0], h0[1]); w.y = pk2(h0[2], h0[3]); w.z = pk2(h1[0], h1[1]); w.w = pk2(h1[2], h1[3]);
                *(u32x4*)(HID + (size_t)(row0 + ai * HALF + m * 16) * DE + col0) = w; }
    }
};
struct EpiDown {
    static constexpr bool PERM = true, SEG = false;
    bf16_t* Y; const float* GV;
    __device__ __forceinline__ void operator()(const f32x4 (&acc)[2][2][4][2], const Unit& u, int wr, int wc, int fr, int fq) const {
        const int row0 = u.pm * BM + wr * 64 + fr, col0 = (u.pn & 3) * BM + wc * 32 + 8 * fq;
#pragma unroll
        for (int ai = 0; ai < 2; ++ai)
#pragma unroll
            for (int m = 0; m < 4; ++m) { const int row = row0 + ai * HALF + m * 16; const float gv = GV[row];
#pragma unroll
                for (int bj = 0; bj < 2; ++bj) { const f32x4 v0 = acc[ai][bj][m][0] * gv, v1 = acc[ai][bj][m][1] * gv;
                    u32x4 w; w.x = pk2(v0[0], v0[1]); w.y = pk2(v0[2], v0[3]); w.z = pk2(v1[0], v1[1]); w.w = pk2(v1[2], v1[3]);
                    *(u32x4*)(Y + (size_t)row * D + col0 + bj * HALF) = w; } }
    }
};
}

#define XB_TMO      128
#define XB_XCNT(j)  (256  + 64 * (j))
#define XB_XSUB(j)  (1280 + 64 * (j))
#define XB_XGEN(j)  (2304 + 64 * (j))
#define XB_TOP      3328
#define XB_TOPGEN   3392
#define XCD_BAR_WORDS 3456
#define XB_SPIN_CAP (1u << 22)
__device__ __forceinline__ unsigned xb_ld(unsigned* p)              { return __hip_atomic_load(p, __ATOMIC_RELAXED, __HIP_MEMORY_SCOPE_AGENT); }
__device__ __forceinline__ unsigned xb_add(unsigned* p, unsigned v) { return __hip_atomic_fetch_add(p, v, __ATOMIC_RELAXED, __HIP_MEMORY_SCOPE_AGENT); }
__device__ __forceinline__ unsigned xb_xcc_id() { return (unsigned)__builtin_amdgcn_s_getreg((3 << 11) | 20) & 0xFu; }
#define XB_SPIN(cond, bar) do { unsigned _sp = 0; while (cond) { __builtin_amdgcn_s_sleep(1); \
    if ((++_sp & 255u) == 0u) { if (xb_ld(&(bar)[XB_TMO])) break; if (_sp > XB_SPIN_CAP) { atomicAdd(&(bar)[XB_TMO], 1u); break; } } } } while (0)
struct XcdBarrier { unsigned* bar; unsigned x; volatile LAS unsigned* st; };
__device__ __forceinline__ XcdBarrier xcd_barrier_post(unsigned* bar, volatile LAS unsigned* st) {
    XcdBarrier b; b.bar = bar; b.x = xb_xcc_id(); b.st = st;
    if (threadIdx.x == 0) (void)xb_add(&bar[XB_XCNT(b.x)], 1u);
    return b;
}
__device__ __forceinline__ void xcd_barrier_complete(unsigned* bar, unsigned x, unsigned& nloc, unsigned& nx) {
    const unsigned G = gridDim.x * gridDim.y * gridDim.z;
    unsigned sum, cnt, mine, sp = 0u;
    for (;;) {
        sum = 0u; cnt = 0u; mine = 0u;
#pragma unroll
        for (unsigned j = 0; j < 16; ++j) { const unsigned c = xb_ld(&bar[XB_XCNT(j)]); sum += c; cnt += (c > 0u) ? 1u : 0u; }
        mine = xb_ld(&bar[XB_XCNT(x)]);
        if (sum == G) break;
        __builtin_amdgcn_s_sleep(1);
        if ((++sp & 255u) == 0u) { if (xb_ld(&bar[XB_TMO])) break; if (sp > XB_SPIN_CAP) { atomicAdd(&bar[XB_TMO], 1u); break; } }
    }
    nloc = mine > 0u ? mine : 1u; nx = cnt > 0u ? cnt : 1u;
}
__device__ __forceinline__ void xcd_barrier(const XcdBarrier& b) {
    asm volatile("s_waitcnt vmcnt(0)" ::: "memory");
    __syncthreads();
    if (threadIdx.x == 0) {
        unsigned* bar = b.bar; asm volatile("" : "+s"(bar));
        __builtin_amdgcn_s_waitcnt(0);
        unsigned nloc = b.st[0], nx = b.st[1];
        if (nloc == 0u) { xcd_barrier_complete(bar, b.x, nloc, nx); b.st[0] = nloc; b.st[1] = nx; }
        const unsigned old = xb_add(&bar[XB_XSUB(b.x)], 1u);
        const unsigned gen = old / nloc;
        if (old + 1u == (gen + 1u) * nloc) {
            __builtin_amdgcn_fence(__ATOMIC_RELEASE, "agent");
            asm volatile("s_waitcnt vmcnt(0)" ::: "memory");
            const unsigned og = xb_add(&bar[XB_TOP], 1u);
            const unsigned tg = og / nx;
            if (og + 1u == (tg + 1u) * nx) xb_add(&bar[XB_TOPGEN], 1u);
            else XB_SPIN(xb_ld(&bar[XB_TOPGEN]) == tg, bar);
            __builtin_amdgcn_fence(__ATOMIC_ACQUIRE, "agent");
            xb_add(&bar[XB_XGEN(b.x)], 1u);
            asm volatile("s_waitcnt vmcnt(0)" ::: "memory");
        } else {
            XB_SPIN(xb_ld(&bar[XB_XGEN(b.x)]) == gen, bar);
            __builtin_amdgcn_fence(__ATOMIC_ACQUIRE, "agent");
            asm volatile("s_waitcnt vmcnt(0)" ::: "memory");
        }
    }
    __syncthreads();
}

struct Args { const float* in[20]; float* out; unsigned char* ws; int ph_lo, ph_hi; };
typedef const __attribute__((address_space(4))) Args* KArgs;
DI KArgs kargs() { KArgs p = (KArgs)__builtin_amdgcn_kernarg_segment_ptr(); asm volatile("" : "+s"(p)); return p; }
struct Ctx {
    float* out; unsigned char* ws;
    int tid, lane, wave, G, bid;
    int layer, slab;
    int nseq, seqlen;
    int stok, sbase;
    int dry;
};
#define WSP(T, off) ((T*)(c.ws + (off)))
#define BIGP(T, off) ((T*)(c.ws + WS_BIG + (off)))

__device__ const float INV_FREQ[32] = {1.000000000e+00f, 7.498942018e-01f, 5.623413324e-01f, 4.216965139e-01f, 3.162277639e-01f, 2.371373773e-01f, 1.778279394e-01f, 1.333521456e-01f, 1.000000015e-01f, 7.498942316e-02f, 5.623413250e-02f, 4.216964915e-02f, 3.162277490e-02f, 2.371373773e-02f, 1.778279431e-02f, 1.333521400e-02f, 9.999999776e-03f, 7.498942316e-03f, 5.623413250e-03f, 4.216964822e-03f, 3.162277630e-03f, 2.371373819e-03f, 1.778279431e-03f, 1.333521446e-03f, 1.000000047e-03f, 7.498941850e-04f, 5.623413017e-04f, 4.216965172e-04f, 3.162277571e-04f, 2.371373703e-04f, 1.778279402e-04f, 1.333521504e-04f};
DI void tr_item(const float* src, long src_ld, int src_col0, int nvalid, int kvalid, bf16_t* dst, long dst_ld, int dst_row0, int k0, LAS float* scr, int lane) {
    float tv[32];
#pragma unroll
    for (int i = 0; i < 32; ++i) { const int kk = 2 * i + (lane >> 5), cc = lane & 31;
        tv[i] = 0.f; if ((k0 + kk) < kvalid && cc < nvalid) tv[i] = src[(size_t)(k0 + kk) * src_ld + src_col0 + cc]; }
#pragma unroll
    for (int i = 0; i < 32; ++i) { const int kk = 2 * i + (lane >> 5), cc = lane & 31; scr[kk * 33 + cc] = tv[i]; }
    asm volatile("s_waitcnt lgkmcnt(0)" ::: "memory");
    const int c8 = lane & 7;
#pragma unroll
    for (int j = 0; j < 4; ++j) { const int n = (lane >> 3) + 8 * j; const LAS float* s = scr + (8 * c8) * 33 + n;
        u32x4 o; o.x = pk2(s[0 * 33], s[1 * 33]); o.y = pk2(s[2 * 33], s[3 * 33]); o.z = pk2(s[4 * 33], s[5 * 33]); o.w = pk2(s[6 * 33], s[7 * 33]);
        *(u32x4*)(dst + (size_t)(dst_row0 + n) * dst_ld + k0 + 8 * c8) = o; }
    asm volatile("s_waitcnt lgkmcnt(0)" ::: "memory");
}
DI void phase_weights(KArgs args, LAS unsigned char* lds, const Ctx& c) {
    const int l = c.layer, lane = c.lane;
    LAS float* scr = (LAS float*)(lds + c.wave * 8448);
    const int gw = c.bid * 8 + c.wave, NGW = c.G * 8;
    constexpr int I_IN = 16 * 208, I_NA = 4 * 32, I_DIL = 2 * 32, I_GDN = 6 * 32, I_OUT = 16 * 32, I_GU1 = 16 * 128, I_D1 = 32 * 32;
    constexpr int NITEMS = I_IN + I_NA + I_DIL + I_GDN + I_OUT + 16 * I_GU1 + 16 * I_D1;
    for (int it = gw; it < NITEMS; it += NGW) {
        int r = it;
        const float* src; long sld; int sc0, nv = 32, kv; bf16_t* dst; long dld; int dr0, k0;
        if (r < I_IN) { const int kb = r / 208, nb = r % 208, n0 = 32 * nb; src = args->in[2] + (size_t)l * D * DIN; sld = DIN; kv = D;
            if (n0 < 3072) { sc0 = 3480 + n0; } else { sc0 = n0 - 3072; nv = DIN - n0; if (nv < 0) { nv = 0; sc0 = 0; } }
            dst = WSP(bf16_t, WS_WIN); dld = D; dr0 = n0; k0 = 64 * kb; }
        else if ((r -= I_IN) < I_NA) { const int kb = r / 32, nb = r % 32; src = args->in[8] + (size_t)l * 256 * D; sld = D; sc0 = 32 * nb; kv = 256; dst = WSP(bf16_t, WS_WBR); dld = 768; dr0 = 32 * nb; k0 = 64 * kb; }
        else if ((r -= I_NA) < I_DIL) { const int kb = r / 32, nb = r % 32; src = args->in[9] + (size_t)l * 128 * D; sld = D; sc0 = 32 * nb; kv = 128; dst = WSP(bf16_t, WS_WBR) + 256; dld = 768; dr0 = 32 * nb; k0 = 64 * kb; }
        else if ((r -= I_DIL) < I_GDN) { const int kb = r / 32, nb = r % 32; src = args->in[10] + (size_t)l * 384 * D; sld = D; sc0 = 32 * nb; kv = 384; dst = WSP(bf16_t, WS_WBR) + 384; dld = 768; dr0 = 32 * nb; k0 = 64 * kb; }
        else if ((r -= I_GDN) < I_OUT) { const int kb = r / 32, nb = r % 32; src = args->in[11] + (size_t)l * D * D; sld = D; sc0 = 32 * nb; kv = D; dst = WSP(bf16_t, WS_WOUT); dld = D; dr0 = 32 * nb; k0 = 64 * kb; }
        else if ((r -= I_OUT) < 16 * I_GU1) { const int e = r / I_GU1, q = r % I_GU1, kb = q / 128, nb = q % 128, n0 = 32 * nb, j = n0 >> 8, rr = n0 & 255;
            src = (rr < 128 ? args->in[16] : args->in[15]) + ((size_t)l * NE + e) * D * DE; sld = DE; sc0 = 128 * j + (rr & 127); kv = D;
            dst = WSP(bf16_t, WS_WGU) + (size_t)e * 4096 * D; dld = D; dr0 = n0; k0 = 64 * kb; }
        else { r -= 16 * I_GU1; const int e = r / I_D1, q = r % I_D1, kb = q / 32, nb = q % 32;
            src = args->in[17] + ((size_t)l * NE + e) * DE * D; sld = D; sc0 = 32 * nb; kv = DE; dst = WSP(bf16_t, WS_WD) + (size_t)e * D * DE; dld = DE; dr0 = 32 * nb; k0 = 64 * kb; }
        tr_item(src, sld, sc0, nv, kv, dst, dld, dr0, k0, scr, lane);
    }
    if (l == 0) {
        for (int t = gw; t < T_ALL; t += NGW) {
            const float* xr = (t < T_P) ? args->in[0] + (size_t)t * D : args->in[1] + (size_t)(t - T_P) * D;
            bf16_t* o = WSP(bf16_t, WS_XB) + (size_t)t * D;
#pragma unroll
            for (int j = 0; j < 4; ++j) { const f32x4 v = *(const f32x4*)(xr + 4 * lane + 256 * j); u32x2 w; w.x = pk2(v[0], v[1]); w.y = pk2(v[2], v[3]); *(u32x2*)(o + 4 * lane + 256 * j) = w; }
        }
        float* cs = WSP(float, WS_CS);
        for (int i = c.bid * 512 + c.tid; i < 16384 * 32; i += c.G * 512) { const int pos = i >> 5, k = i & 31;
            const float inv = INV_FREQ[k];
            const float ang = (float)pos * inv;
            cs[pos * 64 + k] = cosf(ang); cs[pos * 64 + 32 + k] = sinf(ang); }
    }
}

constexpr int TLD = 72, TILEB = 64 * TLD * 2;
DI int tsw(int row) { return ((row >> 4) & 3) << 3; }
template <bool SA = false, bool SB = false> DI f32x16 mm_tile(const LAS bf16_t* A, const LAS bf16_t* Bt, int m0, int n0, int lane) {
    f32x16 acc = zero16(); const int r = lane & 31, hh = lane >> 5; const int sa = SA ? tsw(m0 + r) : 0, sb = SB ? tsw(n0 + r) : 0;
#pragma unroll
    for (int ks = 0; ks < 4; ++ks) { const bf16x8 a = *(const LAS bf16x8*)(A + (m0 + r) * TLD + ((16 * ks + 8 * hh) ^ sa)); const bf16x8 b = *(const LAS bf16x8*)(Bt + (n0 + r) * TLD + ((16 * ks + 8 * hh) ^ sb)); acc = MFMA32(a, b, acc); }
    return acc;
}

constexpr int PI_P0 = 0, PI_P1 = 9216, PI_INTRA = 18432, PI_AM = 27648, PI_TT = 45056, PI_TD0 = 54272, PI_TD1 = 60416, PI_PM = 65024, PI_VEC = 71168, PI_BYTES = 72704;
constexpr int PI_WT = PI_AM, PI_UT = PI_TD0;
DI void gdn_prep_pair(KArgs args, LAS unsigned char* L0, const Ctx& c, int pu) {
    int tid = c.tid; asm volatile("" : "+v"(tid)); const int lane = tid & 63, wave = __builtin_amdgcn_readfirstlane(tid >> 6), l = c.layer;
    const int dir = wave >> 2, wg = wave & 3, tg = tid & 255, head = pu % 6, gch = pu / 6, inst = (gch * 6 + head) * 2 + dir;
    const int cps = c.seqlen >> 6, seq = gch / cps, n = gch % cps;
    const bf16_t* PROJ = BIGP(bf16_t, B_PROJ); const float* BA = BIGP(float, B_BA);
    unsigned char* G = BIGP(unsigned char, B_GSCR) + (size_t)inst * GSTRIDE;
    LAS unsigned char* L = L0 + dir * PI_BYTES;
    LAS bf16_t* P0 = (LAS bf16_t*)(L + PI_P0); LAS bf16_t* P1 = (LAS bf16_t*)(L + PI_P1); LAS bf16_t* INTRA = (LAS bf16_t*)(L + PI_INTRA);
    LAS float* AM = (LAS float*)(L + PI_AM); LAS bf16_t* TT = (LAS bf16_t*)(L + PI_TT);
    LAS float* TD0 = (LAS float*)(L + PI_TD0); LAS float* TD1 = (LAS float*)(L + PI_TD1); LAS float* PM = (LAS float*)(L + PI_PM);
    LAS float* GV = (LAS float*)(L + PI_VEC); LAS float* BV = GV + 64; LAS float* GC = GV + 128;
    LAS bf16_t* WT = (LAS bf16_t*)(L + PI_WT); LAS bf16_t* UT = (LAS bf16_t*)(L + PI_UT);
    const int ia = tg >> 3, p = tg & 7;
    float q[2][8], k[2][8], v[2][8];
#pragma unroll
    for (int h2 = 0; h2 < 2; ++h2)
#pragma unroll
        for (int j = 0; j < 8; ++j) { q[h2][j] = 0.f; k[h2][j] = 0.f; v[h2][j] = 0.f; }
    const float* cw = args->in[4] + (size_t)l * 5 * 1152 + 64 * head + 8 * p;
#pragma unroll
    for (int tp = 0; tp < 5; ++tp) { const float* w = cw + tp * 1152;
        const f32x4 wq0 = *(const f32x4*)w, wq1 = *(const f32x4*)(w + 4), wk0 = *(const f32x4*)(w + 384), wk1 = *(const f32x4*)(w + 388), wv0 = *(const f32x4*)(w + 768), wv1 = *(const f32x4*)(w + 772);
#pragma unroll
        for (int h2 = 0; h2 < 2; ++h2) { const int i = ia + 32 * h2, tokl = dir ? 63 - i : i, pp = n * 64 + tokl + tp - 2;
            if (pp >= 0 && pp < c.seqlen) { const bf16_t* rp = PROJ + (size_t)(seq * c.seqlen + pp) * NPROJ + 64 * head + 8 * p;
                const u32x4 rq = *(const u32x4*)(rp + C_QC), rk = *(const u32x4*)(rp + C_KC), rv = *(const u32x4*)(rp + C_VC);
#pragma unroll
                for (int j = 0; j < 4; ++j) { const float a0 = (j < 2) ? wq0[2 * j] : wq1[2 * j - 4], a1 = (j < 2) ? wq0[2 * j + 1] : wq1[2 * j - 3];
                    const float b0 = (j < 2) ? wk0[2 * j] : wk1[2 * j - 4], b1 = (j < 2) ? wk0[2 * j + 1] : wk1[2 * j - 3];
                    const float c0 = (j < 2) ? wv0[2 * j] : wv1[2 * j - 4], c1 = (j < 2) ? wv0[2 * j + 1] : wv1[2 * j - 3];
                    q[h2][2 * j] += a0 * bflo(rq[j]); q[h2][2 * j + 1] += a1 * bfhi(rq[j]);
                    k[h2][2 * j] += b0 * bflo(rk[j]); k[h2][2 * j + 1] += b1 * bfhi(rk[j]);
                    v[h2][2 * j] += c0 * bflo(rv[j]); v[h2][2 * j + 1] += c1 * bfhi(rv[j]); } } } }
#pragma unroll
    for (int h2 = 0; h2 < 2; ++h2) { float sq = 0.f, sk = 0.f;
#pragma unroll
        for (int j = 0; j < 8; ++j) { q[h2][j] = siluf_(q[h2][j]); k[h2][j] = siluf_(k[h2][j]); v[h2][j] = siluf_(v[h2][j]); sq += q[h2][j] * q[h2][j]; sk += k[h2][j] * k[h2][j]; }
        sq += __shfl_xor(sq, 1); sq += __shfl_xor(sq, 2); sq += __shfl_xor(sq, 4);
        sk += __shfl_xor(sk, 1); sk += __shfl_xor(sk, 2); sk += __shfl_xor(sk, 4);
        const float rq_ = 0.125f * frsq(sq + NORM_EPS), rk_ = frsq(sk + NORM_EPS);
#pragma unroll
        for (int j = 0; j < 8; ++j) { q[h2][j] *= rq_; k[h2][j] *= rk_; }
        if (p == 0) { const int i = ia + 32 * h2, tokl = dir ? 63 - i : i; const float* bar = BA + (size_t)(seq * c.seqlen + n * 64 + tokl) * 32;
            const float bl = bar[dir * 6 + head], al = bar[12 + dir * 6 + head];
            const float xx = al + args->in[6][l * 12 + dir * 6 + head];
            const float sp = xx > 20.f ? xx : log1pf(expf(xx));
            GV[i] = -expf(args->in[5][l * 12 + dir * 6 + head]) * sp; BV[i] = sigmoidf_(bl); } }
    __syncthreads();
    float gcl_;
    { float x = GV[lane];
#pragma unroll
        for (int o = 1; o < 64; o <<= 1) { const float y = __shfl_up(x, o); if (lane >= o) x += y; }
        if (wg == 0) GC[lane] = x;
        gcl_ = x; }
    const float gc0 = __shfl(gcl_, ia), gc1 = __shfl(gcl_, ia + 32), gcl = __shfl(gcl_, 63);
#pragma unroll
    for (int h2 = 0; h2 < 2; ++h2) { const int i = ia + 32 * h2; u32x4 wq, wk;
#pragma unroll
        for (int j = 0; j < 4; ++j) { wq[j] = pk2(q[h2][2 * j], q[h2][2 * j + 1]); wk[j] = pk2(k[h2][2 * j], k[h2][2 * j + 1]); }
        *(LAS u32x4*)(P0 + i * TLD + 8 * p) = wq; *(LAS u32x4*)(P1 + i * TLD + 8 * p) = wk; }
    __syncthreads();
    { const int mat = wg >> 1, mt = wg & 1, hh = lane >> 5;
#pragma unroll
        for (int nt = 0; nt < 2; ++nt) { const int jc = 32 * nt + (lane & 31);
            const f32x16 a = mm_tile(mat ? P0 : P1, P1, 32 * mt, 32 * nt, lane);
            const float gj = GC[jc];
#pragma unroll
            for (int r = 0; r < 16; ++r) { const int ii = 32 * mt + crow(r, hh); const float gi = GC[ii];
                if (mat == 0) AM[ii * 68 + jc] = (jc < ii) ? BV[ii] * a[r] * __expf(gi - gj) : 0.f;
                else INTRA[ii * TLD + jc] = (bf16_t)(pk2((jc <= ii) ? a[r] * __expf(gi - gj) : 0.f, 0.f) & 0xffffu); } } }
    __syncthreads();
    if (wg == dir) {
        const int b = lane >> 5, cidx = lane & 31; float t[32];
#pragma unroll
        for (int ii = 0; ii < 32; ++ii) t[ii] = (ii == cidx) ? 1.f : 0.f;
        const LAS float* Ab = AM + (32 * b) * 68 + 32 * b;
#pragma unroll
        for (int ii = 1; ii < 32; ++ii) { float acc = 0.f;
#pragma unroll
            for (int j4 = 0; j4 < ii; j4 += 4) { const f32x4 a4 = *(const LAS f32x4*)(Ab + ii * 68 + j4);
                acc += a4[0] * t[j4]; acc += a4[1] * t[j4 + 1]; acc += a4[2] * t[j4 + 2]; acc += a4[3] * t[j4 + 3]; }
            t[ii] -= acc; }
        LAS float* td = b ? TD1 : TD0; const int tds = b ? 36 : 48;
#pragma unroll
        for (int ii = 0; ii < 32; ++ii) { td[ii * tds + cidx] = t[ii]; TT[(32 * b + ii) * TLD + 32 * b + cidx] = (bf16_t)(pk2(t[ii], 0.f) & 0xffffu); }
    }
#pragma unroll
    for (int h2 = 0; h2 < 2; ++h2) { const int i = ia + 32 * h2; const float be = BV[i], eg = __expf(h2 ? gc1 : gc0);
#pragma unroll
        for (int j = 0; j < 8; ++j) { const int d = 8 * p + j, o_ = d * TLD + (i ^ tsw(d)); P0[o_] = (bf16_t)(pk2(k[h2][j] * be * eg, 0.f) & 0xffffu); P1[o_] = (bf16_t)(pk2(v[h2][j] * be, 0.f) & 0xffffu); } }
    { unsigned zz; asm volatile("v_mov_b32 %0, 0" : "=v"(zz)); u32x2 z; z.x = zz; z.y = zz; *(LAS u32x2*)(TT + (tg >> 3) * TLD + 32 + 4 * (tg & 7)) = z; }
    __syncthreads();
    { const int qi = wg >> 1, qj = wg & 1, r16 = lane & 15, g4 = lane >> 4; f32x4 pc = {0.f, 0.f, 0.f, 0.f};
#pragma unroll
        for (int kk = 0; kk < 8; ++kk) pc = __builtin_amdgcn_mfma_f32_16x16x4f32(AM[(32 + 16 * qi + r16) * 68 + 4 * kk + g4], TD0[(4 * kk + g4) * 48 + 16 * qj + r16], pc, 0, 0, 0);
#pragma unroll
        for (int r = 0; r < 4; ++r) PM[(16 * qi + 4 * g4 + r) * 48 + 16 * qj + r16] = pc[r]; }
    __syncthreads();
    { const int qi = wg >> 1, qj = wg & 1, r16 = lane & 15, g4 = lane >> 4; f32x4 pc = {0.f, 0.f, 0.f, 0.f};
#pragma unroll
        for (int kk = 0; kk < 8; ++kk) pc = __builtin_amdgcn_mfma_f32_16x16x4f32(TD1[(16 * qi + r16) * 36 + 4 * kk + g4], PM[(4 * kk + g4) * 48 + 16 * qj + r16], pc, 0, 0, 0);
#pragma unroll
        for (int r = 0; r < 4; ++r) TT[(32 + 16 * qi + 4 * g4 + r) * TLD + 16 * qj + r16] = (bf16_t)(pk2(-pc[r], 0.f) & 0xffffu); }
    __syncthreads();
    { const int which = wg >> 1, mt = wg & 1, hh = lane >> 5;
#pragma unroll
        for (int nt = 0; nt < 2; ++nt) { const int dc = 32 * nt + (lane & 31);
            const f32x16 a = mm_tile<false, true>(TT, which ? P1 : P0, 32 * mt, 32 * nt, lane);
            LAS bf16_t* dst = (which ? UT : WT) + dc * TLD; const int sw = tsw(dc);
#pragma unroll
            for (int g = 0; g < 4; ++g) { u32x2 w; w.x = pk2(a[4 * g], a[4 * g + 1]); w.y = pk2(a[4 * g + 2], a[4 * g + 3]); *(LAS u32x2*)(dst + ((32 * mt + 8 * g + 4 * hh) ^ sw)) = w; } } }
    __syncthreads();
#pragma unroll
    for (int h2 = 0; h2 < 2; ++h2) { const int i = ia + 32 * h2; const float gci = h2 ? gc1 : gc0, eg = __expf(gci), ekd = __expf(gcl - gci); u32x4 wqd;
#pragma unroll
        for (int j = 0; j < 4; ++j) wqd[j] = pk2(q[h2][2 * j] * eg, q[h2][2 * j + 1] * eg);
        *(LAS u32x4*)(P1 + i * TLD + 8 * p) = wqd;
#pragma unroll
        for (int j = 0; j < 8; ++j) { const int d = 8 * p + j; P0[d * TLD + (i ^ tsw(d))] = (bf16_t)(pk2(k[h2][j] * ekd, 0.f) & 0xffffu); } }
    __syncthreads();
    { const int hh = lane >> 5, rr = lane & 31;
        if (wg == 0) {
#pragma unroll
            for (int t4 = 0; t4 < 4; ++t4) { const int mtb = t4 >> 1, nta = t4 & 1; const f32x16 a = mm_tile<true, true>(WT, P0, 32 * mtb, 32 * nta, lane);
                f32x16 na; for (int r = 0; r < 16; ++r) na[r] = -a[r];
                *(bf16x8*)(G + (size_t)((nta * 4 + 2 * mtb) * 64 + lane) * 16) = pack8<0>(na); *(bf16x8*)(G + (size_t)((nta * 4 + 2 * mtb + 1) * 64 + lane) * 16) = pack8<1>(na); }
        } else if (wg == 1) {
#pragma unroll
            for (int t4 = 0; t4 < 4; ++t4) { const int mta = t4 >> 1, nte = t4 & 1; const f32x16 a = mm_tile<true, true>(P0, UT, 32 * mta, 32 * nte, lane);
                bf16x8* dp = (bf16x8*)(G + 8192 + (size_t)((nte * 2 + mta) * 64 + lane) * 32); dp[0] = pack8<0>(a); dp[1] = pack8<1>(a); }
        } else if (wg == 2) {
#pragma unroll
            for (int t4 = 0; t4 < 4; ++t4) { const int mtb = t4 >> 1, nti = t4 & 1; const f32x16 a = mm_tile<true, false>(WT, INTRA, 32 * mtb, 32 * nti, lane);
                f32x16 qe; const LAS bf16_t* qd = P1 + (32 * nti + rr) * TLD + 32 * mtb + 4 * hh;
#pragma unroll
                for (int g = 0; g < 4; ++g) { const u32x2 w = *(const LAS u32x2*)(qd + 8 * g); qe[4 * g] = bflo(w.x) - a[4 * g]; qe[4 * g + 1] = bfhi(w.x) - a[4 * g + 1]; qe[4 * g + 2] = bflo(w.y) - a[4 * g + 2]; qe[4 * g + 3] = bfhi(w.y) - a[4 * g + 3]; }
                *(bf16x8*)(G + 16384 + (size_t)((nti * 4 + 2 * mtb) * 64 + lane) * 16) = pack8<0>(qe); *(bf16x8*)(G + 16384 + (size_t)((nti * 4 + 2 * mtb + 1) * 64 + lane) * 16) = pack8<1>(qe); }
        } else {
#pragma unroll
            for (int t4 = 0; t4 < 4; ++t4) { const int mti = t4 >> 1, nte = t4 & 1; const f32x16 a = mm_tile<false, true>(INTRA, UT, 32 * mti, 32 * nte, lane);
                bf16_t* dst = (bf16_t*)(G + 24576) + (size_t)(32 * nte + rr) * 64 + 32 * mti + 4 * hh;
#pragma unroll
                for (int g = 0; g < 4; ++g) { u32x2 w; w.x = pk2(a[4 * g], a[4 * g + 1]); w.y = pk2(a[4 * g + 2], a[4 * g + 3]); *(u32x2*)(dst + 8 * g) = w; } }
            if (lane == 0) *(float*)(G + 40960) = __expf(gcl);
        } }
    __syncthreads();
}

DI void pv_accum(const f32x16 (&acc)[2][2], f32x16 (&o)[2][2], const LAS bf16_t* Vt, int lane) {
    const int r = lane & 31, hh = lane >> 5;
#pragma unroll
    for (int mt = 0; mt < 2; ++mt) {
        {   const bf16x8 p0 = pack8<0>(acc[mt][0]), p1 = pack8<0>(acc[mt][1]);
#pragma unroll
            for (int mo = 0; mo < 2; ++mo) { const LAS bf16_t* s = Vt + (32 * mo + r) * TLD; const int c0 = (32 * mt + 4 * hh) ^ tsw(32 * mo + r);
                const u32x2 lo = *(const LAS u32x2*)(s + c0), hi = *(const LAS u32x2*)(s + (c0 ^ 8)); u32x4 w; w.x = lo.x; w.y = lo.y; w.z = hi.x; w.w = hi.y; const bf16x8 vf = __builtin_bit_cast(bf16x8, w);
                o[mo][0] = MFMA32(vf, p0, o[mo][0]); o[mo][1] = MFMA32(vf, p1, o[mo][1]); } }
        {   const bf16x8 p0 = pack8<1>(acc[mt][0]), p1 = pack8<1>(acc[mt][1]);
#pragma unroll
            for (int mo = 0; mo < 2; ++mo) { const LAS bf16_t* s = Vt + (32 * mo + r) * TLD; const int c0 = (32 * mt + 16 + 4 * hh) ^ tsw(32 * mo + r);
                const u32x2 lo = *(const LAS u32x2*)(s + c0), hi = *(const LAS u32x2*)(s + (c0 ^ 8)); u32x4 w; w.x = lo.x; w.y = lo.y; w.z = hi.x; w.w = hi.y; const bf16x8 vf = __builtin_bit_cast(bf16x8, w);
                o[mo][0] = MFMA32(vf, p0, o[mo][0]); o[mo][1] = MFMA32(vf, p1, o[mo][1]); } }
    }
}
template <class F> DI void stage_vt(LAS bf16_t* Vt, int lane, F vrow) {
#pragma unroll
    for (int it = 0; it < 8; ++it) { const int id = it * 64 + lane, key = id >> 3, part = id & 7;
        const u32x4 w = *(const u32x4*)(vrow(key) + 8 * part);
#pragma unroll
        for (int j = 0; j < 4; ++j) { const int d0 = 8 * part + 2 * j, ks_ = key ^ tsw(d0); Vt[d0 * TLD + ks_] = (bf16_t)(w[j] & 0xffffu); Vt[(d0 + 1) * TLD + ks_] = (bf16_t)(w[j] >> 16); } }
}
DI void write_o_slot(LAS float* SL, const f32x16 (&o)[2][2], int lane) {
    const int r = lane & 31, hh = lane >> 5;
#pragma unroll
    for (int mo = 0; mo < 2; ++mo)
#pragma unroll
        for (int nt = 0; nt < 2; ++nt)
#pragma unroll
            for (int g = 0; g < 4; ++g) { f32x4 v; v[0] = o[mo][nt][4 * g]; v[1] = o[mo][nt][4 * g + 1]; v[2] = o[mo][nt][4 * g + 2]; v[3] = o[mo][nt][4 * g + 3];
                *(LAS f32x4*)(SL + (32 * nt + r) * 68 + 32 * mo + 8 * g + 4 * hh) = v; }
}
DI void add_o_slot(const LAS float* SL, f32x16 (&o)[2][2], int lane) {
    const int r = lane & 31, hh = lane >> 5;
#pragma unroll
    for (int mo = 0; mo < 2; ++mo)
#pragma unroll
        for (int nt = 0; nt < 2; ++nt)
#pragma unroll
            for (int g = 0; g < 4; ++g) { const f32x4 v = *(const LAS f32x4*)(SL + (32 * nt + r) * 68 + 32 * mo + 8 * g + 4 * hh);
                o[mo][nt][4 * g] += v[0]; o[mo][nt][4 * g + 1] += v[1]; o[mo][nt][4 * g + 2] += v[2]; o[mo][nt][4 * g + 3] += v[3]; }
}

constexpr int WAREA = 10240;
DI void osm_update(f32x16 (&acc)[2][2], f32x16 (&o)[2][2], float (&m)[2], float (&l)[2]) {
#pragma unroll
    for (int nt = 0; nt < 2; ++nt) { float mx = -1e30f;
#pragma unroll
        for (int mt = 0; mt < 2; ++mt)
#pragma unroll
            for (int g = 0; g < 16; ++g) mx = fmaxf(mx, acc[mt][nt][g]);
        mx = fmaxf(mx, __shfl_xor(mx, 32));
        const float mn = fmaxf(m[nt], mx), sc = __expf(m[nt] - mn); float sm = 0.f;
#pragma unroll
        for (int mt = 0; mt < 2; ++mt)
#pragma unroll
            for (int g = 0; g < 16; ++g) { const float pz = __expf(acc[mt][nt][g] - mn); acc[mt][nt][g] = pz; sm += pz; }
        sm += __shfl_xor(sm, 32);
        l[nt] = l[nt] * sc + sm; m[nt] = mn;
#pragma unroll
        for (int g = 0; g < 16; ++g) { o[0][nt][g] *= sc; o[1][nt][g] *= sc; } }
}
template <class F> DI void store_o_rows(LAS bf16_t* T, const f32x16 (&o)[2][2], const float (&scale)[2], int lane, F rowp) {
    const int r = lane & 31, hh = lane >> 5;
#pragma unroll
    for (int mo = 0; mo < 2; ++mo)
#pragma unroll
        for (int nt = 0; nt < 2; ++nt)
#pragma unroll
            for (int g = 0; g < 4; ++g) { u32x2 w; w.x = pk2(o[mo][nt][4 * g] * scale[nt], o[mo][nt][4 * g + 1] * scale[nt]); w.y = pk2(o[mo][nt][4 * g + 2] * scale[nt], o[mo][nt][4 * g + 3] * scale[nt]);
                *(LAS u32x2*)(T + (32 * nt + r) * TLD + 32 * mo + 8 * g + 4 * hh) = w; }
    asm volatile("s_waitcnt lgkmcnt(0)" ::: "memory");
#pragma unroll
    for (int it = 0; it < 8; ++it) { const int id = it * 64 + lane, q = id >> 3, part = id & 7; *(u32x4*)(rowp(q) + 8 * part) = *(const LAS u32x4*)(T + q * TLD + 8 * part); }
    asm volatile("s_waitcnt lgkmcnt(0)" ::: "memory");
}
DI void na_wave_unit(KArgs args, LAS unsigned char* L, const Ctx& c, int u, int lane, int wave) {
    const int l = c.layer, head = u & 3, gr = u >> 2, rows = c.seqlen >> 6, seq = gr / rows, r = gr % rows;
    int rs = r - 4; rs = rs < 0 ? 0 : (rs > rows - 8 ? rows - 8 : rs);
    const bf16_t* PROJ = BIGP(bf16_t, B_PROJ);
    const size_t tq0 = (size_t)seq * c.seqlen + (size_t)r * 64;
    LAS bf16_t* Vt = (LAS bf16_t*)(L + wave * WAREA);
    LAS float* BIAS = (LAS float*)(L + wave * WAREA + 9216);
    const int rr = lane & 31, hh = lane >> 5;
#pragma unroll
    for (int w = 0; w < 4; ++w) { const int idx = w * 64 + lane, kw = idx >> 5, dc = idx & 31;
        if (dc < 31) BIAS[idx] = args->in[3][(((size_t)l * 4 + head) * 15 + (rs + kw - r + 7)) * 31 + dc]; }
    bf16x8 qf[2][4];
#pragma unroll
    for (int nt = 0; nt < 2; ++nt)
#pragma unroll
        for (int ks = 0; ks < 4; ++ks) qf[nt][ks] = *(const bf16x8*)(PROJ + (tq0 + 32 * nt + rr) * NPROJ + C_QA + 64 * head + 16 * ks + 8 * hh);
    f32x16 o[2][2]; o[0][0] = zero16(); o[0][1] = zero16(); o[1][0] = zero16(); o[1][1] = zero16();
    float m[2] = {-1e30f, -1e30f}, ls[2] = {0.f, 0.f};
    for (int w = 0; w < 8; ++w) {
        const size_t tk0 = (size_t)seq * c.seqlen + (size_t)(rs + w) * 64;
        asm volatile("s_waitcnt lgkmcnt(0)" ::: "memory");
        stage_vt(Vt, lane, [&](int key) { return PROJ + (tk0 + key) * NPROJ + C_VA + 64 * head; });
        f32x16 acc[2][2]; acc[0][0] = zero16(); acc[0][1] = zero16(); acc[1][0] = zero16(); acc[1][1] = zero16();
#pragma unroll
        for (int mt = 0; mt < 2; ++mt)
#pragma unroll
            for (int ks = 0; ks < 4; ++ks) { const bf16x8 kf = *(const bf16x8*)(PROJ + (tk0 + 32 * mt + rr) * NPROJ + C_KA + 64 * head + 16 * ks + 8 * hh);
                acc[mt][0] = MFMA32(kf, qf[0][ks], acc[mt][0]); acc[mt][1] = MFMA32(kf, qf[1][ks], acc[mt][1]); }
        asm volatile("s_waitcnt lgkmcnt(0)" ::: "memory");
        const LAS float* brow = BIAS + w * 32;
#pragma unroll
        for (int nt = 0; nt < 2; ++nt) { const int qc = 32 * nt + rr; int ws = qc - 8; ws = ws < 0 ? 0 : (ws > 48 ? 48 : ws);
#pragma unroll
            for (int mt = 0; mt < 2; ++mt)
#pragma unroll
                for (int g = 0; g < 16; ++g) { const int kc = 32 * mt + crow(g, hh); const bool ok = (kc >= ws) && (kc < ws + 16);
                    acc[mt][nt][g] = ok ? acc[mt][nt][g] * 0.125f + brow[ok ? (kc - qc + 15) : 0] : -1e30f; } }
        osm_update(acc, o, m, ls);
        pv_accum(acc, o, Vt, lane);
    }
    asm volatile("s_waitcnt lgkmcnt(0)" ::: "memory");
    const float sc[2] = {frcp(ls[0]), frcp(ls[1])};
    store_o_rows(Vt, o, sc, lane, [&](int q) { return BIGP(bf16_t, B_ONA) + (tq0 + q) * 768 + 64 * head; });
}
DI void rope_frag4(bf16x8 (&f)[4], const float* cs, int hh) {
#pragma unroll
    for (int ks = 0; ks < 2; ++ks) { const float* cp = cs + 16 * ks + 8 * hh;
        const f32x4 c0 = *(const f32x4*)cp, c1 = *(const f32x4*)(cp + 4), s0 = *(const f32x4*)(cp + 32), s1 = *(const f32x4*)(cp + 36);
        const u32x4 a = __builtin_bit_cast(u32x4, f[ks]), b = __builtin_bit_cast(u32x4, f[ks + 2]); u32x4 ra, rb;
#pragma unroll
        for (int j = 0; j < 4; ++j) { const float cl = (j < 2) ? c0[2 * j] : c1[2 * j - 4], ch = (j < 2) ? c0[2 * j + 1] : c1[2 * j - 3];
            const float sl = (j < 2) ? s0[2 * j] : s1[2 * j - 4], sh = (j < 2) ? s0[2 * j + 1] : s1[2 * j - 3];
            const float x1l = bflo(a[j]), x1h = bfhi(a[j]), x2l = bflo(b[j]), x2h = bfhi(b[j]);
            ra[j] = pk2(x1l * cl - x2l * sl, x1h * ch - x2h * sh); rb[j] = pk2(x1l * sl + x2l * cl, x1h * sh + x2h * ch); }
        f[ks] = __builtin_bit_cast(bf16x8, ra); f[ks + 2] = __builtin_bit_cast(bf16x8, rb); }
}
DI void dil_wave_unit(KArgs args, LAS unsigned char* L, const Ctx& c, int u, int lane, int wave) {
    const int hd = u & 1, uu = u >> 1, upg = c.stok >> 6, g = uu / upg, v = uu % upg, ups = c.seqlen >> 6, seq = v / ups, wq = v % ups;
    const int dsh = 2 * g, dd = 1 << dsh, nb = ups >> dsh, cls = wq / nb, jb = wq % nb, head = 2 * g + hd;
    const bf16_t* PROJ = BIGP(bf16_t, B_PROJ); const float* CS = WSP(float, WS_CS);
    const size_t sb = (size_t)seq * c.seqlen;
    const int rr = lane & 31, hh = lane >> 5;
    LAS bf16_t* Vt = (LAS bf16_t*)(L + wave * WAREA);
    bf16x8 qf[2][4];
#pragma unroll
    for (int nt = 0; nt < 2; ++nt) { const int pos = cls + dd * (64 * jb + 32 * nt + rr);
#pragma unroll
        for (int ks = 0; ks < 4; ++ks) qf[nt][ks] = *(const bf16x8*)(PROJ + (sb + pos) * NPROJ + C_QD + 64 * head + 16 * ks + 8 * hh);
        rope_frag4(qf[nt], CS + (size_t)pos * 64, hh); }
    f32x16 o[2][2]; o[0][0] = zero16(); o[0][1] = zero16(); o[1][0] = zero16(); o[1][1] = zero16();
    float m[2] = {-1e30f, -1e30f}, ls[2] = {0.f, 0.f};
    for (int kt = 0; kt < 3; ++kt) { const int kj = jb - 1 + kt;
        if (kj < 0 || kj >= nb) continue;
        asm volatile("s_waitcnt lgkmcnt(0)" ::: "memory");
        stage_vt(Vt, lane, [&](int key) { return PROJ + (sb + cls + (size_t)dd * (64 * kj + key)) * NPROJ + C_VD + 64 * head; });
        f32x16 acc[2][2]; acc[0][0] = zero16(); acc[0][1] = zero16(); acc[1][0] = zero16(); acc[1][1] = zero16();
#pragma unroll
        for (int mt = 0; mt < 2; ++mt) { const int pos = cls + dd * (64 * kj + 32 * mt + rr); bf16x8 kf[4];
#pragma unroll
            for (int ks = 0; ks < 4; ++ks) kf[ks] = *(const bf16x8*)(PROJ + (sb + pos) * NPROJ + C_KD + 64 * head + 16 * ks + 8 * hh);
            rope_frag4(kf, CS + (size_t)pos * 64, hh);
#pragma unroll
            for (int ks = 0; ks < 4; ++ks) { acc[mt][0] = MFMA32(kf[ks], qf[0][ks], acc[mt][0]); acc[mt][1] = MFMA32(kf[ks], qf[1][ks], acc[mt][1]); } }
#pragma unroll
        for (int nt = 0; nt < 2; ++nt) { const int qc = 32 * nt + rr;
#pragma unroll
            for (int mt = 0; mt < 2; ++mt)
#pragma unroll
                for (int gg = 0; gg < 16; ++gg) { const int kc = 32 * mt + crow(gg, hh); const bool ok = (kt == 1) || (kt == 0 ? (kc >= qc) : (kc <= qc));
                    acc[mt][nt][gg] = ok ? acc[mt][nt][gg] * 0.125f : -1e30f; } }
        osm_update(acc, o, m, ls);
        pv_accum(acc, o, Vt, lane);
    }
    asm volatile("s_waitcnt lgkmcnt(0)" ::: "memory");
    bf16_t* DP = BIGP(bf16_t, B_DILP); float* DM = BIGP(float, B_DILM);
    const float one[2] = {1.f, 1.f};
    store_o_rows(Vt, o, one, lane, [&](int q) { return DP + ((((size_t)g * SLABMAX + sb + cls + (size_t)dd * (64 * jb + q)) * 2 + hd)) * 64; });
    if (hh == 0) {
#pragma unroll
        for (int nt = 0; nt < 2; ++nt) { const size_t base = (((size_t)g * SLABMAX + sb + cls + (size_t)dd * (64 * jb + 32 * nt + rr)) * 2 + hd); DM[base * 2] = m[nt]; DM[base * 2 + 1] = ls[nt]; } }
}

DI void phase_mix_a(KArgs args, LAS unsigned char* L, const Ctx& c) {
    const int N_PREP = (c.stok >> 6) * 6;
    for (int u = c.bid; u < N_PREP; u += c.G) gdn_prep_pair(args, L, c, u);
}
DI void attn_wave_units(KArgs args, LAS unsigned char* L, const Ctx& c) {
    int tid = c.tid; asm volatile("" : "+v"(tid)); const int lane = tid & 63, wave = __builtin_amdgcn_readfirstlane(tid >> 6);
    const int nch_ = c.stok >> 6, N_NA = nch_ * 4, N_DIL = nch_ * 6;
    unsigned* q = (unsigned*)(c.ws + WS_CTL) + 32768 + 128 * (c.layer * 4 + c.slab);
    for (;;) { unsigned u = 0; if (lane == 0) u = __hip_atomic_fetch_add(q, 1u, __ATOMIC_RELAXED, __HIP_MEMORY_SCOPE_AGENT);
        u = (unsigned)__builtin_amdgcn_readfirstlane((int)u); if (u >= (unsigned)N_NA) break; na_wave_unit(args, L, c, (int)u, lane, wave); }
    int tid2 = c.tid; asm volatile("" : "+v"(tid2)); const int lane2 = tid2 & 63, wave2 = __builtin_amdgcn_readfirstlane(tid2 >> 6);
    for (;;) { unsigned u = 0; if (lane2 == 0) u = __hip_atomic_fetch_add(q + 64, 1u, __ATOMIC_RELAXED, __HIP_MEMORY_SCOPE_AGENT);
        u = (unsigned)__builtin_amdgcn_readfirstlane((int)u); if (u >= (unsigned)N_DIL) break; dil_wave_unit(args, L, c, (int)u, lane2, wave2); }
}

DI void phase_scan(KArgs args, LAS unsigned char* L, const Ctx& c) {
    const int nwu = c.nseq * 24, wu = c.bid;
    if (wu < nwu && c.wave == 0) {
        const int lane = c.lane, rr = lane & 31, hh = lane >> 5;
        const int chain = wu >> 1, nt = wu & 1, seq = chain / 12, rem = chain % 12, head = rem >> 1, dir = rem & 1;
        const int nch = c.seqlen >> 6, gch0 = seq * nch;
        unsigned char* GS = BIGP(unsigned char, B_GSCR);
        f32x16 S[2]; S[0] = zero16(); S[1] = zero16();
        bf16x8 A[2][2][4]; u32x4 cm[2][2][2]; float gl[2];
        const long gstep = (long)(dir ? -1 : 1) * 12 * GSTRIDE;
        const unsigned char* Gp = GS + (size_t)(((gch0 + (dir ? nch - 1 : 0)) * 6 + head) * 2 + dir) * GSTRIDE;
        unsigned char* Gs = (unsigned char*)Gp;
#define SCAN_LOAD(B) do { _Pragma("unroll") for (int mt = 0; mt < 2; ++mt) { _Pragma("unroll") for (int ks = 0; ks < 4; ++ks) A[B][mt][ks] = *(const bf16x8*)(Gp + (size_t)((mt * 4 + ks) * 64 + lane) * 16); \
            const u32x4* cp = (const u32x4*)(Gp + 8192 + (size_t)((nt * 2 + mt) * 64 + lane) * 32); cm[B][mt][0] = cp[0]; cm[B][mt][1] = cp[1]; } gl[B] = *(const float*)(Gp + 40960); } while (0)
#define SCAN_STEP(B) do { { bf16_t* St = (bf16_t*)(Gs + 32768) + (size_t)(32 * nt + rr) * 64 + 4 * hh; \
            _Pragma("unroll") for (int mt = 0; mt < 2; ++mt) _Pragma("unroll") for (int g = 0; g < 4; ++g) { u32x2 w; w.x = pk2(S[mt][4 * g], S[mt][4 * g + 1]); w.y = pk2(S[mt][4 * g + 2], S[mt][4 * g + 3]); *(u32x2*)(St + 32 * mt + 8 * g) = w; } } \
            const bf16x8 b0 = pack8<0>(S[0]), b1 = pack8<1>(S[0]), b2 = pack8<0>(S[1]), b3 = pack8<1>(S[1]); f32x16 nw[2]; \
            _Pragma("unroll") for (int mt = 0; mt < 2; ++mt) { \
                _Pragma("unroll") for (int g = 0; g < 8; ++g) { const unsigned wv = (g < 4) ? cm[B][mt][0][g] : cm[B][mt][1][g - 4]; nw[mt][2 * g] = gl[B] * S[mt][2 * g] + bflo(wv); nw[mt][2 * g + 1] = gl[B] * S[mt][2 * g + 1] + bfhi(wv); } \
                nw[mt] = MFMA32(A[B][mt][0], b0, nw[mt]); nw[mt] = MFMA32(A[B][mt][1], b1, nw[mt]); nw[mt] = MFMA32(A[B][mt][2], b2, nw[mt]); nw[mt] = MFMA32(A[B][mt][3], b3, nw[mt]); } \
            S[0] = nw[0]; S[1] = nw[1]; Gs += gstep; } while (0)
        SCAN_LOAD(0); Gp += gstep; SCAN_LOAD(1); Gp += gstep;
        for (int step = 0; step < nch; step += 2) {
            const bool more = step + 2 < nch;
            if (!more) Gp -= 2 * gstep;
            SCAN_STEP(0); SCAN_LOAD(0); Gp += gstep;
            SCAN_STEP(1); SCAN_LOAD(1); Gp += gstep;
        }
#undef SCAN_LOAD
#undef SCAN_STEP
    }
    attn_wave_units(args, L, c);
}

DI void dil_merge(const Ctx& c) {
    { const bf16_t* DP = BIGP(bf16_t, B_DILP); const float* DM = BIGP(float, B_DILM); bf16_t* OD = BIGP(bf16_t, B_ONA) + 256;
        for (int it = c.bid * 512 + c.tid; it < c.stok * 32; it += c.G * 512) { const int tok = it >> 5, part = it & 31;
            u32x4 w = {0u, 0u, 0u, 0u};
            if (part < 16) { const int hd = part >> 3, p = part & 7; float m[3], dn[3];
#pragma unroll
                for (int g = 0; g < 3; ++g) { const size_t b = (((size_t)g * SLABMAX + tok) * 2 + hd); m[g] = DM[b * 2]; dn[g] = DM[b * 2 + 1]; }
                const float M = fmaxf(m[0], fmaxf(m[1], m[2])); float num[8], den = 0.f;
#pragma unroll
                for (int j = 0; j < 8; ++j) num[j] = 0.f;
#pragma unroll
                for (int g = 0; g < 3; ++g) { const float f = __expf(m[g] - M); den += f * dn[g]; const u32x4 a = *(const u32x4*)(DP + (((size_t)g * SLABMAX + tok) * 2 + hd) * 64 + 8 * p);
                    num[0] += f * bflo(a[0]); num[1] += f * bfhi(a[0]); num[2] += f * bflo(a[1]); num[3] += f * bfhi(a[1]); num[4] += f * bflo(a[2]); num[5] += f * bfhi(a[2]); num[6] += f * bflo(a[3]); num[7] += f * bfhi(a[3]); }
                const float inv = frcp(den);
                w.x = pk2(num[0] * inv, num[1] * inv); w.y = pk2(num[2] * inv, num[3] * inv); w.z = pk2(num[4] * inv, num[5] * inv); w.w = pk2(num[6] * inv, num[7] * inv); }
            if (part < 16) *(u32x4*)(OD + (size_t)tok * 768 + 8 * part) = w; } }
}

DI void phase_gdn_out(KArgs args, LAS unsigned char* L, const Ctx& c) {
    dil_merge(c);
    const int lane = c.lane, wave = c.wave, tid = c.tid, l = c.layer;
    const bf16_t* PROJ = BIGP(bf16_t, B_PROJ); unsigned char* GS = BIGP(unsigned char, B_GSCR); bf16_t* OG = BIGP(bf16_t, B_ONA) + 384;
    LAS float* OF = (LAS float*)L;
    for (int u = c.bid; u < (c.stok >> 6) * 6; u += c.G) { const int gch = u / 6, head = u % 6;
        { const int dir = wave >> 2, mt = (wave >> 1) & 1, nt = wave & 1, rr = lane & 31, hh = lane >> 5;
            const unsigned char* G = GS + (size_t)((gch * 6 + head) * 2 + dir) * GSTRIDE;
            const bf16_t* Qe = (const bf16_t*)(G + 16384); const bf16_t* Oct = (const bf16_t*)(G + 24576); const bf16_t* St = (const bf16_t*)(G + 32768);
            f32x16 acc = zero16();
#pragma unroll
            for (int ks = 0; ks < 4; ++ks) { const bf16x8 a = *(const bf16x8*)(Qe + (size_t)((mt * 4 + ks) * 64 + lane) * 8);
                const bf16_t* sp = St + (32 * nt + rr) * 64 + 32 * (ks >> 1) + 16 * (ks & 1) + 4 * hh; const u32x2 lo = *(const u32x2*)sp, hi = *(const u32x2*)(sp + 8);
                u32x4 bw; bw.x = lo.x; bw.y = lo.y; bw.z = hi.x; bw.w = hi.y; acc = MFMA32(a, __builtin_bit_cast(bf16x8, bw), acc); }
            const int e = 32 * nt + rr;
#pragma unroll
            for (int g = 0; g < 4; ++g) { const u32x2 w = *(const u32x2*)(Oct + e * 64 + 32 * mt + 8 * g + 4 * hh);
                const float v0 = acc[4 * g] + bflo(w.x), v1 = acc[4 * g + 1] + bfhi(w.x), v2 = acc[4 * g + 2] + bflo(w.y), v3 = acc[4 * g + 3] + bfhi(w.y);
                const int i0 = 32 * mt + 8 * g + 4 * hh;
#pragma unroll
                for (int j = 0; j < 4; ++j) { const int ii = i0 + j, tl = dir ? 63 - ii : ii; OF[(dir * 64 + tl) * 68 + e] = (j == 0) ? v0 : (j == 1) ? v1 : (j == 2) ? v2 : v3; } } }
        __syncthreads();
        { const int i = tid >> 3, p = tid & 7; const size_t tok = (size_t)gch * 64 + i;
            const LAS float* a = OF + i * 68 + 8 * p; const LAS float* b = OF + (64 + i) * 68 + 8 * p;
            float ov[8]; float ss = 0.f;
#pragma unroll
            for (int j = 0; j < 8; ++j) { ov[j] = a[j] + b[j]; ss += ov[j] * ov[j]; }
            ss += __shfl_xor(ss, 1); ss += __shfl_xor(ss, 2); ss += __shfl_xor(ss, 4);
            const float rs = frsq(ss * (1.0f / 64.0f) + NORM_EPS);
            const u32x4 zw = *(const u32x4*)(PROJ + tok * NPROJ + C_ZC + 64 * head + 8 * p);
            const float* nw = args->in[7] + l * 64 + 8 * p;
            float r[8];
#pragma unroll
            for (int j = 0; j < 4; ++j) { r[2 * j] = ov[2 * j] * rs * nw[2 * j] * siluf_(bflo(zw[j])); r[2 * j + 1] = ov[2 * j + 1] * rs * nw[2 * j + 1] * siluf_(bfhi(zw[j])); }
            u32x4 w; w.x = pk2(r[0], r[1]); w.y = pk2(r[2], r[3]); w.z = pk2(r[4], r[5]); w.w = pk2(r[6], r[7]);
            *(u32x4*)(OG + tok * 768 + 64 * head + 8 * p) = w; }
        __syncthreads();
    }
}

DI void phase_ln1(KArgs args, LAS unsigned char* L, const Ctx& c) {
    const int lane = c.lane, l = c.layer;
    LAS float* WR = (LAS float*)L;
    { const float* wr = args->in[14] + (size_t)l * D * 16;
        for (int i = c.tid; i < D * 16; i += 512) { const int col = i >> 4, e = i & 15, j = col >> 8, ln = (col >> 2) & 63, q = col & 3; WR[((j * 4 + q) * 64 + ln) * 20 + e] = wr[i]; } }
    __syncthreads();
    const float* g1 = args->in[12] + l * D; const float* b1 = args->in[13] + l * D;
    f32x4 gv[4], bv[4];
#pragma unroll
    for (int j = 0; j < 4; ++j) { gv[j] = *(const f32x4*)(g1 + 4 * lane + 256 * j); bv[j] = *(const f32x4*)(b1 + 4 * lane + 256 * j); }
    float* AFF = WSP(float, WS_AFF); int* SLOT = WSP(int, WS_SLOT); bf16_t* XB = WSP(bf16_t, WS_XB);
    f32x4 nv[4];
    { const int rl0 = c.bid * 8 + c.wave; if (rl0 < c.stok) { const float* hp = c.out + ((size_t)c.sbase + rl0) * D;
#pragma unroll
        for (int j = 0; j < 4; ++j) nv[j] = *(const f32x4*)(hp + 4 * lane + 256 * j); } }
    for (int rl = c.bid * 8 + c.wave; rl < c.stok; rl += c.G * 8) { const size_t tok = (size_t)c.sbase + rl;
        float* hr = c.out + tok * D; f32x4 v[4]; float s = 0.f;
#pragma unroll
        for (int j = 0; j < 4; ++j) { v[j] = nv[j]; s += (v[j][0] + v[j][1]) + (v[j][2] + v[j][3]); }
        if (rl + c.G * 8 < c.stok) { const float* hp = hr + (size_t)c.G * 8 * D;
#pragma unroll
            for (int j = 0; j < 4; ++j) nv[j] = *(const f32x4*)(hp + 4 * lane + 256 * j); }
        const float mean = wave_sum(s) * (1.0f / D); float s2 = 0.f;
#pragma unroll
        for (int j = 0; j < 4; ++j) { v[j] = v[j] - mean; s2 += (v[j][0] * v[j][0] + v[j][1] * v[j][1]) + (v[j][2] * v[j][2] + v[j][3] * v[j][3]); }
        const float rstd = frsq(wave_sum(s2) * (1.0f / D) + LN_EPS);
        float lg[16];
#pragma unroll
        for (int e = 0; e < 16; ++e) lg[e] = 0.f;
#pragma unroll
        for (int j = 0; j < 4; ++j) { v[j] = v[j] * rstd * gv[j] + bv[j];
            if (!c.dry) { *(f32x4*)(hr + 4 * lane + 256 * j) = v[j];
            u32x2 w; w.x = pk2(v[j][0], v[j][1]); w.y = pk2(v[j][2], v[j][3]); *(u32x2*)(XB + tok * D + 4 * lane + 256 * j) = w; }
#pragma unroll
            for (int q = 0; q < 4; ++q) { const LAS float* wp = WR + ((j * 4 + q) * 64 + lane) * 20; const float xv = v[j][q];
#pragma unroll
                for (int e4 = 0; e4 < 4; ++e4) { const f32x4 w4 = *(const LAS f32x4*)(wp + 4 * e4); lg[4 * e4] += xv * w4[0]; lg[4 * e4 + 1] += xv * w4[1]; lg[4 * e4 + 2] += xv * w4[2]; lg[4 * e4 + 3] += xv * w4[3]; } }
            asm volatile("" ::: "memory"); }
        float mx = -1e30f;
#pragma unroll
        for (int e = 0; e < 16; ++e) { lg[e] = wave_sum(lg[e]); mx = fmaxf(mx, lg[e]); }
        float den = 0.f;
#pragma unroll
        for (int e = 0; e < 16; ++e) { lg[e] = expf(lg[e] - mx); den += lg[e]; }
        float mine = 0.f;
#pragma unroll
        for (int e = 0; e < 16; ++e) mine = (lane == e) ? lg[e] : mine;
        if (lane < 16 && !c.dry) { AFF[(size_t)lane * T_ALL + tok] = mine / den; SLOT[tok * 16 + lane] = -1; }
    }
}
DI void phase_ln2(KArgs args, LAS unsigned char* L, const Ctx& c) {
    const int lane = c.lane, l = c.layer;
    const float* g2 = args->in[18] + l * D; const float* b2 = args->in[19] + l * D;
    f32x4 gv[4], bv[4];
#pragma unroll
    for (int j = 0; j < 4; ++j) { gv[j] = *(const f32x4*)(g2 + 4 * lane + 256 * j); bv[j] = *(const f32x4*)(b2 + 4 * lane + 256 * j); }
    const int* SLOT = WSP(int, WS_SLOT); bf16_t* XB = WSP(bf16_t, WS_XB);
    f32x4 nv[4]; int nsv = -1;
    { const int t0 = c.bid * 8 + c.wave; if (t0 < T_ALL) { const float* xp = c.out + (size_t)t0 * D; nsv = SLOT[(size_t)t0 * 16 + (lane & 15)];
#pragma unroll
        for (int j = 0; j < 4; ++j) nv[j] = *(const f32x4*)(xp + 4 * lane + 256 * j); } }
    for (int t = c.bid * 8 + c.wave; t < T_ALL; t += c.G * 8) { const size_t tok = (size_t)t;
        float* xr = c.out + tok * D; f32x4 v[4];
#pragma unroll
        for (int j = 0; j < 4; ++j) v[j] = nv[j] * ALPHA;
        const int sv = nsv;
        if (t + c.G * 8 < T_ALL) { const float* xp = xr + (size_t)c.G * 8 * D; nsv = SLOT[(tok + c.G * 8) * 16 + (lane & 15)];
#pragma unroll
            for (int j = 0; j < 4; ++j) nv[j] = *(const f32x4*)(xp + 4 * lane + 256 * j); }
#pragma unroll
        for (int e = 0; e < 16; ++e) { const int s = __builtin_amdgcn_readlane(sv, e);
            if (s >= 0) { const bf16_t* yr = BIGP(bf16_t, (e < 8 ? B_XY0 : B_XY1)) + ((size_t)(e & 7) * CAP + s) * D;
#pragma unroll
                for (int j = 0; j < 4; ++j) { const u32x2 w = *(const u32x2*)(yr + 4 * lane + 256 * j); v[j][0] += bflo(w.x); v[j][1] += bfhi(w.x); v[j][2] += bflo(w.y); v[j][3] += bfhi(w.y); } } }
        float s = 0.f;
#pragma unroll
        for (int j = 0; j < 4; ++j) s += (v[j][0] + v[j][1]) + (v[j][2] + v[j][3]);
        const float mean = wave_sum(s) * (1.0f / D); float s2 = 0.f;
#pragma unroll
        for (int j = 0; j < 4; ++j) { v[j] = v[j] - mean; s2 += (v[j][0] * v[j][0] + v[j][1] * v[j][1]) + (v[j][2] * v[j][2] + v[j][3] * v[j][3]); }
        const float rstd = frsq(wave_sum(s2) * (1.0f / D) + LN_EPS);
#pragma unroll
        for (int j = 0; j < 4; ++j) { v[j] = v[j] * rstd * gv[j] + bv[j];
            if (!c.dry) { *(f32x4*)(xr + 4 * lane + 256 * j) = v[j];
            u32x2 w; w.x = pk2(v[j][0], v[j][1]); w.y = pk2(v[j][2], v[j][3]); *(u32x2*)(XB + tok * D + 4 * lane + 256 * j) = w; } }
    }
}

DI int block_excl_scan(int v, LAS int* tmp, int tid, int& total) {
    const int lane = tid & 63, wave = tid >> 6; int x = v;
#pragma unroll
    for (int o = 1; o < 64; o <<= 1) { const int y = __shfl_up(x, o); if (lane >= o) x += y; }
    __syncthreads();
    if (lane == 63) tmp[wave] = x;
    __syncthreads();
    int base = 0, tot = 0;
#pragma unroll
    for (int w = 0; w < 8; ++w) { const int tw = tmp[w]; if (w < wave) base += tw; tot += tw; }
    total = tot;
    return base + x - v;
}
DI void phase_select(KArgs args, LAS unsigned char* L, const Ctx& c) {
    if (c.bid >= 32) return;
    const int tid = c.tid, grp = c.bid >> 4, e = c.bid & 15;
    const int n = grp ? T_S : T_P, t0 = grp ? T_P : 0, C = n >> 3, slot0 = grp ? CAP_P : 0;
    const unsigned* v = (const unsigned*)(WSP(float, WS_AFF) + (size_t)e * T_ALL + t0);
    LAS unsigned* hist = (LAS unsigned*)L; LAS int* sh = (LAS int*)(L + 1024); LAS int* tmp = (LAS int*)(L + 1024 + 64);
    unsigned prefix = 0u; int kk = C;
    for (int pass = 0; pass < 4; ++pass) { const int shift = 24 - 8 * pass; const unsigned mhi = pass == 0 ? 0u : (0xFFFFFFFFu << (shift + 8));
        if (tid < 256) hist[tid] = 0u;
        __syncthreads();
        for (int i = tid * 4; i < n; i += 512 * 16) {
            u32x4 x4[4];
#pragma unroll
            for (int k = 0; k < 4; ++k) x4[k] = *(const u32x4*)(v + i + k * 2048);
#pragma unroll
            for (int k = 0; k < 4; ++k)
#pragma unroll
                for (int j = 0; j < 4; ++j) { const unsigned x = x4[k][j]; if ((x & mhi) == prefix) __hip_atomic_fetch_add(&hist[(x >> shift) & 255u], 1u, __ATOMIC_RELAXED, __HIP_MEMORY_SCOPE_WORKGROUP); } }
        __syncthreads();
        if (tid == 0) { int cum = 0, sel = 0; for (int b = 255; b >= 0; --b) { const int h = (int)hist[b]; if (cum + h >= kk) { sel = b; break; } cum += h; } sh[0] = sel; sh[1] = kk - cum; }
        __syncthreads();
        prefix |= ((unsigned)sh[0]) << shift; kk = sh[1];
        __syncthreads();
    }
    const unsigned thr = prefix;
    const int per = n >> 9, i0 = tid * per;
    int ngt = 0, ntie = 0;
    for (int i = 0; i < per; i += 4) { const u32x4 x = *(const u32x4*)(v + i0 + i);
#pragma unroll
        for (int j = 0; j < 4; ++j) { ngt += (x[j] > thr); ntie += (x[j] == thr); } }
    int tot;
    const int tie_base = block_excl_scan(ntie, tmp, tid, tot);
    int take = kk - tie_base; take = take < 0 ? 0 : (take > ntie ? ntie : take);
    int pos = block_excl_scan(ngt + take, tmp, tid, tot);
    int* IDX = WSP(int, WS_IDX) + e * CAP + slot0;
    int tr = 0;
    for (int i = 0; i < per; i += 4) { const u32x4 x = *(const u32x4*)(v + i0 + i);
#pragma unroll
        for (int j = 0; j < 4; ++j) { bool s = x[j] > thr; if (x[j] == thr) { s = tr < take; ++tr; } if (s) { IDX[pos] = t0 + i0 + i + j; ++pos; } } }
}
DI void phase_gather(KArgs args, LAS unsigned char* L, const Ctx& c) {
    const int lane = c.lane; const int* IDX = WSP(int, WS_IDX); const bf16_t* XB = WSP(bf16_t, WS_XB);
    float* GATEV = WSP(float, WS_GATEV); int* SLOT = WSP(int, WS_SLOT); const float* AFF = WSP(float, WS_AFF);
    for (int row0 = (c.bid * 8 + c.wave) * 4; row0 < NE * CAP; row0 += c.G * 8 * 4) {
        const int e = row0 / CAP, s0 = row0 % CAP; int t[4]; u32x4 a[4], b[4];
#pragma unroll
        for (int k = 0; k < 4; ++k) t[k] = IDX[row0 + k];
#pragma unroll
        for (int k = 0; k < 4; ++k) { const u32x4* src = (const u32x4*)(XB + (size_t)t[k] * D); a[k] = src[lane]; b[k] = src[64 + lane]; }
        u32x4* dst = (u32x4*)(BIGP(bf16_t, (e < 8 ? B_XY0 : B_XY1)) + ((size_t)(e & 7) * CAP + s0) * D);
#pragma unroll
        for (int k = 0; k < 4; ++k) { dst[k * 128 + lane] = a[k]; dst[k * 128 + 64 + lane] = b[k]; }
        if (lane < 4) { const int tt = (lane == 0) ? t[0] : (lane == 1) ? t[1] : (lane == 2) ? t[2] : t[3]; SLOT[(size_t)tt * 16 + e] = s0 + lane; GATEV[row0 + lane] = AFF[(size_t)e * T_ALL + tt]; } }
}

__global__ void __launch_bounds__(512, 2) fwd_kernel(Args args) {
    extern __shared__ __attribute__((aligned(16))) unsigned char lds_raw[];
    LAS unsigned char* L = (LAS unsigned char*)lds_raw;
    Ctx c;
    c.out = args.out; c.ws = args.ws;
    c.tid = threadIdx.x; c.lane = c.tid & 63; c.wave = __builtin_amdgcn_readfirstlane(c.tid >> 6); c.G = gridDim.x; c.bid = blockIdx.x;
    c.layer = 0; c.slab = 0; c.nseq = 8; c.seqlen = 4096; c.stok = 32768; c.sbase = 0; c.dry = 0;
    const int lo = args.ph_lo, hi = args.ph_hi;
    volatile LAS unsigned* MISC = (volatile LAS unsigned*)(L + LDS_MISC);
    if (c.tid < 4) MISC[c.tid] = 0u;
    __syncthreads();
    XcdBarrier bar; bar.bar = (unsigned*)(c.ws + WS_CTL) + 1024; bar.x = 0; bar.st = MISC;
    if (hi - lo > 1) bar = xcd_barrier_post((unsigned*)(c.ws + WS_CTL) + 1024, MISC);
    int pc = 0;
#ifndef PHMASK
#define PHMASK 0xFFFF
#endif
#define PHON(k) (((PHMASK) >> (k)) & 1)
#ifndef REPMASK
#define REPMASK 0x0
#endif
#define PH_BEGIN(k) if (PHON(k) && pc >= lo && pc < hi) { { int tz = threadIdx.x; asm volatile("" : "+v"(tz)); c.tid = tz; c.lane = tz & 63; c.wave = __builtin_amdgcn_readfirstlane(tz >> 6); } KArgs ka = kargs(); c.ws = ka->ws; c.out = ka->out; { int b_ = blockIdx.x, g_ = gridDim.x; asm volatile("" : "+s"(b_), "+s"(g_)); c.bid = b_; c.G = g_; } for (int rep_ = 0; rep_ < (((REPMASK) >> (k)) & 1) + 1; ++rep_) { if (rep_) __syncthreads(); c.dry = (rep_ + 1 < (((REPMASK) >> (k)) & 1) + 1);
#ifndef BARREP
#define BARREP 0
#endif
#define PH_END   } if (pc + 1 < hi) { xcd_barrier(bar); if (BARREP) { xcd_barrier(bar); xcd_barrier(bar); } } else { asm volatile("s_waitcnt vmcnt(0)" ::: "memory"); __syncthreads(); } } ++pc;

    for (int layer = 0; layer < 2; ++layer) {
        c.layer = layer;
        PH_BEGIN(0) phase_weights(ka, L, c); PH_END
        for (int slab = 0; slab < NSLAB; ++slab) {
            c.slab = slab; c.nseq = slab < 2 ? 8 : 1; c.seqlen = slab < 2 ? 4096 : 16384; c.stok = slab < 2 ? 32768 : 16384; c.sbase = slab * 32768; const int stok = c.stok; const size_t sbase = (size_t)c.sbase;
            PH_BEGIN(1) {
                pg8::Gemm g{WSP(bf16_t, WS_XB) + sbase * D, WSP(bf16_t, WS_WIN), stok, NPROJ, D}; pg8::StaticOrder S; S.init(stok, NPROJ, c.G, c.bid);
                pg8::EpiInProj E{BIGP(bf16_t, B_PROJ), BIGP(float, B_BA)};
                pg8::gemm_phase<pg8::EpiInProj, pg8::StaticOrder>(L, g, S, E); } PH_END
            PH_BEGIN(2) phase_mix_a(ka, L, c); PH_END
            PH_BEGIN(3) phase_scan(ka, L, c); PH_END
            PH_BEGIN(4) phase_gdn_out(ka, L, c); PH_END
            PH_BEGIN(5) {
                pg8::StaticOrder S; S.init(stok, D, c.G, c.bid);
                pg8::Gemm g{BIGP(bf16_t, B_ONA), WSP(bf16_t, WS_WBR), stok, D, 768}; pg8::EpiGateCat E{BIGP(bf16_t, B_PROJ), BIGP(bf16_t, B_MERGED)};
                pg8::gemm_phase<pg8::EpiGateCat, pg8::StaticOrder>(L, g, S, E); } PH_END
            PH_BEGIN(6) {
                const float* xr = layer == 0 ? (slab < 2 ? ka->in[0] + sbase * D : ka->in[1]) : c.out + sbase * D;
                pg8::Gemm g{BIGP(bf16_t, B_MERGED), WSP(bf16_t, WS_WOUT), stok, D, D}; pg8::StaticOrder S; S.init(stok, D, c.G, c.bid);
                pg8::EpiRes E{xr, c.out + sbase * D};
                pg8::gemm_phase<pg8::EpiRes, pg8::StaticOrder>(L, g, S, E); } PH_END
#ifndef LN1PROBE
#define LN1PROBE 0
#endif
            PH_BEGIN(7) if (LN1PROBE) { c.dry = 1; phase_ln1(ka, L, c); __syncthreads(); c.dry = 0; } phase_ln1(ka, L, c); PH_END
        }
        PH_BEGIN(8) phase_select(ka, L, c); PH_END
        PH_BEGIN(9) phase_gather(ka, L, c); PH_END
        for (int half = 0; half < 2; ++half) {
            PH_BEGIN(10) {
                pg8::Gemm g{BIGP(bf16_t, half ? B_XY1 : B_XY0), WSP(bf16_t, WS_WGU) + (size_t)half * 8 * 4096 * D, 8 * CAP, 8 * 4096, D}; pg8::MoeOrder S; S.init(8, CAP / 256, 16, c.G, c.bid);
                pg8::EpiSwiglu E{BIGP(bf16_t, B_HID)};
                pg8::gemm_phase<pg8::EpiSwiglu, pg8::MoeOrder>(L, g, S, E); } PH_END
            PH_BEGIN(11) {
                pg8::Gemm g{BIGP(bf16_t, B_HID), WSP(bf16_t, WS_WD) + (size_t)half * 8 * D * DE, 8 * CAP, 8 * D, DE}; pg8::MoeOrder S; S.init(8, CAP / 256, 4, c.G, c.bid);
                pg8::EpiDown E{BIGP(bf16_t, half ? B_XY1 : B_XY0), WSP(float, WS_GATEV) + (size_t)half * 8 * CAP};
                pg8::gemm_phase<pg8::EpiDown, pg8::MoeOrder>(L, g, S, E); } PH_END
        }
        PH_BEGIN(12) phase_ln2(ka, L, c); PH_END
    }
#undef PH_BEGIN
#undef PH_END
}

constexpr int N_PHASES = 2 * (1 + NSLAB * 7 + 2 + 4 + 1);

extern "C" void kernel_launch(void* const* d_in, const int* in_sizes, int n_in, void* d_out, int out_size, void* d_ws, size_t ws_size, hipStream_t stream) {
    static int grid = 0;
    if (grid == 0) {
        if (n_in != 20 || ws_size < WS_END) { fprintf(stderr, "kernel_launch: unexpected n_in %d or ws_size %zu (< %zu)\n", n_in, ws_size, (size_t)WS_END); grid = -1; return; }
        int dev = 0, cus = 0, per_cu = 0;
        if (hipGetDevice(&dev) != hipSuccess || hipDeviceGetAttribute(&cus, hipDeviceAttributeMultiprocessorCount, dev) != hipSuccess) { grid = -1; return; }
        if (hipFuncSetAttribute((const void*)fwd_kernel, hipFuncAttributeMaxDynamicSharedMemorySize, LDS_BYTES) != hipSuccess) { fprintf(stderr, "kernel_launch: hipFuncSetAttribute failed\n"); grid = -1; return; }
        if (hipOccupancyMaxActiveBlocksPerMultiprocessor(&per_cu, (const void*)fwd_kernel, 512, LDS_BYTES) != hipSuccess || per_cu < 1) fprintf(stderr, "kernel_launch: occupancy query says %d\n", per_cu);
        (void)hipGetLastError();
        grid = cus;
    }
    if (grid < 0) return;
    (void)hipMemsetAsync((char*)d_ws + WS_CTL, 0, 1 * MiB, stream);
    Args a{};
    for (int i = 0; i < 20; ++i) a.in[i] = (const float*)d_in[i];
    a.out = (float*)d_out; a.ws = (unsigned char*)d_ws;
#if MK_N_LAUNCHES == 1
    a.ph_lo = 0; a.ph_hi = N_PHASES;
    hipLaunchKernelGGL(fwd_kernel, dim3(grid), dim3(512), LDS_BYTES, stream, a);
#else
    for (int p = 0; p < N_PHASES; ++p) { a.ph_lo = p; a.ph_hi = p + 1; hipLaunchKernelGGL(fwd_kernel, dim3(grid), dim3(512), LDS_BYTES, stream, a); }
#endif
}
```

```cpp
#include <hip/hip_runtime.h>
#include <stdint.h>
#include <stdio.h>

#define LAS __attribute__((address_space(3)))
#define DI __device__ __forceinline__
typedef unsigned short bf16_t;
typedef short bf16x8 __attribute__((ext_vector_type(8)));
typedef float f32x4 __attribute__((ext_vector_type(4)));
typedef float f32x2 __attribute__((ext_vector_type(2)));
typedef float f32x16 __attribute__((ext_vector_type(16)));
typedef unsigned u32x4 __attribute__((ext_vector_type(4)));
typedef unsigned u32x2 __attribute__((ext_vector_type(2)));
typedef __bf16 bf16x2v __attribute__((ext_vector_type(2)));

#ifndef MK_N_LAUNCHES
#define MK_N_LAUNCHES 1
#endif

constexpr int D = 1024, T_ALL = 81920, T_P = 65536, T_S = 16384, SLABMAX = 32768, NSLAB = 3;
constexpr int DIN = 6552, NPROJ = 6656;
constexpr int C_GATE = 0, C_QA = 3072, C_KA = 3328, C_VA = 3584, C_QD = 3840, C_KD = 4224, C_VD = 4608, C_QC = 4992, C_KC = 5376, C_VC = 5760, C_ZC = 6144;
constexpr int NE = 16, DE = 2048, CAP_P = 8192, CAP_S = 2048, CAP = CAP_P + CAP_S;
constexpr float ALPHA = 1.41421356237f, LN_EPS = 1e-5f, NORM_EPS = 1e-6f;
constexpr size_t MiB = 1u << 20;
constexpr size_t WS_CTL = 0, WS_WIN = 1 * MiB, WS_WBR = 14 * MiB, WS_WOUT = 16 * MiB, WS_WGU = 18 * MiB, WS_WD = 146 * MiB, WS_XB = 210 * MiB;
constexpr size_t WS_AFF = 370 * MiB, WS_SLOT = 375 * MiB, WS_IDX = 380 * MiB, WS_GATEV = 381 * MiB, WS_CS = 382 * MiB, WS_BIG = 386 * MiB, WS_END = 1130 * MiB;
constexpr size_t B_PROJ = 0, B_BA = 416 * MiB, B_ONA = 420 * MiB, B_ODIL = 436 * MiB, B_OGDN = 452 * MiB, B_DILP = 476 * MiB, B_DILM = 500 * MiB, B_GSCR = 502 * MiB, B_MERGEF = 502 * MiB, B_MERGED = 630 * MiB;
constexpr size_t B_XY0 = 0, B_XY1 = 160 * MiB, B_HID = 320 * MiB;
constexpr int GSTRIDE = 41216;
constexpr int LDS_BYTES = 147456;
constexpr int LDS_MISC = 145408;

DI unsigned pk2(float lo, float hi) { f32x2 v = {lo, hi}; bf16x2v b = __builtin_convertvector(v, bf16x2v); return __builtin_bit_cast(unsigned, b); }
DI unsigned pk4_fp8(float a, float b, float c, float d) {
    int w = __builtin_amdgcn_cvt_pk_fp8_f32(a, b, 0, false); w = __builtin_amdgcn_cvt_pk_fp8_f32(c, d, w, true); return (unsigned)w; }
DI float bflo(unsigned u) { return __uint_as_float(u << 16); }
DI float bfhi(unsigned u) { return __uint_as_float(u & 0xffff0000u); }
DI float frcp(float x) { return __builtin_amdgcn_rcpf(x); }
DI float frsq(float x) { return __builtin_amdgcn_rsqf(x); }
DI float sigmoidf_(float x) { return frcp(1.0f + __expf(-x)); }
DI float siluf_(float x) { return x * frcp(1.0f + __expf(-x)); }
DI float wave_sum(float v) {
#pragma unroll
    for (int o = 1; o < 64; o <<= 1) v += __shfl_xor(v, o);
    return v;
}
#define MFMA32(a, b, c) __builtin_amdgcn_mfma_f32_32x32x16_bf16((a), (b), (c), 0, 0, 0)
DI int crow(int reg, int h) { return (reg & 3) + 8 * (reg >> 2) + 4 * h; }
DI f32x16 zero16() { f32x16 z; for (int i = 0; i < 16; ++i) z[i] = 0.f; return z; }
template <int S> DI bf16x8 pack8(const f32x16& x) {
    u32x4 p; p[0] = pk2(x[8 * S], x[8 * S + 1]); p[1] = pk2(x[8 * S + 2], x[8 * S + 3]); p[2] = pk2(x[8 * S + 4], x[8 * S + 5]); p[3] = pk2(x[8 * S + 6], x[8 * S + 7]);
    return __builtin_bit_cast(bf16x8, p);
}

namespace pg8 {
constexpr int BM = 256, BK = 64, HALF = 128, HTB = HALF * BK * 2, STAGE_BYTES = 8 * HTB, NXCD = 8, WGM = 8;
__host__ __device__ __forceinline__ int lds_byte(int r, int c) { const int st = (r >> 4) * 2 + (c >> 5), rr = r & 15, cc = c & 31, ob = rr * 64 + cc * 2; return st * 1024 + (ob ^ (((ob >> 9) & 1) << 5)); }
__host__ __device__ __forceinline__ void stage_rc(int b, int& R, int& C) { const int st = b / 1024, sb = b % 1024, swz = sb ^ (((sb >> 9) & 1) << 5); R = (st >> 1) * 16 + swz / 64; C = (st & 1) * 32 + (swz % 64) / 2; }
__host__ __device__ __forceinline__ int perm32(int rho) { const int n = rho >> 4, i = rho & 15; return 8 * (i >> 2) + 4 * n + (i & 3); }
struct Unit { int pm, pn; };
struct Gemm { const bf16_t* A; const bf16_t* Bt; int M, N, K; };
struct StaticOrder {
    int nM, nN, nwg, G, c;
    __device__ void init(int M, int N, int G_, int c_) { nM = M / BM; nN = N / BM; nwg = nM * nN; G = G_; c = c_; }
    __device__ bool next(int i, Unit& u) const {
        const long L = (long)i * G + c; if (L >= nwg) return false;
        int wgid = (int)L; { const int q = nwg / NXCD, r = nwg % NXCD, xcd = wgid % NXCD, off = wgid / NXCD; wgid = (xcd < r ? xcd * (q + 1) : r * (q + 1) + (xcd - r) * q) + off; }
        const int nig = WGM * nN, gid = wgid / nig, fm = gid * WGM, gsz = (nM - fm) < WGM ? (nM - fm) : WGM;
        u.pm = fm + ((wgid % nig) % gsz); u.pn = (wgid % nig) / gsz; return true;
    }
    __device__ __forceinline__ void a_ready(const Unit&) const {}
    __device__ __forceinline__ void done(const Unit&) const {}
};
struct MoeOrder {
    int nMe, nNe, per, total, G, c, xr, xc, rpx, cpx, share;
    __device__ void init(int nE, int nMe_, int nNe_, int G_, int c_) { nMe = nMe_; nNe = nNe_; per = nMe * nNe; total = nE * per; G = G_; c = c_;
        xc = (nNe % 2 == 0 && nNe >= 8) ? 2 : 1; xr = 8 / xc; rpx = nMe / xr; cpx = nNe / xc; share = rpx * cpx; }
    __device__ bool next(int i, Unit& u) const {
        if ((G & 7) == 0 && nMe % xr == 0) {
            const int x = c & 7, q = c >> 3, nq = G >> 3; const long j = (long)i * nq + q; if (j >= (long)(total / 8)) return false;
            const int e = (int)(j / share), r = (int)(j % share); const int pm = (x / xc) * rpx + r % rpx, pn = (x % xc) * cpx + r / rpx;
            u.pm = e * nMe + pm; u.pn = e * nNe + pn; return true;
        }
        const long L = (long)i * G + c; if (L >= total) return false;
        const int e = (int)(L / per), r = (int)(L % per);
        u.pm = e * nMe + r % nMe; u.pn = e * nNe + r / nMe; return true;
    }
    __device__ __forceinline__ void a_ready(const Unit&) const {}
    __device__ __forceinline__ void done(const Unit&) const {}
};

template <class Epi, class Sched>
__device__ __forceinline__ void gemm_phase(LAS unsigned char* lds, const Gemm g, const Sched& S, const Epi& E) {
    int tid = threadIdx.x; asm volatile("" : "+v"(tid));
    const int wid = __builtin_amdgcn_readfirstlane(tid >> 6), lane = tid & 63, wr = wid >> 2, wc = wid & 3, fr = lane & 15, fq = lane >> 4;
    int Kv = g.K; asm volatile("" : "+s"(Kv));
    const int K = Kv, nt = K / BK;
    unsigned voffA[2], voffB[2];
#pragma unroll
    for (int i = 0; i < 2; ++i) { int R, C; stage_rc(tid * 16 + i * 8192, R, C); const int Rb = Epi::PERM ? ((R & ~31) + perm32(R & 31)) : R;
        voffA[i] = (unsigned)(R * K + C) * 2u; voffB[i] = (unsigned)(Rb * K + C) * 2u; }
    const size_t kstep = (size_t)(BK * 2);
    const size_t hstep = (size_t)HALF * K * 2;
    const size_t tstep = 2 * hstep;
    const unsigned ldsw = (unsigned)wid * 1024u;
    const int aoff = lds_byte(wr * 64 + fr, fq * 8), boff = lds_byte(wc * 32 + fr, fq * 8);
#define PG8_SA(b, h) (((b) * 2 + (h)) * HTB)
#define PG8_SB(b, h) ((4 + (b) * 2 + (h)) * HTB)
#define PG8_STAGE(bufoff, gbase, voff) do { _Pragma("unroll") for (int _i = 0; _i < 2; ++_i) \
        __builtin_amdgcn_global_load_lds((const unsigned*)((const char*)(gbase) + (voff)[_i]), (LAS unsigned*)(lds + (bufoff) + ldsw + _i * 8192), 16, 0, 0); } while (0)
#define PG8_LD8(p) __builtin_shufflevector(*(const LAS v4i_*)(p), *(const LAS v4i_*)((p) + 1024), 0, 1, 2, 3, 4, 5, 6, 7)
#define PG8_LDA(dst, b, h) do { _Pragma("unroll") for (int m = 0; m < 4; ++m) { if constexpr (Epi::FP8) dst##8[m] = PG8_LD8(lds + PG8_SA(b, h) + aoff + m * 2048); \
        else { _Pragma("unroll") for (int k = 0; k < 2; ++k) dst[m][k] = *(const LAS bf16x8*)(lds + PG8_SA(b, h) + aoff + m * 2048 + k * 1024); } } } while (0)
#define PG8_LDB(dst, b, h) do { _Pragma("unroll") for (int n = 0; n < 2; ++n) { if constexpr (Epi::FP8) dst##8[n] = PG8_LD8(lds + PG8_SB(b, h) + boff + n * 2048); \
        else { _Pragma("unroll") for (int k = 0; k < 2; ++k) dst[n][k] = *(const LAS bf16x8*)(lds + PG8_SB(b, h) + boff + n * 2048 + k * 1024); } } } while (0)
#define PG8_MMA(ai, bj, At, Bt) do { __builtin_amdgcn_s_setprio(1); _Pragma("unroll") for (int m = 0; m < 4; ++m) _Pragma("unroll") for (int n = 0; n < 2; ++n) { \
        if constexpr (Epi::FP8) asm volatile("v_mfma_scale_f32_16x16x128_f8f6f4 %0, %1, %2, %0, %3, %3 op_sel_hi:[0,0,0]" : "+v"(acc[ai][bj][m][n]) : "v"(Bt##8[n]), "v"(At##8[m]), "v"(fp8_unit_scale));   \
        else { _Pragma("unroll") for (int k = 0; k < 2; ++k) acc[ai][bj][m][n] = __builtin_amdgcn_mfma_f32_16x16x32_bf16(Bt[n][k], At[m][k], acc[ai][bj][m][n], 0, 0, 0); } } \
        __builtin_amdgcn_s_setprio(0); } while (0)
#define PG8_WAIT_V(n) asm volatile("s_waitcnt vmcnt(" #n ")" ::: "memory")
#define PG8_WAIT_L(n) asm volatile("s_waitcnt lgkmcnt(" #n ")" ::: "memory")
#define PG8_BAR __builtin_amdgcn_s_barrier()
#define PG8_SCHED __builtin_amdgcn_sched_barrier(0)
    Unit cur, nxt; int ui = 0;
    if (!S.next(0, cur)) return;
    f32x4 acc[2][2][4][2];
#pragma unroll
    for (int a = 0; a < 2; ++a)
#pragma unroll
        for (int b = 0; b < 2; ++b)
#pragma unroll
            for (int m = 0; m < 4; ++m)
#pragma unroll
                for (int n = 0; n < 2; ++n) acc[a][b][m][n] = (f32x4){0.f, 0.f, 0.f, 0.f};
    typedef int v4i_ __attribute__((ext_vector_type(4))); typedef int v8i_ __attribute__((ext_vector_type(8)));
    bf16x8 At[4][2], B0[2][2], B1[2][2]; v8i_ At8[4], B08[2], B18[2];
    int fp8_unit_scale = 0x7F7F7F7F; asm volatile("" : "+v"(fp8_unit_scale));
    const char* cA = (const char*)g.A + (size_t)cur.pm * tstep; const char* cB = (const char*)g.Bt + (size_t)cur.pn * tstep;
    S.a_ready(cur);
    PG8_STAGE(PG8_SB(0, 0), cB, voffB); PG8_STAGE(PG8_SA(0, 0), cA, voffA); PG8_STAGE(PG8_SB(0, 1), cB + hstep, voffB); PG8_STAGE(PG8_SA(0, 1), cA + hstep, voffA);
    if (wr == 1) PG8_BAR;
    PG8_WAIT_V(4); PG8_BAR;
    PG8_STAGE(PG8_SB(1, 0), cB + kstep, voffB); PG8_STAGE(PG8_SA(1, 0), cA + kstep, voffA); PG8_STAGE(PG8_SB(1, 1), cB + hstep + kstep, voffB);
    PG8_WAIT_V(6); PG8_BAR;
    for (;;) {
        const bool has_next = S.next(ui + 1, nxt);
        const char* nA = has_next ? (const char*)g.A + (size_t)nxt.pm * tstep : cA; const char* nB = has_next ? (const char*)g.Bt + (size_t)nxt.pn * tstep : cB;
        for (int t = 0; t < nt; t += 2) {
            const bool last = (t == nt - 2);
            const char* a1 = cA + (size_t)(t + 1) * kstep;
            const char* a2 = last ? nA : cA + (size_t)(t + 2) * kstep; const char* b2 = last ? nB : cB + (size_t)(t + 2) * kstep;
            const char* a3 = a2 + kstep; const char* b3 = b2 + kstep;
            if (last && has_next) S.a_ready(nxt);
            if constexpr (Epi::SEG) { if (t == 4 || t == 6) { int tz = tid; asm volatile("" : "+v"(tz)); const int wz = __builtin_amdgcn_readfirstlane(tz >> 6), lz = tz & 63; E.mid(acc, cur, t == 4 ? 0 : 1, wz >> 2, wz & 3, lz & 15, lz >> 4); } }
            PG8_LDB(B0, 0, 0); PG8_SCHED; PG8_LDA(At, 0, 0); PG8_STAGE(PG8_SA(1, 1), a1 + hstep, voffA);
            PG8_WAIT_L(8); PG8_BAR; PG8_WAIT_L(0); PG8_MMA(0, 0, At, B0); PG8_BAR; PG8_SCHED;
            PG8_LDB(B1, 0, 1); PG8_STAGE(PG8_SB(0, 0), b2, voffB);
            PG8_BAR; PG8_WAIT_L(0); PG8_MMA(0, 1, At, B1); PG8_BAR;
            PG8_LDA(At, 0, 1); PG8_STAGE(PG8_SA(0, 0), a2, voffA);
            PG8_BAR; PG8_WAIT_L(0); PG8_MMA(1, 0, At, B0); PG8_BAR; PG8_SCHED;
            PG8_STAGE(PG8_SB(0, 1), b2 + hstep, voffB);
            PG8_WAIT_V(6); PG8_BAR; PG8_MMA(1, 1, At, B1); PG8_BAR;
            PG8_LDB(B0, 1, 0); PG8_SCHED; PG8_LDA(At, 1, 0); PG8_STAGE(PG8_SA(0, 1), a2 + hstep, voffA);
            PG8_WAIT_L(8); PG8_BAR; PG8_WAIT_L(0); PG8_MMA(0, 0, At, B0); PG8_BAR; PG8_SCHED;
            PG8_LDB(B1, 1, 1); PG8_STAGE(PG8_SB(1, 0), b3, voffB);
            PG8_BAR; PG8_WAIT_L(0); PG8_MMA(0, 1, At, B1); PG8_BAR;
            PG8_LDA(At, 1, 1); PG8_STAGE(PG8_SA(1, 0), a3, voffA);
            PG8_BAR; PG8_WAIT_L(0); PG8_MMA(1, 0, At, B0); PG8_BAR; PG8_SCHED;
            PG8_STAGE(PG8_SB(1, 1), b3 + hstep, voffB);
            PG8_WAIT_V(6); PG8_BAR; PG8_MMA(1, 1, At, B1); PG8_BAR;
        }
        if constexpr (Epi::FP8) asm volatile("s_nop 15\n\ts_nop 15\n\ts_nop 15" ::: "memory");
        { int tz = tid; asm volatile("" : "+v"(tz)); const int wz = __builtin_amdgcn_readfirstlane(tz >> 6), lz = tz & 63;
          E(acc, cur, wz >> 2, wz & 3, lz & 15, lz >> 4); } S.done(cur);
        if (!has_next) break;
#pragma unroll
        for (int a = 0; a < 2; ++a)
#pragma unroll
            for (int b = 0; b < 2; ++b)
#pragma unroll
                for (int m = 0; m < 4; ++m)
#pragma unroll
                    for (int n = 0; n < 2; ++n) acc[a][b][m][n] = (f32x4){0.f, 0.f, 0.f, 0.f};
        cur = nxt; cA = nA; cB = nB; ++ui;
    }
    PG8_WAIT_V(0);
    if (wr == 0) PG8_BAR;
    PG8_BAR;
#undef PG8_SA
#undef PG8_SB
#undef PG8_STAGE
#undef PG8_LDA
#undef PG8_LD8
#undef PG8_LDB
#undef PG8_MMA
#undef PG8_WAIT_V
#undef PG8_WAIT_L
#undef PG8_BAR
#undef PG8_SCHED
}

struct EpiInProj {
    static constexpr bool PERM = true, SEG = false, FP8 = false;
    bf16_t* O; float* BA;
    __device__ __forceinline__ void operator()(const f32x4 (&acc)[2][2][4][2], const Unit& u, int wr, int wc, int fr, int fq) const {
        const int row0 = u.pm * BM + wr * 64 + fr, col0 = u.pn * BM + wc * 32 + 8 * fq;
        const bool sig = u.pn < 12, ba = (u.pn == 25) && (wc == 0) && (fq < 3);
#pragma unroll
        for (int ai = 0; ai < 2; ++ai)
#pragma unroll
            for (int m = 0; m < 4; ++m) { const int row = row0 + ai * HALF + m * 16; bf16_t* rowp = O + (size_t)row * NPROJ + col0;
#pragma unroll
                for (int bj = 0; bj < 2; ++bj) { f32x4 v0 = acc[ai][bj][m][0], v1 = acc[ai][bj][m][1];
                    if (sig) {
#pragma unroll
                        for (int j = 0; j < 4; ++j) { v0[j] = sigmoidf_(v0[j]); v1[j] = sigmoidf_(v1[j]); } }
                    u32x4 w; w.x = pk2(v0[0], v0[1]); w.y = pk2(v0[2], v0[3]); w.z = pk2(v1[0], v1[1]); w.w = pk2(v1[2], v1[3]);
                    *(u32x4*)(rowp + bj * HALF) = w;
                    if (bj == 1 && ba) { float* bp = BA + (size_t)row * 32 + 8 * fq; *(f32x4*)bp = v0; *(f32x4*)(bp + 4) = v1; } } }
    }
};
struct EpiGateCat {
    static constexpr bool PERM = false, SEG = true, FP8 = false;
    const bf16_t* PROJ; bf16_t* MB;
    __device__ __forceinline__ void mid(f32x4 (&acc)[2][2][4][2], const Unit& u, int seg, int wr, int wc, int fr, int fq) const {
        const int row0 = u.pm * BM + wr * 64 + fr, col0 = u.pn * BM + wc * 32 + 4 * fq;
#pragma unroll
        for (int ai = 0; ai < 2; ++ai)
#pragma unroll
            for (int m = 0; m < 4; ++m) { int rowi = row0 + ai * HALF + m * 16; asm volatile("" : "+v"(rowi)); const bf16_t* gp = PROJ + (size_t)rowi * NPROJ + C_GATE + seg * 1024 + col0;
#pragma unroll
                for (int bj = 0; bj < 2; ++bj)
#pragma unroll
                    for (int n = 0; n < 2; ++n) { const u32x2 ga = *(const u32x2*)(gp + bj * HALF + n * 16), gb = *(const u32x2*)(gp + 1024 + bj * HALF + n * 16);
                        f32x4& v = acc[ai][bj][m][n]; v[0] *= bflo(ga.x) * frcp(bflo(gb.x)); v[1] *= bfhi(ga.x) * frcp(bfhi(gb.x)); v[2] *= bflo(ga.y) * frcp(bflo(gb.y)); v[3] *= bfhi(ga.y) * frcp(bfhi(gb.y)); }
                asm volatile("" ::: "memory"); }
    }
    __device__ __forceinline__ void operator()(const f32x4 (&acc)[2][2][4][2], const Unit& u, int wr, int wc, int fr, int fq) const {
        const int row0 = u.pm * BM + wr * 64 + fr, col0 = u.pn * BM + wc * 32 + 4 * fq;
#pragma unroll
        for (int ai = 0; ai < 2; ++ai)
#pragma unroll
            for (int m = 0; m < 4; ++m) { int rowi = row0 + ai * HALF + m * 16; asm volatile("" : "+v"(rowi)); const size_t row = (size_t)rowi;
#pragma unroll
                for (int bj = 0; bj < 2; ++bj)
#pragma unroll
                    for (int n = 0; n < 2; ++n) { const int col = col0 + bj * HALF + n * 16;
                        const u32x2 gw = *(const u32x2*)(PROJ + row * NPROJ + C_GATE + 2 * 1024 + col);
                        const f32x4 v = acc[ai][bj][m][n];
                        u32x2 w; w.x = pk2(v[0] * bflo(gw.x), v[1] * bfhi(gw.x)); w.y = pk2(v[2] * bflo(gw.y), v[3] * bfhi(gw.y)); *(u32x2*)(MB + row * D + col) = w; }
                asm volatile("" ::: "memory"); }
    }
};
struct EpiRes {
    static constexpr bool PERM = false, SEG = false, FP8 = false;
    const float* XR; float* H;
    __device__ __forceinline__ void operator()(const f32x4 (&acc)[2][2][4][2], const Unit& u, int wr, int wc, int fr, int fq) const {
        const int row0 = u.pm * BM + wr * 64 + fr, col0 = u.pn * BM + wc * 32 + 4 * fq;
#pragma unroll
        for (int ai = 0; ai < 2; ++ai)
#pragma unroll
            for (int m = 0; m < 4; ++m) { int rowi = row0 + ai * HALF + m * 16; asm volatile("" : "+v"(rowi)); const size_t off = (size_t)rowi * D + col0;
#pragma unroll
                for (int bj = 0; bj < 2; ++bj)
#pragma unroll
                    for (int n = 0; n < 2; ++n) { const f32x4 xr = *(const f32x4*)(XR + off + bj * HALF + n * 16);
                        *(f32x4*)(H + off + bj * HALF + n * 16) = xr * ALPHA + acc[ai][bj][m][n]; }
                asm volatile("" ::: "memory"); }
    }
};
struct EpiSwiglu {
    static constexpr bool PERM = true, SEG = false, FP8 = true;
    unsigned char* HID;
    __device__ __forceinline__ void operator()(const f32x4 (&acc)[2][2][4][2], const Unit& u, int wr, int wc, int fr, int fq) const {
        const int row0 = u.pm * BM + wr * 64 + fr, col0 = (u.pn & 15) * 128 + wc * 32 + 8 * fq;
#pragma unroll
        for (int ai = 0; ai < 2; ++ai)
#pragma unroll
            for (int m = 0; m < 4; ++m) { const f32x4 g0 = acc[ai][0][m][0] * 0.03125f, g1 = acc[ai][0][m][1] * 0.03125f, u0 = acc[ai][1][m][0] * 0.03125f, u1 = acc[ai][1][m][1] * 0.03125f;
                f32x4 h0, h1;
#pragma unroll
                for (int j = 0; j < 4; ++j) { h0[j] = siluf_(g0[j]) * u0[j]; h1[j] = siluf_(g1[j]) * u1[j]; }
                u32x2 w; w.x = pk4_fp8(h0[0], h0[1], h0[2], h0[3]); w.y = pk4_fp8(h1[0], h1[1], h1[2], h1[3]);
                int rowi = row0 + ai * HALF + m * 16; asm volatile("" : "+v"(rowi));
                *(u32x2*)(HID + (size_t)rowi * DE + col0) = w; asm volatile("" ::: "memory"); }
    }
};
struct EpiDown {
    static constexpr bool PERM = true, SEG = false, FP8 = true;
    bf16_t* Y; const float* GV;
    __device__ __forceinline__ void operator()(const f32x4 (&acc)[2][2][4][2], const Unit& u, int wr, int wc, int fr, int fq) const {
        const int row0 = u.pm * BM + wr * 64 + fr, col0 = (u.pn & 3) * BM + wc * 32 + 8 * fq;
#pragma unroll
        for (int ai = 0; ai < 2; ++ai)
#pragma unroll
            for (int m = 0; m < 4; ++m) { int row = row0 + ai * HALF + m * 16; asm volatile("" : "+v"(row)); const float gv = GV[row] * 0.03125f;
#pragma unroll
                for (int bj = 0; bj < 2; ++bj) { const f32x4 v0 = acc[ai][bj][m][0] * gv, v1 = acc[ai][bj][m][1] * gv;
                    u32x4 w; w.x = pk2(v0[0], v0[1]); w.y = pk2(v0[2], v0[3]); w.z = pk2(v1[0], v1[1]); w.w = pk2(v1[2], v1[3]);
                    *(u32x4*)(Y + (size_t)row * D + col0 + bj * HALF) = w; } }
    }
};
}

#define XB_TMO      128
#define XB_XCNT(j)  (256  + 64 * (j))
#define XB_XSUB(j)  (1280 + 64 * (j))
#define XB_XGEN(j)  (2304 + 64 * (j))
#define XB_TOP      3328
#define XB_TOPGEN   3392
#define XCD_BAR_WORDS 3456
#define XB_SPIN_CAP (1u << 22)
__device__ __forceinline__ unsigned xb_ld(unsigned* p)              { return __hip_atomic_load(p, __ATOMIC_RELAXED, __HIP_MEMORY_SCOPE_AGENT); }
__device__ __forceinline__ unsigned xb_add(unsigned* p, unsigned v) { return __hip_atomic_fetch_add(p, v, __ATOMIC_RELAXED, __HIP_MEMORY_SCOPE_AGENT); }
__device__ __forceinline__ unsigned xb_xcc_id() { return (unsigned)__builtin_amdgcn_s_getreg((3 << 11) | 20) & 0xFu; }
#define XB_SPIN(cond, bar) do { unsigned _sp = 0; while (cond) { __builtin_amdgcn_s_sleep(1); \
    if ((++_sp & 255u) == 0u) { if (xb_ld(&(bar)[XB_TMO])) break; if (_sp > XB_SPIN_CAP) { atomicAdd(&(bar)[XB_TMO], 1u); break; } } } } while (0)
struct XcdBarrier { unsigned* bar; unsigned x; volatile LAS unsigned* st; };
__device__ __forceinline__ XcdBarrier xcd_barrier_post(unsigned* bar, volatile LAS unsigned* st) {
    XcdBarrier b; b.bar = bar; b.x = xb_xcc_id(); b.st = st;
    if (threadIdx.x == 0) (void)xb_add(&bar[XB_XCNT(b.x)], 1u);
    return b;
}
__device__ __forceinline__ void xcd_barrier_complete(unsigned* bar, unsigned x, unsigned& nloc, unsigned& nx) {
    const unsigned G = gridDim.x * gridDim.y * gridDim.z;
    unsigned sum, cnt, mine, sp = 0u;
    for (;;) {
        sum = 0u; cnt = 0u; mine = 0u;
#pragma unroll
        for (unsigned j = 0; j < 16; ++j) { const unsigned c = xb_ld(&bar[XB_XCNT(j)]); sum += c; cnt += (c > 0u) ? 1u : 0u; }
        mine = xb_ld(&bar[XB_XCNT(x)]);
        if (sum == G) break;
        __builtin_amdgcn_s_sleep(1);
        if ((++sp & 255u) == 0u) { if (xb_ld(&bar[XB_TMO])) break; if (sp > XB_SPIN_CAP) { atomicAdd(&bar[XB_TMO], 1u); break; } }
    }
    nloc = mine > 0u ? mine : 1u; nx = cnt > 0u ? cnt : 1u;
}
__device__ __forceinline__ void xcd_barrier(const XcdBarrier& b) {
    asm volatile("s_waitcnt vmcnt(0)" ::: "memory");
    __syncthreads();
    if (threadIdx.x == 0) {
        unsigned* bar = b.bar; asm volatile("" : "+s"(bar));
        __builtin_amdgcn_s_waitcnt(0);
        unsigned nloc = b.st[0], nx = b.st[1];
        if (nloc == 0u) { xcd_barrier_complete(bar, b.x, nloc, nx); b.st[0] = nloc; b.st[1] = nx; }
        const unsigned old = xb_add(&bar[XB_XSUB(b.x)], 1u);
        const unsigned gen = old / nloc;
        if (old + 1u == (gen + 1u) * nloc) {
            __builtin_amdgcn_fence(__ATOMIC_RELEASE, "agent");
            asm volatile("s_waitcnt vmcnt(0)" ::: "memory");
            const unsigned og = xb_add(&bar[XB_TOP], 1u);
            const unsigned tg = og / nx;
            if (og + 1u == (tg + 1u) * nx) xb_add(&bar[XB_TOPGEN], 1u);
            else XB_SPIN(xb_ld(&bar[XB_TOPGEN]) == tg, bar);
            __builtin_amdgcn_fence(__ATOMIC_ACQUIRE, "agent");
            xb_add(&bar[XB_XGEN(b.x)], 1u);
            asm volatile("s_waitcnt vmcnt(0)" ::: "memory");
        } else {
            XB_SPIN(xb_ld(&bar[XB_XGEN(b.x)]) == gen, bar);
            __builtin_amdgcn_fence(__ATOMIC_ACQUIRE, "agent");
            asm volatile("s_waitcnt vmcnt(0)" ::: "memory");
        }
    }
    __syncthreads();
}

struct Args { const float* in[20]; float* out; unsigned char* ws; int ph_lo, ph_hi; };
typedef const __attribute__((address_space(4))) Args* KArgs;
DI KArgs kargs() { KArgs p = (KArgs)__builtin_amdgcn_kernarg_segment_ptr(); asm volatile("" : "+s"(p)); return p; }
struct Ctx {
    float* out; unsigned char* ws;
    int tid, lane, wave, G, bid;
    int layer, slab;
    int nseq, seqlen;
    int stok, sbase;
    int dry;
};
#define WSP(T, off) ((T*)(c.ws + (off)))
#define BIGP(T, off) ((T*)(c.ws + WS_BIG + (off)))

__device__ const float INV_FREQ[32] = {1.000000000e+00f, 7.498942018e-01f, 5.623413324e-01f, 4.216965139e-01f, 3.162277639e-01f, 2.371373773e-01f, 1.778279394e-01f, 1.333521456e-01f, 1.000000015e-01f, 7.498942316e-02f, 5.623413250e-02f, 4.216964915e-02f, 3.162277490e-02f, 2.371373773e-02f, 1.778279431e-02f, 1.333521400e-02f, 9.999999776e-03f, 7.498942316e-03f, 5.623413250e-03f, 4.216964822e-03f, 3.162277630e-03f, 2.371373819e-03f, 1.778279431e-03f, 1.333521446e-03f, 1.000000047e-03f, 7.498941850e-04f, 5.623413017e-04f, 4.216965172e-04f, 3.162277571e-04f, 2.371373703e-04f, 1.778279402e-04f, 1.333521504e-04f};
DI void tr_item(const float* src, long src_ld, int src_col0, int nvalid, int kvalid, bf16_t* dst, long dst_ld, int dst_row0, int k0, LAS float* scr, int lane) {
    float tv[32];
#pragma unroll
    for (int i = 0; i < 32; ++i) { const int kk = 2 * i + (lane >> 5), cc = lane & 31;
        tv[i] = 0.f; if ((k0 + kk) < kvalid && cc < nvalid) tv[i] = src[(size_t)(k0 + kk) * src_ld + src_col0 + cc]; }
#pragma unroll
    for (int i = 0; i < 32; ++i) { const int kk = 2 * i + (lane >> 5), cc = lane & 31; scr[kk * 33 + cc] = tv[i]; }
    asm volatile("s_waitcnt lgkmcnt(0)" ::: "memory");
    const int c8 = lane & 7;
#pragma unroll
    for (int j = 0; j < 4; ++j) { const int n = (lane >> 3) + 8 * j; const LAS float* s = scr + (8 * c8) * 33 + n;
        u32x4 o; o.x = pk2(s[0 * 33], s[1 * 33]); o.y = pk2(s[2 * 33], s[3 * 33]); o.z = pk2(s[4 * 33], s[5 * 33]); o.w = pk2(s[6 * 33], s[7 * 33]);
        *(u32x4*)(dst + (size_t)(dst_row0 + n) * dst_ld + k0 + 8 * c8) = o; }
    asm volatile("s_waitcnt lgkmcnt(0)" ::: "memory");
}
DI void tr_item8(const float* src, long src_ld, int src_col0, int kvalid, unsigned char* dst, long dst_ld, int dst_row0, int k0, float scale, LAS float* scr, int lane) {
    float tv[32];
#pragma unroll
    for (int i = 0; i < 32; ++i) { const int kk = 2 * i + (lane >> 5), cc = lane & 31; tv[i] = 0.f; if ((k0 + kk) < kvalid) tv[i] = src[(size_t)(k0 + kk) * src_ld + src_col0 + cc]; }
#pragma unroll
    for (int i = 0; i < 32; ++i) { const int kk = 2 * i + (lane >> 5), cc = lane & 31; scr[kk * 33 + cc] = tv[i]; }
    asm volatile("s_waitcnt lgkmcnt(0)" ::: "memory");
    const int c8 = lane & 7;
#pragma unroll
    for (int j = 0; j < 4; ++j) { const int n = (lane >> 3) + 8 * j; const LAS float* s = scr + (8 * c8) * 33 + n;
        u32x2 o; o.x = pk4_fp8(s[0 * 33] * scale, s[1 * 33] * scale, s[2 * 33] * scale, s[3 * 33] * scale); o.y = pk4_fp8(s[4 * 33] * scale, s[5 * 33] * scale, s[6 * 33] * scale, s[7 * 33] * scale);
        *(u32x2*)(dst + (size_t)(dst_row0 + n) * dst_ld + k0 + 8 * c8) = o; }
    asm volatile("s_waitcnt lgkmcnt(0)" ::: "memory");
}
DI void phase_weights(KArgs args, LAS unsigned char* lds, const Ctx& c) {
    const int l = c.layer, lane = c.lane;
    LAS float* scr = (LAS float*)(lds + c.wave * 8448);
    const int gw = c.bid * 8 + c.wave, NGW = c.G * 8;
    constexpr int I_IN = 16 * 208, I_NA = 4 * 32, I_DIL = 2 * 32, I_GDN = 6 * 32, I_OUT = 16 * 32, I_GU1 = 16 * 128, I_D1 = 32 * 32;
    constexpr int NITEMS = I_IN + I_NA + I_DIL + I_GDN + I_OUT + 16 * I_GU1 + 16 * I_D1;
    for (int it = gw; it < NITEMS; it += NGW) {
        int r = it;
        const float* src; long sld; int sc0, nv = 32, kv; bf16_t* dst; long dld; int dr0, k0;
        if (r < I_IN) { const int kb = r / 208, nb = r % 208, n0 = 32 * nb; src = args->in[2] + (size_t)l * D * DIN; sld = DIN; kv = D;
            if (n0 < 3072) { sc0 = 3480 + n0; } else { sc0 = n0 - 3072; nv = DIN - n0; if (nv < 0) { nv = 0; sc0 = 0; } }
            dst = WSP(bf16_t, WS_WIN); dld = D; dr0 = n0; k0 = 64 * kb; }
        else if ((r -= I_IN) < I_NA) { const int kb = r / 32, nb = r % 32; src = args->in[8] + (size_t)l * 256 * D; sld = D; sc0 = 32 * nb; kv = 256; dst = WSP(bf16_t, WS_WBR); dld = 768; dr0 = 32 * nb; k0 = 64 * kb; }
        else if ((r -= I_NA) < I_DIL) { const int kb = r / 32, nb = r % 32; src = args->in[9] + (size_t)l * 128 * D; sld = D; sc0 = 32 * nb; kv = 128; dst = WSP(bf16_t, WS_WBR) + 256; dld = 768; dr0 = 32 * nb; k0 = 64 * kb; }
        else if ((r -= I_DIL) < I_GDN) { const int kb = r / 32, nb = r % 32; src = args->in[10] + (size_t)l * 384 * D; sld = D; sc0 = 32 * nb; kv = 384; dst = WSP(bf16_t, WS_WBR) + 384; dld = 768; dr0 = 32 * nb; k0 = 64 * kb; }
        else if ((r -= I_GDN) < I_OUT) { const int kb = r / 32, nb = r % 32; src = args->in[11] + (size_t)l * D * D; sld = D; sc0 = 32 * nb; kv = D; dst = WSP(bf16_t, WS_WOUT); dld = D; dr0 = 32 * nb; k0 = 64 * kb; }
        else if ((r -= I_OUT) < 16 * I_GU1) { const int e = r / I_GU1, q = r % I_GU1, kb = q / 128, nb = q % 128, n0 = 32 * nb, j = n0 >> 8, rr = n0 & 255;
            tr_item8((rr < 128 ? args->in[16] : args->in[15]) + ((size_t)l * NE + e) * D * DE, DE, 128 * j + (rr & 127), D, WSP(unsigned char, WS_WGU) + (size_t)e * 4096 * D, D, n0, 64 * kb, 32.0f, scr, lane); continue; }
        else { r -= 16 * I_GU1; const int e = r / I_D1, q = r % I_D1, kb = q / 32, nb = q % 32;
            tr_item8(args->in[17] + ((size_t)l * NE + e) * DE * D, D, 32 * nb, DE, WSP(unsigned char, WS_WD) + (size_t)e * D * DE, DE, 32 * nb, 64 * kb, 32.0f, scr, lane); continue; }
        tr_item(src, sld, sc0, nv, kv, dst, dld, dr0, k0, scr, lane);
    }
    if (l == 0) {
        for (int t = gw; t < T_ALL; t += NGW) {
            const float* xr = (t < T_P) ? args->in[0] + (size_t)t * D : args->in[1] + (size_t)(t - T_P) * D;
            bf16_t* o = WSP(bf16_t, WS_XB) + (size_t)t * D;
#pragma unroll
            for (int j = 0; j < 4; ++j) { const f32x4 v = *(const f32x4*)(xr + 4 * lane + 256 * j); u32x2 w; w.x = pk2(v[0], v[1]); w.y = pk2(v[2], v[3]); *(u32x2*)(o + 4 * lane + 256 * j) = w; }
        }
        float* cs = WSP(float, WS_CS);
        for (int i = c.bid * 512 + c.tid; i < 16384 * 32; i += c.G * 512) { const int pos = i >> 5, k = i & 31;
            const float inv = INV_FREQ[k];
            const float ang = (float)pos * inv;
            cs[pos * 64 + k] = cosf(ang); cs[pos * 64 + 32 + k] = sinf(ang); }
    }
}

constexpr int TLD = 72, TILEB = 64 * TLD * 2;
DI int tsw(int row) { return ((row >> 4) & 3) << 3; }
template <bool SA = false, bool SB = false> DI f32x16 mm_tile(const LAS bf16_t* A, const LAS bf16_t* Bt, int m0, int n0, int lane) {
    f32x16 acc = zero16(); const int r = lane & 31, hh = lane >> 5; const int sa = SA ? tsw(m0 + r) : 0, sb = SB ? tsw(n0 + r) : 0;
#pragma unroll
    for (int ks = 0; ks < 4; ++ks) { const bf16x8 a = *(const LAS bf16x8*)(A + (m0 + r) * TLD + ((16 * ks + 8 * hh) ^ sa)); const bf16x8 b = *(const LAS bf16x8*)(Bt + (n0 + r) * TLD + ((16 * ks + 8 * hh) ^ sb)); acc = MFMA32(a, b, acc); }
    return acc;
}

constexpr int PI_P0 = 0, PI_P1 = 9216, PI_INTRA = 18432, PI_AM = 27648, PI_TT = 45056, PI_TD0 = 54272, PI_TD1 = 60416, PI_PM = 65024, PI_VEC = 71168, PI_BYTES = 72704;
constexpr int PI_WT = PI_AM, PI_UT = PI_TD0;
DI void gdn_prep_pair(KArgs args, LAS unsigned char* L0, const Ctx& c, int pu) {
    int tid = c.tid; asm volatile("" : "+v"(tid)); const int lane = tid & 63, wave = __builtin_amdgcn_readfirstlane(tid >> 6), l = c.layer;
    const int dir = wave >> 2, wg = wave & 3, tg = tid & 255, head = pu % 6, gch = pu / 6, inst = (gch * 6 + head) * 2 + dir;
    const int cps = c.seqlen >> 6, seq = gch / cps, n = gch % cps;
    const bf16_t* PROJ = BIGP(bf16_t, B_PROJ); const float* BA = BIGP(float, B_BA);
    unsigned char* G = BIGP(unsigned char, B_GSCR) + (size_t)inst * GSTRIDE;
    LAS unsigned char* L = L0 + dir * PI_BYTES;
    LAS bf16_t* P0 = (LAS bf16_t*)(L + PI_P0); LAS bf16_t* P1 = (LAS bf16_t*)(L + PI_P1); LAS bf16_t* INTRA = (LAS bf16_t*)(L + PI_INTRA);
    LAS float* AM = (LAS float*)(L + PI_AM); LAS bf16_t* TT = (LAS bf16_t*)(L + PI_TT);
    LAS float* TD0 = (LAS float*)(L + PI_TD0); LAS float* TD1 = (LAS float*)(L + PI_TD1); LAS float* PM = (LAS float*)(L + PI_PM);
    LAS float* GV = (LAS float*)(L + PI_VEC); LAS float* BV = GV + 64; LAS float* GC = GV + 128;
    LAS bf16_t* WT = (LAS bf16_t*)(L + PI_WT); LAS bf16_t* UT = (LAS bf16_t*)(L + PI_UT);
    const int ia = tg >> 3, p = tg & 7;
    float q[2][8], k[2][8], v[2][8];
#pragma unroll
    for (int h2 = 0; h2 < 2; ++h2)
#pragma unroll
        for (int j = 0; j < 8; ++j) { q[h2][j] = 0.f; k[h2][j] = 0.f; v[h2][j] = 0.f; }
    const float* cw = args->in[4] + (size_t)l * 5 * 1152 + 64 * head + 8 * p;
#pragma unroll
    for (int tp = 0; tp < 5; ++tp) { const float* w = cw + tp * 1152;
        const f32x4 wq0 = *(const f32x4*)w, wq1 = *(const f32x4*)(w + 4), wk0 = *(const f32x4*)(w + 384), wk1 = *(const f32x4*)(w + 388), wv0 = *(const f32x4*)(w + 768), wv1 = *(const f32x4*)(w + 772);
#pragma unroll
        for (int h2 = 0; h2 < 2; ++h2) { const int i = ia + 32 * h2, tokl = dir ? 63 - i : i, pp = n * 64 + tokl + tp - 2;
            if (pp >= 0 && pp < c.seqlen) { const bf16_t* rp = PROJ + (size_t)(seq * c.seqlen + pp) * NPROJ + 64 * head + 8 * p;
                const u32x4 rq = *(const u32x4*)(rp + C_QC), rk = *(const u32x4*)(rp + C_KC), rv = *(const u32x4*)(rp + C_VC);
#pragma unroll
                for (int j = 0; j < 4; ++j) { const float a0 = (j < 2) ? wq0[2 * j] : wq1[2 * j - 4], a1 = (j < 2) ? wq0[2 * j + 1] : wq1[2 * j - 3];
                    const float b0 = (j < 2) ? wk0[2 * j] : wk1[2 * j - 4], b1 = (j < 2) ? wk0[2 * j + 1] : wk1[2 * j - 3];
                    const float c0 = (j < 2) ? wv0[2 * j] : wv1[2 * j - 4], c1 = (j < 2) ? wv0[2 * j + 1] : wv1[2 * j - 3];
                    q[h2][2 * j] += a0 * bflo(rq[j]); q[h2][2 * j + 1] += a1 * bfhi(rq[j]);
                    k[h2][2 * j] += b0 * bflo(rk[j]); k[h2][2 * j + 1] += b1 * bfhi(rk[j]);
                    v[h2][2 * j] += c0 * bflo(rv[j]); v[h2][2 * j + 1] += c1 * bfhi(rv[j]); } } } }
#pragma unroll
    for (int h2 = 0; h2 < 2; ++h2) { float sq = 0.f, sk = 0.f;
#pragma unroll
        for (int j = 0; j < 8; ++j) { q[h2][j] = siluf_(q[h2][j]); k[h2][j] = siluf_(k[h2][j]); v[h2][j] = siluf_(v[h2][j]); sq += q[h2][j] * q[h2][j]; sk += k[h2][j] * k[h2][j]; }
        sq += __shfl_xor(sq, 1); sq += __shfl_xor(sq, 2); sq += __shfl_xor(sq, 4);
        sk += __shfl_xor(sk, 1); sk += __shfl_xor(sk, 2); sk += __shfl_xor(sk, 4);
        const float rq_ = 0.125f * frsq(sq + NORM_EPS), rk_ = frsq(sk + NORM_EPS);
#pragma unroll
        for (int j = 0; j < 8; ++j) { q[h2][j] *= rq_; k[h2][j] *= rk_; }
        if (p == 0) { const int i = ia + 32 * h2, tokl = dir ? 63 - i : i; const float* bar = BA + (size_t)(seq * c.seqlen + n * 64 + tokl) * 32;
            const float bl = bar[dir * 6 + head], al = bar[12 + dir * 6 + head];
            const float xx = al + args->in[6][l * 12 + dir * 6 + head];
            const float sp = xx > 20.f ? xx : log1pf(expf(xx));
            GV[i] = -expf(args->in[5][l * 12 + dir * 6 + head]) * sp; BV[i] = sigmoidf_(bl); } }
    __syncthreads();
    float gcl_;
    { float x = GV[lane];
#pragma unroll
        for (int o = 1; o < 64; o <<= 1) { const float y = __shfl_up(x, o); if (lane >= o) x += y; }
        if (wg == 0) GC[lane] = x;
        gcl_ = x; }
    const float gc0 = __shfl(gcl_, ia), gc1 = __shfl(gcl_, ia + 32), gcl = __shfl(gcl_, 63);
#pragma unroll
    for (int h2 = 0; h2 < 2; ++h2) { const int i = ia + 32 * h2; u32x4 wq, wk;
#pragma unroll
        for (int j = 0; j < 4; ++j) { wq[j] = pk2(q[h2][2 * j], q[h2][2 * j + 1]); wk[j] = pk2(k[h2][2 * j], k[h2][2 * j + 1]); }
        *(LAS u32x4*)(P0 + i * TLD + 8 * p) = wq; *(LAS u32x4*)(P1 + i * TLD + 8 * p) = wk; }
    __syncthreads();
    { const int mat = wg >> 1, mt = wg & 1, hh = lane >> 5;
#pragma unroll
        for (int nt = 0; nt < 2; ++nt) { const int jc = 32 * nt + (lane & 31);
            const f32x16 a = mm_tile(mat ? P0 : P1, P1, 32 * mt, 32 * nt, lane);
            const float gj = GC[jc];
#pragma unroll
            for (int r = 0; r < 16; ++r) { const int ii = 32 * mt + crow(r, hh); const float gi = GC[ii];
                if (mat == 0) AM[ii * 68 + jc] = (jc < ii) ? BV[ii] * a[r] * __expf(gi - gj) : 0.f;
                else INTRA[ii * TLD + jc] = (bf16_t)(pk2((jc <= ii) ? a[r] * __expf(gi - gj) : 0.f, 0.f) & 0xffffu); } } }
    __syncthreads();
    if (wg == dir) {
        const int b = lane >> 5, cidx = lane & 31; float t[32];
#pragma unroll
        for (int ii = 0; ii < 32; ++ii) t[ii] = (ii == cidx) ? 1.f : 0.f;
        const LAS float* Ab = AM + (32 * b) * 68 + 32 * b;
#pragma unroll
        for (int ii = 1; ii < 32; ++ii) { float acc = 0.f;
#pragma unroll
            for (int j4 = 0; j4 < ii; j4 += 4) { const f32x4 a4 = *(const LAS f32x4*)(Ab + ii * 68 + j4);
                acc += a4[0] * t[j4]; acc += a4[1] * t[j4 + 1]; acc += a4[2] * t[j4 + 2]; acc += a4[3] * t[j4 + 3]; }
            t[ii] -= acc; }
        LAS float* td = b ? TD1 : TD0; const int tds = b ? 36 : 48;
#pragma unroll
        for (int ii = 0; ii < 32; ++ii) { td[ii * tds + cidx] = t[ii]; TT[(32 * b + ii) * TLD + 32 * b + cidx] = (bf16_t)(pk2(t[ii], 0.f) & 0xffffu); }
    }
#pragma unroll
    for (int h2 = 0; h2 < 2; ++h2) { const int i = ia + 32 * h2; const float be = BV[i], eg = __expf(h2 ? gc1 : gc0);
#pragma unroll
        for (int j = 0; j < 8; ++j) { const int d = 8 * p + j, o_ = d * TLD + (i ^ tsw(d)); P0[o_] = (bf16_t)(pk2(k[h2][j] * be * eg, 0.f) & 0xffffu); P1[o_] = (bf16_t)(pk2(v[h2][j] * be, 0.f) & 0xffffu); } }
    { unsigned zz; asm volatile("v_mov_b32 %0, 0" : "=v"(zz)); u32x2 z; z.x = zz; z.y = zz; *(LAS u32x2*)(TT + (tg >> 3) * TLD + 32 + 4 * (tg & 7)) = z; }
    __syncthreads();
    { const int qi = wg >> 1, qj = wg & 1, r16 = lane & 15, g4 = lane >> 4; f32x4 pc = {0.f, 0.f, 0.f, 0.f};
#pragma unroll
        for (int kk = 0; kk < 8; ++kk) pc = __builtin_amdgcn_mfma_f32_16x16x4f32(AM[(32 + 16 * qi + r16) * 68 + 4 * kk + g4], TD0[(4 * kk + g4) * 48 + 16 * qj + r16], pc, 0, 0, 0);
#pragma unroll
        for (int r = 0; r < 4; ++r) PM[(16 * qi + 4 * g4 + r) * 48 + 16 * qj + r16] = pc[r]; }
    __syncthreads();
    { const int qi = wg >> 1, qj = wg & 1, r16 = lane & 15, g4 = lane >> 4; f32x4 pc = {0.f, 0.f, 0.f, 0.f};
#pragma unroll
        for (int kk = 0; kk < 8; ++kk) pc = __builtin_amdgcn_mfma_f32_16x16x4f32(TD1[(16 * qi + r16) * 36 + 4 * kk + g4], PM[(4 * kk + g4) * 48 + 16 * qj + r16], pc, 0, 0, 0);
#pragma unroll
        for (int r = 0; r < 4; ++r) TT[(32 + 16 * qi + 4 * g4 + r) * TLD + 16 * qj + r16] = (bf16_t)(pk2(-pc[r], 0.f) & 0xffffu); }
    __syncthreads();
    { const int which = wg >> 1, mt = wg & 1, hh = lane >> 5;
#pragma unroll
        for (int nt = 0; nt < 2; ++nt) { const int dc = 32 * nt + (lane & 31);
            const f32x16 a = mm_tile<false, true>(TT, which ? P1 : P0, 32 * mt, 32 * nt, lane);
            LAS bf16_t* dst = (which ? UT : WT) + dc * TLD; const int sw = tsw(dc);
#pragma unroll
            for (int g = 0; g < 4; ++g) { u32x2 w; w.x = pk2(a[4 * g], a[4 * g + 1]); w.y = pk2(a[4 * g + 2], a[4 * g + 3]); *(LAS u32x2*)(dst + ((32 * mt + 8 * g + 4 * hh) ^ sw)) = w; } } }
    __syncthreads();
#pragma unroll
    for (int h2 = 0; h2 < 2; ++h2) { const int i = ia + 32 * h2; const float gci = h2 ? gc1 : gc0, eg = __expf(gci), ekd = __expf(gcl - gci); u32x4 wqd;
#pragma unroll
        for (int j = 0; j < 4; ++j) wqd[j] = pk2(q[h2][2 * j] * eg, q[h2][2 * j + 1] * eg);
        *(LAS u32x4*)(P1 + i * TLD + 8 * p) = wqd;
#pragma unroll
        for (int j = 0; j < 8; ++j) { const int d = 8 * p + j; P0[d * TLD + (i ^ tsw(d))] = (bf16_t)(pk2(k[h2][j] * ekd, 0.f) & 0xffffu); } }
    __syncthreads();
    { const int hh = lane >> 5, rr = lane & 31;
        if (wg == 0) {
#pragma unroll
            for (int t4 = 0; t4 < 4; ++t4) { const int mtb = t4 >> 1, nta = t4 & 1; const f32x16 a = mm_tile<true, true>(WT, P0, 32 * mtb, 32 * nta, lane);
                f32x16 na; for (int r = 0; r < 16; ++r) na[r] = -a[r];
                *(bf16x8*)(G + (size_t)((nta * 4 + 2 * mtb) * 64 + lane) * 16) = pack8<0>(na); *(bf16x8*)(G + (size_t)((nta * 4 + 2 * mtb + 1) * 64 + lane) * 16) = pack8<1>(na); }
        } else if (wg == 1) {
#pragma unroll
            for (int t4 = 0; t4 < 4; ++t4) { const int mta = t4 >> 1, nte = t4 & 1; const f32x16 a = mm_tile<true, true>(P0, UT, 32 * mta, 32 * nte, lane);
                bf16x8* dp = (bf16x8*)(G + 8192 + (size_t)((nte * 2 + mta) * 64 + lane) * 32); dp[0] = pack8<0>(a); dp[1] = pack8<1>(a); }
        } else if (wg == 2) {
#pragma unroll
            for (int t4 = 0; t4 < 4; ++t4) { const int mtb = t4 >> 1, nti = t4 & 1; const f32x16 a = mm_tile<true, false>(WT, INTRA, 32 * mtb, 32 * nti, lane);
                f32x16 qe; const LAS bf16_t* qd = P1 + (32 * nti + rr) * TLD + 32 * mtb + 4 * hh;
#pragma unroll
                for (int g = 0; g < 4; ++g) { const u32x2 w = *(const LAS u32x2*)(qd + 8 * g); qe[4 * g] = bflo(w.x) - a[4 * g]; qe[4 * g + 1] = bfhi(w.x) - a[4 * g + 1]; qe[4 * g + 2] = bflo(w.y) - a[4 * g + 2]; qe[4 * g + 3] = bfhi(w.y) - a[4 * g + 3]; }
                *(bf16x8*)(G + 16384 + (size_t)((nti * 4 + 2 * mtb) * 64 + lane) * 16) = pack8<0>(qe); *(bf16x8*)(G + 16384 + (size_t)((nti * 4 + 2 * mtb + 1) * 64 + lane) * 16) = pack8<1>(qe); }
        } else {
#pragma unroll
            for (int t4 = 0; t4 < 4; ++t4) { const int mti = t4 >> 1, nte = t4 & 1; const f32x16 a = mm_tile<false, true>(INTRA, UT, 32 * mti, 32 * nte, lane);
                bf16_t* dst = (bf16_t*)(G + 24576) + (size_t)(32 * nte + rr) * 64 + 32 * mti + 4 * hh;
#pragma unroll
                for (int g = 0; g < 4; ++g) { u32x2 w; w.x = pk2(a[4 * g], a[4 * g + 1]); w.y = pk2(a[4 * g + 2], a[4 * g + 3]); *(u32x2*)(dst + 8 * g) = w; } }
            if (lane == 0) *(float*)(G + 40960) = __expf(gcl);
        } }
    __syncthreads();
}

DI void pv_accum(const f32x16 (&acc)[2][2], f32x16 (&o)[2][2], const LAS bf16_t* Vt, int lane) {
    const int r = lane & 31, hh = lane >> 5;
#pragma unroll
    for (int mt = 0; mt < 2; ++mt) {
        {   const bf16x8 p0 = pack8<0>(acc[mt][0]), p1 = pack8<0>(acc[mt][1]);
#pragma unroll
            for (int mo = 0; mo < 2; ++mo) { const LAS bf16_t* s = Vt + (32 * mo + r) * TLD; const int c0 = (32 * mt + 4 * hh) ^ tsw(32 * mo + r);
                const u32x2 lo = *(const LAS u32x2*)(s + c0), hi = *(const LAS u32x2*)(s + (c0 ^ 8)); u32x4 w; w.x = lo.x; w.y = lo.y; w.z = hi.x; w.w = hi.y; const bf16x8 vf = __builtin_bit_cast(bf16x8, w);
                o[mo][0] = MFMA32(vf, p0, o[mo][0]); o[mo][1] = MFMA32(vf, p1, o[mo][1]); } }
        {   const bf16x8 p0 = pack8<1>(acc[mt][0]), p1 = pack8<1>(acc[mt][1]);
#pragma unroll
            for (int mo = 0; mo < 2; ++mo) { const LAS bf16_t* s = Vt + (32 * mo + r) * TLD; const int c0 = (32 * mt + 16 + 4 * hh) ^ tsw(32 * mo + r);
                const u32x2 lo = *(const LAS u32x2*)(s + c0), hi = *(const LAS u32x2*)(s + (c0 ^ 8)); u32x4 w; w.x = lo.x; w.y = lo.y; w.z = hi.x; w.w = hi.y; const bf16x8 vf = __builtin_bit_cast(bf16x8, w);
                o[mo][0] = MFMA32(vf, p0, o[mo][0]); o[mo][1] = MFMA32(vf, p1, o[mo][1]); } }
    }
}
template <class F> DI void stage_vt(LAS bf16_t* Vt, int lane, F vrow) {
#pragma unroll
    for (int it = 0; it < 8; ++it) { const int id = it * 64 + lane, key = id >> 3, part = id & 7;
        const u32x4 w = *(const u32x4*)(vrow(key) + 8 * part);
#pragma unroll
        for (int j = 0; j < 4; ++j) { const int d0 = 8 * part + 2 * j, ks_ = key ^ tsw(d0); Vt[d0 * TLD + ks_] = (bf16_t)(w[j] & 0xffffu); Vt[(d0 + 1) * TLD + ks_] = (bf16_t)(w[j] >> 16); } }
}
DI void write_o_slot(LAS float* SL, const f32x16 (&o)[2][2], int lane) {
    const int r = lane & 31, hh = lane >> 5;
#pragma unroll
    for (int mo = 0; mo < 2; ++mo)
#pragma unroll
        for (int nt = 0; nt < 2; ++nt)
#pragma unroll
            for (int g = 0; g < 4; ++g) { f32x4 v; v[0] = o[mo][nt][4 * g]; v[1] = o[mo][nt][4 * g + 1]; v[2] = o[mo][nt][4 * g + 2]; v[3] = o[mo][nt][4 * g + 3];
                *(LAS f32x4*)(SL + (32 * nt + r) * 68 + 32 * mo + 8 * g + 4 * hh) = v; }
}
DI void add_o_slot(const LAS float* SL, f32x16 (&o)[2][2], int lane) {
    const int r = lane & 31, hh = lane >> 5;
#pragma unroll
    for (int mo = 0; mo < 2; ++mo)
#pragma unroll
        for (int nt = 0; nt < 2; ++nt)
#pragma unroll
            for (int g = 0; g < 4; ++g) { const f32x4 v = *(const LAS f32x4*)(SL + (32 * nt + r) * 68 + 32 * mo + 8 * g + 4 * hh);
                o[mo][nt][4 * g] += v[0]; o[mo][nt][4 * g + 1] += v[1]; o[mo][nt][4 * g + 2] += v[2]; o[mo][nt][4 * g + 3] += v[3]; }
}

constexpr int WAREA = 10240;
DI void osm_update(f32x16 (&acc)[2][2], f32x16 (&o)[2][2], float (&m)[2], float (&l)[2]) {
#pragma unroll
    for (int nt = 0; nt < 2; ++nt) { float mx = -1e30f;
#pragma unroll
        for (int mt = 0; mt < 2; ++mt)
#pragma unroll
            for (int g = 0; g < 16; ++g) mx = fmaxf(mx, acc[mt][nt][g]);
        mx = fmaxf(mx, __shfl_xor(mx, 32));
        const float mn = fmaxf(m[nt], mx), sc = __expf(m[nt] - mn); float sm = 0.f;
#pragma unroll
        for (int mt = 0; mt < 2; ++mt)
#pragma unroll
            for (int g = 0; g < 16; ++g) { const float pz = __expf(acc[mt][nt][g] - mn); acc[mt][nt][g] = pz; sm += pz; }
        sm += __shfl_xor(sm, 32);
        l[nt] = l[nt] * sc + sm; m[nt] = mn;
#pragma unroll
        for (int g = 0; g < 16; ++g) { o[0][nt][g] *= sc; o[1][nt][g] *= sc; } }
}
template <class F> DI void store_o_rows(LAS bf16_t* T, const f32x16 (&o)[2][2], const float (&scale)[2], int lane, F rowp) {
    const int r = lane & 31, hh = lane >> 5;
#pragma unroll
    for (int mo = 0; mo < 2; ++mo)
#pragma unroll
        for (int nt = 0; nt < 2; ++nt)
#pragma unroll
            for (int g = 0; g < 4; ++g) { u32x2 w; w.x = pk2(o[mo][nt][4 * g] * scale[nt], o[mo][nt][4 * g + 1] * scale[nt]); w.y = pk2(o[mo][nt][4 * g + 2] * scale[nt], o[mo][nt][4 * g + 3] * scale[nt]);
                *(LAS u32x2*)(T + (32 * nt + r) * TLD + 32 * mo + 8 * g + 4 * hh) = w; }
    asm volatile("s_waitcnt lgkmcnt(0)" ::: "memory");
#pragma unroll
    for (int it = 0; it < 8; ++it) { const int id = it * 64 + lane, q = id >> 3, part = id & 7; *(u32x4*)(rowp(q) + 8 * part) = *(const LAS u32x4*)(T + q * TLD + 8 * part); }
    asm volatile("s_waitcnt lgkmcnt(0)" ::: "memory");
}
DI void na_wave_unit(KArgs args, LAS unsigned char* L, const Ctx& c, int u, int lane, int wave) {
    const int l = c.layer, head = u & 3, gr = u >> 2, rows = c.seqlen >> 6, seq = gr / rows, r = gr % rows;
    int rs = r - 4; rs = rs < 0 ? 0 : (rs > rows - 8 ? rows - 8 : rs);
    const bf16_t* PROJ = BIGP(bf16_t, B_PROJ);
    const size_t tq0 = (size_t)seq * c.seqlen + (size_t)r * 64;
    LAS bf16_t* Vt = (LAS bf16_t*)(L + wave * WAREA);
    LAS float* BIAS = (LAS float*)(L + wave * WAREA + 9216);
    const int rr = lane & 31, hh = lane >> 5;
#pragma unroll
    for (int w = 0; w < 4; ++w) { const int idx = w * 64 + lane, kw = idx >> 5, dc = idx & 31;
        if (dc < 31) BIAS[idx] = args->in[3][(((size_t)l * 4 + head) * 15 + (rs + kw - r + 7)) * 31 + dc]; }
    bf16x8 qf[2][4];
#pragma unroll
    for (int nt = 0; nt < 2; ++nt)
#pragma unroll
        for (int ks = 0; ks < 4; ++ks) qf[nt][ks] = *(const bf16x8*)(PROJ + (tq0 + 32 * nt + rr) * NPROJ + C_QA + 64 * head + 16 * ks + 8 * hh);
    f32x16 o[2][2]; o[0][0] = zero16(); o[0][1] = zero16(); o[1][0] = zero16(); o[1][1] = zero16();
    float m[2] = {-1e30f, -1e30f}, ls[2] = {0.f, 0.f};
    for (int w = 0; w < 8; ++w) {
        const size_t tk0 = (size_t)seq * c.seqlen + (size_t)(rs + w) * 64;
        asm volatile("s_waitcnt lgkmcnt(0)" ::: "memory");
        stage_vt(Vt, lane, [&](int key) { return PROJ + (tk0 + key) * NPROJ + C_VA + 64 * head; });
        f32x16 acc[2][2]; acc[0][0] = zero16(); acc[0][1] = zero16(); acc[1][0] = zero16(); acc[1][1] = zero16();
#pragma unroll
        for (int mt = 0; mt < 2; ++mt)
#pragma unroll
            for (int ks = 0; ks < 4; ++ks) { const bf16x8 kf = *(const bf16x8*)(PROJ + (tk0 + 32 * mt + rr) * NPROJ + C_KA + 64 * head + 16 * ks + 8 * hh);
                acc[mt][0] = MFMA32(kf, qf[0][ks], acc[mt][0]); acc[mt][1] = MFMA32(kf, qf[1][ks], acc[mt][1]); }
        asm volatile("s_waitcnt lgkmcnt(0)" ::: "memory");
        const LAS float* brow = BIAS + w * 32;
#pragma unroll
        for (int nt = 0; nt < 2; ++nt) { const int qc = 32 * nt + rr; int ws = qc - 8; ws = ws < 0 ? 0 : (ws > 48 ? 48 : ws);
#pragma unroll
            for (int mt = 0; mt < 2; ++mt)
#pragma unroll
                for (int g = 0; g < 16; ++g) { const int kc = 32 * mt + crow(g, hh); const bool ok = (kc >= ws) && (kc < ws + 16);
                    acc[mt][nt][g] = ok ? acc[mt][nt][g] * 0.125f + brow[ok ? (kc - qc + 15) : 0] : -1e30f; } }
        osm_update(acc, o, m, ls);
        pv_accum(acc, o, Vt, lane);
    }
    asm volatile("s_waitcnt lgkmcnt(0)" ::: "memory");
    const float sc[2] = {frcp(ls[0]), frcp(ls[1])};
    store_o_rows(Vt, o, sc, lane, [&](int q) { return BIGP(bf16_t, B_ONA) + (tq0 + q) * 768 + 64 * head; });
}
DI void rope_frag4(bf16x8 (&f)[4], const float* cs, int hh) {
#pragma unroll
    for (int ks = 0; ks < 2; ++ks) { const float* cp = cs + 16 * ks + 8 * hh;
        const f32x4 c0 = *(const f32x4*)cp, c1 = *(const f32x4*)(cp + 4), s0 = *(const f32x4*)(cp + 32), s1 = *(const f32x4*)(cp + 36);
        const u32x4 a = __builtin_bit_cast(u32x4, f[ks]), b = __builtin_bit_cast(u32x4, f[ks + 2]); u32x4 ra, rb;
#pragma unroll
        for (int j = 0; j < 4; ++j) { const float cl = (j < 2) ? c0[2 * j] : c1[2 * j - 4], ch = (j < 2) ? c0[2 * j + 1] : c1[2 * j - 3];
            const float sl = (j < 2) ? s0[2 * j] : s1[2 * j - 4], sh = (j < 2) ? s0[2 * j + 1] : s1[2 * j - 3];
            const float x1l = bflo(a[j]), x1h = bfhi(a[j]), x2l = bflo(b[j]), x2h = bfhi(b[j]);
            ra[j] = pk2(x1l * cl - x2l * sl, x1h * ch - x2h * sh); rb[j] = pk2(x1l * sl + x2l * cl, x1h * sh + x2h * ch); }
        f[ks] = __builtin_bit_cast(bf16x8, ra); f[ks + 2] = __builtin_bit_cast(bf16x8, rb); }
}
DI void dil_wave_unit(KArgs args, LAS unsigned char* L, const Ctx& c, int u, int lane, int wave) {
    const int hd = u & 1, uu = u >> 1, upg = c.stok >> 6, g = uu / upg, v = uu % upg, ups = c.seqlen >> 6, seq = v / ups, wq = v % ups;
    const int dsh = 2 * g, dd = 1 << dsh, nb = ups >> dsh, cls = wq / nb, jb = wq % nb, head = 2 * g + hd;
    const bf16_t* PROJ = BIGP(bf16_t, B_PROJ); const float* CS = WSP(float, WS_CS);
    const size_t sb = (size_t)seq * c.seqlen;
    const int rr = lane & 31, hh = lane >> 5;
    LAS bf16_t* Vt = (LAS bf16_t*)(L + wave * WAREA);
    bf16x8 qf[2][4];
#pragma unroll
    for (int nt = 0; nt < 2; ++nt) { const int pos = cls + dd * (64 * jb + 32 * nt + rr);
#pragma unroll
        for (int ks = 0; ks < 4; ++ks) qf[nt][ks] = *(const bf16x8*)(PROJ + (sb + pos) * NPROJ + C_QD + 64 * head + 16 * ks + 8 * hh);
        rope_frag4(qf[nt], CS + (size_t)pos * 64, hh); }
    f32x16 o[2][2]; o[0][0] = zero16(); o[0][1] = zero16(); o[1][0] = zero16(); o[1][1] = zero16();
    float m[2] = {-1e30f, -1e30f}, ls[2] = {0.f, 0.f};
    for (int kt = 0; kt < 3; ++kt) { const int kj = jb - 1 + kt;
        if (kj < 0 || kj >= nb) continue;
        asm volatile("s_waitcnt lgkmcnt(0)" ::: "memory");
        stage_vt(Vt, lane, [&](int key) { return PROJ + (sb + cls + (size_t)dd * (64 * kj + key)) * NPROJ + C_VD + 64 * head; });
        f32x16 acc[2][2]; acc[0][0] = zero16(); acc[0][1] = zero16(); acc[1][0] = zero16(); acc[1][1] = zero16();
#pragma unroll
        for (int mt = 0; mt < 2; ++mt) { const int pos = cls + dd * (64 * kj + 32 * mt + rr); bf16x8 kf[4];
#pragma unroll
            for (int ks = 0; ks < 4; ++ks) kf[ks] = *(const bf16x8*)(PROJ + (sb + pos) * NPROJ + C_KD + 64 * head + 16 * ks + 8 * hh);
            rope_frag4(kf, CS + (size_t)pos * 64, hh);
#pragma unroll
            for (int ks = 0; ks < 4; ++ks) { acc[mt][0] = MFMA32(kf[ks], qf[0][ks], acc[mt][0]); acc[mt][1] = MFMA32(kf[ks], qf[1][ks], acc[mt][1]); } }
#pragma unroll
        for (int nt = 0; nt < 2; ++nt) { const int qc = 32 * nt + rr;
#pragma unroll
            for (int mt = 0; mt < 2; ++mt)
#pragma unroll
                for (int gg = 0; gg < 16; ++gg) { const int kc = 32 * mt + crow(gg, hh); const bool ok = (kt == 1) || (kt == 0 ? (kc >= qc) : (kc <= qc));
                    acc[mt][nt][gg] = ok ? acc[mt][nt][gg] * 0.125f : -1e30f; } }
        osm_update(acc, o, m, ls);
        pv_accum(acc, o, Vt, lane);
    }
    asm volatile("s_waitcnt lgkmcnt(0)" ::: "memory");
    bf16_t* DP = BIGP(bf16_t, B_DILP); float* DM = BIGP(float, B_DILM);
    const float one[2] = {1.f, 1.f};
    store_o_rows(Vt, o, one, lane, [&](int q) { return DP + ((((size_t)g * SLABMAX + sb + cls + (size_t)dd * (64 * jb + q)) * 2 + hd)) * 64; });
    if (hh == 0) {
#pragma unroll
        for (int nt = 0; nt < 2; ++nt) { const size_t base = (((size_t)g * SLABMAX + sb + cls + (size_t)dd * (64 * jb + 32 * nt + rr)) * 2 + hd); DM[base * 2] = m[nt]; DM[base * 2 + 1] = ls[nt]; } }
}

DI void phase_mix_a(KArgs args, LAS unsigned char* L, const Ctx& c) {
    const int N_PREP = (c.stok >> 6) * 6;
    for (int u = c.bid; u < N_PREP; u += c.G) gdn_prep_pair(args, L, c, u);
}
DI void attn_wave_units(KArgs args, LAS unsigned char* L, const Ctx& c) {
    int tid = c.tid; asm volatile("" : "+v"(tid)); const int lane = tid & 63, wave = __builtin_amdgcn_readfirstlane(tid >> 6);
    const int nch_ = c.stok >> 6, N_NA = nch_ * 4, N_DIL = nch_ * 6;
    unsigned* q = (unsigned*)(c.ws + WS_CTL) + 32768 + 128 * (c.layer * 4 + c.slab);
    for (;;) { unsigned u = 0; if (lane == 0) u = __hip_atomic_fetch_add(q, 1u, __ATOMIC_RELAXED, __HIP_MEMORY_SCOPE_AGENT);
        u = (unsigned)__builtin_amdgcn_readfirstlane((int)u); if (u >= (unsigned)N_NA) break; na_wave_unit(args, L, c, (int)u, lane, wave); }
    int tid2 = c.tid; asm volatile("" : "+v"(tid2)); const int lane2 = tid2 & 63, wave2 = __builtin_amdgcn_readfirstlane(tid2 >> 6);
    for (;;) { unsigned u = 0; if (lane2 == 0) u = __hip_atomic_fetch_add(q + 64, 1u, __ATOMIC_RELAXED, __HIP_MEMORY_SCOPE_AGENT);
        u = (unsigned)__builtin_amdgcn_readfirstlane((int)u); if (u >= (unsigned)N_DIL) break; dil_wave_unit(args, L, c, (int)u, lane2, wave2); }
}

DI void phase_scan(KArgs args, LAS unsigned char* L, const Ctx& c) {
    const int nwu = c.nseq * 24, wu = c.bid;
    if (wu < nwu && c.wave == 0) {
        const int lane = c.lane, rr = lane & 31, hh = lane >> 5;
        const int chain = wu >> 1, nt = wu & 1, seq = chain / 12, rem = chain % 12, head = rem >> 1, dir = rem & 1;
        const int nch = c.seqlen >> 6, gch0 = seq * nch;
        unsigned char* GS = BIGP(unsigned char, B_GSCR);
        f32x16 S[2]; S[0] = zero16(); S[1] = zero16();
        bf16x8 A[2][2][4]; u32x4 cm[2][2][2]; float gl[2];
        const long gstep = (long)(dir ? -1 : 1) * 12 * GSTRIDE;
        const unsigned char* Gp = GS + (size_t)(((gch0 + (dir ? nch - 1 : 0)) * 6 + head) * 2 + dir) * GSTRIDE;
        unsigned char* Gs = (unsigned char*)Gp;
#define SCAN_LOAD(B) do { _Pragma("unroll") for (int mt = 0; mt < 2; ++mt) { _Pragma("unroll") for (int ks = 0; ks < 4; ++ks) A[B][mt][ks] = *(const bf16x8*)(Gp + (size_t)((mt * 4 + ks) * 64 + lane) * 16); \
            const u32x4* cp = (const u32x4*)(Gp + 8192 + (size_t)((nt * 2 + mt) * 64 + lane) * 32); cm[B][mt][0] = cp[0]; cm[B][mt][1] = cp[1]; } gl[B] = *(const float*)(Gp + 40960); } while (0)
#define SCAN_STEP(B) do { { bf16_t* St = (bf16_t*)(Gs + 32768) + (size_t)(32 * nt + rr) * 64 + 4 * hh; \
            _Pragma("unroll") for (int mt = 0; mt < 2; ++mt) _Pragma("unroll") for (int g = 0; g < 4; ++g) { u32x2 w; w.x = pk2(S[mt][4 * g], S[mt][4 * g + 1]); w.y = pk2(S[mt][4 * g + 2], S[mt][4 * g + 3]); *(u32x2*)(St + 32 * mt + 8 * g) = w; } } \
            const bf16x8 b0 = pack8<0>(S[0]), b1 = pack8<1>(S[0]), b2 = pack8<0>(S[1]), b3 = pack8<1>(S[1]); f32x16 nw[2]; \
            _Pragma("unroll") for (int mt = 0; mt < 2; ++mt) { \
                _Pragma("unroll") for (int g = 0; g < 8; ++g) { const unsigned wv = (g < 4) ? cm[B][mt][0][g] : cm[B][mt][1][g - 4]; nw[mt][2 * g] = gl[B] * S[mt][2 * g] + bflo(wv); nw[mt][2 * g + 1] = gl[B] * S[mt][2 * g + 1] + bfhi(wv); } \
                nw[mt] = MFMA32(A[B][mt][0], b0, nw[mt]); nw[mt] = MFMA32(A[B][mt][1], b1, nw[mt]); nw[mt] = MFMA32(A[B][mt][2], b2, nw[mt]); nw[mt] = MFMA32(A[B][mt][3], b3, nw[mt]); } \
            S[0] = nw[0]; S[1] = nw[1]; Gs += gstep; } while (0)
        SCAN_LOAD(0); Gp += gstep; SCAN_LOAD(1); Gp += gstep;
        for (int step = 0; step < nch; step += 2) {
            const bool more = step + 2 < nch;
            if (!more) Gp -= 2 * gstep;
            SCAN_STEP(0); SCAN_LOAD(0); Gp += gstep;
            SCAN_STEP(1); SCAN_LOAD(1); Gp += gstep;
        }
#undef SCAN_LOAD
#undef SCAN_STEP
    }
    attn_wave_units(args, L, c);
}

DI void dil_merge(const Ctx& c) {
    { const bf16_t* DP = BIGP(bf16_t, B_DILP); const float* DM = BIGP(float, B_DILM); bf16_t* OD = BIGP(bf16_t, B_ONA) + 256;
        for (int it = c.bid * 512 + c.tid; it < c.stok * 32; it += c.G * 512) { const int tok = it >> 5, part = it & 31;
            u32x4 w = {0u, 0u, 0u, 0u};
            if (part < 16) { const int hd = part >> 3, p = part & 7; float m[3], dn[3];
#pragma unroll
                for (int g = 0; g < 3; ++g) { const size_t b = (((size_t)g * SLABMAX + tok) * 2 + hd); m[g] = DM[b * 2]; dn[g] = DM[b * 2 + 1]; }
                const float M = fmaxf(m[0], fmaxf(m[1], m[2])); float num[8], den = 0.f;
#pragma unroll
                for (int j = 0; j < 8; ++j) num[j] = 0.f;
#pragma unroll
                for (int g = 0; g < 3; ++g) { const float f = __expf(m[g] - M); den += f * dn[g]; const u32x4 a = *(const u32x4*)(DP + (((size_t)g * SLABMAX + tok) * 2 + hd) * 64 + 8 * p);
                    num[0] += f * bflo(a[0]); num[1] += f * bfhi(a[0]); num[2] += f * bflo(a[1]); num[3] += f * bfhi(a[1]); num[4] += f * bflo(a[2]); num[5] += f * bfhi(a[2]); num[6] += f * bflo(a[3]); num[7] += f * bfhi(a[3]); }
                const float inv = frcp(den);
                w.x = pk2(num[0] * inv, num[1] * inv); w.y = pk2(num[2] * inv, num[3] * inv); w.z = pk2(num[4] * inv, num[5] * inv); w.w = pk2(num[6] * inv, num[7] * inv); }
            if (part < 16) *(u32x4*)(OD + (size_t)tok * 768 + 8 * part) = w; } }
}

DI void phase_gdn_out(KArgs args, LAS unsigned char* L, const Ctx& c) {
    dil_merge(c);
    const int lane = c.lane, wave = c.wave, tid = c.tid, l = c.layer;
    const bf16_t* PROJ = BIGP(bf16_t, B_PROJ); unsigned char* GS = BIGP(unsigned char, B_GSCR); bf16_t* OG = BIGP(bf16_t, B_ONA) + 384;
    LAS float* OF = (LAS float*)L;
    for (int u = c.bid; u < (c.stok >> 6) * 6; u += c.G) { const int gch = u / 6, head = u % 6;
        { const int dir = wave >> 2, mt = (wave >> 1) & 1, nt = wave & 1, rr = lane & 31, hh = lane >> 5;
            const unsigned char* G = GS + (size_t)((gch * 6 + head) * 2 + dir) * GSTRIDE;
            const bf16_t* Qe = (const bf16_t*)(G + 16384); const bf16_t* Oct = (const bf16_t*)(G + 24576); const bf16_t* St = (const bf16_t*)(G + 32768);
            f32x16 acc = zero16();
#pragma unroll
            for (int ks = 0; ks < 4; ++ks) { const bf16x8 a = *(const bf16x8*)(Qe + (size_t)((mt * 4 + ks) * 64 + lane) * 8);
                const bf16_t* sp = St + (32 * nt + rr) * 64 + 32 * (ks >> 1) + 16 * (ks & 1) + 4 * hh; const u32x2 lo = *(const u32x2*)sp, hi = *(const u32x2*)(sp + 8);
                u32x4 bw; bw.x = lo.x; bw.y = lo.y; bw.z = hi.x; bw.w = hi.y; acc = MFMA32(a, __builtin_bit_cast(bf16x8, bw), acc); }
            const int e = 32 * nt + rr;
#pragma unroll
            for (int g = 0; g < 4; ++g) { const u32x2 w = *(const u32x2*)(Oct + e * 64 + 32 * mt + 8 * g + 4 * hh);
                const float v0 = acc[4 * g] + bflo(w.x), v1 = acc[4 * g + 1] + bfhi(w.x), v2 = acc[4 * g + 2] + bflo(w.y), v3 = acc[4 * g + 3] + bfhi(w.y);
                const int i0 = 32 * mt + 8 * g + 4 * hh;
#pragma unroll
                for (int j = 0; j < 4; ++j) { const int ii = i0 + j, tl = dir ? 63 - ii : ii; OF[(dir * 64 + tl) * 68 + e] = (j == 0) ? v0 : (j == 1) ? v1 : (j == 2) ? v2 : v3; } } }
        __syncthreads();
        { const int i = tid >> 3, p = tid & 7; const size_t tok = (size_t)gch * 64 + i;
            const LAS float* a = OF + i * 68 + 8 * p; const LAS float* b = OF + (64 + i) * 68 + 8 * p;
            float ov[8]; float ss = 0.f;
#pragma unroll
            for (int j = 0; j < 8; ++j) { ov[j] = a[j] + b[j]; ss += ov[j] * ov[j]; }
            ss += __shfl_xor(ss, 1); ss += __shfl_xor(ss, 2); ss += __shfl_xor(ss, 4);
            const float rs = frsq(ss * (1.0f / 64.0f) + NORM_EPS);
            const u32x4 zw = *(const u32x4*)(PROJ + tok * NPROJ + C_ZC + 64 * head + 8 * p);
            const float* nw = args->in[7] + l * 64 + 8 * p;
            float r[8];
#pragma unroll
            for (int j = 0; j < 4; ++j) { r[2 * j] = ov[2 * j] * rs * nw[2 * j] * siluf_(bflo(zw[j])); r[2 * j + 1] = ov[2 * j + 1] * rs * nw[2 * j + 1] * siluf_(bfhi(zw[j])); }
            u32x4 w; w.x = pk2(r[0], r[1]); w.y = pk2(r[2], r[3]); w.z = pk2(r[4], r[5]); w.w = pk2(r[6], r[7]);
            *(u32x4*)(OG + tok * 768 + 64 * head + 8 * p) = w; }
        __syncthreads();
    }
}

DI void phase_ln1(KArgs args, LAS unsigned char* L, const Ctx& c) {
    const int lane = c.lane, l = c.layer;
    LAS float* WR = (LAS float*)L;
    { const float* wr = args->in[14] + (size_t)l * D * 16;
        for (int i = c.tid; i < D * 16; i += 512) { const int col = i >> 4, e = i & 15, j = col >> 8, ln = (col >> 2) & 63, q = col & 3; WR[((j * 4 + q) * 64 + ln) * 20 + e] = wr[i]; } }
    __syncthreads();
    const float* g1 = args->in[12] + l * D; const float* b1 = args->in[13] + l * D;
    f32x4 gv[4], bv[4];
#pragma unroll
    for (int j = 0; j < 4; ++j) { gv[j] = *(const f32x4*)(g1 + 4 * lane + 256 * j); bv[j] = *(const f32x4*)(b1 + 4 * lane + 256 * j); }
    float* AFF = WSP(float, WS_AFF); int* SLOT = WSP(int, WS_SLOT); bf16_t* XB = WSP(bf16_t, WS_XB);
    f32x4 nv[4];
    { const int rl0 = c.bid * 8 + c.wave; if (rl0 < c.stok) { const float* hp = c.out + ((size_t)c.sbase + rl0) * D;
#pragma unroll
        for (int j = 0; j < 4; ++j) nv[j] = *(const f32x4*)(hp + 4 * lane + 256 * j); } }
    for (int rl = c.bid * 8 + c.wave; rl < c.stok; rl += c.G * 8) { const size_t tok = (size_t)c.sbase + rl;
        float* hr = c.out + tok * D; f32x4 v[4]; float s = 0.f;
#pragma unroll
        for (int j = 0; j < 4; ++j) { v[j] = nv[j]; s += (v[j][0] + v[j][1]) + (v[j][2] + v[j][3]); }
        if (rl + c.G * 8 < c.stok) { const float* hp = hr + (size_t)c.G * 8 * D;
#pragma unroll
            for (int j = 0; j < 4; ++j) nv[j] = *(const f32x4*)(hp + 4 * lane + 256 * j); }
        const float mean = wave_sum(s) * (1.0f / D); float s2 = 0.f;
#pragma unroll
        for (int j = 0; j < 4; ++j) { v[j] = v[j] - mean; s2 += (v[j][0] * v[j][0] + v[j][1] * v[j][1]) + (v[j][2] * v[j][2] + v[j][3] * v[j][3]); }
        const float rstd = frsq(wave_sum(s2) * (1.0f / D) + LN_EPS);
        float lg[16];
#pragma unroll
        for (int e = 0; e < 16; ++e) lg[e] = 0.f;
#pragma unroll
        for (int j = 0; j < 4; ++j) { v[j] = v[j] * rstd * gv[j] + bv[j];
            if (!c.dry) { *(f32x4*)(hr + 4 * lane + 256 * j) = v[j];
            u32x2 w; w.x = pk2(v[j][0], v[j][1]); w.y = pk2(v[j][2], v[j][3]); *(u32x2*)(XB + tok * D + 4 * lane + 256 * j) = w; }
#pragma unroll
            for (int q = 0; q < 4; ++q) { const LAS float* wp = WR + ((j * 4 + q) * 64 + lane) * 20; const float xv = v[j][q];
#pragma unroll
                for (int e4 = 0; e4 < 4; ++e4) { const f32x4 w4 = *(const LAS f32x4*)(wp + 4 * e4); lg[4 * e4] += xv * w4[0]; lg[4 * e4 + 1] += xv * w4[1]; lg[4 * e4 + 2] += xv * w4[2]; lg[4 * e4 + 3] += xv * w4[3]; } }
            asm volatile("" ::: "memory"); }
        float mx = -1e30f;
#pragma unroll
        for (int e = 0; e < 16; ++e) { lg[e] = wave_sum(lg[e]); mx = fmaxf(mx, lg[e]); }
        float den = 0.f;
#pragma unroll
        for (int e = 0; e < 16; ++e) { lg[e] = expf(lg[e] - mx); den += lg[e]; }
        float mine = 0.f;
#pragma unroll
        for (int e = 0; e < 16; ++e) mine = (lane == e) ? lg[e] : mine;
        if (lane < 16 && !c.dry) { AFF[(size_t)lane * T_ALL + tok] = mine / den; SLOT[tok * 16 + lane] = -1; }
    }
}
DI void phase_ln2(KArgs args, LAS unsigned char* L, const Ctx& c) {
    const int lane = c.lane, l = c.layer;
    const float* g2 = args->in[18] + l * D; const float* b2 = args->in[19] + l * D;
    f32x4 gv[4], bv[4];
#pragma unroll
    for (int j = 0; j < 4; ++j) { gv[j] = *(const f32x4*)(g2 + 4 * lane + 256 * j); bv[j] = *(const f32x4*)(b2 + 4 * lane + 256 * j); }
    const int* SLOT = WSP(int, WS_SLOT); bf16_t* XB = WSP(bf16_t, WS_XB);
    f32x4 nv[4]; int nsv = -1;
    { const int t0 = c.bid * 8 + c.wave; if (t0 < T_ALL) { const float* xp = c.out + (size_t)t0 * D; nsv = SLOT[(size_t)t0 * 16 + (lane & 15)];
#pragma unroll
        for (int j = 0; j < 4; ++j) nv[j] = *(const f32x4*)(xp + 4 * lane + 256 * j); } }
    for (int t = c.bid * 8 + c.wave; t < T_ALL; t += c.G * 8) { const size_t tok = (size_t)t;
        float* xr = c.out + tok * D; f32x4 v[4];
#pragma unroll
        for (int j = 0; j < 4; ++j) v[j] = nv[j] * ALPHA;
        const int sv = nsv;
        if (t + c.G * 8 < T_ALL) { const float* xp = xr + (size_t)c.G * 8 * D; nsv = SLOT[(tok + c.G * 8) * 16 + (lane & 15)];
#pragma unroll
            for (int j = 0; j < 4; ++j) nv[j] = *(const f32x4*)(xp + 4 * lane + 256 * j); }
#pragma unroll
        for (int e = 0; e < 16; ++e) { const int s = __builtin_amdgcn_readlane(sv, e);
            if (s >= 0) { const bf16_t* yr = BIGP(bf16_t, (e < 8 ? B_XY0 : B_XY1)) + ((size_t)(e & 7) * CAP + s) * D;
#pragma unroll
                for (int j = 0; j < 4; ++j) { const u32x2 w = *(const u32x2*)(yr + 4 * lane + 256 * j); v[j][0] += bflo(w.x); v[j][1] += bfhi(w.x); v[j][2] += bflo(w.y); v[j][3] += bfhi(w.y); } } }
        float s = 0.f;
#pragma unroll
        for (int j = 0; j < 4; ++j) s += (v[j][0] + v[j][1]) + (v[j][2] + v[j][3]);
        const float mean = wave_sum(s) * (1.0f / D); float s2 = 0.f;
#pragma unroll
        for (int j = 0; j < 4; ++j) { v[j] = v[j] - mean; s2 += (v[j][0] * v[j][0] + v[j][1] * v[j][1]) + (v[j][2] * v[j][2] + v[j][3] * v[j][3]); }
        const float rstd = frsq(wave_sum(s2) * (1.0f / D) + LN_EPS);
#pragma unroll
        for (int j = 0; j < 4; ++j) { v[j] = v[j] * rstd * gv[j] + bv[j];
            if (!c.dry) { *(f32x4*)(xr + 4 * lane + 256 * j) = v[j];
            u32x2 w; w.x = pk2(v[j][0], v[j][1]); w.y = pk2(v[j][2], v[j][3]); *(u32x2*)(XB + tok * D + 4 * lane + 256 * j) = w; } }
    }
}

DI int block_excl_scan(int v, LAS int* tmp, int tid, int& total) {
    const int lane = tid & 63, wave = tid >> 6; int x = v;
#pragma unroll
    for (int o = 1; o < 64; o <<= 1) { const int y = __shfl_up(x, o); if (lane >= o) x += y; }
    __syncthreads();
    if (lane == 63) tmp[wave] = x;
    __syncthreads();
    int base = 0, tot = 0;
#pragma unroll
    for (int w = 0; w < 8; ++w) { const int tw = tmp[w]; if (w < wave) base += tw; tot += tw; }
    total = tot;
    return base + x - v;
}
DI void phase_select(KArgs args, LAS unsigned char* L, const Ctx& c) {
    if (c.bid >= 32) return;
    const int tid = c.tid, grp = c.bid >> 4, e = c.bid & 15;
    const int n = grp ? T_S : T_P, t0 = grp ? T_P : 0, C = n >> 3, slot0 = grp ? CAP_P : 0;
    const unsigned* v = (const unsigned*)(WSP(float, WS_AFF) + (size_t)e * T_ALL + t0);
    LAS unsigned* hist = (LAS unsigned*)L; LAS int* sh = (LAS int*)(L + 1024); LAS int* tmp = (LAS int*)(L + 1024 + 64);
    unsigned prefix = 0u; int kk = C;
    for (int pass = 0; pass < 4; ++pass) { const int shift = 24 - 8 * pass; const unsigned mhi = pass == 0 ? 0u : (0xFFFFFFFFu << (shift + 8));
        if (tid < 256) hist[tid] = 0u;
        __syncthreads();
        for (int i = tid * 4; i < n; i += 512 * 16) {
            u32x4 x4[4];
#pragma unroll
            for (int k = 0; k < 4; ++k) x4[k] = *(const u32x4*)(v + i + k * 2048);
#pragma unroll
            for (int k = 0; k < 4; ++k)
#pragma unroll
                for (int j = 0; j < 4; ++j) { const unsigned x = x4[k][j]; if ((x & mhi) == prefix) __hip_atomic_fetch_add(&hist[(x >> shift) & 255u], 1u, __ATOMIC_RELAXED, __HIP_MEMORY_SCOPE_WORKGROUP); } }
        __syncthreads();
        if (tid == 0) { int cum = 0, sel = 0; for (int b = 255; b >= 0; --b) { const int h = (int)hist[b]; if (cum + h >= kk) { sel = b; break; } cum += h; } sh[0] = sel; sh[1] = kk - cum; }
        __syncthreads();
        prefix |= ((unsigned)sh[0]) << shift; kk = sh[1];
        __syncthreads();
    }
    const unsigned thr = prefix;
    const int per = n >> 9, i0 = tid * per;
    int ngt = 0, ntie = 0;
    for (int i = 0; i < per; i += 4) { const u32x4 x = *(const u32x4*)(v + i0 + i);
#pragma unroll
        for (int j = 0; j < 4; ++j) { ngt += (x[j] > thr); ntie += (x[j] == thr); } }
    int tot;
    const int tie_base = block_excl_scan(ntie, tmp, tid, tot);
    int take = kk - tie_base; take = take < 0 ? 0 : (take > ntie ? ntie : take);
    int pos = block_excl_scan(ngt + take, tmp, tid, tot);
    int* IDX = WSP(int, WS_IDX) + e * CAP + slot0;
    int tr = 0;
    for (int i = 0; i < per; i += 4) { const u32x4 x = *(const u32x4*)(v + i0 + i);
#pragma unroll
        for (int j = 0; j < 4; ++j) { bool s = x[j] > thr; if (x[j] == thr) { s = tr < take; ++tr; } if (s) { IDX[pos] = t0 + i0 + i + j; ++pos; } } }
}
DI void phase_gather(KArgs args, LAS unsigned char* L, const Ctx& c) {
    const int lane = c.lane; const int* IDX = WSP(int, WS_IDX); const bf16_t* XB = WSP(bf16_t, WS_XB);
    float* GATEV = WSP(float, WS_GATEV); int* SLOT = WSP(int, WS_SLOT); const float* AFF = WSP(float, WS_AFF);
    for (int row0 = (c.bid * 8 + c.wave) * 4; row0 < NE * CAP; row0 += c.G * 8 * 4) {
        const int e = row0 / CAP, s0 = row0 % CAP; int t[4]; u32x4 a[4], b[4];
#pragma unroll
        for (int k = 0; k < 4; ++k) t[k] = IDX[row0 + k];
#pragma unroll
        for (int k = 0; k < 4; ++k) { const u32x4* src = (const u32x4*)(XB + (size_t)t[k] * D) + 2 * lane; a[k] = src[0]; b[k] = src[1]; }
        u32x4* dst = (u32x4*)(BIGP(unsigned char, (e < 8 ? B_XY0 : B_XY1)) + ((size_t)(e & 7) * CAP + s0) * D);
#pragma unroll
        for (int k = 0; k < 4; ++k) { u32x4 w;
            w.x = pk4_fp8(bflo(a[k].x), bfhi(a[k].x), bflo(a[k].y), bfhi(a[k].y)); w.y = pk4_fp8(bflo(a[k].z), bfhi(a[k].z), bflo(a[k].w), bfhi(a[k].w));
            w.z = pk4_fp8(bflo(b[k].x), bfhi(b[k].x), bflo(b[k].y), bfhi(b[k].y)); w.w = pk4_fp8(bflo(b[k].z), bfhi(b[k].z), bflo(b[k].w), bfhi(b[k].w));
            dst[k * 64 + lane] = w; }
        if (lane < 4) { const int tt = (lane == 0) ? t[0] : (lane == 1) ? t[1] : (lane == 2) ? t[2] : t[3]; SLOT[(size_t)tt * 16 + e] = s0 + lane; GATEV[row0 + lane] = AFF[(size_t)e * T_ALL + tt]; } }
}

__global__ void __launch_bounds__(512, 2) fwd_kernel(Args args) {
    extern __shared__ __attribute__((aligned(16))) unsigned char lds_raw[];
    LAS unsigned char* L = (LAS unsigned char*)lds_raw;
    Ctx c;
    c.out = args.out; c.ws = args.ws;
    c.tid = threadIdx.x; c.lane = c.tid & 63; c.wave = __builtin_amdgcn_readfirstlane(c.tid >> 6); c.G = gridDim.x; c.bid = blockIdx.x;
    c.layer = 0; c.slab = 0; c.nseq = 8; c.seqlen = 4096; c.stok = 32768; c.sbase = 0; c.dry = 0;
    const int lo = args.ph_lo, hi = args.ph_hi;
    volatile LAS unsigned* MISC = (volatile LAS unsigned*)(L + LDS_MISC);
    if (c.tid < 4) MISC[c.tid] = 0u;
    __syncthreads();
    XcdBarrier bar; bar.bar = (unsigned*)(c.ws + WS_CTL) + 1024; bar.x = 0; bar.st = MISC;
    if (hi - lo > 1) bar = xcd_barrier_post((unsigned*)(c.ws + WS_CTL) + 1024, MISC);
    int pc = 0;
#ifndef PHMASK
#define PHMASK 0xFFFF
#endif
#define PHON(k) (((PHMASK) >> (k)) & 1)
#ifndef REPMASK
#define REPMASK 0x0
#endif
#define PH_BEGIN(k) if (PHON(k) && pc >= lo && pc < hi) { { int tz = threadIdx.x; asm volatile("" : "+v"(tz)); c.tid = tz; c.lane = tz & 63; c.wave = __builtin_amdgcn_readfirstlane(tz >> 6); } KArgs ka = kargs(); c.ws = ka->ws; c.out = ka->out; { int b_ = blockIdx.x, g_ = gridDim.x; asm volatile("" : "+s"(b_), "+s"(g_)); c.bid = b_; c.G = g_; } for (int rep_ = 0; rep_ < (((REPMASK) >> (k)) & 1) + 1; ++rep_) { if (rep_) __syncthreads(); c.dry = (rep_ + 1 < (((REPMASK) >> (k)) & 1) + 1);
#ifndef BARREP
#define BARREP 0
#endif
#define PH_END   } if (pc + 1 < hi) { xcd_barrier(bar); if (BARREP) { xcd_barrier(bar); xcd_barrier(bar); } } else { asm volatile("s_waitcnt vmcnt(0)" ::: "memory"); __syncthreads(); } } ++pc;

    for (int layer = 0; layer < 2; ++layer) {
        c.layer = layer;
        PH_BEGIN(0) phase_weights(ka, L, c); PH_END
        for (int slab = 0; slab < NSLAB; ++slab) {
            c.slab = slab; c.nseq = slab < 2 ? 8 : 1; c.seqlen = slab < 2 ? 4096 : 16384; c.stok = slab < 2 ? 32768 : 16384; c.sbase = slab * 32768; const int stok = c.stok; const size_t sbase = (size_t)c.sbase;
            PH_BEGIN(1) {
                pg8::Gemm g{WSP(bf16_t, WS_XB) + sbase * D, WSP(bf16_t, WS_WIN), stok, NPROJ, D}; pg8::StaticOrder S; S.init(stok, NPROJ, c.G, c.bid);
                pg8::EpiInProj E{BIGP(bf16_t, B_PROJ), BIGP(float, B_BA)};
                pg8::gemm_phase<pg8::EpiInProj, pg8::StaticOrder>(L, g, S, E); } PH_END
            PH_BEGIN(2) phase_mix_a(ka, L, c); PH_END
            PH_BEGIN(3) phase_scan(ka, L, c); PH_END
            PH_BEGIN(4) phase_gdn_out(ka, L, c); PH_END
            PH_BEGIN(5) {
                pg8::StaticOrder S; S.init(stok, D, c.G, c.bid);
                pg8::Gemm g{BIGP(bf16_t, B_ONA), WSP(bf16_t, WS_WBR), stok, D, 768}; pg8::EpiGateCat E{BIGP(bf16_t, B_PROJ), BIGP(bf16_t, B_MERGED)};
                pg8::gemm_phase<pg8::EpiGateCat, pg8::StaticOrder>(L, g, S, E); } PH_END
            PH_BEGIN(6) {
                const float* xr = layer == 0 ? (slab < 2 ? ka->in[0] + sbase * D : ka->in[1]) : c.out + sbase * D;
                pg8::Gemm g{BIGP(bf16_t, B_MERGED), WSP(bf16_t, WS_WOUT), stok, D, D}; pg8::StaticOrder S; S.init(stok, D, c.G, c.bid);
                pg8::EpiRes E{xr, c.out + sbase * D};
                pg8::gemm_phase<pg8::EpiRes, pg8::StaticOrder>(L, g, S, E); } PH_END
#ifndef LN1PROBE
#define LN1PROBE 0
#endif
            PH_BEGIN(7) if (LN1PROBE) { c.dry = 1; phase_ln1(ka, L, c); __syncthreads(); c.dry = 0; } phase_ln1(ka, L, c); PH_END
        }
        PH_BEGIN(8) phase_select(ka, L, c); PH_END
        PH_BEGIN(9) phase_gather(ka, L, c); PH_END
        for (int half = 0; half < 2; ++half) {
            PH_BEGIN(10) {
                pg8::Gemm g{BIGP(bf16_t, half ? B_XY1 : B_XY0), (const bf16_t*)(WSP(unsigned char, WS_WGU) + (size_t)half * 8 * 4096 * D), 8 * CAP, 8 * 4096, D / 2}; pg8::MoeOrder S; S.init(8, CAP / 256, 16, c.G, c.bid);
                pg8::EpiSwiglu E{BIGP(unsigned char, B_HID)};
                pg8::gemm_phase<pg8::EpiSwiglu, pg8::MoeOrder>(L, g, S, E); } PH_END
            PH_BEGIN(11) {
                pg8::Gemm g{BIGP(bf16_t, B_HID), (const bf16_t*)(WSP(unsigned char, WS_WD) + (size_t)half * 8 * D * DE), 8 * CAP, 8 * D, DE / 2}; pg8::MoeOrder S; S.init(8, CAP / 256, 4, c.G, c.bid);
                pg8::EpiDown E{BIGP(bf16_t, half ? B_XY1 : B_XY0), WSP(float, WS_GATEV) + (size_t)half * 8 * CAP};
                pg8::gemm_phase<pg8::EpiDown, pg8::MoeOrder>(L, g, S, E); } PH_END
        }
        PH_BEGIN(12) phase_ln2(ka, L, c); PH_END
    }
#undef PH_BEGIN
#undef PH_END
}

constexpr int N_PHASES = 2 * (1 + NSLAB * 7 + 2 + 4 + 1);

extern "C" void kernel_launch(void* const* d_in, const int* in_sizes, int n_in, void* d_out, int out_size, void* d_ws, size_t ws_size, hipStream_t stream) {
    static int grid = 0;
    if (grid == 0) {
        if (n_in != 20 || ws_size < WS_END) { fprintf(stderr, "kernel_launch: unexpected n_in %d or ws_size %zu (< %zu)\n", n_in, ws_size, (size_t)WS_END); grid = -1; return; }
        int dev = 0, cus = 0, per_cu = 0;
        if (hipGetDevice(&dev) != hipSuccess || hipDeviceGetAttribute(&cus, hipDeviceAttributeMultiprocessorCount, dev) != hipSuccess) { grid = -1; return; }
        if (hipFuncSetAttribute((const void*)fwd_kernel, hipFuncAttributeMaxDynamicSharedMemorySize, LDS_BYTES) != hipSuccess) { fprintf(stderr, "kernel_launch: hipFuncSetAttribute failed\n"); grid = -1; return; }
        if (hipOccupancyMaxActiveBlocksPerMultiprocessor(&per_cu, (const void*)fwd_kernel, 512, LDS_BYTES) != hipSuccess || per_cu < 1) fprintf(stderr, "kernel_launch: occupancy query says %d\n", per_cu);
        (void)hipGetLastError();
        grid = cus;
    }
    if (grid < 0) return;
    (void)hipMemsetAsync((char*)d_ws + WS_CTL, 0, 1 * MiB, stream);
    Args a{};
    for (int i = 0; i < 20; ++i) a.in[i] = (const float*)d_in[i];
    a.out = (float*)d_out; a.ws = (unsigned char*)d_ws;
#if MK_N_LAUNCHES == 1
    a.ph_lo = 0; a.ph_hi = N_PHASES;
    hipLaunchKernelGGL(fwd_kernel, dim3(grid), dim3(512), LDS_BYTES, stream, a);
#else
    for (int p = 0; p < N_PHASES; ++p) { a.ph_lo = p; a.ph_hi = p + 1; hipLaunchKernelGGL(fwd_kernel, dim3(grid), dim3(512), LDS_BYTES, stream, a); }
#endif
}
```

```cpp
#include <hip/hip_runtime.h>
#include <stdint.h>
#include <stdio.h>

#define LAS __attribute__((address_space(3)))
#define DI __device__ __forceinline__
typedef unsigned short bf16_t;
typedef short bf16x8 __attribute__((ext_vector_type(8)));
typedef float f32x4 __attribute__((ext_vector_type(4)));
typedef float f32x2 __attribute__((ext_vector_type(2)));
typedef float f32x16 __attribute__((ext_vector_type(16)));
typedef unsigned u32x4 __attribute__((ext_vector_type(4)));
typedef unsigned u32x2 __attribute__((ext_vector_type(2)));
typedef __bf16 bf16x2v __attribute__((ext_vector_type(2)));

#ifndef MK_N_LAUNCHES
#define MK_N_LAUNCHES 1
#endif

constexpr int D = 1024, T_ALL = 81920, T_P = 65536, T_S = 16384, SLABMAX = 32768, NSLAB = 3;
constexpr int DIN = 6552, NPROJ = 6656;
constexpr int C_GATE = 0, C_QA = 3072, C_KA = 3328, C_VA = 3584, C_QD = 3840, C_KD = 4224, C_VD = 4608, C_QC = 4992, C_KC = 5376, C_VC = 5760, C_ZC = 6144;
constexpr int NE = 16, DE = 2048, CAP_P = 8192, CAP_S = 2048, CAP = CAP_P + CAP_S;
constexpr float ALPHA = 1.41421356237f, LN_EPS = 1e-5f, NORM_EPS = 1e-6f;
constexpr size_t MiB = 1u << 20;
constexpr size_t WS_CTL = 0, WS_WIN = 1 * MiB, WS_WBR = 14 * MiB, WS_WOUT = 16 * MiB, WS_WGU = 18 * MiB, WS_WD = 82 * MiB, WS_XB8 = 114 * MiB, WS_WG8 = 194 * MiB, WS_XB = 210 * MiB;
constexpr size_t WS_AFF = 370 * MiB, WS_SLOT = 375 * MiB, WS_IDX = 380 * MiB, WS_GATEV = 381 * MiB, WS_CS = 382 * MiB, WS_BIG = 386 * MiB, WS_END = 1130 * MiB;
constexpr size_t B_PROJ = 0, B_BA = 416 * MiB, B_ONA = 420 * MiB, B_ODIL = 436 * MiB, B_OGDN = 452 * MiB, B_DILP = 476 * MiB, B_DILM = 500 * MiB, B_GSCR = 502 * MiB, B_MERGEF = 502 * MiB, B_MERGED = 630 * MiB;
constexpr size_t B_XY0 = 0, B_XY1 = 160 * MiB, B_HID = 320 * MiB;
constexpr int GSTRIDE = 41216;
constexpr int LDS_BYTES = 147456;
constexpr int LDS_MISC = 145408;

DI unsigned pk2(float lo, float hi) { f32x2 v = {lo, hi}; bf16x2v b = __builtin_convertvector(v, bf16x2v); return __builtin_bit_cast(unsigned, b); }
DI unsigned pk4_fp8(float a, float b, float c, float d) {
    int w = __builtin_amdgcn_cvt_pk_fp8_f32(a, b, 0, false); w = __builtin_amdgcn_cvt_pk_fp8_f32(c, d, w, true); return (unsigned)w; }
DI float bflo(unsigned u) { return __uint_as_float(u << 16); }
DI float bfhi(unsigned u) { return __uint_as_float(u & 0xffff0000u); }
DI float frcp(float x) { return __builtin_amdgcn_rcpf(x); }
DI float frsq(float x) { return __builtin_amdgcn_rsqf(x); }
DI float sigmoidf_(float x) { return frcp(1.0f + __expf(-x)); }
DI float siluf_(float x) { return x * frcp(1.0f + __expf(-x)); }
DI float wave_sum(float v) {
#pragma unroll
    for (int o = 1; o < 64; o <<= 1) v += __shfl_xor(v, o);
    return v;
}
#define MFMA32(a, b, c) __builtin_amdgcn_mfma_f32_32x32x16_bf16((a), (b), (c), 0, 0, 0)
DI int crow(int reg, int h) { return (reg & 3) + 8 * (reg >> 2) + 4 * h; }
DI f32x16 zero16() { f32x16 z; for (int i = 0; i < 16; ++i) z[i] = 0.f; return z; }
template <int S> DI bf16x8 pack8(const f32x16& x) {
    u32x4 p; p[0] = pk2(x[8 * S], x[8 * S + 1]); p[1] = pk2(x[8 * S + 2], x[8 * S + 3]); p[2] = pk2(x[8 * S + 4], x[8 * S + 5]); p[3] = pk2(x[8 * S + 6], x[8 * S + 7]);
    return __builtin_bit_cast(bf16x8, p);
}

namespace pg8 {
constexpr int BM = 256, BK = 64, HALF = 128, HTB = HALF * BK * 2, STAGE_BYTES = 8 * HTB, NXCD = 8, WGM = 8;
__host__ __device__ __forceinline__ int lds_byte(int r, int c) { const int st = (r >> 4) * 2 + (c >> 5), rr = r & 15, cc = c & 31, ob = rr * 64 + cc * 2; return st * 1024 + (ob ^ (((ob >> 9) & 1) << 5)); }
__host__ __device__ __forceinline__ void stage_rc(int b, int& R, int& C) { const int st = b / 1024, sb = b % 1024, swz = sb ^ (((sb >> 9) & 1) << 5); R = (st >> 1) * 16 + swz / 64; C = (st & 1) * 32 + (swz % 64) / 2; }
__host__ __device__ __forceinline__ int perm32(int rho) { const int n = rho >> 4, i = rho & 15; return 8 * (i >> 2) + 4 * n + (i & 3); }
struct Unit { int pm, pn; };
struct Gemm { const bf16_t* A; const bf16_t* Bt; int M, N, K; };
struct StaticOrder {
    int nM, nN, nwg, G, c;
    __device__ void init(int M, int N, int G_, int c_) { nM = M / BM; nN = N / BM; nwg = nM * nN; G = G_; c = c_; }
    __device__ bool next(int i, Unit& u) const {
        const long L = (long)i * G + c; if (L >= nwg) return false;
        int wgid = (int)L; { const int q = nwg / NXCD, r = nwg % NXCD, xcd = wgid % NXCD, off = wgid / NXCD; wgid = (xcd < r ? xcd * (q + 1) : r * (q + 1) + (xcd - r) * q) + off; }
        const int nig = WGM * nN, gid = wgid / nig, fm = gid * WGM, gsz = (nM - fm) < WGM ? (nM - fm) : WGM;
        u.pm = fm + ((wgid % nig) % gsz); u.pn = (wgid % nig) / gsz; return true;
    }
    __device__ __forceinline__ void a_ready(const Unit&) const {}
    __device__ __forceinline__ void done(const Unit&) const {}
};
struct MoeOrder {
    int nMe, nNe, per, total, G, c, xr, xc, rpx, cpx, share;
    __device__ void init(int nE, int nMe_, int nNe_, int G_, int c_) { nMe = nMe_; nNe = nNe_; per = nMe * nNe; total = nE * per; G = G_; c = c_;
        xc = (nNe % 2 == 0 && nNe >= 8) ? 2 : 1; xr = 8 / xc; rpx = nMe / xr; cpx = nNe / xc; share = rpx * cpx; }
    __device__ bool next(int i, Unit& u) const {
        if ((G & 7) == 0 && nMe % xr == 0) {
            const int x = c & 7, q = c >> 3, nq = G >> 3; const long j = (long)i * nq + q; if (j >= (long)(total / 8)) return false;
            const int e = (int)(j / share), r = (int)(j % share); const int pm = (x / xc) * rpx + r % rpx, pn = (x % xc) * cpx + r / rpx;
            u.pm = e * nMe + pm; u.pn = e * nNe + pn; return true;
        }
        const long L = (long)i * G + c; if (L >= total) return false;
        const int e = (int)(L / per), r = (int)(L % per);
        u.pm = e * nMe + r % nMe; u.pn = e * nNe + r / nMe; return true;
    }
    __device__ __forceinline__ void a_ready(const Unit&) const {}
    __device__ __forceinline__ void done(const Unit&) const {}
};

template <class Epi, class Sched>
__device__ __forceinline__ void gemm_phase(LAS unsigned char* lds, const Gemm g, const Sched& S, const Epi& E) {
    int tid = threadIdx.x; asm volatile("" : "+v"(tid));
    const int wid = __builtin_amdgcn_readfirstlane(tid >> 6), lane = tid & 63, wr = wid >> 2, wc = wid & 3, fr = lane & 15, fq = lane >> 4;
    int Kv = g.K; asm volatile("" : "+s"(Kv));
    const int K = Kv, nt = K / BK;
    unsigned voffA[2], voffB[2];
#pragma unroll
    for (int i = 0; i < 2; ++i) { int R, C; stage_rc(tid * 16 + i * 8192, R, C); const int Rb = Epi::PERM ? ((R & ~31) + perm32(R & 31)) : R;
        voffA[i] = (unsigned)(R * K + C) * 2u; voffB[i] = (unsigned)(Rb * K + C) * 2u; }
    const size_t kstep = (size_t)(BK * 2);
    const size_t hstep = (size_t)HALF * K * 2;
    const size_t tstep = 2 * hstep;
    const unsigned ldsw = (unsigned)wid * 1024u;
    const int aoff = lds_byte(wr * 64 + fr, fq * 8), boff = lds_byte(wc * 32 + fr, fq * 8);
#define PG8_SA(b, h) (((b) * 2 + (h)) * HTB)
#define PG8_SB(b, h) ((4 + (b) * 2 + (h)) * HTB)
#define PG8_STAGE(bufoff, gbase, voff) do { _Pragma("unroll") for (int _i = 0; _i < 2; ++_i) \
        __builtin_amdgcn_global_load_lds((const unsigned*)((const char*)(gbase) + (voff)[_i]), (LAS unsigned*)(lds + (bufoff) + ldsw + _i * 8192), 16, 0, 0); } while (0)
#define PG8_LD8(p) __builtin_shufflevector(*(const LAS v4i_*)(p), *(const LAS v4i_*)((p) + 1024), 0, 1, 2, 3, 4, 5, 6, 7)
#define PG8_LDA(dst, b, h) do { _Pragma("unroll") for (int m = 0; m < 4; ++m) { if constexpr (Epi::FP8) dst##8[m] = PG8_LD8(lds + PG8_SA(b, h) + aoff + m * 2048); \
        else { _Pragma("unroll") for (int k = 0; k < 2; ++k) dst[m][k] = *(const LAS bf16x8*)(lds + PG8_SA(b, h) + aoff + m * 2048 + k * 1024); } } } while (0)
#define PG8_LDB(dst, b, h) do { _Pragma("unroll") for (int n = 0; n < 2; ++n) { if constexpr (Epi::FP8) dst##8[n] = PG8_LD8(lds + PG8_SB(b, h) + boff + n * 2048); \
        else { _Pragma("unroll") for (int k = 0; k < 2; ++k) dst[n][k] = *(const LAS bf16x8*)(lds + PG8_SB(b, h) + boff + n * 2048 + k * 1024); } } } while (0)
#define PG8_MMA(ai, bj, At, Bt) do { __builtin_amdgcn_s_setprio(1); _Pragma("unroll") for (int m = 0; m < 4; ++m) _Pragma("unroll") for (int n = 0; n < 2; ++n) { \
        if constexpr (Epi::FP8) asm volatile("v_mfma_scale_f32_16x16x128_f8f6f4 %0, %1, %2, %0, %3, %3 op_sel_hi:[0,0,0]" : "+v"(acc[ai][bj][m][n]) : "v"(Bt##8[n]), "v"(At##8[m]), "v"(fp8_unit_scale));   \
        else { _Pragma("unroll") for (int k = 0; k < 2; ++k) acc[ai][bj][m][n] = __builtin_amdgcn_mfma_f32_16x16x32_bf16(Bt[n][k], At[m][k], acc[ai][bj][m][n], 0, 0, 0); } } \
        __builtin_amdgcn_s_setprio(0); } while (0)
#define PG8_WAIT_V(n) asm volatile("s_waitcnt vmcnt(" #n ")" ::: "memory")
#define PG8_WAIT_L(n) asm volatile("s_waitcnt lgkmcnt(" #n ")" ::: "memory")
#define PG8_BAR __builtin_amdgcn_s_barrier()
#define PG8_SCHED __builtin_amdgcn_sched_barrier(0)
    Unit cur, nxt; int ui = 0;
    if (!S.next(0, cur)) return;
    f32x4 acc[2][2][4][2];
#pragma unroll
    for (int a = 0; a < 2; ++a)
#pragma unroll
        for (int b = 0; b < 2; ++b)
#pragma unroll
            for (int m = 0; m < 4; ++m)
#pragma unroll
                for (int n = 0; n < 2; ++n) acc[a][b][m][n] = (f32x4){0.f, 0.f, 0.f, 0.f};
    typedef int v4i_ __attribute__((ext_vector_type(4))); typedef int v8i_ __attribute__((ext_vector_type(8)));
    bf16x8 At[4][2], B0[2][2], B1[2][2]; v8i_ At8[4], B08[2], B18[2];
    int fp8_unit_scale = 0x7F7F7F7F; asm volatile("" : "+v"(fp8_unit_scale));
    const char* cA = (const char*)g.A + (size_t)cur.pm * tstep; const char* cB = (const char*)g.Bt + (size_t)cur.pn * tstep;
    S.a_ready(cur);
    PG8_STAGE(PG8_SB(0, 0), cB, voffB); PG8_STAGE(PG8_SA(0, 0), cA, voffA); PG8_STAGE(PG8_SB(0, 1), cB + hstep, voffB); PG8_STAGE(PG8_SA(0, 1), cA + hstep, voffA);
    if (wr == 1) PG8_BAR;
    PG8_WAIT_V(4); PG8_BAR;
    PG8_STAGE(PG8_SB(1, 0), cB + kstep, voffB); PG8_STAGE(PG8_SA(1, 0), cA + kstep, voffA); PG8_STAGE(PG8_SB(1, 1), cB + hstep + kstep, voffB);
    PG8_WAIT_V(6); PG8_BAR;
    for (;;) {
        const bool has_next = S.next(ui + 1, nxt);
        const char* nA = has_next ? (const char*)g.A + (size_t)nxt.pm * tstep : cA; const char* nB = has_next ? (const char*)g.Bt + (size_t)nxt.pn * tstep : cB;
        for (int t = 0; t < nt; t += 2) {
            const bool last = (t == nt - 2);
            const char* a1 = cA + (size_t)(t + 1) * kstep;
            const char* a2 = last ? nA : cA + (size_t)(t + 2) * kstep; const char* b2 = last ? nB : cB + (size_t)(t + 2) * kstep;
            const char* a3 = a2 + kstep; const char* b3 = b2 + kstep;
            if (last && has_next) S.a_ready(nxt);
            if constexpr (Epi::SEG) { if (t == 4 || t == 6) { int tz = tid; asm volatile("" : "+v"(tz)); const int wz = __builtin_amdgcn_readfirstlane(tz >> 6), lz = tz & 63; E.mid(acc, cur, t == 4 ? 0 : 1, wz >> 2, wz & 3, lz & 15, lz >> 4); } }
            PG8_LDB(B0, 0, 0); PG8_SCHED; PG8_LDA(At, 0, 0); PG8_STAGE(PG8_SA(1, 1), a1 + hstep, voffA);
            PG8_WAIT_L(8); PG8_BAR; PG8_WAIT_L(0); PG8_MMA(0, 0, At, B0); PG8_BAR; PG8_SCHED;
            PG8_LDB(B1, 0, 1); PG8_STAGE(PG8_SB(0, 0), b2, voffB);
            PG8_BAR; PG8_WAIT_L(0); PG8_MMA(0, 1, At, B1); PG8_BAR;
            PG8_LDA(At, 0, 1); PG8_STAGE(PG8_SA(0, 0), a2, voffA);
            PG8_BAR; PG8_WAIT_L(0); PG8_MMA(1, 0, At, B0); PG8_BAR; PG8_SCHED;
            PG8_STAGE(PG8_SB(0, 1), b2 + hstep, voffB);
            PG8_WAIT_V(6); PG8_BAR; PG8_MMA(1, 1, At, B1); PG8_BAR;
            PG8_LDB(B0, 1, 0); PG8_SCHED; PG8_LDA(At, 1, 0); PG8_STAGE(PG8_SA(0, 1), a2 + hstep, voffA);
            PG8_WAIT_L(8); PG8_BAR; PG8_WAIT_L(0); PG8_MMA(0, 0, At, B0); PG8_BAR; PG8_SCHED;
            PG8_LDB(B1, 1, 1); PG8_STAGE(PG8_SB(1, 0), b3, voffB);
            PG8_BAR; PG8_WAIT_L(0); PG8_MMA(0, 1, At, B1); PG8_BAR;
            PG8_LDA(At, 1, 1); PG8_STAGE(PG8_SA(1, 0), a3, voffA);
            PG8_BAR; PG8_WAIT_L(0); PG8_MMA(1, 0, At, B0); PG8_BAR; PG8_SCHED;
            PG8_STAGE(PG8_SB(1, 1), b3 + hstep, voffB);
            PG8_WAIT_V(6); PG8_BAR; PG8_MMA(1, 1, At, B1); PG8_BAR;
        }
        if constexpr (Epi::FP8) asm volatile("s_nop 15\n\ts_nop 15\n\ts_nop 15" ::: "memory");
        { int tz = tid; asm volatile("" : "+v"(tz)); const int wz = __builtin_amdgcn_readfirstlane(tz >> 6), lz = tz & 63;
          E(acc, cur, wz >> 2, wz & 3, lz & 15, lz >> 4); } S.done(cur);
        if (!has_next) break;
#pragma unroll
        for (int a = 0; a < 2; ++a)
#pragma unroll
            for (int b = 0; b < 2; ++b)
#pragma unroll
                for (int m = 0; m < 4; ++m)
#pragma unroll
                    for (int n = 0; n < 2; ++n) acc[a][b][m][n] = (f32x4){0.f, 0.f, 0.f, 0.f};
        cur = nxt; cA = nA; cB = nB; ++ui;
    }
    PG8_WAIT_V(0);
    if (wr == 0) PG8_BAR;
    PG8_BAR;
#undef PG8_SA
#undef PG8_SB
#undef PG8_STAGE
#undef PG8_LDA
#undef PG8_LD8
#undef PG8_LDB
#undef PG8_MMA
#undef PG8_WAIT_V
#undef PG8_WAIT_L
#undef PG8_BAR
#undef PG8_SCHED
}

struct EpiInProj {
    static constexpr bool PERM = true, SEG = false, FP8 = false;
    bf16_t* O; float* BA;
    __device__ __forceinline__ void operator()(const f32x4 (&acc)[2][2][4][2], const Unit& u, int wr, int wc, int fr, int fq) const {
        const int row0 = u.pm * BM + wr * 64 + fr, col0 = 3072 + u.pn * BM + wc * 32 + 8 * fq;
        const bool sig = false, ba = (u.pn == 13) && (wc == 0) && (fq < 3);
#pragma unroll
        for (int ai = 0; ai < 2; ++ai)
#pragma unroll
            for (int m = 0; m < 4; ++m) { const int row = row0 + ai * HALF + m * 16; bf16_t* rowp = O + (size_t)row * NPROJ + col0;
#pragma unroll
                for (int bj = 0; bj < 2; ++bj) { f32x4 v0 = acc[ai][bj][m][0], v1 = acc[ai][bj][m][1];
                    if (sig) {
#pragma unroll
                        for (int j = 0; j < 4; ++j) { v0[j] = sigmoidf_(v0[j]); v1[j] = sigmoidf_(v1[j]); } }
                    u32x4 w; w.x = pk2(v0[0], v0[1]); w.y = pk2(v0[2], v0[3]); w.z = pk2(v1[0], v1[1]); w.w = pk2(v1[2], v1[3]);
                    *(u32x4*)(rowp + bj * HALF) = w;
                    if (bj == 1 && ba) { float* bp = BA + (size_t)row * 32 + 8 * fq; *(f32x4*)bp = v0; *(f32x4*)(bp + 4) = v1; } } }
    }
};
struct EpiGates {
    static constexpr bool PERM = true, SEG = false, FP8 = true;
    bf16_t* O;
    __device__ __forceinline__ void operator()(const f32x4 (&acc)[2][2][4][2], const Unit& u, int wr, int wc, int fr, int fq) const {
        const int row0 = u.pm * BM + wr * 64 + fr, col0 = u.pn * BM + wc * 32 + 8 * fq;
#pragma unroll
        for (int ai = 0; ai < 2; ++ai)
#pragma unroll
            for (int m = 0; m < 4; ++m) { int rowi = row0 + ai * HALF + m * 16; asm volatile("" : "+v"(rowi)); bf16_t* rowp = O + (size_t)rowi * NPROJ + col0;
#pragma unroll
                for (int bj = 0; bj < 2; ++bj) { f32x4 v0 = acc[ai][bj][m][0] * 0.03125f, v1 = acc[ai][bj][m][1] * 0.03125f;
#pragma unroll
                    for (int j = 0; j < 4; ++j) { v0[j] = sigmoidf_(v0[j]); v1[j] = sigmoidf_(v1[j]); }
                    u32x4 w; w.x = pk2(v0[0], v0[1]); w.y = pk2(v0[2], v0[3]); w.z = pk2(v1[0], v1[1]); w.w = pk2(v1[2], v1[3]);
                    *(u32x4*)(rowp + bj * HALF) = w; }
                asm volatile("" ::: "memory"); }
    }
};
struct EpiGateCat {
    static constexpr bool PERM = false, SEG = true, FP8 = false;
    const bf16_t* PROJ; bf16_t* MB;
    __device__ __forceinline__ void mid(f32x4 (&acc)[2][2][4][2], const Unit& u, int seg, int wr, int wc, int fr, int fq) const {
        const int row0 = u.pm * BM + wr * 64 + fr, col0 = u.pn * BM + wc * 32 + 4 * fq;
#pragma unroll
        for (int ai = 0; ai < 2; ++ai)
#pragma unroll
            for (int m = 0; m < 4; ++m) { int rowi = row0 + ai * HALF + m * 16; asm volatile("" : "+v"(rowi)); const bf16_t* gp = PROJ + (size_t)rowi * NPROJ + C_GATE + seg * 1024 + col0;
#pragma unroll
                for (int bj = 0; bj < 2; ++bj)
#pragma unroll
                    for (int n = 0; n < 2; ++n) { const u32x2 ga = *(const u32x2*)(gp + bj * HALF + n * 16), gb = *(const u32x2*)(gp + 1024 + bj * HALF + n * 16);
                        f32x4& v = acc[ai][bj][m][n]; v[0] *= bflo(ga.x) * frcp(bflo(gb.x)); v[1] *= bfhi(ga.x) * frcp(bfhi(gb.x)); v[2] *= bflo(ga.y) * frcp(bflo(gb.y)); v[3] *= bfhi(ga.y) * frcp(bfhi(gb.y)); }
                asm volatile("" ::: "memory"); }
    }
    __device__ __forceinline__ void operator()(const f32x4 (&acc)[2][2][4][2], const Unit& u, int wr, int wc, int fr, int fq) const {
        const int row0 = u.pm * BM + wr * 64 + fr, col0 = u.pn * BM + wc * 32 + 4 * fq;
#pragma unroll
        for (int ai = 0; ai < 2; ++ai)
#pragma unroll
            for (int m = 0; m < 4; ++m) { int rowi = row0 + ai * HALF + m * 16; asm volatile("" : "+v"(rowi)); const size_t row = (size_t)rowi;
#pragma unroll
                for (int bj = 0; bj < 2; ++bj)
#pragma unroll
                    for (int n = 0; n < 2; ++n) { const int col = col0 + bj * HALF + n * 16;
                        const u32x2 gw = *(const u32x2*)(PROJ + row * NPROJ + C_GATE + 2 * 1024 + col);
                        const f32x4 v = acc[ai][bj][m][n];
                        u32x2 w; w.x = pk2(v[0] * bflo(gw.x), v[1] * bfhi(gw.x)); w.y = pk2(v[2] * bflo(gw.y), v[3] * bfhi(gw.y)); *(u32x2*)(MB + row * D + col) = w; }
                asm volatile("" ::: "memory"); }
    }
};
struct EpiRes {
    static constexpr bool PERM = false, SEG = false, FP8 = false;
    const float* XR; float* H;
    __device__ __forceinline__ void operator()(const f32x4 (&acc)[2][2][4][2], const Unit& u, int wr, int wc, int fr, int fq) const {
        const int row0 = u.pm * BM + wr * 64 + fr, col0 = u.pn * BM + wc * 32 + 4 * fq;
#pragma unroll
        for (int ai = 0; ai < 2; ++ai)
#pragma unroll
            for (int m = 0; m < 4; ++m) { int rowi = row0 + ai * HALF + m * 16; asm volatile("" : "+v"(rowi)); const size_t off = (size_t)rowi * D + col0;
#pragma unroll
                for (int bj = 0; bj < 2; ++bj)
#pragma unroll
                    for (int n = 0; n < 2; ++n) { const f32x4 xr = *(const f32x4*)(XR + off + bj * HALF + n * 16);
                        *(f32x4*)(H + off + bj * HALF + n * 16) = xr * ALPHA + acc[ai][bj][m][n]; }
                asm volatile("" ::: "memory"); }
    }
};
struct EpiSwiglu {
    static constexpr bool PERM = true, SEG = false, FP8 = true;
    unsigned char* HID;
    __device__ __forceinline__ void operator()(const f32x4 (&acc)[2][2][4][2], const Unit& u, int wr, int wc, int fr, int fq) const {
        const int row0 = u.pm * BM + wr * 64 + fr, col0 = (u.pn & 15) * 128 + wc * 32 + 8 * fq;
#pragma unroll
        for (int ai = 0; ai < 2; ++ai)
#pragma unroll
            for (int m = 0; m < 4; ++m) { const f32x4 g0 = acc[ai][0][m][0] * 0.03125f, g1 = acc[ai][0][m][1] * 0.03125f, u0 = acc[ai][1][m][0] * 0.03125f, u1 = acc[ai][1][m][1] * 0.03125f;
                f32x4 h0, h1;
#pragma unroll
                for (int j = 0; j < 4; ++j) { h0[j] = siluf_(g0[j]) * u0[j]; h1[j] = siluf_(g1[j]) * u1[j]; }
                u32x2 w; w.x = pk4_fp8(h0[0], h0[1], h0[2], h0[3]); w.y = pk4_fp8(h1[0], h1[1], h1[2], h1[3]);
                int rowi = row0 + ai * HALF + m * 16; asm volatile("" : "+v"(rowi));
                *(u32x2*)(HID + (size_t)rowi * DE + col0) = w; asm volatile("" ::: "memory"); }
    }
};
struct EpiDown {
    static constexpr bool PERM = true, SEG = false, FP8 = true;
    bf16_t* Y; const float* GV;
    __device__ __forceinline__ void operator()(const f32x4 (&acc)[2][2][4][2], const Unit& u, int wr, int wc, int fr, int fq) const {
        const int row0 = u.pm * BM + wr * 64 + fr, col0 = (u.pn & 3) * BM + wc * 32 + 8 * fq;
#pragma unroll
        for (int ai = 0; ai < 2; ++ai)
#pragma unroll
            for (int m = 0; m < 4; ++m) { int row = row0 + ai * HALF + m * 16; asm volatile("" : "+v"(row)); const float gv = GV[row] * 0.03125f;
#pragma unroll
                for (int bj = 0; bj < 2; ++bj) { const f32x4 v0 = acc[ai][bj][m][0] * gv, v1 = acc[ai][bj][m][1] * gv;
                    u32x4 w; w.x = pk2(v0[0], v0[1]); w.y = pk2(v0[2], v0[3]); w.z = pk2(v1[0], v1[1]); w.w = pk2(v1[2], v1[3]);
                    *(u32x4*)(Y + (size_t)row * D + col0 + bj * HALF) = w; } }
    }
};
}

#define XB_TMO      128
#define XB_XCNT(j)  (256  + 64 * (j))
#define XB_XSUB(j)  (1280 + 64 * (j))
#define XB_XGEN(j)  (2304 + 64 * (j))
#define XB_TOP      3328
#define XB_TOPGEN   3392
#define XCD_BAR_WORDS 3456
#define XB_SPIN_CAP (1u << 22)
__device__ __forceinline__ unsigned xb_ld(unsigned* p)              { return __hip_atomic_load(p, __ATOMIC_RELAXED, __HIP_MEMORY_SCOPE_AGENT); }
__device__ __forceinline__ unsigned xb_add(unsigned* p, unsigned v) { return __hip_atomic_fetch_add(p, v, __ATOMIC_RELAXED, __HIP_MEMORY_SCOPE_AGENT); }
__device__ __forceinline__ unsigned xb_xcc_id() { return (unsigned)__builtin_amdgcn_s_getreg((3 << 11) | 20) & 0xFu; }
#define XB_SPIN(cond, bar) do { unsigned _sp = 0; while (cond) { __builtin_amdgcn_s_sleep(1); \
    if ((++_sp & 255u) == 0u) { if (xb_ld(&(bar)[XB_TMO])) break; if (_sp > XB_SPIN_CAP) { atomicAdd(&(bar)[XB_TMO], 1u); break; } } } } while (0)
struct XcdBarrier { unsigned* bar; unsigned x; volatile LAS unsigned* st; };
__device__ __forceinline__ XcdBarrier xcd_barrier_post(unsigned* bar, volatile LAS unsigned* st) {
    XcdBarrier b; b.bar = bar; b.x = xb_xcc_id(); b.st = st;
    if (threadIdx.x == 0) (void)xb_add(&bar[XB_XCNT(b.x)], 1u);
    return b;
}
__device__ __forceinline__ void xcd_barrier_complete(unsigned* bar, unsigned x, unsigned& nloc, unsigned& nx) {
    const unsigned G = gridDim.x * gridDim.y * gridDim.z;
    unsigned sum, cnt, mine, sp = 0u;
    for (;;) {
        sum = 0u; cnt = 0u; mine = 0u;
#pragma unroll
        for (unsigned j = 0; j < 16; ++j) { const unsigned c = xb_ld(&bar[XB_XCNT(j)]); sum += c; cnt += (c > 0u) ? 1u : 0u; }
        mine = xb_ld(&bar[XB_XCNT(x)]);
        if (sum == G) break;
        __builtin_amdgcn_s_sleep(1);
        if ((++sp & 255u) == 0u) { if (xb_ld(&bar[XB_TMO])) break; if (sp > XB_SPIN_CAP) { atomicAdd(&bar[XB_TMO], 1u); break; } }
    }
    nloc = mine > 0u ? mine : 1u; nx = cnt > 0u ? cnt : 1u;
}
__device__ __forceinline__ void xcd_barrier(const XcdBarrier& b) {
    asm volatile("s_waitcnt vmcnt(0)" ::: "memory");
    __syncthreads();
    if (threadIdx.x == 0) {
        unsigned* bar = b.bar; asm volatile("" : "+s"(bar));
        __builtin_amdgcn_s_waitcnt(0);
        unsigned nloc = b.st[0], nx = b.st[1];
        if (nloc == 0u) { xcd_barrier_complete(bar, b.x, nloc, nx); b.st[0] = nloc; b.st[1] = nx; }
        const unsigned old = xb_add(&bar[XB_XSUB(b.x)], 1u);
        const unsigned gen = old / nloc;
        if (old + 1u == (gen + 1u) * nloc) {
            __builtin_amdgcn_fence(__ATOMIC_RELEASE, "agent");
            asm volatile("s_waitcnt vmcnt(0)" ::: "memory");
            const unsigned og = xb_add(&bar[XB_TOP], 1u);
            const unsigned tg = og / nx;
            if (og + 1u == (tg + 1u) * nx) xb_add(&bar[XB_TOPGEN], 1u);
            else XB_SPIN(xb_ld(&bar[XB_TOPGEN]) == tg, bar);
            __builtin_amdgcn_fence(__ATOMIC_ACQUIRE, "agent");
            xb_add(&bar[XB_XGEN(b.x)], 1u);
            asm volatile("s_waitcnt vmcnt(0)" ::: "memory");
        } else {
            XB_SPIN(xb_ld(&bar[XB_XGEN(b.x)]) == gen, bar);
            __builtin_amdgcn_fence(__ATOMIC_ACQUIRE, "agent");
            asm volatile("s_waitcnt vmcnt(0)" ::: "memory");
        }
    }
    __syncthreads();
}

struct Args { const float* in[20]; float* out; unsigned char* ws; int ph_lo, ph_hi; };
typedef const __attribute__((address_space(4))) Args* KArgs;
DI KArgs kargs() { KArgs p = (KArgs)__builtin_amdgcn_kernarg_segment_ptr(); asm volatile("" : "+s"(p)); return p; }
struct Ctx {
    float* out; unsigned char* ws;
    int tid, lane, wave, G, bid;
    int layer, slab;
    int nseq, seqlen;
    int stok, sbase;
    int dry;
};
#define WSP(T, off) ((T*)(c.ws + (off)))
#define BIGP(T, off) ((T*)(c.ws + WS_BIG + (off)))

__device__ const float INV_FREQ[32] = {1.000000000e+00f, 7.498942018e-01f, 5.623413324e-01f, 4.216965139e-01f, 3.162277639e-01f, 2.371373773e-01f, 1.778279394e-01f, 1.333521456e-01f, 1.000000015e-01f, 7.498942316e-02f, 5.623413250e-02f, 4.216964915e-02f, 3.162277490e-02f, 2.371373773e-02f, 1.778279431e-02f, 1.333521400e-02f, 9.999999776e-03f, 7.498942316e-03f, 5.623413250e-03f, 4.216964822e-03f, 3.162277630e-03f, 2.371373819e-03f, 1.778279431e-03f, 1.333521446e-03f, 1.000000047e-03f, 7.498941850e-04f, 5.623413017e-04f, 4.216965172e-04f, 3.162277571e-04f, 2.371373703e-04f, 1.778279402e-04f, 1.333521504e-04f};
DI void tr_item(const float* src, long src_ld, int src_col0, int nvalid, int kvalid, bf16_t* dst, long dst_ld, int dst_row0, int k0, LAS float* scr, int lane) {
    float tv[32];
#pragma unroll
    for (int i = 0; i < 32; ++i) { const int kk = 2 * i + (lane >> 5), cc = lane & 31;
        tv[i] = 0.f; if ((k0 + kk) < kvalid && cc < nvalid) tv[i] = src[(size_t)(k0 + kk) * src_ld + src_col0 + cc]; }
#pragma unroll
    for (int i = 0; i < 32; ++i) { const int kk = 2 * i + (lane >> 5), cc = lane & 31; scr[kk * 33 + cc] = tv[i]; }
    asm volatile("s_waitcnt lgkmcnt(0)" ::: "memory");
    const int c8 = lane & 7;
#pragma unroll
    for (int j = 0; j < 4; ++j) { const int n = (lane >> 3) + 8 * j; const LAS float* s = scr + (8 * c8) * 33 + n;
        u32x4 o; o.x = pk2(s[0 * 33], s[1 * 33]); o.y = pk2(s[2 * 33], s[3 * 33]); o.z = pk2(s[4 * 33], s[5 * 33]); o.w = pk2(s[6 * 33], s[7 * 33]);
        *(u32x4*)(dst + (size_t)(dst_row0 + n) * dst_ld + k0 + 8 * c8) = o; }
    asm volatile("s_waitcnt lgkmcnt(0)" ::: "memory");
}
DI void tr_item8(const float* src, long src_ld, int src_col0, int kvalid, unsigned char* dst, long dst_ld, int dst_row0, int k0, float scale, LAS float* scr, int lane) {
    float tv[32];
#pragma unroll
    for (int i = 0; i < 32; ++i) { const int kk = 2 * i + (lane >> 5), cc = lane & 31; tv[i] = 0.f; if ((k0 + kk) < kvalid) tv[i] = src[(size_t)(k0 + kk) * src_ld + src_col0 + cc]; }
#pragma unroll
    for (int i = 0; i < 32; ++i) { const int kk = 2 * i + (lane >> 5), cc = lane & 31; scr[kk * 33 + cc] = tv[i]; }
    asm volatile("s_waitcnt lgkmcnt(0)" ::: "memory");
    const int c8 = lane & 7;
#pragma unroll
    for (int j = 0; j < 4; ++j) { const int n = (lane >> 3) + 8 * j; const LAS float* s = scr + (8 * c8) * 33 + n;
        u32x2 o; o.x = pk4_fp8(s[0 * 33] * scale, s[1 * 33] * scale, s[2 * 33] * scale, s[3 * 33] * scale); o.y = pk4_fp8(s[4 * 33] * scale, s[5 * 33] * scale, s[6 * 33] * scale, s[7 * 33] * scale);
        *(u32x2*)(dst + (size_t)(dst_row0 + n) * dst_ld + k0 + 8 * c8) = o; }
    asm volatile("s_waitcnt lgkmcnt(0)" ::: "memory");
}
DI void phase_weights(KArgs args, LAS unsigned char* lds, const Ctx& c) {
    const int l = c.layer, lane = c.lane;
    LAS float* scr = (LAS float*)(lds + c.wave * 8448);
    const int gw = c.bid * 8 + c.wave, NGW = c.G * 8;
    constexpr int I_IN = 16 * 112 + 16 * 96, I_NA = 4 * 32, I_DIL = 2 * 32, I_GDN = 6 * 32, I_OUT = 16 * 32, I_GU1 = 16 * 128, I_D1 = 32 * 32;
    constexpr int NITEMS = I_IN + I_NA + I_DIL + I_GDN + I_OUT + 16 * I_GU1 + 16 * I_D1;
    for (int it = gw; it < NITEMS; it += NGW) {
        int r = it;
        const float* src; long sld; int sc0, nv = 32, kv; bf16_t* dst; long dld; int dr0, k0;
        if (r < 16 * 112) { const int kb = r / 112, nb = r % 112, n0 = 32 * nb; src = args->in[2] + (size_t)l * D * DIN; sld = DIN; kv = D;
            sc0 = n0; nv = 3480 - n0; if (nv < 0) { nv = 0; sc0 = 0; } if (nv > 32) nv = 32;
            dst = WSP(bf16_t, WS_WIN); dld = D; dr0 = n0; k0 = 64 * kb; }
        else if (r < I_IN) { const int q = r - 16 * 112, kb = q / 96, nb = q % 96;
            tr_item8(args->in[2] + (size_t)l * D * DIN, DIN, 3480 + 32 * nb, D, WSP(unsigned char, WS_WG8), D, 32 * nb, 64 * kb, 32.0f, scr, lane); continue; }
        else if ((r -= I_IN) < I_NA) { const int kb = r / 32, nb = r % 32; src = args->in[8] + (size_t)l * 256 * D; sld = D; sc0 = 32 * nb; kv = 256; dst = WSP(bf16_t, WS_WBR); dld = 768; dr0 = 32 * nb; k0 = 64 * kb; }
        else if ((r -= I_NA) < I_DIL) { const int kb = r / 32, nb = r % 32; src = args->in[9] + (size_t)l * 128 * D; sld = D; sc0 = 32 * nb; kv = 128; dst = WSP(bf16_t, WS_WBR) + 256; dld = 768; dr0 = 32 * nb; k0 = 64 * kb; }
        else if ((r -= I_DIL) < I_GDN) { const int kb = r / 32, nb = r % 32; src = args->in[10] + (size_t)l * 384 * D; sld = D; sc0 = 32 * nb; kv = 384; dst = WSP(bf16_t, WS_WBR) + 384; dld = 768; dr0 = 32 * nb; k0 = 64 * kb; }
        else if ((r -= I_GDN) < I_OUT) { const int kb = r / 32, nb = r % 32; src = args->in[11] + (size_t)l * D * D; sld = D; sc0 = 32 * nb; kv = D; dst = WSP(bf16_t, WS_WOUT); dld = D; dr0 = 32 * nb; k0 = 64 * kb; }
        else if ((r -= I_OUT) < 16 * I_GU1) { const int e = r / I_GU1, q = r % I_GU1, kb = q / 128, nb = q % 128, n0 = 32 * nb, j = n0 >> 8, rr = n0 & 255;
            tr_item8((rr < 128 ? args->in[16] : args->in[15]) + ((size_t)l * NE + e) * D * DE, DE, 128 * j + (rr & 127), D, WSP(unsigned char, WS_WGU) + (size_t)e * 4096 * D, D, n0, 64 * kb, 32.0f, scr, lane); continue; }
        else { r -= 16 * I_GU1; const int e = r / I_D1, q = r % I_D1, kb = q / 32, nb = q % 32;
            tr_item8(args->in[17] + ((size_t)l * NE + e) * DE * D, D, 32 * nb, DE, WSP(unsigned char, WS_WD) + (size_t)e * D * DE, DE, 32 * nb, 64 * kb, 32.0f, scr, lane); continue; }
        tr_item(src, sld, sc0, nv, kv, dst, dld, dr0, k0, scr, lane);
    }
    if (l == 0) {
        for (int t = gw; t < T_ALL; t += NGW) {
            const float* xr = (t < T_P) ? args->in[0] + (size_t)t * D : args->in[1] + (size_t)(t - T_P) * D;
            bf16_t* o = WSP(bf16_t, WS_XB) + (size_t)t * D;
#pragma unroll
            for (int j = 0; j < 4; ++j) { const f32x4 v = *(const f32x4*)(xr + 4 * lane + 256 * j); u32x2 w; w.x = pk2(v[0], v[1]); w.y = pk2(v[2], v[3]); *(u32x2*)(o + 4 * lane + 256 * j) = w;
                *(unsigned*)(WSP(unsigned char, WS_XB8) + (size_t)t * D + 4 * lane + 256 * j) = pk4_fp8(v[0], v[1], v[2], v[3]); }
        }
        float* cs = WSP(float, WS_CS);
        for (int i = c.bid * 512 + c.tid; i < 16384 * 32; i += c.G * 512) { const int pos = i >> 5, k = i & 31;
            const float inv = INV_FREQ[k];
            const float ang = (float)pos * inv;
            cs[pos * 64 + k] = cosf(ang); cs[pos * 64 + 32 + k] = sinf(ang); }
    }
}

constexpr int TLD = 72, TILEB = 64 * TLD * 2;
DI int tsw(int row) { return ((row >> 4) & 3) << 3; }
template <bool SA = false, bool SB = false> DI f32x16 mm_tile(const LAS bf16_t* A, const LAS bf16_t* Bt, int m0, int n0, int lane) {
    f32x16 acc = zero16(); const int r = lane & 31, hh = lane >> 5; const int sa = SA ? tsw(m0 + r) : 0, sb = SB ? tsw(n0 + r) : 0;
#pragma unroll
    for (int ks = 0; ks < 4; ++ks) { const bf16x8 a = *(const LAS bf16x8*)(A + (m0 + r) * TLD + ((16 * ks + 8 * hh) ^ sa)); const bf16x8 b = *(const LAS bf16x8*)(Bt + (n0 + r) * TLD + ((16 * ks + 8 * hh) ^ sb)); acc = MFMA32(a, b, acc); }
    return acc;
}

constexpr int PI_P0 = 0, PI_P1 = 9216, PI_INTRA = 18432, PI_AM = 27648, PI_TT = 45056, PI_TD0 = 54272, PI_TD1 = 60416, PI_PM = 65024, PI_VEC = 71168, PI_BYTES = 72704;
constexpr int PI_WT = PI_AM, PI_UT = PI_TD0;
DI void gdn_prep_pair(KArgs args, LAS unsigned char* L0, const Ctx& c, int pu) {
    int tid = c.tid; asm volatile("" : "+v"(tid)); const int lane = tid & 63, wave = __builtin_amdgcn_readfirstlane(tid >> 6), l = c.layer;
    const int dir = wave >> 2, wg = wave & 3, tg = tid & 255, head = pu % 6, gch = pu / 6, inst = (gch * 6 + head) * 2 + dir;
    const int cps = c.seqlen >> 6, seq = gch / cps, n = gch % cps;
    const bf16_t* PROJ = BIGP(bf16_t, B_PROJ); const float* BA = BIGP(float, B_BA);
    unsigned char* G = BIGP(unsigned char, B_GSCR) + (size_t)inst * GSTRIDE;
    LAS unsigned char* L = L0 + dir * PI_BYTES;
    LAS bf16_t* P0 = (LAS bf16_t*)(L + PI_P0); LAS bf16_t* P1 = (LAS bf16_t*)(L + PI_P1); LAS bf16_t* INTRA = (LAS bf16_t*)(L + PI_INTRA);
    LAS float* AM = (LAS float*)(L + PI_AM); LAS bf16_t* TT = (LAS bf16_t*)(L + PI_TT);
    LAS float* TD0 = (LAS float*)(L + PI_TD0); LAS float* TD1 = (LAS float*)(L + PI_TD1); LAS float* PM = (LAS float*)(L + PI_PM);
    LAS float* GV = (LAS float*)(L + PI_VEC); LAS float* BV = GV + 64; LAS float* GC = GV + 128;
    LAS bf16_t* WT = (LAS bf16_t*)(L + PI_WT); LAS bf16_t* UT = (LAS bf16_t*)(L + PI_UT);
    const int ia = tg >> 3, p = tg & 7;
    float q[2][8], k[2][8], v[2][8];
#pragma unroll
    for (int h2 = 0; h2 < 2; ++h2)
#pragma unroll
        for (int j = 0; j < 8; ++j) { q[h2][j] = 0.f; k[h2][j] = 0.f; v[h2][j] = 0.f; }
    const float* cw = args->in[4] + (size_t)l * 5 * 1152 + 64 * head + 8 * p;
#pragma unroll
    for (int tp = 0; tp < 5; ++tp) { const float* w = cw + tp * 1152;
        const f32x4 wq0 = *(const f32x4*)w, wq1 = *(const f32x4*)(w + 4), wk0 = *(const f32x4*)(w + 384), wk1 = *(const f32x4*)(w + 388), wv0 = *(const f32x4*)(w + 768), wv1 = *(const f32x4*)(w + 772);
#pragma unroll
        for (int h2 = 0; h2 < 2; ++h2) { const int i = ia + 32 * h2, tokl = dir ? 63 - i : i, pp = n * 64 + tokl + tp - 2;
            if (pp >= 0 && pp < c.seqlen) { const bf16_t* rp = PROJ + (size_t)(seq * c.seqlen + pp) * NPROJ + 64 * head + 8 * p;
                const u32x4 rq = *(const u32x4*)(rp + C_QC), rk = *(const u32x4*)(rp + C_KC), rv = *(const u32x4*)(rp + C_VC);
#pragma unroll
                for (int j = 0; j < 4; ++j) { const float a0 = (j < 2) ? wq0[2 * j] : wq1[2 * j - 4], a1 = (j < 2) ? wq0[2 * j + 1] : wq1[2 * j - 3];
                    const float b0 = (j < 2) ? wk0[2 * j] : wk1[2 * j - 4], b1 = (j < 2) ? wk0[2 * j + 1] : wk1[2 * j - 3];
                    const float c0 = (j < 2) ? wv0[2 * j] : wv1[2 * j - 4], c1 = (j < 2) ? wv0[2 * j + 1] : wv1[2 * j - 3];
                    q[h2][2 * j] += a0 * bflo(rq[j]); q[h2][2 * j + 1] += a1 * bfhi(rq[j]);
                    k[h2][2 * j] += b0 * bflo(rk[j]); k[h2][2 * j + 1] += b1 * bfhi(rk[j]);
                    v[h2][2 * j] += c0 * bflo(rv[j]); v[h2][2 * j + 1] += c1 * bfhi(rv[j]); } } } }
#pragma unroll
    for (int h2 = 0; h2 < 2; ++h2) { float sq = 0.f, sk = 0.f;
#pragma unroll
        for (int j = 0; j < 8; ++j) { q[h2][j] = siluf_(q[h2][j]); k[h2][j] = siluf_(k[h2][j]); v[h2][j] = siluf_(v[h2][j]); sq += q[h2][j] * q[h2][j]; sk += k[h2][j] * k[h2][j]; }
        sq += __shfl_xor(sq, 1); sq += __shfl_xor(sq, 2); sq += __shfl_xor(sq, 4);
        sk += __shfl_xor(sk, 1); sk += __shfl_xor(sk, 2); sk += __shfl_xor(sk, 4);
        const float rq_ = 0.125f * frsq(sq + NORM_EPS), rk_ = frsq(sk + NORM_EPS);
#pragma unroll
        for (int j = 0; j < 8; ++j) { q[h2][j] *= rq_; k[h2][j] *= rk_; }
        if (p == 0) { const int i = ia + 32 * h2, tokl = dir ? 63 - i : i; const float* bar = BA + (size_t)(seq * c.seqlen + n * 64 + tokl) * 32;
            const float bl = bar[dir * 6 + head], al = bar[12 + dir * 6 + head];
            const float xx = al + args->in[6][l * 12 + dir * 6 + head];
            const float sp = xx > 20.f ? xx : log1pf(expf(xx));
            GV[i] = -expf(args->in[5][l * 12 + dir * 6 + head]) * sp; BV[i] = sigmoidf_(bl); } }
    __syncthreads();
    float gcl_;
    { float x = GV[lane];
#pragma unroll
        for (int o = 1; o < 64; o <<= 1) { const float y = __shfl_up(x, o); if (lane >= o) x += y; }
        if (wg == 0) GC[lane] = x;
        gcl_ = x; }
    const float gc0 = __shfl(gcl_, ia), gc1 = __shfl(gcl_, ia + 32), gcl = __shfl(gcl_, 63);
#pragma unroll
    for (int h2 = 0; h2 < 2; ++h2) { const int i = ia + 32 * h2; u32x4 wq, wk;
#pragma unroll
        for (int j = 0; j < 4; ++j) { wq[j] = pk2(q[h2][2 * j], q[h2][2 * j + 1]); wk[j] = pk2(k[h2][2 * j], k[h2][2 * j + 1]); }
        *(LAS u32x4*)(P0 + i * TLD + 8 * p) = wq; *(LAS u32x4*)(P1 + i * TLD + 8 * p) = wk; }
    __syncthreads();
    { const int mat = wg >> 1, mt = wg & 1, hh = lane >> 5;
#pragma unroll
        for (int nt = 0; nt < 2; ++nt) { const int jc = 32 * nt + (lane & 31);
            const f32x16 a = mm_tile(mat ? P0 : P1, P1, 32 * mt, 32 * nt, lane);
            const float gj = GC[jc];
#pragma unroll
            for (int r = 0; r < 16; ++r) { const int ii = 32 * mt + crow(r, hh); const float gi = GC[ii];
                if (mat == 0) AM[ii * 68 + jc] = (jc < ii) ? BV[ii] * a[r] * __expf(gi - gj) : 0.f;
                else INTRA[ii * TLD + jc] = (bf16_t)(pk2((jc <= ii) ? a[r] * __expf(gi - gj) : 0.f, 0.f) & 0xffffu); } } }
    __syncthreads();
    if (wg == dir) {
        const int b = lane >> 5, cidx = lane & 31; float t[32];
#pragma unroll
        for (int ii = 0; ii < 32; ++ii) t[ii] = (ii == cidx) ? 1.f : 0.f;
        const LAS float* Ab = AM + (32 * b) * 68 + 32 * b;
#pragma unroll
        for (int ii = 1; ii < 32; ++ii) { float acc = 0.f;
#pragma unroll
            for (int j4 = 0; j4 < ii; j4 += 4) { const f32x4 a4 = *(const LAS f32x4*)(Ab + ii * 68 + j4);
                acc += a4[0] * t[j4]; acc += a4[1] * t[j4 + 1]; acc += a4[2] * t[j4 + 2]; acc += a4[3] * t[j4 + 3]; }
            t[ii] -= acc; }
        LAS float* td = b ? TD1 : TD0; const int tds = b ? 36 : 48;
#pragma unroll
        for (int ii = 0; ii < 32; ++ii) { td[ii * tds + cidx] = t[ii]; TT[(32 * b + ii) * TLD + 32 * b + cidx] = (bf16_t)(pk2(t[ii], 0.f) & 0xffffu); }
    }
#pragma unroll
    for (int h2 = 0; h2 < 2; ++h2) { const int i = ia + 32 * h2; const float be = BV[i], eg = __expf(h2 ? gc1 : gc0);
#pragma unroll
        for (int j = 0; j < 8; ++j) { const int d = 8 * p + j, o_ = d * TLD + (i ^ tsw(d)); P0[o_] = (bf16_t)(pk2(k[h2][j] * be * eg, 0.f) & 0xffffu); P1[o_] = (bf16_t)(pk2(v[h2][j] * be, 0.f) & 0xffffu); } }
    { unsigned zz; asm volatile("v_mov_b32 %0, 0" : "=v"(zz)); u32x2 z; z.x = zz; z.y = zz; *(LAS u32x2*)(TT + (tg >> 3) * TLD + 32 + 4 * (tg & 7)) = z; }
    __syncthreads();
    { const int qi = wg >> 1, qj = wg & 1, r16 = lane & 15, g4 = lane >> 4; f32x4 pc = {0.f, 0.f, 0.f, 0.f};
#pragma unroll
        for (int kk = 0; kk < 8; ++kk) pc = __builtin_amdgcn_mfma_f32_16x16x4f32(AM[(32 + 16 * qi + r16) * 68 + 4 * kk + g4], TD0[(4 * kk + g4) * 48 + 16 * qj + r16], pc, 0, 0, 0);
#pragma unroll
        for (int r = 0; r < 4; ++r) PM[(16 * qi + 4 * g4 + r) * 48 + 16 * qj + r16] = pc[r]; }
    __syncthreads();
    { const int qi = wg >> 1, qj = wg & 1, r16 = lane & 15, g4 = lane >> 4; f32x4 pc = {0.f, 0.f, 0.f, 0.f};
#pragma unroll
        for (int kk = 0; kk < 8; ++kk) pc = __builtin_amdgcn_mfma_f32_16x16x4f32(TD1[(16 * qi + r16) * 36 + 4 * kk + g4], PM[(4 * kk + g4) * 48 + 16 * qj + r16], pc, 0, 0, 0);
#pragma unroll
        for (int r = 0; r < 4; ++r) TT[(32 + 16 * qi + 4 * g4 + r) * TLD + 16 * qj + r16] = (bf16_t)(pk2(-pc[r], 0.f) & 0xffffu); }
    __syncthreads();
    { const int which = wg >> 1, mt = wg & 1, hh = lane >> 5;
#pragma unroll
        for (int nt = 0; nt < 2; ++nt) { const int dc = 32 * nt + (lane & 31);
            const f32x16 a = mm_tile<false, true>(TT, which ? P1 : P0, 32 * mt, 32 * nt, lane);
            LAS bf16_t* dst = (which ? UT : WT) + dc * TLD; const int sw = tsw(dc);
#pragma unroll
            for (int g = 0; g < 4; ++g) { u32x2 w; w.x = pk2(a[4 * g], a[4 * g + 1]); w.y = pk2(a[4 * g + 2], a[4 * g + 3]); *(LAS u32x2*)(dst + ((32 * mt + 8 * g + 4 * hh) ^ sw)) = w; } } }
    __syncthreads();
#pragma unroll
    for (int h2 = 0; h2 < 2; ++h2) { const int i = ia + 32 * h2; const float gci = h2 ? gc1 : gc0, eg = __expf(gci), ekd = __expf(gcl - gci); u32x4 wqd;
#pragma unroll
        for (int j = 0; j < 4; ++j) wqd[j] = pk2(q[h2][2 * j] * eg, q[h2][2 * j + 1] * eg);
        *(LAS u32x4*)(P1 + i * TLD + 8 * p) = wqd;
#pragma unroll
        for (int j = 0; j < 8; ++j) { const int d = 8 * p + j; P0[d * TLD + (i ^ tsw(d))] = (bf16_t)(pk2(k[h2][j] * ekd, 0.f) & 0xffffu); } }
    __syncthreads();
    { const int hh = lane >> 5, rr = lane & 31;
        if (wg == 0) {
#pragma unroll
            for (int t4 = 0; t4 < 4; ++t4) { const int mtb = t4 >> 1, nta = t4 & 1; const f32x16 a = mm_tile<true, true>(WT, P0, 32 * mtb, 32 * nta, lane);
                f32x16 na; for (int r = 0; r < 16; ++r) na[r] = -a[r];
                *(bf16x8*)(G + (size_t)((nta * 4 + 2 * mtb) * 64 + lane) * 16) = pack8<0>(na); *(bf16x8*)(G + (size_t)((nta * 4 + 2 * mtb + 1) * 64 + lane) * 16) = pack8<1>(na); }
        } else if (wg == 1) {
#pragma unroll
            for (int t4 = 0; t4 < 4; ++t4) { const int mta = t4 >> 1, nte = t4 & 1; const f32x16 a = mm_tile<true, true>(P0, UT, 32 * mta, 32 * nte, lane);
                bf16x8* dp = (bf16x8*)(G + 8192 + (size_t)((nte * 2 + mta) * 64 + lane) * 32); dp[0] = pack8<0>(a); dp[1] = pack8<1>(a); }
        } else if (wg == 2) {
#pragma unroll
            for (int t4 = 0; t4 < 4; ++t4) { const int mtb = t4 >> 1, nti = t4 & 1; const f32x16 a = mm_tile<true, false>(WT, INTRA, 32 * mtb, 32 * nti, lane);
                f32x16 qe; const LAS bf16_t* qd = P1 + (32 * nti + rr) * TLD + 32 * mtb + 4 * hh;
#pragma unroll
                for (int g = 0; g < 4; ++g) { const u32x2 w = *(const LAS u32x2*)(qd + 8 * g); qe[4 * g] = bflo(w.x) - a[4 * g]; qe[4 * g + 1] = bfhi(w.x) - a[4 * g + 1]; qe[4 * g + 2] = bflo(w.y) - a[4 * g + 2]; qe[4 * g + 3] = bfhi(w.y) - a[4 * g + 3]; }
                *(bf16x8*)(G + 16384 + (size_t)((nti * 4 + 2 * mtb) * 64 + lane) * 16) = pack8<0>(qe); *(bf16x8*)(G + 16384 + (size_t)((nti * 4 + 2 * mtb + 1) * 64 + lane) * 16) = pack8<1>(qe); }
        } else {
#pragma unroll
            for (int t4 = 0; t4 < 4; ++t4) { const int mti = t4 >> 1, nte = t4 & 1; const f32x16 a = mm_tile<false, true>(INTRA, UT, 32 * mti, 32 * nte, lane);
                bf16_t* dst = (bf16_t*)(G + 24576) + (size_t)(32 * nte + rr) * 64 + 32 * mti + 4 * hh;
#pragma unroll
                for (int g = 0; g < 4; ++g) { u32x2 w; w.x = pk2(a[4 * g], a[4 * g + 1]); w.y = pk2(a[4 * g + 2], a[4 * g + 3]); *(u32x2*)(dst + 8 * g) = w; } }
            if (lane == 0) *(float*)(G + 40960) = __expf(gcl);
        } }
    __syncthreads();
}

DI void pv_accum(const f32x16 (&acc)[2][2], f32x16 (&o)[2][2], const LAS bf16_t* Vt, int lane) {
    const int r = lane & 31, hh = lane >> 5;
#pragma unroll
    for (int mt = 0; mt < 2; ++mt) {
        {   const bf16x8 p0 = pack8<0>(acc[mt][0]), p1 = pack8<0>(acc[mt][1]);
#pragma unroll
            for (int mo = 0; mo < 2; ++mo) { const LAS bf16_t* s = Vt + (32 * mo + r) * TLD; const int c0 = (32 * mt + 4 * hh) ^ tsw(32 * mo + r);
                const u32x2 lo = *(const LAS u32x2*)(s + c0), hi = *(const LAS u32x2*)(s + (c0 ^ 8)); u32x4 w; w.x = lo.x; w.y = lo.y; w.z = hi.x; w.w = hi.y; const bf16x8 vf = __builtin_bit_cast(bf16x8, w);
                o[mo][0] = MFMA32(vf, p0, o[mo][0]); o[mo][1] = MFMA32(vf, p1, o[mo][1]); } }
        {   const bf16x8 p0 = pack8<1>(acc[mt][0]), p1 = pack8<1>(acc[mt][1]);
#pragma unroll
            for (int mo = 0; mo < 2; ++mo) { const LAS bf16_t* s = Vt + (32 * mo + r) * TLD; const int c0 = (32 * mt + 16 + 4 * hh) ^ tsw(32 * mo + r);
                const u32x2 lo = *(const LAS u32x2*)(s + c0), hi = *(const LAS u32x2*)(s + (c0 ^ 8)); u32x4 w; w.x = lo.x; w.y = lo.y; w.z = hi.x; w.w = hi.y; const bf16x8 vf = __builtin_bit_cast(bf16x8, w);
                o[mo][0] = MFMA32(vf, p0, o[mo][0]); o[mo][1] = MFMA32(vf, p1, o[mo][1]); } }
    }
}
template <class F> DI void stage_vt(LAS bf16_t* Vt, int lane, F vrow) {
#pragma unroll
    for (int it = 0; it < 8; ++it) { const int id = it * 64 + lane, key = id >> 3, part = id & 7;
        const u32x4 w = *(const u32x4*)(vrow(key) + 8 * part);
#pragma unroll
        for (int j = 0; j < 4; ++j) { const int d0 = 8 * part + 2 * j, ks_ = key ^ tsw(d0); Vt[d0 * TLD + ks_] = (bf16_t)(w[j] & 0xffffu); Vt[(d0 + 1) * TLD + ks_] = (bf16_t)(w[j] >> 16); } }
}
DI void write_o_slot(LAS float* SL, const f32x16 (&o)[2][2], int lane) {
    const int r = lane & 31, hh = lane >> 5;
#pragma unroll
    for (int mo = 0; mo < 2; ++mo)
#pragma unroll
        for (int nt = 0; nt < 2; ++nt)
#pragma unroll
            for (int g = 0; g < 4; ++g) { f32x4 v; v[0] = o[mo][nt][4 * g]; v[1] = o[mo][nt][4 * g + 1]; v[2] = o[mo][nt][4 * g + 2]; v[3] = o[mo][nt][4 * g + 3];
                *(LAS f32x4*)(SL + (32 * nt + r) * 68 + 32 * mo + 8 * g + 4 * hh) = v; }
}
DI void add_o_slot(const LAS float* SL, f32x16 (&o)[2][2], int lane) {
    const int r = lane & 31, hh = lane >> 5;
#pragma unroll
    for (int mo = 0; mo < 2; ++mo)
#pragma unroll
        for (int nt = 0; nt < 2; ++nt)
#pragma unroll
            for (int g = 0; g < 4; ++g) { const f32x4 v = *(const LAS f32x4*)(SL + (32 * nt + r) * 68 + 32 * mo + 8 * g + 4 * hh);
                o[mo][nt][4 * g] += v[0]; o[mo][nt][4 * g + 1] += v[1]; o[mo][nt][4 * g + 2] += v[2]; o[mo][nt][4 * g + 3] += v[3]; }
}

constexpr int WAREA = 10240;
DI void osm_update(f32x16 (&acc)[2][2], f32x16 (&o)[2][2], float (&m)[2], float (&l)[2]) {
#pragma unroll
    for (int nt = 0; nt < 2; ++nt) { float mx = -1e30f;
#pragma unroll
        for (int mt = 0; mt < 2; ++mt)
#pragma unroll
            for (int g = 0; g < 16; ++g) mx = fmaxf(mx, acc[mt][nt][g]);
        mx = fmaxf(mx, __shfl_xor(mx, 32));
        const float mn = fmaxf(m[nt], mx), sc = __expf(m[nt] - mn); float sm = 0.f;
#pragma unroll
        for (int mt = 0; mt < 2; ++mt)
#pragma unroll
            for (int g = 0; g < 16; ++g) { const float pz = __expf(acc[mt][nt][g] - mn); acc[mt][nt][g] = pz; sm += pz; }
        sm += __shfl_xor(sm, 32);
        l[nt] = l[nt] * sc + sm; m[nt] = mn;
#pragma unroll
        for (int g = 0; g < 16; ++g) { o[0][nt][g] *= sc; o[1][nt][g] *= sc; } }
}
template <class F> DI void store_o_rows(LAS bf16_t* T, const f32x16 (&o)[2][2], const float (&scale)[2], int lane, F rowp) {
    const int r = lane & 31, hh = lane >> 5;
#pragma unroll
    for (int mo = 0; mo < 2; ++mo)
#pragma unroll
        for (int nt = 0; nt < 2; ++nt)
#pragma unroll
            for (int g = 0; g < 4; ++g) { u32x2 w; w.x = pk2(o[mo][nt][4 * g] * scale[nt], o[mo][nt][4 * g + 1] * scale[nt]); w.y = pk2(o[mo][nt][4 * g + 2] * scale[nt], o[mo][nt][4 * g + 3] * scale[nt]);
                *(LAS u32x2*)(T + (32 * nt + r) * TLD + 32 * mo + 8 * g + 4 * hh) = w; }
    asm volatile("s_waitcnt lgkmcnt(0)" ::: "memory");
#pragma unroll
    for (int it = 0; it < 8; ++it) { const int id = it * 64 + lane, q = id >> 3, part = id & 7; *(u32x4*)(rowp(q) + 8 * part) = *(const LAS u32x4*)(T + q * TLD + 8 * part); }
    asm volatile("s_waitcnt lgkmcnt(0)" ::: "memory");
}
DI void na_wave_unit(KArgs args, LAS unsigned char* L, const Ctx& c, int u, int lane, int wave) {
    const int l = c.layer, head = u & 3, gr = u >> 2, rows = c.seqlen >> 6, seq = gr / rows, r = gr % rows;
    int rs = r - 4; rs = rs < 0 ? 0 : (rs > rows - 8 ? rows - 8 : rs);
    const bf16_t* PROJ = BIGP(bf16_t, B_PROJ);
    const size_t tq0 = (size_t)seq * c.seqlen + (size_t)r * 64;
    LAS bf16_t* Vt = (LAS bf16_t*)(L + wave * WAREA);
    LAS float* BIAS = (LAS float*)(L + wave * WAREA + 9216);
    const int rr = lane & 31, hh = lane >> 5;
#pragma unroll
    for (int w = 0; w < 4; ++w) { const int idx = w * 64 + lane, kw = idx >> 5, dc = idx & 31;
        if (dc < 31) BIAS[idx] = args->in[3][(((size_t)l * 4 + head) * 15 + (rs + kw - r + 7)) * 31 + dc]; }
    bf16x8 qf[2][4];
#pragma unroll
    for (int nt = 0; nt < 2; ++nt)
#pragma unroll
        for (int ks = 0; ks < 4; ++ks) qf[nt][ks] = *(const bf16x8*)(PROJ + (tq0 + 32 * nt + rr) * NPROJ + C_QA + 64 * head + 16 * ks + 8 * hh);
    f32x16 o[2][2]; o[0][0] = zero16(); o[0][1] = zero16(); o[1][0] = zero16(); o[1][1] = zero16();
    float m[2] = {-1e30f, -1e30f}, ls[2] = {0.f, 0.f};
    for (int w = 0; w < 8; ++w) {
        const size_t tk0 = (size_t)seq * c.seqlen + (size_t)(rs + w) * 64;
        asm volatile("s_waitcnt lgkmcnt(0)" ::: "memory");
        stage_vt(Vt, lane, [&](int key) { return PROJ + (tk0 + key) * NPROJ + C_VA + 64 * head; });
        f32x16 acc[2][2]; acc[0][0] = zero16(); acc[0][1] = zero16(); acc[1][0] = zero16(); acc[1][1] = zero16();
#pragma unroll
        for (int mt = 0; mt < 2; ++mt)
#pragma unroll
            for (int ks = 0; ks < 4; ++ks) { const bf16x8 kf = *(const bf16x8*)(PROJ + (tk0 + 32 * mt + rr) * NPROJ + C_KA + 64 * head + 16 * ks + 8 * hh);
                acc[mt][0] = MFMA32(kf, qf[0][ks], acc[mt][0]); acc[mt][1] = MFMA32(kf, qf[1][ks], acc[mt][1]); }
        asm volatile("s_waitcnt lgkmcnt(0)" ::: "memory");
        const LAS float* brow = BIAS + w * 32;
#pragma unroll
        for (int nt = 0; nt < 2; ++nt) { const int qc = 32 * nt + rr; int ws = qc - 8; ws = ws < 0 ? 0 : (ws > 48 ? 48 : ws);
#pragma unroll
            for (int mt = 0; mt < 2; ++mt)
#pragma unroll
                for (int g = 0; g < 16; ++g) { const int kc = 32 * mt + crow(g, hh); const bool ok = (kc >= ws) && (kc < ws + 16);
                    acc[mt][nt][g] = ok ? acc[mt][nt][g] * 0.125f + brow[ok ? (kc - qc + 15) : 0] : -1e30f; } }
        osm_update(acc, o, m, ls);
        pv_accum(acc, o, Vt, lane);
    }
    asm volatile("s_waitcnt lgkmcnt(0)" ::: "memory");
    const float sc[2] = {frcp(ls[0]), frcp(ls[1])};
    store_o_rows(Vt, o, sc, lane, [&](int q) { return BIGP(bf16_t, B_ONA) + (tq0 + q) * 768 + 64 * head; });
}
DI void rope_frag4(bf16x8 (&f)[4], const float* cs, int hh) {
#pragma unroll
    for (int ks = 0; ks < 2; ++ks) { const float* cp = cs + 16 * ks + 8 * hh;
        const f32x4 c0 = *(const f32x4*)cp, c1 = *(const f32x4*)(cp + 4), s0 = *(const f32x4*)(cp + 32), s1 = *(const f32x4*)(cp + 36);
        const u32x4 a = __builtin_bit_cast(u32x4, f[ks]), b = __builtin_bit_cast(u32x4, f[ks + 2]); u32x4 ra, rb;
#pragma unroll
        for (int j = 0; j < 4; ++j) { const float cl = (j < 2) ? c0[2 * j] : c1[2 * j - 4], ch = (j < 2) ? c0[2 * j + 1] : c1[2 * j - 3];
            const float sl = (j < 2) ? s0[2 * j] : s1[2 * j - 4], sh = (j < 2) ? s0[2 * j + 1] : s1[2 * j - 3];
            const float x1l = bflo(a[j]), x1h = bfhi(a[j]), x2l = bflo(b[j]), x2h = bfhi(b[j]);
            ra[j] = pk2(x1l * cl - x2l * sl, x1h * ch - x2h * sh); rb[j] = pk2(x1l * sl + x2l * cl, x1h * sh + x2h * ch); }
        f[ks] = __builtin_bit_cast(bf16x8, ra); f[ks + 2] = __builtin_bit_cast(bf16x8, rb); }
}
DI void dil_wave_unit(KArgs args, LAS unsigned char* L, const Ctx& c, int u, int lane, int wave) {
    const int hd = u & 1, uu = u >> 1, upg = c.stok >> 6, g = uu / upg, v = uu % upg, ups = c.seqlen >> 6, seq = v / ups, wq = v % ups;
    const int dsh = 2 * g, dd = 1 << dsh, nb = ups >> dsh, cls = wq / nb, jb = wq % nb, head = 2 * g + hd;
    const bf16_t* PROJ = BIGP(bf16_t, B_PROJ); const float* CS = WSP(float, WS_CS);
    const size_t sb = (size_t)seq * c.seqlen;
    const int rr = lane & 31, hh = lane >> 5;
    LAS bf16_t* Vt = (LAS bf16_t*)(L + wave * WAREA);
    bf16x8 qf[2][4];
#pragma unroll
    for (int nt = 0; nt < 2; ++nt) { const int pos = cls + dd * (64 * jb + 32 * nt + rr);
#pragma unroll
        for (int ks = 0; ks < 4; ++ks) qf[nt][ks] = *(const bf16x8*)(PROJ + (sb + pos) * NPROJ + C_QD + 64 * head + 16 * ks + 8 * hh);
        rope_frag4(qf[nt], CS + (size_t)pos * 64, hh); }
    f32x16 o[2][2]; o[0][0] = zero16(); o[0][1] = zero16(); o[1][0] = zero16(); o[1][1] = zero16();
    float m[2] = {-1e30f, -1e30f}, ls[2] = {0.f, 0.f};
    for (int kt = 0; kt < 3; ++kt) { const int kj = jb - 1 + kt;
        if (kj < 0 || kj >= nb) continue;
        asm volatile("s_waitcnt lgkmcnt(0)" ::: "memory");
        stage_vt(Vt, lane, [&](int key) { return PROJ + (sb + cls + (size_t)dd * (64 * kj + key)) * NPROJ + C_VD + 64 * head; });
        f32x16 acc[2][2]; acc[0][0] = zero16(); acc[0][1] = zero16(); acc[1][0] = zero16(); acc[1][1] = zero16();
#pragma unroll
        for (int mt = 0; mt < 2; ++mt) { const int pos = cls + dd * (64 * kj + 32 * mt + rr); bf16x8 kf[4];
#pragma unroll
            for (int ks = 0; ks < 4; ++ks) kf[ks] = *(const bf16x8*)(PROJ + (sb + pos) * NPROJ + C_KD + 64 * head + 16 * ks + 8 * hh);
            rope_frag4(kf, CS + (size_t)pos * 64, hh);
#pragma unroll
            for (int ks = 0; ks < 4; ++ks) { acc[mt][0] = MFMA32(kf[ks], qf[0][ks], acc[mt][0]); acc[mt][1] = MFMA32(kf[ks], qf[1][ks], acc[mt][1]); } }
#pragma unroll
        for (int nt = 0; nt < 2; ++nt) { const int qc = 32 * nt + rr;
#pragma unroll
            for (int mt = 0; mt < 2; ++mt)
#pragma unroll
                for (int gg = 0; gg < 16; ++gg) { const int kc = 32 * mt + crow(gg, hh); const bool ok = (kt == 1) || (kt == 0 ? (kc >= qc) : (kc <= qc));
                    acc[mt][nt][gg] = ok ? acc[mt][nt][gg] * 0.125f : -1e30f; } }
        osm_update(acc, o, m, ls);
        pv_accum(acc, o, Vt, lane);
    }
    asm volatile("s_waitcnt lgkmcnt(0)" ::: "memory");
    bf16_t* DP = BIGP(bf16_t, B_DILP); float* DM = BIGP(float, B_DILM);
    const float one[2] = {1.f, 1.f};
    store_o_rows(Vt, o, one, lane, [&](int q) { return DP + ((((size_t)g * SLABMAX + sb + cls + (size_t)dd * (64 * jb + q)) * 2 + hd)) * 64; });
    if (hh == 0) {
#pragma unroll
        for (int nt = 0; nt < 2; ++nt) { const size_t base = (((size_t)g * SLABMAX + sb + cls + (size_t)dd * (64 * jb + 32 * nt + rr)) * 2 + hd); DM[base * 2] = m[nt]; DM[base * 2 + 1] = ls[nt]; } }
}

DI void phase_mix_a(KArgs args, LAS unsigned char* L, const Ctx& c) {
    const int N_PREP = (c.stok >> 6) * 6;
    for (int u = c.bid; u < N_PREP; u += c.G) gdn_prep_pair(args, L, c, u);
}
DI void attn_wave_units(KArgs args, LAS unsigned char* L, const Ctx& c) {
    int tid = c.tid; asm volatile("" : "+v"(tid)); const int lane = tid & 63, wave = __builtin_amdgcn_readfirstlane(tid >> 6);
    const int nch_ = c.stok >> 6, N_NA = nch_ * 4, N_DIL = nch_ * 6;
    unsigned* q = (unsigned*)(c.ws + WS_CTL) + 32768 + 128 * (c.layer * 4 + c.slab);
    for (;;) { unsigned u = 0; if (lane == 0) u = __hip_atomic_fetch_add(q, 1u, __ATOMIC_RELAXED, __HIP_MEMORY_SCOPE_AGENT);
        u = (unsigned)__builtin_amdgcn_readfirstlane((int)u); if (u >= (unsigned)N_NA) break; na_wave_unit(args, L, c, (int)u, lane, wave); }
    int tid2 = c.tid; asm volatile("" : "+v"(tid2)); const int lane2 = tid2 & 63, wave2 = __builtin_amdgcn_readfirstlane(tid2 >> 6);
    for (;;) { unsigned u = 0; if (lane2 == 0) u = __hip_atomic_fetch_add(q + 64, 1u, __ATOMIC_RELAXED, __HIP_MEMORY_SCOPE_AGENT);
        u = (unsigned)__builtin_amdgcn_readfirstlane((int)u); if (u >= (unsigned)N_DIL) break; dil_wave_unit(args, L, c, (int)u, lane2, wave2); }
}

DI void phase_scan(KArgs args, LAS unsigned char* L, const Ctx& c) {
    const int nwu = c.nseq * 24, wu = c.bid;
    if (wu < nwu && c.wave == 0) {
        const int lane = c.lane, rr = lane & 31, hh = lane >> 5;
        const int chain = wu >> 1, nt = wu & 1, seq = chain / 12, rem = chain % 12, head = rem >> 1, dir = rem & 1;
        const int nch = c.seqlen >> 6, gch0 = seq * nch;
        unsigned char* GS = BIGP(unsigned char, B_GSCR);
        f32x16 S[2]; S[0] = zero16(); S[1] = zero16();
        bf16x8 A[2][2][4]; u32x4 cm[2][2][2]; float gl[2];
        const long gstep = (long)(dir ? -1 : 1) * 12 * GSTRIDE;
        const unsigned char* Gp = GS + (size_t)(((gch0 + (dir ? nch - 1 : 0)) * 6 + head) * 2 + dir) * GSTRIDE;
        unsigned char* Gs = (unsigned char*)Gp;
#define SCAN_LOAD(B) do { _Pragma("unroll") for (int mt = 0; mt < 2; ++mt) { _Pragma("unroll") for (int ks = 0; ks < 4; ++ks) A[B][mt][ks] = *(const bf16x8*)(Gp + (size_t)((mt * 4 + ks) * 64 + lane) * 16); \
            const u32x4* cp = (const u32x4*)(Gp + 8192 + (size_t)((nt * 2 + mt) * 64 + lane) * 32); cm[B][mt][0] = cp[0]; cm[B][mt][1] = cp[1]; } gl[B] = *(const float*)(Gp + 40960); } while (0)
#define SCAN_STEP(B) do { { bf16_t* St = (bf16_t*)(Gs + 32768) + (size_t)(32 * nt + rr) * 64 + 4 * hh; \
            _Pragma("unroll") for (int mt = 0; mt < 2; ++mt) _Pragma("unroll") for (int g = 0; g < 4; ++g) { u32x2 w; w.x = pk2(S[mt][4 * g], S[mt][4 * g + 1]); w.y = pk2(S[mt][4 * g + 2], S[mt][4 * g + 3]); *(u32x2*)(St + 32 * mt + 8 * g) = w; } } \
            const bf16x8 b0 = pack8<0>(S[0]), b1 = pack8<1>(S[0]), b2 = pack8<0>(S[1]), b3 = pack8<1>(S[1]); f32x16 nw[2]; \
            _Pragma("unroll") for (int mt = 0; mt < 2; ++mt) { \
                _Pragma("unroll") for (int g = 0; g < 8; ++g) { const unsigned wv = (g < 4) ? cm[B][mt][0][g] : cm[B][mt][1][g - 4]; nw[mt][2 * g] = gl[B] * S[mt][2 * g] + bflo(wv); nw[mt][2 * g + 1] = gl[B] * S[mt][2 * g + 1] + bfhi(wv); } \
                nw[mt] = MFMA32(A[B][mt][0], b0, nw[mt]); nw[mt] = MFMA32(A[B][mt][1], b1, nw[mt]); nw[mt] = MFMA32(A[B][mt][2], b2, nw[mt]); nw[mt] = MFMA32(A[B][mt][3], b3, nw[mt]); } \
            S[0] = nw[0]; S[1] = nw[1]; Gs += gstep; } while (0)
        SCAN_LOAD(0); Gp += gstep; SCAN_LOAD(1); Gp += gstep;
        for (int step = 0; step < nch; step += 2) {
            const bool more = step + 2 < nch;
            if (!more) Gp -= 2 * gstep;
            SCAN_STEP(0); SCAN_LOAD(0); Gp += gstep;
            SCAN_STEP(1); SCAN_LOAD(1); Gp += gstep;
        }
#undef SCAN_LOAD
#undef SCAN_STEP
    }
    attn_wave_units(args, L, c);
}

DI void dil_merge(const Ctx& c) {
    { const bf16_t* DP = BIGP(bf16_t, B_DILP); const float* DM = BIGP(float, B_DILM); bf16_t* OD = BIGP(bf16_t, B_ONA) + 256;
        for (int it = c.bid * 512 + c.tid; it < c.stok * 32; it += c.G * 512) { const int tok = it >> 5, part = it & 31;
            u32x4 w = {0u, 0u, 0u, 0u};
            if (part < 16) { const int hd = part >> 3, p = part & 7; float m[3], dn[3];
#pragma unroll
                for (int g = 0; g < 3; ++g) { const size_t b = (((size_t)g * SLABMAX + tok) * 2 + hd); m[g] = DM[b * 2]; dn[g] = DM[b * 2 + 1]; }
                const float M = fmaxf(m[0], fmaxf(m[1], m[2])); float num[8], den = 0.f;
#pragma unroll
                for (int j = 0; j < 8; ++j) num[j] = 0.f;
#pragma unroll
                for (int g = 0; g < 3; ++g) { const float f = __expf(m[g] - M); den += f * dn[g]; const u32x4 a = *(const u32x4*)(DP + (((size_t)g * SLABMAX + tok) * 2 + hd) * 64 + 8 * p);
                    num[0] += f * bflo(a[0]); num[1] += f * bfhi(a[0]); num[2] += f * bflo(a[1]); num[3] += f * bfhi(a[1]); num[4] += f * bflo(a[2]); num[5] += f * bfhi(a[2]); num[6] += f * bflo(a[3]); num[7] += f * bfhi(a[3]); }
                const float inv = frcp(den);
                w.x = pk2(num[0] * inv, num[1] * inv); w.y = pk2(num[2] * inv, num[3] * inv); w.z = pk2(num[4] * inv, num[5] * inv); w.w = pk2(num[6] * inv, num[7] * inv); }
            if (part < 16) *(u32x4*)(OD + (size_t)tok * 768 + 8 * part) = w; } }
}

DI void phase_gdn_out(KArgs args, LAS unsigned char* L, const Ctx& c) {
    dil_merge(c);
    const int lane = c.lane, wave = c.wave, tid = c.tid, l = c.layer;
    const bf16_t* PROJ = BIGP(bf16_t, B_PROJ); unsigned char* GS = BIGP(unsigned char, B_GSCR); bf16_t* OG = BIGP(bf16_t, B_ONA) + 384;
    LAS float* OF = (LAS float*)L;
    for (int u = c.bid; u < (c.stok >> 6) * 6; u += c.G) { const int gch = u / 6, head = u % 6;
        { const int dir = wave >> 2, mt = (wave >> 1) & 1, nt = wave & 1, rr = lane & 31, hh = lane >> 5;
            const unsigned char* G = GS + (size_t)((gch * 6 + head) * 2 + dir) * GSTRIDE;
            const bf16_t* Qe = (const bf16_t*)(G + 16384); const bf16_t* Oct = (const bf16_t*)(G + 24576); const bf16_t* St = (const bf16_t*)(G + 32768);
            f32x16 acc = zero16();
#pragma unroll
            for (int ks = 0; ks < 4; ++ks) { const bf16x8 a = *(const bf16x8*)(Qe + (size_t)((mt * 4 + ks) * 64 + lane) * 8);
                const bf16_t* sp = St + (32 * nt + rr) * 64 + 32 * (ks >> 1) + 16 * (ks & 1) + 4 * hh; const u32x2 lo = *(const u32x2*)sp, hi = *(const u32x2*)(sp + 8);
                u32x4 bw; bw.x = lo.x; bw.y = lo.y; bw.z = hi.x; bw.w = hi.y; acc = MFMA32(a, __builtin_bit_cast(bf16x8, bw), acc); }
            const int e = 32 * nt + rr;
#pragma unroll
            for (int g = 0; g < 4; ++g) { const u32x2 w = *(const u32x2*)(Oct + e * 64 + 32 * mt + 8 * g + 4 * hh);
                const float v0 = acc[4 * g] + bflo(w.x), v1 = acc[4 * g + 1] + bfhi(w.x), v2 = acc[4 * g + 2] + bflo(w.y), v3 = acc[4 * g + 3] + bfhi(w.y);
                const int i0 = 32 * mt + 8 * g + 4 * hh;
#pragma unroll
                for (int j = 0; j < 4; ++j) { const int ii = i0 + j, tl = dir ? 63 - ii : ii; OF[(dir * 64 + tl) * 68 + e] = (j == 0) ? v0 : (j == 1) ? v1 : (j == 2) ? v2 : v3; } } }
        __syncthreads();
        { const int i = tid >> 3, p = tid & 7; const size_t tok = (size_t)gch * 64 + i;
            const LAS float* a = OF + i * 68 + 8 * p; const LAS float* b = OF + (64 + i) * 68 + 8 * p;
            float ov[8]; float ss = 0.f;
#pragma unroll
            for (int j = 0; j < 8; ++j) { ov[j] = a[j] + b[j]; ss += ov[j] * ov[j]; }
            ss += __shfl_xor(ss, 1); ss += __shfl_xor(ss, 2); ss += __shfl_xor(ss, 4);
            const float rs = frsq(ss * (1.0f / 64.0f) + NORM_EPS);
            const u32x4 zw = *(const u32x4*)(PROJ + tok * NPROJ + C_ZC + 64 * head + 8 * p);
            const float* nw = args->in[7] + l * 64 + 8 * p;
            float r[8];
#pragma unroll
            for (int j = 0; j < 4; ++j) { r[2 * j] = ov[2 * j] * rs * nw[2 * j] * siluf_(bflo(zw[j])); r[2 * j + 1] = ov[2 * j + 1] * rs * nw[2 * j + 1] * siluf_(bfhi(zw[j])); }
            u32x4 w; w.x = pk2(r[0], r[1]); w.y = pk2(r[2], r[3]); w.z = pk2(r[4], r[5]); w.w = pk2(r[6], r[7]);
            *(u32x4*)(OG + tok * 768 + 64 * head + 8 * p) = w; }
        __syncthreads();
    }
}

DI void phase_ln1(KArgs args, LAS unsigned char* L, const Ctx& c) {
    const int lane = c.lane, l = c.layer;
    LAS float* WR = (LAS float*)L;
    { const float* wr = args->in[14] + (size_t)l * D * 16;
        for (int i = c.tid; i < D * 16; i += 512) { const int col = i >> 4, e = i & 15, j = col >> 8, ln = (col >> 2) & 63, q = col & 3; WR[((j * 4 + q) * 64 + ln) * 20 + e] = wr[i]; } }
    __syncthreads();
    const float* g1 = args->in[12] + l * D; const float* b1 = args->in[13] + l * D;
    f32x4 gv[4], bv[4];
#pragma unroll
    for (int j = 0; j < 4; ++j) { gv[j] = *(const f32x4*)(g1 + 4 * lane + 256 * j); bv[j] = *(const f32x4*)(b1 + 4 * lane + 256 * j); }
    float* AFF = WSP(float, WS_AFF); int* SLOT = WSP(int, WS_SLOT); bf16_t* XB = WSP(bf16_t, WS_XB);
    f32x4 nv[4];
    { const int rl0 = c.bid * 8 + c.wave; if (rl0 < c.stok) { const float* hp = c.out + ((size_t)c.sbase + rl0) * D;
#pragma unroll
        for (int j = 0; j < 4; ++j) nv[j] = *(const f32x4*)(hp + 4 * lane + 256 * j); } }
    for (int rl = c.bid * 8 + c.wave; rl < c.stok; rl += c.G * 8) { const size_t tok = (size_t)c.sbase + rl;
        float* hr = c.out + tok * D; f32x4 v[4]; float s = 0.f;
#pragma unroll
        for (int j = 0; j < 4; ++j) { v[j] = nv[j]; s += (v[j][0] + v[j][1]) + (v[j][2] + v[j][3]); }
        if (rl + c.G * 8 < c.stok) { const float* hp = hr + (size_t)c.G * 8 * D;
#pragma unroll
            for (int j = 0; j < 4; ++j) nv[j] = *(const f32x4*)(hp + 4 * lane + 256 * j); }
        const float mean = wave_sum(s) * (1.0f / D); float s2 = 0.f;
#pragma unroll
        for (int j = 0; j < 4; ++j) { v[j] = v[j] - mean; s2 += (v[j][0] * v[j][0] + v[j][1] * v[j][1]) + (v[j][2] * v[j][2] + v[j][3] * v[j][3]); }
        const float rstd = frsq(wave_sum(s2) * (1.0f / D) + LN_EPS);
        float lg[16];
#pragma unroll
        for (int e = 0; e < 16; ++e) lg[e] = 0.f;
#pragma unroll
        for (int j = 0; j < 4; ++j) { v[j] = v[j] * rstd * gv[j] + bv[j];
            if (!c.dry) { *(f32x4*)(hr + 4 * lane + 256 * j) = v[j];
            u32x2 w; w.x = pk2(v[j][0], v[j][1]); w.y = pk2(v[j][2], v[j][3]); *(u32x2*)(XB + tok * D + 4 * lane + 256 * j) = w; }
#pragma unroll
            for (int q = 0; q < 4; ++q) { const LAS float* wp = WR + ((j * 4 + q) * 64 + lane) * 20; const float xv = v[j][q];
#pragma unroll
                for (int e4 = 0; e4 < 4; ++e4) { const f32x4 w4 = *(const LAS f32x4*)(wp + 4 * e4); lg[4 * e4] += xv * w4[0]; lg[4 * e4 + 1] += xv * w4[1]; lg[4 * e4 + 2] += xv * w4[2]; lg[4 * e4 + 3] += xv * w4[3]; } }
            asm volatile("" ::: "memory"); }
        float mx = -1e30f;
#pragma unroll
        for (int e = 0; e < 16; ++e) { lg[e] = wave_sum(lg[e]); mx = fmaxf(mx, lg[e]); }
        float den = 0.f;
#pragma unroll
        for (int e = 0; e < 16; ++e) { lg[e] = expf(lg[e] - mx); den += lg[e]; }
        float mine = 0.f;
#pragma unroll
        for (int e = 0; e < 16; ++e) mine = (lane == e) ? lg[e] : mine;
        if (lane < 16 && !c.dry) { AFF[(size_t)lane * T_ALL + tok] = mine / den; SLOT[tok * 16 + lane] = -1; }
    }
}
DI void phase_ln2(KArgs args, LAS unsigned char* L, const Ctx& c) {
    const int lane = c.lane, l = c.layer;
    const float* g2 = args->in[18] + l * D; const float* b2 = args->in[19] + l * D;
    f32x4 gv[4], bv[4];
#pragma unroll
    for (int j = 0; j < 4; ++j) { gv[j] = *(const f32x4*)(g2 + 4 * lane + 256 * j); bv[j] = *(const f32x4*)(b2 + 4 * lane + 256 * j); }
    const int* SLOT = WSP(int, WS_SLOT); bf16_t* XB = WSP(bf16_t, WS_XB);
    f32x4 nv[4]; int nsv = -1;
    { const int t0 = c.bid * 8 + c.wave; if (t0 < T_ALL) { const float* xp = c.out + (size_t)t0 * D; nsv = SLOT[(size_t)t0 * 16 + (lane & 15)];
#pragma unroll
        for (int j = 0; j < 4; ++j) nv[j] = *(const f32x4*)(xp + 4 * lane + 256 * j); } }
    for (int t = c.bid * 8 + c.wave; t < T_ALL; t += c.G * 8) { const size_t tok = (size_t)t;
        float* xr = c.out + tok * D; f32x4 v[4];
#pragma unroll
        for (int j = 0; j < 4; ++j) v[j] = nv[j] * ALPHA;
        const int sv = nsv;
        if (t + c.G * 8 < T_ALL) { const float* xp = xr + (size_t)c.G * 8 * D; nsv = SLOT[(tok + c.G * 8) * 16 + (lane & 15)];
#pragma unroll
            for (int j = 0; j < 4; ++j) nv[j] = *(const f32x4*)(xp + 4 * lane + 256 * j); }
#pragma unroll
        for (int e = 0; e < 16; ++e) { const int s = __builtin_amdgcn_readlane(sv, e);
            if (s >= 0) { const bf16_t* yr = BIGP(bf16_t, (e < 8 ? B_XY0 : B_XY1)) + ((size_t)(e & 7) * CAP + s) * D;
#pragma unroll
                for (int j = 0; j < 4; ++j) { const u32x2 w = *(const u32x2*)(yr + 4 * lane + 256 * j); v[j][0] += bflo(w.x); v[j][1] += bfhi(w.x); v[j][2] += bflo(w.y); v[j][3] += bfhi(w.y); } } }
        float s = 0.f;
#pragma unroll
        for (int j = 0; j < 4; ++j) s += (v[j][0] + v[j][1]) + (v[j][2] + v[j][3]);
        const float mean = wave_sum(s) * (1.0f / D); float s2 = 0.f;
#pragma unroll
        for (int j = 0; j < 4; ++j) { v[j] = v[j] - mean; s2 += (v[j][0] * v[j][0] + v[j][1] * v[j][1]) + (v[j][2] * v[j][2] + v[j][3] * v[j][3]); }
        const float rstd = frsq(wave_sum(s2) * (1.0f / D) + LN_EPS);
#pragma unroll
        for (int j = 0; j < 4; ++j) { v[j] = v[j] * rstd * gv[j] + bv[j];
            if (!c.dry) { *(f32x4*)(xr + 4 * lane + 256 * j) = v[j];
            u32x2 w; w.x = pk2(v[j][0], v[j][1]); w.y = pk2(v[j][2], v[j][3]); *(u32x2*)(XB + tok * D + 4 * lane + 256 * j) = w;
            *(unsigned*)(WSP(unsigned char, WS_XB8) + tok * D + 4 * lane + 256 * j) = pk4_fp8(v[j][0], v[j][1], v[j][2], v[j][3]); } }
    }
}

DI int block_excl_scan(int v, LAS int* tmp, int tid, int& total) {
    const int lane = tid & 63, wave = tid >> 6; int x = v;
#pragma unroll
    for (int o = 1; o < 64; o <<= 1) { const int y = __shfl_up(x, o); if (lane >= o) x += y; }
    __syncthreads();
    if (lane == 63) tmp[wave] = x;
    __syncthreads();
    int base = 0, tot = 0;
#pragma unroll
    for (int w = 0; w < 8; ++w) { const int tw = tmp[w]; if (w < wave) base += tw; tot += tw; }
    total = tot;
    return base + x - v;
}
DI void phase_select(KArgs args, LAS unsigned char* L, const Ctx& c) {
    if (c.bid >= 32) return;
    const int tid = c.tid, grp = c.bid >> 4, e = c.bid & 15;
    const int n = grp ? T_S : T_P, t0 = grp ? T_P : 0, C = n >> 3, slot0 = grp ? CAP_P : 0;
    const unsigned* v = (const unsigned*)(WSP(float, WS_AFF) + (size_t)e * T_ALL + t0);
    LAS unsigned* hist = (LAS unsigned*)L; LAS int* sh = (LAS int*)(L + 1024); LAS int* tmp = (LAS int*)(L + 1024 + 64);
    unsigned prefix = 0u; int kk = C;
    for (int pass = 0; pass < 4; ++pass) { const int shift = 24 - 8 * pass; const unsigned mhi = pass == 0 ? 0u : (0xFFFFFFFFu << (shift + 8));
        if (tid < 256) hist[tid] = 0u;
        __syncthreads();
        for (int i = tid * 4; i < n; i += 512 * 16) {
            u32x4 x4[4];
#pragma unroll
            for (int k = 0; k < 4; ++k) x4[k] = *(const u32x4*)(v + i + k * 2048);
#pragma unroll
            for (int k = 0; k < 4; ++k)
#pragma unroll
                for (int j = 0; j < 4; ++j) { const unsigned x = x4[k][j]; if ((x & mhi) == prefix) __hip_atomic_fetch_add(&hist[(x >> shift) & 255u], 1u, __ATOMIC_RELAXED, __HIP_MEMORY_SCOPE_WORKGROUP); } }
        __syncthreads();
        if (tid == 0) { int cum = 0, sel = 0; for (int b = 255; b >= 0; --b) { const int h = (int)hist[b]; if (cum + h >= kk) { sel = b; break; } cum += h; } sh[0] = sel; sh[1] = kk - cum; }
        __syncthreads();
        prefix |= ((unsigned)sh[0]) << shift; kk = sh[1];
        __syncthreads();
    }
    const unsigned thr = prefix;
    const int per = n >> 9, i0 = tid * per;
    int ngt = 0, ntie = 0;
    for (int i = 0; i < per; i += 4) { const u32x4 x = *(const u32x4*)(v + i0 + i);
#pragma unroll
        for (int j = 0; j < 4; ++j) { ngt += (x[j] > thr); ntie += (x[j] == thr); } }
    int tot;
    const int tie_base = block_excl_scan(ntie, tmp, tid, tot);
    int take = kk - tie_base; take = take < 0 ? 0 : (take > ntie ? ntie : take);
    int pos = block_excl_scan(ngt + take, tmp, tid, tot);
    int* IDX = WSP(int, WS_IDX) + e * CAP + slot0;
    int tr = 0;
    for (int i = 0; i < per; i += 4) { const u32x4 x = *(const u32x4*)(v + i0 + i);
#pragma unroll
        for (int j = 0; j < 4; ++j) { bool s = x[j] > thr; if (x[j] == thr) { s = tr < take; ++tr; } if (s) { IDX[pos] = t0 + i0 + i + j; ++pos; } } }
}
DI void phase_gather(KArgs args, LAS unsigned char* L, const Ctx& c) {
    const int lane = c.lane; const int* IDX = WSP(int, WS_IDX); const bf16_t* XB = WSP(bf16_t, WS_XB);
    float* GATEV = WSP(float, WS_GATEV); int* SLOT = WSP(int, WS_SLOT); const float* AFF = WSP(float, WS_AFF);
    for (int row0 = (c.bid * 8 + c.wave) * 4; row0 < NE * CAP; row0 += c.G * 8 * 4) {
        const int e = row0 / CAP, s0 = row0 % CAP; int t[4]; u32x4 a[4], b[4];
#pragma unroll
        for (int k = 0; k < 4; ++k) t[k] = IDX[row0 + k];
#pragma unroll
        for (int k = 0; k < 4; ++k) { const u32x4* src = (const u32x4*)(XB + (size_t)t[k] * D) + 2 * lane; a[k] = src[0]; b[k] = src[1]; }
        u32x4* dst = (u32x4*)(BIGP(unsigned char, (e < 8 ? B_XY0 : B_XY1)) + ((size_t)(e & 7) * CAP + s0) * D);
#pragma unroll
        for (int k = 0; k < 4; ++k) { u32x4 w;
            w.x = pk4_fp8(bflo(a[k].x), bfhi(a[k].x), bflo(a[k].y), bfhi(a[k].y)); w.y = pk4_fp8(bflo(a[k].z), bfhi(a[k].z), bflo(a[k].w), bfhi(a[k].w));
            w.z = pk4_fp8(bflo(b[k].x), bfhi(b[k].x), bflo(b[k].y), bfhi(b[k].y)); w.w = pk4_fp8(bflo(b[k].z), bfhi(b[k].z), bflo(b[k].w), bfhi(b[k].w));
            dst[k * 64 + lane] = w; }
        if (lane < 4) { const int tt = (lane == 0) ? t[0] : (lane == 1) ? t[1] : (lane == 2) ? t[2] : t[3]; SLOT[(size_t)tt * 16 + e] = s0 + lane; GATEV[row0 + lane] = AFF[(size_t)e * T_ALL + tt]; } }
}

__global__ void __launch_bounds__(512, 2) fwd_kernel(Args args) {
    extern __shared__ __attribute__((aligned(16))) unsigned char lds_raw[];
    LAS unsigned char* L = (LAS unsigned char*)lds_raw;
    Ctx c;
    c.out = args.out; c.ws = args.ws;
    c.tid = threadIdx.x; c.lane = c.tid & 63; c.wave = __builtin_amdgcn_readfirstlane(c.tid >> 6); c.G = gridDim.x; c.bid = blockIdx.x;
    c.layer = 0; c.slab = 0; c.nseq = 8; c.seqlen = 4096; c.stok = 32768; c.sbase = 0; c.dry = 0;
    const int lo = args.ph_lo, hi = args.ph_hi;
    volatile LAS unsigned* MISC = (volatile LAS unsigned*)(L + LDS_MISC);
    if (c.tid < 4) MISC[c.tid] = 0u;
    __syncthreads();
    XcdBarrier bar; bar.bar = (unsigned*)(c.ws + WS_CTL) + 1024; bar.x = 0; bar.st = MISC;
    if (hi - lo > 1) bar = xcd_barrier_post((unsigned*)(c.ws + WS_CTL) + 1024, MISC);
    int pc = 0;
#ifndef PHMASK
#define PHMASK 0xFFFF
#endif
#define PHON(k) (((PHMASK) >> (k)) & 1)
#ifndef REPMASK
#define REPMASK 0x0
#endif
#define PH_BEGIN(k) if (PHON(k) && pc >= lo && pc < hi) { { int tz = threadIdx.x; asm volatile("" : "+v"(tz)); c.tid = tz; c.lane = tz & 63; c.wave = __builtin_amdgcn_readfirstlane(tz >> 6); } KArgs ka = kargs(); c.ws = ka->ws; c.out = ka->out; { int b_ = blockIdx.x, g_ = gridDim.x; asm volatile("" : "+s"(b_), "+s"(g_)); c.bid = b_; c.G = g_; } for (int rep_ = 0; rep_ < (((REPMASK) >> (k)) & 1) + 1; ++rep_) { if (rep_) __syncthreads(); c.dry = (rep_ + 1 < (((REPMASK) >> (k)) & 1) + 1);
#ifndef BARREP
#define BARREP 0
#endif
#define PH_END   } if (pc + 1 < hi) { xcd_barrier(bar); if (BARREP) { xcd_barrier(bar); xcd_barrier(bar); } } else { asm volatile("s_waitcnt vmcnt(0)" ::: "memory"); __syncthreads(); } } ++pc;

    for (int layer = 0; layer < 2; ++layer) {
        c.layer = layer;
        PH_BEGIN(0) phase_weights(ka, L, c); PH_END
        for (int slab = 0; slab < NSLAB; ++slab) {
            c.slab = slab; c.nseq = slab < 2 ? 8 : 1; c.seqlen = slab < 2 ? 4096 : 16384; c.stok = slab < 2 ? 32768 : 16384; c.sbase = slab * 32768; const int stok = c.stok; const size_t sbase = (size_t)c.sbase;
            PH_BEGIN(1) {
                { pg8::Gemm g{WSP(bf16_t, WS_XB) + sbase * D, WSP(bf16_t, WS_WIN), stok, 3584, D}; pg8::StaticOrder S; S.init(stok, 3584, c.G, c.bid);
                  pg8::EpiInProj E{BIGP(bf16_t, B_PROJ), BIGP(float, B_BA)};
                  pg8::gemm_phase<pg8::EpiInProj, pg8::StaticOrder>(L, g, S, E); }
                { pg8::Gemm g{(const bf16_t*)(WSP(unsigned char, WS_XB8) + sbase * D), (const bf16_t*)WSP(unsigned char, WS_WG8), stok, 3072, D / 2}; pg8::StaticOrder S; S.init(stok, 3072, c.G, c.bid);
                  pg8::EpiGates E{BIGP(bf16_t, B_PROJ)};
                  pg8::gemm_phase<pg8::EpiGates, pg8::StaticOrder>(L, g, S, E); } } PH_END
            PH_BEGIN(2) phase_mix_a(ka, L, c); PH_END
            PH_BEGIN(3) phase_scan(ka, L, c); PH_END
            PH_BEGIN(4) phase_gdn_out(ka, L, c); PH_END
            PH_BEGIN(5) {
                pg8::StaticOrder S; S.init(stok, D, c.G, c.bid);
                pg8::Gemm g{BIGP(bf16_t, B_ONA), WSP(bf16_t, WS_WBR), stok, D, 768}; pg8::EpiGateCat E{BIGP(bf16_t, B_PROJ), BIGP(bf16_t, B_MERGED)};
                pg8::gemm_phase<pg8::EpiGateCat, pg8::StaticOrder>(L, g, S, E); } PH_END
            PH_BEGIN(6) {
                const float* xr = layer == 0 ? (slab < 2 ? ka->in[0] + sbase * D : ka->in[1]) : c.out + sbase * D;
                pg8::Gemm g{BIGP(bf16_t, B_MERGED), WSP(bf16_t, WS_WOUT), stok, D, D}; pg8::StaticOrder S; S.init(stok, D, c.G, c.bid);
                pg8::EpiRes E{xr, c.out + sbase * D};
                pg8::gemm_phase<pg8::EpiRes, pg8::StaticOrder>(L, g, S, E); } PH_END
#ifndef LN1PROBE
#define LN1PROBE 0
#endif
            PH_BEGIN(7) if (LN1PROBE) { c.dry = 1; phase_ln1(ka, L, c); __syncthreads(); c.dry = 0; } phase_ln1(ka, L, c); PH_END
        }
        PH_BEGIN(8) phase_select(ka, L, c); PH_END
        PH_BEGIN(9) phase_gather(ka, L, c); PH_END
        for (int half = 0; half < 2; ++half) {
            PH_BEGIN(10) {
                pg8::Gemm g{BIGP(bf16_t, half ? B_XY1 : B_XY0), (const bf16_t*)(WSP(unsigned char, WS_WGU) + (size_t)half * 8 * 4096 * D), 8 * CAP, 8 * 4096, D / 2}; pg8::MoeOrder S; S.init(8, CAP / 256, 16, c.G, c.bid);
                pg8::EpiSwiglu E{BIGP(unsigned char, B_HID)};
                pg8::gemm_phase<pg8::EpiSwiglu, pg8::MoeOrder>(L, g, S, E); } PH_END
            PH_BEGIN(11) {
                pg8::Gemm g{BIGP(bf16_t, B_HID), (const bf16_t*)(WSP(unsigned char, WS_WD) + (size_t)half * 8 * D * DE), 8 * CAP, 8 * D, DE / 2}; pg8::MoeOrder S; S.init(8, CAP / 256, 4, c.G, c.bid);
                pg8::EpiDown E{BIGP(bf16_t, half ? B_XY1 : B_XY0), WSP(float, WS_GATEV) + (size_t)half * 8 * CAP};
                pg8::gemm_phase<pg8::EpiDown, pg8::MoeOrder>(L, g, S, E); } PH_END
        }
        PH_BEGIN(12) phase_ln2(ka, L, c); PH_END
    }
#undef PH_BEGIN
#undef PH_END
}

constexpr int N_PHASES = 2 * (1 + NSLAB * 7 + 2 + 4 + 1);

extern "C" void kernel_launch(void* const* d_in, const int* in_sizes, int n_in, void* d_out, int out_size, void* d_ws, size_t ws_size, hipStream_t stream) {
    static int grid = 0;
    if (grid == 0) {
        if (n_in != 20 || ws_size < WS_END) { fprintf(stderr, "kernel_launch: unexpected n_in %d or ws_size %zu (< %zu)\n", n_in, ws_size, (size_t)WS_END); grid = -1; return; }
        int dev = 0, cus = 0, per_cu = 0;
        if (hipGetDevice(&dev) != hipSuccess || hipDeviceGetAttribute(&cus, hipDeviceAttributeMultiprocessorCount, dev) != hipSuccess) { grid = -1; return; }
        if (hipFuncSetAttribute((const void*)fwd_kernel, hipFuncAttributeMaxDynamicSharedMemorySize, LDS_BYTES) != hipSuccess) { fprintf(stderr, "kernel_launch: hipFuncSetAttribute failed\n"); grid = -1; return; }
        if (hipOccupancyMaxActiveBlocksPerMultiprocessor(&per_cu, (const void*)fwd_kernel, 512, LDS_BYTES) != hipSuccess || per_cu < 1) fprintf(stderr, "kernel_launch: occupancy query says %d\n", per_cu);
        (void)hipGetLastError();
        grid = cus;
    }
    if (grid < 0) return;
    (void)hipMemsetAsync((char*)d_ws + WS_CTL, 0, 1 * MiB, stream);
    Args a{};
    for (int i = 0; i < 20; ++i) a.in[i] = (const float*)d_in[i];
    a.out = (float*)d_out; a.ws = (unsigned char*)d_ws;
#if MK_N_LAUNCHES == 1
    a.ph_lo = 0; a.ph_hi = N_PHASES;
    hipLaunchKernelGGL(fwd_kernel, dim3(grid), dim3(512), LDS_BYTES, stream, a);
#else
    for (int p = 0; p < N_PHASES; ++p) { a.ph_lo = p; a.ph_hi = p + 1; hipLaunchKernelGGL(fwd_kernel, dim3(grid), dim3(512), LDS_BYTES, stream, a); }
#endif
}
```

```cpp
#include <hip/hip_runtime.h>
#include <stdint.h>
#include <stdio.h>

#define LAS __attribute__((address_space(3)))
#define DI __device__ __forceinline__
typedef unsigned short bf16_t;
typedef short bf16x8 __attribute__((ext_vector_type(8)));
typedef float f32x4 __attribute__((ext_vector_type(4)));
typedef float f32x2 __attribute__((ext_vector_type(2)));
typedef float f32x16 __attribute__((ext_vector_type(16)));
typedef unsigned u32x4 __attribute__((ext_vector_type(4)));
typedef unsigned u32x2 __attribute__((ext_vector_type(2)));
typedef __bf16 bf16x2v __attribute__((ext_vector_type(2)));

#ifndef MK_N_LAUNCHES
#define MK_N_LAUNCHES 1
#endif

constexpr int D = 1024, T_ALL = 81920, T_P = 65536, T_S = 16384, SLABMAX = 32768, NSLAB = 3;
constexpr int DIN = 6552, NPROJ = 6656;
constexpr int C_GATE = 0, C_QA = 3072, C_KA = 3328, C_VA = 3584, C_QD = 3840, C_KD = 4224, C_VD = 4608, C_QC = 4992, C_KC = 5376, C_VC = 5760, C_ZC = 6144;
constexpr int NE = 16, DE = 2048, CAP_P = 8192, CAP_S = 2048, CAP = CAP_P + CAP_S;
constexpr float ALPHA = 1.41421356237f, LN_EPS = 1e-5f, NORM_EPS = 1e-6f;
constexpr size_t MiB = 1u << 20;
constexpr size_t WS_CTL = 0, WS_WIN = 1 * MiB, WS_WBR = 14 * MiB, WS_WOUT = 16 * MiB, WS_WGU = 18 * MiB, WS_WD = 82 * MiB, WS_XB8 = 114 * MiB, WS_WG8 = 194 * MiB, WS_XB = 210 * MiB;
constexpr size_t WS_AFF = 370 * MiB, WS_SLOT = 375 * MiB, WS_IDX = 380 * MiB, WS_GATEV = 381 * MiB, WS_CS = 382 * MiB, WS_BIG = 386 * MiB, WS_END = 1130 * MiB;
constexpr size_t B_PROJ = 0, B_BA = 416 * MiB, B_ONA = 420 * MiB, B_ODIL = 436 * MiB, B_OGDN = 452 * MiB, B_DILP = 476 * MiB, B_DILM = 500 * MiB, B_GSCR = 502 * MiB, B_MERGEF = 502 * MiB, B_MERGED = 630 * MiB;
constexpr size_t B_XY0 = 0, B_XY1 = 160 * MiB, B_HID = 320 * MiB;
constexpr int GSTRIDE = 41216;
constexpr int LDS_BYTES = 147456;
constexpr int LDS_MISC = 145408;

DI unsigned pk2(float lo, float hi) { f32x2 v = {lo, hi}; bf16x2v b = __builtin_convertvector(v, bf16x2v); return __builtin_bit_cast(unsigned, b); }
DI unsigned pk4_fp8(float a, float b, float c, float d) {
    int w = __builtin_amdgcn_cvt_pk_fp8_f32(a, b, 0, false); w = __builtin_amdgcn_cvt_pk_fp8_f32(c, d, w, true); return (unsigned)w; }
DI float bflo(unsigned u) { return __uint_as_float(u << 16); }
DI float bfhi(unsigned u) { return __uint_as_float(u & 0xffff0000u); }
DI float frcp(float x) { return __builtin_amdgcn_rcpf(x); }
DI float frsq(float x) { return __builtin_amdgcn_rsqf(x); }
DI float sigmoidf_(float x) { return frcp(1.0f + __expf(-x)); }
DI float siluf_(float x) { return x * frcp(1.0f + __expf(-x)); }
DI float wave_sum(float v) {
#pragma unroll
    for (int o = 1; o < 64; o <<= 1) v += __shfl_xor(v, o);
    return v;
}
#define MFMA32(a, b, c) __builtin_amdgcn_mfma_f32_32x32x16_bf16((a), (b), (c), 0, 0, 0)
DI int crow(int reg, int h) { return (reg & 3) + 8 * (reg >> 2) + 4 * h; }
DI f32x16 zero16() { f32x16 z; for (int i = 0; i < 16; ++i) z[i] = 0.f; return z; }
template <int S> DI bf16x8 pack8(const f32x16& x) {
    u32x4 p; p[0] = pk2(x[8 * S], x[8 * S + 1]); p[1] = pk2(x[8 * S + 2], x[8 * S + 3]); p[2] = pk2(x[8 * S + 4], x[8 * S + 5]); p[3] = pk2(x[8 * S + 6], x[8 * S + 7]);
    return __builtin_bit_cast(bf16x8, p);
}

namespace pg8 {
constexpr int BM = 256, BK = 64, HALF = 128, HTB = HALF * BK * 2, STAGE_BYTES = 8 * HTB, NXCD = 8, WGM = 8;
__host__ __device__ __forceinline__ int lds_byte(int r, int c) { const int st = (r >> 4) * 2 + (c >> 5), rr = r & 15, cc = c & 31, ob = rr * 64 + cc * 2; return st * 1024 + (ob ^ (((ob >> 9) & 1) << 5)); }
__host__ __device__ __forceinline__ void stage_rc(int b, int& R, int& C) { const int st = b / 1024, sb = b % 1024, swz = sb ^ (((sb >> 9) & 1) << 5); R = (st >> 1) * 16 + swz / 64; C = (st & 1) * 32 + (swz % 64) / 2; }
__host__ __device__ __forceinline__ int perm32(int rho) { const int n = rho >> 4, i = rho & 15; return 8 * (i >> 2) + 4 * n + (i & 3); }
struct Unit { int pm, pn; };
struct Gemm { const bf16_t* A; const bf16_t* Bt; int M, N, K; };
struct StaticOrder {
    int nM, nN, nwg, G, c;
    __device__ void init(int M, int N, int G_, int c_) { nM = M / BM; nN = N / BM; nwg = nM * nN; G = G_; c = c_; }
    __device__ bool next(int i, Unit& u) const {
        const long L = (long)i * G + c; if (L >= nwg) return false;
        int wgid = (int)L; { const int q = nwg / NXCD, r = nwg % NXCD, xcd = wgid % NXCD, off = wgid / NXCD; wgid = (xcd < r ? xcd * (q + 1) : r * (q + 1) + (xcd - r) * q) + off; }
        const int nig = WGM * nN, gid = wgid / nig, fm = gid * WGM, gsz = (nM - fm) < WGM ? (nM - fm) : WGM;
        u.pm = fm + ((wgid % nig) % gsz); u.pn = (wgid % nig) / gsz; return true;
    }
    __device__ __forceinline__ void a_ready(const Unit&) const {}
    __device__ __forceinline__ void done(const Unit&) const {}
};
struct MoeOrder {
    int nMe, nNe, per, total, G, c, xr, xc, rpx, cpx, share;
    __device__ void init(int nE, int nMe_, int nNe_, int G_, int c_) { nMe = nMe_; nNe = nNe_; per = nMe * nNe; total = nE * per; G = G_; c = c_;
        xc = (nNe % 2 == 0 && nNe >= 8) ? 2 : 1; xr = 8 / xc; rpx = nMe / xr; cpx = nNe / xc; share = rpx * cpx; }
    __device__ bool next(int i, Unit& u) const {
        if ((G & 7) == 0 && nMe % xr == 0) {
            const int x = c & 7, q = c >> 3, nq = G >> 3; const long j = (long)i * nq + q; if (j >= (long)(total / 8)) return false;
            const int e = (int)(j / share), r = (int)(j % share); const int pm = (x / xc) * rpx + r % rpx, pn = (x % xc) * cpx + r / rpx;
            u.pm = e * nMe + pm; u.pn = e * nNe + pn; return true;
        }
        const long L = (long)i * G + c; if (L >= total) return false;
        const int e = (int)(L / per), r = (int)(L % per);
        u.pm = e * nMe + r % nMe; u.pn = e * nNe + r / nMe; return true;
    }
    __device__ __forceinline__ void a_ready(const Unit&) const {}
    __device__ __forceinline__ void done(const Unit&) const {}
};

template <class Epi, class Sched>
__device__ __forceinline__ void gemm_phase(LAS unsigned char* lds, const Gemm g, const Sched& S, const Epi& E) {
    int tid = threadIdx.x; asm volatile("" : "+v"(tid));
    const int wid = __builtin_amdgcn_readfirstlane(tid >> 6), lane = tid & 63, wr = wid >> 2, wc = wid & 3, fr = lane & 15, fq = lane >> 4;
    int Kv = g.K; asm volatile("" : "+s"(Kv));
    const int K = Kv, nt = K / BK;
    unsigned voffA[2], voffB[2];
#pragma unroll
    for (int i = 0; i < 2; ++i) { int R, C; stage_rc(tid * 16 + i * 8192, R, C); const int Rb = Epi::PERM ? ((R & ~31) + perm32(R & 31)) : R;
        voffA[i] = (unsigned)(R * K + C) * 2u; voffB[i] = (unsigned)(Rb * K + C) * 2u; }
    const size_t kstep = (size_t)(BK * 2);
    const size_t hstep = (size_t)HALF * K * 2;
    const size_t tstep = 2 * hstep;
    const unsigned ldsw = (unsigned)wid * 1024u;
    const int aoff = lds_byte(wr * 64 + fr, fq * 8), boff = lds_byte(wc * 32 + fr, fq * 8);
#define PG8_SA(b, h) (((b) * 2 + (h)) * HTB)
#define PG8_SB(b, h) ((4 + (b) * 2 + (h)) * HTB)
#define PG8_STAGE(bufoff, gbase, voff) do { _Pragma("unroll") for (int _i = 0; _i < 2; ++_i) \
        __builtin_amdgcn_global_load_lds((const unsigned*)((const char*)(gbase) + (voff)[_i]), (LAS unsigned*)(lds + (bufoff) + ldsw + _i * 8192), 16, 0, 0); } while (0)
#define PG8_LD8(p) __builtin_shufflevector(*(const LAS v4i_*)(p), *(const LAS v4i_*)((p) + 1024), 0, 1, 2, 3, 4, 5, 6, 7)
#define PG8_LDA(dst, b, h) do { _Pragma("unroll") for (int m = 0; m < 4; ++m) { if constexpr (Epi::FP8) dst##8[m] = PG8_LD8(lds + PG8_SA(b, h) + aoff + m * 2048); \
        else { _Pragma("unroll") for (int k = 0; k < 2; ++k) dst[m][k] = *(const LAS bf16x8*)(lds + PG8_SA(b, h) + aoff + m * 2048 + k * 1024); } } } while (0)
#define PG8_LDB(dst, b, h) do { _Pragma("unroll") for (int n = 0; n < 2; ++n) { if constexpr (Epi::FP8) dst##8[n] = PG8_LD8(lds + PG8_SB(b, h) + boff + n * 2048); \
        else { _Pragma("unroll") for (int k = 0; k < 2; ++k) dst[n][k] = *(const LAS bf16x8*)(lds + PG8_SB(b, h) + boff + n * 2048 + k * 1024); } } } while (0)
#define PG8_MMA(ai, bj, At, Bt) do { __builtin_amdgcn_s_setprio(1); _Pragma("unroll") for (int m = 0; m < 4; ++m) _Pragma("unroll") for (int n = 0; n < 2; ++n) { \
        if constexpr (Epi::FP8) asm volatile("v_mfma_scale_f32_16x16x128_f8f6f4 %0, %1, %2, %0, %3, %3 op_sel_hi:[0,0,0]" : "+v"(acc[ai][bj][m][n]) : "v"(Bt##8[n]), "v"(At##8[m]), "v"(fp8_unit_scale));   \
        else { _Pragma("unroll") for (int k = 0; k < 2; ++k) acc[ai][bj][m][n] = __builtin_amdgcn_mfma_f32_16x16x32_bf16(Bt[n][k], At[m][k], acc[ai][bj][m][n], 0, 0, 0); } } \
        __builtin_amdgcn_s_setprio(0); } while (0)
#define PG8_WAIT_V(n) asm volatile("s_waitcnt vmcnt(" #n ")" ::: "memory")
#define PG8_WAIT_L(n) asm volatile("s_waitcnt lgkmcnt(" #n ")" ::: "memory")
#define PG8_BAR __builtin_amdgcn_s_barrier()
#define PG8_SCHED __builtin_amdgcn_sched_barrier(0)
    Unit cur, nxt; int ui = 0;
    if (!S.next(0, cur)) return;
    f32x4 acc[2][2][4][2];
#pragma unroll
    for (int a = 0; a < 2; ++a)
#pragma unroll
        for (int b = 0; b < 2; ++b)
#pragma unroll
            for (int m = 0; m < 4; ++m)
#pragma unroll
                for (int n = 0; n < 2; ++n) acc[a][b][m][n] = (f32x4){0.f, 0.f, 0.f, 0.f};
    typedef int v4i_ __attribute__((ext_vector_type(4))); typedef int v8i_ __attribute__((ext_vector_type(8)));
    bf16x8 At[4][2], B0[2][2], B1[2][2]; v8i_ At8[4], B08[2], B18[2];
    int fp8_unit_scale = 0x7F7F7F7F; asm volatile("" : "+v"(fp8_unit_scale));
    const char* cA = (const char*)g.A + (size_t)cur.pm * tstep; const char* cB = (const char*)g.Bt + (size_t)cur.pn * tstep;
    S.a_ready(cur);
    PG8_STAGE(PG8_SB(0, 0), cB, voffB); PG8_STAGE(PG8_SA(0, 0), cA, voffA); PG8_STAGE(PG8_SB(0, 1), cB + hstep, voffB); PG8_STAGE(PG8_SA(0, 1), cA + hstep, voffA);
    if (wr == 1) PG8_BAR;
    PG8_WAIT_V(4); PG8_BAR;
    PG8_STAGE(PG8_SB(1, 0), cB + kstep, voffB); PG8_STAGE(PG8_SA(1, 0), cA + kstep, voffA); PG8_STAGE(PG8_SB(1, 1), cB + hstep + kstep, voffB);
    PG8_WAIT_V(6); PG8_BAR;
    for (;;) {
        const bool has_next = S.next(ui + 1, nxt);
        const char* nA = has_next ? (const char*)g.A + (size_t)nxt.pm * tstep : cA; const char* nB = has_next ? (const char*)g.Bt + (size_t)nxt.pn * tstep : cB;
        for (int t = 0; t < nt; t += 2) {
            const bool last = (t == nt - 2);
            const char* a1 = cA + (size_t)(t + 1) * kstep;
            const char* a2 = last ? nA : cA + (size_t)(t + 2) * kstep; const char* b2 = last ? nB : cB + (size_t)(t + 2) * kstep;
            const char* a3 = a2 + kstep; const char* b3 = b2 + kstep;
            if (last && has_next) S.a_ready(nxt);
            if constexpr (Epi::SEG) { if (t == 4 || t == 6) { int tz = tid; asm volatile("" : "+v"(tz)); const int wz = __builtin_amdgcn_readfirstlane(tz >> 6), lz = tz & 63; E.mid(acc, cur, t == 4 ? 0 : 1, wz >> 2, wz & 3, lz & 15, lz >> 4); } }
            PG8_LDB(B0, 0, 0); PG8_SCHED; PG8_LDA(At, 0, 0); PG8_STAGE(PG8_SA(1, 1), a1 + hstep, voffA);
            PG8_WAIT_L(8); PG8_BAR; PG8_WAIT_L(0); PG8_MMA(0, 0, At, B0); PG8_BAR; PG8_SCHED;
            PG8_LDB(B1, 0, 1); PG8_STAGE(PG8_SB(0, 0), b2, voffB);
            PG8_BAR; PG8_WAIT_L(0); PG8_MMA(0, 1, At, B1); PG8_BAR;
            PG8_LDA(At, 0, 1); PG8_STAGE(PG8_SA(0, 0), a2, voffA);
            PG8_BAR; PG8_WAIT_L(0); PG8_MMA(1, 0, At, B0); PG8_BAR; PG8_SCHED;
            PG8_STAGE(PG8_SB(0, 1), b2 + hstep, voffB);
            PG8_WAIT_V(6); PG8_BAR; PG8_MMA(1, 1, At, B1); PG8_BAR;
            PG8_LDB(B0, 1, 0); PG8_SCHED; PG8_LDA(At, 1, 0); PG8_STAGE(PG8_SA(0, 1), a2 + hstep, voffA);
            PG8_WAIT_L(8); PG8_BAR; PG8_WAIT_L(0); PG8_MMA(0, 0, At, B0); PG8_BAR; PG8_SCHED;
            PG8_LDB(B1, 1, 1); PG8_STAGE(PG8_SB(1, 0), b3, voffB);
            PG8_BAR; PG8_WAIT_L(0); PG8_MMA(0, 1, At, B1); PG8_BAR;
            PG8_LDA(At, 1, 1); PG8_STAGE(PG8_SA(1, 0), a3, voffA);
            PG8_BAR; PG8_WAIT_L(0); PG8_MMA(1, 0, At, B0); PG8_BAR; PG8_SCHED;
            PG8_STAGE(PG8_SB(1, 1), b3 + hstep, voffB);
            PG8_WAIT_V(6); PG8_BAR; PG8_MMA(1, 1, At, B1); PG8_BAR;
        }
        if constexpr (Epi::FP8) asm volatile("s_nop 15\n\ts_nop 15\n\ts_nop 15" ::: "memory");
        { int tz = tid; asm volatile("" : "+v"(tz)); const int wz = __builtin_amdgcn_readfirstlane(tz >> 6), lz = tz & 63;
          E(acc, cur, wz >> 2, wz & 3, lz & 15, lz >> 4); } S.done(cur);
        if (!has_next) break;
#pragma unroll
        for (int a = 0; a < 2; ++a)
#pragma unroll
            for (int b = 0; b < 2; ++b)
#pragma unroll
                for (int m = 0; m < 4; ++m)
#pragma unroll
                    for (int n = 0; n < 2; ++n) acc[a][b][m][n] = (f32x4){0.f, 0.f, 0.f, 0.f};
        cur = nxt; cA = nA; cB = nB; ++ui;
    }
    PG8_WAIT_V(0);
    if (wr == 0) PG8_BAR;
    PG8_BAR;
#undef PG8_SA
#undef PG8_SB
#undef PG8_STAGE
#undef PG8_LDA
#undef PG8_LD8
#undef PG8_LDB
#undef PG8_MMA
#undef PG8_WAIT_V
#undef PG8_WAIT_L
#undef PG8_BAR
#undef PG8_SCHED
}

struct EpiInProj {
    static constexpr bool PERM = true, SEG = false, FP8 = false;
    bf16_t* O; float* BA;
    __device__ __forceinline__ void operator()(const f32x4 (&acc)[2][2][4][2], const Unit& u, int wr, int wc, int fr, int fq) const {
        const int row0 = u.pm * BM + wr * 64 + fr, col0 = 3072 + u.pn * BM + wc * 32 + 8 * fq;
        const bool sig = false, ba = (u.pn == 13) && (wc == 0) && (fq < 3);
#pragma unroll
        for (int ai = 0; ai < 2; ++ai)
#pragma unroll
            for (int m = 0; m < 4; ++m) { const int row = row0 + ai * HALF + m * 16; bf16_t* rowp = O + (size_t)row * NPROJ + col0;
#pragma unroll
                for (int bj = 0; bj < 2; ++bj) { f32x4 v0 = acc[ai][bj][m][0], v1 = acc[ai][bj][m][1];
                    if (sig) {
#pragma unroll
                        for (int j = 0; j < 4; ++j) { v0[j] = sigmoidf_(v0[j]); v1[j] = sigmoidf_(v1[j]); } }
                    u32x4 w; w.x = pk2(v0[0], v0[1]); w.y = pk2(v0[2], v0[3]); w.z = pk2(v1[0], v1[1]); w.w = pk2(v1[2], v1[3]);
                    *(u32x4*)(rowp + bj * HALF) = w;
                    if (bj == 1 && ba) { float* bp = BA + (size_t)row * 32 + 8 * fq; *(f32x4*)bp = v0; *(f32x4*)(bp + 4) = v1; } } }
    }
};
struct EpiGates {
    static constexpr bool PERM = true, SEG = false, FP8 = true;
    bf16_t* O;
    __device__ __forceinline__ void operator()(const f32x4 (&acc)[2][2][4][2], const Unit& u, int wr, int wc, int fr, int fq) const {
        const int row0 = u.pm * BM + wr * 64 + fr, col0 = u.pn * BM + wc * 32 + 8 * fq;
#pragma unroll
        for (int ai = 0; ai < 2; ++ai)
#pragma unroll
            for (int m = 0; m < 4; ++m) { int rowi = row0 + ai * HALF + m * 16; asm volatile("" : "+v"(rowi)); bf16_t* rowp = O + (size_t)rowi * NPROJ + col0;
#pragma unroll
                for (int bj = 0; bj < 2; ++bj) { f32x4 v0 = acc[ai][bj][m][0] * 0.03125f, v1 = acc[ai][bj][m][1] * 0.03125f;
#pragma unroll
                    for (int j = 0; j < 4; ++j) { v0[j] = sigmoidf_(v0[j]); v1[j] = sigmoidf_(v1[j]); }
                    u32x4 w; w.x = pk2(v0[0], v0[1]); w.y = pk2(v0[2], v0[3]); w.z = pk2(v1[0], v1[1]); w.w = pk2(v1[2], v1[3]);
                    *(u32x4*)(rowp + bj * HALF) = w; }
                asm volatile("" ::: "memory"); }
    }
};
struct EpiGateCat {
    static constexpr bool PERM = false, SEG = true, FP8 = false;
    const bf16_t* PROJ; bf16_t* MB;
    __device__ __forceinline__ void mid(f32x4 (&acc)[2][2][4][2], const Unit& u, int seg, int wr, int wc, int fr, int fq) const {
        const int row0 = u.pm * BM + wr * 64 + fr, col0 = u.pn * BM + wc * 32 + 4 * fq;
#pragma unroll
        for (int ai = 0; ai < 2; ++ai)
#pragma unroll
            for (int m = 0; m < 4; ++m) { int rowi = row0 + ai * HALF + m * 16; asm volatile("" : "+v"(rowi)); const bf16_t* gp = PROJ + (size_t)rowi * NPROJ + C_GATE + seg * 1024 + col0;
#pragma unroll
                for (int bj = 0; bj < 2; ++bj)
#pragma unroll
                    for (int n = 0; n < 2; ++n) { const u32x2 ga = *(const u32x2*)(gp + bj * HALF + n * 16), gb = *(const u32x2*)(gp + 1024 + bj * HALF + n * 16);
                        f32x4& v = acc[ai][bj][m][n]; v[0] *= bflo(ga.x) * frcp(bflo(gb.x)); v[1] *= bfhi(ga.x) * frcp(bfhi(gb.x)); v[2] *= bflo(ga.y) * frcp(bflo(gb.y)); v[3] *= bfhi(ga.y) * frcp(bfhi(gb.y)); }
                asm volatile("" ::: "memory"); }
    }
    __device__ __forceinline__ void operator()(const f32x4 (&acc)[2][2][4][2], const Unit& u, int wr, int wc, int fr, int fq) const {
        const int row0 = u.pm * BM + wr * 64 + fr, col0 = u.pn * BM + wc * 32 + 4 * fq;
#pragma unroll
        for (int ai = 0; ai < 2; ++ai)
#pragma unroll
            for (int m = 0; m < 4; ++m) { int rowi = row0 + ai * HALF + m * 16; asm volatile("" : "+v"(rowi)); const size_t row = (size_t)rowi;
#pragma unroll
                for (int bj = 0; bj < 2; ++bj)
#pragma unroll
                    for (int n = 0; n < 2; ++n) { const int col = col0 + bj * HALF + n * 16;
                        const u32x2 gw = *(const u32x2*)(PROJ + row * NPROJ + C_GATE + 2 * 1024 + col);
                        const f32x4 v = acc[ai][bj][m][n];
                        u32x2 w; w.x = pk2(v[0] * bflo(gw.x), v[1] * bfhi(gw.x)); w.y = pk2(v[2] * bflo(gw.y), v[3] * bfhi(gw.y)); *(u32x2*)(MB + row * D + col) = w; }
                asm volatile("" ::: "memory"); }
    }
};
struct EpiRes {
    static constexpr bool PERM = false, SEG = false, FP8 = false;
    const float* XR; float* H;
    __device__ __forceinline__ void operator()(const f32x4 (&acc)[2][2][4][2], const Unit& u, int wr, int wc, int fr, int fq) const {
        const int row0 = u.pm * BM + wr * 64 + fr, col0 = u.pn * BM + wc * 32 + 4 * fq;
#pragma unroll
        for (int ai = 0; ai < 2; ++ai)
#pragma unroll
            for (int m = 0; m < 4; ++m) { int rowi = row0 + ai * HALF + m * 16; asm volatile("" : "+v"(rowi)); const size_t off = (size_t)rowi * D + col0;
#pragma unroll
                for (int bj = 0; bj < 2; ++bj)
#pragma unroll
                    for (int n = 0; n < 2; ++n) { const f32x4 xr = *(const f32x4*)(XR + off + bj * HALF + n * 16);
                        *(f32x4*)(H + off + bj * HALF + n * 16) = xr * ALPHA + acc[ai][bj][m][n]; }
                asm volatile("" ::: "memory"); }
    }
};
struct EpiSwiglu {
    static constexpr bool PERM = true, SEG = false, FP8 = true;
    unsigned char* HID;
    __device__ __forceinline__ void operator()(const f32x4 (&acc)[2][2][4][2], const Unit& u, int wr, int wc, int fr, int fq) const {
        const int row0 = u.pm * BM + wr * 64 + fr, col0 = (u.pn & 15) * 128 + wc * 32 + 8 * fq;
#pragma unroll
        for (int ai = 0; ai < 2; ++ai)
#pragma unroll
            for (int m = 0; m < 4; ++m) { const f32x4 g0 = acc[ai][0][m][0] * 0.03125f, g1 = acc[ai][0][m][1] * 0.03125f, u0 = acc[ai][1][m][0] * 0.03125f, u1 = acc[ai][1][m][1] * 0.03125f;
                f32x4 h0, h1;
#pragma unroll
                for (int j = 0; j < 4; ++j) { h0[j] = siluf_(g0[j]) * u0[j]; h1[j] = siluf_(g1[j]) * u1[j]; }
                u32x2 w; w.x = pk4_fp8(h0[0], h0[1], h0[2], h0[3]); w.y = pk4_fp8(h1[0], h1[1], h1[2], h1[3]);
                int rowi = row0 + ai * HALF + m * 16; asm volatile("" : "+v"(rowi));
                *(u32x2*)(HID + (size_t)rowi * DE + col0) = w; asm volatile("" ::: "memory"); }
    }
};
struct EpiDown {
    static constexpr bool PERM = true, SEG = false, FP8 = true;
    bf16_t* Y; const float* GV;
    __device__ __forceinline__ void operator()(const f32x4 (&acc)[2][2][4][2], const Unit& u, int wr, int wc, int fr, int fq) const {
        const int row0 = u.pm * BM + wr * 64 + fr, col0 = (u.pn & 3) * BM + wc * 32 + 8 * fq;
#pragma unroll
        for (int ai = 0; ai < 2; ++ai)
#pragma unroll
            for (int m = 0; m < 4; ++m) { int row = row0 + ai * HALF + m * 16; asm volatile("" : "+v"(row)); const float gv = GV[row] * 0.03125f;
#pragma unroll
                for (int bj = 0; bj < 2; ++bj) { const f32x4 v0 = acc[ai][bj][m][0] * gv, v1 = acc[ai][bj][m][1] * gv;
                    u32x4 w; w.x = pk2(v0[0], v0[1]); w.y = pk2(v0[2], v0[3]); w.z = pk2(v1[0], v1[1]); w.w = pk2(v1[2], v1[3]);
                    *(u32x4*)(Y + (size_t)row * D + col0 + bj * HALF) = w; } }
    }
};
}

#define XB_TMO      128
#define XB_XCNT(j)  (256  + 64 * (j))
#define XB_XSUB(j)  (1280 + 64 * (j))
#define XB_XGEN(j)  (2304 + 64 * (j))
#define XB_TOP      3328
#define XB_TOPGEN   3392
#define XCD_BAR_WORDS 3456
#define XB_SPIN_CAP (1u << 22)
__device__ __forceinline__ unsigned xb_ld(unsigned* p)              { return __hip_atomic_load(p, __ATOMIC_RELAXED, __HIP_MEMORY_SCOPE_AGENT); }
__device__ __forceinline__ unsigned xb_add(unsigned* p, unsigned v) { return __hip_atomic_fetch_add(p, v, __ATOMIC_RELAXED, __HIP_MEMORY_SCOPE_AGENT); }
__device__ __forceinline__ unsigned xb_xcc_id() { return (unsigned)__builtin_amdgcn_s_getreg((3 << 11) | 20) & 0xFu; }
#define XB_SPIN(cond, bar) do { unsigned _sp = 0; while (cond) { __builtin_amdgcn_s_sleep(1); \
    if ((++_sp & 255u) == 0u) { if (xb_ld(&(bar)[XB_TMO])) break; if (_sp > XB_SPIN_CAP) { atomicAdd(&(bar)[XB_TMO], 1u); break; } } } } while (0)
struct XcdBarrier { unsigned* bar; unsigned x; volatile LAS unsigned* st; };
__device__ __forceinline__ XcdBarrier xcd_barrier_post(unsigned* bar, volatile LAS unsigned* st) {
    XcdBarrier b; b.bar = bar; b.x = xb_xcc_id(); b.st = st;
    if (threadIdx.x == 0) (void)xb_add(&bar[XB_XCNT(b.x)], 1u);
    return b;
}
__device__ __forceinline__ void xcd_barrier_complete(unsigned* bar, unsigned x, unsigned& nloc, unsigned& nx) {
    const unsigned G = gridDim.x * gridDim.y * gridDim.z;
    unsigned sum, cnt, mine, sp = 0u;
    for (;;) {
        sum = 0u; cnt = 0u; mine = 0u;
#pragma unroll
        for (unsigned j = 0; j < 16; ++j) { const unsigned c = xb_ld(&bar[XB_XCNT(j)]); sum += c; cnt += (c > 0u) ? 1u : 0u; }
        mine = xb_ld(&bar[XB_XCNT(x)]);
        if (sum == G) break;
        __builtin_amdgcn_s_sleep(1);
        if ((++sp & 255u) == 0u) { if (xb_ld(&bar[XB_TMO])) break; if (sp > XB_SPIN_CAP) { atomicAdd(&bar[XB_TMO], 1u); break; } }
    }
    nloc = mine > 0u ? mine : 1u; nx = cnt > 0u ? cnt : 1u;
}
__device__ __forceinline__ void xcd_barrier(const XcdBarrier& b) {
    asm volatile("s_waitcnt vmcnt(0)" ::: "memory");
    __syncthreads();
    if (threadIdx.x == 0) {
        unsigned* bar = b.bar; asm volatile("" : "+s"(bar));
        __builtin_amdgcn_s_waitcnt(0);
        unsigned nloc = b.st[0], nx = b.st[1];
        if (nloc == 0u) { xcd_barrier_complete(bar, b.x, nloc, nx); b.st[0] = nloc; b.st[1] = nx; }
        const unsigned old = xb_add(&bar[XB_XSUB(b.x)], 1u);
        const unsigned gen = old / nloc;
        if (old + 1u == (gen + 1u) * nloc) {
            __builtin_amdgcn_fence(__ATOMIC_RELEASE, "agent");
            asm volatile("s_waitcnt vmcnt(0)" ::: "memory");
            const unsigned og = xb_add(&bar[XB_TOP], 1u);
            const unsigned tg = og / nx;
            if (og + 1u == (tg + 1u) * nx) xb_add(&bar[XB_TOPGEN], 1u);
            else XB_SPIN(xb_ld(&bar[XB_TOPGEN]) == tg, bar);
            __builtin_amdgcn_fence(__ATOMIC_ACQUIRE, "agent");
            xb_add(&bar[XB_XGEN(b.x)], 1u);
            asm volatile("s_waitcnt vmcnt(0)" ::: "memory");
        } else {
            XB_SPIN(xb_ld(&bar[XB_XGEN(b.x)]) == gen, bar);
            __builtin_amdgcn_fence(__ATOMIC_ACQUIRE, "agent");
            asm volatile("s_waitcnt vmcnt(0)" ::: "memory");
        }
    }
    __syncthreads();
}

struct Args { const float* in[20]; float* out; unsigned char* ws; int ph_lo, ph_hi; };
typedef const __attribute__((address_space(4))) Args* KArgs;
DI KArgs kargs() { KArgs p = (KArgs)__builtin_amdgcn_kernarg_segment_ptr(); asm volatile("" : "+s"(p)); return p; }
struct Ctx {
    float* out; unsigned char* ws;
    int tid, lane, wave, G, bid;
    int layer, slab;
    int nseq, seqlen;
    int stok, sbase;
    int dry;
};
#define WSP(T, off) ((T*)(c.ws + (off)))
#define BIGP(T, off) ((T*)(c.ws + WS_BIG + (off)))

__device__ const float INV_FREQ[32] = {1.000000000e+00f, 7.498942018e-01f, 5.623413324e-01f, 4.216965139e-01f, 3.162277639e-01f, 2.371373773e-01f, 1.778279394e-01f, 1.333521456e-01f, 1.000000015e-01f, 7.498942316e-02f, 5.623413250e-02f, 4.216964915e-02f, 3.162277490e-02f, 2.371373773e-02f, 1.778279431e-02f, 1.333521400e-02f, 9.999999776e-03f, 7.498942316e-03f, 5.623413250e-03f, 4.216964822e-03f, 3.162277630e-03f, 2.371373819e-03f, 1.778279431e-03f, 1.333521446e-03f, 1.000000047e-03f, 7.498941850e-04f, 5.623413017e-04f, 4.216965172e-04f, 3.162277571e-04f, 2.371373703e-04f, 1.778279402e-04f, 1.333521504e-04f};
DI void tr_item(const float* src, long src_ld, int src_col0, int nvalid, int kvalid, bf16_t* dst, long dst_ld, int dst_row0, int k0, LAS float* scr, int lane) {
    float tv[32];
#pragma unroll
    for (int i = 0; i < 32; ++i) { const int kk = 2 * i + (lane >> 5), cc = lane & 31;
        tv[i] = 0.f; if ((k0 + kk) < kvalid && cc < nvalid) tv[i] = src[(size_t)(k0 + kk) * src_ld + src_col0 + cc]; }
#pragma unroll
    for (int i = 0; i < 32; ++i) { const int kk = 2 * i + (lane >> 5), cc = lane & 31; scr[kk * 33 + cc] = tv[i]; }
    asm volatile("s_waitcnt lgkmcnt(0)" ::: "memory");
    const int c8 = lane & 7;
#pragma unroll
    for (int j = 0; j < 4; ++j) { const int n = (lane >> 3) + 8 * j; const LAS float* s = scr + (8 * c8) * 33 + n;
        u32x4 o; o.x = pk2(s[0 * 33], s[1 * 33]); o.y = pk2(s[2 * 33], s[3 * 33]); o.z = pk2(s[4 * 33], s[5 * 33]); o.w = pk2(s[6 * 33], s[7 * 33]);
        *(u32x4*)(dst + (size_t)(dst_row0 + n) * dst_ld + k0 + 8 * c8) = o; }
    asm volatile("s_waitcnt lgkmcnt(0)" ::: "memory");
}
DI void tr_item8(const float* src, long src_ld, int src_col0, int kvalid, unsigned char* dst, long dst_ld, int dst_row0, int k0, float scale, LAS float* scr, int lane) {
    float tv[32];
#pragma unroll
    for (int i = 0; i < 32; ++i) { const int kk = 2 * i + (lane >> 5), cc = lane & 31; tv[i] = 0.f; if ((k0 + kk) < kvalid) tv[i] = src[(size_t)(k0 + kk) * src_ld + src_col0 + cc]; }
#pragma unroll
    for (int i = 0; i < 32; ++i) { const int kk = 2 * i + (lane >> 5), cc = lane & 31; scr[kk * 33 + cc] = tv[i]; }
    asm volatile("s_waitcnt lgkmcnt(0)" ::: "memory");
    const int c8 = lane & 7;
#pragma unroll
    for (int j = 0; j < 4; ++j) { const int n = (lane >> 3) + 8 * j; const LAS float* s = scr + (8 * c8) * 33 + n;
        u32x2 o; o.x = pk4_fp8(s[0 * 33] * scale, s[1 * 33] * scale, s[2 * 33] * scale, s[3 * 33] * scale); o.y = pk4_fp8(s[4 * 33] * scale, s[5 * 33] * scale, s[6 * 33] * scale, s[7 * 33] * scale);
        *(u32x2*)(dst + (size_t)(dst_row0 + n) * dst_ld + k0 + 8 * c8) = o; }
    asm volatile("s_waitcnt lgkmcnt(0)" ::: "memory");
}
DI void phase_weights(KArgs args, LAS unsigned char* lds, const Ctx& c) {
    const int l = c.layer, lane = c.lane;
    LAS float* scr = (LAS float*)(lds + c.wave * 8448);
    const int gw = c.bid * 8 + c.wave, NGW = c.G * 8;
    constexpr int I_IN = 16 * 112 + 16 * 96, I_NA = 4 * 32, I_DIL = 2 * 32, I_GDN = 6 * 32, I_OUT = 16 * 32, I_GU1 = 16 * 128, I_D1 = 32 * 32;
    constexpr int NITEMS = I_IN + I_NA + I_DIL + I_GDN + I_OUT + 16 * I_GU1 + 16 * I_D1;
    for (int it = gw; it < NITEMS; it += NGW) {
        int r = it;
        const float* src; long sld; int sc0, nv = 32, kv; bf16_t* dst; long dld; int dr0, k0;
        if (r < 16 * 112) { const int kb = r / 112, nb = r % 112, n0 = 32 * nb; src = args->in[2] + (size_t)l * D * DIN; sld = DIN; kv = D;
            sc0 = n0; nv = 3480 - n0; if (nv < 0) { nv = 0; sc0 = 0; } if (nv > 32) nv = 32;
            dst = WSP(bf16_t, WS_WIN); dld = D; dr0 = n0; k0 = 64 * kb; }
        else if (r < I_IN) { const int q = r - 16 * 112, kb = q / 96, nb = q % 96;
            tr_item8(args->in[2] + (size_t)l * D * DIN, DIN, 3480 + 32 * nb, D, WSP(unsigned char, WS_WG8), D, 32 * nb, 64 * kb, 32.0f, scr, lane); continue; }
        else if ((r -= I_IN) < I_NA) { const int kb = r / 32, nb = r % 32; src = args->in[8] + (size_t)l * 256 * D; sld = D; sc0 = 32 * nb; kv = 256; dst = WSP(bf16_t, WS_WBR); dld = 768; dr0 = 32 * nb; k0 = 64 * kb; }
        else if ((r -= I_NA) < I_DIL) { const int kb = r / 32, nb = r % 32; src = args->in[9] + (size_t)l * 128 * D; sld = D; sc0 = 32 * nb; kv = 128; dst = WSP(bf16_t, WS_WBR) + 256; dld = 768; dr0 = 32 * nb; k0 = 64 * kb; }
        else if ((r -= I_DIL) < I_GDN) { const int kb = r / 32, nb = r % 32; src = args->in[10] + (size_t)l * 384 * D; sld = D; sc0 = 32 * nb; kv = 384; dst = WSP(bf16_t, WS_WBR) + 384; dld = 768; dr0 = 32 * nb; k0 = 64 * kb; }
        else if ((r -= I_GDN) < I_OUT) { const int kb = r / 32, nb = r % 32; src = args->in[11] + (size_t)l * D * D; sld = D; sc0 = 32 * nb; kv = D; dst = WSP(bf16_t, WS_WOUT); dld = D; dr0 = 32 * nb; k0 = 64 * kb; }
        else if ((r -= I_OUT) < 16 * I_GU1) { const int e = r / I_GU1, q = r % I_GU1, kb = q / 128, nb = q % 128, n0 = 32 * nb, j = n0 >> 8, rr = n0 & 255;
            tr_item8((rr < 128 ? args->in[16] : args->in[15]) + ((size_t)l * NE + e) * D * DE, DE, 128 * j + (rr & 127), D, WSP(unsigned char, WS_WGU) + (size_t)e * 4096 * D, D, n0, 64 * kb, 32.0f, scr, lane); continue; }
        else { r -= 16 * I_GU1; const int e = r / I_D1, q = r % I_D1, kb = q / 32, nb = q % 32;
            tr_item8(args->in[17] + ((size_t)l * NE + e) * DE * D, D, 32 * nb, DE, WSP(unsigned char, WS_WD) + (size_t)e * D * DE, DE, 32 * nb, 64 * kb, 32.0f, scr, lane); continue; }
        tr_item(src, sld, sc0, nv, kv, dst, dld, dr0, k0, scr, lane);
    }
    if (l == 0) {
        for (int t = gw; t < T_ALL; t += NGW) {
            const float* xr = (t < T_P) ? args->in[0] + (size_t)t * D : args->in[1] + (size_t)(t - T_P) * D;
            bf16_t* o = WSP(bf16_t, WS_XB) + (size_t)t * D;
#pragma unroll
            for (int j = 0; j < 4; ++j) { const f32x4 v = *(const f32x4*)(xr + 4 * lane + 256 * j); u32x2 w; w.x = pk2(v[0], v[1]); w.y = pk2(v[2], v[3]); *(u32x2*)(o + 4 * lane + 256 * j) = w;
                *(unsigned*)(WSP(unsigned char, WS_XB8) + (size_t)t * D + 4 * lane + 256 * j) = pk4_fp8(v[0], v[1], v[2], v[3]); }
        }
        float* cs = WSP(float, WS_CS);
        for (int i = c.bid * 512 + c.tid; i < 16384 * 32; i += c.G * 512) { const int pos = i >> 5, k = i & 31;
            const float inv = INV_FREQ[k];
            const float ang = (float)pos * inv;
            cs[pos * 64 + k] = cosf(ang); cs[pos * 64 + 32 + k] = sinf(ang); }
    }
}

constexpr int TLD = 72, TILEB = 64 * TLD * 2;
DI int tsw(int row) { return ((row >> 4) & 3) << 3; }
template <bool SA = false, bool SB = false> DI f32x16 mm_tile(const LAS bf16_t* A, const LAS bf16_t* Bt, int m0, int n0, int lane) {
    f32x16 acc = zero16(); const int r = lane & 31, hh = lane >> 5; const int sa = SA ? tsw(m0 + r) : 0, sb = SB ? tsw(n0 + r) : 0;
#pragma unroll
    for (int ks = 0; ks < 4; ++ks) { const bf16x8 a = *(const LAS bf16x8*)(A + (m0 + r) * TLD + ((16 * ks + 8 * hh) ^ sa)); const bf16x8 b = *(const LAS bf16x8*)(Bt + (n0 + r) * TLD + ((16 * ks + 8 * hh) ^ sb)); acc = MFMA32(a, b, acc); }
    return acc;
}

constexpr int PI_P0 = 0, PI_P1 = 9216, PI_INTRA = 18432, PI_AM = 27648, PI_TT = 45056, PI_TD0 = 54272, PI_TD1 = 60416, PI_PM = 65024, PI_VEC = 71168, PI_BYTES = 72704;
constexpr int PI_WT = PI_AM, PI_UT = PI_TD0;
DI void gdn_prep_pair(KArgs args, LAS unsigned char* L0, const Ctx& c, int pu) {
    int tid = c.tid; asm volatile("" : "+v"(tid)); const int lane = tid & 63, wave = __builtin_amdgcn_readfirstlane(tid >> 6), l = c.layer;
    const int dir = wave >> 2, wg = wave & 3, tg = tid & 255, head = pu % 6, gch = pu / 6, inst = (gch * 6 + head) * 2 + dir;
    const int cps = c.seqlen >> 6, seq = gch / cps, n = gch % cps;
    const bf16_t* PROJ = BIGP(bf16_t, B_PROJ); const float* BA = BIGP(float, B_BA);
    unsigned char* G = BIGP(unsigned char, B_GSCR) + (size_t)inst * GSTRIDE;
    LAS unsigned char* L = L0 + dir * PI_BYTES;
    LAS bf16_t* P0 = (LAS bf16_t*)(L + PI_P0); LAS bf16_t* P1 = (LAS bf16_t*)(L + PI_P1); LAS bf16_t* INTRA = (LAS bf16_t*)(L + PI_INTRA);
    LAS float* AM = (LAS float*)(L + PI_AM); LAS bf16_t* TT = (LAS bf16_t*)(L + PI_TT);
    LAS float* TD0 = (LAS float*)(L + PI_TD0); LAS float* TD1 = (LAS float*)(L + PI_TD1); LAS float* PM = (LAS float*)(L + PI_PM);
    LAS float* GV = (LAS float*)(L + PI_VEC); LAS float* BV = GV + 64; LAS float* GC = GV + 128;
    LAS bf16_t* WT = (LAS bf16_t*)(L + PI_WT); LAS bf16_t* UT = (LAS bf16_t*)(L + PI_UT);
    const int ia = tg >> 3, p = tg & 7;
    LAS float* XQ = (LAS float*)(L0 + PI_AM);
    LAS float* XK = (LAS float*)(L0 + PI_TT);
    LAS float* XV = (LAS float*)(L0 + PI_BYTES + PI_AM);
    {   float q1[8], k1[8], v1[8];
#pragma unroll
        for (int j = 0; j < 8; ++j) { q1[j] = 0.f; k1[j] = 0.f; v1[j] = 0.f; }
        const float* cw = args->in[4] + (size_t)l * 5 * 1152 + 64 * head + 8 * p;
        const int tr = ia + 32 * dir;
#pragma unroll
        for (int tp = 0; tp < 5; ++tp) { const float* w = cw + tp * 1152;
            const f32x4 wq0 = *(const f32x4*)w, wq1 = *(const f32x4*)(w + 4), wk0 = *(const f32x4*)(w + 384), wk1 = *(const f32x4*)(w + 388), wv0 = *(const f32x4*)(w + 768), wv1 = *(const f32x4*)(w + 772);
            const int pp = n * 64 + tr + tp - 2;
            if (pp >= 0 && pp < c.seqlen) { const bf16_t* rp = PROJ + (size_t)(seq * c.seqlen + pp) * NPROJ + 64 * head + 8 * p;
                const u32x4 rq = *(const u32x4*)(rp + C_QC), rk = *(const u32x4*)(rp + C_KC), rv = *(const u32x4*)(rp + C_VC);
#pragma unroll
                for (int j = 0; j < 4; ++j) { const float a0 = (j < 2) ? wq0[2 * j] : wq1[2 * j - 4], a1 = (j < 2) ? wq0[2 * j + 1] : wq1[2 * j - 3];
                    const float b0 = (j < 2) ? wk0[2 * j] : wk1[2 * j - 4], b1 = (j < 2) ? wk0[2 * j + 1] : wk1[2 * j - 3];
                    const float c0 = (j < 2) ? wv0[2 * j] : wv1[2 * j - 4], c1 = (j < 2) ? wv0[2 * j + 1] : wv1[2 * j - 3];
                    q1[2 * j] += a0 * bflo(rq[j]); q1[2 * j + 1] += a1 * bfhi(rq[j]);
                    k1[2 * j] += b0 * bflo(rk[j]); k1[2 * j + 1] += b1 * bfhi(rk[j]);
                    v1[2 * j] += c0 * bflo(rv[j]); v1[2 * j + 1] += c1 * bfhi(rv[j]); } } }
        float sq = 0.f, sk = 0.f;
#pragma unroll
        for (int j = 0; j < 8; ++j) { q1[j] = siluf_(q1[j]); k1[j] = siluf_(k1[j]); v1[j] = siluf_(v1[j]); sq += q1[j] * q1[j]; sk += k1[j] * k1[j]; }
        sq += __shfl_xor(sq, 1); sq += __shfl_xor(sq, 2); sq += __shfl_xor(sq, 4);
        sk += __shfl_xor(sk, 1); sk += __shfl_xor(sk, 2); sk += __shfl_xor(sk, 4);
        const float rq_ = 0.125f * frsq(sq + NORM_EPS), rk_ = frsq(sk + NORM_EPS);
        f32x4 o0, o1;
        o0[0] = q1[0] * rq_; o0[1] = q1[1] * rq_; o0[2] = q1[2] * rq_; o0[3] = q1[3] * rq_; o1[0] = q1[4] * rq_; o1[1] = q1[5] * rq_; o1[2] = q1[6] * rq_; o1[3] = q1[7] * rq_;
        *(LAS f32x4*)(XQ + tr * 64 + 8 * p) = o0; *(LAS f32x4*)(XQ + tr * 64 + 8 * p + 4) = o1;
        o0[0] = k1[0] * rk_; o0[1] = k1[1] * rk_; o0[2] = k1[2] * rk_; o0[3] = k1[3] * rk_; o1[0] = k1[4] * rk_; o1[1] = k1[5] * rk_; o1[2] = k1[6] * rk_; o1[3] = k1[7] * rk_;
        *(LAS f32x4*)(XK + tr * 64 + 8 * p) = o0; *(LAS f32x4*)(XK + tr * 64 + 8 * p + 4) = o1;
        o0[0] = v1[0]; o0[1] = v1[1]; o0[2] = v1[2]; o0[3] = v1[3]; o1[0] = v1[4]; o1[1] = v1[5]; o1[2] = v1[6]; o1[3] = v1[7];
        *(LAS f32x4*)(XV + tr * 64 + 8 * p) = o0; *(LAS f32x4*)(XV + tr * 64 + 8 * p + 4) = o1; }
#pragma unroll
    for (int h2 = 0; h2 < 2; ++h2) {
        if (p == 0) { const int i = ia + 32 * h2, tokl = dir ? 63 - i : i; const float* bar = BA + (size_t)(seq * c.seqlen + n * 64 + tokl) * 32;
            const float bl = bar[dir * 6 + head], al = bar[12 + dir * 6 + head];
            const float xx = al + args->in[6][l * 12 + dir * 6 + head];
            const float sp = xx > 20.f ? xx : log1pf(expf(xx));
            GV[i] = -expf(args->in[5][l * 12 + dir * 6 + head]) * sp; BV[i] = sigmoidf_(bl); } }
    __syncthreads();
    float q[2][8], k[2][8], v[2][8];
#pragma unroll
    for (int h2 = 0; h2 < 2; ++h2) { const int i = ia + 32 * h2, tokl = dir ? 63 - i : i;
        const f32x4 a0 = *(const LAS f32x4*)(XQ + tokl * 64 + 8 * p), a1 = *(const LAS f32x4*)(XQ + tokl * 64 + 8 * p + 4), b0 = *(const LAS f32x4*)(XK + tokl * 64 + 8 * p), b1 = *(const LAS f32x4*)(XK + tokl * 64 + 8 * p + 4),
                    c0 = *(const LAS f32x4*)(XV + tokl * 64 + 8 * p), c1 = *(const LAS f32x4*)(XV + tokl * 64 + 8 * p + 4);
#pragma unroll
        for (int j = 0; j < 4; ++j) { q[h2][j] = a0[j]; q[h2][4 + j] = a1[j]; k[h2][j] = b0[j]; k[h2][4 + j] = b1[j]; v[h2][j] = c0[j]; v[h2][4 + j] = c1[j]; } }
    float gcl_;
    { float x = GV[lane];
#pragma unroll
        for (int o = 1; o < 64; o <<= 1) { const float y = __shfl_up(x, o); if (lane >= o) x += y; }
        if (wg == 0) GC[lane] = x;
        gcl_ = x; }
    const float gc0 = __shfl(gcl_, ia), gc1 = __shfl(gcl_, ia + 32), gcl = __shfl(gcl_, 63);
#pragma unroll
    for (int h2 = 0; h2 < 2; ++h2) { const int i = ia + 32 * h2; u32x4 wq, wk;
#pragma unroll
        for (int j = 0; j < 4; ++j) { wq[j] = pk2(q[h2][2 * j], q[h2][2 * j + 1]); wk[j] = pk2(k[h2][2 * j], k[h2][2 * j + 1]); }
        *(LAS u32x4*)(P0 + i * TLD + 8 * p) = wq; *(LAS u32x4*)(P1 + i * TLD + 8 * p) = wk; }
    __syncthreads();
    { const int mat = wg >> 1, mt = wg & 1, hh = lane >> 5;
#pragma unroll
        for (int nt = 0; nt < 2; ++nt) { const int jc = 32 * nt + (lane & 31);
            const f32x16 a = mm_tile(mat ? P0 : P1, P1, 32 * mt, 32 * nt, lane);
            const float gj = GC[jc];
#pragma unroll
            for (int r = 0; r < 16; ++r) { const int ii = 32 * mt + crow(r, hh); const float gi = GC[ii];
                if (mat == 0) AM[ii * 68 + jc] = (jc < ii) ? BV[ii] * a[r] * __expf(gi - gj) : 0.f;
                else INTRA[ii * TLD + jc] = (bf16_t)(pk2((jc <= ii) ? a[r] * __expf(gi - gj) : 0.f, 0.f) & 0xffffu); } } }
    __syncthreads();
    if (wg == dir) {
        const int b = lane >> 5, cidx = lane & 31; float t[32];
#pragma unroll
        for (int ii = 0; ii < 32; ++ii) t[ii] = (ii == cidx) ? 1.f : 0.f;
        const LAS float* Ab = AM + (32 * b) * 68 + 32 * b;
#pragma unroll
        for (int ii = 1; ii < 32; ++ii) { float acc = 0.f;
#pragma unroll
            for (int j4 = 0; j4 < ii; j4 += 4) { const f32x4 a4 = *(const LAS f32x4*)(Ab + ii * 68 + j4);
                acc += a4[0] * t[j4]; acc += a4[1] * t[j4 + 1]; acc += a4[2] * t[j4 + 2]; acc += a4[3] * t[j4 + 3]; }
            t[ii] -= acc; }
        LAS float* td = b ? TD1 : TD0; const int tds = b ? 36 : 48;
#pragma unroll
        for (int ii = 0; ii < 32; ++ii) { td[ii * tds + cidx] = t[ii]; TT[(32 * b + ii) * TLD + 32 * b + cidx] = (bf16_t)(pk2(t[ii], 0.f) & 0xffffu); }
    }
#pragma unroll
    for (int h2 = 0; h2 < 2; ++h2) { const int i = ia + 32 * h2; const float be = BV[i], eg = __expf(h2 ? gc1 : gc0);
#pragma unroll
        for (int j = 0; j < 8; ++j) { const int d = 8 * p + j, o_ = d * TLD + (i ^ tsw(d)); P0[o_] = (bf16_t)(pk2(k[h2][j] * be * eg, 0.f) & 0xffffu); P1[o_] = (bf16_t)(pk2(v[h2][j] * be, 0.f) & 0xffffu); } }
    { unsigned zz; asm volatile("v_mov_b32 %0, 0" : "=v"(zz)); u32x2 z; z.x = zz; z.y = zz; *(LAS u32x2*)(TT + (tg >> 3) * TLD + 32 + 4 * (tg & 7)) = z; }
    __syncthreads();
    { const int qi = wg >> 1, qj = wg & 1, r16 = lane & 15, g4 = lane >> 4; f32x4 pc = {0.f, 0.f, 0.f, 0.f};
#pragma unroll
        for (int kk = 0; kk < 8; ++kk) pc = __builtin_amdgcn_mfma_f32_16x16x4f32(AM[(32 + 16 * qi + r16) * 68 + 4 * kk + g4], TD0[(4 * kk + g4) * 48 + 16 * qj + r16], pc, 0, 0, 0);
#pragma unroll
        for (int r = 0; r < 4; ++r) PM[(16 * qi + 4 * g4 + r) * 48 + 16 * qj + r16] = pc[r]; }
    __syncthreads();
    { const int qi = wg >> 1, qj = wg & 1, r16 = lane & 15, g4 = lane >> 4; f32x4 pc = {0.f, 0.f, 0.f, 0.f};
#pragma unroll
        for (int kk = 0; kk < 8; ++kk) pc = __builtin_amdgcn_mfma_f32_16x16x4f32(TD1[(16 * qi + r16) * 36 + 4 * kk + g4], PM[(4 * kk + g4) * 48 + 16 * qj + r16], pc, 0, 0, 0);
#pragma unroll
        for (int r = 0; r < 4; ++r) TT[(32 + 16 * qi + 4 * g4 + r) * TLD + 16 * qj + r16] = (bf16_t)(pk2(-pc[r], 0.f) & 0xffffu); }
    __syncthreads();
    { const int which = wg >> 1, mt = wg & 1, hh = lane >> 5;
#pragma unroll
        for (int nt = 0; nt < 2; ++nt) { const int dc = 32 * nt + (lane & 31);
            const f32x16 a = mm_tile<false, true>(TT, which ? P1 : P0, 32 * mt, 32 * nt, lane);
            LAS bf16_t* dst = (which ? UT : WT) + dc * TLD; const int sw = tsw(dc);
#pragma unroll
            for (int g = 0; g < 4; ++g) { u32x2 w; w.x = pk2(a[4 * g], a[4 * g + 1]); w.y = pk2(a[4 * g + 2], a[4 * g + 3]); *(LAS u32x2*)(dst + ((32 * mt + 8 * g + 4 * hh) ^ sw)) = w; } } }
    __syncthreads();
#pragma unroll
    for (int h2 = 0; h2 < 2; ++h2) { const int i = ia + 32 * h2; const float gci = h2 ? gc1 : gc0, eg = __expf(gci), ekd = __expf(gcl - gci); u32x4 wqd;
#pragma unroll
        for (int j = 0; j < 4; ++j) wqd[j] = pk2(q[h2][2 * j] * eg, q[h2][2 * j + 1] * eg);
        *(LAS u32x4*)(P1 + i * TLD + 8 * p) = wqd;
#pragma unroll
        for (int j = 0; j < 8; ++j) { const int d = 8 * p + j; P0[d * TLD + (i ^ tsw(d))] = (bf16_t)(pk2(k[h2][j] * ekd, 0.f) & 0xffffu); } }
    __syncthreads();
    { const int hh = lane >> 5, rr = lane & 31;
        if (wg == 0) {
#pragma unroll
            for (int t4 = 0; t4 < 4; ++t4) { const int mtb = t4 >> 1, nta = t4 & 1; const f32x16 a = mm_tile<true, true>(WT, P0, 32 * mtb, 32 * nta, lane);
                f32x16 na; for (int r = 0; r < 16; ++r) na[r] = -a[r];
                *(bf16x8*)(G + (size_t)((nta * 4 + 2 * mtb) * 64 + lane) * 16) = pack8<0>(na); *(bf16x8*)(G + (size_t)((nta * 4 + 2 * mtb + 1) * 64 + lane) * 16) = pack8<1>(na); }
        } else if (wg == 1) {
#pragma unroll
            for (int t4 = 0; t4 < 4; ++t4) { const int mta = t4 >> 1, nte = t4 & 1; const f32x16 a = mm_tile<true, true>(P0, UT, 32 * mta, 32 * nte, lane);
                bf16x8* dp = (bf16x8*)(G + 8192 + (size_t)((nte * 2 + mta) * 64 + lane) * 32); dp[0] = pack8<0>(a); dp[1] = pack8<1>(a); }
        } else if (wg == 2) {
#pragma unroll
            for (int t4 = 0; t4 < 4; ++t4) { const int mtb = t4 >> 1, nti = t4 & 1; const f32x16 a = mm_tile<true, false>(WT, INTRA, 32 * mtb, 32 * nti, lane);
                f32x16 qe; const LAS bf16_t* qd = P1 + (32 * nti + rr) * TLD + 32 * mtb + 4 * hh;
#pragma unroll
                for (int g = 0; g < 4; ++g) { const u32x2 w = *(const LAS u32x2*)(qd + 8 * g); qe[4 * g] = bflo(w.x) - a[4 * g]; qe[4 * g + 1] = bfhi(w.x) - a[4 * g + 1]; qe[4 * g + 2] = bflo(w.y) - a[4 * g + 2]; qe[4 * g + 3] = bfhi(w.y) - a[4 * g + 3]; }
                *(bf16x8*)(G + 16384 + (size_t)((nti * 4 + 2 * mtb) * 64 + lane) * 16) = pack8<0>(qe); *(bf16x8*)(G + 16384 + (size_t)((nti * 4 + 2 * mtb + 1) * 64 + lane) * 16) = pack8<1>(qe); }
        } else {
#pragma unroll
            for (int t4 = 0; t4 < 4; ++t4) { const int mti = t4 >> 1, nte = t4 & 1; const f32x16 a = mm_tile<false, true>(INTRA, UT, 32 * mti, 32 * nte, lane);
                bf16_t* dst = (bf16_t*)(G + 24576) + (size_t)(32 * nte + rr) * 64 + 32 * mti + 4 * hh;
#pragma unroll
                for (int g = 0; g < 4; ++g) { u32x2 w; w.x = pk2(a[4 * g], a[4 * g + 1]); w.y = pk2(a[4 * g + 2], a[4 * g + 3]); *(u32x2*)(dst + 8 * g) = w; } }
            if (lane == 0) *(float*)(G + 40960) = __expf(gcl);
        } }
    __syncthreads();
}

DI void pv_accum(const f32x16 (&acc)[2][2], f32x16 (&o)[2][2], const LAS bf16_t* Vt, int lane) {
    const int r = lane & 31, hh = lane >> 5;
#pragma unroll
    for (int mt = 0; mt < 2; ++mt) {
        {   const bf16x8 p0 = pack8<0>(acc[mt][0]), p1 = pack8<0>(acc[mt][1]);
#pragma unroll
            for (int mo = 0; mo < 2; ++mo) { const LAS bf16_t* s = Vt + (32 * mo + r) * TLD; const int c0 = (32 * mt + 4 * hh) ^ tsw(32 * mo + r);
                const u32x2 lo = *(const LAS u32x2*)(s + c0), hi = *(const LAS u32x2*)(s + (c0 ^ 8)); u32x4 w; w.x = lo.x; w.y = lo.y; w.z = hi.x; w.w = hi.y; const bf16x8 vf = __builtin_bit_cast(bf16x8, w);
                o[mo][0] = MFMA32(vf, p0, o[mo][0]); o[mo][1] = MFMA32(vf, p1, o[mo][1]); } }
        {   const bf16x8 p0 = pack8<1>(acc[mt][0]), p1 = pack8<1>(acc[mt][1]);
#pragma unroll
            for (int mo = 0; mo < 2; ++mo) { const LAS bf16_t* s = Vt + (32 * mo + r) * TLD; const int c0 = (32 * mt + 16 + 4 * hh) ^ tsw(32 * mo + r);
                const u32x2 lo = *(const LAS u32x2*)(s + c0), hi = *(const LAS u32x2*)(s + (c0 ^ 8)); u32x4 w; w.x = lo.x; w.y = lo.y; w.z = hi.x; w.w = hi.y; const bf16x8 vf = __builtin_bit_cast(bf16x8, w);
                o[mo][0] = MFMA32(vf, p0, o[mo][0]); o[mo][1] = MFMA32(vf, p1, o[mo][1]); } }
    }
}
template <class F> DI void stage_vt(LAS bf16_t* Vt, int lane, F vrow) {
#pragma unroll
    for (int it = 0; it < 8; ++it) { const int id = it * 64 + lane, key = id >> 3, part = id & 7;
        const u32x4 w = *(const u32x4*)(vrow(key) + 8 * part);
#pragma unroll
        for (int j = 0; j < 4; ++j) { const int d0 = 8 * part + 2 * j, ks_ = key ^ tsw(d0); Vt[d0 * TLD + ks_] = (bf16_t)(w[j] & 0xffffu); Vt[(d0 + 1) * TLD + ks_] = (bf16_t)(w[j] >> 16); } }
}
DI void write_o_slot(LAS float* SL, const f32x16 (&o)[2][2], int lane) {
    const int r = lane & 31, hh = lane >> 5;
#pragma unroll
    for (int mo = 0; mo < 2; ++mo)
#pragma unroll
        for (int nt = 0; nt < 2; ++nt)
#pragma unroll
            for (int g = 0; g < 4; ++g) { f32x4 v; v[0] = o[mo][nt][4 * g]; v[1] = o[mo][nt][4 * g + 1]; v[2] = o[mo][nt][4 * g + 2]; v[3] = o[mo][nt][4 * g + 3];
                *(LAS f32x4*)(SL + (32 * nt + r) * 68 + 32 * mo + 8 * g + 4 * hh) = v; }
}
DI void add_o_slot(const LAS float* SL, f32x16 (&o)[2][2], int lane) {
    const int r = lane & 31, hh = lane >> 5;
#pragma unroll
    for (int mo = 0; mo < 2; ++mo)
#pragma unroll
        for (int nt = 0; nt < 2; ++nt)
#pragma unroll
            for (int g = 0; g < 4; ++g) { const f32x4 v = *(const LAS f32x4*)(SL + (32 * nt + r) * 68 + 32 * mo + 8 * g + 4 * hh);
                o[mo][nt][4 * g] += v[0]; o[mo][nt][4 * g + 1] += v[1]; o[mo][nt][4 * g + 2] += v[2]; o[mo][nt][4 * g + 3] += v[3]; }
}

constexpr int WAREA = 10240;
DI void osm_update(f32x16 (&acc)[2][2], f32x16 (&o)[2][2], float (&m)[2], float (&l)[2]) {
#pragma unroll
    for (int nt = 0; nt < 2; ++nt) { float mx = -1e30f;
#pragma unroll
        for (int mt = 0; mt < 2; ++mt)
#pragma unroll
            for (int g = 0; g < 16; ++g) mx = fmaxf(mx, acc[mt][nt][g]);
        mx = fmaxf(mx, __shfl_xor(mx, 32));
        const float mn = fmaxf(m[nt], mx), sc = __expf(m[nt] - mn); float sm = 0.f;
#pragma unroll
        for (int mt = 0; mt < 2; ++mt)
#pragma unroll
            for (int g = 0; g < 16; ++g) { const float pz = __expf(acc[mt][nt][g] - mn); acc[mt][nt][g] = pz; sm += pz; }
        sm += __shfl_xor(sm, 32);
        l[nt] = l[nt] * sc + sm; m[nt] = mn;
#pragma unroll
        for (int g = 0; g < 16; ++g) { o[0][nt][g] *= sc; o[1][nt][g] *= sc; } }
}
template <class F> DI void store_o_rows(LAS bf16_t* T, const f32x16 (&o)[2][2], const float (&scale)[2], int lane, F rowp) {
    const int r = lane & 31, hh = lane >> 5;
#pragma unroll
    for (int mo = 0; mo < 2; ++mo)
#pragma unroll
        for (int nt = 0; nt < 2; ++nt)
#pragma unroll
            for (int g = 0; g < 4; ++g) { u32x2 w; w.x = pk2(o[mo][nt][4 * g] * scale[nt], o[mo][nt][4 * g + 1] * scale[nt]); w.y = pk2(o[mo][nt][4 * g + 2] * scale[nt], o[mo][nt][4 * g + 3] * scale[nt]);
                *(LAS u32x2*)(T + (32 * nt + r) * TLD + 32 * mo + 8 * g + 4 * hh) = w; }
    asm volatile("s_waitcnt lgkmcnt(0)" ::: "memory");
#pragma unroll
    for (int it = 0; it < 8; ++it) { const int id = it * 64 + lane, q = id >> 3, part = id & 7; *(u32x4*)(rowp(q) + 8 * part) = *(const LAS u32x4*)(T + q * TLD + 8 * part); }
    asm volatile("s_waitcnt lgkmcnt(0)" ::: "memory");
}
DI void na_wave_unit(KArgs args, LAS unsigned char* L, const Ctx& c, int u, int lane, int wave) {
    const int l = c.layer, head = u & 3, gr = u >> 2, rows = c.seqlen >> 6, seq = gr / rows, r = gr % rows;
    int rs = r - 4; rs = rs < 0 ? 0 : (rs > rows - 8 ? rows - 8 : rs);
    const bf16_t* PROJ = BIGP(bf16_t, B_PROJ);
    const size_t tq0 = (size_t)seq * c.seqlen + (size_t)r * 64;
    LAS bf16_t* Vt = (LAS bf16_t*)(L + wave * WAREA);
    LAS float* BIAS = (LAS float*)(L + wave * WAREA + 9216);
    const int rr = lane & 31, hh = lane >> 5;
#pragma unroll
    for (int w = 0; w < 4; ++w) { const int idx = w * 64 + lane, kw = idx >> 5, dc = idx & 31;
        if (dc < 31) BIAS[idx] = args->in[3][(((size_t)l * 4 + head) * 15 + (rs + kw - r + 7)) * 31 + dc]; }
    bf16x8 qf[2][4];
#pragma unroll
    for (int nt = 0; nt < 2; ++nt)
#pragma unroll
        for (int ks = 0; ks < 4; ++ks) qf[nt][ks] = *(const bf16x8*)(PROJ + (tq0 + 32 * nt + rr) * NPROJ + C_QA + 64 * head + 16 * ks + 8 * hh);
    f32x16 o[2][2]; o[0][0] = zero16(); o[0][1] = zero16(); o[1][0] = zero16(); o[1][1] = zero16();
    float m[2] = {-1e30f, -1e30f}, ls[2] = {0.f, 0.f};
    for (int w = 0; w < 8; ++w) {
        const size_t tk0 = (size_t)seq * c.seqlen + (size_t)(rs + w) * 64;
        asm volatile("s_waitcnt lgkmcnt(0)" ::: "memory");
        stage_vt(Vt, lane, [&](int key) { return PROJ + (tk0 + key) * NPROJ + C_VA + 64 * head; });
        f32x16 acc[2][2]; acc[0][0] = zero16(); acc[0][1] = zero16(); acc[1][0] = zero16(); acc[1][1] = zero16();
#pragma unroll
        for (int mt = 0; mt < 2; ++mt)
#pragma unroll
            for (int ks = 0; ks < 4; ++ks) { const bf16x8 kf = *(const bf16x8*)(PROJ + (tk0 + 32 * mt + rr) * NPROJ + C_KA + 64 * head + 16 * ks + 8 * hh);
                acc[mt][0] = MFMA32(kf, qf[0][ks], acc[mt][0]); acc[mt][1] = MFMA32(kf, qf[1][ks], acc[mt][1]); }
        asm volatile("s_waitcnt lgkmcnt(0)" ::: "memory");
        const LAS float* brow = BIAS + w * 32;
#pragma unroll
        for (int nt = 0; nt < 2; ++nt) { const int qc = 32 * nt + rr; int ws = qc - 8; ws = ws < 0 ? 0 : (ws > 48 ? 48 : ws);
#pragma unroll
            for (int mt = 0; mt < 2; ++mt)
#pragma unroll
                for (int g = 0; g < 16; ++g) { const int kc = 32 * mt + crow(g, hh); const bool ok = (kc >= ws) && (kc < ws + 16);
                    acc[mt][nt][g] = ok ? acc[mt][nt][g] * 0.125f + brow[ok ? (kc - qc + 15) : 0] : -1e30f; } }
        osm_update(acc, o, m, ls);
        pv_accum(acc, o, Vt, lane);
    }
    asm volatile("s_waitcnt lgkmcnt(0)" ::: "memory");
    const float sc[2] = {frcp(ls[0]), frcp(ls[1])};
    store_o_rows(Vt, o, sc, lane, [&](int q) { return BIGP(bf16_t, B_ONA) + (tq0 + q) * 768 + 64 * head; });
}
DI void rope_frag4(bf16x8 (&f)[4], const float* cs, int hh) {
#pragma unroll
    for (int ks = 0; ks < 2; ++ks) { const float* cp = cs + 16 * ks + 8 * hh;
        const f32x4 c0 = *(const f32x4*)cp, c1 = *(const f32x4*)(cp + 4), s0 = *(const f32x4*)(cp + 32), s1 = *(const f32x4*)(cp + 36);
        const u32x4 a = __builtin_bit_cast(u32x4, f[ks]), b = __builtin_bit_cast(u32x4, f[ks + 2]); u32x4 ra, rb;
#pragma unroll
        for (int j = 0; j < 4; ++j) { const float cl = (j < 2) ? c0[2 * j] : c1[2 * j - 4], ch = (j < 2) ? c0[2 * j + 1] : c1[2 * j - 3];
            const float sl = (j < 2) ? s0[2 * j] : s1[2 * j - 4], sh = (j < 2) ? s0[2 * j + 1] : s1[2 * j - 3];
            const float x1l = bflo(a[j]), x1h = bfhi(a[j]), x2l = bflo(b[j]), x2h = bfhi(b[j]);
            ra[j] = pk2(x1l * cl - x2l * sl, x1h * ch - x2h * sh); rb[j] = pk2(x1l * sl + x2l * cl, x1h * sh + x2h * ch); }
        f[ks] = __builtin_bit_cast(bf16x8, ra); f[ks + 2] = __builtin_bit_cast(bf16x8, rb); }
}
DI void dil_wave_unit(KArgs args, LAS unsigned char* L, const Ctx& c, int u, int lane, int wave) {
    const int hd = u & 1, uu = u >> 1, upg = c.stok >> 6, g = uu / upg, v = uu % upg, ups = c.seqlen >> 6, seq = v / ups, wq = v % ups;
    const int dsh = 2 * g, dd = 1 << dsh, nb = ups >> dsh, cls = wq / nb, jb = wq % nb, head = 2 * g + hd;
    const bf16_t* PROJ = BIGP(bf16_t, B_PROJ); const float* CS = WSP(float, WS_CS);
    const size_t sb = (size_t)seq * c.seqlen;
    const int rr = lane & 31, hh = lane >> 5;
    LAS bf16_t* Vt = (LAS bf16_t*)(L + wave * WAREA);
    bf16x8 qf[2][4];
#pragma unroll
    for (int nt = 0; nt < 2; ++nt) { const int pos = cls + dd * (64 * jb + 32 * nt + rr);
#pragma unroll
        for (int ks = 0; ks < 4; ++ks) qf[nt][ks] = *(const bf16x8*)(PROJ + (sb + pos) * NPROJ + C_QD + 64 * head + 16 * ks + 8 * hh);
        rope_frag4(qf[nt], CS + (size_t)pos * 64, hh); }
    f32x16 o[2][2]; o[0][0] = zero16(); o[0][1] = zero16(); o[1][0] = zero16(); o[1][1] = zero16();
    float m[2] = {-1e30f, -1e30f}, ls[2] = {0.f, 0.f};
    for (int kt = 0; kt < 3; ++kt) { const int kj = jb - 1 + kt;
        if (kj < 0 || kj >= nb) continue;
        asm volatile("s_waitcnt lgkmcnt(0)" ::: "memory");
        stage_vt(Vt, lane, [&](int key) { return PROJ + (sb + cls + (size_t)dd * (64 * kj + key)) * NPROJ + C_VD + 64 * head; });
        f32x16 acc[2][2]; acc[0][0] = zero16(); acc[0][1] = zero16(); acc[1][0] = zero16(); acc[1][1] = zero16();
#pragma unroll
        for (int mt = 0; mt < 2; ++mt) { const int pos = cls + dd * (64 * kj + 32 * mt + rr); bf16x8 kf[4];
#pragma unroll
            for (int ks = 0; ks < 4; ++ks) kf[ks] = *(const bf16x8*)(PROJ + (sb + pos) * NPROJ + C_KD + 64 * head + 16 * ks + 8 * hh);
            rope_frag4(kf, CS + (size_t)pos * 64, hh);
#pragma unroll
            for (int ks = 0; ks < 4; ++ks) { acc[mt][0] = MFMA32(kf[ks], qf[0][ks], acc[mt][0]); acc[mt][1] = MFMA32(kf[ks], qf[1][ks], acc[mt][1]); } }
#pragma unroll
        for (int nt = 0; nt < 2; ++nt) { const int qc = 32 * nt + rr;
#pragma unroll
            for (int mt = 0; mt < 2; ++mt)
#pragma unroll
                for (int gg = 0; gg < 16; ++gg) { const int kc = 32 * mt + crow(gg, hh); const bool ok = (kt == 1) || (kt == 0 ? (kc >= qc) : (kc <= qc));
                    acc[mt][nt][gg] = ok ? acc[mt][nt][gg] * 0.125f : -1e30f; } }
        osm_update(acc, o, m, ls);
        pv_accum(acc, o, Vt, lane);
    }
    asm volatile("s_waitcnt lgkmcnt(0)" ::: "memory");
    bf16_t* DP = BIGP(bf16_t, B_DILP); float* DM = BIGP(float, B_DILM);
    const float one[2] = {1.f, 1.f};
    store_o_rows(Vt, o, one, lane, [&](int q) { return DP + ((((size_t)g * SLABMAX + sb + cls + (size_t)dd * (64 * jb + q)) * 2 + hd)) * 64; });
    if (hh == 0) {
#pragma unroll
        for (int nt = 0; nt < 2; ++nt) { const size_t base = (((size_t)g * SLABMAX + sb + cls + (size_t)dd * (64 * jb + 32 * nt + rr)) * 2 + hd); DM[base * 2] = m[nt]; DM[base * 2 + 1] = ls[nt]; } }
}

DI void phase_mix_a(KArgs args, LAS unsigned char* L, const Ctx& c) {
    const int N_PREP = (c.stok >> 6) * 6;
    for (int u = c.bid; u < N_PREP; u += c.G) gdn_prep_pair(args, L, c, u);
}
DI void attn_wave_units(KArgs args, LAS unsigned char* L, const Ctx& c) {
    int tid = c.tid; asm volatile("" : "+v"(tid)); const int lane = tid & 63, wave = __builtin_amdgcn_readfirstlane(tid >> 6);
    const int nch_ = c.stok >> 6, N_NA = nch_ * 4, N_DIL = nch_ * 6;
    unsigned* q = (unsigned*)(c.ws + WS_CTL) + 32768 + 128 * (c.layer * 4 + c.slab);
    for (;;) { unsigned u = 0; if (lane == 0) u = __hip_atomic_fetch_add(q, 1u, __ATOMIC_RELAXED, __HIP_MEMORY_SCOPE_AGENT);
        u = (unsigned)__builtin_amdgcn_readfirstlane((int)u); if (u >= (unsigned)N_NA) break; na_wave_unit(args, L, c, (int)u, lane, wave); }
    int tid2 = c.tid; asm volatile("" : "+v"(tid2)); const int lane2 = tid2 & 63, wave2 = __builtin_amdgcn_readfirstlane(tid2 >> 6);
    for (;;) { unsigned u = 0; if (lane2 == 0) u = __hip_atomic_fetch_add(q + 64, 1u, __ATOMIC_RELAXED, __HIP_MEMORY_SCOPE_AGENT);
        u = (unsigned)__builtin_amdgcn_readfirstlane((int)u); if (u >= (unsigned)N_DIL) break; dil_wave_unit(args, L, c, (int)u, lane2, wave2); }
}

DI void phase_select(KArgs args, LAS unsigned char* L, const Ctx& c, int inst);
DI void phase_scan(KArgs args, LAS unsigned char* L, const Ctx& c) {
    if (c.slab == NSLAB - 1 && c.bid >= 24 && c.bid < 40) { phase_select(args, L, c, c.bid - 24); return; }
    const int nwu = c.nseq * 24, wu = c.bid;
    if (wu < nwu && c.wave == 0) {
        const int lane = c.lane, rr = lane & 31, hh = lane >> 5;
        const int chain = wu >> 1, nt = wu & 1, seq = chain / 12, rem = chain % 12, head = rem >> 1, dir = rem & 1;
        const int nch = c.seqlen >> 6, gch0 = seq * nch;
        unsigned char* GS = BIGP(unsigned char, B_GSCR);
        f32x16 S[2]; S[0] = zero16(); S[1] = zero16();
        bf16x8 A[2][2][4]; u32x4 cm[2][2][2]; float gl[2];
        const long gstep = (long)(dir ? -1 : 1) * 12 * GSTRIDE;
        const unsigned char* Gp = GS + (size_t)(((gch0 + (dir ? nch - 1 : 0)) * 6 + head) * 2 + dir) * GSTRIDE;
        unsigned char* Gs = (unsigned char*)Gp;
#define SCAN_LOAD(B) do { _Pragma("unroll") for (int mt = 0; mt < 2; ++mt) { _Pragma("unroll") for (int ks = 0; ks < 4; ++ks) A[B][mt][ks] = *(const bf16x8*)(Gp + (size_t)((mt * 4 + ks) * 64 + lane) * 16); \
            const u32x4* cp = (const u32x4*)(Gp + 8192 + (size_t)((nt * 2 + mt) * 64 + lane) * 32); cm[B][mt][0] = cp[0]; cm[B][mt][1] = cp[1]; } gl[B] = *(const float*)(Gp + 40960); } while (0)
#define SCAN_STEP(B) do { { bf16_t* St = (bf16_t*)(Gs + 32768) + (size_t)(32 * nt + rr) * 64 + 4 * hh; \
            _Pragma("unroll") for (int mt = 0; mt < 2; ++mt) _Pragma("unroll") for (int g = 0; g < 4; ++g) { u32x2 w; w.x = pk2(S[mt][4 * g], S[mt][4 * g + 1]); w.y = pk2(S[mt][4 * g + 2], S[mt][4 * g + 3]); *(u32x2*)(St + 32 * mt + 8 * g) = w; } } \
            const bf16x8 b0 = pack8<0>(S[0]), b1 = pack8<1>(S[0]), b2 = pack8<0>(S[1]), b3 = pack8<1>(S[1]); f32x16 nw[2]; \
            _Pragma("unroll") for (int mt = 0; mt < 2; ++mt) { \
                _Pragma("unroll") for (int g = 0; g < 8; ++g) { const unsigned wv = (g < 4) ? cm[B][mt][0][g] : cm[B][mt][1][g - 4]; nw[mt][2 * g] = gl[B] * S[mt][2 * g] + bflo(wv); nw[mt][2 * g + 1] = gl[B] * S[mt][2 * g + 1] + bfhi(wv); } \
                nw[mt] = MFMA32(A[B][mt][0], b0, nw[mt]); nw[mt] = MFMA32(A[B][mt][1], b1, nw[mt]); nw[mt] = MFMA32(A[B][mt][2], b2, nw[mt]); nw[mt] = MFMA32(A[B][mt][3], b3, nw[mt]); } \
            S[0] = nw[0]; S[1] = nw[1]; Gs += gstep; } while (0)
        SCAN_LOAD(0); Gp += gstep; SCAN_LOAD(1); Gp += gstep;
        for (int step = 0; step < nch; step += 2) {
            const bool more = step + 2 < nch;
            if (!more) Gp -= 2 * gstep;
            SCAN_STEP(0); SCAN_LOAD(0); Gp += gstep;
            SCAN_STEP(1); SCAN_LOAD(1); Gp += gstep;
        }
#undef SCAN_LOAD
#undef SCAN_STEP
    }
    attn_wave_units(args, L, c);
}

DI void dil_merge(const Ctx& c) {
    { const bf16_t* DP = BIGP(bf16_t, B_DILP); const float* DM = BIGP(float, B_DILM); bf16_t* OD = BIGP(bf16_t, B_ONA) + 256;
        for (int it = c.bid * 512 + c.tid; it < c.stok * 32; it += c.G * 512) { const int tok = it >> 5, part = it & 31;
            u32x4 w = {0u, 0u, 0u, 0u};
            if (part < 16) { const int hd = part >> 3, p = part & 7; float m[3], dn[3];
#pragma unroll
                for (int g = 0; g < 3; ++g) { const size_t b = (((size_t)g * SLABMAX + tok) * 2 + hd); m[g] = DM[b * 2]; dn[g] = DM[b * 2 + 1]; }
                const float M = fmaxf(m[0], fmaxf(m[1], m[2])); float num[8], den = 0.f;
#pragma unroll
                for (int j = 0; j < 8; ++j) num[j] = 0.f;
#pragma unroll
                for (int g = 0; g < 3; ++g) { const float f = __expf(m[g] - M); den += f * dn[g]; const u32x4 a = *(const u32x4*)(DP + (((size_t)g * SLABMAX + tok) * 2 + hd) * 64 + 8 * p);
                    num[0] += f * bflo(a[0]); num[1] += f * bfhi(a[0]); num[2] += f * bflo(a[1]); num[3] += f * bfhi(a[1]); num[4] += f * bflo(a[2]); num[5] += f * bfhi(a[2]); num[6] += f * bflo(a[3]); num[7] += f * bfhi(a[3]); }
                const float inv = frcp(den);
                w.x = pk2(num[0] * inv, num[1] * inv); w.y = pk2(num[2] * inv, num[3] * inv); w.z = pk2(num[4] * inv, num[5] * inv); w.w = pk2(num[6] * inv, num[7] * inv); }
            if (part < 16) *(u32x4*)(OD + (size_t)tok * 768 + 8 * part) = w; } }
}

DI void phase_gdn_out(KArgs args, LAS unsigned char* L, const Ctx& c) {
    dil_merge(c);
    const int lane = c.lane, wave = c.wave, tid = c.tid, l = c.layer;
    const bf16_t* PROJ = BIGP(bf16_t, B_PROJ); unsigned char* GS = BIGP(unsigned char, B_GSCR); bf16_t* OG = BIGP(bf16_t, B_ONA) + 384;
    LAS float* OF = (LAS float*)L;
    for (int u = c.bid; u < (c.stok >> 6) * 6; u += c.G) { const int gch = u / 6, head = u % 6;
        { const int dir = wave >> 2, mt = (wave >> 1) & 1, nt = wave & 1, rr = lane & 31, hh = lane >> 5;
            const unsigned char* G = GS + (size_t)((gch * 6 + head) * 2 + dir) * GSTRIDE;
            const bf16_t* Qe = (const bf16_t*)(G + 16384); const bf16_t* Oct = (const bf16_t*)(G + 24576); const bf16_t* St = (const bf16_t*)(G + 32768);
            f32x16 acc = zero16();
#pragma unroll
            for (int ks = 0; ks < 4; ++ks) { const bf16x8 a = *(const bf16x8*)(Qe + (size_t)((mt * 4 + ks) * 64 + lane) * 8);
                const bf16_t* sp = St + (32 * nt + rr) * 64 + 32 * (ks >> 1) + 16 * (ks & 1) + 4 * hh; const u32x2 lo = *(const u32x2*)sp, hi = *(const u32x2*)(sp + 8);
                u32x4 bw; bw.x = lo.x; bw.y = lo.y; bw.z = hi.x; bw.w = hi.y; acc = MFMA32(a, __builtin_bit_cast(bf16x8, bw), acc); }
            const int e = 32 * nt + rr;
#pragma unroll
            for (int g = 0; g < 4; ++g) { const u32x2 w = *(const u32x2*)(Oct + e * 64 + 32 * mt + 8 * g + 4 * hh);
                const float v0 = acc[4 * g] + bflo(w.x), v1 = acc[4 * g + 1] + bfhi(w.x), v2 = acc[4 * g + 2] + bflo(w.y), v3 = acc[4 * g + 3] + bfhi(w.y);
                const int i0 = 32 * mt + 8 * g + 4 * hh;
#pragma unroll
                for (int j = 0; j < 4; ++j) { const int ii = i0 + j, tl = dir ? 63 - ii : ii; OF[(dir * 64 + tl) * 68 + e] = (j == 0) ? v0 : (j == 1) ? v1 : (j == 2) ? v2 : v3; } } }
        __syncthreads();
        { const int i = tid >> 3, p = tid & 7; const size_t tok = (size_t)gch * 64 + i;
            const LAS float* a = OF + i * 68 + 8 * p; const LAS float* b = OF + (64 + i) * 68 + 8 * p;
            float ov[8]; float ss = 0.f;
#pragma unroll
            for (int j = 0; j < 8; ++j) { ov[j] = a[j] + b[j]; ss += ov[j] * ov[j]; }
            ss += __shfl_xor(ss, 1); ss += __shfl_xor(ss, 2); ss += __shfl_xor(ss, 4);
            const float rs = frsq(ss * (1.0f / 64.0f) + NORM_EPS);
            const u32x4 zw = *(const u32x4*)(PROJ + tok * NPROJ + C_ZC + 64 * head + 8 * p);
            const float* nw = args->in[7] + l * 64 + 8 * p;
            float r[8];
#pragma unroll
            for (int j = 0; j < 4; ++j) { r[2 * j] = ov[2 * j] * rs * nw[2 * j] * siluf_(bflo(zw[j])); r[2 * j + 1] = ov[2 * j + 1] * rs * nw[2 * j + 1] * siluf_(bfhi(zw[j])); }
            u32x4 w; w.x = pk2(r[0], r[1]); w.y = pk2(r[2], r[3]); w.z = pk2(r[4], r[5]); w.w = pk2(r[6], r[7]);
            *(u32x4*)(OG + tok * 768 + 64 * head + 8 * p) = w; }
        __syncthreads();
    }
}

DI void phase_ln1(KArgs args, LAS unsigned char* L, const Ctx& c) {
    const int lane = c.lane, l = c.layer;
    LAS float* WR = (LAS float*)L;
    { const float* wr = args->in[14] + (size_t)l * D * 16;
        for (int i = c.tid; i < D * 16; i += 512) { const int col = i >> 4, e = i & 15, j = col >> 8, ln = (col >> 2) & 63, q = col & 3; WR[((j * 4 + q) * 64 + ln) * 20 + e] = wr[i]; } }
    __syncthreads();
    const float* g1 = args->in[12] + l * D; const float* b1 = args->in[13] + l * D;
    f32x4 gv[4], bv[4];
#pragma unroll
    for (int j = 0; j < 4; ++j) { gv[j] = *(const f32x4*)(g1 + 4 * lane + 256 * j); bv[j] = *(const f32x4*)(b1 + 4 * lane + 256 * j); }
    float* AFF = WSP(float, WS_AFF); int* SLOT = WSP(int, WS_SLOT); bf16_t* XB = WSP(bf16_t, WS_XB);
    f32x4 nv[4];
    { const int rl0 = c.bid * 8 + c.wave; if (rl0 < c.stok) { const float* hp = c.out + ((size_t)c.sbase + rl0) * D;
#pragma unroll
        for (int j = 0; j < 4; ++j) nv[j] = *(const f32x4*)(hp + 4 * lane + 256 * j); } }
    for (int rl = c.bid * 8 + c.wave; rl < c.stok; rl += c.G * 8) { const size_t tok = (size_t)c.sbase + rl;
        float* hr = c.out + tok * D; f32x4 v[4]; float s = 0.f;
#pragma unroll
        for (int j = 0; j < 4; ++j) { v[j] = nv[j]; s += (v[j][0] + v[j][1]) + (v[j][2] + v[j][3]); }
        if (rl + c.G * 8 < c.stok) { const float* hp = hr + (size_t)c.G * 8 * D;
#pragma unroll
            for (int j = 0; j < 4; ++j) nv[j] = *(const f32x4*)(hp + 4 * lane + 256 * j); }
        const float mean = wave_sum(s) * (1.0f / D); float s2 = 0.f;
#pragma unroll
        for (int j = 0; j < 4; ++j) { v[j] = v[j] - mean; s2 += (v[j][0] * v[j][0] + v[j][1] * v[j][1]) + (v[j][2] * v[j][2] + v[j][3] * v[j][3]); }
        const float rstd = frsq(wave_sum(s2) * (1.0f / D) + LN_EPS);
        float lg[16];
#pragma unroll
        for (int e = 0; e < 16; ++e) lg[e] = 0.f;
#pragma unroll
        for (int j = 0; j < 4; ++j) { v[j] = v[j] * rstd * gv[j] + bv[j];
            if (!c.dry) { *(f32x4*)(hr + 4 * lane + 256 * j) = v[j];
            u32x2 w; w.x = pk2(v[j][0], v[j][1]); w.y = pk2(v[j][2], v[j][3]); *(u32x2*)(XB + tok * D + 4 * lane + 256 * j) = w; }
#pragma unroll
            for (int q = 0; q < 4; ++q) { const LAS float* wp = WR + ((j * 4 + q) * 64 + lane) * 20; const float xv = v[j][q];
#pragma unroll
                for (int e4 = 0; e4 < 4; ++e4) { const f32x4 w4 = *(const LAS f32x4*)(wp + 4 * e4); lg[4 * e4] += xv * w4[0]; lg[4 * e4 + 1] += xv * w4[1]; lg[4 * e4 + 2] += xv * w4[2]; lg[4 * e4 + 3] += xv * w4[3]; } }
            asm volatile("" ::: "memory"); }
        float mx = -1e30f;
#pragma unroll
        for (int e = 0; e < 16; ++e) { lg[e] = wave_sum(lg[e]); mx = fmaxf(mx, lg[e]); }
        float den = 0.f;
#pragma unroll
        for (int e = 0; e < 16; ++e) { lg[e] = expf(lg[e] - mx); den += lg[e]; }
        float mine = 0.f;
#pragma unroll
        for (int e = 0; e < 16; ++e) mine = (lane == e) ? lg[e] : mine;
        if (lane < 16 && !c.dry) { AFF[(size_t)lane * T_ALL + tok] = mine / den; SLOT[tok * 16 + lane] = -1; }
    }
}
DI void phase_ln2(KArgs args, LAS unsigned char* L, const Ctx& c) {
    const int lane = c.lane, l = c.layer;
    const float* g2 = args->in[18] + l * D; const float* b2 = args->in[19] + l * D;
    f32x4 gv[4], bv[4];
#pragma unroll
    for (int j = 0; j < 4; ++j) { gv[j] = *(const f32x4*)(g2 + 4 * lane + 256 * j); bv[j] = *(const f32x4*)(b2 + 4 * lane + 256 * j); }
    const int* SLOT = WSP(int, WS_SLOT); bf16_t* XB = WSP(bf16_t, WS_XB);
    f32x4 nv[4]; int nsv = -1;
    { const int t0 = c.bid * 8 + c.wave; if (t0 < T_ALL) { const float* xp = c.out + (size_t)t0 * D; nsv = SLOT[(size_t)t0 * 16 + (lane & 15)];
#pragma unroll
        for (int j = 0; j < 4; ++j) nv[j] = *(const f32x4*)(xp + 4 * lane + 256 * j); } }
    for (int t = c.bid * 8 + c.wave; t < T_ALL; t += c.G * 8) { const size_t tok = (size_t)t;
        float* xr = c.out + tok * D; f32x4 v[4];
#pragma unroll
        for (int j = 0; j < 4; ++j) v[j] = nv[j] * ALPHA;
        const int sv = nsv;
        if (t + c.G * 8 < T_ALL) { const float* xp = xr + (size_t)c.G * 8 * D; nsv = SLOT[(tok + c.G * 8) * 16 + (lane & 15)];
#pragma unroll
            for (int j = 0; j < 4; ++j) nv[j] = *(const f32x4*)(xp + 4 * lane + 256 * j); }
#pragma unroll
        for (int e = 0; e < 16; ++e) { const int s = __builtin_amdgcn_readlane(sv, e);
            if (s >= 0) { const bf16_t* yr = BIGP(bf16_t, (e < 8 ? B_XY0 : B_XY1)) + ((size_t)(e & 7) * CAP + s) * D;
#pragma unroll
                for (int j = 0; j < 4; ++j) { const u32x2 w = *(const u32x2*)(yr + 4 * lane + 256 * j); v[j][0] += bflo(w.x); v[j][1] += bfhi(w.x); v[j][2] += bflo(w.y); v[j][3] += bfhi(w.y); } } }
        float s = 0.f;
#pragma unroll
        for (int j = 0; j < 4; ++j) s += (v[j][0] + v[j][1]) + (v[j][2] + v[j][3]);
        const float mean = wave_sum(s) * (1.0f / D); float s2 = 0.f;
#pragma unroll
        for (int j = 0; j < 4; ++j) { v[j] = v[j] - mean; s2 += (v[j][0] * v[j][0] + v[j][1] * v[j][1]) + (v[j][2] * v[j][2] + v[j][3] * v[j][3]); }
        const float rstd = frsq(wave_sum(s2) * (1.0f / D) + LN_EPS);
#pragma unroll
        for (int j = 0; j < 4; ++j) { v[j] = v[j] * rstd * gv[j] + bv[j];
            if (!c.dry) { *(f32x4*)(xr + 4 * lane + 256 * j) = v[j];
            u32x2 w; w.x = pk2(v[j][0], v[j][1]); w.y = pk2(v[j][2], v[j][3]); *(u32x2*)(XB + tok * D + 4 * lane + 256 * j) = w;
            *(unsigned*)(WSP(unsigned char, WS_XB8) + tok * D + 4 * lane + 256 * j) = pk4_fp8(v[j][0], v[j][1], v[j][2], v[j][3]); } }
    }
}

DI int block_excl_scan(int v, LAS int* tmp, int tid, int& total) {
    const int lane = tid & 63, wave = tid >> 6; int x = v;
#pragma unroll
    for (int o = 1; o < 64; o <<= 1) { const int y = __shfl_up(x, o); if (lane >= o) x += y; }
    __syncthreads();
    if (lane == 63) tmp[wave] = x;
    __syncthreads();
    int base = 0, tot = 0;
#pragma unroll
    for (int w = 0; w < 8; ++w) { const int tw = tmp[w]; if (w < wave) base += tw; tot += tw; }
    total = tot;
    return base + x - v;
}
DI void phase_select(KArgs args, LAS unsigned char* L, const Ctx& c, int inst) {
    if (inst < 0 || inst >= 32) return;
    const int tid = c.tid, grp = inst >> 4, e = inst & 15;
    const int n = grp ? T_S : T_P, t0 = grp ? T_P : 0, C = n >> 3, slot0 = grp ? CAP_P : 0;
    const unsigned* v = (const unsigned*)(WSP(float, WS_AFF) + (size_t)e * T_ALL + t0);
    LAS unsigned* hist = (LAS unsigned*)L; LAS int* sh = (LAS int*)(L + 1024); LAS int* tmp = (LAS int*)(L + 1024 + 64);
    unsigned prefix = 0u; int kk = C;
    for (int pass = 0; pass < 4; ++pass) { const int shift = 24 - 8 * pass; const unsigned mhi = pass == 0 ? 0u : (0xFFFFFFFFu << (shift + 8));
        if (tid < 256) hist[tid] = 0u;
        __syncthreads();
        for (int i = tid * 4; i < n; i += 512 * 16) {
            u32x4 x4[4];
#pragma unroll
            for (int k = 0; k < 4; ++k) x4[k] = *(const u32x4*)(v + i + k * 2048);
#pragma unroll
            for (int k = 0; k < 4; ++k)
#pragma unroll
                for (int j = 0; j < 4; ++j) { const unsigned x = x4[k][j]; if ((x & mhi) == prefix) __hip_atomic_fetch_add(&hist[(x >> shift) & 255u], 1u, __ATOMIC_RELAXED, __HIP_MEMORY_SCOPE_WORKGROUP); } }
        __syncthreads();
        if (tid == 0) { int cum = 0, sel = 0; for (int b = 255; b >= 0; --b) { const int h = (int)hist[b]; if (cum + h >= kk) { sel = b; break; } cum += h; } sh[0] = sel; sh[1] = kk - cum; }
        __syncthreads();
        prefix |= ((unsigned)sh[0]) << shift; kk = sh[1];
        __syncthreads();
    }
    const unsigned thr = prefix;
    const int per = n >> 9, i0 = tid * per;
    int ngt = 0, ntie = 0;
    for (int i = 0; i < per; i += 4) { const u32x4 x = *(const u32x4*)(v + i0 + i);
#pragma unroll
        for (int j = 0; j < 4; ++j) { ngt += (x[j] > thr); ntie += (x[j] == thr); } }
    int tot;
    const int tie_base = block_excl_scan(ntie, tmp, tid, tot);
    int take = kk - tie_base; take = take < 0 ? 0 : (take > ntie ? ntie : take);
    int pos = block_excl_scan(ngt + take, tmp, tid, tot);
    int* IDX = WSP(int, WS_IDX) + e * CAP + slot0;
    int tr = 0;
    for (int i = 0; i < per; i += 4) { const u32x4 x = *(const u32x4*)(v + i0 + i);
#pragma unroll
        for (int j = 0; j < 4; ++j) { bool s = x[j] > thr; if (x[j] == thr) { s = tr < take; ++tr; } if (s) { IDX[pos] = t0 + i0 + i + j; ++pos; } } }
}
DI void phase_gather(KArgs args, LAS unsigned char* L, const Ctx& c) {
    const int lane = c.lane; const int* IDX = WSP(int, WS_IDX); const bf16_t* XB = WSP(bf16_t, WS_XB);
    float* GATEV = WSP(float, WS_GATEV); int* SLOT = WSP(int, WS_SLOT); const float* AFF = WSP(float, WS_AFF);
    for (int row0 = (c.bid * 8 + c.wave) * 4; row0 < NE * CAP; row0 += c.G * 8 * 4) {
        const int e = row0 / CAP, s0 = row0 % CAP; int t[4]; u32x4 a[4], b[4];
#pragma unroll
        for (int k = 0; k < 4; ++k) t[k] = IDX[row0 + k];
#pragma unroll
        for (int k = 0; k < 4; ++k) { const u32x4* src = (const u32x4*)(XB + (size_t)t[k] * D) + 2 * lane; a[k] = src[0]; b[k] = src[1]; }
        u32x4* dst = (u32x4*)(BIGP(unsigned char, (e < 8 ? B_XY0 : B_XY1)) + ((size_t)(e & 7) * CAP + s0) * D);
#pragma unroll
        for (int k = 0; k < 4; ++k) { u32x4 w;
            w.x = pk4_fp8(bflo(a[k].x), bfhi(a[k].x), bflo(a[k].y), bfhi(a[k].y)); w.y = pk4_fp8(bflo(a[k].z), bfhi(a[k].z), bflo(a[k].w), bfhi(a[k].w));
            w.z = pk4_fp8(bflo(b[k].x), bfhi(b[k].x), bflo(b[k].y), bfhi(b[k].y)); w.w = pk4_fp8(bflo(b[k].z), bfhi(b[k].z), bflo(b[k].w), bfhi(b[k].w));
            dst[k * 64 + lane] = w; }
        if (lane < 4) { const int tt = (lane == 0) ? t[0] : (lane == 1) ? t[1] : (lane == 2) ? t[2] : t[3]; SLOT[(size_t)tt * 16 + e] = s0 + lane; GATEV[row0 + lane] = AFF[(size_t)e * T_ALL + tt]; } }
}

__global__ void __launch_bounds__(512, 2) fwd_kernel(Args args) {
    extern __shared__ __attribute__((aligned(16))) unsigned char lds_raw[];
    LAS unsigned char* L = (LAS unsigned char*)lds_raw;
    Ctx c;
    c.out = args.out; c.ws = args.ws;
    c.tid = threadIdx.x; c.lane = c.tid & 63; c.wave = __builtin_amdgcn_readfirstlane(c.tid >> 6); c.G = gridDim.x; c.bid = blockIdx.x;
    c.layer = 0; c.slab = 0; c.nseq = 8; c.seqlen = 4096; c.stok = 32768; c.sbase = 0; c.dry = 0;
    const int lo = args.ph_lo, hi = args.ph_hi;
    volatile LAS unsigned* MISC = (volatile LAS unsigned*)(L + LDS_MISC);
    if (c.tid < 4) MISC[c.tid] = 0u;
    __syncthreads();
    XcdBarrier bar; bar.bar = (unsigned*)(c.ws + WS_CTL) + 1024; bar.x = 0; bar.st = MISC;
    if (hi - lo > 1) bar = xcd_barrier_post((unsigned*)(c.ws + WS_CTL) + 1024, MISC);
    int pc = 0;
#ifndef PHMASK
#define PHMASK 0xFFFF
#endif
#define PHON(k) (((PHMASK) >> (k)) & 1)
#ifndef REPMASK
#define REPMASK 0x0
#endif
#define PH_BEGIN(k) if (PHON(k) && pc >= lo && pc < hi) { { int tz = threadIdx.x; asm volatile("" : "+v"(tz)); c.tid = tz; c.lane = tz & 63; c.wave = __builtin_amdgcn_readfirstlane(tz >> 6); } KArgs ka = kargs(); c.ws = ka->ws; c.out = ka->out; { int b_ = blockIdx.x, g_ = gridDim.x; asm volatile("" : "+s"(b_), "+s"(g_)); c.bid = b_; c.G = g_; } for (int rep_ = 0; rep_ < (((REPMASK) >> (k)) & 1) + 1; ++rep_) { if (rep_) __syncthreads(); c.dry = (rep_ + 1 < (((REPMASK) >> (k)) & 1) + 1);
#ifndef BARREP
#define BARREP 0
#endif
#define PH_END   } if (pc + 1 < hi) { xcd_barrier(bar); if (BARREP) { xcd_barrier(bar); xcd_barrier(bar); } } else { asm volatile("s_waitcnt vmcnt(0)" ::: "memory"); __syncthreads(); } } ++pc;

    for (int layer = 0; layer < 2; ++layer) {
        c.layer = layer;
        PH_BEGIN(0) phase_weights(ka, L, c); PH_END
        for (int slab = 0; slab < NSLAB; ++slab) {
            c.slab = slab; c.nseq = slab < 2 ? 8 : 1; c.seqlen = slab < 2 ? 4096 : 16384; c.stok = slab < 2 ? 32768 : 16384; c.sbase = slab * 32768; const int stok = c.stok; const size_t sbase = (size_t)c.sbase;
            PH_BEGIN(1) {
                { pg8::Gemm g{WSP(bf16_t, WS_XB) + sbase * D, WSP(bf16_t, WS_WIN), stok, 3584, D}; pg8::StaticOrder S; S.init(stok, 3584, c.G, c.bid);
                  pg8::EpiInProj E{BIGP(bf16_t, B_PROJ), BIGP(float, B_BA)};
                  pg8::gemm_phase<pg8::EpiInProj, pg8::StaticOrder>(L, g, S, E); }
                { pg8::Gemm g{(const bf16_t*)(WSP(unsigned char, WS_XB8) + sbase * D), (const bf16_t*)WSP(unsigned char, WS_WG8), stok, 3072, D / 2}; pg8::StaticOrder S; S.init(stok, 3072, c.G, c.bid);
                  pg8::EpiGates E{BIGP(bf16_t, B_PROJ)};
                  pg8::gemm_phase<pg8::EpiGates, pg8::StaticOrder>(L, g, S, E); } } PH_END
            PH_BEGIN(2) phase_mix_a(ka, L, c); PH_END
            PH_BEGIN(3) phase_scan(ka, L, c); PH_END
            PH_BEGIN(4) phase_gdn_out(ka, L, c); PH_END
            PH_BEGIN(5) {
                pg8::StaticOrder S; S.init(stok, D, c.G, c.bid);
                pg8::Gemm g{BIGP(bf16_t, B_ONA), WSP(bf16_t, WS_WBR), stok, D, 768}; pg8::EpiGateCat E{BIGP(bf16_t, B_PROJ), BIGP(bf16_t, B_MERGED)};
                pg8::gemm_phase<pg8::EpiGateCat, pg8::StaticOrder>(L, g, S, E); } PH_END
            PH_BEGIN(6) {
                const float* xr = layer == 0 ? (slab < 2 ? ka->in[0] + sbase * D : ka->in[1]) : c.out + sbase * D;
                pg8::Gemm g{BIGP(bf16_t, B_MERGED), WSP(bf16_t, WS_WOUT), stok, D, D}; pg8::StaticOrder S; S.init(stok, D, c.G, c.bid);
                pg8::EpiRes E{xr, c.out + sbase * D};
                pg8::gemm_phase<pg8::EpiRes, pg8::StaticOrder>(L, g, S, E); } PH_END
#ifndef LN1PROBE
#define LN1PROBE 0
#endif
            PH_BEGIN(7) if (LN1PROBE) { c.dry = 1; phase_ln1(ka, L, c); __syncthreads(); c.dry = 0; } phase_ln1(ka, L, c); PH_END
        }
        PH_BEGIN(8) phase_select(ka, L, c, c.bid < 16 ? 16 + c.bid : -1); PH_END
        PH_BEGIN(9) phase_gather(ka, L, c); PH_END
        for (int half = 0; half < 2; ++half) {
            PH_BEGIN(10) {
                pg8::Gemm g{BIGP(bf16_t, half ? B_XY1 : B_XY0), (const bf16_t*)(WSP(unsigned char, WS_WGU) + (size_t)half * 8 * 4096 * D), 8 * CAP, 8 * 4096, D / 2}; pg8::MoeOrder S; S.init(8, CAP / 256, 16, c.G, c.bid);
                pg8::EpiSwiglu E{BIGP(unsigned char, B_HID)};
                pg8::gemm_phase<pg8::EpiSwiglu, pg8::MoeOrder>(L, g, S, E); } PH_END
            PH_BEGIN(11) {
                pg8::Gemm g{BIGP(bf16_t, B_HID), (const bf16_t*)(WSP(unsigned char, WS_WD) + (size_t)half * 8 * D * DE), 8 * CAP, 8 * D, DE / 2}; pg8::MoeOrder S; S.init(8, CAP / 256, 4, c.G, c.bid);
                pg8::EpiDown E{BIGP(bf16_t, half ? B_XY1 : B_XY0), WSP(float, WS_GATEV) + (size_t)half * 8 * CAP};
                pg8::gemm_phase<pg8::EpiDown, pg8::MoeOrder>(L, g, S, E); } PH_END
        }
        PH_BEGIN(12) phase_ln2(ka, L, c); PH_END
    }
#undef PH_BEGIN
#undef PH_END
}

constexpr int N_PHASES = 2 * (1 + NSLAB * 7 + 2 + 4 + 1);

extern "C" void kernel_launch(void* const* d_in, const int* in_sizes, int n_in, void* d_out, int out_size, void* d_ws, size_t ws_size, hipStream_t stream) {
    static int grid = 0;
    if (grid == 0) {
        if (n_in != 20 || ws_size < WS_END) { fprintf(stderr, "kernel_launch: unexpected n_in %d or ws_size %zu (< %zu)\n", n_in, ws_size, (size_t)WS_END); grid = -1; return; }
        int dev = 0, cus = 0, per_cu = 0;
        if (hipGetDevice(&dev) != hipSuccess || hipDeviceGetAttribute(&cus, hipDeviceAttributeMultiprocessorCount, dev) != hipSuccess) { grid = -1; return; }
        if (hipFuncSetAttribute((const void*)fwd_kernel, hipFuncAttributeMaxDynamicSharedMemorySize, LDS_BYTES) != hipSuccess) { fprintf(stderr, "kernel_launch: hipFuncSetAttribute failed\n"); grid = -1; return; }
        if (hipOccupancyMaxActiveBlocksPerMultiprocessor(&per_cu, (const void*)fwd_kernel, 512, LDS_BYTES) != hipSuccess || per_cu < 1) fprintf(stderr, "kernel_launch: occupancy query says %d\n", per_cu);
        (void)hipGetLastError();
        grid = cus;
    }
    if (grid < 0) return;
    (void)hipMemsetAsync((char*)d_ws + WS_CTL, 0, 1 * MiB, stream);
    Args a{};
    for (int i = 0; i < 20; ++i) a.in[i] = (const float*)d_in[i];
    a.out = (float*)d_out; a.ws = (unsigned char*)d_ws;
#if MK_N_LAUNCHES == 1
    a.ph_lo = 0; a.ph_hi = N_PHASES;
    hipLaunchKernelGGL(fwd_kernel, dim3(grid), dim3(512), LDS_BYTES, stream, a);
#else
    for (int p = 0; p < N_PHASES; ++p) { a.ph_lo = p; a.ph_hi = p + 1; hipLaunchKernelGGL(fwd_kernel, dim3(grid), dim3(512), LDS_BYTES, stream, a); }
#endif
}
```

```cpp
#include <hip/hip_runtime.h>
#include <stdint.h>
#include <stdio.h>

#define LAS __attribute__((address_space(3)))
#define DI __device__ __forceinline__
typedef unsigned short bf16_t;
typedef short bf16x8 __attribute__((ext_vector_type(8)));
typedef float f32x4 __attribute__((ext_vector_type(4)));
typedef float f32x2 __attribute__((ext_vector_type(2)));
typedef float f32x16 __attribute__((ext_vector_type(16)));
typedef unsigned u32x4 __attribute__((ext_vector_type(4)));
typedef unsigned u32x2 __attribute__((ext_vector_type(2)));
typedef __bf16 bf16x2v __attribute__((ext_vector_type(2)));

#ifndef MK_N_LAUNCHES
#define MK_N_LAUNCHES 1
#endif

constexpr int D = 1024, T_ALL = 81920, T_P = 65536, T_S = 16384, SLABMAX = 32768, NSLAB = 3;
constexpr int DIN = 6552, NPROJ = 6656;
constexpr int C_GATE = 0, C_QA = 3072, C_KA = 3328, C_VA = 3584, C_QD = 3840, C_KD = 4224, C_VD = 4608, C_QC = 4992, C_KC = 5376, C_VC = 5760, C_ZC = 6144;
constexpr int NE = 16, DE = 2048, CAP_P = 8192, CAP_S = 2048, CAP = CAP_P + CAP_S;
constexpr float ALPHA = 1.41421356237f, LN_EPS = 1e-5f, NORM_EPS = 1e-6f;
constexpr size_t MiB = 1u << 20;
constexpr size_t WS_CTL = 0, WS_WIN = 1 * MiB, WS_WBR = 14 * MiB, WS_WOUT = 16 * MiB, WS_WGU = 18 * MiB, WS_WD = 82 * MiB, WS_XB8 = 114 * MiB, WS_WG8 = 194 * MiB, WS_XB = 210 * MiB;
constexpr size_t WS_AFF = 370 * MiB, WS_SLOT = 375 * MiB, WS_IDX = 380 * MiB, WS_GATEV = 381 * MiB, WS_CS = 382 * MiB, WS_BIG = 386 * MiB, WS_END = 1130 * MiB;
constexpr size_t B_PROJ = 0, B_BA = 416 * MiB, B_ONA = 420 * MiB, B_ODIL = 436 * MiB, B_OGDN = 452 * MiB, B_DILP = 476 * MiB, B_DILM = 500 * MiB, B_GSCR = 502 * MiB, B_MERGEF = 502 * MiB, B_MERGED = 630 * MiB;
constexpr size_t B_XY0 = 0, B_XY1 = 160 * MiB, B_HID = 320 * MiB;
constexpr int GSTRIDE = 41216;
constexpr int LDS_BYTES = 147456;
constexpr int LDS_MISC = 145408;

DI unsigned pk2(float lo, float hi) { f32x2 v = {lo, hi}; bf16x2v b = __builtin_convertvector(v, bf16x2v); return __builtin_bit_cast(unsigned, b); }
DI unsigned pk4_fp8(float a, float b, float c, float d) {
    int w = __builtin_amdgcn_cvt_pk_fp8_f32(a, b, 0, false); w = __builtin_amdgcn_cvt_pk_fp8_f32(c, d, w, true); return (unsigned)w; }
DI float bflo(unsigned u) { return __uint_as_float(u << 16); }
DI float bfhi(unsigned u) { return __uint_as_float(u & 0xffff0000u); }
DI float frcp(float x) { return __builtin_amdgcn_rcpf(x); }
DI float frsq(float x) { return __builtin_amdgcn_rsqf(x); }
DI float sigmoidf_(float x) { return frcp(1.0f + __expf(-x)); }
DI float siluf_(float x) { return x * frcp(1.0f + __expf(-x)); }
DI float wave_sum(float v) {
#pragma unroll
    for (int o = 1; o < 64; o <<= 1) v += __shfl_xor(v, o);
    return v;
}
#define MFMA32(a, b, c) __builtin_amdgcn_mfma_f32_32x32x16_bf16((a), (b), (c), 0, 0, 0)
DI int crow(int reg, int h) { return (reg & 3) + 8 * (reg >> 2) + 4 * h; }
DI f32x16 zero16() { f32x16 z; for (int i = 0; i < 16; ++i) z[i] = 0.f; return z; }
template <int S> DI bf16x8 pack8(const f32x16& x) {
    u32x4 p; p[0] = pk2(x[8 * S], x[8 * S + 1]); p[1] = pk2(x[8 * S + 2], x[8 * S + 3]); p[2] = pk2(x[8 * S + 4], x[8 * S + 5]); p[3] = pk2(x[8 * S + 6], x[8 * S + 7]);
    return __builtin_bit_cast(bf16x8, p);
}

namespace pg8 {
constexpr int BM = 256, BK = 64, HALF = 128, HTB = HALF * BK * 2, STAGE_BYTES = 8 * HTB, NXCD = 8, WGM = 8;
__host__ __device__ __forceinline__ int lds_byte(int r, int c) { const int st = (r >> 4) * 2 + (c >> 5), rr = r & 15, cc = c & 31, ob = rr * 64 + cc * 2; return st * 1024 + (ob ^ (((ob >> 9) & 1) << 5)); }
__host__ __device__ __forceinline__ void stage_rc(int b, int& R, int& C) { const int st = b / 1024, sb = b % 1024, swz = sb ^ (((sb >> 9) & 1) << 5); R = (st >> 1) * 16 + swz / 64; C = (st & 1) * 32 + (swz % 64) / 2; }
__host__ __device__ __forceinline__ int perm32(int rho) { const int n = rho >> 4, i = rho & 15; return 8 * (i >> 2) + 4 * n + (i & 3); }
struct Unit { int pm, pn; };
struct Gemm { const bf16_t* A; const bf16_t* Bt; int M, N, K; };
struct StaticOrder {
    int nM, nN, nwg, G, c;
    __device__ void init(int M, int N, int G_, int c_) { nM = M / BM; nN = N / BM; nwg = nM * nN; G = G_; c = c_; }
    __device__ bool next(int i, Unit& u) const {
        const long L = (long)i * G + c; if (L >= nwg) return false;
        int wgid = (int)L; { const int q = nwg / NXCD, r = nwg % NXCD, xcd = wgid % NXCD, off = wgid / NXCD; wgid = (xcd < r ? xcd * (q + 1) : r * (q + 1) + (xcd - r) * q) + off; }
        const int nig = WGM * nN, gid = wgid / nig, fm = gid * WGM, gsz = (nM - fm) < WGM ? (nM - fm) : WGM;
        u.pm = fm + ((wgid % nig) % gsz); u.pn = (wgid % nig) / gsz; return true;
    }
    __device__ __forceinline__ void a_ready(const Unit&) const {}
    __device__ __forceinline__ void done(const Unit&) const {}
};
struct MoeOrder {
    int nMe, nNe, per, total, G, c, xr, xc, rpx, cpx, share;
    __device__ void init(int nE, int nMe_, int nNe_, int G_, int c_) { nMe = nMe_; nNe = nNe_; per = nMe * nNe; total = nE * per; G = G_; c = c_;
        xc = (nNe % 2 == 0 && nNe >= 8) ? 2 : 1; xr = 8 / xc; rpx = nMe / xr; cpx = nNe / xc; share = rpx * cpx; }
    __device__ bool next(int i, Unit& u) const {
        if ((G & 7) == 0 && nMe % xr == 0) {
            const int x = c & 7, q = c >> 3, nq = G >> 3; const long j = (long)i * nq + q; if (j >= (long)(total / 8)) return false;
            const int e = (int)(j / share), r = (int)(j % share); const int pm = (x / xc) * rpx + r % rpx, pn = (x % xc) * cpx + r / rpx;
            u.pm = e * nMe + pm; u.pn = e * nNe + pn; return true;
        }
        const long L = (long)i * G + c; if (L >= total) return false;
        const int e = (int)(L / per), r = (int)(L % per);
        u.pm = e * nMe + r % nMe; u.pn = e * nNe + r / nMe; return true;
    }
    __device__ __forceinline__ void a_ready(const Unit&) const {}
    __device__ __forceinline__ void done(const Unit&) const {}
};

template <class Epi, class Sched>
__device__ __forceinline__ void gemm_phase(LAS unsigned char* lds, const Gemm g, const Sched& S, const Epi& E) {
    int tid = threadIdx.x; asm volatile("" : "+v"(tid));
    const int wid = __builtin_amdgcn_readfirstlane(tid >> 6), lane = tid & 63, wr = wid >> 2, wc = wid & 3, fr = lane & 15, fq = lane >> 4;
    int Kv = g.K; asm volatile("" : "+s"(Kv));
    const int K = Kv, nt = K / BK;
    unsigned voffA[2], voffB[2];
#pragma unroll
    for (int i = 0; i < 2; ++i) { int R, C; stage_rc(tid * 16 + i * 8192, R, C); const int Rb = Epi::PERM ? ((R & ~31) + perm32(R & 31)) : R;
        voffA[i] = (unsigned)(R * K + C) * 2u; voffB[i] = (unsigned)(Rb * K + C) * 2u; }
    const size_t kstep = (size_t)(BK * 2);
    const size_t hstep = (size_t)HALF * K * 2;
    const size_t tstep = 2 * hstep;
    const unsigned ldsw = (unsigned)wid * 1024u;
    const int aoff = lds_byte(wr * 64 + fr, fq * 8), boff = lds_byte(wc * 32 + fr, fq * 8);
#define PG8_SA(b, h) (((b) * 2 + (h)) * HTB)
#define PG8_SB(b, h) ((4 + (b) * 2 + (h)) * HTB)
#define PG8_STAGE(bufoff, gbase, voff) do { _Pragma("unroll") for (int _i = 0; _i < 2; ++_i) \
        __builtin_amdgcn_global_load_lds((const unsigned*)((const char*)(gbase) + (voff)[_i]), (LAS unsigned*)(lds + (bufoff) + ldsw + _i * 8192), 16, 0, 0); } while (0)
#define PG8_LD8(p) __builtin_shufflevector(*(const LAS v4i_*)(p), *(const LAS v4i_*)((p) + 1024), 0, 1, 2, 3, 4, 5, 6, 7)
#define PG8_LDA(dst, b, h) do { _Pragma("unroll") for (int m = 0; m < 4; ++m) { if constexpr (Epi::FP8) dst##8[m] = PG8_LD8(lds + PG8_SA(b, h) + aoff + m * 2048); \
        else { _Pragma("unroll") for (int k = 0; k < 2; ++k) dst[m][k] = *(const LAS bf16x8*)(lds + PG8_SA(b, h) + aoff + m * 2048 + k * 1024); } } } while (0)
#define PG8_LDB(dst, b, h) do { _Pragma("unroll") for (int n = 0; n < 2; ++n) { if constexpr (Epi::FP8) dst##8[n] = PG8_LD8(lds + PG8_SB(b, h) + boff + n * 2048); \
        else { _Pragma("unroll") for (int k = 0; k < 2; ++k) dst[n][k] = *(const LAS bf16x8*)(lds + PG8_SB(b, h) + boff + n * 2048 + k * 1024); } } } while (0)
#define PG8_MMA(ai, bj, At, Bt) do { __builtin_amdgcn_s_setprio(1); _Pragma("unroll") for (int m = 0; m < 4; ++m) _Pragma("unroll") for (int n = 0; n < 2; ++n) { \
        if constexpr (Epi::FP8) asm volatile("v_mfma_scale_f32_16x16x128_f8f6f4 %0, %1, %2, %0, %3, %3 op_sel_hi:[0,0,0]" : "+v"(acc[ai][bj][m][n]) : "v"(Bt##8[n]), "v"(At##8[m]), "v"(fp8_unit_scale));   \
        else { _Pragma("unroll") for (int k = 0; k < 2; ++k) acc[ai][bj][m][n] = __builtin_amdgcn_mfma_f32_16x16x32_bf16(Bt[n][k], At[m][k], acc[ai][bj][m][n], 0, 0, 0); } } \
        __builtin_amdgcn_s_setprio(0); } while (0)
#define PG8_WAIT_V(n) asm volatile("s_waitcnt vmcnt(" #n ")" ::: "memory")
#define PG8_WAIT_L(n) asm volatile("s_waitcnt lgkmcnt(" #n ")" ::: "memory")
#define PG8_BAR __builtin_amdgcn_s_barrier()
#define PG8_SCHED __builtin_amdgcn_sched_barrier(0)
    Unit cur, nxt; int ui = 0;
    if (!S.next(0, cur)) return;
    f32x4 acc[2][2][4][2];
#pragma unroll
    for (int a = 0; a < 2; ++a)
#pragma unroll
        for (int b = 0; b < 2; ++b)
#pragma unroll
            for (int m = 0; m < 4; ++m)
#pragma unroll
                for (int n = 0; n < 2; ++n) acc[a][b][m][n] = (f32x4){0.f, 0.f, 0.f, 0.f};
    typedef int v4i_ __attribute__((ext_vector_type(4))); typedef int v8i_ __attribute__((ext_vector_type(8)));
    bf16x8 At[4][2], B0[2][2], B1[2][2]; v8i_ At8[4], B08[2], B18[2];
    int fp8_unit_scale = 0x7F7F7F7F; asm volatile("" : "+v"(fp8_unit_scale));
    const char* cA = (const char*)g.A + (size_t)cur.pm * tstep; const char* cB = (const char*)g.Bt + (size_t)cur.pn * tstep;
    S.a_ready(cur);
    PG8_STAGE(PG8_SB(0, 0), cB, voffB); PG8_STAGE(PG8_SA(0, 0), cA, voffA); PG8_STAGE(PG8_SB(0, 1), cB + hstep, voffB); PG8_STAGE(PG8_SA(0, 1), cA + hstep, voffA);
    if (wr == 1) PG8_BAR;
    PG8_WAIT_V(4); PG8_BAR;
    PG8_STAGE(PG8_SB(1, 0), cB + kstep, voffB); PG8_STAGE(PG8_SA(1, 0), cA + kstep, voffA); PG8_STAGE(PG8_SB(1, 1), cB + hstep + kstep, voffB);
    PG8_WAIT_V(6); PG8_BAR;
    for (;;) {
        const bool has_next = S.next(ui + 1, nxt);
        const char* nA = has_next ? (const char*)g.A + (size_t)nxt.pm * tstep : cA; const char* nB = has_next ? (const char*)g.Bt + (size_t)nxt.pn * tstep : cB;
        for (int t = 0; t < nt; t += 2) {
            const bool last = (t == nt - 2);
            const char* a1 = cA + (size_t)(t + 1) * kstep;
            const char* a2 = last ? nA : cA + (size_t)(t + 2) * kstep; const char* b2 = last ? nB : cB + (size_t)(t + 2) * kstep;
            const char* a3 = a2 + kstep; const char* b3 = b2 + kstep;
            if (last && has_next) S.a_ready(nxt);
            if constexpr (Epi::SEG) { if (t == 4 || t == 6) { int tz = tid; asm volatile("" : "+v"(tz)); const int wz = __builtin_amdgcn_readfirstlane(tz >> 6), lz = tz & 63; E.mid(acc, cur, t == 4 ? 0 : 1, wz >> 2, wz & 3, lz & 15, lz >> 4); } }
            PG8_LDB(B0, 0, 0); PG8_SCHED; PG8_LDA(At, 0, 0); PG8_STAGE(PG8_SA(1, 1), a1 + hstep, voffA);
            PG8_WAIT_L(8); PG8_BAR; PG8_WAIT_L(0); PG8_MMA(0, 0, At, B0); PG8_BAR; PG8_SCHED;
            PG8_LDB(B1, 0, 1); PG8_STAGE(PG8_SB(0, 0), b2, voffB);
            PG8_BAR; PG8_WAIT_L(0); PG8_MMA(0, 1, At, B1); PG8_BAR;
            PG8_LDA(At, 0, 1); PG8_STAGE(PG8_SA(0, 0), a2, voffA);
            PG8_BAR; PG8_WAIT_L(0); PG8_MMA(1, 0, At, B0); PG8_BAR; PG8_SCHED;
            PG8_STAGE(PG8_SB(0, 1), b2 + hstep, voffB);
            PG8_WAIT_V(6); PG8_BAR; PG8_MMA(1, 1, At, B1); PG8_BAR;
            PG8_LDB(B0, 1, 0); PG8_SCHED; PG8_LDA(At, 1, 0); PG8_STAGE(PG8_SA(0, 1), a2 + hstep, voffA);
            PG8_WAIT_L(8); PG8_BAR; PG8_WAIT_L(0); PG8_MMA(0, 0, At, B0); PG8_BAR; PG8_SCHED;
            PG8_LDB(B1, 1, 1); PG8_STAGE(PG8_SB(1, 0), b3, voffB);
            PG8_BAR; PG8_WAIT_L(0); PG8_MMA(0, 1, At, B1); PG8_BAR;
            PG8_LDA(At, 1, 1); PG8_STAGE(PG8_SA(1, 0), a3, voffA);
            PG8_BAR; PG8_WAIT_L(0); PG8_MMA(1, 0, At, B0); PG8_BAR; PG8_SCHED;
            PG8_STAGE(PG8_SB(1, 1), b3 + hstep, voffB);
            PG8_WAIT_V(6); PG8_BAR; PG8_MMA(1, 1, At, B1); PG8_BAR;
        }
        if constexpr (Epi::FP8) asm volatile("s_nop 15\n\ts_nop 15\n\ts_nop 15" ::: "memory");
        { int tz = tid; asm volatile("" : "+v"(tz)); const int wz = __builtin_amdgcn_readfirstlane(tz >> 6), lz = tz & 63;
          E(acc, cur, wz >> 2, wz & 3, lz & 15, lz >> 4); } S.done(cur);
        if (!has_next) break;
#pragma unroll
        for (int a = 0; a < 2; ++a)
#pragma unroll
            for (int b = 0; b < 2; ++b)
#pragma unroll
                for (int m = 0; m < 4; ++m)
#pragma unroll
                    for (int n = 0; n < 2; ++n) acc[a][b][m][n] = (f32x4){0.f, 0.f, 0.f, 0.f};
        cur = nxt; cA = nA; cB = nB; ++ui;
    }
    PG8_WAIT_V(0);
    if (wr == 0) PG8_BAR;
    PG8_BAR;
#undef PG8_SA
#undef PG8_SB
#undef PG8_STAGE
#undef PG8_LDA
#undef PG8_LD8
#undef PG8_LDB
#undef PG8_MMA
#undef PG8_WAIT_V
#undef PG8_WAIT_L
#undef PG8_BAR
#undef PG8_SCHED
}

struct EpiInProj {
    static constexpr bool PERM = true, SEG = false, FP8 = false;
    bf16_t* O; float* BA;
    __device__ __forceinline__ void operator()(const f32x4 (&acc)[2][2][4][2], const Unit& u, int wr, int wc, int fr, int fq) const {
        const int row0 = u.pm * BM + wr * 64 + fr, col0 = 3072 + u.pn * BM + wc * 32 + 8 * fq;
        const bool sig = false, ba = (u.pn == 13) && (wc == 0) && (fq < 3);
#pragma unroll
        for (int ai = 0; ai < 2; ++ai)
#pragma unroll
            for (int m = 0; m < 4; ++m) { const int row = row0 + ai * HALF + m * 16; bf16_t* rowp = O + (size_t)row * NPROJ + col0;
#pragma unroll
                for (int bj = 0; bj < 2; ++bj) { f32x4 v0 = acc[ai][bj][m][0], v1 = acc[ai][bj][m][1];
                    if (sig) {
#pragma unroll
                        for (int j = 0; j < 4; ++j) { v0[j] = sigmoidf_(v0[j]); v1[j] = sigmoidf_(v1[j]); } }
                    u32x4 w; w.x = pk2(v0[0], v0[1]); w.y = pk2(v0[2], v0[3]); w.z = pk2(v1[0], v1[1]); w.w = pk2(v1[2], v1[3]);
                    *(u32x4*)(rowp + bj * HALF) = w;
                    if (bj == 1 && ba) { float* bp = BA + (size_t)row * 32 + 8 * fq; *(f32x4*)bp = v0; *(f32x4*)(bp + 4) = v1; } } }
    }
};
struct EpiGates {
    static constexpr bool PERM = true, SEG = false, FP8 = true;
    bf16_t* O;
    __device__ __forceinline__ void operator()(const f32x4 (&acc)[2][2][4][2], const Unit& u, int wr, int wc, int fr, int fq) const {
        const int row0 = u.pm * BM + wr * 64 + fr, col0 = u.pn * BM + wc * 32 + 8 * fq;
#pragma unroll
        for (int ai = 0; ai < 2; ++ai)
#pragma unroll
            for (int m = 0; m < 4; ++m) { int rowi = row0 + ai * HALF + m * 16; asm volatile("" : "+v"(rowi)); bf16_t* rowp = O + (size_t)rowi * NPROJ + col0;
#pragma unroll
                for (int bj = 0; bj < 2; ++bj) { f32x4 v0 = acc[ai][bj][m][0] * 0.03125f, v1 = acc[ai][bj][m][1] * 0.03125f;
#pragma unroll
                    for (int j = 0; j < 4; ++j) { v0[j] = sigmoidf_(v0[j]); v1[j] = sigmoidf_(v1[j]); }
                    u32x4 w; w.x = pk2(v0[0], v0[1]); w.y = pk2(v0[2], v0[3]); w.z = pk2(v1[0], v1[1]); w.w = pk2(v1[2], v1[3]);
                    *(u32x4*)(rowp + bj * HALF) = w; }
                asm volatile("" ::: "memory"); }
    }
};
struct EpiGateCat {
    static constexpr bool PERM = false, SEG = true, FP8 = false;
    const bf16_t* PROJ; bf16_t* MB;
    __device__ __forceinline__ void mid(f32x4 (&acc)[2][2][4][2], const Unit& u, int seg, int wr, int wc, int fr, int fq) const {
        const int row0 = u.pm * BM + wr * 64 + fr, col0 = u.pn * BM + wc * 32 + 4 * fq;
#pragma unroll
        for (int ai = 0; ai < 2; ++ai) {
            int rowb = row0 + ai * HALF; asm volatile("" : "+v"(rowb)); const bf16_t* gp0 = PROJ + (size_t)rowb * NPROJ + C_GATE + seg * 1024 + col0;
            u32x2 ga[4][2][2], gb[4][2][2];
#pragma unroll
            for (int m = 0; m < 4; ++m)
#pragma unroll
                for (int bj = 0; bj < 2; ++bj)
#pragma unroll
                    for (int n = 0; n < 2; ++n) { const bf16_t* gp = gp0 + (size_t)(m * 16) * NPROJ + bj * HALF + n * 16; ga[m][bj][n] = *(const u32x2*)gp; gb[m][bj][n] = *(const u32x2*)(gp + 1024); }
#pragma unroll
            for (int m = 0; m < 4; ++m)
#pragma unroll
                for (int bj = 0; bj < 2; ++bj)
#pragma unroll
                    for (int n = 0; n < 2; ++n) { const u32x2 a_ = ga[m][bj][n], b_ = gb[m][bj][n];
                        f32x4& v = acc[ai][bj][m][n]; v[0] *= bflo(a_.x) * frcp(bflo(b_.x)); v[1] *= bfhi(a_.x) * frcp(bfhi(b_.x)); v[2] *= bflo(a_.y) * frcp(bflo(b_.y)); v[3] *= bfhi(a_.y) * frcp(bfhi(b_.y)); }
            asm volatile("" ::: "memory"); }
    }
    __device__ __forceinline__ void operator()(const f32x4 (&acc)[2][2][4][2], const Unit& u, int wr, int wc, int fr, int fq) const {
        const int row0 = u.pm * BM + wr * 64 + fr, col0 = u.pn * BM + wc * 32 + 4 * fq;
#pragma unroll
        for (int ai = 0; ai < 2; ++ai) {
            int rowb = row0 + ai * HALF; asm volatile("" : "+v"(rowb)); const bf16_t* gp0 = PROJ + (size_t)rowb * NPROJ + C_GATE + 2 * 1024 + col0; bf16_t* mp0 = MB + (size_t)rowb * D + col0;
            u32x2 gw[4][2][2];
#pragma unroll
            for (int m = 0; m < 4; ++m)
#pragma unroll
                for (int bj = 0; bj < 2; ++bj)
#pragma unroll
                    for (int n = 0; n < 2; ++n) gw[m][bj][n] = *(const u32x2*)(gp0 + (size_t)(m * 16) * NPROJ + bj * HALF + n * 16);
#pragma unroll
            for (int m = 0; m < 4; ++m)
#pragma unroll
                for (int bj = 0; bj < 2; ++bj)
#pragma unroll
                    for (int n = 0; n < 2; ++n) { const u32x2 g_ = gw[m][bj][n]; const f32x4 v = acc[ai][bj][m][n];
                        u32x2 w; w.x = pk2(v[0] * bflo(g_.x), v[1] * bfhi(g_.x)); w.y = pk2(v[2] * bflo(g_.y), v[3] * bfhi(g_.y)); *(u32x2*)(mp0 + (size_t)(m * 16) * D + bj * HALF + n * 16) = w; }
            asm volatile("" ::: "memory"); }
    }
};
struct EpiRes {
    static constexpr bool PERM = false, SEG = false, FP8 = false;
    const float* XR; float* H;
    __device__ __forceinline__ void operator()(const f32x4 (&acc)[2][2][4][2], const Unit& u, int wr, int wc, int fr, int fq) const {
        const int row0 = u.pm * BM + wr * 64 + fr, col0 = u.pn * BM + wc * 32 + 4 * fq;
#pragma unroll
        for (int ai = 0; ai < 2; ++ai) {
            int rowb = row0 + ai * HALF; asm volatile("" : "+v"(rowb)); const size_t off0 = (size_t)rowb * D + col0;
            f32x4 xr[4][2][2];
#pragma unroll
            for (int m = 0; m < 4; ++m)
#pragma unroll
                for (int bj = 0; bj < 2; ++bj)
#pragma unroll
                    for (int n = 0; n < 2; ++n) xr[m][bj][n] = *(const f32x4*)(XR + off0 + (size_t)(m * 16) * D + bj * HALF + n * 16);
#pragma unroll
            for (int m = 0; m < 4; ++m)
#pragma unroll
                for (int bj = 0; bj < 2; ++bj)
#pragma unroll
                    for (int n = 0; n < 2; ++n) *(f32x4*)(H + off0 + (size_t)(m * 16) * D + bj * HALF + n * 16) = xr[m][bj][n] * ALPHA + acc[ai][bj][m][n];
            asm volatile("" ::: "memory"); }
    }
};
struct EpiSwiglu {
    static constexpr bool PERM = true, SEG = false, FP8 = true;
    unsigned char* HID;
    __device__ __forceinline__ void operator()(const f32x4 (&acc)[2][2][4][2], const Unit& u, int wr, int wc, int fr, int fq) const {
        const int row0 = u.pm * BM + wr * 64 + fr, col0 = (u.pn & 15) * 128 + wc * 32 + 8 * fq;
#pragma unroll
        for (int ai = 0; ai < 2; ++ai)
#pragma unroll
            for (int m = 0; m < 4; ++m) { const f32x4 g0 = acc[ai][0][m][0] * 0.03125f, g1 = acc[ai][0][m][1] * 0.03125f, u0 = acc[ai][1][m][0] * 0.03125f, u1 = acc[ai][1][m][1] * 0.03125f;
                f32x4 h0, h1;
#pragma unroll
                for (int j = 0; j < 4; ++j) { h0[j] = siluf_(g0[j]) * u0[j]; h1[j] = siluf_(g1[j]) * u1[j]; }
                u32x2 w; w.x = pk4_fp8(h0[0], h0[1], h0[2], h0[3]); w.y = pk4_fp8(h1[0], h1[1], h1[2], h1[3]);
                int rowi = row0 + ai * HALF + m * 16; asm volatile("" : "+v"(rowi));
                *(u32x2*)(HID + (size_t)rowi * DE + col0) = w; asm volatile("" ::: "memory"); }
    }
};
struct EpiDown {
    static constexpr bool PERM = true, SEG = false, FP8 = true;
    bf16_t* Y; const float* GV;
    __device__ __forceinline__ void operator()(const f32x4 (&acc)[2][2][4][2], const Unit& u, int wr, int wc, int fr, int fq) const {
        const int row0 = u.pm * BM + wr * 64 + fr, col0 = (u.pn & 3) * BM + wc * 32 + 8 * fq;
        float gvs[2][4];
#pragma unroll
        for (int ai = 0; ai < 2; ++ai)
#pragma unroll
            for (int m = 0; m < 4; ++m) gvs[ai][m] = GV[row0 + ai * HALF + m * 16];
#pragma unroll
        for (int ai = 0; ai < 2; ++ai)
#pragma unroll
            for (int m = 0; m < 4; ++m) { int row = row0 + ai * HALF + m * 16; asm volatile("" : "+v"(row)); const float gv = gvs[ai][m] * 0.03125f;
#pragma unroll
                for (int bj = 0; bj < 2; ++bj) { const f32x4 v0 = acc[ai][bj][m][0] * gv, v1 = acc[ai][bj][m][1] * gv;
                    u32x4 w; w.x = pk2(v0[0], v0[1]); w.y = pk2(v0[2], v0[3]); w.z = pk2(v1[0], v1[1]); w.w = pk2(v1[2], v1[3]);
                    *(u32x4*)(Y + (size_t)row * D + col0 + bj * HALF) = w; } }
    }
};
}

#define XB_TMO      128
#define XB_XCNT(j)  (256  + 64 * (j))
#define XB_XSUB(j)  (1280 + 64 * (j))
#define XB_XGEN(j)  (2304 + 64 * (j))
#define XB_TOP      3328
#define XB_TOPGEN   3392
#define XCD_BAR_WORDS 3456
#define XB_SPIN_CAP (1u << 22)
__device__ __forceinline__ unsigned xb_ld(unsigned* p)              { return __hip_atomic_load(p, __ATOMIC_RELAXED, __HIP_MEMORY_SCOPE_AGENT); }
__device__ __forceinline__ unsigned xb_add(unsigned* p, unsigned v) { return __hip_atomic_fetch_add(p, v, __ATOMIC_RELAXED, __HIP_MEMORY_SCOPE_AGENT); }
__device__ __forceinline__ unsigned xb_xcc_id() { return (unsigned)__builtin_amdgcn_s_getreg((3 << 11) | 20) & 0xFu; }
#define XB_SPIN(cond, bar) do { unsigned _sp = 0; while (cond) { __builtin_amdgcn_s_sleep(1); \
    if ((++_sp & 255u) == 0u) { if (xb_ld(&(bar)[XB_TMO])) break; if (_sp > XB_SPIN_CAP) { atomicAdd(&(bar)[XB_TMO], 1u); break; } } } } while (0)
struct XcdBarrier { unsigned* bar; unsigned x; volatile LAS unsigned* st; };
__device__ __forceinline__ XcdBarrier xcd_barrier_post(unsigned* bar, volatile LAS unsigned* st) {
    XcdBarrier b; b.bar = bar; b.x = xb_xcc_id(); b.st = st;
    if (threadIdx.x == 0) (void)xb_add(&bar[XB_XCNT(b.x)], 1u);
    return b;
}
__device__ __forceinline__ void xcd_barrier_complete(unsigned* bar, unsigned x, unsigned& nloc, unsigned& nx) {
    const unsigned G = gridDim.x * gridDim.y * gridDim.z;
    unsigned sum, cnt, mine, sp = 0u;
    for (;;) {
        sum = 0u; cnt = 0u; mine = 0u;
#pragma unroll
        for (unsigned j = 0; j < 16; ++j) { const unsigned c = xb_ld(&bar[XB_XCNT(j)]); sum += c; cnt += (c > 0u) ? 1u : 0u; }
        mine = xb_ld(&bar[XB_XCNT(x)]);
        if (sum == G) break;
        __builtin_amdgcn_s_sleep(1);
        if ((++sp & 255u) == 0u) { if (xb_ld(&bar[XB_TMO])) break; if (sp > XB_SPIN_CAP) { atomicAdd(&bar[XB_TMO], 1u); break; } }
    }
    nloc = mine > 0u ? mine : 1u; nx = cnt > 0u ? cnt : 1u;
}
__device__ __forceinline__ void xcd_barrier(const XcdBarrier& b) {
    asm volatile("s_waitcnt vmcnt(0)" ::: "memory");
    __syncthreads();
    if (threadIdx.x == 0) {
        unsigned* bar = b.bar; asm volatile("" : "+s"(bar));
        __builtin_amdgcn_s_waitcnt(0);
        unsigned nloc = b.st[0], nx = b.st[1];
        if (nloc == 0u) { xcd_barrier_complete(bar, b.x, nloc, nx); b.st[0] = nloc; b.st[1] = nx; }
        const unsigned old = xb_add(&bar[XB_XSUB(b.x)], 1u);
        const unsigned gen = old / nloc;
        if (old + 1u == (gen + 1u) * nloc) {
            __builtin_amdgcn_fence(__ATOMIC_RELEASE, "agent");
            asm volatile("s_waitcnt vmcnt(0)" ::: "memory");
            const unsigned og = xb_add(&bar[XB_TOP], 1u);
            const unsigned tg = og / nx;
            if (og + 1u == (tg + 1u) * nx) xb_add(&bar[XB_TOPGEN], 1u);
            else XB_SPIN(xb_ld(&bar[XB_TOPGEN]) == tg, bar);
            __builtin_amdgcn_fence(__ATOMIC_ACQUIRE, "agent");
            xb_add(&bar[XB_XGEN(b.x)], 1u);
            asm volatile("s_waitcnt vmcnt(0)" ::: "memory");
        } else {
            XB_SPIN(xb_ld(&bar[XB_XGEN(b.x)]) == gen, bar);
            __builtin_amdgcn_fence(__ATOMIC_ACQUIRE, "agent");
            asm volatile("s_waitcnt vmcnt(0)" ::: "memory");
        }
    }
    __syncthreads();
}

struct Args { const float* in[20]; float* out; unsigned char* ws; int ph_lo, ph_hi; };
typedef const __attribute__((address_space(4))) Args* KArgs;
DI KArgs kargs() { KArgs p = (KArgs)__builtin_amdgcn_kernarg_segment_ptr(); asm volatile("" : "+s"(p)); return p; }
struct Ctx {
    float* out; unsigned char* ws;
    int tid, lane, wave, G, bid;
    int layer, slab;
    int nseq, seqlen;
    int stok, sbase;
    int dry;
};
#define WSP(T, off) ((T*)(c.ws + (off)))
#define BIGP(T, off) ((T*)(c.ws + WS_BIG + (off)))

__device__ const float INV_FREQ[32] = {1.000000000e+00f, 7.498942018e-01f, 5.623413324e-01f, 4.216965139e-01f, 3.162277639e-01f, 2.371373773e-01f, 1.778279394e-01f, 1.333521456e-01f, 1.000000015e-01f, 7.498942316e-02f, 5.623413250e-02f, 4.216964915e-02f, 3.162277490e-02f, 2.371373773e-02f, 1.778279431e-02f, 1.333521400e-02f, 9.999999776e-03f, 7.498942316e-03f, 5.623413250e-03f, 4.216964822e-03f, 3.162277630e-03f, 2.371373819e-03f, 1.778279431e-03f, 1.333521446e-03f, 1.000000047e-03f, 7.498941850e-04f, 5.623413017e-04f, 4.216965172e-04f, 3.162277571e-04f, 2.371373703e-04f, 1.778279402e-04f, 1.333521504e-04f};
DI void tr_item(const float* src, long src_ld, int src_col0, int nvalid, int kvalid, bf16_t* dst, long dst_ld, int dst_row0, int k0, LAS float* scr, int lane) {
    float tv[32];
#pragma unroll
    for (int i = 0; i < 32; ++i) { const int kk = 2 * i + (lane >> 5), cc = lane & 31;
        tv[i] = 0.f; if ((k0 + kk) < kvalid && cc < nvalid) tv[i] = src[(size_t)(k0 + kk) * src_ld + src_col0 + cc]; }
#pragma unroll
    for (int i = 0; i < 32; ++i) { const int kk = 2 * i + (lane >> 5), cc = lane & 31; scr[kk * 33 + cc] = tv[i]; }
    asm volatile("s_waitcnt lgkmcnt(0)" ::: "memory");
    const int c8 = lane & 7;
#pragma unroll
    for (int j = 0; j < 4; ++j) { const int n = (lane >> 3) + 8 * j; const LAS float* s = scr + (8 * c8) * 33 + n;
        u32x4 o; o.x = pk2(s[0 * 33], s[1 * 33]); o.y = pk2(s[2 * 33], s[3 * 33]); o.z = pk2(s[4 * 33], s[5 * 33]); o.w = pk2(s[6 * 33], s[7 * 33]);
        *(u32x4*)(dst + (size_t)(dst_row0 + n) * dst_ld + k0 + 8 * c8) = o; }
    asm volatile("s_waitcnt lgkmcnt(0)" ::: "memory");
}
DI void tr_item8(const float* src, long src_ld, int src_col0, int kvalid, unsigned char* dst, long dst_ld, int dst_row0, int k0, float scale, LAS float* scr, int lane) {
    float tv[32];
#pragma unroll
    for (int i = 0; i < 32; ++i) { const int kk = 2 * i + (lane >> 5), cc = lane & 31; tv[i] = 0.f; if ((k0 + kk) < kvalid) tv[i] = src[(size_t)(k0 + kk) * src_ld + src_col0 + cc]; }
#pragma unroll
    for (int i = 0; i < 32; ++i) { const int kk = 2 * i + (lane >> 5), cc = lane & 31; scr[kk * 33 + cc] = tv[i]; }
    asm volatile("s_waitcnt lgkmcnt(0)" ::: "memory");
    const int c8 = lane & 7;
#pragma unroll
    for (int j = 0; j < 4; ++j) { const int n = (lane >> 3) + 8 * j; const LAS float* s = scr + (8 * c8) * 33 + n;
        u32x2 o; o.x = pk4_fp8(s[0 * 33] * scale, s[1 * 33] * scale, s[2 * 33] * scale, s[3 * 33] * scale); o.y = pk4_fp8(s[4 * 33] * scale, s[5 * 33] * scale, s[6 * 33] * scale, s[7 * 33] * scale);
        *(u32x2*)(dst + (size_t)(dst_row0 + n) * dst_ld + k0 + 8 * c8) = o; }
    asm volatile("s_waitcnt lgkmcnt(0)" ::: "memory");
}
DI void phase_weights(KArgs args, LAS unsigned char* lds, const Ctx& c) {
    const int l = c.layer, lane = c.lane;
    LAS float* scr = (LAS float*)(lds + c.wave * 8448);
    const int gw = c.bid * 8 + c.wave, NGW = c.G * 8;
    constexpr int I_IN = 16 * 112 + 16 * 96, I_NA = 4 * 32, I_DIL = 2 * 32, I_GDN = 6 * 32, I_OUT = 16 * 32, I_GU1 = 16 * 128, I_D1 = 32 * 32;
    constexpr int NITEMS = I_IN + I_NA + I_DIL + I_GDN + I_OUT + 16 * I_GU1 + 16 * I_D1;
    for (int it = gw; it < NITEMS; it += NGW) {
        int r = it;
        const float* src; long sld; int sc0, nv = 32, kv; bf16_t* dst; long dld; int dr0, k0;
        if (r < 16 * 112) { const int kb = r / 112, nb = r % 112, n0 = 32 * nb; src = args->in[2] + (size_t)l * D * DIN; sld = DIN; kv = D;
            sc0 = n0; nv = 3480 - n0; if (nv < 0) { nv = 0; sc0 = 0; } if (nv > 32) nv = 32;
            dst = WSP(bf16_t, WS_WIN); dld = D; dr0 = n0; k0 = 64 * kb; }
        else if (r < I_IN) { const int q = r - 16 * 112, kb = q / 96, nb = q % 96;
            tr_item8(args->in[2] + (size_t)l * D * DIN, DIN, 3480 + 32 * nb, D, WSP(unsigned char, WS_WG8), D, 32 * nb, 64 * kb, 32.0f, scr, lane); continue; }
        else if ((r -= I_IN) < I_NA) { const int kb = r / 32, nb = r % 32; src = args->in[8] + (size_t)l * 256 * D; sld = D; sc0 = 32 * nb; kv = 256; dst = WSP(bf16_t, WS_WBR); dld = 768; dr0 = 32 * nb; k0 = 64 * kb; }
        else if ((r -= I_NA) < I_DIL) { const int kb = r / 32, nb = r % 32; src = args->in[9] + (size_t)l * 128 * D; sld = D; sc0 = 32 * nb; kv = 128; dst = WSP(bf16_t, WS_WBR) + 256; dld = 768; dr0 = 32 * nb; k0 = 64 * kb; }
        else if ((r -= I_DIL) < I_GDN) { const int kb = r / 32, nb = r % 32; src = args->in[10] + (size_t)l * 384 * D; sld = D; sc0 = 32 * nb; kv = 384; dst = WSP(bf16_t, WS_WBR) + 384; dld = 768; dr0 = 32 * nb; k0 = 64 * kb; }
        else if ((r -= I_GDN) < I_OUT) { const int kb = r / 32, nb = r % 32; src = args->in[11] + (size_t)l * D * D; sld = D; sc0 = 32 * nb; kv = D; dst = WSP(bf16_t, WS_WOUT); dld = D; dr0 = 32 * nb; k0 = 64 * kb; }
        else if ((r -= I_OUT) < 16 * I_GU1) { const int e = r / I_GU1, q = r % I_GU1, kb = q / 128, nb = q % 128, n0 = 32 * nb, j = n0 >> 8, rr = n0 & 255;
            tr_item8((rr < 128 ? args->in[16] : args->in[15]) + ((size_t)l * NE + e) * D * DE, DE, 128 * j + (rr & 127), D, WSP(unsigned char, WS_WGU) + (size_t)e * 4096 * D, D, n0, 64 * kb, 32.0f, scr, lane); continue; }
        else { r -= 16 * I_GU1; const int e = r / I_D1, q = r % I_D1, kb = q / 32, nb = q % 32;
            tr_item8(args->in[17] + ((size_t)l * NE + e) * DE * D, D, 32 * nb, DE, WSP(unsigned char, WS_WD) + (size_t)e * D * DE, DE, 32 * nb, 64 * kb, 32.0f, scr, lane); continue; }
        tr_item(src, sld, sc0, nv, kv, dst, dld, dr0, k0, scr, lane);
    }
    if (l == 0) {
        for (int t = gw; t < T_ALL; t += NGW) {
            const float* xr = (t < T_P) ? args->in[0] + (size_t)t * D : args->in[1] + (size_t)(t - T_P) * D;
            bf16_t* o = WSP(bf16_t, WS_XB) + (size_t)t * D;
#pragma unroll
            for (int j = 0; j < 4; ++j) { const f32x4 v = *(const f32x4*)(xr + 4 * lane + 256 * j); u32x2 w; w.x = pk2(v[0], v[1]); w.y = pk2(v[2], v[3]); *(u32x2*)(o + 4 * lane + 256 * j) = w;
                *(unsigned*)(WSP(unsigned char, WS_XB8) + (size_t)t * D + 4 * lane + 256 * j) = pk4_fp8(v[0], v[1], v[2], v[3]); }
        }
        float* cs = WSP(float, WS_CS);
        for (int i = c.bid * 512 + c.tid; i < 16384 * 32; i += c.G * 512) { const int pos = i >> 5, k = i & 31;
            const float inv = INV_FREQ[k];
            const float ang = (float)pos * inv;
            cs[pos * 64 + k] = cosf(ang); cs[pos * 64 + 32 + k] = sinf(ang); }
    }
}

constexpr int TLD = 72, TILEB = 64 * TLD * 2;
DI int tsw(int row) { return ((row >> 4) & 3) << 3; }
template <bool SA = false, bool SB = false> DI f32x16 mm_tile(const LAS bf16_t* A, const LAS bf16_t* Bt, int m0, int n0, int lane) {
    f32x16 acc = zero16(); const int r = lane & 31, hh = lane >> 5; const int sa = SA ? tsw(m0 + r) : 0, sb = SB ? tsw(n0 + r) : 0;
#pragma unroll
    for (int ks = 0; ks < 4; ++ks) { const bf16x8 a = *(const LAS bf16x8*)(A + (m0 + r) * TLD + ((16 * ks + 8 * hh) ^ sa)); const bf16x8 b = *(const LAS bf16x8*)(Bt + (n0 + r) * TLD + ((16 * ks + 8 * hh) ^ sb)); acc = MFMA32(a, b, acc); }
    return acc;
}

constexpr int PI_P0 = 0, PI_P1 = 9216, PI_INTRA = 18432, PI_AM = 27648, PI_TT = 45056, PI_TD0 = 54272, PI_TD1 = 60416, PI_PM = 65024, PI_VEC = 71168, PI_BYTES = 72704;
constexpr int PI_WT = PI_AM, PI_UT = PI_TD0;
DI void gdn_prep_pair(KArgs args, LAS unsigned char* L0, const Ctx& c, int pu) {
    int tid = c.tid; asm volatile("" : "+v"(tid)); const int lane = tid & 63, wave = __builtin_amdgcn_readfirstlane(tid >> 6), l = c.layer;
    const int dir = wave >> 2, wg = wave & 3, tg = tid & 255, head = pu % 6, gch = pu / 6, inst = (gch * 6 + head) * 2 + dir;
    const int cps = c.seqlen >> 6, seq = gch / cps, n = gch % cps;
    const bf16_t* PROJ = BIGP(bf16_t, B_PROJ); const float* BA = BIGP(float, B_BA);
    unsigned char* G = BIGP(unsigned char, B_GSCR) + (size_t)inst * GSTRIDE;
    LAS unsigned char* L = L0 + dir * PI_BYTES;
    LAS bf16_t* P0 = (LAS bf16_t*)(L + PI_P0); LAS bf16_t* P1 = (LAS bf16_t*)(L + PI_P1); LAS bf16_t* INTRA = (LAS bf16_t*)(L + PI_INTRA);
    LAS float* AM = (LAS float*)(L + PI_AM); LAS bf16_t* TT = (LAS bf16_t*)(L + PI_TT);
    LAS float* TD0 = (LAS float*)(L + PI_TD0); LAS float* TD1 = (LAS float*)(L + PI_TD1); LAS float* PM = (LAS float*)(L + PI_PM);
    LAS float* GV = (LAS float*)(L + PI_VEC); LAS float* BV = GV + 64; LAS float* GC = GV + 128;
    LAS bf16_t* WT = (LAS bf16_t*)(L + PI_WT); LAS bf16_t* UT = (LAS bf16_t*)(L + PI_UT);
    const int ia = tg >> 3, p = tg & 7;
    LAS float* XQ = (LAS float*)(L0 + PI_AM);
    LAS float* XK = (LAS float*)(L0 + PI_TT);
    LAS float* XV = (LAS float*)(L0 + PI_BYTES + PI_AM);
    {   float q1[8], k1[8], v1[8];
#pragma unroll
        for (int j = 0; j < 8; ++j) { q1[j] = 0.f; k1[j] = 0.f; v1[j] = 0.f; }
        const float* cw = args->in[4] + (size_t)l * 5 * 1152 + 64 * head + 8 * p;
        const int tr = ia + 32 * dir;
        u32x4 rqa[5], rka[5], rva[5];
#pragma unroll
        for (int tp = 0; tp < 5; ++tp) { const int pp = n * 64 + tr + tp - 2, ppc = pp < 0 ? 0 : (pp >= c.seqlen ? c.seqlen - 1 : pp);
            const bf16_t* rp = PROJ + (size_t)(seq * c.seqlen + ppc) * NPROJ + 64 * head + 8 * p;
            rqa[tp] = *(const u32x4*)(rp + C_QC); rka[tp] = *(const u32x4*)(rp + C_KC); rva[tp] = *(const u32x4*)(rp + C_VC); }
#pragma unroll
        for (int tp = 0; tp < 5; ++tp) { const float* w = cw + tp * 1152;
            const f32x4 wq0 = *(const f32x4*)w, wq1 = *(const f32x4*)(w + 4), wk0 = *(const f32x4*)(w + 384), wk1 = *(const f32x4*)(w + 388), wv0 = *(const f32x4*)(w + 768), wv1 = *(const f32x4*)(w + 772);
            const int pp = n * 64 + tr + tp - 2; const bool inr = (pp >= 0 && pp < c.seqlen);
            { u32x4 rq = rqa[tp], rk = rka[tp], rv = rva[tp];
                if (!inr) { rq = (u32x4){0u, 0u, 0u, 0u}; rk = rq; rv = rq; }
#pragma unroll
                for (int j = 0; j < 4; ++j) { const float a0 = (j < 2) ? wq0[2 * j] : wq1[2 * j - 4], a1 = (j < 2) ? wq0[2 * j + 1] : wq1[2 * j - 3];
                    const float b0 = (j < 2) ? wk0[2 * j] : wk1[2 * j - 4], b1 = (j < 2) ? wk0[2 * j + 1] : wk1[2 * j - 3];
                    const float c0 = (j < 2) ? wv0[2 * j] : wv1[2 * j - 4], c1 = (j < 2) ? wv0[2 * j + 1] : wv1[2 * j - 3];
                    q1[2 * j] += a0 * bflo(rq[j]); q1[2 * j + 1] += a1 * bfhi(rq[j]);
                    k1[2 * j] += b0 * bflo(rk[j]); k1[2 * j + 1] += b1 * bfhi(rk[j]);
                    v1[2 * j] += c0 * bflo(rv[j]); v1[2 * j + 1] += c1 * bfhi(rv[j]); } } }
        float sq = 0.f, sk = 0.f;
#pragma unroll
        for (int j = 0; j < 8; ++j) { q1[j] = siluf_(q1[j]); k1[j] = siluf_(k1[j]); v1[j] = siluf_(v1[j]); sq += q1[j] * q1[j]; sk += k1[j] * k1[j]; }
        sq += __shfl_xor(sq, 1); sq += __shfl_xor(sq, 2); sq += __shfl_xor(sq, 4);
        sk += __shfl_xor(sk, 1); sk += __shfl_xor(sk, 2); sk += __shfl_xor(sk, 4);
        const float rq_ = 0.125f * frsq(sq + NORM_EPS), rk_ = frsq(sk + NORM_EPS);
        f32x4 o0, o1;
        o0[0] = q1[0] * rq_; o0[1] = q1[1] * rq_; o0[2] = q1[2] * rq_; o0[3] = q1[3] * rq_; o1[0] = q1[4] * rq_; o1[1] = q1[5] * rq_; o1[2] = q1[6] * rq_; o1[3] = q1[7] * rq_;
        *(LAS f32x4*)(XQ + tr * 64 + 8 * p) = o0; *(LAS f32x4*)(XQ + tr * 64 + 8 * p + 4) = o1;
        o0[0] = k1[0] * rk_; o0[1] = k1[1] * rk_; o0[2] = k1[2] * rk_; o0[3] = k1[3] * rk_; o1[0] = k1[4] * rk_; o1[1] = k1[5] * rk_; o1[2] = k1[6] * rk_; o1[3] = k1[7] * rk_;
        *(LAS f32x4*)(XK + tr * 64 + 8 * p) = o0; *(LAS f32x4*)(XK + tr * 64 + 8 * p + 4) = o1;
        o0[0] = v1[0]; o0[1] = v1[1]; o0[2] = v1[2]; o0[3] = v1[3]; o1[0] = v1[4]; o1[1] = v1[5]; o1[2] = v1[6]; o1[3] = v1[7];
        *(LAS f32x4*)(XV + tr * 64 + 8 * p) = o0; *(LAS f32x4*)(XV + tr * 64 + 8 * p + 4) = o1; }
#pragma unroll
    for (int h2 = 0; h2 < 2; ++h2) {
        if (p == 0) { const int i = ia + 32 * h2, tokl = dir ? 63 - i : i; const float* bar = BA + (size_t)(seq * c.seqlen + n * 64 + tokl) * 32;
            const float bl = bar[dir * 6 + head], al = bar[12 + dir * 6 + head];
            const float xx = al + args->in[6][l * 12 + dir * 6 + head];
            const float sp = xx > 20.f ? xx : log1pf(expf(xx));
            GV[i] = -expf(args->in[5][l * 12 + dir * 6 + head]) * sp; BV[i] = sigmoidf_(bl); } }
    __syncthreads();
    float q[2][8], k[2][8], v[2][8];
#pragma unroll
    for (int h2 = 0; h2 < 2; ++h2) { const int i = ia + 32 * h2, tokl = dir ? 63 - i : i;
        const f32x4 a0 = *(const LAS f32x4*)(XQ + tokl * 64 + 8 * p), a1 = *(const LAS f32x4*)(XQ + tokl * 64 + 8 * p + 4), b0 = *(const LAS f32x4*)(XK + tokl * 64 + 8 * p), b1 = *(const LAS f32x4*)(XK + tokl * 64 + 8 * p + 4),
                    c0 = *(const LAS f32x4*)(XV + tokl * 64 + 8 * p), c1 = *(const LAS f32x4*)(XV + tokl * 64 + 8 * p + 4);
#pragma unroll
        for (int j = 0; j < 4; ++j) { q[h2][j] = a0[j]; q[h2][4 + j] = a1[j]; k[h2][j] = b0[j]; k[h2][4 + j] = b1[j]; v[h2][j] = c0[j]; v[h2][4 + j] = c1[j]; } }
    float gcl_;
    { float x = GV[lane];
#pragma unroll
        for (int o = 1; o < 64; o <<= 1) { const float y = __shfl_up(x, o); if (lane >= o) x += y; }
        if (wg == 0) GC[lane] = x;
        gcl_ = x; }
    const float gc0 = __shfl(gcl_, ia), gc1 = __shfl(gcl_, ia + 32), gcl = __shfl(gcl_, 63);
#pragma unroll
    for (int h2 = 0; h2 < 2; ++h2) { const int i = ia + 32 * h2; u32x4 wq, wk;
#pragma unroll
        for (int j = 0; j < 4; ++j) { wq[j] = pk2(q[h2][2 * j], q[h2][2 * j + 1]); wk[j] = pk2(k[h2][2 * j], k[h2][2 * j + 1]); }
        *(LAS u32x4*)(P0 + i * TLD + 8 * p) = wq; *(LAS u32x4*)(P1 + i * TLD + 8 * p) = wk; }
    __syncthreads();
    { const int mat = wg >> 1, mt = wg & 1, hh = lane >> 5;
#pragma unroll
        for (int nt = 0; nt < 2; ++nt) { const int jc = 32 * nt + (lane & 31);
            const f32x16 a = mm_tile(mat ? P0 : P1, P1, 32 * mt, 32 * nt, lane);
            const float gj = GC[jc];
#pragma unroll
            for (int r = 0; r < 16; ++r) { const int ii = 32 * mt + crow(r, hh); const float gi = GC[ii];
                if (mat == 0) AM[ii * 68 + jc] = (jc < ii) ? BV[ii] * a[r] * __expf(gi - gj) : 0.f;
                else INTRA[ii * TLD + jc] = (bf16_t)(pk2((jc <= ii) ? a[r] * __expf(gi - gj) : 0.f, 0.f) & 0xffffu); } } }
    __syncthreads();
    if (wg == dir) {
        const int b = lane >> 5, cidx = lane & 31; float t[32];
#pragma unroll
        for (int ii = 0; ii < 32; ++ii) t[ii] = (ii == cidx) ? 1.f : 0.f;
        const LAS float* Ab = AM + (32 * b) * 68 + 32 * b;
#pragma unroll
        for (int ii = 1; ii < 32; ++ii) { float acc = 0.f;
#pragma unroll
            for (int j4 = 0; j4 < ii; j4 += 4) { const f32x4 a4 = *(const LAS f32x4*)(Ab + ii * 68 + j4);
                acc += a4[0] * t[j4]; acc += a4[1] * t[j4 + 1]; acc += a4[2] * t[j4 + 2]; acc += a4[3] * t[j4 + 3]; }
            t[ii] -= acc; }
        LAS float* td = b ? TD1 : TD0; const int tds = b ? 36 : 48;
#pragma unroll
        for (int ii = 0; ii < 32; ++ii) { td[ii * tds + cidx] = t[ii]; TT[(32 * b + ii) * TLD + 32 * b + cidx] = (bf16_t)(pk2(t[ii], 0.f) & 0xffffu); }
    }
#pragma unroll
    for (int h2 = 0; h2 < 2; ++h2) { const int i = ia + 32 * h2; const float be = BV[i], eg = __expf(h2 ? gc1 : gc0);
#pragma unroll
        for (int j = 0; j < 8; ++j) { const int d = 8 * p + j, o_ = d * TLD + (i ^ tsw(d)); P0[o_] = (bf16_t)(pk2(k[h2][j] * be * eg, 0.f) & 0xffffu); P1[o_] = (bf16_t)(pk2(v[h2][j] * be, 0.f) & 0xffffu); } }
    { unsigned zz; asm volatile("v_mov_b32 %0, 0" : "=v"(zz)); u32x2 z; z.x = zz; z.y = zz; *(LAS u32x2*)(TT + (tg >> 3) * TLD + 32 + 4 * (tg & 7)) = z; }
    __syncthreads();
    { const int qi = wg >> 1, qj = wg & 1, r16 = lane & 15, g4 = lane >> 4; f32x4 pc = {0.f, 0.f, 0.f, 0.f};
#pragma unroll
        for (int kk = 0; kk < 8; ++kk) pc = __builtin_amdgcn_mfma_f32_16x16x4f32(AM[(32 + 16 * qi + r16) * 68 + 4 * kk + g4], TD0[(4 * kk + g4) * 48 + 16 * qj + r16], pc, 0, 0, 0);
#pragma unroll
        for (int r = 0; r < 4; ++r) PM[(16 * qi + 4 * g4 + r) * 48 + 16 * qj + r16] = pc[r]; }
    __syncthreads();
    { const int qi = wg >> 1, qj = wg & 1, r16 = lane & 15, g4 = lane >> 4; f32x4 pc = {0.f, 0.f, 0.f, 0.f};
#pragma unroll
        for (int kk = 0; kk < 8; ++kk) pc = __builtin_amdgcn_mfma_f32_16x16x4f32(TD1[(16 * qi + r16) * 36 + 4 * kk + g4], PM[(4 * kk + g4) * 48 + 16 * qj + r16], pc, 0, 0, 0);
#pragma unroll
        for (int r = 0; r < 4; ++r) TT[(32 + 16 * qi + 4 * g4 + r) * TLD + 16 * qj + r16] = (bf16_t)(pk2(-pc[r], 0.f) & 0xffffu); }
    __syncthreads();
    { const int which = wg >> 1, mt = wg & 1, hh = lane >> 5;
#pragma unroll
        for (int nt = 0; nt < 2; ++nt) { const int dc = 32 * nt + (lane & 31);
            const f32x16 a = mm_tile<false, true>(TT, which ? P1 : P0, 32 * mt, 32 * nt, lane);
            LAS bf16_t* dst = (which ? UT : WT) + dc * TLD; const int sw = tsw(dc);
#pragma unroll
            for (int g = 0; g < 4; ++g) { u32x2 w; w.x = pk2(a[4 * g], a[4 * g + 1]); w.y = pk2(a[4 * g + 2], a[4 * g + 3]); *(LAS u32x2*)(dst + ((32 * mt + 8 * g + 4 * hh) ^ sw)) = w; } } }
    __syncthreads();
#pragma unroll
    for (int h2 = 0; h2 < 2; ++h2) { const int i = ia + 32 * h2; const float gci = h2 ? gc1 : gc0, eg = __expf(gci), ekd = __expf(gcl - gci); u32x4 wqd;
#pragma unroll
        for (int j = 0; j < 4; ++j) wqd[j] = pk2(q[h2][2 * j] * eg, q[h2][2 * j + 1] * eg);
        *(LAS u32x4*)(P1 + i * TLD + 8 * p) = wqd;
#pragma unroll
        for (int j = 0; j < 8; ++j) { const int d = 8 * p + j; P0[d * TLD + (i ^ tsw(d))] = (bf16_t)(pk2(k[h2][j] * ekd, 0.f) & 0xffffu); } }
    __syncthreads();
    { const int hh = lane >> 5, rr = lane & 31;
        if (wg == 0) {
#pragma unroll
            for (int t4 = 0; t4 < 4; ++t4) { const int mtb = t4 >> 1, nta = t4 & 1; const f32x16 a = mm_tile<true, true>(WT, P0, 32 * mtb, 32 * nta, lane);
                f32x16 na; for (int r = 0; r < 16; ++r) na[r] = -a[r];
                *(bf16x8*)(G + (size_t)((nta * 4 + 2 * mtb) * 64 + lane) * 16) = pack8<0>(na); *(bf16x8*)(G + (size_t)((nta * 4 + 2 * mtb + 1) * 64 + lane) * 16) = pack8<1>(na); }
        } else if (wg == 1) {
#pragma unroll
            for (int t4 = 0; t4 < 4; ++t4) { const int mta = t4 >> 1, nte = t4 & 1; const f32x16 a = mm_tile<true, true>(P0, UT, 32 * mta, 32 * nte, lane);
                bf16x8* dp = (bf16x8*)(G + 8192 + (size_t)((nte * 2 + mta) * 64 + lane) * 32); dp[0] = pack8<0>(a); dp[1] = pack8<1>(a); }
        } else if (wg == 2) {
#pragma unroll
            for (int t4 = 0; t4 < 4; ++t4) { const int mtb = t4 >> 1, nti = t4 & 1; const f32x16 a = mm_tile<true, false>(WT, INTRA, 32 * mtb, 32 * nti, lane);
                f32x16 qe; const LAS bf16_t* qd = P1 + (32 * nti + rr) * TLD + 32 * mtb + 4 * hh;
#pragma unroll
                for (int g = 0; g < 4; ++g) { const u32x2 w = *(const LAS u32x2*)(qd + 8 * g); qe[4 * g] = bflo(w.x) - a[4 * g]; qe[4 * g + 1] = bfhi(w.x) - a[4 * g + 1]; qe[4 * g + 2] = bflo(w.y) - a[4 * g + 2]; qe[4 * g + 3] = bfhi(w.y) - a[4 * g + 3]; }
                *(bf16x8*)(G + 16384 + (size_t)((nti * 4 + 2 * mtb) * 64 + lane) * 16) = pack8<0>(qe); *(bf16x8*)(G + 16384 + (size_t)((nti * 4 + 2 * mtb + 1) * 64 + lane) * 16) = pack8<1>(qe); }
        } else {
#pragma unroll
            for (int t4 = 0; t4 < 4; ++t4) { const int mti = t4 >> 1, nte = t4 & 1; const f32x16 a = mm_tile<false, true>(INTRA, UT, 32 * mti, 32 * nte, lane);
                bf16_t* dst = (bf16_t*)(G + 24576) + (size_t)(32 * nte + rr) * 64 + 32 * mti + 4 * hh;
#pragma unroll
                for (int g = 0; g < 4; ++g) { u32x2 w; w.x = pk2(a[4 * g], a[4 * g + 1]); w.y = pk2(a[4 * g + 2], a[4 * g + 3]); *(u32x2*)(dst + 8 * g) = w; } }
            if (lane == 0) *(float*)(G + 40960) = __expf(gcl);
        } }
    __syncthreads();
}

DI void pv_accum(const f32x16 (&acc)[2][2], f32x16 (&o)[2][2], const LAS bf16_t* Vt, int lane) {
    const int r = lane & 31, hh = lane >> 5;
#pragma unroll
    for (int mt = 0; mt < 2; ++mt) {
        {   const bf16x8 p0 = pack8<0>(acc[mt][0]), p1 = pack8<0>(acc[mt][1]);
#pragma unroll
            for (int mo = 0; mo < 2; ++mo) { const LAS bf16_t* s = Vt + (32 * mo + r) * TLD; const int c0 = (32 * mt + 4 * hh) ^ tsw(32 * mo + r);
                const u32x2 lo = *(const LAS u32x2*)(s + c0), hi = *(const LAS u32x2*)(s + (c0 ^ 8)); u32x4 w; w.x = lo.x; w.y = lo.y; w.z = hi.x; w.w = hi.y; const bf16x8 vf = __builtin_bit_cast(bf16x8, w);
                o[mo][0] = MFMA32(vf, p0, o[mo][0]); o[mo][1] = MFMA32(vf, p1, o[mo][1]); } }
        {   const bf16x8 p0 = pack8<1>(acc[mt][0]), p1 = pack8<1>(acc[mt][1]);
#pragma unroll
            for (int mo = 0; mo < 2; ++mo) { const LAS bf16_t* s = Vt + (32 * mo + r) * TLD; const int c0 = (32 * mt + 16 + 4 * hh) ^ tsw(32 * mo + r);
                const u32x2 lo = *(const LAS u32x2*)(s + c0), hi = *(const LAS u32x2*)(s + (c0 ^ 8)); u32x4 w; w.x = lo.x; w.y = lo.y; w.z = hi.x; w.w = hi.y; const bf16x8 vf = __builtin_bit_cast(bf16x8, w);
                o[mo][0] = MFMA32(vf, p0, o[mo][0]); o[mo][1] = MFMA32(vf, p1, o[mo][1]); } }
    }
}
template <class F> DI void stage_vt(LAS bf16_t* Vt, int lane, F vrow) {
#pragma unroll
    for (int it = 0; it < 8; ++it) { const int id = it * 64 + lane, key = id >> 3, part = id & 7;
        const u32x4 w = *(const u32x4*)(vrow(key) + 8 * part);
#pragma unroll
        for (int j = 0; j < 4; ++j) { const int d0 = 8 * part + 2 * j, ks_ = key ^ tsw(d0); Vt[d0 * TLD + ks_] = (bf16_t)(w[j] & 0xffffu); Vt[(d0 + 1) * TLD + ks_] = (bf16_t)(w[j] >> 16); } }
}
DI void write_o_slot(LAS float* SL, const f32x16 (&o)[2][2], int lane) {
    const int r = lane & 31, hh = lane >> 5;
#pragma unroll
    for (int mo = 0; mo < 2; ++mo)
#pragma unroll
        for (int nt = 0; nt < 2; ++nt)
#pragma unroll
            for (int g = 0; g < 4; ++g) { f32x4 v; v[0] = o[mo][nt][4 * g]; v[1] = o[mo][nt][4 * g + 1]; v[2] = o[mo][nt][4 * g + 2]; v[3] = o[mo][nt][4 * g + 3];
                *(LAS f32x4*)(SL + (32 * nt + r) * 68 + 32 * mo + 8 * g + 4 * hh) = v; }
}
DI void add_o_slot(const LAS float* SL, f32x16 (&o)[2][2], int lane) {
    const int r = lane & 31, hh = lane >> 5;
#pragma unroll
    for (int mo = 0; mo < 2; ++mo)
#pragma unroll
        for (int nt = 0; nt < 2; ++nt)
#pragma unroll
            for (int g = 0; g < 4; ++g) { const f32x4 v = *(const LAS f32x4*)(SL + (32 * nt + r) * 68 + 32 * mo + 8 * g + 4 * hh);
                o[mo][nt][4 * g] += v[0]; o[mo][nt][4 * g + 1] += v[1]; o[mo][nt][4 * g + 2] += v[2]; o[mo][nt][4 * g + 3] += v[3]; }
}

constexpr int WAREA = 10240;
DI void osm_update(f32x16 (&acc)[2][2], f32x16 (&o)[2][2], float (&m)[2], float (&l)[2]) {
#pragma unroll
    for (int nt = 0; nt < 2; ++nt) { float mx = -1e30f;
#pragma unroll
        for (int mt = 0; mt < 2; ++mt)
#pragma unroll
            for (int g = 0; g < 16; ++g) mx = fmaxf(mx, acc[mt][nt][g]);
        mx = fmaxf(mx, __shfl_xor(mx, 32));
        const float mn = fmaxf(m[nt], mx), sc = __expf(m[nt] - mn); float sm = 0.f;
#pragma unroll
        for (int mt = 0; mt < 2; ++mt)
#pragma unroll
            for (int g = 0; g < 16; ++g) { const float pz = __expf(acc[mt][nt][g] - mn); acc[mt][nt][g] = pz; sm += pz; }
        sm += __shfl_xor(sm, 32);
        l[nt] = l[nt] * sc + sm; m[nt] = mn;
#pragma unroll
        for (int g = 0; g < 16; ++g) { o[0][nt][g] *= sc; o[1][nt][g] *= sc; } }
}
template <class F> DI void store_o_rows(LAS bf16_t* T, const f32x16 (&o)[2][2], const float (&scale)[2], int lane, F rowp) {
    const int r = lane & 31, hh = lane >> 5;
#pragma unroll
    for (int mo = 0; mo < 2; ++mo)
#pragma unroll
        for (int nt = 0; nt < 2; ++nt)
#pragma unroll
            for (int g = 0; g < 4; ++g) { u32x2 w; w.x = pk2(o[mo][nt][4 * g] * scale[nt], o[mo][nt][4 * g + 1] * scale[nt]); w.y = pk2(o[mo][nt][4 * g + 2] * scale[nt], o[mo][nt][4 * g + 3] * scale[nt]);
                *(LAS u32x2*)(T + (32 * nt + r) * TLD + 32 * mo + 8 * g + 4 * hh) = w; }
    asm volatile("s_waitcnt lgkmcnt(0)" ::: "memory");
#pragma unroll
    for (int it = 0; it < 8; ++it) { const int id = it * 64 + lane, q = id >> 3, part = id & 7; *(u32x4*)(rowp(q) + 8 * part) = *(const LAS u32x4*)(T + q * TLD + 8 * part); }
    asm volatile("s_waitcnt lgkmcnt(0)" ::: "memory");
}
DI void na_wave_unit(KArgs args, LAS unsigned char* L, const Ctx& c, int u, int lane, int wave) {
    const int l = c.layer, head = u & 3, gr = u >> 2, rows = c.seqlen >> 6, seq = gr / rows, r = gr % rows;
    int rs = r - 4; rs = rs < 0 ? 0 : (rs > rows - 8 ? rows - 8 : rs);
    const bf16_t* PROJ = BIGP(bf16_t, B_PROJ);
    const size_t tq0 = (size_t)seq * c.seqlen + (size_t)r * 64;
    LAS bf16_t* Vt = (LAS bf16_t*)(L + wave * WAREA);
    LAS float* BIAS = (LAS float*)(L + wave * WAREA + 9216);
    const int rr = lane & 31, hh = lane >> 5;
#pragma unroll
    for (int w = 0; w < 4; ++w) { const int idx = w * 64 + lane, kw = idx >> 5, dc = idx & 31;
        if (dc < 31) BIAS[idx] = args->in[3][(((size_t)l * 4 + head) * 15 + (rs + kw - r + 7)) * 31 + dc]; }
    bf16x8 qf[2][4];
#pragma unroll
    for (int nt = 0; nt < 2; ++nt)
#pragma unroll
        for (int ks = 0; ks < 4; ++ks) qf[nt][ks] = *(const bf16x8*)(PROJ + (tq0 + 32 * nt + rr) * NPROJ + C_QA + 64 * head + 16 * ks + 8 * hh);
    f32x16 o[2][2]; o[0][0] = zero16(); o[0][1] = zero16(); o[1][0] = zero16(); o[1][1] = zero16();
    float m[2] = {-1e30f, -1e30f}, ls[2] = {0.f, 0.f};
    for (int w = 0; w < 8; ++w) {
        const size_t tk0 = (size_t)seq * c.seqlen + (size_t)(rs + w) * 64;
        asm volatile("s_waitcnt lgkmcnt(0)" ::: "memory");
        stage_vt(Vt, lane, [&](int key) { return PROJ + (tk0 + key) * NPROJ + C_VA + 64 * head; });
        f32x16 acc[2][2]; acc[0][0] = zero16(); acc[0][1] = zero16(); acc[1][0] = zero16(); acc[1][1] = zero16();
#pragma unroll
        for (int mt = 0; mt < 2; ++mt)
#pragma unroll
            for (int ks = 0; ks < 4; ++ks) { const bf16x8 kf = *(const bf16x8*)(PROJ + (tk0 + 32 * mt + rr) * NPROJ + C_KA + 64 * head + 16 * ks + 8 * hh);
                acc[mt][0] = MFMA32(kf, qf[0][ks], acc[mt][0]); acc[mt][1] = MFMA32(kf, qf[1][ks], acc[mt][1]); }
        asm volatile("s_waitcnt lgkmcnt(0)" ::: "memory");
        const LAS float* brow = BIAS + w * 32;
#pragma unroll
        for (int nt = 0; nt < 2; ++nt) { const int qc = 32 * nt + rr; int ws = qc - 8; ws = ws < 0 ? 0 : (ws > 48 ? 48 : ws);
#pragma unroll
            for (int mt = 0; mt < 2; ++mt)
#pragma unroll
                for (int g = 0; g < 16; ++g) { const int kc = 32 * mt + crow(g, hh); const bool ok = (kc >= ws) && (kc < ws + 16);
                    acc[mt][nt][g] = ok ? acc[mt][nt][g] * 0.125f + brow[ok ? (kc - qc + 15) : 0] : -1e30f; } }
        osm_update(acc, o, m, ls);
        pv_accum(acc, o, Vt, lane);
    }
    asm volatile("s_waitcnt lgkmcnt(0)" ::: "memory");
    const float sc[2] = {frcp(ls[0]), frcp(ls[1])};
    store_o_rows(Vt, o, sc, lane, [&](int q) { return BIGP(bf16_t, B_ONA) + (tq0 + q) * 768 + 64 * head; });
}
DI void rope_frag4(bf16x8 (&f)[4], const float* cs, int hh) {
#pragma unroll
    for (int ks = 0; ks < 2; ++ks) { const float* cp = cs + 16 * ks + 8 * hh;
        const f32x4 c0 = *(const f32x4*)cp, c1 = *(const f32x4*)(cp + 4), s0 = *(const f32x4*)(cp + 32), s1 = *(const f32x4*)(cp + 36);
        const u32x4 a = __builtin_bit_cast(u32x4, f[ks]), b = __builtin_bit_cast(u32x4, f[ks + 2]); u32x4 ra, rb;
#pragma unroll
        for (int j = 0; j < 4; ++j) { const float cl = (j < 2) ? c0[2 * j] : c1[2 * j - 4], ch = (j < 2) ? c0[2 * j + 1] : c1[2 * j - 3];
            const float sl = (j < 2) ? s0[2 * j] : s1[2 * j - 4], sh = (j < 2) ? s0[2 * j + 1] : s1[2 * j - 3];
            const float x1l = bflo(a[j]), x1h = bfhi(a[j]), x2l = bflo(b[j]), x2h = bfhi(b[j]);
            ra[j] = pk2(x1l * cl - x2l * sl, x1h * ch - x2h * sh); rb[j] = pk2(x1l * sl + x2l * cl, x1h * sh + x2h * ch); }
        f[ks] = __builtin_bit_cast(bf16x8, ra); f[ks + 2] = __builtin_bit_cast(bf16x8, rb); }
}
DI void dil_wave_unit(KArgs args, LAS unsigned char* L, const Ctx& c, int u, int lane, int wave) {
    const int hd = u & 1, uu = u >> 1, upg = c.stok >> 6, g = uu / upg, v = uu % upg, ups = c.seqlen >> 6, seq = v / ups, wq = v % ups;
    const int dsh = 2 * g, dd = 1 << dsh, nb = ups >> dsh, cls = wq / nb, jb = wq % nb, head = 2 * g + hd;
    const bf16_t* PROJ = BIGP(bf16_t, B_PROJ); const float* CS = WSP(float, WS_CS);
    const size_t sb = (size_t)seq * c.seqlen;
    const int rr = lane & 31, hh = lane >> 5;
    LAS bf16_t* Vt = (LAS bf16_t*)(L + wave * WAREA);
    bf16x8 qf[2][4];
#pragma unroll
    for (int nt = 0; nt < 2; ++nt) { const int pos = cls + dd * (64 * jb + 32 * nt + rr);
#pragma unroll
        for (int ks = 0; ks < 4; ++ks) qf[nt][ks] = *(const bf16x8*)(PROJ + (sb + pos) * NPROJ + C_QD + 64 * head + 16 * ks + 8 * hh);
        rope_frag4(qf[nt], CS + (size_t)pos * 64, hh); }
    f32x16 o[2][2]; o[0][0] = zero16(); o[0][1] = zero16(); o[1][0] = zero16(); o[1][1] = zero16();
    float m[2] = {-1e30f, -1e30f}, ls[2] = {0.f, 0.f};
    for (int kt = 0; kt < 3; ++kt) { const int kj = jb - 1 + kt;
        if (kj < 0 || kj >= nb) continue;
        asm volatile("s_waitcnt lgkmcnt(0)" ::: "memory");
        stage_vt(Vt, lane, [&](int key) { return PROJ + (sb + cls + (size_t)dd * (64 * kj + key)) * NPROJ + C_VD + 64 * head; });
        f32x16 acc[2][2]; acc[0][0] = zero16(); acc[0][1] = zero16(); acc[1][0] = zero16(); acc[1][1] = zero16();
#pragma unroll
        for (int mt = 0; mt < 2; ++mt) { const int pos = cls + dd * (64 * kj + 32 * mt + rr); bf16x8 kf[4];
#pragma unroll
            for (int ks = 0; ks < 4; ++ks) kf[ks] = *(const bf16x8*)(PROJ + (sb + pos) * NPROJ + C_KD + 64 * head + 16 * ks + 8 * hh);
            rope_frag4(kf, CS + (size_t)pos * 64, hh);
#pragma unroll
            for (int ks = 0; ks < 4; ++ks) { acc[mt][0] = MFMA32(kf[ks], qf[0][ks], acc[mt][0]); acc[mt][1] = MFMA32(kf[ks], qf[1][ks], acc[mt][1]); } }
#pragma unroll
        for (int nt = 0; nt < 2; ++nt) { const int qc = 32 * nt + rr;
#pragma unroll
            for (int mt = 0; mt < 2; ++mt)
#pragma unroll
                for (int gg = 0; gg < 16; ++gg) { const int kc = 32 * mt + crow(gg, hh); const bool ok = (kt == 1) || (kt == 0 ? (kc >= qc) : (kc <= qc));
                    acc[mt][nt][gg] = ok ? acc[mt][nt][gg] * 0.125f : -1e30f; } }
        osm_update(acc, o, m, ls);
        pv_accum(acc, o, Vt, lane);
    }
    asm volatile("s_waitcnt lgkmcnt(0)" ::: "memory");
    bf16_t* DP = BIGP(bf16_t, B_DILP); float* DM = BIGP(float, B_DILM);
    const float one[2] = {1.f, 1.f};
    store_o_rows(Vt, o, one, lane, [&](int q) { return DP + ((((size_t)g * SLABMAX + sb + cls + (size_t)dd * (64 * jb + q)) * 2 + hd)) * 64; });
    if (hh == 0) {
#pragma unroll
        for (int nt = 0; nt < 2; ++nt) { const size_t base = (((size_t)g * SLABMAX + sb + cls + (size_t)dd * (64 * jb + 32 * nt + rr)) * 2 + hd); DM[base * 2] = m[nt]; DM[base * 2 + 1] = ls[nt]; } }
}

DI void phase_mix_a(KArgs args, LAS unsigned char* L, const Ctx& c) {
    const int N_PREP = (c.stok >> 6) * 6;
    for (int u = c.bid; u < N_PREP; u += c.G) gdn_prep_pair(args, L, c, u);
}
DI void attn_wave_units(KArgs args, LAS unsigned char* L, const Ctx& c) {
    int tid = c.tid; asm volatile("" : "+v"(tid)); const int lane = tid & 63, wave = __builtin_amdgcn_readfirstlane(tid >> 6);
    const int nch_ = c.stok >> 6, N_NA = nch_ * 4, N_DIL = nch_ * 6;
    unsigned* q = (unsigned*)(c.ws + WS_CTL) + 32768 + 128 * (c.layer * 4 + c.slab);
    for (;;) { unsigned u = 0; if (lane == 0) u = __hip_atomic_fetch_add(q, 1u, __ATOMIC_RELAXED, __HIP_MEMORY_SCOPE_AGENT);
        u = (unsigned)__builtin_amdgcn_readfirstlane((int)u); if (u >= (unsigned)N_NA) break; na_wave_unit(args, L, c, (int)u, lane, wave); }
    int tid2 = c.tid; asm volatile("" : "+v"(tid2)); const int lane2 = tid2 & 63, wave2 = __builtin_amdgcn_readfirstlane(tid2 >> 6);
    for (;;) { unsigned u = 0; if (lane2 == 0) u = __hip_atomic_fetch_add(q + 64, 1u, __ATOMIC_RELAXED, __HIP_MEMORY_SCOPE_AGENT);
        u = (unsigned)__builtin_amdgcn_readfirstlane((int)u); if (u >= (unsigned)N_DIL) break; dil_wave_unit(args, L, c, (int)u, lane2, wave2); }
}

DI void phase_select(KArgs args, LAS unsigned char* L, const Ctx& c, int inst);
DI void phase_scan(KArgs args, LAS unsigned char* L, const Ctx& c) {
    if (c.slab == NSLAB - 1 && c.bid >= 24 && c.bid < 40) { phase_select(args, L, c, c.bid - 24); return; }
    const int nwu = c.nseq * 24, wu = c.bid;
    if (wu < nwu && c.wave == 0) {
        const int lane = c.lane, rr = lane & 31, hh = lane >> 5;
        const int chain = wu >> 1, nt = wu & 1, seq = chain / 12, rem = chain % 12, head = rem >> 1, dir = rem & 1;
        const int nch = c.seqlen >> 6, gch0 = seq * nch;
        unsigned char* GS = BIGP(unsigned char, B_GSCR);
        f32x16 S[2]; S[0] = zero16(); S[1] = zero16();
        bf16x8 A[2][2][4]; u32x4 cm[2][2][2]; float gl[2];
        const long gstep = (long)(dir ? -1 : 1) * 12 * GSTRIDE;
        const unsigned char* Gp = GS + (size_t)(((gch0 + (dir ? nch - 1 : 0)) * 6 + head) * 2 + dir) * GSTRIDE;
        unsigned char* Gs = (unsigned char*)Gp;
#define SCAN_LOAD(B) do { _Pragma("unroll") for (int mt = 0; mt < 2; ++mt) { _Pragma("unroll") for (int ks = 0; ks < 4; ++ks) A[B][mt][ks] = *(const bf16x8*)(Gp + (size_t)((mt * 4 + ks) * 64 + lane) * 16); \
            const u32x4* cp = (const u32x4*)(Gp + 8192 + (size_t)((nt * 2 + mt) * 64 + lane) * 32); cm[B][mt][0] = cp[0]; cm[B][mt][1] = cp[1]; } gl[B] = *(const float*)(Gp + 40960); } while (0)
#define SCAN_STEP(B) do { { bf16_t* St = (bf16_t*)(Gs + 32768) + (size_t)(32 * nt + rr) * 64 + 4 * hh; \
            _Pragma("unroll") for (int mt = 0; mt < 2; ++mt) _Pragma("unroll") for (int g = 0; g < 4; ++g) { u32x2 w; w.x = pk2(S[mt][4 * g], S[mt][4 * g + 1]); w.y = pk2(S[mt][4 * g + 2], S[mt][4 * g + 3]); *(u32x2*)(St + 32 * mt + 8 * g) = w; } } \
            const bf16x8 b0 = pack8<0>(S[0]), b1 = pack8<1>(S[0]), b2 = pack8<0>(S[1]), b3 = pack8<1>(S[1]); f32x16 nw[2]; \
            _Pragma("unroll") for (int mt = 0; mt < 2; ++mt) { \
                _Pragma("unroll") for (int g = 0; g < 8; ++g) { const unsigned wv = (g < 4) ? cm[B][mt][0][g] : cm[B][mt][1][g - 4]; nw[mt][2 * g] = gl[B] * S[mt][2 * g] + bflo(wv); nw[mt][2 * g + 1] = gl[B] * S[mt][2 * g + 1] + bfhi(wv); } \
                nw[mt] = MFMA32(A[B][mt][0], b0, nw[mt]); nw[mt] = MFMA32(A[B][mt][1], b1, nw[mt]); nw[mt] = MFMA32(A[B][mt][2], b2, nw[mt]); nw[mt] = MFMA32(A[B][mt][3], b3, nw[mt]); } \
            S[0] = nw[0]; S[1] = nw[1]; Gs += gstep; } while (0)
        SCAN_LOAD(0); Gp += gstep; SCAN_LOAD(1); Gp += gstep;
        for (int step = 0; step < nch; step += 2) {
            const bool more = step + 2 < nch;
            if (!more) Gp -= 2 * gstep;
            SCAN_STEP(0); SCAN_LOAD(0); Gp += gstep;
            SCAN_STEP(1); SCAN_LOAD(1); Gp += gstep;
        }
#undef SCAN_LOAD
#undef SCAN_STEP
    }
    attn_wave_units(args, L, c);
}

DI void dil_merge(const Ctx& c) {
    { const bf16_t* DP = BIGP(bf16_t, B_DILP); const float* DM = BIGP(float, B_DILM); bf16_t* OD = BIGP(bf16_t, B_ONA) + 256;
        for (int it = c.bid * 512 + c.tid; it < c.stok * 32; it += c.G * 512) { const int tok = it >> 5, part = it & 31;
            u32x4 w = {0u, 0u, 0u, 0u};
            if (part < 16) { const int hd = part >> 3, p = part & 7; float m[3], dn[3];
#pragma unroll
                for (int g = 0; g < 3; ++g) { const size_t b = (((size_t)g * SLABMAX + tok) * 2 + hd); m[g] = DM[b * 2]; dn[g] = DM[b * 2 + 1]; }
                const float M = fmaxf(m[0], fmaxf(m[1], m[2])); float num[8], den = 0.f;
#pragma unroll
                for (int j = 0; j < 8; ++j) num[j] = 0.f;
#pragma unroll
                for (int g = 0; g < 3; ++g) { const float f = __expf(m[g] - M); den += f * dn[g]; const u32x4 a = *(const u32x4*)(DP + (((size_t)g * SLABMAX + tok) * 2 + hd) * 64 + 8 * p);
                    num[0] += f * bflo(a[0]); num[1] += f * bfhi(a[0]); num[2] += f * bflo(a[1]); num[3] += f * bfhi(a[1]); num[4] += f * bflo(a[2]); num[5] += f * bfhi(a[2]); num[6] += f * bflo(a[3]); num[7] += f * bfhi(a[3]); }
                const float inv = frcp(den);
                w.x = pk2(num[0] * inv, num[1] * inv); w.y = pk2(num[2] * inv, num[3] * inv); w.z = pk2(num[4] * inv, num[5] * inv); w.w = pk2(num[6] * inv, num[7] * inv); }
            if (part < 16) *(u32x4*)(OD + (size_t)tok * 768 + 8 * part) = w; } }
}

DI void phase_gdn_out(KArgs args, LAS unsigned char* L, const Ctx& c) {
    dil_merge(c);
    const int lane = c.lane, wave = c.wave, tid = c.tid, l = c.layer;
    const bf16_t* PROJ = BIGP(bf16_t, B_PROJ); unsigned char* GS = BIGP(unsigned char, B_GSCR); bf16_t* OG = BIGP(bf16_t, B_ONA) + 384;
    LAS float* OF = (LAS float*)L;
    for (int u = c.bid; u < (c.stok >> 6) * 6; u += c.G) { const int gch = u / 6, head = u % 6;
        { const int dir = wave >> 2, mt = (wave >> 1) & 1, nt = wave & 1, rr = lane & 31, hh = lane >> 5;
            const unsigned char* G = GS + (size_t)((gch * 6 + head) * 2 + dir) * GSTRIDE;
            const bf16_t* Qe = (const bf16_t*)(G + 16384); const bf16_t* Oct = (const bf16_t*)(G + 24576); const bf16_t* St = (const bf16_t*)(G + 32768);
            f32x16 acc = zero16();
#pragma unroll
            for (int ks = 0; ks < 4; ++ks) { const bf16x8 a = *(const bf16x8*)(Qe + (size_t)((mt * 4 + ks) * 64 + lane) * 8);
                const bf16_t* sp = St + (32 * nt + rr) * 64 + 32 * (ks >> 1) + 16 * (ks & 1) + 4 * hh; const u32x2 lo = *(const u32x2*)sp, hi = *(const u32x2*)(sp + 8);
                u32x4 bw; bw.x = lo.x; bw.y = lo.y; bw.z = hi.x; bw.w = hi.y; acc = MFMA32(a, __builtin_bit_cast(bf16x8, bw), acc); }
            const int e = 32 * nt + rr;
#pragma unroll
            for (int g = 0; g < 4; ++g) { const u32x2 w = *(const u32x2*)(Oct + e * 64 + 32 * mt + 8 * g + 4 * hh);
                const float v0 = acc[4 * g] + bflo(w.x), v1 = acc[4 * g + 1] + bfhi(w.x), v2 = acc[4 * g + 2] + bflo(w.y), v3 = acc[4 * g + 3] + bfhi(w.y);
                const int i0 = 32 * mt + 8 * g + 4 * hh;
#pragma unroll
                for (int j = 0; j < 4; ++j) { const int ii = i0 + j, tl = dir ? 63 - ii : ii; OF[(dir * 64 + tl) * 68 + e] = (j == 0) ? v0 : (j == 1) ? v1 : (j == 2) ? v2 : v3; } } }
        __syncthreads();
        { const int i = tid >> 3, p = tid & 7; const size_t tok = (size_t)gch * 64 + i;
            const LAS float* a = OF + i * 68 + 8 * p; const LAS float* b = OF + (64 + i) * 68 + 8 * p;
            float ov[8]; float ss = 0.f;
#pragma unroll
            for (int j = 0; j < 8; ++j) { ov[j] = a[j] + b[j]; ss += ov[j] * ov[j]; }
            ss += __shfl_xor(ss, 1); ss += __shfl_xor(ss, 2); ss += __shfl_xor(ss, 4);
            const float rs = frsq(ss * (1.0f / 64.0f) + NORM_EPS);
            const u32x4 zw = *(const u32x4*)(PROJ + tok * NPROJ + C_ZC + 64 * head + 8 * p);
            const float* nw = args->in[7] + l * 64 + 8 * p;
            float r[8];
#pragma unroll
            for (int j = 0; j < 4; ++j) { r[2 * j] = ov[2 * j] * rs * nw[2 * j] * siluf_(bflo(zw[j])); r[2 * j + 1] = ov[2 * j + 1] * rs * nw[2 * j + 1] * siluf_(bfhi(zw[j])); }
            u32x4 w; w.x = pk2(r[0], r[1]); w.y = pk2(r[2], r[3]); w.z = pk2(r[4], r[5]); w.w = pk2(r[6], r[7]);
            *(u32x4*)(OG + tok * 768 + 64 * head + 8 * p) = w; }
        __syncthreads();
    }
}

DI void phase_ln1(KArgs args, LAS unsigned char* L, const Ctx& c) {
    const int lane = c.lane, l = c.layer;
    LAS float* WR = (LAS float*)L;
    { const float* wr = args->in[14] + (size_t)l * D * 16;
        for (int i = c.tid; i < D * 16; i += 512) { const int col = i >> 4, e = i & 15, j = col >> 8, ln = (col >> 2) & 63, q = col & 3; WR[((j * 4 + q) * 64 + ln) * 20 + e] = wr[i]; } }
    __syncthreads();
    const float* g1 = args->in[12] + l * D; const float* b1 = args->in[13] + l * D;
    f32x4 gv[4], bv[4];
#pragma unroll
    for (int j = 0; j < 4; ++j) { gv[j] = *(const f32x4*)(g1 + 4 * lane + 256 * j); bv[j] = *(const f32x4*)(b1 + 4 * lane + 256 * j); }
    float* AFF = WSP(float, WS_AFF); int* SLOT = WSP(int, WS_SLOT); bf16_t* XB = WSP(bf16_t, WS_XB);
    f32x4 nv[4];
    { const int rl0 = c.bid * 8 + c.wave; if (rl0 < c.stok) { const float* hp = c.out + ((size_t)c.sbase + rl0) * D;
#pragma unroll
        for (int j = 0; j < 4; ++j) nv[j] = *(const f32x4*)(hp + 4 * lane + 256 * j); } }
    for (int rl = c.bid * 8 + c.wave; rl < c.stok; rl += c.G * 8) { const size_t tok = (size_t)c.sbase + rl;
        float* hr = c.out + tok * D; f32x4 v[4]; float s = 0.f;
#pragma unroll
        for (int j = 0; j < 4; ++j) { v[j] = nv[j]; s += (v[j][0] + v[j][1]) + (v[j][2] + v[j][3]); }
        if (rl + c.G * 8 < c.stok) { const float* hp = hr + (size_t)c.G * 8 * D;
#pragma unroll
            for (int j = 0; j < 4; ++j) nv[j] = *(const f32x4*)(hp + 4 * lane + 256 * j); }
        const float mean = wave_sum(s) * (1.0f / D); float s2 = 0.f;
#pragma unroll
        for (int j = 0; j < 4; ++j) { v[j] = v[j] - mean; s2 += (v[j][0] * v[j][0] + v[j][1] * v[j][1]) + (v[j][2] * v[j][2] + v[j][3] * v[j][3]); }
        const float rstd = frsq(wave_sum(s2) * (1.0f / D) + LN_EPS);
        float lg[16];
#pragma unroll
        for (int e = 0; e < 16; ++e) lg[e] = 0.f;
#pragma unroll
        for (int j = 0; j < 4; ++j) { v[j] = v[j] * rstd * gv[j] + bv[j];
            if (!c.dry) { *(f32x4*)(hr + 4 * lane + 256 * j) = v[j];
            u32x2 w; w.x = pk2(v[j][0], v[j][1]); w.y = pk2(v[j][2], v[j][3]); *(u32x2*)(XB + tok * D + 4 * lane + 256 * j) = w; }
#pragma unroll
            for (int q = 0; q < 4; ++q) { const LAS float* wp = WR + ((j * 4 + q) * 64 + lane) * 20; const float xv = v[j][q];
#pragma unroll
                for (int e4 = 0; e4 < 4; ++e4) { const f32x4 w4 = *(const LAS f32x4*)(wp + 4 * e4); lg[4 * e4] += xv * w4[0]; lg[4 * e4 + 1] += xv * w4[1]; lg[4 * e4 + 2] += xv * w4[2]; lg[4 * e4 + 3] += xv * w4[3]; } }
            asm volatile("" ::: "memory"); }
        float mx = -1e30f;
#pragma unroll
        for (int e = 0; e < 16; ++e) { lg[e] = wave_sum(lg[e]); mx = fmaxf(mx, lg[e]); }
        float den = 0.f;
#pragma unroll
        for (int e = 0; e < 16; ++e) { lg[e] = expf(lg[e] - mx); den += lg[e]; }
        float mine = 0.f;
#pragma unroll
        for (int e = 0; e < 16; ++e) mine = (lane == e) ? lg[e] : mine;
        if (lane < 16 && !c.dry) { AFF[(size_t)lane * T_ALL + tok] = mine / den; SLOT[tok * 16 + lane] = -1; }
    }
}
DI void phase_ln2(KArgs args, LAS unsigned char* L, const Ctx& c) {
    const int lane = c.lane, l = c.layer;
    const float* g2 = args->in[18] + l * D; const float* b2 = args->in[19] + l * D;
    f32x4 gv[4], bv[4];
#pragma unroll
    for (int j = 0; j < 4; ++j) { gv[j] = *(const f32x4*)(g2 + 4 * lane + 256 * j); bv[j] = *(const f32x4*)(b2 + 4 * lane + 256 * j); }
    const int* SLOT = WSP(int, WS_SLOT); bf16_t* XB = WSP(bf16_t, WS_XB);
    f32x4 nv[4]; int nsv = -1;
    { const int t0 = c.bid * 8 + c.wave; if (t0 < T_ALL) { const float* xp = c.out + (size_t)t0 * D; nsv = SLOT[(size_t)t0 * 16 + (lane & 15)];
#pragma unroll
        for (int j = 0; j < 4; ++j) nv[j] = *(const f32x4*)(xp + 4 * lane + 256 * j); } }
    for (int t = c.bid * 8 + c.wave; t < T_ALL; t += c.G * 8) { const size_t tok = (size_t)t;
        float* xr = c.out + tok * D; f32x4 v[4];
#pragma unroll
        for (int j = 0; j < 4; ++j) v[j] = nv[j] * ALPHA;
        const int sv = nsv;
        if (t + c.G * 8 < T_ALL) { const float* xp = xr + (size_t)c.G * 8 * D; nsv = SLOT[(tok + c.G * 8) * 16 + (lane & 15)];
#pragma unroll
            for (int j = 0; j < 4; ++j) nv[j] = *(const f32x4*)(xp + 4 * lane + 256 * j); }
#pragma unroll
        for (int e = 0; e < 16; ++e) { const int s = __builtin_amdgcn_readlane(sv, e);
            if (s >= 0) { const bf16_t* yr = BIGP(bf16_t, (e < 8 ? B_XY0 : B_XY1)) + ((size_t)(e & 7) * CAP + s) * D;
#pragma unroll
                for (int j = 0; j < 4; ++j) { const u32x2 w = *(const u32x2*)(yr + 4 * lane + 256 * j); v[j][0] += bflo(w.x); v[j][1] += bfhi(w.x); v[j][2] += bflo(w.y); v[j][3] += bfhi(w.y); } } }
        float s = 0.f;
#pragma unroll
        for (int j = 0; j < 4; ++j) s += (v[j][0] + v[j][1]) + (v[j][2] + v[j][3]);
        const float mean = wave_sum(s) * (1.0f / D); float s2 = 0.f;
#pragma unroll
        for (int j = 0; j < 4; ++j) { v[j] = v[j] - mean; s2 += (v[j][0] * v[j][0] + v[j][1] * v[j][1]) + (v[j][2] * v[j][2] + v[j][3] * v[j][3]); }
        const float rstd = frsq(wave_sum(s2) * (1.0f / D) + LN_EPS);
#pragma unroll
        for (int j = 0; j < 4; ++j) { v[j] = v[j] * rstd * gv[j] + bv[j];
            if (!c.dry) { *(f32x4*)(xr + 4 * lane + 256 * j) = v[j];
            u32x2 w; w.x = pk2(v[j][0], v[j][1]); w.y = pk2(v[j][2], v[j][3]); *(u32x2*)(XB + tok * D + 4 * lane + 256 * j) = w;
            *(unsigned*)(WSP(unsigned char, WS_XB8) + tok * D + 4 * lane + 256 * j) = pk4_fp8(v[j][0], v[j][1], v[j][2], v[j][3]); } }
    }
}

DI int block_excl_scan(int v, LAS int* tmp, int tid, int& total) {
    const int lane = tid & 63, wave = tid >> 6; int x = v;
#pragma unroll
    for (int o = 1; o < 64; o <<= 1) { const int y = __shfl_up(x, o); if (lane >= o) x += y; }
    __syncthreads();
    if (lane == 63) tmp[wave] = x;
    __syncthreads();
    int base = 0, tot = 0;
#pragma unroll
    for (int w = 0; w < 8; ++w) { const int tw = tmp[w]; if (w < wave) base += tw; tot += tw; }
    total = tot;
    return base + x - v;
}
DI void phase_select(KArgs args, LAS unsigned char* L, const Ctx& c, int inst) {
    if (inst < 0 || inst >= 32) return;
    const int tid = c.tid, grp = inst >> 4, e = inst & 15;
    const int n = grp ? T_S : T_P, t0 = grp ? T_P : 0, C = n >> 3, slot0 = grp ? CAP_P : 0;
    const unsigned* v = (const unsigned*)(WSP(float, WS_AFF) + (size_t)e * T_ALL + t0);
    LAS unsigned* hist = (LAS unsigned*)L; LAS int* sh = (LAS int*)(L + 1024); LAS int* tmp = (LAS int*)(L + 1024 + 64);
    unsigned prefix = 0u; int kk = C;
    for (int pass = 0; pass < 4; ++pass) { const int shift = 24 - 8 * pass; const unsigned mhi = pass == 0 ? 0u : (0xFFFFFFFFu << (shift + 8));
        if (tid < 256) hist[tid] = 0u;
        __syncthreads();
        for (int i = tid * 4; i < n; i += 512 * 16) {
            u32x4 x4[4];
#pragma unroll
            for (int k = 0; k < 4; ++k) x4[k] = *(const u32x4*)(v + i + k * 2048);
#pragma unroll
            for (int k = 0; k < 4; ++k)
#pragma unroll
                for (int j = 0; j < 4; ++j) { const unsigned x = x4[k][j]; if ((x & mhi) == prefix) __hip_atomic_fetch_add(&hist[(x >> shift) & 255u], 1u, __ATOMIC_RELAXED, __HIP_MEMORY_SCOPE_WORKGROUP); } }
        __syncthreads();
        if (tid == 0) { int cum = 0, sel = 0; for (int b = 255; b >= 0; --b) { const int h = (int)hist[b]; if (cum + h >= kk) { sel = b; break; } cum += h; } sh[0] = sel; sh[1] = kk - cum; }
        __syncthreads();
        prefix |= ((unsigned)sh[0]) << shift; kk = sh[1];
        __syncthreads();
    }
    const unsigned thr = prefix;
    const int per = n >> 9, i0 = tid * per;
    int ngt = 0, ntie = 0;
    for (int i = 0; i < per; i += 4) { const u32x4 x = *(const u32x4*)(v + i0 + i);
#pragma unroll
        for (int j = 0; j < 4; ++j) { ngt += (x[j] > thr); ntie += (x[j] == thr); } }
    int tot;
    const int tie_base = block_excl_scan(ntie, tmp, tid, tot);
    int take = kk - tie_base; take = take < 0 ? 0 : (take > ntie ? ntie : take);
    int pos = block_excl_scan(ngt + take, tmp, tid, tot);
    int* IDX = WSP(int, WS_IDX) + e * CAP + slot0;
    int tr = 0;
    for (int i = 0; i < per; i += 4) { const u32x4 x = *(const u32x4*)(v + i0 + i);
#pragma unroll
        for (int j = 0; j < 4; ++j) { bool s = x[j] > thr; if (x[j] == thr) { s = tr < take; ++tr; } if (s) { IDX[pos] = t0 + i0 + i + j; ++pos; } } }
}
DI void phase_gather(KArgs args, LAS unsigned char* L, const Ctx& c) {
    const int lane = c.lane; const int* IDX = WSP(int, WS_IDX); const bf16_t* XB = WSP(bf16_t, WS_XB);
    float* GATEV = WSP(float, WS_GATEV); int* SLOT = WSP(int, WS_SLOT); const float* AFF = WSP(float, WS_AFF);
    for (int row0 = (c.bid * 8 + c.wave) * 4; row0 < NE * CAP; row0 += c.G * 8 * 4) {
        const int e = row0 / CAP, s0 = row0 % CAP; int t[4]; u32x4 a[4], b[4];
#pragma unroll
        for (int k = 0; k < 4; ++k) t[k] = IDX[row0 + k];
#pragma unroll
        for (int k = 0; k < 4; ++k) { const u32x4* src = (const u32x4*)(XB + (size_t)t[k] * D) + 2 * lane; a[k] = src[0]; b[k] = src[1]; }
        u32x4* dst = (u32x4*)(BIGP(unsigned char, (e < 8 ? B_XY0 : B_XY1)) + ((size_t)(e & 7) * CAP + s0) * D);
#pragma unroll
        for (int k = 0; k < 4; ++k) { u32x4 w;
            w.x = pk4_fp8(bflo(a[k].x), bfhi(a[k].x), bflo(a[k].y), bfhi(a[k].y)); w.y = pk4_fp8(bflo(a[k].z), bfhi(a[k].z), bflo(a[k].w), bfhi(a[k].w));
            w.z = pk4_fp8(bflo(b[k].x), bfhi(b[k].x), bflo(b[k].y), bfhi(b[k].y)); w.w = pk4_fp8(bflo(b[k].z), bfhi(b[k].z), bflo(b[k].w), bfhi(b[k].w));
            dst[k * 64 + lane] = w; }
        if (lane < 4) { const int tt = (lane == 0) ? t[0] : (lane == 1) ? t[1] : (lane == 2) ? t[2] : t[3]; SLOT[(size_t)tt * 16 + e] = s0 + lane; GATEV[row0 + lane] = AFF[(size_t)e * T_ALL + tt]; } }
}

__global__ void __launch_bounds__(512, 2) fwd_kernel(Args args) {
    extern __shared__ __attribute__((aligned(16))) unsigned char lds_raw[];
    LAS unsigned char* L = (LAS unsigned char*)lds_raw;
    Ctx c;
    c.out = args.out; c.ws = args.ws;
    c.tid = threadIdx.x; c.lane = c.tid & 63; c.wave = __builtin_amdgcn_readfirstlane(c.tid >> 6); c.G = gridDim.x; c.bid = blockIdx.x;
    c.layer = 0; c.slab = 0; c.nseq = 8; c.seqlen = 4096; c.stok = 32768; c.sbase = 0; c.dry = 0;
    const int lo = args.ph_lo, hi = args.ph_hi;
    volatile LAS unsigned* MISC = (volatile LAS unsigned*)(L + LDS_MISC);
    if (c.tid < 4) MISC[c.tid] = 0u;
    __syncthreads();
    XcdBarrier bar; bar.bar = (unsigned*)(c.ws + WS_CTL) + 1024; bar.x = 0; bar.st = MISC;
    if (hi - lo > 1) bar = xcd_barrier_post((unsigned*)(c.ws + WS_CTL) + 1024, MISC);
    int pc = 0;
#ifndef PHMASK
#define PHMASK 0xFFFF
#endif
#define PHON(k) (((PHMASK) >> (k)) & 1)
#ifndef REPMASK
#define REPMASK 0x0
#endif
#define PH_BEGIN(k) if (PHON(k) && pc >= lo && pc < hi) { { int tz = threadIdx.x; asm volatile("" : "+v"(tz)); c.tid = tz; c.lane = tz & 63; c.wave = __builtin_amdgcn_readfirstlane(tz >> 6); } KArgs ka = kargs(); c.ws = ka->ws; c.out = ka->out; { int b_ = blockIdx.x, g_ = gridDim.x; asm volatile("" : "+s"(b_), "+s"(g_)); c.bid = b_; c.G = g_; } for (int rep_ = 0; rep_ < (((REPMASK) >> (k)) & 1) + 1; ++rep_) { if (rep_) __syncthreads(); c.dry = (rep_ + 1 < (((REPMASK) >> (k)) & 1) + 1);
#ifndef BARREP
#define BARREP 0
#endif
#define PH_END   } if (pc + 1 < hi) { xcd_barrier(bar); if (BARREP) { xcd_barrier(bar); xcd_barrier(bar); } } else { asm volatile("s_waitcnt vmcnt(0)" ::: "memory"); __syncthreads(); } } ++pc;

    for (int layer = 0; layer < 2; ++layer) {
        c.layer = layer;
        PH_BEGIN(0) phase_weights(ka, L, c); PH_END
        for (int slab = 0; slab < NSLAB; ++slab) {
            c.slab = slab; c.nseq = slab < 2 ? 8 : 1; c.seqlen = slab < 2 ? 4096 : 16384; c.stok = slab < 2 ? 32768 : 16384; c.sbase = slab * 32768; const int stok = c.stok; const size_t sbase = (size_t)c.sbase;
            PH_BEGIN(1) {
                { pg8::Gemm g{WSP(bf16_t, WS_XB) + sbase * D, WSP(bf16_t, WS_WIN), stok, 3584, D}; pg8::StaticOrder S; S.init(stok, 3584, c.G, c.bid);
                  pg8::EpiInProj E{BIGP(bf16_t, B_PROJ), BIGP(float, B_BA)};
                  pg8::gemm_phase<pg8::EpiInProj, pg8::StaticOrder>(L, g, S, E); }
                { pg8::Gemm g{(const bf16_t*)(WSP(unsigned char, WS_XB8) + sbase * D), (const bf16_t*)WSP(unsigned char, WS_WG8), stok, 3072, D / 2}; pg8::StaticOrder S; S.init(stok, 3072, c.G, c.bid);
                  pg8::EpiGates E{BIGP(bf16_t, B_PROJ)};
                  pg8::gemm_phase<pg8::EpiGates, pg8::StaticOrder>(L, g, S, E); } } PH_END
            PH_BEGIN(2) phase_mix_a(ka, L, c); PH_END
            PH_BEGIN(3) phase_scan(ka, L, c); PH_END
            PH_BEGIN(4) phase_gdn_out(ka, L, c); PH_END
            PH_BEGIN(5) {
                pg8::StaticOrder S; S.init(stok, D, c.G, c.bid);
                pg8::Gemm g{BIGP(bf16_t, B_ONA), WSP(bf16_t, WS_WBR), stok, D, 768}; pg8::EpiGateCat E{BIGP(bf16_t, B_PROJ), BIGP(bf16_t, B_MERGED)};
                pg8::gemm_phase<pg8::EpiGateCat, pg8::StaticOrder>(L, g, S, E); } PH_END
            PH_BEGIN(6) {
                const float* xr = layer == 0 ? (slab < 2 ? ka->in[0] + sbase * D : ka->in[1]) : c.out + sbase * D;
                pg8::Gemm g{BIGP(bf16_t, B_MERGED), WSP(bf16_t, WS_WOUT), stok, D, D}; pg8::StaticOrder S; S.init(stok, D, c.G, c.bid);
                pg8::EpiRes E{xr, c.out + sbase * D};
                pg8::gemm_phase<pg8::EpiRes, pg8::StaticOrder>(L, g, S, E); } PH_END
#ifndef LN1PROBE
#define LN1PROBE 0
#endif
            PH_BEGIN(7) if (LN1PROBE) { c.dry = 1; phase_ln1(ka, L, c); __syncthreads(); c.dry = 0; } phase_ln1(ka, L, c); PH_END
        }
        PH_BEGIN(8) phase_select(ka, L, c, c.bid < 16 ? 16 + c.bid : -1); PH_END
        PH_BEGIN(9) phase_gather(ka, L, c); PH_END
        for (int half = 0; half < 2; ++half) {
            PH_BEGIN(10) {
                pg8::Gemm g{BIGP(bf16_t, half ? B_XY1 : B_XY0), (const bf16_t*)(WSP(unsigned char, WS_WGU) + (size_t)half * 8 * 4096 * D), 8 * CAP, 8 * 4096, D / 2}; pg8::MoeOrder S; S.init(8, CAP / 256, 16, c.G, c.bid);
                pg8::EpiSwiglu E{BIGP(unsigned char, B_HID)};
                pg8::gemm_phase<pg8::EpiSwiglu, pg8::MoeOrder>(L, g, S, E); } PH_END
            PH_BEGIN(11) {
                pg8::Gemm g{BIGP(bf16_t, B_HID), (const bf16_t*)(WSP(unsigned char, WS_WD) + (size_t)half * 8 * D * DE), 8 * CAP, 8 * D, DE / 2}; pg8::MoeOrder S; S.init(8, CAP / 256, 4, c.G, c.bid);
                pg8::EpiDown E{BIGP(bf16_t, half ? B_XY1 : B_XY0), WSP(float, WS_GATEV) + (size_t)half * 8 * CAP};
                pg8::gemm_phase<pg8::EpiDown, pg8::MoeOrder>(L, g, S, E); } PH_END
        }
        PH_BEGIN(12) phase_ln2(ka, L, c); PH_END
    }
#undef PH_BEGIN
#undef PH_END
}

constexpr int N_PHASES = 2 * (1 + NSLAB * 7 + 2 + 4 + 1);

extern "C" void kernel_launch(void* const* d_in, const int* in_sizes, int n_in, void* d_out, int out_size, void* d_ws, size_t ws_size, hipStream_t stream) {
    static int grid = 0;
    if (grid == 0) {
        if (n_in != 20 || ws_size < WS_END) { fprintf(stderr, "kernel_launch: unexpected n_in %d or ws_size %zu (< %zu)\n", n_in, ws_size, (size_t)WS_END); grid = -1; return; }
        int dev = 0, cus = 0, per_cu = 0;
        if (hipGetDevice(&dev) != hipSuccess || hipDeviceGetAttribute(&cus, hipDeviceAttributeMultiprocessorCount, dev) != hipSuccess) { grid = -1; return; }
        if (hipFuncSetAttribute((const void*)fwd_kernel, hipFuncAttributeMaxDynamicSharedMemorySize, LDS_BYTES) != hipSuccess) { fprintf(stderr, "kernel_launch: hipFuncSetAttribute failed\n"); grid = -1; return; }
        if (hipOccupancyMaxActiveBlocksPerMultiprocessor(&per_cu, (const void*)fwd_kernel, 512, LDS_BYTES) != hipSuccess || per_cu < 1) fprintf(stderr, "kernel_launch: occupancy query says %d\n", per_cu);
        (void)hipGetLastError();
        grid = cus;
    }
    if (grid < 0) return;
    (void)hipMemsetAsync((char*)d_ws + WS_CTL, 0, 1 * MiB, stream);
    Args a{};
    for (int i = 0; i < 20; ++i) a.in[i] = (const float*)d_in[i];
    a.out = (float*)d_out; a.ws = (unsigned char*)d_ws;
#if MK_N_LAUNCHES == 1
    a.ph_lo = 0; a.ph_hi = N_PHASES;
    hipLaunchKernelGGL(fwd_kernel, dim3(grid), dim3(512), LDS_BYTES, stream, a);
#else
    for (int p = 0; p < N_PHASES; ++p) { a.ph_lo = p; a.ph_hi = p + 1; hipLaunchKernelGGL(fwd_kernel, dim3(grid), dim3(512), LDS_BYTES, stream, a); }
#endif
}
```

```cpp
#include <hip/hip_runtime.h>
#include <stdint.h>
#include <stdio.h>

#define LAS __attribute__((address_space(3)))
#define DI __device__ __forceinline__
typedef unsigned short bf16_t;
typedef short bf16x8 __attribute__((ext_vector_type(8)));
typedef float f32x4 __attribute__((ext_vector_type(4)));
typedef float f32x2 __attribute__((ext_vector_type(2)));
typedef float f32x16 __attribute__((ext_vector_type(16)));
typedef unsigned u32x4 __attribute__((ext_vector_type(4)));
typedef unsigned u32x2 __attribute__((ext_vector_type(2)));
typedef __bf16 bf16x2v __attribute__((ext_vector_type(2)));

#ifndef MK_N_LAUNCHES
#define MK_N_LAUNCHES 1
#endif

constexpr int D = 1024, T_ALL = 81920, T_P = 65536, T_S = 16384, SLABMAX = 32768, NSLAB = 3;
constexpr int DIN = 6552, NPROJ = 6656;
constexpr int C_GATE = 0, C_QA = 3072, C_KA = 3328, C_VA = 3584, C_QD = 3840, C_KD = 4224, C_VD = 4608, C_QC = 4992, C_KC = 5376, C_VC = 5760, C_ZC = 6144;
constexpr int NE = 16, DE = 2048, CAP_P = 8192, CAP_S = 2048, CAP = CAP_P + CAP_S;
constexpr float ALPHA = 1.41421356237f, LN_EPS = 1e-5f, NORM_EPS = 1e-6f;
constexpr size_t MiB = 1u << 20;
constexpr size_t WS_CTL = 0, WS_WIN = 1 * MiB, WS_WBR = 14 * MiB, WS_WOUT = 16 * MiB, WS_WGU = 18 * MiB, WS_WD = 82 * MiB, WS_XB8 = 114 * MiB, WS_WG8 = 194 * MiB, WS_XB = 210 * MiB;
constexpr size_t WS_AFF = 370 * MiB, WS_SLOT = 375 * MiB, WS_IDX = 380 * MiB, WS_GATEV = 381 * MiB, WS_CS = 382 * MiB, WS_BIG = 386 * MiB, WS_END = 1130 * MiB;
constexpr size_t B_PROJ = 0, B_BA = 416 * MiB, B_ONA = 420 * MiB, B_ODIL = 436 * MiB, B_OGDN = 452 * MiB, B_DILP = 476 * MiB, B_DILM = 500 * MiB, B_GSCR = 502 * MiB, B_MERGEF = 502 * MiB, B_MERGED = 630 * MiB;
constexpr size_t B_XY0 = 0, B_XY1 = 160 * MiB, B_HID = 320 * MiB;
constexpr int GSTRIDE = 41216;
constexpr int LDS_BYTES = 147456;
constexpr int LDS_MISC = 145408;

DI unsigned pk2(float lo, float hi) { f32x2 v = {lo, hi}; bf16x2v b = __builtin_convertvector(v, bf16x2v); return __builtin_bit_cast(unsigned, b); }
DI unsigned pk4_fp8(float a, float b, float c, float d) {
    int w = __builtin_amdgcn_cvt_pk_fp8_f32(a, b, 0, false); w = __builtin_amdgcn_cvt_pk_fp8_f32(c, d, w, true); return (unsigned)w; }
DI float bflo(unsigned u) { return __uint_as_float(u << 16); }
DI float bfhi(unsigned u) { return __uint_as_float(u & 0xffff0000u); }
DI float frcp(float x) { return __builtin_amdgcn_rcpf(x); }
DI float frsq(float x) { return __builtin_amdgcn_rsqf(x); }
DI float sigmoidf_(float x) { return frcp(1.0f + __expf(-x)); }
DI float siluf_(float x) { return x * frcp(1.0f + __expf(-x)); }
DI float wave_sum(float v) {
#pragma unroll
    for (int o = 1; o < 64; o <<= 1) v += __shfl_xor(v, o);
    return v;
}
#define MFMA32(a, b, c) __builtin_amdgcn_mfma_f32_32x32x16_bf16((a), (b), (c), 0, 0, 0)
DI int crow(int reg, int h) { return (reg & 3) + 8 * (reg >> 2) + 4 * h; }
DI f32x16 zero16() { f32x16 z; for (int i = 0; i < 16; ++i) z[i] = 0.f; return z; }
template <int S> DI bf16x8 pack8(const f32x16& x) {
    u32x4 p; p[0] = pk2(x[8 * S], x[8 * S + 1]); p[1] = pk2(x[8 * S + 2], x[8 * S + 3]); p[2] = pk2(x[8 * S + 4], x[8 * S + 5]); p[3] = pk2(x[8 * S + 6], x[8 * S + 7]);
    return __builtin_bit_cast(bf16x8, p);
}

namespace pg8 {
constexpr int BM = 256, BK = 64, HALF = 128, HTB = HALF * BK * 2, STAGE_BYTES = 8 * HTB, NXCD = 8, WGM = 8;
__host__ __device__ __forceinline__ int lds_byte(int r, int c) { const int st = (r >> 4) * 2 + (c >> 5), rr = r & 15, cc = c & 31, ob = rr * 64 + cc * 2; return st * 1024 + (ob ^ (((ob >> 9) & 1) << 5)); }
__host__ __device__ __forceinline__ void stage_rc(int b, int& R, int& C) { const int st = b / 1024, sb = b % 1024, swz = sb ^ (((sb >> 9) & 1) << 5); R = (st >> 1) * 16 + swz / 64; C = (st & 1) * 32 + (swz % 64) / 2; }
__host__ __device__ __forceinline__ int perm32(int rho) { const int n = rho >> 4, i = rho & 15; return 8 * (i >> 2) + 4 * n + (i & 3); }
struct Unit { int pm, pn; };
struct Gemm { const bf16_t* A; const bf16_t* Bt; int M, N, K; };
struct StaticOrder {
    int nM, nN, nwg, G, c;
    __device__ void init(int M, int N, int G_, int c_) { nM = M / BM; nN = N / BM; nwg = nM * nN; G = G_; c = c_; }
    __device__ bool next(int i, Unit& u) const {
        const long L = (long)i * G + c; if (L >= nwg) return false;
        int wgid = (int)L; { const int q = nwg / NXCD, r = nwg % NXCD, xcd = wgid % NXCD, off = wgid / NXCD; wgid = (xcd < r ? xcd * (q + 1) : r * (q + 1) + (xcd - r) * q) + off; }
        const int nig = WGM * nN, gid = wgid / nig, fm = gid * WGM, gsz = (nM - fm) < WGM ? (nM - fm) : WGM;
        u.pm = fm + ((wgid % nig) % gsz); u.pn = (wgid % nig) / gsz; return true;
    }
    __device__ __forceinline__ void a_ready(const Unit&) const {}
    __device__ __forceinline__ void done(const Unit&) const {}
};
struct MoeOrder {
    int nMe, nNe, per, total, G, c, xr, xc, rpx, cpx, share;
    __device__ void init(int nE, int nMe_, int nNe_, int G_, int c_) { nMe = nMe_; nNe = nNe_; per = nMe * nNe; total = nE * per; G = G_; c = c_;
        xc = (nNe % 2 == 0 && nNe >= 8) ? 2 : 1; xr = 8 / xc; rpx = nMe / xr; cpx = nNe / xc; share = rpx * cpx; }
    __device__ bool next(int i, Unit& u) const {
        if ((G & 7) == 0 && nMe % xr == 0) {
            const int x = c & 7, q = c >> 3, nq = G >> 3; const long j = (long)i * nq + q; if (j >= (long)(total / 8)) return false;
            const int e = (int)(j / share), r = (int)(j % share); const int pm = (x / xc) * rpx + r % rpx, pn = (x % xc) * cpx + r / rpx;
            u.pm = e * nMe + pm; u.pn = e * nNe + pn; return true;
        }
        const long L = (long)i * G + c; if (L >= total) return false;
        const int e = (int)(L / per), r = (int)(L % per);
        u.pm = e * nMe + r % nMe; u.pn = e * nNe + r / nMe; return true;
    }
    __device__ __forceinline__ void a_ready(const Unit&) const {}
    __device__ __forceinline__ void done(const Unit&) const {}
};

template <class Epi, class Sched>
__device__ __forceinline__ void gemm_phase(LAS unsigned char* lds, const Gemm g, const Sched& S, const Epi& E) {
    int tid = threadIdx.x; asm volatile("" : "+v"(tid));
    const int wid = __builtin_amdgcn_readfirstlane(tid >> 6), lane = tid & 63, wr = wid >> 2, wc = wid & 3, fr = lane & 15, fq = lane >> 4;
    int Kv = g.K; asm volatile("" : "+s"(Kv));
    const int K = Kv, nt = K / BK;
    unsigned voffA[2], voffB[2];
#pragma unroll
    for (int i = 0; i < 2; ++i) { int R, C; stage_rc(tid * 16 + i * 8192, R, C); const int Rb = Epi::PERM ? ((R & ~31) + perm32(R & 31)) : R;
        voffA[i] = (unsigned)(R * K + C) * 2u; voffB[i] = (unsigned)(Rb * K + C) * 2u; }
    const size_t kstep = (size_t)(BK * 2);
    const size_t hstep = (size_t)HALF * K * 2;
    const size_t tstep = 2 * hstep;
    const unsigned ldsw = (unsigned)wid * 1024u;
    const int aoff = lds_byte(wr * 64 + fr, fq * 8), boff = lds_byte(wc * 32 + fr, fq * 8);
#define PG8_SA(b, h) (((b) * 2 + (h)) * HTB)
#define PG8_SB(b, h) ((4 + (b) * 2 + (h)) * HTB)
#define PG8_STAGE(bufoff, gbase, voff) do { _Pragma("unroll") for (int _i = 0; _i < 2; ++_i) \
        __builtin_amdgcn_global_load_lds((const unsigned*)((const char*)(gbase) + (voff)[_i]), (LAS unsigned*)(lds + (bufoff) + ldsw + _i * 8192), 16, 0, 0); } while (0)
#define PG8_LD8(p) __builtin_shufflevector(*(const LAS v4i_*)(p), *(const LAS v4i_*)((p) + 1024), 0, 1, 2, 3, 4, 5, 6, 7)
#define PG8_LDA(dst, b, h) do { _Pragma("unroll") for (int m = 0; m < 4; ++m) { if constexpr (Epi::FP8) dst##8[m] = PG8_LD8(lds + PG8_SA(b, h) + aoff + m * 2048); \
        else { _Pragma("unroll") for (int k = 0; k < 2; ++k) dst[m][k] = *(const LAS bf16x8*)(lds + PG8_SA(b, h) + aoff + m * 2048 + k * 1024); } } } while (0)
#define PG8_LDB(dst, b, h) do { _Pragma("unroll") for (int n = 0; n < 2; ++n) { if constexpr (Epi::FP8) dst##8[n] = PG8_LD8(lds + PG8_SB(b, h) + boff + n * 2048); \
        else { _Pragma("unroll") for (int k = 0; k < 2; ++k) dst[n][k] = *(const LAS bf16x8*)(lds + PG8_SB(b, h) + boff + n * 2048 + k * 1024); } } } while (0)
#define PG8_MMA(ai, bj, At, Bt) do { __builtin_amdgcn_s_setprio(1); _Pragma("unroll") for (int m = 0; m < 4; ++m) _Pragma("unroll") for (int n = 0; n < 2; ++n) { \
        if constexpr (Epi::FP8) asm volatile("v_mfma_scale_f32_16x16x128_f8f6f4 %0, %1, %2, %0, %3, %3 op_sel_hi:[0,0,0]" : "+v"(acc[ai][bj][m][n]) : "v"(Bt##8[n]), "v"(At##8[m]), "v"(fp8_unit_scale));   \
        else { _Pragma("unroll") for (int k = 0; k < 2; ++k) acc[ai][bj][m][n] = __builtin_amdgcn_mfma_f32_16x16x32_bf16(Bt[n][k], At[m][k], acc[ai][bj][m][n], 0, 0, 0); } } \
        __builtin_amdgcn_s_setprio(0); } while (0)
#define PG8_WAIT_V(n) asm volatile("s_waitcnt vmcnt(" #n ")" ::: "memory")
#define PG8_WAIT_L(n) asm volatile("s_waitcnt lgkmcnt(" #n ")" ::: "memory")
#define PG8_BAR __builtin_amdgcn_s_barrier()
#define PG8_SCHED __builtin_amdgcn_sched_barrier(0)
    Unit cur, nxt; int ui = 0;
    if (!S.next(0, cur)) return;
    f32x4 acc[2][2][4][2];
#pragma unroll
    for (int a = 0; a < 2; ++a)
#pragma unroll
        for (int b = 0; b < 2; ++b)
#pragma unroll
            for (int m = 0; m < 4; ++m)
#pragma unroll
                for (int n = 0; n < 2; ++n) acc[a][b][m][n] = (f32x4){0.f, 0.f, 0.f, 0.f};
    typedef int v4i_ __attribute__((ext_vector_type(4))); typedef int v8i_ __attribute__((ext_vector_type(8)));
    bf16x8 At[4][2], B0[2][2], B1[2][2]; v8i_ At8[4], B08[2], B18[2];
    int fp8_unit_scale = 0x7F7F7F7F; asm volatile("" : "+v"(fp8_unit_scale));
    const char* cA = (const char*)g.A + (size_t)cur.pm * tstep; const char* cB = (const char*)g.Bt + (size_t)cur.pn * tstep;
    S.a_ready(cur);
    PG8_STAGE(PG8_SB(0, 0), cB, voffB); PG8_STAGE(PG8_SA(0, 0), cA, voffA); PG8_STAGE(PG8_SB(0, 1), cB + hstep, voffB); PG8_STAGE(PG8_SA(0, 1), cA + hstep, voffA);
    if (wr == 1) PG8_BAR;
    PG8_WAIT_V(4); PG8_BAR;
    PG8_STAGE(PG8_SB(1, 0), cB + kstep, voffB); PG8_STAGE(PG8_SA(1, 0), cA + kstep, voffA); PG8_STAGE(PG8_SB(1, 1), cB + hstep + kstep, voffB);
    PG8_WAIT_V(6); PG8_BAR;
    for (;;) {
        const bool has_next = S.next(ui + 1, nxt);
        const char* nA = has_next ? (const char*)g.A + (size_t)nxt.pm * tstep : cA; const char* nB = has_next ? (const char*)g.Bt + (size_t)nxt.pn * tstep : cB;
        for (int t = 0; t < nt; t += 2) {
            const bool last = (t == nt - 2);
            const char* a1 = cA + (size_t)(t + 1) * kstep;
            const char* a2 = last ? nA : cA + (size_t)(t + 2) * kstep; const char* b2 = last ? nB : cB + (size_t)(t + 2) * kstep;
            const char* a3 = a2 + kstep; const char* b3 = b2 + kstep;
            if (last && has_next) S.a_ready(nxt);
            if constexpr (Epi::SEG) { if (t == 4 || t == 6) { int tz = tid; asm volatile("" : "+v"(tz)); const int wz = __builtin_amdgcn_readfirstlane(tz >> 6), lz = tz & 63; E.mid(acc, cur, t == 4 ? 0 : 1, wz >> 2, wz & 3, lz & 15, lz >> 4); } }
            PG8_LDB(B0, 0, 0); PG8_SCHED; PG8_LDA(At, 0, 0); PG8_STAGE(PG8_SA(1, 1), a1 + hstep, voffA);
            PG8_WAIT_L(8); PG8_BAR; PG8_WAIT_L(0); PG8_MMA(0, 0, At, B0); PG8_BAR; PG8_SCHED;
            PG8_LDB(B1, 0, 1); PG8_STAGE(PG8_SB(0, 0), b2, voffB);
            PG8_BAR; PG8_WAIT_L(0); PG8_MMA(0, 1, At, B1); PG8_BAR;
            PG8_LDA(At, 0, 1); PG8_STAGE(PG8_SA(0, 0), a2, voffA);
            PG8_BAR; PG8_WAIT_L(0); PG8_MMA(1, 0, At, B0); PG8_BAR; PG8_SCHED;
            PG8_STAGE(PG8_SB(0, 1), b2 + hstep, voffB);
            PG8_WAIT_V(6); PG8_BAR; PG8_MMA(1, 1, At, B1); PG8_BAR;
            PG8_LDB(B0, 1, 0); PG8_SCHED; PG8_LDA(At, 1, 0); PG8_STAGE(PG8_SA(0, 1), a2 + hstep, voffA);
            PG8_WAIT_L(8); PG8_BAR; PG8_WAIT_L(0); PG8_MMA(0, 0, At, B0); PG8_BAR; PG8_SCHED;
            PG8_LDB(B1, 1, 1); PG8_STAGE(PG8_SB(1, 0), b3, voffB);
            PG8_BAR; PG8_WAIT_L(0); PG8_MMA(0, 1, At, B1); PG8_BAR;
            PG8_LDA(At, 1, 1); PG8_STAGE(PG8_SA(1, 0), a3, voffA);
            PG8_BAR; PG8_WAIT_L(0); PG8_MMA(1, 0, At, B0); PG8_BAR; PG8_SCHED;
            PG8_STAGE(PG8_SB(1, 1), b3 + hstep, voffB);
            PG8_WAIT_V(6); PG8_BAR; PG8_MMA(1, 1, At, B1); PG8_BAR;
        }
        if constexpr (Epi::FP8) asm volatile("s_nop 15\n\ts_nop 15\n\ts_nop 15" ::: "memory");
        { int tz = tid; asm volatile("" : "+v"(tz)); const int wz = __builtin_amdgcn_readfirstlane(tz >> 6), lz = tz & 63;
          E(acc, cur, wz >> 2, wz & 3, lz & 15, lz >> 4); } S.done(cur);
        if (!has_next) break;
#pragma unroll
        for (int a = 0; a < 2; ++a)
#pragma unroll
            for (int b = 0; b < 2; ++b)
#pragma unroll
                for (int m = 0; m < 4; ++m)
#pragma unroll
                    for (int n = 0; n < 2; ++n) acc[a][b][m][n] = (f32x4){0.f, 0.f, 0.f, 0.f};
        cur = nxt; cA = nA; cB = nB; ++ui;
    }
    PG8_WAIT_V(0);
    if (wr == 0) PG8_BAR;
    PG8_BAR;
#undef PG8_SA
#undef PG8_SB
#undef PG8_STAGE
#undef PG8_LDA
#undef PG8_LD8
#undef PG8_LDB
#undef PG8_MMA
#undef PG8_WAIT_V
#undef PG8_WAIT_L
#undef PG8_BAR
#undef PG8_SCHED
}

struct EpiInProj {
    static constexpr bool PERM = true, SEG = false, FP8 = false;
    bf16_t* O; float* BA;
    __device__ __forceinline__ void operator()(const f32x4 (&acc)[2][2][4][2], const Unit& u, int wr, int wc, int fr, int fq) const {
        const int row0 = u.pm * BM + wr * 64 + fr, col0 = 3072 + u.pn * BM + wc * 32 + 8 * fq;
        const bool sig = false, ba = (u.pn == 13) && (wc == 0) && (fq < 3);
#pragma unroll
        for (int ai = 0; ai < 2; ++ai)
#pragma unroll
            for (int m = 0; m < 4; ++m) { const int row = row0 + ai * HALF + m * 16; bf16_t* rowp = O + (size_t)row * NPROJ + col0;
#pragma unroll
                for (int bj = 0; bj < 2; ++bj) { f32x4 v0 = acc[ai][bj][m][0], v1 = acc[ai][bj][m][1];
                    if (sig) {
#pragma unroll
                        for (int j = 0; j < 4; ++j) { v0[j] = sigmoidf_(v0[j]); v1[j] = sigmoidf_(v1[j]); } }
                    u32x4 w; w.x = pk2(v0[0], v0[1]); w.y = pk2(v0[2], v0[3]); w.z = pk2(v1[0], v1[1]); w.w = pk2(v1[2], v1[3]);
                    *(u32x4*)(rowp + bj * HALF) = w;
                    if (bj == 1 && ba) { float* bp = BA + (size_t)row * 32 + 8 * fq; *(f32x4*)bp = v0; *(f32x4*)(bp + 4) = v1; } } }
    }
};
struct EpiGates {
    static constexpr bool PERM = true, SEG = false, FP8 = true;
    bf16_t* O;
    __device__ __forceinline__ void operator()(const f32x4 (&acc)[2][2][4][2], const Unit& u, int wr, int wc, int fr, int fq) const {
        const int row0 = u.pm * BM + wr * 64 + fr, col0 = u.pn * BM + wc * 32 + 8 * fq;
#pragma unroll
        for (int ai = 0; ai < 2; ++ai)
#pragma unroll
            for (int m = 0; m < 4; ++m) { int rowi = row0 + ai * HALF + m * 16; asm volatile("" : "+v"(rowi)); bf16_t* rowp = O + (size_t)rowi * NPROJ + col0;
#pragma unroll
                for (int bj = 0; bj < 2; ++bj) { f32x4 v0 = acc[ai][bj][m][0] * 0.03125f, v1 = acc[ai][bj][m][1] * 0.03125f;
#pragma unroll
                    for (int j = 0; j < 4; ++j) { v0[j] = sigmoidf_(v0[j]); v1[j] = sigmoidf_(v1[j]); }
                    u32x4 w; w.x = pk2(v0[0], v0[1]); w.y = pk2(v0[2], v0[3]); w.z = pk2(v1[0], v1[1]); w.w = pk2(v1[2], v1[3]);
                    *(u32x4*)(rowp + bj * HALF) = w; }
                asm volatile("" ::: "memory"); }
    }
};
struct EpiGateCat {
    static constexpr bool PERM = false, SEG = true, FP8 = false;
    const bf16_t* PROJ; bf16_t* MB;
    __device__ __forceinline__ void mid(f32x4 (&acc)[2][2][4][2], const Unit& u, int seg, int wr, int wc, int fr, int fq) const {
        const int row0 = u.pm * BM + wr * 64 + fr, col0 = u.pn * BM + wc * 32 + 4 * fq;
#pragma unroll
        for (int ai = 0; ai < 2; ++ai) {
            int rowb = row0 + ai * HALF; asm volatile("" : "+v"(rowb)); const bf16_t* gp0 = PROJ + (size_t)rowb * NPROJ + C_GATE + seg * 1024 + col0;
            u32x2 ga[4][2][2], gb[4][2][2];
#pragma unroll
            for (int m = 0; m < 4; ++m)
#pragma unroll
                for (int bj = 0; bj < 2; ++bj)
#pragma unroll
                    for (int n = 0; n < 2; ++n) { const bf16_t* gp = gp0 + (size_t)(m * 16) * NPROJ + bj * HALF + n * 16; ga[m][bj][n] = *(const u32x2*)gp; gb[m][bj][n] = *(const u32x2*)(gp + 1024); }
#pragma unroll
            for (int m = 0; m < 4; ++m)
#pragma unroll
                for (int bj = 0; bj < 2; ++bj)
#pragma unroll
                    for (int n = 0; n < 2; ++n) { const u32x2 a_ = ga[m][bj][n], b_ = gb[m][bj][n];
                        f32x4& v = acc[ai][bj][m][n]; v[0] *= bflo(a_.x) * frcp(bflo(b_.x)); v[1] *= bfhi(a_.x) * frcp(bfhi(b_.x)); v[2] *= bflo(a_.y) * frcp(bflo(b_.y)); v[3] *= bfhi(a_.y) * frcp(bfhi(b_.y)); }
            asm volatile("" ::: "memory"); }
    }
    __device__ __forceinline__ void operator()(const f32x4 (&acc)[2][2][4][2], const Unit& u, int wr, int wc, int fr, int fq) const {
        const int row0 = u.pm * BM + wr * 64 + fr, col0 = u.pn * BM + wc * 32 + 4 * fq;
#pragma unroll
        for (int ai = 0; ai < 2; ++ai) {
            int rowb = row0 + ai * HALF; asm volatile("" : "+v"(rowb)); const bf16_t* gp0 = PROJ + (size_t)rowb * NPROJ + C_GATE + 2 * 1024 + col0; bf16_t* mp0 = MB + (size_t)rowb * D + col0;
            u32x2 gw[4][2][2];
#pragma unroll
            for (int m = 0; m < 4; ++m)
#pragma unroll
                for (int bj = 0; bj < 2; ++bj)
#pragma unroll
                    for (int n = 0; n < 2; ++n) gw[m][bj][n] = *(const u32x2*)(gp0 + (size_t)(m * 16) * NPROJ + bj * HALF + n * 16);
#pragma unroll
            for (int m = 0; m < 4; ++m)
#pragma unroll
                for (int bj = 0; bj < 2; ++bj)
#pragma unroll
                    for (int n = 0; n < 2; ++n) { const u32x2 g_ = gw[m][bj][n]; const f32x4 v = acc[ai][bj][m][n];
                        u32x2 w; w.x = pk2(v[0] * bflo(g_.x), v[1] * bfhi(g_.x)); w.y = pk2(v[2] * bflo(g_.y), v[3] * bfhi(g_.y)); *(u32x2*)(mp0 + (size_t)(m * 16) * D + bj * HALF + n * 16) = w; }
            asm volatile("" ::: "memory"); }
    }
};
struct EpiRes {
    static constexpr bool PERM = false, SEG = false, FP8 = false;
    const float* XR; float* H;
    __device__ __forceinline__ void operator()(const f32x4 (&acc)[2][2][4][2], const Unit& u, int wr, int wc, int fr, int fq) const {
        const int row0 = u.pm * BM + wr * 64 + fr, col0 = u.pn * BM + wc * 32 + 4 * fq;
#pragma unroll
        for (int ai = 0; ai < 2; ++ai) {
            int rowb = row0 + ai * HALF; asm volatile("" : "+v"(rowb)); const size_t off0 = (size_t)rowb * D + col0;
            f32x4 xr[4][2][2];
#pragma unroll
            for (int m = 0; m < 4; ++m)
#pragma unroll
                for (int bj = 0; bj < 2; ++bj)
#pragma unroll
                    for (int n = 0; n < 2; ++n) xr[m][bj][n] = *(const f32x4*)(XR + off0 + (size_t)(m * 16) * D + bj * HALF + n * 16);
#pragma unroll
            for (int m = 0; m < 4; ++m)
#pragma unroll
                for (int bj = 0; bj < 2; ++bj)
#pragma unroll
                    for (int n = 0; n < 2; ++n) *(f32x4*)(H + off0 + (size_t)(m * 16) * D + bj * HALF + n * 16) = xr[m][bj][n] * ALPHA + acc[ai][bj][m][n];
            asm volatile("" ::: "memory"); }
    }
};
struct EpiSwiglu {
    static constexpr bool PERM = true, SEG = false, FP8 = true;
    unsigned char* HID;
    __device__ __forceinline__ void operator()(const f32x4 (&acc)[2][2][4][2], const Unit& u, int wr, int wc, int fr, int fq) const {
        const int row0 = u.pm * BM + wr * 64 + fr, col0 = (u.pn & 15) * 128 + wc * 32 + 8 * fq;
#pragma unroll
        for (int ai = 0; ai < 2; ++ai)
#pragma unroll
            for (int m = 0; m < 4; ++m) { const f32x4 g0 = acc[ai][0][m][0] * 0.03125f, g1 = acc[ai][0][m][1] * 0.03125f, u0 = acc[ai][1][m][0] * 0.03125f, u1 = acc[ai][1][m][1] * 0.03125f;
                f32x4 h0, h1;
#pragma unroll
                for (int j = 0; j < 4; ++j) { h0[j] = siluf_(g0[j]) * u0[j]; h1[j] = siluf_(g1[j]) * u1[j]; }
                u32x2 w; w.x = pk4_fp8(h0[0], h0[1], h0[2], h0[3]); w.y = pk4_fp8(h1[0], h1[1], h1[2], h1[3]);
                int rowi = row0 + ai * HALF + m * 16; asm volatile("" : "+v"(rowi));
                *(u32x2*)(HID + (size_t)rowi * DE + col0) = w; asm volatile("" ::: "memory"); }
    }
};
struct EpiDown {
    static constexpr bool PERM = true, SEG = false, FP8 = true;
    bf16_t* Y; const float* GV;
    __device__ __forceinline__ void operator()(const f32x4 (&acc)[2][2][4][2], const Unit& u, int wr, int wc, int fr, int fq) const {
        const int row0 = u.pm * BM + wr * 64 + fr, col0 = (u.pn & 3) * BM + wc * 32 + 8 * fq;
        float gvs[2][4];
#pragma unroll
        for (int ai = 0; ai < 2; ++ai)
#pragma unroll
            for (int m = 0; m < 4; ++m) gvs[ai][m] = GV[row0 + ai * HALF + m * 16];
#pragma unroll
        for (int ai = 0; ai < 2; ++ai)
#pragma unroll
            for (int m = 0; m < 4; ++m) { int row = row0 + ai * HALF + m * 16; asm volatile("" : "+v"(row)); const float gv = gvs[ai][m] * 0.03125f;
#pragma unroll
                for (int bj = 0; bj < 2; ++bj) { const f32x4 v0 = acc[ai][bj][m][0] * gv, v1 = acc[ai][bj][m][1] * gv;
                    u32x4 w; w.x = pk2(v0[0], v0[1]); w.y = pk2(v0[2], v0[3]); w.z = pk2(v1[0], v1[1]); w.w = pk2(v1[2], v1[3]);
                    *(u32x4*)(Y + (size_t)row * D + col0 + bj * HALF) = w; } }
    }
};
}

#define XB_TMO      128
#define XB_XCNT(j)  (256  + 64 * (j))
#define XB_XSUB(j)  (1280 + 64 * (j))
#define XB_XGEN(j)  (2304 + 64 * (j))
#define XB_TOP      3328
#define XB_TOPGEN   3392
#define XCD_BAR_WORDS 3456
#define XB_SPIN_CAP (1u << 22)
__device__ __forceinline__ unsigned xb_ld(unsigned* p)              { return __hip_atomic_load(p, __ATOMIC_RELAXED, __HIP_MEMORY_SCOPE_AGENT); }
__device__ __forceinline__ unsigned xb_add(unsigned* p, unsigned v) { return __hip_atomic_fetch_add(p, v, __ATOMIC_RELAXED, __HIP_MEMORY_SCOPE_AGENT); }
__device__ __forceinline__ unsigned xb_xcc_id() { return (unsigned)__builtin_amdgcn_s_getreg((3 << 11) | 20) & 0xFu; }
#define XB_SPIN(cond, bar) do { unsigned _sp = 0; while (cond) { __builtin_amdgcn_s_sleep(1); \
    if ((++_sp & 255u) == 0u) { if (xb_ld(&(bar)[XB_TMO])) break; if (_sp > XB_SPIN_CAP) { atomicAdd(&(bar)[XB_TMO], 1u); break; } } } } while (0)
struct XcdBarrier { unsigned* bar; unsigned x; volatile LAS unsigned* st; };
__device__ __forceinline__ XcdBarrier xcd_barrier_post(unsigned* bar, volatile LAS unsigned* st) {
    XcdBarrier b; b.bar = bar; b.x = xb_xcc_id(); b.st = st;
    if (threadIdx.x == 0) (void)xb_add(&bar[XB_XCNT(b.x)], 1u);
    return b;
}
__device__ __forceinline__ void xcd_barrier_complete(unsigned* bar, unsigned x, unsigned& nloc, unsigned& nx) {
    const unsigned G = gridDim.x * gridDim.y * gridDim.z;
    unsigned sum, cnt, mine, sp = 0u;
    for (;;) {
        sum = 0u; cnt = 0u; mine = 0u;
#pragma unroll
        for (unsigned j = 0; j < 16; ++j) { const unsigned c = xb_ld(&bar[XB_XCNT(j)]); sum += c; cnt += (c > 0u) ? 1u : 0u; }
        mine = xb_ld(&bar[XB_XCNT(x)]);
        if (sum == G) break;
        __builtin_amdgcn_s_sleep(1);
        if ((++sp & 255u) == 0u) { if (xb_ld(&bar[XB_TMO])) break; if (sp > XB_SPIN_CAP) { atomicAdd(&bar[XB_TMO], 1u); break; } }
    }
    nloc = mine > 0u ? mine : 1u; nx = cnt > 0u ? cnt : 1u;
}
__device__ __forceinline__ void xcd_barrier(const XcdBarrier& b) {
    asm volatile("s_waitcnt vmcnt(0)" ::: "memory");
    __syncthreads();
    if (threadIdx.x == 0) {
        unsigned* bar = b.bar; asm volatile("" : "+s"(bar));
        __builtin_amdgcn_s_waitcnt(0);
        unsigned nloc = b.st[0], nx = b.st[1];
        if (nloc == 0u) { xcd_barrier_complete(bar, b.x, nloc, nx); b.st[0] = nloc; b.st[1] = nx; }
        const unsigned old = xb_add(&bar[XB_XSUB(b.x)], 1u);
        const unsigned gen = old / nloc;
        if (old + 1u == (gen + 1u) * nloc) {
            __builtin_amdgcn_fence(__ATOMIC_RELEASE, "agent");
            asm volatile("s_waitcnt vmcnt(0)" ::: "memory");
            const unsigned og = xb_add(&bar[XB_TOP], 1u);
            const unsigned tg = og / nx;
            if (og + 1u == (tg + 1u) * nx) xb_add(&bar[XB_TOPGEN], 1u);
            else XB_SPIN(xb_ld(&bar[XB_TOPGEN]) == tg, bar);
            __builtin_amdgcn_fence(__ATOMIC_ACQUIRE, "agent");
            xb_add(&bar[XB_XGEN(b.x)], 1u);
            asm volatile("s_waitcnt vmcnt(0)" ::: "memory");
        } else {
            XB_SPIN(xb_ld(&bar[XB_XGEN(b.x)]) == gen, bar);
            __builtin_amdgcn_fence(__ATOMIC_ACQUIRE, "agent");
            asm volatile("s_waitcnt vmcnt(0)" ::: "memory");
        }
    }
    __syncthreads();
}

struct Args { const float* in[20]; float* out; unsigned char* ws; int ph_lo, ph_hi; };
typedef const __attribute__((address_space(4))) Args* KArgs;
DI KArgs kargs() { KArgs p = (KArgs)__builtin_amdgcn_kernarg_segment_ptr(); asm volatile("" : "+s"(p)); return p; }
struct Ctx {
    float* out; unsigned char* ws;
    int tid, lane, wave, G, bid;
    int layer, slab;
    int nseq, seqlen;
    int stok, sbase;
    int dry;
};
#define WSP(T, off) ((T*)(c.ws + (off)))
#define BIGP(T, off) ((T*)(c.ws + WS_BIG + (off)))

__device__ const float INV_FREQ[32] = {1.000000000e+00f, 7.498942018e-01f, 5.623413324e-01f, 4.216965139e-01f, 3.162277639e-01f, 2.371373773e-01f, 1.778279394e-01f, 1.333521456e-01f, 1.000000015e-01f, 7.498942316e-02f, 5.623413250e-02f, 4.216964915e-02f, 3.162277490e-02f, 2.371373773e-02f, 1.778279431e-02f, 1.333521400e-02f, 9.999999776e-03f, 7.498942316e-03f, 5.623413250e-03f, 4.216964822e-03f, 3.162277630e-03f, 2.371373819e-03f, 1.778279431e-03f, 1.333521446e-03f, 1.000000047e-03f, 7.498941850e-04f, 5.623413017e-04f, 4.216965172e-04f, 3.162277571e-04f, 2.371373703e-04f, 1.778279402e-04f, 1.333521504e-04f};
DI void tr_item(const float* src, long src_ld, int src_col0, int nvalid, int kvalid, bf16_t* dst, long dst_ld, int dst_row0, int k0, LAS float* scr, int lane) {
    float tv[32];
#pragma unroll
    for (int i = 0; i < 32; ++i) { const int kk = 2 * i + (lane >> 5), cc = lane & 31;
        tv[i] = 0.f; if ((k0 + kk) < kvalid && cc < nvalid) tv[i] = src[(size_t)(k0 + kk) * src_ld + src_col0 + cc]; }
#pragma unroll
    for (int i = 0; i < 32; ++i) { const int kk = 2 * i + (lane >> 5), cc = lane & 31; scr[kk * 33 + cc] = tv[i]; }
    asm volatile("s_waitcnt lgkmcnt(0)" ::: "memory");
    const int c8 = lane & 7;
#pragma unroll
    for (int j = 0; j < 4; ++j) { const int n = (lane >> 3) + 8 * j; const LAS float* s = scr + (8 * c8) * 33 + n;
        u32x4 o; o.x = pk2(s[0 * 33], s[1 * 33]); o.y = pk2(s[2 * 33], s[3 * 33]); o.z = pk2(s[4 * 33], s[5 * 33]); o.w = pk2(s[6 * 33], s[7 * 33]);
        *(u32x4*)(dst + (size_t)(dst_row0 + n) * dst_ld + k0 + 8 * c8) = o; }
    asm volatile("s_waitcnt lgkmcnt(0)" ::: "memory");
}
DI void tr_item8(const float* src, long src_ld, int src_col0, int kvalid, unsigned char* dst, long dst_ld, int dst_row0, int k0, float scale, LAS float* scr, int lane) {
    float tv[32];
#pragma unroll
    for (int i = 0; i < 32; ++i) { const int kk = 2 * i + (lane >> 5), cc = lane & 31; tv[i] = 0.f; if ((k0 + kk) < kvalid) tv[i] = src[(size_t)(k0 + kk) * src_ld + src_col0 + cc]; }
#pragma unroll
    for (int i = 0; i < 32; ++i) { const int kk = 2 * i + (lane >> 5), cc = lane & 31; scr[kk * 33 + cc] = tv[i]; }
    asm volatile("s_waitcnt lgkmcnt(0)" ::: "memory");
    const int c8 = lane & 7;
#pragma unroll
    for (int j = 0; j < 4; ++j) { const int n = (lane >> 3) + 8 * j; const LAS float* s = scr + (8 * c8) * 33 + n;
        u32x2 o; o.x = pk4_fp8(s[0 * 33] * scale, s[1 * 33] * scale, s[2 * 33] * scale, s[3 * 33] * scale); o.y = pk4_fp8(s[4 * 33] * scale, s[5 * 33] * scale, s[6 * 33] * scale, s[7 * 33] * scale);
        *(u32x2*)(dst + (size_t)(dst_row0 + n) * dst_ld + k0 + 8 * c8) = o; }
    asm volatile("s_waitcnt lgkmcnt(0)" ::: "memory");
}
DI void phase_weights(KArgs args, LAS unsigned char* lds, const Ctx& c) {
    const int l = c.layer, lane = c.lane;
    LAS float* scr = (LAS float*)(lds + c.wave * 8448);
    const int gw = c.bid * 8 + c.wave, NGW = c.G * 8;
    constexpr int I_IN = 16 * 112 + 16 * 96, I_NA = 4 * 32, I_DIL = 2 * 32, I_GDN = 6 * 32, I_OUT = 16 * 32, I_GU1 = 16 * 128, I_D1 = 32 * 32;
    constexpr int NITEMS = I_IN + I_NA + I_DIL + I_GDN + I_OUT + 16 * I_GU1 + 16 * I_D1;
    for (int it = gw; it < NITEMS; it += NGW) {
        int r = it;
        const float* src; long sld; int sc0, nv = 32, kv; bf16_t* dst; long dld; int dr0, k0;
        if (r < 16 * 112) { const int kb = r / 112, nb = r % 112, n0 = 32 * nb; src = args->in[2] + (size_t)l * D * DIN; sld = DIN; kv = D;
            sc0 = n0; nv = 3480 - n0; if (nv < 0) { nv = 0; sc0 = 0; } if (nv > 32) nv = 32;
            dst = WSP(bf16_t, WS_WIN); dld = D; dr0 = n0; k0 = 64 * kb; }
        else if (r < I_IN) { const int q = r - 16 * 112, kb = q / 96, nb = q % 96;
            tr_item8(args->in[2] + (size_t)l * D * DIN, DIN, 3480 + 32 * nb, D, WSP(unsigned char, WS_WG8), D, 32 * nb, 64 * kb, 32.0f, scr, lane); continue; }
        else if ((r -= I_IN) < I_NA) { const int kb = r / 32, nb = r % 32; src = args->in[8] + (size_t)l * 256 * D; sld = D; sc0 = 32 * nb; kv = 256; dst = WSP(bf16_t, WS_WBR); dld = 768; dr0 = 32 * nb; k0 = 64 * kb; }
        else if ((r -= I_NA) < I_DIL) { const int kb = r / 32, nb = r % 32; src = args->in[9] + (size_t)l * 128 * D; sld = D; sc0 = 32 * nb; kv = 128; dst = WSP(bf16_t, WS_WBR) + 256; dld = 768; dr0 = 32 * nb; k0 = 64 * kb; }
        else if ((r -= I_DIL) < I_GDN) { const int kb = r / 32, nb = r % 32; src = args->in[10] + (size_t)l * 384 * D; sld = D; sc0 = 32 * nb; kv = 384; dst = WSP(bf16_t, WS_WBR) + 384; dld = 768; dr0 = 32 * nb; k0 = 64 * kb; }
        else if ((r -= I_GDN) < I_OUT) { const int kb = r / 32, nb = r % 32; src = args->in[11] + (size_t)l * D * D; sld = D; sc0 = 32 * nb; kv = D; dst = WSP(bf16_t, WS_WOUT); dld = D; dr0 = 32 * nb; k0 = 64 * kb; }
        else if ((r -= I_OUT) < 16 * I_GU1) { const int e = r / I_GU1, q = r % I_GU1, kb = q / 128, nb = q % 128, n0 = 32 * nb, j = n0 >> 8, rr = n0 & 255;
            tr_item8((rr < 128 ? args->in[16] : args->in[15]) + ((size_t)l * NE + e) * D * DE, DE, 128 * j + (rr & 127), D, WSP(unsigned char, WS_WGU) + (size_t)e * 4096 * D, D, n0, 64 * kb, 32.0f, scr, lane); continue; }
        else { r -= 16 * I_GU1; const int e = r / I_D1, q = r % I_D1, kb = q / 32, nb = q % 32;
            tr_item8(args->in[17] + ((size_t)l * NE + e) * DE * D, D, 32 * nb, DE, WSP(unsigned char, WS_WD) + (size_t)e * D * DE, DE, 32 * nb, 64 * kb, 32.0f, scr, lane); continue; }
        tr_item(src, sld, sc0, nv, kv, dst, dld, dr0, k0, scr, lane);
    }
    if (l == 0) {
        for (int t = gw; t < T_ALL; t += NGW) {
            const float* xr = (t < T_P) ? args->in[0] + (size_t)t * D : args->in[1] + (size_t)(t - T_P) * D;
            bf16_t* o = WSP(bf16_t, WS_XB) + (size_t)t * D;
#pragma unroll
            for (int j = 0; j < 4; ++j) { const f32x4 v = *(const f32x4*)(xr + 4 * lane + 256 * j); u32x2 w; w.x = pk2(v[0], v[1]); w.y = pk2(v[2], v[3]); *(u32x2*)(o + 4 * lane + 256 * j) = w;
                *(unsigned*)(WSP(unsigned char, WS_XB8) + (size_t)t * D + 4 * lane + 256 * j) = pk4_fp8(v[0], v[1], v[2], v[3]); }
        }
        float* cs = WSP(float, WS_CS);
        for (int i = c.bid * 512 + c.tid; i < 16384 * 32; i += c.G * 512) { const int pos = i >> 5, k = i & 31;
            const float inv = INV_FREQ[k];
            const float ang = (float)pos * inv;
            cs[pos * 64 + k] = cosf(ang); cs[pos * 64 + 32 + k] = sinf(ang); }
    }
}

constexpr int TLD = 72, TILEB = 64 * TLD * 2;
DI int tsw(int row) { return ((row >> 4) & 3) << 3; }
template <bool SA = false, bool SB = false> DI f32x16 mm_tile(const LAS bf16_t* A, const LAS bf16_t* Bt, int m0, int n0, int lane) {
    f32x16 acc = zero16(); const int r = lane & 31, hh = lane >> 5; const int sa = SA ? tsw(m0 + r) : 0, sb = SB ? tsw(n0 + r) : 0;
#pragma unroll
    for (int ks = 0; ks < 4; ++ks) { const bf16x8 a = *(const LAS bf16x8*)(A + (m0 + r) * TLD + ((16 * ks + 8 * hh) ^ sa)); const bf16x8 b = *(const LAS bf16x8*)(Bt + (n0 + r) * TLD + ((16 * ks + 8 * hh) ^ sb)); acc = MFMA32(a, b, acc); }
    return acc;
}

constexpr int PI_P0 = 0, PI_P1 = 9216, PI_INTRA = 18432, PI_AM = 27648, PI_TT = 45056, PI_TD0 = 54272, PI_TD1 = 60416, PI_PM = 65024, PI_VEC = 71168, PI_BYTES = 72704;
constexpr int PI_WT = PI_AM, PI_UT = PI_TD0;
DI void gdn_prep_pair(KArgs args, LAS unsigned char* L0, const Ctx& c, int pu) {
    int tid = c.tid; asm volatile("" : "+v"(tid)); const int lane = tid & 63, wave = __builtin_amdgcn_readfirstlane(tid >> 6), l = c.layer;
    const int dir = wave >> 2, wg = wave & 3, tg = tid & 255, head = pu % 6, gch = pu / 6, inst = (gch * 6 + head) * 2 + dir;
    const int cps = c.seqlen >> 6, seq = gch / cps, n = gch % cps;
    const bf16_t* PROJ = BIGP(bf16_t, B_PROJ); const float* BA = BIGP(float, B_BA);
    unsigned char* G = BIGP(unsigned char, B_GSCR) + (size_t)inst * GSTRIDE;
    LAS unsigned char* L = L0 + dir * PI_BYTES;
    LAS bf16_t* P0 = (LAS bf16_t*)(L + PI_P0); LAS bf16_t* P1 = (LAS bf16_t*)(L + PI_P1); LAS bf16_t* INTRA = (LAS bf16_t*)(L + PI_INTRA);
    LAS float* AM = (LAS float*)(L + PI_AM); LAS bf16_t* TT = (LAS bf16_t*)(L + PI_TT);
    LAS float* TD0 = (LAS float*)(L + PI_TD0); LAS float* TD1 = (LAS float*)(L + PI_TD1); LAS float* PM = (LAS float*)(L + PI_PM);
    LAS float* GV = (LAS float*)(L + PI_VEC); LAS float* BV = GV + 64; LAS float* GC = GV + 128;
    LAS bf16_t* WT = (LAS bf16_t*)(L + PI_WT); LAS bf16_t* UT = (LAS bf16_t*)(L + PI_UT);
    const int ia = tg >> 3, p = tg & 7;
    LAS float* XQ = (LAS float*)(L0 + PI_AM);
    LAS float* XK = (LAS float*)(L0 + PI_TT);
    LAS float* XV = (LAS float*)(L0 + PI_BYTES + PI_AM);
    {   float q1[8], k1[8], v1[8];
#pragma unroll
        for (int j = 0; j < 8; ++j) { q1[j] = 0.f; k1[j] = 0.f; v1[j] = 0.f; }
        const float* cw = args->in[4] + (size_t)l * 5 * 1152 + 64 * head + 8 * p;
        const int tr = ia + 32 * dir;
        u32x4 rqa[5], rka[5], rva[5];
#pragma unroll
        for (int tp = 0; tp < 5; ++tp) { const int pp = n * 64 + tr + tp - 2, ppc = pp < 0 ? 0 : (pp >= c.seqlen ? c.seqlen - 1 : pp);
            const bf16_t* rp = PROJ + (size_t)(seq * c.seqlen + ppc) * NPROJ + 64 * head + 8 * p;
            rqa[tp] = *(const u32x4*)(rp + C_QC); rka[tp] = *(const u32x4*)(rp + C_KC); rva[tp] = *(const u32x4*)(rp + C_VC); }
#pragma unroll
        for (int tp = 0; tp < 5; ++tp) { const float* w = cw + tp * 1152;
            const f32x4 wq0 = *(const f32x4*)w, wq1 = *(const f32x4*)(w + 4), wk0 = *(const f32x4*)(w + 384), wk1 = *(const f32x4*)(w + 388), wv0 = *(const f32x4*)(w + 768), wv1 = *(const f32x4*)(w + 772);
            const int pp = n * 64 + tr + tp - 2; const bool inr = (pp >= 0 && pp < c.seqlen);
            { u32x4 rq = rqa[tp], rk = rka[tp], rv = rva[tp];
                if (!inr) { rq = (u32x4){0u, 0u, 0u, 0u}; rk = rq; rv = rq; }
#pragma unroll
                for (int j = 0; j < 4; ++j) { const float a0 = (j < 2) ? wq0[2 * j] : wq1[2 * j - 4], a1 = (j < 2) ? wq0[2 * j + 1] : wq1[2 * j - 3];
                    const float b0 = (j < 2) ? wk0[2 * j] : wk1[2 * j - 4], b1 = (j < 2) ? wk0[2 * j + 1] : wk1[2 * j - 3];
                    const float c0 = (j < 2) ? wv0[2 * j] : wv1[2 * j - 4], c1 = (j < 2) ? wv0[2 * j + 1] : wv1[2 * j - 3];
                    q1[2 * j] += a0 * bflo(rq[j]); q1[2 * j + 1] += a1 * bfhi(rq[j]);
                    k1[2 * j] += b0 * bflo(rk[j]); k1[2 * j + 1] += b1 * bfhi(rk[j]);
                    v1[2 * j] += c0 * bflo(rv[j]); v1[2 * j + 1] += c1 * bfhi(rv[j]); } } }
        float sq = 0.f, sk = 0.f;
#pragma unroll
        for (int j = 0; j < 8; ++j) { q1[j] = siluf_(q1[j]); k1[j] = siluf_(k1[j]); v1[j] = siluf_(v1[j]); sq += q1[j] * q1[j]; sk += k1[j] * k1[j]; }
        sq += __shfl_xor(sq, 1); sq += __shfl_xor(sq, 2); sq += __shfl_xor(sq, 4);
        sk += __shfl_xor(sk, 1); sk += __shfl_xor(sk, 2); sk += __shfl_xor(sk, 4);
        const float rq_ = 0.125f * frsq(sq + NORM_EPS), rk_ = frsq(sk + NORM_EPS);
        f32x4 o0, o1;
        o0[0] = q1[0] * rq_; o0[1] = q1[1] * rq_; o0[2] = q1[2] * rq_; o0[3] = q1[3] * rq_; o1[0] = q1[4] * rq_; o1[1] = q1[5] * rq_; o1[2] = q1[6] * rq_; o1[3] = q1[7] * rq_;
        *(LAS f32x4*)(XQ + tr * 64 + 8 * p) = o0; *(LAS f32x4*)(XQ + tr * 64 + 8 * p + 4) = o1;
        o0[0] = k1[0] * rk_; o0[1] = k1[1] * rk_; o0[2] = k1[2] * rk_; o0[3] = k1[3] * rk_; o1[0] = k1[4] * rk_; o1[1] = k1[5] * rk_; o1[2] = k1[6] * rk_; o1[3] = k1[7] * rk_;
        *(LAS f32x4*)(XK + tr * 64 + 8 * p) = o0; *(LAS f32x4*)(XK + tr * 64 + 8 * p + 4) = o1;
        o0[0] = v1[0]; o0[1] = v1[1]; o0[2] = v1[2]; o0[3] = v1[3]; o1[0] = v1[4]; o1[1] = v1[5]; o1[2] = v1[6]; o1[3] = v1[7];
        *(LAS f32x4*)(XV + tr * 64 + 8 * p) = o0; *(LAS f32x4*)(XV + tr * 64 + 8 * p + 4) = o1; }
#pragma unroll
    for (int h2 = 0; h2 < 2; ++h2) {
        if (p == 0) { const int i = ia + 32 * h2, tokl = dir ? 63 - i : i; const float* bar = BA + (size_t)(seq * c.seqlen + n * 64 + tokl) * 32;
            const float bl = bar[dir * 6 + head], al = bar[12 + dir * 6 + head];
            const float xx = al + args->in[6][l * 12 + dir * 6 + head];
            const float sp = xx > 20.f ? xx : log1pf(expf(xx));
            GV[i] = -expf(args->in[5][l * 12 + dir * 6 + head]) * sp; BV[i] = sigmoidf_(bl); } }
    __syncthreads();
    float q[2][8], k[2][8], v[2][8];
#pragma unroll
    for (int h2 = 0; h2 < 2; ++h2) { const int i = ia + 32 * h2, tokl = dir ? 63 - i : i;
        const f32x4 a0 = *(const LAS f32x4*)(XQ + tokl * 64 + 8 * p), a1 = *(const LAS f32x4*)(XQ + tokl * 64 + 8 * p + 4), b0 = *(const LAS f32x4*)(XK + tokl * 64 + 8 * p), b1 = *(const LAS f32x4*)(XK + tokl * 64 + 8 * p + 4),
                    c0 = *(const LAS f32x4*)(XV + tokl * 64 + 8 * p), c1 = *(const LAS f32x4*)(XV + tokl * 64 + 8 * p + 4);
#pragma unroll
        for (int j = 0; j < 4; ++j) { q[h2][j] = a0[j]; q[h2][4 + j] = a1[j]; k[h2][j] = b0[j]; k[h2][4 + j] = b1[j]; v[h2][j] = c0[j]; v[h2][4 + j] = c1[j]; } }
    float gcl_;
    { float x = GV[lane];
#pragma unroll
        for (int o = 1; o < 64; o <<= 1) { const float y = __shfl_up(x, o); if (lane >= o) x += y; }
        if (wg == 0) GC[lane] = x;
        gcl_ = x; }
    const float gc0 = __shfl(gcl_, ia), gc1 = __shfl(gcl_, ia + 32), gcl = __shfl(gcl_, 63);
#pragma unroll
    for (int h2 = 0; h2 < 2; ++h2) { const int i = ia + 32 * h2; u32x4 wq, wk;
#pragma unroll
        for (int j = 0; j < 4; ++j) { wq[j] = pk2(q[h2][2 * j], q[h2][2 * j + 1]); wk[j] = pk2(k[h2][2 * j], k[h2][2 * j + 1]); }
        *(LAS u32x4*)(P0 + i * TLD + 8 * p) = wq; *(LAS u32x4*)(P1 + i * TLD + 8 * p) = wk; }
    __syncthreads();
    { const int mat = wg >> 1, mt = wg & 1, hh = lane >> 5;
#pragma unroll
        for (int nt = 0; nt < 2; ++nt) { const int jc = 32 * nt + (lane & 31);
            const f32x16 a = mm_tile(mat ? P0 : P1, P1, 32 * mt, 32 * nt, lane);
            const float gj = GC[jc];
#pragma unroll
            for (int r = 0; r < 16; ++r) { const int ii = 32 * mt + crow(r, hh); const float gi = GC[ii];
                if (mat == 0) AM[ii * 68 + jc] = (jc < ii) ? BV[ii] * a[r] * __expf(gi - gj) : 0.f;
                else INTRA[ii * TLD + jc] = (bf16_t)(pk2((jc <= ii) ? a[r] * __expf(gi - gj) : 0.f, 0.f) & 0xffffu); } } }
    __syncthreads();
    if (wg == dir) {
        const int b = lane >> 5, cidx = lane & 31; float t[32];
#pragma unroll
        for (int ii = 0; ii < 32; ++ii) t[ii] = (ii == cidx) ? 1.f : 0.f;
        const LAS float* Ab = AM + (32 * b) * 68 + 32 * b;
#pragma unroll
        for (int ii = 1; ii < 32; ++ii) { float acc = 0.f;
#pragma unroll
            for (int j4 = 0; j4 < ii; j4 += 4) { const f32x4 a4 = *(const LAS f32x4*)(Ab + ii * 68 + j4);
                acc += a4[0] * t[j4]; acc += a4[1] * t[j4 + 1]; acc += a4[2] * t[j4 + 2]; acc += a4[3] * t[j4 + 3]; }
            t[ii] -= acc; }
        LAS float* td = b ? TD1 : TD0; const int tds = b ? 36 : 48;
#pragma unroll
        for (int ii = 0; ii < 32; ++ii) { td[ii * tds + cidx] = t[ii]; TT[(32 * b + ii) * TLD + 32 * b + cidx] = (bf16_t)(pk2(t[ii], 0.f) & 0xffffu); }
    }
#pragma unroll
    for (int h2 = 0; h2 < 2; ++h2) { const int i = ia + 32 * h2; const float be = BV[i], eg = __expf(h2 ? gc1 : gc0);
#pragma unroll
        for (int j = 0; j < 8; ++j) { const int d = 8 * p + j, o_ = d * TLD + (i ^ tsw(d)); P0[o_] = (bf16_t)(pk2(k[h2][j] * be * eg, 0.f) & 0xffffu); P1[o_] = (bf16_t)(pk2(v[h2][j] * be, 0.f) & 0xffffu); } }
    { unsigned zz; asm volatile("v_mov_b32 %0, 0" : "=v"(zz)); u32x2 z; z.x = zz; z.y = zz; *(LAS u32x2*)(TT + (tg >> 3) * TLD + 32 + 4 * (tg & 7)) = z; }
    __syncthreads();
    { const int qi = wg >> 1, qj = wg & 1, r16 = lane & 15, g4 = lane >> 4; f32x4 pc = {0.f, 0.f, 0.f, 0.f};
#pragma unroll
        for (int kk = 0; kk < 8; ++kk) pc = __builtin_amdgcn_mfma_f32_16x16x4f32(AM[(32 + 16 * qi + r16) * 68 + 4 * kk + g4], TD0[(4 * kk + g4) * 48 + 16 * qj + r16], pc, 0, 0, 0);
#pragma unroll
        for (int r = 0; r < 4; ++r) PM[(16 * qi + 4 * g4 + r) * 48 + 16 * qj + r16] = pc[r]; }
    __syncthreads();
    { const int qi = wg >> 1, qj = wg & 1, r16 = lane & 15, g4 = lane >> 4; f32x4 pc = {0.f, 0.f, 0.f, 0.f};
#pragma unroll
        for (int kk = 0; kk < 8; ++kk) pc = __builtin_amdgcn_mfma_f32_16x16x4f32(TD1[(16 * qi + r16) * 36 + 4 * kk + g4], PM[(4 * kk + g4) * 48 + 16 * qj + r16], pc, 0, 0, 0);
#pragma unroll
        for (int r = 0; r < 4; ++r) TT[(32 + 16 * qi + 4 * g4 + r) * TLD + 16 * qj + r16] = (bf16_t)(pk2(-pc[r], 0.f) & 0xffffu); }
    __syncthreads();
    { const int which = wg >> 1, mt = wg & 1, hh = lane >> 5;
#pragma unroll
        for (int nt = 0; nt < 2; ++nt) { const int dc = 32 * nt + (lane & 31);
            const f32x16 a = mm_tile<false, true>(TT, which ? P1 : P0, 32 * mt, 32 * nt, lane);
            LAS bf16_t* dst = (which ? UT : WT) + dc * TLD; const int sw = tsw(dc);
#pragma unroll
            for (int g = 0; g < 4; ++g) { u32x2 w; w.x = pk2(a[4 * g], a[4 * g + 1]); w.y = pk2(a[4 * g + 2], a[4 * g + 3]); *(LAS u32x2*)(dst + ((32 * mt + 8 * g + 4 * hh) ^ sw)) = w; } } }
    __syncthreads();
#pragma unroll
    for (int h2 = 0; h2 < 2; ++h2) { const int i = ia + 32 * h2; const float gci = h2 ? gc1 : gc0, eg = __expf(gci), ekd = __expf(gcl - gci); u32x4 wqd;
#pragma unroll
        for (int j = 0; j < 4; ++j) wqd[j] = pk2(q[h2][2 * j] * eg, q[h2][2 * j + 1] * eg);
        *(LAS u32x4*)(P1 + i * TLD + 8 * p) = wqd;
#pragma unroll
        for (int j = 0; j < 8; ++j) { const int d = 8 * p + j; P0[d * TLD + (i ^ tsw(d))] = (bf16_t)(pk2(k[h2][j] * ekd, 0.f) & 0xffffu); } }
    __syncthreads();
    { const int hh = lane >> 5, rr = lane & 31;
        if (wg == 0) {
#pragma unroll
            for (int t4 = 0; t4 < 4; ++t4) { const int mtb = t4 >> 1, nta = t4 & 1; const f32x16 a = mm_tile<true, true>(WT, P0, 32 * mtb, 32 * nta, lane);
                f32x16 na; for (int r = 0; r < 16; ++r) na[r] = -a[r];
                *(bf16x8*)(G + (size_t)((nta * 4 + 2 * mtb) * 64 + lane) * 16) = pack8<0>(na); *(bf16x8*)(G + (size_t)((nta * 4 + 2 * mtb + 1) * 64 + lane) * 16) = pack8<1>(na); }
        } else if (wg == 1) {
#pragma unroll
            for (int t4 = 0; t4 < 4; ++t4) { const int mta = t4 >> 1, nte = t4 & 1; const f32x16 a = mm_tile<true, true>(P0, UT, 32 * mta, 32 * nte, lane);
                bf16x8* dp = (bf16x8*)(G + 8192 + (size_t)((nte * 2 + mta) * 64 + lane) * 32); dp[0] = pack8<0>(a); dp[1] = pack8<1>(a); }
        } else if (wg == 2) {
#pragma unroll
            for (int t4 = 0; t4 < 4; ++t4) { const int mtb = t4 >> 1, nti = t4 & 1; const f32x16 a = mm_tile<true, false>(WT, INTRA, 32 * mtb, 32 * nti, lane);
                f32x16 qe; const LAS bf16_t* qd = P1 + (32 * nti + rr) * TLD + 32 * mtb + 4 * hh;
#pragma unroll
                for (int g = 0; g < 4; ++g) { const u32x2 w = *(const LAS u32x2*)(qd + 8 * g); qe[4 * g] = bflo(w.x) - a[4 * g]; qe[4 * g + 1] = bfhi(w.x) - a[4 * g + 1]; qe[4 * g + 2] = bflo(w.y) - a[4 * g + 2]; qe[4 * g + 3] = bfhi(w.y) - a[4 * g + 3]; }
                *(bf16x8*)(G + 16384 + (size_t)((nti * 4 + 2 * mtb) * 64 + lane) * 16) = pack8<0>(qe); *(bf16x8*)(G + 16384 + (size_t)((nti * 4 + 2 * mtb + 1) * 64 + lane) * 16) = pack8<1>(qe); }
        } else {
#pragma unroll
            for (int t4 = 0; t4 < 4; ++t4) { const int mti = t4 >> 1, nte = t4 & 1; const f32x16 a = mm_tile<false, true>(INTRA, UT, 32 * mti, 32 * nte, lane);
                bf16_t* dst = (bf16_t*)(G + 24576) + (size_t)(32 * nte + rr) * 64 + 32 * mti + 4 * hh;
#pragma unroll
                for (int g = 0; g < 4; ++g) { u32x2 w; w.x = pk2(a[4 * g], a[4 * g + 1]); w.y = pk2(a[4 * g + 2], a[4 * g + 3]); *(u32x2*)(dst + 8 * g) = w; } }
            if (lane == 0) *(float*)(G + 40960) = __expf(gcl);
        } }
    __syncthreads();
}

DI void pv_accum(const f32x16 (&acc)[2][2], f32x16 (&o)[2][2], const LAS bf16_t* Vt, int lane) {
    const int r = lane & 31, hh = lane >> 5;
#pragma unroll
    for (int mt = 0; mt < 2; ++mt) {
        {   const bf16x8 p0 = pack8<0>(acc[mt][0]), p1 = pack8<0>(acc[mt][1]);
#pragma unroll
            for (int mo = 0; mo < 2; ++mo) { const LAS bf16_t* s = Vt + (32 * mo + r) * TLD; const int c0 = (32 * mt + 4 * hh) ^ tsw(32 * mo + r);
                const u32x2 lo = *(const LAS u32x2*)(s + c0), hi = *(const LAS u32x2*)(s + (c0 ^ 8)); u32x4 w; w.x = lo.x; w.y = lo.y; w.z = hi.x; w.w = hi.y; const bf16x8 vf = __builtin_bit_cast(bf16x8, w);
                o[mo][0] = MFMA32(vf, p0, o[mo][0]); o[mo][1] = MFMA32(vf, p1, o[mo][1]); } }
        {   const bf16x8 p0 = pack8<1>(acc[mt][0]), p1 = pack8<1>(acc[mt][1]);
#pragma unroll
            for (int mo = 0; mo < 2; ++mo) { const LAS bf16_t* s = Vt + (32 * mo + r) * TLD; const int c0 = (32 * mt + 16 + 4 * hh) ^ tsw(32 * mo + r);
                const u32x2 lo = *(const LAS u32x2*)(s + c0), hi = *(const LAS u32x2*)(s + (c0 ^ 8)); u32x4 w; w.x = lo.x; w.y = lo.y; w.z = hi.x; w.w = hi.y; const bf16x8 vf = __builtin_bit_cast(bf16x8, w);
                o[mo][0] = MFMA32(vf, p0, o[mo][0]); o[mo][1] = MFMA32(vf, p1, o[mo][1]); } }
    }
}
template <class F> DI void stage_vt(LAS bf16_t* Vt, int lane, F vrow) {
#pragma unroll
    for (int it = 0; it < 8; ++it) { const int id = it * 64 + lane, key = id >> 3, part = id & 7;
        const u32x4 w = *(const u32x4*)(vrow(key) + 8 * part);
#pragma unroll
        for (int j = 0; j < 4; ++j) { const int d0 = 8 * part + 2 * j, ks_ = key ^ tsw(d0); Vt[d0 * TLD + ks_] = (bf16_t)(w[j] & 0xffffu); Vt[(d0 + 1) * TLD + ks_] = (bf16_t)(w[j] >> 16); } }
}
DI void write_o_slot(LAS float* SL, const f32x16 (&o)[2][2], int lane) {
    const int r = lane & 31, hh = lane >> 5;
#pragma unroll
    for (int mo = 0; mo < 2; ++mo)
#pragma unroll
        for (int nt = 0; nt < 2; ++nt)
#pragma unroll
            for (int g = 0; g < 4; ++g) { f32x4 v; v[0] = o[mo][nt][4 * g]; v[1] = o[mo][nt][4 * g + 1]; v[2] = o[mo][nt][4 * g + 2]; v[3] = o[mo][nt][4 * g + 3];
                *(LAS f32x4*)(SL + (32 * nt + r) * 68 + 32 * mo + 8 * g + 4 * hh) = v; }
}
DI void add_o_slot(const LAS float* SL, f32x16 (&o)[2][2], int lane) {
    const int r = lane & 31, hh = lane >> 5;
#pragma unroll
    for (int mo = 0; mo < 2; ++mo)
#pragma unroll
        for (int nt = 0; nt < 2; ++nt)
#pragma unroll
            for (int g = 0; g < 4; ++g) { const f32x4 v = *(const LAS f32x4*)(SL + (32 * nt + r) * 68 + 32 * mo + 8 * g + 4 * hh);
                o[mo][nt][4 * g] += v[0]; o[mo][nt][4 * g + 1] += v[1]; o[mo][nt][4 * g + 2] += v[2]; o[mo][nt][4 * g + 3] += v[3]; }
}

constexpr int WAREA = 10240;
DI void osm_update(f32x16 (&acc)[2][2], f32x16 (&o)[2][2], float (&m)[2], float (&l)[2]) {
#pragma unroll
    for (int nt = 0; nt < 2; ++nt) { float mx = -1e30f;
#pragma unroll
        for (int mt = 0; mt < 2; ++mt)
#pragma unroll
            for (int g = 0; g < 16; ++g) mx = fmaxf(mx, acc[mt][nt][g]);
        mx = fmaxf(mx, __shfl_xor(mx, 32));
        const float mn = fmaxf(m[nt], mx), sc = __expf(m[nt] - mn); float sm = 0.f;
#pragma unroll
        for (int mt = 0; mt < 2; ++mt)
#pragma unroll
            for (int g = 0; g < 16; ++g) { const float pz = __expf(acc[mt][nt][g] - mn); acc[mt][nt][g] = pz; sm += pz; }
        sm += __shfl_xor(sm, 32);
        l[nt] = l[nt] * sc + sm; m[nt] = mn;
#pragma unroll
        for (int g = 0; g < 16; ++g) { o[0][nt][g] *= sc; o[1][nt][g] *= sc; } }
}
template <class F> DI void store_o_rows(LAS bf16_t* T, const f32x16 (&o)[2][2], const float (&scale)[2], int lane, F rowp) {
    const int r = lane & 31, hh = lane >> 5;
#pragma unroll
    for (int mo = 0; mo < 2; ++mo)
#pragma unroll
        for (int nt = 0; nt < 2; ++nt)
#pragma unroll
            for (int g = 0; g < 4; ++g) { u32x2 w; w.x = pk2(o[mo][nt][4 * g] * scale[nt], o[mo][nt][4 * g + 1] * scale[nt]); w.y = pk2(o[mo][nt][4 * g + 2] * scale[nt], o[mo][nt][4 * g + 3] * scale[nt]);
                *(LAS u32x2*)(T + (32 * nt + r) * TLD + 32 * mo + 8 * g + 4 * hh) = w; }
    asm volatile("s_waitcnt lgkmcnt(0)" ::: "memory");
#pragma unroll
    for (int it = 0; it < 8; ++it) { const int id = it * 64 + lane, q = id >> 3, part = id & 7; *(u32x4*)(rowp(q) + 8 * part) = *(const LAS u32x4*)(T + q * TLD + 8 * part); }
    asm volatile("s_waitcnt lgkmcnt(0)" ::: "memory");
}
DI void na_wave_unit(KArgs args, LAS unsigned char* L, const Ctx& c, int u, int lane, int wave) {
    const int l = c.layer, head = u & 3, gr = u >> 2, rows = c.seqlen >> 6, seq = gr / rows, r = gr % rows;
    int rs = r - 4; rs = rs < 0 ? 0 : (rs > rows - 8 ? rows - 8 : rs);
    const bf16_t* PROJ = BIGP(bf16_t, B_PROJ);
    const size_t tq0 = (size_t)seq * c.seqlen + (size_t)r * 64;
    LAS bf16_t* Vt = (LAS bf16_t*)(L + wave * WAREA);
    LAS float* BIAS = (LAS float*)(L + wave * WAREA + 9216);
    const int rr = lane & 31, hh = lane >> 5;
#pragma unroll
    for (int w = 0; w < 4; ++w) { const int idx = w * 64 + lane, kw = idx >> 5, dc = idx & 31;
        if (dc < 31) BIAS[idx] = args->in[3][(((size_t)l * 4 + head) * 15 + (rs + kw - r + 7)) * 31 + dc]; }
    bf16x8 qf[2][4];
#pragma unroll
    for (int nt = 0; nt < 2; ++nt)
#pragma unroll
        for (int ks = 0; ks < 4; ++ks) qf[nt][ks] = *(const bf16x8*)(PROJ + (tq0 + 32 * nt + rr) * NPROJ + C_QA + 64 * head + 16 * ks + 8 * hh);
    f32x16 o[2][2]; o[0][0] = zero16(); o[0][1] = zero16(); o[1][0] = zero16(); o[1][1] = zero16();
    float m[2] = {-1e30f, -1e30f}, ls[2] = {0.f, 0.f};
    for (int w = 0; w < 8; ++w) {
        const size_t tk0 = (size_t)seq * c.seqlen + (size_t)(rs + w) * 64;
        asm volatile("s_waitcnt lgkmcnt(0)" ::: "memory");
        stage_vt(Vt, lane, [&](int key) { return PROJ + (tk0 + key) * NPROJ + C_VA + 64 * head; });
        f32x16 acc[2][2]; acc[0][0] = zero16(); acc[0][1] = zero16(); acc[1][0] = zero16(); acc[1][1] = zero16();
#pragma unroll
        for (int mt = 0; mt < 2; ++mt)
#pragma unroll
            for (int ks = 0; ks < 4; ++ks) { const bf16x8 kf = *(const bf16x8*)(PROJ + (tk0 + 32 * mt + rr) * NPROJ + C_KA + 64 * head + 16 * ks + 8 * hh);
                acc[mt][0] = MFMA32(kf, qf[0][ks], acc[mt][0]); acc[mt][1] = MFMA32(kf, qf[1][ks], acc[mt][1]); }
        asm volatile("s_waitcnt lgkmcnt(0)" ::: "memory");
        const LAS float* brow = BIAS + w * 32;
#pragma unroll
        for (int nt = 0; nt < 2; ++nt) { const int qc = 32 * nt + rr; int ws = qc - 8; ws = ws < 0 ? 0 : (ws > 48 ? 48 : ws);
#pragma unroll
            for (int mt = 0; mt < 2; ++mt)
#pragma unroll
                for (int g = 0; g < 16; ++g) { const int kc = 32 * mt + crow(g, hh); const bool ok = (kc >= ws) && (kc < ws + 16);
                    acc[mt][nt][g] = ok ? acc[mt][nt][g] * 0.125f + brow[ok ? (kc - qc + 15) : 0] : -1e30f; } }
        osm_update(acc, o, m, ls);
        pv_accum(acc, o, Vt, lane);
    }
    asm volatile("s_waitcnt lgkmcnt(0)" ::: "memory");
    const float sc[2] = {frcp(ls[0]), frcp(ls[1])};
    store_o_rows(Vt, o, sc, lane, [&](int q) { return BIGP(bf16_t, B_ONA) + (tq0 + q) * 768 + 64 * head; });
}
DI void rope_frag4(bf16x8 (&f)[4], const float* cs, int hh) {
#pragma unroll
    for (int ks = 0; ks < 2; ++ks) { const float* cp = cs + 16 * ks + 8 * hh;
        const f32x4 c0 = *(const f32x4*)cp, c1 = *(const f32x4*)(cp + 4), s0 = *(const f32x4*)(cp + 32), s1 = *(const f32x4*)(cp + 36);
        const u32x4 a = __builtin_bit_cast(u32x4, f[ks]), b = __builtin_bit_cast(u32x4, f[ks + 2]); u32x4 ra, rb;
#pragma unroll
        for (int j = 0; j < 4; ++j) { const float cl = (j < 2) ? c0[2 * j] : c1[2 * j - 4], ch = (j < 2) ? c0[2 * j + 1] : c1[2 * j - 3];
            const float sl = (j < 2) ? s0[2 * j] : s1[2 * j - 4], sh = (j < 2) ? s0[2 * j + 1] : s1[2 * j - 3];
            const float x1l = bflo(a[j]), x1h = bfhi(a[j]), x2l = bflo(b[j]), x2h = bfhi(b[j]);
            ra[j] = pk2(x1l * cl - x2l * sl, x1h * ch - x2h * sh); rb[j] = pk2(x1l * sl + x2l * cl, x1h * sh + x2h * ch); }
        f[ks] = __builtin_bit_cast(bf16x8, ra); f[ks + 2] = __builtin_bit_cast(bf16x8, rb); }
}
DI void dil_wave_unit(KArgs args, LAS unsigned char* L, const Ctx& c, int u, int lane, int wave) {
    const int hd = u & 1, uu = u >> 1, upg = c.stok >> 6, g = uu / upg, v = uu % upg, ups = c.seqlen >> 6, seq = v / ups, wq = v % ups;
    const int dsh = 2 * g, dd = 1 << dsh, nb = ups >> dsh, cls = wq / nb, jb = wq % nb, head = 2 * g + hd;
    const bf16_t* PROJ = BIGP(bf16_t, B_PROJ); const float* CS = WSP(float, WS_CS);
    const size_t sb = (size_t)seq * c.seqlen;
    const int rr = lane & 31, hh = lane >> 5;
    LAS bf16_t* Vt = (LAS bf16_t*)(L + wave * WAREA);
    bf16x8 qf[2][4];
#pragma unroll
    for (int nt = 0; nt < 2; ++nt) { const int pos = cls + dd * (64 * jb + 32 * nt + rr);
#pragma unroll
        for (int ks = 0; ks < 4; ++ks) qf[nt][ks] = *(const bf16x8*)(PROJ + (sb + pos) * NPROJ + C_QD + 64 * head + 16 * ks + 8 * hh);
        rope_frag4(qf[nt], CS + (size_t)pos * 64, hh); }
    f32x16 o[2][2]; o[0][0] = zero16(); o[0][1] = zero16(); o[1][0] = zero16(); o[1][1] = zero16();
    float m[2] = {-1e30f, -1e30f}, ls[2] = {0.f, 0.f};
    for (int kt = 0; kt < 3; ++kt) { const int kj = jb - 1 + kt;
        if (kj < 0 || kj >= nb) continue;
        asm volatile("s_waitcnt lgkmcnt(0)" ::: "memory");
        stage_vt(Vt, lane, [&](int key) { return PROJ + (sb + cls + (size_t)dd * (64 * kj + key)) * NPROJ + C_VD + 64 * head; });
        f32x16 acc[2][2]; acc[0][0] = zero16(); acc[0][1] = zero16(); acc[1][0] = zero16(); acc[1][1] = zero16();
#pragma unroll
        for (int mt = 0; mt < 2; ++mt) { const int pos = cls + dd * (64 * kj + 32 * mt + rr); bf16x8 kf[4];
#pragma unroll
            for (int ks = 0; ks < 4; ++ks) kf[ks] = *(const bf16x8*)(PROJ + (sb + pos) * NPROJ + C_KD + 64 * head + 16 * ks + 8 * hh);
            rope_frag4(kf, CS + (size_t)pos * 64, hh);
#pragma unroll
            for (int ks = 0; ks < 4; ++ks) { acc[mt][0] = MFMA32(kf[ks], qf[0][ks], acc[mt][0]); acc[mt][1] = MFMA32(kf[ks], qf[1][ks], acc[mt][1]); } }
#pragma unroll
        for (int nt = 0; nt < 2; ++nt) { const int qc = 32 * nt + rr;
#pragma unroll
            for (int mt = 0; mt < 2; ++mt)
#pragma unroll
                for (int gg = 0; gg < 16; ++gg) { const int kc = 32 * mt + crow(gg, hh); const bool ok = (kt == 1) || (kt == 0 ? (kc >= qc) : (kc <= qc));
                    acc[mt][nt][gg] = ok ? acc[mt][nt][gg] * 0.125f : -1e30f; } }
        osm_update(acc, o, m, ls);
        pv_accum(acc, o, Vt, lane);
    }
    asm volatile("s_waitcnt lgkmcnt(0)" ::: "memory");
    bf16_t* DP = BIGP(bf16_t, B_DILP); float* DM = BIGP(float, B_DILM);
    const float one[2] = {1.f, 1.f};
    store_o_rows(Vt, o, one, lane, [&](int q) { return DP + ((((size_t)g * SLABMAX + sb + cls + (size_t)dd * (64 * jb + q)) * 2 + hd)) * 64; });
    if (hh == 0) {
#pragma unroll
        for (int nt = 0; nt < 2; ++nt) { const size_t base = (((size_t)g * SLABMAX + sb + cls + (size_t)dd * (64 * jb + 32 * nt + rr)) * 2 + hd); DM[base * 2] = m[nt]; DM[base * 2 + 1] = ls[nt]; } }
}

DI void phase_mix_a(KArgs args, LAS unsigned char* L, const Ctx& c) {
    const int N_PREP = (c.stok >> 6) * 6;
    for (int u = c.bid; u < N_PREP; u += c.G) gdn_prep_pair(args, L, c, u);
}
DI void attn_wave_units(KArgs args, LAS unsigned char* L, const Ctx& c) {
    int tid = c.tid; asm volatile("" : "+v"(tid)); const int lane = tid & 63, wave = __builtin_amdgcn_readfirstlane(tid >> 6);
    const int nch_ = c.stok >> 6, N_NA = nch_ * 4, N_DIL = nch_ * 6;
    unsigned* q = (unsigned*)(c.ws + WS_CTL) + 32768 + 128 * (c.layer * 4 + c.slab);
    for (;;) { unsigned u = 0; if (lane == 0) u = __hip_atomic_fetch_add(q, 1u, __ATOMIC_RELAXED, __HIP_MEMORY_SCOPE_AGENT);
        u = (unsigned)__builtin_amdgcn_readfirstlane((int)u); if (u >= (unsigned)N_NA) break; na_wave_unit(args, L, c, (int)u, lane, wave); }
    int tid2 = c.tid; asm volatile("" : "+v"(tid2)); const int lane2 = tid2 & 63, wave2 = __builtin_amdgcn_readfirstlane(tid2 >> 6);
    for (;;) { unsigned u = 0; if (lane2 == 0) u = __hip_atomic_fetch_add(q + 64, 1u, __ATOMIC_RELAXED, __HIP_MEMORY_SCOPE_AGENT);
        u = (unsigned)__builtin_amdgcn_readfirstlane((int)u); if (u >= (unsigned)N_DIL) break; dil_wave_unit(args, L, c, (int)u, lane2, wave2); }
}

DI void phase_select(KArgs args, LAS unsigned char* L, const Ctx& c, int inst);
DI void phase_scan(KArgs args, LAS unsigned char* L, const Ctx& c) {
    if (c.slab == NSLAB - 1 && c.bid >= 24 && c.bid < 40) { phase_select(args, L, c, c.bid - 24); return; }
    const int nwu = c.nseq * 24, wu = c.bid;
    if (wu < nwu && c.wave == 0) {
        const int lane = c.lane;
        const int chain = wu >> 1, nt = wu & 1, seq = chain / 12, rem = chain % 12, head = rem >> 1, dir = rem & 1;
        const int nch = c.seqlen >> 6, gch0 = seq * nch;
        unsigned char* GS = BIGP(unsigned char, B_GSCR);
        f32x16 S[2]; S[0] = zero16(); S[1] = zero16();
        bf16x8 A[2][2][4]; u32x4 cm[2][2][2];
        const long gstep = (long)(dir ? -1 : 1) * 12 * GSTRIDE;
        const unsigned char* G0 = GS + (size_t)(((gch0 + (dir ? nch - 1 : 0)) * 6 + head) * 2 + dir) * GSTRIDE;
        unsigned char* Gs = (unsigned char*)G0;
        float glv[4];
#pragma unroll
        for (int q = 0; q < 4; ++q) { const int sq = q * 64 + lane; glv[q] = *(const float*)(G0 + (long)(sq < nch ? sq : nch - 1) * gstep + 40960); }
        LAS unsigned char* RING = L + 81920;
        int dslot = 0, rslot = 0, dstage = 0;
#define SCAN_DMA() do { const unsigned char* gp = G0 + (long)(dstage < nch ? dstage : nch - 1) * gstep; LAS unsigned char* sl = RING + dslot * 12288; \
            _Pragma("unroll") for (int j = 0; j < 8; ++j) __builtin_amdgcn_global_load_lds((const unsigned*)(gp + (size_t)(j * 64 + lane) * 16), (LAS unsigned*)(sl + j * 1024), 16, 0, 0); \
            _Pragma("unroll") for (int j = 0; j < 4; ++j) __builtin_amdgcn_global_load_lds((const unsigned*)(gp + 8192 + (size_t)((nt * 2 + (j >> 1)) * 64 + lane) * 32 + (j & 1) * 16), (LAS unsigned*)(sl + 8192 + j * 1024), 16, 0, 0); \
            ++dstage; dslot = dslot == 4 ? 0 : dslot + 1; } while (0)
#define SCAN_LOAD(B) do { const LAS unsigned char* sl = RING + rslot * 12288 + lane * 16; \
            _Pragma("unroll") for (int mt = 0; mt < 2; ++mt) { _Pragma("unroll") for (int ks = 0; ks < 4; ++ks) A[B][mt][ks] = *(const LAS bf16x8*)(sl + (mt * 4 + ks) * 1024); \
                cm[B][mt][0] = *(const LAS u32x4*)(sl + 8192 + (mt * 2) * 1024); cm[B][mt][1] = *(const LAS u32x4*)(sl + 8192 + (mt * 2 + 1) * 1024); } \
            rslot = rslot == 4 ? 0 : rslot + 1; } while (0)
#define SCAN_STEP(B, st) do { const bf16x8 b0 = pack8<0>(S[0]), b1 = pack8<1>(S[0]), b2 = pack8<0>(S[1]), b3 = pack8<1>(S[1]); f32x16 nw[2]; \
            { bf16x8* St = (bf16x8*)(Gs + 32768) + (nt * 4) * 64 + lane; St[0] = b0; St[64] = b1; St[128] = b2; St[192] = b3; }     \
            const int sq_ = (st) >> 6; const float gsel = sq_ == 0 ? glv[0] : (sq_ == 1 ? glv[1] : (sq_ == 2 ? glv[2] : glv[3])); \
            const float glc = __builtin_bit_cast(float, __builtin_amdgcn_readlane(__builtin_bit_cast(int, gsel), (st) & 63)); \
            _Pragma("unroll") for (int mt = 0; mt < 2; ++mt) { \
                _Pragma("unroll") for (int g = 0; g < 8; ++g) { const unsigned wv = (g < 4) ? cm[B][mt][0][g] : cm[B][mt][1][g - 4]; nw[mt][2 * g] = glc * S[mt][2 * g] + bflo(wv); nw[mt][2 * g + 1] = glc * S[mt][2 * g + 1] + bfhi(wv); } \
                nw[mt] = MFMA32(A[B][mt][0], b0, nw[mt]); nw[mt] = MFMA32(A[B][mt][1], b1, nw[mt]); nw[mt] = MFMA32(A[B][mt][2], b2, nw[mt]); nw[mt] = MFMA32(A[B][mt][3], b3, nw[mt]); } \
            S[0] = nw[0]; S[1] = nw[1]; Gs += gstep; } while (0)
        SCAN_DMA(); SCAN_DMA(); SCAN_DMA(); SCAN_DMA(); SCAN_DMA();
        asm volatile("s_waitcnt vmcnt(48)" ::: "memory"); SCAN_LOAD(0);
        asm volatile("s_waitcnt vmcnt(36)" ::: "memory"); SCAN_LOAD(1);
        for (int step = 0; step < nch; step += 2) {
            SCAN_STEP(0, step);     asm volatile("s_waitcnt vmcnt(24)" ::: "memory"); SCAN_LOAD(0); SCAN_DMA();
            SCAN_STEP(1, step + 1); asm volatile("s_waitcnt vmcnt(24)" ::: "memory"); SCAN_LOAD(1); SCAN_DMA();
        }
        asm volatile("s_waitcnt vmcnt(0)" ::: "memory");
#undef SCAN_DMA
#undef SCAN_LOAD
#undef SCAN_STEP
    }
    attn_wave_units(args, L, c);
}

DI void dil_merge(const Ctx& c) {
    { const bf16_t* DP = BIGP(bf16_t, B_DILP); const float* DM = BIGP(float, B_DILM); bf16_t* OD = BIGP(bf16_t, B_ONA) + 256;
        for (int it = c.bid * 512 + c.tid; it < c.stok * 32; it += c.G * 512) { const int tok = it >> 5, part = it & 31;
            u32x4 w = {0u, 0u, 0u, 0u};
            if (part < 16) { const int hd = part >> 3, p = part & 7; float m[3], dn[3];
#pragma unroll
                for (int g = 0; g < 3; ++g) { const size_t b = (((size_t)g * SLABMAX + tok) * 2 + hd); m[g] = DM[b * 2]; dn[g] = DM[b * 2 + 1]; }
                const float M = fmaxf(m[0], fmaxf(m[1], m[2])); float num[8], den = 0.f;
#pragma unroll
                for (int j = 0; j < 8; ++j) num[j] = 0.f;
#pragma unroll
                for (int g = 0; g < 3; ++g) { const float f = __expf(m[g] - M); den += f * dn[g]; const u32x4 a = *(const u32x4*)(DP + (((size_t)g * SLABMAX + tok) * 2 + hd) * 64 + 8 * p);
                    num[0] += f * bflo(a[0]); num[1] += f * bfhi(a[0]); num[2] += f * bflo(a[1]); num[3] += f * bfhi(a[1]); num[4] += f * bflo(a[2]); num[5] += f * bfhi(a[2]); num[6] += f * bflo(a[3]); num[7] += f * bfhi(a[3]); }
                const float inv = frcp(den);
                w.x = pk2(num[0] * inv, num[1] * inv); w.y = pk2(num[2] * inv, num[3] * inv); w.z = pk2(num[4] * inv, num[5] * inv); w.w = pk2(num[6] * inv, num[7] * inv); }
            if (part < 16) *(u32x4*)(OD + (size_t)tok * 768 + 8 * part) = w; } }
}

DI void phase_gdn_out(KArgs args, LAS unsigned char* L, const Ctx& c) {
    dil_merge(c);
    const int lane = c.lane, wave = c.wave, tid = c.tid, l = c.layer;
    const bf16_t* PROJ = BIGP(bf16_t, B_PROJ); unsigned char* GS = BIGP(unsigned char, B_GSCR); bf16_t* OG = BIGP(bf16_t, B_ONA) + 384;
    LAS float* OF = (LAS float*)L;
    for (int u = c.bid; u < (c.stok >> 6) * 6; u += c.G) { const int gch = u / 6, head = u % 6;
        { const int dir = wave >> 2, mt = (wave >> 1) & 1, nt = wave & 1, rr = lane & 31, hh = lane >> 5;
            const unsigned char* G = GS + (size_t)((gch * 6 + head) * 2 + dir) * GSTRIDE;
            const bf16_t* Qe = (const bf16_t*)(G + 16384); const bf16_t* Oct = (const bf16_t*)(G + 24576); const bf16_t* St = (const bf16_t*)(G + 32768);
            f32x16 acc = zero16();
#pragma unroll
            for (int ks = 0; ks < 4; ++ks) { const bf16x8 a = *(const bf16x8*)(Qe + (size_t)((mt * 4 + ks) * 64 + lane) * 8);
                const bf16x8 bw = *((const bf16x8*)St + (nt * 4 + ks) * 64 + lane); acc = MFMA32(a, bw, acc); }
            const int e = 32 * nt + rr;
#pragma unroll
            for (int g = 0; g < 4; ++g) { const u32x2 w = *(const u32x2*)(Oct + e * 64 + 32 * mt + 8 * g + 4 * hh);
                const float v0 = acc[4 * g] + bflo(w.x), v1 = acc[4 * g + 1] + bfhi(w.x), v2 = acc[4 * g + 2] + bflo(w.y), v3 = acc[4 * g + 3] + bfhi(w.y);
                const int i0 = 32 * mt + 8 * g + 4 * hh;
#pragma unroll
                for (int j = 0; j < 4; ++j) { const int ii = i0 + j, tl = dir ? 63 - ii : ii; OF[(dir * 64 + tl) * 68 + e] = (j == 0) ? v0 : (j == 1) ? v1 : (j == 2) ? v2 : v3; } } }
        __syncthreads();
        { const int i = tid >> 3, p = tid & 7; const size_t tok = (size_t)gch * 64 + i;
            const LAS float* a = OF + i * 68 + 8 * p; const LAS float* b = OF + (64 + i) * 68 + 8 * p;
            float ov[8]; float ss = 0.f;
#pragma unroll
            for (int j = 0; j < 8; ++j) { ov[j] = a[j] + b[j]; ss += ov[j] * ov[j]; }
            ss += __shfl_xor(ss, 1); ss += __shfl_xor(ss, 2); ss += __shfl_xor(ss, 4);
            const float rs = frsq(ss * (1.0f / 64.0f) + NORM_EPS);
            const u32x4 zw = *(const u32x4*)(PROJ + tok * NPROJ + C_ZC + 64 * head + 8 * p);
            const float* nw = args->in[7] + l * 64 + 8 * p;
            float r[8];
#pragma unroll
            for (int j = 0; j < 4; ++j) { r[2 * j] = ov[2 * j] * rs * nw[2 * j] * siluf_(bflo(zw[j])); r[2 * j + 1] = ov[2 * j + 1] * rs * nw[2 * j + 1] * siluf_(bfhi(zw[j])); }
            u32x4 w; w.x = pk2(r[0], r[1]); w.y = pk2(r[2], r[3]); w.z = pk2(r[4], r[5]); w.w = pk2(r[6], r[7]);
            *(u32x4*)(OG + tok * 768 + 64 * head + 8 * p) = w; }
        __syncthreads();
    }
}

DI void phase_ln1(KArgs args, LAS unsigned char* L, const Ctx& c) {
    const int lane = c.lane, l = c.layer;
    LAS float* WR = (LAS float*)L;
    { const float* wr = args->in[14] + (size_t)l * D * 16;
        for (int i = c.tid; i < D * 16; i += 512) { const int col = i >> 4, e = i & 15, j = col >> 8, ln = (col >> 2) & 63, q = col & 3; WR[((j * 4 + q) * 64 + ln) * 20 + e] = wr[i]; } }
    __syncthreads();
    const float* g1 = args->in[12] + l * D; const float* b1 = args->in[13] + l * D;
    f32x4 gv[4], bv[4];
#pragma unroll
    for (int j = 0; j < 4; ++j) { gv[j] = *(const f32x4*)(g1 + 4 * lane + 256 * j); bv[j] = *(const f32x4*)(b1 + 4 * lane + 256 * j); }
    float* AFF = WSP(float, WS_AFF); int* SLOT = WSP(int, WS_SLOT); bf16_t* XB = WSP(bf16_t, WS_XB);
    f32x4 nv[4];
    { const int rl0 = c.bid * 8 + c.wave; if (rl0 < c.stok) { const float* hp = c.out + ((size_t)c.sbase + rl0) * D;
#pragma unroll
        for (int j = 0; j < 4; ++j) nv[j] = *(const f32x4*)(hp + 4 * lane + 256 * j); } }
    for (int rl = c.bid * 8 + c.wave; rl < c.stok; rl += c.G * 8) { const size_t tok = (size_t)c.sbase + rl;
        float* hr = c.out + tok * D; f32x4 v[4]; float s = 0.f;
#pragma unroll
        for (int j = 0; j < 4; ++j) { v[j] = nv[j]; s += (v[j][0] + v[j][1]) + (v[j][2] + v[j][3]); }
        if (rl + c.G * 8 < c.stok) { const float* hp = hr + (size_t)c.G * 8 * D;
#pragma unroll
            for (int j = 0; j < 4; ++j) nv[j] = *(const f32x4*)(hp + 4 * lane + 256 * j); }
        const float mean = wave_sum(s) * (1.0f / D); float s2 = 0.f;
#pragma unroll
        for (int j = 0; j < 4; ++j) { v[j] = v[j] - mean; s2 += (v[j][0] * v[j][0] + v[j][1] * v[j][1]) + (v[j][2] * v[j][2] + v[j][3] * v[j][3]); }
        const float rstd = frsq(wave_sum(s2) * (1.0f / D) + LN_EPS);
        float lg[16];
#pragma unroll
        for (int e = 0; e < 16; ++e) lg[e] = 0.f;
#pragma unroll
        for (int j = 0; j < 4; ++j) { v[j] = v[j] * rstd * gv[j] + bv[j];
            if (!c.dry) { *(f32x4*)(hr + 4 * lane + 256 * j) = v[j];
            u32x2 w; w.x = pk2(v[j][0], v[j][1]); w.y = pk2(v[j][2], v[j][3]); *(u32x2*)(XB + tok * D + 4 * lane + 256 * j) = w; }
#pragma unroll
            for (int q = 0; q < 4; ++q) { const LAS float* wp = WR + ((j * 4 + q) * 64 + lane) * 20; const float xv = v[j][q];
#pragma unroll
                for (int e4 = 0; e4 < 4; ++e4) { const f32x4 w4 = *(const LAS f32x4*)(wp + 4 * e4); lg[4 * e4] += xv * w4[0]; lg[4 * e4 + 1] += xv * w4[1]; lg[4 * e4 + 2] += xv * w4[2]; lg[4 * e4 + 3] += xv * w4[3]; } }
            asm volatile("" ::: "memory"); }
        float mx = -1e30f;
#pragma unroll
        for (int e = 0; e < 16; ++e) { lg[e] = wave_sum(lg[e]); mx = fmaxf(mx, lg[e]); }
        float den = 0.f;
#pragma unroll
        for (int e = 0; e < 16; ++e) { lg[e] = expf(lg[e] - mx); den += lg[e]; }
        float mine = 0.f;
#pragma unroll
        for (int e = 0; e < 16; ++e) mine = (lane == e) ? lg[e] : mine;
        if (lane < 16 && !c.dry) { AFF[(size_t)lane * T_ALL + tok] = mine / den; SLOT[tok * 16 + lane] = -1; }
    }
}
DI void phase_ln2(KArgs args, LAS unsigned char* L, const Ctx& c) {
    const int lane = c.lane, l = c.layer;
    const float* g2 = args->in[18] + l * D; const float* b2 = args->in[19] + l * D;
    f32x4 gv[4], bv[4];
#pragma unroll
    for (int j = 0; j < 4; ++j) { gv[j] = *(const f32x4*)(g2 + 4 * lane + 256 * j); bv[j] = *(const f32x4*)(b2 + 4 * lane + 256 * j); }
    const int* SLOT = WSP(int, WS_SLOT); bf16_t* XB = WSP(bf16_t, WS_XB);
    f32x4 nv[4]; int nsv = -1;
    { const int t0 = c.bid * 8 + c.wave; if (t0 < T_ALL) { const float* xp = c.out + (size_t)t0 * D; nsv = SLOT[(size_t)t0 * 16 + (lane & 15)];
#pragma unroll
        for (int j = 0; j < 4; ++j) nv[j] = *(const f32x4*)(xp + 4 * lane + 256 * j); } }
    for (int t = c.bid * 8 + c.wave; t < T_ALL; t += c.G * 8) { const size_t tok = (size_t)t;
        float* xr = c.out + tok * D; f32x4 v[4];
#pragma unroll
        for (int j = 0; j < 4; ++j) v[j] = nv[j] * ALPHA;
        const int sv = nsv;
        if (t + c.G * 8 < T_ALL) { const float* xp = xr + (size_t)c.G * 8 * D; nsv = SLOT[(tok + c.G * 8) * 16 + (lane & 15)];
#pragma unroll
            for (int j = 0; j < 4; ++j) nv[j] = *(const f32x4*)(xp + 4 * lane + 256 * j); }
#pragma unroll
        for (int e = 0; e < 16; ++e) { const int s = __builtin_amdgcn_readlane(sv, e);
            if (s >= 0) { const bf16_t* yr = BIGP(bf16_t, (e < 8 ? B_XY0 : B_XY1)) + ((size_t)(e & 7) * CAP + s) * D;
#pragma unroll
                for (int j = 0; j < 4; ++j) { const u32x2 w = *(const u32x2*)(yr + 4 * lane + 256 * j); v[j][0] += bflo(w.x); v[j][1] += bfhi(w.x); v[j][2] += bflo(w.y); v[j][3] += bfhi(w.y); } } }
        float s = 0.f;
#pragma unroll
        for (int j = 0; j < 4; ++j) s += (v[j][0] + v[j][1]) + (v[j][2] + v[j][3]);
        const float mean = wave_sum(s) * (1.0f / D); float s2 = 0.f;
#pragma unroll
        for (int j = 0; j < 4; ++j) { v[j] = v[j] - mean; s2 += (v[j][0] * v[j][0] + v[j][1] * v[j][1]) + (v[j][2] * v[j][2] + v[j][3] * v[j][3]); }
        const float rstd = frsq(wave_sum(s2) * (1.0f / D) + LN_EPS);
#pragma unroll
        for (int j = 0; j < 4; ++j) { v[j] = v[j] * rstd * gv[j] + bv[j];
            if (!c.dry) { *(f32x4*)(xr + 4 * lane + 256 * j) = v[j];
            u32x2 w; w.x = pk2(v[j][0], v[j][1]); w.y = pk2(v[j][2], v[j][3]); *(u32x2*)(XB + tok * D + 4 * lane + 256 * j) = w;
            *(unsigned*)(WSP(unsigned char, WS_XB8) + tok * D + 4 * lane + 256 * j) = pk4_fp8(v[j][0], v[j][1], v[j][2], v[j][3]); } }
    }
}

DI int block_excl_scan(int v, LAS int* tmp, int tid, int& total) {
    const int lane = tid & 63, wave = tid >> 6; int x = v;
#pragma unroll
    for (int o = 1; o < 64; o <<= 1) { const int y = __shfl_up(x, o); if (lane >= o) x += y; }
    __syncthreads();
    if (lane == 63) tmp[wave] = x;
    __syncthreads();
    int base = 0, tot = 0;
#pragma unroll
    for (int w = 0; w < 8; ++w) { const int tw = tmp[w]; if (w < wave) base += tw; tot += tw; }
    total = tot;
    return base + x - v;
}
DI void phase_select(KArgs args, LAS unsigned char* L, const Ctx& c, int inst) {
    if (inst < 0 || inst >= 32) return;
    const int tid = c.tid, grp = inst >> 4, e = inst & 15;
    const int n = grp ? T_S : T_P, t0 = grp ? T_P : 0, C = n >> 3, slot0 = grp ? CAP_P : 0;
    const unsigned* v = (const unsigned*)(WSP(float, WS_AFF) + (size_t)e * T_ALL + t0);
    LAS unsigned* hist = (LAS unsigned*)L; LAS int* sh = (LAS int*)(L + 8192); LAS int* tmp = (LAS int*)(L + 8192 + 64);
    unsigned prefix = 0u; int kk = C;
    for (int pass = 0; pass < 3; ++pass) {
        const int shift = pass == 0 ? 21 : (pass == 1 ? 10 : 0); const unsigned bmask = pass == 2 ? 1023u : 2047u;
        const unsigned mhi = pass == 0 ? 0u : (pass == 1 ? 0xFFE00000u : 0xFFFFFC00u);
        *(LAS u32x4*)(hist + 4 * tid) = (u32x4){0u, 0u, 0u, 0u};
        __syncthreads();
        for (int i = tid * 4; i < n; i += 512 * 16) {
            u32x4 x4[4];
#pragma unroll
            for (int k = 0; k < 4; ++k) x4[k] = *(const u32x4*)(v + i + k * 2048);
#pragma unroll
            for (int k = 0; k < 4; ++k)
#pragma unroll
                for (int j = 0; j < 4; ++j) { const unsigned x = x4[k][j]; if ((x & mhi) == prefix) __hip_atomic_fetch_add(&hist[(x >> shift) & bmask], 1u, __ATOMIC_RELAXED, __HIP_MEMORY_SCOPE_WORKGROUP); } }
        __syncthreads();
        {
            const u32x4 hv = *(const LAS u32x4*)(hist + 2044 - 4 * tid); int tot;
            int cum = block_excl_scan((int)(hv[0] + hv[1] + hv[2] + hv[3]), tmp, tid, tot);
            const int c1 = cum + (int)hv.w, c2 = c1 + (int)hv.z, c3 = c2 + (int)hv.y, c4 = c3 + (int)hv.x;
            if (cum < kk && kk <= c4) { const int j = kk <= c1 ? 0 : (kk <= c2 ? 1 : (kk <= c3 ? 2 : 3)); const int cb = kk <= c1 ? cum : (kk <= c2 ? c1 : (kk <= c3 ? c2 : c3));
                sh[0] = 2047 - 4 * tid - j; sh[1] = kk - cb; } }
        __syncthreads();
        prefix |= ((unsigned)sh[0]) << shift; kk = sh[1];
        __syncthreads();
    }
    const unsigned thr = prefix;
    const int per = n >> 9, i0 = tid * per;
    int ngt = 0, ntie = 0;
    for (int i = 0; i < per; i += 4) { const u32x4 x = *(const u32x4*)(v + i0 + i);
#pragma unroll
        for (int j = 0; j < 4; ++j) { ngt += (x[j] > thr); ntie += (x[j] == thr); } }
    int tot;
    const int tie_base = block_excl_scan(ntie, tmp, tid, tot);
    int take = kk - tie_base; take = take < 0 ? 0 : (take > ntie ? ntie : take);
    int pos = block_excl_scan(ngt + take, tmp, tid, tot);
    int* IDX = WSP(int, WS_IDX) + e * CAP + slot0;
    int tr = 0;
    for (int i = 0; i < per; i += 4) { const u32x4 x = *(const u32x4*)(v + i0 + i);
#pragma unroll
        for (int j = 0; j < 4; ++j) { bool s = x[j] > thr; if (x[j] == thr) { s = tr < take; ++tr; } if (s) { IDX[pos] = t0 + i0 + i + j; ++pos; } } }
}
DI void phase_gather(KArgs args, LAS unsigned char* L, const Ctx& c) {
    const int lane = c.lane; const int* IDX = WSP(int, WS_IDX); const bf16_t* XB = WSP(bf16_t, WS_XB);
    float* GATEV = WSP(float, WS_GATEV); int* SLOT = WSP(int, WS_SLOT); const float* AFF = WSP(float, WS_AFF);
    for (int row0 = (c.bid * 8 + c.wave) * 4; row0 < NE * CAP; row0 += c.G * 8 * 4) {
        const int e = row0 / CAP, s0 = row0 % CAP; int t[4]; u32x4 a[4], b[4];
#pragma unroll
        for (int k = 0; k < 4; ++k) t[k] = IDX[row0 + k];
#pragma unroll
        for (int k = 0; k < 4; ++k) { const u32x4* src = (const u32x4*)(XB + (size_t)t[k] * D) + 2 * lane; a[k] = src[0]; b[k] = src[1]; }
        u32x4* dst = (u32x4*)(BIGP(unsigned char, (e < 8 ? B_XY0 : B_XY1)) + ((size_t)(e & 7) * CAP + s0) * D);
#pragma unroll
        for (int k = 0; k < 4; ++k) { u32x4 w;
            w.x = pk4_fp8(bflo(a[k].x), bfhi(a[k].x), bflo(a[k].y), bfhi(a[k].y)); w.y = pk4_fp8(bflo(a[k].z), bfhi(a[k].z), bflo(a[k].w), bfhi(a[k].w));
            w.z = pk4_fp8(bflo(b[k].x), bfhi(b[k].x), bflo(b[k].y), bfhi(b[k].y)); w.w = pk4_fp8(bflo(b[k].z), bfhi(b[k].z), bflo(b[k].w), bfhi(b[k].w));
            dst[k * 64 + lane] = w; }
        if (lane < 4) { const int tt = (lane == 0) ? t[0] : (lane == 1) ? t[1] : (lane == 2) ? t[2] : t[3]; SLOT[(size_t)tt * 16 + e] = s0 + lane; GATEV[row0 + lane] = AFF[(size_t)e * T_ALL + tt]; } }
}

__global__ void __launch_bounds__(512, 2) fwd_kernel(Args args) {
    extern __shared__ __attribute__((aligned(16))) unsigned char lds_raw[];
    LAS unsigned char* L = (LAS unsigned char*)lds_raw;
    Ctx c;
    c.out = args.out; c.ws = args.ws;
    c.tid = threadIdx.x; c.lane = c.tid & 63; c.wave = __builtin_amdgcn_readfirstlane(c.tid >> 6); c.G = gridDim.x; c.bid = blockIdx.x;
    c.layer = 0; c.slab = 0; c.nseq = 8; c.seqlen = 4096; c.stok = 32768; c.sbase = 0; c.dry = 0;
    const int lo = args.ph_lo, hi = args.ph_hi;
    volatile LAS unsigned* MISC = (volatile LAS unsigned*)(L + LDS_MISC);
    if (c.tid < 4) MISC[c.tid] = 0u;
    __syncthreads();
    XcdBarrier bar; bar.bar = (unsigned*)(c.ws + WS_CTL) + 1024; bar.x = 0; bar.st = MISC;
    if (hi - lo > 1) bar = xcd_barrier_post((unsigned*)(c.ws + WS_CTL) + 1024, MISC);
    int pc = 0;
#ifndef PHMASK
#define PHMASK 0xFFFF
#endif
#define PHON(k) (((PHMASK) >> (k)) & 1)
#ifndef REPMASK
#define REPMASK 0x0
#endif
#define PH_BEGIN(k) if (PHON(k) && pc >= lo && pc < hi) { { int tz = threadIdx.x; asm volatile("" : "+v"(tz)); c.tid = tz; c.lane = tz & 63; c.wave = __builtin_amdgcn_readfirstlane(tz >> 6); } KArgs ka = kargs(); c.ws = ka->ws; c.out = ka->out; { int b_ = blockIdx.x, g_ = gridDim.x; asm volatile("" : "+s"(b_), "+s"(g_)); c.bid = b_; c.G = g_; } for (int rep_ = 0; rep_ < (((REPMASK) >> (k)) & 1) + 1; ++rep_) { if (rep_) __syncthreads(); c.dry = (rep_ + 1 < (((REPMASK) >> (k)) & 1) + 1);
#ifndef BARREP
#define BARREP 0
#endif
#define PH_END   } if (pc + 1 < hi) { xcd_barrier(bar); if (BARREP) { xcd_barrier(bar); xcd_barrier(bar); } } else { asm volatile("s_waitcnt vmcnt(0)" ::: "memory"); __syncthreads(); } } ++pc;

    for (int layer = 0; layer < 2; ++layer) {
        c.layer = layer;
        PH_BEGIN(0) phase_weights(ka, L, c); PH_END
        for (int slab = 0; slab < NSLAB; ++slab) {
            c.slab = slab; c.nseq = slab < 2 ? 8 : 1; c.seqlen = slab < 2 ? 4096 : 16384; c.stok = slab < 2 ? 32768 : 16384; c.sbase = slab * 32768; const int stok = c.stok; const size_t sbase = (size_t)c.sbase;
            PH_BEGIN(1) {
                { pg8::Gemm g{WSP(bf16_t, WS_XB) + sbase * D, WSP(bf16_t, WS_WIN), stok, 3584, D}; pg8::StaticOrder S; S.init(stok, 3584, c.G, c.bid);
                  pg8::EpiInProj E{BIGP(bf16_t, B_PROJ), BIGP(float, B_BA)};
                  pg8::gemm_phase<pg8::EpiInProj, pg8::StaticOrder>(L, g, S, E); }
                { pg8::Gemm g{(const bf16_t*)(WSP(unsigned char, WS_XB8) + sbase * D), (const bf16_t*)WSP(unsigned char, WS_WG8), stok, 3072, D / 2}; pg8::StaticOrder S; S.init(stok, 3072, c.G, c.bid);
                  pg8::EpiGates E{BIGP(bf16_t, B_PROJ)};
                  pg8::gemm_phase<pg8::EpiGates, pg8::StaticOrder>(L, g, S, E); } } PH_END
            PH_BEGIN(2) phase_mix_a(ka, L, c); PH_END
            PH_BEGIN(3) phase_scan(ka, L, c); PH_END
            PH_BEGIN(4) phase_gdn_out(ka, L, c); PH_END
            PH_BEGIN(5) {
                pg8::StaticOrder S; S.init(stok, D, c.G, c.bid);
                pg8::Gemm g{BIGP(bf16_t, B_ONA), WSP(bf16_t, WS_WBR), stok, D, 768}; pg8::EpiGateCat E{BIGP(bf16_t, B_PROJ), BIGP(bf16_t, B_MERGED)};
                pg8::gemm_phase<pg8::EpiGateCat, pg8::StaticOrder>(L, g, S, E); } PH_END
            PH_BEGIN(6) {
                const float* xr = layer == 0 ? (slab < 2 ? ka->in[0] + sbase * D : ka->in[1]) : c.out + sbase * D;
                pg8::Gemm g{BIGP(bf16_t, B_MERGED), WSP(bf16_t, WS_WOUT), stok, D, D}; pg8::StaticOrder S; S.init(stok, D, c.G, c.bid);
                pg8::EpiRes E{xr, c.out + sbase * D};
                pg8::gemm_phase<pg8::EpiRes, pg8::StaticOrder>(L, g, S, E); } PH_END
#ifndef LN1PROBE
#define LN1PROBE 0
#endif
            PH_BEGIN(7) if (LN1PROBE) { c.dry = 1; phase_ln1(ka, L, c); __syncthreads(); c.dry = 0; } phase_ln1(ka, L, c); PH_END
        }
        PH_BEGIN(8) phase_select(ka, L, c, c.bid < 16 ? 16 + c.bid : -1); PH_END
        PH_BEGIN(9) phase_gather(ka, L, c); PH_END
        for (int half = 0; half < 2; ++half) {
            PH_BEGIN(10) {
                pg8::Gemm g{BIGP(bf16_t, half ? B_XY1 : B_XY0), (const bf16_t*)(WSP(unsigned char, WS_WGU) + (size_t)half * 8 * 4096 * D), 8 * CAP, 8 * 4096, D / 2}; pg8::MoeOrder S; S.init(8, CAP / 256, 16, c.G, c.bid);
                pg8::EpiSwiglu E{BIGP(unsigned char, B_HID)};
                pg8::gemm_phase<pg8::EpiSwiglu, pg8::MoeOrder>(L, g, S, E); } PH_END
            PH_BEGIN(11) {
                pg8::Gemm g{BIGP(bf16_t, B_HID), (const bf16_t*)(WSP(unsigned char, WS_WD) + (size_t)half * 8 * D * DE), 8 * CAP, 8 * D, DE / 2}; pg8::MoeOrder S; S.init(8, CAP / 256, 4, c.G, c.bid);
                pg8::EpiDown E{BIGP(bf16_t, half ? B_XY1 : B_XY0), WSP(float, WS_GATEV) + (size_t)half * 8 * CAP};
                pg8::gemm_phase<pg8::EpiDown, pg8::MoeOrder>(L, g, S, E); } PH_END
        }
        PH_BEGIN(12) phase_ln2(ka, L, c); PH_END
    }
#undef PH_BEGIN
#undef PH_END
}

constexpr int N_PHASES = 2 * (1 + NSLAB * 7 + 2 + 4 + 1);

extern "C" void kernel_launch(void* const* d_in, const int* in_sizes, int n_in, void* d_out, int out_size, void* d_ws, size_t ws_size, hipStream_t stream) {
    static int grid = 0;
    if (grid == 0) {
        if (n_in != 20 || ws_size < WS_END) { fprintf(stderr, "kernel_launch: unexpected n_in %d or ws_size %zu (< %zu)\n", n_in, ws_size, (size_t)WS_END); grid = -1; return; }
        int dev = 0, cus = 0, per_cu = 0;
        if (hipGetDevice(&dev) != hipSuccess || hipDeviceGetAttribute(&cus, hipDeviceAttributeMultiprocessorCount, dev) != hipSuccess) { grid = -1; return; }
        if (hipFuncSetAttribute((const void*)fwd_kernel, hipFuncAttributeMaxDynamicSharedMemorySize, LDS_BYTES) != hipSuccess) { fprintf(stderr, "kernel_launch: hipFuncSetAttribute failed\n"); grid = -1; return; }
        if (hipOccupancyMaxActiveBlocksPerMultiprocessor(&per_cu, (const void*)fwd_kernel, 512, LDS_BYTES) != hipSuccess || per_cu < 1) fprintf(stderr, "kernel_launch: occupancy query says %d\n", per_cu);
        (void)hipGetLastError();
        grid = cus;
    }
    if (grid < 0) return;
    (void)hipMemsetAsync((char*)d_ws + WS_CTL, 0, 1 * MiB, stream);
    Args a{};
    for (int i = 0; i < 20; ++i) a.in[i] = (const float*)d_in[i];
    a.out = (float*)d_out; a.ws = (unsigned char*)d_ws;
#if MK_N_LAUNCHES == 1
    a.ph_lo = 0; a.ph_hi = N_PHASES;
    hipLaunchKernelGGL(fwd_kernel, dim3(grid), dim3(512), LDS_BYTES, stream, a);
#else
    for (int p = 0; p < N_PHASES; ++p) { a.ph_lo = p; a.ph_hi = p + 1; hipLaunchKernelGGL(fwd_kernel, dim3(grid), dim3(512), LDS_BYTES, stream, a); }
#endif
}
```

```cpp
#include <hip/hip_runtime.h>
#include <stdint.h>
#include <stdio.h>

#define LAS __attribute__((address_space(3)))
#define DI __device__ __forceinline__
typedef unsigned short bf16_t;
typedef short bf16x8 __attribute__((ext_vector_type(8)));
typedef float f32x4 __attribute__((ext_vector_type(4)));
typedef float f32x2 __attribute__((ext_vector_type(2)));
typedef float f32x16 __attribute__((ext_vector_type(16)));
typedef unsigned u32x4 __attribute__((ext_vector_type(4)));
typedef unsigned u32x2 __attribute__((ext_vector_type(2)));
typedef __bf16 bf16x2v __attribute__((ext_vector_type(2)));

#ifndef MK_N_LAUNCHES
#define MK_N_LAUNCHES 1
#endif

constexpr int D = 1024, T_ALL = 81920, T_P = 65536, T_S = 16384, SLABMAX = 32768, NSLAB = 3;
constexpr int DIN = 6552, NPROJ = 6656;
constexpr int C_GATE = 0, C_QA = 3072, C_KA = 3328, C_VA = 3584, C_QD = 3840, C_KD = 4224, C_VD = 4608, C_QC = 4992, C_KC = 5376, C_VC = 5760, C_ZC = 6144;
constexpr int NE = 16, DE = 2048, CAP_P = 8192, CAP_S = 2048, CAP = CAP_P + CAP_S;
constexpr float ALPHA = 1.41421356237f, LN_EPS = 1e-5f, NORM_EPS = 1e-6f;
constexpr size_t MiB = 1u << 20;
constexpr size_t WS_CTL = 0, WS_WIN = 1 * MiB, WS_WBR = 14 * MiB, WS_WOUT = 16 * MiB, WS_WGU = 18 * MiB, WS_WD = 82 * MiB, WS_XB8 = 114 * MiB, WS_WG8 = 194 * MiB, WS_XB = 210 * MiB;
constexpr size_t WS_AFF = 370 * MiB, WS_SLOT = 375 * MiB, WS_IDX = 380 * MiB, WS_GATEV = 381 * MiB, WS_CS = 382 * MiB, WS_BIG = 386 * MiB, WS_END = 1130 * MiB;
constexpr size_t B_PROJ = 0, B_BA = 416 * MiB, B_ONA = 420 * MiB, B_ODIL = 436 * MiB, B_OGDN = 452 * MiB, B_DILP = 476 * MiB, B_DILM = 500 * MiB, B_GSCR = 502 * MiB, B_MERGEF = 502 * MiB, B_MERGED = 630 * MiB;
constexpr size_t B_XY0 = 0, B_XY1 = 160 * MiB, B_HID = 320 * MiB;
constexpr int GSTRIDE = 41216;
constexpr int LDS_BYTES = 147456;
constexpr int LDS_MISC = 145408;

DI unsigned pk2(float lo, float hi) { f32x2 v = {lo, hi}; bf16x2v b = __builtin_convertvector(v, bf16x2v); return __builtin_bit_cast(unsigned, b); }
DI unsigned pk4_fp8(float a, float b, float c, float d) {
    int w = __builtin_amdgcn_cvt_pk_fp8_f32(a, b, 0, false); w = __builtin_amdgcn_cvt_pk_fp8_f32(c, d, w, true); return (unsigned)w; }
DI float bflo(unsigned u) { return __uint_as_float(u << 16); }
DI float bfhi(unsigned u) { return __uint_as_float(u & 0xffff0000u); }
DI float frcp(float x) { return __builtin_amdgcn_rcpf(x); }
DI float frsq(float x) { return __builtin_amdgcn_rsqf(x); }
DI float sigmoidf_(float x) { return frcp(1.0f + __expf(-x)); }
DI float siluf_(float x) { return x * frcp(1.0f + __expf(-x)); }
DI float wave_sum(float v) {
#pragma unroll
    for (int o = 1; o < 64; o <<= 1) v += __shfl_xor(v, o);
    return v;
}
#define MFMA32(a, b, c) __builtin_amdgcn_mfma_f32_32x32x16_bf16((a), (b), (c), 0, 0, 0)
DI int crow(int reg, int h) { return (reg & 3) + 8 * (reg >> 2) + 4 * h; }
DI f32x16 zero16() { f32x16 z; for (int i = 0; i < 16; ++i) z[i] = 0.f; return z; }
template <int S> DI bf16x8 pack8(const f32x16& x) {
    u32x4 p; p[0] = pk2(x[8 * S], x[8 * S + 1]); p[1] = pk2(x[8 * S + 2], x[8 * S + 3]); p[2] = pk2(x[8 * S + 4], x[8 * S + 5]); p[3] = pk2(x[8 * S + 6], x[8 * S + 7]);
    return __builtin_bit_cast(bf16x8, p);
}

namespace pg8 {
constexpr int BM = 256, BK = 64, HALF = 128, HTB = HALF * BK * 2, STAGE_BYTES = 8 * HTB, NXCD = 8, WGM = 8;
__host__ __device__ __forceinline__ int lds_byte(int r, int c) { const int st = (r >> 4) * 2 + (c >> 5), rr = r & 15, cc = c & 31, ob = rr * 64 + cc * 2; return st * 1024 + (ob ^ (((ob >> 9) & 1) << 5)); }
__host__ __device__ __forceinline__ void stage_rc(int b, int& R, int& C) { const int st = b / 1024, sb = b % 1024, swz = sb ^ (((sb >> 9) & 1) << 5); R = (st >> 1) * 16 + swz / 64; C = (st & 1) * 32 + (swz % 64) / 2; }
__host__ __device__ __forceinline__ int perm32(int rho) { const int n = rho >> 4, i = rho & 15; return 8 * (i >> 2) + 4 * n + (i & 3); }
struct Unit { int pm, pn; };
struct Gemm { const bf16_t* A; const bf16_t* Bt; int M, N, K; };
struct StaticOrder {
    int nM, nN, nwg, G, c;
    __device__ void init(int M, int N, int G_, int c_) { nM = M / BM; nN = N / BM; nwg = nM * nN; G = G_; c = c_; }
    __device__ bool next(int i, Unit& u) const {
        const long L = (long)i * G + c; if (L >= nwg) return false;
        int wgid = (int)L; { const int q = nwg / NXCD, r = nwg % NXCD, xcd = wgid % NXCD, off = wgid / NXCD; wgid = (xcd < r ? xcd * (q + 1) : r * (q + 1) + (xcd - r) * q) + off; }
        const int nig = WGM * nN, gid = wgid / nig, fm = gid * WGM, gsz = (nM - fm) < WGM ? (nM - fm) : WGM;
        u.pm = fm + ((wgid % nig) % gsz); u.pn = (wgid % nig) / gsz; return true;
    }
    __device__ __forceinline__ void a_ready(const Unit&) const {}
    __device__ __forceinline__ void done(const Unit&) const {}
};
struct MoeOrder {
    int nMe, nNe, per, total, G, c, xr, xc, rpx, cpx, share;
    __device__ void init(int nE, int nMe_, int nNe_, int G_, int c_) { nMe = nMe_; nNe = nNe_; per = nMe * nNe; total = nE * per; G = G_; c = c_;
        xc = (nNe % 2 == 0 && nNe >= 8) ? 2 : 1; xr = 8 / xc; rpx = nMe / xr; cpx = nNe / xc; share = rpx * cpx; }
    __device__ bool next(int i, Unit& u) const {
        if ((G & 7) == 0 && nMe % xr == 0) {
            const int x = c & 7, q = c >> 3, nq = G >> 3; const long j = (long)i * nq + q; if (j >= (long)(total / 8)) return false;
            const int e = (int)(j / share), r = (int)(j % share); const int pm = (x / xc) * rpx + r % rpx, pn = (x % xc) * cpx + r / rpx;
            u.pm = e * nMe + pm; u.pn = e * nNe + pn; return true;
        }
        const long L = (long)i * G + c; if (L >= total) return false;
        const int e = (int)(L / per), r = (int)(L % per);
        u.pm = e * nMe + r % nMe; u.pn = e * nNe + r / nMe; return true;
    }
    __device__ __forceinline__ void a_ready(const Unit&) const {}
    __device__ __forceinline__ void done(const Unit&) const {}
};

template <class Epi, class Sched>
__device__ __forceinline__ void gemm_phase(LAS unsigned char* lds, const Gemm g, const Sched& S, const Epi& E) {
    int tid = threadIdx.x; asm volatile("" : "+v"(tid));
    const int wid = __builtin_amdgcn_readfirstlane(tid >> 6), lane = tid & 63, wr = wid >> 2, wc = wid & 3, fr = lane & 15, fq = lane >> 4;
    int Kv = g.K; asm volatile("" : "+s"(Kv));
    const int K = Kv, nt = K / BK;
    unsigned voffA[2], voffB[2];
#pragma unroll
    for (int i = 0; i < 2; ++i) { int R, C; stage_rc(tid * 16 + i * 8192, R, C); const int Rb = Epi::PERM ? ((R & ~31) + perm32(R & 31)) : R;
        voffA[i] = (unsigned)(R * K + C) * 2u; voffB[i] = (unsigned)(Rb * K + C) * 2u; }
    const size_t kstep = (size_t)(BK * 2);
    const size_t hstep = (size_t)HALF * K * 2;
    const size_t tstep = 2 * hstep;
    const unsigned ldsw = (unsigned)wid * 1024u;
    const int aoff = lds_byte(wr * 64 + fr, fq * 8), boff = lds_byte(wc * 32 + fr, fq * 8);
#define PG8_SA(b, h) (((b) * 2 + (h)) * HTB)
#define PG8_SB(b, h) ((4 + (b) * 2 + (h)) * HTB)
#define PG8_STAGE(bufoff, gbase, voff) do { _Pragma("unroll") for (int _i = 0; _i < 2; ++_i) \
        __builtin_amdgcn_global_load_lds((const unsigned*)((const char*)(gbase) + (voff)[_i]), (LAS unsigned*)(lds + (bufoff) + ldsw + _i * 8192), 16, 0, 0); } while (0)
#define PG8_LD8(p) __builtin_shufflevector(*(const LAS v4i_*)(p), *(const LAS v4i_*)((p) + 1024), 0, 1, 2, 3, 4, 5, 6, 7)
#define PG8_LDA(dst, b, h) do { _Pragma("unroll") for (int m = 0; m < 4; ++m) { if constexpr (Epi::FP8) dst##8[m] = PG8_LD8(lds + PG8_SA(b, h) + aoff + m * 2048); \
        else { _Pragma("unroll") for (int k = 0; k < 2; ++k) dst[m][k] = *(const LAS bf16x8*)(lds + PG8_SA(b, h) + aoff + m * 2048 + k * 1024); } } } while (0)
#define PG8_LDB(dst, b, h) do { _Pragma("unroll") for (int n = 0; n < 2; ++n) { if constexpr (Epi::FP8) dst##8[n] = PG8_LD8(lds + PG8_SB(b, h) + boff + n * 2048); \
        else { _Pragma("unroll") for (int k = 0; k < 2; ++k) dst[n][k] = *(const LAS bf16x8*)(lds + PG8_SB(b, h) + boff + n * 2048 + k * 1024); } } } while (0)
#define PG8_MMA(ai, bj, At, Bt) do { __builtin_amdgcn_s_setprio(1); _Pragma("unroll") for (int m = 0; m < 4; ++m) _Pragma("unroll") for (int n = 0; n < 2; ++n) { \
        if constexpr (Epi::FP8) asm volatile("v_mfma_scale_f32_16x16x128_f8f6f4 %0, %1, %2, %0, %3, %3 op_sel_hi:[0,0,0]" : "+v"(acc[ai][bj][m][n]) : "v"(Bt##8[n]), "v"(At##8[m]), "v"(fp8_unit_scale));   \
        else { _Pragma("unroll") for (int k = 0; k < 2; ++k) acc[ai][bj][m][n] = __builtin_amdgcn_mfma_f32_16x16x32_bf16(Bt[n][k], At[m][k], acc[ai][bj][m][n], 0, 0, 0); } } \
        __builtin_amdgcn_s_setprio(0); } while (0)
#define PG8_WAIT_V(n) asm volatile("s_waitcnt vmcnt(" #n ")" ::: "memory")
#define PG8_WAIT_L(n) asm volatile("s_waitcnt lgkmcnt(" #n ")" ::: "memory")
#define PG8_BAR __builtin_amdgcn_s_barrier()
#define PG8_SCHED __builtin_amdgcn_sched_barrier(0)
    Unit cur, nxt; int ui = 0;
    if (!S.next(0, cur)) return;
    f32x4 acc[2][2][4][2];
#pragma unroll
    for (int a = 0; a < 2; ++a)
#pragma unroll
        for (int b = 0; b < 2; ++b)
#pragma unroll
            for (int m = 0; m < 4; ++m)
#pragma unroll
                for (int n = 0; n < 2; ++n) acc[a][b][m][n] = (f32x4){0.f, 0.f, 0.f, 0.f};
    typedef int v4i_ __attribute__((ext_vector_type(4))); typedef int v8i_ __attribute__((ext_vector_type(8)));
    bf16x8 At[4][2], B0[2][2], B1[2][2]; v8i_ At8[4], B08[2], B18[2];
    int fp8_unit_scale = 0x7F7F7F7F; asm volatile("" : "+v"(fp8_unit_scale));
    const char* cA = (const char*)g.A + (size_t)cur.pm * tstep; const char* cB = (const char*)g.Bt + (size_t)cur.pn * tstep;
    S.a_ready(cur);
    PG8_STAGE(PG8_SB(0, 0), cB, voffB); PG8_STAGE(PG8_SA(0, 0), cA, voffA); PG8_STAGE(PG8_SB(0, 1), cB + hstep, voffB); PG8_STAGE(PG8_SA(0, 1), cA + hstep, voffA);
    if (wr == 1) PG8_BAR;
    PG8_WAIT_V(4); PG8_BAR;
    PG8_STAGE(PG8_SB(1, 0), cB + kstep, voffB); PG8_STAGE(PG8_SA(1, 0), cA + kstep, voffA); PG8_STAGE(PG8_SB(1, 1), cB + hstep + kstep, voffB);
    PG8_WAIT_V(6); PG8_BAR;
    for (;;) {
        const bool has_next = S.next(ui + 1, nxt);
        const char* nA = has_next ? (const char*)g.A + (size_t)nxt.pm * tstep : cA; const char* nB = has_next ? (const char*)g.Bt + (size_t)nxt.pn * tstep : cB;
        for (int t = 0; t < nt; t += 2) {
            const bool last = (t == nt - 2);
            const char* a1 = cA + (size_t)(t + 1) * kstep;
            const char* a2 = last ? nA : cA + (size_t)(t + 2) * kstep; const char* b2 = last ? nB : cB + (size_t)(t + 2) * kstep;
            const char* a3 = a2 + kstep; const char* b3 = b2 + kstep;
            if (last && has_next) S.a_ready(nxt);
            if constexpr (Epi::SEG) { if (t == 4 || t == 6) { int tz = tid; asm volatile("" : "+v"(tz)); const int wz = __builtin_amdgcn_readfirstlane(tz >> 6), lz = tz & 63; E.mid(acc, cur, t == 4 ? 0 : 1, wz >> 2, wz & 3, lz & 15, lz >> 4); } }
            PG8_LDB(B0, 0, 0); PG8_SCHED; PG8_LDA(At, 0, 0); PG8_STAGE(PG8_SA(1, 1), a1 + hstep, voffA);
            PG8_WAIT_L(8); PG8_BAR; PG8_WAIT_L(0); PG8_MMA(0, 0, At, B0); PG8_BAR; PG8_SCHED;
            PG8_LDB(B1, 0, 1); PG8_STAGE(PG8_SB(0, 0), b2, voffB);
            PG8_BAR; PG8_WAIT_L(0); PG8_MMA(0, 1, At, B1); PG8_BAR;
            PG8_LDA(At, 0, 1); PG8_STAGE(PG8_SA(0, 0), a2, voffA);
            PG8_BAR; PG8_WAIT_L(0); PG8_MMA(1, 0, At, B0); PG8_BAR; PG8_SCHED;
            PG8_STAGE(PG8_SB(0, 1), b2 + hstep, voffB);
            PG8_WAIT_V(6); PG8_BAR; PG8_MMA(1, 1, At, B1); PG8_BAR;
            PG8_LDB(B0, 1, 0); PG8_SCHED; PG8_LDA(At, 1, 0); PG8_STAGE(PG8_SA(0, 1), a2 + hstep, voffA);
            PG8_WAIT_L(8); PG8_BAR; PG8_WAIT_L(0); PG8_MMA(0, 0, At, B0); PG8_BAR; PG8_SCHED;
            PG8_LDB(B1, 1, 1); PG8_STAGE(PG8_SB(1, 0), b3, voffB);
            PG8_BAR; PG8_WAIT_L(0); PG8_MMA(0, 1, At, B1); PG8_BAR;
            PG8_LDA(At, 1, 1); PG8_STAGE(PG8_SA(1, 0), a3, voffA);
            PG8_BAR; PG8_WAIT_L(0); PG8_MMA(1, 0, At, B0); PG8_BAR; PG8_SCHED;
            PG8_STAGE(PG8_SB(1, 1), b3 + hstep, voffB);
            PG8_WAIT_V(6); PG8_BAR; PG8_MMA(1, 1, At, B1); PG8_BAR;
        }
        if constexpr (Epi::FP8) asm volatile("s_nop 15\n\ts_nop 15\n\ts_nop 15" ::: "memory");
        { int tz = tid; asm volatile("" : "+v"(tz)); const int wz = __builtin_amdgcn_readfirstlane(tz >> 6), lz = tz & 63;
          E(acc, cur, wz >> 2, wz & 3, lz & 15, lz >> 4); } S.done(cur);
        if (!has_next) break;
#pragma unroll
        for (int a = 0; a < 2; ++a)
#pragma unroll
            for (int b = 0; b < 2; ++b)
#pragma unroll
                for (int m = 0; m < 4; ++m)
#pragma unroll
                    for (int n = 0; n < 2; ++n) acc[a][b][m][n] = (f32x4){0.f, 0.f, 0.f, 0.f};
        cur = nxt; cA = nA; cB = nB; ++ui;
    }
    PG8_WAIT_V(0);
    if (wr == 0) PG8_BAR;
    PG8_BAR;
#undef PG8_SA
#undef PG8_SB
#undef PG8_STAGE
#undef PG8_LDA
#undef PG8_LD8
#undef PG8_LDB
#undef PG8_MMA
#undef PG8_WAIT_V
#undef PG8_WAIT_L
#undef PG8_BAR
#undef PG8_SCHED
}

struct EpiInProj {
    static constexpr bool PERM = true, SEG = false, FP8 = false;
    bf16_t* O; float* BA;
    __device__ __forceinline__ void operator()(const f32x4 (&acc)[2][2][4][2], const Unit& u, int wr, int wc, int fr, int fq) const {
        const int row0 = u.pm * BM + wr * 64 + fr, col0 = 3072 + u.pn * BM + wc * 32 + 8 * fq;
        const bool sig = false, ba = (u.pn == 13) && (wc == 0) && (fq < 3);
#pragma unroll
        for (int ai = 0; ai < 2; ++ai)
#pragma unroll
            for (int m = 0; m < 4; ++m) { const int row = row0 + ai * HALF + m * 16; bf16_t* rowp = O + (size_t)row * NPROJ + col0;
#pragma unroll
                for (int bj = 0; bj < 2; ++bj) { f32x4 v0 = acc[ai][bj][m][0], v1 = acc[ai][bj][m][1];
                    if (sig) {
#pragma unroll
                        for (int j = 0; j < 4; ++j) { v0[j] = sigmoidf_(v0[j]); v1[j] = sigmoidf_(v1[j]); } }
                    u32x4 w; w.x = pk2(v0[0], v0[1]); w.y = pk2(v0[2], v0[3]); w.z = pk2(v1[0], v1[1]); w.w = pk2(v1[2], v1[3]);
                    *(u32x4*)(rowp + bj * HALF) = w;
                    if (bj == 1 && ba) { float* bp = BA + (size_t)row * 32 + 8 * fq; *(f32x4*)bp = v0; *(f32x4*)(bp + 4) = v1; } } }
    }
};
struct EpiGates {
    static constexpr bool PERM = true, SEG = false, FP8 = true;
    bf16_t* O;
    __device__ __forceinline__ void operator()(const f32x4 (&acc)[2][2][4][2], const Unit& u, int wr, int wc, int fr, int fq) const {
        const int row0 = u.pm * BM + wr * 64 + fr, col0 = u.pn * BM + wc * 32 + 8 * fq;
#pragma unroll
        for (int ai = 0; ai < 2; ++ai)
#pragma unroll
            for (int m = 0; m < 4; ++m) { int rowi = row0 + ai * HALF + m * 16; asm volatile("" : "+v"(rowi)); bf16_t* rowp = O + (size_t)rowi * NPROJ + col0;
#pragma unroll
                for (int bj = 0; bj < 2; ++bj) { f32x4 v0 = acc[ai][bj][m][0] * 0.03125f, v1 = acc[ai][bj][m][1] * 0.03125f;
#pragma unroll
                    for (int j = 0; j < 4; ++j) { v0[j] = sigmoidf_(v0[j]); v1[j] = sigmoidf_(v1[j]); }
                    u32x4 w; w.x = pk2(v0[0], v0[1]); w.y = pk2(v0[2], v0[3]); w.z = pk2(v1[0], v1[1]); w.w = pk2(v1[2], v1[3]);
                    *(u32x4*)(rowp + bj * HALF) = w; }
                asm volatile("" ::: "memory"); }
    }
};
struct EpiGateCat {
    static constexpr bool PERM = false, SEG = true, FP8 = false;
    const bf16_t* PROJ; bf16_t* MB;
    __device__ __forceinline__ void mid(f32x4 (&acc)[2][2][4][2], const Unit& u, int seg, int wr, int wc, int fr, int fq) const {
        const int row0 = u.pm * BM + wr * 64 + fr, col0 = u.pn * BM + wc * 32 + 4 * fq;
#pragma unroll
        for (int ai = 0; ai < 2; ++ai) {
            int rowb = row0 + ai * HALF; asm volatile("" : "+v"(rowb)); const bf16_t* gp0 = PROJ + (size_t)rowb * NPROJ + C_GATE + seg * 1024 + col0;
            u32x2 ga[4][2][2], gb[4][2][2];
#pragma unroll
            for (int m = 0; m < 4; ++m)
#pragma unroll
                for (int bj = 0; bj < 2; ++bj)
#pragma unroll
                    for (int n = 0; n < 2; ++n) { const bf16_t* gp = gp0 + (size_t)(m * 16) * NPROJ + bj * HALF + n * 16; ga[m][bj][n] = *(const u32x2*)gp; gb[m][bj][n] = *(const u32x2*)(gp + 1024); }
#pragma unroll
            for (int m = 0; m < 4; ++m)
#pragma unroll
                for (int bj = 0; bj < 2; ++bj)
#pragma unroll
                    for (int n = 0; n < 2; ++n) { const u32x2 a_ = ga[m][bj][n], b_ = gb[m][bj][n];
                        f32x4& v = acc[ai][bj][m][n]; v[0] *= bflo(a_.x) * frcp(bflo(b_.x)); v[1] *= bfhi(a_.x) * frcp(bfhi(b_.x)); v[2] *= bflo(a_.y) * frcp(bflo(b_.y)); v[3] *= bfhi(a_.y) * frcp(bfhi(b_.y)); }
            asm volatile("" ::: "memory"); }
    }
    __device__ __forceinline__ void operator()(const f32x4 (&acc)[2][2][4][2], const Unit& u, int wr, int wc, int fr, int fq) const {
        const int row0 = u.pm * BM + wr * 64 + fr, col0 = u.pn * BM + wc * 32 + 4 * fq;
#pragma unroll
        for (int ai = 0; ai < 2; ++ai) {
            int rowb = row0 + ai * HALF; asm volatile("" : "+v"(rowb)); const bf16_t* gp0 = PROJ + (size_t)rowb * NPROJ + C_GATE + 2 * 1024 + col0; bf16_t* mp0 = MB + (size_t)rowb * D + col0;
            u32x2 gw[4][2][2];
#pragma unroll
            for (int m = 0; m < 4; ++m)
#pragma unroll
                for (int bj = 0; bj < 2; ++bj)
#pragma unroll
                    for (int n = 0; n < 2; ++n) gw[m][bj][n] = *(const u32x2*)(gp0 + (size_t)(m * 16) * NPROJ + bj * HALF + n * 16);
#pragma unroll
            for (int m = 0; m < 4; ++m)
#pragma unroll
                for (int bj = 0; bj < 2; ++bj)
#pragma unroll
                    for (int n = 0; n < 2; ++n) { const u32x2 g_ = gw[m][bj][n]; const f32x4 v = acc[ai][bj][m][n];
                        u32x2 w; w.x = pk2(v[0] * bflo(g_.x), v[1] * bfhi(g_.x)); w.y = pk2(v[2] * bflo(g_.y), v[3] * bfhi(g_.y)); *(u32x2*)(mp0 + (size_t)(m * 16) * D + bj * HALF + n * 16) = w; }
            asm volatile("" ::: "memory"); }
    }
};
struct EpiRes {
    static constexpr bool PERM = true, SEG = false, FP8 = false;
    const bf16_t* XR; bf16_t* H;
    __device__ __forceinline__ void operator()(const f32x4 (&acc)[2][2][4][2], const Unit& u, int wr, int wc, int fr, int fq) const {
        const int row0 = u.pm * BM + wr * 64 + fr, col0 = u.pn * BM + wc * 32 + 8 * fq;
#pragma unroll
        for (int ai = 0; ai < 2; ++ai) {
            int rowb = row0 + ai * HALF; asm volatile("" : "+v"(rowb)); const size_t off0 = (size_t)rowb * D + col0;
            u32x4 xr[4][2];
#pragma unroll
            for (int m = 0; m < 4; ++m)
#pragma unroll
                for (int bj = 0; bj < 2; ++bj) xr[m][bj] = *(const u32x4*)(XR + off0 + (size_t)(m * 16) * D + bj * HALF);
#pragma unroll
            for (int m = 0; m < 4; ++m)
#pragma unroll
                for (int bj = 0; bj < 2; ++bj) { const u32x4 x = xr[m][bj]; const f32x4 v0 = acc[ai][bj][m][0], v1 = acc[ai][bj][m][1]; u32x4 w;
                    w.x = pk2(bflo(x.x) * ALPHA + v0[0], bfhi(x.x) * ALPHA + v0[1]); w.y = pk2(bflo(x.y) * ALPHA + v0[2], bfhi(x.y) * ALPHA + v0[3]);
                    w.z = pk2(bflo(x.z) * ALPHA + v1[0], bfhi(x.z) * ALPHA + v1[1]); w.w = pk2(bflo(x.w) * ALPHA + v1[2], bfhi(x.w) * ALPHA + v1[3]);
                    *(u32x4*)(H + off0 + (size_t)(m * 16) * D + bj * HALF) = w; }
            asm volatile("" ::: "memory"); }
    }
};
struct EpiSwiglu {
    static constexpr bool PERM = true, SEG = false, FP8 = true;
    unsigned char* HID;
    __device__ __forceinline__ void operator()(const f32x4 (&acc)[2][2][4][2], const Unit& u, int wr, int wc, int fr, int fq) const {
        const int row0 = u.pm * BM + wr * 64 + fr, col0 = (u.pn & 15) * 128 + wc * 32 + 8 * fq;
#pragma unroll
        for (int ai = 0; ai < 2; ++ai)
#pragma unroll
            for (int m = 0; m < 4; ++m) { const f32x4 g0 = acc[ai][0][m][0] * 0.03125f, g1 = acc[ai][0][m][1] * 0.03125f, u0 = acc[ai][1][m][0] * 0.03125f, u1 = acc[ai][1][m][1] * 0.03125f;
                f32x4 h0, h1;
#pragma unroll
                for (int j = 0; j < 4; ++j) { h0[j] = siluf_(g0[j]) * u0[j]; h1[j] = siluf_(g1[j]) * u1[j]; }
                u32x2 w; w.x = pk4_fp8(h0[0], h0[1], h0[2], h0[3]); w.y = pk4_fp8(h1[0], h1[1], h1[2], h1[3]);
                int rowi = row0 + ai * HALF + m * 16; asm volatile("" : "+v"(rowi));
                *(u32x2*)(HID + (size_t)rowi * DE + col0) = w; asm volatile("" ::: "memory"); }
    }
};
struct EpiDown {
    static constexpr bool PERM = true, SEG = false, FP8 = true;
    bf16_t* Y; const float* GV;
    __device__ __forceinline__ void operator()(const f32x4 (&acc)[2][2][4][2], const Unit& u, int wr, int wc, int fr, int fq) const {
        const int row0 = u.pm * BM + wr * 64 + fr, col0 = (u.pn & 3) * BM + wc * 32 + 8 * fq;
        float gvs[2][4];
#pragma unroll
        for (int ai = 0; ai < 2; ++ai)
#pragma unroll
            for (int m = 0; m < 4; ++m) gvs[ai][m] = GV[row0 + ai * HALF + m * 16];
#pragma unroll
        for (int ai = 0; ai < 2; ++ai)
#pragma unroll
            for (int m = 0; m < 4; ++m) { int row = row0 + ai * HALF + m * 16; asm volatile("" : "+v"(row)); const float gv = gvs[ai][m] * 0.03125f;
#pragma unroll
                for (int bj = 0; bj < 2; ++bj) { const f32x4 v0 = acc[ai][bj][m][0] * gv, v1 = acc[ai][bj][m][1] * gv;
                    u32x4 w; w.x = pk2(v0[0], v0[1]); w.y = pk2(v0[2], v0[3]); w.z = pk2(v1[0], v1[1]); w.w = pk2(v1[2], v1[3]);
                    *(u32x4*)(Y + (size_t)row * D + col0 + bj * HALF) = w; } }
    }
};
}

#define XB_TMO      128
#define XB_XCNT(j)  (256  + 64 * (j))
#define XB_XSUB(j)  (1280 + 64 * (j))
#define XB_XGEN(j)  (2304 + 64 * (j))
#define XB_TOP      3328
#define XB_TOPGEN   3392
#define XCD_BAR_WORDS 3456
#define XB_SPIN_CAP (1u << 22)
__device__ __forceinline__ unsigned xb_ld(unsigned* p)              { return __hip_atomic_load(p, __ATOMIC_RELAXED, __HIP_MEMORY_SCOPE_AGENT); }
__device__ __forceinline__ unsigned xb_add(unsigned* p, unsigned v) { return __hip_atomic_fetch_add(p, v, __ATOMIC_RELAXED, __HIP_MEMORY_SCOPE_AGENT); }
__device__ __forceinline__ unsigned xb_xcc_id() { return (unsigned)__builtin_amdgcn_s_getreg((3 << 11) | 20) & 0xFu; }
#define XB_SPIN(cond, bar) do { unsigned _sp = 0; while (cond) { __builtin_amdgcn_s_sleep(1); \
    if ((++_sp & 255u) == 0u) { if (xb_ld(&(bar)[XB_TMO])) break; if (_sp > XB_SPIN_CAP) { atomicAdd(&(bar)[XB_TMO], 1u); break; } } } } while (0)
struct XcdBarrier { unsigned* bar; unsigned x; volatile LAS unsigned* st; };
__device__ __forceinline__ XcdBarrier xcd_barrier_post(unsigned* bar, volatile LAS unsigned* st) {
    XcdBarrier b; b.bar = bar; b.x = xb_xcc_id(); b.st = st;
    if (threadIdx.x == 0) (void)xb_add(&bar[XB_XCNT(b.x)], 1u);
    return b;
}
__device__ __forceinline__ void xcd_barrier_complete(unsigned* bar, unsigned x, unsigned& nloc, unsigned& nx) {
    const unsigned G = gridDim.x * gridDim.y * gridDim.z;
    unsigned sum, cnt, mine, sp = 0u;
    for (;;) {
        sum = 0u; cnt = 0u; mine = 0u;
#pragma unroll
        for (unsigned j = 0; j < 16; ++j) { const unsigned c = xb_ld(&bar[XB_XCNT(j)]); sum += c; cnt += (c > 0u) ? 1u : 0u; }
        mine = xb_ld(&bar[XB_XCNT(x)]);
        if (sum == G) break;
        __builtin_amdgcn_s_sleep(1);
        if ((++sp & 255u) == 0u) { if (xb_ld(&bar[XB_TMO])) break; if (sp > XB_SPIN_CAP) { atomicAdd(&bar[XB_TMO], 1u); break; } }
    }
    nloc = mine > 0u ? mine : 1u; nx = cnt > 0u ? cnt : 1u;
}
__device__ __forceinline__ void xcd_barrier(const XcdBarrier& b) {
    asm volatile("s_waitcnt vmcnt(0)" ::: "memory");
    __syncthreads();
    if (threadIdx.x == 0) {
        unsigned* bar = b.bar; asm volatile("" : "+s"(bar));
        __builtin_amdgcn_s_waitcnt(0);
        unsigned nloc = b.st[0], nx = b.st[1];
        if (nloc == 0u) { xcd_barrier_complete(bar, b.x, nloc, nx); b.st[0] = nloc; b.st[1] = nx; }
        const unsigned old = xb_add(&bar[XB_XSUB(b.x)], 1u);
        const unsigned gen = old / nloc;
        if (old + 1u == (gen + 1u) * nloc) {
            __builtin_amdgcn_fence(__ATOMIC_RELEASE, "agent");
            asm volatile("s_waitcnt vmcnt(0)" ::: "memory");
            const unsigned og = xb_add(&bar[XB_TOP], 1u);
            const unsigned tg = og / nx;
            if (og + 1u == (tg + 1u) * nx) xb_add(&bar[XB_TOPGEN], 1u);
            else XB_SPIN(xb_ld(&bar[XB_TOPGEN]) == tg, bar);
            __builtin_amdgcn_fence(__ATOMIC_ACQUIRE, "agent");
            xb_add(&bar[XB_XGEN(b.x)], 1u);
            asm volatile("s_waitcnt vmcnt(0)" ::: "memory");
        } else {
            XB_SPIN(xb_ld(&bar[XB_XGEN(b.x)]) == gen, bar);
            __builtin_amdgcn_fence(__ATOMIC_ACQUIRE, "agent");
            asm volatile("s_waitcnt vmcnt(0)" ::: "memory");
        }
    }
    __syncthreads();
}

struct Args { const float* in[20]; float* out; unsigned char* ws; int ph_lo, ph_hi; };
typedef const __attribute__((address_space(4))) Args* KArgs;
DI KArgs kargs() { KArgs p = (KArgs)__builtin_amdgcn_kernarg_segment_ptr(); asm volatile("" : "+s"(p)); return p; }
struct Ctx {
    float* out; unsigned char* ws;
    int tid, lane, wave, G, bid;
    int layer, slab;
    int nseq, seqlen;
    int stok, sbase;
    int dry;
};
#define WSP(T, off) ((T*)(c.ws + (off)))
#define BIGP(T, off) ((T*)(c.ws + WS_BIG + (off)))

__device__ const float INV_FREQ[32] = {1.000000000e+00f, 7.498942018e-01f, 5.623413324e-01f, 4.216965139e-01f, 3.162277639e-01f, 2.371373773e-01f, 1.778279394e-01f, 1.333521456e-01f, 1.000000015e-01f, 7.498942316e-02f, 5.623413250e-02f, 4.216964915e-02f, 3.162277490e-02f, 2.371373773e-02f, 1.778279431e-02f, 1.333521400e-02f, 9.999999776e-03f, 7.498942316e-03f, 5.623413250e-03f, 4.216964822e-03f, 3.162277630e-03f, 2.371373819e-03f, 1.778279431e-03f, 1.333521446e-03f, 1.000000047e-03f, 7.498941850e-04f, 5.623413017e-04f, 4.216965172e-04f, 3.162277571e-04f, 2.371373703e-04f, 1.778279402e-04f, 1.333521504e-04f};
DI void tr_item(const float* src, long src_ld, int src_col0, int nvalid, int kvalid, bf16_t* dst, long dst_ld, int dst_row0, int k0, LAS float* scr, int lane) {
    float tv[32];
#pragma unroll
    for (int i = 0; i < 32; ++i) { const int kk = 2 * i + (lane >> 5), cc = lane & 31;
        tv[i] = 0.f; if ((k0 + kk) < kvalid && cc < nvalid) tv[i] = src[(size_t)(k0 + kk) * src_ld + src_col0 + cc]; }
#pragma unroll
    for (int i = 0; i < 32; ++i) { const int kk = 2 * i + (lane >> 5), cc = lane & 31; scr[kk * 33 + cc] = tv[i]; }
    asm volatile("s_waitcnt lgkmcnt(0)" ::: "memory");
    const int c8 = lane & 7;
#pragma unroll
    for (int j = 0; j < 4; ++j) { const int n = (lane >> 3) + 8 * j; const LAS float* s = scr + (8 * c8) * 33 + n;
        u32x4 o; o.x = pk2(s[0 * 33], s[1 * 33]); o.y = pk2(s[2 * 33], s[3 * 33]); o.z = pk2(s[4 * 33], s[5 * 33]); o.w = pk2(s[6 * 33], s[7 * 33]);
        *(u32x4*)(dst + (size_t)(dst_row0 + n) * dst_ld + k0 + 8 * c8) = o; }
    asm volatile("s_waitcnt lgkmcnt(0)" ::: "memory");
}
DI void tr_item8(const float* src, long src_ld, int src_col0, int kvalid, unsigned char* dst, long dst_ld, int dst_row0, int k0, float scale, LAS float* scr, int lane) {
    float tv[32];
#pragma unroll
    for (int i = 0; i < 32; ++i) { const int kk = 2 * i + (lane >> 5), cc = lane & 31; tv[i] = 0.f; if ((k0 + kk) < kvalid) tv[i] = src[(size_t)(k0 + kk) * src_ld + src_col0 + cc]; }
#pragma unroll
    for (int i = 0; i < 32; ++i) { const int kk = 2 * i + (lane >> 5), cc = lane & 31; scr[kk * 33 + cc] = tv[i]; }
    asm volatile("s_waitcnt lgkmcnt(0)" ::: "memory");
    const int c8 = lane & 7;
#pragma unroll
    for (int j = 0; j < 4; ++j) { const int n = (lane >> 3) + 8 * j; const LAS float* s = scr + (8 * c8) * 33 + n;
        u32x2 o; o.x = pk4_fp8(s[0 * 33] * scale, s[1 * 33] * scale, s[2 * 33] * scale, s[3 * 33] * scale); o.y = pk4_fp8(s[4 * 33] * scale, s[5 * 33] * scale, s[6 * 33] * scale, s[7 * 33] * scale);
        *(u32x2*)(dst + (size_t)(dst_row0 + n) * dst_ld + k0 + 8 * c8) = o; }
    asm volatile("s_waitcnt lgkmcnt(0)" ::: "memory");
}
DI void phase_weights(KArgs args, LAS unsigned char* lds, const Ctx& c) {
    const int l = c.layer, lane = c.lane;
    LAS float* scr = (LAS float*)(lds + c.wave * 8448);
    const int gw = c.bid * 8 + c.wave, NGW = c.G * 8;
    constexpr int I_IN = 16 * 112 + 16 * 96, I_NA = 4 * 32, I_DIL = 2 * 32, I_GDN = 6 * 32, I_OUT = 16 * 32, I_GU1 = 16 * 128, I_D1 = 32 * 32;
    constexpr int NITEMS = I_IN + I_NA + I_DIL + I_GDN + I_OUT + 16 * I_GU1 + 16 * I_D1;
    for (int it = gw; it < NITEMS; it += NGW) {
        int r = it;
        const float* src; long sld; int sc0, nv = 32, kv; bf16_t* dst; long dld; int dr0, k0;
        if (r < 16 * 112) { const int kb = r / 112, nb = r % 112, n0 = 32 * nb; src = args->in[2] + (size_t)l * D * DIN; sld = DIN; kv = D;
            sc0 = n0; nv = 3480 - n0; if (nv < 0) { nv = 0; sc0 = 0; } if (nv > 32) nv = 32;
            dst = WSP(bf16_t, WS_WIN); dld = D; dr0 = n0; k0 = 64 * kb; }
        else if (r < I_IN) { const int q = r - 16 * 112, kb = q / 96, nb = q % 96;
            tr_item8(args->in[2] + (size_t)l * D * DIN, DIN, 3480 + 32 * nb, D, WSP(unsigned char, WS_WG8), D, 32 * nb, 64 * kb, 32.0f, scr, lane); continue; }
        else if ((r -= I_IN) < I_NA) { const int kb = r / 32, nb = r % 32; src = args->in[8] + (size_t)l * 256 * D; sld = D; sc0 = 32 * nb; kv = 256; dst = WSP(bf16_t, WS_WBR); dld = 768; dr0 = 32 * nb; k0 = 64 * kb; }
        else if ((r -= I_NA) < I_DIL) { const int kb = r / 32, nb = r % 32; src = args->in[9] + (size_t)l * 128 * D; sld = D; sc0 = 32 * nb; kv = 128; dst = WSP(bf16_t, WS_WBR) + 256; dld = 768; dr0 = 32 * nb; k0 = 64 * kb; }
        else if ((r -= I_DIL) < I_GDN) { const int kb = r / 32, nb = r % 32; src = args->in[10] + (size_t)l * 384 * D; sld = D; sc0 = 32 * nb; kv = 384; dst = WSP(bf16_t, WS_WBR) + 384; dld = 768; dr0 = 32 * nb; k0 = 64 * kb; }
        else if ((r -= I_GDN) < I_OUT) { const int kb = r / 32, nb = r % 32; src = args->in[11] + (size_t)l * D * D; sld = D; sc0 = 32 * nb; kv = D; dst = WSP(bf16_t, WS_WOUT); dld = D; dr0 = 32 * nb; k0 = 64 * kb; }
        else if ((r -= I_OUT) < 16 * I_GU1) { const int e = r / I_GU1, q = r % I_GU1, kb = q / 128, nb = q % 128, n0 = 32 * nb, j = n0 >> 8, rr = n0 & 255;
            tr_item8((rr < 128 ? args->in[16] : args->in[15]) + ((size_t)l * NE + e) * D * DE, DE, 128 * j + (rr & 127), D, WSP(unsigned char, WS_WGU) + (size_t)e * 4096 * D, D, n0, 64 * kb, 32.0f, scr, lane); continue; }
        else { r -= 16 * I_GU1; const int e = r / I_D1, q = r % I_D1, kb = q / 32, nb = q % 32;
            tr_item8(args->in[17] + ((size_t)l * NE + e) * DE * D, D, 32 * nb, DE, WSP(unsigned char, WS_WD) + (size_t)e * D * DE, DE, 32 * nb, 64 * kb, 32.0f, scr, lane); continue; }
        tr_item(src, sld, sc0, nv, kv, dst, dld, dr0, k0, scr, lane);
    }
    if (l == 0) {
        for (int t = gw; t < T_ALL; t += NGW) {
            const float* xr = (t < T_P) ? args->in[0] + (size_t)t * D : args->in[1] + (size_t)(t - T_P) * D;
            bf16_t* o = WSP(bf16_t, WS_XB) + (size_t)t * D;
#pragma unroll
            for (int j = 0; j < 4; ++j) { const f32x4 v = *(const f32x4*)(xr + 4 * lane + 256 * j); u32x2 w; w.x = pk2(v[0], v[1]); w.y = pk2(v[2], v[3]); *(u32x2*)(o + 4 * lane + 256 * j) = w;
                *(unsigned*)(WSP(unsigned char, WS_XB8) + (size_t)t * D + 4 * lane + 256 * j) = pk4_fp8(v[0], v[1], v[2], v[3]); }
        }
        float* cs = WSP(float, WS_CS);
        for (int i = c.bid * 512 + c.tid; i < 16384 * 32; i += c.G * 512) { const int pos = i >> 5, k = i & 31;
            const float inv = INV_FREQ[k];
            const float ang = (float)pos * inv;
            cs[pos * 64 + k] = cosf(ang); cs[pos * 64 + 32 + k] = sinf(ang); }
    }
}

constexpr int TLD = 72, TILEB = 64 * TLD * 2;
DI int tsw(int row) { return ((row >> 4) & 3) << 3; }
template <bool SA = false, bool SB = false> DI f32x16 mm_tile(const LAS bf16_t* A, const LAS bf16_t* Bt, int m0, int n0, int lane) {
    f32x16 acc = zero16(); const int r = lane & 31, hh = lane >> 5; const int sa = SA ? tsw(m0 + r) : 0, sb = SB ? tsw(n0 + r) : 0;
#pragma unroll
    for (int ks = 0; ks < 4; ++ks) { const bf16x8 a = *(const LAS bf16x8*)(A + (m0 + r) * TLD + ((16 * ks + 8 * hh) ^ sa)); const bf16x8 b = *(const LAS bf16x8*)(Bt + (n0 + r) * TLD + ((16 * ks + 8 * hh) ^ sb)); acc = MFMA32(a, b, acc); }
    return acc;
}

constexpr int PI_P0 = 0, PI_P1 = 9216, PI_INTRA = 18432, PI_AM = 27648, PI_TT = 45056, PI_TD0 = 54272, PI_TD1 = 60416, PI_PM = 65024, PI_VEC = 71168, PI_BYTES = 72704;
constexpr int PI_WT = PI_AM, PI_UT = PI_TD0;
DI void gdn_prep_pair(KArgs args, LAS unsigned char* L0, const Ctx& c, int pu) {
    int tid = c.tid; asm volatile("" : "+v"(tid)); const int lane = tid & 63, wave = __builtin_amdgcn_readfirstlane(tid >> 6), l = c.layer;
    const int dir = wave >> 2, wg = wave & 3, tg = tid & 255, head = pu % 6, gch = pu / 6, inst = (gch * 6 + head) * 2 + dir;
    const int cps = c.seqlen >> 6, seq = gch / cps, n = gch % cps;
    const bf16_t* PROJ = BIGP(bf16_t, B_PROJ); const float* BA = BIGP(float, B_BA);
    unsigned char* G = BIGP(unsigned char, B_GSCR) + (size_t)inst * GSTRIDE;
    LAS unsigned char* L = L0 + dir * PI_BYTES;
    LAS bf16_t* P0 = (LAS bf16_t*)(L + PI_P0); LAS bf16_t* P1 = (LAS bf16_t*)(L + PI_P1); LAS bf16_t* INTRA = (LAS bf16_t*)(L + PI_INTRA);
    LAS float* AM = (LAS float*)(L + PI_AM); LAS bf16_t* TT = (LAS bf16_t*)(L + PI_TT);
    LAS float* TD0 = (LAS float*)(L + PI_TD0); LAS float* TD1 = (LAS float*)(L + PI_TD1); LAS float* PM = (LAS float*)(L + PI_PM);
    LAS float* GV = (LAS float*)(L + PI_VEC); LAS float* BV = GV + 64; LAS float* GC = GV + 128;
    LAS bf16_t* WT = (LAS bf16_t*)(L + PI_WT); LAS bf16_t* UT = (LAS bf16_t*)(L + PI_UT);
    const int ia = tg >> 3, p = tg & 7;
    LAS float* XQ = (LAS float*)(L0 + PI_AM);
    LAS float* XK = (LAS float*)(L0 + PI_TT);
    LAS float* XV = (LAS float*)(L0 + PI_BYTES + PI_AM);
    {   float q1[8], k1[8], v1[8];
#pragma unroll
        for (int j = 0; j < 8; ++j) { q1[j] = 0.f; k1[j] = 0.f; v1[j] = 0.f; }
        const float* cw = args->in[4] + (size_t)l * 5 * 1152 + 64 * head + 8 * p;
        const int tr = ia + 32 * dir;
        u32x4 rqa[5], rka[5], rva[5];
#pragma unroll
        for (int tp = 0; tp < 5; ++tp) { const int pp = n * 64 + tr + tp - 2, ppc = pp < 0 ? 0 : (pp >= c.seqlen ? c.seqlen - 1 : pp);
            const bf16_t* rp = PROJ + (size_t)(seq * c.seqlen + ppc) * NPROJ + 64 * head + 8 * p;
            rqa[tp] = *(const u32x4*)(rp + C_QC); rka[tp] = *(const u32x4*)(rp + C_KC); rva[tp] = *(const u32x4*)(rp + C_VC); }
#pragma unroll
        for (int tp = 0; tp < 5; ++tp) { const float* w = cw + tp * 1152;
            const f32x4 wq0 = *(const f32x4*)w, wq1 = *(const f32x4*)(w + 4), wk0 = *(const f32x4*)(w + 384), wk1 = *(const f32x4*)(w + 388), wv0 = *(const f32x4*)(w + 768), wv1 = *(const f32x4*)(w + 772);
            const int pp = n * 64 + tr + tp - 2; const bool inr = (pp >= 0 && pp < c.seqlen);
            { u32x4 rq = rqa[tp], rk = rka[tp], rv = rva[tp];
                if (!inr) { rq = (u32x4){0u, 0u, 0u, 0u}; rk = rq; rv = rq; }
#pragma unroll
                for (int j = 0; j < 4; ++j) { const float a0 = (j < 2) ? wq0[2 * j] : wq1[2 * j - 4], a1 = (j < 2) ? wq0[2 * j + 1] : wq1[2 * j - 3];
                    const float b0 = (j < 2) ? wk0[2 * j] : wk1[2 * j - 4], b1 = (j < 2) ? wk0[2 * j + 1] : wk1[2 * j - 3];
                    const float c0 = (j < 2) ? wv0[2 * j] : wv1[2 * j - 4], c1 = (j < 2) ? wv0[2 * j + 1] : wv1[2 * j - 3];
                    q1[2 * j] += a0 * bflo(rq[j]); q1[2 * j + 1] += a1 * bfhi(rq[j]);
                    k1[2 * j] += b0 * bflo(rk[j]); k1[2 * j + 1] += b1 * bfhi(rk[j]);
                    v1[2 * j] += c0 * bflo(rv[j]); v1[2 * j + 1] += c1 * bfhi(rv[j]); } } }
        float sq = 0.f, sk = 0.f;
#pragma unroll
        for (int j = 0; j < 8; ++j) { q1[j] = siluf_(q1[j]); k1[j] = siluf_(k1[j]); v1[j] = siluf_(v1[j]); sq += q1[j] * q1[j]; sk += k1[j] * k1[j]; }
        sq += __shfl_xor(sq, 1); sq += __shfl_xor(sq, 2); sq += __shfl_xor(sq, 4);
        sk += __shfl_xor(sk, 1); sk += __shfl_xor(sk, 2); sk += __shfl_xor(sk, 4);
        const float rq_ = 0.125f * frsq(sq + NORM_EPS), rk_ = frsq(sk + NORM_EPS);
        f32x4 o0, o1;
        o0[0] = q1[0] * rq_; o0[1] = q1[1] * rq_; o0[2] = q1[2] * rq_; o0[3] = q1[3] * rq_; o1[0] = q1[4] * rq_; o1[1] = q1[5] * rq_; o1[2] = q1[6] * rq_; o1[3] = q1[7] * rq_;
        *(LAS f32x4*)(XQ + tr * 64 + 8 * p) = o0; *(LAS f32x4*)(XQ + tr * 64 + 8 * p + 4) = o1;
        o0[0] = k1[0] * rk_; o0[1] = k1[1] * rk_; o0[2] = k1[2] * rk_; o0[3] = k1[3] * rk_; o1[0] = k1[4] * rk_; o1[1] = k1[5] * rk_; o1[2] = k1[6] * rk_; o1[3] = k1[7] * rk_;
        *(LAS f32x4*)(XK + tr * 64 + 8 * p) = o0; *(LAS f32x4*)(XK + tr * 64 + 8 * p + 4) = o1;
        o0[0] = v1[0]; o0[1] = v1[1]; o0[2] = v1[2]; o0[3] = v1[3]; o1[0] = v1[4]; o1[1] = v1[5]; o1[2] = v1[6]; o1[3] = v1[7];
        *(LAS f32x4*)(XV + tr * 64 + 8 * p) = o0; *(LAS f32x4*)(XV + tr * 64 + 8 * p + 4) = o1; }
#pragma unroll
    for (int h2 = 0; h2 < 2; ++h2) {
        if (p == 0) { const int i = ia + 32 * h2, tokl = dir ? 63 - i : i; const float* bar = BA + (size_t)(seq * c.seqlen + n * 64 + tokl) * 32;
            const float bl = bar[dir * 6 + head], al = bar[12 + dir * 6 + head];
            const float xx = al + args->in[6][l * 12 + dir * 6 + head];
            const float sp = xx > 20.f ? xx : log1pf(expf(xx));
            GV[i] = -expf(args->in[5][l * 12 + dir * 6 + head]) * sp; BV[i] = sigmoidf_(bl); } }
    __syncthreads();
    float q[2][8], k[2][8], v[2][8];
#pragma unroll
    for (int h2 = 0; h2 < 2; ++h2) { const int i = ia + 32 * h2, tokl = dir ? 63 - i : i;
        const f32x4 a0 = *(const LAS f32x4*)(XQ + tokl * 64 + 8 * p), a1 = *(const LAS f32x4*)(XQ + tokl * 64 + 8 * p + 4), b0 = *(const LAS f32x4*)(XK + tokl * 64 + 8 * p), b1 = *(const LAS f32x4*)(XK + tokl * 64 + 8 * p + 4),
                    c0 = *(const LAS f32x4*)(XV + tokl * 64 + 8 * p), c1 = *(const LAS f32x4*)(XV + tokl * 64 + 8 * p + 4);
#pragma unroll
        for (int j = 0; j < 4; ++j) { q[h2][j] = a0[j]; q[h2][4 + j] = a1[j]; k[h2][j] = b0[j]; k[h2][4 + j] = b1[j]; v[h2][j] = c0[j]; v[h2][4 + j] = c1[j]; } }
    float gcl_;
    { float x = GV[lane];
#pragma unroll
        for (int o = 1; o < 64; o <<= 1) { const float y = __shfl_up(x, o); if (lane >= o) x += y; }
        if (wg == 0) GC[lane] = x;
        gcl_ = x; }
    const float gc0 = __shfl(gcl_, ia), gc1 = __shfl(gcl_, ia + 32), gcl = __shfl(gcl_, 63);
#pragma unroll
    for (int h2 = 0; h2 < 2; ++h2) { const int i = ia + 32 * h2; u32x4 wq, wk;
#pragma unroll
        for (int j = 0; j < 4; ++j) { wq[j] = pk2(q[h2][2 * j], q[h2][2 * j + 1]); wk[j] = pk2(k[h2][2 * j], k[h2][2 * j + 1]); }
        *(LAS u32x4*)(P0 + i * TLD + 8 * p) = wq; *(LAS u32x4*)(P1 + i * TLD + 8 * p) = wk; }
    __syncthreads();
    { const int mat = wg >> 1, mt = wg & 1, hh = lane >> 5;
#pragma unroll
        for (int nt = 0; nt < 2; ++nt) { const int jc = 32 * nt + (lane & 31);
            const f32x16 a = mm_tile(mat ? P0 : P1, P1, 32 * mt, 32 * nt, lane);
            const float gj = GC[jc];
#pragma unroll
            for (int r = 0; r < 16; ++r) { const int ii = 32 * mt + crow(r, hh); const float gi = GC[ii];
                if (mat == 0) AM[ii * 68 + jc] = (jc < ii) ? BV[ii] * a[r] * __expf(gi - gj) : 0.f;
                else INTRA[ii * TLD + jc] = (bf16_t)(pk2((jc <= ii) ? a[r] * __expf(gi - gj) : 0.f, 0.f) & 0xffffu); } } }
    __syncthreads();
    if (wg == dir) {
        const int b = lane >> 5, cidx = lane & 31; float t[32];
#pragma unroll
        for (int ii = 0; ii < 32; ++ii) t[ii] = (ii == cidx) ? 1.f : 0.f;
        const LAS float* Ab = AM + (32 * b) * 68 + 32 * b;
#pragma unroll
        for (int ii = 1; ii < 32; ++ii) { float acc = 0.f;
#pragma unroll
            for (int j4 = 0; j4 < ii; j4 += 4) { const f32x4 a4 = *(const LAS f32x4*)(Ab + ii * 68 + j4);
                acc += a4[0] * t[j4]; acc += a4[1] * t[j4 + 1]; acc += a4[2] * t[j4 + 2]; acc += a4[3] * t[j4 + 3]; }
            t[ii] -= acc; }
        LAS float* td = b ? TD1 : TD0; const int tds = b ? 36 : 48;
#pragma unroll
        for (int ii = 0; ii < 32; ++ii) { td[ii * tds + cidx] = t[ii]; TT[(32 * b + ii) * TLD + 32 * b + cidx] = (bf16_t)(pk2(t[ii], 0.f) & 0xffffu); }
    }
#pragma unroll
    for (int h2 = 0; h2 < 2; ++h2) { const int i = ia + 32 * h2; const float be = BV[i], eg = __expf(h2 ? gc1 : gc0);
#pragma unroll
        for (int j = 0; j < 8; ++j) { const int d = 8 * p + j, o_ = d * TLD + (i ^ tsw(d)); P0[o_] = (bf16_t)(pk2(k[h2][j] * be * eg, 0.f) & 0xffffu); P1[o_] = (bf16_t)(pk2(v[h2][j] * be, 0.f) & 0xffffu); } }
    { unsigned zz; asm volatile("v_mov_b32 %0, 0" : "=v"(zz)); u32x2 z; z.x = zz; z.y = zz; *(LAS u32x2*)(TT + (tg >> 3) * TLD + 32 + 4 * (tg & 7)) = z; }
    __syncthreads();
    { const int qi = wg >> 1, qj = wg & 1, r16 = lane & 15, g4 = lane >> 4; f32x4 pc = {0.f, 0.f, 0.f, 0.f};
#pragma unroll
        for (int kk = 0; kk < 8; ++kk) pc = __builtin_amdgcn_mfma_f32_16x16x4f32(AM[(32 + 16 * qi + r16) * 68 + 4 * kk + g4], TD0[(4 * kk + g4) * 48 + 16 * qj + r16], pc, 0, 0, 0);
#pragma unroll
        for (int r = 0; r < 4; ++r) PM[(16 * qi + 4 * g4 + r) * 48 + 16 * qj + r16] = pc[r]; }
    __syncthreads();
    { const int qi = wg >> 1, qj = wg & 1, r16 = lane & 15, g4 = lane >> 4; f32x4 pc = {0.f, 0.f, 0.f, 0.f};
#pragma unroll
        for (int kk = 0; kk < 8; ++kk) pc = __builtin_amdgcn_mfma_f32_16x16x4f32(TD1[(16 * qi + r16) * 36 + 4 * kk + g4], PM[(4 * kk + g4) * 48 + 16 * qj + r16], pc, 0, 0, 0);
#pragma unroll
        for (int r = 0; r < 4; ++r) TT[(32 + 16 * qi + 4 * g4 + r) * TLD + 16 * qj + r16] = (bf16_t)(pk2(-pc[r], 0.f) & 0xffffu); }
    __syncthreads();
    { const int which = wg >> 1, mt = wg & 1, hh = lane >> 5;
#pragma unroll
        for (int nt = 0; nt < 2; ++nt) { const int dc = 32 * nt + (lane & 31);
            const f32x16 a = mm_tile<false, true>(TT, which ? P1 : P0, 32 * mt, 32 * nt, lane);
            LAS bf16_t* dst = (which ? UT : WT) + dc * TLD; const int sw = tsw(dc);
#pragma unroll
            for (int g = 0; g < 4; ++g) { u32x2 w; w.x = pk2(a[4 * g], a[4 * g + 1]); w.y = pk2(a[4 * g + 2], a[4 * g + 3]); *(LAS u32x2*)(dst + ((32 * mt + 8 * g + 4 * hh) ^ sw)) = w; } } }
    __syncthreads();
#pragma unroll
    for (int h2 = 0; h2 < 2; ++h2) { const int i = ia + 32 * h2; const float gci = h2 ? gc1 : gc0, eg = __expf(gci), ekd = __expf(gcl - gci); u32x4 wqd;
#pragma unroll
        for (int j = 0; j < 4; ++j) wqd[j] = pk2(q[h2][2 * j] * eg, q[h2][2 * j + 1] * eg);
        *(LAS u32x4*)(P1 + i * TLD + 8 * p) = wqd;
#pragma unroll
        for (int j = 0; j < 8; ++j) { const int d = 8 * p + j; P0[d * TLD + (i ^ tsw(d))] = (bf16_t)(pk2(k[h2][j] * ekd, 0.f) & 0xffffu); } }
    __syncthreads();
    { const int hh = lane >> 5, rr = lane & 31;
        if (wg == 0) {
#pragma unroll
            for (int t4 = 0; t4 < 4; ++t4) { const int mtb = t4 >> 1, nta = t4 & 1; const f32x16 a = mm_tile<true, true>(WT, P0, 32 * mtb, 32 * nta, lane);
                f32x16 na; for (int r = 0; r < 16; ++r) na[r] = -a[r];
                *(bf16x8*)(G + (size_t)((nta * 4 + 2 * mtb) * 64 + lane) * 16) = pack8<0>(na); *(bf16x8*)(G + (size_t)((nta * 4 + 2 * mtb + 1) * 64 + lane) * 16) = pack8<1>(na); }
        } else if (wg == 1) {
#pragma unroll
            for (int t4 = 0; t4 < 4; ++t4) { const int mta = t4 >> 1, nte = t4 & 1; const f32x16 a = mm_tile<true, true>(P0, UT, 32 * mta, 32 * nte, lane);
                bf16x8* dp = (bf16x8*)(G + 8192 + (size_t)((nte * 2 + mta) * 64 + lane) * 32); dp[0] = pack8<0>(a); dp[1] = pack8<1>(a); }
        } else if (wg == 2) {
#pragma unroll
            for (int t4 = 0; t4 < 4; ++t4) { const int mtb = t4 >> 1, nti = t4 & 1; const f32x16 a = mm_tile<true, false>(WT, INTRA, 32 * mtb, 32 * nti, lane);
                f32x16 qe; const LAS bf16_t* qd = P1 + (32 * nti + rr) * TLD + 32 * mtb + 4 * hh;
#pragma unroll
                for (int g = 0; g < 4; ++g) { const u32x2 w = *(const LAS u32x2*)(qd + 8 * g); qe[4 * g] = bflo(w.x) - a[4 * g]; qe[4 * g + 1] = bfhi(w.x) - a[4 * g + 1]; qe[4 * g + 2] = bflo(w.y) - a[4 * g + 2]; qe[4 * g + 3] = bfhi(w.y) - a[4 * g + 3]; }
                *(bf16x8*)(G + 16384 + (size_t)((nti * 4 + 2 * mtb) * 64 + lane) * 16) = pack8<0>(qe); *(bf16x8*)(G + 16384 + (size_t)((nti * 4 + 2 * mtb + 1) * 64 + lane) * 16) = pack8<1>(qe); }
        } else {
#pragma unroll
            for (int t4 = 0; t4 < 4; ++t4) { const int mti = t4 >> 1, nte = t4 & 1; const f32x16 a = mm_tile<false, true>(INTRA, UT, 32 * mti, 32 * nte, lane);
                bf16_t* dst = (bf16_t*)(G + 24576) + (size_t)(32 * nte + rr) * 64 + 32 * mti + 4 * hh;
#pragma unroll
                for (int g = 0; g < 4; ++g) { u32x2 w; w.x = pk2(a[4 * g], a[4 * g + 1]); w.y = pk2(a[4 * g + 2], a[4 * g + 3]); *(u32x2*)(dst + 8 * g) = w; } }
            if (lane == 0) *(float*)(G + 40960) = __expf(gcl);
        } }
    __syncthreads();
}

DI void pv_accum(const f32x16 (&acc)[2][2], f32x16 (&o)[2][2], const LAS bf16_t* Vt, int lane) {
    const int r = lane & 31, hh = lane >> 5;
#pragma unroll
    for (int mt = 0; mt < 2; ++mt) {
        {   const bf16x8 p0 = pack8<0>(acc[mt][0]), p1 = pack8<0>(acc[mt][1]);
#pragma unroll
            for (int mo = 0; mo < 2; ++mo) { const LAS bf16_t* s = Vt + (32 * mo + r) * TLD; const int c0 = (32 * mt + 4 * hh) ^ tsw(32 * mo + r);
                const u32x2 lo = *(const LAS u32x2*)(s + c0), hi = *(const LAS u32x2*)(s + (c0 ^ 8)); u32x4 w; w.x = lo.x; w.y = lo.y; w.z = hi.x; w.w = hi.y; const bf16x8 vf = __builtin_bit_cast(bf16x8, w);
                o[mo][0] = MFMA32(vf, p0, o[mo][0]); o[mo][1] = MFMA32(vf, p1, o[mo][1]); } }
        {   const bf16x8 p0 = pack8<1>(acc[mt][0]), p1 = pack8<1>(acc[mt][1]);
#pragma unroll
            for (int mo = 0; mo < 2; ++mo) { const LAS bf16_t* s = Vt + (32 * mo + r) * TLD; const int c0 = (32 * mt + 16 + 4 * hh) ^ tsw(32 * mo + r);
                const u32x2 lo = *(const LAS u32x2*)(s + c0), hi = *(const LAS u32x2*)(s + (c0 ^ 8)); u32x4 w; w.x = lo.x; w.y = lo.y; w.z = hi.x; w.w = hi.y; const bf16x8 vf = __builtin_bit_cast(bf16x8, w);
                o[mo][0] = MFMA32(vf, p0, o[mo][0]); o[mo][1] = MFMA32(vf, p1, o[mo][1]); } }
    }
}
template <class F> DI void stage_vt(LAS bf16_t* Vt, int lane, F vrow) {
#pragma unroll
    for (int it = 0; it < 8; ++it) { const int id = it * 64 + lane, key = id >> 3, part = id & 7;
        const u32x4 w = *(const u32x4*)(vrow(key) + 8 * part);
#pragma unroll
        for (int j = 0; j < 4; ++j) { const int d0 = 8 * part + 2 * j, ks_ = key ^ tsw(d0); Vt[d0 * TLD + ks_] = (bf16_t)(w[j] & 0xffffu); Vt[(d0 + 1) * TLD + ks_] = (bf16_t)(w[j] >> 16); } }
}
DI void write_o_slot(LAS float* SL, const f32x16 (&o)[2][2], int lane) {
    const int r = lane & 31, hh = lane >> 5;
#pragma unroll
    for (int mo = 0; mo < 2; ++mo)
#pragma unroll
        for (int nt = 0; nt < 2; ++nt)
#pragma unroll
            for (int g = 0; g < 4; ++g) { f32x4 v; v[0] = o[mo][nt][4 * g]; v[1] = o[mo][nt][4 * g + 1]; v[2] = o[mo][nt][4 * g + 2]; v[3] = o[mo][nt][4 * g + 3];
                *(LAS f32x4*)(SL + (32 * nt + r) * 68 + 32 * mo + 8 * g + 4 * hh) = v; }
}
DI void add_o_slot(const LAS float* SL, f32x16 (&o)[2][2], int lane) {
    const int r = lane & 31, hh = lane >> 5;
#pragma unroll
    for (int mo = 0; mo < 2; ++mo)
#pragma unroll
        for (int nt = 0; nt < 2; ++nt)
#pragma unroll
            for (int g = 0; g < 4; ++g) { const f32x4 v = *(const LAS f32x4*)(SL + (32 * nt + r) * 68 + 32 * mo + 8 * g + 4 * hh);
                o[mo][nt][4 * g] += v[0]; o[mo][nt][4 * g + 1] += v[1]; o[mo][nt][4 * g + 2] += v[2]; o[mo][nt][4 * g + 3] += v[3]; }
}

constexpr int WAREA = 10240;
DI void osm_update(f32x16 (&acc)[2][2], f32x16 (&o)[2][2], float (&m)[2], float (&l)[2]) {
#pragma unroll
    for (int nt = 0; nt < 2; ++nt) { float mx = -1e30f;
#pragma unroll
        for (int mt = 0; mt < 2; ++mt)
#pragma unroll
            for (int g = 0; g < 16; ++g) mx = fmaxf(mx, acc[mt][nt][g]);
        mx = fmaxf(mx, __shfl_xor(mx, 32));
        const float mn = fmaxf(m[nt], mx), sc = __expf(m[nt] - mn); float sm = 0.f;
#pragma unroll
        for (int mt = 0; mt < 2; ++mt)
#pragma unroll
            for (int g = 0; g < 16; ++g) { const float pz = __expf(acc[mt][nt][g] - mn); acc[mt][nt][g] = pz; sm += pz; }
        sm += __shfl_xor(sm, 32);
        l[nt] = l[nt] * sc + sm; m[nt] = mn;
#pragma unroll
        for (int g = 0; g < 16; ++g) { o[0][nt][g] *= sc; o[1][nt][g] *= sc; } }
}
template <class F> DI void store_o_rows(LAS bf16_t* T, const f32x16 (&o)[2][2], const float (&scale)[2], int lane, F rowp) {
    const int r = lane & 31, hh = lane >> 5;
#pragma unroll
    for (int mo = 0; mo < 2; ++mo)
#pragma unroll
        for (int nt = 0; nt < 2; ++nt)
#pragma unroll
            for (int g = 0; g < 4; ++g) { u32x2 w; w.x = pk2(o[mo][nt][4 * g] * scale[nt], o[mo][nt][4 * g + 1] * scale[nt]); w.y = pk2(o[mo][nt][4 * g + 2] * scale[nt], o[mo][nt][4 * g + 3] * scale[nt]);
                *(LAS u32x2*)(T + (32 * nt + r) * TLD + 32 * mo + 8 * g + 4 * hh) = w; }
    asm volatile("s_waitcnt lgkmcnt(0)" ::: "memory");
#pragma unroll
    for (int it = 0; it < 8; ++it) { const int id = it * 64 + lane, q = id >> 3, part = id & 7; *(u32x4*)(rowp(q) + 8 * part) = *(const LAS u32x4*)(T + q * TLD + 8 * part); }
    asm volatile("s_waitcnt lgkmcnt(0)" ::: "memory");
}
DI void na_wave_unit(KArgs args, LAS unsigned char* L, const Ctx& c, int u, int lane, int wave) {
    const int l = c.layer, head = u & 3, gr = u >> 2, rows = c.seqlen >> 6, seq = gr / rows, r = gr % rows;
    int rs = r - 4; rs = rs < 0 ? 0 : (rs > rows - 8 ? rows - 8 : rs);
    const bf16_t* PROJ = BIGP(bf16_t, B_PROJ);
    const size_t tq0 = (size_t)seq * c.seqlen + (size_t)r * 64;
    LAS bf16_t* Vt = (LAS bf16_t*)(L + wave * WAREA);
    LAS float* BIAS = (LAS float*)(L + wave * WAREA + 9216);
    const int rr = lane & 31, hh = lane >> 5;
#pragma unroll
    for (int w = 0; w < 4; ++w) { const int idx = w * 64 + lane, kw = idx >> 5, dc = idx & 31;
        if (dc < 31) BIAS[idx] = args->in[3][(((size_t)l * 4 + head) * 15 + (rs + kw - r + 7)) * 31 + dc]; }
    bf16x8 qf[2][4];
#pragma unroll
    for (int nt = 0; nt < 2; ++nt)
#pragma unroll
        for (int ks = 0; ks < 4; ++ks) qf[nt][ks] = *(const bf16x8*)(PROJ + (tq0 + 32 * nt + rr) * NPROJ + C_QA + 64 * head + 16 * ks + 8 * hh);
    f32x16 o[2][2]; o[0][0] = zero16(); o[0][1] = zero16(); o[1][0] = zero16(); o[1][1] = zero16();
    float m[2] = {-1e30f, -1e30f}, ls[2] = {0.f, 0.f};
    for (int w = 0; w < 8; ++w) {
        const size_t tk0 = (size_t)seq * c.seqlen + (size_t)(rs + w) * 64;
        asm volatile("s_waitcnt lgkmcnt(0)" ::: "memory");
        stage_vt(Vt, lane, [&](int key) { return PROJ + (tk0 + key) * NPROJ + C_VA + 64 * head; });
        f32x16 acc[2][2]; acc[0][0] = zero16(); acc[0][1] = zero16(); acc[1][0] = zero16(); acc[1][1] = zero16();
#pragma unroll
        for (int mt = 0; mt < 2; ++mt)
#pragma unroll
            for (int ks = 0; ks < 4; ++ks) { const bf16x8 kf = *(const bf16x8*)(PROJ + (tk0 + 32 * mt + rr) * NPROJ + C_KA + 64 * head + 16 * ks + 8 * hh);
                acc[mt][0] = MFMA32(kf, qf[0][ks], acc[mt][0]); acc[mt][1] = MFMA32(kf, qf[1][ks], acc[mt][1]); }
        asm volatile("s_waitcnt lgkmcnt(0)" ::: "memory");
        const LAS float* brow = BIAS + w * 32;
#pragma unroll
        for (int nt = 0; nt < 2; ++nt) { const int qc = 32 * nt + rr; int ws = qc - 8; ws = ws < 0 ? 0 : (ws > 48 ? 48 : ws);
#pragma unroll
            for (int mt = 0; mt < 2; ++mt)
#pragma unroll
                for (int g = 0; g < 16; ++g) { const int kc = 32 * mt + crow(g, hh); const bool ok = (kc >= ws) && (kc < ws + 16);
                    acc[mt][nt][g] = ok ? acc[mt][nt][g] * 0.125f + brow[ok ? (kc - qc + 15) : 0] : -1e30f; } }
        osm_update(acc, o, m, ls);
        pv_accum(acc, o, Vt, lane);
    }
    asm volatile("s_waitcnt lgkmcnt(0)" ::: "memory");
    const float sc[2] = {frcp(ls[0]), frcp(ls[1])};
    store_o_rows(Vt, o, sc, lane, [&](int q) { return BIGP(bf16_t, B_ONA) + (tq0 + q) * 768 + 64 * head; });
}
DI void rope_frag4(bf16x8 (&f)[4], const float* cs, int hh) {
#pragma unroll
    for (int ks = 0; ks < 2; ++ks) { const float* cp = cs + 16 * ks + 8 * hh;
        const f32x4 c0 = *(const f32x4*)cp, c1 = *(const f32x4*)(cp + 4), s0 = *(const f32x4*)(cp + 32), s1 = *(const f32x4*)(cp + 36);
        const u32x4 a = __builtin_bit_cast(u32x4, f[ks]), b = __builtin_bit_cast(u32x4, f[ks + 2]); u32x4 ra, rb;
#pragma unroll
        for (int j = 0; j < 4; ++j) { const float cl = (j < 2) ? c0[2 * j] : c1[2 * j - 4], ch = (j < 2) ? c0[2 * j + 1] : c1[2 * j - 3];
            const float sl = (j < 2) ? s0[2 * j] : s1[2 * j - 4], sh = (j < 2) ? s0[2 * j + 1] : s1[2 * j - 3];
            const float x1l = bflo(a[j]), x1h = bfhi(a[j]), x2l = bflo(b[j]), x2h = bfhi(b[j]);
            ra[j] = pk2(x1l * cl - x2l * sl, x1h * ch - x2h * sh); rb[j] = pk2(x1l * sl + x2l * cl, x1h * sh + x2h * ch); }
        f[ks] = __builtin_bit_cast(bf16x8, ra); f[ks + 2] = __builtin_bit_cast(bf16x8, rb); }
}
DI void dil_wave_unit(KArgs args, LAS unsigned char* L, const Ctx& c, int u, int lane, int wave) {
    const int hd = u & 1, uu = u >> 1, upg = c.stok >> 6, g = uu / upg, v = uu % upg, ups = c.seqlen >> 6, seq = v / ups, wq = v % ups;
    const int dsh = 2 * g, dd = 1 << dsh, nb = ups >> dsh, cls = wq / nb, jb = wq % nb, head = 2 * g + hd;
    const bf16_t* PROJ = BIGP(bf16_t, B_PROJ); const float* CS = WSP(float, WS_CS);
    const size_t sb = (size_t)seq * c.seqlen;
    const int rr = lane & 31, hh = lane >> 5;
    LAS bf16_t* Vt = (LAS bf16_t*)(L + wave * WAREA);
    bf16x8 qf[2][4];
#pragma unroll
    for (int nt = 0; nt < 2; ++nt) { const int pos = cls + dd * (64 * jb + 32 * nt + rr);
#pragma unroll
        for (int ks = 0; ks < 4; ++ks) qf[nt][ks] = *(const bf16x8*)(PROJ + (sb + pos) * NPROJ + C_QD + 64 * head + 16 * ks + 8 * hh);
        rope_frag4(qf[nt], CS + (size_t)pos * 64, hh); }
    f32x16 o[2][2]; o[0][0] = zero16(); o[0][1] = zero16(); o[1][0] = zero16(); o[1][1] = zero16();
    float m[2] = {-1e30f, -1e30f}, ls[2] = {0.f, 0.f};
    for (int kt = 0; kt < 3; ++kt) { const int kj = jb - 1 + kt;
        if (kj < 0 || kj >= nb) continue;
        asm volatile("s_waitcnt lgkmcnt(0)" ::: "memory");
        stage_vt(Vt, lane, [&](int key) { return PROJ + (sb + cls + (size_t)dd * (64 * kj + key)) * NPROJ + C_VD + 64 * head; });
        f32x16 acc[2][2]; acc[0][0] = zero16(); acc[0][1] = zero16(); acc[1][0] = zero16(); acc[1][1] = zero16();
#pragma unroll
        for (int mt = 0; mt < 2; ++mt) { const int pos = cls + dd * (64 * kj + 32 * mt + rr); bf16x8 kf[4];
#pragma unroll
            for (int ks = 0; ks < 4; ++ks) kf[ks] = *(const bf16x8*)(PROJ + (sb + pos) * NPROJ + C_KD + 64 * head + 16 * ks + 8 * hh);
            rope_frag4(kf, CS + (size_t)pos * 64, hh);
#pragma unroll
            for (int ks = 0; ks < 4; ++ks) { acc[mt][0] = MFMA32(kf[ks], qf[0][ks], acc[mt][0]); acc[mt][1] = MFMA32(kf[ks], qf[1][ks], acc[mt][1]); } }
#pragma unroll
        for (int nt = 0; nt < 2; ++nt) { const int qc = 32 * nt + rr;
#pragma unroll
            for (int mt = 0; mt < 2; ++mt)
#pragma unroll
                for (int gg = 0; gg < 16; ++gg) { const int kc = 32 * mt + crow(gg, hh); const bool ok = (kt == 1) || (kt == 0 ? (kc >= qc) : (kc <= qc));
                    acc[mt][nt][gg] = ok ? acc[mt][nt][gg] * 0.125f : -1e30f; } }
        osm_update(acc, o, m, ls);
        pv_accum(acc, o, Vt, lane);
    }
    asm volatile("s_waitcnt lgkmcnt(0)" ::: "memory");
    bf16_t* DP = BIGP(bf16_t, B_DILP); float* DM = BIGP(float, B_DILM);
    const float one[2] = {1.f, 1.f};
    store_o_rows(Vt, o, one, lane, [&](int q) { return DP + ((((size_t)g * SLABMAX + sb + cls + (size_t)dd * (64 * jb + q)) * 2 + hd)) * 64; });
    if (hh == 0) {
#pragma unroll
        for (int nt = 0; nt < 2; ++nt) { const size_t base = (((size_t)g * SLABMAX + sb + cls + (size_t)dd * (64 * jb + 32 * nt + rr)) * 2 + hd); DM[base * 2] = m[nt]; DM[base * 2 + 1] = ls[nt]; } }
}

DI void phase_mix_a(KArgs args, LAS unsigned char* L, const Ctx& c) {
    const int N_PREP = (c.stok >> 6) * 6;
    for (int u = c.bid; u < N_PREP; u += c.G) gdn_prep_pair(args, L, c, u);
}
DI void attn_wave_units(KArgs args, LAS unsigned char* L, const Ctx& c) {
    int tid = c.tid; asm volatile("" : "+v"(tid)); const int lane = tid & 63, wave = __builtin_amdgcn_readfirstlane(tid >> 6);
    const int nch_ = c.stok >> 6, N_NA = nch_ * 4, N_DIL = nch_ * 6;
    unsigned* q = (unsigned*)(c.ws + WS_CTL) + 32768 + 128 * (c.layer * 4 + c.slab);
    for (;;) { unsigned u = 0; if (lane == 0) u = __hip_atomic_fetch_add(q, 1u, __ATOMIC_RELAXED, __HIP_MEMORY_SCOPE_AGENT);
        u = (unsigned)__builtin_amdgcn_readfirstlane((int)u); if (u >= (unsigned)N_NA) break; na_wave_unit(args, L, c, (int)u, lane, wave); }
    int tid2 = c.tid; asm volatile("" : "+v"(tid2)); const int lane2 = tid2 & 63, wave2 = __builtin_amdgcn_readfirstlane(tid2 >> 6);
    for (;;) { unsigned u = 0; if (lane2 == 0) u = __hip_atomic_fetch_add(q + 64, 1u, __ATOMIC_RELAXED, __HIP_MEMORY_SCOPE_AGENT);
        u = (unsigned)__builtin_amdgcn_readfirstlane((int)u); if (u >= (unsigned)N_DIL) break; dil_wave_unit(args, L, c, (int)u, lane2, wave2); }
}

DI void phase_select(KArgs args, LAS unsigned char* L, const Ctx& c, int inst);
DI void phase_scan(KArgs args, LAS unsigned char* L, const Ctx& c) {
    if (c.slab == NSLAB - 1 && c.bid >= 24 && c.bid < 40) { phase_select(args, L, c, c.bid - 24); return; }
    const int nwu = c.nseq * 24, wu = c.bid;
    if (wu < nwu && c.wave == 0) {
        const int lane = c.lane;
        const int chain = wu >> 1, nt = wu & 1, seq = chain / 12, rem = chain % 12, head = rem >> 1, dir = rem & 1;
        const int nch = c.seqlen >> 6, gch0 = seq * nch;
        unsigned char* GS = BIGP(unsigned char, B_GSCR);
        f32x16 S[2]; S[0] = zero16(); S[1] = zero16();
        bf16x8 A[2][2][4]; u32x4 cm[2][2][2];
        const long gstep = (long)(dir ? -1 : 1) * 12 * GSTRIDE;
        const unsigned char* G0 = GS + (size_t)(((gch0 + (dir ? nch - 1 : 0)) * 6 + head) * 2 + dir) * GSTRIDE;
        unsigned char* Gs = (unsigned char*)G0;
        float glv[4];
#pragma unroll
        for (int q = 0; q < 4; ++q) { const int sq = q * 64 + lane; glv[q] = *(const float*)(G0 + (long)(sq < nch ? sq : nch - 1) * gstep + 40960); }
        LAS unsigned char* RING = L + 81920;
        int dslot = 0, rslot = 0, dstage = 0;
#define SCAN_DMA() do { const unsigned char* gp = G0 + (long)(dstage < nch ? dstage : nch - 1) * gstep; LAS unsigned char* sl = RING + dslot * 12288; \
            _Pragma("unroll") for (int j = 0; j < 8; ++j) __builtin_amdgcn_global_load_lds((const unsigned*)(gp + (size_t)(j * 64 + lane) * 16), (LAS unsigned*)(sl + j * 1024), 16, 0, 0); \
            _Pragma("unroll") for (int j = 0; j < 4; ++j) __builtin_amdgcn_global_load_lds((const unsigned*)(gp + 8192 + (size_t)((nt * 2 + (j >> 1)) * 64 + lane) * 32 + (j & 1) * 16), (LAS unsigned*)(sl + 8192 + j * 1024), 16, 0, 0); \
            ++dstage; dslot = dslot == 4 ? 0 : dslot + 1; } while (0)
#define SCAN_LOAD(B) do { const LAS unsigned char* sl = RING + rslot * 12288 + lane * 16; \
            _Pragma("unroll") for (int mt = 0; mt < 2; ++mt) { _Pragma("unroll") for (int ks = 0; ks < 4; ++ks) A[B][mt][ks] = *(const LAS bf16x8*)(sl + (mt * 4 + ks) * 1024); \
                cm[B][mt][0] = *(const LAS u32x4*)(sl + 8192 + (mt * 2) * 1024); cm[B][mt][1] = *(const LAS u32x4*)(sl + 8192 + (mt * 2 + 1) * 1024); } \
            rslot = rslot == 4 ? 0 : rslot + 1; } while (0)
#define SCAN_STEP(B, st) do { const bf16x8 b0 = pack8<0>(S[0]), b1 = pack8<1>(S[0]), b2 = pack8<0>(S[1]), b3 = pack8<1>(S[1]); f32x16 nw[2]; \
            { bf16x8* St = (bf16x8*)(Gs + 32768) + (nt * 4) * 64 + lane; St[0] = b0; St[64] = b1; St[128] = b2; St[192] = b3; }     \
            const int sq_ = (st) >> 6; const float gsel = sq_ == 0 ? glv[0] : (sq_ == 1 ? glv[1] : (sq_ == 2 ? glv[2] : glv[3])); \
            const float glc = __builtin_bit_cast(float, __builtin_amdgcn_readlane(__builtin_bit_cast(int, gsel), (st) & 63)); \
            _Pragma("unroll") for (int mt = 0; mt < 2; ++mt) { \
                _Pragma("unroll") for (int g = 0; g < 8; ++g) { const unsigned wv = (g < 4) ? cm[B][mt][0][g] : cm[B][mt][1][g - 4]; nw[mt][2 * g] = glc * S[mt][2 * g] + bflo(wv); nw[mt][2 * g + 1] = glc * S[mt][2 * g + 1] + bfhi(wv); } \
                nw[mt] = MFMA32(A[B][mt][0], b0, nw[mt]); nw[mt] = MFMA32(A[B][mt][1], b1, nw[mt]); nw[mt] = MFMA32(A[B][mt][2], b2, nw[mt]); nw[mt] = MFMA32(A[B][mt][3], b3, nw[mt]); } \
            S[0] = nw[0]; S[1] = nw[1]; Gs += gstep; } while (0)
        SCAN_DMA(); SCAN_DMA(); SCAN_DMA(); SCAN_DMA(); SCAN_DMA();
        asm volatile("s_waitcnt vmcnt(48)" ::: "memory"); SCAN_LOAD(0);
        asm volatile("s_waitcnt vmcnt(36)" ::: "memory"); SCAN_LOAD(1);
        for (int step = 0; step < nch; step += 2) {
            SCAN_STEP(0, step);     asm volatile("s_waitcnt vmcnt(24)" ::: "memory"); SCAN_LOAD(0); SCAN_DMA();
            SCAN_STEP(1, step + 1); asm volatile("s_waitcnt vmcnt(24)" ::: "memory"); SCAN_LOAD(1); SCAN_DMA();
        }
        asm volatile("s_waitcnt vmcnt(0)" ::: "memory");
#undef SCAN_DMA
#undef SCAN_LOAD
#undef SCAN_STEP
    }
    attn_wave_units(args, L, c);
}

DI void dil_merge(const Ctx& c) {
    { const bf16_t* DP = BIGP(bf16_t, B_DILP); const float* DM = BIGP(float, B_DILM); bf16_t* OD = BIGP(bf16_t, B_ONA) + 256;
        for (int it = c.bid * 512 + c.tid; it < c.stok * 32; it += c.G * 512) { const int tok = it >> 5, part = it & 31;
            u32x4 w = {0u, 0u, 0u, 0u};
            if (part < 16) { const int hd = part >> 3, p = part & 7; float m[3], dn[3];
#pragma unroll
                for (int g = 0; g < 3; ++g) { const size_t b = (((size_t)g * SLABMAX + tok) * 2 + hd); m[g] = DM[b * 2]; dn[g] = DM[b * 2 + 1]; }
                const float M = fmaxf(m[0], fmaxf(m[1], m[2])); float num[8], den = 0.f;
#pragma unroll
                for (int j = 0; j < 8; ++j) num[j] = 0.f;
#pragma unroll
                for (int g = 0; g < 3; ++g) { const float f = __expf(m[g] - M); den += f * dn[g]; const u32x4 a = *(const u32x4*)(DP + (((size_t)g * SLABMAX + tok) * 2 + hd) * 64 + 8 * p);
                    num[0] += f * bflo(a[0]); num[1] += f * bfhi(a[0]); num[2] += f * bflo(a[1]); num[3] += f * bfhi(a[1]); num[4] += f * bflo(a[2]); num[5] += f * bfhi(a[2]); num[6] += f * bflo(a[3]); num[7] += f * bfhi(a[3]); }
                const float inv = frcp(den);
                w.x = pk2(num[0] * inv, num[1] * inv); w.y = pk2(num[2] * inv, num[3] * inv); w.z = pk2(num[4] * inv, num[5] * inv); w.w = pk2(num[6] * inv, num[7] * inv); }
            if (part < 16) *(u32x4*)(OD + (size_t)tok * 768 + 8 * part) = w; } }
}

DI void phase_gdn_out(KArgs args, LAS unsigned char* L, const Ctx& c) {
    dil_merge(c);
    const int lane = c.lane, wave = c.wave, tid = c.tid, l = c.layer;
    const bf16_t* PROJ = BIGP(bf16_t, B_PROJ); unsigned char* GS = BIGP(unsigned char, B_GSCR); bf16_t* OG = BIGP(bf16_t, B_ONA) + 384;
    LAS float* OF = (LAS float*)L;
    for (int u = c.bid; u < (c.stok >> 6) * 6; u += c.G) { const int gch = u / 6, head = u % 6;
        { const int dir = wave >> 2, mt = (wave >> 1) & 1, nt = wave & 1, rr = lane & 31, hh = lane >> 5;
            const unsigned char* G = GS + (size_t)((gch * 6 + head) * 2 + dir) * GSTRIDE;
            const bf16_t* Qe = (const bf16_t*)(G + 16384); const bf16_t* Oct = (const bf16_t*)(G + 24576); const bf16_t* St = (const bf16_t*)(G + 32768);
            f32x16 acc = zero16();
#pragma unroll
            for (int ks = 0; ks < 4; ++ks) { const bf16x8 a = *(const bf16x8*)(Qe + (size_t)((mt * 4 + ks) * 64 + lane) * 8);
                const bf16x8 bw = *((const bf16x8*)St + (nt * 4 + ks) * 64 + lane); acc = MFMA32(a, bw, acc); }
            const int e = 32 * nt + rr;
#pragma unroll
            for (int g = 0; g < 4; ++g) { const u32x2 w = *(const u32x2*)(Oct + e * 64 + 32 * mt + 8 * g + 4 * hh);
                const float v0 = acc[4 * g] + bflo(w.x), v1 = acc[4 * g + 1] + bfhi(w.x), v2 = acc[4 * g + 2] + bflo(w.y), v3 = acc[4 * g + 3] + bfhi(w.y);
                const int i0 = 32 * mt + 8 * g + 4 * hh;
#pragma unroll
                for (int j = 0; j < 4; ++j) { const int ii = i0 + j, tl = dir ? 63 - ii : ii; OF[(dir * 64 + tl) * 68 + e] = (j == 0) ? v0 : (j == 1) ? v1 : (j == 2) ? v2 : v3; } } }
        __syncthreads();
        { const int i = tid >> 3, p = tid & 7; const size_t tok = (size_t)gch * 64 + i;
            const LAS float* a = OF + i * 68 + 8 * p; const LAS float* b = OF + (64 + i) * 68 + 8 * p;
            float ov[8]; float ss = 0.f;
#pragma unroll
            for (int j = 0; j < 8; ++j) { ov[j] = a[j] + b[j]; ss += ov[j] * ov[j]; }
            ss += __shfl_xor(ss, 1); ss += __shfl_xor(ss, 2); ss += __shfl_xor(ss, 4);
            const float rs = frsq(ss * (1.0f / 64.0f) + NORM_EPS);
            const u32x4 zw = *(const u32x4*)(PROJ + tok * NPROJ + C_ZC + 64 * head + 8 * p);
            const float* nw = args->in[7] + l * 64 + 8 * p;
            float r[8];
#pragma unroll
            for (int j = 0; j < 4; ++j) { r[2 * j] = ov[2 * j] * rs * nw[2 * j] * siluf_(bflo(zw[j])); r[2 * j + 1] = ov[2 * j + 1] * rs * nw[2 * j + 1] * siluf_(bfhi(zw[j])); }
            u32x4 w; w.x = pk2(r[0], r[1]); w.y = pk2(r[2], r[3]); w.z = pk2(r[4], r[5]); w.w = pk2(r[6], r[7]);
            *(u32x4*)(OG + tok * 768 + 64 * head + 8 * p) = w; }
        __syncthreads();
    }
}

DI void phase_ln1(KArgs args, LAS unsigned char* L, const Ctx& c) {
    const int lane = c.lane, l = c.layer;
    LAS float* WR = (LAS float*)L;
    { const float* wr = args->in[14] + (size_t)l * D * 16;
        for (int i = c.tid; i < D * 16; i += 512) { const int col = i >> 4, e = i & 15, j = col >> 8, ln = (col >> 2) & 63, q = col & 3; WR[((j * 4 + q) * 64 + ln) * 20 + e] = wr[i]; } }
    __syncthreads();
    const float* g1 = args->in[12] + l * D; const float* b1 = args->in[13] + l * D;
    f32x4 gv[4], bv[4];
#pragma unroll
    for (int j = 0; j < 4; ++j) { gv[j] = *(const f32x4*)(g1 + 4 * lane + 256 * j); bv[j] = *(const f32x4*)(b1 + 4 * lane + 256 * j); }
    float* AFF = WSP(float, WS_AFF); int* SLOT = WSP(int, WS_SLOT); bf16_t* XB = WSP(bf16_t, WS_XB);
    u32x2 nv[4];
    { const int rl0 = c.bid * 8 + c.wave; if (rl0 < c.stok) { const bf16_t* hp = (const bf16_t*)c.out + ((size_t)c.sbase + rl0) * D;
#pragma unroll
        for (int j = 0; j < 4; ++j) nv[j] = *(const u32x2*)(hp + 4 * lane + 256 * j); } }
    for (int rl = c.bid * 8 + c.wave; rl < c.stok; rl += c.G * 8) { const size_t tok = (size_t)c.sbase + rl;
        const bf16_t* hr = (const bf16_t*)c.out + tok * D; f32x4 v[4]; float s = 0.f;
#pragma unroll
        for (int j = 0; j < 4; ++j) { v[j][0] = bflo(nv[j].x); v[j][1] = bfhi(nv[j].x); v[j][2] = bflo(nv[j].y); v[j][3] = bfhi(nv[j].y); s += (v[j][0] + v[j][1]) + (v[j][2] + v[j][3]); }
        if (rl + c.G * 8 < c.stok) { const bf16_t* hp = hr + (size_t)c.G * 8 * D;
#pragma unroll
            for (int j = 0; j < 4; ++j) nv[j] = *(const u32x2*)(hp + 4 * lane + 256 * j); }
        const float mean = wave_sum(s) * (1.0f / D); float s2 = 0.f;
#pragma unroll
        for (int j = 0; j < 4; ++j) { v[j] = v[j] - mean; s2 += (v[j][0] * v[j][0] + v[j][1] * v[j][1]) + (v[j][2] * v[j][2] + v[j][3] * v[j][3]); }
        const float rstd = frsq(wave_sum(s2) * (1.0f / D) + LN_EPS);
        float lg[16];
#pragma unroll
        for (int e = 0; e < 16; ++e) lg[e] = 0.f;
#pragma unroll
        for (int j = 0; j < 4; ++j) { v[j] = v[j] * rstd * gv[j] + bv[j];
            if (!c.dry) { u32x2 w; w.x = pk2(v[j][0], v[j][1]); w.y = pk2(v[j][2], v[j][3]); *(u32x2*)(XB + tok * D + 4 * lane + 256 * j) = w; }
#pragma unroll
            for (int q = 0; q < 4; ++q) { const LAS float* wp = WR + ((j * 4 + q) * 64 + lane) * 20; const float xv = v[j][q];
#pragma unroll
                for (int e4 = 0; e4 < 4; ++e4) { const f32x4 w4 = *(const LAS f32x4*)(wp + 4 * e4); lg[4 * e4] += xv * w4[0]; lg[4 * e4 + 1] += xv * w4[1]; lg[4 * e4 + 2] += xv * w4[2]; lg[4 * e4 + 3] += xv * w4[3]; } }
            asm volatile("" ::: "memory"); }
        float mx = -1e30f;
#pragma unroll
        for (int e = 0; e < 16; ++e) { lg[e] = wave_sum(lg[e]); mx = fmaxf(mx, lg[e]); }
        float den = 0.f;
#pragma unroll
        for (int e = 0; e < 16; ++e) { lg[e] = expf(lg[e] - mx); den += lg[e]; }
        float mine = 0.f;
#pragma unroll
        for (int e = 0; e < 16; ++e) mine = (lane == e) ? lg[e] : mine;
        if (lane < 16 && !c.dry) { AFF[(size_t)lane * T_ALL + tok] = mine / den; SLOT[tok * 16 + lane] = -1; }
    }
}
DI void phase_ln2(KArgs args, LAS unsigned char* L, const Ctx& c) {
    const int lane = c.lane, l = c.layer;
    const float* g2 = args->in[18] + l * D; const float* b2 = args->in[19] + l * D;
    f32x4 gv[4], bv[4];
#pragma unroll
    for (int j = 0; j < 4; ++j) { gv[j] = *(const f32x4*)(g2 + 4 * lane + 256 * j); bv[j] = *(const f32x4*)(b2 + 4 * lane + 256 * j); }
    const int* SLOT = WSP(int, WS_SLOT); bf16_t* XB = WSP(bf16_t, WS_XB);
    u32x2 nv[4]; int nsv = -1;
    { const int t0 = c.bid * 8 + c.wave; if (t0 < T_ALL) { const bf16_t* xp = XB + (size_t)t0 * D; nsv = SLOT[(size_t)t0 * 16 + (lane & 15)];
#pragma unroll
        for (int j = 0; j < 4; ++j) nv[j] = *(const u32x2*)(xp + 4 * lane + 256 * j); } }
    for (int t = c.bid * 8 + c.wave; t < T_ALL; t += c.G * 8) { const size_t tok = (size_t)t;
        float* xr = c.out + tok * D; f32x4 v[4];
#pragma unroll
        for (int j = 0; j < 4; ++j) { v[j][0] = bflo(nv[j].x) * ALPHA; v[j][1] = bfhi(nv[j].x) * ALPHA; v[j][2] = bflo(nv[j].y) * ALPHA; v[j][3] = bfhi(nv[j].y) * ALPHA; }
        const int sv = nsv;
        if (t + c.G * 8 < T_ALL) { const bf16_t* xp = XB + (tok + c.G * 8) * D; nsv = SLOT[(tok + c.G * 8) * 16 + (lane & 15)];
#pragma unroll
            for (int j = 0; j < 4; ++j) nv[j] = *(const u32x2*)(xp + 4 * lane + 256 * j); }
#pragma unroll
        for (int e = 0; e < 16; ++e) { const int s = __builtin_amdgcn_readlane(sv, e);
            if (s >= 0) { const bf16_t* yr = BIGP(bf16_t, (e < 8 ? B_XY0 : B_XY1)) + ((size_t)(e & 7) * CAP + s) * D;
#pragma unroll
                for (int j = 0; j < 4; ++j) { const u32x2 w = *(const u32x2*)(yr + 4 * lane + 256 * j); v[j][0] += bflo(w.x); v[j][1] += bfhi(w.x); v[j][2] += bflo(w.y); v[j][3] += bfhi(w.y); } } }
        float s = 0.f;
#pragma unroll
        for (int j = 0; j < 4; ++j) s += (v[j][0] + v[j][1]) + (v[j][2] + v[j][3]);
        const float mean = wave_sum(s) * (1.0f / D); float s2 = 0.f;
#pragma unroll
        for (int j = 0; j < 4; ++j) { v[j] = v[j] - mean; s2 += (v[j][0] * v[j][0] + v[j][1] * v[j][1]) + (v[j][2] * v[j][2] + v[j][3] * v[j][3]); }
        const float rstd = frsq(wave_sum(s2) * (1.0f / D) + LN_EPS);
#pragma unroll
        for (int j = 0; j < 4; ++j) { v[j] = v[j] * rstd * gv[j] + bv[j];
            if (!c.dry) {
                if (l == 1) *(f32x4*)(xr + 4 * lane + 256 * j) = v[j];
                else { u32x2 w; w.x = pk2(v[j][0], v[j][1]); w.y = pk2(v[j][2], v[j][3]); *(u32x2*)(XB + tok * D + 4 * lane + 256 * j) = w;
                    *(unsigned*)(WSP(unsigned char, WS_XB8) + tok * D + 4 * lane + 256 * j) = pk4_fp8(v[j][0], v[j][1], v[j][2], v[j][3]); } } }
    }
}

DI int block_excl_scan(int v, LAS int* tmp, int tid, int& total) {
    const int lane = tid & 63, wave = tid >> 6; int x = v;
#pragma unroll
    for (int o = 1; o < 64; o <<= 1) { const int y = __shfl_up(x, o); if (lane >= o) x += y; }
    __syncthreads();
    if (lane == 63) tmp[wave] = x;
    __syncthreads();
    int base = 0, tot = 0;
#pragma unroll
    for (int w = 0; w < 8; ++w) { const int tw = tmp[w]; if (w < wave) base += tw; tot += tw; }
    total = tot;
    return base + x - v;
}
DI void phase_select(KArgs args, LAS unsigned char* L, const Ctx& c, int inst) {
    if (inst < 0 || inst >= 32) return;
    const int tid = c.tid, grp = inst >> 4, e = inst & 15;
    const int n = grp ? T_S : T_P, t0 = grp ? T_P : 0, C = n >> 3, slot0 = grp ? CAP_P : 0;
    const unsigned* v = (const unsigned*)(WSP(float, WS_AFF) + (size_t)e * T_ALL + t0);
    LAS unsigned* hist = (LAS unsigned*)L; LAS int* sh = (LAS int*)(L + 8192); LAS int* tmp = (LAS int*)(L + 8192 + 64);
    unsigned prefix = 0u; int kk = C;
    for (int pass = 0; pass < 3; ++pass) {
        const int shift = pass == 0 ? 21 : (pass == 1 ? 10 : 0); const unsigned bmask = pass == 2 ? 1023u : 2047u;
        const unsigned mhi = pass == 0 ? 0u : (pass == 1 ? 0xFFE00000u : 0xFFFFFC00u);
        *(LAS u32x4*)(hist + 4 * tid) = (u32x4){0u, 0u, 0u, 0u};
        __syncthreads();
        for (int i = tid * 4; i < n; i += 512 * 16) {
            u32x4 x4[4];
#pragma unroll
            for (int k = 0; k < 4; ++k) x4[k] = *(const u32x4*)(v + i + k * 2048);
#pragma unroll
            for (int k = 0; k < 4; ++k)
#pragma unroll
                for (int j = 0; j < 4; ++j) { const unsigned x = x4[k][j]; if ((x & mhi) == prefix) __hip_atomic_fetch_add(&hist[(x >> shift) & bmask], 1u, __ATOMIC_RELAXED, __HIP_MEMORY_SCOPE_WORKGROUP); } }
        __syncthreads();
        {
            const u32x4 hv = *(const LAS u32x4*)(hist + 2044 - 4 * tid); int tot;
            int cum = block_excl_scan((int)(hv[0] + hv[1] + hv[2] + hv[3]), tmp, tid, tot);
            const int c1 = cum + (int)hv.w, c2 = c1 + (int)hv.z, c3 = c2 + (int)hv.y, c4 = c3 + (int)hv.x;
            if (cum < kk && kk <= c4) { const int j = kk <= c1 ? 0 : (kk <= c2 ? 1 : (kk <= c3 ? 2 : 3)); const int cb = kk <= c1 ? cum : (kk <= c2 ? c1 : (kk <= c3 ? c2 : c3));
                sh[0] = 2047 - 4 * tid - j; sh[1] = kk - cb; } }
        __syncthreads();
        prefix |= ((unsigned)sh[0]) << shift; kk = sh[1];
        __syncthreads();
    }
    const unsigned thr = prefix;
    const int per = n >> 9, i0 = tid * per;
    int ngt = 0, ntie = 0;
    for (int i = 0; i < per; i += 4) { const u32x4 x = *(const u32x4*)(v + i0 + i);
#pragma unroll
        for (int j = 0; j < 4; ++j) { ngt += (x[j] > thr); ntie += (x[j] == thr); } }
    int tot;
    const int tie_base = block_excl_scan(ntie, tmp, tid, tot);
    int take = kk - tie_base; take = take < 0 ? 0 : (take > ntie ? ntie : take);
    int pos = block_excl_scan(ngt + take, tmp, tid, tot);
    int* IDX = WSP(int, WS_IDX) + e * CAP + slot0;
    int tr = 0;
    for (int i = 0; i < per; i += 4) { const u32x4 x = *(const u32x4*)(v + i0 + i);
#pragma unroll
        for (int j = 0; j < 4; ++j) { bool s = x[j] > thr; if (x[j] == thr) { s = tr < take; ++tr; } if (s) { IDX[pos] = t0 + i0 + i + j; ++pos; } } }
}
DI void phase_gather(KArgs args, LAS unsigned char* L, const Ctx& c) {
    const int lane = c.lane; const int* IDX = WSP(int, WS_IDX); const bf16_t* XB = WSP(bf16_t, WS_XB);
    float* GATEV = WSP(float, WS_GATEV); int* SLOT = WSP(int, WS_SLOT); const float* AFF = WSP(float, WS_AFF);
    for (int row0 = (c.bid * 8 + c.wave) * 4; row0 < NE * CAP; row0 += c.G * 8 * 4) {
        const int e = row0 / CAP, s0 = row0 % CAP; int t[4]; u32x4 a[4], b[4];
#pragma unroll
        for (int k = 0; k < 4; ++k) t[k] = IDX[row0 + k];
#pragma unroll
        for (int k = 0; k < 4; ++k) { const u32x4* src = (const u32x4*)(XB + (size_t)t[k] * D) + 2 * lane; a[k] = src[0]; b[k] = src[1]; }
        u32x4* dst = (u32x4*)(BIGP(unsigned char, (e < 8 ? B_XY0 : B_XY1)) + ((size_t)(e & 7) * CAP + s0) * D);
#pragma unroll
        for (int k = 0; k < 4; ++k) { u32x4 w;
            w.x = pk4_fp8(bflo(a[k].x), bfhi(a[k].x), bflo(a[k].y), bfhi(a[k].y)); w.y = pk4_fp8(bflo(a[k].z), bfhi(a[k].z), bflo(a[k].w), bfhi(a[k].w));
            w.z = pk4_fp8(bflo(b[k].x), bfhi(b[k].x), bflo(b[k].y), bfhi(b[k].y)); w.w = pk4_fp8(bflo(b[k].z), bfhi(b[k].z), bflo(b[k].w), bfhi(b[k].w));
            dst[k * 64 + lane] = w; }
        if (lane < 4) { const int tt = (lane == 0) ? t[0] : (lane == 1) ? t[1] : (lane == 2) ? t[2] : t[3]; SLOT[(size_t)tt * 16 + e] = s0 + lane; GATEV[row0 + lane] = AFF[(size_t)e * T_ALL + tt]; } }
}

__global__ void __launch_bounds__(512, 2) fwd_kernel(Args args) {
    extern __shared__ __attribute__((aligned(16))) unsigned char lds_raw[];
    LAS unsigned char* L = (LAS unsigned char*)lds_raw;
    Ctx c;
    c.out = args.out; c.ws = args.ws;
    c.tid = threadIdx.x; c.lane = c.tid & 63; c.wave = __builtin_amdgcn_readfirstlane(c.tid >> 6); c.G = gridDim.x; c.bid = blockIdx.x;
    c.layer = 0; c.slab = 0; c.nseq = 8; c.seqlen = 4096; c.stok = 32768; c.sbase = 0; c.dry = 0;
    const int lo = args.ph_lo, hi = args.ph_hi;
    volatile LAS unsigned* MISC = (volatile LAS unsigned*)(L + LDS_MISC);
    if (c.tid < 4) MISC[c.tid] = 0u;
    __syncthreads();
    XcdBarrier bar; bar.bar = (unsigned*)(c.ws + WS_CTL) + 1024; bar.x = 0; bar.st = MISC;
    if (hi - lo > 1) bar = xcd_barrier_post((unsigned*)(c.ws + WS_CTL) + 1024, MISC);
    int pc = 0;
#ifndef PHMASK
#define PHMASK 0xFFFF
#endif
#define PHON(k) (((PHMASK) >> (k)) & 1)
#ifndef REPMASK
#define REPMASK 0x0
#endif
#define PH_BEGIN(k) if (PHON(k) && pc >= lo && pc < hi) { { int tz = threadIdx.x; asm volatile("" : "+v"(tz)); c.tid = tz; c.lane = tz & 63; c.wave = __builtin_amdgcn_readfirstlane(tz >> 6); } KArgs ka = kargs(); c.ws = ka->ws; c.out = ka->out; { int b_ = blockIdx.x, g_ = gridDim.x; asm volatile("" : "+s"(b_), "+s"(g_)); c.bid = b_; c.G = g_; } for (int rep_ = 0; rep_ < (((REPMASK) >> (k)) & 1) + 1; ++rep_) { if (rep_) __syncthreads(); c.dry = (rep_ + 1 < (((REPMASK) >> (k)) & 1) + 1);
#ifndef BARREP
#define BARREP 0
#endif
#define PH_END   } if (pc + 1 < hi) { xcd_barrier(bar); if (BARREP) { xcd_barrier(bar); xcd_barrier(bar); } } else { asm volatile("s_waitcnt vmcnt(0)" ::: "memory"); __syncthreads(); } } ++pc;

    for (int layer = 0; layer < 2; ++layer) {
        c.layer = layer;
        PH_BEGIN(0) phase_weights(ka, L, c); PH_END
        for (int slab = 0; slab < NSLAB; ++slab) {
            c.slab = slab; c.nseq = slab < 2 ? 8 : 1; c.seqlen = slab < 2 ? 4096 : 16384; c.stok = slab < 2 ? 32768 : 16384; c.sbase = slab * 32768; const int stok = c.stok; const size_t sbase = (size_t)c.sbase;
            PH_BEGIN(1) {
                { pg8::Gemm g{WSP(bf16_t, WS_XB) + sbase * D, WSP(bf16_t, WS_WIN), stok, 3584, D}; pg8::StaticOrder S; S.init(stok, 3584, c.G, c.bid);
                  pg8::EpiInProj E{BIGP(bf16_t, B_PROJ), BIGP(float, B_BA)};
                  pg8::gemm_phase<pg8::EpiInProj, pg8::StaticOrder>(L, g, S, E); }
                { pg8::Gemm g{(const bf16_t*)(WSP(unsigned char, WS_XB8) + sbase * D), (const bf16_t*)WSP(unsigned char, WS_WG8), stok, 3072, D / 2}; pg8::StaticOrder S; S.init(stok, 3072, c.G, c.bid);
                  pg8::EpiGates E{BIGP(bf16_t, B_PROJ)};
                  pg8::gemm_phase<pg8::EpiGates, pg8::StaticOrder>(L, g, S, E); } } PH_END
            PH_BEGIN(2) phase_mix_a(ka, L, c); PH_END
            PH_BEGIN(3) phase_scan(ka, L, c); PH_END
            PH_BEGIN(4) phase_gdn_out(ka, L, c); PH_END
            PH_BEGIN(5) {
                pg8::StaticOrder S; S.init(stok, D, c.G, c.bid);
                pg8::Gemm g{BIGP(bf16_t, B_ONA), WSP(bf16_t, WS_WBR), stok, D, 768}; pg8::EpiGateCat E{BIGP(bf16_t, B_PROJ), BIGP(bf16_t, B_MERGED)};
                pg8::gemm_phase<pg8::EpiGateCat, pg8::StaticOrder>(L, g, S, E); } PH_END
            PH_BEGIN(6) {
                pg8::Gemm g{BIGP(bf16_t, B_MERGED), WSP(bf16_t, WS_WOUT), stok, D, D}; pg8::StaticOrder S; S.init(stok, D, c.G, c.bid);
                pg8::EpiRes E{WSP(bf16_t, WS_XB) + sbase * D, (bf16_t*)c.out + sbase * D};
                pg8::gemm_phase<pg8::EpiRes, pg8::StaticOrder>(L, g, S, E); } PH_END
#ifndef LN1PROBE
#define LN1PROBE 0
#endif
            PH_BEGIN(7) if (LN1PROBE) { c.dry = 1; phase_ln1(ka, L, c); __syncthreads(); c.dry = 0; } phase_ln1(ka, L, c); PH_END
        }
        PH_BEGIN(8) phase_select(ka, L, c, c.bid < 16 ? 16 + c.bid : -1); PH_END
        PH_BEGIN(9) phase_gather(ka, L, c); PH_END
        for (int half = 0; half < 2; ++half) {
            PH_BEGIN(10) {
                pg8::Gemm g{BIGP(bf16_t, half ? B_XY1 : B_XY0), (const bf16_t*)(WSP(unsigned char, WS_WGU) + (size_t)half * 8 * 4096 * D), 8 * CAP, 8 * 4096, D / 2}; pg8::MoeOrder S; S.init(8, CAP / 256, 16, c.G, c.bid);
                pg8::EpiSwiglu E{BIGP(unsigned char, B_HID)};
                pg8::gemm_phase<pg8::EpiSwiglu, pg8::MoeOrder>(L, g, S, E); } PH_END
            PH_BEGIN(11) {
                pg8::Gemm g{BIGP(bf16_t, B_HID), (const bf16_t*)(WSP(unsigned char, WS_WD) + (size_t)half * 8 * D * DE), 8 * CAP, 8 * D, DE / 2}; pg8::MoeOrder S; S.init(8, CAP / 256, 4, c.G, c.bid);
                pg8::EpiDown E{BIGP(bf16_t, half ? B_XY1 : B_XY0), WSP(float, WS_GATEV) + (size_t)half * 8 * CAP};
                pg8::gemm_phase<pg8::EpiDown, pg8::MoeOrder>(L, g, S, E); } PH_END
        }
        PH_BEGIN(12) phase_ln2(ka, L, c); PH_END
    }
#undef PH_BEGIN
#undef PH_END
}

constexpr int N_PHASES = 2 * (1 + NSLAB * 7 + 2 + 4 + 1);

extern "C" void kernel_launch(void* const* d_in, const int* in_sizes, int n_in, void* d_out, int out_size, void* d_ws, size_t ws_size, hipStream_t stream) {
    static int grid = 0;
    if (grid == 0) {
        if (n_in != 20 || ws_size < WS_END) { fprintf(stderr, "kernel_launch: unexpected n_in %d or ws_size %zu (< %zu)\n", n_in, ws_size, (size_t)WS_END); grid = -1; return; }
        int dev = 0, cus = 0, per_cu = 0;
        if (hipGetDevice(&dev) != hipSuccess || hipDeviceGetAttribute(&cus, hipDeviceAttributeMultiprocessorCount, dev) != hipSuccess) { grid = -1; return; }
        if (hipFuncSetAttribute((const void*)fwd_kernel, hipFuncAttributeMaxDynamicSharedMemorySize, LDS_BYTES) != hipSuccess) { fprintf(stderr, "kernel_launch: hipFuncSetAttribute failed\n"); grid = -1; return; }
        if (hipOccupancyMaxActiveBlocksPerMultiprocessor(&per_cu, (const void*)fwd_kernel, 512, LDS_BYTES) != hipSuccess || per_cu < 1) fprintf(stderr, "kernel_launch: occupancy query says %d\n", per_cu);
        (void)hipGetLastError();
        grid = cus;
    }
    if (grid < 0) return;
    (void)hipMemsetAsync((char*)d_ws + WS_CTL, 0, 1 * MiB, stream);
    Args a{};
    for (int i = 0; i < 20; ++i) a.in[i] = (const float*)d_in[i];
    a.out = (float*)d_out; a.ws = (unsigned char*)d_ws;
#if MK_N_LAUNCHES == 1
    a.ph_lo = 0; a.ph_hi = N_PHASES;
    hipLaunchKernelGGL(fwd_kernel, dim3(grid), dim3(512), LDS_BYTES, stream, a);
#else
    for (int p = 0; p < N_PHASES; ++p) { a.ph_lo = p; a.ph_hi = p + 1; hipLaunchKernelGGL(fwd_kernel, dim3(grid), dim3(512), LDS_BYTES, stream, a); }
#endif
}
```

```cpp
#include <hip/hip_runtime.h>
#include <stdint.h>
#include <stdio.h>

#define LAS __attribute__((address_space(3)))
#define DI __device__ __forceinline__
typedef unsigned short bf16_t;
typedef short bf16x8 __attribute__((ext_vector_type(8)));
typedef float f32x4 __attribute__((ext_vector_type(4)));
typedef float f32x2 __attribute__((ext_vector_type(2)));
typedef float f32x16 __attribute__((ext_vector_type(16)));
typedef unsigned u32x4 __attribute__((ext_vector_type(4)));
typedef unsigned u32x2 __attribute__((ext_vector_type(2)));
typedef __bf16 bf16x2v __attribute__((ext_vector_type(2)));

#ifndef MK_N_LAUNCHES
#define MK_N_LAUNCHES 1
#endif

constexpr int D = 1024, T_ALL = 81920, T_P = 65536, T_S = 16384, SLABMAX = 32768, NSLAB = 3;
constexpr int DIN = 6552, NPROJ = 3584;
constexpr int C_QA = 0, C_KA = 256, C_VA = 512, C_QD = 768, C_KD = 1152, C_VD = 1536, C_QC = 1920, C_KC = 2304, C_VC = 2688, C_ZC = 3072;
constexpr int NE = 16, DE = 2048, CAP_P = 8192, CAP_S = 2048, CAP = CAP_P + CAP_S;
constexpr float ALPHA = 1.41421356237f, LN_EPS = 1e-5f, NORM_EPS = 1e-6f;
constexpr size_t MiB = 1u << 20;
constexpr size_t WS_CTL = 0, WS_WIN = 1 * MiB, WS_WBR = 14 * MiB, WS_WOUT = 16 * MiB, WS_WGU = 18 * MiB, WS_WD = 82 * MiB, WS_XB8 = 114 * MiB, WS_WG8 = 194 * MiB, WS_XB = 210 * MiB;
constexpr size_t WS_AFF = 370 * MiB, WS_SLOT = 375 * MiB, WS_IDX = 380 * MiB, WS_GATEV = 381 * MiB, WS_CS = 382 * MiB, WS_BIG = 386 * MiB, WS_END = 1130 * MiB;
constexpr size_t B_PROJ = 0, B_GATES = 224 * MiB, B_BA = 416 * MiB, B_ONA = 420 * MiB, B_ODIL = 436 * MiB, B_OGDN = 452 * MiB, B_DILP = 476 * MiB, B_DILM = 500 * MiB, B_GSCR = 502 * MiB, B_MERGEF = 502 * MiB, B_MERGED = 630 * MiB;
constexpr size_t B_XY0 = 0, B_XY1 = 160 * MiB, B_HID = 320 * MiB;
constexpr int GSTRIDE = 41216;
constexpr int LDS_BYTES = 147456;
constexpr int LDS_MISC = 145408;

DI unsigned pk2(float lo, float hi) { f32x2 v = {lo, hi}; bf16x2v b = __builtin_convertvector(v, bf16x2v); return __builtin_bit_cast(unsigned, b); }
DI unsigned pk4_fp8(float a, float b, float c, float d) {
    int w = __builtin_amdgcn_cvt_pk_fp8_f32(a, b, 0, false); w = __builtin_amdgcn_cvt_pk_fp8_f32(c, d, w, true); return (unsigned)w; }
DI float bflo(unsigned u) { return __uint_as_float(u << 16); }
DI float bfhi(unsigned u) { return __uint_as_float(u & 0xffff0000u); }
DI float frcp(float x) { return __builtin_amdgcn_rcpf(x); }
DI float frsq(float x) { return __builtin_amdgcn_rsqf(x); }
DI float sigmoidf_(float x) { return frcp(1.0f + __expf(-x)); }
DI float siluf_(float x) { return x * frcp(1.0f + __expf(-x)); }
DI float wave_sum(float v) {
#pragma unroll
    for (int o = 1; o < 64; o <<= 1) v += __shfl_xor(v, o);
    return v;
}
#define MFMA32(a, b, c) __builtin_amdgcn_mfma_f32_32x32x16_bf16((a), (b), (c), 0, 0, 0)
DI int crow(int reg, int h) { return (reg & 3) + 8 * (reg >> 2) + 4 * h; }
DI f32x16 zero16() { f32x16 z; for (int i = 0; i < 16; ++i) z[i] = 0.f; return z; }
template <int S> DI bf16x8 pack8(const f32x16& x) {
    u32x4 p; p[0] = pk2(x[8 * S], x[8 * S + 1]); p[1] = pk2(x[8 * S + 2], x[8 * S + 3]); p[2] = pk2(x[8 * S + 4], x[8 * S + 5]); p[3] = pk2(x[8 * S + 6], x[8 * S + 7]);
    return __builtin_bit_cast(bf16x8, p);
}

namespace pg8 {
constexpr int BM = 256, BK = 64, HALF = 128, HTB = HALF * BK * 2, STAGE_BYTES = 8 * HTB, NXCD = 8, WGM = 8;
__host__ __device__ __forceinline__ int lds_byte(int r, int c) { const int st = (r >> 4) * 2 + (c >> 5), rr = r & 15, cc = c & 31, ob = rr * 64 + cc * 2; return st * 1024 + (ob ^ (((ob >> 9) & 1) << 5)); }
__host__ __device__ __forceinline__ void stage_rc(int b, int& R, int& C) { const int st = b / 1024, sb = b % 1024, swz = sb ^ (((sb >> 9) & 1) << 5); R = (st >> 1) * 16 + swz / 64; C = (st & 1) * 32 + (swz % 64) / 2; }
__host__ __device__ __forceinline__ int perm32(int rho) { const int n = rho >> 4, i = rho & 15; return 8 * (i >> 2) + 4 * n + (i & 3); }
struct Unit { int pm, pn; };
struct Gemm { const bf16_t* A; const bf16_t* Bt; int M, N, K; };
struct StaticOrder {
    int nM, nN, nwg, G, c;
    __device__ void init(int M, int N, int G_, int c_) { nM = M / BM; nN = N / BM; nwg = nM * nN; G = G_; c = c_; }
    __device__ bool next(int i, Unit& u) const {
        const long L = (long)i * G + c; if (L >= nwg) return false;
        int wgid = (int)L; { const int q = nwg / NXCD, r = nwg % NXCD, xcd = wgid % NXCD, off = wgid / NXCD; wgid = (xcd < r ? xcd * (q + 1) : r * (q + 1) + (xcd - r) * q) + off; }
        const int nig = WGM * nN, gid = wgid / nig, fm = gid * WGM, gsz = (nM - fm) < WGM ? (nM - fm) : WGM;
        u.pm = fm + ((wgid % nig) % gsz); u.pn = (wgid % nig) / gsz; return true;
    }
    __device__ __forceinline__ void a_ready(const Unit&) const {}
    __device__ __forceinline__ void done(const Unit&) const {}
};
struct MoeOrder {
    int nMe, nNe, per, total, G, c, xr, xc, rpx, cpx, share;
    __device__ void init(int nE, int nMe_, int nNe_, int G_, int c_) { nMe = nMe_; nNe = nNe_; per = nMe * nNe; total = nE * per; G = G_; c = c_;
        xc = (nNe % 2 == 0 && nNe >= 8) ? 2 : 1; xr = 8 / xc; rpx = nMe / xr; cpx = nNe / xc; share = rpx * cpx; }
    __device__ bool next(int i, Unit& u) const {
        if ((G & 7) == 0 && nMe % xr == 0) {
            const int x = c & 7, q = c >> 3, nq = G >> 3; const long j = (long)i * nq + q; if (j >= (long)(total / 8)) return false;
            const int e = (int)(j / share), r = (int)(j % share); const int pm = (x / xc) * rpx + r % rpx, pn = (x % xc) * cpx + r / rpx;
            u.pm = e * nMe + pm; u.pn = e * nNe + pn; return true;
        }
        const long L = (long)i * G + c; if (L >= total) return false;
        const int e = (int)(L / per), r = (int)(L % per);
        u.pm = e * nMe + r % nMe; u.pn = e * nNe + r / nMe; return true;
    }
    __device__ __forceinline__ void a_ready(const Unit&) const {}
    __device__ __forceinline__ void done(const Unit&) const {}
};

template <class Epi, class Sched>
__device__ __forceinline__ void gemm_phase(LAS unsigned char* lds, const Gemm g, const Sched& S, const Epi& E) {
    int tid = threadIdx.x; asm volatile("" : "+v"(tid));
    const int wid = __builtin_amdgcn_readfirstlane(tid >> 6), lane = tid & 63, wr = wid >> 2, wc = wid & 3, fr = lane & 15, fq = lane >> 4;
    int Kv = g.K; asm volatile("" : "+s"(Kv));
    const int K = Kv, nt = K / BK;
    unsigned voffA[2], voffB[2];
#pragma unroll
    for (int i = 0; i < 2; ++i) { int R, C; stage_rc(tid * 16 + i * 8192, R, C); const int Rb = Epi::PERM ? ((R & ~31) + perm32(R & 31)) : R;
        voffA[i] = (unsigned)(R * K + C) * 2u; voffB[i] = (unsigned)(Rb * K + C) * 2u; }
    const size_t kstep = (size_t)(BK * 2);
    const size_t hstep = (size_t)HALF * K * 2;
    const size_t tstep = 2 * hstep;
    const unsigned ldsw = (unsigned)wid * 1024u;
    const int aoff = lds_byte(wr * 64 + fr, fq * 8), boff = lds_byte(wc * 32 + fr, fq * 8);
#define PG8_SA(b, h) (((b) * 2 + (h)) * HTB)
#define PG8_SB(b, h) ((4 + (b) * 2 + (h)) * HTB)
#define PG8_STAGE(bufoff, gbase, voff) do { _Pragma("unroll") for (int _i = 0; _i < 2; ++_i) \
        __builtin_amdgcn_global_load_lds((const unsigned*)((const char*)(gbase) + (voff)[_i]), (LAS unsigned*)(lds + (bufoff) + ldsw + _i * 8192), 16, 0, 0); } while (0)
#define PG8_LD8(p) __builtin_shufflevector(*(const LAS v4i_*)(p), *(const LAS v4i_*)((p) + 1024), 0, 1, 2, 3, 4, 5, 6, 7)
#define PG8_LDA(dst, b, h) do { _Pragma("unroll") for (int m = 0; m < 4; ++m) { if constexpr (Epi::FP8) dst##8[m] = PG8_LD8(lds + PG8_SA(b, h) + aoff + m * 2048); \
        else { _Pragma("unroll") for (int k = 0; k < 2; ++k) dst[m][k] = *(const LAS bf16x8*)(lds + PG8_SA(b, h) + aoff + m * 2048 + k * 1024); } } } while (0)
#define PG8_LDB(dst, b, h) do { _Pragma("unroll") for (int n = 0; n < 2; ++n) { if constexpr (Epi::FP8) dst##8[n] = PG8_LD8(lds + PG8_SB(b, h) + boff + n * 2048); \
        else { _Pragma("unroll") for (int k = 0; k < 2; ++k) dst[n][k] = *(const LAS bf16x8*)(lds + PG8_SB(b, h) + boff + n * 2048 + k * 1024); } } } while (0)
#define PG8_MMA(ai, bj, At, Bt) do { __builtin_amdgcn_s_setprio(1); _Pragma("unroll") for (int m = 0; m < 4; ++m) _Pragma("unroll") for (int n = 0; n < 2; ++n) { \
        if constexpr (Epi::FP8) asm volatile("v_mfma_scale_f32_16x16x128_f8f6f4 %0, %1, %2, %0, %3, %3 op_sel_hi:[0,0,0]" : "+v"(acc[ai][bj][m][n]) : "v"(Bt##8[n]), "v"(At##8[m]), "v"(fp8_unit_scale));   \
        else { _Pragma("unroll") for (int k = 0; k < 2; ++k) acc[ai][bj][m][n] = __builtin_amdgcn_mfma_f32_16x16x32_bf16(Bt[n][k], At[m][k], acc[ai][bj][m][n], 0, 0, 0); } } \
        __builtin_amdgcn_s_setprio(0); } while (0)
#define PG8_WAIT_V(n) asm volatile("s_waitcnt vmcnt(" #n ")" ::: "memory")
#define PG8_WAIT_L(n) asm volatile("s_waitcnt lgkmcnt(" #n ")" ::: "memory")
#define PG8_BAR __builtin_amdgcn_s_barrier()
#define PG8_SCHED __builtin_amdgcn_sched_barrier(0)
    Unit cur, nxt; int ui = 0;
    if (!S.next(0, cur)) return;
    f32x4 acc[2][2][4][2];
#pragma unroll
    for (int a = 0; a < 2; ++a)
#pragma unroll
        for (int b = 0; b < 2; ++b)
#pragma unroll
            for (int m = 0; m < 4; ++m)
#pragma unroll
                for (int n = 0; n < 2; ++n) acc[a][b][m][n] = (f32x4){0.f, 0.f, 0.f, 0.f};
    typedef int v4i_ __attribute__((ext_vector_type(4))); typedef int v8i_ __attribute__((ext_vector_type(8)));
    bf16x8 At[4][2], B0[2][2], B1[2][2]; v8i_ At8[4], B08[2], B18[2];
    int fp8_unit_scale = 0x7F7F7F7F; asm volatile("" : "+v"(fp8_unit_scale));
    const char* cA = (const char*)g.A + (size_t)cur.pm * tstep; const char* cB = (const char*)g.Bt + (size_t)cur.pn * tstep;
    S.a_ready(cur);
    PG8_STAGE(PG8_SB(0, 0), cB, voffB); PG8_STAGE(PG8_SA(0, 0), cA, voffA); PG8_STAGE(PG8_SB(0, 1), cB + hstep, voffB); PG8_STAGE(PG8_SA(0, 1), cA + hstep, voffA);
    if (wr == 1) PG8_BAR;
    PG8_WAIT_V(4); PG8_BAR;
    PG8_STAGE(PG8_SB(1, 0), cB + kstep, voffB); PG8_STAGE(PG8_SA(1, 0), cA + kstep, voffA); PG8_STAGE(PG8_SB(1, 1), cB + hstep + kstep, voffB);
    PG8_WAIT_V(6); PG8_BAR;
    for (;;) {
        const bool has_next = S.next(ui + 1, nxt);
        const char* nA = has_next ? (const char*)g.A + (size_t)nxt.pm * tstep : cA; const char* nB = has_next ? (const char*)g.Bt + (size_t)nxt.pn * tstep : cB;
        for (int t = 0; t < nt; t += 2) {
            const bool last = (t == nt - 2);
            const char* a1 = cA + (size_t)(t + 1) * kstep;
            const char* a2 = last ? nA : cA + (size_t)(t + 2) * kstep; const char* b2 = last ? nB : cB + (size_t)(t + 2) * kstep;
            const char* a3 = a2 + kstep; const char* b3 = b2 + kstep;
            if (last && has_next) S.a_ready(nxt);
            if constexpr (Epi::SEG) { if (t == 4 || t == 6) { int tz = tid; asm volatile("" : "+v"(tz)); const int wz = __builtin_amdgcn_readfirstlane(tz >> 6), lz = tz & 63; E.mid(acc, cur, t == 4 ? 0 : 1, wz >> 2, wz & 3, lz & 15, lz >> 4); } }
            PG8_LDB(B0, 0, 0); PG8_SCHED; PG8_LDA(At, 0, 0); PG8_STAGE(PG8_SA(1, 1), a1 + hstep, voffA);
            PG8_WAIT_L(8); PG8_BAR; PG8_WAIT_L(0); PG8_MMA(0, 0, At, B0); PG8_BAR; PG8_SCHED;
            PG8_LDB(B1, 0, 1); PG8_STAGE(PG8_SB(0, 0), b2, voffB);
            PG8_BAR; PG8_WAIT_L(0); PG8_MMA(0, 1, At, B1); PG8_BAR;
            PG8_LDA(At, 0, 1); PG8_STAGE(PG8_SA(0, 0), a2, voffA);
            PG8_BAR; PG8_WAIT_L(0); PG8_MMA(1, 0, At, B0); PG8_BAR; PG8_SCHED;
            PG8_STAGE(PG8_SB(0, 1), b2 + hstep, voffB);
            PG8_WAIT_V(6); PG8_BAR; PG8_MMA(1, 1, At, B1); PG8_BAR;
            PG8_LDB(B0, 1, 0); PG8_SCHED; PG8_LDA(At, 1, 0); PG8_STAGE(PG8_SA(0, 1), a2 + hstep, voffA);
            PG8_WAIT_L(8); PG8_BAR; PG8_WAIT_L(0); PG8_MMA(0, 0, At, B0); PG8_BAR; PG8_SCHED;
            PG8_LDB(B1, 1, 1); PG8_STAGE(PG8_SB(1, 0), b3, voffB);
            PG8_BAR; PG8_WAIT_L(0); PG8_MMA(0, 1, At, B1); PG8_BAR;
            PG8_LDA(At, 1, 1); PG8_STAGE(PG8_SA(1, 0), a3, voffA);
            PG8_BAR; PG8_WAIT_L(0); PG8_MMA(1, 0, At, B0); PG8_BAR; PG8_SCHED;
            PG8_STAGE(PG8_SB(1, 1), b3 + hstep, voffB);
            PG8_WAIT_V(6); PG8_BAR; PG8_MMA(1, 1, At, B1); PG8_BAR;
        }
        if constexpr (Epi::FP8) asm volatile("s_nop 15\n\ts_nop 15\n\ts_nop 15" ::: "memory");
        { int tz = tid; asm volatile("" : "+v"(tz)); const int wz = __builtin_amdgcn_readfirstlane(tz >> 6), lz = tz & 63;
          E(acc, cur, wz >> 2, wz & 3, lz & 15, lz >> 4); } S.done(cur);
        if (!has_next) break;
#pragma unroll
        for (int a = 0; a < 2; ++a)
#pragma unroll
            for (int b = 0; b < 2; ++b)
#pragma unroll
                for (int m = 0; m < 4; ++m)
#pragma unroll
                    for (int n = 0; n < 2; ++n) acc[a][b][m][n] = (f32x4){0.f, 0.f, 0.f, 0.f};
        cur = nxt; cA = nA; cB = nB; ++ui;
    }
    PG8_WAIT_V(0);
    if (wr == 0) PG8_BAR;
    PG8_BAR;
#undef PG8_SA
#undef PG8_SB
#undef PG8_STAGE
#undef PG8_LDA
#undef PG8_LD8
#undef PG8_LDB
#undef PG8_MMA
#undef PG8_WAIT_V
#undef PG8_WAIT_L
#undef PG8_BAR
#undef PG8_SCHED
}

struct EpiInProj {
    static constexpr bool PERM = true, SEG = false, FP8 = false;
    bf16_t* O; float* BA;
    __device__ __forceinline__ void operator()(const f32x4 (&acc)[2][2][4][2], const Unit& u, int wr, int wc, int fr, int fq) const {
        const int row0 = u.pm * BM + wr * 64 + fr, col0 = u.pn * BM + wc * 32 + 8 * fq;
        const bool sig = false, ba = (u.pn == 13) && (wc == 0) && (fq < 3);
#pragma unroll
        for (int ai = 0; ai < 2; ++ai)
#pragma unroll
            for (int m = 0; m < 4; ++m) { int row = row0 + ai * HALF + m * 16; asm volatile("" : "+v"(row)); bf16_t* rowp = O + (size_t)row * NPROJ + col0;
#pragma unroll
                for (int bj = 0; bj < 2; ++bj) { f32x4 v0 = acc[ai][bj][m][0], v1 = acc[ai][bj][m][1];
                    if (sig) {
#pragma unroll
                        for (int j = 0; j < 4; ++j) { v0[j] = sigmoidf_(v0[j]); v1[j] = sigmoidf_(v1[j]); } }
                    u32x4 w; w.x = pk2(v0[0], v0[1]); w.y = pk2(v0[2], v0[3]); w.z = pk2(v1[0], v1[1]); w.w = pk2(v1[2], v1[3]);
                    *(u32x4*)(rowp + bj * HALF) = w;
                    if (bj == 1 && ba) { float* bp = BA + (size_t)row * 32 + 8 * fq; *(f32x4*)bp = v0; *(f32x4*)(bp + 4) = v1; } } }
    }
};
struct EpiGates {
    static constexpr bool PERM = true, SEG = false, FP8 = true;
    u32x4* G;
    __device__ __forceinline__ void operator()(const f32x4 (&acc)[2][2][4][2], const Unit& u, int wr, int wc, int fr, int fq) const {
#pragma unroll
        for (int ai = 0; ai < 2; ++ai)
#pragma unroll
            for (int m = 0; m < 4; ++m) {
                unsigned boff = (unsigned)(((u.pm * 12 + u.pn) * (16 * 512) + ((wr * 4 + wc) * 64 + fq * 16 + fr)) * 16 + ((ai * 4 + m) * 2) * 8192); asm volatile("" : "+v"(boff));
#pragma unroll
                for (int bj = 0; bj < 2; ++bj) { f32x4 v0 = acc[ai][bj][m][0] * 0.03125f, v1 = acc[ai][bj][m][1] * 0.03125f;
#pragma unroll
                    for (int j = 0; j < 4; ++j) { v0[j] = sigmoidf_(v0[j]); v1[j] = sigmoidf_(v1[j]); }
                    u32x4 w; w.x = pk2(v0[0], v0[1]); w.y = pk2(v0[2], v0[3]); w.z = pk2(v1[0], v1[1]); w.w = pk2(v1[2], v1[3]);
                    *(u32x4*)((unsigned char*)G + (boff + bj * 8192)) = w; }
                asm volatile("" ::: "memory"); }
    }
};
struct EpiGateCat {
    static constexpr bool PERM = true, SEG = true, FP8 = false;
    const u32x4* GT; bf16_t* MB;
    __device__ __forceinline__ void mid(f32x4 (&acc)[2][2][4][2], const Unit& u, int seg, int wr, int wc, int fr, int fq) const {
#pragma unroll
        for (int ai = 0; ai < 2; ++ai) {
            int toff = (wr * 4 + wc) * 64 + fq * 16 + fr; asm volatile("" : "+v"(toff));
            const u32x4* ga = GT + ((size_t)u.pm * 12 + seg * 4 + u.pn) * (16 * 512) + toff; const u32x4* gb = ga + (size_t)4 * 16 * 512;
            u32x4 A_[4][2], B_[4][2];
#pragma unroll
            for (int m = 0; m < 4; ++m)
#pragma unroll
                for (int bj = 0; bj < 2; ++bj) { A_[m][bj] = ga[((ai * 4 + m) * 2 + bj) * 512]; B_[m][bj] = gb[((ai * 4 + m) * 2 + bj) * 512]; }
#pragma unroll
            for (int m = 0; m < 4; ++m)
#pragma unroll
                for (int bj = 0; bj < 2; ++bj) { const u32x4 a_ = A_[m][bj], b_ = B_[m][bj]; f32x4& v0 = acc[ai][bj][m][0]; f32x4& v1 = acc[ai][bj][m][1];
                    v0[0] *= bflo(a_.x) * frcp(bflo(b_.x)); v0[1] *= bfhi(a_.x) * frcp(bfhi(b_.x)); v0[2] *= bflo(a_.y) * frcp(bflo(b_.y)); v0[3] *= bfhi(a_.y) * frcp(bfhi(b_.y));
                    v1[0] *= bflo(a_.z) * frcp(bflo(b_.z)); v1[1] *= bfhi(a_.z) * frcp(bfhi(b_.z)); v1[2] *= bflo(a_.w) * frcp(bflo(b_.w)); v1[3] *= bfhi(a_.w) * frcp(bfhi(b_.w)); }
            asm volatile("" ::: "memory"); }
    }
    __device__ __forceinline__ void operator()(const f32x4 (&acc)[2][2][4][2], const Unit& u, int wr, int wc, int fr, int fq) const {
        const int row0 = u.pm * BM + wr * 64 + fr, col0 = u.pn * BM + wc * 32 + 8 * fq;
#pragma unroll
        for (int ai = 0; ai < 2; ++ai) {
            int rowb = row0 + ai * HALF; asm volatile("" : "+v"(rowb)); bf16_t* mp0 = MB + (size_t)rowb * D + col0;
            int toff = (wr * 4 + wc) * 64 + fq * 16 + fr; asm volatile("" : "+v"(toff));
            const u32x4* gc = GT + ((size_t)u.pm * 12 + 8 + u.pn) * (16 * 512) + toff;
            u32x4 gw[4][2];
#pragma unroll
            for (int m = 0; m < 4; ++m)
#pragma unroll
                for (int bj = 0; bj < 2; ++bj) gw[m][bj] = gc[((ai * 4 + m) * 2 + bj) * 512];
#pragma unroll
            for (int m = 0; m < 4; ++m)
#pragma unroll
                for (int bj = 0; bj < 2; ++bj) { const u32x4 g_ = gw[m][bj]; const f32x4 v0 = acc[ai][bj][m][0], v1 = acc[ai][bj][m][1]; u32x4 w;
                    w.x = pk2(v0[0] * bflo(g_.x), v0[1] * bfhi(g_.x)); w.y = pk2(v0[2] * bflo(g_.y), v0[3] * bfhi(g_.y)); w.z = pk2(v1[0] * bflo(g_.z), v1[1] * bfhi(g_.z)); w.w = pk2(v1[2] * bflo(g_.w), v1[3] * bfhi(g_.w));
                    *(u32x4*)(mp0 + (size_t)(m * 16) * D + bj * HALF) = w; }
            asm volatile("" ::: "memory"); }
    }
};
struct EpiRes {
    static constexpr bool PERM = true, SEG = false, FP8 = false;
    const bf16_t* XR; bf16_t* H;
    __device__ __forceinline__ void operator()(const f32x4 (&acc)[2][2][4][2], const Unit& u, int wr, int wc, int fr, int fq) const {
        const int row0 = u.pm * BM + wr * 64 + fr, col0 = u.pn * BM + wc * 32 + 8 * fq;
#pragma unroll
        for (int ai = 0; ai < 2; ++ai) {
            int rowb = row0 + ai * HALF; asm volatile("" : "+v"(rowb)); const size_t off0 = (size_t)rowb * D + col0;
            u32x4 xr[4][2];
#pragma unroll
            for (int m = 0; m < 4; ++m)
#pragma unroll
                for (int bj = 0; bj < 2; ++bj) xr[m][bj] = *(const u32x4*)(XR + off0 + (size_t)(m * 16) * D + bj * HALF);
#pragma unroll
            for (int m = 0; m < 4; ++m)
#pragma unroll
                for (int bj = 0; bj < 2; ++bj) { const u32x4 x = xr[m][bj]; const f32x4 v0 = acc[ai][bj][m][0], v1 = acc[ai][bj][m][1]; u32x4 w;
                    w.x = pk2(bflo(x.x) * ALPHA + v0[0], bfhi(x.x) * ALPHA + v0[1]); w.y = pk2(bflo(x.y) * ALPHA + v0[2], bfhi(x.y) * ALPHA + v0[3]);
                    w.z = pk2(bflo(x.z) * ALPHA + v1[0], bfhi(x.z) * ALPHA + v1[1]); w.w = pk2(bflo(x.w) * ALPHA + v1[2], bfhi(x.w) * ALPHA + v1[3]);
                    *(u32x4*)(H + off0 + (size_t)(m * 16) * D + bj * HALF) = w; }
            asm volatile("" ::: "memory"); }
    }
};
struct EpiSwiglu {
    static constexpr bool PERM = true, SEG = false, FP8 = true;
    unsigned char* HID;
    __device__ __forceinline__ void operator()(const f32x4 (&acc)[2][2][4][2], const Unit& u, int wr, int wc, int fr, int fq) const {
        const int row0 = u.pm * BM + wr * 64 + fr, col0 = (u.pn & 15) * 128 + wc * 32 + 8 * fq;
#pragma unroll
        for (int ai = 0; ai < 2; ++ai)
#pragma unroll
            for (int m = 0; m < 4; ++m) { const f32x4 g0 = acc[ai][0][m][0] * 0.03125f, g1 = acc[ai][0][m][1] * 0.03125f, u0 = acc[ai][1][m][0] * 0.03125f, u1 = acc[ai][1][m][1] * 0.03125f;
                f32x4 h0, h1;
#pragma unroll
                for (int j = 0; j < 4; ++j) { h0[j] = siluf_(g0[j]) * u0[j]; h1[j] = siluf_(g1[j]) * u1[j]; }
                u32x2 w; w.x = pk4_fp8(h0[0], h0[1], h0[2], h0[3]); w.y = pk4_fp8(h1[0], h1[1], h1[2], h1[3]);
                int rowi = row0 + ai * HALF + m * 16; asm volatile("" : "+v"(rowi));
                *(u32x2*)(HID + (size_t)rowi * DE + col0) = w; asm volatile("" ::: "memory"); }
    }
};
struct EpiDown {
    static constexpr bool PERM = true, SEG = false, FP8 = true;
    bf16_t* Y; const float* GV;
    __device__ __forceinline__ void operator()(const f32x4 (&acc)[2][2][4][2], const Unit& u, int wr, int wc, int fr, int fq) const {
        const int row0 = u.pm * BM + wr * 64 + fr, col0 = (u.pn & 3) * BM + wc * 32 + 8 * fq;
        float gvs[2][4];
#pragma unroll
        for (int ai = 0; ai < 2; ++ai)
#pragma unroll
            for (int m = 0; m < 4; ++m) gvs[ai][m] = GV[row0 + ai * HALF + m * 16];
#pragma unroll
        for (int ai = 0; ai < 2; ++ai)
#pragma unroll
            for (int m = 0; m < 4; ++m) { int row = row0 + ai * HALF + m * 16; asm volatile("" : "+v"(row)); const float gv = gvs[ai][m] * 0.03125f;
#pragma unroll
                for (int bj = 0; bj < 2; ++bj) { const f32x4 v0 = acc[ai][bj][m][0] * gv, v1 = acc[ai][bj][m][1] * gv;
                    u32x4 w; w.x = pk2(v0[0], v0[1]); w.y = pk2(v0[2], v0[3]); w.z = pk2(v1[0], v1[1]); w.w = pk2(v1[2], v1[3]);
                    *(u32x4*)(Y + (size_t)row * D + col0 + bj * HALF) = w; } }
    }
};
}

#define XB_TMO      128
#define XB_XCNT(j)  (256  + 64 * (j))
#define XB_XSUB(j)  (1280 + 64 * (j))
#define XB_XGEN(j)  (2304 + 64 * (j))
#define XB_TOP      3328
#define XB_TOPGEN   3392
#define XCD_BAR_WORDS 3456
#define XB_SPIN_CAP (1u << 22)
__device__ __forceinline__ unsigned xb_ld(unsigned* p)              { return __hip_atomic_load(p, __ATOMIC_RELAXED, __HIP_MEMORY_SCOPE_AGENT); }
__device__ __forceinline__ unsigned xb_add(unsigned* p, unsigned v) { return __hip_atomic_fetch_add(p, v, __ATOMIC_RELAXED, __HIP_MEMORY_SCOPE_AGENT); }
__device__ __forceinline__ unsigned xb_xcc_id() { return (unsigned)__builtin_amdgcn_s_getreg((3 << 11) | 20) & 0xFu; }
#define XB_SPIN(cond, bar) do { unsigned _sp = 0; while (cond) { __builtin_amdgcn_s_sleep(1); \
    if ((++_sp & 255u) == 0u) { if (xb_ld(&(bar)[XB_TMO])) break; if (_sp > XB_SPIN_CAP) { atomicAdd(&(bar)[XB_TMO], 1u); break; } } } } while (0)
struct XcdBarrier { unsigned* bar; unsigned x; volatile LAS unsigned* st; };
__device__ __forceinline__ XcdBarrier xcd_barrier_post(unsigned* bar, volatile LAS unsigned* st) {
    XcdBarrier b; b.bar = bar; b.x = xb_xcc_id(); b.st = st;
    if (threadIdx.x == 0) (void)xb_add(&bar[XB_XCNT(b.x)], 1u);
    return b;
}
__device__ __forceinline__ void xcd_barrier_complete(unsigned* bar, unsigned x, unsigned& nloc, unsigned& nx) {
    const unsigned G = gridDim.x * gridDim.y * gridDim.z;
    unsigned sum, cnt, mine, sp = 0u;
    for (;;) {
        sum = 0u; cnt = 0u; mine = 0u;
#pragma unroll
        for (unsigned j = 0; j < 16; ++j) { const unsigned c = xb_ld(&bar[XB_XCNT(j)]); sum += c; cnt += (c > 0u) ? 1u : 0u; }
        mine = xb_ld(&bar[XB_XCNT(x)]);
        if (sum == G) break;
        __builtin_amdgcn_s_sleep(1);
        if ((++sp & 255u) == 0u) { if (xb_ld(&bar[XB_TMO])) break; if (sp > XB_SPIN_CAP) { atomicAdd(&bar[XB_TMO], 1u); break; } }
    }
    nloc = mine > 0u ? mine : 1u; nx = cnt > 0u ? cnt : 1u;
}
__device__ __forceinline__ void xcd_barrier(const XcdBarrier& b) {
    asm volatile("s_waitcnt vmcnt(0)" ::: "memory");
    __syncthreads();
    if (threadIdx.x == 0) {
        unsigned* bar = b.bar; asm volatile("" : "+s"(bar));
        __builtin_amdgcn_s_waitcnt(0);
        unsigned nloc = b.st[0], nx = b.st[1];
        if (nloc == 0u) { xcd_barrier_complete(bar, b.x, nloc, nx); b.st[0] = nloc; b.st[1] = nx; }
        const unsigned old = xb_add(&bar[XB_XSUB(b.x)], 1u);
        const unsigned gen = old / nloc;
        if (old + 1u == (gen + 1u) * nloc) {
            __builtin_amdgcn_fence(__ATOMIC_RELEASE, "agent");
            asm volatile("s_waitcnt vmcnt(0)" ::: "memory");
            const unsigned og = xb_add(&bar[XB_TOP], 1u);
            const unsigned tg = og / nx;
            if (og + 1u == (tg + 1u) * nx) xb_add(&bar[XB_TOPGEN], 1u);
            else XB_SPIN(xb_ld(&bar[XB_TOPGEN]) == tg, bar);
            __builtin_amdgcn_fence(__ATOMIC_ACQUIRE, "agent");
            xb_add(&bar[XB_XGEN(b.x)], 1u);
            asm volatile("s_waitcnt vmcnt(0)" ::: "memory");
        } else {
            XB_SPIN(xb_ld(&bar[XB_XGEN(b.x)]) == gen, bar);
            __builtin_amdgcn_fence(__ATOMIC_ACQUIRE, "agent");
            asm volatile("s_waitcnt vmcnt(0)" ::: "memory");
        }
    }
    __syncthreads();
}

struct Args { const float* in[20]; float* out; unsigned char* ws; int ph_lo, ph_hi; };
typedef const __attribute__((address_space(4))) Args* KArgs;
DI KArgs kargs() { KArgs p = (KArgs)__builtin_amdgcn_kernarg_segment_ptr(); asm volatile("" : "+s"(p)); return p; }
struct Ctx {
    float* out; unsigned char* ws;
    int tid, lane, wave, G, bid;
    int layer, slab;
    int nseq, seqlen;
    int stok, sbase;
    int dry;
};
#define WSP(T, off) ((T*)(c.ws + (off)))
#define BIGP(T, off) ((T*)(c.ws + WS_BIG + (off)))

__device__ const float INV_FREQ[32] = {1.000000000e+00f, 7.498942018e-01f, 5.623413324e-01f, 4.216965139e-01f, 3.162277639e-01f, 2.371373773e-01f, 1.778279394e-01f, 1.333521456e-01f, 1.000000015e-01f, 7.498942316e-02f, 5.623413250e-02f, 4.216964915e-02f, 3.162277490e-02f, 2.371373773e-02f, 1.778279431e-02f, 1.333521400e-02f, 9.999999776e-03f, 7.498942316e-03f, 5.623413250e-03f, 4.216964822e-03f, 3.162277630e-03f, 2.371373819e-03f, 1.778279431e-03f, 1.333521446e-03f, 1.000000047e-03f, 7.498941850e-04f, 5.623413017e-04f, 4.216965172e-04f, 3.162277571e-04f, 2.371373703e-04f, 1.778279402e-04f, 1.333521504e-04f};
DI void tr_item(const float* src, long src_ld, int src_col0, int nvalid, int kvalid, bf16_t* dst, long dst_ld, int dst_row0, int k0, LAS float* scr, int lane) {
    float tv[32];
#pragma unroll
    for (int i = 0; i < 32; ++i) { const int kk = 2 * i + (lane >> 5), cc = lane & 31;
        tv[i] = 0.f; if ((k0 + kk) < kvalid && cc < nvalid) tv[i] = src[(size_t)(k0 + kk) * src_ld + src_col0 + cc]; }
#pragma unroll
    for (int i = 0; i < 32; ++i) { const int kk = 2 * i + (lane >> 5), cc = lane & 31; scr[kk * 33 + cc] = tv[i]; }
    asm volatile("s_waitcnt lgkmcnt(0)" ::: "memory");
    const int c8 = lane & 7;
#pragma unroll
    for (int j = 0; j < 4; ++j) { const int n = (lane >> 3) + 8 * j; const LAS float* s = scr + (8 * c8) * 33 + n;
        u32x4 o; o.x = pk2(s[0 * 33], s[1 * 33]); o.y = pk2(s[2 * 33], s[3 * 33]); o.z = pk2(s[4 * 33], s[5 * 33]); o.w = pk2(s[6 * 33], s[7 * 33]);
        *(u32x4*)(dst + (size_t)(dst_row0 + n) * dst_ld + k0 + 8 * c8) = o; }
    asm volatile("s_waitcnt lgkmcnt(0)" ::: "memory");
}
DI void tr_item8(const float* src, long src_ld, int src_col0, int kvalid, unsigned char* dst, long dst_ld, int dst_row0, int k0, float scale, LAS float* scr, int lane) {
    float tv[32];
#pragma unroll
    for (int i = 0; i < 32; ++i) { const int kk = 2 * i + (lane >> 5), cc = lane & 31; tv[i] = 0.f; if ((k0 + kk) < kvalid) tv[i] = src[(size_t)(k0 + kk) * src_ld + src_col0 + cc]; }
#pragma unroll
    for (int i = 0; i < 32; ++i) { const int kk = 2 * i + (lane >> 5), cc = lane & 31; scr[kk * 33 + cc] = tv[i]; }
    asm volatile("s_waitcnt lgkmcnt(0)" ::: "memory");
    const int c8 = lane & 7;
#pragma unroll
    for (int j = 0; j < 4; ++j) { const int n = (lane >> 3) + 8 * j; const LAS float* s = scr + (8 * c8) * 33 + n;
        u32x2 o; o.x = pk4_fp8(s[0 * 33] * scale, s[1 * 33] * scale, s[2 * 33] * scale, s[3 * 33] * scale); o.y = pk4_fp8(s[4 * 33] * scale, s[5 * 33] * scale, s[6 * 33] * scale, s[7 * 33] * scale);
        *(u32x2*)(dst + (size_t)(dst_row0 + n) * dst_ld + k0 + 8 * c8) = o; }
    asm volatile("s_waitcnt lgkmcnt(0)" ::: "memory");
}
DI void phase_weights(KArgs args, LAS unsigned char* lds, const Ctx& c) {
    const int l = c.layer, lane = c.lane;
    LAS float* scr = (LAS float*)(lds + c.wave * 8448);
    const int gw = c.bid * 8 + c.wave, NGW = c.G * 8;
    constexpr int I_IN = 16 * 112 + 16 * 96, I_NA = 4 * 32, I_DIL = 2 * 32, I_GDN = 6 * 32, I_OUT = 16 * 32, I_GU1 = 16 * 128, I_D1 = 32 * 32;
    constexpr int NITEMS = I_IN + I_NA + I_DIL + I_GDN + I_OUT + 16 * I_GU1 + 16 * I_D1;
    for (int it = gw; it < NITEMS; it += NGW) {
        int r = it;
        const float* src; long sld; int sc0, nv = 32, kv; bf16_t* dst; long dld; int dr0, k0;
        if (r < 16 * 112) { const int kb = r / 112, nb = r % 112, n0 = 32 * nb; src = args->in[2] + (size_t)l * D * DIN; sld = DIN; kv = D;
            sc0 = n0; nv = 3480 - n0; if (nv < 0) { nv = 0; sc0 = 0; } if (nv > 32) nv = 32;
            dst = WSP(bf16_t, WS_WIN); dld = D; dr0 = n0; k0 = 64 * kb; }
        else if (r < I_IN) { const int q = r - 16 * 112, kb = q / 96, nb = q % 96;
            tr_item8(args->in[2] + (size_t)l * D * DIN, DIN, 3480 + 32 * nb, D, WSP(unsigned char, WS_WG8), D, 32 * nb, 64 * kb, 32.0f, scr, lane); continue; }
        else if ((r -= I_IN) < I_NA) { const int kb = r / 32, nb = r % 32; src = args->in[8] + (size_t)l * 256 * D; sld = D; sc0 = 32 * nb; kv = 256; dst = WSP(bf16_t, WS_WBR); dld = 768; dr0 = 32 * nb; k0 = 64 * kb; }
        else if ((r -= I_NA) < I_DIL) { const int kb = r / 32, nb = r % 32; src = args->in[9] + (size_t)l * 128 * D; sld = D; sc0 = 32 * nb; kv = 128; dst = WSP(bf16_t, WS_WBR) + 256; dld = 768; dr0 = 32 * nb; k0 = 64 * kb; }
        else if ((r -= I_DIL) < I_GDN) { const int kb = r / 32, nb = r % 32; src = args->in[10] + (size_t)l * 384 * D; sld = D; sc0 = 32 * nb; kv = 384; dst = WSP(bf16_t, WS_WBR) + 384; dld = 768; dr0 = 32 * nb; k0 = 64 * kb; }
        else if ((r -= I_GDN) < I_OUT) { const int kb = r / 32, nb = r % 32; src = args->in[11] + (size_t)l * D * D; sld = D; sc0 = 32 * nb; kv = D; dst = WSP(bf16_t, WS_WOUT); dld = D; dr0 = 32 * nb; k0 = 64 * kb; }
        else if ((r -= I_OUT) < 16 * I_GU1) { const int e = r / I_GU1, q = r % I_GU1, kb = q / 128, nb = q % 128, n0 = 32 * nb, j = n0 >> 8, rr = n0 & 255;
            tr_item8((rr < 128 ? args->in[16] : args->in[15]) + ((size_t)l * NE + e) * D * DE, DE, 128 * j + (rr & 127), D, WSP(unsigned char, WS_WGU) + (size_t)e * 4096 * D, D, n0, 64 * kb, 32.0f, scr, lane); continue; }
        else { r -= 16 * I_GU1; const int e = r / I_D1, q = r % I_D1, kb = q / 32, nb = q % 32;
            tr_item8(args->in[17] + ((size_t)l * NE + e) * DE * D, D, 32 * nb, DE, WSP(unsigned char, WS_WD) + (size_t)e * D * DE, DE, 32 * nb, 64 * kb, 32.0f, scr, lane); continue; }
        tr_item(src, sld, sc0, nv, kv, dst, dld, dr0, k0, scr, lane);
    }
    if (l == 0) {
        for (int t = gw; t < T_ALL; t += NGW) {
            const float* xr = (t < T_P) ? args->in[0] + (size_t)t * D : args->in[1] + (size_t)(t - T_P) * D;
            bf16_t* o = WSP(bf16_t, WS_XB) + (size_t)t * D;
#pragma unroll
            for (int j = 0; j < 4; ++j) { const f32x4 v = *(const f32x4*)(xr + 4 * lane + 256 * j); u32x2 w; w.x = pk2(v[0], v[1]); w.y = pk2(v[2], v[3]); *(u32x2*)(o + 4 * lane + 256 * j) = w;
                *(unsigned*)(WSP(unsigned char, WS_XB8) + (size_t)t * D + 4 * lane + 256 * j) = pk4_fp8(v[0], v[1], v[2], v[3]); }
        }
        float* cs = WSP(float, WS_CS);
        for (int i = c.bid * 512 + c.tid; i < 16384 * 32; i += c.G * 512) { const int pos = i >> 5, k = i & 31;
            const float inv = INV_FREQ[k];
            const float ang = (float)pos * inv;
            cs[pos * 64 + k] = cosf(ang); cs[pos * 64 + 32 + k] = sinf(ang); }
    }
}

constexpr int TLD = 72, TILEB = 64 * TLD * 2;
DI int tsw(int row) { return ((row >> 4) & 3) << 3; }
template <bool SA = false, bool SB = false> DI f32x16 mm_tile(const LAS bf16_t* A, const LAS bf16_t* Bt, int m0, int n0, int lane) {
    f32x16 acc = zero16(); const int r = lane & 31, hh = lane >> 5; const int sa = SA ? tsw(m0 + r) : 0, sb = SB ? tsw(n0 + r) : 0;
#pragma unroll
    for (int ks = 0; ks < 4; ++ks) { const bf16x8 a = *(const LAS bf16x8*)(A + (m0 + r) * TLD + ((16 * ks + 8 * hh) ^ sa)); const bf16x8 b = *(const LAS bf16x8*)(Bt + (n0 + r) * TLD + ((16 * ks + 8 * hh) ^ sb)); acc = MFMA32(a, b, acc); }
    return acc;
}

constexpr int PI_P0 = 0, PI_P1 = 9216, PI_INTRA = 18432, PI_AM = 27648, PI_TT = 45056, PI_TD0 = 54272, PI_TD1 = 60416, PI_PM = 65024, PI_VEC = 71168, PI_BYTES = 72704;
constexpr int PI_WT = PI_AM, PI_UT = PI_TD0;
DI void gdn_prep_pair(KArgs args, LAS unsigned char* L0, const Ctx& c, int pu) {
    int tid = c.tid; asm volatile("" : "+v"(tid)); const int lane = tid & 63, wave = __builtin_amdgcn_readfirstlane(tid >> 6), l = c.layer;
    const int dir = wave >> 2, wg = wave & 3, tg = tid & 255, head = pu % 6, gch = pu / 6, inst = (gch * 6 + head) * 2 + dir;
    const int cps = c.seqlen >> 6, seq = gch / cps, n = gch % cps;
    const bf16_t* PROJ = BIGP(bf16_t, B_PROJ); const float* BA = BIGP(float, B_BA);
    unsigned char* G = BIGP(unsigned char, B_GSCR) + (size_t)inst * GSTRIDE;
    LAS unsigned char* L = L0 + dir * PI_BYTES;
    LAS bf16_t* P0 = (LAS bf16_t*)(L + PI_P0); LAS bf16_t* P1 = (LAS bf16_t*)(L + PI_P1); LAS bf16_t* INTRA = (LAS bf16_t*)(L + PI_INTRA);
    LAS float* AM = (LAS float*)(L + PI_AM); LAS bf16_t* TT = (LAS bf16_t*)(L + PI_TT);
    LAS float* TD0 = (LAS float*)(L + PI_TD0); LAS float* TD1 = (LAS float*)(L + PI_TD1); LAS float* PM = (LAS float*)(L + PI_PM);
    LAS float* GV = (LAS float*)(L + PI_VEC); LAS float* BV = GV + 64; LAS float* GC = GV + 128;
    LAS bf16_t* WT = (LAS bf16_t*)(L + PI_WT); LAS bf16_t* UT = (LAS bf16_t*)(L + PI_UT);
    const int ia = tg >> 3, p = tg & 7;
    LAS float* XQ = (LAS float*)(L0 + PI_AM);
    LAS float* XK = (LAS float*)(L0 + PI_TT);
    LAS float* XV = (LAS float*)(L0 + PI_BYTES + PI_AM);
    {   float q1[8], k1[8], v1[8];
#pragma unroll
        for (int j = 0; j < 8; ++j) { q1[j] = 0.f; k1[j] = 0.f; v1[j] = 0.f; }
        const float* cw = args->in[4] + (size_t)l * 5 * 1152 + 64 * head + 8 * p;
        const int tr = ia + 32 * dir;
        u32x4 rqa[5], rka[5], rva[5];
#pragma unroll
        for (int tp = 0; tp < 5; ++tp) { const int pp = n * 64 + tr + tp - 2, ppc = pp < 0 ? 0 : (pp >= c.seqlen ? c.seqlen - 1 : pp);
            const bf16_t* rp = PROJ + (size_t)(seq * c.seqlen + ppc) * NPROJ + 64 * head + 8 * p;
            rqa[tp] = *(const u32x4*)(rp + C_QC); rka[tp] = *(const u32x4*)(rp + C_KC); rva[tp] = *(const u32x4*)(rp + C_VC); }
#pragma unroll
        for (int tp = 0; tp < 5; ++tp) { const float* w = cw + tp * 1152;
            const f32x4 wq0 = *(const f32x4*)w, wq1 = *(const f32x4*)(w + 4), wk0 = *(const f32x4*)(w + 384), wk1 = *(const f32x4*)(w + 388), wv0 = *(const f32x4*)(w + 768), wv1 = *(const f32x4*)(w + 772);
            const int pp = n * 64 + tr + tp - 2; const bool inr = (pp >= 0 && pp < c.seqlen);
            { u32x4 rq = rqa[tp], rk = rka[tp], rv = rva[tp];
                if (!inr) { rq = (u32x4){0u, 0u, 0u, 0u}; rk = rq; rv = rq; }
#pragma unroll
                for (int j = 0; j < 4; ++j) { const float a0 = (j < 2) ? wq0[2 * j] : wq1[2 * j - 4], a1 = (j < 2) ? wq0[2 * j + 1] : wq1[2 * j - 3];
                    const float b0 = (j < 2) ? wk0[2 * j] : wk1[2 * j - 4], b1 = (j < 2) ? wk0[2 * j + 1] : wk1[2 * j - 3];
                    const float c0 = (j < 2) ? wv0[2 * j] : wv1[2 * j - 4], c1 = (j < 2) ? wv0[2 * j + 1] : wv1[2 * j - 3];
                    q1[2 * j] += a0 * bflo(rq[j]); q1[2 * j + 1] += a1 * bfhi(rq[j]);
                    k1[2 * j] += b0 * bflo(rk[j]); k1[2 * j + 1] += b1 * bfhi(rk[j]);
                    v1[2 * j] += c0 * bflo(rv[j]); v1[2 * j + 1] += c1 * bfhi(rv[j]); } } }
        float sq = 0.f, sk = 0.f;
#pragma unroll
        for (int j = 0; j < 8; ++j) { q1[j] = siluf_(q1[j]); k1[j] = siluf_(k1[j]); v1[j] = siluf_(v1[j]); sq += q1[j] * q1[j]; sk += k1[j] * k1[j]; }
        sq += __shfl_xor(sq, 1); sq += __shfl_xor(sq, 2); sq += __shfl_xor(sq, 4);
        sk += __shfl_xor(sk, 1); sk += __shfl_xor(sk, 2); sk += __shfl_xor(sk, 4);
        const float rq_ = 0.125f * frsq(sq + NORM_EPS), rk_ = frsq(sk + NORM_EPS);
        f32x4 o0, o1;
        o0[0] = q1[0] * rq_; o0[1] = q1[1] * rq_; o0[2] = q1[2] * rq_; o0[3] = q1[3] * rq_; o1[0] = q1[4] * rq_; o1[1] = q1[5] * rq_; o1[2] = q1[6] * rq_; o1[3] = q1[7] * rq_;
        *(LAS f32x4*)(XQ + tr * 64 + 8 * p) = o0; *(LAS f32x4*)(XQ + tr * 64 + 8 * p + 4) = o1;
        o0[0] = k1[0] * rk_; o0[1] = k1[1] * rk_; o0[2] = k1[2] * rk_; o0[3] = k1[3] * rk_; o1[0] = k1[4] * rk_; o1[1] = k1[5] * rk_; o1[2] = k1[6] * rk_; o1[3] = k1[7] * rk_;
        *(LAS f32x4*)(XK + tr * 64 + 8 * p) = o0; *(LAS f32x4*)(XK + tr * 64 + 8 * p + 4) = o1;
        o0[0] = v1[0]; o0[1] = v1[1]; o0[2] = v1[2]; o0[3] = v1[3]; o1[0] = v1[4]; o1[1] = v1[5]; o1[2] = v1[6]; o1[3] = v1[7];
        *(LAS f32x4*)(XV + tr * 64 + 8 * p) = o0; *(LAS f32x4*)(XV + tr * 64 + 8 * p + 4) = o1; }
#pragma unroll
    for (int h2 = 0; h2 < 2; ++h2) {
        if (p == 0) { const int i = ia + 32 * h2, tokl = dir ? 63 - i : i; const float* bar = BA + (size_t)(seq * c.seqlen + n * 64 + tokl) * 32;
            const float bl = bar[dir * 6 + head], al = bar[12 + dir * 6 + head];
            const float xx = al + args->in[6][l * 12 + dir * 6 + head];
            const float sp = xx > 20.f ? xx : log1pf(expf(xx));
            GV[i] = -expf(args->in[5][l * 12 + dir * 6 + head]) * sp; BV[i] = sigmoidf_(bl); } }
    __syncthreads();
    float q[2][8], k[2][8], v[2][8];
#pragma unroll
    for (int h2 = 0; h2 < 2; ++h2) { const int i = ia + 32 * h2, tokl = dir ? 63 - i : i;
        const f32x4 a0 = *(const LAS f32x4*)(XQ + tokl * 64 + 8 * p), a1 = *(const LAS f32x4*)(XQ + tokl * 64 + 8 * p + 4), b0 = *(const LAS f32x4*)(XK + tokl * 64 + 8 * p), b1 = *(const LAS f32x4*)(XK + tokl * 64 + 8 * p + 4),
                    c0 = *(const LAS f32x4*)(XV + tokl * 64 + 8 * p), c1 = *(const LAS f32x4*)(XV + tokl * 64 + 8 * p + 4);
#pragma unroll
        for (int j = 0; j < 4; ++j) { q[h2][j] = a0[j]; q[h2][4 + j] = a1[j]; k[h2][j] = b0[j]; k[h2][4 + j] = b1[j]; v[h2][j] = c0[j]; v[h2][4 + j] = c1[j]; } }
    float gcl_;
    { float x = GV[lane];
#pragma unroll
        for (int o = 1; o < 64; o <<= 1) { const float y = __shfl_up(x, o); if (lane >= o) x += y; }
        if (wg == 0) GC[lane] = x;
        gcl_ = x; }
    const float gc0 = __shfl(gcl_, ia), gc1 = __shfl(gcl_, ia + 32), gcl = __shfl(gcl_, 63);
#pragma unroll
    for (int h2 = 0; h2 < 2; ++h2) { const int i = ia + 32 * h2; u32x4 wq, wk;
#pragma unroll
        for (int j = 0; j < 4; ++j) { wq[j] = pk2(q[h2][2 * j], q[h2][2 * j + 1]); wk[j] = pk2(k[h2][2 * j], k[h2][2 * j + 1]); }
        *(LAS u32x4*)(P0 + i * TLD + 8 * p) = wq; *(LAS u32x4*)(P1 + i * TLD + 8 * p) = wk; }
    __syncthreads();
    { const int mat = wg >> 1, mt = wg & 1, hh = lane >> 5;
#pragma unroll
        for (int nt = 0; nt < 2; ++nt) { const int jc = 32 * nt + (lane & 31);
            const f32x16 a = mm_tile(mat ? P0 : P1, P1, 32 * mt, 32 * nt, lane);
            const float gj = GC[jc];
#pragma unroll
            for (int r = 0; r < 16; ++r) { const int ii = 32 * mt + crow(r, hh); const float gi = GC[ii];
                if (mat == 0) AM[ii * 68 + jc] = (jc < ii) ? BV[ii] * a[r] * __expf(gi - gj) : 0.f;
                else INTRA[ii * TLD + jc] = (bf16_t)(pk2((jc <= ii) ? a[r] * __expf(gi - gj) : 0.f, 0.f) & 0xffffu); } } }
    __syncthreads();
    if (wg == dir) {
        const int b = lane >> 5, cidx = lane & 31; float t[32];
#pragma unroll
        for (int ii = 0; ii < 32; ++ii) t[ii] = (ii == cidx) ? 1.f : 0.f;
        const LAS float* Ab = AM + (32 * b) * 68 + 32 * b;
#pragma unroll
        for (int ii = 1; ii < 32; ++ii) { float acc = 0.f;
#pragma unroll
            for (int j4 = 0; j4 < ii; j4 += 4) { const f32x4 a4 = *(const LAS f32x4*)(Ab + ii * 68 + j4);
                acc += a4[0] * t[j4]; acc += a4[1] * t[j4 + 1]; acc += a4[2] * t[j4 + 2]; acc += a4[3] * t[j4 + 3]; }
            t[ii] -= acc; }
        LAS float* td = b ? TD1 : TD0; const int tds = b ? 36 : 48;
#pragma unroll
        for (int ii = 0; ii < 32; ++ii) { td[ii * tds + cidx] = t[ii]; TT[(32 * b + ii) * TLD + 32 * b + cidx] = (bf16_t)(pk2(t[ii], 0.f) & 0xffffu); }
    }
#pragma unroll
    for (int h2 = 0; h2 < 2; ++h2) { const int i = ia + 32 * h2; const float be = BV[i], eg = __expf(h2 ? gc1 : gc0);
#pragma unroll
        for (int j = 0; j < 8; ++j) { const int d = 8 * p + j, o_ = d * TLD + (i ^ tsw(d)); P0[o_] = (bf16_t)(pk2(k[h2][j] * be * eg, 0.f) & 0xffffu); P1[o_] = (bf16_t)(pk2(v[h2][j] * be, 0.f) & 0xffffu); } }
    { unsigned zz; asm volatile("v_mov_b32 %0, 0" : "=v"(zz)); u32x2 z; z.x = zz; z.y = zz; *(LAS u32x2*)(TT + (tg >> 3) * TLD + 32 + 4 * (tg & 7)) = z; }
    __syncthreads();
    { const int qi = wg >> 1, qj = wg & 1, r16 = lane & 15, g4 = lane >> 4; f32x4 pc = {0.f, 0.f, 0.f, 0.f};
#pragma unroll
        for (int kk = 0; kk < 8; ++kk) pc = __builtin_amdgcn_mfma_f32_16x16x4f32(AM[(32 + 16 * qi + r16) * 68 + 4 * kk + g4], TD0[(4 * kk + g4) * 48 + 16 * qj + r16], pc, 0, 0, 0);
#pragma unroll
        for (int r = 0; r < 4; ++r) PM[(16 * qi + 4 * g4 + r) * 48 + 16 * qj + r16] = pc[r]; }
    __syncthreads();
    { const int qi = wg >> 1, qj = wg & 1, r16 = lane & 15, g4 = lane >> 4; f32x4 pc = {0.f, 0.f, 0.f, 0.f};
#pragma unroll
        for (int kk = 0; kk < 8; ++kk) pc = __builtin_amdgcn_mfma_f32_16x16x4f32(TD1[(16 * qi + r16) * 36 + 4 * kk + g4], PM[(4 * kk + g4) * 48 + 16 * qj + r16], pc, 0, 0, 0);
#pragma unroll
        for (int r = 0; r < 4; ++r) TT[(32 + 16 * qi + 4 * g4 + r) * TLD + 16 * qj + r16] = (bf16_t)(pk2(-pc[r], 0.f) & 0xffffu); }
    __syncthreads();
    { const int which = wg >> 1, mt = wg & 1, hh = lane >> 5;
#pragma unroll
        for (int nt = 0; nt < 2; ++nt) { const int dc = 32 * nt + (lane & 31);
            const f32x16 a = mm_tile<false, true>(TT, which ? P1 : P0, 32 * mt, 32 * nt, lane);
            LAS bf16_t* dst = (which ? UT : WT) + dc * TLD; const int sw = tsw(dc);
#pragma unroll
            for (int g = 0; g < 4; ++g) { u32x2 w; w.x = pk2(a[4 * g], a[4 * g + 1]); w.y = pk2(a[4 * g + 2], a[4 * g + 3]); *(LAS u32x2*)(dst + ((32 * mt + 8 * g + 4 * hh) ^ sw)) = w; } } }
    __syncthreads();
#pragma unroll
    for (int h2 = 0; h2 < 2; ++h2) { const int i = ia + 32 * h2; const float gci = h2 ? gc1 : gc0, eg = __expf(gci), ekd = __expf(gcl - gci); u32x4 wqd;
#pragma unroll
        for (int j = 0; j < 4; ++j) wqd[j] = pk2(q[h2][2 * j] * eg, q[h2][2 * j + 1] * eg);
        *(LAS u32x4*)(P1 + i * TLD + 8 * p) = wqd;
#pragma unroll
        for (int j = 0; j < 8; ++j) { const int d = 8 * p + j; P0[d * TLD + (i ^ tsw(d))] = (bf16_t)(pk2(k[h2][j] * ekd, 0.f) & 0xffffu); } }
    __syncthreads();
    { const int hh = lane >> 5, rr = lane & 31;
        if (wg == 0) {
#pragma unroll
            for (int t4 = 0; t4 < 4; ++t4) { const int mtb = t4 >> 1, nta = t4 & 1; const f32x16 a = mm_tile<true, true>(WT, P0, 32 * mtb, 32 * nta, lane);
                f32x16 na; for (int r = 0; r < 16; ++r) na[r] = -a[r];
                *(bf16x8*)(G + (size_t)((nta * 4 + 2 * mtb) * 64 + lane) * 16) = pack8<0>(na); *(bf16x8*)(G + (size_t)((nta * 4 + 2 * mtb + 1) * 64 + lane) * 16) = pack8<1>(na); }
        } else if (wg == 1) {
#pragma unroll
            for (int t4 = 0; t4 < 4; ++t4) { const int mta = t4 >> 1, nte = t4 & 1; const f32x16 a = mm_tile<true, true>(P0, UT, 32 * mta, 32 * nte, lane);
                bf16x8* dp = (bf16x8*)(G + 8192 + (size_t)((nte * 2 + mta) * 64 + lane) * 32); dp[0] = pack8<0>(a); dp[1] = pack8<1>(a); }
        } else if (wg == 2) {
#pragma unroll
            for (int t4 = 0; t4 < 4; ++t4) { const int mtb = t4 >> 1, nti = t4 & 1; const f32x16 a = mm_tile<true, false>(WT, INTRA, 32 * mtb, 32 * nti, lane);
                f32x16 qe; const LAS bf16_t* qd = P1 + (32 * nti + rr) * TLD + 32 * mtb + 4 * hh;
#pragma unroll
                for (int g = 0; g < 4; ++g) { const u32x2 w = *(const LAS u32x2*)(qd + 8 * g); qe[4 * g] = bflo(w.x) - a[4 * g]; qe[4 * g + 1] = bfhi(w.x) - a[4 * g + 1]; qe[4 * g + 2] = bflo(w.y) - a[4 * g + 2]; qe[4 * g + 3] = bfhi(w.y) - a[4 * g + 3]; }
                *(bf16x8*)(G + 16384 + (size_t)((nti * 4 + 2 * mtb) * 64 + lane) * 16) = pack8<0>(qe); *(bf16x8*)(G + 16384 + (size_t)((nti * 4 + 2 * mtb + 1) * 64 + lane) * 16) = pack8<1>(qe); }
        } else {
#pragma unroll
            for (int t4 = 0; t4 < 4; ++t4) { const int mti = t4 >> 1, nte = t4 & 1; const f32x16 a = mm_tile<false, true>(INTRA, UT, 32 * mti, 32 * nte, lane);
                bf16x8* dp = (bf16x8*)(G + 24576) + (size_t)((nte * 2 + mti) * 2) * 64 + lane; dp[0] = pack8<0>(a); dp[64] = pack8<1>(a); }
            if (lane == 0) *(float*)(G + 40960) = __expf(gcl);
        } }
    __syncthreads();
}

DI void pv_accum(const f32x16 (&acc)[2][2], f32x16 (&o)[2][2], const LAS bf16_t* Vt, int lane) {
    const int r = lane & 31, hh = lane >> 5;
#pragma unroll
    for (int mt = 0; mt < 2; ++mt) {
        {   const bf16x8 p0 = pack8<0>(acc[mt][0]), p1 = pack8<0>(acc[mt][1]);
#pragma unroll
            for (int mo = 0; mo < 2; ++mo) { const LAS bf16_t* s = Vt + (32 * mo + r) * TLD; const int c0 = (32 * mt + 4 * hh) ^ tsw(32 * mo + r);
                const u32x2 lo = *(const LAS u32x2*)(s + c0), hi = *(const LAS u32x2*)(s + (c0 ^ 8)); u32x4 w; w.x = lo.x; w.y = lo.y; w.z = hi.x; w.w = hi.y; const bf16x8 vf = __builtin_bit_cast(bf16x8, w);
                o[mo][0] = MFMA32(vf, p0, o[mo][0]); o[mo][1] = MFMA32(vf, p1, o[mo][1]); } }
        {   const bf16x8 p0 = pack8<1>(acc[mt][0]), p1 = pack8<1>(acc[mt][1]);
#pragma unroll
            for (int mo = 0; mo < 2; ++mo) { const LAS bf16_t* s = Vt + (32 * mo + r) * TLD; const int c0 = (32 * mt + 16 + 4 * hh) ^ tsw(32 * mo + r);
                const u32x2 lo = *(const LAS u32x2*)(s + c0), hi = *(const LAS u32x2*)(s + (c0 ^ 8)); u32x4 w; w.x = lo.x; w.y = lo.y; w.z = hi.x; w.w = hi.y; const bf16x8 vf = __builtin_bit_cast(bf16x8, w);
                o[mo][0] = MFMA32(vf, p0, o[mo][0]); o[mo][1] = MFMA32(vf, p1, o[mo][1]); } }
    }
}
template <class F> DI void stage_vt(LAS bf16_t* Vt, int lane, F vrow) {
#pragma unroll
    for (int it = 0; it < 8; ++it) { const int id = it * 64 + lane, key = id >> 3, part = id & 7;
        const u32x4 w = *(const u32x4*)(vrow(key) + 8 * part);
#pragma unroll
        for (int j = 0; j < 4; ++j) { const int d0 = 8 * part + 2 * j, ks_ = key ^ tsw(d0); Vt[d0 * TLD + ks_] = (bf16_t)(w[j] & 0xffffu); Vt[(d0 + 1) * TLD + ks_] = (bf16_t)(w[j] >> 16); } }
}
DI void write_o_slot(LAS float* SL, const f32x16 (&o)[2][2], int lane) {
    const int r = lane & 31, hh = lane >> 5;
#pragma unroll
    for (int mo = 0; mo < 2; ++mo)
#pragma unroll
        for (int nt = 0; nt < 2; ++nt)
#pragma unroll
            for (int g = 0; g < 4; ++g) { f32x4 v; v[0] = o[mo][nt][4 * g]; v[1] = o[mo][nt][4 * g + 1]; v[2] = o[mo][nt][4 * g + 2]; v[3] = o[mo][nt][4 * g + 3];
                *(LAS f32x4*)(SL + (32 * nt + r) * 68 + 32 * mo + 8 * g + 4 * hh) = v; }
}
DI void add_o_slot(const LAS float* SL, f32x16 (&o)[2][2], int lane) {
    const int r = lane & 31, hh = lane >> 5;
#pragma unroll
    for (int mo = 0; mo < 2; ++mo)
#pragma unroll
        for (int nt = 0; nt < 2; ++nt)
#pragma unroll
            for (int g = 0; g < 4; ++g) { const f32x4 v = *(const LAS f32x4*)(SL + (32 * nt + r) * 68 + 32 * mo + 8 * g + 4 * hh);
                o[mo][nt][4 * g] += v[0]; o[mo][nt][4 * g + 1] += v[1]; o[mo][nt][4 * g + 2] += v[2]; o[mo][nt][4 * g + 3] += v[3]; }
}

constexpr int WAREA = 10240;
DI void osm_update(f32x16 (&acc)[2][2], f32x16 (&o)[2][2], float (&m)[2], float (&l)[2]) {
#pragma unroll
    for (int nt = 0; nt < 2; ++nt) { float mx = -1e30f;
#pragma unroll
        for (int mt = 0; mt < 2; ++mt)
#pragma unroll
            for (int g = 0; g < 16; ++g) mx = fmaxf(mx, acc[mt][nt][g]);
        mx = fmaxf(mx, __shfl_xor(mx, 32));
        const float mn = fmaxf(m[nt], mx), sc = __expf(m[nt] - mn); float sm = 0.f;
#pragma unroll
        for (int mt = 0; mt < 2; ++mt)
#pragma unroll
            for (int g = 0; g < 16; ++g) { const float pz = __expf(acc[mt][nt][g] - mn); acc[mt][nt][g] = pz; sm += pz; }
        sm += __shfl_xor(sm, 32);
        l[nt] = l[nt] * sc + sm; m[nt] = mn;
#pragma unroll
        for (int g = 0; g < 16; ++g) { o[0][nt][g] *= sc; o[1][nt][g] *= sc; } }
}
template <class F> DI void store_o_rows(LAS bf16_t* T, const f32x16 (&o)[2][2], const float (&scale)[2], int lane, F rowp) {
    const int r = lane & 31, hh = lane >> 5;
#pragma unroll
    for (int mo = 0; mo < 2; ++mo)
#pragma unroll
        for (int nt = 0; nt < 2; ++nt)
#pragma unroll
            for (int g = 0; g < 4; ++g) { u32x2 w; w.x = pk2(o[mo][nt][4 * g] * scale[nt], o[mo][nt][4 * g + 1] * scale[nt]); w.y = pk2(o[mo][nt][4 * g + 2] * scale[nt], o[mo][nt][4 * g + 3] * scale[nt]);
                *(LAS u32x2*)(T + (32 * nt + r) * TLD + 32 * mo + 8 * g + 4 * hh) = w; }
    asm volatile("s_waitcnt lgkmcnt(0)" ::: "memory");
#pragma unroll
    for (int it = 0; it < 8; ++it) { const int id = it * 64 + lane, q = id >> 3, part = id & 7; *(u32x4*)(rowp(q) + 8 * part) = *(const LAS u32x4*)(T + q * TLD + 8 * part); }
    asm volatile("s_waitcnt lgkmcnt(0)" ::: "memory");
}
DI void na_wave_unit(KArgs args, LAS unsigned char* L, const Ctx& c, int u, int lane, int wave) {
    const int l = c.layer, head = u & 3, gr = u >> 2, rows = c.seqlen >> 6, seq = gr / rows, r = gr % rows;
    int rs = r - 4; rs = rs < 0 ? 0 : (rs > rows - 8 ? rows - 8 : rs);
    const bf16_t* PROJ = BIGP(bf16_t, B_PROJ);
    const size_t tq0 = (size_t)seq * c.seqlen + (size_t)r * 64;
    LAS bf16_t* Vt = (LAS bf16_t*)(L + wave * WAREA);
    LAS float* BIAS = (LAS float*)(L + wave * WAREA + 9216);
    const int rr = lane & 31, hh = lane >> 5;
#pragma unroll
    for (int w = 0; w < 4; ++w) { const int idx = w * 64 + lane, kw = idx >> 5, dc = idx & 31;
        if (dc < 31) BIAS[idx] = args->in[3][(((size_t)l * 4 + head) * 15 + (rs + kw - r + 7)) * 31 + dc]; }
    bf16x8 qf[2][4];
#pragma unroll
    for (int nt = 0; nt < 2; ++nt)
#pragma unroll
        for (int ks = 0; ks < 4; ++ks) qf[nt][ks] = *(const bf16x8*)(PROJ + (tq0 + 32 * nt + rr) * NPROJ + C_QA + 64 * head + 16 * ks + 8 * hh);
    f32x16 o[2][2]; o[0][0] = zero16(); o[0][1] = zero16(); o[1][0] = zero16(); o[1][1] = zero16();
    float m[2] = {-1e30f, -1e30f}, ls[2] = {0.f, 0.f};
    for (int w = 0; w < 8; ++w) {
        const size_t tk0 = (size_t)seq * c.seqlen + (size_t)(rs + w) * 64;
        asm volatile("s_waitcnt lgkmcnt(0)" ::: "memory");
        stage_vt(Vt, lane, [&](int key) { return PROJ + (tk0 + key) * NPROJ + C_VA + 64 * head; });
        f32x16 acc[2][2]; acc[0][0] = zero16(); acc[0][1] = zero16(); acc[1][0] = zero16(); acc[1][1] = zero16();
#pragma unroll
        for (int mt = 0; mt < 2; ++mt)
#pragma unroll
            for (int ks = 0; ks < 4; ++ks) { const bf16x8 kf = *(const bf16x8*)(PROJ + (tk0 + 32 * mt + rr) * NPROJ + C_KA + 64 * head + 16 * ks + 8 * hh);
                acc[mt][0] = MFMA32(kf, qf[0][ks], acc[mt][0]); acc[mt][1] = MFMA32(kf, qf[1][ks], acc[mt][1]); }
        asm volatile("s_waitcnt lgkmcnt(0)" ::: "memory");
        const LAS float* brow = BIAS + w * 32;
#pragma unroll
        for (int nt = 0; nt < 2; ++nt) { const int qc = 32 * nt + rr; int ws = qc - 8; ws = ws < 0 ? 0 : (ws > 48 ? 48 : ws);
#pragma unroll
            for (int mt = 0; mt < 2; ++mt)
#pragma unroll
                for (int g = 0; g < 16; ++g) { const int kc = 32 * mt + crow(g, hh); const bool ok = (kc >= ws) && (kc < ws + 16);
                    acc[mt][nt][g] = ok ? acc[mt][nt][g] * 0.125f + brow[ok ? (kc - qc + 15) : 0] : -1e30f; } }
        osm_update(acc, o, m, ls);
        pv_accum(acc, o, Vt, lane);
    }
    asm volatile("s_waitcnt lgkmcnt(0)" ::: "memory");
    const float sc[2] = {frcp(ls[0]), frcp(ls[1])};
    store_o_rows(Vt, o, sc, lane, [&](int q) { return BIGP(bf16_t, B_ONA) + (tq0 + q) * 768 + 64 * head; });
}
DI void rope_frag4(bf16x8 (&f)[4], const float* cs, int hh) {
#pragma unroll
    for (int ks = 0; ks < 2; ++ks) { const float* cp = cs + 16 * ks + 8 * hh;
        const f32x4 c0 = *(const f32x4*)cp, c1 = *(const f32x4*)(cp + 4), s0 = *(const f32x4*)(cp + 32), s1 = *(const f32x4*)(cp + 36);
        const u32x4 a = __builtin_bit_cast(u32x4, f[ks]), b = __builtin_bit_cast(u32x4, f[ks + 2]); u32x4 ra, rb;
#pragma unroll
        for (int j = 0; j < 4; ++j) { const float cl = (j < 2) ? c0[2 * j] : c1[2 * j - 4], ch = (j < 2) ? c0[2 * j + 1] : c1[2 * j - 3];
            const float sl = (j < 2) ? s0[2 * j] : s1[2 * j - 4], sh = (j < 2) ? s0[2 * j + 1] : s1[2 * j - 3];
            const float x1l = bflo(a[j]), x1h = bfhi(a[j]), x2l = bflo(b[j]), x2h = bfhi(b[j]);
            ra[j] = pk2(x1l * cl - x2l * sl, x1h * ch - x2h * sh); rb[j] = pk2(x1l * sl + x2l * cl, x1h * sh + x2h * ch); }
        f[ks] = __builtin_bit_cast(bf16x8, ra); f[ks + 2] = __builtin_bit_cast(bf16x8, rb); }
}
DI void dil_wave_unit(KArgs args, LAS unsigned char* L, const Ctx& c, int u, int lane, int wave) {
    const int hd = u & 1, uu = u >> 1, upg = c.stok >> 6, g = uu / upg, v = uu % upg, ups = c.seqlen >> 6, seq = v / ups, wq = v % ups;
    const int dsh = 2 * g, dd = 1 << dsh, nb = ups >> dsh, cls = wq / nb, jb = wq % nb, head = 2 * g + hd;
    const bf16_t* PROJ = BIGP(bf16_t, B_PROJ); const float* CS = WSP(float, WS_CS);
    const size_t sb = (size_t)seq * c.seqlen;
    const int rr = lane & 31, hh = lane >> 5;
    LAS bf16_t* Vt = (LAS bf16_t*)(L + wave * WAREA);
    bf16x8 qf[2][4];
#pragma unroll
    for (int nt = 0; nt < 2; ++nt) { const int pos = cls + dd * (64 * jb + 32 * nt + rr);
#pragma unroll
        for (int ks = 0; ks < 4; ++ks) qf[nt][ks] = *(const bf16x8*)(PROJ + (sb + pos) * NPROJ + C_QD + 64 * head + 16 * ks + 8 * hh);
        rope_frag4(qf[nt], CS + (size_t)pos * 64, hh); }
    f32x16 o[2][2]; o[0][0] = zero16(); o[0][1] = zero16(); o[1][0] = zero16(); o[1][1] = zero16();
    float m[2] = {-1e30f, -1e30f}, ls[2] = {0.f, 0.f};
    for (int kt = 0; kt < 3; ++kt) { const int kj = jb - 1 + kt;
        if (kj < 0 || kj >= nb) continue;
        asm volatile("s_waitcnt lgkmcnt(0)" ::: "memory");
        stage_vt(Vt, lane, [&](int key) { return PROJ + (sb + cls + (size_t)dd * (64 * kj + key)) * NPROJ + C_VD + 64 * head; });
        f32x16 acc[2][2]; acc[0][0] = zero16(); acc[0][1] = zero16(); acc[1][0] = zero16(); acc[1][1] = zero16();
#pragma unroll
        for (int mt = 0; mt < 2; ++mt) { const int pos = cls + dd * (64 * kj + 32 * mt + rr); bf16x8 kf[4];
#pragma unroll
            for (int ks = 0; ks < 4; ++ks) kf[ks] = *(const bf16x8*)(PROJ + (sb + pos) * NPROJ + C_KD + 64 * head + 16 * ks + 8 * hh);
            rope_frag4(kf, CS + (size_t)pos * 64, hh);
#pragma unroll
            for (int ks = 0; ks < 4; ++ks) { acc[mt][0] = MFMA32(kf[ks], qf[0][ks], acc[mt][0]); acc[mt][1] = MFMA32(kf[ks], qf[1][ks], acc[mt][1]); } }
#pragma unroll
        for (int nt = 0; nt < 2; ++nt) { const int qc = 32 * nt + rr;
#pragma unroll
            for (int mt = 0; mt < 2; ++mt)
#pragma unroll
                for (int gg = 0; gg < 16; ++gg) { const int kc = 32 * mt + crow(gg, hh); const bool ok = (kt == 1) || (kt == 0 ? (kc >= qc) : (kc <= qc));
                    acc[mt][nt][gg] = ok ? acc[mt][nt][gg] * 0.125f : -1e30f; } }
        osm_update(acc, o, m, ls);
        pv_accum(acc, o, Vt, lane);
    }
    asm volatile("s_waitcnt lgkmcnt(0)" ::: "memory");
    bf16_t* DP = BIGP(bf16_t, B_DILP); float* DM = BIGP(float, B_DILM);
    const float one[2] = {1.f, 1.f};
    store_o_rows(Vt, o, one, lane, [&](int q) { return DP + ((((size_t)g * SLABMAX + sb + cls + (size_t)dd * (64 * jb + q)) * 2 + hd)) * 64; });
    if (hh == 0) {
#pragma unroll
        for (int nt = 0; nt < 2; ++nt) { const size_t base = (((size_t)g * SLABMAX + sb + cls + (size_t)dd * (64 * jb + 32 * nt + rr)) * 2 + hd); DM[base * 2] = m[nt]; DM[base * 2 + 1] = ls[nt]; } }
}

DI void phase_mix_a(KArgs args, LAS unsigned char* L, const Ctx& c) {
    const int N_PREP = (c.stok >> 6) * 6;
    for (int u = c.bid; u < N_PREP; u += c.G) gdn_prep_pair(args, L, c, u);
}
DI void attn_wave_units(KArgs args, LAS unsigned char* L, const Ctx& c) {
    int tid = c.tid; asm volatile("" : "+v"(tid)); const int lane = tid & 63, wave = __builtin_amdgcn_readfirstlane(tid >> 6);
    const int nch_ = c.stok >> 6, N_NA = nch_ * 4, N_DIL = nch_ * 6;
    unsigned* q = (unsigned*)(c.ws + WS_CTL) + 32768 + 128 * (c.layer * 4 + c.slab);
    for (;;) { unsigned u = 0; if (lane == 0) u = __hip_atomic_fetch_add(q, 1u, __ATOMIC_RELAXED, __HIP_MEMORY_SCOPE_AGENT);
        u = (unsigned)__builtin_amdgcn_readfirstlane((int)u); if (u >= (unsigned)N_NA) break; na_wave_unit(args, L, c, (int)u, lane, wave); }
    int tid2 = c.tid; asm volatile("" : "+v"(tid2)); const int lane2 = tid2 & 63, wave2 = __builtin_amdgcn_readfirstlane(tid2 >> 6);
    for (;;) { unsigned u = 0; if (lane2 == 0) u = __hip_atomic_fetch_add(q + 64, 1u, __ATOMIC_RELAXED, __HIP_MEMORY_SCOPE_AGENT);
        u = (unsigned)__builtin_amdgcn_readfirstlane((int)u); if (u >= (unsigned)N_DIL) break; dil_wave_unit(args, L, c, (int)u, lane2, wave2); }
}

DI void phase_select(KArgs args, LAS unsigned char* L, const Ctx& c, int inst);
DI void phase_scan(KArgs args, LAS unsigned char* L, const Ctx& c) {
    if (c.slab == NSLAB - 1 && c.bid >= 24 && c.bid < 40) { phase_select(args, L, c, c.bid - 24); return; }
    const int nwu = c.nseq * 24, wu = c.bid;
    if (wu < nwu && c.wave == 0) {
        const int lane = c.lane;
        const int chain = wu >> 1, nt = wu & 1, seq = chain / 12, rem = chain % 12, head = rem >> 1, dir = rem & 1;
        const int nch = c.seqlen >> 6, gch0 = seq * nch;
        unsigned char* GS = BIGP(unsigned char, B_GSCR);
        f32x16 S[2]; S[0] = zero16(); S[1] = zero16();
        bf16x8 A[2][2][4]; u32x4 cm[2][2][2];
        const long gstep = (long)(dir ? -1 : 1) * 12 * GSTRIDE;
        const unsigned char* G0 = GS + (size_t)(((gch0 + (dir ? nch - 1 : 0)) * 6 + head) * 2 + dir) * GSTRIDE;
        unsigned char* Gs = (unsigned char*)G0;
        float glv[4];
#pragma unroll
        for (int q = 0; q < 4; ++q) { const int sq = q * 64 + lane; glv[q] = *(const float*)(G0 + (long)(sq < nch ? sq : nch - 1) * gstep + 40960); }
        LAS unsigned char* RING = L + 81920;
        int dslot = 0, rslot = 0, dstage = 0;
#define SCAN_DMA() do { const unsigned char* gp = G0 + (long)(dstage < nch ? dstage : nch - 1) * gstep; LAS unsigned char* sl = RING + dslot * 12288; \
            _Pragma("unroll") for (int j = 0; j < 8; ++j) __builtin_amdgcn_global_load_lds((const unsigned*)(gp + (size_t)(j * 64 + lane) * 16), (LAS unsigned*)(sl + j * 1024), 16, 0, 0); \
            _Pragma("unroll") for (int j = 0; j < 4; ++j) __builtin_amdgcn_global_load_lds((const unsigned*)(gp + 8192 + (size_t)((nt * 2 + (j >> 1)) * 64 + lane) * 32 + (j & 1) * 16), (LAS unsigned*)(sl + 8192 + j * 1024), 16, 0, 0); \
            ++dstage; dslot = dslot == 4 ? 0 : dslot + 1; } while (0)
#define SCAN_LOAD(B) do { const LAS unsigned char* sl = RING + rslot * 12288 + lane * 16; \
            _Pragma("unroll") for (int mt = 0; mt < 2; ++mt) { _Pragma("unroll") for (int ks = 0; ks < 4; ++ks) A[B][mt][ks] = *(const LAS bf16x8*)(sl + (mt * 4 + ks) * 1024); \
                cm[B][mt][0] = *(const LAS u32x4*)(sl + 8192 + (mt * 2) * 1024); cm[B][mt][1] = *(const LAS u32x4*)(sl + 8192 + (mt * 2 + 1) * 1024); } \
            rslot = rslot == 4 ? 0 : rslot + 1; } while (0)
#define SCAN_STEP(B, st) do { const bf16x8 b0 = pack8<0>(S[0]), b1 = pack8<1>(S[0]), b2 = pack8<0>(S[1]), b3 = pack8<1>(S[1]); f32x16 nw[2]; \
            { bf16x8* St = (bf16x8*)(Gs + 32768) + (nt * 4) * 64 + lane; St[0] = b0; St[64] = b1; St[128] = b2; St[192] = b3; }     \
            const int sq_ = (st) >> 6; const float gsel = sq_ == 0 ? glv[0] : (sq_ == 1 ? glv[1] : (sq_ == 2 ? glv[2] : glv[3])); \
            const float glc = __builtin_bit_cast(float, __builtin_amdgcn_readlane(__builtin_bit_cast(int, gsel), (st) & 63)); \
            _Pragma("unroll") for (int mt = 0; mt < 2; ++mt) { \
                _Pragma("unroll") for (int g = 0; g < 8; ++g) { const unsigned wv = (g < 4) ? cm[B][mt][0][g] : cm[B][mt][1][g - 4]; nw[mt][2 * g] = glc * S[mt][2 * g] + bflo(wv); nw[mt][2 * g + 1] = glc * S[mt][2 * g + 1] + bfhi(wv); } \
                nw[mt] = MFMA32(A[B][mt][0], b0, nw[mt]); nw[mt] = MFMA32(A[B][mt][1], b1, nw[mt]); nw[mt] = MFMA32(A[B][mt][2], b2, nw[mt]); nw[mt] = MFMA32(A[B][mt][3], b3, nw[mt]); } \
            S[0] = nw[0]; S[1] = nw[1]; Gs += gstep; } while (0)
        SCAN_DMA(); SCAN_DMA(); SCAN_DMA(); SCAN_DMA(); SCAN_DMA();
        asm volatile("s_waitcnt vmcnt(48)" ::: "memory"); SCAN_LOAD(0);
        asm volatile("s_waitcnt vmcnt(36)" ::: "memory"); SCAN_LOAD(1);
        for (int step = 0; step < nch; step += 2) {
            SCAN_STEP(0, step);     asm volatile("s_waitcnt vmcnt(24)" ::: "memory"); SCAN_LOAD(0); SCAN_DMA();
            SCAN_STEP(1, step + 1); asm volatile("s_waitcnt vmcnt(24)" ::: "memory"); SCAN_LOAD(1); SCAN_DMA();
        }
        asm volatile("s_waitcnt vmcnt(0)" ::: "memory");
#undef SCAN_DMA
#undef SCAN_LOAD
#undef SCAN_STEP
    }
    attn_wave_units(args, L, c);
}

DI void dil_merge(const Ctx& c) {
    { const bf16_t* DP = BIGP(bf16_t, B_DILP); const float* DM = BIGP(float, B_DILM); bf16_t* OD = BIGP(bf16_t, B_ONA) + 256;
        for (int it = c.bid * 512 + c.tid; it < c.stok * 32; it += c.G * 512) { const int tok = it >> 5, part = it & 31;
            u32x4 w = {0u, 0u, 0u, 0u};
            if (part < 16) { const int hd = part >> 3, p = part & 7; float m[3], dn[3];
#pragma unroll
                for (int g = 0; g < 3; ++g) { const size_t b = (((size_t)g * SLABMAX + tok) * 2 + hd); m[g] = DM[b * 2]; dn[g] = DM[b * 2 + 1]; }
                const float M = fmaxf(m[0], fmaxf(m[1], m[2])); float num[8], den = 0.f;
#pragma unroll
                for (int j = 0; j < 8; ++j) num[j] = 0.f;
#pragma unroll
                for (int g = 0; g < 3; ++g) { const float f = __expf(m[g] - M); den += f * dn[g]; const u32x4 a = *(const u32x4*)(DP + (((size_t)g * SLABMAX + tok) * 2 + hd) * 64 + 8 * p);
                    num[0] += f * bflo(a[0]); num[1] += f * bfhi(a[0]); num[2] += f * bflo(a[1]); num[3] += f * bfhi(a[1]); num[4] += f * bflo(a[2]); num[5] += f * bfhi(a[2]); num[6] += f * bflo(a[3]); num[7] += f * bfhi(a[3]); }
                const float inv = frcp(den);
                w.x = pk2(num[0] * inv, num[1] * inv); w.y = pk2(num[2] * inv, num[3] * inv); w.z = pk2(num[4] * inv, num[5] * inv); w.w = pk2(num[6] * inv, num[7] * inv); }
            if (part < 16) *(u32x4*)(OD + (size_t)tok * 768 + 8 * part) = w; } }
}

DI void phase_gdn_out(KArgs args, LAS unsigned char* L, const Ctx& c) {
    dil_merge(c);
    const int lane = c.lane, wave = c.wave, tid = c.tid, l = c.layer;
    const bf16_t* PROJ = BIGP(bf16_t, B_PROJ); unsigned char* GS = BIGP(unsigned char, B_GSCR); bf16_t* OG = BIGP(bf16_t, B_ONA) + 384;
    LAS float* OF = (LAS float*)L;
    for (int u = c.bid; u < (c.stok >> 6) * 6; u += c.G) { const int gch = u / 6, head = u % 6;
        { const int dir = wave >> 2, mt = (wave >> 1) & 1, nt = wave & 1, rr = lane & 31, hh = lane >> 5;
            const unsigned char* G = GS + (size_t)((gch * 6 + head) * 2 + dir) * GSTRIDE;
            const bf16_t* Qe = (const bf16_t*)(G + 16384); const bf16_t* Oct = (const bf16_t*)(G + 24576); const bf16_t* St = (const bf16_t*)(G + 32768);
            f32x16 acc = zero16();
#pragma unroll
            for (int ks = 0; ks < 4; ++ks) { const bf16x8 a = *(const bf16x8*)(Qe + (size_t)((mt * 4 + ks) * 64 + lane) * 8);
                const bf16x8 bw = *((const bf16x8*)St + (nt * 4 + ks) * 64 + lane); acc = MFMA32(a, bw, acc); }
            const int e = 32 * nt + rr;
            const u32x4 oc0 = *((const u32x4*)Oct + ((nt * 2 + mt) * 2) * 64 + lane), oc1 = *((const u32x4*)Oct + ((nt * 2 + mt) * 2 + 1) * 64 + lane);
#pragma unroll
            for (int g = 0; g < 4; ++g) { u32x2 w; w.x = (g == 0) ? oc0.x : (g == 1) ? oc0.z : (g == 2) ? oc1.x : oc1.z; w.y = (g == 0) ? oc0.y : (g == 1) ? oc0.w : (g == 2) ? oc1.y : oc1.w;
                const float v0 = acc[4 * g] + bflo(w.x), v1 = acc[4 * g + 1] + bfhi(w.x), v2 = acc[4 * g + 2] + bflo(w.y), v3 = acc[4 * g + 3] + bfhi(w.y);
                const int i0 = 32 * mt + 8 * g + 4 * hh;
#pragma unroll
                for (int j = 0; j < 4; ++j) { const int ii = i0 + j, tl = dir ? 63 - ii : ii; OF[(dir * 64 + tl) * 68 + e] = (j == 0) ? v0 : (j == 1) ? v1 : (j == 2) ? v2 : v3; } } }
        __syncthreads();
        { const int i = tid >> 3, p = tid & 7; const size_t tok = (size_t)gch * 64 + i;
            const LAS float* a = OF + i * 68 + 8 * p; const LAS float* b = OF + (64 + i) * 68 + 8 * p;
            float ov[8]; float ss = 0.f;
#pragma unroll
            for (int j = 0; j < 8; ++j) { ov[j] = a[j] + b[j]; ss += ov[j] * ov[j]; }
            ss += __shfl_xor(ss, 1); ss += __shfl_xor(ss, 2); ss += __shfl_xor(ss, 4);
            const float rs = frsq(ss * (1.0f / 64.0f) + NORM_EPS);
            const u32x4 zw = *(const u32x4*)(PROJ + tok * NPROJ + C_ZC + 64 * head + 8 * p);
            const float* nw = args->in[7] + l * 64 + 8 * p;
            float r[8];
#pragma unroll
            for (int j = 0; j < 4; ++j) { r[2 * j] = ov[2 * j] * rs * nw[2 * j] * siluf_(bflo(zw[j])); r[2 * j + 1] = ov[2 * j + 1] * rs * nw[2 * j + 1] * siluf_(bfhi(zw[j])); }
            u32x4 w; w.x = pk2(r[0], r[1]); w.y = pk2(r[2], r[3]); w.z = pk2(r[4], r[5]); w.w = pk2(r[6], r[7]);
            *(u32x4*)(OG + tok * 768 + 64 * head + 8 * p) = w; }
        __syncthreads();
    }
}

DI void phase_ln1(KArgs args, LAS unsigned char* L, const Ctx& c) {
    const int lane = c.lane, l = c.layer;
    LAS float* WR = (LAS float*)L;
    { const float* wr = args->in[14] + (size_t)l * D * 16;
        for (int i = c.tid; i < D * 16; i += 512) { const int col = i >> 4, e = i & 15, j = col >> 8, ln = (col >> 2) & 63, q = col & 3; WR[((j * 4 + q) * 64 + ln) * 20 + e] = wr[i]; } }
    __syncthreads();
    const float* g1 = args->in[12] + l * D; const float* b1 = args->in[13] + l * D;
    f32x4 gv[4], bv[4];
#pragma unroll
    for (int j = 0; j < 4; ++j) { gv[j] = *(const f32x4*)(g1 + 4 * lane + 256 * j); bv[j] = *(const f32x4*)(b1 + 4 * lane + 256 * j); }
    float* AFF = WSP(float, WS_AFF); int* SLOT = WSP(int, WS_SLOT); bf16_t* XB = WSP(bf16_t, WS_XB);
    u32x2 nv[4];
    { const int rl0 = c.bid * 8 + c.wave; if (rl0 < c.stok) { const bf16_t* hp = (const bf16_t*)c.out + ((size_t)c.sbase + rl0) * D;
#pragma unroll
        for (int j = 0; j < 4; ++j) nv[j] = *(const u32x2*)(hp + 4 * lane + 256 * j); } }
    for (int rl = c.bid * 8 + c.wave; rl < c.stok; rl += c.G * 8) { const size_t tok = (size_t)c.sbase + rl;
        const bf16_t* hr = (const bf16_t*)c.out + tok * D; f32x4 v[4]; float s = 0.f;
#pragma unroll
        for (int j = 0; j < 4; ++j) { v[j][0] = bflo(nv[j].x); v[j][1] = bfhi(nv[j].x); v[j][2] = bflo(nv[j].y); v[j][3] = bfhi(nv[j].y); s += (v[j][0] + v[j][1]) + (v[j][2] + v[j][3]); }
        if (rl + c.G * 8 < c.stok) { const bf16_t* hp = hr + (size_t)c.G * 8 * D;
#pragma unroll
            for (int j = 0; j < 4; ++j) nv[j] = *(const u32x2*)(hp + 4 * lane + 256 * j); }
        const float mean = wave_sum(s) * (1.0f / D); float s2 = 0.f;
#pragma unroll
        for (int j = 0; j < 4; ++j) { v[j] = v[j] - mean; s2 += (v[j][0] * v[j][0] + v[j][1] * v[j][1]) + (v[j][2] * v[j][2] + v[j][3] * v[j][3]); }
        const float rstd = frsq(wave_sum(s2) * (1.0f / D) + LN_EPS);
        float lg[16];
#pragma unroll
        for (int e = 0; e < 16; ++e) lg[e] = 0.f;
#pragma unroll
        for (int j = 0; j < 4; ++j) { v[j] = v[j] * rstd * gv[j] + bv[j];
            if (!c.dry) { u32x2 w; w.x = pk2(v[j][0], v[j][1]); w.y = pk2(v[j][2], v[j][3]); *(u32x2*)(XB + tok * D + 4 * lane + 256 * j) = w; }
#pragma unroll
            for (int q = 0; q < 4; ++q) { const LAS float* wp = WR + ((j * 4 + q) * 64 + lane) * 20; const float xv = v[j][q];
#pragma unroll
                for (int e4 = 0; e4 < 4; ++e4) { const f32x4 w4 = *(const LAS f32x4*)(wp + 4 * e4); lg[4 * e4] += xv * w4[0]; lg[4 * e4 + 1] += xv * w4[1]; lg[4 * e4 + 2] += xv * w4[2]; lg[4 * e4 + 3] += xv * w4[3]; } }
            asm volatile("" ::: "memory"); }
        float mx = -1e30f;
#pragma unroll
        for (int e = 0; e < 16; ++e) { lg[e] = wave_sum(lg[e]); mx = fmaxf(mx, lg[e]); }
        float den = 0.f;
#pragma unroll
        for (int e = 0; e < 16; ++e) { lg[e] = expf(lg[e] - mx); den += lg[e]; }
        float mine = 0.f;
#pragma unroll
        for (int e = 0; e < 16; ++e) mine = (lane == e) ? lg[e] : mine;
        if (lane < 16 && !c.dry) { AFF[(size_t)lane * T_ALL + tok] = mine / den; SLOT[tok * 16 + lane] = -1; }
    }
}
DI void phase_ln2(KArgs args, LAS unsigned char* L, const Ctx& c) {
    const int lane = c.lane, l = c.layer;
    const float* g2 = args->in[18] + l * D; const float* b2 = args->in[19] + l * D;
    f32x4 gv[4], bv[4];
#pragma unroll
    for (int j = 0; j < 4; ++j) { gv[j] = *(const f32x4*)(g2 + 4 * lane + 256 * j); bv[j] = *(const f32x4*)(b2 + 4 * lane + 256 * j); }
    const int* SLOT = WSP(int, WS_SLOT); bf16_t* XB = WSP(bf16_t, WS_XB);
    u32x2 nv[4]; int nsv = -1;
    { const int t0 = c.bid * 8 + c.wave; if (t0 < T_ALL) { const bf16_t* xp = XB + (size_t)t0 * D; nsv = SLOT[(size_t)t0 * 16 + (lane & 15)];
#pragma unroll
        for (int j = 0; j < 4; ++j) nv[j] = *(const u32x2*)(xp + 4 * lane + 256 * j); } }
    for (int t = c.bid * 8 + c.wave; t < T_ALL; t += c.G * 8) { const size_t tok = (size_t)t;
        float* xr = c.out + tok * D; f32x4 v[4];
#pragma unroll
        for (int j = 0; j < 4; ++j) { v[j][0] = bflo(nv[j].x) * ALPHA; v[j][1] = bfhi(nv[j].x) * ALPHA; v[j][2] = bflo(nv[j].y) * ALPHA; v[j][3] = bfhi(nv[j].y) * ALPHA; }
        const int sv = nsv;
        if (t + c.G * 8 < T_ALL) { const bf16_t* xp = XB + (tok + c.G * 8) * D; nsv = SLOT[(tok + c.G * 8) * 16 + (lane & 15)];
#pragma unroll
            for (int j = 0; j < 4; ++j) nv[j] = *(const u32x2*)(xp + 4 * lane + 256 * j); }
#pragma unroll
        for (int e = 0; e < 16; ++e) { const int s = __builtin_amdgcn_readlane(sv, e);
            if (s >= 0) { const bf16_t* yr = BIGP(bf16_t, (e < 8 ? B_XY0 : B_XY1)) + ((size_t)(e & 7) * CAP + s) * D;
#pragma unroll
                for (int j = 0; j < 4; ++j) { const u32x2 w = *(const u32x2*)(yr + 4 * lane + 256 * j); v[j][0] += bflo(w.x); v[j][1] += bfhi(w.x); v[j][2] += bflo(w.y); v[j][3] += bfhi(w.y); } } }
        float s = 0.f;
#pragma unroll
        for (int j = 0; j < 4; ++j) s += (v[j][0] + v[j][1]) + (v[j][2] + v[j][3]);
        const float mean = wave_sum(s) * (1.0f / D); float s2 = 0.f;
#pragma unroll
        for (int j = 0; j < 4; ++j) { v[j] = v[j] - mean; s2 += (v[j][0] * v[j][0] + v[j][1] * v[j][1]) + (v[j][2] * v[j][2] + v[j][3] * v[j][3]); }
        const float rstd = frsq(wave_sum(s2) * (1.0f / D) + LN_EPS);
#pragma unroll
        for (int j = 0; j < 4; ++j) { v[j] = v[j] * rstd * gv[j] + bv[j];
            if (!c.dry) {
                if (l == 1) *(f32x4*)(xr + 4 * lane + 256 * j) = v[j];
                else { u32x2 w; w.x = pk2(v[j][0], v[j][1]); w.y = pk2(v[j][2], v[j][3]); *(u32x2*)(XB + tok * D + 4 * lane + 256 * j) = w;
                    *(unsigned*)(WSP(unsigned char, WS_XB8) + tok * D + 4 * lane + 256 * j) = pk4_fp8(v[j][0], v[j][1], v[j][2], v[j][3]); } } }
    }
}

DI int block_excl_scan(int v, LAS int* tmp, int tid, int& total) {
    const int lane = tid & 63, wave = tid >> 6; int x = v;
#pragma unroll
    for (int o = 1; o < 64; o <<= 1) { const int y = __shfl_up(x, o); if (lane >= o) x += y; }
    __syncthreads();
    if (lane == 63) tmp[wave] = x;
    __syncthreads();
    int base = 0, tot = 0;
#pragma unroll
    for (int w = 0; w < 8; ++w) { const int tw = tmp[w]; if (w < wave) base += tw; tot += tw; }
    total = tot;
    return base + x - v;
}
DI void phase_select(KArgs args, LAS unsigned char* L, const Ctx& c, int inst) {
    if (inst < 0 || inst >= 32) return;
    const int tid = c.tid, grp = inst >> 4, e = inst & 15;
    const int n = grp ? T_S : T_P, t0 = grp ? T_P : 0, C = n >> 3, slot0 = grp ? CAP_P : 0;
    const unsigned* v = (const unsigned*)(WSP(float, WS_AFF) + (size_t)e * T_ALL + t0);
    LAS unsigned* hist = (LAS unsigned*)L; LAS int* sh = (LAS int*)(L + 8192); LAS int* tmp = (LAS int*)(L + 8192 + 64);
    unsigned prefix = 0u; int kk = C;
    for (int pass = 0; pass < 3; ++pass) {
        const int shift = pass == 0 ? 21 : (pass == 1 ? 10 : 0); const unsigned bmask = pass == 2 ? 1023u : 2047u;
        const unsigned mhi = pass == 0 ? 0u : (pass == 1 ? 0xFFE00000u : 0xFFFFFC00u);
        { unsigned zz; asm volatile("v_mov_b32 %0, 0" : "=v"(zz)); u32x4 z4; z4.x = zz; z4.y = zz; z4.z = zz; z4.w = zz; *(LAS u32x4*)(hist + 4 * tid) = z4; }
        __syncthreads();
        for (int i = tid * 4; i < n; i += 512 * 16) {
            u32x4 x4[4];
#pragma unroll
            for (int k = 0; k < 4; ++k) x4[k] = *(const u32x4*)(v + i + k * 2048);
#pragma unroll
            for (int k = 0; k < 4; ++k)
#pragma unroll
                for (int j = 0; j < 4; ++j) { const unsigned x = x4[k][j]; if ((x & mhi) == prefix) __hip_atomic_fetch_add(&hist[(x >> shift) & bmask], 1u, __ATOMIC_RELAXED, __HIP_MEMORY_SCOPE_WORKGROUP); } }
        __syncthreads();
        {
            const u32x4 hv = *(const LAS u32x4*)(hist + 2044 - 4 * tid); int tot;
            int cum = block_excl_scan((int)(hv[0] + hv[1] + hv[2] + hv[3]), tmp, tid, tot);
            const int c1 = cum + (int)hv.w, c2 = c1 + (int)hv.z, c3 = c2 + (int)hv.y, c4 = c3 + (int)hv.x;
            if (cum < kk && kk <= c4) { const int j = kk <= c1 ? 0 : (kk <= c2 ? 1 : (kk <= c3 ? 2 : 3)); const int cb = kk <= c1 ? cum : (kk <= c2 ? c1 : (kk <= c3 ? c2 : c3));
                sh[0] = 2047 - 4 * tid - j; sh[1] = kk - cb; } }
        __syncthreads();
        prefix |= ((unsigned)sh[0]) << shift; kk = sh[1];
        __syncthreads();
    }
    const unsigned thr = prefix;
    const int per = n >> 9, i0 = tid * per;
    int ngt = 0, ntie = 0;
    for (int i = 0; i < per; i += 4) { const u32x4 x = *(const u32x4*)(v + i0 + i);
#pragma unroll
        for (int j = 0; j < 4; ++j) { ngt += (x[j] > thr); ntie += (x[j] == thr); } }
    int tot;
    const int tie_base = block_excl_scan(ntie, tmp, tid, tot);
    int take = kk - tie_base; take = take < 0 ? 0 : (take > ntie ? ntie : take);
    int pos = block_excl_scan(ngt + take, tmp, tid, tot);
    int* IDX = WSP(int, WS_IDX) + e * CAP + slot0;
    int tr = 0;
    for (int i = 0; i < per; i += 4) { const u32x4 x = *(const u32x4*)(v + i0 + i);
#pragma unroll
        for (int j = 0; j < 4; ++j) { bool s = x[j] > thr; if (x[j] == thr) { s = tr < take; ++tr; } if (s) { IDX[pos] = t0 + i0 + i + j; ++pos; } } }
}
DI void phase_gather(KArgs args, LAS unsigned char* L, const Ctx& c) {
    const int lane = c.lane; const int* IDX = WSP(int, WS_IDX); const bf16_t* XB = WSP(bf16_t, WS_XB);
    float* GATEV = WSP(float, WS_GATEV); int* SLOT = WSP(int, WS_SLOT); const float* AFF = WSP(float, WS_AFF);
    for (int row0 = (c.bid * 8 + c.wave) * 4; row0 < NE * CAP; row0 += c.G * 8 * 4) {
        const int e = row0 / CAP, s0 = row0 % CAP; int t[4]; u32x4 a[4], b[4];
#pragma unroll
        for (int k = 0; k < 4; ++k) t[k] = IDX[row0 + k];
#pragma unroll
        for (int k = 0; k < 4; ++k) { const u32x4* src = (const u32x4*)(XB + (size_t)t[k] * D) + 2 * lane; a[k] = src[0]; b[k] = src[1]; }
        u32x4* dst = (u32x4*)(BIGP(unsigned char, (e < 8 ? B_XY0 : B_XY1)) + ((size_t)(e & 7) * CAP + s0) * D);
#pragma unroll
        for (int k = 0; k < 4; ++k) { u32x4 w;
            w.x = pk4_fp8(bflo(a[k].x), bfhi(a[k].x), bflo(a[k].y), bfhi(a[k].y)); w.y = pk4_fp8(bflo(a[k].z), bfhi(a[k].z), bflo(a[k].w), bfhi(a[k].w));
            w.z = pk4_fp8(bflo(b[k].x), bfhi(b[k].x), bflo(b[k].y), bfhi(b[k].y)); w.w = pk4_fp8(bflo(b[k].z), bfhi(b[k].z), bflo(b[k].w), bfhi(b[k].w));
            dst[k * 64 + lane] = w; }
        if (lane < 4) { const int tt = (lane == 0) ? t[0] : (lane == 1) ? t[1] : (lane == 2) ? t[2] : t[3]; SLOT[(size_t)tt * 16 + e] = s0 + lane; GATEV[row0 + lane] = AFF[(size_t)e * T_ALL + tt]; } }
}

__global__ void __launch_bounds__(512, 2) fwd_kernel(Args args) {
    extern __shared__ __attribute__((aligned(16))) unsigned char lds_raw[];
    LAS unsigned char* L = (LAS unsigned char*)lds_raw;
    Ctx c;
    c.out = args.out; c.ws = args.ws;
    c.tid = threadIdx.x; c.lane = c.tid & 63; c.wave = __builtin_amdgcn_readfirstlane(c.tid >> 6); c.G = gridDim.x; c.bid = blockIdx.x;
    c.layer = 0; c.slab = 0; c.nseq = 8; c.seqlen = 4096; c.stok = 32768; c.sbase = 0; c.dry = 0;
    const int lo = args.ph_lo, hi = args.ph_hi;
    volatile LAS unsigned* MISC = (volatile LAS unsigned*)(L + LDS_MISC);
    if (c.tid < 4) MISC[c.tid] = 0u;
    __syncthreads();
    XcdBarrier bar; bar.bar = (unsigned*)(c.ws + WS_CTL) + 1024; bar.x = 0; bar.st = MISC;
    if (hi - lo > 1) bar = xcd_barrier_post((unsigned*)(c.ws + WS_CTL) + 1024, MISC);
    int pc = 0;
#ifndef PHMASK
#define PHMASK 0xFFFF
#endif
#define PHON(k) (((PHMASK) >> (k)) & 1)
#ifndef REPMASK
#define REPMASK 0x0
#endif
#define PH_BEGIN(k) if (PHON(k) && pc >= lo && pc < hi) { { int tz = threadIdx.x; asm volatile("" : "+v"(tz)); c.tid = tz; c.lane = tz & 63; c.wave = __builtin_amdgcn_readfirstlane(tz >> 6); } KArgs ka = kargs(); c.ws = ka->ws; c.out = ka->out; { int b_ = blockIdx.x, g_ = gridDim.x; asm volatile("" : "+s"(b_), "+s"(g_)); c.bid = b_; c.G = g_; } for (int rep_ = 0; rep_ < (((REPMASK) >> (k)) & 1) + 1; ++rep_) { if (rep_) __syncthreads(); c.dry = (rep_ + 1 < (((REPMASK) >> (k)) & 1) + 1);
#ifndef BARREP
#define BARREP 0
#endif
#define PH_END   } if (pc + 1 < hi) { xcd_barrier(bar); if (BARREP) { xcd_barrier(bar); xcd_barrier(bar); } } else { asm volatile("s_waitcnt vmcnt(0)" ::: "memory"); __syncthreads(); } } ++pc;

    for (int layer = 0; layer < 2; ++layer) {
        c.layer = layer;
        PH_BEGIN(0) phase_weights(ka, L, c); PH_END
        for (int slab = 0; slab < NSLAB; ++slab) {
            c.slab = slab; c.nseq = slab < 2 ? 8 : 1; c.seqlen = slab < 2 ? 4096 : 16384; c.stok = slab < 2 ? 32768 : 16384; c.sbase = slab * 32768; const int stok = c.stok; const size_t sbase = (size_t)c.sbase;
            PH_BEGIN(1) {
                const int swp = (c.bid >> 2) & 1;
                for (int k2 = 0; k2 < 2; ++k2) {
                  if ((k2 ^ swp) == 0) { pg8::Gemm g{WSP(bf16_t, WS_XB) + sbase * D, WSP(bf16_t, WS_WIN), stok, 3584, D}; pg8::StaticOrder S; S.init(stok, 3584, c.G, c.bid);
                    pg8::EpiInProj E{BIGP(bf16_t, B_PROJ), BIGP(float, B_BA)};
                    pg8::gemm_phase<pg8::EpiInProj, pg8::StaticOrder>(L, g, S, E); }
                  else { pg8::Gemm g{(const bf16_t*)(WSP(unsigned char, WS_XB8) + sbase * D), (const bf16_t*)WSP(unsigned char, WS_WG8), stok, 3072, D / 2}; pg8::StaticOrder S; S.init(stok, 3072, c.G, c.bid);
                    pg8::EpiGates E{BIGP(u32x4, B_GATES)};
                    pg8::gemm_phase<pg8::EpiGates, pg8::StaticOrder>(L, g, S, E); } } } PH_END
            PH_BEGIN(2) phase_mix_a(ka, L, c); PH_END
            PH_BEGIN(3) phase_scan(ka, L, c); PH_END
            PH_BEGIN(4) phase_gdn_out(ka, L, c); PH_END
            PH_BEGIN(5) {
                pg8::StaticOrder S; S.init(stok, D, c.G, c.bid);
                pg8::Gemm g{BIGP(bf16_t, B_ONA), WSP(bf16_t, WS_WBR), stok, D, 768}; pg8::EpiGateCat E{BIGP(u32x4, B_GATES), BIGP(bf16_t, B_MERGED)};
                pg8::gemm_phase<pg8::EpiGateCat, pg8::StaticOrder>(L, g, S, E); } PH_END
            PH_BEGIN(6) {
                pg8::Gemm g{BIGP(bf16_t, B_MERGED), WSP(bf16_t, WS_WOUT), stok, D, D}; pg8::StaticOrder S; S.init(stok, D, c.G, c.bid);
                pg8::EpiRes E{WSP(bf16_t, WS_XB) + sbase * D, (bf16_t*)c.out + sbase * D};
                pg8::gemm_phase<pg8::EpiRes, pg8::StaticOrder>(L, g, S, E); } PH_END
#ifndef LN1PROBE
#define LN1PROBE 0
#endif
            PH_BEGIN(7) if (LN1PROBE) { c.dry = 1; phase_ln1(ka, L, c); __syncthreads(); c.dry = 0; } phase_ln1(ka, L, c); PH_END
        }
        PH_BEGIN(8) phase_select(ka, L, c, c.bid < 16 ? 16 + c.bid : -1); PH_END
        PH_BEGIN(9) phase_gather(ka, L, c); PH_END
        for (int half = 0; half < 2; ++half) {
            PH_BEGIN(10) {
                pg8::Gemm g{BIGP(bf16_t, half ? B_XY1 : B_XY0), (const bf16_t*)(WSP(unsigned char, WS_WGU) + (size_t)half * 8 * 4096 * D), 8 * CAP, 8 * 4096, D / 2}; pg8::MoeOrder S; S.init(8, CAP / 256, 16, c.G, c.bid);
                pg8::EpiSwiglu E{BIGP(unsigned char, B_HID)};
                pg8::gemm_phase<pg8::EpiSwiglu, pg8::MoeOrder>(L, g, S, E); } PH_END
            PH_BEGIN(11) {
                pg8::Gemm g{BIGP(bf16_t, B_HID), (const bf16_t*)(WSP(unsigned char, WS_WD) + (size_t)half * 8 * D * DE), 8 * CAP, 8 * D, DE / 2}; pg8::MoeOrder S; S.init(8, CAP / 256, 4, c.G, c.bid);
                pg8::EpiDown E{BIGP(bf16_t, half ? B_XY1 : B_XY0), WSP(float, WS_GATEV) + (size_t)half * 8 * CAP};
                pg8::gemm_phase<pg8::EpiDown, pg8::MoeOrder>(L, g, S, E); } PH_END
        }
        PH_BEGIN(12) phase_ln2(ka, L, c); PH_END
    }
#undef PH_BEGIN
#undef PH_END
}

constexpr int N_PHASES = 2 * (1 + NSLAB * 7 + 2 + 4 + 1);

extern "C" void kernel_launch(void* const* d_in, const int* in_sizes, int n_in, void* d_out, int out_size, void* d_ws, size_t ws_size, hipStream_t stream) {
    static int grid = 0;
    if (grid == 0) {
        if (n_in != 20 || ws_size < WS_END) { fprintf(stderr, "kernel_launch: unexpected n_in %d or ws_size %zu (< %zu)\n", n_in, ws_size, (size_t)WS_END); grid = -1; return; }
        int dev = 0, cus = 0, per_cu = 0;
        if (hipGetDevice(&dev) != hipSuccess || hipDeviceGetAttribute(&cus, hipDeviceAttributeMultiprocessorCount, dev) != hipSuccess) { grid = -1; return; }
        if (hipFuncSetAttribute((const void*)fwd_kernel, hipFuncAttributeMaxDynamicSharedMemorySize, LDS_BYTES) != hipSuccess) { fprintf(stderr, "kernel_launch: hipFuncSetAttribute failed\n"); grid = -1; return; }
        if (hipOccupancyMaxActiveBlocksPerMultiprocessor(&per_cu, (const void*)fwd_kernel, 512, LDS_BYTES) != hipSuccess || per_cu < 1) fprintf(stderr, "kernel_launch: occupancy query says %d\n", per_cu);
        (void)hipGetLastError();
        grid = cus;
    }
    if (grid < 0) return;
    (void)hipMemsetAsync((char*)d_ws + WS_CTL, 0, 1 * MiB, stream);
    Args a{};
    for (int i = 0; i < 20; ++i) a.in[i] = (const float*)d_in[i];
    a.out = (float*)d_out; a.ws = (unsigned char*)d_ws;
#if MK_N_LAUNCHES == 1
    a.ph_lo = 0; a.ph_hi = N_PHASES;
    hipLaunchKernelGGL(fwd_kernel, dim3(grid), dim3(512), LDS_BYTES, stream, a);
#else
    for (int p = 0; p < N_PHASES; ++p) { a.ph_lo = p; a.ph_hi = p + 1; hipLaunchKernelGGL(fwd_kernel, dim3(grid), dim3(512), LDS_BYTES, stream, a); }
#endif
}
```

```cpp
#include <hip/hip_runtime.h>
#include <stdint.h>
#include <stdio.h>

#define LAS __attribute__((address_space(3)))
#define DI __device__ __forceinline__
typedef unsigned short bf16_t;
typedef short bf16x8 __attribute__((ext_vector_type(8)));
typedef float f32x4 __attribute__((ext_vector_type(4)));
typedef float f32x2 __attribute__((ext_vector_type(2)));
typedef float f32x16 __attribute__((ext_vector_type(16)));
typedef unsigned u32x4 __attribute__((ext_vector_type(4)));
typedef unsigned u32x2 __attribute__((ext_vector_type(2)));
typedef __bf16 bf16x2v __attribute__((ext_vector_type(2)));

#ifndef MK_N_LAUNCHES
#define MK_N_LAUNCHES 1
#endif

constexpr int D = 1024, T_ALL = 81920, T_P = 65536, T_S = 16384, SLABMAX = 32768, NSLAB = 3;
constexpr int DIN = 6552, NPROJ = 3584;
constexpr int C_QA = 0, C_KA = 256, C_VA = 512, C_QD = 768, C_KD = 1152, C_VD = 1536, C_QC = 1920, C_KC = 2304, C_VC = 2688, C_ZC = 3072;
constexpr int NE = 16, DE = 2048, CAP_P = 8192, CAP_S = 2048, CAP = CAP_P + CAP_S;
constexpr float ALPHA = 1.41421356237f, LN_EPS = 1e-5f, NORM_EPS = 1e-6f;
constexpr size_t MiB = 1u << 20;
constexpr size_t WS_CTL = 0, WS_WIN = 1 * MiB, WS_WBR = 14 * MiB, WS_WOUT = 16 * MiB, WS_WGU = 18 * MiB, WS_WD = 82 * MiB, WS_XB8 = 114 * MiB, WS_WG8 = 194 * MiB, WS_XB = 210 * MiB;
constexpr size_t WS_AFF = 370 * MiB, WS_SLOT = 375 * MiB, WS_IDX = 380 * MiB, WS_GATEV = 381 * MiB, WS_CS = 382 * MiB, WS_BIG = 386 * MiB, WS_END = 1130 * MiB;
constexpr size_t B_PROJ = 0, B_GATES = 224 * MiB, B_BA = 416 * MiB, B_ONA = 420 * MiB, B_ODIL = 436 * MiB, B_OGDN = 452 * MiB, B_DILP = 476 * MiB, B_DILM = 500 * MiB, B_GSCR = 502 * MiB, B_MERGEF = 502 * MiB, B_MERGED = 630 * MiB;
constexpr size_t B_XY0 = 0, B_XY1 = 160 * MiB, B_HID = 320 * MiB;
constexpr int GSTRIDE = 41216;
constexpr int LDS_BYTES = 151552;
constexpr int LDS_MISC = 145408, LDS_CW = LDS_MISC + 256;

DI unsigned pk2(float lo, float hi) { f32x2 v = {lo, hi}; bf16x2v b = __builtin_convertvector(v, bf16x2v); return __builtin_bit_cast(unsigned, b); }
DI unsigned pk4_fp8(float a, float b, float c, float d) {
    int w = __builtin_amdgcn_cvt_pk_fp8_f32(a, b, 0, false); w = __builtin_amdgcn_cvt_pk_fp8_f32(c, d, w, true); return (unsigned)w; }
DI float bflo(unsigned u) { return __uint_as_float(u << 16); }
DI float bfhi(unsigned u) { return __uint_as_float(u & 0xffff0000u); }
DI float frcp(float x) { return __builtin_amdgcn_rcpf(x); }
DI float frsq(float x) { return __builtin_amdgcn_rsqf(x); }
DI float sigmoidf_(float x) { return frcp(1.0f + __expf(-x)); }
DI float siluf_(float x) { return x * frcp(1.0f + __expf(-x)); }
DI void lds_barrier() { asm volatile("s_waitcnt lgkmcnt(0)\n\ts_barrier" ::: "memory"); }
DI float wave_sum(float v) {
#pragma unroll
    for (int o = 1; o < 64; o <<= 1) v += __shfl_xor(v, o);
    return v;
}
#define MFMA32(a, b, c) __builtin_amdgcn_mfma_f32_32x32x16_bf16((a), (b), (c), 0, 0, 0)
DI int crow(int reg, int h) { return (reg & 3) + 8 * (reg >> 2) + 4 * h; }
DI f32x16 zero16() { f32x16 z; for (int i = 0; i < 16; ++i) z[i] = 0.f; return z; }
template <int S> DI bf16x8 pack8(const f32x16& x) {
    u32x4 p; p[0] = pk2(x[8 * S], x[8 * S + 1]); p[1] = pk2(x[8 * S + 2], x[8 * S + 3]); p[2] = pk2(x[8 * S + 4], x[8 * S + 5]); p[3] = pk2(x[8 * S + 6], x[8 * S + 7]);
    return __builtin_bit_cast(bf16x8, p);
}

namespace pg8 {
constexpr int BM = 256, BK = 64, HALF = 128, HTB = HALF * BK * 2, STAGE_BYTES = 8 * HTB, NXCD = 8, WGM = 8;
__host__ __device__ __forceinline__ int lds_byte(int r, int c) { const int st = (r >> 4) * 2 + (c >> 5), rr = r & 15, cc = c & 31, ob = rr * 64 + cc * 2; return st * 1024 + (ob ^ (((ob >> 9) & 1) << 5)); }
__host__ __device__ __forceinline__ void stage_rc(int b, int& R, int& C) { const int st = b / 1024, sb = b % 1024, swz = sb ^ (((sb >> 9) & 1) << 5); R = (st >> 1) * 16 + swz / 64; C = (st & 1) * 32 + (swz % 64) / 2; }
__host__ __device__ __forceinline__ int perm32(int rho) { const int n = rho >> 4, i = rho & 15; return 8 * (i >> 2) + 4 * n + (i & 3); }
struct Unit { int pm, pn; };
struct Gemm { const bf16_t* A; const bf16_t* Bt; int M, N, K; };
struct StaticOrder {
    int nM, nN, nwg, G, c;
    __device__ void init(int M, int N, int G_, int c_) { nM = M / BM; nN = N / BM; nwg = nM * nN; G = G_; c = c_; }
    __device__ bool next(int i, Unit& u) const {
        const long L = (long)i * G + c; if (L >= nwg) return false;
        int wgid = (int)L; { const int q = nwg / NXCD, r = nwg % NXCD, xcd = wgid % NXCD, off = wgid / NXCD; wgid = (xcd < r ? xcd * (q + 1) : r * (q + 1) + (xcd - r) * q) + off; }
        const int nig = WGM * nN, gid = wgid / nig, fm = gid * WGM, gsz = (nM - fm) < WGM ? (nM - fm) : WGM;
        u.pm = fm + ((wgid % nig) % gsz); u.pn = (wgid % nig) / gsz; return true;
    }
    __device__ __forceinline__ void a_ready(const Unit&) const {}
    __device__ __forceinline__ void done(const Unit&) const {}
};
struct MoeOrder {
    int nMe, nNe, per, total, G, c, xr, xc, rpx, cpx, share;
    __device__ void init(int nE, int nMe_, int nNe_, int G_, int c_) { nMe = nMe_; nNe = nNe_; per = nMe * nNe; total = nE * per; G = G_; c = c_;
        xc = (nNe % 2 == 0 && nNe >= 8) ? 2 : 1; xr = 8 / xc; rpx = nMe / xr; cpx = nNe / xc; share = rpx * cpx; }
    __device__ bool next(int i, Unit& u) const {
        if ((G & 7) == 0 && nMe % xr == 0) {
            const int x = c & 7, q = c >> 3, nq = G >> 3; const long j = (long)i * nq + q; if (j >= (long)(total / 8)) return false;
            const int e = (int)(j / share), r = (int)(j % share); const int pm = (x / xc) * rpx + r % rpx, pn = (x % xc) * cpx + r / rpx;
            u.pm = e * nMe + pm; u.pn = e * nNe + pn; return true;
        }
        const long L = (long)i * G + c; if (L >= total) return false;
        const int e = (int)(L / per), r = (int)(L % per);
        u.pm = e * nMe + r % nMe; u.pn = e * nNe + r / nMe; return true;
    }
    __device__ __forceinline__ void a_ready(const Unit&) const {}
    __device__ __forceinline__ void done(const Unit&) const {}
};

template <class Epi, class Sched>
__device__ __forceinline__ void gemm_phase(LAS unsigned char* lds, const Gemm g, const Sched& S, const Epi& E) {
    int tid = threadIdx.x; asm volatile("" : "+v"(tid));
    const int wid = __builtin_amdgcn_readfirstlane(tid >> 6), lane = tid & 63, wr = wid >> 2, wc = wid & 3, fr = lane & 15, fq = lane >> 4;
    int Kv = g.K; asm volatile("" : "+s"(Kv));
    const int K = Kv, nt = K / BK;
    unsigned voffA[2], voffB[2];
#pragma unroll
    for (int i = 0; i < 2; ++i) { int R, C; stage_rc(tid * 16 + i * 8192, R, C); const int Rb = Epi::PERM ? ((R & ~31) + perm32(R & 31)) : R;
        voffA[i] = (unsigned)(R * K + C) * 2u; voffB[i] = (unsigned)(Rb * K + C) * 2u; }
    const size_t kstep = (size_t)(BK * 2);
    const size_t hstep = (size_t)HALF * K * 2;
    const size_t tstep = 2 * hstep;
    const unsigned ldsw = (unsigned)wid * 1024u;
    const int aoff = lds_byte(wr * 64 + fr, fq * 8), boff = lds_byte(wc * 32 + fr, fq * 8);
#define PG8_SA(b, h) (((b) * 2 + (h)) * HTB)
#define PG8_SB(b, h) ((4 + (b) * 2 + (h)) * HTB)
#define PG8_STAGE(bufoff, gbase, voff) do { _Pragma("unroll") for (int _i = 0; _i < 2; ++_i) \
        __builtin_amdgcn_global_load_lds((const unsigned*)((const char*)(gbase) + (voff)[_i]), (LAS unsigned*)(lds + (bufoff) + ldsw + _i * 8192), 16, 0, 0); } while (0)
#define PG8_LD8(p) __builtin_shufflevector(*(const LAS v4i_*)(p), *(const LAS v4i_*)((p) + 1024), 0, 1, 2, 3, 4, 5, 6, 7)
#define PG8_LDA(dst, b, h) do { _Pragma("unroll") for (int m = 0; m < 4; ++m) { if constexpr (Epi::FP8) dst##8[m] = PG8_LD8(lds + PG8_SA(b, h) + aoff + m * 2048); \
        else { _Pragma("unroll") for (int k = 0; k < 2; ++k) dst[m][k] = *(const LAS bf16x8*)(lds + PG8_SA(b, h) + aoff + m * 2048 + k * 1024); } } } while (0)
#define PG8_LDB(dst, b, h) do { _Pragma("unroll") for (int n = 0; n < 2; ++n) { if constexpr (Epi::FP8) dst##8[n] = PG8_LD8(lds + PG8_SB(b, h) + boff + n * 2048); \
        else { _Pragma("unroll") for (int k = 0; k < 2; ++k) dst[n][k] = *(const LAS bf16x8*)(lds + PG8_SB(b, h) + boff + n * 2048 + k * 1024); } } } while (0)
#define PG8_MMA(ai, bj, At, Bt) do { __builtin_amdgcn_s_setprio(1); _Pragma("unroll") for (int m = 0; m < 4; ++m) _Pragma("unroll") for (int n = 0; n < 2; ++n) { \
        if constexpr (Epi::FP8) asm volatile("v_mfma_scale_f32_16x16x128_f8f6f4 %0, %1, %2, %0, %3, %3 op_sel_hi:[0,0,0]" : "+v"(acc[ai][bj][m][n]) : "v"(Bt##8[n]), "v"(At##8[m]), "v"(fp8_unit_scale));   \
        else { _Pragma("unroll") for (int k = 0; k < 2; ++k) acc[ai][bj][m][n] = __builtin_amdgcn_mfma_f32_16x16x32_bf16(Bt[n][k], At[m][k], acc[ai][bj][m][n], 0, 0, 0); } } \
        __builtin_amdgcn_s_setprio(0); } while (0)
#define PG8_WAIT_V(n) asm volatile("s_waitcnt vmcnt(" #n ")" ::: "memory")
#define PG8_WAIT_L(n) asm volatile("s_waitcnt lgkmcnt(" #n ")" ::: "memory")
#define PG8_BAR __builtin_amdgcn_s_barrier()
#define PG8_SCHED __builtin_amdgcn_sched_barrier(0)
    Unit cur, nxt; int ui = 0;
    if (!S.next(0, cur)) return;
    f32x4 acc[2][2][4][2];
#pragma unroll
    for (int a = 0; a < 2; ++a)
#pragma unroll
        for (int b = 0; b < 2; ++b)
#pragma unroll
            for (int m = 0; m < 4; ++m)
#pragma unroll
                for (int n = 0; n < 2; ++n) acc[a][b][m][n] = (f32x4){0.f, 0.f, 0.f, 0.f};
    typedef int v4i_ __attribute__((ext_vector_type(4))); typedef int v8i_ __attribute__((ext_vector_type(8)));
    bf16x8 At[4][2], B0[2][2], B1[2][2]; v8i_ At8[4], B08[2], B18[2];
    int fp8_unit_scale = 0x7F7F7F7F; asm volatile("" : "+v"(fp8_unit_scale));
    const char* cA = (const char*)g.A + (size_t)cur.pm * tstep; const char* cB = (const char*)g.Bt + (size_t)cur.pn * tstep;
    S.a_ready(cur);
    PG8_STAGE(PG8_SB(0, 0), cB, voffB); PG8_STAGE(PG8_SA(0, 0), cA, voffA); PG8_STAGE(PG8_SB(0, 1), cB + hstep, voffB); PG8_STAGE(PG8_SA(0, 1), cA + hstep, voffA);
    if (wr == 1) PG8_BAR;
    PG8_WAIT_V(4); PG8_BAR;
    PG8_STAGE(PG8_SB(1, 0), cB + kstep, voffB); PG8_STAGE(PG8_SA(1, 0), cA + kstep, voffA); PG8_STAGE(PG8_SB(1, 1), cB + hstep + kstep, voffB);
    PG8_WAIT_V(6); PG8_BAR;
    for (;;) {
        const bool has_next = S.next(ui + 1, nxt);
        const char* nA = has_next ? (const char*)g.A + (size_t)nxt.pm * tstep : cA; const char* nB = has_next ? (const char*)g.Bt + (size_t)nxt.pn * tstep : cB;
        for (int t = 0; t < nt; t += 2) {
            const bool last = (t == nt - 2);
            const char* a1 = cA + (size_t)(t + 1) * kstep;
            const char* a2 = last ? nA : cA + (size_t)(t + 2) * kstep; const char* b2 = last ? nB : cB + (size_t)(t + 2) * kstep;
            const char* a3 = a2 + kstep; const char* b3 = b2 + kstep;
            if (last && has_next) S.a_ready(nxt);
            if constexpr (Epi::SEG) { if (t == 4 || t == 6) { int tz = tid; asm volatile("" : "+v"(tz)); const int wz = __builtin_amdgcn_readfirstlane(tz >> 6), lz = tz & 63; E.mid(acc, cur, t == 4 ? 0 : 1, wz >> 2, wz & 3, lz & 15, lz >> 4); } }
            PG8_LDB(B0, 0, 0); PG8_SCHED; PG8_LDA(At, 0, 0); PG8_STAGE(PG8_SA(1, 1), a1 + hstep, voffA);
            PG8_WAIT_L(8); PG8_BAR; PG8_WAIT_L(0); PG8_MMA(0, 0, At, B0); PG8_BAR; PG8_SCHED;
            PG8_LDB(B1, 0, 1); PG8_STAGE(PG8_SB(0, 0), b2, voffB);
            PG8_BAR; PG8_WAIT_L(0); PG8_MMA(0, 1, At, B1); PG8_BAR;
            PG8_LDA(At, 0, 1); PG8_STAGE(PG8_SA(0, 0), a2, voffA);
            PG8_BAR; PG8_WAIT_L(0); PG8_MMA(1, 0, At, B0); PG8_BAR; PG8_SCHED;
            PG8_STAGE(PG8_SB(0, 1), b2 + hstep, voffB);
            PG8_WAIT_V(6); PG8_BAR; PG8_MMA(1, 1, At, B1); PG8_BAR;
            PG8_LDB(B0, 1, 0); PG8_SCHED; PG8_LDA(At, 1, 0); PG8_STAGE(PG8_SA(0, 1), a2 + hstep, voffA);
            PG8_WAIT_L(8); PG8_BAR; PG8_WAIT_L(0); PG8_MMA(0, 0, At, B0); PG8_BAR; PG8_SCHED;
            PG8_LDB(B1, 1, 1); PG8_STAGE(PG8_SB(1, 0), b3, voffB);
            PG8_BAR; PG8_WAIT_L(0); PG8_MMA(0, 1, At, B1); PG8_BAR;
            PG8_LDA(At, 1, 1); PG8_STAGE(PG8_SA(1, 0), a3, voffA);
            PG8_BAR; PG8_WAIT_L(0); PG8_MMA(1, 0, At, B0); PG8_BAR; PG8_SCHED;
            PG8_STAGE(PG8_SB(1, 1), b3 + hstep, voffB);
            PG8_WAIT_V(6); PG8_BAR; PG8_MMA(1, 1, At, B1); PG8_BAR;
        }
        if constexpr (Epi::FP8) asm volatile("s_nop 15\n\ts_nop 15\n\ts_nop 15" ::: "memory");
        { int tz = tid; asm volatile("" : "+v"(tz)); const int wz = __builtin_amdgcn_readfirstlane(tz >> 6), lz = tz & 63;
          E(acc, cur, wz >> 2, wz & 3, lz & 15, lz >> 4); } S.done(cur);
        if (!has_next) break;
#pragma unroll
        for (int a = 0; a < 2; ++a)
#pragma unroll
            for (int b = 0; b < 2; ++b)
#pragma unroll
                for (int m = 0; m < 4; ++m)
#pragma unroll
                    for (int n = 0; n < 2; ++n) acc[a][b][m][n] = (f32x4){0.f, 0.f, 0.f, 0.f};
        cur = nxt; cA = nA; cB = nB; ++ui;
    }
    PG8_WAIT_V(0);
    if (wr == 0) PG8_BAR;
    PG8_BAR;
#undef PG8_SA
#undef PG8_SB
#undef PG8_STAGE
#undef PG8_LDA
#undef PG8_LD8
#undef PG8_LDB
#undef PG8_MMA
#undef PG8_WAIT_V
#undef PG8_WAIT_L
#undef PG8_BAR
#undef PG8_SCHED
}

struct EpiInProj {
    static constexpr bool PERM = true, SEG = false, FP8 = false;
    bf16_t* O; float* BA;
    __device__ __forceinline__ void operator()(const f32x4 (&acc)[2][2][4][2], const Unit& u, int wr, int wc, int fr, int fq) const {
        const int row0 = u.pm * BM + wr * 64 + fr, col0 = u.pn * BM + wc * 32 + 8 * fq;
        const bool sig = false, ba = (u.pn == 13) && (wc == 0) && (fq < 3);
#pragma unroll
        for (int ai = 0; ai < 2; ++ai)
#pragma unroll
            for (int m = 0; m < 4; ++m) { int row = row0 + ai * HALF + m * 16; asm volatile("" : "+v"(row)); bf16_t* rowp = O + (size_t)row * NPROJ + col0;
#pragma unroll
                for (int bj = 0; bj < 2; ++bj) { f32x4 v0 = acc[ai][bj][m][0], v1 = acc[ai][bj][m][1];
                    if (sig) {
#pragma unroll
                        for (int j = 0; j < 4; ++j) { v0[j] = sigmoidf_(v0[j]); v1[j] = sigmoidf_(v1[j]); } }
                    u32x4 w; w.x = pk2(v0[0], v0[1]); w.y = pk2(v0[2], v0[3]); w.z = pk2(v1[0], v1[1]); w.w = pk2(v1[2], v1[3]);
                    *(u32x4*)(rowp + bj * HALF) = w;
                    if (bj == 1 && ba) { float* bp = BA + (size_t)row * 32 + 8 * fq; *(f32x4*)bp = v0; *(f32x4*)(bp + 4) = v1; } } }
    }
};
struct EpiGates {
    static constexpr bool PERM = true, SEG = false, FP8 = true;
    unsigned char* G;
    static __device__ __forceinline__ unsigned q4(const f32x4& v) { unsigned r = 0u;
#pragma unroll
        for (int j = 0; j < 4; ++j) r = __builtin_amdgcn_cvt_pk_u8_f32(fmaxf(sigmoidf_(v[j]) * 255.0f, 1.0f), j, r);
        return r; }
    __device__ __forceinline__ void operator()(const f32x4 (&acc)[2][2][4][2], const Unit& u, int wr, int wc, int fr, int fq) const {
#pragma unroll
        for (int ai = 0; ai < 2; ++ai)
#pragma unroll
            for (int m = 0; m < 4; ++m) {
                unsigned boff = (unsigned)(((u.pm * 12 + u.pn) * (16 * 512) + ((wr * 4 + wc) * 64 + fq * 16 + fr)) * 8 + ((ai * 4 + m) * 2) * 4096); asm volatile("" : "+v"(boff));
#pragma unroll
                for (int bj = 0; bj < 2; ++bj) { u32x2 w; w.x = q4(acc[ai][bj][m][0] * 0.03125f); w.y = q4(acc[ai][bj][m][1] * 0.03125f);
                    *(u32x2*)(G + (boff + bj * 4096)) = w; }
                asm volatile("" ::: "memory"); }
    }
};
struct EpiGateCat {
    static constexpr bool PERM = true, SEG = true, FP8 = false;
    const u32x2* GT; bf16_t* MB;
    static __device__ __forceinline__ float ub(unsigned x, int j) { return (float)((x >> (8 * j)) & 0xffu); }
    __device__ __forceinline__ void mid(f32x4 (&acc)[2][2][4][2], const Unit& u, int seg, int wr, int wc, int fr, int fq) const {
#pragma unroll
        for (int ai = 0; ai < 2; ++ai) {
            int toff = (wr * 4 + wc) * 64 + fq * 16 + fr; asm volatile("" : "+v"(toff));
            const u32x2* ga = GT + ((size_t)u.pm * 12 + seg * 4 + u.pn) * (16 * 512) + toff; const u32x2* gb = ga + (size_t)4 * 16 * 512;
            u32x2 A_[4][2], B_[4][2];
#pragma unroll
            for (int m = 0; m < 4; ++m)
#pragma unroll
                for (int bj = 0; bj < 2; ++bj) { A_[m][bj] = ga[((ai * 4 + m) * 2 + bj) * 512]; B_[m][bj] = gb[((ai * 4 + m) * 2 + bj) * 512]; }
#pragma unroll
            for (int m = 0; m < 4; ++m)
#pragma unroll
                for (int bj = 0; bj < 2; ++bj) { const u32x2 a_ = A_[m][bj], b_ = B_[m][bj]; f32x4& v0 = acc[ai][bj][m][0]; f32x4& v1 = acc[ai][bj][m][1];
#pragma unroll
                    for (int j = 0; j < 4; ++j) { v0[j] *= ub(a_.x, j) * frcp(ub(b_.x, j)); v1[j] *= ub(a_.y, j) * frcp(ub(b_.y, j)); } }
            asm volatile("" ::: "memory"); }
    }
    __device__ __forceinline__ void operator()(const f32x4 (&acc)[2][2][4][2], const Unit& u, int wr, int wc, int fr, int fq) const {
        const int row0 = u.pm * BM + wr * 64 + fr, col0 = u.pn * BM + wc * 32 + 8 * fq;
#pragma unroll
        for (int ai = 0; ai < 2; ++ai) {
            int rowb = row0 + ai * HALF; asm volatile("" : "+v"(rowb)); bf16_t* mp0 = MB + (size_t)rowb * D + col0;
            int toff = (wr * 4 + wc) * 64 + fq * 16 + fr; asm volatile("" : "+v"(toff));
            const u32x2* gc = GT + ((size_t)u.pm * 12 + 8 + u.pn) * (16 * 512) + toff;
            u32x2 gw[4][2];
#pragma unroll
            for (int m = 0; m < 4; ++m)
#pragma unroll
                for (int bj = 0; bj < 2; ++bj) gw[m][bj] = gc[((ai * 4 + m) * 2 + bj) * 512];
#pragma unroll
            for (int m = 0; m < 4; ++m)
#pragma unroll
                for (int bj = 0; bj < 2; ++bj) { const u32x2 g_ = gw[m][bj]; const f32x4 v0 = acc[ai][bj][m][0] * (1.0f / 255.0f), v1 = acc[ai][bj][m][1] * (1.0f / 255.0f); u32x4 w;
                    w.x = pk2(v0[0] * ub(g_.x, 0), v0[1] * ub(g_.x, 1)); w.y = pk2(v0[2] * ub(g_.x, 2), v0[3] * ub(g_.x, 3)); w.z = pk2(v1[0] * ub(g_.y, 0), v1[1] * ub(g_.y, 1)); w.w = pk2(v1[2] * ub(g_.y, 2), v1[3] * ub(g_.y, 3));
                    *(u32x4*)(mp0 + (size_t)(m * 16) * D + bj * HALF) = w; }
            asm volatile("" ::: "memory"); }
    }
};
struct EpiRes {
    static constexpr bool PERM = true, SEG = false, FP8 = false;
    const bf16_t* XR; bf16_t* H;
    __device__ __forceinline__ void operator()(const f32x4 (&acc)[2][2][4][2], const Unit& u, int wr, int wc, int fr, int fq) const {
        const int row0 = u.pm * BM + wr * 64 + fr, col0 = u.pn * BM + wc * 32 + 8 * fq;
#pragma unroll
        for (int ai = 0; ai < 2; ++ai) {
            int rowb = row0 + ai * HALF; asm volatile("" : "+v"(rowb)); const size_t off0 = (size_t)rowb * D + col0;
            u32x4 xr[4][2];
#pragma unroll
            for (int m = 0; m < 4; ++m)
#pragma unroll
                for (int bj = 0; bj < 2; ++bj) xr[m][bj] = *(const u32x4*)(XR + off0 + (size_t)(m * 16) * D + bj * HALF);
#pragma unroll
            for (int m = 0; m < 4; ++m)
#pragma unroll
                for (int bj = 0; bj < 2; ++bj) { const u32x4 x = xr[m][bj]; const f32x4 v0 = acc[ai][bj][m][0], v1 = acc[ai][bj][m][1]; u32x4 w;
                    w.x = pk2(bflo(x.x) * ALPHA + v0[0], bfhi(x.x) * ALPHA + v0[1]); w.y = pk2(bflo(x.y) * ALPHA + v0[2], bfhi(x.y) * ALPHA + v0[3]);
                    w.z = pk2(bflo(x.z) * ALPHA + v1[0], bfhi(x.z) * ALPHA + v1[1]); w.w = pk2(bflo(x.w) * ALPHA + v1[2], bfhi(x.w) * ALPHA + v1[3]);
                    *(u32x4*)(H + off0 + (size_t)(m * 16) * D + bj * HALF) = w; }
            asm volatile("" ::: "memory"); }
    }
};
struct EpiSwiglu {
    static constexpr bool PERM = true, SEG = false, FP8 = true;
    unsigned char* HID;
    __device__ __forceinline__ void operator()(const f32x4 (&acc)[2][2][4][2], const Unit& u, int wr, int wc, int fr, int fq) const {
        const int row0 = u.pm * BM + wr * 64 + fr, col0 = (u.pn & 15) * 128 + wc * 32 + 8 * fq;
#pragma unroll
        for (int ai = 0; ai < 2; ++ai)
#pragma unroll
            for (int m = 0; m < 4; ++m) { const f32x4 g0 = acc[ai][0][m][0] * 0.03125f, g1 = acc[ai][0][m][1] * 0.03125f, u0 = acc[ai][1][m][0] * 0.03125f, u1 = acc[ai][1][m][1] * 0.03125f;
                f32x4 h0, h1;
#pragma unroll
                for (int j = 0; j < 4; ++j) { h0[j] = siluf_(g0[j]) * u0[j]; h1[j] = siluf_(g1[j]) * u1[j]; }
                u32x2 w; w.x = pk4_fp8(h0[0], h0[1], h0[2], h0[3]); w.y = pk4_fp8(h1[0], h1[1], h1[2], h1[3]);
                int rowi = row0 + ai * HALF + m * 16; asm volatile("" : "+v"(rowi));
                *(u32x2*)(HID + (size_t)rowi * DE + col0) = w; asm volatile("" ::: "memory"); }
    }
};
struct EpiDown {
    static constexpr bool PERM = true, SEG = false, FP8 = true;
    bf16_t* Y; const float* GV;
    __device__ __forceinline__ void operator()(const f32x4 (&acc)[2][2][4][2], const Unit& u, int wr, int wc, int fr, int fq) const {
        const int row0 = u.pm * BM + wr * 64 + fr, col0 = (u.pn & 3) * BM + wc * 32 + 8 * fq;
        float gvs[2][4];
#pragma unroll
        for (int ai = 0; ai < 2; ++ai)
#pragma unroll
            for (int m = 0; m < 4; ++m) gvs[ai][m] = GV[row0 + ai * HALF + m * 16];
#pragma unroll
        for (int ai = 0; ai < 2; ++ai)
#pragma unroll
            for (int m = 0; m < 4; ++m) { int row = row0 + ai * HALF + m * 16; asm volatile("" : "+v"(row)); const float gv = gvs[ai][m] * 0.03125f;
#pragma unroll
                for (int bj = 0; bj < 2; ++bj) { const f32x4 v0 = acc[ai][bj][m][0] * gv, v1 = acc[ai][bj][m][1] * gv;
                    u32x4 w; w.x = pk2(v0[0], v0[1]); w.y = pk2(v0[2], v0[3]); w.z = pk2(v1[0], v1[1]); w.w = pk2(v1[2], v1[3]);
                    *(u32x4*)(Y + (size_t)row * D + col0 + bj * HALF) = w; } }
    }
};
}

#define XB_TMO      128
#define XB_XCNT(j)  (256  + 64 * (j))
#define XB_XSUB(j)  (1280 + 64 * (j))
#define XB_XGEN(j)  (2304 + 64 * (j))
#define XB_TOP      3328
#define XB_TOPGEN   3392
#define XCD_BAR_WORDS 3456
#define XB_SPIN_CAP (1u << 22)
__device__ __forceinline__ unsigned xb_ld(unsigned* p)              { return __hip_atomic_load(p, __ATOMIC_RELAXED, __HIP_MEMORY_SCOPE_AGENT); }
__device__ __forceinline__ unsigned xb_add(unsigned* p, unsigned v) { return __hip_atomic_fetch_add(p, v, __ATOMIC_RELAXED, __HIP_MEMORY_SCOPE_AGENT); }
__device__ __forceinline__ unsigned xb_xcc_id() { return (unsigned)__builtin_amdgcn_s_getreg((3 << 11) | 20) & 0xFu; }
#define XB_SPIN(cond, bar) do { unsigned _sp = 0; while (cond) { __builtin_amdgcn_s_sleep(1); \
    if ((++_sp & 255u) == 0u) { if (xb_ld(&(bar)[XB_TMO])) break; if (_sp > XB_SPIN_CAP) { atomicAdd(&(bar)[XB_TMO], 1u); break; } } } } while (0)
struct XcdBarrier { unsigned* bar; unsigned x; volatile LAS unsigned* st; };
__device__ __forceinline__ XcdBarrier xcd_barrier_post(unsigned* bar, volatile LAS unsigned* st) {
    XcdBarrier b; b.bar = bar; b.x = xb_xcc_id(); b.st = st;
    if (threadIdx.x == 0) (void)xb_add(&bar[XB_XCNT(b.x)], 1u);
    return b;
}
__device__ __forceinline__ void xcd_barrier_complete(unsigned* bar, unsigned x, unsigned& nloc, unsigned& nx) {
    const unsigned G = gridDim.x * gridDim.y * gridDim.z;
    unsigned sum, cnt, mine, sp = 0u;
    for (;;) {
        sum = 0u; cnt = 0u; mine = 0u;
#pragma unroll
        for (unsigned j = 0; j < 16; ++j) { const unsigned c = xb_ld(&bar[XB_XCNT(j)]); sum += c; cnt += (c > 0u) ? 1u : 0u; }
        mine = xb_ld(&bar[XB_XCNT(x)]);
        if (sum == G) break;
        __builtin_amdgcn_s_sleep(1);
        if ((++sp & 255u) == 0u) { if (xb_ld(&bar[XB_TMO])) break; if (sp > XB_SPIN_CAP) { atomicAdd(&bar[XB_TMO], 1u); break; } }
    }
    nloc = mine > 0u ? mine : 1u; nx = cnt > 0u ? cnt : 1u;
}
__device__ __forceinline__ void xcd_barrier(const XcdBarrier& b) {
    asm volatile("s_waitcnt vmcnt(0)" ::: "memory");
    __syncthreads();
    if (threadIdx.x == 0) {
        unsigned* bar = b.bar; asm volatile("" : "+s"(bar));
        __builtin_amdgcn_s_waitcnt(0);
        unsigned nloc = b.st[0], nx = b.st[1];
        if (nloc == 0u) { xcd_barrier_complete(bar, b.x, nloc, nx); b.st[0] = nloc; b.st[1] = nx; }
        const unsigned old = xb_add(&bar[XB_XSUB(b.x)], 1u);
        const unsigned gen = old / nloc;
        if (old + 1u == (gen + 1u) * nloc) {
            __builtin_amdgcn_fence(__ATOMIC_RELEASE, "agent");
            asm volatile("s_waitcnt vmcnt(0)" ::: "memory");
            const unsigned og = xb_add(&bar[XB_TOP], 1u);
            const unsigned tg = og / nx;
            if (og + 1u == (tg + 1u) * nx) xb_add(&bar[XB_TOPGEN], 1u);
            else XB_SPIN(xb_ld(&bar[XB_TOPGEN]) == tg, bar);
            __builtin_amdgcn_fence(__ATOMIC_ACQUIRE, "agent");
            xb_add(&bar[XB_XGEN(b.x)], 1u);
            asm volatile("s_waitcnt vmcnt(0)" ::: "memory");
        } else {
            XB_SPIN(xb_ld(&bar[XB_XGEN(b.x)]) == gen, bar);
            __builtin_amdgcn_fence(__ATOMIC_ACQUIRE, "agent");
            asm volatile("s_waitcnt vmcnt(0)" ::: "memory");
        }
    }
    __syncthreads();
}

struct Args { const float* in[20]; float* out; unsigned char* ws; int ph_lo, ph_hi; };
typedef const __attribute__((address_space(4))) Args* KArgs;
DI KArgs kargs() { KArgs p = (KArgs)__builtin_amdgcn_kernarg_segment_ptr(); asm volatile("" : "+s"(p)); return p; }
struct Ctx {
    float* out; unsigned char* ws;
    int tid, lane, wave, G, bid;
    int layer, slab;
    int nseq, seqlen;
    int stok, sbase;
    int dry;
};
#define WSP(T, off) ((T*)(c.ws + (off)))
#define BIGP(T, off) ((T*)(c.ws + WS_BIG + (off)))

__device__ const float INV_FREQ[32] = {1.000000000e+00f, 7.498942018e-01f, 5.623413324e-01f, 4.216965139e-01f, 3.162277639e-01f, 2.371373773e-01f, 1.778279394e-01f, 1.333521456e-01f, 1.000000015e-01f, 7.498942316e-02f, 5.623413250e-02f, 4.216964915e-02f, 3.162277490e-02f, 2.371373773e-02f, 1.778279431e-02f, 1.333521400e-02f, 9.999999776e-03f, 7.498942316e-03f, 5.623413250e-03f, 4.216964822e-03f, 3.162277630e-03f, 2.371373819e-03f, 1.778279431e-03f, 1.333521446e-03f, 1.000000047e-03f, 7.498941850e-04f, 5.623413017e-04f, 4.216965172e-04f, 3.162277571e-04f, 2.371373703e-04f, 1.778279402e-04f, 1.333521504e-04f};
DI void tr_item(const float* src, long src_ld, int src_col0, int nvalid, int kvalid, bf16_t* dst, long dst_ld, int dst_row0, int k0, LAS float* scr, int lane) {
    float tv[32];
#pragma unroll
    for (int i = 0; i < 32; ++i) { const int kk = 2 * i + (lane >> 5), cc = lane & 31;
        tv[i] = 0.f; if ((k0 + kk) < kvalid && cc < nvalid) tv[i] = src[(size_t)(k0 + kk) * src_ld + src_col0 + cc]; }
#pragma unroll
    for (int i = 0; i < 32; ++i) { const int kk = 2 * i + (lane >> 5), cc = lane & 31; scr[kk * 33 + cc] = tv[i]; }
    asm volatile("s_waitcnt lgkmcnt(0)" ::: "memory");
    const int c8 = lane & 7;
#pragma unroll
    for (int j = 0; j < 4; ++j) { const int n = (lane >> 3) + 8 * j; const LAS float* s = scr + (8 * c8) * 33 + n;
        u32x4 o; o.x = pk2(s[0 * 33], s[1 * 33]); o.y = pk2(s[2 * 33], s[3 * 33]); o.z = pk2(s[4 * 33], s[5 * 33]); o.w = pk2(s[6 * 33], s[7 * 33]);
        *(u32x4*)(dst + (size_t)(dst_row0 + n) * dst_ld + k0 + 8 * c8) = o; }
    asm volatile("s_waitcnt lgkmcnt(0)" ::: "memory");
}
DI void tr_item8(const float* src, long src_ld, int src_col0, int kvalid, unsigned char* dst, long dst_ld, int dst_row0, int k0, float scale, LAS float* scr, int lane) {
    float tv[32];
#pragma unroll
    for (int i = 0; i < 32; ++i) { const int kk = 2 * i + (lane >> 5), cc = lane & 31; tv[i] = 0.f; if ((k0 + kk) < kvalid) tv[i] = src[(size_t)(k0 + kk) * src_ld + src_col0 + cc]; }
#pragma unroll
    for (int i = 0; i < 32; ++i) { const int kk = 2 * i + (lane >> 5), cc = lane & 31; scr[kk * 33 + cc] = tv[i]; }
    asm volatile("s_waitcnt lgkmcnt(0)" ::: "memory");
    const int c8 = lane & 7;
#pragma unroll
    for (int j = 0; j < 4; ++j) { const int n = (lane >> 3) + 8 * j; const LAS float* s = scr + (8 * c8) * 33 + n;
        u32x2 o; o.x = pk4_fp8(s[0 * 33] * scale, s[1 * 33] * scale, s[2 * 33] * scale, s[3 * 33] * scale); o.y = pk4_fp8(s[4 * 33] * scale, s[5 * 33] * scale, s[6 * 33] * scale, s[7 * 33] * scale);
        *(u32x2*)(dst + (size_t)(dst_row0 + n) * dst_ld + k0 + 8 * c8) = o; }
    asm volatile("s_waitcnt lgkmcnt(0)" ::: "memory");
}
DI void phase_weights(KArgs args, LAS unsigned char* lds, const Ctx& c) {
    const int l = c.layer, lane = c.lane;
    LAS float* scr = (LAS float*)(lds + c.wave * 8448);
    const int gw = c.bid * 8 + c.wave, NGW = c.G * 8;
    constexpr int I_IN = 16 * 112 + 16 * 96, I_NA = 4 * 32, I_DIL = 2 * 32, I_GDN = 6 * 32, I_OUT = 16 * 32, I_GU1 = 16 * 128, I_D1 = 32 * 32;
    constexpr int NITEMS = I_IN + I_NA + I_DIL + I_GDN + I_OUT + 16 * I_GU1 + 16 * I_D1;
    for (int it = gw; it < NITEMS; it += NGW) {
        int r = it;
        const float* src; long sld; int sc0, nv = 32, kv; bf16_t* dst; long dld; int dr0, k0;
        if (r < 16 * 112) { const int kb = r / 112, nb = r % 112, n0 = 32 * nb; src = args->in[2] + (size_t)l * D * DIN; sld = DIN; kv = D;
            sc0 = n0; nv = 3480 - n0; if (nv < 0) { nv = 0; sc0 = 0; } if (nv > 32) nv = 32;
            dst = WSP(bf16_t, WS_WIN); dld = D; dr0 = n0; k0 = 64 * kb; }
        else if (r < I_IN) { const int q = r - 16 * 112, kb = q / 96, nb = q % 96;
            tr_item8(args->in[2] + (size_t)l * D * DIN, DIN, 3480 + 32 * nb, D, WSP(unsigned char, WS_WG8), D, 32 * nb, 64 * kb, 32.0f, scr, lane); continue; }
        else if ((r -= I_IN) < I_NA) { const int kb = r / 32, nb = r % 32; src = args->in[8] + (size_t)l * 256 * D; sld = D; sc0 = 32 * nb; kv = 256; dst = WSP(bf16_t, WS_WBR); dld = 768; dr0 = 32 * nb; k0 = 64 * kb; }
        else if ((r -= I_NA) < I_DIL) { const int kb = r / 32, nb = r % 32; src = args->in[9] + (size_t)l * 128 * D; sld = D; sc0 = 32 * nb; kv = 128; dst = WSP(bf16_t, WS_WBR) + 256; dld = 768; dr0 = 32 * nb; k0 = 64 * kb; }
        else if ((r -= I_DIL) < I_GDN) { const int kb = r / 32, nb = r % 32; src = args->in[10] + (size_t)l * 384 * D; sld = D; sc0 = 32 * nb; kv = 384; dst = WSP(bf16_t, WS_WBR) + 384; dld = 768; dr0 = 32 * nb; k0 = 64 * kb; }
        else if ((r -= I_GDN) < I_OUT) { const int kb = r / 32, nb = r % 32; src = args->in[11] + (size_t)l * D * D; sld = D; sc0 = 32 * nb; kv = D; dst = WSP(bf16_t, WS_WOUT); dld = D; dr0 = 32 * nb; k0 = 64 * kb; }
        else if ((r -= I_OUT) < 16 * I_GU1) { const int e = r / I_GU1, q = r % I_GU1, kb = q / 128, nb = q % 128, n0 = 32 * nb, j = n0 >> 8, rr = n0 & 255;
            tr_item8((rr < 128 ? args->in[16] : args->in[15]) + ((size_t)l * NE + e) * D * DE, DE, 128 * j + (rr & 127), D, WSP(unsigned char, WS_WGU) + (size_t)e * 4096 * D, D, n0, 64 * kb, 32.0f, scr, lane); continue; }
        else { r -= 16 * I_GU1; const int e = r / I_D1, q = r % I_D1, kb = q / 32, nb = q % 32;
            tr_item8(args->in[17] + ((size_t)l * NE + e) * DE * D, D, 32 * nb, DE, WSP(unsigned char, WS_WD) + (size_t)e * D * DE, DE, 32 * nb, 64 * kb, 32.0f, scr, lane); continue; }
        tr_item(src, sld, sc0, nv, kv, dst, dld, dr0, k0, scr, lane);
    }
    if (l == 0) {
        for (int t = gw; t < T_ALL; t += NGW) {
            const float* xr = (t < T_P) ? args->in[0] + (size_t)t * D : args->in[1] + (size_t)(t - T_P) * D;
            bf16_t* o = WSP(bf16_t, WS_XB) + (size_t)t * D;
#pragma unroll
            for (int j = 0; j < 4; ++j) { const f32x4 v = *(const f32x4*)(xr + 4 * lane + 256 * j); u32x2 w; w.x = pk2(v[0], v[1]); w.y = pk2(v[2], v[3]); *(u32x2*)(o + 4 * lane + 256 * j) = w;
                *(unsigned*)(WSP(unsigned char, WS_XB8) + (size_t)t * D + 4 * lane + 256 * j) = pk4_fp8(v[0], v[1], v[2], v[3]); }
        }
        float* cs = WSP(float, WS_CS);
        for (int i = c.bid * 512 + c.tid; i < 16384 * 32; i += c.G * 512) { const int pos = i >> 5, k = i & 31;
            const float inv = INV_FREQ[k];
            const float ang = (float)pos * inv;
            cs[pos * 64 + k] = cosf(ang); cs[pos * 64 + 32 + k] = sinf(ang); }
    }
}

constexpr int TLD = 72, TILEB = 64 * TLD * 2;
DI int tsw(int row) { return ((row >> 4) & 3) << 3; }
template <bool SA = false, bool SB = false> DI f32x16 mm_tile(const LAS bf16_t* A, const LAS bf16_t* Bt, int m0, int n0, int lane) {
    f32x16 acc = zero16(); const int r = lane & 31, hh = lane >> 5; const int sa = SA ? tsw(m0 + r) : 0, sb = SB ? tsw(n0 + r) : 0;
#pragma unroll
    for (int ks = 0; ks < 4; ++ks) { const bf16x8 a = *(const LAS bf16x8*)(A + (m0 + r) * TLD + ((16 * ks + 8 * hh) ^ sa)); const bf16x8 b = *(const LAS bf16x8*)(Bt + (n0 + r) * TLD + ((16 * ks + 8 * hh) ^ sb)); acc = MFMA32(a, b, acc); }
    return acc;
}

constexpr int PI_P0 = 0, PI_P1 = 9216, PI_INTRA = 18432, PI_AM = 27648, PI_TT = 45056, PI_TD0 = 54272, PI_TD1 = 60416, PI_PM = 65024, PI_VEC = 71168, PI_BYTES = 72704;
constexpr int PI_WT = PI_AM, PI_UT = PI_TD0;
struct PrepIn { float bl[2], al[2], cw[2]; };
DI void gdn_prep_loads(KArgs args, const Ctx& c, int pu, PrepIn& in) {
    int tid = c.tid; asm volatile("" : "+v"(tid));
    { const float* cwg = args->in[4] + (size_t)c.layer * 5 * 1152 + 64 * (pu % 6);
#pragma unroll
        for (int k = 0; k < 2; ++k) { int i = tid + 512 * k; i = i < 960 ? i : 959; const int tp = i / 192, r = i % 192; in.cw[k] = cwg[tp * 1152 + (r >> 6) * 384 + (r & 63)]; } }
    const int dir = tid >> 8, tg = tid & 255, head = pu % 6, gch = pu / 6, cps = c.seqlen >> 6, seq = gch / cps, n = gch % cps, ia = tg >> 3, p = tg & 7, tr = ia + 32 * dir;
    const float* BA = BIGP(float, B_BA);
#pragma unroll
    for (int h2 = 0; h2 < 2; ++h2) { const int i = ia + 32 * h2, tokl = dir ? 63 - i : i; const float* bar = BA + (size_t)(seq * c.seqlen + n * 64 + tokl) * 32;
        in.bl[h2] = bar[dir * 6 + head]; in.al[h2] = bar[12 + dir * 6 + head]; }
}
DI void gdn_prep_put_cw(LAS unsigned char* L0, const Ctx& c, const PrepIn& in) {
    int tid = c.tid; asm volatile("" : "+v"(tid)); LAS float* CW = (LAS float*)(L0 + LDS_CW);
    CW[tid] = in.cw[0]; if (tid < 448) CW[tid + 512] = in.cw[1];
}
DI void gdn_prep_pair(KArgs args, LAS unsigned char* L0, const Ctx& c, int pu, PrepIn& in, int pu_next) {
    int tid = c.tid; asm volatile("" : "+v"(tid)); const int lane = tid & 63, wave = __builtin_amdgcn_readfirstlane(tid >> 6), l = c.layer;
    const int dir = wave >> 2, wg = wave & 3, tg = tid & 255, head = pu % 6, gch = pu / 6, inst = (gch * 6 + head) * 2 + dir;
    const int cps = c.seqlen >> 6, seq = gch / cps, n = gch % cps;
    const bf16_t* PROJ = BIGP(bf16_t, B_PROJ); const float* BA = BIGP(float, B_BA);
    unsigned char* G = BIGP(unsigned char, B_GSCR) + (size_t)inst * GSTRIDE;
    LAS unsigned char* L = L0 + dir * PI_BYTES;
    LAS bf16_t* P0 = (LAS bf16_t*)(L + PI_P0); LAS bf16_t* P1 = (LAS bf16_t*)(L + PI_P1); LAS bf16_t* INTRA = (LAS bf16_t*)(L + PI_INTRA);
    LAS float* AM = (LAS float*)(L + PI_AM); LAS bf16_t* TT = (LAS bf16_t*)(L + PI_TT);
    LAS float* TD0 = (LAS float*)(L + PI_TD0); LAS float* TD1 = (LAS float*)(L + PI_TD1); LAS float* PM = (LAS float*)(L + PI_PM);
    LAS float* GV = (LAS float*)(L + PI_VEC); LAS float* BV = GV + 64; LAS float* GC = GV + 128;
    LAS bf16_t* WT = (LAS bf16_t*)(L + PI_WT); LAS bf16_t* UT = (LAS bf16_t*)(L + PI_UT);
    const int ia = tg >> 3, p = tg & 7;
    LAS float* XQ = (LAS float*)(L0 + PI_AM);
    LAS float* XK = (LAS float*)(L0 + PI_TT);
    LAS float* XV = (LAS float*)(L0 + PI_BYTES + PI_AM);
    {   float q1[8], k1[8], v1[8];
#pragma unroll
        for (int j = 0; j < 8; ++j) { q1[j] = 0.f; k1[j] = 0.f; v1[j] = 0.f; }
        const LAS float* cw = (const LAS float*)(L0 + LDS_CW) + 8 * p;
        const int tr = ia + 32 * dir;
        u32x4 rqa[5], rka[5], rva[5];
#pragma unroll
        for (int tp = 0; tp < 5; ++tp) { const int pp = n * 64 + tr + tp - 2, ppc = pp < 0 ? 0 : (pp >= c.seqlen ? c.seqlen - 1 : pp);
            const bf16_t* rp = PROJ + (size_t)(seq * c.seqlen + ppc) * NPROJ + 64 * head + 8 * p;
            rqa[tp] = *(const u32x4*)(rp + C_QC); rka[tp] = *(const u32x4*)(rp + C_KC); rva[tp] = *(const u32x4*)(rp + C_VC); }
#pragma unroll
        for (int tp = 0; tp < 5; ++tp) { const LAS float* w = cw + tp * 192;
            const f32x4 wq0 = *(const LAS f32x4*)w, wq1 = *(const LAS f32x4*)(w + 4), wk0 = *(const LAS f32x4*)(w + 64), wk1 = *(const LAS f32x4*)(w + 68), wv0 = *(const LAS f32x4*)(w + 128), wv1 = *(const LAS f32x4*)(w + 132);
            const int pp = n * 64 + tr + tp - 2; const bool inr = (pp >= 0 && pp < c.seqlen);
            { u32x4 rq = rqa[tp], rk = rka[tp], rv = rva[tp];
                if (!inr) { rq = (u32x4){0u, 0u, 0u, 0u}; rk = rq; rv = rq; }
#pragma unroll
                for (int j = 0; j < 4; ++j) { const float a0 = (j < 2) ? wq0[2 * j] : wq1[2 * j - 4], a1 = (j < 2) ? wq0[2 * j + 1] : wq1[2 * j - 3];
                    const float b0 = (j < 2) ? wk0[2 * j] : wk1[2 * j - 4], b1 = (j < 2) ? wk0[2 * j + 1] : wk1[2 * j - 3];
                    const float c0 = (j < 2) ? wv0[2 * j] : wv1[2 * j - 4], c1 = (j < 2) ? wv0[2 * j + 1] : wv1[2 * j - 3];
                    q1[2 * j] += a0 * bflo(rq[j]); q1[2 * j + 1] += a1 * bfhi(rq[j]);
                    k1[2 * j] += b0 * bflo(rk[j]); k1[2 * j + 1] += b1 * bfhi(rk[j]);
                    v1[2 * j] += c0 * bflo(rv[j]); v1[2 * j + 1] += c1 * bfhi(rv[j]); } } }
        float sq = 0.f, sk = 0.f;
#pragma unroll
        for (int j = 0; j < 8; ++j) { q1[j] = siluf_(q1[j]); k1[j] = siluf_(k1[j]); v1[j] = siluf_(v1[j]); sq += q1[j] * q1[j]; sk += k1[j] * k1[j]; }
        sq += __shfl_xor(sq, 1); sq += __shfl_xor(sq, 2); sq += __shfl_xor(sq, 4);
        sk += __shfl_xor(sk, 1); sk += __shfl_xor(sk, 2); sk += __shfl_xor(sk, 4);
        const float rq_ = 0.125f * frsq(sq + NORM_EPS), rk_ = frsq(sk + NORM_EPS);
        f32x4 o0, o1;
        o0[0] = q1[0] * rq_; o0[1] = q1[1] * rq_; o0[2] = q1[2] * rq_; o0[3] = q1[3] * rq_; o1[0] = q1[4] * rq_; o1[1] = q1[5] * rq_; o1[2] = q1[6] * rq_; o1[3] = q1[7] * rq_;
        *(LAS f32x4*)(XQ + tr * 64 + 8 * p) = o0; *(LAS f32x4*)(XQ + tr * 64 + 8 * p + 4) = o1;
        o0[0] = k1[0] * rk_; o0[1] = k1[1] * rk_; o0[2] = k1[2] * rk_; o0[3] = k1[3] * rk_; o1[0] = k1[4] * rk_; o1[1] = k1[5] * rk_; o1[2] = k1[6] * rk_; o1[3] = k1[7] * rk_;
        *(LAS f32x4*)(XK + tr * 64 + 8 * p) = o0; *(LAS f32x4*)(XK + tr * 64 + 8 * p + 4) = o1;
        o0[0] = v1[0]; o0[1] = v1[1]; o0[2] = v1[2]; o0[3] = v1[3]; o1[0] = v1[4]; o1[1] = v1[5]; o1[2] = v1[6]; o1[3] = v1[7];
        *(LAS f32x4*)(XV + tr * 64 + 8 * p) = o0; *(LAS f32x4*)(XV + tr * 64 + 8 * p + 4) = o1; }
#pragma unroll
    for (int h2 = 0; h2 < 2; ++h2) {
        if (p == 0) { const int i = ia + 32 * h2;
            const float bl = in.bl[h2], al = in.al[h2];
            const float xx = al + args->in[6][l * 12 + dir * 6 + head];
            const float sp = xx > 20.f ? xx : log1pf(expf(xx));
            GV[i] = -expf(args->in[5][l * 12 + dir * 6 + head]) * sp; BV[i] = sigmoidf_(bl); } }
    lds_barrier();
    float q[2][8], k[2][8], v[2][8];
#pragma unroll
    for (int h2 = 0; h2 < 2; ++h2) { const int i = ia + 32 * h2, tokl = dir ? 63 - i : i;
        const f32x4 a0 = *(const LAS f32x4*)(XQ + tokl * 64 + 8 * p), a1 = *(const LAS f32x4*)(XQ + tokl * 64 + 8 * p + 4), b0 = *(const LAS f32x4*)(XK + tokl * 64 + 8 * p), b1 = *(const LAS f32x4*)(XK + tokl * 64 + 8 * p + 4),
                    c0 = *(const LAS f32x4*)(XV + tokl * 64 + 8 * p), c1 = *(const LAS f32x4*)(XV + tokl * 64 + 8 * p + 4);
#pragma unroll
        for (int j = 0; j < 4; ++j) { q[h2][j] = a0[j]; q[h2][4 + j] = a1[j]; k[h2][j] = b0[j]; k[h2][4 + j] = b1[j]; v[h2][j] = c0[j]; v[h2][4 + j] = c1[j]; } }
    float gcl_;
    { float x = GV[lane];
#pragma unroll
        for (int o = 1; o < 64; o <<= 1) { const float y = __shfl_up(x, o); if (lane >= o) x += y; }
        if (wg == 0) GC[lane] = x;
        gcl_ = x; }
    const float gc0 = __shfl(gcl_, ia), gc1 = __shfl(gcl_, ia + 32), gcl = __shfl(gcl_, 63);
#pragma unroll
    for (int h2 = 0; h2 < 2; ++h2) { const int i = ia + 32 * h2; u32x4 wq, wk;
#pragma unroll
        for (int j = 0; j < 4; ++j) { wq[j] = pk2(q[h2][2 * j], q[h2][2 * j + 1]); wk[j] = pk2(k[h2][2 * j], k[h2][2 * j + 1]); }
        *(LAS u32x4*)(P0 + i * TLD + 8 * p) = wq; *(LAS u32x4*)(P1 + i * TLD + 8 * p) = wk; }
    lds_barrier();
    { const int mat = wg >> 1, mt = wg & 1, hh = lane >> 5;
#pragma unroll
        for (int nt = 0; nt < 2; ++nt) { const int jc = 32 * nt + (lane & 31);
            const f32x16 a = mm_tile(mat ? P0 : P1, P1, 32 * mt, 32 * nt, lane);
            const float gj = GC[jc];
#pragma unroll
            for (int r = 0; r < 16; ++r) { const int ii = 32 * mt + crow(r, hh); const float gi = GC[ii];
                if (mat == 0) AM[ii * 68 + jc] = (jc < ii) ? BV[ii] * a[r] * __expf(gi - gj) : 0.f;
                else INTRA[ii * TLD + jc] = (bf16_t)(pk2((jc <= ii) ? a[r] * __expf(gi - gj) : 0.f, 0.f) & 0xffffu); } } }
    lds_barrier();
    if (wg == dir) {
        const int b = lane >> 5, cidx = lane & 31; float t[32]; typedef float f32x2_ __attribute__((ext_vector_type(2)));
#pragma unroll
        for (int ii = 0; ii < 32; ++ii) t[ii] = (ii == cidx) ? 1.f : 0.f;
        const LAS float* Ab = AM + (32 * b) * 68 + 32 * b;
        f32x4 rb[2][8];
        rb[1][0] = *(const LAS f32x4*)(Ab + 68);
        __builtin_amdgcn_sched_barrier(0);
#pragma unroll
        for (int ii = 1; ii < 32; ++ii) {
            if (ii + 1 < 32) {
#pragma unroll
                for (int j4 = 0; j4 < ii + 1; j4 += 4) rb[(ii + 1) & 1][j4 >> 2] = *(const LAS f32x4*)(Ab + (ii + 1) * 68 + j4); }
            __builtin_amdgcn_sched_barrier(0);
            f32x2_ a0 = {0.f, 0.f}, a1 = {0.f, 0.f};
#pragma unroll
            for (int j4 = 0; j4 < ii; j4 += 4) { const f32x4 a4 = rb[ii & 1][j4 >> 2];
                const f32x2_ tl = {t[j4], t[j4 + 1]}, th = {t[j4 + 2], t[j4 + 3]}, al = {a4[0], a4[1]}, ah = {a4[2], a4[3]};
                a0 += al * tl; a1 += ah * th; }
            a0 += a1; t[ii] -= a0.x + a0.y;
            __builtin_amdgcn_sched_barrier(0); }
        LAS float* td = b ? TD1 : TD0; const int tds = b ? 36 : 48;
#pragma unroll
        for (int ii = 0; ii < 32; ++ii) { td[ii * tds + cidx] = t[ii]; TT[(32 * b + ii) * TLD + 32 * b + cidx] = (bf16_t)(pk2(t[ii], 0.f) & 0xffffu); }
    }
#pragma unroll
    for (int h2 = 0; h2 < 2; ++h2) { const int i = ia + 32 * h2; const float be = BV[i], eg = __expf(h2 ? gc1 : gc0);
#pragma unroll
        for (int j = 0; j < 8; ++j) { const int d = 8 * p + j, o_ = d * TLD + (i ^ tsw(d)); P0[o_] = (bf16_t)(pk2(k[h2][j] * be * eg, 0.f) & 0xffffu); P1[o_] = (bf16_t)(pk2(v[h2][j] * be, 0.f) & 0xffffu); } }
    { unsigned zz; asm volatile("v_mov_b32 %0, 0" : "=v"(zz)); u32x2 z; z.x = zz; z.y = zz; *(LAS u32x2*)(TT + (tg >> 3) * TLD + 32 + 4 * (tg & 7)) = z; }
    lds_barrier();
    { const int qi = wg >> 1, qj = wg & 1, r16 = lane & 15, g4 = lane >> 4; f32x4 pc = {0.f, 0.f, 0.f, 0.f};
#pragma unroll
        for (int kk = 0; kk < 8; ++kk) pc = __builtin_amdgcn_mfma_f32_16x16x4f32(AM[(32 + 16 * qi + r16) * 68 + 4 * kk + g4], TD0[(4 * kk + g4) * 48 + 16 * qj + r16], pc, 0, 0, 0);
#pragma unroll
        for (int r = 0; r < 4; ++r) PM[(16 * qi + 4 * g4 + r) * 48 + 16 * qj + r16] = pc[r]; }
    lds_barrier();
    { const int qi = wg >> 1, qj = wg & 1, r16 = lane & 15, g4 = lane >> 4; f32x4 pc = {0.f, 0.f, 0.f, 0.f};
#pragma unroll
        for (int kk = 0; kk < 8; ++kk) pc = __builtin_amdgcn_mfma_f32_16x16x4f32(TD1[(16 * qi + r16) * 36 + 4 * kk + g4], PM[(4 * kk + g4) * 48 + 16 * qj + r16], pc, 0, 0, 0);
#pragma unroll
        for (int r = 0; r < 4; ++r) TT[(32 + 16 * qi + 4 * g4 + r) * TLD + 16 * qj + r16] = (bf16_t)(pk2(-pc[r], 0.f) & 0xffffu); }
    lds_barrier();
    { const int which = wg >> 1, mt = wg & 1, hh = lane >> 5;
#pragma unroll
        for (int nt = 0; nt < 2; ++nt) { const int dc = 32 * nt + (lane & 31);
            const f32x16 a = mm_tile<false, true>(TT, which ? P1 : P0, 32 * mt, 32 * nt, lane);
            LAS bf16_t* dst = (which ? UT : WT) + dc * TLD; const int sw = tsw(dc);
#pragma unroll
            for (int g = 0; g < 4; ++g) { u32x2 w; w.x = pk2(a[4 * g], a[4 * g + 1]); w.y = pk2(a[4 * g + 2], a[4 * g + 3]); *(LAS u32x2*)(dst + ((32 * mt + 8 * g + 4 * hh) ^ sw)) = w; } } }
    lds_barrier();
#pragma unroll
    for (int h2 = 0; h2 < 2; ++h2) { const int i = ia + 32 * h2; const float gci = h2 ? gc1 : gc0, eg = __expf(gci), ekd = __expf(gcl - gci); u32x4 wqd;
#pragma unroll
        for (int j = 0; j < 4; ++j) wqd[j] = pk2(q[h2][2 * j] * eg, q[h2][2 * j + 1] * eg);
        *(LAS u32x4*)(P1 + i * TLD + 8 * p) = wqd;
#pragma unroll
        for (int j = 0; j < 8; ++j) { const int d = 8 * p + j; P0[d * TLD + (i ^ tsw(d))] = (bf16_t)(pk2(k[h2][j] * ekd, 0.f) & 0xffffu); } }
    lds_barrier();
    if (pu_next >= 0) gdn_prep_loads(args, c, pu_next, in);
    { const int hh = lane >> 5, rr = lane & 31;
        if (wg == 0) {
#pragma unroll
            for (int t4 = 0; t4 < 4; ++t4) { const int mtb = t4 >> 1, nta = t4 & 1; const f32x16 a = mm_tile<true, true>(WT, P0, 32 * mtb, 32 * nta, lane);
                f32x16 na; for (int r = 0; r < 16; ++r) na[r] = -a[r];
                *(bf16x8*)(G + (size_t)((nta * 4 + 2 * mtb) * 64 + lane) * 16) = pack8<0>(na); *(bf16x8*)(G + (size_t)((nta * 4 + 2 * mtb + 1) * 64 + lane) * 16) = pack8<1>(na); }
        } else if (wg == 1) {
#pragma unroll
            for (int t4 = 0; t4 < 4; ++t4) { const int mta = t4 >> 1, nte = t4 & 1; const f32x16 a = mm_tile<true, true>(P0, UT, 32 * mta, 32 * nte, lane);
                bf16x8* dp = (bf16x8*)(G + 8192 + (size_t)((nte * 2 + mta) * 64 + lane) * 32); dp[0] = pack8<0>(a); dp[1] = pack8<1>(a); }
        } else if (wg == 2) {
#pragma unroll
            for (int t4 = 0; t4 < 4; ++t4) { const int mtb = t4 >> 1, nti = t4 & 1; const f32x16 a = mm_tile<true, false>(WT, INTRA, 32 * mtb, 32 * nti, lane);
                f32x16 qe; const LAS bf16_t* qd = P1 + (32 * nti + rr) * TLD + 32 * mtb + 4 * hh;
#pragma unroll
                for (int g = 0; g < 4; ++g) { const u32x2 w = *(const LAS u32x2*)(qd + 8 * g); qe[4 * g] = bflo(w.x) - a[4 * g]; qe[4 * g + 1] = bfhi(w.x) - a[4 * g + 1]; qe[4 * g + 2] = bflo(w.y) - a[4 * g + 2]; qe[4 * g + 3] = bfhi(w.y) - a[4 * g + 3]; }
                *(bf16x8*)(G + 16384 + (size_t)((nti * 4 + 2 * mtb) * 64 + lane) * 16) = pack8<0>(qe); *(bf16x8*)(G + 16384 + (size_t)((nti * 4 + 2 * mtb + 1) * 64 + lane) * 16) = pack8<1>(qe); }
        } else {
#pragma unroll
            for (int t4 = 0; t4 < 4; ++t4) { const int mti = t4 >> 1, nte = t4 & 1; const f32x16 a = mm_tile<false, true>(INTRA, UT, 32 * mti, 32 * nte, lane);
                bf16x8* dp = (bf16x8*)(G + 24576) + (size_t)((nte * 2 + mti) * 2) * 64 + lane; dp[0] = pack8<0>(a); dp[64] = pack8<1>(a); }
            if (lane == 0) *(float*)(G + 40960) = __expf(gcl);
        } }
    if (pu_next >= 0) gdn_prep_put_cw(L0, c, in);
    lds_barrier();
}

DI void pv_accum(const f32x16 (&acc)[2][2], f32x16 (&o)[2][2], const LAS bf16_t* Vt, int lane) {
    const int r = lane & 31, hh = lane >> 5;
#pragma unroll
    for (int mt = 0; mt < 2; ++mt) {
        {   const bf16x8 p0 = pack8<0>(acc[mt][0]), p1 = pack8<0>(acc[mt][1]);
#pragma unroll
            for (int mo = 0; mo < 2; ++mo) { const LAS bf16_t* s = Vt + (32 * mo + r) * TLD; const int c0 = (32 * mt + 4 * hh) ^ tsw(32 * mo + r);
                const u32x2 lo = *(const LAS u32x2*)(s + c0), hi = *(const LAS u32x2*)(s + (c0 ^ 8)); u32x4 w; w.x = lo.x; w.y = lo.y; w.z = hi.x; w.w = hi.y; const bf16x8 vf = __builtin_bit_cast(bf16x8, w);
                o[mo][0] = MFMA32(vf, p0, o[mo][0]); o[mo][1] = MFMA32(vf, p1, o[mo][1]); } }
        {   const bf16x8 p0 = pack8<1>(acc[mt][0]), p1 = pack8<1>(acc[mt][1]);
#pragma unroll
            for (int mo = 0; mo < 2; ++mo) { const LAS bf16_t* s = Vt + (32 * mo + r) * TLD; const int c0 = (32 * mt + 16 + 4 * hh) ^ tsw(32 * mo + r);
                const u32x2 lo = *(const LAS u32x2*)(s + c0), hi = *(const LAS u32x2*)(s + (c0 ^ 8)); u32x4 w; w.x = lo.x; w.y = lo.y; w.z = hi.x; w.w = hi.y; const bf16x8 vf = __builtin_bit_cast(bf16x8, w);
                o[mo][0] = MFMA32(vf, p0, o[mo][0]); o[mo][1] = MFMA32(vf, p1, o[mo][1]); } }
    }
}
template <class F> DI void stage_vt(LAS bf16_t* Vt, int lane, F vrow) {
#pragma unroll
    for (int it = 0; it < 8; ++it) { const int id = it * 64 + lane, key = id >> 3, part = id & 7;
        const u32x4 w = *(const u32x4*)(vrow(key) + 8 * part);
#pragma unroll
        for (int j = 0; j < 4; ++j) { const int d0 = 8 * part + 2 * j, ks_ = key ^ tsw(d0); Vt[d0 * TLD + ks_] = (bf16_t)(w[j] & 0xffffu); Vt[(d0 + 1) * TLD + ks_] = (bf16_t)(w[j] >> 16); } }
}
DI void write_o_slot(LAS float* SL, const f32x16 (&o)[2][2], int lane) {
    const int r = lane & 31, hh = lane >> 5;
#pragma unroll
    for (int mo = 0; mo < 2; ++mo)
#pragma unroll
        for (int nt = 0; nt < 2; ++nt)
#pragma unroll
            for (int g = 0; g < 4; ++g) { f32x4 v; v[0] = o[mo][nt][4 * g]; v[1] = o[mo][nt][4 * g + 1]; v[2] = o[mo][nt][4 * g + 2]; v[3] = o[mo][nt][4 * g + 3];
                *(LAS f32x4*)(SL + (32 * nt + r) * 68 + 32 * mo + 8 * g + 4 * hh) = v; }
}
DI void add_o_slot(const LAS float* SL, f32x16 (&o)[2][2], int lane) {
    const int r = lane & 31, hh = lane >> 5;
#pragma unroll
    for (int mo = 0; mo < 2; ++mo)
#pragma unroll
        for (int nt = 0; nt < 2; ++nt)
#pragma unroll
            for (int g = 0; g < 4; ++g) { const f32x4 v = *(const LAS f32x4*)(SL + (32 * nt + r) * 68 + 32 * mo + 8 * g + 4 * hh);
                o[mo][nt][4 * g] += v[0]; o[mo][nt][4 * g + 1] += v[1]; o[mo][nt][4 * g + 2] += v[2]; o[mo][nt][4 * g + 3] += v[3]; }
}

constexpr int WAREA = 10240;
DI void osm_update(f32x16 (&acc)[2][2], f32x16 (&o)[2][2], float (&m)[2], float (&l)[2]) {
#pragma unroll
    for (int nt = 0; nt < 2; ++nt) { float mx = -1e30f;
#pragma unroll
        for (int mt = 0; mt < 2; ++mt)
#pragma unroll
            for (int g = 0; g < 16; ++g) mx = fmaxf(mx, acc[mt][nt][g]);
        mx = fmaxf(mx, __shfl_xor(mx, 32));
        const float mn = fmaxf(m[nt], mx), sc = __expf(m[nt] - mn); float sm = 0.f;
#pragma unroll
        for (int mt = 0; mt < 2; ++mt)
#pragma unroll
            for (int g = 0; g < 16; ++g) { const float pz = __expf(acc[mt][nt][g] - mn); acc[mt][nt][g] = pz; sm += pz; }
        sm += __shfl_xor(sm, 32);
        l[nt] = l[nt] * sc + sm; m[nt] = mn;
#pragma unroll
        for (int g = 0; g < 16; ++g) { o[0][nt][g] *= sc; o[1][nt][g] *= sc; } }
}
template <class F> DI void store_o_rows(LAS bf16_t* T, const f32x16 (&o)[2][2], const float (&scale)[2], int lane, F rowp) {
    const int r = lane & 31, hh = lane >> 5;
#pragma unroll
    for (int mo = 0; mo < 2; ++mo)
#pragma unroll
        for (int nt = 0; nt < 2; ++nt)
#pragma unroll
            for (int g = 0; g < 4; ++g) { u32x2 w; w.x = pk2(o[mo][nt][4 * g] * scale[nt], o[mo][nt][4 * g + 1] * scale[nt]); w.y = pk2(o[mo][nt][4 * g + 2] * scale[nt], o[mo][nt][4 * g + 3] * scale[nt]);
                *(LAS u32x2*)(T + (32 * nt + r) * TLD + 32 * mo + 8 * g + 4 * hh) = w; }
    asm volatile("s_waitcnt lgkmcnt(0)" ::: "memory");
#pragma unroll
    for (int it = 0; it < 8; ++it) { const int id = it * 64 + lane, q = id >> 3, part = id & 7; *(u32x4*)(rowp(q) + 8 * part) = *(const LAS u32x4*)(T + q * TLD + 8 * part); }
    asm volatile("s_waitcnt lgkmcnt(0)" ::: "memory");
}
DI void na_wave_unit(KArgs args, LAS unsigned char* L, const Ctx& c, int u, int lane, int wave) {
    const int l = c.layer, head = u & 3, gr = u >> 2, rows = c.seqlen >> 6, seq = gr / rows, r = gr % rows;
    int rs = r - 4; rs = rs < 0 ? 0 : (rs > rows - 8 ? rows - 8 : rs);
    const bf16_t* PROJ = BIGP(bf16_t, B_PROJ);
    const size_t tq0 = (size_t)seq * c.seqlen + (size_t)r * 64;
    LAS bf16_t* Vt = (LAS bf16_t*)(L + wave * WAREA);
    LAS float* BIAS = (LAS float*)(L + wave * WAREA + 9216);
    const int rr = lane & 31, hh = lane >> 5;
#pragma unroll
    for (int w = 0; w < 4; ++w) { const int idx = w * 64 + lane, kw = idx >> 5, dc = idx & 31;
        if (dc < 31) BIAS[idx] = args->in[3][(((size_t)l * 4 + head) * 15 + (rs + kw - r + 7)) * 31 + dc]; }
    bf16x8 qf[2][4];
#pragma unroll
    for (int nt = 0; nt < 2; ++nt)
#pragma unroll
        for (int ks = 0; ks < 4; ++ks) qf[nt][ks] = *(const bf16x8*)(PROJ + (tq0 + 32 * nt + rr) * NPROJ + C_QA + 64 * head + 16 * ks + 8 * hh);
    f32x16 o[2][2]; o[0][0] = zero16(); o[0][1] = zero16(); o[1][0] = zero16(); o[1][1] = zero16();
    float m[2] = {-1e30f, -1e30f}, ls[2] = {0.f, 0.f};
    for (int w = 0; w < 8; ++w) {
        const size_t tk0 = (size_t)seq * c.seqlen + (size_t)(rs + w) * 64;
        asm volatile("s_waitcnt lgkmcnt(0)" ::: "memory");
        stage_vt(Vt, lane, [&](int key) { return PROJ + (tk0 + key) * NPROJ + C_VA + 64 * head; });
        f32x16 acc[2][2]; acc[0][0] = zero16(); acc[0][1] = zero16(); acc[1][0] = zero16(); acc[1][1] = zero16();
#pragma unroll
        for (int mt = 0; mt < 2; ++mt)
#pragma unroll
            for (int ks = 0; ks < 4; ++ks) { const bf16x8 kf = *(const bf16x8*)(PROJ + (tk0 + 32 * mt + rr) * NPROJ + C_KA + 64 * head + 16 * ks + 8 * hh);
                acc[mt][0] = MFMA32(kf, qf[0][ks], acc[mt][0]); acc[mt][1] = MFMA32(kf, qf[1][ks], acc[mt][1]); }
        asm volatile("s_waitcnt lgkmcnt(0)" ::: "memory");
        const LAS float* brow = BIAS + w * 32;
#pragma unroll
        for (int nt = 0; nt < 2; ++nt) { const int qc = 32 * nt + rr; int ws = qc - 8; ws = ws < 0 ? 0 : (ws > 48 ? 48 : ws);
#pragma unroll
            for (int mt = 0; mt < 2; ++mt) {
                const volatile LAS float* bp = brow + (32 * mt + 4 * hh - qc + 15); float bv[16];
#pragma unroll
                for (int g = 0; g < 16; ++g) { const bool live = (mt == nt) || (nt == 0 ? g < 4 : g >= 12);
                    bv[g] = live ? bp[(g & 3) + 8 * (g >> 2)] : 0.f; }
#pragma unroll
                for (int g = 0; g < 16; ++g) { const bool live = (mt == nt) || (nt == 0 ? g < 4 : g >= 12); const int kc = 32 * mt + crow(g, hh); const bool ok = live && (kc >= ws) && (kc < ws + 16);
                    acc[mt][nt][g] = ok ? acc[mt][nt][g] * 0.125f + bv[g] : -1e30f; } } }
        osm_update(acc, o, m, ls);
        pv_accum(acc, o, Vt, lane);
    }
    asm volatile("s_waitcnt lgkmcnt(0)" ::: "memory");
    const float sc[2] = {frcp(ls[0]), frcp(ls[1])};
    store_o_rows(Vt, o, sc, lane, [&](int q) { return BIGP(bf16_t, B_ONA) + (tq0 + q) * 768 + 64 * head; });
}
DI void rope_frag4(bf16x8 (&f)[4], const float* cs, int hh) {
#pragma unroll
    for (int ks = 0; ks < 2; ++ks) { const float* cp = cs + 16 * ks + 8 * hh;
        const f32x4 c0 = *(const f32x4*)cp, c1 = *(const f32x4*)(cp + 4), s0 = *(const f32x4*)(cp + 32), s1 = *(const f32x4*)(cp + 36);
        const u32x4 a = __builtin_bit_cast(u32x4, f[ks]), b = __builtin_bit_cast(u32x4, f[ks + 2]); u32x4 ra, rb;
#pragma unroll
        for (int j = 0; j < 4; ++j) { const float cl = (j < 2) ? c0[2 * j] : c1[2 * j - 4], ch = (j < 2) ? c0[2 * j + 1] : c1[2 * j - 3];
            const float sl = (j < 2) ? s0[2 * j] : s1[2 * j - 4], sh = (j < 2) ? s0[2 * j + 1] : s1[2 * j - 3];
            const float x1l = bflo(a[j]), x1h = bfhi(a[j]), x2l = bflo(b[j]), x2h = bfhi(b[j]);
            ra[j] = pk2(x1l * cl - x2l * sl, x1h * ch - x2h * sh); rb[j] = pk2(x1l * sl + x2l * cl, x1h * sh + x2h * ch); }
        f[ks] = __builtin_bit_cast(bf16x8, ra); f[ks + 2] = __builtin_bit_cast(bf16x8, rb); }
}
DI void dil_wave_unit(KArgs args, LAS unsigned char* L, const Ctx& c, int u, int lane, int wave) {
    const int hd = u & 1, uu = u >> 1, upg = c.stok >> 6, g = uu / upg, v = uu % upg, ups = c.seqlen >> 6, seq = v / ups, wq = v % ups;
    const int dsh = 2 * g, dd = 1 << dsh, nb = ups >> dsh, cls = wq / nb, jb = wq % nb, head = 2 * g + hd;
    const bf16_t* PROJ = BIGP(bf16_t, B_PROJ); const float* CS = WSP(float, WS_CS);
    const size_t sb = (size_t)seq * c.seqlen;
    const int rr = lane & 31, hh = lane >> 5;
    LAS bf16_t* Vt = (LAS bf16_t*)(L + wave * WAREA);
    bf16x8 qf[2][4];
#pragma unroll
    for (int nt = 0; nt < 2; ++nt) { const int pos = cls + dd * (64 * jb + 32 * nt + rr);
#pragma unroll
        for (int ks = 0; ks < 4; ++ks) qf[nt][ks] = *(const bf16x8*)(PROJ + (sb + pos) * NPROJ + C_QD + 64 * head + 16 * ks + 8 * hh);
        rope_frag4(qf[nt], CS + (size_t)pos * 64, hh); }
    f32x16 o[2][2]; o[0][0] = zero16(); o[0][1] = zero16(); o[1][0] = zero16(); o[1][1] = zero16();
    float m[2] = {-1e30f, -1e30f}, ls[2] = {0.f, 0.f};
    for (int kt = 0; kt < 3; ++kt) { const int kj = jb - 1 + kt;
        if (kj < 0 || kj >= nb) continue;
        asm volatile("s_waitcnt lgkmcnt(0)" ::: "memory");
        stage_vt(Vt, lane, [&](int key) { return PROJ + (sb + cls + (size_t)dd * (64 * kj + key)) * NPROJ + C_VD + 64 * head; });
        f32x16 acc[2][2]; acc[0][0] = zero16(); acc[0][1] = zero16(); acc[1][0] = zero16(); acc[1][1] = zero16();
#pragma unroll
        for (int mt = 0; mt < 2; ++mt) { const int pos = cls + dd * (64 * kj + 32 * mt + rr); bf16x8 kf[4];
#pragma unroll
            for (int ks = 0; ks < 4; ++ks) kf[ks] = *(const bf16x8*)(PROJ + (sb + pos) * NPROJ + C_KD + 64 * head + 16 * ks + 8 * hh);
            rope_frag4(kf, CS + (size_t)pos * 64, hh);
#pragma unroll
            for (int ks = 0; ks < 4; ++ks) { acc[mt][0] = MFMA32(kf[ks], qf[0][ks], acc[mt][0]); acc[mt][1] = MFMA32(kf[ks], qf[1][ks], acc[mt][1]); } }
#pragma unroll
        for (int nt = 0; nt < 2; ++nt) { const int qc = 32 * nt + rr;
#pragma unroll
            for (int mt = 0; mt < 2; ++mt)
#pragma unroll
                for (int gg = 0; gg < 16; ++gg) { const int kc = 32 * mt + crow(gg, hh); const bool ok = (kt == 1) || (kt == 0 ? (kc >= qc) : (kc <= qc));
                    acc[mt][nt][gg] = ok ? acc[mt][nt][gg] * 0.125f : -1e30f; } }
        osm_update(acc, o, m, ls);
        pv_accum(acc, o, Vt, lane);
    }
    asm volatile("s_waitcnt lgkmcnt(0)" ::: "memory");
    bf16_t* DP = BIGP(bf16_t, B_DILP); float* DM = BIGP(float, B_DILM);
    const float one[2] = {1.f, 1.f};
    store_o_rows(Vt, o, one, lane, [&](int q) { return DP + ((((size_t)g * SLABMAX + sb + cls + (size_t)dd * (64 * jb + q)) * 2 + hd)) * 64; });
    if (hh == 0) {
#pragma unroll
        for (int nt = 0; nt < 2; ++nt) { const size_t base = (((size_t)g * SLABMAX + sb + cls + (size_t)dd * (64 * jb + 32 * nt + rr)) * 2 + hd); DM[base * 2] = m[nt]; DM[base * 2 + 1] = ls[nt]; } }
}

DI void phase_mix_a(KArgs args, LAS unsigned char* L, const Ctx& c) {
    const int N_PREP = (c.stok >> 6) * 6;
    PrepIn in; if (c.bid < N_PREP) { gdn_prep_loads(args, c, c.bid, in); gdn_prep_put_cw(L, c, in); lds_barrier(); }
    for (int u = c.bid; u < N_PREP; u += c.G) gdn_prep_pair(args, L, c, u, in, u + c.G < N_PREP ? u + c.G : -1);
}
DI void attn_wave_units(KArgs args, LAS unsigned char* L, const Ctx& c) {
    int tid = c.tid; asm volatile("" : "+v"(tid)); const int lane = tid & 63, wave = __builtin_amdgcn_readfirstlane(tid >> 6);
    const int nch_ = c.stok >> 6, N_NA = nch_ * 4, N_DIL = nch_ * 6;
    unsigned* q = (unsigned*)(c.ws + WS_CTL) + 32768 + 128 * (c.layer * 4 + c.slab);
    for (;;) { unsigned u = 0; if (lane == 0) u = __hip_atomic_fetch_add(q, 1u, __ATOMIC_RELAXED, __HIP_MEMORY_SCOPE_AGENT);
        u = (unsigned)__builtin_amdgcn_readfirstlane((int)u); if (u >= (unsigned)N_NA) break; na_wave_unit(args, L, c, (int)u, lane, wave); }
    int tid2 = c.tid; asm volatile("" : "+v"(tid2)); const int lane2 = tid2 & 63, wave2 = __builtin_amdgcn_readfirstlane(tid2 >> 6);
    for (;;) { unsigned u = 0; if (lane2 == 0) u = __hip_atomic_fetch_add(q + 64, 1u, __ATOMIC_RELAXED, __HIP_MEMORY_SCOPE_AGENT);
        u = (unsigned)__builtin_amdgcn_readfirstlane((int)u); if (u >= (unsigned)N_DIL) break; dil_wave_unit(args, L, c, (int)u, lane2, wave2); }
}

DI void phase_select(KArgs args, LAS unsigned char* L, const Ctx& c, int inst);
DI void phase_scan(KArgs args, LAS unsigned char* L, const Ctx& c) {
    if (c.slab == NSLAB - 1 && c.bid >= 24 && c.bid < 40) { phase_select(args, L, c, c.bid - 24); return; }
    const int nwu = c.nseq * 24, wu = c.bid;
    if (wu < nwu && c.wave == 0) {
        const int lane = c.lane;
        const int chain = wu >> 1, nt = wu & 1, seq = chain / 12, rem = chain % 12, head = rem >> 1, dir = rem & 1;
        const int nch = c.seqlen >> 6, gch0 = seq * nch;
        unsigned char* GS = BIGP(unsigned char, B_GSCR);
        f32x16 S[2]; S[0] = zero16(); S[1] = zero16();
        bf16x8 A[2][2][4]; u32x4 cm[2][2][2];
        const long gstep = (long)(dir ? -1 : 1) * 12 * GSTRIDE;
        const unsigned char* G0 = GS + (size_t)(((gch0 + (dir ? nch - 1 : 0)) * 6 + head) * 2 + dir) * GSTRIDE;
        unsigned char* Gs = (unsigned char*)G0;
        float glv[4];
#pragma unroll
        for (int q = 0; q < 4; ++q) { const int sq = q * 64 + lane; glv[q] = *(const float*)(G0 + (long)(sq < nch ? sq : nch - 1) * gstep + 40960); }
        LAS unsigned char* RING = L + 81920;
        int dslot = 0, rslot = 0, dstage = 0;
#define SCAN_DMA() do { const unsigned char* gp = G0 + (long)(dstage < nch ? dstage : nch - 1) * gstep; LAS unsigned char* sl = RING + dslot * 12288; \
            _Pragma("unroll") for (int j = 0; j < 8; ++j) __builtin_amdgcn_global_load_lds((const unsigned*)(gp + (size_t)(j * 64 + lane) * 16), (LAS unsigned*)(sl + j * 1024), 16, 0, 0); \
            _Pragma("unroll") for (int j = 0; j < 4; ++j) __builtin_amdgcn_global_load_lds((const unsigned*)(gp + 8192 + (size_t)((nt * 2 + (j >> 1)) * 64 + lane) * 32 + (j & 1) * 16), (LAS unsigned*)(sl + 8192 + j * 1024), 16, 0, 0); \
            ++dstage; dslot = dslot == 4 ? 0 : dslot + 1; } while (0)
#define SCAN_LOAD(B) do { const LAS unsigned char* sl = RING + rslot * 12288 + lane * 16; \
            _Pragma("unroll") for (int mt = 0; mt < 2; ++mt) { _Pragma("unroll") for (int ks = 0; ks < 4; ++ks) A[B][mt][ks] = *(const LAS bf16x8*)(sl + (mt * 4 + ks) * 1024); \
                cm[B][mt][0] = *(const LAS u32x4*)(sl + 8192 + (mt * 2) * 1024); cm[B][mt][1] = *(const LAS u32x4*)(sl + 8192 + (mt * 2 + 1) * 1024); } \
            rslot = rslot == 4 ? 0 : rslot + 1; } while (0)
#define SCAN_STEP(B, st) do { const bf16x8 b0 = pack8<0>(S[0]), b1 = pack8<1>(S[0]), b2 = pack8<0>(S[1]), b3 = pack8<1>(S[1]); f32x16 nw[2]; \
            { bf16x8* St = (bf16x8*)(Gs + 32768) + (nt * 4) * 64 + lane; St[0] = b0; St[64] = b1; St[128] = b2; St[192] = b3; }     \
            const int sq_ = (st) >> 6; const float gsel = sq_ == 0 ? glv[0] : (sq_ == 1 ? glv[1] : (sq_ == 2 ? glv[2] : glv[3])); \
            const float glc = __builtin_bit_cast(float, __builtin_amdgcn_readlane(__builtin_bit_cast(int, gsel), (st) & 63)); \
            _Pragma("unroll") for (int mt = 0; mt < 2; ++mt) { \
                _Pragma("unroll") for (int g = 0; g < 8; ++g) { const unsigned wv = (g < 4) ? cm[B][mt][0][g] : cm[B][mt][1][g - 4]; nw[mt][2 * g] = glc * S[mt][2 * g] + bflo(wv); nw[mt][2 * g + 1] = glc * S[mt][2 * g + 1] + bfhi(wv); } \
                nw[mt] = MFMA32(A[B][mt][0], b0, nw[mt]); nw[mt] = MFMA32(A[B][mt][1], b1, nw[mt]); nw[mt] = MFMA32(A[B][mt][2], b2, nw[mt]); nw[mt] = MFMA32(A[B][mt][3], b3, nw[mt]); } \
            S[0] = nw[0]; S[1] = nw[1]; Gs += gstep; } while (0)
        SCAN_DMA(); SCAN_DMA(); SCAN_DMA(); SCAN_DMA(); SCAN_DMA();
        asm volatile("s_waitcnt vmcnt(48)" ::: "memory"); SCAN_LOAD(0);
        asm volatile("s_waitcnt vmcnt(36)" ::: "memory"); SCAN_LOAD(1);
        for (int step = 0; step < nch; step += 2) {
            SCAN_STEP(0, step);     asm volatile("s_waitcnt vmcnt(24)" ::: "memory"); SCAN_LOAD(0); SCAN_DMA();
            SCAN_STEP(1, step + 1); asm volatile("s_waitcnt vmcnt(24)" ::: "memory"); SCAN_LOAD(1); SCAN_DMA();
        }
        asm volatile("s_waitcnt vmcnt(0)" ::: "memory");
#undef SCAN_DMA
#undef SCAN_LOAD
#undef SCAN_STEP
    }
    attn_wave_units(args, L, c);
}

DI void dil_merge(const Ctx& c) {
    { const bf16_t* DP = BIGP(bf16_t, B_DILP); const float* DM = BIGP(float, B_DILM); bf16_t* OD = BIGP(bf16_t, B_ONA) + 256;
        for (int it = c.bid * 512 + c.tid; it < c.stok * 32; it += c.G * 512) { const int tok = it >> 5, part = it & 31;
            u32x4 w = {0u, 0u, 0u, 0u};
            if (part < 16) { const int hd = part >> 3, p = part & 7; float m[3], dn[3];
#pragma unroll
                for (int g = 0; g < 3; ++g) { const size_t b = (((size_t)g * SLABMAX + tok) * 2 + hd); m[g] = DM[b * 2]; dn[g] = DM[b * 2 + 1]; }
                const float M = fmaxf(m[0], fmaxf(m[1], m[2])); float num[8], den = 0.f;
#pragma unroll
                for (int j = 0; j < 8; ++j) num[j] = 0.f;
#pragma unroll
                for (int g = 0; g < 3; ++g) { const float f = __expf(m[g] - M); den += f * dn[g]; const u32x4 a = *(const u32x4*)(DP + (((size_t)g * SLABMAX + tok) * 2 + hd) * 64 + 8 * p);
                    num[0] += f * bflo(a[0]); num[1] += f * bfhi(a[0]); num[2] += f * bflo(a[1]); num[3] += f * bfhi(a[1]); num[4] += f * bflo(a[2]); num[5] += f * bfhi(a[2]); num[6] += f * bflo(a[3]); num[7] += f * bfhi(a[3]); }
                const float inv = frcp(den);
                w.x = pk2(num[0] * inv, num[1] * inv); w.y = pk2(num[2] * inv, num[3] * inv); w.z = pk2(num[4] * inv, num[5] * inv); w.w = pk2(num[6] * inv, num[7] * inv); }
            if (part < 16) *(u32x4*)(OD + (size_t)tok * 768 + 8 * part) = w; } }
}

DI void phase_gdn_out(KArgs args, LAS unsigned char* L, const Ctx& c) {
    dil_merge(c);
    const int lane = c.lane, wave = c.wave, tid = c.tid, l = c.layer;
    const bf16_t* PROJ = BIGP(bf16_t, B_PROJ); unsigned char* GS = BIGP(unsigned char, B_GSCR); bf16_t* OG = BIGP(bf16_t, B_ONA) + 384;
    LAS float* OF = (LAS float*)L;
    for (int u = c.bid; u < (c.stok >> 6) * 6; u += c.G) { const int gch = u / 6, head = u % 6;
        { const int dir = wave >> 2, mt = (wave >> 1) & 1, nt = wave & 1, rr = lane & 31, hh = lane >> 5;
            const unsigned char* G = GS + (size_t)((gch * 6 + head) * 2 + dir) * GSTRIDE;
            const bf16_t* Qe = (const bf16_t*)(G + 16384); const bf16_t* Oct = (const bf16_t*)(G + 24576); const bf16_t* St = (const bf16_t*)(G + 32768);
            f32x16 acc = zero16();
#pragma unroll
            for (int ks = 0; ks < 4; ++ks) { const bf16x8 a = *(const bf16x8*)(Qe + (size_t)((mt * 4 + ks) * 64 + lane) * 8);
                const bf16x8 bw = *((const bf16x8*)St + (nt * 4 + ks) * 64 + lane); acc = MFMA32(a, bw, acc); }
            const int e = 32 * nt + rr;
            const u32x4 oc0 = *((const u32x4*)Oct + ((nt * 2 + mt) * 2) * 64 + lane), oc1 = *((const u32x4*)Oct + ((nt * 2 + mt) * 2 + 1) * 64 + lane);
#pragma unroll
            for (int g = 0; g < 4; ++g) { u32x2 w; w.x = (g == 0) ? oc0.x : (g == 1) ? oc0.z : (g == 2) ? oc1.x : oc1.z; w.y = (g == 0) ? oc0.y : (g == 1) ? oc0.w : (g == 2) ? oc1.y : oc1.w;
                const float v0 = acc[4 * g] + bflo(w.x), v1 = acc[4 * g + 1] + bfhi(w.x), v2 = acc[4 * g + 2] + bflo(w.y), v3 = acc[4 * g + 3] + bfhi(w.y);
                const int i0 = 32 * mt + 8 * g + 4 * hh;
#pragma unroll
                for (int j = 0; j < 4; ++j) { const int ii = i0 + j, tl = dir ? 63 - ii : ii; OF[(dir * 64 + tl) * 68 + e] = (j == 0) ? v0 : (j == 1) ? v1 : (j == 2) ? v2 : v3; } } }
        lds_barrier();
        { const int i = tid >> 3, p = tid & 7; const size_t tok = (size_t)gch * 64 + i;
            const LAS float* a = OF + i * 68 + 8 * p; const LAS float* b = OF + (64 + i) * 68 + 8 * p;
            float ov[8]; float ss = 0.f;
#pragma unroll
            for (int j = 0; j < 8; ++j) { ov[j] = a[j] + b[j]; ss += ov[j] * ov[j]; }
            ss += __shfl_xor(ss, 1); ss += __shfl_xor(ss, 2); ss += __shfl_xor(ss, 4);
            const float rs = frsq(ss * (1.0f / 64.0f) + NORM_EPS);
            const u32x4 zw = *(const u32x4*)(PROJ + tok * NPROJ + C_ZC + 64 * head + 8 * p);
            const float* nw = args->in[7] + l * 64 + 8 * p;
            float r[8];
#pragma unroll
            for (int j = 0; j < 4; ++j) { r[2 * j] = ov[2 * j] * rs * nw[2 * j] * siluf_(bflo(zw[j])); r[2 * j + 1] = ov[2 * j + 1] * rs * nw[2 * j + 1] * siluf_(bfhi(zw[j])); }
            u32x4 w; w.x = pk2(r[0], r[1]); w.y = pk2(r[2], r[3]); w.z = pk2(r[4], r[5]); w.w = pk2(r[6], r[7]);
            *(u32x4*)(OG + tok * 768 + 64 * head + 8 * p) = w; }
        lds_barrier();
    }
}

DI void phase_ln1(KArgs args, LAS unsigned char* L, const Ctx& c) {
    const int lane = c.lane, l = c.layer;
    LAS float* WR = (LAS float*)L;
    { const float* wr = args->in[14] + (size_t)l * D * 16;
        for (int i = c.tid; i < D * 16; i += 512) { const int col = i >> 4, e = i & 15, j = col >> 8, ln = (col >> 2) & 63, q = col & 3; WR[((j * 4 + q) * 64 + ln) * 20 + e] = wr[i]; } }
    __syncthreads();
    const float* g1 = args->in[12] + l * D; const float* b1 = args->in[13] + l * D;
    f32x4 gv[4], bv[4];
#pragma unroll
    for (int j = 0; j < 4; ++j) { gv[j] = *(const f32x4*)(g1 + 4 * lane + 256 * j); bv[j] = *(const f32x4*)(b1 + 4 * lane + 256 * j); }
    float* AFF = WSP(float, WS_AFF); int* SLOT = WSP(int, WS_SLOT); bf16_t* XB = WSP(bf16_t, WS_XB);
    u32x2 nv[4];
    { const int rl0 = c.bid * 8 + c.wave; if (rl0 < c.stok) { const bf16_t* hp = (const bf16_t*)c.out + ((size_t)c.sbase + rl0) * D;
#pragma unroll
        for (int j = 0; j < 4; ++j) nv[j] = *(const u32x2*)(hp + 4 * lane + 256 * j); } }
    for (int rl = c.bid * 8 + c.wave; rl < c.stok; rl += c.G * 8) { const size_t tok = (size_t)c.sbase + rl;
        const bf16_t* hr = (const bf16_t*)c.out + tok * D; f32x4 v[4]; float s = 0.f;
#pragma unroll
        for (int j = 0; j < 4; ++j) { v[j][0] = bflo(nv[j].x); v[j][1] = bfhi(nv[j].x); v[j][2] = bflo(nv[j].y); v[j][3] = bfhi(nv[j].y); s += (v[j][0] + v[j][1]) + (v[j][2] + v[j][3]); }
        if (rl + c.G * 8 < c.stok) { const bf16_t* hp = hr + (size_t)c.G * 8 * D;
#pragma unroll
            for (int j = 0; j < 4; ++j) nv[j] = *(const u32x2*)(hp + 4 * lane + 256 * j); }
        const float mean = wave_sum(s) * (1.0f / D); float s2 = 0.f;
#pragma unroll
        for (int j = 0; j < 4; ++j) { v[j] = v[j] - mean; s2 += (v[j][0] * v[j][0] + v[j][1] * v[j][1]) + (v[j][2] * v[j][2] + v[j][3] * v[j][3]); }
        const float rstd = frsq(wave_sum(s2) * (1.0f / D) + LN_EPS);
        float lg[16];
#pragma unroll
        for (int e = 0; e < 16; ++e) lg[e] = 0.f;
#pragma unroll
        for (int j = 0; j < 4; ++j) { v[j] = v[j] * rstd * gv[j] + bv[j];
            if (!c.dry) { u32x2 w; w.x = pk2(v[j][0], v[j][1]); w.y = pk2(v[j][2], v[j][3]); *(u32x2*)(XB + tok * D + 4 * lane + 256 * j) = w; }
#pragma unroll
            for (int q = 0; q < 4; ++q) { const LAS float* wp = WR + ((j * 4 + q) * 64 + lane) * 20; const float xv = v[j][q];
#pragma unroll
                for (int e4 = 0; e4 < 4; ++e4) { const f32x4 w4 = *(const LAS f32x4*)(wp + 4 * e4); lg[4 * e4] += xv * w4[0]; lg[4 * e4 + 1] += xv * w4[1]; lg[4 * e4 + 2] += xv * w4[2]; lg[4 * e4 + 3] += xv * w4[3]; } }
            asm volatile("" ::: "memory"); }
        float mx = -1e30f;
#pragma unroll
        for (int e = 0; e < 16; ++e) { lg[e] = wave_sum(lg[e]); mx = fmaxf(mx, lg[e]); }
        float den = 0.f;
#pragma unroll
        for (int e = 0; e < 16; ++e) { lg[e] = expf(lg[e] - mx); den += lg[e]; }
        float mine = 0.f;
#pragma unroll
        for (int e = 0; e < 16; ++e) mine = (lane == e) ? lg[e] : mine;
        if (lane < 16 && !c.dry) { AFF[(size_t)lane * T_ALL + tok] = mine / den; SLOT[tok * 16 + lane] = -1; }
    }
}
DI void phase_ln2(KArgs args, LAS unsigned char* L, const Ctx& c) {
    const int lane = c.lane, l = c.layer;
    const float* g2 = args->in[18] + l * D; const float* b2 = args->in[19] + l * D;
    f32x4 gv[4], bv[4];
#pragma unroll
    for (int j = 0; j < 4; ++j) { gv[j] = *(const f32x4*)(g2 + 4 * lane + 256 * j); bv[j] = *(const f32x4*)(b2 + 4 * lane + 256 * j); }
    const int* SLOT = WSP(int, WS_SLOT); bf16_t* XB = WSP(bf16_t, WS_XB);
    u32x2 nv[4]; int nsv = -1;
    { const int t0 = c.bid * 8 + c.wave; if (t0 < T_ALL) { const bf16_t* xp = XB + (size_t)t0 * D; nsv = SLOT[(size_t)t0 * 16 + (lane & 15)];
#pragma unroll
        for (int j = 0; j < 4; ++j) nv[j] = *(const u32x2*)(xp + 4 * lane + 256 * j); } }
    for (int t = c.bid * 8 + c.wave; t < T_ALL; t += c.G * 8) { const size_t tok = (size_t)t;
        float* xr = c.out + tok * D; f32x4 v[4];
#pragma unroll
        for (int j = 0; j < 4; ++j) { v[j][0] = bflo(nv[j].x) * ALPHA; v[j][1] = bfhi(nv[j].x) * ALPHA; v[j][2] = bflo(nv[j].y) * ALPHA; v[j][3] = bfhi(nv[j].y) * ALPHA; }
        const int sv = nsv;
        if (t + c.G * 8 < T_ALL) { const bf16_t* xp = XB + (tok + c.G * 8) * D; nsv = SLOT[(tok + c.G * 8) * 16 + (lane & 15)];
#pragma unroll
            for (int j = 0; j < 4; ++j) nv[j] = *(const u32x2*)(xp + 4 * lane + 256 * j); }
#pragma unroll
        for (int e = 0; e < 16; ++e) { const int s = __builtin_amdgcn_readlane(sv, e);
            if (s >= 0) { const bf16_t* yr = BIGP(bf16_t, (e < 8 ? B_XY0 : B_XY1)) + ((size_t)(e & 7) * CAP + s) * D;
#pragma unroll
                for (int j = 0; j < 4; ++j) { const u32x2 w = *(const u32x2*)(yr + 4 * lane + 256 * j); v[j][0] += bflo(w.x); v[j][1] += bfhi(w.x); v[j][2] += bflo(w.y); v[j][3] += bfhi(w.y); } } }
        float s = 0.f;
#pragma unroll
        for (int j = 0; j < 4; ++j) s += (v[j][0] + v[j][1]) + (v[j][2] + v[j][3]);
        const float mean = wave_sum(s) * (1.0f / D); float s2 = 0.f;
#pragma unroll
        for (int j = 0; j < 4; ++j) { v[j] = v[j] - mean; s2 += (v[j][0] * v[j][0] + v[j][1] * v[j][1]) + (v[j][2] * v[j][2] + v[j][3] * v[j][3]); }
        const float rstd = frsq(wave_sum(s2) * (1.0f / D) + LN_EPS);
#pragma unroll
        for (int j = 0; j < 4; ++j) { v[j] = v[j] * rstd * gv[j] + bv[j];
            if (!c.dry) {
                if (l == 1) *(f32x4*)(xr + 4 * lane + 256 * j) = v[j];
                else { u32x2 w; w.x = pk2(v[j][0], v[j][1]); w.y = pk2(v[j][2], v[j][3]); *(u32x2*)(XB + tok * D + 4 * lane + 256 * j) = w;
                    *(unsigned*)(WSP(unsigned char, WS_XB8) + tok * D + 4 * lane + 256 * j) = pk4_fp8(v[j][0], v[j][1], v[j][2], v[j][3]); } } }
    }
}

DI int block_excl_scan(int v, LAS int* tmp, int tid, int& total) {
    const int lane = tid & 63, wave = tid >> 6; int x = v;
#pragma unroll
    for (int o = 1; o < 64; o <<= 1) { const int y = __shfl_up(x, o); if (lane >= o) x += y; }
    __syncthreads();
    if (lane == 63) tmp[wave] = x;
    __syncthreads();
    int base = 0, tot = 0;
#pragma unroll
    for (int w = 0; w < 8; ++w) { const int tw = tmp[w]; if (w < wave) base += tw; tot += tw; }
    total = tot;
    return base + x - v;
}
DI void phase_select(KArgs args, LAS unsigned char* L, const Ctx& c, int inst) {
    if (inst < 0 || inst >= 32) return;
    const int tid = c.tid, grp = inst >> 4, e = inst & 15;
    const int n = grp ? T_S : T_P, t0 = grp ? T_P : 0, C = n >> 3, slot0 = grp ? CAP_P : 0;
    const unsigned* v = (const unsigned*)(WSP(float, WS_AFF) + (size_t)e * T_ALL + t0);
    LAS unsigned* hist = (LAS unsigned*)L; LAS int* sh = (LAS int*)(L + 8192); LAS int* tmp = (LAS int*)(L + 8192 + 64);
    unsigned prefix = 0u; int kk = C, nbin = 0;
    for (int pass = 0; pass < 3; ++pass) {
        const int shift = pass == 0 ? 21 : (pass == 1 ? 10 : 0); const unsigned bmask = pass == 2 ? 1023u : 2047u;
        const unsigned mhi = pass == 0 ? 0u : (pass == 1 ? 0xFFE00000u : 0xFFFFFC00u);
        { unsigned zz; asm volatile("v_mov_b32 %0, 0" : "=v"(zz)); u32x4 z4; z4.x = zz; z4.y = zz; z4.z = zz; z4.w = zz; *(LAS u32x4*)(hist + 4 * tid) = z4; }
        __syncthreads();
        for (int i = tid * 4; i < n; i += 512 * 16) {
            u32x4 x4[4];
#pragma unroll
            for (int k = 0; k < 4; ++k) x4[k] = *(const u32x4*)(v + i + k * 2048);
#pragma unroll
            for (int k = 0; k < 4; ++k)
#pragma unroll
                for (int j = 0; j < 4; ++j) { const unsigned x = x4[k][j]; if ((x & mhi) == prefix) __hip_atomic_fetch_add(&hist[(x >> shift) & bmask], 1u, __ATOMIC_RELAXED, __HIP_MEMORY_SCOPE_WORKGROUP); } }
        __syncthreads();
        {
            const u32x4 hv = *(const LAS u32x4*)(hist + 2044 - 4 * tid); int tot;
            int cum = block_excl_scan((int)(hv[0] + hv[1] + hv[2] + hv[3]), tmp, tid, tot);
            const int c1 = cum + (int)hv.w, c2 = c1 + (int)hv.z, c3 = c2 + (int)hv.y, c4 = c3 + (int)hv.x;
            if (cum < kk && kk <= c4) { const int j = kk <= c1 ? 0 : (kk <= c2 ? 1 : (kk <= c3 ? 2 : 3)); const int cb = kk <= c1 ? cum : (kk <= c2 ? c1 : (kk <= c3 ? c2 : c3));
                sh[0] = 2047 - 4 * tid - j; sh[1] = kk - cb; sh[2] = (j == 0 ? c1 : (j == 1 ? c2 : (j == 2 ? c3 : c4))) - cb; } }
        __syncthreads();
        prefix |= ((unsigned)sh[0]) << shift; kk = sh[1]; nbin = sh[2];
        __syncthreads();
    }
    const unsigned thr = prefix;
    int* IDX = WSP(int, WS_IDX) + e * CAP + slot0;
    LAS int* ctr = sh + 8;
    if (tid == 0) ctr[0] = 0;
    __syncthreads();
    const bool ordered = kk < nbin; int tie_run = 0;
    const int lane = tid & 63; const unsigned long long ltm = (1ull << lane) - 1ull;
    for (int it = 0; it < (n >> 11); it += 4) {
        u32x4 x4[4];
#pragma unroll
        for (int k = 0; k < 4; ++k) x4[k] = *(const u32x4*)(v + (it + k) * 2048 + 4 * tid);
#pragma unroll
        for (int k = 0; k < 4; ++k) { const u32x4 x = x4[k];
            int tie_base = 0;
            if (ordered) { const int tiec = (x[0] == thr) + (x[1] == thr) + (x[2] == thr) + (x[3] == thr); int tot; tie_base = tie_run + block_excl_scan(tiec, tmp, tid, tot); tie_run += tot; }
            bool sj[4]; int off[4], tot4 = 0;
#pragma unroll
            for (int j = 0; j < 4; ++j) { bool s_ = x[j] > thr; if (x[j] == thr) { s_ = !ordered || tie_base < kk; ++tie_base; } sj[j] = s_;
                const unsigned long long m = __ballot(s_); off[j] = tot4 + __popcll(m & ltm); tot4 += __popcll(m); }
            int base = 0; if (lane == 0 && tot4 > 0) base = __hip_atomic_fetch_add(ctr, tot4, __ATOMIC_RELAXED, __HIP_MEMORY_SCOPE_WORKGROUP);
            base = __builtin_amdgcn_readfirstlane(base);
#pragma unroll
            for (int j = 0; j < 4; ++j) if (sj[j]) IDX[base + off[j]] = t0 + (it + k) * 2048 + 4 * tid + j; } }
}
DI void phase_gather(KArgs args, LAS unsigned char* L, const Ctx& c) {
    const int lane = c.lane; const int* IDX = WSP(int, WS_IDX); const bf16_t* XB = WSP(bf16_t, WS_XB);
    float* GATEV = WSP(float, WS_GATEV); int* SLOT = WSP(int, WS_SLOT); const float* AFF = WSP(float, WS_AFF);
    for (int row0 = (c.bid * 8 + c.wave) * 4; row0 < NE * CAP; row0 += c.G * 8 * 4) {
        const int e = row0 / CAP, s0 = row0 % CAP; int t[4]; u32x4 a[4], b[4];
#pragma unroll
        for (int k = 0; k < 4; ++k) t[k] = IDX[row0 + k];
#pragma unroll
        for (int k = 0; k < 4; ++k) { const u32x4* src = (const u32x4*)(XB + (size_t)t[k] * D) + 2 * lane; a[k] = src[0]; b[k] = src[1]; }
        u32x4* dst = (u32x4*)(BIGP(unsigned char, (e < 8 ? B_XY0 : B_XY1)) + ((size_t)(e & 7) * CAP + s0) * D);
#pragma unroll
        for (int k = 0; k < 4; ++k) { u32x4 w;
            w.x = pk4_fp8(bflo(a[k].x), bfhi(a[k].x), bflo(a[k].y), bfhi(a[k].y)); w.y = pk4_fp8(bflo(a[k].z), bfhi(a[k].z), bflo(a[k].w), bfhi(a[k].w));
            w.z = pk4_fp8(bflo(b[k].x), bfhi(b[k].x), bflo(b[k].y), bfhi(b[k].y)); w.w = pk4_fp8(bflo(b[k].z), bfhi(b[k].z), bflo(b[k].w), bfhi(b[k].w));
            dst[k * 64 + lane] = w; }
        if (lane < 4) { const int tt = (lane == 0) ? t[0] : (lane == 1) ? t[1] : (lane == 2) ? t[2] : t[3]; SLOT[(size_t)tt * 16 + e] = s0 + lane; GATEV[row0 + lane] = AFF[(size_t)e * T_ALL + tt]; } }
}

__global__ void __launch_bounds__(512, 2) fwd_kernel(Args args) {
    extern __shared__ __attribute__((aligned(16))) unsigned char lds_raw[];
    LAS unsigned char* L = (LAS unsigned char*)lds_raw;
    Ctx c;
    c.out = args.out; c.ws = args.ws;
    c.tid = threadIdx.x; c.lane = c.tid & 63; c.wave = __builtin_amdgcn_readfirstlane(c.tid >> 6); c.G = gridDim.x; c.bid = blockIdx.x;
    c.layer = 0; c.slab = 0; c.nseq = 8; c.seqlen = 4096; c.stok = 32768; c.sbase = 0; c.dry = 0;
    const int lo = args.ph_lo, hi = args.ph_hi;
    volatile LAS unsigned* MISC = (volatile LAS unsigned*)(L + LDS_MISC);
    if (c.tid < 4) MISC[c.tid] = 0u;
    __syncthreads();
    XcdBarrier bar; bar.bar = (unsigned*)(c.ws + WS_CTL) + 1024; bar.x = 0; bar.st = MISC;
    if (hi - lo > 1) bar = xcd_barrier_post((unsigned*)(c.ws + WS_CTL) + 1024, MISC);
    int pc = 0;
#ifndef PHMASK
#define PHMASK 0xFFFF
#endif
#define PHON(k) (((PHMASK) >> (k)) & 1)
#ifndef REPMASK
#define REPMASK 0x0
#endif
#define PH_BEGIN(k) if (PHON(k) && pc >= lo && pc < hi) { { int tz = threadIdx.x; asm volatile("" : "+v"(tz)); c.tid = tz; c.lane = tz & 63; c.wave = __builtin_amdgcn_readfirstlane(tz >> 6); } KArgs ka = kargs(); c.ws = ka->ws; c.out = ka->out; { int b_ = blockIdx.x, g_ = gridDim.x; asm volatile("" : "+s"(b_), "+s"(g_)); c.bid = b_; c.G = g_; } for (int rep_ = 0; rep_ < (((REPMASK) >> (k)) & 1) + 1; ++rep_) { if (rep_) __syncthreads(); c.dry = (rep_ + 1 < (((REPMASK) >> (k)) & 1) + 1);
#ifndef BARREP
#define BARREP 0
#endif
#define PH_END   } if (pc + 1 < hi) { xcd_barrier(bar); if (BARREP) { xcd_barrier(bar); xcd_barrier(bar); } } else { asm volatile("s_waitcnt vmcnt(0)" ::: "memory"); __syncthreads(); } } ++pc;

    for (int layer = 0; layer < 2; ++layer) {
        c.layer = layer;
        PH_BEGIN(0) phase_weights(ka, L, c); PH_END
        for (int slab = 0; slab < NSLAB; ++slab) {
            c.slab = slab; c.nseq = slab < 2 ? 8 : 1; c.seqlen = slab < 2 ? 4096 : 16384; c.stok = slab < 2 ? 32768 : 16384; c.sbase = slab * 32768; const int stok = c.stok; const size_t sbase = (size_t)c.sbase;
            PH_BEGIN(1) {
                const int swp = (c.bid >> 2) & 1;
                for (int k2 = 0; k2 < 2; ++k2) {
                  if ((k2 ^ swp) == 0) { pg8::Gemm g{WSP(bf16_t, WS_XB) + sbase * D, WSP(bf16_t, WS_WIN), stok, 3584, D}; pg8::StaticOrder S; S.init(stok, 3584, c.G, c.bid);
                    pg8::EpiInProj E{BIGP(bf16_t, B_PROJ), BIGP(float, B_BA)};
                    pg8::gemm_phase<pg8::EpiInProj, pg8::StaticOrder>(L, g, S, E); }
                  else { pg8::Gemm g{(const bf16_t*)(WSP(unsigned char, WS_XB8) + sbase * D), (const bf16_t*)WSP(unsigned char, WS_WG8), stok, 3072, D / 2}; pg8::StaticOrder S; S.init(stok, 3072, c.G, c.bid);
                    pg8::EpiGates E{BIGP(unsigned char, B_GATES)};
                    pg8::gemm_phase<pg8::EpiGates, pg8::StaticOrder>(L, g, S, E); } } } PH_END
            PH_BEGIN(2) phase_mix_a(ka, L, c); PH_END
            PH_BEGIN(3) phase_scan(ka, L, c); PH_END
            PH_BEGIN(4) phase_gdn_out(ka, L, c); PH_END
            PH_BEGIN(5) {
                pg8::StaticOrder S; S.init(stok, D, c.G, c.bid);
                pg8::Gemm g{BIGP(bf16_t, B_ONA), WSP(bf16_t, WS_WBR), stok, D, 768}; pg8::EpiGateCat E{BIGP(u32x2, B_GATES), BIGP(bf16_t, B_MERGED)};
                pg8::gemm_phase<pg8::EpiGateCat, pg8::StaticOrder>(L, g, S, E); } PH_END
            PH_BEGIN(6) {
                pg8::Gemm g{BIGP(bf16_t, B_MERGED), WSP(bf16_t, WS_WOUT), stok, D, D}; pg8::StaticOrder S; S.init(stok, D, c.G, c.bid);
                pg8::EpiRes E{WSP(bf16_t, WS_XB) + sbase * D, (bf16_t*)c.out + sbase * D};
                pg8::gemm_phase<pg8::EpiRes, pg8::StaticOrder>(L, g, S, E); } PH_END
#ifndef LN1PROBE
#define LN1PROBE 0
#endif
            PH_BEGIN(7) if (LN1PROBE) { c.dry = 1; phase_ln1(ka, L, c); __syncthreads(); c.dry = 0; } phase_ln1(ka, L, c); PH_END
        }
        PH_BEGIN(8) phase_select(ka, L, c, c.bid < 16 ? 16 + c.bid : -1); PH_END
        PH_BEGIN(9) phase_gather(ka, L, c); PH_END
        for (int half = 0; half < 2; ++half) {
            PH_BEGIN(10) {
                pg8::Gemm g{BIGP(bf16_t, half ? B_XY1 : B_XY0), (const bf16_t*)(WSP(unsigned char, WS_WGU) + (size_t)half * 8 * 4096 * D), 8 * CAP, 8 * 4096, D / 2}; pg8::MoeOrder S; S.init(8, CAP / 256, 16, c.G, c.bid);
                pg8::EpiSwiglu E{BIGP(unsigned char, B_HID)};
                pg8::gemm_phase<pg8::EpiSwiglu, pg8::MoeOrder>(L, g, S, E); } PH_END
            PH_BEGIN(11) {
                pg8::Gemm g{BIGP(bf16_t, B_HID), (const bf16_t*)(WSP(unsigned char, WS_WD) + (size_t)half * 8 * D * DE), 8 * CAP, 8 * D, DE / 2}; pg8::MoeOrder S; S.init(8, CAP / 256, 4, c.G, c.bid);
                pg8::EpiDown E{BIGP(bf16_t, half ? B_XY1 : B_XY0), WSP(float, WS_GATEV) + (size_t)half * 8 * CAP};
                pg8::gemm_phase<pg8::EpiDown, pg8::MoeOrder>(L, g, S, E); } PH_END
        }
        PH_BEGIN(12) phase_ln2(ka, L, c); PH_END
    }
#undef PH_BEGIN
#undef PH_END
}

constexpr int N_PHASES = 2 * (1 + NSLAB * 7 + 2 + 4 + 1);

extern "C" void kernel_launch(void* const* d_in, const int* in_sizes, int n_in, void* d_out, int out_size, void* d_ws, size_t ws_size, hipStream_t stream) {
    static int grid = 0;
    if (grid == 0) {
        if (n_in != 20 || ws_size < WS_END) { fprintf(stderr, "kernel_launch: unexpected n_in %d or ws_size %zu (< %zu)\n", n_in, ws_size, (size_t)WS_END); grid = -1; return; }
        int dev = 0, cus = 0, per_cu = 0;
        if (hipGetDevice(&dev) != hipSuccess || hipDeviceGetAttribute(&cus, hipDeviceAttributeMultiprocessorCount, dev) != hipSuccess) { grid = -1; return; }
        if (hipFuncSetAttribute((const void*)fwd_kernel, hipFuncAttributeMaxDynamicSharedMemorySize, LDS_BYTES) != hipSuccess) { fprintf(stderr, "kernel_launch: hipFuncSetAttribute failed\n"); grid = -1; return; }
        if (hipOccupancyMaxActiveBlocksPerMultiprocessor(&per_cu, (const void*)fwd_kernel, 512, LDS_BYTES) != hipSuccess || per_cu < 1) fprintf(stderr, "kernel_launch: occupancy query says %d\n", per_cu);
        (void)hipGetLastError();
        grid = cus;
    }
    if (grid < 0) return;
    (void)hipMemsetAsync((char*)d_ws + WS_CTL, 0, 1 * MiB, stream);
    Args a{};
    for (int i = 0; i < 20; ++i) a.in[i] = (const float*)d_in[i];
    a.out = (float*)d_out; a.ws = (unsigned char*)d_ws;
#if MK_N_LAUNCHES == 1
    a.ph_lo = 0; a.ph_hi = N_PHASES;
    hipLaunchKernelGGL(fwd_kernel, dim3(grid), dim3(512), LDS_BYTES, stream, a);
#else
    for (int p = 0; p < N_PHASES; ++p) { a.ph_lo = p; a.ph_hi = p + 1; hipLaunchKernelGGL(fwd_kernel, dim3(grid), dim3(512), LDS_BYTES, stream, a); }
#endif
}
```

```cpp
#include <hip/hip_runtime.h>
#include <stdint.h>
#include <stdio.h>

#define LAS __attribute__((address_space(3)))
#define DI __device__ __forceinline__
typedef unsigned short bf16_t;
typedef short bf16x8 __attribute__((ext_vector_type(8)));
typedef float f32x4 __attribute__((ext_vector_type(4)));
typedef float f32x2 __attribute__((ext_vector_type(2)));
typedef float f32x16 __attribute__((ext_vector_type(16)));
typedef unsigned u32x4 __attribute__((ext_vector_type(4)));
typedef unsigned u32x2 __attribute__((ext_vector_type(2)));
typedef __bf16 bf16x2v __attribute__((ext_vector_type(2)));

#ifndef MK_N_LAUNCHES
#define MK_N_LAUNCHES 1
#endif

constexpr int D = 1024, T_ALL = 81920, T_P = 65536, T_S = 16384, SLABMAX = 32768, NSLAB = 3;
constexpr int DIN = 6552, NPROJ = 3584;
constexpr int C_QA = 0, C_KA = 256, C_VA = 512, C_QD = 768, C_KD = 1152, C_VD = 1536, C_QC = 1920, C_KC = 2304, C_VC = 2688, C_ZC = 3072;
constexpr int NE = 16, DE = 2048, CAP_P = 8192, CAP_S = 2048, CAP = CAP_P + CAP_S;
constexpr float ALPHA = 1.41421356237f, LN_EPS = 1e-5f, NORM_EPS = 1e-6f;
constexpr size_t MiB = 1u << 20;
constexpr size_t WS_CTL = 0, WS_WIN = 1 * MiB, WS_WBR = 14 * MiB, WS_WOUT = 16 * MiB, WS_WGU = 18 * MiB, WS_WD = 82 * MiB, WS_XB8 = 114 * MiB, WS_WG8 = 194 * MiB, WS_XB = 210 * MiB;
constexpr size_t WS_AFF = 370 * MiB, WS_SLOT = 375 * MiB, WS_IDX = 380 * MiB, WS_GATEV = 381 * MiB, WS_CS = 382 * MiB, WS_BIG = 386 * MiB, WS_END = 1130 * MiB;
constexpr size_t B_PROJ = 0, B_GATES = 224 * MiB, B_BA = 416 * MiB, B_ONA = 420 * MiB, B_ODIL = 436 * MiB, B_OGDN = 452 * MiB, B_DILP = 476 * MiB, B_DILM = 500 * MiB, B_GSCR = 502 * MiB, B_MERGEF = 502 * MiB, B_MERGED = 630 * MiB;
constexpr size_t B_XY0 = 0, B_XY1 = 160 * MiB, B_HID = 320 * MiB;
constexpr int GSTRIDE = 41216;
constexpr int LDS_BYTES = 151552;
constexpr int LDS_MISC = 145408, LDS_CW = LDS_MISC + 256;

DI unsigned pk2(float lo, float hi) { f32x2 v = {lo, hi}; bf16x2v b = __builtin_convertvector(v, bf16x2v); return __builtin_bit_cast(unsigned, b); }
DI unsigned pk4_fp8(float a, float b, float c, float d) {
    int w = __builtin_amdgcn_cvt_pk_fp8_f32(a, b, 0, false); w = __builtin_amdgcn_cvt_pk_fp8_f32(c, d, w, true); return (unsigned)w; }
DI float bflo(unsigned u) { return __uint_as_float(u << 16); }
DI float bfhi(unsigned u) { return __uint_as_float(u & 0xffff0000u); }
DI float frcp(float x) { return __builtin_amdgcn_rcpf(x); }
DI float frsq(float x) { return __builtin_amdgcn_rsqf(x); }
DI float sigmoidf_(float x) { return frcp(1.0f + __expf(-x)); }
DI float siluf_(float x) { return x * frcp(1.0f + __expf(-x)); }
DI void lds_barrier() { asm volatile("s_waitcnt lgkmcnt(0)\n\ts_barrier" ::: "memory"); }
DI float wave_sum(float v) {
#pragma unroll
    for (int o = 1; o < 64; o <<= 1) v += __shfl_xor(v, o);
    return v;
}
#define MFMA32(a, b, c) __builtin_amdgcn_mfma_f32_32x32x16_bf16((a), (b), (c), 0, 0, 0)
DI int crow(int reg, int h) { return (reg & 3) + 8 * (reg >> 2) + 4 * h; }
DI f32x16 zero16() { f32x16 z; for (int i = 0; i < 16; ++i) z[i] = 0.f; return z; }
template <int S> DI bf16x8 pack8(const f32x16& x) {
    u32x4 p; p[0] = pk2(x[8 * S], x[8 * S + 1]); p[1] = pk2(x[8 * S + 2], x[8 * S + 3]); p[2] = pk2(x[8 * S + 4], x[8 * S + 5]); p[3] = pk2(x[8 * S + 6], x[8 * S + 7]);
    return __builtin_bit_cast(bf16x8, p);
}

namespace pg8 {
constexpr int BM = 256, BK = 64, HALF = 128, HTB = HALF * BK * 2, STAGE_BYTES = 8 * HTB, NXCD = 8, WGM = 8;
__host__ __device__ __forceinline__ int lds_byte(int r, int c) { const int st = (r >> 4) * 2 + (c >> 5), rr = r & 15, cc = c & 31, ob = rr * 64 + cc * 2; return st * 1024 + (ob ^ (((ob >> 9) & 1) << 5)); }
__host__ __device__ __forceinline__ void stage_rc(int b, int& R, int& C) { const int st = b / 1024, sb = b % 1024, swz = sb ^ (((sb >> 9) & 1) << 5); R = (st >> 1) * 16 + swz / 64; C = (st & 1) * 32 + (swz % 64) / 2; }
__host__ __device__ __forceinline__ int perm32(int rho) { const int n = rho >> 4, i = rho & 15; return 8 * (i >> 2) + 4 * n + (i & 3); }
struct Unit { int pm, pn; };
struct Gemm { const bf16_t* A; const bf16_t* Bt; int M, N, K; };
struct StaticOrder {
    int nM, nN, nwg, G, c;
    __device__ void init(int M, int N, int G_, int c_) { nM = M / BM; nN = N / BM; nwg = nM * nN; G = G_; c = c_; }
    __device__ bool next(int i, Unit& u) const {
        const long L = (long)i * G + c; if (L >= nwg) return false;
        int wgid = (int)L; { const int q = nwg / NXCD, r = nwg % NXCD, xcd = wgid % NXCD, off = wgid / NXCD; wgid = (xcd < r ? xcd * (q + 1) : r * (q + 1) + (xcd - r) * q) + off; }
        const int nig = WGM * nN, gid = wgid / nig, fm = gid * WGM, gsz = (nM - fm) < WGM ? (nM - fm) : WGM;
        u.pm = fm + ((wgid % nig) % gsz); u.pn = (wgid % nig) / gsz; return true;
    }
    __device__ __forceinline__ void a_ready(const Unit&) const {}
    __device__ __forceinline__ void done(const Unit&) const {}
};
struct MoeOrder {
    int nMe, nNe, per, total, G, c, xr, xc, rpx, cpx, share;
    __device__ void init(int nE, int nMe_, int nNe_, int G_, int c_) { nMe = nMe_; nNe = nNe_; per = nMe * nNe; total = nE * per; G = G_; c = c_;
        xc = (nNe % 2 == 0 && nNe >= 8) ? 2 : 1; xr = 8 / xc; rpx = nMe / xr; cpx = nNe / xc; share = rpx * cpx; }
    __device__ bool next(int i, Unit& u) const {
        if ((G & 7) == 0 && nMe % xr == 0) {
            const int x = c & 7, q = c >> 3, nq = G >> 3; const long j = (long)i * nq + q; if (j >= (long)(total / 8)) return false;
            const int e = (int)(j / share), r = (int)(j % share); const int pm = (x / xc) * rpx + r % rpx, pn = (x % xc) * cpx + r / rpx;
            u.pm = e * nMe + pm; u.pn = e * nNe + pn; return true;
        }
        const long L = (long)i * G + c; if (L >= total) return false;
        const int e = (int)(L / per), r = (int)(L % per);
        u.pm = e * nMe + r % nMe; u.pn = e * nNe + r / nMe; return true;
    }
    __device__ __forceinline__ void a_ready(const Unit&) const {}
    __device__ __forceinline__ void done(const Unit&) const {}
};

template <class Epi, class Sched>
__device__ __forceinline__ void gemm_phase(LAS unsigned char* lds, const Gemm g, const Sched& S, const Epi& E) {
    int tid = threadIdx.x; asm volatile("" : "+v"(tid));
    const int wid = __builtin_amdgcn_readfirstlane(tid >> 6), lane = tid & 63, wr = wid >> 2, wc = wid & 3, fr = lane & 15, fq = lane >> 4;
    int Kv = g.K; asm volatile("" : "+s"(Kv));
    const int K = Kv, nt = K / BK;
    unsigned voffA[2], voffB[2];
#pragma unroll
    for (int i = 0; i < 2; ++i) { int R, C; stage_rc(tid * 16 + i * 8192, R, C); const int Rb = Epi::PERM ? ((R & ~31) + perm32(R & 31)) : R;
        voffA[i] = (unsigned)(R * K + C) * 2u; voffB[i] = (unsigned)(Rb * K + C) * 2u; }
    const size_t kstep = (size_t)(BK * 2);
    const size_t hstep = (size_t)HALF * K * 2;
    const size_t tstep = 2 * hstep;
    const unsigned ldsw = (unsigned)wid * 1024u;
    const int aoff = lds_byte(wr * 64 + fr, fq * 8), boff = lds_byte(wc * 32 + fr, fq * 8);
#define PG8_SA(b, h) (((b) * 2 + (h)) * HTB)
#define PG8_SB(b, h) ((4 + (b) * 2 + (h)) * HTB)
#define PG8_STAGE(bufoff, gbase, voff) do { _Pragma("unroll") for (int _i = 0; _i < 2; ++_i) \
        __builtin_amdgcn_global_load_lds((const unsigned*)((const char*)(gbase) + (voff)[_i]), (LAS unsigned*)(lds + (bufoff) + ldsw + _i * 8192), 16, 0, 0); } while (0)
#define PG8_LD8(p) __builtin_shufflevector(*(const LAS v4i_*)(p), *(const LAS v4i_*)((p) + 1024), 0, 1, 2, 3, 4, 5, 6, 7)
#define PG8_LDA(dst, b, h) do { _Pragma("unroll") for (int m = 0; m < 4; ++m) { if constexpr (Epi::FP8) dst##8[m] = PG8_LD8(lds + PG8_SA(b, h) + aoff + m * 2048); \
        else { _Pragma("unroll") for (int k = 0; k < 2; ++k) dst[m][k] = *(const LAS bf16x8*)(lds + PG8_SA(b, h) + aoff + m * 2048 + k * 1024); } } } while (0)
#define PG8_LDB(dst, b, h) do { _Pragma("unroll") for (int n = 0; n < 2; ++n) { if constexpr (Epi::FP8) dst##8[n] = PG8_LD8(lds + PG8_SB(b, h) + boff + n * 2048); \
        else { _Pragma("unroll") for (int k = 0; k < 2; ++k) dst[n][k] = *(const LAS bf16x8*)(lds + PG8_SB(b, h) + boff + n * 2048 + k * 1024); } } } while (0)
#define PG8_MMA(ai, bj, At, Bt) do { __builtin_amdgcn_s_setprio(1); _Pragma("unroll") for (int m = 0; m < 4; ++m) _Pragma("unroll") for (int n = 0; n < 2; ++n) { \
        if constexpr (Epi::FP8) asm volatile("v_mfma_scale_f32_16x16x128_f8f6f4 %0, %1, %2, %0, %3, %3 op_sel_hi:[0,0,0]" : "+v"(acc[ai][bj][m][n]) : "v"(Bt##8[n]), "v"(At##8[m]), "v"(fp8_unit_scale));   \
        else { _Pragma("unroll") for (int k = 0; k < 2; ++k) acc[ai][bj][m][n] = __builtin_amdgcn_mfma_f32_16x16x32_bf16(Bt[n][k], At[m][k], acc[ai][bj][m][n], 0, 0, 0); } } \
        __builtin_amdgcn_s_setprio(0); } while (0)
#define PG8_WAIT_V(n) asm volatile("s_waitcnt vmcnt(" #n ")" ::: "memory")
#define PG8_WAIT_L(n) asm volatile("s_waitcnt lgkmcnt(" #n ")" ::: "memory")
#define PG8_BAR __builtin_amdgcn_s_barrier()
#define PG8_SCHED __builtin_amdgcn_sched_barrier(0)
    Unit cur, nxt; int ui = 0;
    if (!S.next(0, cur)) return;
    f32x4 acc[2][2][4][2];
#pragma unroll
    for (int a = 0; a < 2; ++a)
#pragma unroll
        for (int b = 0; b < 2; ++b)
#pragma unroll
            for (int m = 0; m < 4; ++m)
#pragma unroll
                for (int n = 0; n < 2; ++n) acc[a][b][m][n] = (f32x4){0.f, 0.f, 0.f, 0.f};
    typedef int v4i_ __attribute__((ext_vector_type(4))); typedef int v8i_ __attribute__((ext_vector_type(8)));
    bf16x8 At[4][2], B0[2][2], B1[2][2]; v8i_ At8[4], B08[2], B18[2];
    int fp8_unit_scale = 0x7F7F7F7F; asm volatile("" : "+v"(fp8_unit_scale));
    const char* cA = (const char*)g.A + (size_t)cur.pm * tstep; const char* cB = (const char*)g.Bt + (size_t)cur.pn * tstep;
    S.a_ready(cur);
    PG8_STAGE(PG8_SB(0, 0), cB, voffB); PG8_STAGE(PG8_SA(0, 0), cA, voffA); PG8_STAGE(PG8_SB(0, 1), cB + hstep, voffB); PG8_STAGE(PG8_SA(0, 1), cA + hstep, voffA);
    if (wr == 1) PG8_BAR;
    PG8_WAIT_V(4); PG8_BAR;
    PG8_STAGE(PG8_SB(1, 0), cB + kstep, voffB); PG8_STAGE(PG8_SA(1, 0), cA + kstep, voffA); PG8_STAGE(PG8_SB(1, 1), cB + hstep + kstep, voffB);
    PG8_WAIT_V(6); PG8_BAR;
    for (;;) {
        const bool has_next = S.next(ui + 1, nxt);
        const char* nA = has_next ? (const char*)g.A + (size_t)nxt.pm * tstep : cA; const char* nB = has_next ? (const char*)g.Bt + (size_t)nxt.pn * tstep : cB;
        for (int t = 0; t < nt; t += 2) {
            const bool last = (t == nt - 2);
            const char* a1 = cA + (size_t)(t + 1) * kstep;
            const char* a2 = last ? nA : cA + (size_t)(t + 2) * kstep; const char* b2 = last ? nB : cB + (size_t)(t + 2) * kstep;
            const char* a3 = a2 + kstep; const char* b3 = b2 + kstep;
            if (last && has_next) S.a_ready(nxt);
            if constexpr (Epi::SEG) { if (t == 4 || t == 6) { int tz = tid; asm volatile("" : "+v"(tz)); const int wz = __builtin_amdgcn_readfirstlane(tz >> 6), lz = tz & 63; E.mid(acc, cur, t == 4 ? 0 : 1, wz >> 2, wz & 3, lz & 15, lz >> 4); } }
            PG8_LDB(B0, 0, 0); PG8_SCHED; PG8_LDA(At, 0, 0); PG8_STAGE(PG8_SA(1, 1), a1 + hstep, voffA);
            PG8_WAIT_L(8); PG8_BAR; PG8_WAIT_L(0); PG8_MMA(0, 0, At, B0); PG8_BAR; PG8_SCHED;
            PG8_LDB(B1, 0, 1); PG8_STAGE(PG8_SB(0, 0), b2, voffB);
            PG8_BAR; PG8_WAIT_L(0); PG8_MMA(0, 1, At, B1); PG8_BAR;
            PG8_LDA(At, 0, 1); PG8_STAGE(PG8_SA(0, 0), a2, voffA);
            PG8_BAR; PG8_WAIT_L(0); PG8_MMA(1, 0, At, B0); PG8_BAR; PG8_SCHED;
            PG8_STAGE(PG8_SB(0, 1), b2 + hstep, voffB);
            PG8_WAIT_V(6); PG8_BAR; PG8_MMA(1, 1, At, B1); PG8_BAR;
            PG8_LDB(B0, 1, 0); PG8_SCHED; PG8_LDA(At, 1, 0); PG8_STAGE(PG8_SA(0, 1), a2 + hstep, voffA);
            PG8_WAIT_L(8); PG8_BAR; PG8_WAIT_L(0); PG8_MMA(0, 0, At, B0); PG8_BAR; PG8_SCHED;
            PG8_LDB(B1, 1, 1); PG8_STAGE(PG8_SB(1, 0), b3, voffB);
            PG8_BAR; PG8_WAIT_L(0); PG8_MMA(0, 1, At, B1); PG8_BAR;
            PG8_LDA(At, 1, 1); PG8_STAGE(PG8_SA(1, 0), a3, voffA);
            PG8_BAR; PG8_WAIT_L(0); PG8_MMA(1, 0, At, B0); PG8_BAR; PG8_SCHED;
            PG8_STAGE(PG8_SB(1, 1), b3 + hstep, voffB);
            PG8_WAIT_V(6); PG8_BAR; PG8_MMA(1, 1, At, B1); PG8_BAR;
        }
        if constexpr (Epi::FP8) asm volatile("s_nop 15\n\ts_nop 15\n\ts_nop 15" ::: "memory");
        { int tz = tid; asm volatile("" : "+v"(tz)); const int wz = __builtin_amdgcn_readfirstlane(tz >> 6), lz = tz & 63;
          E(acc, cur, wz >> 2, wz & 3, lz & 15, lz >> 4); } S.done(cur);
        if (!has_next) break;
#pragma unroll
        for (int a = 0; a < 2; ++a)
#pragma unroll
            for (int b = 0; b < 2; ++b)
#pragma unroll
                for (int m = 0; m < 4; ++m)
#pragma unroll
                    for (int n = 0; n < 2; ++n) acc[a][b][m][n] = (f32x4){0.f, 0.f, 0.f, 0.f};
        cur = nxt; cA = nA; cB = nB; ++ui;
    }
    PG8_WAIT_V(0);
    if (wr == 0) PG8_BAR;
    PG8_BAR;
#undef PG8_SA
#undef PG8_SB
#undef PG8_STAGE
#undef PG8_LDA
#undef PG8_LD8
#undef PG8_LDB
#undef PG8_MMA
#undef PG8_WAIT_V
#undef PG8_WAIT_L
#undef PG8_BAR
#undef PG8_SCHED
}

struct EpiInProj {
    static constexpr bool PERM = true, SEG = false, FP8 = false;
    bf16_t* O; float* BA;
    __device__ __forceinline__ void operator()(const f32x4 (&acc)[2][2][4][2], const Unit& u, int wr, int wc, int fr, int fq) const {
        const int row0 = u.pm * BM + wr * 64 + fr, col0 = u.pn * BM + wc * 32 + 8 * fq;
        const bool sig = false, ba = (u.pn == 13) && (wc == 0) && (fq < 3);
#pragma unroll
        for (int ai = 0; ai < 2; ++ai)
#pragma unroll
            for (int m = 0; m < 4; ++m) { int row = row0 + ai * HALF + m * 16; asm volatile("" : "+v"(row)); bf16_t* rowp = O + (size_t)row * NPROJ + col0;
#pragma unroll
                for (int bj = 0; bj < 2; ++bj) { f32x4 v0 = acc[ai][bj][m][0], v1 = acc[ai][bj][m][1];
                    if (sig) {
#pragma unroll
                        for (int j = 0; j < 4; ++j) { v0[j] = sigmoidf_(v0[j]); v1[j] = sigmoidf_(v1[j]); } }
                    u32x4 w; w.x = pk2(v0[0], v0[1]); w.y = pk2(v0[2], v0[3]); w.z = pk2(v1[0], v1[1]); w.w = pk2(v1[2], v1[3]);
                    *(u32x4*)(rowp + bj * HALF) = w;
                    if (bj == 1 && ba) { float* bp = BA + (size_t)row * 32 + 8 * fq; *(f32x4*)bp = v0; *(f32x4*)(bp + 4) = v1; } } }
    }
};
struct EpiGates {
    static constexpr bool PERM = true, SEG = false, FP8 = true;
    unsigned char* G;
    static __device__ __forceinline__ unsigned q4(const f32x4& v) { unsigned r = 0u;
#pragma unroll
        for (int j = 0; j < 4; ++j) r = __builtin_amdgcn_cvt_pk_u8_f32(fmaxf(sigmoidf_(v[j]) * 255.0f, 1.0f), j, r);
        return r; }
    __device__ __forceinline__ void operator()(const f32x4 (&acc)[2][2][4][2], const Unit& u, int wr, int wc, int fr, int fq) const {
#pragma unroll
        for (int ai = 0; ai < 2; ++ai)
#pragma unroll
            for (int m = 0; m < 4; ++m) {
                unsigned boff = (unsigned)(((u.pm * 12 + u.pn) * (16 * 512) + ((wr * 4 + wc) * 64 + fq * 16 + fr)) * 8 + ((ai * 4 + m) * 2) * 4096); asm volatile("" : "+v"(boff));
#pragma unroll
                for (int bj = 0; bj < 2; ++bj) { u32x2 w; w.x = q4(acc[ai][bj][m][0] * 0.03125f); w.y = q4(acc[ai][bj][m][1] * 0.03125f);
                    *(u32x2*)(G + (boff + bj * 4096)) = w; }
                asm volatile("" ::: "memory"); }
    }
};
struct EpiGateCat {
    static constexpr bool PERM = true, SEG = true, FP8 = false;
    const u32x2* GT; bf16_t* MB;
    static __device__ __forceinline__ float ub(unsigned x, int j) { return (float)((x >> (8 * j)) & 0xffu); }
    __device__ __forceinline__ void mid(f32x4 (&acc)[2][2][4][2], const Unit& u, int seg, int wr, int wc, int fr, int fq) const {
#pragma unroll
        for (int ai = 0; ai < 2; ++ai) {
            int toff = (wr * 4 + wc) * 64 + fq * 16 + fr; asm volatile("" : "+v"(toff));
            const u32x2* ga = GT + ((size_t)u.pm * 12 + seg * 4 + u.pn) * (16 * 512) + toff; const u32x2* gb = ga + (size_t)4 * 16 * 512;
            u32x2 A_[4][2], B_[4][2];
#pragma unroll
            for (int m = 0; m < 4; ++m)
#pragma unroll
                for (int bj = 0; bj < 2; ++bj) { A_[m][bj] = ga[((ai * 4 + m) * 2 + bj) * 512]; B_[m][bj] = gb[((ai * 4 + m) * 2 + bj) * 512]; }
#pragma unroll
            for (int m = 0; m < 4; ++m)
#pragma unroll
                for (int bj = 0; bj < 2; ++bj) { const u32x2 a_ = A_[m][bj], b_ = B_[m][bj]; f32x4& v0 = acc[ai][bj][m][0]; f32x4& v1 = acc[ai][bj][m][1];
#pragma unroll
                    for (int j = 0; j < 4; ++j) { v0[j] *= ub(a_.x, j) * frcp(ub(b_.x, j)); v1[j] *= ub(a_.y, j) * frcp(ub(b_.y, j)); } }
            asm volatile("" ::: "memory"); }
    }
    __device__ __forceinline__ void operator()(const f32x4 (&acc)[2][2][4][2], const Unit& u, int wr, int wc, int fr, int fq) const {
        const int row0 = u.pm * BM + wr * 64 + fr, col0 = u.pn * BM + wc * 32 + 8 * fq;
#pragma unroll
        for (int ai = 0; ai < 2; ++ai) {
            int rowb = row0 + ai * HALF; asm volatile("" : "+v"(rowb)); bf16_t* mp0 = MB + (size_t)rowb * D + col0;
            int toff = (wr * 4 + wc) * 64 + fq * 16 + fr; asm volatile("" : "+v"(toff));
            const u32x2* gc = GT + ((size_t)u.pm * 12 + 8 + u.pn) * (16 * 512) + toff;
            u32x2 gw[4][2];
#pragma unroll
            for (int m = 0; m < 4; ++m)
#pragma unroll
                for (int bj = 0; bj < 2; ++bj) gw[m][bj] = gc[((ai * 4 + m) * 2 + bj) * 512];
#pragma unroll
            for (int m = 0; m < 4; ++m)
#pragma unroll
                for (int bj = 0; bj < 2; ++bj) { const u32x2 g_ = gw[m][bj]; const f32x4 v0 = acc[ai][bj][m][0] * (1.0f / 255.0f), v1 = acc[ai][bj][m][1] * (1.0f / 255.0f); u32x4 w;
                    w.x = pk2(v0[0] * ub(g_.x, 0), v0[1] * ub(g_.x, 1)); w.y = pk2(v0[2] * ub(g_.x, 2), v0[3] * ub(g_.x, 3)); w.z = pk2(v1[0] * ub(g_.y, 0), v1[1] * ub(g_.y, 1)); w.w = pk2(v1[2] * ub(g_.y, 2), v1[3] * ub(g_.y, 3));
                    *(u32x4*)(mp0 + (size_t)(m * 16) * D + bj * HALF) = w; }
            asm volatile("" ::: "memory"); }
    }
};
struct EpiRes {
    static constexpr bool PERM = true, SEG = false, FP8 = false;
    const bf16_t* XR; bf16_t* H;
    __device__ __forceinline__ void operator()(const f32x4 (&acc)[2][2][4][2], const Unit& u, int wr, int wc, int fr, int fq) const {
        const int row0 = u.pm * BM + wr * 64 + fr, col0 = u.pn * BM + wc * 32 + 8 * fq;
#pragma unroll
        for (int ai = 0; ai < 2; ++ai) {
            int rowb = row0 + ai * HALF; asm volatile("" : "+v"(rowb)); const size_t off0 = (size_t)rowb * D + col0;
            u32x4 xr[4][2];
#pragma unroll
            for (int m = 0; m < 4; ++m)
#pragma unroll
                for (int bj = 0; bj < 2; ++bj) xr[m][bj] = *(const u32x4*)(XR + off0 + (size_t)(m * 16) * D + bj * HALF);
#pragma unroll
            for (int m = 0; m < 4; ++m)
#pragma unroll
                for (int bj = 0; bj < 2; ++bj) { const u32x4 x = xr[m][bj]; const f32x4 v0 = acc[ai][bj][m][0], v1 = acc[ai][bj][m][1]; u32x4 w;
                    w.x = pk2(bflo(x.x) * ALPHA + v0[0], bfhi(x.x) * ALPHA + v0[1]); w.y = pk2(bflo(x.y) * ALPHA + v0[2], bfhi(x.y) * ALPHA + v0[3]);
                    w.z = pk2(bflo(x.z) * ALPHA + v1[0], bfhi(x.z) * ALPHA + v1[1]); w.w = pk2(bflo(x.w) * ALPHA + v1[2], bfhi(x.w) * ALPHA + v1[3]);
                    *(u32x4*)(H + off0 + (size_t)(m * 16) * D + bj * HALF) = w; }
            asm volatile("" ::: "memory"); }
    }
};
struct EpiSwiglu {
    static constexpr bool PERM = true, SEG = false, FP8 = true;
    unsigned char* HID;
    __device__ __forceinline__ void operator()(const f32x4 (&acc)[2][2][4][2], const Unit& u, int wr, int wc, int fr, int fq) const {
        const int row0 = u.pm * BM + wr * 64 + fr, col0 = (u.pn & 15) * 128 + wc * 32 + 8 * fq;
#pragma unroll
        for (int ai = 0; ai < 2; ++ai)
#pragma unroll
            for (int m = 0; m < 4; ++m) { const f32x4 g0 = acc[ai][0][m][0] * 0.03125f, g1 = acc[ai][0][m][1] * 0.03125f, u0 = acc[ai][1][m][0] * 0.03125f, u1 = acc[ai][1][m][1] * 0.03125f;
                f32x4 h0, h1;
#pragma unroll
                for (int j = 0; j < 4; ++j) { h0[j] = siluf_(g0[j]) * u0[j]; h1[j] = siluf_(g1[j]) * u1[j]; }
                u32x2 w; w.x = pk4_fp8(h0[0], h0[1], h0[2], h0[3]); w.y = pk4_fp8(h1[0], h1[1], h1[2], h1[3]);
                int rowi = row0 + ai * HALF + m * 16; asm volatile("" : "+v"(rowi));
                *(u32x2*)(HID + (size_t)rowi * DE + col0) = w; asm volatile("" ::: "memory"); }
    }
};
struct EpiDown {
    static constexpr bool PERM = true, SEG = false, FP8 = true;
    bf16_t* Y; const float* GV;
    __device__ __forceinline__ void operator()(const f32x4 (&acc)[2][2][4][2], const Unit& u, int wr, int wc, int fr, int fq) const {
        const int row0 = u.pm * BM + wr * 64 + fr, col0 = (u.pn & 3) * BM + wc * 32 + 8 * fq;
        float gvs[2][4];
#pragma unroll
        for (int ai = 0; ai < 2; ++ai)
#pragma unroll
            for (int m = 0; m < 4; ++m) gvs[ai][m] = GV[row0 + ai * HALF + m * 16];
#pragma unroll
        for (int ai = 0; ai < 2; ++ai)
#pragma unroll
            for (int m = 0; m < 4; ++m) { int row = row0 + ai * HALF + m * 16; asm volatile("" : "+v"(row)); const float gv = gvs[ai][m] * 0.03125f;
#pragma unroll
                for (int bj = 0; bj < 2; ++bj) { const f32x4 v0 = acc[ai][bj][m][0] * gv, v1 = acc[ai][bj][m][1] * gv;
                    u32x4 w; w.x = pk2(v0[0], v0[1]); w.y = pk2(v0[2], v0[3]); w.z = pk2(v1[0], v1[1]); w.w = pk2(v1[2], v1[3]);
                    *(u32x4*)(Y + (size_t)row * D + col0 + bj * HALF) = w; } }
    }
};
}

#define XB_TMO      128
#define XB_XCNT(j)  (256  + 64 * (j))
#define XB_XSUB(j)  (1280 + 64 * (j))
#define XB_XGEN(j)  (2304 + 64 * (j))
#define XB_TOP      3328
#define XB_TOPGEN   3392
#define XCD_BAR_WORDS 3456
#define XB_SPIN_CAP (1u << 22)
__device__ __forceinline__ unsigned xb_ld(unsigned* p)              { return __hip_atomic_load(p, __ATOMIC_RELAXED, __HIP_MEMORY_SCOPE_AGENT); }
__device__ __forceinline__ unsigned xb_add(unsigned* p, unsigned v) { return __hip_atomic_fetch_add(p, v, __ATOMIC_RELAXED, __HIP_MEMORY_SCOPE_AGENT); }
__device__ __forceinline__ unsigned xb_xcc_id() { return (unsigned)__builtin_amdgcn_s_getreg((3 << 11) | 20) & 0xFu; }
#define XB_SPIN(cond, bar) do { unsigned _sp = 0; while (cond) { __builtin_amdgcn_s_sleep(1); \
    if ((++_sp & 255u) == 0u) { if (xb_ld(&(bar)[XB_TMO])) break; if (_sp > XB_SPIN_CAP) { atomicAdd(&(bar)[XB_TMO], 1u); break; } } } } while (0)
struct XcdBarrier { unsigned* bar; unsigned x; volatile LAS unsigned* st; };
__device__ __forceinline__ XcdBarrier xcd_barrier_post(unsigned* bar, volatile LAS unsigned* st) {
    XcdBarrier b; b.bar = bar; b.x = xb_xcc_id(); b.st = st;
    if (threadIdx.x == 0) (void)xb_add(&bar[XB_XCNT(b.x)], 1u);
    return b;
}
__device__ __forceinline__ void xcd_barrier_complete(unsigned* bar, unsigned x, unsigned& nloc, unsigned& nx) {
    const unsigned G = gridDim.x * gridDim.y * gridDim.z;
    unsigned sum, cnt, mine, sp = 0u;
    for (;;) {
        sum = 0u; cnt = 0u; mine = 0u;
#pragma unroll
        for (unsigned j = 0; j < 16; ++j) { const unsigned c = xb_ld(&bar[XB_XCNT(j)]); sum += c; cnt += (c > 0u) ? 1u : 0u; }
        mine = xb_ld(&bar[XB_XCNT(x)]);
        if (sum == G) break;
        __builtin_amdgcn_s_sleep(1);
        if ((++sp & 255u) == 0u) { if (xb_ld(&bar[XB_TMO])) break; if (sp > XB_SPIN_CAP) { atomicAdd(&bar[XB_TMO], 1u); break; } }
    }
    nloc = mine > 0u ? mine : 1u; nx = cnt > 0u ? cnt : 1u;
}
__device__ __forceinline__ void xcd_barrier(const XcdBarrier& b) {
    asm volatile("s_waitcnt vmcnt(0)" ::: "memory");
    __syncthreads();
    if (threadIdx.x == 0) {
        unsigned* bar = b.bar; asm volatile("" : "+s"(bar));
        __builtin_amdgcn_s_waitcnt(0);
        unsigned nloc = b.st[0], nx = b.st[1];
        if (nloc == 0u) { xcd_barrier_complete(bar, b.x, nloc, nx); b.st[0] = nloc; b.st[1] = nx; }
        const unsigned old = xb_add(&bar[XB_XSUB(b.x)], 1u);
        const unsigned gen = old / nloc;
        if (old + 1u == (gen + 1u) * nloc) {
            __builtin_amdgcn_fence(__ATOMIC_RELEASE, "agent");
            asm volatile("s_waitcnt vmcnt(0)" ::: "memory");
            const unsigned og = xb_add(&bar[XB_TOP], 1u);
            const unsigned tg = og / nx;
            if (og + 1u == (tg + 1u) * nx) xb_add(&bar[XB_TOPGEN], 1u);
            else XB_SPIN(xb_ld(&bar[XB_TOPGEN]) == tg, bar);
            __builtin_amdgcn_fence(__ATOMIC_ACQUIRE, "agent");
            xb_add(&bar[XB_XGEN(b.x)], 1u);
            asm volatile("s_waitcnt vmcnt(0)" ::: "memory");
        } else {
            XB_SPIN(xb_ld(&bar[XB_XGEN(b.x)]) == gen, bar);
            __builtin_amdgcn_fence(__ATOMIC_ACQUIRE, "agent");
            asm volatile("s_waitcnt vmcnt(0)" ::: "memory");
        }
    }
    __syncthreads();
}

struct Args { const float* in[20]; float* out; unsigned char* ws; int ph_lo, ph_hi; };
typedef const __attribute__((address_space(4))) Args* KArgs;
DI KArgs kargs() { KArgs p = (KArgs)__builtin_amdgcn_kernarg_segment_ptr(); asm volatile("" : "+s"(p)); return p; }
struct Ctx {
    float* out; unsigned char* ws;
    int tid, lane, wave, G, bid;
    int layer, slab;
    int nseq, seqlen;
    int stok, sbase;
    int dry;
};
#define WSP(T, off) ((T*)(c.ws + (off)))
#define BIGP(T, off) ((T*)(c.ws + WS_BIG + (off)))

__device__ const float INV_FREQ[32] = {1.000000000e+00f, 7.498942018e-01f, 5.623413324e-01f, 4.216965139e-01f, 3.162277639e-01f, 2.371373773e-01f, 1.778279394e-01f, 1.333521456e-01f, 1.000000015e-01f, 7.498942316e-02f, 5.623413250e-02f, 4.216964915e-02f, 3.162277490e-02f, 2.371373773e-02f, 1.778279431e-02f, 1.333521400e-02f, 9.999999776e-03f, 7.498942316e-03f, 5.623413250e-03f, 4.216964822e-03f, 3.162277630e-03f, 2.371373819e-03f, 1.778279431e-03f, 1.333521446e-03f, 1.000000047e-03f, 7.498941850e-04f, 5.623413017e-04f, 4.216965172e-04f, 3.162277571e-04f, 2.371373703e-04f, 1.778279402e-04f, 1.333521504e-04f};
DI void tr_item(const float* src, long src_ld, int src_col0, int nvalid, int kvalid, bf16_t* dst, long dst_ld, int dst_row0, int k0, LAS float* scr, int lane) {
    float tv[32];
#pragma unroll
    for (int i = 0; i < 32; ++i) { const int kk = 2 * i + (lane >> 5), cc = lane & 31;
        tv[i] = 0.f; if ((k0 + kk) < kvalid && cc < nvalid) tv[i] = src[(size_t)(k0 + kk) * src_ld + src_col0 + cc]; }
#pragma unroll
    for (int i = 0; i < 32; ++i) { const int kk = 2 * i + (lane >> 5), cc = lane & 31; scr[kk * 33 + cc] = tv[i]; }
    asm volatile("s_waitcnt lgkmcnt(0)" ::: "memory");
    const int c8 = lane & 7;
#pragma unroll
    for (int j = 0; j < 4; ++j) { const int n = (lane >> 3) + 8 * j; const LAS float* s = scr + (8 * c8) * 33 + n;
        u32x4 o; o.x = pk2(s[0 * 33], s[1 * 33]); o.y = pk2(s[2 * 33], s[3 * 33]); o.z = pk2(s[4 * 33], s[5 * 33]); o.w = pk2(s[6 * 33], s[7 * 33]);
        *(u32x4*)(dst + (size_t)(dst_row0 + n) * dst_ld + k0 + 8 * c8) = o; }
    asm volatile("s_waitcnt lgkmcnt(0)" ::: "memory");
}
DI void tr_item8(const float* src, long src_ld, int src_col0, int kvalid, unsigned char* dst, long dst_ld, int dst_row0, int k0, float scale, LAS float* scr, int lane) {
    float tv[32];
#pragma unroll
    for (int i = 0; i < 32; ++i) { const int kk = 2 * i + (lane >> 5), cc = lane & 31; tv[i] = 0.f; if ((k0 + kk) < kvalid) tv[i] = src[(size_t)(k0 + kk) * src_ld + src_col0 + cc]; }
#pragma unroll
    for (int i = 0; i < 32; ++i) { const int kk = 2 * i + (lane >> 5), cc = lane & 31; scr[kk * 33 + cc] = tv[i]; }
    asm volatile("s_waitcnt lgkmcnt(0)" ::: "memory");
    const int c8 = lane & 7;
#pragma unroll
    for (int j = 0; j < 4; ++j) { const int n = (lane >> 3) + 8 * j; const LAS float* s = scr + (8 * c8) * 33 + n;
        u32x2 o; o.x = pk4_fp8(s[0 * 33] * scale, s[1 * 33] * scale, s[2 * 33] * scale, s[3 * 33] * scale); o.y = pk4_fp8(s[4 * 33] * scale, s[5 * 33] * scale, s[6 * 33] * scale, s[7 * 33] * scale);
        *(u32x2*)(dst + (size_t)(dst_row0 + n) * dst_ld + k0 + 8 * c8) = o; }
    asm volatile("s_waitcnt lgkmcnt(0)" ::: "memory");
}
DI void phase_weights(KArgs args, LAS unsigned char* lds, const Ctx& c) {
    const int l = c.layer, lane = c.lane;
    LAS float* scr = (LAS float*)(lds + c.wave * 8448);
    const int gw = c.bid * 8 + c.wave, NGW = c.G * 8;
    constexpr int I_IN = 16 * 112 + 16 * 96, I_NA = 4 * 32, I_DIL = 2 * 32, I_GDN = 6 * 32, I_OUT = 16 * 32, I_GU1 = 16 * 128, I_D1 = 32 * 32;
    constexpr int NITEMS = I_IN + I_NA + I_DIL + I_GDN + I_OUT + 16 * I_GU1 + 16 * I_D1;
    for (int it = gw; it < NITEMS; it += NGW) {
        int r = it;
        const float* src; long sld; int sc0, nv = 32, kv; bf16_t* dst; long dld; int dr0, k0;
        if (r < 16 * 112) { const int kb = r / 112, nb = r % 112, n0 = 32 * nb; src = args->in[2] + (size_t)l * D * DIN; sld = DIN; kv = D;
            sc0 = n0; nv = 3480 - n0; if (nv < 0) { nv = 0; sc0 = 0; } if (nv > 32) nv = 32;
            dst = WSP(bf16_t, WS_WIN); dld = D; dr0 = n0; k0 = 64 * kb; }
        else if (r < I_IN) { const int q = r - 16 * 112, kb = q / 96, nb = q % 96;
            tr_item8(args->in[2] + (size_t)l * D * DIN, DIN, 3480 + 32 * nb, D, WSP(unsigned char, WS_WG8), D, 32 * nb, 64 * kb, 32.0f, scr, lane); continue; }
        else if ((r -= I_IN) < I_NA) { const int kb = r / 32, nb = r % 32; src = args->in[8] + (size_t)l * 256 * D; sld = D; sc0 = 32 * nb; kv = 256; dst = WSP(bf16_t, WS_WBR); dld = 768; dr0 = 32 * nb; k0 = 64 * kb; }
        else if ((r -= I_NA) < I_DIL) { const int kb = r / 32, nb = r % 32; src = args->in[9] + (size_t)l * 128 * D; sld = D; sc0 = 32 * nb; kv = 128; dst = WSP(bf16_t, WS_WBR) + 256; dld = 768; dr0 = 32 * nb; k0 = 64 * kb; }
        else if ((r -= I_DIL) < I_GDN) { const int kb = r / 32, nb = r % 32; src = args->in[10] + (size_t)l * 384 * D; sld = D; sc0 = 32 * nb; kv = 384; dst = WSP(bf16_t, WS_WBR) + 384; dld = 768; dr0 = 32 * nb; k0 = 64 * kb; }
        else if ((r -= I_GDN) < I_OUT) { const int kb = r / 32, nb = r % 32; src = args->in[11] + (size_t)l * D * D; sld = D; sc0 = 32 * nb; kv = D; dst = WSP(bf16_t, WS_WOUT); dld = D; dr0 = 32 * nb; k0 = 64 * kb; }
        else if ((r -= I_OUT) < 16 * I_GU1) { const int e = r / I_GU1, q = r % I_GU1, kb = q / 128, nb = q % 128, n0 = 32 * nb, j = n0 >> 8, rr = n0 & 255;
            tr_item8((rr < 128 ? args->in[16] : args->in[15]) + ((size_t)l * NE + e) * D * DE, DE, 128 * j + (rr & 127), D, WSP(unsigned char, WS_WGU) + (size_t)e * 4096 * D, D, n0, 64 * kb, 32.0f, scr, lane); continue; }
        else { r -= 16 * I_GU1; const int e = r / I_D1, q = r % I_D1, kb = q / 32, nb = q % 32;
            tr_item8(args->in[17] + ((size_t)l * NE + e) * DE * D, D, 32 * nb, DE, WSP(unsigned char, WS_WD) + (size_t)e * D * DE, DE, 32 * nb, 64 * kb, 32.0f, scr, lane); continue; }
        tr_item(src, sld, sc0, nv, kv, dst, dld, dr0, k0, scr, lane);
    }
    if (l == 0) {
        for (int t = gw; t < T_ALL; t += NGW) {
            const float* xr = (t < T_P) ? args->in[0] + (size_t)t * D : args->in[1] + (size_t)(t - T_P) * D;
            bf16_t* o = WSP(bf16_t, WS_XB) + (size_t)t * D;
#pragma unroll
            for (int j = 0; j < 4; ++j) { const f32x4 v = *(const f32x4*)(xr + 4 * lane + 256 * j); u32x2 w; w.x = pk2(v[0], v[1]); w.y = pk2(v[2], v[3]); *(u32x2*)(o + 4 * lane + 256 * j) = w;
                *(unsigned*)(WSP(unsigned char, WS_XB8) + (size_t)t * D + 4 * lane + 256 * j) = pk4_fp8(v[0], v[1], v[2], v[3]); }
        }
        float* cs = WSP(float, WS_CS);
        for (int i = c.bid * 512 + c.tid; i < 16384 * 32; i += c.G * 512) { const int pos = i >> 5, k = i & 31;
            const float inv = INV_FREQ[k];
            const float ang = (float)pos * inv;
            cs[pos * 64 + k] = cosf(ang); cs[pos * 64 + 32 + k] = sinf(ang); }
    }
}

constexpr int TLD = 72, TILEB = 64 * TLD * 2;
DI int tsw(int row) { return ((row >> 4) & 3) << 3; }
template <bool SA = false, bool SB = false> DI f32x16 mm_tile(const LAS bf16_t* A, const LAS bf16_t* Bt, int m0, int n0, int lane) {
    f32x16 acc = zero16(); const int r = lane & 31, hh = lane >> 5; const int sa = SA ? tsw(m0 + r) : 0, sb = SB ? tsw(n0 + r) : 0;
#pragma unroll
    for (int ks = 0; ks < 4; ++ks) { const bf16x8 a = *(const LAS bf16x8*)(A + (m0 + r) * TLD + ((16 * ks + 8 * hh) ^ sa)); const bf16x8 b = *(const LAS bf16x8*)(Bt + (n0 + r) * TLD + ((16 * ks + 8 * hh) ^ sb)); acc = MFMA32(a, b, acc); }
    return acc;
}

constexpr int PI_P0 = 0, PI_P1 = 9216, PI_INTRA = 18432, PI_AM = 27648, PI_TT = 45056, PI_TD0 = 54272, PI_TD1 = 60416, PI_PM = 65024, PI_VEC = 71168, PI_BYTES = 72704;
constexpr int PI_WT = PI_AM, PI_UT = PI_TD0;
struct PrepIn { float bl[2], al[2], cw[2]; };
DI void gdn_prep_loads(KArgs args, const Ctx& c, int pu, PrepIn& in) {
    int tid = c.tid; asm volatile("" : "+v"(tid));
    { const float* cwg = args->in[4] + (size_t)c.layer * 5 * 1152 + 64 * (pu % 6);
#pragma unroll
        for (int k = 0; k < 2; ++k) { int i = tid + 512 * k; i = i < 960 ? i : 959; const int tp = i / 192, r = i % 192; in.cw[k] = cwg[tp * 1152 + (r >> 6) * 384 + (r & 63)]; } }
    const int dir = tid >> 8, tg = tid & 255, head = pu % 6, gch = pu / 6, cps = c.seqlen >> 6, seq = gch / cps, n = gch % cps, ia = tg >> 3, p = tg & 7, tr = ia + 32 * dir;
    const float* BA = BIGP(float, B_BA);
#pragma unroll
    for (int h2 = 0; h2 < 2; ++h2) { const int i = ia + 32 * h2, tokl = dir ? 63 - i : i; const float* bar = BA + (size_t)(seq * c.seqlen + n * 64 + tokl) * 32;
        in.bl[h2] = bar[dir * 6 + head]; in.al[h2] = bar[12 + dir * 6 + head]; }
}
DI void gdn_prep_put_cw(LAS unsigned char* L0, const Ctx& c, const PrepIn& in) {
    int tid = c.tid; asm volatile("" : "+v"(tid)); LAS float* CW = (LAS float*)(L0 + LDS_CW);
    CW[tid] = in.cw[0]; if (tid < 448) CW[tid + 512] = in.cw[1];
}
DI void gdn_prep_pair(KArgs args, LAS unsigned char* L0, const Ctx& c, int pu, PrepIn& in, int pu_next) {
    int tid = c.tid; asm volatile("" : "+v"(tid)); const int lane = tid & 63, wave = __builtin_amdgcn_readfirstlane(tid >> 6), l = c.layer;
    const int dir = wave >> 2, wg = wave & 3, tg = tid & 255, head = pu % 6, gch = pu / 6, inst = (gch * 6 + head) * 2 + dir;
    const int cps = c.seqlen >> 6, seq = gch / cps, n = gch % cps;
    const bf16_t* PROJ = BIGP(bf16_t, B_PROJ); const float* BA = BIGP(float, B_BA);
    unsigned char* G = BIGP(unsigned char, B_GSCR) + (size_t)inst * GSTRIDE;
    LAS unsigned char* L = L0 + dir * PI_BYTES;
    LAS bf16_t* P0 = (LAS bf16_t*)(L + PI_P0); LAS bf16_t* P1 = (LAS bf16_t*)(L + PI_P1); LAS bf16_t* INTRA = (LAS bf16_t*)(L + PI_INTRA);
    LAS float* AM = (LAS float*)(L + PI_AM); LAS bf16_t* TT = (LAS bf16_t*)(L + PI_TT);
    LAS float* TD0 = (LAS float*)(L + PI_TD0); LAS float* TD1 = (LAS float*)(L + PI_TD1); LAS float* PM = (LAS float*)(L + PI_PM);
    LAS float* GV = (LAS float*)(L + PI_VEC); LAS float* BV = GV + 64; LAS float* GC = GV + 128;
    LAS bf16_t* WT = (LAS bf16_t*)(L + PI_WT); LAS bf16_t* UT = (LAS bf16_t*)(L + PI_UT);
    const int ia = tg >> 3, p = tg & 7;
    LAS float* XQ = (LAS float*)(L0 + PI_AM);
    LAS float* XK = (LAS float*)(L0 + PI_TT);
    LAS float* XV = (LAS float*)(L0 + PI_BYTES + PI_AM);
    {   float q1[8], k1[8], v1[8];
#pragma unroll
        for (int j = 0; j < 8; ++j) { q1[j] = 0.f; k1[j] = 0.f; v1[j] = 0.f; }
        const LAS float* cw = (const LAS float*)(L0 + LDS_CW) + 8 * p;
        const int tr = ia + 32 * dir;
        u32x4 rqa[5], rka[5], rva[5];
#pragma unroll
        for (int tp = 0; tp < 5; ++tp) { const int pp = n * 64 + tr + tp - 2, ppc = pp < 0 ? 0 : (pp >= c.seqlen ? c.seqlen - 1 : pp);
            const bf16_t* rp = PROJ + (size_t)(seq * c.seqlen + ppc) * NPROJ + 64 * head + 8 * p;
            rqa[tp] = *(const u32x4*)(rp + C_QC); rka[tp] = *(const u32x4*)(rp + C_KC); rva[tp] = *(const u32x4*)(rp + C_VC); }
#pragma unroll
        for (int tp = 0; tp < 5; ++tp) { const LAS float* w = cw + tp * 192;
            const f32x4 wq0 = *(const LAS f32x4*)w, wq1 = *(const LAS f32x4*)(w + 4), wk0 = *(const LAS f32x4*)(w + 64), wk1 = *(const LAS f32x4*)(w + 68), wv0 = *(const LAS f32x4*)(w + 128), wv1 = *(const LAS f32x4*)(w + 132);
            const int pp = n * 64 + tr + tp - 2; const bool inr = (pp >= 0 && pp < c.seqlen);
            { u32x4 rq = rqa[tp], rk = rka[tp], rv = rva[tp];
                if (!inr) { rq = (u32x4){0u, 0u, 0u, 0u}; rk = rq; rv = rq; }
#pragma unroll
                for (int j = 0; j < 4; ++j) { const float a0 = (j < 2) ? wq0[2 * j] : wq1[2 * j - 4], a1 = (j < 2) ? wq0[2 * j + 1] : wq1[2 * j - 3];
                    const float b0 = (j < 2) ? wk0[2 * j] : wk1[2 * j - 4], b1 = (j < 2) ? wk0[2 * j + 1] : wk1[2 * j - 3];
                    const float c0 = (j < 2) ? wv0[2 * j] : wv1[2 * j - 4], c1 = (j < 2) ? wv0[2 * j + 1] : wv1[2 * j - 3];
                    q1[2 * j] += a0 * bflo(rq[j]); q1[2 * j + 1] += a1 * bfhi(rq[j]);
                    k1[2 * j] += b0 * bflo(rk[j]); k1[2 * j + 1] += b1 * bfhi(rk[j]);
                    v1[2 * j] += c0 * bflo(rv[j]); v1[2 * j + 1] += c1 * bfhi(rv[j]); } } }
        float sq = 0.f, sk = 0.f;
#pragma unroll
        for (int j = 0; j < 8; ++j) { q1[j] = siluf_(q1[j]); k1[j] = siluf_(k1[j]); v1[j] = siluf_(v1[j]); sq += q1[j] * q1[j]; sk += k1[j] * k1[j]; }
        sq += __shfl_xor(sq, 1); sq += __shfl_xor(sq, 2); sq += __shfl_xor(sq, 4);
        sk += __shfl_xor(sk, 1); sk += __shfl_xor(sk, 2); sk += __shfl_xor(sk, 4);
        const float rq_ = 0.125f * frsq(sq + NORM_EPS), rk_ = frsq(sk + NORM_EPS);
        f32x4 o0, o1;
        o0[0] = q1[0] * rq_; o0[1] = q1[1] * rq_; o0[2] = q1[2] * rq_; o0[3] = q1[3] * rq_; o1[0] = q1[4] * rq_; o1[1] = q1[5] * rq_; o1[2] = q1[6] * rq_; o1[3] = q1[7] * rq_;
        *(LAS f32x4*)(XQ + tr * 64 + 8 * p) = o0; *(LAS f32x4*)(XQ + tr * 64 + 8 * p + 4) = o1;
        o0[0] = k1[0] * rk_; o0[1] = k1[1] * rk_; o0[2] = k1[2] * rk_; o0[3] = k1[3] * rk_; o1[0] = k1[4] * rk_; o1[1] = k1[5] * rk_; o1[2] = k1[6] * rk_; o1[3] = k1[7] * rk_;
        *(LAS f32x4*)(XK + tr * 64 + 8 * p) = o0; *(LAS f32x4*)(XK + tr * 64 + 8 * p + 4) = o1;
        o0[0] = v1[0]; o0[1] = v1[1]; o0[2] = v1[2]; o0[3] = v1[3]; o1[0] = v1[4]; o1[1] = v1[5]; o1[2] = v1[6]; o1[3] = v1[7];
        *(LAS f32x4*)(XV + tr * 64 + 8 * p) = o0; *(LAS f32x4*)(XV + tr * 64 + 8 * p + 4) = o1; }
#pragma unroll
    for (int h2 = 0; h2 < 2; ++h2) {
        if (p == 0) { const int i = ia + 32 * h2;
            const float bl = in.bl[h2], al = in.al[h2];
            const float xx = al + args->in[6][l * 12 + dir * 6 + head];
            const float sp = xx > 20.f ? xx : log1pf(expf(xx));
            GV[i] = -expf(args->in[5][l * 12 + dir * 6 + head]) * sp; BV[i] = sigmoidf_(bl); } }
    lds_barrier();
    float q[2][8], k[2][8], v[2][8];
#pragma unroll
    for (int h2 = 0; h2 < 2; ++h2) { const int i = ia + 32 * h2, tokl = dir ? 63 - i : i;
        const f32x4 a0 = *(const LAS f32x4*)(XQ + tokl * 64 + 8 * p), a1 = *(const LAS f32x4*)(XQ + tokl * 64 + 8 * p + 4), b0 = *(const LAS f32x4*)(XK + tokl * 64 + 8 * p), b1 = *(const LAS f32x4*)(XK + tokl * 64 + 8 * p + 4),
                    c0 = *(const LAS f32x4*)(XV + tokl * 64 + 8 * p), c1 = *(const LAS f32x4*)(XV + tokl * 64 + 8 * p + 4);
#pragma unroll
        for (int j = 0; j < 4; ++j) { q[h2][j] = a0[j]; q[h2][4 + j] = a1[j]; k[h2][j] = b0[j]; k[h2][4 + j] = b1[j]; v[h2][j] = c0[j]; v[h2][4 + j] = c1[j]; } }
    float gcl_;
    { float x = GV[lane];
#pragma unroll
        for (int o = 1; o < 64; o <<= 1) { const float y = __shfl_up(x, o); if (lane >= o) x += y; }
        if (wg == 0) GC[lane] = x;
        gcl_ = x; }
    const float gc0 = __shfl(gcl_, ia), gc1 = __shfl(gcl_, ia + 32), gcl = __shfl(gcl_, 63);
#pragma unroll
    for (int h2 = 0; h2 < 2; ++h2) { const int i = ia + 32 * h2; u32x4 wq, wk;
#pragma unroll
        for (int j = 0; j < 4; ++j) { wq[j] = pk2(q[h2][2 * j], q[h2][2 * j + 1]); wk[j] = pk2(k[h2][2 * j], k[h2][2 * j + 1]); }
        *(LAS u32x4*)(P0 + i * TLD + 8 * p) = wq; *(LAS u32x4*)(P1 + i * TLD + 8 * p) = wk; }
    lds_barrier();
    { const int mat = wg >> 1, mt = wg & 1, hh = lane >> 5;
        float gi[16], bi[16];
#pragma unroll
        for (int r = 0; r < 16; ++r) { const int ii = 32 * mt + crow(r, hh); gi[r] = GC[ii]; bi[r] = BV[ii]; }
        __builtin_amdgcn_sched_barrier(0);
#pragma unroll
        for (int nt = 0; nt < 2; ++nt) { const int jc = 32 * nt + (lane & 31);
            const f32x16 a = mm_tile(mat ? P0 : P1, P1, 32 * mt, 32 * nt, lane);
            const float gj = GC[jc];
            if (mat == 0) {
#pragma unroll
                for (int r = 0; r < 16; ++r) { const int ii = 32 * mt + crow(r, hh); const float ev = bi[r] * a[r] * __expf(gi[r] - gj); AM[ii * 68 + jc] = (jc < ii) ? ev : 0.f; }
            } else {
#pragma unroll
                for (int r = 0; r < 16; ++r) { const int ii = 32 * mt + crow(r, hh); const float ev = a[r] * __expf(gi[r] - gj); INTRA[ii * TLD + jc] = (bf16_t)(pk2((jc <= ii) ? ev : 0.f, 0.f) & 0xffffu); } } } }
    lds_barrier();
    if (wg == dir) {
        const int b = lane >> 5, cidx = lane & 31; float t[32]; typedef float f32x2_ __attribute__((ext_vector_type(2)));
#pragma unroll
        for (int ii = 0; ii < 32; ++ii) t[ii] = (ii == cidx) ? 1.f : 0.f;
        const LAS float* Ab = AM + (32 * b) * 68 + 32 * b;
        f32x4 rb[2][8];
        rb[1][0] = *(const LAS f32x4*)(Ab + 68);
        __builtin_amdgcn_sched_barrier(0);
#pragma unroll
        for (int ii = 1; ii < 32; ++ii) {
            if (ii + 1 < 32) {
#pragma unroll
                for (int j4 = 0; j4 < ii + 1; j4 += 4) rb[(ii + 1) & 1][j4 >> 2] = *(const LAS f32x4*)(Ab + (ii + 1) * 68 + j4); }
            __builtin_amdgcn_sched_barrier(0);
            f32x2_ a0 = {0.f, 0.f}, a1 = {0.f, 0.f};
#pragma unroll
            for (int j4 = 0; j4 < ii; j4 += 4) { const f32x4 a4 = rb[ii & 1][j4 >> 2];
                const f32x2_ tl = {t[j4], t[j4 + 1]}, th = {t[j4 + 2], t[j4 + 3]}, al = {a4[0], a4[1]}, ah = {a4[2], a4[3]};
                a0 += al * tl; a1 += ah * th; }
            a0 += a1; t[ii] -= a0.x + a0.y;
            __builtin_amdgcn_sched_barrier(0); }
        LAS float* td = b ? TD1 : TD0; const int tds = b ? 36 : 48;
#pragma unroll
        for (int ii = 0; ii < 32; ++ii) { td[ii * tds + cidx] = t[ii]; TT[(32 * b + ii) * TLD + 32 * b + cidx] = (bf16_t)(pk2(t[ii], 0.f) & 0xffffu); }
    }
#pragma unroll
    for (int h2 = 0; h2 < 2; ++h2) { const int i = ia + 32 * h2; const float be = BV[i], eg = __expf(h2 ? gc1 : gc0);
#pragma unroll
        for (int j = 0; j < 8; ++j) { const int d = 8 * p + j, o_ = d * TLD + (i ^ tsw(d)); P0[o_] = (bf16_t)(pk2(k[h2][j] * be * eg, 0.f) & 0xffffu); P1[o_] = (bf16_t)(pk2(v[h2][j] * be, 0.f) & 0xffffu); } }
    { unsigned zz; asm volatile("v_mov_b32 %0, 0" : "=v"(zz)); u32x2 z; z.x = zz; z.y = zz; *(LAS u32x2*)(TT + (tg >> 3) * TLD + 32 + 4 * (tg & 7)) = z; }
    lds_barrier();
    { const int qi = wg >> 1, qj = wg & 1, r16 = lane & 15, g4 = lane >> 4; f32x4 pc = {0.f, 0.f, 0.f, 0.f}; float av[8], bw[8];
#pragma unroll
        for (int kk = 0; kk < 8; ++kk) { av[kk] = AM[(32 + 16 * qi + r16) * 68 + 4 * kk + g4]; bw[kk] = TD0[(4 * kk + g4) * 48 + 16 * qj + r16]; }
        __builtin_amdgcn_sched_barrier(0);
#pragma unroll
        for (int kk = 0; kk < 8; ++kk) pc = __builtin_amdgcn_mfma_f32_16x16x4f32(av[kk], bw[kk], pc, 0, 0, 0);
#pragma unroll
        for (int r = 0; r < 4; ++r) PM[(16 * qi + 4 * g4 + r) * 48 + 16 * qj + r16] = pc[r]; }
    lds_barrier();
    { const int qi = wg >> 1, qj = wg & 1, r16 = lane & 15, g4 = lane >> 4; f32x4 pc = {0.f, 0.f, 0.f, 0.f}; float av[8], bw[8];
#pragma unroll
        for (int kk = 0; kk < 8; ++kk) { av[kk] = TD1[(16 * qi + r16) * 36 + 4 * kk + g4]; bw[kk] = PM[(4 * kk + g4) * 48 + 16 * qj + r16]; }
        __builtin_amdgcn_sched_barrier(0);
#pragma unroll
        for (int kk = 0; kk < 8; ++kk) pc = __builtin_amdgcn_mfma_f32_16x16x4f32(av[kk], bw[kk], pc, 0, 0, 0);
#pragma unroll
        for (int r = 0; r < 4; ++r) TT[(32 + 16 * qi + 4 * g4 + r) * TLD + 16 * qj + r16] = (bf16_t)(pk2(-pc[r], 0.f) & 0xffffu); }
    lds_barrier();
    { const int which = wg >> 1, mt = wg & 1, hh = lane >> 5;
#pragma unroll
        for (int nt = 0; nt < 2; ++nt) { const int dc = 32 * nt + (lane & 31);
            const f32x16 a = mm_tile<false, true>(TT, which ? P1 : P0, 32 * mt, 32 * nt, lane);
            LAS bf16_t* dst = (which ? UT : WT) + dc * TLD; const int sw = tsw(dc);
#pragma unroll
            for (int g = 0; g < 4; ++g) { u32x2 w; w.x = pk2(a[4 * g], a[4 * g + 1]); w.y = pk2(a[4 * g + 2], a[4 * g + 3]); *(LAS u32x2*)(dst + ((32 * mt + 8 * g + 4 * hh) ^ sw)) = w; } } }
    lds_barrier();
#pragma unroll
    for (int h2 = 0; h2 < 2; ++h2) { const int i = ia + 32 * h2; const float gci = h2 ? gc1 : gc0, eg = __expf(gci), ekd = __expf(gcl - gci); u32x4 wqd;
#pragma unroll
        for (int j = 0; j < 4; ++j) wqd[j] = pk2(q[h2][2 * j] * eg, q[h2][2 * j + 1] * eg);
        *(LAS u32x4*)(P1 + i * TLD + 8 * p) = wqd;
#pragma unroll
        for (int j = 0; j < 8; ++j) { const int d = 8 * p + j; P0[d * TLD + (i ^ tsw(d))] = (bf16_t)(pk2(k[h2][j] * ekd, 0.f) & 0xffffu); } }
    lds_barrier();
    if (pu_next >= 0) gdn_prep_loads(args, c, pu_next, in);
    { const int hh = lane >> 5, rr = lane & 31;
        if (wg == 0) {
#pragma unroll
            for (int t4 = 0; t4 < 4; ++t4) { const int mtb = t4 >> 1, nta = t4 & 1; const f32x16 a = mm_tile<true, true>(WT, P0, 32 * mtb, 32 * nta, lane);
                f32x16 na; for (int r = 0; r < 16; ++r) na[r] = -a[r];
                *(bf16x8*)(G + (size_t)((nta * 4 + 2 * mtb) * 64 + lane) * 16) = pack8<0>(na); *(bf16x8*)(G + (size_t)((nta * 4 + 2 * mtb + 1) * 64 + lane) * 16) = pack8<1>(na); }
        } else if (wg == 1) {
#pragma unroll
            for (int t4 = 0; t4 < 4; ++t4) { const int mta = t4 >> 1, nte = t4 & 1; const f32x16 a = mm_tile<true, true>(P0, UT, 32 * mta, 32 * nte, lane);
                bf16x8* dp = (bf16x8*)(G + 8192 + (size_t)((nte * 2 + mta) * 64 + lane) * 32); dp[0] = pack8<0>(a); dp[1] = pack8<1>(a); }
        } else if (wg == 2) {
#pragma unroll
            for (int t4 = 0; t4 < 4; ++t4) { const int mtb = t4 >> 1, nti = t4 & 1; const f32x16 a = mm_tile<true, false>(WT, INTRA, 32 * mtb, 32 * nti, lane);
                f32x16 qe; const LAS bf16_t* qd = P1 + (32 * nti + rr) * TLD + 32 * mtb + 4 * hh;
#pragma unroll
                for (int g = 0; g < 4; ++g) { const u32x2 w = *(const LAS u32x2*)(qd + 8 * g); qe[4 * g] = bflo(w.x) - a[4 * g]; qe[4 * g + 1] = bfhi(w.x) - a[4 * g + 1]; qe[4 * g + 2] = bflo(w.y) - a[4 * g + 2]; qe[4 * g + 3] = bfhi(w.y) - a[4 * g + 3]; }
                *(bf16x8*)(G + 16384 + (size_t)((nti * 4 + 2 * mtb) * 64 + lane) * 16) = pack8<0>(qe); *(bf16x8*)(G + 16384 + (size_t)((nti * 4 + 2 * mtb + 1) * 64 + lane) * 16) = pack8<1>(qe); }
        } else {
#pragma unroll
            for (int t4 = 0; t4 < 4; ++t4) { const int mti = t4 >> 1, nte = t4 & 1; const f32x16 a = mm_tile<false, true>(INTRA, UT, 32 * mti, 32 * nte, lane);
                bf16x8* dp = (bf16x8*)(G + 24576) + (size_t)((nte * 2 + mti) * 2) * 64 + lane; dp[0] = pack8<0>(a); dp[64] = pack8<1>(a); }
            if (lane == 0) *(float*)(G + 40960) = __expf(gcl);
        } }
    if (pu_next >= 0) gdn_prep_put_cw(L0, c, in);
    lds_barrier();
}

DI void pv_accum(const f32x16 (&acc)[2][2], f32x16 (&o)[2][2], const LAS bf16_t* Vt, int lane) {
    const int r = lane & 31, hh = lane >> 5;
#pragma unroll
    for (int mt = 0; mt < 2; ++mt) {
        {   const bf16x8 p0 = pack8<0>(acc[mt][0]), p1 = pack8<0>(acc[mt][1]);
#pragma unroll
            for (int mo = 0; mo < 2; ++mo) { const LAS bf16_t* s = Vt + (32 * mo + r) * TLD; const int c0 = (32 * mt + 4 * hh) ^ tsw(32 * mo + r);
                const u32x2 lo = *(const LAS u32x2*)(s + c0), hi = *(const LAS u32x2*)(s + (c0 ^ 8)); u32x4 w; w.x = lo.x; w.y = lo.y; w.z = hi.x; w.w = hi.y; const bf16x8 vf = __builtin_bit_cast(bf16x8, w);
                o[mo][0] = MFMA32(vf, p0, o[mo][0]); o[mo][1] = MFMA32(vf, p1, o[mo][1]); } }
        {   const bf16x8 p0 = pack8<1>(acc[mt][0]), p1 = pack8<1>(acc[mt][1]);
#pragma unroll
            for (int mo = 0; mo < 2; ++mo) { const LAS bf16_t* s = Vt + (32 * mo + r) * TLD; const int c0 = (32 * mt + 16 + 4 * hh) ^ tsw(32 * mo + r);
                const u32x2 lo = *(const LAS u32x2*)(s + c0), hi = *(const LAS u32x2*)(s + (c0 ^ 8)); u32x4 w; w.x = lo.x; w.y = lo.y; w.z = hi.x; w.w = hi.y; const bf16x8 vf = __builtin_bit_cast(bf16x8, w);
                o[mo][0] = MFMA32(vf, p0, o[mo][0]); o[mo][1] = MFMA32(vf, p1, o[mo][1]); } }
    }
}
template <class F> DI void load_v(u32x4 (&vr)[8], int lane, F vrow) {
#pragma unroll
    for (int it = 0; it < 8; ++it) { const int id = it * 64 + lane, key = id >> 3, part = id & 7; vr[it] = *(const u32x4*)(vrow(key) + 8 * part); }
}
DI void put_vt(LAS bf16_t* Vt, int lane, const u32x4 (&vr)[8]) {
#pragma unroll
    for (int it = 0; it < 8; ++it) { const int id = it * 64 + lane, key = id >> 3, part = id & 7; const u32x4 w = vr[it];
#pragma unroll
        for (int j = 0; j < 4; ++j) { const int d0 = 8 * part + 2 * j, ks_ = key ^ tsw(d0); Vt[d0 * TLD + ks_] = (bf16_t)(w[j] & 0xffffu); Vt[(d0 + 1) * TLD + ks_] = (bf16_t)(w[j] >> 16); } }
}
DI void write_o_slot(LAS float* SL, const f32x16 (&o)[2][2], int lane) {
    const int r = lane & 31, hh = lane >> 5;
#pragma unroll
    for (int mo = 0; mo < 2; ++mo)
#pragma unroll
        for (int nt = 0; nt < 2; ++nt)
#pragma unroll
            for (int g = 0; g < 4; ++g) { f32x4 v; v[0] = o[mo][nt][4 * g]; v[1] = o[mo][nt][4 * g + 1]; v[2] = o[mo][nt][4 * g + 2]; v[3] = o[mo][nt][4 * g + 3];
                *(LAS f32x4*)(SL + (32 * nt + r) * 68 + 32 * mo + 8 * g + 4 * hh) = v; }
}
DI void add_o_slot(const LAS float* SL, f32x16 (&o)[2][2], int lane) {
    const int r = lane & 31, hh = lane >> 5;
#pragma unroll
    for (int mo = 0; mo < 2; ++mo)
#pragma unroll
        for (int nt = 0; nt < 2; ++nt)
#pragma unroll
            for (int g = 0; g < 4; ++g) { const f32x4 v = *(const LAS f32x4*)(SL + (32 * nt + r) * 68 + 32 * mo + 8 * g + 4 * hh);
                o[mo][nt][4 * g] += v[0]; o[mo][nt][4 * g + 1] += v[1]; o[mo][nt][4 * g + 2] += v[2]; o[mo][nt][4 * g + 3] += v[3]; }
}

constexpr int WAREA = 10240;
DI void osm_update(f32x16 (&acc)[2][2], f32x16 (&o)[2][2], float (&m)[2], float (&l)[2]) {
#pragma unroll
    for (int nt = 0; nt < 2; ++nt) { float mx = -1e30f;
#pragma unroll
        for (int mt = 0; mt < 2; ++mt)
#pragma unroll
            for (int g = 0; g < 16; ++g) mx = fmaxf(mx, acc[mt][nt][g]);
        mx = fmaxf(mx, __shfl_xor(mx, 32));
        const float mn = fmaxf(m[nt], mx), sc = __expf(m[nt] - mn); float sm = 0.f;
#pragma unroll
        for (int mt = 0; mt < 2; ++mt)
#pragma unroll
            for (int g = 0; g < 16; ++g) { const float pz = __expf(acc[mt][nt][g] - mn); acc[mt][nt][g] = pz; sm += pz; }
        sm += __shfl_xor(sm, 32);
        l[nt] = l[nt] * sc + sm; m[nt] = mn;
#pragma unroll
        for (int g = 0; g < 16; ++g) { o[0][nt][g] *= sc; o[1][nt][g] *= sc; } }
}
template <class F> DI void store_o_rows(LAS bf16_t* T, const f32x16 (&o)[2][2], const float (&scale)[2], int lane, F rowp) {
    const int r = lane & 31, hh = lane >> 5;
#pragma unroll
    for (int mo = 0; mo < 2; ++mo)
#pragma unroll
        for (int nt = 0; nt < 2; ++nt)
#pragma unroll
            for (int g = 0; g < 4; ++g) { u32x2 w; w.x = pk2(o[mo][nt][4 * g] * scale[nt], o[mo][nt][4 * g + 1] * scale[nt]); w.y = pk2(o[mo][nt][4 * g + 2] * scale[nt], o[mo][nt][4 * g + 3] * scale[nt]);
                *(LAS u32x2*)(T + (32 * nt + r) * TLD + 32 * mo + 8 * g + 4 * hh) = w; }
    asm volatile("s_waitcnt lgkmcnt(0)" ::: "memory");
#pragma unroll
    for (int it = 0; it < 8; ++it) { const int id = it * 64 + lane, q = id >> 3, part = id & 7; *(u32x4*)(rowp(q) + 8 * part) = *(const LAS u32x4*)(T + q * TLD + 8 * part); }
    asm volatile("s_waitcnt lgkmcnt(0)" ::: "memory");
}
DI void na_wave_unit(KArgs args, LAS unsigned char* L, const Ctx& c, int u, int lane, int wave) {
    const int l = c.layer, head = u & 3, gr = u >> 2, rows = c.seqlen >> 6, seq = gr / rows, r = gr % rows;
    int rs = r - 4; rs = rs < 0 ? 0 : (rs > rows - 8 ? rows - 8 : rs);
    const bf16_t* PROJ = BIGP(bf16_t, B_PROJ);
    const size_t tq0 = (size_t)seq * c.seqlen + (size_t)r * 64;
    LAS bf16_t* Vt = (LAS bf16_t*)(L + wave * WAREA);
    LAS float* BIAS = (LAS float*)(L + wave * WAREA + 9216);
    const int rr = lane & 31, hh = lane >> 5;
#pragma unroll
    for (int w = 0; w < 4; ++w) { const int idx = w * 64 + lane, kw = idx >> 5, dc = idx & 31;
        if (dc < 31) BIAS[idx] = args->in[3][(((size_t)l * 4 + head) * 15 + (rs + kw - r + 7)) * 31 + dc]; }
    bf16x8 qf[2][4];
#pragma unroll
    for (int nt = 0; nt < 2; ++nt)
#pragma unroll
        for (int ks = 0; ks < 4; ++ks) qf[nt][ks] = *(const bf16x8*)(PROJ + (tq0 + 32 * nt + rr) * NPROJ + C_QA + 64 * head + 16 * ks + 8 * hh);
    f32x16 o[2][2]; o[0][0] = zero16(); o[0][1] = zero16(); o[1][0] = zero16(); o[1][1] = zero16();
    float m[2] = {-1e30f, -1e30f}, ls[2] = {0.f, 0.f};
    for (int w = 0; w < 8; ++w) {
        const size_t tk0 = (size_t)seq * c.seqlen + (size_t)(rs + w) * 64;
        u32x4 vr[8]; bf16x8 kf[2][4];
        load_v(vr, lane, [&](int key) { return PROJ + (tk0 + key) * NPROJ + C_VA + 64 * head; });
#pragma unroll
        for (int mt = 0; mt < 2; ++mt)
#pragma unroll
            for (int ks = 0; ks < 4; ++ks) kf[mt][ks] = *(const bf16x8*)(PROJ + (tk0 + 32 * mt + rr) * NPROJ + C_KA + 64 * head + 16 * ks + 8 * hh);
        __builtin_amdgcn_sched_barrier(0);
        asm volatile("s_waitcnt lgkmcnt(0)" ::: "memory");
        put_vt(Vt, lane, vr);
        f32x16 acc[2][2]; acc[0][0] = zero16(); acc[0][1] = zero16(); acc[1][0] = zero16(); acc[1][1] = zero16();
#pragma unroll
        for (int mt = 0; mt < 2; ++mt)
#pragma unroll
            for (int ks = 0; ks < 4; ++ks) { acc[mt][0] = MFMA32(kf[mt][ks], qf[0][ks], acc[mt][0]); acc[mt][1] = MFMA32(kf[mt][ks], qf[1][ks], acc[mt][1]); }
        asm volatile("s_waitcnt lgkmcnt(0)" ::: "memory");
        const LAS float* brow = BIAS + w * 32;
#pragma unroll
        for (int nt = 0; nt < 2; ++nt) { const int qc = 32 * nt + rr; int ws = qc - 8; ws = ws < 0 ? 0 : (ws > 48 ? 48 : ws);
#pragma unroll
            for (int mt = 0; mt < 2; ++mt) {
                const volatile LAS float* bp = brow + (32 * mt + 4 * hh - qc + 15); float bv[16];
#pragma unroll
                for (int g = 0; g < 16; ++g) { const bool live = (mt == nt) || (nt == 0 ? g < 4 : g >= 12);
                    bv[g] = live ? bp[(g & 3) + 8 * (g >> 2)] : 0.f; }
#pragma unroll
                for (int g = 0; g < 16; ++g) { const bool live = (mt == nt) || (nt == 0 ? g < 4 : g >= 12); const int kc = 32 * mt + crow(g, hh); const bool ok = live && (kc >= ws) && (kc < ws + 16);
                    acc[mt][nt][g] = ok ? acc[mt][nt][g] * 0.125f + bv[g] : -1e30f; } } }
        osm_update(acc, o, m, ls);
        pv_accum(acc, o, Vt, lane);
    }
    asm volatile("s_waitcnt lgkmcnt(0)" ::: "memory");
    const float sc[2] = {frcp(ls[0]), frcp(ls[1])};
    store_o_rows(Vt, o, sc, lane, [&](int q) { return BIGP(bf16_t, B_ONA) + (tq0 + q) * 768 + 64 * head; });
}
struct RopeCS { f32x4 v[2][4]; };
DI void rope_load(RopeCS& t, const float* cs, int hh) {
#pragma unroll
    for (int ks = 0; ks < 2; ++ks) { const float* cp = cs + 16 * ks + 8 * hh; t.v[ks][0] = *(const f32x4*)cp; t.v[ks][1] = *(const f32x4*)(cp + 4); t.v[ks][2] = *(const f32x4*)(cp + 32); t.v[ks][3] = *(const f32x4*)(cp + 36); }
}
DI void rope_frag4(bf16x8 (&f)[4], const RopeCS& t) {
#pragma unroll
    for (int ks = 0; ks < 2; ++ks) {
        const f32x4 c0 = t.v[ks][0], c1 = t.v[ks][1], s0 = t.v[ks][2], s1 = t.v[ks][3];
        const u32x4 a = __builtin_bit_cast(u32x4, f[ks]), b = __builtin_bit_cast(u32x4, f[ks + 2]); u32x4 ra, rb;
#pragma unroll
        for (int j = 0; j < 4; ++j) { const float cl = (j < 2) ? c0[2 * j] : c1[2 * j - 4], ch = (j < 2) ? c0[2 * j + 1] : c1[2 * j - 3];
            const float sl = (j < 2) ? s0[2 * j] : s1[2 * j - 4], sh = (j < 2) ? s0[2 * j + 1] : s1[2 * j - 3];
            const float x1l = bflo(a[j]), x1h = bfhi(a[j]), x2l = bflo(b[j]), x2h = bfhi(b[j]);
            ra[j] = pk2(x1l * cl - x2l * sl, x1h * ch - x2h * sh); rb[j] = pk2(x1l * sl + x2l * cl, x1h * sh + x2h * ch); }
        f[ks] = __builtin_bit_cast(bf16x8, ra); f[ks + 2] = __builtin_bit_cast(bf16x8, rb); }
}
DI void dil_wave_unit(KArgs args, LAS unsigned char* L, const Ctx& c, int u, int lane, int wave) {
    const int hd = u & 1, uu = u >> 1, upg = c.stok >> 6, g = uu / upg, v = uu % upg, ups = c.seqlen >> 6, seq = v / ups, wq = v % ups;
    const int dsh = 2 * g, dd = 1 << dsh, nb = ups >> dsh, cls = wq / nb, jb = wq % nb, head = 2 * g + hd;
    const bf16_t* PROJ = BIGP(bf16_t, B_PROJ); const float* CS = WSP(float, WS_CS);
    const size_t sb = (size_t)seq * c.seqlen;
    const int rr = lane & 31, hh = lane >> 5;
    LAS bf16_t* Vt = (LAS bf16_t*)(L + wave * WAREA);
    bf16x8 qf[2][4];
#pragma unroll
    for (int nt = 0; nt < 2; ++nt) { const int pos = cls + dd * (64 * jb + 32 * nt + rr);
#pragma unroll
        for (int ks = 0; ks < 4; ++ks) qf[nt][ks] = *(const bf16x8*)(PROJ + (sb + pos) * NPROJ + C_QD + 64 * head + 16 * ks + 8 * hh);
        RopeCS tq; rope_load(tq, CS + (size_t)pos * 64, hh); __builtin_amdgcn_sched_barrier(0);
        rope_frag4(qf[nt], tq); }
    f32x16 o[2][2]; o[0][0] = zero16(); o[0][1] = zero16(); o[1][0] = zero16(); o[1][1] = zero16();
    float m[2] = {-1e30f, -1e30f}, ls[2] = {0.f, 0.f};
    for (int kt = 0; kt < 3; ++kt) { const int kj = jb - 1 + kt;
        if (kj < 0 || kj >= nb) continue;
        u32x4 vr[8]; bf16x8 kfa[2][4];
        load_v(vr, lane, [&](int key) { return PROJ + (sb + cls + (size_t)dd * (64 * kj + key)) * NPROJ + C_VD + 64 * head; });
#pragma unroll
        for (int mt = 0; mt < 2; ++mt) { const int pos = cls + dd * (64 * kj + 32 * mt + rr);
#pragma unroll
            for (int ks = 0; ks < 4; ++ks) kfa[mt][ks] = *(const bf16x8*)(PROJ + (sb + pos) * NPROJ + C_KD + 64 * head + 16 * ks + 8 * hh); }
        __builtin_amdgcn_sched_barrier(0);
        asm volatile("s_waitcnt lgkmcnt(0)" ::: "memory");
        put_vt(Vt, lane, vr);
        f32x16 acc[2][2]; acc[0][0] = zero16(); acc[0][1] = zero16(); acc[1][0] = zero16(); acc[1][1] = zero16();
#pragma unroll
        for (int mt = 0; mt < 2; ++mt) {
            RopeCS tk; rope_load(tk, CS + (size_t)(cls + dd * (64 * kj + 32 * mt + rr)) * 64, hh); __builtin_amdgcn_sched_barrier(0);
            rope_frag4(kfa[mt], tk);
#pragma unroll
            for (int ks = 0; ks < 4; ++ks) { acc[mt][0] = MFMA32(kfa[mt][ks], qf[0][ks], acc[mt][0]); acc[mt][1] = MFMA32(kfa[mt][ks], qf[1][ks], acc[mt][1]); } }
#pragma unroll
        for (int nt = 0; nt < 2; ++nt) { const int qc = 32 * nt + rr;
#pragma unroll
            for (int mt = 0; mt < 2; ++mt)
#pragma unroll
                for (int gg = 0; gg < 16; ++gg) { const int kc = 32 * mt + crow(gg, hh); const bool ok = (kt == 1) || (kt == 0 ? (kc >= qc) : (kc <= qc));
                    acc[mt][nt][gg] = ok ? acc[mt][nt][gg] * 0.125f : -1e30f; } }
        osm_update(acc, o, m, ls);
        pv_accum(acc, o, Vt, lane);
    }
    asm volatile("s_waitcnt lgkmcnt(0)" ::: "memory");
    bf16_t* DP = BIGP(bf16_t, B_DILP); float* DM = BIGP(float, B_DILM);
    const float one[2] = {1.f, 1.f};
    store_o_rows(Vt, o, one, lane, [&](int q) { return DP + ((((size_t)g * SLABMAX + sb + cls + (size_t)dd * (64 * jb + q)) * 2 + hd)) * 64; });
    if (hh == 0) {
#pragma unroll
        for (int nt = 0; nt < 2; ++nt) { const size_t base = (((size_t)g * SLABMAX + sb + cls + (size_t)dd * (64 * jb + 32 * nt + rr)) * 2 + hd); DM[base * 2] = m[nt]; DM[base * 2 + 1] = ls[nt]; } }
}

DI void phase_mix_a(KArgs args, LAS unsigned char* L, const Ctx& c) {
    const int N_PREP = (c.stok >> 6) * 6;
    PrepIn in; if (c.bid < N_PREP) { gdn_prep_loads(args, c, c.bid, in); gdn_prep_put_cw(L, c, in); lds_barrier(); }
    for (int u = c.bid; u < N_PREP; u += c.G) gdn_prep_pair(args, L, c, u, in, u + c.G < N_PREP ? u + c.G : -1);
}
DI void attn_wave_units(KArgs args, LAS unsigned char* L, const Ctx& c) {
    int tid = c.tid; asm volatile("" : "+v"(tid)); const int lane = tid & 63, wave = __builtin_amdgcn_readfirstlane(tid >> 6);
    const int nch_ = c.stok >> 6, N_NA = nch_ * 4, N_DIL = nch_ * 6;
    unsigned* q = (unsigned*)(c.ws + WS_CTL) + 32768 + 128 * (c.layer * 4 + c.slab);
    for (;;) { unsigned u = 0; if (lane == 0) u = __hip_atomic_fetch_add(q, 1u, __ATOMIC_RELAXED, __HIP_MEMORY_SCOPE_AGENT);
        u = (unsigned)__builtin_amdgcn_readfirstlane((int)u); if (u >= (unsigned)N_NA) break; na_wave_unit(args, L, c, (int)u, lane, wave); }
    int tid2 = c.tid; asm volatile("" : "+v"(tid2)); const int lane2 = tid2 & 63, wave2 = __builtin_amdgcn_readfirstlane(tid2 >> 6);
    for (;;) { unsigned u = 0; if (lane2 == 0) u = __hip_atomic_fetch_add(q + 64, 1u, __ATOMIC_RELAXED, __HIP_MEMORY_SCOPE_AGENT);
        u = (unsigned)__builtin_amdgcn_readfirstlane((int)u); if (u >= (unsigned)N_DIL) break; dil_wave_unit(args, L, c, (int)u, lane2, wave2); }
}

DI void phase_select(KArgs args, LAS unsigned char* L, const Ctx& c, int inst);
DI void phase_scan(KArgs args, LAS unsigned char* L, const Ctx& c) {
    if (c.slab == NSLAB - 1 && c.bid >= 24 && c.bid < 40) { phase_select(args, L, c, c.bid - 24); return; }
    const int nwu = c.nseq * 24, wu = c.bid;
    if (wu < nwu && c.wave == 0) {
        const int lane = c.lane;
        const int chain = wu >> 1, nt = wu & 1, seq = chain / 12, rem = chain % 12, head = rem >> 1, dir = rem & 1;
        const int nch = c.seqlen >> 6, gch0 = seq * nch;
        unsigned char* GS = BIGP(unsigned char, B_GSCR);
        f32x16 S[2]; S[0] = zero16(); S[1] = zero16();
        bf16x8 A[2][2][4]; u32x4 cm[2][2][2];
        const long gstep = (long)(dir ? -1 : 1) * 12 * GSTRIDE;
        const unsigned char* G0 = GS + (size_t)(((gch0 + (dir ? nch - 1 : 0)) * 6 + head) * 2 + dir) * GSTRIDE;
        unsigned char* Gs = (unsigned char*)G0;
        float glv[4];
#pragma unroll
        for (int q = 0; q < 4; ++q) { const int sq = q * 64 + lane; glv[q] = *(const float*)(G0 + (long)(sq < nch ? sq : nch - 1) * gstep + 40960); }
        LAS unsigned char* RING = L + 81920;
        int dslot = 0, rslot = 0, dstage = 0;
#define SCAN_DMA() do { const unsigned char* gp = G0 + (long)(dstage < nch ? dstage : nch - 1) * gstep; LAS unsigned char* sl = RING + dslot * 12288; \
            _Pragma("unroll") for (int j = 0; j < 8; ++j) __builtin_amdgcn_global_load_lds((const unsigned*)(gp + (size_t)(j * 64 + lane) * 16), (LAS unsigned*)(sl + j * 1024), 16, 0, 0); \
            _Pragma("unroll") for (int j = 0; j < 4; ++j) __builtin_amdgcn_global_load_lds((const unsigned*)(gp + 8192 + (size_t)((nt * 2 + (j >> 1)) * 64 + lane) * 32 + (j & 1) * 16), (LAS unsigned*)(sl + 8192 + j * 1024), 16, 0, 0); \
            ++dstage; dslot = dslot == 4 ? 0 : dslot + 1; } while (0)
#define SCAN_LOAD(B) do { const LAS unsigned char* sl = RING + rslot * 12288 + lane * 16; \
            _Pragma("unroll") for (int mt = 0; mt < 2; ++mt) { _Pragma("unroll") for (int ks = 0; ks < 4; ++ks) A[B][mt][ks] = *(const LAS bf16x8*)(sl + (mt * 4 + ks) * 1024); \
                cm[B][mt][0] = *(const LAS u32x4*)(sl + 8192 + (mt * 2) * 1024); cm[B][mt][1] = *(const LAS u32x4*)(sl + 8192 + (mt * 2 + 1) * 1024); } \
            rslot = rslot == 4 ? 0 : rslot + 1; } while (0)
#define SCAN_STEP(B, st) do { const bf16x8 b0 = pack8<0>(S[0]), b1 = pack8<1>(S[0]), b2 = pack8<0>(S[1]), b3 = pack8<1>(S[1]); f32x16 nw[2]; \
            { bf16x8* St = (bf16x8*)(Gs + 32768) + (nt * 4) * 64 + lane; St[0] = b0; St[64] = b1; St[128] = b2; St[192] = b3; }     \
            const int sq_ = (st) >> 6; const float gsel = sq_ == 0 ? glv[0] : (sq_ == 1 ? glv[1] : (sq_ == 2 ? glv[2] : glv[3])); \
            const float glc = __builtin_bit_cast(float, __builtin_amdgcn_readlane(__builtin_bit_cast(int, gsel), (st) & 63)); \
            _Pragma("unroll") for (int mt = 0; mt < 2; ++mt) { \
                _Pragma("unroll") for (int g = 0; g < 8; ++g) { const unsigned wv = (g < 4) ? cm[B][mt][0][g] : cm[B][mt][1][g - 4]; nw[mt][2 * g] = glc * S[mt][2 * g] + bflo(wv); nw[mt][2 * g + 1] = glc * S[mt][2 * g + 1] + bfhi(wv); } \
                nw[mt] = MFMA32(A[B][mt][0], b0, nw[mt]); nw[mt] = MFMA32(A[B][mt][1], b1, nw[mt]); nw[mt] = MFMA32(A[B][mt][2], b2, nw[mt]); nw[mt] = MFMA32(A[B][mt][3], b3, nw[mt]); } \
            S[0] = nw[0]; S[1] = nw[1]; Gs += gstep; } while (0)
        SCAN_DMA(); SCAN_DMA(); SCAN_DMA(); SCAN_DMA(); SCAN_DMA();
        asm volatile("s_waitcnt vmcnt(48)" ::: "memory"); SCAN_LOAD(0);
        asm volatile("s_waitcnt vmcnt(36)" ::: "memory"); SCAN_LOAD(1);
        for (int step = 0; step < nch; step += 2) {
            SCAN_STEP(0, step);     asm volatile("s_waitcnt vmcnt(24)" ::: "memory"); SCAN_LOAD(0); SCAN_DMA();
            SCAN_STEP(1, step + 1); asm volatile("s_waitcnt vmcnt(24)" ::: "memory"); SCAN_LOAD(1); SCAN_DMA();
        }
        asm volatile("s_waitcnt vmcnt(0)" ::: "memory");
#undef SCAN_DMA
#undef SCAN_LOAD
#undef SCAN_STEP
    }
    attn_wave_units(args, L, c);
}

DI void dil_merge(const Ctx& c) {
    { const bf16_t* DP = BIGP(bf16_t, B_DILP); const float* DM = BIGP(float, B_DILM); bf16_t* OD = BIGP(bf16_t, B_ONA) + 256;
        for (int it = c.bid * 512 + c.tid; it < c.stok * 32; it += c.G * 512) { const int tok = it >> 5, part = it & 31;
            u32x4 w = {0u, 0u, 0u, 0u};
            if (part < 16) { const int hd = part >> 3, p = part & 7; float m[3], dn[3];
#pragma unroll
                for (int g = 0; g < 3; ++g) { const size_t b = (((size_t)g * SLABMAX + tok) * 2 + hd); m[g] = DM[b * 2]; dn[g] = DM[b * 2 + 1]; }
                const float M = fmaxf(m[0], fmaxf(m[1], m[2])); float num[8], den = 0.f;
#pragma unroll
                for (int j = 0; j < 8; ++j) num[j] = 0.f;
#pragma unroll
                for (int g = 0; g < 3; ++g) { const float f = __expf(m[g] - M); den += f * dn[g]; const u32x4 a = *(const u32x4*)(DP + (((size_t)g * SLABMAX + tok) * 2 + hd) * 64 + 8 * p);
                    num[0] += f * bflo(a[0]); num[1] += f * bfhi(a[0]); num[2] += f * bflo(a[1]); num[3] += f * bfhi(a[1]); num[4] += f * bflo(a[2]); num[5] += f * bfhi(a[2]); num[6] += f * bflo(a[3]); num[7] += f * bfhi(a[3]); }
                const float inv = frcp(den);
                w.x = pk2(num[0] * inv, num[1] * inv); w.y = pk2(num[2] * inv, num[3] * inv); w.z = pk2(num[4] * inv, num[5] * inv); w.w = pk2(num[6] * inv, num[7] * inv); }
            if (part < 16) *(u32x4*)(OD + (size_t)tok * 768 + 8 * part) = w; } }
}

DI void phase_gdn_out(KArgs args, LAS unsigned char* L, const Ctx& c) {
    dil_merge(c);
    const int lane = c.lane, wave = c.wave, tid = c.tid, l = c.layer;
    const bf16_t* PROJ = BIGP(bf16_t, B_PROJ); unsigned char* GS = BIGP(unsigned char, B_GSCR); bf16_t* OG = BIGP(bf16_t, B_ONA) + 384;
    LAS float* OF = (LAS float*)L;
    for (int u = c.bid; u < (c.stok >> 6) * 6; u += c.G) { const int gch = u / 6, head = u % 6;
        { const int dir = wave >> 2, mt = (wave >> 1) & 1, nt = wave & 1, rr = lane & 31, hh = lane >> 5;
            const unsigned char* G = GS + (size_t)((gch * 6 + head) * 2 + dir) * GSTRIDE;
            const bf16_t* Qe = (const bf16_t*)(G + 16384); const bf16_t* Oct = (const bf16_t*)(G + 24576); const bf16_t* St = (const bf16_t*)(G + 32768);
            f32x16 acc = zero16(); bf16x8 qa[4], sb_[4];
#pragma unroll
            for (int ks = 0; ks < 4; ++ks) { qa[ks] = *(const bf16x8*)(Qe + (size_t)((mt * 4 + ks) * 64 + lane) * 8);
                sb_[ks] = *((const bf16x8*)St + (nt * 4 + ks) * 64 + lane); }
            const u32x4 oc0 = *((const u32x4*)Oct + ((nt * 2 + mt) * 2) * 64 + lane), oc1 = *((const u32x4*)Oct + ((nt * 2 + mt) * 2 + 1) * 64 + lane);
            __builtin_amdgcn_sched_barrier(0);
#pragma unroll
            for (int ks = 0; ks < 4; ++ks) acc = MFMA32(qa[ks], sb_[ks], acc);
            const int e = 32 * nt + rr;
#pragma unroll
            for (int g = 0; g < 4; ++g) { u32x2 w; w.x = (g == 0) ? oc0.x : (g == 1) ? oc0.z : (g == 2) ? oc1.x : oc1.z; w.y = (g == 0) ? oc0.y : (g == 1) ? oc0.w : (g == 2) ? oc1.y : oc1.w;
                const float v0 = acc[4 * g] + bflo(w.x), v1 = acc[4 * g + 1] + bfhi(w.x), v2 = acc[4 * g + 2] + bflo(w.y), v3 = acc[4 * g + 3] + bfhi(w.y);
                const int i0 = 32 * mt + 8 * g + 4 * hh;
#pragma unroll
                for (int j = 0; j < 4; ++j) { const int ii = i0 + j, tl = dir ? 63 - ii : ii; OF[(dir * 64 + tl) * 68 + e] = (j == 0) ? v0 : (j == 1) ? v1 : (j == 2) ? v2 : v3; } } }
        lds_barrier();
        { const int i = tid >> 3, p = tid & 7; const size_t tok = (size_t)gch * 64 + i;
            const LAS float* a = OF + i * 68 + 8 * p; const LAS float* b = OF + (64 + i) * 68 + 8 * p;
            float ov[8]; float ss = 0.f;
#pragma unroll
            for (int j = 0; j < 8; ++j) { ov[j] = a[j] + b[j]; ss += ov[j] * ov[j]; }
            ss += __shfl_xor(ss, 1); ss += __shfl_xor(ss, 2); ss += __shfl_xor(ss, 4);
            const float rs = frsq(ss * (1.0f / 64.0f) + NORM_EPS);
            const u32x4 zw = *(const u32x4*)(PROJ + tok * NPROJ + C_ZC + 64 * head + 8 * p);
            const float* nw = args->in[7] + l * 64 + 8 * p;
            float r[8];
#pragma unroll
            for (int j = 0; j < 4; ++j) { r[2 * j] = ov[2 * j] * rs * nw[2 * j] * siluf_(bflo(zw[j])); r[2 * j + 1] = ov[2 * j + 1] * rs * nw[2 * j + 1] * siluf_(bfhi(zw[j])); }
            u32x4 w; w.x = pk2(r[0], r[1]); w.y = pk2(r[2], r[3]); w.z = pk2(r[4], r[5]); w.w = pk2(r[6], r[7]);
            *(u32x4*)(OG + tok * 768 + 64 * head + 8 * p) = w; }
        lds_barrier();
    }
}

DI void phase_ln1(KArgs args, LAS unsigned char* L, const Ctx& c) {
    const int lane = c.lane, l = c.layer;
    LAS float* WR = (LAS float*)L;
    { const float* wr = args->in[14] + (size_t)l * D * 16;
        for (int i = c.tid; i < D * 16; i += 512) { const int col = i >> 4, e = i & 15, j = col >> 8, ln = (col >> 2) & 63, q = col & 3; WR[((j * 4 + q) * 64 + ln) * 20 + e] = wr[i]; } }
    __syncthreads();
    const float* g1 = args->in[12] + l * D; const float* b1 = args->in[13] + l * D;
    f32x4 gv[4], bv[4];
#pragma unroll
    for (int j = 0; j < 4; ++j) { gv[j] = *(const f32x4*)(g1 + 4 * lane + 256 * j); bv[j] = *(const f32x4*)(b1 + 4 * lane + 256 * j); }
    float* AFF = WSP(float, WS_AFF); int* SLOT = WSP(int, WS_SLOT); bf16_t* XB = WSP(bf16_t, WS_XB);
    u32x2 nv[4];
    { const int rl0 = c.bid * 8 + c.wave; if (rl0 < c.stok) { const bf16_t* hp = (const bf16_t*)c.out + ((size_t)c.sbase + rl0) * D;
#pragma unroll
        for (int j = 0; j < 4; ++j) nv[j] = *(const u32x2*)(hp + 4 * lane + 256 * j); } }
    for (int rl = c.bid * 8 + c.wave; rl < c.stok; rl += c.G * 8) { const size_t tok = (size_t)c.sbase + rl;
        const bf16_t* hr = (const bf16_t*)c.out + tok * D; f32x4 v[4]; float s = 0.f;
#pragma unroll
        for (int j = 0; j < 4; ++j) { v[j][0] = bflo(nv[j].x); v[j][1] = bfhi(nv[j].x); v[j][2] = bflo(nv[j].y); v[j][3] = bfhi(nv[j].y); s += (v[j][0] + v[j][1]) + (v[j][2] + v[j][3]); }
        if (rl + c.G * 8 < c.stok) { const bf16_t* hp = hr + (size_t)c.G * 8 * D;
#pragma unroll
            for (int j = 0; j < 4; ++j) nv[j] = *(const u32x2*)(hp + 4 * lane + 256 * j); }
        const float mean = wave_sum(s) * (1.0f / D); float s2 = 0.f;
#pragma unroll
        for (int j = 0; j < 4; ++j) { v[j] = v[j] - mean; s2 += (v[j][0] * v[j][0] + v[j][1] * v[j][1]) + (v[j][2] * v[j][2] + v[j][3] * v[j][3]); }
        const float rstd = frsq(wave_sum(s2) * (1.0f / D) + LN_EPS);
        float lg[16];
#pragma unroll
        for (int e = 0; e < 16; ++e) lg[e] = 0.f;
#pragma unroll
        for (int j = 0; j < 4; ++j) { v[j] = v[j] * rstd * gv[j] + bv[j];
            if (!c.dry) { u32x2 w; w.x = pk2(v[j][0], v[j][1]); w.y = pk2(v[j][2], v[j][3]); *(u32x2*)(XB + tok * D + 4 * lane + 256 * j) = w; }
#pragma unroll
            for (int q = 0; q < 4; ++q) { const LAS float* wp = WR + ((j * 4 + q) * 64 + lane) * 20; const float xv = v[j][q];
#pragma unroll
                for (int e4 = 0; e4 < 4; ++e4) { const f32x4 w4 = *(const LAS f32x4*)(wp + 4 * e4); lg[4 * e4] += xv * w4[0]; lg[4 * e4 + 1] += xv * w4[1]; lg[4 * e4 + 2] += xv * w4[2]; lg[4 * e4 + 3] += xv * w4[3]; } }
            asm volatile("" ::: "memory"); }
        float mx = -1e30f;
#pragma unroll
        for (int e = 0; e < 16; ++e) { lg[e] = wave_sum(lg[e]); mx = fmaxf(mx, lg[e]); }
        float den = 0.f;
#pragma unroll
        for (int e = 0; e < 16; ++e) { lg[e] = expf(lg[e] - mx); den += lg[e]; }
        float mine = 0.f;
#pragma unroll
        for (int e = 0; e < 16; ++e) mine = (lane == e) ? lg[e] : mine;
        if (lane < 16 && !c.dry) { AFF[(size_t)lane * T_ALL + tok] = mine / den; SLOT[tok * 16 + lane] = -1; }
    }
}
DI void phase_ln2(KArgs args, LAS unsigned char* L, const Ctx& c) {
    const int lane = c.lane, l = c.layer;
    const float* g2 = args->in[18] + l * D; const float* b2 = args->in[19] + l * D;
    f32x4 gv[4], bv[4];
#pragma unroll
    for (int j = 0; j < 4; ++j) { gv[j] = *(const f32x4*)(g2 + 4 * lane + 256 * j); bv[j] = *(const f32x4*)(b2 + 4 * lane + 256 * j); }
    const int* SLOT = WSP(int, WS_SLOT); bf16_t* XB = WSP(bf16_t, WS_XB);
    u32x2 nv[4]; int nsv = -1;
    { const int t0 = c.bid * 8 + c.wave; if (t0 < T_ALL) { const bf16_t* xp = XB + (size_t)t0 * D; nsv = SLOT[(size_t)t0 * 16 + (lane & 15)];
#pragma unroll
        for (int j = 0; j < 4; ++j) nv[j] = *(const u32x2*)(xp + 4 * lane + 256 * j); } }
    for (int t = c.bid * 8 + c.wave; t < T_ALL; t += c.G * 8) { const size_t tok = (size_t)t;
        float* xr = c.out + tok * D; f32x4 v[4];
#pragma unroll
        for (int j = 0; j < 4; ++j) { v[j][0] = bflo(nv[j].x) * ALPHA; v[j][1] = bfhi(nv[j].x) * ALPHA; v[j][2] = bflo(nv[j].y) * ALPHA; v[j][3] = bfhi(nv[j].y) * ALPHA; }
        const int sv = nsv;
        if (t + c.G * 8 < T_ALL) { const bf16_t* xp = XB + (tok + c.G * 8) * D; nsv = SLOT[(tok + c.G * 8) * 16 + (lane & 15)];
#pragma unroll
            for (int j = 0; j < 4; ++j) nv[j] = *(const u32x2*)(xp + 4 * lane + 256 * j); }
        {
            unsigned mk = (unsigned)(__ballot(sv >= 0) & 0xffffull);
            while (mk) { const int e0 = __builtin_ctz(mk); mk &= mk - 1u; const bool two = mk != 0u; const int e1 = two ? __builtin_ctz(mk) : e0; if (two) mk &= mk - 1u;
                const int s0 = __builtin_amdgcn_readlane(sv, e0), s1 = __builtin_amdgcn_readlane(sv, e1);
                const bf16_t* y0 = BIGP(bf16_t, (e0 < 8 ? B_XY0 : B_XY1)) + ((size_t)(e0 & 7) * CAP + s0) * D + 4 * lane;
                const bf16_t* y1 = BIGP(bf16_t, (e1 < 8 ? B_XY0 : B_XY1)) + ((size_t)(e1 & 7) * CAP + s1) * D + 4 * lane;
                u32x2 w0[4], w1[4];
#pragma unroll
                for (int j = 0; j < 4; ++j) { w0[j] = *(const u32x2*)(y0 + 256 * j); w1[j] = *(const u32x2*)(y1 + 256 * j); }
                __builtin_amdgcn_sched_barrier(0);
                const float f1 = two ? 1.0f : 0.0f;
#pragma unroll
                for (int j = 0; j < 4; ++j) { v[j][0] += bflo(w0[j].x); v[j][1] += bfhi(w0[j].x); v[j][2] += bflo(w0[j].y); v[j][3] += bfhi(w0[j].y);
                    v[j][0] += f1 * bflo(w1[j].x); v[j][1] += f1 * bfhi(w1[j].x); v[j][2] += f1 * bflo(w1[j].y); v[j][3] += f1 * bfhi(w1[j].y); } } }
        float s = 0.f;
#pragma unroll
        for (int j = 0; j < 4; ++j) s += (v[j][0] + v[j][1]) + (v[j][2] + v[j][3]);
        const float mean = wave_sum(s) * (1.0f / D); float s2 = 0.f;
#pragma unroll
        for (int j = 0; j < 4; ++j) { v[j] = v[j] - mean; s2 += (v[j][0] * v[j][0] + v[j][1] * v[j][1]) + (v[j][2] * v[j][2] + v[j][3] * v[j][3]); }
        const float rstd = frsq(wave_sum(s2) * (1.0f / D) + LN_EPS);
#pragma unroll
        for (int j = 0; j < 4; ++j) { v[j] = v[j] * rstd * gv[j] + bv[j];
            if (!c.dry) {
                if (l == 1) *(f32x4*)(xr + 4 * lane + 256 * j) = v[j];
                else { u32x2 w; w.x = pk2(v[j][0], v[j][1]); w.y = pk2(v[j][2], v[j][3]); *(u32x2*)(XB + tok * D + 4 * lane + 256 * j) = w;
                    *(unsigned*)(WSP(unsigned char, WS_XB8) + tok * D + 4 * lane + 256 * j) = pk4_fp8(v[j][0], v[j][1], v[j][2], v[j][3]); } } }
    }
}

DI int block_excl_scan(int v, LAS int* tmp, int tid, int& total) {
    const int lane = tid & 63, wave = tid >> 6; int x = v;
#pragma unroll
    for (int o = 1; o < 64; o <<= 1) { const int y = __shfl_up(x, o); if (lane >= o) x += y; }
    __syncthreads();
    if (lane == 63) tmp[wave] = x;
    __syncthreads();
    int base = 0, tot = 0;
#pragma unroll
    for (int w = 0; w < 8; ++w) { const int tw = tmp[w]; if (w < wave) base += tw; tot += tw; }
    total = tot;
    return base + x - v;
}
DI void phase_select(KArgs args, LAS unsigned char* L, const Ctx& c, int inst) {
    if (inst < 0 || inst >= 32) return;
    const int tid = c.tid, grp = inst >> 4, e = inst & 15;
    const int n = grp ? T_S : T_P, t0 = grp ? T_P : 0, C = n >> 3, slot0 = grp ? CAP_P : 0;
    const unsigned* v = (const unsigned*)(WSP(float, WS_AFF) + (size_t)e * T_ALL + t0);
    LAS unsigned* hist = (LAS unsigned*)L; LAS int* sh = (LAS int*)(L + 8192); LAS int* tmp = (LAS int*)(L + 8192 + 64);
    unsigned prefix = 0u; int kk = C, nbin = 0;
    for (int pass = 0; pass < 3; ++pass) {
        const int shift = pass == 0 ? 21 : (pass == 1 ? 10 : 0); const unsigned bmask = pass == 2 ? 1023u : 2047u;
        const unsigned mhi = pass == 0 ? 0u : (pass == 1 ? 0xFFE00000u : 0xFFFFFC00u);
        { unsigned zz; asm volatile("v_mov_b32 %0, 0" : "=v"(zz)); u32x4 z4; z4.x = zz; z4.y = zz; z4.z = zz; z4.w = zz; *(LAS u32x4*)(hist + 4 * tid) = z4; }
        __syncthreads();
        for (int i = tid * 4; i < n; i += 512 * 16) {
            u32x4 x4[4];
#pragma unroll
            for (int k = 0; k < 4; ++k) x4[k] = *(const u32x4*)(v + i + k * 2048);
#pragma unroll
            for (int k = 0; k < 4; ++k)
#pragma unroll
                for (int j = 0; j < 4; ++j) { const unsigned x = x4[k][j]; if ((x & mhi) == prefix) __hip_atomic_fetch_add(&hist[(x >> shift) & bmask], 1u, __ATOMIC_RELAXED, __HIP_MEMORY_SCOPE_WORKGROUP); } }
        __syncthreads();
        {
            const u32x4 hv = *(const LAS u32x4*)(hist + 2044 - 4 * tid); int tot;
            int cum = block_excl_scan((int)(hv[0] + hv[1] + hv[2] + hv[3]), tmp, tid, tot);
            const int c1 = cum + (int)hv.w, c2 = c1 + (int)hv.z, c3 = c2 + (int)hv.y, c4 = c3 + (int)hv.x;
            if (cum < kk && kk <= c4) { const int j = kk <= c1 ? 0 : (kk <= c2 ? 1 : (kk <= c3 ? 2 : 3)); const int cb = kk <= c1 ? cum : (kk <= c2 ? c1 : (kk <= c3 ? c2 : c3));
                sh[0] = 2047 - 4 * tid - j; sh[1] = kk - cb; sh[2] = (j == 0 ? c1 : (j == 1 ? c2 : (j == 2 ? c3 : c4))) - cb; } }
        __syncthreads();
        prefix |= ((unsigned)sh[0]) << shift; kk = sh[1]; nbin = sh[2];
        __syncthreads();
    }
    const unsigned thr = prefix;
    int* IDX = WSP(int, WS_IDX) + e * CAP + slot0;
    LAS int* ctr = sh + 8;
    if (tid == 0) ctr[0] = 0;
    __syncthreads();
    const bool ordered = kk < nbin; int tie_run = 0;
    const int lane = tid & 63; const unsigned long long ltm = (1ull << lane) - 1ull;
    for (int it = 0; it < (n >> 11); it += 4) {
        u32x4 x4[4];
#pragma unroll
        for (int k = 0; k < 4; ++k) x4[k] = *(const u32x4*)(v + (it + k) * 2048 + 4 * tid);
#pragma unroll
        for (int k = 0; k < 4; ++k) { const u32x4 x = x4[k];
            int tie_base = 0;
            if (ordered) { const int tiec = (x[0] == thr) + (x[1] == thr) + (x[2] == thr) + (x[3] == thr); int tot; tie_base = tie_run + block_excl_scan(tiec, tmp, tid, tot); tie_run += tot; }
            bool sj[4]; int off[4], tot4 = 0;
#pragma unroll
            for (int j = 0; j < 4; ++j) { bool s_ = x[j] > thr; if (x[j] == thr) { s_ = !ordered || tie_base < kk; ++tie_base; } sj[j] = s_;
                const unsigned long long m = __ballot(s_); off[j] = tot4 + __popcll(m & ltm); tot4 += __popcll(m); }
            int base = 0; if (lane == 0 && tot4 > 0) base = __hip_atomic_fetch_add(ctr, tot4, __ATOMIC_RELAXED, __HIP_MEMORY_SCOPE_WORKGROUP);
            base = __builtin_amdgcn_readfirstlane(base);
#pragma unroll
            for (int j = 0; j < 4; ++j) if (sj[j]) IDX[base + off[j]] = t0 + (it + k) * 2048 + 4 * tid + j; } }
}
DI void phase_gather(KArgs args, LAS unsigned char* L, const Ctx& c) {
    const int lane = c.lane; const int* IDX = WSP(int, WS_IDX); const bf16_t* XB = WSP(bf16_t, WS_XB);
    float* GATEV = WSP(float, WS_GATEV); int* SLOT = WSP(int, WS_SLOT); const float* AFF = WSP(float, WS_AFF);
    for (int row0 = (c.bid * 8 + c.wave) * 4; row0 < NE * CAP; row0 += c.G * 8 * 4) {
        const int e = row0 / CAP, s0 = row0 % CAP; int t[4]; u32x4 a[4], b[4];
#pragma unroll
        for (int k = 0; k < 4; ++k) t[k] = IDX[row0 + k];
#pragma unroll
        for (int k = 0; k < 4; ++k) { const u32x4* src = (const u32x4*)(XB + (size_t)t[k] * D) + 2 * lane; a[k] = src[0]; b[k] = src[1]; }
        u32x4* dst = (u32x4*)(BIGP(unsigned char, (e < 8 ? B_XY0 : B_XY1)) + ((size_t)(e & 7) * CAP + s0) * D);
#pragma unroll
        for (int k = 0; k < 4; ++k) { u32x4 w;
            w.x = pk4_fp8(bflo(a[k].x), bfhi(a[k].x), bflo(a[k].y), bfhi(a[k].y)); w.y = pk4_fp8(bflo(a[k].z), bfhi(a[k].z), bflo(a[k].w), bfhi(a[k].w));
            w.z = pk4_fp8(bflo(b[k].x), bfhi(b[k].x), bflo(b[k].y), bfhi(b[k].y)); w.w = pk4_fp8(bflo(b[k].z), bfhi(b[k].z), bflo(b[k].w), bfhi(b[k].w));
            dst[k * 64 + lane] = w; }
        if (lane < 4) { const int tt = (lane == 0) ? t[0] : (lane == 1) ? t[1] : (lane == 2) ? t[2] : t[3]; SLOT[(size_t)tt * 16 + e] = s0 + lane; GATEV[row0 + lane] = AFF[(size_t)e * T_ALL + tt]; } }
}

__global__ void __launch_bounds__(512, 2) fwd_kernel(Args args) {
    extern __shared__ __attribute__((aligned(16))) unsigned char lds_raw[];
    LAS unsigned char* L = (LAS unsigned char*)lds_raw;
    Ctx c;
    c.out = args.out; c.ws = args.ws;
    c.tid = threadIdx.x; c.lane = c.tid & 63; c.wave = __builtin_amdgcn_readfirstlane(c.tid >> 6); c.G = gridDim.x; c.bid = blockIdx.x;
    c.layer = 0; c.slab = 0; c.nseq = 8; c.seqlen = 4096; c.stok = 32768; c.sbase = 0; c.dry = 0;
    const int lo = args.ph_lo, hi = args.ph_hi;
    volatile LAS unsigned* MISC = (volatile LAS unsigned*)(L + LDS_MISC);
    if (c.tid < 4) MISC[c.tid] = 0u;
    __syncthreads();
    XcdBarrier bar; bar.bar = (unsigned*)(c.ws + WS_CTL) + 1024; bar.x = 0; bar.st = MISC;
    if (hi - lo > 1) bar = xcd_barrier_post((unsigned*)(c.ws + WS_CTL) + 1024, MISC);
    int pc = 0;
#ifndef PHMASK
#define PHMASK 0xFFFF
#endif
#define PHON(k) (((PHMASK) >> (k)) & 1)
#ifndef REPMASK
#define REPMASK 0x0
#endif
#define PH_BEGIN(k) if (PHON(k) && pc >= lo && pc < hi) { { int tz = threadIdx.x; asm volatile("" : "+v"(tz)); c.tid = tz; c.lane = tz & 63; c.wave = __builtin_amdgcn_readfirstlane(tz >> 6); } KArgs ka = kargs(); c.ws = ka->ws; c.out = ka->out; { int b_ = blockIdx.x, g_ = gridDim.x; asm volatile("" : "+s"(b_), "+s"(g_)); c.bid = b_; c.G = g_; } for (int rep_ = 0; rep_ < (((REPMASK) >> (k)) & 1) + 1; ++rep_) { if (rep_) __syncthreads(); c.dry = (rep_ + 1 < (((REPMASK) >> (k)) & 1) + 1);
#ifndef BARREP
#define BARREP 0
#endif
#define PH_END   } if (pc + 1 < hi) { xcd_barrier(bar); if (BARREP) { xcd_barrier(bar); xcd_barrier(bar); } } else { asm volatile("s_waitcnt vmcnt(0)" ::: "memory"); __syncthreads(); } } ++pc;

    for (int layer = 0; layer < 2; ++layer) {
        c.layer = layer;
        PH_BEGIN(0) phase_weights(ka, L, c); PH_END
        for (int slab = 0; slab < NSLAB; ++slab) {
            c.slab = slab; c.nseq = slab < 2 ? 8 : 1; c.seqlen = slab < 2 ? 4096 : 16384; c.stok = slab < 2 ? 32768 : 16384; c.sbase = slab * 32768; const int stok = c.stok; const size_t sbase = (size_t)c.sbase;
            PH_BEGIN(1) {
                const int swp = (c.bid >> 2) & 1;
                for (int k2 = 0; k2 < 2; ++k2) {
                  if ((k2 ^ swp) == 0) { pg8::Gemm g{WSP(bf16_t, WS_XB) + sbase * D, WSP(bf16_t, WS_WIN), stok, 3584, D}; pg8::StaticOrder S; S.init(stok, 3584, c.G, c.bid);
                    pg8::EpiInProj E{BIGP(bf16_t, B_PROJ), BIGP(float, B_BA)};
                    pg8::gemm_phase<pg8::EpiInProj, pg8::StaticOrder>(L, g, S, E); }
                  else { pg8::Gemm g{(const bf16_t*)(WSP(unsigned char, WS_XB8) + sbase * D), (const bf16_t*)WSP(unsigned char, WS_WG8), stok, 3072, D / 2}; pg8::StaticOrder S; S.init(stok, 3072, c.G, c.bid);
                    pg8::EpiGates E{BIGP(unsigned char, B_GATES)};
                    pg8::gemm_phase<pg8::EpiGates, pg8::StaticOrder>(L, g, S, E); } } } PH_END
            PH_BEGIN(2) phase_mix_a(ka, L, c); PH_END
            PH_BEGIN(3) phase_scan(ka, L, c); PH_END
            PH_BEGIN(4) phase_gdn_out(ka, L, c); PH_END
            PH_BEGIN(5) {
                pg8::StaticOrder S; S.init(stok, D, c.G, c.bid);
                pg8::Gemm g{BIGP(bf16_t, B_ONA), WSP(bf16_t, WS_WBR), stok, D, 768}; pg8::EpiGateCat E{BIGP(u32x2, B_GATES), BIGP(bf16_t, B_MERGED)};
                pg8::gemm_phase<pg8::EpiGateCat, pg8::StaticOrder>(L, g, S, E); } PH_END
            PH_BEGIN(6) {
                pg8::Gemm g{BIGP(bf16_t, B_MERGED), WSP(bf16_t, WS_WOUT), stok, D, D}; pg8::StaticOrder S; S.init(stok, D, c.G, c.bid);
                pg8::EpiRes E{WSP(bf16_t, WS_XB) + sbase * D, (bf16_t*)c.out + sbase * D};
                pg8::gemm_phase<pg8::EpiRes, pg8::StaticOrder>(L, g, S, E); } PH_END
#ifndef LN1PROBE
#define LN1PROBE 0
#endif
            PH_BEGIN(7) if (LN1PROBE) { c.dry = 1; phase_ln1(ka, L, c); __syncthreads(); c.dry = 0; } phase_ln1(ka, L, c); PH_END
        }
        PH_BEGIN(8) phase_select(ka, L, c, c.bid < 16 ? 16 + c.bid : -1); PH_END
        PH_BEGIN(9) phase_gather(ka, L, c); PH_END
        for (int half = 0; half < 2; ++half) {
            PH_BEGIN(10) {
                pg8::Gemm g{BIGP(bf16_t, half ? B_XY1 : B_XY0), (const bf16_t*)(WSP(unsigned char, WS_WGU) + (size_t)half * 8 * 4096 * D), 8 * CAP, 8 * 4096, D / 2}; pg8::MoeOrder S; S.init(8, CAP / 256, 16, c.G, c.bid);
                pg8::EpiSwiglu E{BIGP(unsigned char, B_HID)};
                pg8::gemm_phase<pg8::EpiSwiglu, pg8::MoeOrder>(L, g, S, E); } PH_END
            PH_BEGIN(11) {
                pg8::Gemm g{BIGP(bf16_t, B_HID), (const bf16_t*)(WSP(unsigned char, WS_WD) + (size_t)half * 8 * D * DE), 8 * CAP, 8 * D, DE / 2}; pg8::MoeOrder S; S.init(8, CAP / 256, 4, c.G, c.bid);
                pg8::EpiDown E{BIGP(bf16_t, half ? B_XY1 : B_XY0), WSP(float, WS_GATEV) + (size_t)half * 8 * CAP};
                pg8::gemm_phase<pg8::EpiDown, pg8::MoeOrder>(L, g, S, E); } PH_END
        }
        PH_BEGIN(12) phase_ln2(ka, L, c); PH_END
    }
#undef PH_BEGIN
#undef PH_END
}

constexpr int N_PHASES = 2 * (1 + NSLAB * 7 + 2 + 4 + 1);

extern "C" void kernel_launch(void* const* d_in, const int* in_sizes, int n_in, void* d_out, int out_size, void* d_ws, size_t ws_size, hipStream_t stream) {
    static int grid = 0;
    if (grid == 0) {
        if (n_in != 20 || ws_size < WS_END) { fprintf(stderr, "kernel_launch: unexpected n_in %d or ws_size %zu (< %zu)\n", n_in, ws_size, (size_t)WS_END); grid = -1; return; }
        int dev = 0, cus = 0, per_cu = 0;
        if (hipGetDevice(&dev) != hipSuccess || hipDeviceGetAttribute(&cus, hipDeviceAttributeMultiprocessorCount, dev) != hipSuccess) { grid = -1; return; }
        if (hipFuncSetAttribute((const void*)fwd_kernel, hipFuncAttributeMaxDynamicSharedMemorySize, LDS_BYTES) != hipSuccess) { fprintf(stderr, "kernel_launch: hipFuncSetAttribute failed\n"); grid = -1; return; }
        if (hipOccupancyMaxActiveBlocksPerMultiprocessor(&per_cu, (const void*)fwd_kernel, 512, LDS_BYTES) != hipSuccess || per_cu < 1) fprintf(stderr, "kernel_launch: occupancy query says %d\n", per_cu);
        (void)hipGetLastError();
        grid = cus;
    }
    if (grid < 0) return;
    (void)hipMemsetAsync((char*)d_ws + WS_CTL, 0, 1 * MiB, stream);
    Args a{};
    for (int i = 0; i < 20; ++i) a.in[i] = (const float*)d_in[i];
    a.out = (float*)d_out; a.ws = (unsigned char*)d_ws;
#if MK_N_LAUNCHES == 1
    a.ph_lo = 0; a.ph_hi = N_PHASES;
    hipLaunchKernelGGL(fwd_kernel, dim3(grid), dim3(512), LDS_BYTES, stream, a);
#else
    for (int p = 0; p < N_PHASES; ++p) { a.ph_lo = p; a.ph_hi = p + 1; hipLaunchKernelGGL(fwd_kernel, dim3(grid), dim3(512), LDS_BYTES, stream, a); }
#endif
}
```

```cpp
#include <hip/hip_runtime.h>
#include <stdint.h>
#include <stdio.h>

#define LAS __attribute__((address_space(3)))
#define DI __device__ __forceinline__
typedef unsigned short bf16_t;
typedef short bf16x8 __attribute__((ext_vector_type(8)));
typedef float f32x4 __attribute__((ext_vector_type(4)));
typedef float f32x2 __attribute__((ext_vector_type(2)));
typedef float f32x16 __attribute__((ext_vector_type(16)));
typedef unsigned u32x4 __attribute__((ext_vector_type(4)));
typedef unsigned u32x2 __attribute__((ext_vector_type(2)));
typedef __bf16 bf16x2v __attribute__((ext_vector_type(2)));

#ifndef MK_N_LAUNCHES
#define MK_N_LAUNCHES 1
#endif

constexpr int D = 1024, T_ALL = 81920, T_P = 65536, T_S = 16384, SLABMAX = 32768, NSLAB = 3;
constexpr int DIN = 6552, NPROJ = 3584;
constexpr int C_QA = 0, C_KA = 256, C_VA = 512, C_QD = 768, C_KD = 1152, C_VD = 1536, C_QC = 1920, C_KC = 2304, C_VC = 2688, C_ZC = 3072;
constexpr int NE = 16, DE = 2048, CAP_P = 8192, CAP_S = 2048, CAP = CAP_P + CAP_S;
constexpr float ALPHA = 1.41421356237f, LN_EPS = 1e-5f, NORM_EPS = 1e-6f;
constexpr size_t MiB = 1u << 20;
constexpr size_t WS_CTL = 0, WS_WIN = 1 * MiB, WS_WBR = 14 * MiB, WS_WOUT = 16 * MiB, WS_WGU = 18 * MiB, WS_WD = 82 * MiB, WS_XB8 = 114 * MiB, WS_WG8 = 194 * MiB, WS_XB = 210 * MiB;
constexpr size_t WS_AFF = 370 * MiB, WS_SLOT = 375 * MiB, WS_IDX = 380 * MiB, WS_GATEV = 381 * MiB, WS_CS = 382 * MiB, WS_BIG = 386 * MiB, WS_END = 1130 * MiB;
constexpr size_t B_PROJ = 0, B_GATES = 224 * MiB, B_BA = 416 * MiB, B_ONA = 420 * MiB, B_ODIL = 436 * MiB, B_OGDN = 452 * MiB, B_DILP = 476 * MiB, B_DILM = 500 * MiB, B_GSCR = 502 * MiB, B_MERGEF = 502 * MiB, B_MERGED = 630 * MiB;
constexpr size_t B_XY0 = 0, B_XY1 = 160 * MiB, B_HID = 320 * MiB;
constexpr int GSTRIDE = 41216;
constexpr int LDS_BYTES = 151552;
constexpr int LDS_MISC = 145408, LDS_CW = LDS_MISC + 256;

DI unsigned pk2(float lo, float hi) { f32x2 v = {lo, hi}; bf16x2v b = __builtin_convertvector(v, bf16x2v); return __builtin_bit_cast(unsigned, b); }
DI unsigned pk4_fp8(float a, float b, float c, float d) {
    int w = __builtin_amdgcn_cvt_pk_fp8_f32(a, b, 0, false); w = __builtin_amdgcn_cvt_pk_fp8_f32(c, d, w, true); return (unsigned)w; }
DI float bflo(unsigned u) { return __uint_as_float(u << 16); }
DI float bfhi(unsigned u) { return __uint_as_float(u & 0xffff0000u); }
DI float frcp(float x) { return __builtin_amdgcn_rcpf(x); }
DI float frsq(float x) { return __builtin_amdgcn_rsqf(x); }
DI float sigmoidf_(float x) { return frcp(1.0f + __expf(-x)); }
DI float siluf_(float x) { return x * frcp(1.0f + __expf(-x)); }
DI void lds_barrier() { asm volatile("s_waitcnt lgkmcnt(0)\n\ts_barrier" ::: "memory"); }
DI float wave_sum(float v) {
#pragma unroll
    for (int o = 1; o < 64; o <<= 1) v += __shfl_xor(v, o);
    return v;
}
#define MFMA32(a, b, c) __builtin_amdgcn_mfma_f32_32x32x16_bf16((a), (b), (c), 0, 0, 0)
DI int crow(int reg, int h) { return (reg & 3) + 8 * (reg >> 2) + 4 * h; }
DI f32x16 zero16() { f32x16 z; for (int i = 0; i < 16; ++i) z[i] = 0.f; return z; }
template <int S> DI bf16x8 pack8(const f32x16& x) {
    u32x4 p; p[0] = pk2(x[8 * S], x[8 * S + 1]); p[1] = pk2(x[8 * S + 2], x[8 * S + 3]); p[2] = pk2(x[8 * S + 4], x[8 * S + 5]); p[3] = pk2(x[8 * S + 6], x[8 * S + 7]);
    return __builtin_bit_cast(bf16x8, p);
}

namespace pg8 {
constexpr int BM = 256, BK = 64, HALF = 128, HTB = HALF * BK * 2, STAGE_BYTES = 8 * HTB, NXCD = 8, WGM = 8;
__host__ __device__ __forceinline__ int lds_byte(int r, int c) { const int st = (r >> 4) * 2 + (c >> 5), rr = r & 15, cc = c & 31, ob = rr * 64 + cc * 2; return st * 1024 + (ob ^ (((ob >> 9) & 1) << 5)); }
__host__ __device__ __forceinline__ void stage_rc(int b, int& R, int& C) { const int st = b / 1024, sb = b % 1024, swz = sb ^ (((sb >> 9) & 1) << 5); R = (st >> 1) * 16 + swz / 64; C = (st & 1) * 32 + (swz % 64) / 2; }
__host__ __device__ __forceinline__ int perm32(int rho) { const int n = rho >> 4, i = rho & 15; return 8 * (i >> 2) + 4 * n + (i & 3); }
struct Unit { int pm, pn; };
struct Gemm { const bf16_t* A; const bf16_t* Bt; int M, N, K; };
struct StaticOrder {
    int nM, nN, nwg, G, c;
    __device__ void init(int M, int N, int G_, int c_) { nM = M / BM; nN = N / BM; nwg = nM * nN; G = G_; c = c_; }
    __device__ bool next(int i, Unit& u) const {
        const long L = (long)i * G + c; if (L >= nwg) return false;
        int wgid = (int)L; { const int q = nwg / NXCD, r = nwg % NXCD, xcd = wgid % NXCD, off = wgid / NXCD; wgid = (xcd < r ? xcd * (q + 1) : r * (q + 1) + (xcd - r) * q) + off; }
        const int nig = WGM * nN, gid = wgid / nig, fm = gid * WGM, gsz = (nM - fm) < WGM ? (nM - fm) : WGM;
        u.pm = fm + ((wgid % nig) % gsz); u.pn = (wgid % nig) / gsz; return true;
    }
    __device__ __forceinline__ void a_ready(const Unit&) const {}
    __device__ __forceinline__ void done(const Unit&) const {}
};
struct MoeOrder {
    int nMe, nNe, per, total, G, c, xr, xc, rpx, cpx, share;
    __device__ void init(int nE, int nMe_, int nNe_, int G_, int c_) { nMe = nMe_; nNe = nNe_; per = nMe * nNe; total = nE * per; G = G_; c = c_;
        xc = (nNe % 2 == 0 && nNe >= 8) ? 2 : 1; xr = 8 / xc; rpx = nMe / xr; cpx = nNe / xc; share = rpx * cpx; }
    __device__ bool next(int i, Unit& u) const {
        if ((G & 7) == 0 && nMe % xr == 0) {
            const int x = c & 7, q = c >> 3, nq = G >> 3; const long j = (long)i * nq + q; if (j >= (long)(total / 8)) return false;
            const int e = (int)(j / share), r = (int)(j % share); const int pm = (x / xc) * rpx + r % rpx, pn = (x % xc) * cpx + r / rpx;
            u.pm = e * nMe + pm; u.pn = e * nNe + pn; return true;
        }
        const long L = (long)i * G + c; if (L >= total) return false;
        const int e = (int)(L / per), r = (int)(L % per);
        u.pm = e * nMe + r % nMe; u.pn = e * nNe + r / nMe; return true;
    }
    __device__ __forceinline__ void a_ready(const Unit&) const {}
    __device__ __forceinline__ void done(const Unit&) const {}
};

template <class Epi, class Sched>
__device__ __forceinline__ void gemm_phase(LAS unsigned char* lds, const Gemm g, const Sched& S, const Epi& E) {
    int tid = threadIdx.x; asm volatile("" : "+v"(tid));
    const int wid = __builtin_amdgcn_readfirstlane(tid >> 6), lane = tid & 63, wr = wid >> 2, wc = wid & 3, fr = lane & 15, fq = lane >> 4;
    int Kv = g.K; asm volatile("" : "+s"(Kv));
    const int K = Kv, nt = K / BK;
    unsigned voffA[2], voffB[2];
#pragma unroll
    for (int i = 0; i < 2; ++i) { int R, C; stage_rc(tid * 16 + i * 8192, R, C); const int Rb = Epi::PERM ? ((R & ~31) + perm32(R & 31)) : R;
        voffA[i] = (unsigned)(R * K + C) * 2u; voffB[i] = (unsigned)(Rb * K + C) * 2u; }
    const size_t kstep = (size_t)(BK * 2);
    const size_t hstep = (size_t)HALF * K * 2;
    const size_t tstep = 2 * hstep;
    const unsigned ldsw = (unsigned)wid * 1024u;
    const int aoff = lds_byte(wr * 64 + fr, fq * 8), boff = lds_byte(wc * 32 + fr, fq * 8);
#define PG8_SA(b, h) (((b) * 2 + (h)) * HTB)
#define PG8_SB(b, h) ((4 + (b) * 2 + (h)) * HTB)
#define PG8_STAGE(bufoff, gbase, voff) do { _Pragma("unroll") for (int _i = 0; _i < 2; ++_i) \
        __builtin_amdgcn_global_load_lds((const unsigned*)((const char*)(gbase) + (voff)[_i]), (LAS unsigned*)(lds + (bufoff) + ldsw + _i * 8192), 16, 0, 0); } while (0)
#define PG8_LD8(p) __builtin_shufflevector(*(const LAS v4i_*)(p), *(const LAS v4i_*)((p) + 1024), 0, 1, 2, 3, 4, 5, 6, 7)
#define PG8_LDA(dst, b, h) do { _Pragma("unroll") for (int m = 0; m < 4; ++m) { if constexpr (Epi::FP8) dst##8[m] = PG8_LD8(lds + PG8_SA(b, h) + aoff + m * 2048); \
        else { _Pragma("unroll") for (int k = 0; k < 2; ++k) dst[m][k] = *(const LAS bf16x8*)(lds + PG8_SA(b, h) + aoff + m * 2048 + k * 1024); } } } while (0)
#define PG8_LDB(dst, b, h) do { _Pragma("unroll") for (int n = 0; n < 2; ++n) { if constexpr (Epi::FP8) dst##8[n] = PG8_LD8(lds + PG8_SB(b, h) + boff + n * 2048); \
        else { _Pragma("unroll") for (int k = 0; k < 2; ++k) dst[n][k] = *(const LAS bf16x8*)(lds + PG8_SB(b, h) + boff + n * 2048 + k * 1024); } } } while (0)
#define PG8_MMA(ai, bj, At, Bt) do { __builtin_amdgcn_s_setprio(1); _Pragma("unroll") for (int m = 0; m < 4; ++m) _Pragma("unroll") for (int n = 0; n < 2; ++n) { \
        if constexpr (Epi::FP8) asm volatile("v_mfma_scale_f32_16x16x128_f8f6f4 %0, %1, %2, %0, %3, %3 op_sel_hi:[0,0,0]" : "+v"(acc[ai][bj][m][n]) : "v"(Bt##8[n]), "v"(At##8[m]), "v"(fp8_unit_scale));   \
        else { _Pragma("unroll") for (int k = 0; k < 2; ++k) acc[ai][bj][m][n] = __builtin_amdgcn_mfma_f32_16x16x32_bf16(Bt[n][k], At[m][k], acc[ai][bj][m][n], 0, 0, 0); } } \
        __builtin_amdgcn_s_setprio(0); } while (0)
#define PG8_WAIT_V(n) asm volatile("s_waitcnt vmcnt(" #n ")" ::: "memory")
#define PG8_WAIT_L(n) asm volatile("s_waitcnt lgkmcnt(" #n ")" ::: "memory")
#define PG8_BAR __builtin_amdgcn_s_barrier()
#define PG8_SCHED __builtin_amdgcn_sched_barrier(0)
    Unit cur, nxt; int ui = 0;
    if (!S.next(0, cur)) return;
    f32x4 acc[2][2][4][2];
#pragma unroll
    for (int a = 0; a < 2; ++a)
#pragma unroll
        for (int b = 0; b < 2; ++b)
#pragma unroll
            for (int m = 0; m < 4; ++m)
#pragma unroll
                for (int n = 0; n < 2; ++n) acc[a][b][m][n] = (f32x4){0.f, 0.f, 0.f, 0.f};
    typedef int v4i_ __attribute__((ext_vector_type(4))); typedef int v8i_ __attribute__((ext_vector_type(8)));
    bf16x8 At[4][2], B0[2][2], B1[2][2]; v8i_ At8[4], B08[2], B18[2];
    int fp8_unit_scale = 0x7F7F7F7F; asm volatile("" : "+v"(fp8_unit_scale));
    const char* cA = (const char*)g.A + (size_t)cur.pm * tstep; const char* cB = (const char*)g.Bt + (size_t)cur.pn * tstep;
    S.a_ready(cur);
    PG8_STAGE(PG8_SB(0, 0), cB, voffB); PG8_STAGE(PG8_SA(0, 0), cA, voffA); PG8_STAGE(PG8_SB(0, 1), cB + hstep, voffB); PG8_STAGE(PG8_SA(0, 1), cA + hstep, voffA);
    if (wr == 1) PG8_BAR;
    PG8_WAIT_V(4); PG8_BAR;
    PG8_STAGE(PG8_SB(1, 0), cB + kstep, voffB); PG8_STAGE(PG8_SA(1, 0), cA + kstep, voffA); PG8_STAGE(PG8_SB(1, 1), cB + hstep + kstep, voffB);
    PG8_WAIT_V(6); PG8_BAR;
    for (;;) {
        const bool has_next = S.next(ui + 1, nxt);
        const char* nA = has_next ? (const char*)g.A + (size_t)nxt.pm * tstep : cA; const char* nB = has_next ? (const char*)g.Bt + (size_t)nxt.pn * tstep : cB;
        for (int t = 0; t < nt; t += 2) {
            const bool last = (t == nt - 2);
            const char* a1 = cA + (size_t)(t + 1) * kstep;
            const char* a2 = last ? nA : cA + (size_t)(t + 2) * kstep; const char* b2 = last ? nB : cB + (size_t)(t + 2) * kstep;
            const char* a3 = a2 + kstep; const char* b3 = b2 + kstep;
            if (last && has_next) S.a_ready(nxt);
            if constexpr (Epi::SEG) { if (t == 4 || t == 6) { int tz = tid; asm volatile("" : "+v"(tz)); const int wz = __builtin_amdgcn_readfirstlane(tz >> 6), lz = tz & 63; E.mid(acc, cur, t == 4 ? 0 : 1, wz >> 2, wz & 3, lz & 15, lz >> 4); } }
            PG8_LDB(B0, 0, 0); PG8_SCHED; PG8_LDA(At, 0, 0); PG8_STAGE(PG8_SA(1, 1), a1 + hstep, voffA);
            PG8_WAIT_L(8); PG8_BAR; PG8_WAIT_L(0); PG8_MMA(0, 0, At, B0); PG8_BAR; PG8_SCHED;
            PG8_LDB(B1, 0, 1); PG8_STAGE(PG8_SB(0, 0), b2, voffB);
            PG8_BAR; PG8_WAIT_L(0); PG8_MMA(0, 1, At, B1); PG8_BAR;
            PG8_LDA(At, 0, 1); PG8_STAGE(PG8_SA(0, 0), a2, voffA);
            PG8_BAR; PG8_WAIT_L(0); PG8_MMA(1, 0, At, B0); PG8_BAR; PG8_SCHED;
            PG8_STAGE(PG8_SB(0, 1), b2 + hstep, voffB);
            PG8_WAIT_V(6); PG8_BAR; PG8_MMA(1, 1, At, B1); PG8_BAR;
            PG8_LDB(B0, 1, 0); PG8_SCHED; PG8_LDA(At, 1, 0); PG8_STAGE(PG8_SA(0, 1), a2 + hstep, voffA);
            PG8_WAIT_L(8); PG8_BAR; PG8_WAIT_L(0); PG8_MMA(0, 0, At, B0); PG8_BAR; PG8_SCHED;
            PG8_LDB(B1, 1, 1); PG8_STAGE(PG8_SB(1, 0), b3, voffB);
            PG8_BAR; PG8_WAIT_L(0); PG8_MMA(0, 1, At, B1); PG8_BAR;
            PG8_LDA(At, 1, 1); PG8_STAGE(PG8_SA(1, 0), a3, voffA);
            PG8_BAR; PG8_WAIT_L(0); PG8_MMA(1, 0, At, B0); PG8_BAR; PG8_SCHED;
            PG8_STAGE(PG8_SB(1, 1), b3 + hstep, voffB);
            PG8_WAIT_V(6); PG8_BAR; PG8_MMA(1, 1, At, B1); PG8_BAR;
        }
        if constexpr (Epi::FP8) asm volatile("s_nop 15\n\ts_nop 15\n\ts_nop 15" ::: "memory");
        { int tz = tid; asm volatile("" : "+v"(tz)); const int wz = __builtin_amdgcn_readfirstlane(tz >> 6), lz = tz & 63;
          E(acc, cur, wz >> 2, wz & 3, lz & 15, lz >> 4); } S.done(cur);
        if (!has_next) break;
#pragma unroll
        for (int a = 0; a < 2; ++a)
#pragma unroll
            for (int b = 0; b < 2; ++b)
#pragma unroll
                for (int m = 0; m < 4; ++m)
#pragma unroll
                    for (int n = 0; n < 2; ++n) acc[a][b][m][n] = (f32x4){0.f, 0.f, 0.f, 0.f};
        cur = nxt; cA = nA; cB = nB; ++ui;
    }
    PG8_WAIT_V(0);
    if (wr == 0) PG8_BAR;
    PG8_BAR;
#undef PG8_SA
#undef PG8_SB
#undef PG8_STAGE
#undef PG8_LDA
#undef PG8_LD8
#undef PG8_LDB
#undef PG8_MMA
#undef PG8_WAIT_V
#undef PG8_WAIT_L
#undef PG8_BAR
#undef PG8_SCHED
}

struct EpiInProj {
    static constexpr bool PERM = true, SEG = false, FP8 = false;
    bf16_t* O; float* BA;
    __device__ __forceinline__ void operator()(const f32x4 (&acc)[2][2][4][2], const Unit& u, int wr, int wc, int fr, int fq) const {
        const int row0 = u.pm * BM + wr * 64 + fr, col0 = u.pn * BM + wc * 32 + 8 * fq;
        const bool sig = false, ba = (u.pn == 13) && (wc == 0) && (fq < 3);
#pragma unroll
        for (int ai = 0; ai < 2; ++ai)
#pragma unroll
            for (int m = 0; m < 4; ++m) { int row = row0 + ai * HALF + m * 16; asm volatile("" : "+v"(row)); bf16_t* rowp = O + (size_t)row * NPROJ + col0;
#pragma unroll
                for (int bj = 0; bj < 2; ++bj) { f32x4 v0 = acc[ai][bj][m][0], v1 = acc[ai][bj][m][1];
                    if (sig) {
#pragma unroll
                        for (int j = 0; j < 4; ++j) { v0[j] = sigmoidf_(v0[j]); v1[j] = sigmoidf_(v1[j]); } }
                    u32x4 w; w.x = pk2(v0[0], v0[1]); w.y = pk2(v0[2], v0[3]); w.z = pk2(v1[0], v1[1]); w.w = pk2(v1[2], v1[3]);
                    *(u32x4*)(rowp + bj * HALF) = w;
                    if (bj == 1 && ba) { float* bp = BA + (size_t)row * 32 + 8 * fq; *(f32x4*)bp = v0; *(f32x4*)(bp + 4) = v1; } } }
    }
};
struct EpiGates {
    static constexpr bool PERM = true, SEG = false, FP8 = true;
    unsigned char* G;
    static __device__ __forceinline__ unsigned q4(const f32x4& v) { unsigned r = 0u;
#pragma unroll
        for (int j = 0; j < 4; ++j) { const float t = __builtin_amdgcn_exp2f(v[j] * (-0.03125f * 1.44269504088896f));
            r = __builtin_amdgcn_cvt_pk_u8_f32(fmaxf(frcp(__builtin_fmaf(t, 1.0f / 255.0f, 1.0f / 255.0f)), 1.0f), j, r); }
        return r; }
    __device__ __forceinline__ void operator()(const f32x4 (&acc)[2][2][4][2], const Unit& u, int wr, int wc, int fr, int fq) const {
#pragma unroll
        for (int ai = 0; ai < 2; ++ai)
#pragma unroll
            for (int m = 0; m < 4; ++m) {
                unsigned boff = (unsigned)(((u.pm * 12 + u.pn) * (16 * 512) + ((wr * 4 + wc) * 64 + fq * 16 + fr)) * 8 + ((ai * 4 + m) * 2) * 4096); asm volatile("" : "+v"(boff));
#pragma unroll
                for (int bj = 0; bj < 2; ++bj) { u32x2 w; w.x = q4(acc[ai][bj][m][0]); w.y = q4(acc[ai][bj][m][1]);
                    *(u32x2*)(G + (boff + bj * 4096)) = w; }
                asm volatile("" ::: "memory"); }
    }
};
struct EpiGateCat {
    static constexpr bool PERM = true, SEG = true, FP8 = false;
    const u32x2* GT; bf16_t* MB;
    static __device__ __forceinline__ float ub(unsigned x, int j) { return (float)((x >> (8 * j)) & 0xffu); }
    __device__ __forceinline__ void mid(f32x4 (&acc)[2][2][4][2], const Unit& u, int seg, int wr, int wc, int fr, int fq) const {
        {
            int toff = (wr * 4 + wc) * 64 + fq * 16 + fr; asm volatile("" : "+v"(toff));
            const u32x2* ga = GT + ((size_t)u.pm * 12 + seg * 4 + u.pn) * (16 * 512) + toff; const u32x2* gb = ga + (size_t)4 * 16 * 512;
            u32x2 A_[2][4][2], B_[2][4][2];
#pragma unroll
            for (int ai = 0; ai < 2; ++ai)
#pragma unroll
                for (int m = 0; m < 4; ++m)
#pragma unroll
                    for (int bj = 0; bj < 2; ++bj) { A_[ai][m][bj] = ga[((ai * 4 + m) * 2 + bj) * 512]; B_[ai][m][bj] = gb[((ai * 4 + m) * 2 + bj) * 512]; }
#pragma unroll
            for (int ai = 0; ai < 2; ++ai)
#pragma unroll
                for (int m = 0; m < 4; ++m)
#pragma unroll
                    for (int bj = 0; bj < 2; ++bj) { const u32x2 a_ = A_[ai][m][bj], b_ = B_[ai][m][bj]; f32x4& v0 = acc[ai][bj][m][0]; f32x4& v1 = acc[ai][bj][m][1];
#pragma unroll
                        for (int j = 0; j < 4; ++j) { v0[j] *= ub(a_.x, j) * frcp(ub(b_.x, j)); v1[j] *= ub(a_.y, j) * frcp(ub(b_.y, j)); } }
            asm volatile("" ::: "memory"); }
    }
    __device__ __forceinline__ void operator()(const f32x4 (&acc)[2][2][4][2], const Unit& u, int wr, int wc, int fr, int fq) const {
        const int row0 = u.pm * BM + wr * 64 + fr, col0 = u.pn * BM + wc * 32 + 8 * fq;
#pragma unroll
        for (int ai = 0; ai < 2; ++ai) {
            int rowb = row0 + ai * HALF; asm volatile("" : "+v"(rowb)); bf16_t* mp0 = MB + (size_t)rowb * D + col0;
            int toff = (wr * 4 + wc) * 64 + fq * 16 + fr; asm volatile("" : "+v"(toff));
            const u32x2* gc = GT + ((size_t)u.pm * 12 + 8 + u.pn) * (16 * 512) + toff;
            u32x2 gw[4][2];
#pragma unroll
            for (int m = 0; m < 4; ++m)
#pragma unroll
                for (int bj = 0; bj < 2; ++bj) gw[m][bj] = gc[((ai * 4 + m) * 2 + bj) * 512];
#pragma unroll
            for (int m = 0; m < 4; ++m)
#pragma unroll
                for (int bj = 0; bj < 2; ++bj) { const u32x2 g_ = gw[m][bj]; const f32x4 v0 = acc[ai][bj][m][0] * (1.0f / 255.0f), v1 = acc[ai][bj][m][1] * (1.0f / 255.0f); u32x4 w;
                    w.x = pk2(v0[0] * ub(g_.x, 0), v0[1] * ub(g_.x, 1)); w.y = pk2(v0[2] * ub(g_.x, 2), v0[3] * ub(g_.x, 3)); w.z = pk2(v1[0] * ub(g_.y, 0), v1[1] * ub(g_.y, 1)); w.w = pk2(v1[2] * ub(g_.y, 2), v1[3] * ub(g_.y, 3));
                    *(u32x4*)(mp0 + (size_t)(m * 16) * D + bj * HALF) = w; }
            asm volatile("" ::: "memory"); }
    }
};
struct EpiRes {
    static constexpr bool PERM = true, SEG = false, FP8 = false;
    const bf16_t* XR; bf16_t* H;
    __device__ __forceinline__ void operator()(const f32x4 (&acc)[2][2][4][2], const Unit& u, int wr, int wc, int fr, int fq) const {
        const int row0 = u.pm * BM + wr * 64 + fr, col0 = u.pn * BM + wc * 32 + 8 * fq;
#pragma unroll
        for (int ai = 0; ai < 2; ++ai) {
            int rowb = row0 + ai * HALF; asm volatile("" : "+v"(rowb)); const size_t off0 = (size_t)rowb * D + col0;
            u32x4 xr[4][2];
#pragma unroll
            for (int m = 0; m < 4; ++m)
#pragma unroll
                for (int bj = 0; bj < 2; ++bj) xr[m][bj] = *(const u32x4*)(XR + off0 + (size_t)(m * 16) * D + bj * HALF);
#pragma unroll
            for (int m = 0; m < 4; ++m)
#pragma unroll
                for (int bj = 0; bj < 2; ++bj) { const u32x4 x = xr[m][bj]; const f32x4 v0 = acc[ai][bj][m][0], v1 = acc[ai][bj][m][1]; u32x4 w;
                    w.x = pk2(bflo(x.x) * ALPHA + v0[0], bfhi(x.x) * ALPHA + v0[1]); w.y = pk2(bflo(x.y) * ALPHA + v0[2], bfhi(x.y) * ALPHA + v0[3]);
                    w.z = pk2(bflo(x.z) * ALPHA + v1[0], bfhi(x.z) * ALPHA + v1[1]); w.w = pk2(bflo(x.w) * ALPHA + v1[2], bfhi(x.w) * ALPHA + v1[3]);
                    *(u32x4*)(H + off0 + (size_t)(m * 16) * D + bj * HALF) = w; }
            asm volatile("" ::: "memory"); }
    }
};
struct EpiSwiglu {
    static constexpr bool PERM = true, SEG = false, FP8 = true;
    unsigned char* HID;
    __device__ __forceinline__ void operator()(const f32x4 (&acc)[2][2][4][2], const Unit& u, int wr, int wc, int fr, int fq) const {
        const int row0 = u.pm * BM + wr * 64 + fr, col0 = (u.pn & 15) * 128 + wc * 32 + 8 * fq;
#pragma unroll
        for (int ai = 0; ai < 2; ++ai)
#pragma unroll
            for (int m = 0; m < 4; ++m) { const f32x4 g0 = acc[ai][0][m][0], g1 = acc[ai][0][m][1], u0 = acc[ai][1][m][0], u1 = acc[ai][1][m][1];
                f32x4 h0, h1;
#pragma unroll
                for (int j = 0; j < 4; ++j) { const float t0 = __builtin_amdgcn_exp2f(g0[j] * (-0.03125f * 1.44269504088896f)), t1 = __builtin_amdgcn_exp2f(g1[j] * (-0.03125f * 1.44269504088896f));
                    h0[j] = g0[j] * u0[j] * frcp(__builtin_fmaf(t0, 1024.0f, 1024.0f)); h1[j] = g1[j] * u1[j] * frcp(__builtin_fmaf(t1, 1024.0f, 1024.0f)); }
                u32x2 w; w.x = pk4_fp8(h0[0], h0[1], h0[2], h0[3]); w.y = pk4_fp8(h1[0], h1[1], h1[2], h1[3]);
                int rowi = row0 + ai * HALF + m * 16; asm volatile("" : "+v"(rowi));
                *(u32x2*)(HID + (size_t)rowi * DE + col0) = w; asm volatile("" ::: "memory"); }
    }
};
struct EpiDown {
    static constexpr bool PERM = true, SEG = false, FP8 = true;
    bf16_t* Y; const float* GV;
    __device__ __forceinline__ void operator()(const f32x4 (&acc)[2][2][4][2], const Unit& u, int wr, int wc, int fr, int fq) const {
        const int row0 = u.pm * BM + wr * 64 + fr, col0 = (u.pn & 3) * BM + wc * 32 + 8 * fq;
        float gvs[2][4];
#pragma unroll
        for (int ai = 0; ai < 2; ++ai)
#pragma unroll
            for (int m = 0; m < 4; ++m) gvs[ai][m] = GV[row0 + ai * HALF + m * 16];
#pragma unroll
        for (int ai = 0; ai < 2; ++ai)
#pragma unroll
            for (int m = 0; m < 4; ++m) { int row = row0 + ai * HALF + m * 16; asm volatile("" : "+v"(row)); const float gv = gvs[ai][m] * 0.03125f;
#pragma unroll
                for (int bj = 0; bj < 2; ++bj) { const f32x4 v0 = acc[ai][bj][m][0] * gv, v1 = acc[ai][bj][m][1] * gv;
                    u32x4 w; w.x = pk2(v0[0], v0[1]); w.y = pk2(v0[2], v0[3]); w.z = pk2(v1[0], v1[1]); w.w = pk2(v1[2], v1[3]);
                    *(u32x4*)(Y + (size_t)row * D + col0 + bj * HALF) = w; } }
    }
};
}

#define XB_TMO      128
#define XB_XCNT(j)  (256  + 64 * (j))
#define XB_XSUB(j)  (1280 + 64 * (j))
#define XB_XGEN(j)  (2304 + 64 * (j))
#define XB_TOP      3328
#define XB_TOPGEN   3392
#define XCD_BAR_WORDS 3456
#define XB_SPIN_CAP (1u << 22)
__device__ __forceinline__ unsigned xb_ld(unsigned* p)              { return __hip_atomic_load(p, __ATOMIC_RELAXED, __HIP_MEMORY_SCOPE_AGENT); }
__device__ __forceinline__ unsigned xb_add(unsigned* p, unsigned v) { return __hip_atomic_fetch_add(p, v, __ATOMIC_RELAXED, __HIP_MEMORY_SCOPE_AGENT); }
__device__ __forceinline__ unsigned xb_xcc_id() { return (unsigned)__builtin_amdgcn_s_getreg((3 << 11) | 20) & 0xFu; }
#define XB_SPIN(cond, bar) do { unsigned _sp = 0; while (cond) { __builtin_amdgcn_s_sleep(1); \
    if ((++_sp & 255u) == 0u) { if (xb_ld(&(bar)[XB_TMO])) break; if (_sp > XB_SPIN_CAP) { atomicAdd(&(bar)[XB_TMO], 1u); break; } } } } while (0)
struct XcdBarrier { unsigned* bar; unsigned x; volatile LAS unsigned* st; };
__device__ __forceinline__ XcdBarrier xcd_barrier_post(unsigned* bar, volatile LAS unsigned* st) {
    XcdBarrier b; b.bar = bar; b.x = xb_xcc_id(); b.st = st;
    if (threadIdx.x == 0) (void)xb_add(&bar[XB_XCNT(b.x)], 1u);
    return b;
}
__device__ __forceinline__ void xcd_barrier_complete(unsigned* bar, unsigned x, unsigned& nloc, unsigned& nx) {
    const unsigned G = gridDim.x * gridDim.y * gridDim.z;
    unsigned sum, cnt, mine, sp = 0u;
    for (;;) {
        sum = 0u; cnt = 0u; mine = 0u;
#pragma unroll
        for (unsigned j = 0; j < 16; ++j) { const unsigned c = xb_ld(&bar[XB_XCNT(j)]); sum += c; cnt += (c > 0u) ? 1u : 0u; }
        mine = xb_ld(&bar[XB_XCNT(x)]);
        if (sum == G) break;
        __builtin_amdgcn_s_sleep(1);
        if ((++sp & 255u) == 0u) { if (xb_ld(&bar[XB_TMO])) break; if (sp > XB_SPIN_CAP) { atomicAdd(&bar[XB_TMO], 1u); break; } }
    }
    nloc = mine > 0u ? mine : 1u; nx = cnt > 0u ? cnt : 1u;
}
__device__ __forceinline__ void xcd_barrier(const XcdBarrier& b) {
    asm volatile("s_waitcnt vmcnt(0)" ::: "memory");
    __syncthreads();
    if (threadIdx.x == 0) {
        unsigned* bar = b.bar; asm volatile("" : "+s"(bar));
        __builtin_amdgcn_s_waitcnt(0);
        unsigned nloc = b.st[0], nx = b.st[1];
        if (nloc == 0u) { xcd_barrier_complete(bar, b.x, nloc, nx); b.st[0] = nloc; b.st[1] = nx; }
        const unsigned old = xb_add(&bar[XB_XSUB(b.x)], 1u);
        const unsigned gen = old / nloc;
        if (old + 1u == (gen + 1u) * nloc) {
            __builtin_amdgcn_fence(__ATOMIC_RELEASE, "agent");
            asm volatile("s_waitcnt vmcnt(0)" ::: "memory");
            const unsigned og = xb_add(&bar[XB_TOP], 1u);
            const unsigned tg = og / nx;
            if (og + 1u == (tg + 1u) * nx) xb_add(&bar[XB_TOPGEN], 1u);
            else XB_SPIN(xb_ld(&bar[XB_TOPGEN]) == tg, bar);
            __builtin_amdgcn_fence(__ATOMIC_ACQUIRE, "agent");
            xb_add(&bar[XB_XGEN(b.x)], 1u);
            asm volatile("s_waitcnt vmcnt(0)" ::: "memory");
        } else {
            XB_SPIN(xb_ld(&bar[XB_XGEN(b.x)]) == gen, bar);
            __builtin_amdgcn_fence(__ATOMIC_ACQUIRE, "agent");
            asm volatile("s_waitcnt vmcnt(0)" ::: "memory");
        }
    }
    __syncthreads();
}

struct Args { const float* in[20]; float* out; unsigned char* ws; int ph_lo, ph_hi; };
typedef const __attribute__((address_space(4))) Args* KArgs;
DI KArgs kargs() { KArgs p = (KArgs)__builtin_amdgcn_kernarg_segment_ptr(); asm volatile("" : "+s"(p)); return p; }
struct Ctx {
    float* out; unsigned char* ws;
    int tid, lane, wave, G, bid;
    int layer, slab;
    int nseq, seqlen;
    int stok, sbase;
    int dry;
};
#define WSP(T, off) ((T*)(c.ws + (off)))
#define BIGP(T, off) ((T*)(c.ws + WS_BIG + (off)))

__device__ const float INV_FREQ[32] = {1.000000000e+00f, 7.498942018e-01f, 5.623413324e-01f, 4.216965139e-01f, 3.162277639e-01f, 2.371373773e-01f, 1.778279394e-01f, 1.333521456e-01f, 1.000000015e-01f, 7.498942316e-02f, 5.623413250e-02f, 4.216964915e-02f, 3.162277490e-02f, 2.371373773e-02f, 1.778279431e-02f, 1.333521400e-02f, 9.999999776e-03f, 7.498942316e-03f, 5.623413250e-03f, 4.216964822e-03f, 3.162277630e-03f, 2.371373819e-03f, 1.778279431e-03f, 1.333521446e-03f, 1.000000047e-03f, 7.498941850e-04f, 5.623413017e-04f, 4.216965172e-04f, 3.162277571e-04f, 2.371373703e-04f, 1.778279402e-04f, 1.333521504e-04f};
DI void tr_item(const float* src, long src_ld, int src_col0, int nvalid, int kvalid, bf16_t* dst, long dst_ld, int dst_row0, int k0, LAS float* scr, int lane) {
    float tv[32];
#pragma unroll
    for (int i = 0; i < 32; ++i) { const int kk = 2 * i + (lane >> 5), cc = lane & 31;
        tv[i] = 0.f; if ((k0 + kk) < kvalid && cc < nvalid) tv[i] = src[(size_t)(k0 + kk) * src_ld + src_col0 + cc]; }
#pragma unroll
    for (int i = 0; i < 32; ++i) { const int kk = 2 * i + (lane >> 5), cc = lane & 31; scr[kk * 33 + cc] = tv[i]; }
    asm volatile("s_waitcnt lgkmcnt(0)" ::: "memory");
    const int c8 = lane & 7;
#pragma unroll
    for (int j = 0; j < 4; ++j) { const int n = (lane >> 3) + 8 * j; const LAS float* s = scr + (8 * c8) * 33 + n;
        u32x4 o; o.x = pk2(s[0 * 33], s[1 * 33]); o.y = pk2(s[2 * 33], s[3 * 33]); o.z = pk2(s[4 * 33], s[5 * 33]); o.w = pk2(s[6 * 33], s[7 * 33]);
        *(u32x4*)(dst + (size_t)(dst_row0 + n) * dst_ld + k0 + 8 * c8) = o; }
    asm volatile("s_waitcnt lgkmcnt(0)" ::: "memory");
}
DI void tr_item8(const float* src, long src_ld, int src_col0, int kvalid, unsigned char* dst, long dst_ld, int dst_row0, int k0, float scale, LAS float* scr, int lane) {
    float tv[32];
#pragma unroll
    for (int i = 0; i < 32; ++i) { const int kk = 2 * i + (lane >> 5), cc = lane & 31; tv[i] = 0.f; if ((k0 + kk) < kvalid) tv[i] = src[(size_t)(k0 + kk) * src_ld + src_col0 + cc]; }
#pragma unroll
    for (int i = 0; i < 32; ++i) { const int kk = 2 * i + (lane >> 5), cc = lane & 31; scr[kk * 33 + cc] = tv[i]; }
    asm volatile("s_waitcnt lgkmcnt(0)" ::: "memory");
    const int c8 = lane & 7;
#pragma unroll
    for (int j = 0; j < 4; ++j) { const int n = (lane >> 3) + 8 * j; const LAS float* s = scr + (8 * c8) * 33 + n;
        u32x2 o; o.x = pk4_fp8(s[0 * 33] * scale, s[1 * 33] * scale, s[2 * 33] * scale, s[3 * 33] * scale); o.y = pk4_fp8(s[4 * 33] * scale, s[5 * 33] * scale, s[6 * 33] * scale, s[7 * 33] * scale);
        *(u32x2*)(dst + (size_t)(dst_row0 + n) * dst_ld + k0 + 8 * c8) = o; }
    asm volatile("s_waitcnt lgkmcnt(0)" ::: "memory");
}
DI void phase_weights(KArgs args, LAS unsigned char* lds, const Ctx& c) {
    const int l = c.layer, lane = c.lane;
    LAS float* scr = (LAS float*)(lds + c.wave * 8448);
    const int gw = c.bid * 8 + c.wave, NGW = c.G * 8;
    constexpr int I_IN = 16 * 112 + 16 * 96, I_NA = 4 * 32, I_DIL = 2 * 32, I_GDN = 6 * 32, I_OUT = 16 * 32, I_GU1 = 16 * 128, I_D1 = 32 * 32;
    constexpr int NITEMS = I_IN + I_NA + I_DIL + I_GDN + I_OUT + 16 * I_GU1 + 16 * I_D1;
    for (int it = gw; it < NITEMS; it += NGW) {
        int r = it;
        const float* src; long sld; int sc0, nv = 32, kv; bf16_t* dst; long dld; int dr0, k0;
        if (r < 16 * 112) { const int kb = r / 112, nb = r % 112, n0 = 32 * nb; src = args->in[2] + (size_t)l * D * DIN; sld = DIN; kv = D;
            sc0 = n0; nv = 3480 - n0; if (nv < 0) { nv = 0; sc0 = 0; } if (nv > 32) nv = 32;
            dst = WSP(bf16_t, WS_WIN); dld = D; dr0 = n0; k0 = 64 * kb; }
        else if (r < I_IN) { const int q = r - 16 * 112, kb = q / 96, nb = q % 96;
            tr_item8(args->in[2] + (size_t)l * D * DIN, DIN, 3480 + 32 * nb, D, WSP(unsigned char, WS_WG8), D, 32 * nb, 64 * kb, 32.0f, scr, lane); continue; }
        else if ((r -= I_IN) < I_NA) { const int kb = r / 32, nb = r % 32; src = args->in[8] + (size_t)l * 256 * D; sld = D; sc0 = 32 * nb; kv = 256; dst = WSP(bf16_t, WS_WBR); dld = 768; dr0 = 32 * nb; k0 = 64 * kb; }
        else if ((r -= I_NA) < I_DIL) { const int kb = r / 32, nb = r % 32; src = args->in[9] + (size_t)l * 128 * D; sld = D; sc0 = 32 * nb; kv = 128; dst = WSP(bf16_t, WS_WBR) + 256; dld = 768; dr0 = 32 * nb; k0 = 64 * kb; }
        else if ((r -= I_DIL) < I_GDN) { const int kb = r / 32, nb = r % 32; src = args->in[10] + (size_t)l * 384 * D; sld = D; sc0 = 32 * nb; kv = 384; dst = WSP(bf16_t, WS_WBR) + 384; dld = 768; dr0 = 32 * nb; k0 = 64 * kb; }
        else if ((r -= I_GDN) < I_OUT) { const int kb = r / 32, nb = r % 32; src = args->in[11] + (size_t)l * D * D; sld = D; sc0 = 32 * nb; kv = D; dst = WSP(bf16_t, WS_WOUT); dld = D; dr0 = 32 * nb; k0 = 64 * kb; }
        else if ((r -= I_OUT) < 16 * I_GU1) { const int e = r / I_GU1, q = r % I_GU1, kb = q / 128, nb = q % 128, n0 = 32 * nb, j = n0 >> 8, rr = n0 & 255;
            tr_item8((rr < 128 ? args->in[16] : args->in[15]) + ((size_t)l * NE + e) * D * DE, DE, 128 * j + (rr & 127), D, WSP(unsigned char, WS_WGU) + (size_t)e * 4096 * D, D, n0, 64 * kb, 32.0f, scr, lane); continue; }
        else { r -= 16 * I_GU1; const int e = r / I_D1, q = r % I_D1, kb = q / 32, nb = q % 32;
            tr_item8(args->in[17] + ((size_t)l * NE + e) * DE * D, D, 32 * nb, DE, WSP(unsigned char, WS_WD) + (size_t)e * D * DE, DE, 32 * nb, 64 * kb, 32.0f, scr, lane); continue; }
        tr_item(src, sld, sc0, nv, kv, dst, dld, dr0, k0, scr, lane);
    }
    if (l == 0) {
        for (int t = gw; t < T_ALL; t += NGW) {
            const float* xr = (t < T_P) ? args->in[0] + (size_t)t * D : args->in[1] + (size_t)(t - T_P) * D;
            bf16_t* o = WSP(bf16_t, WS_XB) + (size_t)t * D;
#pragma unroll
            for (int j = 0; j < 4; ++j) { const f32x4 v = *(const f32x4*)(xr + 4 * lane + 256 * j); u32x2 w; w.x = pk2(v[0], v[1]); w.y = pk2(v[2], v[3]); *(u32x2*)(o + 4 * lane + 256 * j) = w;
                *(unsigned*)(WSP(unsigned char, WS_XB8) + (size_t)t * D + 4 * lane + 256 * j) = pk4_fp8(v[0], v[1], v[2], v[3]); }
        }
        float* cs = WSP(float, WS_CS);
        for (int i = c.bid * 512 + c.tid; i < 16384 * 32; i += c.G * 512) { const int pos = i >> 5, k = i & 31;
            const float inv = INV_FREQ[k];
            const float ang = (float)pos * inv;
            cs[pos * 64 + k] = cosf(ang); cs[pos * 64 + 32 + k] = sinf(ang); }
    }
}

constexpr int TLD = 72, TILEB = 64 * TLD * 2;
DI int tsw(int row) { return ((row >> 4) & 3) << 3; }
template <bool SA = false, bool SB = false> DI f32x16 mm_tile(const LAS bf16_t* A, const LAS bf16_t* Bt, int m0, int n0, int lane) {
    f32x16 acc = zero16(); const int r = lane & 31, hh = lane >> 5; const int sa = SA ? tsw(m0 + r) : 0, sb = SB ? tsw(n0 + r) : 0;
#pragma unroll
    for (int ks = 0; ks < 4; ++ks) { const bf16x8 a = *(const LAS bf16x8*)(A + (m0 + r) * TLD + ((16 * ks + 8 * hh) ^ sa)); const bf16x8 b = *(const LAS bf16x8*)(Bt + (n0 + r) * TLD + ((16 * ks + 8 * hh) ^ sb)); acc = MFMA32(a, b, acc); }
    return acc;
}

constexpr int PI_P0 = 0, PI_P1 = 9216, PI_INTRA = 18432, PI_AM = 27648, PI_TT = 45056, PI_TD0 = 54272, PI_TD1 = 60416, PI_PM = 65024, PI_VEC = 71168, PI_BYTES = 72704;
constexpr int PI_WT = PI_AM, PI_UT = PI_TD0;
struct PrepIn { float bl[2], al[2], cw[2]; };
DI void gdn_prep_loads(KArgs args, const Ctx& c, int pu, PrepIn& in) {
    int tid = c.tid; asm volatile("" : "+v"(tid));
    { const float* cwg = args->in[4] + (size_t)c.layer * 5 * 1152 + 64 * (pu % 6);
#pragma unroll
        for (int k = 0; k < 2; ++k) { int i = tid + 512 * k; i = i < 960 ? i : 959; const int tp = i / 192, r = i % 192; in.cw[k] = cwg[tp * 1152 + (r >> 6) * 384 + (r & 63)]; } }
    const int dir = tid >> 8, tg = tid & 255, head = pu % 6, gch = pu / 6, cps = c.seqlen >> 6, seq = gch / cps, n = gch % cps, ia = tg >> 3, p = tg & 7, tr = ia + 32 * dir;
    const float* BA = BIGP(float, B_BA);
#pragma unroll
    for (int h2 = 0; h2 < 2; ++h2) { const int i = ia + 32 * h2, tokl = dir ? 63 - i : i; const float* bar = BA + (size_t)(seq * c.seqlen + n * 64 + tokl) * 32;
        in.bl[h2] = bar[dir * 6 + head]; in.al[h2] = bar[12 + dir * 6 + head]; }
}
DI void gdn_prep_put_cw(LAS unsigned char* L0, const Ctx& c, const PrepIn& in) {
    int tid = c.tid; asm volatile("" : "+v"(tid)); LAS float* CW = (LAS float*)(L0 + LDS_CW);
    CW[tid] = in.cw[0]; if (tid < 448) CW[tid + 512] = in.cw[1];
}
DI void gdn_prep_pair(KArgs args, LAS unsigned char* L0, const Ctx& c, int pu, PrepIn& in, int pu_next) {
    int tid = c.tid; asm volatile("" : "+v"(tid)); const int lane = tid & 63, wave = __builtin_amdgcn_readfirstlane(tid >> 6), l = c.layer;
    const int dir = wave >> 2, wg = wave & 3, tg = tid & 255, head = pu % 6, gch = pu / 6, inst = (gch * 6 + head) * 2 + dir;
    const int cps = c.seqlen >> 6, seq = gch / cps, n = gch % cps;
    const bf16_t* PROJ = BIGP(bf16_t, B_PROJ); const float* BA = BIGP(float, B_BA);
    unsigned char* G = BIGP(unsigned char, B_GSCR) + (size_t)inst * GSTRIDE;
    LAS unsigned char* L = L0 + dir * PI_BYTES;
    LAS bf16_t* P0 = (LAS bf16_t*)(L + PI_P0); LAS bf16_t* P1 = (LAS bf16_t*)(L + PI_P1); LAS bf16_t* INTRA = (LAS bf16_t*)(L + PI_INTRA);
    LAS float* AM = (LAS float*)(L + PI_AM); LAS bf16_t* TT = (LAS bf16_t*)(L + PI_TT);
    LAS float* TD0 = (LAS float*)(L + PI_TD0); LAS float* TD1 = (LAS float*)(L + PI_TD1); LAS float* PM = (LAS float*)(L + PI_PM);
    LAS float* GV = (LAS float*)(L + PI_VEC); LAS float* BV = GV + 64; LAS float* GC = GV + 128;
    LAS bf16_t* WT = (LAS bf16_t*)(L + PI_WT); LAS bf16_t* UT = (LAS bf16_t*)(L + PI_UT);
    const int ia = tg >> 3, p = tg & 7;
    LAS float* XQ = (LAS float*)(L0 + PI_AM);
    LAS float* XK = (LAS float*)(L0 + PI_TT);
    LAS float* XV = (LAS float*)(L0 + PI_BYTES + PI_AM);
    {   float q1[8], k1[8], v1[8];
#pragma unroll
        for (int j = 0; j < 8; ++j) { q1[j] = 0.f; k1[j] = 0.f; v1[j] = 0.f; }
        const LAS float* cw = (const LAS float*)(L0 + LDS_CW) + 8 * p;
        const int tr = ia + 32 * dir;
        u32x4 rqa[5], rka[5], rva[5];
#pragma unroll
        for (int tp = 0; tp < 5; ++tp) { const int pp = n * 64 + tr + tp - 2, ppc = pp < 0 ? 0 : (pp >= c.seqlen ? c.seqlen - 1 : pp);
            const bf16_t* rp = PROJ + (size_t)(seq * c.seqlen + ppc) * NPROJ + 64 * head + 8 * p;
            rqa[tp] = *(const u32x4*)(rp + C_QC); rka[tp] = *(const u32x4*)(rp + C_KC); rva[tp] = *(const u32x4*)(rp + C_VC); }
#pragma unroll
        for (int tp = 0; tp < 5; ++tp) { const LAS float* w = cw + tp * 192;
            const f32x4 wq0 = *(const LAS f32x4*)w, wq1 = *(const LAS f32x4*)(w + 4), wk0 = *(const LAS f32x4*)(w + 64), wk1 = *(const LAS f32x4*)(w + 68), wv0 = *(const LAS f32x4*)(w + 128), wv1 = *(const LAS f32x4*)(w + 132);
            const int pp = n * 64 + tr + tp - 2; const bool inr = (pp >= 0 && pp < c.seqlen);
            { u32x4 rq = rqa[tp], rk = rka[tp], rv = rva[tp];
                if (!inr) { rq = (u32x4){0u, 0u, 0u, 0u}; rk = rq; rv = rq; }
#pragma unroll
                for (int j = 0; j < 4; ++j) { const float a0 = (j < 2) ? wq0[2 * j] : wq1[2 * j - 4], a1 = (j < 2) ? wq0[2 * j + 1] : wq1[2 * j - 3];
                    const float b0 = (j < 2) ? wk0[2 * j] : wk1[2 * j - 4], b1 = (j < 2) ? wk0[2 * j + 1] : wk1[2 * j - 3];
                    const float c0 = (j < 2) ? wv0[2 * j] : wv1[2 * j - 4], c1 = (j < 2) ? wv0[2 * j + 1] : wv1[2 * j - 3];
                    q1[2 * j] += a0 * bflo(rq[j]); q1[2 * j + 1] += a1 * bfhi(rq[j]);
                    k1[2 * j] += b0 * bflo(rk[j]); k1[2 * j + 1] += b1 * bfhi(rk[j]);
                    v1[2 * j] += c0 * bflo(rv[j]); v1[2 * j + 1] += c1 * bfhi(rv[j]); } } }
        float sq = 0.f, sk = 0.f;
#pragma unroll
        for (int j = 0; j < 8; ++j) { q1[j] = siluf_(q1[j]); k1[j] = siluf_(k1[j]); v1[j] = siluf_(v1[j]); sq += q1[j] * q1[j]; sk += k1[j] * k1[j]; }
        sq += __shfl_xor(sq, 1); sq += __shfl_xor(sq, 2); sq += __shfl_xor(sq, 4);
        sk += __shfl_xor(sk, 1); sk += __shfl_xor(sk, 2); sk += __shfl_xor(sk, 4);
        const float rq_ = 0.125f * frsq(sq + NORM_EPS), rk_ = frsq(sk + NORM_EPS);
        f32x4 o0, o1;
        o0[0] = q1[0] * rq_; o0[1] = q1[1] * rq_; o0[2] = q1[2] * rq_; o0[3] = q1[3] * rq_; o1[0] = q1[4] * rq_; o1[1] = q1[5] * rq_; o1[2] = q1[6] * rq_; o1[3] = q1[7] * rq_;
        *(LAS f32x4*)(XQ + tr * 64 + 8 * p) = o0; *(LAS f32x4*)(XQ + tr * 64 + 8 * p + 4) = o1;
        o0[0] = k1[0] * rk_; o0[1] = k1[1] * rk_; o0[2] = k1[2] * rk_; o0[3] = k1[3] * rk_; o1[0] = k1[4] * rk_; o1[1] = k1[5] * rk_; o1[2] = k1[6] * rk_; o1[3] = k1[7] * rk_;
        *(LAS f32x4*)(XK + tr * 64 + 8 * p) = o0; *(LAS f32x4*)(XK + tr * 64 + 8 * p + 4) = o1;
        o0[0] = v1[0]; o0[1] = v1[1]; o0[2] = v1[2]; o0[3] = v1[3]; o1[0] = v1[4]; o1[1] = v1[5]; o1[2] = v1[6]; o1[3] = v1[7];
        *(LAS f32x4*)(XV + tr * 64 + 8 * p) = o0; *(LAS f32x4*)(XV + tr * 64 + 8 * p + 4) = o1; }
#pragma unroll
    for (int h2 = 0; h2 < 2; ++h2) {
        if (p == 0) { const int i = ia + 32 * h2;
            const float bl = in.bl[h2], al = in.al[h2];
            const float xx = al + args->in[6][l * 12 + dir * 6 + head];
            const float sp = xx > 20.f ? xx : log1pf(expf(xx));
            GV[i] = -expf(args->in[5][l * 12 + dir * 6 + head]) * sp; BV[i] = sigmoidf_(bl); } }
    lds_barrier();
    float q[2][8], k[2][8], v[2][8];
#pragma unroll
    for (int h2 = 0; h2 < 2; ++h2) { const int i = ia + 32 * h2, tokl = dir ? 63 - i : i;
        const f32x4 a0 = *(const LAS f32x4*)(XQ + tokl * 64 + 8 * p), a1 = *(const LAS f32x4*)(XQ + tokl * 64 + 8 * p + 4), b0 = *(const LAS f32x4*)(XK + tokl * 64 + 8 * p), b1 = *(const LAS f32x4*)(XK + tokl * 64 + 8 * p + 4),
                    c0 = *(const LAS f32x4*)(XV + tokl * 64 + 8 * p), c1 = *(const LAS f32x4*)(XV + tokl * 64 + 8 * p + 4);
#pragma unroll
        for (int j = 0; j < 4; ++j) { q[h2][j] = a0[j]; q[h2][4 + j] = a1[j]; k[h2][j] = b0[j]; k[h2][4 + j] = b1[j]; v[h2][j] = c0[j]; v[h2][4 + j] = c1[j]; } }
    float gcl_;
    { float x = GV[lane];
#pragma unroll
        for (int o = 1; o < 64; o <<= 1) { const float y = __shfl_up(x, o); if (lane >= o) x += y; }
        if (wg == 0) GC[lane] = x;
        gcl_ = x; }
    const float gc0 = __shfl(gcl_, ia), gc1 = __shfl(gcl_, ia + 32), gcl = __shfl(gcl_, 63);
#pragma unroll
    for (int h2 = 0; h2 < 2; ++h2) { const int i = ia + 32 * h2; u32x4 wq, wk;
#pragma unroll
        for (int j = 0; j < 4; ++j) { wq[j] = pk2(q[h2][2 * j], q[h2][2 * j + 1]); wk[j] = pk2(k[h2][2 * j], k[h2][2 * j + 1]); }
        *(LAS u32x4*)(P0 + i * TLD + 8 * p) = wq; *(LAS u32x4*)(P1 + i * TLD + 8 * p) = wk; }
    lds_barrier();
    { const int mat = wg >> 1, mt = wg & 1, hh = lane >> 5;
        float gi[16], bi[16];
#pragma unroll
        for (int r = 0; r < 16; ++r) { const int ii = 32 * mt + crow(r, hh); gi[r] = GC[ii]; bi[r] = BV[ii]; }
        __builtin_amdgcn_sched_barrier(0);
#pragma unroll
        for (int nt = 0; nt < 2; ++nt) { const int jc = 32 * nt + (lane & 31);
            const f32x16 a = mm_tile(mat ? P0 : P1, P1, 32 * mt, 32 * nt, lane);
            const float gj = GC[jc];
            if (mat == 0) {
#pragma unroll
                for (int r = 0; r < 16; ++r) { const int ii = 32 * mt + crow(r, hh); const float ev = bi[r] * a[r] * __expf(gi[r] - gj); AM[ii * 68 + jc] = (jc < ii) ? ev : 0.f; }
            } else {
#pragma unroll
                for (int r = 0; r < 16; ++r) { const int ii = 32 * mt + crow(r, hh); const float ev = a[r] * __expf(gi[r] - gj); INTRA[ii * TLD + jc] = (bf16_t)(pk2((jc <= ii) ? ev : 0.f, 0.f) & 0xffffu); } } } }
    lds_barrier();
    if (wg == dir) {
        const int b = lane >> 5, cidx = lane & 31; float t[32]; typedef float f32x2_ __attribute__((ext_vector_type(2)));
#pragma unroll
        for (int ii = 0; ii < 32; ++ii) t[ii] = (ii == cidx) ? 1.f : 0.f;
        const LAS float* Ab = AM + (32 * b) * 68 + 32 * b;
        f32x4 rb[2][8];
        rb[1][0] = *(const LAS f32x4*)(Ab + 68);
        __builtin_amdgcn_sched_barrier(0);
#pragma unroll
        for (int ii = 1; ii < 32; ++ii) {
            if (ii + 1 < 32) {
#pragma unroll
                for (int j4 = 0; j4 < ii + 1; j4 += 4) rb[(ii + 1) & 1][j4 >> 2] = *(const LAS f32x4*)(Ab + (ii + 1) * 68 + j4); }
            __builtin_amdgcn_sched_barrier(0);
            f32x2_ a0 = {0.f, 0.f}, a1 = {0.f, 0.f};
#pragma unroll
            for (int j4 = 0; j4 < ii; j4 += 4) { const f32x4 a4 = rb[ii & 1][j4 >> 2];
                const f32x2_ tl = {t[j4], t[j4 + 1]}, th = {t[j4 + 2], t[j4 + 3]}, al = {a4[0], a4[1]}, ah = {a4[2], a4[3]};
                a0 += al * tl; a1 += ah * th; }
            a0 += a1; t[ii] -= a0.x + a0.y;
            __builtin_amdgcn_sched_barrier(0); }
        LAS float* td = b ? TD1 : TD0; const int tds = b ? 36 : 48;
#pragma unroll
        for (int ii = 0; ii < 32; ++ii) { td[ii * tds + cidx] = t[ii]; TT[(32 * b + ii) * TLD + 32 * b + cidx] = (bf16_t)(pk2(t[ii], 0.f) & 0xffffu); }
    }
#pragma unroll
    for (int h2 = 0; h2 < 2; ++h2) { const int i = ia + 32 * h2; const float be = BV[i], eg = __expf(h2 ? gc1 : gc0);
#pragma unroll
        for (int j = 0; j < 8; ++j) { const int d = 8 * p + j, o_ = d * TLD + (i ^ tsw(d)); P0[o_] = (bf16_t)(pk2(k[h2][j] * be * eg, 0.f) & 0xffffu); P1[o_] = (bf16_t)(pk2(v[h2][j] * be, 0.f) & 0xffffu); } }
    { unsigned zz; asm volatile("v_mov_b32 %0, 0" : "=v"(zz)); u32x2 z; z.x = zz; z.y = zz; *(LAS u32x2*)(TT + (tg >> 3) * TLD + 32 + 4 * (tg & 7)) = z; }
    lds_barrier();
    { const int qi = wg >> 1, qj = wg & 1, r16 = lane & 15, g4 = lane >> 4; f32x4 pc = {0.f, 0.f, 0.f, 0.f}; float av[8], bw[8];
#pragma unroll
        for (int kk = 0; kk < 8; ++kk) { av[kk] = AM[(32 + 16 * qi + r16) * 68 + 4 * kk + g4]; bw[kk] = TD0[(4 * kk + g4) * 48 + 16 * qj + r16]; }
        __builtin_amdgcn_sched_barrier(0);
#pragma unroll
        for (int kk = 0; kk < 8; ++kk) pc = __builtin_amdgcn_mfma_f32_16x16x4f32(av[kk], bw[kk], pc, 0, 0, 0);
#pragma unroll
        for (int r = 0; r < 4; ++r) PM[(16 * qi + 4 * g4 + r) * 48 + 16 * qj + r16] = pc[r]; }
    lds_barrier();
    { const int qi = wg >> 1, qj = wg & 1, r16 = lane & 15, g4 = lane >> 4; f32x4 pc = {0.f, 0.f, 0.f, 0.f}; float av[8], bw[8];
#pragma unroll
        for (int kk = 0; kk < 8; ++kk) { av[kk] = TD1[(16 * qi + r16) * 36 + 4 * kk + g4]; bw[kk] = PM[(4 * kk + g4) * 48 + 16 * qj + r16]; }
        __builtin_amdgcn_sched_barrier(0);
#pragma unroll
        for (int kk = 0; kk < 8; ++kk) pc = __builtin_amdgcn_mfma_f32_16x16x4f32(av[kk], bw[kk], pc, 0, 0, 0);
#pragma unroll
        for (int r = 0; r < 4; ++r) TT[(32 + 16 * qi + 4 * g4 + r) * TLD + 16 * qj + r16] = (bf16_t)(pk2(-pc[r], 0.f) & 0xffffu); }
    lds_barrier();
    { const int which = wg >> 1, mt = wg & 1, hh = lane >> 5;
#pragma unroll
        for (int nt = 0; nt < 2; ++nt) { const int dc = 32 * nt + (lane & 31);
            const f32x16 a = mm_tile<false, true>(TT, which ? P1 : P0, 32 * mt, 32 * nt, lane);
            LAS bf16_t* dst = (which ? UT : WT) + dc * TLD; const int sw = tsw(dc);
#pragma unroll
            for (int g = 0; g < 4; ++g) { u32x2 w; w.x = pk2(a[4 * g], a[4 * g + 1]); w.y = pk2(a[4 * g + 2], a[4 * g + 3]); *(LAS u32x2*)(dst + ((32 * mt + 8 * g + 4 * hh) ^ sw)) = w; } } }
    lds_barrier();
#pragma unroll
    for (int h2 = 0; h2 < 2; ++h2) { const int i = ia + 32 * h2; const float gci = h2 ? gc1 : gc0, eg = __expf(gci), ekd = __expf(gcl - gci); u32x4 wqd;
#pragma unroll
        for (int j = 0; j < 4; ++j) wqd[j] = pk2(q[h2][2 * j] * eg, q[h2][2 * j + 1] * eg);
        *(LAS u32x4*)(P1 + i * TLD + 8 * p) = wqd;
#pragma unroll
        for (int j = 0; j < 8; ++j) { const int d = 8 * p + j; P0[d * TLD + (i ^ tsw(d))] = (bf16_t)(pk2(k[h2][j] * ekd, 0.f) & 0xffffu); } }
    lds_barrier();
    if (pu_next >= 0) gdn_prep_loads(args, c, pu_next, in);
    { const int hh = lane >> 5, rr = lane & 31;
        if (wg == 0) {
#pragma unroll
            for (int t4 = 0; t4 < 4; ++t4) { const int mtb = t4 >> 1, nta = t4 & 1; const f32x16 a = mm_tile<true, true>(WT, P0, 32 * mtb, 32 * nta, lane);
                f32x16 na; for (int r = 0; r < 16; ++r) na[r] = -a[r];
                *(bf16x8*)(G + (size_t)((nta * 4 + 2 * mtb) * 64 + lane) * 16) = pack8<0>(na); *(bf16x8*)(G + (size_t)((nta * 4 + 2 * mtb + 1) * 64 + lane) * 16) = pack8<1>(na); }
        } else if (wg == 1) {
#pragma unroll
            for (int t4 = 0; t4 < 4; ++t4) { const int mta = t4 >> 1, nte = t4 & 1; const f32x16 a = mm_tile<true, true>(P0, UT, 32 * mta, 32 * nte, lane);
                bf16x8* dp = (bf16x8*)(G + 8192 + (size_t)((nte * 2 + mta) * 64 + lane) * 32); dp[0] = pack8<0>(a); dp[1] = pack8<1>(a); }
        } else if (wg == 2) {
#pragma unroll
            for (int t4 = 0; t4 < 4; ++t4) { const int mtb = t4 >> 1, nti = t4 & 1; const f32x16 a = mm_tile<true, false>(WT, INTRA, 32 * mtb, 32 * nti, lane);
                f32x16 qe; const LAS bf16_t* qd = P1 + (32 * nti + rr) * TLD + 32 * mtb + 4 * hh;
#pragma unroll
                for (int g = 0; g < 4; ++g) { const u32x2 w = *(const LAS u32x2*)(qd + 8 * g); qe[4 * g] = bflo(w.x) - a[4 * g]; qe[4 * g + 1] = bfhi(w.x) - a[4 * g + 1]; qe[4 * g + 2] = bflo(w.y) - a[4 * g + 2]; qe[4 * g + 3] = bfhi(w.y) - a[4 * g + 3]; }
                *(bf16x8*)(G + 16384 + (size_t)((nti * 4 + 2 * mtb) * 64 + lane) * 16) = pack8<0>(qe); *(bf16x8*)(G + 16384 + (size_t)((nti * 4 + 2 * mtb + 1) * 64 + lane) * 16) = pack8<1>(qe); }
        } else {
#pragma unroll
            for (int t4 = 0; t4 < 4; ++t4) { const int mti = t4 >> 1, nte = t4 & 1; const f32x16 a = mm_tile<false, true>(INTRA, UT, 32 * mti, 32 * nte, lane);
                bf16x8* dp = (bf16x8*)(G + 24576) + (size_t)((nte * 2 + mti) * 2) * 64 + lane; dp[0] = pack8<0>(a); dp[64] = pack8<1>(a); }
            if (lane == 0) *(float*)(G + 40960) = __expf(gcl);
        } }
    if (pu_next >= 0) gdn_prep_put_cw(L0, c, in);
    lds_barrier();
}

DI void pv_accum(const f32x16 (&acc)[2][2], f32x16 (&o)[2][2], const LAS bf16_t* Vt, int lane) {
    const int r = lane & 31, hh = lane >> 5;
#pragma unroll
    for (int mt = 0; mt < 2; ++mt) {
        {   const bf16x8 p0 = pack8<0>(acc[mt][0]), p1 = pack8<0>(acc[mt][1]);
#pragma unroll
            for (int mo = 0; mo < 2; ++mo) { const LAS bf16_t* s = Vt + (32 * mo + r) * TLD; const int c0 = (32 * mt + 4 * hh) ^ tsw(32 * mo + r);
                const u32x2 lo = *(const LAS u32x2*)(s + c0), hi = *(const LAS u32x2*)(s + (c0 ^ 8)); u32x4 w; w.x = lo.x; w.y = lo.y; w.z = hi.x; w.w = hi.y; const bf16x8 vf = __builtin_bit_cast(bf16x8, w);
                o[mo][0] = MFMA32(vf, p0, o[mo][0]); o[mo][1] = MFMA32(vf, p1, o[mo][1]); } }
        {   const bf16x8 p0 = pack8<1>(acc[mt][0]), p1 = pack8<1>(acc[mt][1]);
#pragma unroll
            for (int mo = 0; mo < 2; ++mo) { const LAS bf16_t* s = Vt + (32 * mo + r) * TLD; const int c0 = (32 * mt + 16 + 4 * hh) ^ tsw(32 * mo + r);
                const u32x2 lo = *(const LAS u32x2*)(s + c0), hi = *(const LAS u32x2*)(s + (c0 ^ 8)); u32x4 w; w.x = lo.x; w.y = lo.y; w.z = hi.x; w.w = hi.y; const bf16x8 vf = __builtin_bit_cast(bf16x8, w);
                o[mo][0] = MFMA32(vf, p0, o[mo][0]); o[mo][1] = MFMA32(vf, p1, o[mo][1]); } }
    }
}
template <class F> DI void load_v(u32x4 (&vr)[8], int lane, F vrow) {
#pragma unroll
    for (int it = 0; it < 8; ++it) { const int id = it * 64 + lane, key = id >> 3, part = id & 7; vr[it] = *(const u32x4*)(vrow(key) + 8 * part); }
}
DI void put_vt(LAS bf16_t* Vt, int lane, const u32x4 (&vr)[8]) {
#pragma unroll
    for (int it = 0; it < 8; ++it) { const int id = it * 64 + lane, key = id >> 3, part = id & 7; const u32x4 w = vr[it];
#pragma unroll
        for (int j = 0; j < 4; ++j) { const int d0 = 8 * part + 2 * j, ks_ = key ^ tsw(d0); Vt[d0 * TLD + ks_] = (bf16_t)(w[j] & 0xffffu); Vt[(d0 + 1) * TLD + ks_] = (bf16_t)(w[j] >> 16); } }
}
DI void write_o_slot(LAS float* SL, const f32x16 (&o)[2][2], int lane) {
    const int r = lane & 31, hh = lane >> 5;
#pragma unroll
    for (int mo = 0; mo < 2; ++mo)
#pragma unroll
        for (int nt = 0; nt < 2; ++nt)
#pragma unroll
            for (int g = 0; g < 4; ++g) { f32x4 v; v[0] = o[mo][nt][4 * g]; v[1] = o[mo][nt][4 * g + 1]; v[2] = o[mo][nt][4 * g + 2]; v[3] = o[mo][nt][4 * g + 3];
                *(LAS f32x4*)(SL + (32 * nt + r) * 68 + 32 * mo + 8 * g + 4 * hh) = v; }
}
DI void add_o_slot(const LAS float* SL, f32x16 (&o)[2][2], int lane) {
    const int r = lane & 31, hh = lane >> 5;
#pragma unroll
    for (int mo = 0; mo < 2; ++mo)
#pragma unroll
        for (int nt = 0; nt < 2; ++nt)
#pragma unroll
            for (int g = 0; g < 4; ++g) { const f32x4 v = *(const LAS f32x4*)(SL + (32 * nt + r) * 68 + 32 * mo + 8 * g + 4 * hh);
                o[mo][nt][4 * g] += v[0]; o[mo][nt][4 * g + 1] += v[1]; o[mo][nt][4 * g + 2] += v[2]; o[mo][nt][4 * g + 3] += v[3]; }
}

constexpr int WAREA = 10240;
DI void osm_update(f32x16 (&acc)[2][2], f32x16 (&o)[2][2], float (&m)[2], float (&l)[2]) {
#pragma unroll
    for (int nt = 0; nt < 2; ++nt) { float mx = -1e30f;
#pragma unroll
        for (int mt = 0; mt < 2; ++mt)
#pragma unroll
            for (int g = 0; g < 16; ++g) mx = fmaxf(mx, acc[mt][nt][g]);
        mx = fmaxf(mx, __shfl_xor(mx, 32));
        const float mn = fmaxf(m[nt], mx), sc = __expf(m[nt] - mn); float sm = 0.f;
#pragma unroll
        for (int mt = 0; mt < 2; ++mt)
#pragma unroll
            for (int g = 0; g < 16; ++g) { const float pz = __expf(acc[mt][nt][g] - mn); acc[mt][nt][g] = pz; sm += pz; }
        sm += __shfl_xor(sm, 32);
        l[nt] = l[nt] * sc + sm; m[nt] = mn;
#pragma unroll
        for (int g = 0; g < 16; ++g) { o[0][nt][g] *= sc; o[1][nt][g] *= sc; } }
}
template <class F> DI void store_o_rows(LAS bf16_t* T, const f32x16 (&o)[2][2], const float (&scale)[2], int lane, F rowp) {
    const int r = lane & 31, hh = lane >> 5;
#pragma unroll
    for (int mo = 0; mo < 2; ++mo)
#pragma unroll
        for (int nt = 0; nt < 2; ++nt)
#pragma unroll
            for (int g = 0; g < 4; ++g) { u32x2 w; w.x = pk2(o[mo][nt][4 * g] * scale[nt], o[mo][nt][4 * g + 1] * scale[nt]); w.y = pk2(o[mo][nt][4 * g + 2] * scale[nt], o[mo][nt][4 * g + 3] * scale[nt]);
                *(LAS u32x2*)(T + (32 * nt + r) * TLD + 32 * mo + 8 * g + 4 * hh) = w; }
    asm volatile("s_waitcnt lgkmcnt(0)" ::: "memory");
#pragma unroll
    for (int it = 0; it < 8; ++it) { const int id = it * 64 + lane, q = id >> 3, part = id & 7; *(u32x4*)(rowp(q) + 8 * part) = *(const LAS u32x4*)(T + q * TLD + 8 * part); }
    asm volatile("s_waitcnt lgkmcnt(0)" ::: "memory");
}
DI void na_wave_unit(KArgs args, LAS unsigned char* L, const Ctx& c, int u, int lane, int wave) {
    const int l = c.layer, head = u & 3, gr = u >> 2, rows = c.seqlen >> 6, seq = gr / rows, r = gr % rows;
    int rs = r - 4; rs = rs < 0 ? 0 : (rs > rows - 8 ? rows - 8 : rs);
    const bf16_t* PROJ = BIGP(bf16_t, B_PROJ);
    const size_t tq0 = (size_t)seq * c.seqlen + (size_t)r * 64;
    LAS bf16_t* Vt = (LAS bf16_t*)(L + wave * WAREA);
    LAS float* BIAS = (LAS float*)(L + wave * WAREA + 9216);
    const int rr = lane & 31, hh = lane >> 5;
#pragma unroll
    for (int w = 0; w < 4; ++w) { const int idx = w * 64 + lane, kw = idx >> 5, dc = idx & 31;
        if (dc < 31) BIAS[idx] = args->in[3][(((size_t)l * 4 + head) * 15 + (rs + kw - r + 7)) * 31 + dc]; }
    bf16x8 qf[2][4];
#pragma unroll
    for (int nt = 0; nt < 2; ++nt)
#pragma unroll
        for (int ks = 0; ks < 4; ++ks) qf[nt][ks] = *(const bf16x8*)(PROJ + (tq0 + 32 * nt + rr) * NPROJ + C_QA + 64 * head + 16 * ks + 8 * hh);
    f32x16 o[2][2]; o[0][0] = zero16(); o[0][1] = zero16(); o[1][0] = zero16(); o[1][1] = zero16();
    float m[2] = {-1e30f, -1e30f}, ls[2] = {0.f, 0.f};
    for (int w = 0; w < 8; ++w) {
        const size_t tk0 = (size_t)seq * c.seqlen + (size_t)(rs + w) * 64;
        u32x4 vr[8]; bf16x8 kf[2][4];
        load_v(vr, lane, [&](int key) { return PROJ + (tk0 + key) * NPROJ + C_VA + 64 * head; });
#pragma unroll
        for (int mt = 0; mt < 2; ++mt)
#pragma unroll
            for (int ks = 0; ks < 4; ++ks) kf[mt][ks] = *(const bf16x8*)(PROJ + (tk0 + 32 * mt + rr) * NPROJ + C_KA + 64 * head + 16 * ks + 8 * hh);
        __builtin_amdgcn_sched_barrier(0);
        asm volatile("s_waitcnt lgkmcnt(0)" ::: "memory");
        put_vt(Vt, lane, vr);
        f32x16 acc[2][2]; acc[0][0] = zero16(); acc[0][1] = zero16(); acc[1][0] = zero16(); acc[1][1] = zero16();
#pragma unroll
        for (int mt = 0; mt < 2; ++mt)
#pragma unroll
            for (int ks = 0; ks < 4; ++ks) { acc[mt][0] = MFMA32(kf[mt][ks], qf[0][ks], acc[mt][0]); acc[mt][1] = MFMA32(kf[mt][ks], qf[1][ks], acc[mt][1]); }
        asm volatile("s_waitcnt lgkmcnt(0)" ::: "memory");
        const LAS float* brow = BIAS + w * 32;
#pragma unroll
        for (int nt = 0; nt < 2; ++nt) { const int qc = 32 * nt + rr; int ws = qc - 8; ws = ws < 0 ? 0 : (ws > 48 ? 48 : ws);
#pragma unroll
            for (int mt = 0; mt < 2; ++mt) {
                const volatile LAS float* bp = brow + (32 * mt + 4 * hh - qc + 15); float bv[16];
#pragma unroll
                for (int g = 0; g < 16; ++g) { const bool live = (mt == nt) || (nt == 0 ? g < 4 : g >= 12);
                    bv[g] = live ? bp[(g & 3) + 8 * (g >> 2)] : 0.f; }
#pragma unroll
                for (int g = 0; g < 16; ++g) { const bool live = (mt == nt) || (nt == 0 ? g < 4 : g >= 12); const int kc = 32 * mt + crow(g, hh); const bool ok = live && (kc >= ws) && (kc < ws + 16);
                    acc[mt][nt][g] = ok ? acc[mt][nt][g] * 0.125f + bv[g] : -1e30f; } } }
        osm_update(acc, o, m, ls);
        pv_accum(acc, o, Vt, lane);
    }
    asm volatile("s_waitcnt lgkmcnt(0)" ::: "memory");
    const float sc[2] = {frcp(ls[0]), frcp(ls[1])};
    store_o_rows(Vt, o, sc, lane, [&](int q) { return BIGP(bf16_t, B_ONA) + (tq0 + q) * 768 + 64 * head; });
}
struct RopeCS { f32x4 v[2][4]; };
DI void rope_load(RopeCS& t, const float* cs, int hh) {
#pragma unroll
    for (int ks = 0; ks < 2; ++ks) { const float* cp = cs + 16 * ks + 8 * hh; t.v[ks][0] = *(const f32x4*)cp; t.v[ks][1] = *(const f32x4*)(cp + 4); t.v[ks][2] = *(const f32x4*)(cp + 32); t.v[ks][3] = *(const f32x4*)(cp + 36); }
}
DI void rope_frag4(bf16x8 (&f)[4], const RopeCS& t) {
#pragma unroll
    for (int ks = 0; ks < 2; ++ks) {
        const f32x4 c0 = t.v[ks][0], c1 = t.v[ks][1], s0 = t.v[ks][2], s1 = t.v[ks][3];
        const u32x4 a = __builtin_bit_cast(u32x4, f[ks]), b = __builtin_bit_cast(u32x4, f[ks + 2]); u32x4 ra, rb;
#pragma unroll
        for (int j = 0; j < 4; ++j) { const float cl = (j < 2) ? c0[2 * j] : c1[2 * j - 4], ch = (j < 2) ? c0[2 * j + 1] : c1[2 * j - 3];
            const float sl = (j < 2) ? s0[2 * j] : s1[2 * j - 4], sh = (j < 2) ? s0[2 * j + 1] : s1[2 * j - 3];
            const float x1l = bflo(a[j]), x1h = bfhi(a[j]), x2l = bflo(b[j]), x2h = bfhi(b[j]);
            ra[j] = pk2(x1l * cl - x2l * sl, x1h * ch - x2h * sh); rb[j] = pk2(x1l * sl + x2l * cl, x1h * sh + x2h * ch); }
        f[ks] = __builtin_bit_cast(bf16x8, ra); f[ks + 2] = __builtin_bit_cast(bf16x8, rb); }
}
DI void dil_wave_unit(KArgs args, LAS unsigned char* L, const Ctx& c, int u, int lane, int wave) {
    const int hd = u & 1, uu = u >> 1, upg = c.stok >> 6, g = uu / upg, v = uu % upg, ups = c.seqlen >> 6, seq = v / ups, wq = v % ups;
    const int dsh = 2 * g, dd = 1 << dsh, nb = ups >> dsh, cls = wq / nb, jb = wq % nb, head = 2 * g + hd;
    const bf16_t* PROJ = BIGP(bf16_t, B_PROJ); const float* CS = WSP(float, WS_CS);
    const size_t sb = (size_t)seq * c.seqlen;
    const int rr = lane & 31, hh = lane >> 5;
    LAS bf16_t* Vt = (LAS bf16_t*)(L + wave * WAREA);
    bf16x8 qf[2][4];
#pragma unroll
    for (int nt = 0; nt < 2; ++nt) { const int pos = cls + dd * (64 * jb + 32 * nt + rr);
#pragma unroll
        for (int ks = 0; ks < 4; ++ks) qf[nt][ks] = *(const bf16x8*)(PROJ + (sb + pos) * NPROJ + C_QD + 64 * head + 16 * ks + 8 * hh);
        RopeCS tq; rope_load(tq, CS + (size_t)pos * 64, hh); __builtin_amdgcn_sched_barrier(0);
        rope_frag4(qf[nt], tq); }
    f32x16 o[2][2]; o[0][0] = zero16(); o[0][1] = zero16(); o[1][0] = zero16(); o[1][1] = zero16();
    float m[2] = {-1e30f, -1e30f}, ls[2] = {0.f, 0.f};
    for (int kt = 0; kt < 3; ++kt) { const int kj = jb - 1 + kt;
        if (kj < 0 || kj >= nb) continue;
        u32x4 vr[8]; bf16x8 kfa[2][4];
        load_v(vr, lane, [&](int key) { return PROJ + (sb + cls + (size_t)dd * (64 * kj + key)) * NPROJ + C_VD + 64 * head; });
#pragma unroll
        for (int mt = 0; mt < 2; ++mt) { const int pos = cls + dd * (64 * kj + 32 * mt + rr);
#pragma unroll
            for (int ks = 0; ks < 4; ++ks) kfa[mt][ks] = *(const bf16x8*)(PROJ + (sb + pos) * NPROJ + C_KD + 64 * head + 16 * ks + 8 * hh); }
        __builtin_amdgcn_sched_barrier(0);
        asm volatile("s_waitcnt lgkmcnt(0)" ::: "memory");
        put_vt(Vt, lane, vr);
        f32x16 acc[2][2]; acc[0][0] = zero16(); acc[0][1] = zero16(); acc[1][0] = zero16(); acc[1][1] = zero16();
#pragma unroll
        for (int mt = 0; mt < 2; ++mt) {
            RopeCS tk; rope_load(tk, CS + (size_t)(cls + dd * (64 * kj + 32 * mt + rr)) * 64, hh); __builtin_amdgcn_sched_barrier(0);
            rope_frag4(kfa[mt], tk);
#pragma unroll
            for (int ks = 0; ks < 4; ++ks) { acc[mt][0] = MFMA32(kfa[mt][ks], qf[0][ks], acc[mt][0]); acc[mt][1] = MFMA32(kfa[mt][ks], qf[1][ks], acc[mt][1]); } }
#pragma unroll
        for (int nt = 0; nt < 2; ++nt) { const int qc = 32 * nt + rr;
#pragma unroll
            for (int mt = 0; mt < 2; ++mt)
#pragma unroll
                for (int gg = 0; gg < 16; ++gg) { const int kc = 32 * mt + crow(gg, hh); const bool ok = (kt == 1) || (kt == 0 ? (kc >= qc) : (kc <= qc));
                    acc[mt][nt][gg] = ok ? acc[mt][nt][gg] * 0.125f : -1e30f; } }
        osm_update(acc, o, m, ls);
        pv_accum(acc, o, Vt, lane);
    }
    asm volatile("s_waitcnt lgkmcnt(0)" ::: "memory");
    bf16_t* DP = BIGP(bf16_t, B_DILP); float* DM = BIGP(float, B_DILM);
    const float one[2] = {1.f, 1.f};
    store_o_rows(Vt, o, one, lane, [&](int q) { return DP + ((((size_t)g * SLABMAX + sb + cls + (size_t)dd * (64 * jb + q)) * 2 + hd)) * 64; });
    if (hh == 0) {
#pragma unroll
        for (int nt = 0; nt < 2; ++nt) { const size_t base = (((size_t)g * SLABMAX + sb + cls + (size_t)dd * (64 * jb + 32 * nt + rr)) * 2 + hd); DM[base * 2] = m[nt]; DM[base * 2 + 1] = ls[nt]; } }
}

DI void phase_mix_a(KArgs args, LAS unsigned char* L, const Ctx& c) {
    const int N_PREP = (c.stok >> 6) * 6;
    PrepIn in; if (c.bid < N_PREP) { gdn_prep_loads(args, c, c.bid, in); gdn_prep_put_cw(L, c, in); lds_barrier(); }
    for (int u = c.bid; u < N_PREP; u += c.G) gdn_prep_pair(args, L, c, u, in, u + c.G < N_PREP ? u + c.G : -1);
}
DI void attn_wave_units(KArgs args, LAS unsigned char* L, const Ctx& c) {
    int tid = c.tid; asm volatile("" : "+v"(tid)); const int lane = tid & 63, wave = __builtin_amdgcn_readfirstlane(tid >> 6);
    const int nch_ = c.stok >> 6, N_NA = nch_ * 4, N_DIL = nch_ * 6;
    unsigned* q = (unsigned*)(c.ws + WS_CTL) + 32768 + 128 * (c.layer * 4 + c.slab);
    for (;;) { unsigned u = 0; if (lane == 0) u = __hip_atomic_fetch_add(q, 1u, __ATOMIC_RELAXED, __HIP_MEMORY_SCOPE_AGENT);
        u = (unsigned)__builtin_amdgcn_readfirstlane((int)u); if (u >= (unsigned)N_NA) break; na_wave_unit(args, L, c, (int)u, lane, wave); }
    int tid2 = c.tid; asm volatile("" : "+v"(tid2)); const int lane2 = tid2 & 63, wave2 = __builtin_amdgcn_readfirstlane(tid2 >> 6);
    for (;;) { unsigned u = 0; if (lane2 == 0) u = __hip_atomic_fetch_add(q + 64, 1u, __ATOMIC_RELAXED, __HIP_MEMORY_SCOPE_AGENT);
        u = (unsigned)__builtin_amdgcn_readfirstlane((int)u); if (u >= (unsigned)N_DIL) break; dil_wave_unit(args, L, c, (int)u, lane2, wave2); }
}

DI void phase_select(KArgs args, LAS unsigned char* L, const Ctx& c, int inst);
DI void phase_scan(KArgs args, LAS unsigned char* L, const Ctx& c) {
    if (c.slab == NSLAB - 1 && c.bid >= 24 && c.bid < 40) { phase_select(args, L, c, c.bid - 24); return; }
    const int nwu = c.nseq * 24, wu = c.bid;
    if (wu < nwu && c.wave == 0) {
        const int lane = c.lane;
        const int chain = wu >> 1, nt = wu & 1, seq = chain / 12, rem = chain % 12, head = rem >> 1, dir = rem & 1;
        const int nch = c.seqlen >> 6, gch0 = seq * nch;
        unsigned char* GS = BIGP(unsigned char, B_GSCR);
        f32x16 S[2]; S[0] = zero16(); S[1] = zero16();
        bf16x8 A[2][2][4]; u32x4 cm[2][2][2];
        const long gstep = (long)(dir ? -1 : 1) * 12 * GSTRIDE;
        const unsigned char* G0 = GS + (size_t)(((gch0 + (dir ? nch - 1 : 0)) * 6 + head) * 2 + dir) * GSTRIDE;
        unsigned char* Gs = (unsigned char*)G0;
        float glv[4];
#pragma unroll
        for (int q = 0; q < 4; ++q) { const int sq = q * 64 + lane; glv[q] = *(const float*)(G0 + (long)(sq < nch ? sq : nch - 1) * gstep + 40960); }
        LAS unsigned char* RING = L + 81920;
        int dslot = 0, rslot = 0, dstage = 0;
#define SCAN_DMA() do { const unsigned char* gp = G0 + (long)(dstage < nch ? dstage : nch - 1) * gstep; LAS unsigned char* sl = RING + dslot * 12288; \
            _Pragma("unroll") for (int j = 0; j < 8; ++j) __builtin_amdgcn_global_load_lds((const unsigned*)(gp + (size_t)(j * 64 + lane) * 16), (LAS unsigned*)(sl + j * 1024), 16, 0, 0); \
            _Pragma("unroll") for (int j = 0; j < 4; ++j) __builtin_amdgcn_global_load_lds((const unsigned*)(gp + 8192 + (size_t)((nt * 2 + (j >> 1)) * 64 + lane) * 32 + (j & 1) * 16), (LAS unsigned*)(sl + 8192 + j * 1024), 16, 0, 0); \
            ++dstage; dslot = dslot == 4 ? 0 : dslot + 1; } while (0)
#define SCAN_LOAD(B) do { const LAS unsigned char* sl = RING + rslot * 12288 + lane * 16; \
            _Pragma("unroll") for (int mt = 0; mt < 2; ++mt) { _Pragma("unroll") for (int ks = 0; ks < 4; ++ks) A[B][mt][ks] = *(const LAS bf16x8*)(sl + (mt * 4 + ks) * 1024); \
                cm[B][mt][0] = *(const LAS u32x4*)(sl + 8192 + (mt * 2) * 1024); cm[B][mt][1] = *(const LAS u32x4*)(sl + 8192 + (mt * 2 + 1) * 1024); } \
            rslot = rslot == 4 ? 0 : rslot + 1; } while (0)
#define SCAN_STEP(B, st) do { const bf16x8 b0 = pack8<0>(S[0]), b1 = pack8<1>(S[0]), b2 = pack8<0>(S[1]), b3 = pack8<1>(S[1]); f32x16 nw[2]; \
            { bf16x8* St = (bf16x8*)(Gs + 32768) + (nt * 4) * 64 + lane; St[0] = b0; St[64] = b1; St[128] = b2; St[192] = b3; }     \
            const int sq_ = (st) >> 6; const float gsel = sq_ == 0 ? glv[0] : (sq_ == 1 ? glv[1] : (sq_ == 2 ? glv[2] : glv[3])); \
            const float glc = __builtin_bit_cast(float, __builtin_amdgcn_readlane(__builtin_bit_cast(int, gsel), (st) & 63)); \
            _Pragma("unroll") for (int mt = 0; mt < 2; ++mt) { \
                _Pragma("unroll") for (int g = 0; g < 8; ++g) { const unsigned wv = (g < 4) ? cm[B][mt][0][g] : cm[B][mt][1][g - 4]; nw[mt][2 * g] = glc * S[mt][2 * g] + bflo(wv); nw[mt][2 * g + 1] = glc * S[mt][2 * g + 1] + bfhi(wv); } \
                nw[mt] = MFMA32(A[B][mt][0], b0, nw[mt]); nw[mt] = MFMA32(A[B][mt][1], b1, nw[mt]); nw[mt] = MFMA32(A[B][mt][2], b2, nw[mt]); nw[mt] = MFMA32(A[B][mt][3], b3, nw[mt]); } \
            S[0] = nw[0]; S[1] = nw[1]; Gs += gstep; } while (0)
        SCAN_DMA(); SCAN_DMA(); SCAN_DMA(); SCAN_DMA(); SCAN_DMA();
        asm volatile("s_waitcnt vmcnt(48)" ::: "memory"); SCAN_LOAD(0);
        asm volatile("s_waitcnt vmcnt(36)" ::: "memory"); SCAN_LOAD(1);
        for (int step = 0; step < nch; step += 2) {
            SCAN_STEP(0, step);     asm volatile("s_waitcnt vmcnt(24)" ::: "memory"); SCAN_LOAD(0); SCAN_DMA();
            SCAN_STEP(1, step + 1); asm volatile("s_waitcnt vmcnt(24)" ::: "memory"); SCAN_LOAD(1); SCAN_DMA();
        }
        asm volatile("s_waitcnt vmcnt(0)" ::: "memory");
#undef SCAN_DMA
#undef SCAN_LOAD
#undef SCAN_STEP
    }
    attn_wave_units(args, L, c);
}

DI void dil_merge(const Ctx& c) {
    { const bf16_t* DP = BIGP(bf16_t, B_DILP); const float* DM = BIGP(float, B_DILM); bf16_t* OD = BIGP(bf16_t, B_ONA) + 256;
        for (int it = c.bid * 512 + c.tid; it < c.stok * 32; it += c.G * 512) { const int tok = it >> 5, part = it & 31;
            u32x4 w = {0u, 0u, 0u, 0u};
            if (part < 16) { const int hd = part >> 3, p = part & 7; float m[3], dn[3];
#pragma unroll
                for (int g = 0; g < 3; ++g) { const size_t b = (((size_t)g * SLABMAX + tok) * 2 + hd); m[g] = DM[b * 2]; dn[g] = DM[b * 2 + 1]; }
                const float M = fmaxf(m[0], fmaxf(m[1], m[2])); float num[8], den = 0.f;
#pragma unroll
                for (int j = 0; j < 8; ++j) num[j] = 0.f;
#pragma unroll
                for (int g = 0; g < 3; ++g) { const float f = __expf(m[g] - M); den += f * dn[g]; const u32x4 a = *(const u32x4*)(DP + (((size_t)g * SLABMAX + tok) * 2 + hd) * 64 + 8 * p);
                    num[0] += f * bflo(a[0]); num[1] += f * bfhi(a[0]); num[2] += f * bflo(a[1]); num[3] += f * bfhi(a[1]); num[4] += f * bflo(a[2]); num[5] += f * bfhi(a[2]); num[6] += f * bflo(a[3]); num[7] += f * bfhi(a[3]); }
                const float inv = frcp(den);
                w.x = pk2(num[0] * inv, num[1] * inv); w.y = pk2(num[2] * inv, num[3] * inv); w.z = pk2(num[4] * inv, num[5] * inv); w.w = pk2(num[6] * inv, num[7] * inv); }
            if (part < 16) *(u32x4*)(OD + (size_t)tok * 768 + 8 * part) = w; } }
}

DI void phase_gdn_out(KArgs args, LAS unsigned char* L, const Ctx& c) {
    dil_merge(c);
    const int lane = c.lane, wave = c.wave, tid = c.tid, l = c.layer;
    const bf16_t* PROJ = BIGP(bf16_t, B_PROJ); unsigned char* GS = BIGP(unsigned char, B_GSCR); bf16_t* OG = BIGP(bf16_t, B_ONA) + 384;
    LAS float* OF = (LAS float*)L;
    const int NU = (c.stok >> 6) * 6; const int dir = wave >> 2, mt = (wave >> 1) & 1, nt = wave & 1, rr = lane & 31, hh = lane >> 5;
    const float* nw = args->in[7] + l * 64 + 8 * (tid & 7); const f32x4 nw0 = *(const f32x4*)nw, nw1 = *(const f32x4*)(nw + 4);
    bf16x8 qa[4], sb_[4]; u32x4 oc0, oc1, zw;
#define GOUT_LOAD(uu) do { const int gch_ = (uu) / 6, head_ = (uu) % 6; const unsigned char* G = GS + (size_t)((gch_ * 6 + head_) * 2 + dir) * GSTRIDE; \
        const bf16_t* Qe = (const bf16_t*)(G + 16384); const u32x4* Oct = (const u32x4*)(G + 24576); const bf16x8* St = (const bf16x8*)(G + 32768); \
        _Pragma("unroll") for (int ks = 0; ks < 4; ++ks) { qa[ks] = *(const bf16x8*)(Qe + (size_t)((mt * 4 + ks) * 64 + lane) * 8); sb_[ks] = St[(nt * 4 + ks) * 64 + lane]; } \
        oc0 = Oct[((nt * 2 + mt) * 2) * 64 + lane]; oc1 = Oct[((nt * 2 + mt) * 2 + 1) * 64 + lane]; \
        zw = *(const u32x4*)(PROJ + ((size_t)gch_ * 64 + (tid >> 3)) * NPROJ + C_ZC + 64 * head_ + 8 * (tid & 7)); } while (0)
    if (c.bid < NU) GOUT_LOAD(c.bid);
    for (int u = c.bid; u < NU; u += c.G) { const int gch = u / 6, head = u % 6;
        bf16x8 qc[4], sc[4]; const u32x4 o0 = oc0, o1 = oc1, zc = zw;
#pragma unroll
        for (int ks = 0; ks < 4; ++ks) { qc[ks] = qa[ks]; sc[ks] = sb_[ks]; }
        { int un = u + c.G; un = un < NU ? un : u; GOUT_LOAD(un); }
        __builtin_amdgcn_sched_barrier(0);
        {   f32x16 acc = zero16();
#pragma unroll
            for (int ks = 0; ks < 4; ++ks) acc = MFMA32(qc[ks], sc[ks], acc);
            const int e = 32 * nt + rr;
#pragma unroll
            for (int g = 0; g < 4; ++g) { u32x2 w; w.x = (g == 0) ? o0.x : (g == 1) ? o0.z : (g == 2) ? o1.x : o1.z; w.y = (g == 0) ? o0.y : (g == 1) ? o0.w : (g == 2) ? o1.y : o1.w;
                const float v0 = acc[4 * g] + bflo(w.x), v1 = acc[4 * g + 1] + bfhi(w.x), v2 = acc[4 * g + 2] + bflo(w.y), v3 = acc[4 * g + 3] + bfhi(w.y);
                const int i0 = 32 * mt + 8 * g + 4 * hh;
#pragma unroll
                for (int j = 0; j < 4; ++j) { const int ii = i0 + j, tl = dir ? 63 - ii : ii; OF[(dir * 64 + tl) * 68 + e] = (j == 0) ? v0 : (j == 1) ? v1 : (j == 2) ? v2 : v3; } } }
        lds_barrier();
        { const int i = tid >> 3, p = tid & 7; const size_t tok = (size_t)gch * 64 + i;
            const LAS float* a = OF + i * 68 + 8 * p; const LAS float* b = OF + (64 + i) * 68 + 8 * p;
            float ov[8]; float ss = 0.f;
#pragma unroll
            for (int j = 0; j < 8; ++j) { ov[j] = a[j] + b[j]; ss += ov[j] * ov[j]; }
            ss += __shfl_xor(ss, 1); ss += __shfl_xor(ss, 2); ss += __shfl_xor(ss, 4);
            const float rs = frsq(ss * (1.0f / 64.0f) + NORM_EPS);
            float r[8];
#pragma unroll
            for (int j = 0; j < 4; ++j) { const float n0 = j < 2 ? nw0[2 * j] : nw1[2 * j - 4], n1 = j < 2 ? nw0[2 * j + 1] : nw1[2 * j - 3];
                r[2 * j] = ov[2 * j] * rs * n0 * siluf_(bflo(zc[j])); r[2 * j + 1] = ov[2 * j + 1] * rs * n1 * siluf_(bfhi(zc[j])); }
            u32x4 w; w.x = pk2(r[0], r[1]); w.y = pk2(r[2], r[3]); w.z = pk2(r[4], r[5]); w.w = pk2(r[6], r[7]);
            *(u32x4*)(OG + tok * 768 + 64 * head + 8 * p) = w; }
        lds_barrier();
    }
#undef GOUT_LOAD
}

DI void phase_ln1(KArgs args, LAS unsigned char* L, const Ctx& c) {
    const int lane = c.lane, l = c.layer;
    LAS float* WR = (LAS float*)L;
    { const float* wr = args->in[14] + (size_t)l * D * 16;
        for (int i = c.tid; i < D * 16; i += 512) { const int col = i >> 4, e = i & 15, j = col >> 8, ln = (col >> 2) & 63, q = col & 3; WR[((j * 4 + q) * 64 + ln) * 20 + e] = wr[i]; } }
    __syncthreads();
    const float* g1 = args->in[12] + l * D; const float* b1 = args->in[13] + l * D;
    f32x4 gv[4], bv[4];
#pragma unroll
    for (int j = 0; j < 4; ++j) { gv[j] = *(const f32x4*)(g1 + 4 * lane + 256 * j); bv[j] = *(const f32x4*)(b1 + 4 * lane + 256 * j); }
    float* AFF = WSP(float, WS_AFF); int* SLOT = WSP(int, WS_SLOT); bf16_t* XB = WSP(bf16_t, WS_XB);
    u32x2 nv[4];
    { const int rl0 = c.bid * 8 + c.wave; if (rl0 < c.stok) { const bf16_t* hp = (const bf16_t*)c.out + ((size_t)c.sbase + rl0) * D;
#pragma unroll
        for (int j = 0; j < 4; ++j) nv[j] = *(const u32x2*)(hp + 4 * lane + 256 * j); } }
    for (int rl = c.bid * 8 + c.wave; rl < c.stok; rl += c.G * 8) { const size_t tok = (size_t)c.sbase + rl;
        const bf16_t* hr = (const bf16_t*)c.out + tok * D; f32x4 v[4]; float s = 0.f;
#pragma unroll
        for (int j = 0; j < 4; ++j) { v[j][0] = bflo(nv[j].x); v[j][1] = bfhi(nv[j].x); v[j][2] = bflo(nv[j].y); v[j][3] = bfhi(nv[j].y); s += (v[j][0] + v[j][1]) + (v[j][2] + v[j][3]); }
        if (rl + c.G * 8 < c.stok) { const bf16_t* hp = hr + (size_t)c.G * 8 * D;
#pragma unroll
            for (int j = 0; j < 4; ++j) nv[j] = *(const u32x2*)(hp + 4 * lane + 256 * j); }
        const float mean = wave_sum(s) * (1.0f / D); float s2 = 0.f;
#pragma unroll
        for (int j = 0; j < 4; ++j) { v[j] = v[j] - mean; s2 += (v[j][0] * v[j][0] + v[j][1] * v[j][1]) + (v[j][2] * v[j][2] + v[j][3] * v[j][3]); }
        const float rstd = frsq(wave_sum(s2) * (1.0f / D) + LN_EPS);
        float lg[16];
#pragma unroll
        for (int e = 0; e < 16; ++e) lg[e] = 0.f;
#pragma unroll
        for (int j = 0; j < 4; ++j) { v[j] = v[j] * rstd * gv[j] + bv[j];
            if (!c.dry) { u32x2 w; w.x = pk2(v[j][0], v[j][1]); w.y = pk2(v[j][2], v[j][3]); *(u32x2*)(XB + tok * D + 4 * lane + 256 * j) = w; }
#pragma unroll
            for (int q = 0; q < 4; ++q) { const LAS float* wp = WR + ((j * 4 + q) * 64 + lane) * 20; const float xv = v[j][q];
#pragma unroll
                for (int e4 = 0; e4 < 4; ++e4) { const f32x4 w4 = *(const LAS f32x4*)(wp + 4 * e4); lg[4 * e4] += xv * w4[0]; lg[4 * e4 + 1] += xv * w4[1]; lg[4 * e4 + 2] += xv * w4[2]; lg[4 * e4 + 3] += xv * w4[3]; } }
            asm volatile("" ::: "memory"); }
        float mx = -1e30f;
#pragma unroll
        for (int e = 0; e < 16; ++e) { lg[e] = wave_sum(lg[e]); mx = fmaxf(mx, lg[e]); }
        float den = 0.f;
#pragma unroll
        for (int e = 0; e < 16; ++e) { lg[e] = expf(lg[e] - mx); den += lg[e]; }
        float mine = 0.f;
#pragma unroll
        for (int e = 0; e < 16; ++e) mine = (lane == e) ? lg[e] : mine;
        if (lane < 16 && !c.dry) { AFF[(size_t)lane * T_ALL + tok] = mine / den; SLOT[tok * 16 + lane] = -1; }
    }
}
DI void phase_ln2(KArgs args, LAS unsigned char* L, const Ctx& c) {
    const int lane = c.lane, l = c.layer;
    const float* g2 = args->in[18] + l * D; const float* b2 = args->in[19] + l * D;
    f32x4 gv[4], bv[4];
#pragma unroll
    for (int j = 0; j < 4; ++j) { gv[j] = *(const f32x4*)(g2 + 4 * lane + 256 * j); bv[j] = *(const f32x4*)(b2 + 4 * lane + 256 * j); }
    const int* SLOT = WSP(int, WS_SLOT); bf16_t* XB = WSP(bf16_t, WS_XB);
    u32x2 nv[4]; int nsv = -1;
    { const int t0 = c.bid * 8 + c.wave; if (t0 < T_ALL) { const bf16_t* xp = XB + (size_t)t0 * D; nsv = SLOT[(size_t)t0 * 16 + (lane & 15)];
#pragma unroll
        for (int j = 0; j < 4; ++j) nv[j] = *(const u32x2*)(xp + 4 * lane + 256 * j); } }
    for (int t = c.bid * 8 + c.wave; t < T_ALL; t += c.G * 8) { const size_t tok = (size_t)t;
        float* xr = c.out + tok * D; f32x4 v[4];
#pragma unroll
        for (int j = 0; j < 4; ++j) { v[j][0] = bflo(nv[j].x) * ALPHA; v[j][1] = bfhi(nv[j].x) * ALPHA; v[j][2] = bflo(nv[j].y) * ALPHA; v[j][3] = bfhi(nv[j].y) * ALPHA; }
        const int sv = nsv;
        if (t + c.G * 8 < T_ALL) { const bf16_t* xp = XB + (tok + c.G * 8) * D; nsv = SLOT[(tok + c.G * 8) * 16 + (lane & 15)];
#pragma unroll
            for (int j = 0; j < 4; ++j) nv[j] = *(const u32x2*)(xp + 4 * lane + 256 * j); }
        {
            unsigned mk = (unsigned)(__ballot(sv >= 0) & 0xffffull);
            while (mk) { const int e0 = __builtin_ctz(mk); mk &= mk - 1u; const bool two = mk != 0u; const int e1 = two ? __builtin_ctz(mk) : e0; if (two) mk &= mk - 1u;
                const int s0 = __builtin_amdgcn_readlane(sv, e0), s1 = __builtin_amdgcn_readlane(sv, e1);
                const bf16_t* y0 = BIGP(bf16_t, (e0 < 8 ? B_XY0 : B_XY1)) + ((size_t)(e0 & 7) * CAP + s0) * D + 4 * lane;
                const bf16_t* y1 = BIGP(bf16_t, (e1 < 8 ? B_XY0 : B_XY1)) + ((size_t)(e1 & 7) * CAP + s1) * D + 4 * lane;
                u32x2 w0[4], w1[4];
#pragma unroll
                for (int j = 0; j < 4; ++j) { w0[j] = *(const u32x2*)(y0 + 256 * j); w1[j] = *(const u32x2*)(y1 + 256 * j); }
                __builtin_amdgcn_sched_barrier(0);
                const float f1 = two ? 1.0f : 0.0f;
#pragma unroll
                for (int j = 0; j < 4; ++j) { v[j][0] += bflo(w0[j].x); v[j][1] += bfhi(w0[j].x); v[j][2] += bflo(w0[j].y); v[j][3] += bfhi(w0[j].y);
                    v[j][0] += f1 * bflo(w1[j].x); v[j][1] += f1 * bfhi(w1[j].x); v[j][2] += f1 * bflo(w1[j].y); v[j][3] += f1 * bfhi(w1[j].y); } } }
        float s = 0.f;
#pragma unroll
        for (int j = 0; j < 4; ++j) s += (v[j][0] + v[j][1]) + (v[j][2] + v[j][3]);
        const float mean = wave_sum(s) * (1.0f / D); float s2 = 0.f;
#pragma unroll
        for (int j = 0; j < 4; ++j) { v[j] = v[j] - mean; s2 += (v[j][0] * v[j][0] + v[j][1] * v[j][1]) + (v[j][2] * v[j][2] + v[j][3] * v[j][3]); }
        const float rstd = frsq(wave_sum(s2) * (1.0f / D) + LN_EPS);
#pragma unroll
        for (int j = 0; j < 4; ++j) { v[j] = v[j] * rstd * gv[j] + bv[j];
            if (!c.dry) {
                if (l == 1) *(f32x4*)(xr + 4 * lane + 256 * j) = v[j];
                else { u32x2 w; w.x = pk2(v[j][0], v[j][1]); w.y = pk2(v[j][2], v[j][3]); *(u32x2*)(XB + tok * D + 4 * lane + 256 * j) = w;
                    *(unsigned*)(WSP(unsigned char, WS_XB8) + tok * D + 4 * lane + 256 * j) = pk4_fp8(v[j][0], v[j][1], v[j][2], v[j][3]); } } }
    }
}

DI int block_excl_scan(int v, LAS int* tmp, int tid, int& total) {
    const int lane = tid & 63, wave = tid >> 6; int x = v;
#pragma unroll
    for (int o = 1; o < 64; o <<= 1) { const int y = __shfl_up(x, o); if (lane >= o) x += y; }
    __syncthreads();
    if (lane == 63) tmp[wave] = x;
    __syncthreads();
    int base = 0, tot = 0;
#pragma unroll
    for (int w = 0; w < 8; ++w) { const int tw = tmp[w]; if (w < wave) base += tw; tot += tw; }
    total = tot;
    return base + x - v;
}
DI void phase_select(KArgs args, LAS unsigned char* L, const Ctx& c, int inst) {
    if (inst < 0 || inst >= 32) return;
    const int tid = c.tid, grp = inst >> 4, e = inst & 15;
    const int n = grp ? T_S : T_P, t0 = grp ? T_P : 0, C = n >> 3, slot0 = grp ? CAP_P : 0;
    const unsigned* v = (const unsigned*)(WSP(float, WS_AFF) + (size_t)e * T_ALL + t0);
    LAS unsigned* hist = (LAS unsigned*)L; LAS int* sh = (LAS int*)(L + 8192); LAS int* tmp = (LAS int*)(L + 8192 + 64);
    unsigned prefix = 0u; int kk = C, nbin = 0;
    for (int pass = 0; pass < 3; ++pass) {
        const int shift = pass == 0 ? 21 : (pass == 1 ? 10 : 0); const unsigned bmask = pass == 2 ? 1023u : 2047u;
        const unsigned mhi = pass == 0 ? 0u : (pass == 1 ? 0xFFE00000u : 0xFFFFFC00u);
        { unsigned zz; asm volatile("v_mov_b32 %0, 0" : "=v"(zz)); u32x4 z4; z4.x = zz; z4.y = zz; z4.z = zz; z4.w = zz; *(LAS u32x4*)(hist + 4 * tid) = z4; }
        __syncthreads();
        for (int i = tid * 4; i < n; i += 512 * 16) {
            u32x4 x4[4];
#pragma unroll
            for (int k = 0; k < 4; ++k) x4[k] = *(const u32x4*)(v + i + k * 2048);
#pragma unroll
            for (int k = 0; k < 4; ++k)
#pragma unroll
                for (int j = 0; j < 4; ++j) { const unsigned x = x4[k][j]; if ((x & mhi) == prefix) __hip_atomic_fetch_add(&hist[(x >> shift) & bmask], 1u, __ATOMIC_RELAXED, __HIP_MEMORY_SCOPE_WORKGROUP); } }
        __syncthreads();
        {
            const u32x4 hv = *(const LAS u32x4*)(hist + 2044 - 4 * tid); int tot;
            int cum = block_excl_scan((int)(hv[0] + hv[1] + hv[2] + hv[3]), tmp, tid, tot);
            const int c1 = cum + (int)hv.w, c2 = c1 + (int)hv.z, c3 = c2 + (int)hv.y, c4 = c3 + (int)hv.x;
            if (cum < kk && kk <= c4) { const int j = kk <= c1 ? 0 : (kk <= c2 ? 1 : (kk <= c3 ? 2 : 3)); const int cb = kk <= c1 ? cum : (kk <= c2 ? c1 : (kk <= c3 ? c2 : c3));
                sh[0] = 2047 - 4 * tid - j; sh[1] = kk - cb; sh[2] = (j == 0 ? c1 : (j == 1 ? c2 : (j == 2 ? c3 : c4))) - cb; } }
        __syncthreads();
        prefix |= ((unsigned)sh[0]) << shift; kk = sh[1]; nbin = sh[2];
        __syncthreads();
    }
    const unsigned thr = prefix;
    int* IDX = WSP(int, WS_IDX) + e * CAP + slot0;
    LAS int* ctr = sh + 8;
    if (tid == 0) ctr[0] = 0;
    __syncthreads();
    const bool ordered = kk < nbin; int tie_run = 0;
    const int lane = tid & 63; const unsigned long long ltm = (1ull << lane) - 1ull;
    for (int it = 0; it < (n >> 11); it += 4) {
        u32x4 x4[4];
#pragma unroll
        for (int k = 0; k < 4; ++k) x4[k] = *(const u32x4*)(v + (it + k) * 2048 + 4 * tid);
#pragma unroll
        for (int k = 0; k < 4; ++k) { const u32x4 x = x4[k];
            int tie_base = 0;
            if (ordered) { const int tiec = (x[0] == thr) + (x[1] == thr) + (x[2] == thr) + (x[3] == thr); int tot; tie_base = tie_run + block_excl_scan(tiec, tmp, tid, tot); tie_run += tot; }
            bool sj[4]; int off[4], tot4 = 0;
#pragma unroll
            for (int j = 0; j < 4; ++j) { bool s_ = x[j] > thr; if (x[j] == thr) { s_ = !ordered || tie_base < kk; ++tie_base; } sj[j] = s_;
                const unsigned long long m = __ballot(s_); off[j] = tot4 + __popcll(m & ltm); tot4 += __popcll(m); }
            int base = 0; if (lane == 0 && tot4 > 0) base = __hip_atomic_fetch_add(ctr, tot4, __ATOMIC_RELAXED, __HIP_MEMORY_SCOPE_WORKGROUP);
            base = __builtin_amdgcn_readfirstlane(base);
#pragma unroll
            for (int j = 0; j < 4; ++j) if (sj[j]) IDX[base + off[j]] = t0 + (it + k) * 2048 + 4 * tid + j; } }
}
DI void phase_gather(KArgs args, LAS unsigned char* L, const Ctx& c) {
    const int lane = c.lane; const int* IDX = WSP(int, WS_IDX); const bf16_t* XB = WSP(bf16_t, WS_XB);
    float* GATEV = WSP(float, WS_GATEV); int* SLOT = WSP(int, WS_SLOT); const float* AFF = WSP(float, WS_AFF);
    for (int row0 = (c.bid * 8 + c.wave) * 4; row0 < NE * CAP; row0 += c.G * 8 * 4) {
        const int e = row0 / CAP, s0 = row0 % CAP; int t[4]; u32x4 a[4], b[4];
#pragma unroll
        for (int k = 0; k < 4; ++k) t[k] = IDX[row0 + k];
#pragma unroll
        for (int k = 0; k < 4; ++k) { const u32x4* src = (const u32x4*)(XB + (size_t)t[k] * D) + 2 * lane; a[k] = src[0]; b[k] = src[1]; }
        u32x4* dst = (u32x4*)(BIGP(unsigned char, (e < 8 ? B_XY0 : B_XY1)) + ((size_t)(e & 7) * CAP + s0) * D);
#pragma unroll
        for (int k = 0; k < 4; ++k) { u32x4 w;
            w.x = pk4_fp8(bflo(a[k].x), bfhi(a[k].x), bflo(a[k].y), bfhi(a[k].y)); w.y = pk4_fp8(bflo(a[k].z), bfhi(a[k].z), bflo(a[k].w), bfhi(a[k].w));
            w.z = pk4_fp8(bflo(b[k].x), bfhi(b[k].x), bflo(b[k].y), bfhi(b[k].y)); w.w = pk4_fp8(bflo(b[k].z), bfhi(b[k].z), bflo(b[k].w), bfhi(b[k].w));
            dst[k * 64 + lane] = w; }
        if (lane < 4) { const int tt = (lane == 0) ? t[0] : (lane == 1) ? t[1] : (lane == 2) ? t[2] : t[3]; SLOT[(size_t)tt * 16 + e] = s0 + lane; GATEV[row0 + lane] = AFF[(size_t)e * T_ALL + tt]; } }
}

__global__ void __launch_bounds__(512, 2) fwd_kernel(Args args) {
    extern __shared__ __attribute__((aligned(16))) unsigned char lds_raw[];
    LAS unsigned char* L = (LAS unsigned char*)lds_raw;
    Ctx c;
    c.out = args.out; c.ws = args.ws;
    c.tid = threadIdx.x; c.lane = c.tid & 63; c.wave = __builtin_amdgcn_readfirstlane(c.tid >> 6); c.G = gridDim.x; c.bid = blockIdx.x;
    c.layer = 0; c.slab = 0; c.nseq = 8; c.seqlen = 4096; c.stok = 32768; c.sbase = 0; c.dry = 0;
    const int lo = args.ph_lo, hi = args.ph_hi;
    volatile LAS unsigned* MISC = (volatile LAS unsigned*)(L + LDS_MISC);
    if (c.tid < 4) MISC[c.tid] = 0u;
    __syncthreads();
    XcdBarrier bar; bar.bar = (unsigned*)(c.ws + WS_CTL) + 1024; bar.x = 0; bar.st = MISC;
    if (hi - lo > 1) bar = xcd_barrier_post((unsigned*)(c.ws + WS_CTL) + 1024, MISC);
    int pc = 0;
#ifndef PHMASK
#define PHMASK 0xFFFF
#endif
#define PHON(k) (((PHMASK) >> (k)) & 1)
#ifndef REPMASK
#define REPMASK 0x0
#endif
#define PH_BEGIN(k) if (PHON(k) && pc >= lo && pc < hi) { { int tz = threadIdx.x; asm volatile("" : "+v"(tz)); c.tid = tz; c.lane = tz & 63; c.wave = __builtin_amdgcn_readfirstlane(tz >> 6); } KArgs ka = kargs(); c.ws = ka->ws; c.out = ka->out; { int b_ = blockIdx.x, g_ = gridDim.x; asm volatile("" : "+s"(b_), "+s"(g_)); c.bid = b_; c.G = g_; } for (int rep_ = 0; rep_ < (((REPMASK) >> (k)) & 1) + 1; ++rep_) { if (rep_) __syncthreads(); c.dry = (rep_ + 1 < (((REPMASK) >> (k)) & 1) + 1);
#ifndef BARREP
#define BARREP 0
#endif
#define PH_END   } if (pc + 1 < hi) { xcd_barrier(bar); if (BARREP) { xcd_barrier(bar); xcd_barrier(bar); } } else { asm volatile("s_waitcnt vmcnt(0)" ::: "memory"); __syncthreads(); } } ++pc;

    for (int layer = 0; layer < 2; ++layer) {
        c.layer = layer;
        PH_BEGIN(0) phase_weights(ka, L, c); PH_END
        for (int slab = 0; slab < NSLAB; ++slab) {
            c.slab = slab; c.nseq = slab < 2 ? 8 : 1; c.seqlen = slab < 2 ? 4096 : 16384; c.stok = slab < 2 ? 32768 : 16384; c.sbase = slab * 32768; const int stok = c.stok; const size_t sbase = (size_t)c.sbase;
            PH_BEGIN(1) {
                const int swp = (c.bid >> 2) & 1;
                for (int k2 = 0; k2 < 2; ++k2) {
                  if ((k2 ^ swp) == 0) { pg8::Gemm g{WSP(bf16_t, WS_XB) + sbase * D, WSP(bf16_t, WS_WIN), stok, 3584, D}; pg8::StaticOrder S; S.init(stok, 3584, c.G, c.bid);
                    pg8::EpiInProj E{BIGP(bf16_t, B_PROJ), BIGP(float, B_BA)};
                    pg8::gemm_phase<pg8::EpiInProj, pg8::StaticOrder>(L, g, S, E); }
                  else { pg8::Gemm g{(const bf16_t*)(WSP(unsigned char, WS_XB8) + sbase * D), (const bf16_t*)WSP(unsigned char, WS_WG8), stok, 3072, D / 2}; pg8::StaticOrder S; S.init(stok, 3072, c.G, c.bid);
                    pg8::EpiGates E{BIGP(unsigned char, B_GATES)};
                    pg8::gemm_phase<pg8::EpiGates, pg8::StaticOrder>(L, g, S, E); } } } PH_END
            PH_BEGIN(2) phase_mix_a(ka, L, c); PH_END
            PH_BEGIN(3) phase_scan(ka, L, c); PH_END
            PH_BEGIN(4) phase_gdn_out(ka, L, c); PH_END
            PH_BEGIN(5) {
                pg8::StaticOrder S; S.init(stok, D, c.G, c.bid);
                pg8::Gemm g{BIGP(bf16_t, B_ONA), WSP(bf16_t, WS_WBR), stok, D, 768}; pg8::EpiGateCat E{BIGP(u32x2, B_GATES), BIGP(bf16_t, B_MERGED)};
                pg8::gemm_phase<pg8::EpiGateCat, pg8::StaticOrder>(L, g, S, E); } PH_END
            PH_BEGIN(6) {
                pg8::Gemm g{BIGP(bf16_t, B_MERGED), WSP(bf16_t, WS_WOUT), stok, D, D}; pg8::StaticOrder S; S.init(stok, D, c.G, c.bid);
                pg8::EpiRes E{WSP(bf16_t, WS_XB) + sbase * D, (bf16_t*)c.out + sbase * D};
                pg8::gemm_phase<pg8::EpiRes, pg8::StaticOrder>(L, g, S, E); } PH_END
#ifndef LN1PROBE
#define LN1PROBE 0
#endif
            PH_BEGIN(7) if (LN1PROBE) { c.dry = 1; phase_ln1(ka, L, c); __syncthreads(); c.dry = 0; } phase_ln1(ka, L, c); PH_END
        }
        PH_BEGIN(8) phase_select(ka, L, c, c.bid < 16 ? 16 + c.bid : -1); PH_END
        PH_BEGIN(9) phase_gather(ka, L, c); PH_END
        for (int half = 0; half < 2; ++half) {
            PH_BEGIN(10) {
                pg8::Gemm g{BIGP(bf16_t, half ? B_XY1 : B_XY0), (const bf16_t*)(WSP(unsigned char, WS_WGU) + (size_t)half * 8 * 4096 * D), 8 * CAP, 8 * 4096, D / 2}; pg8::MoeOrder S; S.init(8, CAP / 256, 16, c.G, c.bid);
                pg8::EpiSwiglu E{BIGP(unsigned char, B_HID)};
                pg8::gemm_phase<pg8::EpiSwiglu, pg8::MoeOrder>(L, g, S, E); } PH_END
            PH_BEGIN(11) {
                pg8::Gemm g{BIGP(bf16_t, B_HID), (const bf16_t*)(WSP(unsigned char, WS_WD) + (size_t)half * 8 * D * DE), 8 * CAP, 8 * D, DE / 2}; pg8::MoeOrder S; S.init(8, CAP / 256, 4, c.G, c.bid);
                pg8::EpiDown E{BIGP(bf16_t, half ? B_XY1 : B_XY0), WSP(float, WS_GATEV) + (size_t)half * 8 * CAP};
                pg8::gemm_phase<pg8::EpiDown, pg8::MoeOrder>(L, g, S, E); } PH_END
        }
        PH_BEGIN(12) phase_ln2(ka, L, c); PH_END
    }
#undef PH_BEGIN
#undef PH_END
}

constexpr int N_PHASES = 2 * (1 + NSLAB * 7 + 2 + 4 + 1);

extern "C" void kernel_launch(void* const* d_in, const int* in_sizes, int n_in, void* d_out, int out_size, void* d_ws, size_t ws_size, hipStream_t stream) {
    static int grid = 0;
    if (grid == 0) {
        if (n_in != 20 || ws_size < WS_END) { fprintf(stderr, "kernel_launch: unexpected n_in %d or ws_size %zu (< %zu)\n", n_in, ws_size, (size_t)WS_END); grid = -1; return; }
        int dev = 0, cus = 0, per_cu = 0;
        if (hipGetDevice(&dev) != hipSuccess || hipDeviceGetAttribute(&cus, hipDeviceAttributeMultiprocessorCount, dev) != hipSuccess) { grid = -1; return; }
        if (hipFuncSetAttribute((const void*)fwd_kernel, hipFuncAttributeMaxDynamicSharedMemorySize, LDS_BYTES) != hipSuccess) { fprintf(stderr, "kernel_launch: hipFuncSetAttribute failed\n"); grid = -1; return; }
        if (hipOccupancyMaxActiveBlocksPerMultiprocessor(&per_cu, (const void*)fwd_kernel, 512, LDS_BYTES) != hipSuccess || per_cu < 1) fprintf(stderr, "kernel_launch: occupancy query says %d\n", per_cu);
        (void)hipGetLastError();
        grid = cus;
    }
    if (grid < 0) return;
    (void)hipMemsetAsync((char*)d_ws + WS_CTL, 0, 1 * MiB, stream);
    Args a{};
    for (int i = 0; i < 20; ++i) a.in[i] = (const float*)d_in[i];
    a.out = (float*)d_out; a.ws = (unsigned char*)d_ws;
#if MK_N_LAUNCHES == 1
    a.ph_lo = 0; a.ph_hi = N_PHASES;
    hipLaunchKernelGGL(fwd_kernel, dim3(grid), dim3(512), LDS_BYTES, stream, a);
#else
    for (int p = 0; p < N_PHASES; ++p) { a.ph_lo = p; a.ph_hi = p + 1; hipLaunchKernelGGL(fwd_kernel, dim3(grid), dim3(512), LDS_BYTES, stream, a); }
#endif
}
```

```cpp
#include <hip/hip_runtime.h>
#include <stdint.h>
#include <stdio.h>

#define LAS __attribute__((address_space(3)))
#define DI __device__ __forceinline__
typedef unsigned short bf16_t;
typedef short bf16x8 __attribute__((ext_vector_type(8)));
typedef float f32x4 __attribute__((ext_vector_type(4)));
typedef float f32x2 __attribute__((ext_vector_type(2)));
typedef float f32x16 __attribute__((ext_vector_type(16)));
typedef unsigned u32x4 __attribute__((ext_vector_type(4)));
typedef unsigned u32x2 __attribute__((ext_vector_type(2)));
typedef __bf16 bf16x2v __attribute__((ext_vector_type(2)));

#ifndef MK_N_LAUNCHES
#define MK_N_LAUNCHES 1
#endif

constexpr int D = 1024, T_ALL = 81920, T_P = 65536, T_S = 16384, SLABMAX = 32768, NSLAB = 3;
constexpr int DIN = 6552, NPROJ = 3584;
constexpr int C_QA = 0, C_KA = 256, C_VA = 512, C_QD = 768, C_KD = 1152, C_VD = 1536, C_QC = 1920, C_KC = 2304, C_VC = 2688, C_ZC = 3072;
constexpr int NE = 16, DE = 2048, CAP_P = 8192, CAP_S = 2048, CAP = CAP_P + CAP_S;
constexpr float ALPHA = 1.41421356237f, LN_EPS = 1e-5f, NORM_EPS = 1e-6f;
constexpr size_t MiB = 1u << 20;
constexpr size_t WS_CTL = 0, WS_WIN = 1 * MiB, WS_WBR = 14 * MiB, WS_WOUT = 16 * MiB, WS_WGU = 18 * MiB, WS_WD = 82 * MiB, WS_XB8 = 114 * MiB, WS_WG8 = 194 * MiB, WS_XB = 210 * MiB;
constexpr size_t WS_AFF = 370 * MiB, WS_SLOT = 375 * MiB, WS_IDX = 380 * MiB, WS_GATEV = 381 * MiB, WS_CS = 382 * MiB, WS_BIG = 386 * MiB, WS_END = 1130 * MiB;
constexpr size_t B_PROJ = 0, B_GATES = 224 * MiB, B_BA = 416 * MiB, B_ONA = 420 * MiB, B_ODIL = 436 * MiB, B_OGDN = 452 * MiB, B_DILP = 476 * MiB, B_DILM = 500 * MiB, B_GSCR = 502 * MiB, B_MERGEF = 502 * MiB, B_MERGED = 630 * MiB;
constexpr size_t B_XY0 = 0, B_XY1 = 160 * MiB, B_HID = 320 * MiB;
constexpr int GSTRIDE = 41216;
constexpr int LDS_BYTES = 151552;
constexpr int LDS_MISC = 145408, LDS_CW = LDS_MISC + 256;

DI unsigned pk2(float lo, float hi) { f32x2 v = {lo, hi}; bf16x2v b = __builtin_convertvector(v, bf16x2v); return __builtin_bit_cast(unsigned, b); }
DI unsigned pk4_fp8(float a, float b, float c, float d) {
    int w = __builtin_amdgcn_cvt_pk_fp8_f32(a, b, 0, false); w = __builtin_amdgcn_cvt_pk_fp8_f32(c, d, w, true); return (unsigned)w; }
DI float bflo(unsigned u) { return __uint_as_float(u << 16); }
DI float bfhi(unsigned u) { return __uint_as_float(u & 0xffff0000u); }
DI float frcp(float x) { return __builtin_amdgcn_rcpf(x); }
DI float frsq(float x) { return __builtin_amdgcn_rsqf(x); }
DI float sigmoidf_(float x) { return frcp(1.0f + __expf(-x)); }
DI float siluf_(float x) { return x * frcp(1.0f + __expf(-x)); }
DI void lds_barrier() { asm volatile("s_waitcnt lgkmcnt(0)\n\ts_barrier" ::: "memory"); }
DI float wave_sum(float v) {
#pragma unroll
    for (int o = 1; o < 64; o <<= 1) v += __shfl_xor(v, o);
    return v;
}
#define MFMA32(a, b, c) __builtin_amdgcn_mfma_f32_32x32x16_bf16((a), (b), (c), 0, 0, 0)
DI int crow(int reg, int h) { return (reg & 3) + 8 * (reg >> 2) + 4 * h; }
DI f32x16 zero16() { f32x16 z; for (int i = 0; i < 16; ++i) z[i] = 0.f; return z; }
template <int S> DI bf16x8 pack8(const f32x16& x) {
    u32x4 p; p[0] = pk2(x[8 * S], x[8 * S + 1]); p[1] = pk2(x[8 * S + 2], x[8 * S + 3]); p[2] = pk2(x[8 * S + 4], x[8 * S + 5]); p[3] = pk2(x[8 * S + 6], x[8 * S + 7]);
    return __builtin_bit_cast(bf16x8, p);
}

namespace pg8 {
constexpr int BM = 256, BK = 64, HALF = 128, HTB = HALF * BK * 2, STAGE_BYTES = 8 * HTB, NXCD = 8, WGM = 8;
__host__ __device__ __forceinline__ int lds_byte(int r, int c) { const int st = (r >> 4) * 2 + (c >> 5), rr = r & 15, cc = c & 31, ob = rr * 64 + cc * 2; return st * 1024 + (ob ^ (((ob >> 9) & 1) << 5)); }
__host__ __device__ __forceinline__ void stage_rc(int b, int& R, int& C) { const int st = b / 1024, sb = b % 1024, swz = sb ^ (((sb >> 9) & 1) << 5); R = (st >> 1) * 16 + swz / 64; C = (st & 1) * 32 + (swz % 64) / 2; }
__host__ __device__ __forceinline__ int perm32(int rho) { const int n = rho >> 4, i = rho & 15; return 8 * (i >> 2) + 4 * n + (i & 3); }
struct Unit { int pm, pn; };
struct Gemm { const bf16_t* A; const bf16_t* Bt; int M, N, K; };
struct StaticOrder {
    int nM, nN, nwg, G, c;
    __device__ void init(int M, int N, int G_, int c_) { nM = M / BM; nN = N / BM; nwg = nM * nN; G = G_; c = c_; }
    __device__ bool next(int i, Unit& u) const {
        const long L = (long)i * G + c; if (L >= nwg) return false;
        int wgid = (int)L; { const int q = nwg / NXCD, r = nwg % NXCD, xcd = wgid % NXCD, off = wgid / NXCD; wgid = (xcd < r ? xcd * (q + 1) : r * (q + 1) + (xcd - r) * q) + off; }
        const int nig = WGM * nN, gid = wgid / nig, fm = gid * WGM, gsz = (nM - fm) < WGM ? (nM - fm) : WGM;
        u.pm = fm + ((wgid % nig) % gsz); u.pn = (wgid % nig) / gsz; return true;
    }
    __device__ __forceinline__ void a_ready(const Unit&) const {}
    __device__ __forceinline__ void done(const Unit&) const {}
};
struct MoeOrder {
    int nMe, nNe, per, total, G, c, xr, xc, rpx, cpx, share;
    __device__ void init(int nE, int nMe_, int nNe_, int G_, int c_) { nMe = nMe_; nNe = nNe_; per = nMe * nNe; total = nE * per; G = G_; c = c_;
        xc = (nNe % 2 == 0 && nNe >= 8) ? 2 : 1; xr = 8 / xc; rpx = nMe / xr; cpx = nNe / xc; share = rpx * cpx; }
    __device__ bool next(int i, Unit& u) const {
        if ((G & 7) == 0 && nMe % xr == 0) {
            const int x = c & 7, q = c >> 3, nq = G >> 3; const long j = (long)i * nq + q; if (j >= (long)(total / 8)) return false;
            const int e = (int)(j / share), r = (int)(j % share); const int pm = (x / xc) * rpx + r % rpx, pn = (x % xc) * cpx + r / rpx;
            u.pm = e * nMe + pm; u.pn = e * nNe + pn; return true;
        }
        const long L = (long)i * G + c; if (L >= total) return false;
        const int e = (int)(L / per), r = (int)(L % per);
        u.pm = e * nMe + r % nMe; u.pn = e * nNe + r / nMe; return true;
    }
    __device__ __forceinline__ void a_ready(const Unit&) const {}
    __device__ __forceinline__ void done(const Unit&) const {}
};

template <class Epi, class Sched>
__device__ __forceinline__ void gemm_phase(LAS unsigned char* lds, const Gemm g, const Sched& S, const Epi& E) {
    int tid = threadIdx.x; asm volatile("" : "+v"(tid));
    const int wid = __builtin_amdgcn_readfirstlane(tid >> 6), lane = tid & 63, wr = wid >> 2, wc = wid & 3, fr = lane & 15, fq = lane >> 4;
    int Kv = g.K; asm volatile("" : "+s"(Kv));
    const int K = Kv, nt = K / BK;
    unsigned voffA[2], voffB[2];
#pragma unroll
    for (int i = 0; i < 2; ++i) { int R, C; stage_rc(tid * 16 + i * 8192, R, C); const int Rb = Epi::PERM ? ((R & ~31) + perm32(R & 31)) : R;
        voffA[i] = (unsigned)(R * K + C) * 2u; voffB[i] = (unsigned)(Rb * K + C) * 2u; }
    const size_t kstep = (size_t)(BK * 2);
    const size_t hstep = (size_t)HALF * K * 2;
    const size_t tstep = 2 * hstep;
    const unsigned ldsw = (unsigned)wid * 1024u;
    const int aoff = lds_byte(wr * 64 + fr, fq * 8), boff = lds_byte(wc * 32 + fr, fq * 8);
#define PG8_SA(b, h) (((b) * 2 + (h)) * HTB)
#define PG8_SB(b, h) ((4 + (b) * 2 + (h)) * HTB)
#define PG8_STAGE(bufoff, gbase, voff) do { _Pragma("unroll") for (int _i = 0; _i < 2; ++_i) \
        __builtin_amdgcn_global_load_lds((const unsigned*)((const char*)(gbase) + (voff)[_i]), (LAS unsigned*)(lds + (bufoff) + ldsw + _i * 8192), 16, 0, 0); } while (0)
#define PG8_LD8(p) __builtin_shufflevector(*(const LAS v4i_*)(p), *(const LAS v4i_*)((p) + 1024), 0, 1, 2, 3, 4, 5, 6, 7)
#define PG8_LDA(dst, b, h) do { _Pragma("unroll") for (int m = 0; m < 4; ++m) { if constexpr (Epi::FP8) dst##8[m] = PG8_LD8(lds + PG8_SA(b, h) + aoff + m * 2048); \
        else { _Pragma("unroll") for (int k = 0; k < 2; ++k) dst[m][k] = *(const LAS bf16x8*)(lds + PG8_SA(b, h) + aoff + m * 2048 + k * 1024); } } } while (0)
#define PG8_LDB(dst, b, h) do { _Pragma("unroll") for (int n = 0; n < 2; ++n) { if constexpr (Epi::FP8) dst##8[n] = PG8_LD8(lds + PG8_SB(b, h) + boff + n * 2048); \
        else { _Pragma("unroll") for (int k = 0; k < 2; ++k) dst[n][k] = *(const LAS bf16x8*)(lds + PG8_SB(b, h) + boff + n * 2048 + k * 1024); } } } while (0)
#define PG8_MMA(ai, bj, At, Bt) do { __builtin_amdgcn_s_setprio(1); _Pragma("unroll") for (int m = 0; m < 4; ++m) _Pragma("unroll") for (int n = 0; n < 2; ++n) { \
        if constexpr (Epi::FP8) asm volatile("v_mfma_scale_f32_16x16x128_f8f6f4 %0, %1, %2, %0, %3, %3 op_sel_hi:[0,0,0]" : "+v"(acc[ai][bj][m][n]) : "v"(Bt##8[n]), "v"(At##8[m]), "v"(fp8_unit_scale));   \
        else { _Pragma("unroll") for (int k = 0; k < 2; ++k) acc[ai][bj][m][n] = __builtin_amdgcn_mfma_f32_16x16x32_bf16(Bt[n][k], At[m][k], acc[ai][bj][m][n], 0, 0, 0); } } \
        __builtin_amdgcn_s_setprio(0); } while (0)
#define PG8_WAIT_V(n) asm volatile("s_waitcnt vmcnt(" #n ")" ::: "memory")
#define PG8_WAIT_L(n) asm volatile("s_waitcnt lgkmcnt(" #n ")" ::: "memory")
#define PG8_BAR __builtin_amdgcn_s_barrier()
#define PG8_SCHED __builtin_amdgcn_sched_barrier(0)
    Unit cur, nxt; int ui = 0;
    if (!S.next(0, cur)) return;
    f32x4 acc[2][2][4][2];
#pragma unroll
    for (int a = 0; a < 2; ++a)
#pragma unroll
        for (int b = 0; b < 2; ++b)
#pragma unroll
            for (int m = 0; m < 4; ++m)
#pragma unroll
                for (int n = 0; n < 2; ++n) acc[a][b][m][n] = (f32x4){0.f, 0.f, 0.f, 0.f};
    typedef int v4i_ __attribute__((ext_vector_type(4))); typedef int v8i_ __attribute__((ext_vector_type(8)));
    bf16x8 At[4][2], B0[2][2], B1[2][2]; v8i_ At8[4], B08[2], B18[2];
    int fp8_unit_scale = 0x7F7F7F7F; asm volatile("" : "+v"(fp8_unit_scale));
    const char* cA = (const char*)g.A + (size_t)cur.pm * tstep; const char* cB = (const char*)g.Bt + (size_t)cur.pn * tstep;
    S.a_ready(cur);
    PG8_STAGE(PG8_SB(0, 0), cB, voffB); PG8_STAGE(PG8_SA(0, 0), cA, voffA); PG8_STAGE(PG8_SB(0, 1), cB + hstep, voffB); PG8_STAGE(PG8_SA(0, 1), cA + hstep, voffA);
    if (wr == 1) PG8_BAR;
    PG8_WAIT_V(4); PG8_BAR;
    PG8_STAGE(PG8_SB(1, 0), cB + kstep, voffB); PG8_STAGE(PG8_SA(1, 0), cA + kstep, voffA); PG8_STAGE(PG8_SB(1, 1), cB + hstep + kstep, voffB);
    PG8_WAIT_V(6); PG8_BAR;
    for (;;) {
        const bool has_next = S.next(ui + 1, nxt);
        const char* nA = has_next ? (const char*)g.A + (size_t)nxt.pm * tstep : cA; const char* nB = has_next ? (const char*)g.Bt + (size_t)nxt.pn * tstep : cB;
        for (int t = 0; t < nt; t += 2) {
            const bool last = (t == nt - 2);
            const char* a1 = cA + (size_t)(t + 1) * kstep;
            const char* a2 = last ? nA : cA + (size_t)(t + 2) * kstep; const char* b2 = last ? nB : cB + (size_t)(t + 2) * kstep;
            const char* a3 = a2 + kstep; const char* b3 = b2 + kstep;
            if (last && has_next) S.a_ready(nxt);
            if constexpr (Epi::SEG) { if (t == 4 || t == 6) { int tz = tid; asm volatile("" : "+v"(tz)); const int wz = __builtin_amdgcn_readfirstlane(tz >> 6), lz = tz & 63; E.mid(acc, cur, t == 4 ? 0 : 1, wz >> 2, wz & 3, lz & 15, lz >> 4); } }
            PG8_LDB(B0, 0, 0); PG8_SCHED; PG8_LDA(At, 0, 0); PG8_STAGE(PG8_SA(1, 1), a1 + hstep, voffA);
            PG8_WAIT_L(8); PG8_BAR; PG8_WAIT_L(0); PG8_MMA(0, 0, At, B0); PG8_BAR; PG8_SCHED;
            PG8_LDB(B1, 0, 1); PG8_STAGE(PG8_SB(0, 0), b2, voffB);
            PG8_BAR; PG8_WAIT_L(0); PG8_MMA(0, 1, At, B1); PG8_BAR;
            PG8_LDA(At, 0, 1); PG8_STAGE(PG8_SA(0, 0), a2, voffA);
            PG8_BAR; PG8_WAIT_L(0); PG8_MMA(1, 0, At, B0); PG8_BAR; PG8_SCHED;
            PG8_STAGE(PG8_SB(0, 1), b2 + hstep, voffB);
            PG8_WAIT_V(6); PG8_BAR; PG8_MMA(1, 1, At, B1); PG8_BAR;
            PG8_LDB(B0, 1, 0); PG8_SCHED; PG8_LDA(At, 1, 0); PG8_STAGE(PG8_SA(0, 1), a2 + hstep, voffA);
            PG8_WAIT_L(8); PG8_BAR; PG8_WAIT_L(0); PG8_MMA(0, 0, At, B0); PG8_BAR; PG8_SCHED;
            PG8_LDB(B1, 1, 1); PG8_STAGE(PG8_SB(1, 0), b3, voffB);
            PG8_BAR; PG8_WAIT_L(0); PG8_MMA(0, 1, At, B1); PG8_BAR;
            PG8_LDA(At, 1, 1); PG8_STAGE(PG8_SA(1, 0), a3, voffA);
            PG8_BAR; PG8_WAIT_L(0); PG8_MMA(1, 0, At, B0); PG8_BAR; PG8_SCHED;
            PG8_STAGE(PG8_SB(1, 1), b3 + hstep, voffB);
            PG8_WAIT_V(6); PG8_BAR; PG8_MMA(1, 1, At, B1); PG8_BAR;
        }
        if constexpr (Epi::FP8) asm volatile("s_nop 15\n\ts_nop 15\n\ts_nop 15" ::: "memory");
        { int tz = tid; asm volatile("" : "+v"(tz)); const int wz = __builtin_amdgcn_readfirstlane(tz >> 6), lz = tz & 63;
          E(acc, cur, wz >> 2, wz & 3, lz & 15, lz >> 4); } S.done(cur);
        if (!has_next) break;
#pragma unroll
        for (int a = 0; a < 2; ++a)
#pragma unroll
            for (int b = 0; b < 2; ++b)
#pragma unroll
                for (int m = 0; m < 4; ++m)
#pragma unroll
                    for (int n = 0; n < 2; ++n) acc[a][b][m][n] = (f32x4){0.f, 0.f, 0.f, 0.f};
        cur = nxt; cA = nA; cB = nB; ++ui;
    }
    PG8_WAIT_V(0);
    if (wr == 0) PG8_BAR;
    PG8_BAR;
#undef PG8_SA
#undef PG8_SB
#undef PG8_STAGE
#undef PG8_LDA
#undef PG8_LD8
#undef PG8_LDB
#undef PG8_MMA
#undef PG8_WAIT_V
#undef PG8_WAIT_L
#undef PG8_BAR
#undef PG8_SCHED
}

struct EpiInProj {
    static constexpr bool PERM = true, SEG = false, FP8 = false;
    bf16_t* O; float* BA;
    __device__ __forceinline__ void operator()(const f32x4 (&acc)[2][2][4][2], const Unit& u, int wr, int wc, int fr, int fq) const {
        const int row0 = u.pm * BM + wr * 64 + fr, col0 = u.pn * BM + wc * 32 + 8 * fq;
        const bool sig = false, ba = (u.pn == 13) && (wc == 0) && (fq < 3);
#pragma unroll
        for (int ai = 0; ai < 2; ++ai)
#pragma unroll
            for (int m = 0; m < 4; ++m) { int row = row0 + ai * HALF + m * 16; asm volatile("" : "+v"(row)); bf16_t* rowp = O + (size_t)row * NPROJ + col0;
#pragma unroll
                for (int bj = 0; bj < 2; ++bj) { f32x4 v0 = acc[ai][bj][m][0], v1 = acc[ai][bj][m][1];
                    if (sig) {
#pragma unroll
                        for (int j = 0; j < 4; ++j) { v0[j] = sigmoidf_(v0[j]); v1[j] = sigmoidf_(v1[j]); } }
                    u32x4 w; w.x = pk2(v0[0], v0[1]); w.y = pk2(v0[2], v0[3]); w.z = pk2(v1[0], v1[1]); w.w = pk2(v1[2], v1[3]);
                    *(u32x4*)(rowp + bj * HALF) = w;
                    if (bj == 1 && ba) { float* bp = BA + (size_t)row * 32 + 8 * fq; *(f32x4*)bp = v0; *(f32x4*)(bp + 4) = v1; } } }
    }
};
struct EpiGates {
    static constexpr bool PERM = true, SEG = false, FP8 = true;
    unsigned char* G;
    static __device__ __forceinline__ unsigned q4(const f32x4& v) { unsigned r = 0u;
#pragma unroll
        for (int j = 0; j < 4; ++j) { const float t = __builtin_amdgcn_exp2f(v[j] * (-0.03125f * 1.44269504088896f));
            r = __builtin_amdgcn_cvt_pk_u8_f32(fmaxf(frcp(__builtin_fmaf(t, 1.0f / 255.0f, 1.0f / 255.0f)), 1.0f), j, r); }
        return r; }
    __device__ __forceinline__ void operator()(const f32x4 (&acc)[2][2][4][2], const Unit& u, int wr, int wc, int fr, int fq) const {
#pragma unroll
        for (int ai = 0; ai < 2; ++ai)
#pragma unroll
            for (int m = 0; m < 4; ++m) {
                unsigned boff = (unsigned)(((u.pm * 12 + u.pn) * (16 * 512) + ((wr * 4 + wc) * 64 + fq * 16 + fr)) * 8 + ((ai * 4 + m) * 2) * 4096); asm volatile("" : "+v"(boff));
#pragma unroll
                for (int bj = 0; bj < 2; ++bj) { u32x2 w; w.x = q4(acc[ai][bj][m][0]); w.y = q4(acc[ai][bj][m][1]);
                    *(u32x2*)(G + (boff + bj * 4096)) = w; }
                asm volatile("" ::: "memory"); }
    }
};
struct EpiGateCat {
    static constexpr bool PERM = true, SEG = true, FP8 = false;
    const u32x2* GT; bf16_t* MB;
    static __device__ __forceinline__ float ub(unsigned x, int j) { return (float)((x >> (8 * j)) & 0xffu); }
    __device__ __forceinline__ void mid(f32x4 (&acc)[2][2][4][2], const Unit& u, int seg, int wr, int wc, int fr, int fq) const {
        {
            int toff = (wr * 4 + wc) * 64 + fq * 16 + fr; asm volatile("" : "+v"(toff));
            const u32x2* ga = GT + ((size_t)u.pm * 12 + seg * 4 + u.pn) * (16 * 512) + toff; const u32x2* gb = ga + (size_t)4 * 16 * 512;
            u32x2 A_[2][4][2], B_[2][4][2];
#pragma unroll
            for (int ai = 0; ai < 2; ++ai)
#pragma unroll
                for (int m = 0; m < 4; ++m)
#pragma unroll
                    for (int bj = 0; bj < 2; ++bj) { A_[ai][m][bj] = ga[((ai * 4 + m) * 2 + bj) * 512]; B_[ai][m][bj] = gb[((ai * 4 + m) * 2 + bj) * 512]; }
#pragma unroll
            for (int ai = 0; ai < 2; ++ai)
#pragma unroll
                for (int m = 0; m < 4; ++m)
#pragma unroll
                    for (int bj = 0; bj < 2; ++bj) { const u32x2 a_ = A_[ai][m][bj], b_ = B_[ai][m][bj]; f32x4& v0 = acc[ai][bj][m][0]; f32x4& v1 = acc[ai][bj][m][1];
#pragma unroll
                        for (int j = 0; j < 4; ++j) { v0[j] *= ub(a_.x, j) * frcp(ub(b_.x, j)); v1[j] *= ub(a_.y, j) * frcp(ub(b_.y, j)); } }
            asm volatile("" ::: "memory"); }
    }
    __device__ __forceinline__ void operator()(const f32x4 (&acc)[2][2][4][2], const Unit& u, int wr, int wc, int fr, int fq) const {
        const int row0 = u.pm * BM + wr * 64 + fr, col0 = u.pn * BM + wc * 32 + 8 * fq;
#pragma unroll
        for (int ai = 0; ai < 2; ++ai) {
            int rowb = row0 + ai * HALF; asm volatile("" : "+v"(rowb)); bf16_t* mp0 = MB + (size_t)rowb * D + col0;
            int toff = (wr * 4 + wc) * 64 + fq * 16 + fr; asm volatile("" : "+v"(toff));
            const u32x2* gc = GT + ((size_t)u.pm * 12 + 8 + u.pn) * (16 * 512) + toff;
            u32x2 gw[4][2];
#pragma unroll
            for (int m = 0; m < 4; ++m)
#pragma unroll
                for (int bj = 0; bj < 2; ++bj) gw[m][bj] = gc[((ai * 4 + m) * 2 + bj) * 512];
#pragma unroll
            for (int m = 0; m < 4; ++m)
#pragma unroll
                for (int bj = 0; bj < 2; ++bj) { const u32x2 g_ = gw[m][bj]; const f32x4 v0 = acc[ai][bj][m][0] * (1.0f / 255.0f), v1 = acc[ai][bj][m][1] * (1.0f / 255.0f); u32x4 w;
                    w.x = pk2(v0[0] * ub(g_.x, 0), v0[1] * ub(g_.x, 1)); w.y = pk2(v0[2] * ub(g_.x, 2), v0[3] * ub(g_.x, 3)); w.z = pk2(v1[0] * ub(g_.y, 0), v1[1] * ub(g_.y, 1)); w.w = pk2(v1[2] * ub(g_.y, 2), v1[3] * ub(g_.y, 3));
                    *(u32x4*)(mp0 + (size_t)(m * 16) * D + bj * HALF) = w; }
            asm volatile("" ::: "memory"); }
    }
};
struct EpiRes {
    static constexpr bool PERM = true, SEG = false, FP8 = false;
    const bf16_t* XR; bf16_t* H;
    __device__ __forceinline__ void operator()(const f32x4 (&acc)[2][2][4][2], const Unit& u, int wr, int wc, int fr, int fq) const {
        const int row0 = u.pm * BM + wr * 64 + fr, col0 = u.pn * BM + wc * 32 + 8 * fq;
#pragma unroll
        for (int ai = 0; ai < 2; ++ai) {
            int rowb = row0 + ai * HALF; asm volatile("" : "+v"(rowb)); const size_t off0 = (size_t)rowb * D + col0;
            u32x4 xr[4][2];
#pragma unroll
            for (int m = 0; m < 4; ++m)
#pragma unroll
                for (int bj = 0; bj < 2; ++bj) xr[m][bj] = *(const u32x4*)(XR + off0 + (size_t)(m * 16) * D + bj * HALF);
#pragma unroll
            for (int m = 0; m < 4; ++m)
#pragma unroll
                for (int bj = 0; bj < 2; ++bj) { const u32x4 x = xr[m][bj]; const f32x4 v0 = acc[ai][bj][m][0], v1 = acc[ai][bj][m][1]; u32x4 w;
                    w.x = pk2(bflo(x.x) * ALPHA + v0[0], bfhi(x.x) * ALPHA + v0[1]); w.y = pk2(bflo(x.y) * ALPHA + v0[2], bfhi(x.y) * ALPHA + v0[3]);
                    w.z = pk2(bflo(x.z) * ALPHA + v1[0], bfhi(x.z) * ALPHA + v1[1]); w.w = pk2(bflo(x.w) * ALPHA + v1[2], bfhi(x.w) * ALPHA + v1[3]);
                    *(u32x4*)(H + off0 + (size_t)(m * 16) * D + bj * HALF) = w; }
            asm volatile("" ::: "memory"); }
    }
};
struct EpiSwiglu {
    static constexpr bool PERM = true, SEG = false, FP8 = true;
    unsigned char* HID;
    __device__ __forceinline__ void operator()(const f32x4 (&acc)[2][2][4][2], const Unit& u, int wr, int wc, int fr, int fq) const {
        const int row0 = u.pm * BM + wr * 64 + fr, col0 = (u.pn & 15) * 128 + wc * 32 + 8 * fq;
#pragma unroll
        for (int ai = 0; ai < 2; ++ai)
#pragma unroll
            for (int m = 0; m < 4; ++m) { const f32x4 g0 = acc[ai][0][m][0], g1 = acc[ai][0][m][1], u0 = acc[ai][1][m][0], u1 = acc[ai][1][m][1];
                f32x4 h0, h1;
#pragma unroll
                for (int j = 0; j < 4; ++j) { const float t0 = __builtin_amdgcn_exp2f(g0[j] * (-0.03125f * 1.44269504088896f)), t1 = __builtin_amdgcn_exp2f(g1[j] * (-0.03125f * 1.44269504088896f));
                    h0[j] = g0[j] * u0[j] * frcp(__builtin_fmaf(t0, 1024.0f, 1024.0f)); h1[j] = g1[j] * u1[j] * frcp(__builtin_fmaf(t1, 1024.0f, 1024.0f)); }
                u32x2 w; w.x = pk4_fp8(h0[0], h0[1], h0[2], h0[3]); w.y = pk4_fp8(h1[0], h1[1], h1[2], h1[3]);
                int rowi = row0 + ai * HALF + m * 16; asm volatile("" : "+v"(rowi));
                *(u32x2*)(HID + (size_t)rowi * DE + col0) = w; asm volatile("" ::: "memory"); }
    }
};
struct EpiDown {
    static constexpr bool PERM = true, SEG = false, FP8 = true;
    bf16_t* Y; const float* GV;
    __device__ __forceinline__ void operator()(const f32x4 (&acc)[2][2][4][2], const Unit& u, int wr, int wc, int fr, int fq) const {
        const int row0 = u.pm * BM + wr * 64 + fr, col0 = (u.pn & 3) * BM + wc * 32 + 8 * fq;
        float gvs[2][4];
#pragma unroll
        for (int ai = 0; ai < 2; ++ai)
#pragma unroll
            for (int m = 0; m < 4; ++m) gvs[ai][m] = GV[row0 + ai * HALF + m * 16];
#pragma unroll
        for (int ai = 0; ai < 2; ++ai)
#pragma unroll
            for (int m = 0; m < 4; ++m) { int row = row0 + ai * HALF + m * 16; asm volatile("" : "+v"(row)); const float gv = gvs[ai][m] * 0.03125f;
#pragma unroll
                for (int bj = 0; bj < 2; ++bj) { const f32x4 v0 = acc[ai][bj][m][0] * gv, v1 = acc[ai][bj][m][1] * gv;
                    u32x4 w; w.x = pk2(v0[0], v0[1]); w.y = pk2(v0[2], v0[3]); w.z = pk2(v1[0], v1[1]); w.w = pk2(v1[2], v1[3]);
                    *(u32x4*)(Y + (size_t)row * D + col0 + bj * HALF) = w; } }
    }
};
}

#define XB_TMO      128
#define XB_XCNT(j)  (256  + 64 * (j))
#define XB_XSUB(j)  (1280 + 64 * (j))
#define XB_XGEN(j)  (2304 + 64 * (j))
#define XB_TOP      3328
#define XB_TOPGEN   3392
#define XCD_BAR_WORDS 3456
#define XB_SPIN_CAP (1u << 22)
__device__ __forceinline__ unsigned xb_ld(unsigned* p)              { return __hip_atomic_load(p, __ATOMIC_RELAXED, __HIP_MEMORY_SCOPE_AGENT); }
__device__ __forceinline__ unsigned xb_add(unsigned* p, unsigned v) { return __hip_atomic_fetch_add(p, v, __ATOMIC_RELAXED, __HIP_MEMORY_SCOPE_AGENT); }
__device__ __forceinline__ unsigned xb_xcc_id() { return (unsigned)__builtin_amdgcn_s_getreg((3 << 11) | 20) & 0xFu; }
#define XB_SPIN(cond, bar) do { unsigned _sp = 0; while (cond) { __builtin_amdgcn_s_sleep(1); \
    if ((++_sp & 255u) == 0u) { if (xb_ld(&(bar)[XB_TMO])) break; if (_sp > XB_SPIN_CAP) { atomicAdd(&(bar)[XB_TMO], 1u); break; } } } } while (0)
struct XcdBarrier { unsigned* bar; unsigned x; volatile LAS unsigned* st; };
__device__ __forceinline__ XcdBarrier xcd_barrier_post(unsigned* bar, volatile LAS unsigned* st) {
    XcdBarrier b; b.bar = bar; b.x = xb_xcc_id(); b.st = st;
    if (threadIdx.x == 0) (void)xb_add(&bar[XB_XCNT(b.x)], 1u);
    return b;
}
__device__ __forceinline__ void xcd_barrier_complete(unsigned* bar, unsigned x, unsigned& nloc, unsigned& nx) {
    const unsigned G = gridDim.x * gridDim.y * gridDim.z;
    unsigned sum, cnt, mine, sp = 0u;
    for (;;) {
        sum = 0u; cnt = 0u; mine = 0u;
#pragma unroll
        for (unsigned j = 0; j < 16; ++j) { const unsigned c = xb_ld(&bar[XB_XCNT(j)]); sum += c; cnt += (c > 0u) ? 1u : 0u; }
        mine = xb_ld(&bar[XB_XCNT(x)]);
        if (sum == G) break;
        __builtin_amdgcn_s_sleep(1);
        if ((++sp & 255u) == 0u) { if (xb_ld(&bar[XB_TMO])) break; if (sp > XB_SPIN_CAP) { atomicAdd(&bar[XB_TMO], 1u); break; } }
    }
    nloc = mine > 0u ? mine : 1u; nx = cnt > 0u ? cnt : 1u;
}
__device__ __forceinline__ void xcd_barrier(const XcdBarrier& b) {
    asm volatile("s_waitcnt vmcnt(0)" ::: "memory");
    __syncthreads();
    if (threadIdx.x == 0) {
        unsigned* bar = b.bar; asm volatile("" : "+s"(bar));
        __builtin_amdgcn_s_waitcnt(0);
        unsigned nloc = b.st[0], nx = b.st[1];
        if (nloc == 0u) { xcd_barrier_complete(bar, b.x, nloc, nx); b.st[0] = nloc; b.st[1] = nx; }
        const unsigned old = xb_add(&bar[XB_XSUB(b.x)], 1u);
        const unsigned gen = old / nloc;
        if (old + 1u == (gen + 1u) * nloc) {
            __builtin_amdgcn_fence(__ATOMIC_RELEASE, "agent");
            asm volatile("s_waitcnt vmcnt(0)" ::: "memory");
            const unsigned og = xb_add(&bar[XB_TOP], 1u);
            const unsigned tg = og / nx;
            if (og + 1u == (tg + 1u) * nx) xb_add(&bar[XB_TOPGEN], 1u);
            else XB_SPIN(xb_ld(&bar[XB_TOPGEN]) == tg, bar);
            __builtin_amdgcn_fence(__ATOMIC_ACQUIRE, "agent");
            xb_add(&bar[XB_XGEN(b.x)], 1u);
            asm volatile("s_waitcnt vmcnt(0)" ::: "memory");
        } else {
            XB_SPIN(xb_ld(&bar[XB_XGEN(b.x)]) == gen, bar);
            __builtin_amdgcn_fence(__ATOMIC_ACQUIRE, "agent");
            asm volatile("s_waitcnt vmcnt(0)" ::: "memory");
        }
    }
    __syncthreads();
}

struct Args { const float* in[20]; float* out; unsigned char* ws; int ph_lo, ph_hi; };
typedef const __attribute__((address_space(4))) Args* KArgs;
DI KArgs kargs() { KArgs p = (KArgs)__builtin_amdgcn_kernarg_segment_ptr(); asm volatile("" : "+s"(p)); return p; }
struct Ctx {
    float* out; unsigned char* ws;
    int tid, lane, wave, G, bid;
    int layer, slab;
    int nseq, seqlen;
    int stok, sbase;
    int dry;
};
#define WSP(T, off) ((T*)(c.ws + (off)))
#define BIGP(T, off) ((T*)(c.ws + WS_BIG + (off)))

__device__ const float INV_FREQ[32] = {1.000000000e+00f, 7.498942018e-01f, 5.623413324e-01f, 4.216965139e-01f, 3.162277639e-01f, 2.371373773e-01f, 1.778279394e-01f, 1.333521456e-01f, 1.000000015e-01f, 7.498942316e-02f, 5.623413250e-02f, 4.216964915e-02f, 3.162277490e-02f, 2.371373773e-02f, 1.778279431e-02f, 1.333521400e-02f, 9.999999776e-03f, 7.498942316e-03f, 5.623413250e-03f, 4.216964822e-03f, 3.162277630e-03f, 2.371373819e-03f, 1.778279431e-03f, 1.333521446e-03f, 1.000000047e-03f, 7.498941850e-04f, 5.623413017e-04f, 4.216965172e-04f, 3.162277571e-04f, 2.371373703e-04f, 1.778279402e-04f, 1.333521504e-04f};
DI void tr_item(const float* src, long src_ld, int src_col0, int nvalid, int kvalid, bf16_t* dst, long dst_ld, int dst_row0, int k0, LAS float* scr, int lane) {
    float tv[32];
#pragma unroll
    for (int i = 0; i < 32; ++i) { const int kk = 2 * i + (lane >> 5), cc = lane & 31;
        tv[i] = 0.f; if ((k0 + kk) < kvalid && cc < nvalid) tv[i] = src[(size_t)(k0 + kk) * src_ld + src_col0 + cc]; }
#pragma unroll
    for (int i = 0; i < 32; ++i) { const int kk = 2 * i + (lane >> 5), cc = lane & 31; scr[kk * 33 + cc] = tv[i]; }
    asm volatile("s_waitcnt lgkmcnt(0)" ::: "memory");
    const int c8 = lane & 7;
#pragma unroll
    for (int j = 0; j < 4; ++j) { const int n = (lane >> 3) + 8 * j; const LAS float* s = scr + (8 * c8) * 33 + n;
        u32x4 o; o.x = pk2(s[0 * 33], s[1 * 33]); o.y = pk2(s[2 * 33], s[3 * 33]); o.z = pk2(s[4 * 33], s[5 * 33]); o.w = pk2(s[6 * 33], s[7 * 33]);
        *(u32x4*)(dst + (size_t)(dst_row0 + n) * dst_ld + k0 + 8 * c8) = o; }
    asm volatile("s_waitcnt lgkmcnt(0)" ::: "memory");
}
DI void tr_item8(const float* src, long src_ld, int src_col0, int kvalid, unsigned char* dst, long dst_ld, int dst_row0, int k0, float scale, LAS float* scr, int lane) {
    float tv[32];
#pragma unroll
    for (int i = 0; i < 32; ++i) { const int kk = 2 * i + (lane >> 5), cc = lane & 31; tv[i] = 0.f; if ((k0 + kk) < kvalid) tv[i] = src[(size_t)(k0 + kk) * src_ld + src_col0 + cc]; }
#pragma unroll
    for (int i = 0; i < 32; ++i) { const int kk = 2 * i + (lane >> 5), cc = lane & 31; scr[kk * 33 + cc] = tv[i]; }
    asm volatile("s_waitcnt lgkmcnt(0)" ::: "memory");
    const int c8 = lane & 7;
#pragma unroll
    for (int j = 0; j < 4; ++j) { const int n = (lane >> 3) + 8 * j; const LAS float* s = scr + (8 * c8) * 33 + n;
        u32x2 o; o.x = pk4_fp8(s[0 * 33] * scale, s[1 * 33] * scale, s[2 * 33] * scale, s[3 * 33] * scale); o.y = pk4_fp8(s[4 * 33] * scale, s[5 * 33] * scale, s[6 * 33] * scale, s[7 * 33] * scale);
        *(u32x2*)(dst + (size_t)(dst_row0 + n) * dst_ld + k0 + 8 * c8) = o; }
    asm volatile("s_waitcnt lgkmcnt(0)" ::: "memory");
}
DI void phase_weights(KArgs args, LAS unsigned char* lds, const Ctx& c) {
    const int l = c.layer, lane = c.lane;
    LAS float* scr = (LAS float*)(lds + c.wave * 8448);
    const int gw = c.bid * 8 + c.wave, NGW = c.G * 8;
    constexpr int I_IN = 16 * 112 + 16 * 96, I_NA = 4 * 32, I_DIL = 2 * 32, I_GDN = 6 * 32, I_OUT = 16 * 32, I_GU1 = 16 * 128, I_D1 = 32 * 32;
    constexpr int NITEMS = I_IN + I_NA + I_DIL + I_GDN + I_OUT + 16 * I_GU1 + 16 * I_D1;
    for (int it = gw; it < NITEMS; it += NGW) {
        int r = it;
        const float* src; long sld; int sc0, nv = 32, kv; bf16_t* dst; long dld; int dr0, k0;
        if (r < 16 * 112) { const int kb = r / 112, nb = r % 112, n0 = 32 * nb; src = args->in[2] + (size_t)l * D * DIN; sld = DIN; kv = D;
            sc0 = n0; nv = 3480 - n0; if (nv < 0) { nv = 0; sc0 = 0; } if (nv > 32) nv = 32;
            dst = WSP(bf16_t, WS_WIN); dld = D; dr0 = n0; k0 = 64 * kb; }
        else if (r < I_IN) { const int q = r - 16 * 112, kb = q / 96, nb = q % 96;
            tr_item8(args->in[2] + (size_t)l * D * DIN, DIN, 3480 + 32 * nb, D, WSP(unsigned char, WS_WG8), D, 32 * nb, 64 * kb, 32.0f, scr, lane); continue; }
        else if ((r -= I_IN) < I_NA) { const int kb = r / 32, nb = r % 32; src = args->in[8] + (size_t)l * 256 * D; sld = D; sc0 = 32 * nb; kv = 256; dst = WSP(bf16_t, WS_WBR); dld = 768; dr0 = 32 * nb; k0 = 64 * kb; }
        else if ((r -= I_NA) < I_DIL) { const int kb = r / 32, nb = r % 32; src = args->in[9] + (size_t)l * 128 * D; sld = D; sc0 = 32 * nb; kv = 128; dst = WSP(bf16_t, WS_WBR) + 256; dld = 768; dr0 = 32 * nb; k0 = 64 * kb; }
        else if ((r -= I_DIL) < I_GDN) { const int kb = r / 32, nb = r % 32; src = args->in[10] + (size_t)l * 384 * D; sld = D; sc0 = 32 * nb; kv = 384; dst = WSP(bf16_t, WS_WBR) + 384; dld = 768; dr0 = 32 * nb; k0 = 64 * kb; }
        else if ((r -= I_GDN) < I_OUT) { const int kb = r / 32, nb = r % 32; src = args->in[11] + (size_t)l * D * D; sld = D; sc0 = 32 * nb; kv = D; dst = WSP(bf16_t, WS_WOUT); dld = D; dr0 = 32 * nb; k0 = 64 * kb; }
        else if ((r -= I_OUT) < 16 * I_GU1) { const int e = r / I_GU1, q = r % I_GU1, kb = q / 128, nb = q % 128, n0 = 32 * nb, j = n0 >> 8, rr = n0 & 255;
            tr_item8((rr < 128 ? args->in[16] : args->in[15]) + ((size_t)l * NE + e) * D * DE, DE, 128 * j + (rr & 127), D, WSP(unsigned char, WS_WGU) + (size_t)e * 4096 * D, D, n0, 64 * kb, 32.0f, scr, lane); continue; }
        else { r -= 16 * I_GU1; const int e = r / I_D1, q = r % I_D1, kb = q / 32, nb = q % 32;
            tr_item8(args->in[17] + ((size_t)l * NE + e) * DE * D, D, 32 * nb, DE, WSP(unsigned char, WS_WD) + (size_t)e * D * DE, DE, 32 * nb, 64 * kb, 32.0f, scr, lane); continue; }
        tr_item(src, sld, sc0, nv, kv, dst, dld, dr0, k0, scr, lane);
    }
    if (l == 0) {
        for (int t = gw; t < T_ALL; t += NGW) {
            const float* xr = (t < T_P) ? args->in[0] + (size_t)t * D : args->in[1] + (size_t)(t - T_P) * D;
            bf16_t* o = WSP(bf16_t, WS_XB) + (size_t)t * D;
#pragma unroll
            for (int j = 0; j < 4; ++j) { const f32x4 v = *(const f32x4*)(xr + 4 * lane + 256 * j); u32x2 w; w.x = pk2(v[0], v[1]); w.y = pk2(v[2], v[3]); *(u32x2*)(o + 4 * lane + 256 * j) = w;
                *(unsigned*)(WSP(unsigned char, WS_XB8) + (size_t)t * D + 4 * lane + 256 * j) = pk4_fp8(v[0], v[1], v[2], v[3]); }
        }
        float* cs = WSP(float, WS_CS);
        for (int i = c.bid * 512 + c.tid; i < 16384 * 32; i += c.G * 512) { const int pos = i >> 5, k = i & 31;
            const float inv = INV_FREQ[k];
            const float ang = (float)pos * inv;
            cs[pos * 64 + k] = cosf(ang); cs[pos * 64 + 32 + k] = sinf(ang); }
    }
}

constexpr int TLD = 72, TILEB = 64 * TLD * 2;
DI int tsw(int row) { return ((row >> 4) & 3) << 3; }
template <bool SA = false, bool SB = false> DI f32x16 mm_tile(const LAS bf16_t* A, const LAS bf16_t* Bt, int m0, int n0, int lane) {
    f32x16 acc = zero16(); const int r = lane & 31, hh = lane >> 5; const int sa = SA ? tsw(m0 + r) : 0, sb = SB ? tsw(n0 + r) : 0;
#pragma unroll
    for (int ks = 0; ks < 4; ++ks) { const bf16x8 a = *(const LAS bf16x8*)(A + (m0 + r) * TLD + ((16 * ks + 8 * hh) ^ sa)); const bf16x8 b = *(const LAS bf16x8*)(Bt + (n0 + r) * TLD + ((16 * ks + 8 * hh) ^ sb)); acc = MFMA32(a, b, acc); }
    return acc;
}

constexpr int PI_P0 = 0, PI_P1 = 9216, PI_INTRA = 18432, PI_AM = 27648, PI_TT = 45056, PI_TD0 = 54272, PI_TD1 = 60416, PI_PM = 65024, PI_VEC = 71168, PI_BYTES = 72704;
constexpr int PI_WT = PI_AM, PI_UT = PI_TD0;
struct PrepIn { float bl[2], al[2], cw[2]; };
DI void gdn_prep_loads(KArgs args, const Ctx& c, int pu, PrepIn& in) {
    int tid = c.tid; asm volatile("" : "+v"(tid));
    { const float* cwg = args->in[4] + (size_t)c.layer * 5 * 1152 + 64 * (pu % 6);
#pragma unroll
        for (int k = 0; k < 2; ++k) { int i = tid + 512 * k; i = i < 960 ? i : 959; const int tp = i / 192, r = i % 192; in.cw[k] = cwg[tp * 1152 + (r >> 6) * 384 + (r & 63)]; } }
    const int dir = tid >> 8, tg = tid & 255, head = pu % 6, gch = pu / 6, cps = c.seqlen >> 6, seq = gch / cps, n = gch % cps, ia = tg >> 3, p = tg & 7, tr = ia + 32 * dir;
    const float* BA = BIGP(float, B_BA);
#pragma unroll
    for (int h2 = 0; h2 < 2; ++h2) { const int i = ia + 32 * h2, tokl = dir ? 63 - i : i; const float* bar = BA + (size_t)(seq * c.seqlen + n * 64 + tokl) * 32;
        in.bl[h2] = bar[dir * 6 + head]; in.al[h2] = bar[12 + dir * 6 + head]; }
}
DI void gdn_prep_put_cw(LAS unsigned char* L0, const Ctx& c, const PrepIn& in) {
    int tid = c.tid; asm volatile("" : "+v"(tid)); LAS float* CW = (LAS float*)(L0 + LDS_CW);
    CW[tid] = in.cw[0]; if (tid < 448) CW[tid + 512] = in.cw[1];
}
DI void gdn_prep_pair(KArgs args, LAS unsigned char* L0, const Ctx& c, int pu, PrepIn& in, int pu_next) {
    int tid = c.tid; asm volatile("" : "+v"(tid)); const int lane = tid & 63, wave = __builtin_amdgcn_readfirstlane(tid >> 6), l = c.layer;
    const int dir = wave >> 2, wg = wave & 3, tg = tid & 255, head = pu % 6, gch = pu / 6, inst = (gch * 6 + head) * 2 + dir;
    const int cps = c.seqlen >> 6, seq = gch / cps, n = gch % cps;
    const bf16_t* PROJ = BIGP(bf16_t, B_PROJ); const float* BA = BIGP(float, B_BA);
    unsigned char* G = BIGP(unsigned char, B_GSCR) + (size_t)inst * GSTRIDE;
    LAS unsigned char* L = L0 + dir * PI_BYTES;
    LAS bf16_t* P0 = (LAS bf16_t*)(L + PI_P0); LAS bf16_t* P1 = (LAS bf16_t*)(L + PI_P1); LAS bf16_t* INTRA = (LAS bf16_t*)(L + PI_INTRA);
    LAS float* AM = (LAS float*)(L + PI_AM); LAS bf16_t* TT = (LAS bf16_t*)(L + PI_TT);
    LAS float* TD0 = (LAS float*)(L + PI_TD0); LAS float* TD1 = (LAS float*)(L + PI_TD1); LAS float* PM = (LAS float*)(L + PI_PM);
    LAS float* GV = (LAS float*)(L + PI_VEC); LAS float* BV = GV + 64; LAS float* GC = GV + 128;
    LAS bf16_t* WT = (LAS bf16_t*)(L + PI_WT); LAS bf16_t* UT = (LAS bf16_t*)(L + PI_UT);
    const int ia = tg >> 3, p = tg & 7;
    LAS float* XQ = (LAS float*)(L0 + PI_AM);
    LAS float* XK = (LAS float*)(L0 + PI_TT);
    LAS float* XV = (LAS float*)(L0 + PI_BYTES + PI_AM);
    {   float q1[8], k1[8], v1[8];
#pragma unroll
        for (int j = 0; j < 8; ++j) { q1[j] = 0.f; k1[j] = 0.f; v1[j] = 0.f; }
        const LAS float* cw = (const LAS float*)(L0 + LDS_CW) + 8 * p;
        const int tr = ia + 32 * dir;
        u32x4 rqa[5], rka[5], rva[5];
#pragma unroll
        for (int tp = 0; tp < 5; ++tp) { const int pp = n * 64 + tr + tp - 2, ppc = pp < 0 ? 0 : (pp >= c.seqlen ? c.seqlen - 1 : pp);
            const bf16_t* rp = PROJ + (size_t)(seq * c.seqlen + ppc) * NPROJ + 64 * head + 8 * p;
            rqa[tp] = *(const u32x4*)(rp + C_QC); rka[tp] = *(const u32x4*)(rp + C_KC); rva[tp] = *(const u32x4*)(rp + C_VC); }
#pragma unroll
        for (int tp = 0; tp < 5; ++tp) { const LAS float* w = cw + tp * 192;
            const f32x4 wq0 = *(const LAS f32x4*)w, wq1 = *(const LAS f32x4*)(w + 4), wk0 = *(const LAS f32x4*)(w + 64), wk1 = *(const LAS f32x4*)(w + 68), wv0 = *(const LAS f32x4*)(w + 128), wv1 = *(const LAS f32x4*)(w + 132);
            const int pp = n * 64 + tr + tp - 2; const bool inr = (pp >= 0 && pp < c.seqlen);
            { u32x4 rq = rqa[tp], rk = rka[tp], rv = rva[tp];
                if (!inr) { rq = (u32x4){0u, 0u, 0u, 0u}; rk = rq; rv = rq; }
#pragma unroll
                for (int j = 0; j < 4; ++j) { const float a0 = (j < 2) ? wq0[2 * j] : wq1[2 * j - 4], a1 = (j < 2) ? wq0[2 * j + 1] : wq1[2 * j - 3];
                    const float b0 = (j < 2) ? wk0[2 * j] : wk1[2 * j - 4], b1 = (j < 2) ? wk0[2 * j + 1] : wk1[2 * j - 3];
                    const float c0 = (j < 2) ? wv0[2 * j] : wv1[2 * j - 4], c1 = (j < 2) ? wv0[2 * j + 1] : wv1[2 * j - 3];
                    q1[2 * j] += a0 * bflo(rq[j]); q1[2 * j + 1] += a1 * bfhi(rq[j]);
                    k1[2 * j] += b0 * bflo(rk[j]); k1[2 * j + 1] += b1 * bfhi(rk[j]);
                    v1[2 * j] += c0 * bflo(rv[j]); v1[2 * j + 1] += c1 * bfhi(rv[j]); } } }
        float sq = 0.f, sk = 0.f;
#pragma unroll
        for (int j = 0; j < 8; ++j) { q1[j] = siluf_(q1[j]); k1[j] = siluf_(k1[j]); v1[j] = siluf_(v1[j]); sq += q1[j] * q1[j]; sk += k1[j] * k1[j]; }
        sq += __shfl_xor(sq, 1); sq += __shfl_xor(sq, 2); sq += __shfl_xor(sq, 4);
        sk += __shfl_xor(sk, 1); sk += __shfl_xor(sk, 2); sk += __shfl_xor(sk, 4);
        const float rq_ = 0.125f * frsq(sq + NORM_EPS), rk_ = frsq(sk + NORM_EPS);
        f32x4 o0, o1;
        o0[0] = q1[0] * rq_; o0[1] = q1[1] * rq_; o0[2] = q1[2] * rq_; o0[3] = q1[3] * rq_; o1[0] = q1[4] * rq_; o1[1] = q1[5] * rq_; o1[2] = q1[6] * rq_; o1[3] = q1[7] * rq_;
        *(LAS f32x4*)(XQ + tr * 64 + 8 * p) = o0; *(LAS f32x4*)(XQ + tr * 64 + 8 * p + 4) = o1;
        o0[0] = k1[0] * rk_; o0[1] = k1[1] * rk_; o0[2] = k1[2] * rk_; o0[3] = k1[3] * rk_; o1[0] = k1[4] * rk_; o1[1] = k1[5] * rk_; o1[2] = k1[6] * rk_; o1[3] = k1[7] * rk_;
        *(LAS f32x4*)(XK + tr * 64 + 8 * p) = o0; *(LAS f32x4*)(XK + tr * 64 + 8 * p + 4) = o1;
        o0[0] = v1[0]; o0[1] = v1[1]; o0[2] = v1[2]; o0[3] = v1[3]; o1[0] = v1[4]; o1[1] = v1[5]; o1[2] = v1[6]; o1[3] = v1[7];
        *(LAS f32x4*)(XV + tr * 64 + 8 * p) = o0; *(LAS f32x4*)(XV + tr * 64 + 8 * p + 4) = o1; }
#pragma unroll
    for (int h2 = 0; h2 < 2; ++h2) {
        if (p == 0) { const int i = ia + 32 * h2;
            const float bl = in.bl[h2], al = in.al[h2];
            const float xx = al + args->in[6][l * 12 + dir * 6 + head];
            const float sp = xx > 20.f ? xx : log1pf(expf(xx));
            GV[i] = -expf(args->in[5][l * 12 + dir * 6 + head]) * sp; BV[i] = sigmoidf_(bl); } }
    lds_barrier();
    float q[2][8], k[2][8], v[2][8];
#pragma unroll
    for (int h2 = 0; h2 < 2; ++h2) { const int i = ia + 32 * h2, tokl = dir ? 63 - i : i;
        const f32x4 a0 = *(const LAS f32x4*)(XQ + tokl * 64 + 8 * p), a1 = *(const LAS f32x4*)(XQ + tokl * 64 + 8 * p + 4), b0 = *(const LAS f32x4*)(XK + tokl * 64 + 8 * p), b1 = *(const LAS f32x4*)(XK + tokl * 64 + 8 * p + 4),
                    c0 = *(const LAS f32x4*)(XV + tokl * 64 + 8 * p), c1 = *(const LAS f32x4*)(XV + tokl * 64 + 8 * p + 4);
#pragma unroll
        for (int j = 0; j < 4; ++j) { q[h2][j] = a0[j]; q[h2][4 + j] = a1[j]; k[h2][j] = b0[j]; k[h2][4 + j] = b1[j]; v[h2][j] = c0[j]; v[h2][4 + j] = c1[j]; } }
    float gcl_;
    { float x = GV[lane];
#pragma unroll
        for (int o = 1; o < 64; o <<= 1) { const float y = __shfl_up(x, o); if (lane >= o) x += y; }
        if (wg == 0) GC[lane] = x;
        gcl_ = x; }
    const float gc0 = __shfl(gcl_, ia), gc1 = __shfl(gcl_, ia + 32), gcl = __shfl(gcl_, 63);
#pragma unroll
    for (int h2 = 0; h2 < 2; ++h2) { const int i = ia + 32 * h2; u32x4 wq, wk;
#pragma unroll
        for (int j = 0; j < 4; ++j) { wq[j] = pk2(q[h2][2 * j], q[h2][2 * j + 1]); wk[j] = pk2(k[h2][2 * j], k[h2][2 * j + 1]); }
        *(LAS u32x4*)(P0 + i * TLD + 8 * p) = wq; *(LAS u32x4*)(P1 + i * TLD + 8 * p) = wk; }
    lds_barrier();
    { const int mat = wg >> 1, mt = wg & 1, hh = lane >> 5;
        float gi[16], bi[16];
#pragma unroll
        for (int r = 0; r < 16; ++r) { const int ii = 32 * mt + crow(r, hh); gi[r] = GC[ii]; bi[r] = BV[ii]; }
        __builtin_amdgcn_sched_barrier(0);
#pragma unroll
        for (int nt = 0; nt < 2; ++nt) { const int jc = 32 * nt + (lane & 31);
            const f32x16 a = mm_tile(mat ? P0 : P1, P1, 32 * mt, 32 * nt, lane);
            const float gj = GC[jc];
            if (mat == 0) {
#pragma unroll
                for (int r = 0; r < 16; ++r) { const int ii = 32 * mt + crow(r, hh); const float ev = bi[r] * a[r] * __expf(gi[r] - gj); AM[ii * 68 + jc] = (jc < ii) ? ev : 0.f; }
            } else {
#pragma unroll
                for (int r = 0; r < 16; ++r) { const int ii = 32 * mt + crow(r, hh); const float ev = a[r] * __expf(gi[r] - gj); INTRA[ii * TLD + jc] = (bf16_t)(pk2((jc <= ii) ? ev : 0.f, 0.f) & 0xffffu); } } } }
    lds_barrier();
    if (wg == dir) {
        const int b = lane >> 5, cidx = lane & 31; float t[32]; typedef float f32x2_ __attribute__((ext_vector_type(2)));
#pragma unroll
        for (int ii = 0; ii < 32; ++ii) t[ii] = (ii == cidx) ? 1.f : 0.f;
        const LAS float* Ab = AM + (32 * b) * 68 + 32 * b;
        f32x4 rb[2][8];
        rb[1][0] = *(const LAS f32x4*)(Ab + 68);
        __builtin_amdgcn_sched_barrier(0);
#pragma unroll
        for (int ii = 1; ii < 32; ++ii) {
            if (ii + 1 < 32) {
#pragma unroll
                for (int j4 = 0; j4 < ii + 1; j4 += 4) rb[(ii + 1) & 1][j4 >> 2] = *(const LAS f32x4*)(Ab + (ii + 1) * 68 + j4); }
            __builtin_amdgcn_sched_barrier(0);
            f32x2_ a0 = {0.f, 0.f}, a1 = {0.f, 0.f};
#pragma unroll
            for (int j4 = 0; j4 < ii; j4 += 4) { const f32x4 a4 = rb[ii & 1][j4 >> 2];
                const f32x2_ tl = {t[j4], t[j4 + 1]}, th = {t[j4 + 2], t[j4 + 3]}, al = {a4[0], a4[1]}, ah = {a4[2], a4[3]};
                a0 += al * tl; a1 += ah * th; }
            a0 += a1; t[ii] -= a0.x + a0.y;
            __builtin_amdgcn_sched_barrier(0); }
        LAS float* td = b ? TD1 : TD0; const int tds = b ? 36 : 48;
#pragma unroll
        for (int ii = 0; ii < 32; ++ii) { td[ii * tds + cidx] = t[ii]; TT[(32 * b + ii) * TLD + 32 * b + cidx] = (bf16_t)(pk2(t[ii], 0.f) & 0xffffu); }
    }
#pragma unroll
    for (int h2 = 0; h2 < 2; ++h2) { const int i = ia + 32 * h2; const float be = BV[i], eg = __expf(h2 ? gc1 : gc0);
#pragma unroll
        for (int j = 0; j < 8; ++j) { const int d = 8 * p + j, o_ = d * TLD + (i ^ tsw(d)); P0[o_] = (bf16_t)(pk2(k[h2][j] * be * eg, 0.f) & 0xffffu); P1[o_] = (bf16_t)(pk2(v[h2][j] * be, 0.f) & 0xffffu); } }
    { unsigned zz; asm volatile("v_mov_b32 %0, 0" : "=v"(zz)); u32x2 z; z.x = zz; z.y = zz; *(LAS u32x2*)(TT + (tg >> 3) * TLD + 32 + 4 * (tg & 7)) = z; }
    lds_barrier();
    { const int qi = wg >> 1, qj = wg & 1, r16 = lane & 15, g4 = lane >> 4; f32x4 pc = {0.f, 0.f, 0.f, 0.f}; float av[8], bw[8];
#pragma unroll
        for (int kk = 0; kk < 8; ++kk) { av[kk] = AM[(32 + 16 * qi + r16) * 68 + 4 * kk + g4]; bw[kk] = TD0[(4 * kk + g4) * 48 + 16 * qj + r16]; }
        __builtin_amdgcn_sched_barrier(0);
#pragma unroll
        for (int kk = 0; kk < 8; ++kk) pc = __builtin_amdgcn_mfma_f32_16x16x4f32(av[kk], bw[kk], pc, 0, 0, 0);
#pragma unroll
        for (int r = 0; r < 4; ++r) PM[(16 * qi + 4 * g4 + r) * 48 + 16 * qj + r16] = pc[r]; }
    lds_barrier();
    { const int qi = wg >> 1, qj = wg & 1, r16 = lane & 15, g4 = lane >> 4; f32x4 pc = {0.f, 0.f, 0.f, 0.f}; float av[8], bw[8];
#pragma unroll
        for (int kk = 0; kk < 8; ++kk) { av[kk] = TD1[(16 * qi + r16) * 36 + 4 * kk + g4]; bw[kk] = PM[(4 * kk + g4) * 48 + 16 * qj + r16]; }
        __builtin_amdgcn_sched_barrier(0);
#pragma unroll
        for (int kk = 0; kk < 8; ++kk) pc = __builtin_amdgcn_mfma_f32_16x16x4f32(av[kk], bw[kk], pc, 0, 0, 0);
#pragma unroll
        for (int r = 0; r < 4; ++r) TT[(32 + 16 * qi + 4 * g4 + r) * TLD + 16 * qj + r16] = (bf16_t)(pk2(-pc[r], 0.f) & 0xffffu); }
    lds_barrier();
    { const int which = wg >> 1, mt = wg & 1, hh = lane >> 5;
#pragma unroll
        for (int nt = 0; nt < 2; ++nt) { const int dc = 32 * nt + (lane & 31);
            const f32x16 a = mm_tile<false, true>(TT, which ? P1 : P0, 32 * mt, 32 * nt, lane);
            LAS bf16_t* dst = (which ? UT : WT) + dc * TLD; const int sw = tsw(dc);
#pragma unroll
            for (int g = 0; g < 4; ++g) { u32x2 w; w.x = pk2(a[4 * g], a[4 * g + 1]); w.y = pk2(a[4 * g + 2], a[4 * g + 3]); *(LAS u32x2*)(dst + ((32 * mt + 8 * g + 4 * hh) ^ sw)) = w; } } }
    lds_barrier();
#pragma unroll
    for (int h2 = 0; h2 < 2; ++h2) { const int i = ia + 32 * h2; const float gci = h2 ? gc1 : gc0, eg = __expf(gci), ekd = __expf(gcl - gci); u32x4 wqd;
#pragma unroll
        for (int j = 0; j < 4; ++j) wqd[j] = pk2(q[h2][2 * j] * eg, q[h2][2 * j + 1] * eg);
        *(LAS u32x4*)(P1 + i * TLD + 8 * p) = wqd;
#pragma unroll
        for (int j = 0; j < 8; ++j) { const int d = 8 * p + j; P0[d * TLD + (i ^ tsw(d))] = (bf16_t)(pk2(k[h2][j] * ekd, 0.f) & 0xffffu); } }
    lds_barrier();
    if (pu_next >= 0) gdn_prep_loads(args, c, pu_next, in);
    { const int hh = lane >> 5, rr = lane & 31;
        if (wg == 0) {
#pragma unroll
            for (int t4 = 0; t4 < 4; ++t4) { const int mtb = t4 >> 1, nta = t4 & 1; const f32x16 a = mm_tile<true, true>(WT, P0, 32 * mtb, 32 * nta, lane);
                f32x16 na; for (int r = 0; r < 16; ++r) na[r] = -a[r];
                *(bf16x8*)(G + (size_t)((nta * 4 + 2 * mtb) * 64 + lane) * 16) = pack8<0>(na); *(bf16x8*)(G + (size_t)((nta * 4 + 2 * mtb + 1) * 64 + lane) * 16) = pack8<1>(na); }
        } else if (wg == 1) {
#pragma unroll
            for (int t4 = 0; t4 < 4; ++t4) { const int mta = t4 >> 1, nte = t4 & 1; const f32x16 a = mm_tile<true, true>(P0, UT, 32 * mta, 32 * nte, lane);
                bf16x8* dp = (bf16x8*)(G + 8192 + (size_t)((nte * 2 + mta) * 64 + lane) * 32); dp[0] = pack8<0>(a); dp[1] = pack8<1>(a); }
        } else if (wg == 2) {
#pragma unroll
            for (int t4 = 0; t4 < 4; ++t4) { const int mtb = t4 >> 1, nti = t4 & 1; const f32x16 a = mm_tile<true, false>(WT, INTRA, 32 * mtb, 32 * nti, lane);
                f32x16 qe; const LAS bf16_t* qd = P1 + (32 * nti + rr) * TLD + 32 * mtb + 4 * hh;
#pragma unroll
                for (int g = 0; g < 4; ++g) { const u32x2 w = *(const LAS u32x2*)(qd + 8 * g); qe[4 * g] = bflo(w.x) - a[4 * g]; qe[4 * g + 1] = bfhi(w.x) - a[4 * g + 1]; qe[4 * g + 2] = bflo(w.y) - a[4 * g + 2]; qe[4 * g + 3] = bfhi(w.y) - a[4 * g + 3]; }
                *(bf16x8*)(G + 16384 + (size_t)((nti * 4 + 2 * mtb) * 64 + lane) * 16) = pack8<0>(qe); *(bf16x8*)(G + 16384 + (size_t)((nti * 4 + 2 * mtb + 1) * 64 + lane) * 16) = pack8<1>(qe); }
        } else {
#pragma unroll
            for (int t4 = 0; t4 < 4; ++t4) { const int mti = t4 >> 1, nte = t4 & 1; const f32x16 a = mm_tile<false, true>(INTRA, UT, 32 * mti, 32 * nte, lane);
                bf16x8* dp = (bf16x8*)(G + 24576) + (size_t)((nte * 2 + mti) * 2) * 64 + lane; dp[0] = pack8<0>(a); dp[64] = pack8<1>(a); }
            if (lane == 0) *(float*)(G + 40960) = __expf(gcl);
        } }
    if (pu_next >= 0) gdn_prep_put_cw(L0, c, in);
    lds_barrier();
}

DI void pv_accum(const f32x16 (&acc)[2][2], f32x16 (&o)[2][2], const LAS bf16_t* Vt, int lane) {
    const int r = lane & 31, hh = lane >> 5;
#pragma unroll
    for (int mt = 0; mt < 2; ++mt) {
        {   const bf16x8 p0 = pack8<0>(acc[mt][0]), p1 = pack8<0>(acc[mt][1]);
#pragma unroll
            for (int mo = 0; mo < 2; ++mo) { const LAS bf16_t* s = Vt + (32 * mo + r) * TLD; const int c0 = (32 * mt + 4 * hh) ^ tsw(32 * mo + r);
                const u32x2 lo = *(const LAS u32x2*)(s + c0), hi = *(const LAS u32x2*)(s + (c0 ^ 8)); u32x4 w; w.x = lo.x; w.y = lo.y; w.z = hi.x; w.w = hi.y; const bf16x8 vf = __builtin_bit_cast(bf16x8, w);
                o[mo][0] = MFMA32(vf, p0, o[mo][0]); o[mo][1] = MFMA32(vf, p1, o[mo][1]); } }
        {   const bf16x8 p0 = pack8<1>(acc[mt][0]), p1 = pack8<1>(acc[mt][1]);
#pragma unroll
            for (int mo = 0; mo < 2; ++mo) { const LAS bf16_t* s = Vt + (32 * mo + r) * TLD; const int c0 = (32 * mt + 16 + 4 * hh) ^ tsw(32 * mo + r);
                const u32x2 lo = *(const LAS u32x2*)(s + c0), hi = *(const LAS u32x2*)(s + (c0 ^ 8)); u32x4 w; w.x = lo.x; w.y = lo.y; w.z = hi.x; w.w = hi.y; const bf16x8 vf = __builtin_bit_cast(bf16x8, w);
                o[mo][0] = MFMA32(vf, p0, o[mo][0]); o[mo][1] = MFMA32(vf, p1, o[mo][1]); } }
    }
}
template <class F> DI void load_v(u32x4 (&vr)[8], int lane, F vrow) {
#pragma unroll
    for (int it = 0; it < 8; ++it) { const int id = it * 64 + lane, key = id >> 3, part = id & 7; vr[it] = *(const u32x4*)(vrow(key) + 8 * part); }
}
DI void put_vt(LAS bf16_t* Vt, int lane, const u32x4 (&vr)[8]) {
#pragma unroll
    for (int it = 0; it < 8; ++it) { const int id = it * 64 + lane, key = id >> 3, part = id & 7; const u32x4 w = vr[it];
#pragma unroll
        for (int j = 0; j < 4; ++j) { const int d0 = 8 * part + 2 * j, ks_ = key ^ tsw(d0); Vt[d0 * TLD + ks_] = (bf16_t)(w[j] & 0xffffu); Vt[(d0 + 1) * TLD + ks_] = (bf16_t)(w[j] >> 16); } }
}
DI void write_o_slot(LAS float* SL, const f32x16 (&o)[2][2], int lane) {
    const int r = lane & 31, hh = lane >> 5;
#pragma unroll
    for (int mo = 0; mo < 2; ++mo)
#pragma unroll
        for (int nt = 0; nt < 2; ++nt)
#pragma unroll
            for (int g = 0; g < 4; ++g) { f32x4 v; v[0] = o[mo][nt][4 * g]; v[1] = o[mo][nt][4 * g + 1]; v[2] = o[mo][nt][4 * g + 2]; v[3] = o[mo][nt][4 * g + 3];
                *(LAS f32x4*)(SL + (32 * nt + r) * 68 + 32 * mo + 8 * g + 4 * hh) = v; }
}
DI void add_o_slot(const LAS float* SL, f32x16 (&o)[2][2], int lane) {
    const int r = lane & 31, hh = lane >> 5;
#pragma unroll
    for (int mo = 0; mo < 2; ++mo)
#pragma unroll
        for (int nt = 0; nt < 2; ++nt)
#pragma unroll
            for (int g = 0; g < 4; ++g) { const f32x4 v = *(const LAS f32x4*)(SL + (32 * nt + r) * 68 + 32 * mo + 8 * g + 4 * hh);
                o[mo][nt][4 * g] += v[0]; o[mo][nt][4 * g + 1] += v[1]; o[mo][nt][4 * g + 2] += v[2]; o[mo][nt][4 * g + 3] += v[3]; }
}

constexpr int WAREA = 10240;
DI void osm_update(f32x16 (&acc)[2][2], f32x16 (&o)[2][2], float (&m)[2], float (&l)[2]) {
#pragma unroll
    for (int nt = 0; nt < 2; ++nt) { float mx = -1e30f;
#pragma unroll
        for (int mt = 0; mt < 2; ++mt)
#pragma unroll
            for (int g = 0; g < 16; ++g) mx = fmaxf(mx, acc[mt][nt][g]);
        mx = fmaxf(mx, __shfl_xor(mx, 32));
        const float mn = fmaxf(m[nt], mx), sc = __expf(m[nt] - mn); float sm = 0.f;
#pragma unroll
        for (int mt = 0; mt < 2; ++mt)
#pragma unroll
            for (int g = 0; g < 16; ++g) { const float pz = __expf(acc[mt][nt][g] - mn); acc[mt][nt][g] = pz; sm += pz; }
        sm += __shfl_xor(sm, 32);
        l[nt] = l[nt] * sc + sm; m[nt] = mn;
#pragma unroll
        for (int g = 0; g < 16; ++g) { o[0][nt][g] *= sc; o[1][nt][g] *= sc; } }
}
template <class F> DI void store_o_rows(LAS bf16_t* T, const f32x16 (&o)[2][2], const float (&scale)[2], int lane, F rowp) {
    const int r = lane & 31, hh = lane >> 5;
#pragma unroll
    for (int mo = 0; mo < 2; ++mo)
#pragma unroll
        for (int nt = 0; nt < 2; ++nt)
#pragma unroll
            for (int g = 0; g < 4; ++g) { u32x2 w; w.x = pk2(o[mo][nt][4 * g] * scale[nt], o[mo][nt][4 * g + 1] * scale[nt]); w.y = pk2(o[mo][nt][4 * g + 2] * scale[nt], o[mo][nt][4 * g + 3] * scale[nt]);
                *(LAS u32x2*)(T + (32 * nt + r) * TLD + 32 * mo + 8 * g + 4 * hh) = w; }
    asm volatile("s_waitcnt lgkmcnt(0)" ::: "memory");
#pragma unroll
    for (int it = 0; it < 8; ++it) { const int id = it * 64 + lane, q = id >> 3, part = id & 7; *(u32x4*)(rowp(q) + 8 * part) = *(const LAS u32x4*)(T + q * TLD + 8 * part); }
    asm volatile("s_waitcnt lgkmcnt(0)" ::: "memory");
}
DI void na_wave_unit(KArgs args, LAS unsigned char* L, const Ctx& c, int u, int lane, int wave) {
    const int l = c.layer, head = u & 3, gr = u >> 2, rows = c.seqlen >> 6, seq = gr / rows, r = gr % rows;
    int rs = r - 4; rs = rs < 0 ? 0 : (rs > rows - 8 ? rows - 8 : rs);
    const bf16_t* PROJ = BIGP(bf16_t, B_PROJ);
    const size_t tq0 = (size_t)seq * c.seqlen + (size_t)r * 64;
    LAS bf16_t* Vt = (LAS bf16_t*)(L + wave * WAREA);
    LAS float* BIAS = (LAS float*)(L + wave * WAREA + 9216);
    const int rr = lane & 31, hh = lane >> 5;
#pragma unroll
    for (int w = 0; w < 4; ++w) { const int idx = w * 64 + lane, kw = idx >> 5, dc = idx & 31;
        if (dc < 31) BIAS[idx] = args->in[3][(((size_t)l * 4 + head) * 15 + (rs + kw - r + 7)) * 31 + dc]; }
    bf16x8 qf[2][4];
#pragma unroll
    for (int nt = 0; nt < 2; ++nt)
#pragma unroll
        for (int ks = 0; ks < 4; ++ks) qf[nt][ks] = *(const bf16x8*)(PROJ + (tq0 + 32 * nt + rr) * NPROJ + C_QA + 64 * head + 16 * ks + 8 * hh);
    f32x16 o[2][2]; o[0][0] = zero16(); o[0][1] = zero16(); o[1][0] = zero16(); o[1][1] = zero16();
    float m[2] = {-1e30f, -1e30f}, ls[2] = {0.f, 0.f};
    for (int w = 0; w < 8; ++w) {
        const size_t tk0 = (size_t)seq * c.seqlen + (size_t)(rs + w) * 64;
        u32x4 vr[8]; bf16x8 kf[2][4];
        load_v(vr, lane, [&](int key) { return PROJ + (tk0 + key) * NPROJ + C_VA + 64 * head; });
#pragma unroll
        for (int mt = 0; mt < 2; ++mt)
#pragma unroll
            for (int ks = 0; ks < 4; ++ks) kf[mt][ks] = *(const bf16x8*)(PROJ + (tk0 + 32 * mt + rr) * NPROJ + C_KA + 64 * head + 16 * ks + 8 * hh);
        __builtin_amdgcn_sched_barrier(0);
        asm volatile("s_waitcnt lgkmcnt(0)" ::: "memory");
        put_vt(Vt, lane, vr);
        f32x16 acc[2][2]; acc[0][0] = zero16(); acc[0][1] = zero16(); acc[1][0] = zero16(); acc[1][1] = zero16();
#pragma unroll
        for (int mt = 0; mt < 2; ++mt)
#pragma unroll
            for (int ks = 0; ks < 4; ++ks) { acc[mt][0] = MFMA32(kf[mt][ks], qf[0][ks], acc[mt][0]); acc[mt][1] = MFMA32(kf[mt][ks], qf[1][ks], acc[mt][1]); }
        asm volatile("s_waitcnt lgkmcnt(0)" ::: "memory");
        const LAS float* brow = BIAS + w * 32;
#pragma unroll
        for (int nt = 0; nt < 2; ++nt) { const int qc = 32 * nt + rr; int ws = qc - 8; ws = ws < 0 ? 0 : (ws > 48 ? 48 : ws);
#pragma unroll
            for (int mt = 0; mt < 2; ++mt) {
                const volatile LAS float* bp = brow + (32 * mt + 4 * hh - qc + 15); float bv[16];
#pragma unroll
                for (int g = 0; g < 16; ++g) { const bool live = (mt == nt) || (nt == 0 ? g < 4 : g >= 12);
                    bv[g] = live ? bp[(g & 3) + 8 * (g >> 2)] : 0.f; }
#pragma unroll
                for (int g = 0; g < 16; ++g) { const bool live = (mt == nt) || (nt == 0 ? g < 4 : g >= 12); const int kc = 32 * mt + crow(g, hh); const bool ok = live && (kc >= ws) && (kc < ws + 16);
                    acc[mt][nt][g] = ok ? acc[mt][nt][g] * 0.125f + bv[g] : -1e30f; } } }
        osm_update(acc, o, m, ls);
        pv_accum(acc, o, Vt, lane);
    }
    asm volatile("s_waitcnt lgkmcnt(0)" ::: "memory");
    const float sc[2] = {frcp(ls[0]), frcp(ls[1])};
    store_o_rows(Vt, o, sc, lane, [&](int q) { return BIGP(bf16_t, B_ONA) + (tq0 + q) * 768 + 64 * head; });
}
struct RopeCS { f32x4 v[2][4]; };
DI void rope_load(RopeCS& t, const float* cs, int hh) {
#pragma unroll
    for (int ks = 0; ks < 2; ++ks) { const float* cp = cs + 16 * ks + 8 * hh; t.v[ks][0] = *(const f32x4*)cp; t.v[ks][1] = *(const f32x4*)(cp + 4); t.v[ks][2] = *(const f32x4*)(cp + 32); t.v[ks][3] = *(const f32x4*)(cp + 36); }
}
DI void rope_frag4(bf16x8 (&f)[4], const RopeCS& t) {
#pragma unroll
    for (int ks = 0; ks < 2; ++ks) {
        const f32x4 c0 = t.v[ks][0], c1 = t.v[ks][1], s0 = t.v[ks][2], s1 = t.v[ks][3];
        const u32x4 a = __builtin_bit_cast(u32x4, f[ks]), b = __builtin_bit_cast(u32x4, f[ks + 2]); u32x4 ra, rb;
#pragma unroll
        for (int j = 0; j < 4; ++j) { const float cl = (j < 2) ? c0[2 * j] : c1[2 * j - 4], ch = (j < 2) ? c0[2 * j + 1] : c1[2 * j - 3];
            const float sl = (j < 2) ? s0[2 * j] : s1[2 * j - 4], sh = (j < 2) ? s0[2 * j + 1] : s1[2 * j - 3];
            const float x1l = bflo(a[j]), x1h = bfhi(a[j]), x2l = bflo(b[j]), x2h = bfhi(b[j]);
            ra[j] = pk2(x1l * cl - x2l * sl, x1h * ch - x2h * sh); rb[j] = pk2(x1l * sl + x2l * cl, x1h * sh + x2h * ch); }
        f[ks] = __builtin_bit_cast(bf16x8, ra); f[ks + 2] = __builtin_bit_cast(bf16x8, rb); }
}
DI void dil_wave_unit(KArgs args, LAS unsigned char* L, const Ctx& c, int u, int lane, int wave) {
    const int hd = u & 1, uu = u >> 1, upg = c.stok >> 6, g = uu / upg, v = uu % upg, ups = c.seqlen >> 6, seq = v / ups, wq = v % ups;
    const int dsh = 2 * g, dd = 1 << dsh, nb = ups >> dsh, cls = wq / nb, jb = wq % nb, head = 2 * g + hd;
    const bf16_t* PROJ = BIGP(bf16_t, B_PROJ); const float* CS = WSP(float, WS_CS);
    const size_t sb = (size_t)seq * c.seqlen;
    const int rr = lane & 31, hh = lane >> 5;
    LAS bf16_t* Vt = (LAS bf16_t*)(L + wave * WAREA);
    bf16x8 qf[2][4];
#pragma unroll
    for (int nt = 0; nt < 2; ++nt) { const int pos = cls + dd * (64 * jb + 32 * nt + rr);
#pragma unroll
        for (int ks = 0; ks < 4; ++ks) qf[nt][ks] = *(const bf16x8*)(PROJ + (sb + pos) * NPROJ + C_QD + 64 * head + 16 * ks + 8 * hh);
        RopeCS tq; rope_load(tq, CS + (size_t)pos * 64, hh); __builtin_amdgcn_sched_barrier(0);
        rope_frag4(qf[nt], tq); }
    f32x16 o[2][2]; o[0][0] = zero16(); o[0][1] = zero16(); o[1][0] = zero16(); o[1][1] = zero16();
    float m[2] = {-1e30f, -1e30f}, ls[2] = {0.f, 0.f};
    for (int kt = 0; kt < 3; ++kt) { const int kj = jb - 1 + kt;
        if (kj < 0 || kj >= nb) continue;
        u32x4 vr[8]; bf16x8 kfa[2][4];
        load_v(vr, lane, [&](int key) { return PROJ + (sb + cls + (size_t)dd * (64 * kj + key)) * NPROJ + C_VD + 64 * head; });
#pragma unroll
        for (int mt = 0; mt < 2; ++mt) { const int pos = cls + dd * (64 * kj + 32 * mt + rr);
#pragma unroll
            for (int ks = 0; ks < 4; ++ks) kfa[mt][ks] = *(const bf16x8*)(PROJ + (sb + pos) * NPROJ + C_KD + 64 * head + 16 * ks + 8 * hh); }
        __builtin_amdgcn_sched_barrier(0);
        asm volatile("s_waitcnt lgkmcnt(0)" ::: "memory");
        put_vt(Vt, lane, vr);
        f32x16 acc[2][2]; acc[0][0] = zero16(); acc[0][1] = zero16(); acc[1][0] = zero16(); acc[1][1] = zero16();
#pragma unroll
        for (int mt = 0; mt < 2; ++mt) {
            RopeCS tk; rope_load(tk, CS + (size_t)(cls + dd * (64 * kj + 32 * mt + rr)) * 64, hh); __builtin_amdgcn_sched_barrier(0);
            rope_frag4(kfa[mt], tk);
#pragma unroll
            for (int ks = 0; ks < 4; ++ks) { acc[mt][0] = MFMA32(kfa[mt][ks], qf[0][ks], acc[mt][0]); acc[mt][1] = MFMA32(kfa[mt][ks], qf[1][ks], acc[mt][1]); } }
#pragma unroll
        for (int nt = 0; nt < 2; ++nt) { const int qc = 32 * nt + rr;
#pragma unroll
            for (int mt = 0; mt < 2; ++mt)
#pragma unroll
                for (int gg = 0; gg < 16; ++gg) { const int kc = 32 * mt + crow(gg, hh); const bool ok = (kt == 1) || (kt == 0 ? (kc >= qc) : (kc <= qc));
                    acc[mt][nt][gg] = ok ? acc[mt][nt][gg] * 0.125f : -1e30f; } }
        osm_update(acc, o, m, ls);
        pv_accum(acc, o, Vt, lane);
    }
    asm volatile("s_waitcnt lgkmcnt(0)" ::: "memory");
    bf16_t* DP = BIGP(bf16_t, B_DILP); float* DM = BIGP(float, B_DILM);
    const float one[2] = {1.f, 1.f};
    store_o_rows(Vt, o, one, lane, [&](int q) { return DP + ((((size_t)g * SLABMAX + sb + cls + (size_t)dd * (64 * jb + q)) * 2 + hd)) * 64; });
    if (hh == 0) {
#pragma unroll
        for (int nt = 0; nt < 2; ++nt) { const size_t base = (((size_t)g * SLABMAX + sb + cls + (size_t)dd * (64 * jb + 32 * nt + rr)) * 2 + hd); DM[base * 2] = m[nt]; DM[base * 2 + 1] = ls[nt]; } }
}

DI void phase_mix_a(KArgs args, LAS unsigned char* L, const Ctx& c) {
    const int N_PREP = (c.stok >> 6) * 6;
    PrepIn in; if (c.bid < N_PREP) { gdn_prep_loads(args, c, c.bid, in); gdn_prep_put_cw(L, c, in); lds_barrier(); }
    for (int u = c.bid; u < N_PREP; u += c.G) gdn_prep_pair(args, L, c, u, in, u + c.G < N_PREP ? u + c.G : -1);
}
DI void attn_wave_units(KArgs args, LAS unsigned char* L, const Ctx& c) {
    int tid = c.tid; asm volatile("" : "+v"(tid)); const int lane = tid & 63, wave = __builtin_amdgcn_readfirstlane(tid >> 6);
    const int nch_ = c.stok >> 6, N_NA = nch_ * 4, N_DIL = nch_ * 6;
    unsigned* q = (unsigned*)(c.ws + WS_CTL) + 32768 + 128 * (c.layer * 4 + c.slab);
    for (;;) { unsigned u = 0; if (lane == 0) u = __hip_atomic_fetch_add(q, 1u, __ATOMIC_RELAXED, __HIP_MEMORY_SCOPE_AGENT);
        u = (unsigned)__builtin_amdgcn_readfirstlane((int)u); if (u >= (unsigned)N_NA) break; na_wave_unit(args, L, c, (int)u, lane, wave); }
    int tid2 = c.tid; asm volatile("" : "+v"(tid2)); const int lane2 = tid2 & 63, wave2 = __builtin_amdgcn_readfirstlane(tid2 >> 6);
    for (;;) { unsigned u = 0; if (lane2 == 0) u = __hip_atomic_fetch_add(q + 64, 1u, __ATOMIC_RELAXED, __HIP_MEMORY_SCOPE_AGENT);
        u = (unsigned)__builtin_amdgcn_readfirstlane((int)u); if (u >= (unsigned)N_DIL) break; dil_wave_unit(args, L, c, (int)u, lane2, wave2); }
}

DI void phase_select(KArgs args, LAS unsigned char* L, const Ctx& c, int inst);
DI void phase_scan(KArgs args, LAS unsigned char* L, const Ctx& c) {
    if (c.slab == NSLAB - 1 && c.bid >= 24 && c.bid < 40) { phase_select(args, L, c, c.bid - 24); return; }
    const int nwu = c.nseq * 24, wu = c.bid;
    if (wu < nwu && c.wave == 0) {
        const int lane = c.lane;
        const int chain = wu >> 1, nt = wu & 1, seq = chain / 12, rem = chain % 12, head = rem >> 1, dir = rem & 1;
        const int nch = c.seqlen >> 6, gch0 = seq * nch;
        unsigned char* GS = BIGP(unsigned char, B_GSCR);
        f32x16 S[2]; S[0] = zero16(); S[1] = zero16();
        bf16x8 A[2][2][4]; u32x4 cm[2][2][2];
        const long gstep = (long)(dir ? -1 : 1) * 12 * GSTRIDE;
        const unsigned char* G0 = GS + (size_t)(((gch0 + (dir ? nch - 1 : 0)) * 6 + head) * 2 + dir) * GSTRIDE;
        unsigned char* Gs = (unsigned char*)G0;
        float glv[4];
#pragma unroll
        for (int q = 0; q < 4; ++q) { const int sq = q * 64 + lane; glv[q] = *(const float*)(G0 + (long)(sq < nch ? sq : nch - 1) * gstep + 40960); }
        LAS unsigned char* RING = L + 81920;
        int dslot = 0, rslot = 0, dstage = 0;
#define SCAN_DMA() do { const unsigned char* gp = G0 + (long)(dstage < nch ? dstage : nch - 1) * gstep; LAS unsigned char* sl = RING + dslot * 12288; \
            _Pragma("unroll") for (int j = 0; j < 8; ++j) __builtin_amdgcn_global_load_lds((const unsigned*)(gp + (size_t)(j * 64 + lane) * 16), (LAS unsigned*)(sl + j * 1024), 16, 0, 0); \
            _Pragma("unroll") for (int j = 0; j < 4; ++j) __builtin_amdgcn_global_load_lds((const unsigned*)(gp + 8192 + (size_t)((nt * 2 + (j >> 1)) * 64 + lane) * 32 + (j & 1) * 16), (LAS unsigned*)(sl + 8192 + j * 1024), 16, 0, 0); \
            ++dstage; dslot = dslot == 4 ? 0 : dslot + 1; } while (0)
#define SCAN_LOAD(B) do { const LAS unsigned char* sl = RING + rslot * 12288 + lane * 16; \
            _Pragma("unroll") for (int mt = 0; mt < 2; ++mt) { _Pragma("unroll") for (int ks = 0; ks < 4; ++ks) A[B][mt][ks] = *(const LAS bf16x8*)(sl + (mt * 4 + ks) * 1024); \
                cm[B][mt][0] = *(const LAS u32x4*)(sl + 8192 + (mt * 2) * 1024); cm[B][mt][1] = *(const LAS u32x4*)(sl + 8192 + (mt * 2 + 1) * 1024); } \
            rslot = rslot == 4 ? 0 : rslot + 1; } while (0)
#define SCAN_STEP(B, st) do { const bf16x8 b0 = pack8<0>(S[0]), b1 = pack8<1>(S[0]), b2 = pack8<0>(S[1]), b3 = pack8<1>(S[1]); f32x16 nw[2]; \
            { bf16x8* St = (bf16x8*)(Gs + 32768) + (nt * 4) * 64 + lane; St[0] = b0; St[64] = b1; St[128] = b2; St[192] = b3; }     \
            const int sq_ = (st) >> 6; const float gsel = sq_ == 0 ? glv[0] : (sq_ == 1 ? glv[1] : (sq_ == 2 ? glv[2] : glv[3])); \
            const float glc = __builtin_bit_cast(float, __builtin_amdgcn_readlane(__builtin_bit_cast(int, gsel), (st) & 63)); \
            _Pragma("unroll") for (int mt = 0; mt < 2; ++mt) { \
                _Pragma("unroll") for (int g = 0; g < 8; ++g) { const unsigned wv = (g < 4) ? cm[B][mt][0][g] : cm[B][mt][1][g - 4]; nw[mt][2 * g] = glc * S[mt][2 * g] + bflo(wv); nw[mt][2 * g + 1] = glc * S[mt][2 * g + 1] + bfhi(wv); } \
                nw[mt] = MFMA32(A[B][mt][0], b0, nw[mt]); nw[mt] = MFMA32(A[B][mt][1], b1, nw[mt]); nw[mt] = MFMA32(A[B][mt][2], b2, nw[mt]); nw[mt] = MFMA32(A[B][mt][3], b3, nw[mt]); } \
            S[0] = nw[0]; S[1] = nw[1]; Gs += gstep; } while (0)
        SCAN_DMA(); SCAN_DMA(); SCAN_DMA(); SCAN_DMA(); SCAN_DMA();
        asm volatile("s_waitcnt vmcnt(48)" ::: "memory"); SCAN_LOAD(0);
        asm volatile("s_waitcnt vmcnt(36)" ::: "memory"); SCAN_LOAD(1);
        for (int step = 0; step < nch; step += 2) {
            SCAN_STEP(0, step);     asm volatile("s_waitcnt vmcnt(24)" ::: "memory"); SCAN_LOAD(0); SCAN_DMA();
            SCAN_STEP(1, step + 1); asm volatile("s_waitcnt vmcnt(24)" ::: "memory"); SCAN_LOAD(1); SCAN_DMA();
        }
        asm volatile("s_waitcnt vmcnt(0)" ::: "memory");
#undef SCAN_DMA
#undef SCAN_LOAD
#undef SCAN_STEP
    }
    attn_wave_units(args, L, c);
}

DI void dil_merge(const Ctx& c) {
    { const bf16_t* DP = BIGP(bf16_t, B_DILP); const float* DM = BIGP(float, B_DILM); bf16_t* OD = BIGP(bf16_t, B_ONA) + 256;
        for (int it = c.bid * 512 + c.tid; it < c.stok * 32; it += c.G * 512) { const int tok = it >> 5, part = it & 31;
            u32x4 w = {0u, 0u, 0u, 0u};
            if (part < 16) { const int hd = part >> 3, p = part & 7; float m[3], dn[3];
#pragma unroll
                for (int g = 0; g < 3; ++g) { const size_t b = (((size_t)g * SLABMAX + tok) * 2 + hd); m[g] = DM[b * 2]; dn[g] = DM[b * 2 + 1]; }
                const float M = fmaxf(m[0], fmaxf(m[1], m[2])); float num[8], den = 0.f;
#pragma unroll
                for (int j = 0; j < 8; ++j) num[j] = 0.f;
#pragma unroll
                for (int g = 0; g < 3; ++g) { const float f = __expf(m[g] - M); den += f * dn[g]; const u32x4 a = *(const u32x4*)(DP + (((size_t)g * SLABMAX + tok) * 2 + hd) * 64 + 8 * p);
                    num[0] += f * bflo(a[0]); num[1] += f * bfhi(a[0]); num[2] += f * bflo(a[1]); num[3] += f * bfhi(a[1]); num[4] += f * bflo(a[2]); num[5] += f * bfhi(a[2]); num[6] += f * bflo(a[3]); num[7] += f * bfhi(a[3]); }
                const float inv = frcp(den);
                w.x = pk2(num[0] * inv, num[1] * inv); w.y = pk2(num[2] * inv, num[3] * inv); w.z = pk2(num[4] * inv, num[5] * inv); w.w = pk2(num[6] * inv, num[7] * inv); }
            if (part < 16) *(u32x4*)(OD + (size_t)tok * 768 + 8 * part) = w; } }
}

DI void phase_gdn_out(KArgs args, LAS unsigned char* L, const Ctx& c) {
    dil_merge(c);
    const int lane = c.lane, wave = c.wave, tid = c.tid, l = c.layer;
    const bf16_t* PROJ = BIGP(bf16_t, B_PROJ); unsigned char* GS = BIGP(unsigned char, B_GSCR); bf16_t* OG = BIGP(bf16_t, B_ONA) + 384;
    LAS float* OF = (LAS float*)L;
    const int NU = (c.stok >> 6) * 6; const int dir = wave >> 2, mt = (wave >> 1) & 1, nt = wave & 1, rr = lane & 31, hh = lane >> 5;
    const float* nw = args->in[7] + l * 64 + 8 * (tid & 7); const f32x4 nw0 = *(const f32x4*)nw, nw1 = *(const f32x4*)(nw + 4);
    bf16x8 qa[4], sb_[4]; u32x4 oc0, oc1, zw;
#define GOUT_LOAD(uu) do { const int gch_ = (uu) / 6, head_ = (uu) % 6; const unsigned char* G = GS + (size_t)((gch_ * 6 + head_) * 2 + dir) * GSTRIDE; \
        const bf16_t* Qe = (const bf16_t*)(G + 16384); const u32x4* Oct = (const u32x4*)(G + 24576); const bf16x8* St = (const bf16x8*)(G + 32768); \
        _Pragma("unroll") for (int ks = 0; ks < 4; ++ks) { qa[ks] = *(const bf16x8*)(Qe + (size_t)((mt * 4 + ks) * 64 + lane) * 8); sb_[ks] = St[(nt * 4 + ks) * 64 + lane]; } \
        oc0 = Oct[((nt * 2 + mt) * 2) * 64 + lane]; oc1 = Oct[((nt * 2 + mt) * 2 + 1) * 64 + lane]; \
        zw = *(const u32x4*)(PROJ + ((size_t)gch_ * 64 + (tid >> 3)) * NPROJ + C_ZC + 64 * head_ + 8 * (tid & 7)); } while (0)
    if (c.bid < NU) GOUT_LOAD(c.bid);
    for (int u = c.bid; u < NU; u += c.G) { const int gch = u / 6, head = u % 6;
        bf16x8 qc[4], sc[4]; const u32x4 o0 = oc0, o1 = oc1, zc = zw;
#pragma unroll
        for (int ks = 0; ks < 4; ++ks) { qc[ks] = qa[ks]; sc[ks] = sb_[ks]; }
        { int un = u + c.G; un = un < NU ? un : u; GOUT_LOAD(un); }
        __builtin_amdgcn_sched_barrier(0);
        {   f32x16 acc = zero16();
#pragma unroll
            for (int ks = 0; ks < 4; ++ks) acc = MFMA32(qc[ks], sc[ks], acc);
            const int e = 32 * nt + rr;
#pragma unroll
            for (int g = 0; g < 4; ++g) { u32x2 w; w.x = (g == 0) ? o0.x : (g == 1) ? o0.z : (g == 2) ? o1.x : o1.z; w.y = (g == 0) ? o0.y : (g == 1) ? o0.w : (g == 2) ? o1.y : o1.w;
                const float v0 = acc[4 * g] + bflo(w.x), v1 = acc[4 * g + 1] + bfhi(w.x), v2 = acc[4 * g + 2] + bflo(w.y), v3 = acc[4 * g + 3] + bfhi(w.y);
                const int i0 = 32 * mt + 8 * g + 4 * hh;
#pragma unroll
                for (int j = 0; j < 4; ++j) { const int ii = i0 + j, tl = dir ? 63 - ii : ii; OF[(dir * 64 + tl) * 68 + e] = (j == 0) ? v0 : (j == 1) ? v1 : (j == 2) ? v2 : v3; } } }
        lds_barrier();
        { const int i = tid >> 3, p = tid & 7; const size_t tok = (size_t)gch * 64 + i;
            const LAS float* a = OF + i * 68 + 8 * p; const LAS float* b = OF + (64 + i) * 68 + 8 * p;
            float ov[8]; float ss = 0.f;
#pragma unroll
            for (int j = 0; j < 8; ++j) { ov[j] = a[j] + b[j]; ss += ov[j] * ov[j]; }
            ss += __shfl_xor(ss, 1); ss += __shfl_xor(ss, 2); ss += __shfl_xor(ss, 4);
            const float rs = frsq(ss * (1.0f / 64.0f) + NORM_EPS);
            float r[8];
#pragma unroll
            for (int j = 0; j < 4; ++j) { const float n0 = j < 2 ? nw0[2 * j] : nw1[2 * j - 4], n1 = j < 2 ? nw0[2 * j + 1] : nw1[2 * j - 3];
                r[2 * j] = ov[2 * j] * rs * n0 * siluf_(bflo(zc[j])); r[2 * j + 1] = ov[2 * j + 1] * rs * n1 * siluf_(bfhi(zc[j])); }
            u32x4 w; w.x = pk2(r[0], r[1]); w.y = pk2(r[2], r[3]); w.z = pk2(r[4], r[5]); w.w = pk2(r[6], r[7]);
            *(u32x4*)(OG + tok * 768 + 64 * head + 8 * p) = w; }
        lds_barrier();
    }
#undef GOUT_LOAD
}

DI void phase_ln1(KArgs args, LAS unsigned char* L, const Ctx& c) {
    const int lane = c.lane, l = c.layer;
    LAS float* WR = (LAS float*)L;
    { const float* wr = args->in[14] + (size_t)l * D * 16;
        for (int i = c.tid; i < D * 16; i += 512) { const int col = i >> 4, e = i & 15, j = col >> 8, ln = (col >> 2) & 63, q = col & 3; WR[((j * 4 + q) * 64 + ln) * 20 + e] = wr[i]; } }
    __syncthreads();
    const float* g1 = args->in[12] + l * D; const float* b1 = args->in[13] + l * D;
    f32x4 gv[4], bv[4];
#pragma unroll
    for (int j = 0; j < 4; ++j) { gv[j] = *(const f32x4*)(g1 + 4 * lane + 256 * j); bv[j] = *(const f32x4*)(b1 + 4 * lane + 256 * j); }
    float* AFF = WSP(float, WS_AFF); int* SLOT = WSP(int, WS_SLOT); bf16_t* XB = WSP(bf16_t, WS_XB);
    u32x2 nv[4];
    { const int rl0 = c.bid * 8 + c.wave; if (rl0 < c.stok) { const bf16_t* hp = (const bf16_t*)c.out + ((size_t)c.sbase + rl0) * D;
#pragma unroll
        for (int j = 0; j < 4; ++j) nv[j] = *(const u32x2*)(hp + 4 * lane + 256 * j); } }
    for (int rl = c.bid * 8 + c.wave; rl < c.stok; rl += c.G * 8) { const size_t tok = (size_t)c.sbase + rl;
        const bf16_t* hr = (const bf16_t*)c.out + tok * D; f32x4 v[4]; float s = 0.f;
#pragma unroll
        for (int j = 0; j < 4; ++j) { v[j][0] = bflo(nv[j].x); v[j][1] = bfhi(nv[j].x); v[j][2] = bflo(nv[j].y); v[j][3] = bfhi(nv[j].y); s += (v[j][0] + v[j][1]) + (v[j][2] + v[j][3]); }
        if (rl + c.G * 8 < c.stok) { const bf16_t* hp = hr + (size_t)c.G * 8 * D;
#pragma unroll
            for (int j = 0; j < 4; ++j) nv[j] = *(const u32x2*)(hp + 4 * lane + 256 * j); }
        const float mean = wave_sum(s) * (1.0f / D); float s2 = 0.f;
#pragma unroll
        for (int j = 0; j < 4; ++j) { v[j] = v[j] - mean; s2 += (v[j][0] * v[j][0] + v[j][1] * v[j][1]) + (v[j][2] * v[j][2] + v[j][3] * v[j][3]); }
        const float rstd = frsq(wave_sum(s2) * (1.0f / D) + LN_EPS);
        float lg[16];
#pragma unroll
        for (int e = 0; e < 16; ++e) lg[e] = 0.f;
#pragma unroll
        for (int j = 0; j < 4; ++j) { v[j] = v[j] * rstd * gv[j] + bv[j];
            if (!c.dry) { u32x2 w; w.x = pk2(v[j][0], v[j][1]); w.y = pk2(v[j][2], v[j][3]); *(u32x2*)(XB + tok * D + 4 * lane + 256 * j) = w; }
#pragma unroll
            for (int q = 0; q < 4; ++q) { const LAS float* wp = WR + ((j * 4 + q) * 64 + lane) * 20; const float xv = v[j][q];
#pragma unroll
                for (int e4 = 0; e4 < 4; ++e4) { const f32x4 w4 = *(const LAS f32x4*)(wp + 4 * e4); lg[4 * e4] += xv * w4[0]; lg[4 * e4 + 1] += xv * w4[1]; lg[4 * e4 + 2] += xv * w4[2]; lg[4 * e4 + 3] += xv * w4[3]; } }
            asm volatile("" ::: "memory"); }
        const bool h5 = (lane & 32) != 0, h4 = (lane & 16) != 0, h3 = (lane & 8) != 0, h2 = (lane & 4) != 0;
        const int eid = (h5 ? 8 : 0) + (h4 ? 4 : 0) + (h3 ? 2 : 0) + (h2 ? 1 : 0);
        float a8[8], b4[4], c2[2], d;
#pragma unroll
        for (int k = 0; k < 8; ++k) { const float snd = h5 ? lg[k] : lg[k + 8]; a8[k] = (h5 ? lg[k + 8] : lg[k]) + __shfl_xor(snd, 32); }
#pragma unroll
        for (int k = 0; k < 4; ++k) { const float snd = h4 ? a8[k] : a8[k + 4]; b4[k] = (h4 ? a8[k + 4] : a8[k]) + __shfl_xor(snd, 16); }
#pragma unroll
        for (int k = 0; k < 2; ++k) { const float snd = h3 ? b4[k] : b4[k + 2]; c2[k] = (h3 ? b4[k + 2] : b4[k]) + __shfl_xor(snd, 8); }
        { const float snd = h2 ? c2[0] : c2[1]; d = (h2 ? c2[1] : c2[0]) + __shfl_xor(snd, 4); }
        d += __shfl_xor(d, 2); d += __shfl_xor(d, 1);
        float mx = d;
        mx = fmaxf(mx, __shfl_xor(mx, 32)); mx = fmaxf(mx, __shfl_xor(mx, 16)); mx = fmaxf(mx, __shfl_xor(mx, 8)); mx = fmaxf(mx, __shfl_xor(mx, 4));
        const float pe = expf(d - mx); float den = pe;
        den += __shfl_xor(den, 32); den += __shfl_xor(den, 16); den += __shfl_xor(den, 8); den += __shfl_xor(den, 4);
        if ((lane & 3) == 0 && !c.dry) { AFF[(size_t)eid * T_ALL + tok] = pe / den; SLOT[tok * 16 + eid] = -1; }
    }
}
DI void phase_ln2(KArgs args, LAS unsigned char* L, const Ctx& c) {
    const int lane = c.lane, l = c.layer;
    const float* g2 = args->in[18] + l * D; const float* b2 = args->in[19] + l * D;
    f32x4 gv[4], bv[4];
#pragma unroll
    for (int j = 0; j < 4; ++j) { gv[j] = *(const f32x4*)(g2 + 4 * lane + 256 * j); bv[j] = *(const f32x4*)(b2 + 4 * lane + 256 * j); }
    const int* SLOT = WSP(int, WS_SLOT); bf16_t* XB = WSP(bf16_t, WS_XB);
    u32x2 nv[4]; int nsv = -1;
    { const int t0 = c.bid * 8 + c.wave; if (t0 < T_ALL) { const bf16_t* xp = XB + (size_t)t0 * D; nsv = SLOT[(size_t)t0 * 16 + (lane & 15)];
#pragma unroll
        for (int j = 0; j < 4; ++j) nv[j] = *(const u32x2*)(xp + 4 * lane + 256 * j); } }
    for (int t = c.bid * 8 + c.wave; t < T_ALL; t += c.G * 8) { const size_t tok = (size_t)t;
        float* xr = c.out + tok * D; f32x4 v[4];
#pragma unroll
        for (int j = 0; j < 4; ++j) { v[j][0] = bflo(nv[j].x) * ALPHA; v[j][1] = bfhi(nv[j].x) * ALPHA; v[j][2] = bflo(nv[j].y) * ALPHA; v[j][3] = bfhi(nv[j].y) * ALPHA; }
        const int sv = nsv;
        if (t + c.G * 8 < T_ALL) { const bf16_t* xp = XB + (tok + c.G * 8) * D; nsv = SLOT[(tok + c.G * 8) * 16 + (lane & 15)];
#pragma unroll
            for (int j = 0; j < 4; ++j) nv[j] = *(const u32x2*)(xp + 4 * lane + 256 * j); }
        {
            unsigned mk = (unsigned)(__ballot(sv >= 0) & 0xffffull);
            while (mk) { const int e0 = __builtin_ctz(mk); mk &= mk - 1u; const bool two = mk != 0u; const int e1 = two ? __builtin_ctz(mk) : e0; if (two) mk &= mk - 1u;
                const int s0 = __builtin_amdgcn_readlane(sv, e0), s1 = __builtin_amdgcn_readlane(sv, e1);
                const bf16_t* y0 = BIGP(bf16_t, (e0 < 8 ? B_XY0 : B_XY1)) + ((size_t)(e0 & 7) * CAP + s0) * D + 4 * lane;
                const bf16_t* y1 = BIGP(bf16_t, (e1 < 8 ? B_XY0 : B_XY1)) + ((size_t)(e1 & 7) * CAP + s1) * D + 4 * lane;
                u32x2 w0[4], w1[4];
#pragma unroll
                for (int j = 0; j < 4; ++j) { w0[j] = *(const u32x2*)(y0 + 256 * j); w1[j] = *(const u32x2*)(y1 + 256 * j); }
                __builtin_amdgcn_sched_barrier(0);
                const float f1 = two ? 1.0f : 0.0f;
#pragma unroll
                for (int j = 0; j < 4; ++j) { v[j][0] += bflo(w0[j].x); v[j][1] += bfhi(w0[j].x); v[j][2] += bflo(w0[j].y); v[j][3] += bfhi(w0[j].y);
                    v[j][0] += f1 * bflo(w1[j].x); v[j][1] += f1 * bfhi(w1[j].x); v[j][2] += f1 * bflo(w1[j].y); v[j][3] += f1 * bfhi(w1[j].y); } } }
        float s = 0.f;
#pragma unroll
        for (int j = 0; j < 4; ++j) s += (v[j][0] + v[j][1]) + (v[j][2] + v[j][3]);
        const float mean = wave_sum(s) * (1.0f / D); float s2 = 0.f;
#pragma unroll
        for (int j = 0; j < 4; ++j) { v[j] = v[j] - mean; s2 += (v[j][0] * v[j][0] + v[j][1] * v[j][1]) + (v[j][2] * v[j][2] + v[j][3] * v[j][3]); }
        const float rstd = frsq(wave_sum(s2) * (1.0f / D) + LN_EPS);
#pragma unroll
        for (int j = 0; j < 4; ++j) { v[j] = v[j] * rstd * gv[j] + bv[j];
            if (!c.dry) {
                if (l == 1) *(f32x4*)(xr + 4 * lane + 256 * j) = v[j];
                else { u32x2 w; w.x = pk2(v[j][0], v[j][1]); w.y = pk2(v[j][2], v[j][3]); *(u32x2*)(XB + tok * D + 4 * lane + 256 * j) = w;
                    *(unsigned*)(WSP(unsigned char, WS_XB8) + tok * D + 4 * lane + 256 * j) = pk4_fp8(v[j][0], v[j][1], v[j][2], v[j][3]); } } }
    }
}

DI int block_excl_scan(int v, LAS int* tmp, int tid, int& total) {
    const int lane = tid & 63, wave = tid >> 6; int x = v;
#pragma unroll
    for (int o = 1; o < 64; o <<= 1) { const int y = __shfl_up(x, o); if (lane >= o) x += y; }
    __syncthreads();
    if (lane == 63) tmp[wave] = x;
    __syncthreads();
    int base = 0, tot = 0;
#pragma unroll
    for (int w = 0; w < 8; ++w) { const int tw = tmp[w]; if (w < wave) base += tw; tot += tw; }
    total = tot;
    return base + x - v;
}
DI void phase_select(KArgs args, LAS unsigned char* L, const Ctx& c, int inst) {
    if (inst < 0 || inst >= 32) return;
    const int tid = c.tid, grp = inst >> 4, e = inst & 15;
    const int n = grp ? T_S : T_P, t0 = grp ? T_P : 0, C = n >> 3, slot0 = grp ? CAP_P : 0;
    const unsigned* v = (const unsigned*)(WSP(float, WS_AFF) + (size_t)e * T_ALL + t0);
    LAS unsigned* hist = (LAS unsigned*)L; LAS int* sh = (LAS int*)(L + 8192); LAS int* tmp = (LAS int*)(L + 8192 + 64);
    unsigned prefix = 0u; int kk = C, nbin = 0;
    for (int pass = 0; pass < 3; ++pass) {
        const int shift = pass == 0 ? 21 : (pass == 1 ? 10 : 0); const unsigned bmask = pass == 2 ? 1023u : 2047u;
        const unsigned mhi = pass == 0 ? 0u : (pass == 1 ? 0xFFE00000u : 0xFFFFFC00u);
        { unsigned zz; asm volatile("v_mov_b32 %0, 0" : "=v"(zz)); u32x4 z4; z4.x = zz; z4.y = zz; z4.z = zz; z4.w = zz; *(LAS u32x4*)(hist + 4 * tid) = z4; }
        __syncthreads();
        for (int i = tid * 4; i < n; i += 512 * 16) {
            u32x4 x4[4];
#pragma unroll
            for (int k = 0; k < 4; ++k) x4[k] = *(const u32x4*)(v + i + k * 2048);
#pragma unroll
            for (int k = 0; k < 4; ++k)
#pragma unroll
                for (int j = 0; j < 4; ++j) { const unsigned x = x4[k][j]; if ((x & mhi) == prefix) __hip_atomic_fetch_add(&hist[(x >> shift) & bmask], 1u, __ATOMIC_RELAXED, __HIP_MEMORY_SCOPE_WORKGROUP); } }
        __syncthreads();
        {
            const u32x4 hv = *(const LAS u32x4*)(hist + 2044 - 4 * tid); int tot;
            int cum = block_excl_scan((int)(hv[0] + hv[1] + hv[2] + hv[3]), tmp, tid, tot);
            const int c1 = cum + (int)hv.w, c2 = c1 + (int)hv.z, c3 = c2 + (int)hv.y, c4 = c3 + (int)hv.x;
            if (cum < kk && kk <= c4) { const int j = kk <= c1 ? 0 : (kk <= c2 ? 1 : (kk <= c3 ? 2 : 3)); const int cb = kk <= c1 ? cum : (kk <= c2 ? c1 : (kk <= c3 ? c2 : c3));
                sh[0] = 2047 - 4 * tid - j; sh[1] = kk - cb; sh[2] = (j == 0 ? c1 : (j == 1 ? c2 : (j == 2 ? c3 : c4))) - cb; } }
        __syncthreads();
        prefix |= ((unsigned)sh[0]) << shift; kk = sh[1]; nbin = sh[2];
        __syncthreads();
    }
    const unsigned thr = prefix;
    int* IDX = WSP(int, WS_IDX) + e * CAP + slot0;
    LAS int* ctr = sh + 8;
    if (tid == 0) ctr[0] = 0;
    __syncthreads();
    const bool ordered = kk < nbin; int tie_run = 0;
    const int lane = tid & 63; const unsigned long long ltm = (1ull << lane) - 1ull;
    for (int it = 0; it < (n >> 11); it += 4) {
        u32x4 x4[4];
#pragma unroll
        for (int k = 0; k < 4; ++k) x4[k] = *(const u32x4*)(v + (it + k) * 2048 + 4 * tid);
#pragma unroll
        for (int k = 0; k < 4; ++k) { const u32x4 x = x4[k];
            int tie_base = 0;
            if (ordered) { const int tiec = (x[0] == thr) + (x[1] == thr) + (x[2] == thr) + (x[3] == thr); int tot; tie_base = tie_run + block_excl_scan(tiec, tmp, tid, tot); tie_run += tot; }
            bool sj[4]; int off[4], tot4 = 0;
#pragma unroll
            for (int j = 0; j < 4; ++j) { bool s_ = x[j] > thr; if (x[j] == thr) { s_ = !ordered || tie_base < kk; ++tie_base; } sj[j] = s_;
                const unsigned long long m = __ballot(s_); off[j] = tot4 + __popcll(m & ltm); tot4 += __popcll(m); }
            int base = 0; if (lane == 0 && tot4 > 0) base = __hip_atomic_fetch_add(ctr, tot4, __ATOMIC_RELAXED, __HIP_MEMORY_SCOPE_WORKGROUP);
            base = __builtin_amdgcn_readfirstlane(base);
#pragma unroll
            for (int j = 0; j < 4; ++j) if (sj[j]) IDX[base + off[j]] = t0 + (it + k) * 2048 + 4 * tid + j; } }
}
DI void phase_gather(KArgs args, LAS unsigned char* L, const Ctx& c) {
    const int lane = c.lane; const int* IDX = WSP(int, WS_IDX); const bf16_t* XB = WSP(bf16_t, WS_XB);
    float* GATEV = WSP(float, WS_GATEV); int* SLOT = WSP(int, WS_SLOT); const float* AFF = WSP(float, WS_AFF);
    for (int row0 = (c.bid * 8 + c.wave) * 4; row0 < NE * CAP; row0 += c.G * 8 * 4) {
        const int e = row0 / CAP, s0 = row0 % CAP; int t[4]; u32x4 a[4], b[4];
#pragma unroll
        for (int k = 0; k < 4; ++k) t[k] = IDX[row0 + k];
#pragma unroll
        for (int k = 0; k < 4; ++k) { const u32x4* src = (const u32x4*)(XB + (size_t)t[k] * D) + 2 * lane; a[k] = src[0]; b[k] = src[1]; }
        u32x4* dst = (u32x4*)(BIGP(unsigned char, (e < 8 ? B_XY0 : B_XY1)) + ((size_t)(e & 7) * CAP + s0) * D);
#pragma unroll
        for (int k = 0; k < 4; ++k) { u32x4 w;
            w.x = pk4_fp8(bflo(a[k].x), bfhi(a[k].x), bflo(a[k].y), bfhi(a[k].y)); w.y = pk4_fp8(bflo(a[k].z), bfhi(a[k].z), bflo(a[k].w), bfhi(a[k].w));
            w.z = pk4_fp8(bflo(b[k].x), bfhi(b[k].x), bflo(b[k].y), bfhi(b[k].y)); w.w = pk4_fp8(bflo(b[k].z), bfhi(b[k].z), bflo(b[k].w), bfhi(b[k].w));
            dst[k * 64 + lane] = w; }
        if (lane < 4) { const int tt = (lane == 0) ? t[0] : (lane == 1) ? t[1] : (lane == 2) ? t[2] : t[3]; SLOT[(size_t)tt * 16 + e] = s0 + lane; GATEV[row0 + lane] = AFF[(size_t)e * T_ALL + tt]; } }
}

__global__ void __launch_bounds__(512, 2) fwd_kernel(Args args) {
    extern __shared__ __attribute__((aligned(16))) unsigned char lds_raw[];
    LAS unsigned char* L = (LAS unsigned char*)lds_raw;
    Ctx c;
    c.out = args.out; c.ws = args.ws;
    c.tid = threadIdx.x; c.lane = c.tid & 63; c.wave = __builtin_amdgcn_readfirstlane(c.tid >> 6); c.G = gridDim.x; c.bid = blockIdx.x;
    c.layer = 0; c.slab = 0; c.nseq = 8; c.seqlen = 4096; c.stok = 32768; c.sbase = 0; c.dry = 0;
    const int lo = args.ph_lo, hi = args.ph_hi;
    volatile LAS unsigned* MISC = (volatile LAS unsigned*)(L + LDS_MISC);
    if (c.tid < 4) MISC[c.tid] = 0u;
    __syncthreads();
    XcdBarrier bar; bar.bar = (unsigned*)(c.ws + WS_CTL) + 1024; bar.x = 0; bar.st = MISC;
    if (hi - lo > 1) bar = xcd_barrier_post((unsigned*)(c.ws + WS_CTL) + 1024, MISC);
    int pc = 0;
#ifndef PHMASK
#define PHMASK 0xFFFF
#endif
#define PHON(k) (((PHMASK) >> (k)) & 1)
#ifndef REPMASK
#define REPMASK 0x0
#endif
#define PH_BEGIN(k) if (PHON(k) && pc >= lo && pc < hi) { { int tz = threadIdx.x; asm volatile("" : "+v"(tz)); c.tid = tz; c.lane = tz & 63; c.wave = __builtin_amdgcn_readfirstlane(tz >> 6); } KArgs ka = kargs(); c.ws = ka->ws; c.out = ka->out; { int b_ = blockIdx.x, g_ = gridDim.x; asm volatile("" : "+s"(b_), "+s"(g_)); c.bid = b_; c.G = g_; } for (int rep_ = 0; rep_ < (((REPMASK) >> (k)) & 1) + 1; ++rep_) { if (rep_) __syncthreads(); c.dry = (rep_ + 1 < (((REPMASK) >> (k)) & 1) + 1);
#ifndef BARREP
#define BARREP 0
#endif
#define PH_END   } if (pc + 1 < hi) { xcd_barrier(bar); if (BARREP) { xcd_barrier(bar); xcd_barrier(bar); } } else { asm volatile("s_waitcnt vmcnt(0)" ::: "memory"); __syncthreads(); } } ++pc;

    for (int layer = 0; layer < 2; ++layer) {
        c.layer = layer;
        PH_BEGIN(0) phase_weights(ka, L, c); PH_END
        for (int slab = 0; slab < NSLAB; ++slab) {
            c.slab = slab; c.nseq = slab < 2 ? 8 : 1; c.seqlen = slab < 2 ? 4096 : 16384; c.stok = slab < 2 ? 32768 : 16384; c.sbase = slab * 32768; const int stok = c.stok; const size_t sbase = (size_t)c.sbase;
            PH_BEGIN(1) {
                const int swp = (c.bid >> 2) & 1;
                for (int k2 = 0; k2 < 2; ++k2) {
                  if ((k2 ^ swp) == 0) { pg8::Gemm g{WSP(bf16_t, WS_XB) + sbase * D, WSP(bf16_t, WS_WIN), stok, 3584, D}; pg8::StaticOrder S; S.init(stok, 3584, c.G, c.bid);
                    pg8::EpiInProj E{BIGP(bf16_t, B_PROJ), BIGP(float, B_BA)};
                    pg8::gemm_phase<pg8::EpiInProj, pg8::StaticOrder>(L, g, S, E); }
                  else { pg8::Gemm g{(const bf16_t*)(WSP(unsigned char, WS_XB8) + sbase * D), (const bf16_t*)WSP(unsigned char, WS_WG8), stok, 3072, D / 2}; pg8::StaticOrder S; S.init(stok, 3072, c.G, c.bid);
                    pg8::EpiGates E{BIGP(unsigned char, B_GATES)};
                    pg8::gemm_phase<pg8::EpiGates, pg8::StaticOrder>(L, g, S, E); } } } PH_END
            PH_BEGIN(2) phase_mix_a(ka, L, c); PH_END
            PH_BEGIN(3) phase_scan(ka, L, c); PH_END
            PH_BEGIN(4) phase_gdn_out(ka, L, c); PH_END
            PH_BEGIN(5) {
                pg8::StaticOrder S; S.init(stok, D, c.G, c.bid);
                pg8::Gemm g{BIGP(bf16_t, B_ONA), WSP(bf16_t, WS_WBR), stok, D, 768}; pg8::EpiGateCat E{BIGP(u32x2, B_GATES), BIGP(bf16_t, B_MERGED)};
                pg8::gemm_phase<pg8::EpiGateCat, pg8::StaticOrder>(L, g, S, E); } PH_END
            PH_BEGIN(6) {
                pg8::Gemm g{BIGP(bf16_t, B_MERGED), WSP(bf16_t, WS_WOUT), stok, D, D}; pg8::StaticOrder S; S.init(stok, D, c.G, c.bid);
                pg8::EpiRes E{WSP(bf16_t, WS_XB) + sbase * D, (bf16_t*)c.out + sbase * D};
                pg8::gemm_phase<pg8::EpiRes, pg8::StaticOrder>(L, g, S, E); } PH_END
#ifndef LN1PROBE
#define LN1PROBE 0
#endif
            PH_BEGIN(7) if (LN1PROBE) { c.dry = 1; phase_ln1(ka, L, c); __syncthreads(); c.dry = 0; } phase_ln1(ka, L, c); PH_END
        }
        PH_BEGIN(8) phase_select(ka, L, c, c.bid < 16 ? 16 + c.bid : -1); PH_END
        PH_BEGIN(9) phase_gather(ka, L, c); PH_END
        for (int half = 0; half < 2; ++half) {
            PH_BEGIN(10) {
                pg8::Gemm g{BIGP(bf16_t, half ? B_XY1 : B_XY0), (const bf16_t*)(WSP(unsigned char, WS_WGU) + (size_t)half * 8 * 4096 * D), 8 * CAP, 8 * 4096, D / 2}; pg8::MoeOrder S; S.init(8, CAP / 256, 16, c.G, c.bid);
                pg8::EpiSwiglu E{BIGP(unsigned char, B_HID)};
                pg8::gemm_phase<pg8::EpiSwiglu, pg8::MoeOrder>(L, g, S, E); } PH_END
            PH_BEGIN(11) {
                pg8::Gemm g{BIGP(bf16_t, B_HID), (const bf16_t*)(WSP(unsigned char, WS_WD) + (size_t)half * 8 * D * DE), 8 * CAP, 8 * D, DE / 2}; pg8::MoeOrder S; S.init(8, CAP / 256, 4, c.G, c.bid);
                pg8::EpiDown E{BIGP(bf16_t, half ? B_XY1 : B_XY0), WSP(float, WS_GATEV) + (size_t)half * 8 * CAP};
                pg8::gemm_phase<pg8::EpiDown, pg8::MoeOrder>(L, g, S, E); } PH_END
        }
        PH_BEGIN(12) phase_ln2(ka, L, c); PH_END
    }
#undef PH_BEGIN
#undef PH_END
}

constexpr int N_PHASES = 2 * (1 + NSLAB * 7 + 2 + 4 + 1);

extern "C" void kernel_launch(void* const* d_in, const int* in_sizes, int n_in, void* d_out, int out_size, void* d_ws, size_t ws_size, hipStream_t stream) {
    static int grid = 0;
    if (grid == 0) {
        if (n_in != 20 || ws_size < WS_END) { fprintf(stderr, "kernel_launch: unexpected n_in %d or ws_size %zu (< %zu)\n", n_in, ws_size, (size_t)WS_END); grid = -1; return; }
        int dev = 0, cus = 0, per_cu = 0;
        if (hipGetDevice(&dev) != hipSuccess || hipDeviceGetAttribute(&cus, hipDeviceAttributeMultiprocessorCount, dev) != hipSuccess) { grid = -1; return; }
        if (hipFuncSetAttribute((const void*)fwd_kernel, hipFuncAttributeMaxDynamicSharedMemorySize, LDS_BYTES) != hipSuccess) { fprintf(stderr, "kernel_launch: hipFuncSetAttribute failed\n"); grid = -1; return; }
        if (hipOccupancyMaxActiveBlocksPerMultiprocessor(&per_cu, (const void*)fwd_kernel, 512, LDS_BYTES) != hipSuccess || per_cu < 1) fprintf(stderr, "kernel_launch: occupancy query says %d\n", per_cu);
        (void)hipGetLastError();
        grid = cus;
    }
    if (grid < 0) return;
    (void)hipMemsetAsync((char*)d_ws + WS_CTL, 0, 1 * MiB, stream);
    Args a{};
    for (int i = 0; i < 20; ++i) a.in[i] = (const float*)d_in[i];
    a.out = (float*)d_out; a.ws = (unsigned char*)d_ws;
#if MK_N_LAUNCHES == 1
    a.ph_lo = 0; a.ph_hi = N_PHASES;
    hipLaunchKernelGGL(fwd_kernel, dim3(grid), dim3(512), LDS_BYTES, stream, a);
#else
    for (int p = 0; p < N_PHASES; ++p) { a.ph_lo = p; a.ph_hi = p + 1; hipLaunchKernelGGL(fwd_kernel, dim3(grid), dim3(512), LDS_BYTES, stream, a); }
#endif
}
```

```cpp
#include <hip/hip_runtime.h>
#include <stdint.h>
#include <stdio.h>

#define LAS __attribute__((address_space(3)))
#define DI __device__ __forceinline__
typedef unsigned short bf16_t;
typedef short bf16x8 __attribute__((ext_vector_type(8)));
typedef float f32x4 __attribute__((ext_vector_type(4)));
typedef float f32x2 __attribute__((ext_vector_type(2)));
typedef float f32x16 __attribute__((ext_vector_type(16)));
typedef unsigned u32x4 __attribute__((ext_vector_type(4)));
typedef unsigned u32x2 __attribute__((ext_vector_type(2)));
typedef __bf16 bf16x2v __attribute__((ext_vector_type(2)));

#ifndef MK_N_LAUNCHES
#define MK_N_LAUNCHES 1
#endif

constexpr int D = 1024, T_ALL = 81920, T_P = 65536, T_S = 16384, SLABMAX = 32768, NSLAB = 3;
constexpr int DIN = 6552, NPROJ = 3584;
constexpr int C_QA = 0, C_KA = 256, C_VA = 512, C_QD = 768, C_KD = 1152, C_VD = 1536, C_QC = 1920, C_KC = 2304, C_VC = 2688, C_ZC = 3072;
constexpr int NE = 16, DE = 2048, CAP_P = 8192, CAP_S = 2048, CAP = CAP_P + CAP_S;
constexpr float ALPHA = 1.41421356237f, LN_EPS = 1e-5f, NORM_EPS = 1e-6f;
constexpr size_t MiB = 1u << 20;
constexpr size_t WS_CTL = 0, WS_WIN = 1 * MiB, WS_WBR = 14 * MiB, WS_WOUT = 16 * MiB, WS_WGU = 18 * MiB, WS_WD = 82 * MiB, WS_XB8 = 114 * MiB, WS_WG8 = 194 * MiB, WS_XB = 210 * MiB;
constexpr size_t WS_AFF = 370 * MiB, WS_SLOT = 375 * MiB, WS_IDX = 380 * MiB, WS_GATEV = 381 * MiB, WS_CS = 382 * MiB, WS_BIG = 386 * MiB, WS_END = 1130 * MiB;
constexpr size_t B_PROJ = 0, B_GATES = 224 * MiB, B_BA = 416 * MiB, B_ONA = 420 * MiB, B_ODIL = 436 * MiB, B_OGDN = 452 * MiB, B_DILP = 476 * MiB, B_DILM = 500 * MiB, B_GSCR = 502 * MiB, B_MERGEF = 502 * MiB, B_MERGED = 630 * MiB;
constexpr size_t B_XY0 = 0, B_XY1 = 160 * MiB, B_HID = 320 * MiB;
constexpr int GSTRIDE = 41216;
constexpr int LDS_BYTES = 151552;
constexpr int LDS_MISC = 145408, LDS_CW = LDS_MISC + 256;

DI unsigned pk2(float lo, float hi) { f32x2 v = {lo, hi}; bf16x2v b = __builtin_convertvector(v, bf16x2v); return __builtin_bit_cast(unsigned, b); }
DI unsigned pk4_fp8(float a, float b, float c, float d) {
    int w = __builtin_amdgcn_cvt_pk_fp8_f32(a, b, 0, false); w = __builtin_amdgcn_cvt_pk_fp8_f32(c, d, w, true); return (unsigned)w; }
DI float bflo(unsigned u) { return __uint_as_float(u << 16); }
DI float bfhi(unsigned u) { return __uint_as_float(u & 0xffff0000u); }
DI float frcp(float x) { return __builtin_amdgcn_rcpf(x); }
DI float frsq(float x) { return __builtin_amdgcn_rsqf(x); }
DI float sigmoidf_(float x) { return frcp(1.0f + __expf(-x)); }
DI float siluf_(float x) { return x * frcp(1.0f + __expf(-x)); }
DI void lds_barrier() { asm volatile("s_waitcnt lgkmcnt(0)\n\ts_barrier" ::: "memory"); }
DI float wave_sum(float v) {
#pragma unroll
    for (int o = 1; o < 64; o <<= 1) v += __shfl_xor(v, o);
    return v;
}
#define MFMA32(a, b, c) __builtin_amdgcn_mfma_f32_32x32x16_bf16((a), (b), (c), 0, 0, 0)
DI int crow(int reg, int h) { return (reg & 3) + 8 * (reg >> 2) + 4 * h; }
DI f32x16 zero16() { f32x16 z; for (int i = 0; i < 16; ++i) z[i] = 0.f; return z; }
template <int S> DI bf16x8 pack8(const f32x16& x) {
    u32x4 p; p[0] = pk2(x[8 * S], x[8 * S + 1]); p[1] = pk2(x[8 * S + 2], x[8 * S + 3]); p[2] = pk2(x[8 * S + 4], x[8 * S + 5]); p[3] = pk2(x[8 * S + 6], x[8 * S + 7]);
    return __builtin_bit_cast(bf16x8, p);
}

namespace pg8 {
constexpr int BM = 256, BK = 64, HALF = 128, HTB = HALF * BK * 2, STAGE_BYTES = 8 * HTB, NXCD = 8, WGM = 8;
__host__ __device__ __forceinline__ int lds_byte(int r, int c) { const int st = (r >> 4) * 2 + (c >> 5), rr = r & 15, cc = c & 31, ob = rr * 64 + cc * 2; return st * 1024 + (ob ^ (((ob >> 9) & 1) << 5)); }
__host__ __device__ __forceinline__ void stage_rc(int b, int& R, int& C) { const int st = b / 1024, sb = b % 1024, swz = sb ^ (((sb >> 9) & 1) << 5); R = (st >> 1) * 16 + swz / 64; C = (st & 1) * 32 + (swz % 64) / 2; }
__host__ __device__ __forceinline__ int perm32(int rho) { const int n = rho >> 4, i = rho & 15; return 8 * (i >> 2) + 4 * n + (i & 3); }
struct Unit { int pm, pn; };
struct Gemm { const bf16_t* A; const bf16_t* Bt; int M, N, K; };
struct StaticOrder {
    int nM, nN, nwg, G, c;
    __device__ void init(int M, int N, int G_, int c_) { nM = M / BM; nN = N / BM; nwg = nM * nN; G = G_; c = c_; }
    __device__ bool next(int i, Unit& u) const {
        const long L = (long)i * G + c; if (L >= nwg) return false;
        int wgid = (int)L; { const int q = nwg / NXCD, r = nwg % NXCD, xcd = wgid % NXCD, off = wgid / NXCD; wgid = (xcd < r ? xcd * (q + 1) : r * (q + 1) + (xcd - r) * q) + off; }
        const int nig = WGM * nN, gid = wgid / nig, fm = gid * WGM, gsz = (nM - fm) < WGM ? (nM - fm) : WGM;
        u.pm = fm + ((wgid % nig) % gsz); u.pn = (wgid % nig) / gsz; return true;
    }
    __device__ __forceinline__ void a_ready(const Unit&) const {}
    __device__ __forceinline__ void done(const Unit&) const {}
};
struct MoeOrder {
    int nMe, nNe, per, total, G, c, xr, xc, rpx, cpx, share;
    __device__ void init(int nE, int nMe_, int nNe_, int G_, int c_) { nMe = nMe_; nNe = nNe_; per = nMe * nNe; total = nE * per; G = G_; c = c_;
        xc = (nNe % 2 == 0 && nNe >= 8) ? 2 : 1; xr = 8 / xc; rpx = nMe / xr; cpx = nNe / xc; share = rpx * cpx; }
    __device__ bool next(int i, Unit& u) const {
        if ((G & 7) == 0 && nMe % xr == 0) {
            const int x = c & 7, q = c >> 3, nq = G >> 3; const long j = (long)i * nq + q; if (j >= (long)(total / 8)) return false;
            const int e = (int)(j / share), r = (int)(j % share); const int pm = (x / xc) * rpx + r % rpx, pn = (x % xc) * cpx + r / rpx;
            u.pm = e * nMe + pm; u.pn = e * nNe + pn; return true;
        }
        const long L = (long)i * G + c; if (L >= total) return false;
        const int e = (int)(L / per), r = (int)(L % per);
        u.pm = e * nMe + r % nMe; u.pn = e * nNe + r / nMe; return true;
    }
    __device__ __forceinline__ void a_ready(const Unit&) const {}
    __device__ __forceinline__ void done(const Unit&) const {}
};

template <class Epi, class Sched>
__device__ __forceinline__ void gemm_phase(LAS unsigned char* lds, const Gemm g, const Sched& S, const Epi& E) {
    int tid = threadIdx.x; asm volatile("" : "+v"(tid));
    const int wid = __builtin_amdgcn_readfirstlane(tid >> 6), lane = tid & 63, wr = wid >> 2, wc = wid & 3, fr = lane & 15, fq = lane >> 4;
    int Kv = g.K; asm volatile("" : "+s"(Kv));
    const int K = Kv, nt = K / BK;
    unsigned voffA[2], voffB[2];
#pragma unroll
    for (int i = 0; i < 2; ++i) { int R, C; stage_rc(tid * 16 + i * 8192, R, C); const int Rb = Epi::PERM ? ((R & ~31) + perm32(R & 31)) : R;
        voffA[i] = (unsigned)(R * K + C) * 2u; voffB[i] = (unsigned)(Rb * K + C) * 2u; }
    const size_t kstep = (size_t)(BK * 2);
    const size_t hstep = (size_t)HALF * K * 2;
    const size_t tstep = 2 * hstep;
    const unsigned ldsw = (unsigned)wid * 1024u;
    const int aoff = lds_byte(wr * 64 + fr, fq * 8), boff = lds_byte(wc * 32 + fr, fq * 8);
#define PG8_SA(b, h) (((b) * 2 + (h)) * HTB)
#define PG8_SB(b, h) ((4 + (b) * 2 + (h)) * HTB)
#define PG8_STAGE(bufoff, gbase, voff) do { _Pragma("unroll") for (int _i = 0; _i < 2; ++_i) \
        __builtin_amdgcn_global_load_lds((const unsigned*)((const char*)(gbase) + (voff)[_i]), (LAS unsigned*)(lds + (bufoff) + ldsw + _i * 8192), 16, 0, 0); } while (0)
#define PG8_LD8(p) __builtin_shufflevector(*(const LAS v4i_*)(p), *(const LAS v4i_*)((p) + 1024), 0, 1, 2, 3, 4, 5, 6, 7)
#define PG8_LDA(dst, b, h) do { _Pragma("unroll") for (int m = 0; m < 4; ++m) { if constexpr (Epi::FP8) dst##8[m] = PG8_LD8(lds + PG8_SA(b, h) + aoff + m * 2048); \
        else { _Pragma("unroll") for (int k = 0; k < 2; ++k) dst[m][k] = *(const LAS bf16x8*)(lds + PG8_SA(b, h) + aoff + m * 2048 + k * 1024); } } } while (0)
#define PG8_LDB(dst, b, h) do { _Pragma("unroll") for (int n = 0; n < 2; ++n) { if constexpr (Epi::FP8) dst##8[n] = PG8_LD8(lds + PG8_SB(b, h) + boff + n * 2048); \
        else { _Pragma("unroll") for (int k = 0; k < 2; ++k) dst[n][k] = *(const LAS bf16x8*)(lds + PG8_SB(b, h) + boff + n * 2048 + k * 1024); } } } while (0)
#define PG8_MMA(ai, bj, At, Bt) do { __builtin_amdgcn_s_setprio(1); _Pragma("unroll") for (int m = 0; m < 4; ++m) _Pragma("unroll") for (int n = 0; n < 2; ++n) { \
        if constexpr (Epi::FP8) asm volatile("v_mfma_scale_f32_16x16x128_f8f6f4 %0, %1, %2, %0, %3, %3 op_sel_hi:[0,0,0]" : "+v"(acc[ai][bj][m][n]) : "v"(Bt##8[n]), "v"(At##8[m]), "v"(fp8_unit_scale));   \
        else { _Pragma("unroll") for (int k = 0; k < 2; ++k) acc[ai][bj][m][n] = __builtin_amdgcn_mfma_f32_16x16x32_bf16(Bt[n][k], At[m][k], acc[ai][bj][m][n], 0, 0, 0); } } \
        __builtin_amdgcn_s_setprio(0); } while (0)
#define PG8_WAIT_V(n) asm volatile("s_waitcnt vmcnt(" #n ")" ::: "memory")
#define PG8_WAIT_L(n) asm volatile("s_waitcnt lgkmcnt(" #n ")" ::: "memory")
#define PG8_BAR __builtin_amdgcn_s_barrier()
#define PG8_SCHED __builtin_amdgcn_sched_barrier(0)
    Unit cur, nxt; int ui = 0;
    if (!S.next(0, cur)) return;
    f32x4 acc[2][2][4][2];
#pragma unroll
    for (int a = 0; a < 2; ++a)
#pragma unroll
        for (int b = 0; b < 2; ++b)
#pragma unroll
            for (int m = 0; m < 4; ++m)
#pragma unroll
                for (int n = 0; n < 2; ++n) acc[a][b][m][n] = (f32x4){0.f, 0.f, 0.f, 0.f};
    typedef int v4i_ __attribute__((ext_vector_type(4))); typedef int v8i_ __attribute__((ext_vector_type(8)));
    bf16x8 At[4][2], B0[2][2], B1[2][2]; v8i_ At8[4], B08[2], B18[2];
    int fp8_unit_scale = 0x7F7F7F7F; asm volatile("" : "+v"(fp8_unit_scale));
    const char* cA = (const char*)g.A + (size_t)cur.pm * tstep; const char* cB = (const char*)g.Bt + (size_t)cur.pn * tstep;
    S.a_ready(cur);
    PG8_STAGE(PG8_SB(0, 0), cB, voffB); PG8_STAGE(PG8_SA(0, 0), cA, voffA); PG8_STAGE(PG8_SB(0, 1), cB + hstep, voffB); PG8_STAGE(PG8_SA(0, 1), cA + hstep, voffA);
    if (wr == 1) PG8_BAR;
    PG8_WAIT_V(4); PG8_BAR;
    PG8_STAGE(PG8_SB(1, 0), cB + kstep, voffB); PG8_STAGE(PG8_SA(1, 0), cA + kstep, voffA); PG8_STAGE(PG8_SB(1, 1), cB + hstep + kstep, voffB);
    PG8_WAIT_V(6); PG8_BAR;
    for (;;) {
        const bool has_next = S.next(ui + 1, nxt);
        const char* nA = has_next ? (const char*)g.A + (size_t)nxt.pm * tstep : cA; const char* nB = has_next ? (const char*)g.Bt + (size_t)nxt.pn * tstep : cB;
        for (int t = 0; t < nt; t += 2) {
            const bool last = (t == nt - 2);
            const char* a1 = cA + (size_t)(t + 1) * kstep;
            const char* a2 = last ? nA : cA + (size_t)(t + 2) * kstep; const char* b2 = last ? nB : cB + (size_t)(t + 2) * kstep;
            const char* a3 = a2 + kstep; const char* b3 = b2 + kstep;
            if (last && has_next) S.a_ready(nxt);
            if constexpr (Epi::SEG) { if (t == 4 || t == 6) { int tz = tid; asm volatile("" : "+v"(tz)); const int wz = __builtin_amdgcn_readfirstlane(tz >> 6), lz = tz & 63; E.mid(acc, cur, t == 4 ? 0 : 1, wz >> 2, wz & 3, lz & 15, lz >> 4); } }
            PG8_LDB(B0, 0, 0); PG8_SCHED; PG8_LDA(At, 0, 0); PG8_STAGE(PG8_SA(1, 1), a1 + hstep, voffA);
            PG8_WAIT_L(8); PG8_BAR; PG8_WAIT_L(0); PG8_MMA(0, 0, At, B0); PG8_BAR; PG8_SCHED;
            PG8_LDB(B1, 0, 1); PG8_STAGE(PG8_SB(0, 0), b2, voffB);
            PG8_BAR; PG8_WAIT_L(0); PG8_MMA(0, 1, At, B1); PG8_BAR;
            PG8_LDA(At, 0, 1); PG8_STAGE(PG8_SA(0, 0), a2, voffA);
            PG8_BAR; PG8_WAIT_L(0); PG8_MMA(1, 0, At, B0); PG8_BAR; PG8_SCHED;
            PG8_STAGE(PG8_SB(0, 1), b2 + hstep, voffB);
            PG8_WAIT_V(6); PG8_BAR; PG8_MMA(1, 1, At, B1); PG8_BAR;
            PG8_LDB(B0, 1, 0); PG8_SCHED; PG8_LDA(At, 1, 0); PG8_STAGE(PG8_SA(0, 1), a2 + hstep, voffA);
            PG8_WAIT_L(8); PG8_BAR; PG8_WAIT_L(0); PG8_MMA(0, 0, At, B0); PG8_BAR; PG8_SCHED;
            PG8_LDB(B1, 1, 1); PG8_STAGE(PG8_SB(1, 0), b3, voffB);
            PG8_BAR; PG8_WAIT_L(0); PG8_MMA(0, 1, At, B1); PG8_BAR;
            PG8_LDA(At, 1, 1); PG8_STAGE(PG8_SA(1, 0), a3, voffA);
            PG8_BAR; PG8_WAIT_L(0); PG8_MMA(1, 0, At, B0); PG8_BAR; PG8_SCHED;
            PG8_STAGE(PG8_SB(1, 1), b3 + hstep, voffB);
            PG8_WAIT_V(6); PG8_BAR; PG8_MMA(1, 1, At, B1); PG8_BAR;
        }
        if constexpr (Epi::FP8) asm volatile("s_nop 15\n\ts_nop 15\n\ts_nop 15" ::: "memory");
        { int tz = tid; asm volatile("" : "+v"(tz)); const int wz = __builtin_amdgcn_readfirstlane(tz >> 6), lz = tz & 63;
          E(acc, cur, wz >> 2, wz & 3, lz & 15, lz >> 4); } S.done(cur);
        if (!has_next) break;
#pragma unroll
        for (int a = 0; a < 2; ++a)
#pragma unroll
            for (int b = 0; b < 2; ++b)
#pragma unroll
                for (int m = 0; m < 4; ++m)
#pragma unroll
                    for (int n = 0; n < 2; ++n) acc[a][b][m][n] = (f32x4){0.f, 0.f, 0.f, 0.f};
        cur = nxt; cA = nA; cB = nB; ++ui;
    }
    PG8_WAIT_V(0);
    if (wr == 0) PG8_BAR;
    PG8_BAR;
#undef PG8_SA
#undef PG8_SB
#undef PG8_STAGE
#undef PG8_LDA
#undef PG8_LD8
#undef PG8_LDB
#undef PG8_MMA
#undef PG8_WAIT_V
#undef PG8_WAIT_L
#undef PG8_BAR
#undef PG8_SCHED
}

struct EpiInProj {
    static constexpr bool PERM = true, SEG = false, FP8 = false;
    bf16_t* O; float* BA; int cofs, bapn;
    __device__ __forceinline__ void operator()(const f32x4 (&acc)[2][2][4][2], const Unit& u, int wr, int wc, int fr, int fq) const {
        const int row0 = u.pm * BM + wr * 64 + fr, col0 = cofs + u.pn * BM + wc * 32 + 8 * fq;
        const bool sig = false, ba = (u.pn == bapn) && (wc == 0) && (fq < 3);
#pragma unroll
        for (int ai = 0; ai < 2; ++ai)
#pragma unroll
            for (int m = 0; m < 4; ++m) { int row = row0 + ai * HALF + m * 16; asm volatile("" : "+v"(row)); bf16_t* rowp = O + (size_t)row * NPROJ + col0;
#pragma unroll
                for (int bj = 0; bj < 2; ++bj) { f32x4 v0 = acc[ai][bj][m][0], v1 = acc[ai][bj][m][1];
                    if (sig) {
#pragma unroll
                        for (int j = 0; j < 4; ++j) { v0[j] = sigmoidf_(v0[j]); v1[j] = sigmoidf_(v1[j]); } }
                    u32x4 w; w.x = pk2(v0[0], v0[1]); w.y = pk2(v0[2], v0[3]); w.z = pk2(v1[0], v1[1]); w.w = pk2(v1[2], v1[3]);
                    *(u32x4*)(rowp + bj * HALF) = w;
                    if (bj == 1 && ba) { float* bp = BA + (size_t)row * 32 + 8 * fq; *(f32x4*)bp = v0; *(f32x4*)(bp + 4) = v1; } } }
    }
};
struct EpiGates {
    static constexpr bool PERM = true, SEG = false, FP8 = true;
    unsigned char* G; bf16_t* O;
    static __device__ __forceinline__ unsigned q4(const f32x4& v) { unsigned r = 0u;
#pragma unroll
        for (int j = 0; j < 4; ++j) { const float t = __builtin_amdgcn_exp2f(v[j] * (-0.03125f * 1.44269504088896f));
            r = __builtin_amdgcn_cvt_pk_u8_f32(fmaxf(frcp(__builtin_fmaf(t, 1.0f / 255.0f, 1.0f / 255.0f)), 1.0f), j, r); }
        return r; }
    __device__ __forceinline__ void operator()(const f32x4 (&acc)[2][2][4][2], const Unit& u, int wr, int wc, int fr, int fq) const {
        if (u.pn >= 12) {
            const int row0 = u.pm * BM + wr * 64 + fr, col0 = (u.pn - 12) * BM + wc * 32 + 8 * fq;
#pragma unroll
            for (int ai = 0; ai < 2; ++ai)
#pragma unroll
                for (int m = 0; m < 4; ++m) { int row = row0 + ai * HALF + m * 16; asm volatile("" : "+v"(row)); bf16_t* rowp = O + (size_t)row * NPROJ + col0;
#pragma unroll
                    for (int bj = 0; bj < 2; ++bj) { const f32x4 v0 = acc[ai][bj][m][0] * 0.03125f, v1 = acc[ai][bj][m][1] * 0.03125f;
                        u32x4 w; w.x = pk2(v0[0], v0[1]); w.y = pk2(v0[2], v0[3]); w.z = pk2(v1[0], v1[1]); w.w = pk2(v1[2], v1[3]);
                        *(u32x4*)(rowp + bj * HALF) = w; }
                    asm volatile("" ::: "memory"); }
            return; }
#pragma unroll
        for (int ai = 0; ai < 2; ++ai)
#pragma unroll
            for (int m = 0; m < 4; ++m) {
                unsigned boff = (unsigned)(((u.pm * 12 + u.pn) * (16 * 512) + ((wr * 4 + wc) * 64 + fq * 16 + fr)) * 8 + ((ai * 4 + m) * 2) * 4096); asm volatile("" : "+v"(boff));
#pragma unroll
                for (int bj = 0; bj < 2; ++bj) { u32x2 w; w.x = q4(acc[ai][bj][m][0]); w.y = q4(acc[ai][bj][m][1]);
                    *(u32x2*)(G + (boff + bj * 4096)) = w; }
                asm volatile("" ::: "memory"); }
    }
};
struct EpiGateCat {
    static constexpr bool PERM = true, SEG = true, FP8 = false;
    const u32x2* GT; bf16_t* MB;
    static __device__ __forceinline__ float ub(unsigned x, int j) { return (float)((x >> (8 * j)) & 0xffu); }
    __device__ __forceinline__ void mid(f32x4 (&acc)[2][2][4][2], const Unit& u, int seg, int wr, int wc, int fr, int fq) const {
        {
            int toff = (wr * 4 + wc) * 64 + fq * 16 + fr; asm volatile("" : "+v"(toff));
            const u32x2* ga = GT + ((size_t)u.pm * 12 + seg * 4 + u.pn) * (16 * 512) + toff; const u32x2* gb = ga + (size_t)4 * 16 * 512;
            u32x2 A_[2][4][2], B_[2][4][2];
#pragma unroll
            for (int ai = 0; ai < 2; ++ai)
#pragma unroll
                for (int m = 0; m < 4; ++m)
#pragma unroll
                    for (int bj = 0; bj < 2; ++bj) { A_[ai][m][bj] = ga[((ai * 4 + m) * 2 + bj) * 512]; B_[ai][m][bj] = gb[((ai * 4 + m) * 2 + bj) * 512]; }
#pragma unroll
            for (int ai = 0; ai < 2; ++ai)
#pragma unroll
                for (int m = 0; m < 4; ++m)
#pragma unroll
                    for (int bj = 0; bj < 2; ++bj) { const u32x2 a_ = A_[ai][m][bj], b_ = B_[ai][m][bj]; f32x4& v0 = acc[ai][bj][m][0]; f32x4& v1 = acc[ai][bj][m][1];
#pragma unroll
                        for (int j = 0; j < 4; ++j) { v0[j] *= ub(a_.x, j) * frcp(ub(b_.x, j)); v1[j] *= ub(a_.y, j) * frcp(ub(b_.y, j)); } }
            asm volatile("" ::: "memory"); }
    }
    __device__ __forceinline__ void operator()(const f32x4 (&acc)[2][2][4][2], const Unit& u, int wr, int wc, int fr, int fq) const {
        const int row0 = u.pm * BM + wr * 64 + fr, col0 = u.pn * BM + wc * 32 + 8 * fq;
#pragma unroll
        for (int ai = 0; ai < 2; ++ai) {
            int rowb = row0 + ai * HALF; asm volatile("" : "+v"(rowb)); bf16_t* mp0 = MB + (size_t)rowb * D + col0;
            int toff = (wr * 4 + wc) * 64 + fq * 16 + fr; asm volatile("" : "+v"(toff));
            const u32x2* gc = GT + ((size_t)u.pm * 12 + 8 + u.pn) * (16 * 512) + toff;
            u32x2 gw[4][2];
#pragma unroll
            for (int m = 0; m < 4; ++m)
#pragma unroll
                for (int bj = 0; bj < 2; ++bj) gw[m][bj] = gc[((ai * 4 + m) * 2 + bj) * 512];
#pragma unroll
            for (int m = 0; m < 4; ++m)
#pragma unroll
                for (int bj = 0; bj < 2; ++bj) { const u32x2 g_ = gw[m][bj]; const f32x4 v0 = acc[ai][bj][m][0] * (1.0f / 255.0f), v1 = acc[ai][bj][m][1] * (1.0f / 255.0f); u32x4 w;
                    w.x = pk2(v0[0] * ub(g_.x, 0), v0[1] * ub(g_.x, 1)); w.y = pk2(v0[2] * ub(g_.x, 2), v0[3] * ub(g_.x, 3)); w.z = pk2(v1[0] * ub(g_.y, 0), v1[1] * ub(g_.y, 1)); w.w = pk2(v1[2] * ub(g_.y, 2), v1[3] * ub(g_.y, 3));
                    *(u32x4*)(mp0 + (size_t)(m * 16) * D + bj * HALF) = w; }
            asm volatile("" ::: "memory"); }
    }
};
struct EpiRes {
    static constexpr bool PERM = true, SEG = false, FP8 = false;
    const bf16_t* XR; bf16_t* H;
    __device__ __forceinline__ void operator()(const f32x4 (&acc)[2][2][4][2], const Unit& u, int wr, int wc, int fr, int fq) const {
        const int row0 = u.pm * BM + wr * 64 + fr, col0 = u.pn * BM + wc * 32 + 8 * fq;
#pragma unroll
        for (int ai = 0; ai < 2; ++ai) {
            int rowb = row0 + ai * HALF; asm volatile("" : "+v"(rowb)); const size_t off0 = (size_t)rowb * D + col0;
            u32x4 xr[4][2];
#pragma unroll
            for (int m = 0; m < 4; ++m)
#pragma unroll
                for (int bj = 0; bj < 2; ++bj) xr[m][bj] = *(const u32x4*)(XR + off0 + (size_t)(m * 16) * D + bj * HALF);
#pragma unroll
            for (int m = 0; m < 4; ++m)
#pragma unroll
                for (int bj = 0; bj < 2; ++bj) { const u32x4 x = xr[m][bj]; const f32x4 v0 = acc[ai][bj][m][0], v1 = acc[ai][bj][m][1]; u32x4 w;
                    w.x = pk2(bflo(x.x) * ALPHA + v0[0], bfhi(x.x) * ALPHA + v0[1]); w.y = pk2(bflo(x.y) * ALPHA + v0[2], bfhi(x.y) * ALPHA + v0[3]);
                    w.z = pk2(bflo(x.z) * ALPHA + v1[0], bfhi(x.z) * ALPHA + v1[1]); w.w = pk2(bflo(x.w) * ALPHA + v1[2], bfhi(x.w) * ALPHA + v1[3]);
                    *(u32x4*)(H + off0 + (size_t)(m * 16) * D + bj * HALF) = w; }
            asm volatile("" ::: "memory"); }
    }
};
struct EpiSwiglu {
    static constexpr bool PERM = true, SEG = false, FP8 = true;
    unsigned char* HID;
    __device__ __forceinline__ void operator()(const f32x4 (&acc)[2][2][4][2], const Unit& u, int wr, int wc, int fr, int fq) const {
        const int row0 = u.pm * BM + wr * 64 + fr, col0 = (u.pn & 15) * 128 + wc * 32 + 8 * fq;
#pragma unroll
        for (int ai = 0; ai < 2; ++ai)
#pragma unroll
            for (int m = 0; m < 4; ++m) { const f32x4 g0 = acc[ai][0][m][0], g1 = acc[ai][0][m][1], u0 = acc[ai][1][m][0], u1 = acc[ai][1][m][1];
                f32x4 h0, h1;
#pragma unroll
                for (int j = 0; j < 4; ++j) { const float t0 = __builtin_amdgcn_exp2f(g0[j] * (-0.03125f * 1.44269504088896f)), t1 = __builtin_amdgcn_exp2f(g1[j] * (-0.03125f * 1.44269504088896f));
                    h0[j] = g0[j] * u0[j] * frcp(__builtin_fmaf(t0, 1024.0f, 1024.0f)); h1[j] = g1[j] * u1[j] * frcp(__builtin_fmaf(t1, 1024.0f, 1024.0f)); }
                u32x2 w; w.x = pk4_fp8(h0[0], h0[1], h0[2], h0[3]); w.y = pk4_fp8(h1[0], h1[1], h1[2], h1[3]);
                int rowi = row0 + ai * HALF + m * 16; asm volatile("" : "+v"(rowi));
                *(u32x2*)(HID + (size_t)rowi * DE + col0) = w; asm volatile("" ::: "memory"); }
    }
};
struct EpiDown {
    static constexpr bool PERM = true, SEG = false, FP8 = true;
    bf16_t* Y; const float* GV;
    __device__ __forceinline__ void operator()(const f32x4 (&acc)[2][2][4][2], const Unit& u, int wr, int wc, int fr, int fq) const {
        const int row0 = u.pm * BM + wr * 64 + fr, col0 = (u.pn & 3) * BM + wc * 32 + 8 * fq;
        float gvs[2][4];
#pragma unroll
        for (int ai = 0; ai < 2; ++ai)
#pragma unroll
            for (int m = 0; m < 4; ++m) gvs[ai][m] = GV[row0 + ai * HALF + m * 16];
#pragma unroll
        for (int ai = 0; ai < 2; ++ai)
#pragma unroll
            for (int m = 0; m < 4; ++m) { int row = row0 + ai * HALF + m * 16; asm volatile("" : "+v"(row)); const float gv = gvs[ai][m] * 0.03125f;
#pragma unroll
                for (int bj = 0; bj < 2; ++bj) { const f32x4 v0 = acc[ai][bj][m][0] * gv, v1 = acc[ai][bj][m][1] * gv;
                    u32x4 w; w.x = pk2(v0[0], v0[1]); w.y = pk2(v0[2], v0[3]); w.z = pk2(v1[0], v1[1]); w.w = pk2(v1[2], v1[3]);
                    *(u32x4*)(Y + (size_t)row * D + col0 + bj * HALF) = w; } }
    }
};
}

#define XB_TMO      128
#define XB_XCNT(j)  (256  + 64 * (j))
#define XB_XSUB(j)  (1280 + 64 * (j))
#define XB_XGEN(j)  (2304 + 64 * (j))
#define XB_TOP      3328
#define XB_TOPGEN   3392
#define XCD_BAR_WORDS 3456
#define XB_SPIN_CAP (1u << 22)
__device__ __forceinline__ unsigned xb_ld(unsigned* p)              { return __hip_atomic_load(p, __ATOMIC_RELAXED, __HIP_MEMORY_SCOPE_AGENT); }
__device__ __forceinline__ unsigned xb_add(unsigned* p, unsigned v) { return __hip_atomic_fetch_add(p, v, __ATOMIC_RELAXED, __HIP_MEMORY_SCOPE_AGENT); }
__device__ __forceinline__ unsigned xb_xcc_id() { return (unsigned)__builtin_amdgcn_s_getreg((3 << 11) | 20) & 0xFu; }
#define XB_SPIN(cond, bar) do { unsigned _sp = 0; while (cond) { __builtin_amdgcn_s_sleep(1); \
    if ((++_sp & 255u) == 0u) { if (xb_ld(&(bar)[XB_TMO])) break; if (_sp > XB_SPIN_CAP) { atomicAdd(&(bar)[XB_TMO], 1u); break; } } } } while (0)
struct XcdBarrier { unsigned* bar; unsigned x; volatile LAS unsigned* st; };
__device__ __forceinline__ XcdBarrier xcd_barrier_post(unsigned* bar, volatile LAS unsigned* st) {
    XcdBarrier b; b.bar = bar; b.x = xb_xcc_id(); b.st = st;
    if (threadIdx.x == 0) (void)xb_add(&bar[XB_XCNT(b.x)], 1u);
    return b;
}
__device__ __forceinline__ void xcd_barrier_complete(unsigned* bar, unsigned x, unsigned& nloc, unsigned& nx) {
    const unsigned G = gridDim.x * gridDim.y * gridDim.z;
    unsigned sum, cnt, mine, sp = 0u;
    for (;;) {
        sum = 0u; cnt = 0u; mine = 0u;
#pragma unroll
        for (unsigned j = 0; j < 16; ++j) { const unsigned c = xb_ld(&bar[XB_XCNT(j)]); sum += c; cnt += (c > 0u) ? 1u : 0u; }
        mine = xb_ld(&bar[XB_XCNT(x)]);
        if (sum == G) break;
        __builtin_amdgcn_s_sleep(1);
        if ((++sp & 255u) == 0u) { if (xb_ld(&bar[XB_TMO])) break; if (sp > XB_SPIN_CAP) { atomicAdd(&bar[XB_TMO], 1u); break; } }
    }
    nloc = mine > 0u ? mine : 1u; nx = cnt > 0u ? cnt : 1u;
}
__device__ __forceinline__ void xcd_barrier(const XcdBarrier& b) {
    asm volatile("s_waitcnt vmcnt(0)" ::: "memory");
    __syncthreads();
    if (threadIdx.x == 0) {
        unsigned* bar = b.bar; asm volatile("" : "+s"(bar));
        __builtin_amdgcn_s_waitcnt(0);
        unsigned nloc = b.st[0], nx = b.st[1];
        if (nloc == 0u) { xcd_barrier_complete(bar, b.x, nloc, nx); b.st[0] = nloc; b.st[1] = nx; }
        const unsigned old = xb_add(&bar[XB_XSUB(b.x)], 1u);
        const unsigned gen = old / nloc;
        if (old + 1u == (gen + 1u) * nloc) {
            __builtin_amdgcn_fence(__ATOMIC_RELEASE, "agent");
            asm volatile("s_waitcnt vmcnt(0)" ::: "memory");
            const unsigned og = xb_add(&bar[XB_TOP], 1u);
            const unsigned tg = og / nx;
            if (og + 1u == (tg + 1u) * nx) xb_add(&bar[XB_TOPGEN], 1u);
            else XB_SPIN(xb_ld(&bar[XB_TOPGEN]) == tg, bar);
            __builtin_amdgcn_fence(__ATOMIC_ACQUIRE, "agent");
            xb_add(&bar[XB_XGEN(b.x)], 1u);
            asm volatile("s_waitcnt vmcnt(0)" ::: "memory");
        } else {
            XB_SPIN(xb_ld(&bar[XB_XGEN(b.x)]) == gen, bar);
            __builtin_amdgcn_fence(__ATOMIC_ACQUIRE, "agent");
            asm volatile("s_waitcnt vmcnt(0)" ::: "memory");
        }
    }
    __syncthreads();
}

struct Args { const float* in[20]; float* out; unsigned char* ws; int ph_lo, ph_hi; };
typedef const __attribute__((address_space(4))) Args* KArgs;
DI KArgs kargs() { KArgs p = (KArgs)__builtin_amdgcn_kernarg_segment_ptr(); asm volatile("" : "+s"(p)); return p; }
struct Ctx {
    float* out; unsigned char* ws;
    int tid, lane, wave, G, bid;
    int layer, slab;
    int nseq, seqlen;
    int stok, sbase;
    int dry;
};
#define WSP(T, off) ((T*)(c.ws + (off)))
#define BIGP(T, off) ((T*)(c.ws + WS_BIG + (off)))

__device__ const float INV_FREQ[32] = {1.000000000e+00f, 7.498942018e-01f, 5.623413324e-01f, 4.216965139e-01f, 3.162277639e-01f, 2.371373773e-01f, 1.778279394e-01f, 1.333521456e-01f, 1.000000015e-01f, 7.498942316e-02f, 5.623413250e-02f, 4.216964915e-02f, 3.162277490e-02f, 2.371373773e-02f, 1.778279431e-02f, 1.333521400e-02f, 9.999999776e-03f, 7.498942316e-03f, 5.623413250e-03f, 4.216964822e-03f, 3.162277630e-03f, 2.371373819e-03f, 1.778279431e-03f, 1.333521446e-03f, 1.000000047e-03f, 7.498941850e-04f, 5.623413017e-04f, 4.216965172e-04f, 3.162277571e-04f, 2.371373703e-04f, 1.778279402e-04f, 1.333521504e-04f};
DI void tr_item(const float* src, long src_ld, int src_col0, int nvalid, int kvalid, bf16_t* dst, long dst_ld, int dst_row0, int k0, LAS float* scr, int lane) {
    float tv[32];
#pragma unroll
    for (int i = 0; i < 32; ++i) { const int kk = 2 * i + (lane >> 5), cc = lane & 31;
        tv[i] = 0.f; if ((k0 + kk) < kvalid && cc < nvalid) tv[i] = src[(size_t)(k0 + kk) * src_ld + src_col0 + cc]; }
#pragma unroll
    for (int i = 0; i < 32; ++i) { const int kk = 2 * i + (lane >> 5), cc = lane & 31; scr[kk * 33 + cc] = tv[i]; }
    asm volatile("s_waitcnt lgkmcnt(0)" ::: "memory");
    const int c8 = lane & 7;
#pragma unroll
    for (int j = 0; j < 4; ++j) { const int n = (lane >> 3) + 8 * j; const LAS float* s = scr + (8 * c8) * 33 + n;
        u32x4 o; o.x = pk2(s[0 * 33], s[1 * 33]); o.y = pk2(s[2 * 33], s[3 * 33]); o.z = pk2(s[4 * 33], s[5 * 33]); o.w = pk2(s[6 * 33], s[7 * 33]);
        *(u32x4*)(dst + (size_t)(dst_row0 + n) * dst_ld + k0 + 8 * c8) = o; }
    asm volatile("s_waitcnt lgkmcnt(0)" ::: "memory");
}
DI void tr_item8(const float* src, long src_ld, int src_col0, int kvalid, unsigned char* dst, long dst_ld, int dst_row0, int k0, float scale, LAS float* scr, int lane) {
    float tv[32];
#pragma unroll
    for (int i = 0; i < 32; ++i) { const int kk = 2 * i + (lane >> 5), cc = lane & 31; tv[i] = 0.f; if ((k0 + kk) < kvalid) tv[i] = src[(size_t)(k0 + kk) * src_ld + src_col0 + cc]; }
#pragma unroll
    for (int i = 0; i < 32; ++i) { const int kk = 2 * i + (lane >> 5), cc = lane & 31; scr[kk * 33 + cc] = tv[i]; }
    asm volatile("s_waitcnt lgkmcnt(0)" ::: "memory");
    const int c8 = lane & 7;
#pragma unroll
    for (int j = 0; j < 4; ++j) { const int n = (lane >> 3) + 8 * j; const LAS float* s = scr + (8 * c8) * 33 + n;
        u32x2 o; o.x = pk4_fp8(s[0 * 33] * scale, s[1 * 33] * scale, s[2 * 33] * scale, s[3 * 33] * scale); o.y = pk4_fp8(s[4 * 33] * scale, s[5 * 33] * scale, s[6 * 33] * scale, s[7 * 33] * scale);
        *(u32x2*)(dst + (size_t)(dst_row0 + n) * dst_ld + k0 + 8 * c8) = o; }
    asm volatile("s_waitcnt lgkmcnt(0)" ::: "memory");
}
DI void phase_weights(KArgs args, LAS unsigned char* lds, const Ctx& c) {
    const int l = c.layer, lane = c.lane;
    LAS float* scr = (LAS float*)(lds + c.wave * 8448);
    const int gw = c.bid * 8 + c.wave, NGW = c.G * 8;
    constexpr int I_IN = 16 * 112 + 16 * 96 + 16 * 56, I_NA = 4 * 32, I_DIL = 2 * 32, I_GDN = 6 * 32, I_OUT = 16 * 32, I_GU1 = 16 * 128, I_D1 = 32 * 32;
    constexpr int NITEMS = I_IN + I_NA + I_DIL + I_GDN + I_OUT + 16 * I_GU1 + 16 * I_D1;
    for (int it = gw; it < NITEMS; it += NGW) {
        int r = it;
        const float* src; long sld; int sc0, nv = 32, kv; bf16_t* dst; long dld; int dr0, k0;
        if (r < 16 * 112) { const int kb = r / 112, nb = r % 112, n0 = 32 * nb; src = args->in[2] + (size_t)l * D * DIN; sld = DIN; kv = D;
            sc0 = n0; nv = 3480 - n0; if (nv < 0) { nv = 0; sc0 = 0; } if (nv > 32) nv = 32;
            dst = WSP(bf16_t, WS_WIN); dld = D; dr0 = n0; k0 = 64 * kb; }
        else if (r < I_IN) { const int q = r - 16 * 112, kb = q / 96, nb = q % 96;
            if (q < 16 * 96) tr_item8(args->in[2] + (size_t)l * D * DIN, DIN, 3480 + 32 * nb, D, WSP(unsigned char, WS_WG8), D, 32 * nb, 64 * kb, 32.0f, scr, lane);
            else { const int q2 = q - 16 * 96, kb2 = q2 / 56, nb2 = q2 % 56;
                tr_item8(args->in[2] + (size_t)l * D * DIN, DIN, 32 * nb2, D, WSP(unsigned char, WS_WG8), D, 3072 + 32 * nb2, 64 * kb2, 32.0f, scr, lane); }
            continue; }
        else if ((r -= I_IN) < I_NA) { const int kb = r / 32, nb = r % 32; src = args->in[8] + (size_t)l * 256 * D; sld = D; sc0 = 32 * nb; kv = 256; dst = WSP(bf16_t, WS_WBR); dld = 768; dr0 = 32 * nb; k0 = 64 * kb; }
        else if ((r -= I_NA) < I_DIL) { const int kb = r / 32, nb = r % 32; src = args->in[9] + (size_t)l * 128 * D; sld = D; sc0 = 32 * nb; kv = 128; dst = WSP(bf16_t, WS_WBR) + 256; dld = 768; dr0 = 32 * nb; k0 = 64 * kb; }
        else if ((r -= I_DIL) < I_GDN) { const int kb = r / 32, nb = r % 32; src = args->in[10] + (size_t)l * 384 * D; sld = D; sc0 = 32 * nb; kv = 384; dst = WSP(bf16_t, WS_WBR) + 384; dld = 768; dr0 = 32 * nb; k0 = 64 * kb; }
        else if ((r -= I_GDN) < I_OUT) { const int kb = r / 32, nb = r % 32; src = args->in[11] + (size_t)l * D * D; sld = D; sc0 = 32 * nb; kv = D; dst = WSP(bf16_t, WS_WOUT); dld = D; dr0 = 32 * nb; k0 = 64 * kb; }
        else if ((r -= I_OUT) < 16 * I_GU1) { const int e = r / I_GU1, q = r % I_GU1, kb = q / 128, nb = q % 128, n0 = 32 * nb, j = n0 >> 8, rr = n0 & 255;
            tr_item8((rr < 128 ? args->in[16] : args->in[15]) + ((size_t)l * NE + e) * D * DE, DE, 128 * j + (rr & 127), D, WSP(unsigned char, WS_WGU) + (size_t)e * 4096 * D, D, n0, 64 * kb, 32.0f, scr, lane); continue; }
        else { r -= 16 * I_GU1; const int e = r / I_D1, q = r % I_D1, kb = q / 32, nb = q % 32;
            tr_item8(args->in[17] + ((size_t)l * NE + e) * DE * D, D, 32 * nb, DE, WSP(unsigned char, WS_WD) + (size_t)e * D * DE, DE, 32 * nb, 64 * kb, 32.0f, scr, lane); continue; }
        tr_item(src, sld, sc0, nv, kv, dst, dld, dr0, k0, scr, lane);
    }
    if (l == 0) {
        for (int t = gw; t < T_ALL; t += NGW) {
            const float* xr = (t < T_P) ? args->in[0] + (size_t)t * D : args->in[1] + (size_t)(t - T_P) * D;
            bf16_t* o = WSP(bf16_t, WS_XB) + (size_t)t * D;
#pragma unroll
            for (int j = 0; j < 4; ++j) { const f32x4 v = *(const f32x4*)(xr + 4 * lane + 256 * j); u32x2 w; w.x = pk2(v[0], v[1]); w.y = pk2(v[2], v[3]); *(u32x2*)(o + 4 * lane + 256 * j) = w;
                *(unsigned*)(WSP(unsigned char, WS_XB8) + (size_t)t * D + 4 * lane + 256 * j) = pk4_fp8(v[0], v[1], v[2], v[3]); }
        }
        float* cs = WSP(float, WS_CS);
        for (int i = c.bid * 512 + c.tid; i < 16384 * 32; i += c.G * 512) { const int pos = i >> 5, k = i & 31;
            const float inv = INV_FREQ[k];
            const float ang = (float)pos * inv;
            cs[pos * 64 + k] = cosf(ang); cs[pos * 64 + 32 + k] = sinf(ang); }
    }
}

constexpr int TLD = 72, TILEB = 64 * TLD * 2;
DI int tsw(int row) { return ((row >> 4) & 3) << 3; }
template <bool SA = false, bool SB = false> DI f32x16 mm_tile(const LAS bf16_t* A, const LAS bf16_t* Bt, int m0, int n0, int lane) {
    f32x16 acc = zero16(); const int r = lane & 31, hh = lane >> 5; const int sa = SA ? tsw(m0 + r) : 0, sb = SB ? tsw(n0 + r) : 0;
#pragma unroll
    for (int ks = 0; ks < 4; ++ks) { const bf16x8 a = *(const LAS bf16x8*)(A + (m0 + r) * TLD + ((16 * ks + 8 * hh) ^ sa)); const bf16x8 b = *(const LAS bf16x8*)(Bt + (n0 + r) * TLD + ((16 * ks + 8 * hh) ^ sb)); acc = MFMA32(a, b, acc); }
    return acc;
}

constexpr int PI_P0 = 0, PI_P1 = 9216, PI_INTRA = 18432, PI_AM = 27648, PI_TT = 45056, PI_TD0 = 54272, PI_TD1 = 60416, PI_PM = 65024, PI_VEC = 71168, PI_BYTES = 72704;
constexpr int PI_WT = PI_AM, PI_UT = PI_TD0;
struct PrepIn { float bl[2], al[2], cw[2]; };
DI void gdn_prep_loads(KArgs args, const Ctx& c, int pu, PrepIn& in) {
    int tid = c.tid; asm volatile("" : "+v"(tid));
    { const float* cwg = args->in[4] + (size_t)c.layer * 5 * 1152 + 64 * (pu % 6);
#pragma unroll
        for (int k = 0; k < 2; ++k) { int i = tid + 512 * k; i = i < 960 ? i : 959; const int tp = i / 192, r = i % 192; in.cw[k] = cwg[tp * 1152 + (r >> 6) * 384 + (r & 63)]; } }
    const int dir = tid >> 8, tg = tid & 255, head = pu % 6, gch = pu / 6, cps = c.seqlen >> 6, seq = gch / cps, n = gch % cps, ia = tg >> 3, p = tg & 7, tr = ia + 32 * dir;
    const float* BA = BIGP(float, B_BA);
#pragma unroll
    for (int h2 = 0; h2 < 2; ++h2) { const int i = ia + 32 * h2, tokl = dir ? 63 - i : i; const float* bar = BA + (size_t)(seq * c.seqlen + n * 64 + tokl) * 32;
        in.bl[h2] = bar[dir * 6 + head]; in.al[h2] = bar[12 + dir * 6 + head]; }
}
DI void gdn_prep_put_cw(LAS unsigned char* L0, const Ctx& c, const PrepIn& in) {
    int tid = c.tid; asm volatile("" : "+v"(tid)); LAS float* CW = (LAS float*)(L0 + LDS_CW);
    CW[tid] = in.cw[0]; if (tid < 448) CW[tid + 512] = in.cw[1];
}
DI void gdn_prep_pair(KArgs args, LAS unsigned char* L0, const Ctx& c, int pu, PrepIn& in, int pu_next) {
    int tid = c.tid; asm volatile("" : "+v"(tid)); const int lane = tid & 63, wave = __builtin_amdgcn_readfirstlane(tid >> 6), l = c.layer;
    const int dir = wave >> 2, wg = wave & 3, tg = tid & 255, head = pu % 6, gch = pu / 6, inst = (gch * 6 + head) * 2 + dir;
    const int cps = c.seqlen >> 6, seq = gch / cps, n = gch % cps;
    const bf16_t* PROJ = BIGP(bf16_t, B_PROJ); const float* BA = BIGP(float, B_BA);
    unsigned char* G = BIGP(unsigned char, B_GSCR) + (size_t)inst * GSTRIDE;
    LAS unsigned char* L = L0 + dir * PI_BYTES;
    LAS bf16_t* P0 = (LAS bf16_t*)(L + PI_P0); LAS bf16_t* P1 = (LAS bf16_t*)(L + PI_P1); LAS bf16_t* INTRA = (LAS bf16_t*)(L + PI_INTRA);
    LAS float* AM = (LAS float*)(L + PI_AM); LAS bf16_t* TT = (LAS bf16_t*)(L + PI_TT);
    LAS float* TD0 = (LAS float*)(L + PI_TD0); LAS float* TD1 = (LAS float*)(L + PI_TD1); LAS float* PM = (LAS float*)(L + PI_PM);
    LAS float* GV = (LAS float*)(L + PI_VEC); LAS float* BV = GV + 64; LAS float* GC = GV + 128;
    LAS bf16_t* WT = (LAS bf16_t*)(L + PI_WT); LAS bf16_t* UT = (LAS bf16_t*)(L + PI_UT);
    const int ia = tg >> 3, p = tg & 7;
    LAS float* XQ = (LAS float*)(L0 + PI_AM);
    LAS float* XK = (LAS float*)(L0 + PI_TT);
    LAS float* XV = (LAS float*)(L0 + PI_BYTES + PI_AM);
    {   float q1[8], k1[8], v1[8];
#pragma unroll
        for (int j = 0; j < 8; ++j) { q1[j] = 0.f; k1[j] = 0.f; v1[j] = 0.f; }
        const LAS float* cw = (const LAS float*)(L0 + LDS_CW) + 8 * p;
        const int tr = ia + 32 * dir;
        u32x4 rqa[5], rka[5], rva[5];
#pragma unroll
        for (int tp = 0; tp < 5; ++tp) { const int pp = n * 64 + tr + tp - 2, ppc = pp < 0 ? 0 : (pp >= c.seqlen ? c.seqlen - 1 : pp);
            const bf16_t* rp = PROJ + (size_t)(seq * c.seqlen + ppc) * NPROJ + 64 * head + 8 * p;
            rqa[tp] = *(const u32x4*)(rp + C_QC); rka[tp] = *(const u32x4*)(rp + C_KC); rva[tp] = *(const u32x4*)(rp + C_VC); }
#pragma unroll
        for (int tp = 0; tp < 5; ++tp) { const LAS float* w = cw + tp * 192;
            const f32x4 wq0 = *(const LAS f32x4*)w, wq1 = *(const LAS f32x4*)(w + 4), wk0 = *(const LAS f32x4*)(w + 64), wk1 = *(const LAS f32x4*)(w + 68), wv0 = *(const LAS f32x4*)(w + 128), wv1 = *(const LAS f32x4*)(w + 132);
            const int pp = n * 64 + tr + tp - 2; const bool inr = (pp >= 0 && pp < c.seqlen);
            { u32x4 rq = rqa[tp], rk = rka[tp], rv = rva[tp];
                if (!inr) { rq = (u32x4){0u, 0u, 0u, 0u}; rk = rq; rv = rq; }
#pragma unroll
                for (int j = 0; j < 4; ++j) { const float a0 = (j < 2) ? wq0[2 * j] : wq1[2 * j - 4], a1 = (j < 2) ? wq0[2 * j + 1] : wq1[2 * j - 3];
                    const float b0 = (j < 2) ? wk0[2 * j] : wk1[2 * j - 4], b1 = (j < 2) ? wk0[2 * j + 1] : wk1[2 * j - 3];
                    const float c0 = (j < 2) ? wv0[2 * j] : wv1[2 * j - 4], c1 = (j < 2) ? wv0[2 * j + 1] : wv1[2 * j - 3];
                    q1[2 * j] += a0 * bflo(rq[j]); q1[2 * j + 1] += a1 * bfhi(rq[j]);
                    k1[2 * j] += b0 * bflo(rk[j]); k1[2 * j + 1] += b1 * bfhi(rk[j]);
                    v1[2 * j] += c0 * bflo(rv[j]); v1[2 * j + 1] += c1 * bfhi(rv[j]); } } }
        float sq = 0.f, sk = 0.f;
#pragma unroll
        for (int j = 0; j < 8; ++j) { q1[j] = siluf_(q1[j]); k1[j] = siluf_(k1[j]); v1[j] = siluf_(v1[j]); sq += q1[j] * q1[j]; sk += k1[j] * k1[j]; }
        sq += __shfl_xor(sq, 1); sq += __shfl_xor(sq, 2); sq += __shfl_xor(sq, 4);
        sk += __shfl_xor(sk, 1); sk += __shfl_xor(sk, 2); sk += __shfl_xor(sk, 4);
        const float rq_ = 0.125f * frsq(sq + NORM_EPS), rk_ = frsq(sk + NORM_EPS);
        f32x4 o0, o1;
        o0[0] = q1[0] * rq_; o0[1] = q1[1] * rq_; o0[2] = q1[2] * rq_; o0[3] = q1[3] * rq_; o1[0] = q1[4] * rq_; o1[1] = q1[5] * rq_; o1[2] = q1[6] * rq_; o1[3] = q1[7] * rq_;
        *(LAS f32x4*)(XQ + tr * 64 + 8 * p) = o0; *(LAS f32x4*)(XQ + tr * 64 + 8 * p + 4) = o1;
        o0[0] = k1[0] * rk_; o0[1] = k1[1] * rk_; o0[2] = k1[2] * rk_; o0[3] = k1[3] * rk_; o1[0] = k1[4] * rk_; o1[1] = k1[5] * rk_; o1[2] = k1[6] * rk_; o1[3] = k1[7] * rk_;
        *(LAS f32x4*)(XK + tr * 64 + 8 * p) = o0; *(LAS f32x4*)(XK + tr * 64 + 8 * p + 4) = o1;
        o0[0] = v1[0]; o0[1] = v1[1]; o0[2] = v1[2]; o0[3] = v1[3]; o1[0] = v1[4]; o1[1] = v1[5]; o1[2] = v1[6]; o1[3] = v1[7];
        *(LAS f32x4*)(XV + tr * 64 + 8 * p) = o0; *(LAS f32x4*)(XV + tr * 64 + 8 * p + 4) = o1; }
#pragma unroll
    for (int h2 = 0; h2 < 2; ++h2) {
        if (p == 0) { const int i = ia + 32 * h2;
            const float bl = in.bl[h2], al = in.al[h2];
            const float xx = al + args->in[6][l * 12 + dir * 6 + head];
            const float sp = xx > 20.f ? xx : log1pf(expf(xx));
            GV[i] = -expf(args->in[5][l * 12 + dir * 6 + head]) * sp; BV[i] = sigmoidf_(bl); } }
    lds_barrier();
    float q[2][8], k[2][8], v[2][8];
#pragma unroll
    for (int h2 = 0; h2 < 2; ++h2) { const int i = ia + 32 * h2, tokl = dir ? 63 - i : i;
        const f32x4 a0 = *(const LAS f32x4*)(XQ + tokl * 64 + 8 * p), a1 = *(const LAS f32x4*)(XQ + tokl * 64 + 8 * p + 4), b0 = *(const LAS f32x4*)(XK + tokl * 64 + 8 * p), b1 = *(const LAS f32x4*)(XK + tokl * 64 + 8 * p + 4),
                    c0 = *(const LAS f32x4*)(XV + tokl * 64 + 8 * p), c1 = *(const LAS f32x4*)(XV + tokl * 64 + 8 * p + 4);
#pragma unroll
        for (int j = 0; j < 4; ++j) { q[h2][j] = a0[j]; q[h2][4 + j] = a1[j]; k[h2][j] = b0[j]; k[h2][4 + j] = b1[j]; v[h2][j] = c0[j]; v[h2][4 + j] = c1[j]; } }
    float gcl_;
    { float x = GV[lane];
#pragma unroll
        for (int o = 1; o < 64; o <<= 1) { const float y = __shfl_up(x, o); if (lane >= o) x += y; }
        if (wg == 0) GC[lane] = x;
        gcl_ = x; }
    const float gc0 = __shfl(gcl_, ia), gc1 = __shfl(gcl_, ia + 32), gcl = __shfl(gcl_, 63);
#pragma unroll
    for (int h2 = 0; h2 < 2; ++h2) { const int i = ia + 32 * h2; u32x4 wq, wk;
#pragma unroll
        for (int j = 0; j < 4; ++j) { wq[j] = pk2(q[h2][2 * j], q[h2][2 * j + 1]); wk[j] = pk2(k[h2][2 * j], k[h2][2 * j + 1]); }
        *(LAS u32x4*)(P0 + i * TLD + 8 * p) = wq; *(LAS u32x4*)(P1 + i * TLD + 8 * p) = wk; }
    lds_barrier();
    { const int mat = wg >> 1, mt = wg & 1, hh = lane >> 5;
        float gi[16], bi[16];
#pragma unroll
        for (int r = 0; r < 16; ++r) { const int ii = 32 * mt + crow(r, hh); gi[r] = GC[ii]; bi[r] = BV[ii]; }
        __builtin_amdgcn_sched_barrier(0);
#pragma unroll
        for (int nt = 0; nt < 2; ++nt) { const int jc = 32 * nt + (lane & 31);
            const f32x16 a = mm_tile(mat ? P0 : P1, P1, 32 * mt, 32 * nt, lane);
            const float gj = GC[jc];
            if (mat == 0) {
#pragma unroll
                for (int r = 0; r < 16; ++r) { const int ii = 32 * mt + crow(r, hh); const float ev = bi[r] * a[r] * __expf(gi[r] - gj); AM[ii * 68 + jc] = (jc < ii) ? ev : 0.f; }
            } else {
#pragma unroll
                for (int r = 0; r < 16; ++r) { const int ii = 32 * mt + crow(r, hh); const float ev = a[r] * __expf(gi[r] - gj); INTRA[ii * TLD + jc] = (bf16_t)(pk2((jc <= ii) ? ev : 0.f, 0.f) & 0xffffu); } } } }
    lds_barrier();
    if (wg == dir) {
        const int b = lane >> 5, cidx = lane & 31; float t[32]; typedef float f32x2_ __attribute__((ext_vector_type(2)));
#pragma unroll
        for (int ii = 0; ii < 32; ++ii) t[ii] = (ii == cidx) ? 1.f : 0.f;
        const LAS float* Ab = AM + (32 * b) * 68 + 32 * b;
        f32x4 rb[2][8];
        rb[1][0] = *(const LAS f32x4*)(Ab + 68);
        __builtin_amdgcn_sched_barrier(0);
#pragma unroll
        for (int ii = 1; ii < 32; ++ii) {
            if (ii + 1 < 32) {
#pragma unroll
                for (int j4 = 0; j4 < ii + 1; j4 += 4) rb[(ii + 1) & 1][j4 >> 2] = *(const LAS f32x4*)(Ab + (ii + 1) * 68 + j4); }
            __builtin_amdgcn_sched_barrier(0);
            f32x2_ a0 = {0.f, 0.f}, a1 = {0.f, 0.f};
#pragma unroll
            for (int j4 = 0; j4 < ii; j4 += 4) { const f32x4 a4 = rb[ii & 1][j4 >> 2];
                const f32x2_ tl = {t[j4], t[j4 + 1]}, th = {t[j4 + 2], t[j4 + 3]}, al = {a4[0], a4[1]}, ah = {a4[2], a4[3]};
                a0 += al * tl; a1 += ah * th; }
            a0 += a1; t[ii] -= a0.x + a0.y;
            __builtin_amdgcn_sched_barrier(0); }
        LAS float* td = b ? TD1 : TD0; const int tds = b ? 36 : 48;
#pragma unroll
        for (int ii = 0; ii < 32; ++ii) { td[ii * tds + cidx] = t[ii]; TT[(32 * b + ii) * TLD + 32 * b + cidx] = (bf16_t)(pk2(t[ii], 0.f) & 0xffffu); }
    }
#pragma unroll
    for (int h2 = 0; h2 < 2; ++h2) { const int i = ia + 32 * h2; const float be = BV[i], eg = __expf(h2 ? gc1 : gc0);
#pragma unroll
        for (int j = 0; j < 8; ++j) { const int d = 8 * p + j, o_ = d * TLD + (i ^ tsw(d)); P0[o_] = (bf16_t)(pk2(k[h2][j] * be * eg, 0.f) & 0xffffu); P1[o_] = (bf16_t)(pk2(v[h2][j] * be, 0.f) & 0xffffu); } }
    { unsigned zz; asm volatile("v_mov_b32 %0, 0" : "=v"(zz)); u32x2 z; z.x = zz; z.y = zz; *(LAS u32x2*)(TT + (tg >> 3) * TLD + 32 + 4 * (tg & 7)) = z; }
    lds_barrier();
    { const int qi = wg >> 1, qj = wg & 1, r16 = lane & 15, g4 = lane >> 4; f32x4 pc = {0.f, 0.f, 0.f, 0.f}; float av[8], bw[8];
#pragma unroll
        for (int kk = 0; kk < 8; ++kk) { av[kk] = AM[(32 + 16 * qi + r16) * 68 + 4 * kk + g4]; bw[kk] = TD0[(4 * kk + g4) * 48 + 16 * qj + r16]; }
        __builtin_amdgcn_sched_barrier(0);
#pragma unroll
        for (int kk = 0; kk < 8; ++kk) pc = __builtin_amdgcn_mfma_f32_16x16x4f32(av[kk], bw[kk], pc, 0, 0, 0);
#pragma unroll
        for (int r = 0; r < 4; ++r) PM[(16 * qi + 4 * g4 + r) * 48 + 16 * qj + r16] = pc[r]; }
    lds_barrier();
    { const int qi = wg >> 1, qj = wg & 1, r16 = lane & 15, g4 = lane >> 4; f32x4 pc = {0.f, 0.f, 0.f, 0.f}; float av[8], bw[8];
#pragma unroll
        for (int kk = 0; kk < 8; ++kk) { av[kk] = TD1[(16 * qi + r16) * 36 + 4 * kk + g4]; bw[kk] = PM[(4 * kk + g4) * 48 + 16 * qj + r16]; }
        __builtin_amdgcn_sched_barrier(0);
#pragma unroll
        for (int kk = 0; kk < 8; ++kk) pc = __builtin_amdgcn_mfma_f32_16x16x4f32(av[kk], bw[kk], pc, 0, 0, 0);
#pragma unroll
        for (int r = 0; r < 4; ++r) TT[(32 + 16 * qi + 4 * g4 + r) * TLD + 16 * qj + r16] = (bf16_t)(pk2(-pc[r], 0.f) & 0xffffu); }
    lds_barrier();
    { const int which = wg >> 1, mt = wg & 1, hh = lane >> 5;
#pragma unroll
        for (int nt = 0; nt < 2; ++nt) { const int dc = 32 * nt + (lane & 31);
            const f32x16 a = mm_tile<false, true>(TT, which ? P1 : P0, 32 * mt, 32 * nt, lane);
            LAS bf16_t* dst = (which ? UT : WT) + dc * TLD; const int sw = tsw(dc);
#pragma unroll
            for (int g = 0; g < 4; ++g) { u32x2 w; w.x = pk2(a[4 * g], a[4 * g + 1]); w.y = pk2(a[4 * g + 2], a[4 * g + 3]); *(LAS u32x2*)(dst + ((32 * mt + 8 * g + 4 * hh) ^ sw)) = w; } } }
    lds_barrier();
#pragma unroll
    for (int h2 = 0; h2 < 2; ++h2) { const int i = ia + 32 * h2; const float gci = h2 ? gc1 : gc0, eg = __expf(gci), ekd = __expf(gcl - gci); u32x4 wqd;
#pragma unroll
        for (int j = 0; j < 4; ++j) wqd[j] = pk2(q[h2][2 * j] * eg, q[h2][2 * j + 1] * eg);
        *(LAS u32x4*)(P1 + i * TLD + 8 * p) = wqd;
#pragma unroll
        for (int j = 0; j < 8; ++j) { const int d = 8 * p + j; P0[d * TLD + (i ^ tsw(d))] = (bf16_t)(pk2(k[h2][j] * ekd, 0.f) & 0xffffu); } }
    lds_barrier();
    if (pu_next >= 0) gdn_prep_loads(args, c, pu_next, in);
    { const int hh = lane >> 5, rr = lane & 31;
        if (wg == 0) {
#pragma unroll
            for (int t4 = 0; t4 < 4; ++t4) { const int mtb = t4 >> 1, nta = t4 & 1; const f32x16 a = mm_tile<true, true>(WT, P0, 32 * mtb, 32 * nta, lane);
                f32x16 na; for (int r = 0; r < 16; ++r) na[r] = -a[r];
                *(bf16x8*)(G + (size_t)((nta * 4 + 2 * mtb) * 64 + lane) * 16) = pack8<0>(na); *(bf16x8*)(G + (size_t)((nta * 4 + 2 * mtb + 1) * 64 + lane) * 16) = pack8<1>(na); }
        } else if (wg == 1) {
#pragma unroll
            for (int t4 = 0; t4 < 4; ++t4) { const int mta = t4 >> 1, nte = t4 & 1; const f32x16 a = mm_tile<true, true>(P0, UT, 32 * mta, 32 * nte, lane);
                bf16x8* dp = (bf16x8*)(G + 8192 + (size_t)((nte * 2 + mta) * 64 + lane) * 32); dp[0] = pack8<0>(a); dp[1] = pack8<1>(a); }
        } else if (wg == 2) {
#pragma unroll
            for (int t4 = 0; t4 < 4; ++t4) { const int mtb = t4 >> 1, nti = t4 & 1; const f32x16 a = mm_tile<true, false>(WT, INTRA, 32 * mtb, 32 * nti, lane);
                f32x16 qe; const LAS bf16_t* qd = P1 + (32 * nti + rr) * TLD + 32 * mtb + 4 * hh;
#pragma unroll
                for (int g = 0; g < 4; ++g) { const u32x2 w = *(const LAS u32x2*)(qd + 8 * g); qe[4 * g] = bflo(w.x) - a[4 * g]; qe[4 * g + 1] = bfhi(w.x) - a[4 * g + 1]; qe[4 * g + 2] = bflo(w.y) - a[4 * g + 2]; qe[4 * g + 3] = bfhi(w.y) - a[4 * g + 3]; }
                *(bf16x8*)(G + 16384 + (size_t)((nti * 4 + 2 * mtb) * 64 + lane) * 16) = pack8<0>(qe); *(bf16x8*)(G + 16384 + (size_t)((nti * 4 + 2 * mtb + 1) * 64 + lane) * 16) = pack8<1>(qe); }
        } else {
#pragma unroll
            for (int t4 = 0; t4 < 4; ++t4) { const int mti = t4 >> 1, nte = t4 & 1; const f32x16 a = mm_tile<false, true>(INTRA, UT, 32 * mti, 32 * nte, lane);
                bf16x8* dp = (bf16x8*)(G + 24576) + (size_t)((nte * 2 + mti) * 2) * 64 + lane; dp[0] = pack8<0>(a); dp[64] = pack8<1>(a); }
            if (lane == 0) *(float*)(G + 40960) = __expf(gcl);
        } }
    if (pu_next >= 0) gdn_prep_put_cw(L0, c, in);
    lds_barrier();
}

DI void pv_accum(const f32x16 (&acc)[2][2], f32x16 (&o)[2][2], const LAS bf16_t* Vt, int lane) {
    const int r = lane & 31, hh = lane >> 5;
#pragma unroll
    for (int mt = 0; mt < 2; ++mt) {
        {   const bf16x8 p0 = pack8<0>(acc[mt][0]), p1 = pack8<0>(acc[mt][1]);
#pragma unroll
            for (int mo = 0; mo < 2; ++mo) { const LAS bf16_t* s = Vt + (32 * mo + r) * TLD; const int c0 = (32 * mt + 4 * hh) ^ tsw(32 * mo + r);
                const u32x2 lo = *(const LAS u32x2*)(s + c0), hi = *(const LAS u32x2*)(s + (c0 ^ 8)); u32x4 w; w.x = lo.x; w.y = lo.y; w.z = hi.x; w.w = hi.y; const bf16x8 vf = __builtin_bit_cast(bf16x8, w);
                o[mo][0] = MFMA32(vf, p0, o[mo][0]); o[mo][1] = MFMA32(vf, p1, o[mo][1]); } }
        {   const bf16x8 p0 = pack8<1>(acc[mt][0]), p1 = pack8<1>(acc[mt][1]);
#pragma unroll
            for (int mo = 0; mo < 2; ++mo) { const LAS bf16_t* s = Vt + (32 * mo + r) * TLD; const int c0 = (32 * mt + 16 + 4 * hh) ^ tsw(32 * mo + r);
                const u32x2 lo = *(const LAS u32x2*)(s + c0), hi = *(const LAS u32x2*)(s + (c0 ^ 8)); u32x4 w; w.x = lo.x; w.y = lo.y; w.z = hi.x; w.w = hi.y; const bf16x8 vf = __builtin_bit_cast(bf16x8, w);
                o[mo][0] = MFMA32(vf, p0, o[mo][0]); o[mo][1] = MFMA32(vf, p1, o[mo][1]); } }
    }
}
template <class F> DI void load_v(u32x4 (&vr)[8], int lane, F vrow) {
#pragma unroll
    for (int it = 0; it < 8; ++it) { const int id = it * 64 + lane, key = id >> 3, part = id & 7; vr[it] = *(const u32x4*)(vrow(key) + 8 * part); }
}
DI void put_vt(LAS bf16_t* Vt, int lane, const u32x4 (&vr)[8]) {
#pragma unroll
    for (int it = 0; it < 8; ++it) { const int id = it * 64 + lane, key = id >> 3, part = id & 7; const u32x4 w = vr[it];
#pragma unroll
        for (int j = 0; j < 4; ++j) { const int d0 = 8 * part + 2 * j, ks_ = key ^ tsw(d0); Vt[d0 * TLD + ks_] = (bf16_t)(w[j] & 0xffffu); Vt[(d0 + 1) * TLD + ks_] = (bf16_t)(w[j] >> 16); } }
}
DI void write_o_slot(LAS float* SL, const f32x16 (&o)[2][2], int lane) {
    const int r = lane & 31, hh = lane >> 5;
#pragma unroll
    for (int mo = 0; mo < 2; ++mo)
#pragma unroll
        for (int nt = 0; nt < 2; ++nt)
#pragma unroll
            for (int g = 0; g < 4; ++g) { f32x4 v; v[0] = o[mo][nt][4 * g]; v[1] = o[mo][nt][4 * g + 1]; v[2] = o[mo][nt][4 * g + 2]; v[3] = o[mo][nt][4 * g + 3];
                *(LAS f32x4*)(SL + (32 * nt + r) * 68 + 32 * mo + 8 * g + 4 * hh) = v; }
}
DI void add_o_slot(const LAS float* SL, f32x16 (&o)[2][2], int lane) {
    const int r = lane & 31, hh = lane >> 5;
#pragma unroll
    for (int mo = 0; mo < 2; ++mo)
#pragma unroll
        for (int nt = 0; nt < 2; ++nt)
#pragma unroll
            for (int g = 0; g < 4; ++g) { const f32x4 v = *(const LAS f32x4*)(SL + (32 * nt + r) * 68 + 32 * mo + 8 * g + 4 * hh);
                o[mo][nt][4 * g] += v[0]; o[mo][nt][4 * g + 1] += v[1]; o[mo][nt][4 * g + 2] += v[2]; o[mo][nt][4 * g + 3] += v[3]; }
}

constexpr int WAREA = 10240;
DI void osm_update(f32x16 (&acc)[2][2], f32x16 (&o)[2][2], float (&m)[2], float (&l)[2]) {
#pragma unroll
    for (int nt = 0; nt < 2; ++nt) { float mx = -1e30f;
#pragma unroll
        for (int mt = 0; mt < 2; ++mt)
#pragma unroll
            for (int g = 0; g < 16; ++g) mx = fmaxf(mx, acc[mt][nt][g]);
        mx = fmaxf(mx, __shfl_xor(mx, 32));
        const float mn = fmaxf(m[nt], mx), sc = __expf(m[nt] - mn); float sm = 0.f;
#pragma unroll
        for (int mt = 0; mt < 2; ++mt)
#pragma unroll
            for (int g = 0; g < 16; ++g) { const float pz = __expf(acc[mt][nt][g] - mn); acc[mt][nt][g] = pz; sm += pz; }
        sm += __shfl_xor(sm, 32);
        l[nt] = l[nt] * sc + sm; m[nt] = mn;
#pragma unroll
        for (int g = 0; g < 16; ++g) { o[0][nt][g] *= sc; o[1][nt][g] *= sc; } }
}
template <class F> DI void store_o_rows(LAS bf16_t* T, const f32x16 (&o)[2][2], const float (&scale)[2], int lane, F rowp) {
    const int r = lane & 31, hh = lane >> 5;
#pragma unroll
    for (int mo = 0; mo < 2; ++mo)
#pragma unroll
        for (int nt = 0; nt < 2; ++nt)
#pragma unroll
            for (int g = 0; g < 4; ++g) { u32x2 w; w.x = pk2(o[mo][nt][4 * g] * scale[nt], o[mo][nt][4 * g + 1] * scale[nt]); w.y = pk2(o[mo][nt][4 * g + 2] * scale[nt], o[mo][nt][4 * g + 3] * scale[nt]);
                *(LAS u32x2*)(T + (32 * nt + r) * TLD + 32 * mo + 8 * g + 4 * hh) = w; }
    asm volatile("s_waitcnt lgkmcnt(0)" ::: "memory");
#pragma unroll
    for (int it = 0; it < 8; ++it) { const int id = it * 64 + lane, q = id >> 3, part = id & 7; *(u32x4*)(rowp(q) + 8 * part) = *(const LAS u32x4*)(T + q * TLD + 8 * part); }
    asm volatile("s_waitcnt lgkmcnt(0)" ::: "memory");
}
DI void na_wave_unit(KArgs args, LAS unsigned char* L, const Ctx& c, int u, int lane, int wave) {
    const int l = c.layer, head = u & 3, gr = u >> 2, rows = c.seqlen >> 6, seq = gr / rows, r = gr % rows;
    int rs = r - 4; rs = rs < 0 ? 0 : (rs > rows - 8 ? rows - 8 : rs);
    const bf16_t* PROJ = BIGP(bf16_t, B_PROJ);
    const size_t tq0 = (size_t)seq * c.seqlen + (size_t)r * 64;
    LAS bf16_t* Vt = (LAS bf16_t*)(L + wave * WAREA);
    LAS float* BIAS = (LAS float*)(L + wave * WAREA + 9216);
    const int rr = lane & 31, hh = lane >> 5;
#pragma unroll
    for (int w = 0; w < 4; ++w) { const int idx = w * 64 + lane, kw = idx >> 5, dc = idx & 31;
        if (dc < 31) BIAS[idx] = args->in[3][(((size_t)l * 4 + head) * 15 + (rs + kw - r + 7)) * 31 + dc]; }
    bf16x8 qf[2][4];
#pragma unroll
    for (int nt = 0; nt < 2; ++nt)
#pragma unroll
        for (int ks = 0; ks < 4; ++ks) qf[nt][ks] = *(const bf16x8*)(PROJ + (tq0 + 32 * nt + rr) * NPROJ + C_QA + 64 * head + 16 * ks + 8 * hh);
    f32x16 o[2][2]; o[0][0] = zero16(); o[0][1] = zero16(); o[1][0] = zero16(); o[1][1] = zero16();
    float m[2] = {-1e30f, -1e30f}, ls[2] = {0.f, 0.f};
    for (int w = 0; w < 8; ++w) {
        const size_t tk0 = (size_t)seq * c.seqlen + (size_t)(rs + w) * 64;
        u32x4 vr[8]; bf16x8 kf[2][4];
        load_v(vr, lane, [&](int key) { return PROJ + (tk0 + key) * NPROJ + C_VA + 64 * head; });
#pragma unroll
        for (int mt = 0; mt < 2; ++mt)
#pragma unroll
            for (int ks = 0; ks < 4; ++ks) kf[mt][ks] = *(const bf16x8*)(PROJ + (tk0 + 32 * mt + rr) * NPROJ + C_KA + 64 * head + 16 * ks + 8 * hh);
        __builtin_amdgcn_sched_barrier(0);
        asm volatile("s_waitcnt lgkmcnt(0)" ::: "memory");
        put_vt(Vt, lane, vr);
        f32x16 acc[2][2]; acc[0][0] = zero16(); acc[0][1] = zero16(); acc[1][0] = zero16(); acc[1][1] = zero16();
#pragma unroll
        for (int mt = 0; mt < 2; ++mt)
#pragma unroll
            for (int ks = 0; ks < 4; ++ks) { acc[mt][0] = MFMA32(kf[mt][ks], qf[0][ks], acc[mt][0]); acc[mt][1] = MFMA32(kf[mt][ks], qf[1][ks], acc[mt][1]); }
        asm volatile("s_waitcnt lgkmcnt(0)" ::: "memory");
        const LAS float* brow = BIAS + w * 32;
#pragma unroll
        for (int nt = 0; nt < 2; ++nt) { const int qc = 32 * nt + rr; int ws = qc - 8; ws = ws < 0 ? 0 : (ws > 48 ? 48 : ws);
#pragma unroll
            for (int mt = 0; mt < 2; ++mt) {
                const volatile LAS float* bp = brow + (32 * mt + 4 * hh - qc + 15); float bv[16];
#pragma unroll
                for (int g = 0; g < 16; ++g) { const bool live = (mt == nt) || (nt == 0 ? g < 4 : g >= 12);
                    bv[g] = live ? bp[(g & 3) + 8 * (g >> 2)] : 0.f; }
#pragma unroll
                for (int g = 0; g < 16; ++g) { const bool live = (mt == nt) || (nt == 0 ? g < 4 : g >= 12); const int kc = 32 * mt + crow(g, hh); const bool ok = live && (kc >= ws) && (kc < ws + 16);
                    acc[mt][nt][g] = ok ? acc[mt][nt][g] * 0.125f + bv[g] : -1e30f; } } }
        osm_update(acc, o, m, ls);
        pv_accum(acc, o, Vt, lane);
    }
    asm volatile("s_waitcnt lgkmcnt(0)" ::: "memory");
    const float sc[2] = {frcp(ls[0]), frcp(ls[1])};
    store_o_rows(Vt, o, sc, lane, [&](int q) { return BIGP(bf16_t, B_ONA) + (tq0 + q) * 768 + 64 * head; });
}
struct RopeCS { f32x4 v[2][4]; };
DI void rope_load(RopeCS& t, const float* cs, int hh) {
#pragma unroll
    for (int ks = 0; ks < 2; ++ks) { const float* cp = cs + 16 * ks + 8 * hh; t.v[ks][0] = *(const f32x4*)cp; t.v[ks][1] = *(const f32x4*)(cp + 4); t.v[ks][2] = *(const f32x4*)(cp + 32); t.v[ks][3] = *(const f32x4*)(cp + 36); }
}
DI void rope_frag4(bf16x8 (&f)[4], const RopeCS& t) {
#pragma unroll
    for (int ks = 0; ks < 2; ++ks) {
        const f32x4 c0 = t.v[ks][0], c1 = t.v[ks][1], s0 = t.v[ks][2], s1 = t.v[ks][3];
        const u32x4 a = __builtin_bit_cast(u32x4, f[ks]), b = __builtin_bit_cast(u32x4, f[ks + 2]); u32x4 ra, rb;
#pragma unroll
        for (int j = 0; j < 4; ++j) { const float cl = (j < 2) ? c0[2 * j] : c1[2 * j - 4], ch = (j < 2) ? c0[2 * j + 1] : c1[2 * j - 3];
            const float sl = (j < 2) ? s0[2 * j] : s1[2 * j - 4], sh = (j < 2) ? s0[2 * j + 1] : s1[2 * j - 3];
            const float x1l = bflo(a[j]), x1h = bfhi(a[j]), x2l = bflo(b[j]), x2h = bfhi(b[j]);
            ra[j] = pk2(x1l * cl - x2l * sl, x1h * ch - x2h * sh); rb[j] = pk2(x1l * sl + x2l * cl, x1h * sh + x2h * ch); }
        f[ks] = __builtin_bit_cast(bf16x8, ra); f[ks + 2] = __builtin_bit_cast(bf16x8, rb); }
}
DI void dil_wave_unit(KArgs args, LAS unsigned char* L, const Ctx& c, int u, int lane, int wave) {
    const int hd = u & 1, uu = u >> 1, upg = c.stok >> 6, g = uu / upg, v = uu % upg, ups = c.seqlen >> 6, seq = v / ups, wq = v % ups;
    const int dsh = 2 * g, dd = 1 << dsh, nb = ups >> dsh, cls = wq / nb, jb = wq % nb, head = 2 * g + hd;
    const bf16_t* PROJ = BIGP(bf16_t, B_PROJ); const float* CS = WSP(float, WS_CS);
    const size_t sb = (size_t)seq * c.seqlen;
    const int rr = lane & 31, hh = lane >> 5;
    LAS bf16_t* Vt = (LAS bf16_t*)(L + wave * WAREA);
    bf16x8 qf[2][4];
#pragma unroll
    for (int nt = 0; nt < 2; ++nt) { const int pos = cls + dd * (64 * jb + 32 * nt + rr);
#pragma unroll
        for (int ks = 0; ks < 4; ++ks) qf[nt][ks] = *(const bf16x8*)(PROJ + (sb + pos) * NPROJ + C_QD + 64 * head + 16 * ks + 8 * hh);
        RopeCS tq; rope_load(tq, CS + (size_t)pos * 64, hh); __builtin_amdgcn_sched_barrier(0);
        rope_frag4(qf[nt], tq); }
    f32x16 o[2][2]; o[0][0] = zero16(); o[0][1] = zero16(); o[1][0] = zero16(); o[1][1] = zero16();
    float m[2] = {-1e30f, -1e30f}, ls[2] = {0.f, 0.f};
    for (int kt = 0; kt < 3; ++kt) { const int kj = jb - 1 + kt;
        if (kj < 0 || kj >= nb) continue;
        u32x4 vr[8]; bf16x8 kfa[2][4];
        load_v(vr, lane, [&](int key) { return PROJ + (sb + cls + (size_t)dd * (64 * kj + key)) * NPROJ + C_VD + 64 * head; });
#pragma unroll
        for (int mt = 0; mt < 2; ++mt) { const int pos = cls + dd * (64 * kj + 32 * mt + rr);
#pragma unroll
            for (int ks = 0; ks < 4; ++ks) kfa[mt][ks] = *(const bf16x8*)(PROJ + (sb + pos) * NPROJ + C_KD + 64 * head + 16 * ks + 8 * hh); }
        __builtin_amdgcn_sched_barrier(0);
        asm volatile("s_waitcnt lgkmcnt(0)" ::: "memory");
        put_vt(Vt, lane, vr);
        f32x16 acc[2][2]; acc[0][0] = zero16(); acc[0][1] = zero16(); acc[1][0] = zero16(); acc[1][1] = zero16();
#pragma unroll
        for (int mt = 0; mt < 2; ++mt) {
            RopeCS tk; rope_load(tk, CS + (size_t)(cls + dd * (64 * kj + 32 * mt + rr)) * 64, hh); __builtin_amdgcn_sched_barrier(0);
            rope_frag4(kfa[mt], tk);
#pragma unroll
            for (int ks = 0; ks < 4; ++ks) { acc[mt][0] = MFMA32(kfa[mt][ks], qf[0][ks], acc[mt][0]); acc[mt][1] = MFMA32(kfa[mt][ks], qf[1][ks], acc[mt][1]); } }
#pragma unroll
        for (int nt = 0; nt < 2; ++nt) { const int qc = 32 * nt + rr;
#pragma unroll
            for (int mt = 0; mt < 2; ++mt)
#pragma unroll
                for (int gg = 0; gg < 16; ++gg) { const int kc = 32 * mt + crow(gg, hh); const bool ok = (kt == 1) || (kt == 0 ? (kc >= qc) : (kc <= qc));
                    acc[mt][nt][gg] = ok ? acc[mt][nt][gg] * 0.125f : -1e30f; } }
        osm_update(acc, o, m, ls);
        pv_accum(acc, o, Vt, lane);
    }
    asm volatile("s_waitcnt lgkmcnt(0)" ::: "memory");
    bf16_t* DP = BIGP(bf16_t, B_DILP); float* DM = BIGP(float, B_DILM);
    const float one[2] = {1.f, 1.f};
    store_o_rows(Vt, o, one, lane, [&](int q) { return DP + ((((size_t)g * SLABMAX + sb + cls + (size_t)dd * (64 * jb + q)) * 2 + hd)) * 64; });
    if (hh == 0) {
#pragma unroll
        for (int nt = 0; nt < 2; ++nt) { const size_t base = (((size_t)g * SLABMAX + sb + cls + (size_t)dd * (64 * jb + 32 * nt + rr)) * 2 + hd); DM[base * 2] = m[nt]; DM[base * 2 + 1] = ls[nt]; } }
}

DI void phase_mix_a(KArgs args, LAS unsigned char* L, const Ctx& c) {
    const int N_PREP = (c.stok >> 6) * 6;
    PrepIn in; if (c.bid < N_PREP) { gdn_prep_loads(args, c, c.bid, in); gdn_prep_put_cw(L, c, in); lds_barrier(); }
    for (int u = c.bid; u < N_PREP; u += c.G) gdn_prep_pair(args, L, c, u, in, u + c.G < N_PREP ? u + c.G : -1);
}
DI void attn_wave_units(KArgs args, LAS unsigned char* L, const Ctx& c) {
    int tid = c.tid; asm volatile("" : "+v"(tid)); const int lane = tid & 63, wave = __builtin_amdgcn_readfirstlane(tid >> 6);
    const int nch_ = c.stok >> 6, N_NA = nch_ * 4, N_DIL = nch_ * 6;
    unsigned* q = (unsigned*)(c.ws + WS_CTL) + 32768 + 128 * (c.layer * 4 + c.slab);
    for (;;) { unsigned u = 0; if (lane == 0) u = __hip_atomic_fetch_add(q, 1u, __ATOMIC_RELAXED, __HIP_MEMORY_SCOPE_AGENT);
        u = (unsigned)__builtin_amdgcn_readfirstlane((int)u); if (u >= (unsigned)N_NA) break; na_wave_unit(args, L, c, (int)u, lane, wave); }
    int tid2 = c.tid; asm volatile("" : "+v"(tid2)); const int lane2 = tid2 & 63, wave2 = __builtin_amdgcn_readfirstlane(tid2 >> 6);
    for (;;) { unsigned u = 0; if (lane2 == 0) u = __hip_atomic_fetch_add(q + 64, 1u, __ATOMIC_RELAXED, __HIP_MEMORY_SCOPE_AGENT);
        u = (unsigned)__builtin_amdgcn_readfirstlane((int)u); if (u >= (unsigned)N_DIL) break; dil_wave_unit(args, L, c, (int)u, lane2, wave2); }
}

DI void phase_select(KArgs args, LAS unsigned char* L, const Ctx& c, int inst);
DI void phase_scan(KArgs args, LAS unsigned char* L, const Ctx& c) {
    if (c.slab == NSLAB - 1 && c.bid >= 24 && c.bid < 40) { phase_select(args, L, c, c.bid - 24); return; }
    const int nwu = c.nseq * 24, wu = c.bid;
    if (wu < nwu && c.wave == 0) {
        const int lane = c.lane;
        const int chain = wu >> 1, nt = wu & 1, seq = chain / 12, rem = chain % 12, head = rem >> 1, dir = rem & 1;
        const int nch = c.seqlen >> 6, gch0 = seq * nch;
        unsigned char* GS = BIGP(unsigned char, B_GSCR);
        f32x16 S[2]; S[0] = zero16(); S[1] = zero16();
        bf16x8 A[2][2][4]; u32x4 cm[2][2][2];
        const long gstep = (long)(dir ? -1 : 1) * 12 * GSTRIDE;
        const unsigned char* G0 = GS + (size_t)(((gch0 + (dir ? nch - 1 : 0)) * 6 + head) * 2 + dir) * GSTRIDE;
        unsigned char* Gs = (unsigned char*)G0;
        float glv[4];
#pragma unroll
        for (int q = 0; q < 4; ++q) { const int sq = q * 64 + lane; glv[q] = *(const float*)(G0 + (long)(sq < nch ? sq : nch - 1) * gstep + 40960); }
        LAS unsigned char* RING = L + 81920;
        int dslot = 0, rslot = 0, dstage = 0;
#define SCAN_DMA() do { const unsigned char* gp = G0 + (long)(dstage < nch ? dstage : nch - 1) * gstep; LAS unsigned char* sl = RING + dslot * 12288; \
            _Pragma("unroll") for (int j = 0; j < 8; ++j) __builtin_amdgcn_global_load_lds((const unsigned*)(gp + (size_t)(j * 64 + lane) * 16), (LAS unsigned*)(sl + j * 1024), 16, 0, 0); \
            _Pragma("unroll") for (int j = 0; j < 4; ++j) __builtin_amdgcn_global_load_lds((const unsigned*)(gp + 8192 + (size_t)((nt * 2 + (j >> 1)) * 64 + lane) * 32 + (j & 1) * 16), (LAS unsigned*)(sl + 8192 + j * 1024), 16, 0, 0); \
            ++dstage; dslot = dslot == 4 ? 0 : dslot + 1; } while (0)
#define SCAN_LOAD(B) do { const LAS unsigned char* sl = RING + rslot * 12288 + lane * 16; \
            _Pragma("unroll") for (int mt = 0; mt < 2; ++mt) { _Pragma("unroll") for (int ks = 0; ks < 4; ++ks) A[B][mt][ks] = *(const LAS bf16x8*)(sl + (mt * 4 + ks) * 1024); \
                cm[B][mt][0] = *(const LAS u32x4*)(sl + 8192 + (mt * 2) * 1024); cm[B][mt][1] = *(const LAS u32x4*)(sl + 8192 + (mt * 2 + 1) * 1024); } \
            rslot = rslot == 4 ? 0 : rslot + 1; } while (0)
#define SCAN_STEP(B, st) do { const bf16x8 b0 = pack8<0>(S[0]), b1 = pack8<1>(S[0]), b2 = pack8<0>(S[1]), b3 = pack8<1>(S[1]); f32x16 nw[2]; \
            { bf16x8* St = (bf16x8*)(Gs + 32768) + (nt * 4) * 64 + lane; St[0] = b0; St[64] = b1; St[128] = b2; St[192] = b3; }     \
            const int sq_ = (st) >> 6; const float gsel = sq_ == 0 ? glv[0] : (sq_ == 1 ? glv[1] : (sq_ == 2 ? glv[2] : glv[3])); \
            const float glc = __builtin_bit_cast(float, __builtin_amdgcn_readlane(__builtin_bit_cast(int, gsel), (st) & 63)); \
            _Pragma("unroll") for (int mt = 0; mt < 2; ++mt) { \
                _Pragma("unroll") for (int g = 0; g < 8; ++g) { const unsigned wv = (g < 4) ? cm[B][mt][0][g] : cm[B][mt][1][g - 4]; nw[mt][2 * g] = glc * S[mt][2 * g] + bflo(wv); nw[mt][2 * g + 1] = glc * S[mt][2 * g + 1] + bfhi(wv); } \
                nw[mt] = MFMA32(A[B][mt][0], b0, nw[mt]); nw[mt] = MFMA32(A[B][mt][1], b1, nw[mt]); nw[mt] = MFMA32(A[B][mt][2], b2, nw[mt]); nw[mt] = MFMA32(A[B][mt][3], b3, nw[mt]); } \
            S[0] = nw[0]; S[1] = nw[1]; Gs += gstep; } while (0)
        SCAN_DMA(); SCAN_DMA(); SCAN_DMA(); SCAN_DMA(); SCAN_DMA();
        asm volatile("s_waitcnt vmcnt(48)" ::: "memory"); SCAN_LOAD(0);
        asm volatile("s_waitcnt vmcnt(36)" ::: "memory"); SCAN_LOAD(1);
        for (int step = 0; step < nch; step += 2) {
            SCAN_STEP(0, step);     asm volatile("s_waitcnt vmcnt(24)" ::: "memory"); SCAN_LOAD(0); SCAN_DMA();
            SCAN_STEP(1, step + 1); asm volatile("s_waitcnt vmcnt(24)" ::: "memory"); SCAN_LOAD(1); SCAN_DMA();
        }
        asm volatile("s_waitcnt vmcnt(0)" ::: "memory");
#undef SCAN_DMA
#undef SCAN_LOAD
#undef SCAN_STEP
    }
    attn_wave_units(args, L, c);
}

DI void dil_merge(const Ctx& c) {
    { const bf16_t* DP = BIGP(bf16_t, B_DILP); const float* DM = BIGP(float, B_DILM); bf16_t* OD = BIGP(bf16_t, B_ONA) + 256;
        for (int it = c.bid * 512 + c.tid; it < c.stok * 32; it += c.G * 512) { const int tok = it >> 5, part = it & 31;
            u32x4 w = {0u, 0u, 0u, 0u};
            if (part < 16) { const int hd = part >> 3, p = part & 7; float m[3], dn[3];
#pragma unroll
                for (int g = 0; g < 3; ++g) { const size_t b = (((size_t)g * SLABMAX + tok) * 2 + hd); m[g] = DM[b * 2]; dn[g] = DM[b * 2 + 1]; }
                const float M = fmaxf(m[0], fmaxf(m[1], m[2])); float num[8], den = 0.f;
#pragma unroll
                for (int j = 0; j < 8; ++j) num[j] = 0.f;
#pragma unroll
                for (int g = 0; g < 3; ++g) { const float f = __expf(m[g] - M); den += f * dn[g]; const u32x4 a = *(const u32x4*)(DP + (((size_t)g * SLABMAX + tok) * 2 + hd) * 64 + 8 * p);
                    num[0] += f * bflo(a[0]); num[1] += f * bfhi(a[0]); num[2] += f * bflo(a[1]); num[3] += f * bfhi(a[1]); num[4] += f * bflo(a[2]); num[5] += f * bfhi(a[2]); num[6] += f * bflo(a[3]); num[7] += f * bfhi(a[3]); }
                const float inv = frcp(den);
                w.x = pk2(num[0] * inv, num[1] * inv); w.y = pk2(num[2] * inv, num[3] * inv); w.z = pk2(num[4] * inv, num[5] * inv); w.w = pk2(num[6] * inv, num[7] * inv); }
            if (part < 16) *(u32x4*)(OD + (size_t)tok * 768 + 8 * part) = w; } }
}

DI void phase_gdn_out(KArgs args, LAS unsigned char* L, const Ctx& c) {
    dil_merge(c);
    const int lane = c.lane, wave = c.wave, tid = c.tid, l = c.layer;
    const bf16_t* PROJ = BIGP(bf16_t, B_PROJ); unsigned char* GS = BIGP(unsigned char, B_GSCR); bf16_t* OG = BIGP(bf16_t, B_ONA) + 384;
    LAS float* OF = (LAS float*)L;
    const int NU = (c.stok >> 6) * 6; const int dir = wave >> 2, mt = (wave >> 1) & 1, nt = wave & 1, rr = lane & 31, hh = lane >> 5;
    const float* nw = args->in[7] + l * 64 + 8 * (tid & 7); const f32x4 nw0 = *(const f32x4*)nw, nw1 = *(const f32x4*)(nw + 4);
    bf16x8 qa[4], sb_[4]; u32x4 oc0, oc1, zw;
#define GOUT_LOAD(uu) do { const int gch_ = (uu) / 6, head_ = (uu) % 6; const unsigned char* G = GS + (size_t)((gch_ * 6 + head_) * 2 + dir) * GSTRIDE; \
        const bf16_t* Qe = (const bf16_t*)(G + 16384); const u32x4* Oct = (const u32x4*)(G + 24576); const bf16x8* St = (const bf16x8*)(G + 32768); \
        _Pragma("unroll") for (int ks = 0; ks < 4; ++ks) { qa[ks] = *(const bf16x8*)(Qe + (size_t)((mt * 4 + ks) * 64 + lane) * 8); sb_[ks] = St[(nt * 4 + ks) * 64 + lane]; } \
        oc0 = Oct[((nt * 2 + mt) * 2) * 64 + lane]; oc1 = Oct[((nt * 2 + mt) * 2 + 1) * 64 + lane]; \
        zw = *(const u32x4*)(PROJ + ((size_t)gch_ * 64 + (tid >> 3)) * NPROJ + C_ZC + 64 * head_ + 8 * (tid & 7)); } while (0)
    if (c.bid < NU) GOUT_LOAD(c.bid);
    for (int u = c.bid; u < NU; u += c.G) { const int gch = u / 6, head = u % 6;
        bf16x8 qc[4], sc[4]; const u32x4 o0 = oc0, o1 = oc1, zc = zw;
#pragma unroll
        for (int ks = 0; ks < 4; ++ks) { qc[ks] = qa[ks]; sc[ks] = sb_[ks]; }
        { int un = u + c.G; un = un < NU ? un : u; GOUT_LOAD(un); }
        __builtin_amdgcn_sched_barrier(0);
        {   f32x16 acc = zero16();
#pragma unroll
            for (int ks = 0; ks < 4; ++ks) acc = MFMA32(qc[ks], sc[ks], acc);
            const int e = 32 * nt + rr;
#pragma unroll
            for (int g = 0; g < 4; ++g) { u32x2 w; w.x = (g == 0) ? o0.x : (g == 1) ? o0.z : (g == 2) ? o1.x : o1.z; w.y = (g == 0) ? o0.y : (g == 1) ? o0.w : (g == 2) ? o1.y : o1.w;
                const float v0 = acc[4 * g] + bflo(w.x), v1 = acc[4 * g + 1] + bfhi(w.x), v2 = acc[4 * g + 2] + bflo(w.y), v3 = acc[4 * g + 3] + bfhi(w.y);
                const int i0 = 32 * mt + 8 * g + 4 * hh;
#pragma unroll
                for (int j = 0; j < 4; ++j) { const int ii = i0 + j, tl = dir ? 63 - ii : ii; OF[(dir * 64 + tl) * 68 + e] = (j == 0) ? v0 : (j == 1) ? v1 : (j == 2) ? v2 : v3; } } }
        lds_barrier();
        { const int i = tid >> 3, p = tid & 7; const size_t tok = (size_t)gch * 64 + i;
            const LAS float* a = OF + i * 68 + 8 * p; const LAS float* b = OF + (64 + i) * 68 + 8 * p;
            float ov[8]; float ss = 0.f;
#pragma unroll
            for (int j = 0; j < 8; ++j) { ov[j] = a[j] + b[j]; ss += ov[j] * ov[j]; }
            ss += __shfl_xor(ss, 1); ss += __shfl_xor(ss, 2); ss += __shfl_xor(ss, 4);
            const float rs = frsq(ss * (1.0f / 64.0f) + NORM_EPS);
            float r[8];
#pragma unroll
            for (int j = 0; j < 4; ++j) { const float n0 = j < 2 ? nw0[2 * j] : nw1[2 * j - 4], n1 = j < 2 ? nw0[2 * j + 1] : nw1[2 * j - 3];
                r[2 * j] = ov[2 * j] * rs * n0 * siluf_(bflo(zc[j])); r[2 * j + 1] = ov[2 * j + 1] * rs * n1 * siluf_(bfhi(zc[j])); }
            u32x4 w; w.x = pk2(r[0], r[1]); w.y = pk2(r[2], r[3]); w.z = pk2(r[4], r[5]); w.w = pk2(r[6], r[7]);
            *(u32x4*)(OG + tok * 768 + 64 * head + 8 * p) = w; }
        lds_barrier();
    }
#undef GOUT_LOAD
}

DI void phase_ln1(KArgs args, LAS unsigned char* L, const Ctx& c) {
    const int lane = c.lane, l = c.layer;
    LAS float* WR = (LAS float*)L;
    { const float* wr = args->in[14] + (size_t)l * D * 16;
        for (int i = c.tid; i < D * 16; i += 512) { const int col = i >> 4, e = i & 15, j = col >> 8, ln = (col >> 2) & 63, q = col & 3; WR[((j * 4 + q) * 64 + ln) * 20 + e] = wr[i]; } }
    __syncthreads();
    const float* g1 = args->in[12] + l * D; const float* b1 = args->in[13] + l * D;
    f32x4 gv[4], bv[4];
#pragma unroll
    for (int j = 0; j < 4; ++j) { gv[j] = *(const f32x4*)(g1 + 4 * lane + 256 * j); bv[j] = *(const f32x4*)(b1 + 4 * lane + 256 * j); }
    float* AFF = WSP(float, WS_AFF); int* SLOT = WSP(int, WS_SLOT); bf16_t* XB = WSP(bf16_t, WS_XB);
    u32x2 nv[4];
    { const int rl0 = c.bid * 8 + c.wave; if (rl0 < c.stok) { const bf16_t* hp = (const bf16_t*)c.out + ((size_t)c.sbase + rl0) * D;
#pragma unroll
        for (int j = 0; j < 4; ++j) nv[j] = *(const u32x2*)(hp + 4 * lane + 256 * j); } }
    for (int rl = c.bid * 8 + c.wave; rl < c.stok; rl += c.G * 8) { const size_t tok = (size_t)c.sbase + rl;
        const bf16_t* hr = (const bf16_t*)c.out + tok * D; f32x4 v[4]; float s = 0.f;
#pragma unroll
        for (int j = 0; j < 4; ++j) { v[j][0] = bflo(nv[j].x); v[j][1] = bfhi(nv[j].x); v[j][2] = bflo(nv[j].y); v[j][3] = bfhi(nv[j].y); s += (v[j][0] + v[j][1]) + (v[j][2] + v[j][3]); }
        if (rl + c.G * 8 < c.stok) { const bf16_t* hp = hr + (size_t)c.G * 8 * D;
#pragma unroll
            for (int j = 0; j < 4; ++j) nv[j] = *(const u32x2*)(hp + 4 * lane + 256 * j); }
        const float mean = wave_sum(s) * (1.0f / D); float s2 = 0.f;
#pragma unroll
        for (int j = 0; j < 4; ++j) { v[j] = v[j] - mean; s2 += (v[j][0] * v[j][0] + v[j][1] * v[j][1]) + (v[j][2] * v[j][2] + v[j][3] * v[j][3]); }
        const float rstd = frsq(wave_sum(s2) * (1.0f / D) + LN_EPS);
        float lg[16];
#pragma unroll
        for (int e = 0; e < 16; ++e) lg[e] = 0.f;
#pragma unroll
        for (int j = 0; j < 4; ++j) { v[j] = v[j] * rstd * gv[j] + bv[j];
            if (!c.dry) { u32x2 w; w.x = pk2(v[j][0], v[j][1]); w.y = pk2(v[j][2], v[j][3]); *(u32x2*)(XB + tok * D + 4 * lane + 256 * j) = w; }
#pragma unroll
            for (int q = 0; q < 4; ++q) { const LAS float* wp = WR + ((j * 4 + q) * 64 + lane) * 20; const float xv = v[j][q];
#pragma unroll
                for (int e4 = 0; e4 < 4; ++e4) { const f32x4 w4 = *(const LAS f32x4*)(wp + 4 * e4); lg[4 * e4] += xv * w4[0]; lg[4 * e4 + 1] += xv * w4[1]; lg[4 * e4 + 2] += xv * w4[2]; lg[4 * e4 + 3] += xv * w4[3]; } }
            asm volatile("" ::: "memory"); }
        const bool h5 = (lane & 32) != 0, h4 = (lane & 16) != 0, h3 = (lane & 8) != 0, h2 = (lane & 4) != 0;
        const int eid = (h5 ? 8 : 0) + (h4 ? 4 : 0) + (h3 ? 2 : 0) + (h2 ? 1 : 0);
        float a8[8], b4[4], c2[2], d;
#pragma unroll
        for (int k = 0; k < 8; ++k) { const float snd = h5 ? lg[k] : lg[k + 8]; a8[k] = (h5 ? lg[k + 8] : lg[k]) + __shfl_xor(snd, 32); }
#pragma unroll
        for (int k = 0; k < 4; ++k) { const float snd = h4 ? a8[k] : a8[k + 4]; b4[k] = (h4 ? a8[k + 4] : a8[k]) + __shfl_xor(snd, 16); }
#pragma unroll
        for (int k = 0; k < 2; ++k) { const float snd = h3 ? b4[k] : b4[k + 2]; c2[k] = (h3 ? b4[k + 2] : b4[k]) + __shfl_xor(snd, 8); }
        { const float snd = h2 ? c2[0] : c2[1]; d = (h2 ? c2[1] : c2[0]) + __shfl_xor(snd, 4); }
        d += __shfl_xor(d, 2); d += __shfl_xor(d, 1);
        float mx = d;
        mx = fmaxf(mx, __shfl_xor(mx, 32)); mx = fmaxf(mx, __shfl_xor(mx, 16)); mx = fmaxf(mx, __shfl_xor(mx, 8)); mx = fmaxf(mx, __shfl_xor(mx, 4));
        const float pe = expf(d - mx); float den = pe;
        den += __shfl_xor(den, 32); den += __shfl_xor(den, 16); den += __shfl_xor(den, 8); den += __shfl_xor(den, 4);
        if ((lane & 3) == 0 && !c.dry) { AFF[(size_t)eid * T_ALL + tok] = pe / den; SLOT[tok * 16 + eid] = -1; }
    }
}
DI void phase_ln2(KArgs args, LAS unsigned char* L, const Ctx& c) {
    const int lane = c.lane, l = c.layer;
    const float* g2 = args->in[18] + l * D; const float* b2 = args->in[19] + l * D;
    f32x4 gv[4], bv[4];
#pragma unroll
    for (int j = 0; j < 4; ++j) { gv[j] = *(const f32x4*)(g2 + 4 * lane + 256 * j); bv[j] = *(const f32x4*)(b2 + 4 * lane + 256 * j); }
    const int* SLOT = WSP(int, WS_SLOT); bf16_t* XB = WSP(bf16_t, WS_XB);
    u32x2 nv[4]; int nsv = -1;
    { const int t0 = c.bid * 8 + c.wave; if (t0 < T_ALL) { const bf16_t* xp = XB + (size_t)t0 * D; nsv = SLOT[(size_t)t0 * 16 + (lane & 15)];
#pragma unroll
        for (int j = 0; j < 4; ++j) nv[j] = *(const u32x2*)(xp + 4 * lane + 256 * j); } }
    for (int t = c.bid * 8 + c.wave; t < T_ALL; t += c.G * 8) { const size_t tok = (size_t)t;
        float* xr = c.out + tok * D; f32x4 v[4];
#pragma unroll
        for (int j = 0; j < 4; ++j) { v[j][0] = bflo(nv[j].x) * ALPHA; v[j][1] = bfhi(nv[j].x) * ALPHA; v[j][2] = bflo(nv[j].y) * ALPHA; v[j][3] = bfhi(nv[j].y) * ALPHA; }
        const int sv = nsv;
        if (t + c.G * 8 < T_ALL) { const bf16_t* xp = XB + (tok + c.G * 8) * D; nsv = SLOT[(tok + c.G * 8) * 16 + (lane & 15)];
#pragma unroll
            for (int j = 0; j < 4; ++j) nv[j] = *(const u32x2*)(xp + 4 * lane + 256 * j); }
        {
            unsigned mk = (unsigned)(__ballot(sv >= 0) & 0xffffull);
            while (mk) { const int e0 = __builtin_ctz(mk); mk &= mk - 1u; const bool two = mk != 0u; const int e1 = two ? __builtin_ctz(mk) : e0; if (two) mk &= mk - 1u;
                const int s0 = __builtin_amdgcn_readlane(sv, e0), s1 = __builtin_amdgcn_readlane(sv, e1);
                const bf16_t* y0 = BIGP(bf16_t, (e0 < 8 ? B_XY0 : B_XY1)) + ((size_t)(e0 & 7) * CAP + s0) * D + 4 * lane;
                const bf16_t* y1 = BIGP(bf16_t, (e1 < 8 ? B_XY0 : B_XY1)) + ((size_t)(e1 & 7) * CAP + s1) * D + 4 * lane;
                u32x2 w0[4], w1[4];
#pragma unroll
                for (int j = 0; j < 4; ++j) { w0[j] = *(const u32x2*)(y0 + 256 * j); w1[j] = *(const u32x2*)(y1 + 256 * j); }
                __builtin_amdgcn_sched_barrier(0);
                const float f1 = two ? 1.0f : 0.0f;
#pragma unroll
                for (int j = 0; j < 4; ++j) { v[j][0] += bflo(w0[j].x); v[j][1] += bfhi(w0[j].x); v[j][2] += bflo(w0[j].y); v[j][3] += bfhi(w0[j].y);
                    v[j][0] += f1 * bflo(w1[j].x); v[j][1] += f1 * bfhi(w1[j].x); v[j][2] += f1 * bflo(w1[j].y); v[j][3] += f1 * bfhi(w1[j].y); } } }
        float s = 0.f;
#pragma unroll
        for (int j = 0; j < 4; ++j) s += (v[j][0] + v[j][1]) + (v[j][2] + v[j][3]);
        const float mean = wave_sum(s) * (1.0f / D); float s2 = 0.f;
#pragma unroll
        for (int j = 0; j < 4; ++j) { v[j] = v[j] - mean; s2 += (v[j][0] * v[j][0] + v[j][1] * v[j][1]) + (v[j][2] * v[j][2] + v[j][3] * v[j][3]); }
        const float rstd = frsq(wave_sum(s2) * (1.0f / D) + LN_EPS);
#pragma unroll
        for (int j = 0; j < 4; ++j) { v[j] = v[j] * rstd * gv[j] + bv[j];
            if (!c.dry) {
                if (l == 1) *(f32x4*)(xr + 4 * lane + 256 * j) = v[j];
                else { u32x2 w; w.x = pk2(v[j][0], v[j][1]); w.y = pk2(v[j][2], v[j][3]); *(u32x2*)(XB + tok * D + 4 * lane + 256 * j) = w;
                    *(unsigned*)(WSP(unsigned char, WS_XB8) + tok * D + 4 * lane + 256 * j) = pk4_fp8(v[j][0], v[j][1], v[j][2], v[j][3]); } } }
    }
}

DI int block_excl_scan(int v, LAS int* tmp, int tid, int& total) {
    const int lane = tid & 63, wave = tid >> 6; int x = v;
#pragma unroll
    for (int o = 1; o < 64; o <<= 1) { const int y = __shfl_up(x, o); if (lane >= o) x += y; }
    __syncthreads();
    if (lane == 63) tmp[wave] = x;
    __syncthreads();
    int base = 0, tot = 0;
#pragma unroll
    for (int w = 0; w < 8; ++w) { const int tw = tmp[w]; if (w < wave) base += tw; tot += tw; }
    total = tot;
    return base + x - v;
}
DI void phase_select(KArgs args, LAS unsigned char* L, const Ctx& c, int inst) {
    if (inst < 0 || inst >= 32) return;
    const int tid = c.tid, grp = inst >> 4, e = inst & 15;
    const int n = grp ? T_S : T_P, t0 = grp ? T_P : 0, C = n >> 3, slot0 = grp ? CAP_P : 0;
    const unsigned* v = (const unsigned*)(WSP(float, WS_AFF) + (size_t)e * T_ALL + t0);
    LAS unsigned* hist = (LAS unsigned*)L; LAS int* sh = (LAS int*)(L + 8192); LAS int* tmp = (LAS int*)(L + 8192 + 64);
    unsigned prefix = 0u; int kk = C, nbin = 0;
    for (int pass = 0; pass < 3; ++pass) {
        const int shift = pass == 0 ? 21 : (pass == 1 ? 10 : 0); const unsigned bmask = pass == 2 ? 1023u : 2047u;
        const unsigned mhi = pass == 0 ? 0u : (pass == 1 ? 0xFFE00000u : 0xFFFFFC00u);
        { unsigned zz; asm volatile("v_mov_b32 %0, 0" : "=v"(zz)); u32x4 z4; z4.x = zz; z4.y = zz; z4.z = zz; z4.w = zz; *(LAS u32x4*)(hist + 4 * tid) = z4; }
        __syncthreads();
        for (int i = tid * 4; i < n; i += 512 * 16) {
            u32x4 x4[4];
#pragma unroll
            for (int k = 0; k < 4; ++k) x4[k] = *(const u32x4*)(v + i + k * 2048);
#pragma unroll
            for (int k = 0; k < 4; ++k)
#pragma unroll
                for (int j = 0; j < 4; ++j) { const unsigned x = x4[k][j]; if ((x & mhi) == prefix) __hip_atomic_fetch_add(&hist[(x >> shift) & bmask], 1u, __ATOMIC_RELAXED, __HIP_MEMORY_SCOPE_WORKGROUP); } }
        __syncthreads();
        {
            const u32x4 hv = *(const LAS u32x4*)(hist + 2044 - 4 * tid); int tot;
            int cum = block_excl_scan((int)(hv[0] + hv[1] + hv[2] + hv[3]), tmp, tid, tot);
            const int c1 = cum + (int)hv.w, c2 = c1 + (int)hv.z, c3 = c2 + (int)hv.y, c4 = c3 + (int)hv.x;
            if (cum < kk && kk <= c4) { const int j = kk <= c1 ? 0 : (kk <= c2 ? 1 : (kk <= c3 ? 2 : 3)); const int cb = kk <= c1 ? cum : (kk <= c2 ? c1 : (kk <= c3 ? c2 : c3));
                sh[0] = 2047 - 4 * tid - j; sh[1] = kk - cb; sh[2] = (j == 0 ? c1 : (j == 1 ? c2 : (j == 2 ? c3 : c4))) - cb; } }
        __syncthreads();
        prefix |= ((unsigned)sh[0]) << shift; kk = sh[1]; nbin = sh[2];
        __syncthreads();
    }
    const unsigned thr = prefix;
    int* IDX = WSP(int, WS_IDX) + e * CAP + slot0;
    LAS int* ctr = sh + 8;
    if (tid == 0) ctr[0] = 0;
    __syncthreads();
    const bool ordered = kk < nbin; int tie_run = 0;
    const int lane = tid & 63; const unsigned long long ltm = (1ull << lane) - 1ull;
    for (int it = 0; it < (n >> 11); it += 4) {
        u32x4 x4[4];
#pragma unroll
        for (int k = 0; k < 4; ++k) x4[k] = *(const u32x4*)(v + (it + k) * 2048 + 4 * tid);
#pragma unroll
        for (int k = 0; k < 4; ++k) { const u32x4 x = x4[k];
            int tie_base = 0;
            if (ordered) { const int tiec = (x[0] == thr) + (x[1] == thr) + (x[2] == thr) + (x[3] == thr); int tot; tie_base = tie_run + block_excl_scan(tiec, tmp, tid, tot); tie_run += tot; }
            bool sj[4]; int off[4], tot4 = 0;
#pragma unroll
            for (int j = 0; j < 4; ++j) { bool s_ = x[j] > thr; if (x[j] == thr) { s_ = !ordered || tie_base < kk; ++tie_base; } sj[j] = s_;
                const unsigned long long m = __ballot(s_); off[j] = tot4 + __popcll(m & ltm); tot4 += __popcll(m); }
            int base = 0; if (lane == 0 && tot4 > 0) base = __hip_atomic_fetch_add(ctr, tot4, __ATOMIC_RELAXED, __HIP_MEMORY_SCOPE_WORKGROUP);
            base = __builtin_amdgcn_readfirstlane(base);
#pragma unroll
            for (int j = 0; j < 4; ++j) if (sj[j]) IDX[base + off[j]] = t0 + (it + k) * 2048 + 4 * tid + j; } }
}
DI void phase_gather(KArgs args, LAS unsigned char* L, const Ctx& c) {
    const int lane = c.lane; const int* IDX = WSP(int, WS_IDX); const bf16_t* XB = WSP(bf16_t, WS_XB);
    float* GATEV = WSP(float, WS_GATEV); int* SLOT = WSP(int, WS_SLOT); const float* AFF = WSP(float, WS_AFF);
    for (int row0 = (c.bid * 8 + c.wave) * 4; row0 < NE * CAP; row0 += c.G * 8 * 4) {
        const int e = row0 / CAP, s0 = row0 % CAP; int t[4]; u32x4 a[4], b[4];
#pragma unroll
        for (int k = 0; k < 4; ++k) t[k] = IDX[row0 + k];
#pragma unroll
        for (int k = 0; k < 4; ++k) { const u32x4* src = (const u32x4*)(XB + (size_t)t[k] * D) + 2 * lane; a[k] = src[0]; b[k] = src[1]; }
        u32x4* dst = (u32x4*)(BIGP(unsigned char, (e < 8 ? B_XY0 : B_XY1)) + ((size_t)(e & 7) * CAP + s0) * D);
#pragma unroll
        for (int k = 0; k < 4; ++k) { u32x4 w;
            w.x = pk4_fp8(bflo(a[k].x), bfhi(a[k].x), bflo(a[k].y), bfhi(a[k].y)); w.y = pk4_fp8(bflo(a[k].z), bfhi(a[k].z), bflo(a[k].w), bfhi(a[k].w));
            w.z = pk4_fp8(bflo(b[k].x), bfhi(b[k].x), bflo(b[k].y), bfhi(b[k].y)); w.w = pk4_fp8(bflo(b[k].z), bfhi(b[k].z), bflo(b[k].w), bfhi(b[k].w));
            dst[k * 64 + lane] = w; }
        if (lane < 4) { const int tt = (lane == 0) ? t[0] : (lane == 1) ? t[1] : (lane == 2) ? t[2] : t[3]; SLOT[(size_t)tt * 16 + e] = s0 + lane; GATEV[row0 + lane] = AFF[(size_t)e * T_ALL + tt]; } }
}

__global__ void __launch_bounds__(512, 2) fwd_kernel(Args args) {
    extern __shared__ __attribute__((aligned(16))) unsigned char lds_raw[];
    LAS unsigned char* L = (LAS unsigned char*)lds_raw;
    Ctx c;
    c.out = args.out; c.ws = args.ws;
    c.tid = threadIdx.x; c.lane = c.tid & 63; c.wave = __builtin_amdgcn_readfirstlane(c.tid >> 6); c.G = gridDim.x; c.bid = blockIdx.x;
    c.layer = 0; c.slab = 0; c.nseq = 8; c.seqlen = 4096; c.stok = 32768; c.sbase = 0; c.dry = 0;
    const int lo = args.ph_lo, hi = args.ph_hi;
    volatile LAS unsigned* MISC = (volatile LAS unsigned*)(L + LDS_MISC);
    if (c.tid < 4) MISC[c.tid] = 0u;
    __syncthreads();
    XcdBarrier bar; bar.bar = (unsigned*)(c.ws + WS_CTL) + 1024; bar.x = 0; bar.st = MISC;
    if (hi - lo > 1) bar = xcd_barrier_post((unsigned*)(c.ws + WS_CTL) + 1024, MISC);
    int pc = 0;
#ifndef PHMASK
#define PHMASK 0xFFFF
#endif
#define PHON(k) (((PHMASK) >> (k)) & 1)
#ifndef REPMASK
#define REPMASK 0x0
#endif
#define PH_BEGIN(k) if (PHON(k) && pc >= lo && pc < hi) { { int tz = threadIdx.x; asm volatile("" : "+v"(tz)); c.tid = tz; c.lane = tz & 63; c.wave = __builtin_amdgcn_readfirstlane(tz >> 6); } KArgs ka = kargs(); c.ws = ka->ws; c.out = ka->out; { int b_ = blockIdx.x, g_ = gridDim.x; asm volatile("" : "+s"(b_), "+s"(g_)); c.bid = b_; c.G = g_; } for (int rep_ = 0; rep_ < (((REPMASK) >> (k)) & 1) + 1; ++rep_) { if (rep_) __syncthreads(); c.dry = (rep_ + 1 < (((REPMASK) >> (k)) & 1) + 1);
#ifndef BARREP
#define BARREP 0
#endif
#define PH_END   } if (pc + 1 < hi) { xcd_barrier(bar); if (BARREP) { xcd_barrier(bar); xcd_barrier(bar); } } else { asm volatile("s_waitcnt vmcnt(0)" ::: "memory"); __syncthreads(); } } ++pc;

    for (int layer = 0; layer < 2; ++layer) {
        c.layer = layer;
        PH_BEGIN(0) phase_weights(ka, L, c); PH_END
        for (int slab = 0; slab < NSLAB; ++slab) {
            c.slab = slab; c.nseq = slab < 2 ? 8 : 1; c.seqlen = slab < 2 ? 4096 : 16384; c.stok = slab < 2 ? 32768 : 16384; c.sbase = slab * 32768; const int stok = c.stok; const size_t sbase = (size_t)c.sbase;
            PH_BEGIN(1) {
                const int swp = (c.bid >> 2) & 1;
                for (int k2 = 0; k2 < 2; ++k2) {
                  if ((k2 ^ swp) == 0) { pg8::Gemm g{WSP(bf16_t, WS_XB) + sbase * D, WSP(bf16_t, WS_WIN) + (size_t)1792 * D, stok, 1792, D}; pg8::StaticOrder S; S.init(stok, 1792, c.G, c.bid);
                    pg8::EpiInProj E{BIGP(bf16_t, B_PROJ), BIGP(float, B_BA), 1792, 6};
                    pg8::gemm_phase<pg8::EpiInProj, pg8::StaticOrder>(L, g, S, E); }
                  else { pg8::Gemm g{(const bf16_t*)(WSP(unsigned char, WS_XB8) + sbase * D), (const bf16_t*)WSP(unsigned char, WS_WG8), stok, 4864, D / 2}; pg8::StaticOrder S; S.init(stok, 4864, c.G, c.bid);
                    pg8::EpiGates E{BIGP(unsigned char, B_GATES), BIGP(bf16_t, B_PROJ)};
                    pg8::gemm_phase<pg8::EpiGates, pg8::StaticOrder>(L, g, S, E); } } } PH_END
            PH_BEGIN(2) phase_mix_a(ka, L, c); PH_END
            PH_BEGIN(3) phase_scan(ka, L, c); PH_END
            PH_BEGIN(4) phase_gdn_out(ka, L, c); PH_END
            PH_BEGIN(5) {
                pg8::StaticOrder S; S.init(stok, D, c.G, c.bid);
                pg8::Gemm g{BIGP(bf16_t, B_ONA), WSP(bf16_t, WS_WBR), stok, D, 768}; pg8::EpiGateCat E{BIGP(u32x2, B_GATES), BIGP(bf16_t, B_MERGED)};
                pg8::gemm_phase<pg8::EpiGateCat, pg8::StaticOrder>(L, g, S, E); } PH_END
            PH_BEGIN(6) {
                pg8::Gemm g{BIGP(bf16_t, B_MERGED), WSP(bf16_t, WS_WOUT), stok, D, D}; pg8::StaticOrder S; S.init(stok, D, c.G, c.bid);
                pg8::EpiRes E{WSP(bf16_t, WS_XB) + sbase * D, (bf16_t*)c.out + sbase * D};
                pg8::gemm_phase<pg8::EpiRes, pg8::StaticOrder>(L, g, S, E); } PH_END
#ifndef LN1PROBE
#define LN1PROBE 0
#endif
            PH_BEGIN(7) if (LN1PROBE) { c.dry = 1; phase_ln1(ka, L, c); __syncthreads(); c.dry = 0; } phase_ln1(ka, L, c); PH_END
        }
        PH_BEGIN(8) phase_select(ka, L, c, c.bid < 16 ? 16 + c.bid : -1); PH_END
        PH_BEGIN(9) phase_gather(ka, L, c); PH_END
        for (int half = 0; half < 2; ++half) {
            PH_BEGIN(10) {
                pg8::Gemm g{BIGP(bf16_t, half ? B_XY1 : B_XY0), (const bf16_t*)(WSP(unsigned char, WS_WGU) + (size_t)half * 8 * 4096 * D), 8 * CAP, 8 * 4096, D / 2}; pg8::MoeOrder S; S.init(8, CAP / 256, 16, c.G, c.bid);
                pg8::EpiSwiglu E{BIGP(unsigned char, B_HID)};
                pg8::gemm_phase<pg8::EpiSwiglu, pg8::MoeOrder>(L, g, S, E); } PH_END
            PH_BEGIN(11) {
                pg8::Gemm g{BIGP(bf16_t, B_HID), (const bf16_t*)(WSP(unsigned char, WS_WD) + (size_t)half * 8 * D * DE), 8 * CAP, 8 * D, DE / 2}; pg8::MoeOrder S; S.init(8, CAP / 256, 4, c.G, c.bid);
                pg8::EpiDown E{BIGP(bf16_t, half ? B_XY1 : B_XY0), WSP(float, WS_GATEV) + (size_t)half * 8 * CAP};
                pg8::gemm_phase<pg8::EpiDown, pg8::MoeOrder>(L, g, S, E); } PH_END
        }
        PH_BEGIN(12) phase_ln2(ka, L, c); PH_END
    }
#undef PH_BEGIN
#undef PH_END
}

constexpr int N_PHASES = 2 * (1 + NSLAB * 7 + 2 + 4 + 1);

extern "C" void kernel_launch(void* const* d_in, const int* in_sizes, int n_in, void* d_out, int out_size, void* d_ws, size_t ws_size, hipStream_t stream) {
    static int grid = 0;
    if (grid == 0) {
        if (n_in != 20 || ws_size < WS_END) { fprintf(stderr, "kernel_launch: unexpected n_in %d or ws_size %zu (< %zu)\n", n_in, ws_size, (size_t)WS_END); grid = -1; return; }
        int dev = 0, cus = 0, per_cu = 0;
        if (hipGetDevice(&dev) != hipSuccess || hipDeviceGetAttribute(&cus, hipDeviceAttributeMultiprocessorCount, dev) != hipSuccess) { grid = -1; return; }
        if (hipFuncSetAttribute((const void*)fwd_kernel, hipFuncAttributeMaxDynamicSharedMemorySize, LDS_BYTES) != hipSuccess) { fprintf(stderr, "kernel_launch: hipFuncSetAttribute failed\n"); grid = -1; return; }
        if (hipOccupancyMaxActiveBlocksPerMultiprocessor(&per_cu, (const void*)fwd_kernel, 512, LDS_BYTES) != hipSuccess || per_cu < 1) fprintf(stderr, "kernel_launch: occupancy query says %d\n", per_cu);
        (void)hipGetLastError();
        grid = cus;
    }
    if (grid < 0) return;
    (void)hipMemsetAsync((char*)d_ws + WS_CTL, 0, 1 * MiB, stream);
    Args a{};
    for (int i = 0; i < 20; ++i) a.in[i] = (const float*)d_in[i];
    a.out = (float*)d_out; a.ws = (unsigned char*)d_ws;
#if MK_N_LAUNCHES == 1
    a.ph_lo = 0; a.ph_hi = N_PHASES;
    hipLaunchKernelGGL(fwd_kernel, dim3(grid), dim3(512), LDS_BYTES, stream, a);
#else
    for (int p = 0; p < N_PHASES; ++p) { a.ph_lo = p; a.ph_hi = p + 1; hipLaunchKernelGGL(fwd_kernel, dim3(grid), dim3(512), LDS_BYTES, stream, a); }
#endif
}
```
